# Optimizing an MI355X kernel written in HIP

```python
import jax, jax.numpy as jnp
from jax import lax
import numpy as np

D_MODEL = 1024
BATCH = 4
SEQ = 4096
DEPTH = 1

HEAD_DIM = 64
SWA_Q_HEADS = 8
SWA_KV_HEADS = 2
SWA_GROUP = SWA_Q_HEADS // SWA_KV_HEADS
WINDOW = 128
BLOCK = 128
FOX_HEADS = 8
SWA_WIDTH = SWA_Q_HEADS * HEAD_DIM
SWA_KV_WIDTH = SWA_KV_HEADS * HEAD_DIM
FOX_WIDTH = FOX_HEADS * HEAD_DIM
NUM_BUCKETS = 32
MAX_DISTANCE = 128
PEER_HEADS = 8
N_KEYS = 128
N_EXPERTS = N_KEYS * N_KEYS
PEER_TOPK = 16
PEER_QDIM = 128
PEER_HALF = PEER_QDIM // 2
PEER_CHUNK = 128
N_MOD = 6
EPS = 1e-6
NEG = -1e30
IN_SPLITS = (SWA_WIDTH, SWA_KV_WIDTH, SWA_KV_WIDTH, FOX_WIDTH, FOX_WIDTH, FOX_WIDTH, FOX_HEADS, D_MODEL, D_MODEL)
IN_WIDTH = sum(IN_SPLITS)
IN_OFFSETS = tuple(int(o) for o in np.cumsum(IN_SPLITS)[:-1])

kernel_name = "gated_swa_fox_peer_hybrid"


def _rmsnorm(x, g):
    xf = x.astype(jnp.float32)
    xf = xf * lax.rsqrt(jnp.mean(xf * xf, axis=-1, keepdims=True) + EPS)
    return xf.astype(x.dtype) * g


def _modulate(h, shift, scale):
    return h * (1 + scale[:, None, :]) + shift[:, None, :]


def _t5_bucket(dist):
    dist = np.clip(dist, 0, None)
    max_exact = NUM_BUCKETS // 2
    large = max_exact + (np.log(np.maximum(dist, 1) / max_exact) / np.log(MAX_DISTANCE / max_exact)
                         * (NUM_BUCKETS - max_exact)).astype(np.int32)
    large = np.minimum(large, NUM_BUCKETS - 1)
    return np.where(dist < max_exact, dist, large).astype(np.int32)


def _swa_attention(q, k, v, sinks, rel_bias):
    B, S = q.shape[0], q.shape[1]
    nb = S // BLOCK
    q = q.reshape(B, nb, BLOCK, SWA_KV_HEADS, SWA_GROUP, HEAD_DIM)
    k = k.reshape(B, S, SWA_KV_HEADS, HEAD_DIM)
    v = v.reshape(B, S, SWA_KV_HEADS, HEAD_DIM)

    def band(t):
        tp = jnp.pad(t, ((0, 0), (BLOCK, 0), (0, 0), (0, 0)))
        prev = tp[:, :S].reshape(B, nb, BLOCK, SWA_KV_HEADS, HEAD_DIM)
        return jnp.concatenate([prev, t.reshape(B, nb, BLOCK, SWA_KV_HEADS, HEAD_DIM)], axis=2)

    kb, vb = band(k), band(v)
    logits = jnp.einsum('bnqhgd,bnkhd->bnhgqk', q, kb).astype(jnp.float32) * (HEAD_DIM ** -0.5)
    qi = np.arange(BLOCK)[:, None]
    kj = np.arange(2 * BLOCK)[None, :]
    dist = qi + BLOCK - kj
    in_band = (dist >= 0) & (dist < WINDOW)
    key_exists = (np.arange(nb)[:, None, None] * BLOCK + kj[None] - BLOCK) >= 0
    valid = in_band[None] & key_exists
    bias = rel_bias[_t5_bucket(dist)].astype(jnp.float32)
    bias = jnp.transpose(bias, (2, 0, 1)).reshape(SWA_KV_HEADS, SWA_GROUP, BLOCK, 2 * BLOCK)
    logits = logits + bias[None, None]
    logits = jnp.where(valid[None, :, None, None], logits, NEG)
    sink = jnp.broadcast_to(sinks.astype(jnp.float32).reshape(SWA_KV_HEADS, SWA_GROUP, 1, 1),
                            logits.shape[:-1] + (1,))
    p = jax.nn.softmax(jnp.concatenate([logits, sink], axis=-1), axis=-1)[..., :-1]
    o = jnp.einsum('bnhgqk,bnkhd->bnqhgd', p.astype(v.dtype), vb)
    return o.reshape(B, S, SWA_WIDTH)


def _fox_attention(q, k, v, log_f):
    B, S = q.shape[0], q.shape[1]
    nb = S // BLOCK
    q = q.reshape(B, S, FOX_HEADS, HEAD_DIM)
    k = k.reshape(B, S, FOX_HEADS, HEAD_DIM)
    v = v.reshape(B, S, FOX_HEADS, HEAD_DIM)
    F = jnp.transpose(jnp.cumsum(log_f, axis=1), (0, 2, 1))
    qb = jnp.transpose(q.reshape(B, nb, BLOCK, FOX_HEADS, HEAD_DIM), (1, 0, 2, 3, 4))
    Fb = jnp.transpose(F.reshape(B, FOX_HEADS, nb, BLOCK), (2, 0, 1, 3))
    kpos = jnp.arange(S)

    def block(args):
        qi, Fi, n = args
        s = jnp.einsum('bqhd,bkhd->bhqk', qi, k).astype(jnp.float32) * (HEAD_DIM ** -0.5)
        s = s + Fi[..., :, None] - F[:, :, None, :]
        qpos = n * BLOCK + jnp.arange(BLOCK)
        s = jnp.where((kpos[None, :] <= qpos[:, None])[None, None], s, NEG)
        p = jax.nn.softmax(s, axis=-1)
        return jnp.einsum('bhqk,bkhd->bqhd', p.astype(v.dtype), v)

    out = lax.map(block, (qb, Fb, jnp.arange(nb)))
    return jnp.transpose(out, (1, 0, 2, 3, 4)).reshape(B, S, FOX_WIDTH)


def _peer(h, w_query, sub_keys, expert_down, expert_up):
    B, S, D = h.shape
    ht = h.reshape(-1, PEER_CHUNK, D)

    def chunk(xc):
        T = xc.shape[0]
        q = (xc @ w_query).reshape(T, PEER_HEADS, 2, PEER_HALF)
        s = jnp.einsum('thpd,hpkd->thpk', q, sub_keys).astype(jnp.float32)
        s1, i1 = lax.top_k(s[:, :, 0], PEER_TOPK)
        s2, i2 = lax.top_k(s[:, :, 1], PEER_TOPK)
        cand = (s1[..., :, None] + s2[..., None, :]).reshape(T, PEER_HEADS, PEER_TOPK * PEER_TOPK)
        cidx = (i1[..., :, None] * N_KEYS + i2[..., None, :]).reshape(T, PEER_HEADS, PEER_TOPK * PEER_TOPK)
        top, pos = lax.top_k(cand, PEER_TOPK)
        idx = jnp.take_along_axis(cidx, pos, axis=-1)
        g = jax.nn.softmax(top, axis=-1).astype(xc.dtype)
        u = expert_down[idx]
        act = jax.nn.gelu(jnp.einsum('td,thkd->thk', xc, u), approximate=False)
        vv = expert_up[idx]
        return jnp.einsum('thk,thkd->td', g * act, vv)

    return lax.map(chunk, ht).reshape(B, S, D)


def setup_inputs(seed: int = 0) -> dict:
    key = jax.random.key(seed)
    ks = jax.random.split(key, 20)
    f32 = jnp.float32
    nrm = lambda k, shape, s: jax.random.normal(k, shape, f32) * s
    return {
        "x": nrm(ks[0], (BATCH, SEQ, D_MODEL), 1.0),
        "c": nrm(ks[1], (BATCH, D_MODEL), 1.0),
        "norm_mix_g": 1.0 + nrm(ks[2], (DEPTH, D_MODEL), 0.02),
        "norm_ffn_g": 1.0 + nrm(ks[3], (DEPTH, D_MODEL), 0.02),
        "w_ada": nrm(ks[4], (DEPTH, D_MODEL, N_MOD * D_MODEL), 0.5 * D_MODEL ** -0.5),
        "b_ada": nrm(ks[5], (DEPTH, N_MOD * D_MODEL), 0.02),
        "w_in": nrm(ks[6], (DEPTH, D_MODEL, IN_WIDTH), D_MODEL ** -0.5),
        "b_forget": 2.0 + nrm(ks[7], (DEPTH, FOX_HEADS), 0.5),
        "sinks": nrm(ks[8], (DEPTH, SWA_Q_HEADS), 0.5),
        "w_branch_a": nrm(ks[9], (DEPTH, SWA_WIDTH, D_MODEL), SWA_WIDTH ** -0.5),
        "w_branch_b": nrm(ks[10], (DEPTH, FOX_WIDTH, D_MODEL), FOX_WIDTH ** -0.5),
        "w_out": nrm(ks[11], (DEPTH, D_MODEL, D_MODEL), D_MODEL ** -0.5),
        "rel_bias": nrm(ks[12], (NUM_BUCKETS, SWA_Q_HEADS), 0.5),
        "w_query": nrm(ks[13], (DEPTH, D_MODEL, PEER_HEADS * PEER_QDIM), D_MODEL ** -0.5),
        "sub_keys": nrm(ks[14], (DEPTH, PEER_HEADS, 2, N_KEYS, PEER_HALF), PEER_HALF ** -0.5),
        "expert_down": nrm(ks[15], (DEPTH, N_EXPERTS, D_MODEL), D_MODEL ** -0.5),
        "expert_up": nrm(ks[16], (DEPTH, N_EXPERTS, D_MODEL), 0.3),
        "final_norm_g": 1.0 + nrm(ks[17], (D_MODEL,), 0.02),
    }


def reference(x, c, norm_mix_g, norm_ffn_g, w_ada, b_ada, w_in, b_forget, sinks, w_branch_a,
              w_branch_b, w_out, rel_bias, w_query, sub_keys, expert_down, expert_up, final_norm_g):
    c_act = jax.nn.silu(c)
    for l in range(DEPTH):
        mod = c_act @ w_ada[l] + b_ada[l]
        sh1, sc1, gt1, sh2, sc2, gt2 = jnp.split(mod, N_MOD, axis=-1)

        h = _modulate(_rmsnorm(x, norm_mix_g[l]), sh1, sc1)
        proj = h @ w_in[l]
        qa, ka, va, qb, kb, vb, fl, gla, glb = jnp.split(proj, IN_OFFSETS, axis=-1)
        log_f = jax.nn.log_sigmoid((fl + b_forget[l]).astype(jnp.float32))
        oa = _swa_attention(qa, ka, va, sinks[l], rel_bias)
        ob = _fox_attention(qb, kb, vb, log_f)
        mixed = jax.nn.sigmoid(gla) * (oa @ w_branch_a[l]) + jax.nn.sigmoid(glb) * (ob @ w_branch_b[l])
        x = x + gt1[:, None, :] * (mixed @ w_out[l])

        h2 = _modulate(_rmsnorm(x, norm_ffn_g[l]), sh2, sc2)
        x = x + gt2[:, None, :] * _peer(h2, w_query[l], sub_keys[l], expert_down[l], expert_up[l])
    return _rmsnorm(x, final_norm_g)
```

```cpp
#include <hip/hip_runtime.h>
#include <cstdio>
#include <cstdint>
namespace pg8 {
#define PG8_LAS __attribute__((address_space(3)))
typedef unsigned short bf16_t;
typedef short bf16x8 __attribute__((ext_vector_type(8)));
typedef float f32x4 __attribute__((ext_vector_type(4)));
typedef unsigned u32x4 __attribute__((ext_vector_type(4)));
constexpr int BM = 256, BK = 64, HALF = 128, HTB = HALF * BK * 2  , STAGE_BYTES = 8 * HTB, NXCD = 8, WGM = 8;

__host__ __device__ __forceinline__ int lds_byte(int r, int c) { const int st = (r >> 4) * 2 + (c >> 5), rr = r & 15, cc = c & 31, ob = rr * 64 + cc * 2; return st * 1024 + (ob ^ (((ob >> 9) & 1) << 5)); }
__host__ __device__ __forceinline__ void stage_rc(int b, int& R, int& C) { const int st = b / 1024, sb = b % 1024, swz = sb ^ (((sb >> 9) & 1) << 5); R = (st >> 1) * 16 + swz / 64; C = (st & 1) * 32 + (swz % 64) / 2; }
__host__ __device__ __forceinline__ int perm32(int rho) { const int n = rho >> 4, i = rho & 15; return 8 * (i >> 2) + 4 * n + (i & 3); }

struct Unit { int pm, pn, src; };
struct Gemm { const bf16_t* A; const bf16_t* Bt; int M, N, K; const bf16_t* A2; const bf16_t* Bt2; };

struct StaticOrder {
    int nM, nN, nwg, G, c;
    __host__ __device__ void init(int M, int N, int G_, int c_) { nM = M / BM; nN = N / BM; nwg = nM * nN; G = G_; c = c_; }
    __host__ __device__ bool next(int i, Unit& u) const {
        const long L = (long)i * G + c; if (L >= nwg) return false;
        int wgid = (int)L; { const int q = nwg / NXCD, r = nwg % NXCD, xcd = wgid % NXCD, off = wgid / NXCD; wgid = (xcd < r ? xcd * (q + 1) : r * (q + 1) + (xcd - r) * q) + off; }
        const int nig = WGM * nN, gid = wgid / nig, fm = gid * WGM, gsz = (nM - fm) < WGM ? (nM - fm) : WGM;
        u.pm = fm + ((wgid % nig) % gsz); u.pn = (wgid % nig) / gsz; u.src = 0; return true;
    }
    __device__ __forceinline__ void a_ready(const Unit&) const {}
    __device__ __forceinline__ void done(const Unit&) const {}
};

__device__ __forceinline__ unsigned cvt_pk_bf16(float lo, float hi) { unsigned r; asm volatile("v_cvt_pk_bf16_f32 %0, %1, %2" : "=v"(r) : "v"(lo), "v"(hi)); return r; }
typedef float f32x2 __attribute__((ext_vector_type(2)));
__device__ __forceinline__ f32x2 gelu_pk(f32x2 v) {
    const f32x2 av = __builtin_elementwise_abs(v), d = av * 0.2316418882f + 1.0f;
    f32x2 t; t.x = __builtin_amdgcn_rcpf(d.x); t.y = __builtin_amdgcn_rcpf(d.y);
    f32x2 q = t * 0.5307027145f + (-0.7265760135f); q = q * t + 0.7107068705f; q = q * t + (-0.142248368f); q = q * t + 0.127414796f; q = q * t;
    const f32x2 s = (v * v) * (-0.72134752044f);
    f32x2 e; e.x = __builtin_amdgcn_exp2f(s.x); e.y = __builtin_amdgcn_exp2f(s.y);
    const f32x2 m = v * (q * e), r = v - m;
    f32x2 o; o.x = v.x < 0.f ? m.x : r.x; o.y = v.y < 0.f ? m.y : r.y; return o;
}

template <int ACT  > struct EpiBf16 {
    static constexpr bool PERM = true, AFTER_DRAIN = false; static_assert(ACT == 0 || ACT == 1, "EpiBf16: ACT is 0 (none) or 1 (gelu_pk)");
    bf16_t* O; int ldc; const float* bias; int split_cols; size_t split_stride; float scale0;
    __device__ __forceinline__ void operator()(const f32x4 (&acc)[2][2][4][2], const Unit& u, int wr, int wc, int fr, int fq) const {
        const int row0 = u.pm * BM + wr * 64 + fr; int colt = u.pn * BM; bf16_t* base = O;
        float sc = 1.f; if (split_cols) { const int t = colt / split_cols; base += (size_t)t * split_stride; colt -= t * split_cols; if (t == 0) sc = scale0; }
        const int col0 = colt + wc * 32 + 8 * fq, bcol0 = u.pn * BM + wc * 32 + 8 * fq;
        f32x4 bv[2][2];
#pragma unroll
        for (int bj = 0; bj < 2; ++bj)
#pragma unroll
            for (int n = 0; n < 2; ++n) bv[bj][n] = bias ? *(const f32x4*)(bias + bcol0 + bj * HALF + 4 * n) : (f32x4){0.f, 0.f, 0.f, 0.f};
#pragma unroll
        for (int ai = 0; ai < 2; ++ai)
#pragma unroll
            for (int m = 0; m < 4; ++m) { bf16_t* rowp = base + (size_t)(row0 + ai * HALF + m * 16) * ldc + col0;
#pragma unroll
                for (int bj = 0; bj < 2; ++bj) { f32x4 v0 = acc[ai][bj][m][0] + bv[bj][0], v1 = acc[ai][bj][m][1] + bv[bj][1];
                    if (ACT == 1) { f32x2 a = gelu_pk((f32x2){v0[0], v0[1]}), b = gelu_pk((f32x2){v0[2], v0[3]}), c = gelu_pk((f32x2){v1[0], v1[1]}), d = gelu_pk((f32x2){v1[2], v1[3]});
                        v0 = (f32x4){a.x, a.y, b.x, b.y}; v1 = (f32x4){c.x, c.y, d.x, d.y}; }
                    v0 = v0 * sc; v1 = v1 * sc; u32x4 w; w.x = cvt_pk_bf16(v0[0], v0[1]); w.y = cvt_pk_bf16(v0[2], v0[3]); w.z = cvt_pk_bf16(v1[0], v1[1]); w.w = cvt_pk_bf16(v1[2], v1[3]);
                    *(u32x4*)(rowp + bj * HALF) = w; } }
    }
};

template <class Epi, class Sched, bool ALIGN_EPI = false, bool SP2 = false>
__device__ __forceinline__ void gemm_phase(PG8_LAS unsigned char* lds, const Gemm g, const Sched& S, const Epi& E) {
    const int tid = threadIdx.x, wid = __builtin_amdgcn_readfirstlane(tid >> 6), lane = tid & 63, wr = wid >> 2, wc = wid & 3, fr = lane & 15, fq = lane >> 4;
    const int K = g.K, nt = K / BK;
    unsigned voffA[2], voffB[2];
#pragma unroll
    for (int i = 0; i < 2; ++i) { int R, C; stage_rc(tid * 16 + i * 8192, R, C); const int Rb = Epi::PERM ? ((R & ~31) + perm32(R & 31)) : R;
        voffA[i] = (unsigned)(R * K + C) * 2u; voffB[i] = (unsigned)(Rb * K + C) * 2u; }
    const size_t kstep = (size_t)(BK * 2);
    const size_t hstep = (size_t)HALF * K * 2;
    const size_t tstep = 2 * hstep;
    const unsigned ldsw = (unsigned)wid * 1024u;
    const int aoff = lds_byte(wr * 64 + fr, fq * 8), boff = lds_byte(wc * 32 + fr, fq * 8);
#define PG8_SA(b, h) (((b) * 2 + (h)) * HTB)
#define PG8_SB(b, h) ((4 + (b) * 2 + (h)) * HTB)
#define PG8_STAGE(bufoff, gbase, voff) do { _Pragma("unroll") for (int _i = 0; _i < 2; ++_i) \
        __builtin_amdgcn_global_load_lds((const unsigned*)((const char*)(gbase) + (voff)[_i]), (PG8_LAS unsigned*)(lds + (bufoff) + ldsw + _i * 8192), 16, 0, 0); } while (0)
#define PG8_LDA(dst, b, h) do { _Pragma("unroll") for (int m = 0; m < 4; ++m) _Pragma("unroll") for (int k = 0; k < 2; ++k) dst[m][k] = *(const PG8_LAS bf16x8*)(lds + PG8_SA(b, h) + aoff + m * 2048 + k * 1024); } while (0)
#define PG8_LDB(dst, b, h) do { _Pragma("unroll") for (int n = 0; n < 2; ++n) _Pragma("unroll") for (int k = 0; k < 2; ++k) dst[n][k] = *(const PG8_LAS bf16x8*)(lds + PG8_SB(b, h) + boff + n * 2048 + k * 1024); } while (0)
#define PG8_MMA(ai, bj, At, Bt) do { __builtin_amdgcn_s_setprio(1); _Pragma("unroll") for (int m = 0; m < 4; ++m) _Pragma("unroll") for (int n = 0; n < 2; ++n) _Pragma("unroll") for (int k = 0; k < 2; ++k) \
        acc[ai][bj][m][n] = __builtin_amdgcn_mfma_f32_16x16x32_bf16(Bt[n][k], At[m][k], acc[ai][bj][m][n], 0, 0, 0); __builtin_amdgcn_s_setprio(0); } while (0)
#define PG8_WAIT_V(n) asm volatile("s_waitcnt vmcnt(" #n ")" ::: "memory")
#define PG8_WAIT_L(n) asm volatile("s_waitcnt lgkmcnt(" #n ")" ::: "memory")
#define PG8_BAR __builtin_amdgcn_s_barrier()
#define PG8_SCHED __builtin_amdgcn_sched_barrier(0)
    Unit cur, nxt; int ui = 0;
    if (!S.next(0, cur)) return;
    f32x4 acc[2][2][4][2];
#pragma unroll
    for (int a = 0; a < 2; ++a)
#pragma unroll
        for (int b = 0; b < 2; ++b)
#pragma unroll
            for (int m = 0; m < 4; ++m)
#pragma unroll
                for (int n = 0; n < 2; ++n) acc[a][b][m][n] = (f32x4){0.f, 0.f, 0.f, 0.f};
    bf16x8 At[4][2], B0[2][2], B1[2][2];
    const char* cA = (const char*)(cur.src ? g.A2 : g.A) + (size_t)cur.pm * tstep; const char* cB = (const char*)(cur.src ? g.Bt2 : g.Bt) + (size_t)cur.pn * tstep;
    S.a_ready(cur);
    if constexpr (SP2) {
        PG8_STAGE(PG8_SB(0, 0), cB, voffB); PG8_STAGE(PG8_SB(0, 1), cB + hstep, voffB); PG8_STAGE(PG8_SA(0, 0), cA, voffA); PG8_STAGE(PG8_SA(0, 1), cA + hstep, voffA);
        if (wr == 1) PG8_BAR;
        PG8_WAIT_V(2); PG8_BAR;
        PG8_STAGE(PG8_SB(1, 0), cB + kstep, voffB); PG8_STAGE(PG8_SA(1, 0), cA + kstep, voffA); PG8_STAGE(PG8_SB(1, 1), cB + hstep + kstep, voffB);
        PG8_WAIT_V(6); PG8_BAR;
    } else {
        PG8_STAGE(PG8_SB(0, 0), cB, voffB); PG8_STAGE(PG8_SA(0, 0), cA, voffA); PG8_STAGE(PG8_SB(0, 1), cB + hstep, voffB); PG8_STAGE(PG8_SA(0, 1), cA + hstep, voffA);
        if (wr == 1) PG8_BAR;
        PG8_WAIT_V(4); PG8_BAR;
        PG8_STAGE(PG8_SB(1, 0), cB + kstep, voffB); PG8_STAGE(PG8_SA(1, 0), cA + kstep, voffA); PG8_STAGE(PG8_SB(1, 1), cB + hstep + kstep, voffB);
        PG8_WAIT_V(6); PG8_BAR;
    }
    for (;;) {
        const bool has_next = S.next(ui + 1, nxt);
        const char* nA = has_next ? (const char*)(nxt.src ? g.A2 : g.A) + (size_t)nxt.pm * tstep : cA; const char* nB = has_next ? (const char*)(nxt.src ? g.Bt2 : g.Bt) + (size_t)nxt.pn * tstep : cB;
        for (int t = 0; t < nt; t += 2) {
            const bool last = (t == nt - 2);
            const char* a1 = cA + (size_t)(t + 1) * kstep;
            const char* a2 = last ? nA : cA + (size_t)(t + 2) * kstep; const char* b2 = last ? nB : cB + (size_t)(t + 2) * kstep;
            const char* a3 = a2 + kstep; const char* b3 = b2 + kstep;
            if (last && has_next) S.a_ready(nxt);
            if constexpr (SP2) {
            PG8_LDB(B0, 0, 0); PG8_LDB(B1, 0, 1); PG8_SCHED; PG8_LDA(At, 0, 0); PG8_STAGE(PG8_SA(1, 1), a1 + hstep, voffA);
            PG8_WAIT_V(8); PG8_WAIT_L(0); PG8_BAR; PG8_MMA(0, 0, At, B0); PG8_MMA(0, 1, At, B1); PG8_BAR; PG8_SCHED;
            PG8_LDA(At, 0, 1); PG8_STAGE(PG8_SB(0, 0), b2, voffB); PG8_STAGE(PG8_SB(0, 1), b2 + hstep, voffB); PG8_STAGE(PG8_SA(0, 0), a2, voffA);
            PG8_WAIT_V(8); PG8_WAIT_L(0); PG8_BAR; PG8_MMA(1, 0, At, B0); PG8_MMA(1, 1, At, B1); PG8_BAR; PG8_SCHED;
            PG8_LDB(B0, 1, 0); PG8_LDB(B1, 1, 1); PG8_SCHED; PG8_LDA(At, 1, 0); PG8_STAGE(PG8_SA(0, 1), a2 + hstep, voffA);
            PG8_WAIT_V(8); PG8_WAIT_L(0); PG8_BAR; PG8_MMA(0, 0, At, B0); PG8_MMA(0, 1, At, B1); PG8_BAR; PG8_SCHED;
            PG8_LDA(At, 1, 1); PG8_STAGE(PG8_SB(1, 0), b3, voffB); PG8_STAGE(PG8_SB(1, 1), b3 + hstep, voffB); PG8_STAGE(PG8_SA(1, 0), a3, voffA);
            PG8_WAIT_V(8); PG8_WAIT_L(0); PG8_BAR; PG8_MMA(1, 0, At, B0); PG8_MMA(1, 1, At, B1); PG8_BAR; PG8_SCHED;
            } else {
            PG8_LDB(B0, 0, 0); PG8_SCHED; PG8_LDA(At, 0, 0); PG8_STAGE(PG8_SA(1, 1), a1 + hstep, voffA);
            PG8_WAIT_L(8); PG8_BAR; PG8_WAIT_L(0); PG8_MMA(0, 0, At, B0); PG8_BAR; PG8_SCHED;
            PG8_LDB(B1, 0, 1); PG8_STAGE(PG8_SB(0, 0), b2, voffB);
            PG8_BAR; PG8_WAIT_L(0); PG8_MMA(0, 1, At, B1); PG8_BAR;
            PG8_LDA(At, 0, 1); PG8_STAGE(PG8_SA(0, 0), a2, voffA);
            PG8_BAR; PG8_WAIT_L(0); PG8_MMA(1, 0, At, B0); PG8_BAR; PG8_SCHED;
            PG8_STAGE(PG8_SB(0, 1), b2 + hstep, voffB);
            PG8_WAIT_V(6); PG8_BAR; PG8_MMA(1, 1, At, B1); PG8_BAR;
            PG8_LDB(B0, 1, 0); PG8_SCHED; PG8_LDA(At, 1, 0); PG8_STAGE(PG8_SA(0, 1), a2 + hstep, voffA);
            PG8_WAIT_L(8); PG8_BAR; PG8_WAIT_L(0); PG8_MMA(0, 0, At, B0); PG8_BAR; PG8_SCHED;
            PG8_LDB(B1, 1, 1); PG8_STAGE(PG8_SB(1, 0), b3, voffB);
            PG8_BAR; PG8_WAIT_L(0); PG8_MMA(0, 1, At, B1); PG8_BAR;
            PG8_LDA(At, 1, 1); PG8_STAGE(PG8_SA(1, 0), a3, voffA);
            PG8_BAR; PG8_WAIT_L(0); PG8_MMA(1, 0, At, B0); PG8_BAR; PG8_SCHED;
            PG8_STAGE(PG8_SB(1, 1), b3 + hstep, voffB);
            PG8_WAIT_V(6); PG8_BAR; PG8_MMA(1, 1, At, B1); PG8_BAR;
            }
        }
        if constexpr (ALIGN_EPI) { if (wr == 0) PG8_BAR; }
        if constexpr (!Epi::AFTER_DRAIN) { E(acc, cur, wr, wc, fr, fq); S.done(cur); }
        if (!has_next) break;
#pragma unroll
        for (int a = 0; a < 2; ++a)
#pragma unroll
            for (int b = 0; b < 2; ++b)
#pragma unroll
                for (int m = 0; m < 4; ++m)
#pragma unroll
                    for (int n = 0; n < 2; ++n) acc[a][b][m][n] = (f32x4){0.f, 0.f, 0.f, 0.f};
        cur = nxt; cA = nA; cB = nB; ++ui;
        if constexpr (ALIGN_EPI) { if (wr == 1) PG8_BAR; }
    }
    PG8_WAIT_V(0);
    if constexpr (!ALIGN_EPI) { if (wr == 0) PG8_BAR; }
    PG8_BAR;
    if constexpr (Epi::AFTER_DRAIN) { E.fused(acc, cur, wr, wc, fr, fq, lds, wid, lane); S.done(cur); }
#undef PG8_SA
#undef PG8_SB
#undef PG8_STAGE
#undef PG8_LDA
#undef PG8_LDB
#undef PG8_MMA
#undef PG8_WAIT_V
#undef PG8_WAIT_L
#undef PG8_BAR
#undef PG8_SCHED
}
}

#define GAS __attribute__((address_space(1)))
#define LAS __attribute__((address_space(3)))
typedef unsigned short bf16;
typedef unsigned v4u __attribute__((ext_vector_type(4)));
typedef float f32x4 __attribute__((ext_vector_type(4)));
typedef short bf16x8 __attribute__((ext_vector_type(8)));
typedef GAS unsigned gu32;
typedef GAS unsigned long long gu64;
#define RLX_AGENT __ATOMIC_RELAXED, __HIP_MEMORY_SCOPE_AGENT
#define LDS_WAIT() asm volatile("s_waitcnt lgkmcnt(0)" ::: "memory")
#define VM_WAIT() asm volatile("s_waitcnt vmcnt(0)" ::: "memory")
__device__ __forceinline__ unsigned long long rt() { return __builtin_amdgcn_s_memrealtime(); }
__device__ __forceinline__ unsigned f2bf(float f) { unsigned u = __builtin_bit_cast(unsigned, f); return (u + 0x7fffu + ((u >> 16) & 1u)) >> 16; }
__device__ __forceinline__ unsigned pk2(float lo, float hi) { return f2bf(lo) | (f2bf(hi) << 16); }

#define XB_TMO      128
#define XB_XCNT(j)  (256  + 64 * (j))
#define XB_XSUB(j)  (1280 + 64 * (j))
#define XB_XGEN(j)  (2304 + 64 * (j))
#define XB_TOP      3328
#define XB_TOPGEN   3392
#define XCD_BAR_WORDS 3456
#define XB_SPIN_CAP (1u << 18)

__device__ __forceinline__ unsigned xb_ld(unsigned* p)              { return __hip_atomic_load(p, __ATOMIC_RELAXED, __HIP_MEMORY_SCOPE_AGENT); }
__device__ __forceinline__ unsigned xb_add(unsigned* p, unsigned v) { return __hip_atomic_fetch_add(p, v, __ATOMIC_RELAXED, __HIP_MEMORY_SCOPE_AGENT); }
__device__ __forceinline__ unsigned xb_xcc_id() { return (unsigned)__builtin_amdgcn_s_getreg((3 << 11) | 20) & 0xFu; }
#define XB_SPIN(cond, bar) do { unsigned _sp = 0; while (cond) { __builtin_amdgcn_s_sleep(1); \
    if ((++_sp & 255u) == 0u) { if (xb_ld(&(bar)[XB_TMO])) break; if (_sp > XB_SPIN_CAP) { atomicAdd(&(bar)[XB_TMO], 1u); break; } } } } while (0)

struct XcdBarrier {
    unsigned* bar; unsigned x;
    volatile LAS unsigned* st;
};

__device__ __forceinline__ XcdBarrier xcd_barrier_post(unsigned* bar, volatile LAS unsigned* st) {
    XcdBarrier b; b.bar = bar; b.x = xb_xcc_id(); b.st = st;
    if (threadIdx.x == 0) (void)xb_add(&bar[XB_XCNT(b.x)], 1u);
    return b;
}
__device__ __forceinline__ void xcd_barrier_complete(unsigned* bar, unsigned x, unsigned& nloc, unsigned& nx) {
    const unsigned G = gridDim.x * gridDim.y * gridDim.z;
    unsigned sum, cnt, mine, sp = 0u;
    for (;;) {
        sum = 0u; cnt = 0u; mine = 0u;
#pragma unroll
        for (unsigned j = 0; j < 16; ++j) { const unsigned c = xb_ld(&bar[XB_XCNT(j)]); sum += c; cnt += (c > 0u) ? 1u : 0u; mine = (j == x) ? c : mine; }
        if (sum == G) break;
        __builtin_amdgcn_s_sleep(1);
        if ((++sp & 255u) == 0u) { if (xb_ld(&bar[XB_TMO])) break; if (sp > XB_SPIN_CAP) { atomicAdd(&bar[XB_TMO], 1u); break; } }
    }
    nloc = mine > 0u ? mine : 1u; nx = cnt > 0u ? cnt : 1u;
}

__device__ __forceinline__ void xcd_barrier(const XcdBarrier& b) {
    asm volatile("s_waitcnt vmcnt(0)" ::: "memory");
    __syncthreads();
    if (threadIdx.x == 0) {
        unsigned* bar = b.bar;
        __builtin_amdgcn_s_waitcnt(0);
        unsigned nloc = b.st[0], nx = b.st[1];
        if (nloc == 0u) { xcd_barrier_complete(bar, b.x, nloc, nx); b.st[0] = nloc; b.st[1] = nx; }
        const unsigned old = xb_add(&bar[XB_XSUB(b.x)], 1u);
        const unsigned gen = old / nloc;
        if (old + 1u == (gen + 1u) * nloc) {
            __builtin_amdgcn_fence(__ATOMIC_RELEASE, "agent");
            asm volatile("s_waitcnt vmcnt(0)" ::: "memory");
            const unsigned og = xb_add(&bar[XB_TOP], 1u);
            const unsigned tg = og / nx;
            if (og + 1u == (tg + 1u) * nx) xb_add(&bar[XB_TOPGEN], 1u);
            else XB_SPIN(xb_ld(&bar[XB_TOPGEN]) == tg, bar);
            __builtin_amdgcn_fence(__ATOMIC_ACQUIRE, "agent");
            xb_add(&bar[XB_XGEN(b.x)], 1u);
            asm volatile("s_waitcnt vmcnt(0)" ::: "memory");
        } else {
            XB_SPIN(xb_ld(&bar[XB_XGEN(b.x)]) == gen, bar);
            __builtin_amdgcn_fence(__ATOMIC_ACQUIRE, "agent");
            asm volatile("s_waitcnt vmcnt(0)" ::: "memory");
        }
    }
    __syncthreads();
}

constexpr int NWAVES = 8, NTHR = 512;
constexpr int BATCH = 4, SEQ = 4096, D = 1024, M = BATCH * SEQ;
constexpr int NPROJ = 4352, LDW_IN = 4360, NMOD = 6144;
constexpr int C_QA = 0, C_KA = 512, C_VA = 640, C_QB = 768, C_KB = 1280, C_VB = 1792, C_GLA = 2304, C_GLB = 3328;
constexpr int NEXP = 16384;
constexpr float EPS = 1e-6f;

constexpr size_t MiB = 1u << 20;
constexpr size_t WS_CTL = 0, CTL_ZERO_BYTES = 1 * MiB;
constexpr size_t WS_MOD = 1 * MiB, WS_LOGF = 1 * MiB + 128 * 1024, WS_SUBK = 2 * MiB;
constexpr size_t WS_WIN = 4 * MiB, WS_WA = 12 * MiB + 512 * 1024, WS_WB = 13 * MiB + 512 * 1024, WS_WOUT = 14 * MiB + 512 * 1024, WS_WQ = 16 * MiB + 512 * 1024;
constexpr size_t WS_ED = 19 * MiB, WS_EU = 51 * MiB;
constexpr size_t WS_H = 83 * MiB, WS_OA = 83 * MiB, WS_OB = 99 * MiB, WS_PIDX = 83 * MiB, WS_PG = 87 * MiB;
constexpr size_t WS_PROJ = 115 * MiB, WS_X1 = 115 * MiB, WS_H2 = 179 * MiB, WS_QP = 211 * MiB;
constexpr size_t WS_END = 251 * MiB;
static_assert(WS_WIN + (size_t)NPROJ * D * 2 <= WS_WA && WS_WQ + (size_t)D * D * 2 <= WS_ED && WS_PROJ + (size_t)M * NPROJ * 2 <= WS_END, "ws map");
constexpr int CW_BAR = 4096;

constexpr int RING_OFF = 0, RING_BYTES = 131072;
constexpr int LDSCTL_OFF = RING_BYTES, MISC_OFF = LDSCTL_OFF + 320;
constexpr int LDS_BYTES = 147456;

typedef float f32x16 __attribute__((ext_vector_type(16)));
typedef short s16x4 __attribute__((ext_vector_type(4)));
typedef unsigned u32x2 __attribute__((ext_vector_type(2)));
typedef float f32x2_t __attribute__((ext_vector_type(2)));
typedef __bf16 bf16x2_t __attribute__((ext_vector_type(2)));

__device__ __forceinline__ unsigned cvtpk(float lo, float hi) { f32x2_t v = {lo, hi}; bf16x2_t b = __builtin_convertvector(v, bf16x2_t); return __builtin_bit_cast(unsigned, b); }
__device__ __forceinline__ float bflo(unsigned u) { return __uint_as_float(u << 16); }
__device__ __forceinline__ float bfhi(unsigned u) { return __uint_as_float(u & 0xffff0000u); }
__device__ __forceinline__ float wave_sum(float v) {
#pragma unroll
    for (int o = 1; o < 64; o <<= 1) v += __shfl_xor(v, o);
    return v;
}
__device__ __forceinline__ int crow(int r, int hi) { return (r & 3) + 8 * (r >> 2) + 4 * hi; }
#define MFMA32(a, b, c) __builtin_amdgcn_mfma_f32_32x32x16_bf16((a), (b), (c), 0, 0, 0)

struct Frame {
    LAS unsigned char* lds;
    int tid, lane, wave, vcu, G;
    const float* in[18]; float* out; unsigned char* ws;
};

__device__ __forceinline__ void p0_transpose_item(const float* W, int ld, int K, int ncols, bf16* WT, int row_off, LAS float* scr, int item, int lane) {
    const int nblk = ncols / 32, kb = item / nblk, nb = item % nblk, k0 = 64 * kb, n0 = 32 * nb;
#pragma unroll 8
    for (int i = 0; i < 32; ++i) { const int kk = 2 * i + (lane >> 5); scr[kk * 33 + (lane & 31)] = W[(size_t)(k0 + kk) * ld + n0 + (lane & 31)]; }
    LDS_WAIT(); asm volatile("" ::: "memory");
    const int c = lane & 7;
#pragma unroll
    for (int j = 0; j < 4; ++j) { const int n = (lane >> 3) + 8 * j; const LAS float* s = scr + (8 * c) * 33 + n;
        v4u o; o.x = pk2(s[0 * 33], s[1 * 33]); o.y = pk2(s[2 * 33], s[3 * 33]); o.z = pk2(s[4 * 33], s[5 * 33]); o.w = pk2(s[6 * 33], s[7 * 33]);
        *(GAS v4u*)(WT + (size_t)(row_off + n0 + n) * K + k0 + 8 * c) = o; }
    LDS_WAIT(); asm volatile("" ::: "memory");
}
__device__ __forceinline__ void p0_convert(const float* __restrict__ src, bf16* __restrict__ dst, long n_iters, int gw, int NGW, int lane) {
    for (long it0 = (long)gw * 4; it0 < n_iters; it0 += (long)NGW * 4) {
        f32x4 a[4][2];
#pragma unroll
        for (int u = 0; u < 4; ++u) { const long it = it0 + u; if (it < n_iters) { const float* p = src + it * 512 + lane * 4; a[u][0] = *(const f32x4*)p; a[u][1] = *(const f32x4*)(p + 256); } }
#pragma unroll
        for (int u = 0; u < 4; ++u) { const long it = it0 + u; if (it < n_iters) { bf16* q = dst + it * 512 + lane * 4;
            u32x2 w0, w1; w0.x = cvtpk(a[u][0].x, a[u][0].y); w0.y = cvtpk(a[u][0].z, a[u][0].w); w1.x = cvtpk(a[u][1].x, a[u][1].y); w1.y = cvtpk(a[u][1].z, a[u][1].w);
            *(u32x2*)q = w0; *(u32x2*)(q + 256) = w1; } }
    }
}
__device__ __forceinline__ void p0_prologue(Frame& F) {
    const float* c = F.in[1]; const float* w_ada = F.in[4]; const float* b_ada = F.in[5];
    float* MOD = (float*)(F.ws + WS_MOD);
    {
        LAS float* cact = (LAS float*)(F.lds);
        LAS float* part = (LAS float*)(F.lds + 16384);
        bool did = false;
        for (int item = F.vcu; item < NMOD / 32; item += F.G) {
            if (!did) { for (int i = F.tid; i < 4096; i += NTHR) { const float cv = c[i]; cact[i] = cv / (1.0f + __expf(-cv)); } did = true; }
            __syncthreads();
            const int n0 = item * 32, col = n0 + (F.lane & 31), ksub = F.lane >> 5;
            float a0 = 0.f, a1 = 0.f, a2 = 0.f, a3 = 0.f;
#pragma unroll 16
            for (int it = 0; it < 64; ++it) { const int k = (it * 8 + F.wave) * 2 + ksub; const float w = w_ada[(size_t)k * NMOD + col];
                a0 += cact[k] * w; a1 += cact[1024 + k] * w; a2 += cact[2048 + k] * w; a3 += cact[3072 + k] * w; }
            a0 += __shfl_xor(a0, 32); a1 += __shfl_xor(a1, 32); a2 += __shfl_xor(a2, 32); a3 += __shfl_xor(a3, 32);
            if (F.lane < 32) { part[(F.wave * 4 + 0) * 32 + F.lane] = a0; part[(F.wave * 4 + 1) * 32 + F.lane] = a1; part[(F.wave * 4 + 2) * 32 + F.lane] = a2; part[(F.wave * 4 + 3) * 32 + F.lane] = a3; }
            __syncthreads();
            if (F.tid < 128) { const int b = F.tid >> 5, cl = F.tid & 31; float s = 0.f;
#pragma unroll
                for (int w = 0; w < 8; ++w) s += part[(w * 4 + b) * 32 + cl];
                MOD[b * NMOD + n0 + cl] = s + b_ada[n0 + cl]; }
            __syncthreads();
        }
    }
    LAS float* scr = (LAS float*)(F.lds + RING_OFF + F.wave * 16384);
    const int gw = F.vcu * NWAVES + F.wave, NGW = F.G * NWAVES;
    constexpr int I_IN1 = (D / 64) * (2304 / 32), I_IN2 = (D / 64) * (2048 / 32), I_AB = (512 / 64) * (D / 32), I_SQ = (D / 64) * (D / 32);
    constexpr int NITEMS = I_IN1 + I_IN2 + 2 * I_AB + 2 * I_SQ;
    bf16* Win_t = (bf16*)(F.ws + WS_WIN);
    for (int it = gw; it < NITEMS; it += NGW) {
        int r = it;
        if (r < I_IN1) { p0_transpose_item(F.in[6], LDW_IN, D, 2304, Win_t, 0, scr, r, F.lane); continue; } r -= I_IN1;
        if (r < I_IN2) { p0_transpose_item(F.in[6] + 2312, LDW_IN, D, 2048, Win_t, 2304, scr, r, F.lane); continue; } r -= I_IN2;
        if (r < I_AB) { p0_transpose_item(F.in[9], D, 512, D, (bf16*)(F.ws + WS_WA), 0, scr, r, F.lane); continue; } r -= I_AB;
        if (r < I_AB) { p0_transpose_item(F.in[10], D, 512, D, (bf16*)(F.ws + WS_WB), 0, scr, r, F.lane); continue; } r -= I_AB;
        if (r < I_SQ) { p0_transpose_item(F.in[11], D, D, D, (bf16*)(F.ws + WS_WOUT), 0, scr, r, F.lane); continue; } r -= I_SQ;
        p0_transpose_item(F.in[13], D, D, D, (bf16*)(F.ws + WS_WQ), 0, scr, r, F.lane);
    }
    p0_convert(F.in[15], (bf16*)(F.ws + WS_ED), (long)NEXP * D / 512, gw, NGW, F.lane);
    p0_convert(F.in[16], (bf16*)(F.ws + WS_EU), (long)NEXP * D / 512, gw, NGW, F.lane);
    p0_convert(F.in[14], (bf16*)(F.ws + WS_SUBK), (long)(8 * 2 * 128 * 64) / 512, gw, NGW, F.lane);
}

__device__ __forceinline__ void p1_norm(Frame& F) {
    const float* x = F.in[0]; const float* g1 = F.in[2]; const float* w_in = F.in[6]; const float* b_forget = F.in[7];
    const float* MOD = (const float*)(F.ws + WS_MOD); bf16* H = (bf16*)(F.ws + WS_H); float* LOGF = (float*)(F.ws + WS_LOGF);
    LAS float* wfl = (LAS float*)(F.lds);
    for (int i = F.tid; i < 8192; i += NTHR) { const int k = i >> 3, j = i & 7; wfl[j * 1024 + k] = w_in[(size_t)k * LDW_IN + 2304 + j]; }
    __syncthreads();
    const int gw = F.vcu * NWAVES + F.wave, NGW = F.G * NWAVES;
    for (int row = gw; row < M; row += NGW) {
        const f32x4* xr = (const f32x4*)(x + (size_t)row * D) + F.lane;
        f32x4 v[4]; float ss = 0.f;
#pragma unroll
        for (int j = 0; j < 4; ++j) { v[j] = xr[64 * j]; ss += (v[j].x * v[j].x + v[j].y * v[j].y) + (v[j].z * v[j].z + v[j].w * v[j].w); }
        ss = wave_sum(ss);
        const float rstd = 1.0f / sqrtf(ss * (1.0f / D) + EPS);
        const int b = row >> 12; const float* mb = MOD + b * NMOD;
        float fl[8];
#pragma unroll
        for (int jj = 0; jj < 8; ++jj) fl[jj] = 0.f;
#pragma unroll
        for (int j = 0; j < 4; ++j) { const int col = 4 * F.lane + 256 * j;
            const f32x4 g = *(const f32x4*)(g1 + col), sh = *(const f32x4*)(mb + col), sc = *(const f32x4*)(mb + 1024 + col);
            const f32x4 hv = (v[j] * rstd) * g * (sc + 1.0f) + sh;
            u32x2 w; w.x = cvtpk(hv.x, hv.y); w.y = cvtpk(hv.z, hv.w);
            *(u32x2*)(H + (size_t)row * D + col) = w;
#pragma unroll
            for (int jj = 0; jj < 8; ++jj) { const f32x4 wv = *(const LAS f32x4*)(wfl + jj * 1024 + col); fl[jj] += (hv.x * wv.x + hv.y * wv.y) + (hv.z * wv.z + hv.w * wv.w); }
        }
        float mine = 0.f;
#pragma unroll
        for (int jj = 0; jj < 8; ++jj) { const float s = wave_sum(fl[jj]); if (F.lane == jj) mine = s; }
        if (F.lane < 8) { const float z = mine + b_forget[F.lane]; const float ls = fminf(z, 0.f) - log1pf(__expf(-fabsf(z))); LOGF[(size_t)row * 8 + F.lane] = ls; }
    }
}

constexpr int KP = 72;
constexpr int VPF = 68;
constexpr int VPS = 260;
struct FlashState { f32x16 o[2]; float m, l; };

__device__ __forceinline__ void flash_tail(FlashState& st, f32x16& s0, f32x16& s1, const LAS bf16* Vs, int vp, int r32, int hi) {
    float mt = s0[0];
#pragma unroll
    for (int r = 1; r < 16; ++r) mt = fmaxf(mt, s0[r]);
#pragma unroll
    for (int r = 0; r < 16; ++r) mt = fmaxf(mt, s1[r]);
    mt = fmaxf(mt, __shfl_xor(mt, 32));
    const float mn = fmaxf(st.m, mt);
    const float alpha = __expf(st.m - mn);
    st.m = mn;
    float ps = 0.f;
#pragma unroll
    for (int r = 0; r < 16; ++r) { s0[r] = __expf(s0[r] - mn); ps += s0[r]; }
#pragma unroll
    for (int r = 0; r < 16; ++r) { s1[r] = __expf(s1[r] - mn); ps += s1[r]; }
    st.l = st.l * alpha + ps;
#pragma unroll
    for (int r = 0; r < 16; ++r) { st.o[0][r] *= alpha; st.o[1][r] *= alpha; }
#pragma unroll
    for (int blk = 0; blk < 2; ++blk)
#pragma unroll
        for (int s = 0; s < 2; ++s) {
            v4u pw;
            if (blk == 0) { pw.x = cvtpk(s0[8 * s + 0], s0[8 * s + 1]); pw.y = cvtpk(s0[8 * s + 2], s0[8 * s + 3]); pw.z = cvtpk(s0[8 * s + 4], s0[8 * s + 5]); pw.w = cvtpk(s0[8 * s + 6], s0[8 * s + 7]); }
            else          { pw.x = cvtpk(s1[8 * s + 0], s1[8 * s + 1]); pw.y = cvtpk(s1[8 * s + 2], s1[8 * s + 3]); pw.z = cvtpk(s1[8 * s + 4], s1[8 * s + 5]); pw.w = cvtpk(s1[8 * s + 6], s1[8 * s + 7]); }
            const bf16x8 pf = __builtin_bit_cast(bf16x8, pw);
#pragma unroll
            for (int db = 0; db < 2; ++db) {
                const LAS bf16* vp0 = Vs + (32 * db + r32) * vp + 32 * blk + 16 * s + 4 * hi;
                const s16x4 lo = *(const LAS s16x4*)vp0, hh = *(const LAS s16x4*)(vp0 + 8);
                const bf16x8 vf = __builtin_shufflevector(lo, hh, 0, 1, 2, 3, 4, 5, 6, 7);
                st.o[db] = MFMA32(vf, pf, st.o[db]);
            }
        }
}
__device__ __forceinline__ void flash_qk(f32x16& s0, f32x16& s1, const bf16x8 (&qf)[4], const LAS bf16* Ks, int r32, int hi) {
    s0 = (f32x16){0.f}; s1 = (f32x16){0.f};
#pragma unroll
    for (int r = 0; r < 16; ++r) { s0[r] = 0.f; s1[r] = 0.f; }
#pragma unroll
    for (int ks = 0; ks < 4; ++ks) {
        const bf16x8 a0 = *(const LAS bf16x8*)(Ks + r32 * KP + 16 * ks + 8 * hi);
        const bf16x8 a1 = *(const LAS bf16x8*)(Ks + (32 + r32) * KP + 16 * ks + 8 * hi);
        s0 = MFMA32(a0, qf[ks], s0); s1 = MFMA32(a1, qf[ks], s1);
    }
}
__device__ __forceinline__ void flash_store(const FlashState& st, bf16* orow, int hi) {
    float lt = st.l + __shfl_xor(st.l, 32);
    const float inv = 1.0f / lt;
#pragma unroll
    for (int db = 0; db < 2; ++db)
#pragma unroll
        for (int rg = 0; rg < 4; ++rg) { u32x2 w; w.x = cvtpk(st.o[db][4 * rg] * inv, st.o[db][4 * rg + 1] * inv); w.y = cvtpk(st.o[db][4 * rg + 2] * inv, st.o[db][4 * rg + 3] * inv);
            *(u32x2*)(orow + 32 * db + 8 * rg + 4 * hi) = w; }
}

__device__ __forceinline__ void fox_unit(Frame& F, int b, int h, int qb) {
    const bf16* proj = (const bf16*)(F.ws + WS_PROJ); const float* LOGF = (const float*)(F.ws + WS_LOGF); bf16* OB = (bf16*)(F.ws + WS_OB);
    LAS float* Fs = (LAS float*)(F.lds);
    LAS float* wtot = (LAS float*)(F.lds + 16384);
    LAS bf16* Kb = (LAS bf16*)(F.lds + 16384 + 64);
    LAS bf16* Vb = (LAS bf16*)(F.lds + 16384 + 64 + 2 * 64 * KP * 2);
    const int lane = F.lane, wave = F.wave, tid = F.tid, r32 = lane & 31, hi = lane >> 5;
    const int q_end = 256 * (qb + 1), NT = q_end / 64;
    const size_t rowbase = (size_t)b * SEQ;
    {
        float v[8]; float run = 0.f;
#pragma unroll
        for (int i = 0; i < 8; ++i) { const int pos = tid * 8 + i; const float lf = (pos < q_end) ? LOGF[(rowbase + pos) * 8 + h] : 0.f; run += lf; v[i] = run; }
        float inc = run;
#pragma unroll
        for (int o = 1; o < 64; o <<= 1) { const float t = __shfl_up(inc, o); if (lane >= o) inc += t; }
        if (lane == 63) wtot[wave] = inc;
        __syncthreads();
        float off = inc - run;
        for (int w = 0; w < wave; ++w) off += wtot[w];
#pragma unroll
        for (int i = 0; i < 8; ++i) Fs[tid * 8 + i] = v[i] + off;
    }
    const int qrow = 256 * qb + 32 * wave + r32;
    bf16x8 qf[4];
    { const bf16* qp = proj + (rowbase + qrow) * NPROJ + C_QB + 64 * h + 8 * hi;
#pragma unroll
      for (int ks = 0; ks < 4; ++ks) qf[ks] = *(const bf16x8*)(qp + 16 * ks); }
    const int tq = 4 * qb + (wave >> 1);
    FlashState st; st.m = -INFINITY; st.l = 0.f;
#pragma unroll
    for (int r = 0; r < 16; ++r) { st.o[0][r] = 0.f; st.o[1][r] = 0.f; }
    const int srow = tid >> 3, sch = tid & 7;
    const bf16* kg = proj + (rowbase + srow) * NPROJ + C_KB + 64 * h + 8 * sch;
    const bf16* vg = proj + (rowbase + srow) * NPROJ + C_VB + 64 * h + 8 * sch;
    v4u kreg, vreg;
    { const size_t o = (size_t)(NT - 1) * 64 * NPROJ; kreg = *(const v4u*)(kg + o); vreg = *(const v4u*)(vg + o); }
    int cur = 0;
    {   *(LAS v4u*)(Kb + srow * KP + 8 * sch) = kreg;
        const unsigned short* vs = (const unsigned short*)&vreg;
#pragma unroll
        for (int i = 0; i < 8; ++i) Vb[(8 * sch + i) * VPF + srow] = vs[i];
    }
    __syncthreads();
    const float fq = Fs[qrow];
    for (int t = NT - 1; t >= 0; --t) {
        if (t > 0) { const size_t o = (size_t)(t - 1) * 64 * NPROJ; kreg = *(const v4u*)(kg + o); vreg = *(const v4u*)(vg + o); }
        if (t <= tq) {
            const LAS bf16* Ks = Kb + cur * 64 * KP; const LAS bf16* Vs = Vb + cur * 64 * VPF;
            f32x16 s0, s1; flash_qk(s0, s1, qf, Ks, r32, hi);
            const LAS float* Fk = Fs + 64 * t;
            const bool diag = (t == tq);
#pragma unroll
            for (int rg = 0; rg < 4; ++rg) {
                const f32x4 f0 = *(const LAS f32x4*)(Fk + 8 * rg + 4 * hi), f1 = *(const LAS f32x4*)(Fk + 32 + 8 * rg + 4 * hi);
#pragma unroll
                for (int i = 0; i < 4; ++i) { const int r = 4 * rg + i; const int kv = 64 * t + 8 * rg + 4 * hi + i;
                    float a = s0[r] * 0.125f + (fq - f0[i]); float c = s1[r] * 0.125f + (fq - f1[i]);
                    if (diag) { if (kv > qrow) a = -INFINITY; if (kv + 32 > qrow) c = -INFINITY; }
                    s0[r] = a; s1[r] = c; }
            }
            flash_tail(st, s0, s1, Vs, VPF, r32, hi);
        }
        if (t > 0) {
            const int nb = cur ^ 1;
            *(LAS v4u*)(Kb + nb * 64 * KP + srow * KP + 8 * sch) = kreg;
            const unsigned short* vs = (const unsigned short*)&vreg;
#pragma unroll
            for (int i = 0; i < 8; ++i) Vb[nb * 64 * VPF + (8 * sch + i) * VPF + srow] = vs[i];
        }
        __syncthreads();
        cur ^= 1;
    }
    flash_store(st, OB + (rowbase + qrow) * 512 + 64 * h, hi);
    __syncthreads();
}

__device__ const unsigned char T5_BUCKET[128] = {0,1,2,3,4,5,6,7,8,9,10,11,12,13,14,15,16,16,16,17,17,18,18,18,19,19,19,20,20,20,20,21,21,21,21,22,22,22,22,22,23,23,23,23,23,23,24,24,24,24,24,24,25,25,25,25,25,25,25,26,26,26,26,26,26,26,26,27,27,27,27,27,27,27,27,27,27,28,28,28,28,28,28,28,28,28,28,29,29,29,29,29,29,29,29,29,29,29,29,30,30,30,30,30,30,30,30,30,30,30,30,30,30,31,31,31,31,31,31,31,31,31,31,31,31,31,31,31};

__device__ __forceinline__ void swa_unit(Frame& F, int b, int kvh, int n) {
    const bf16* proj = (const bf16*)(F.ws + WS_PROJ); bf16* OA = (bf16*)(F.ws + WS_OA);
    const float* sinks = F.in[8]; const float* rel_bias = F.in[12];
    LAS bf16* Kb = (LAS bf16*)(F.lds);
    LAS bf16* Vb = (LAS bf16*)(F.lds + 36864);
    LAS float* bt = (LAS float*)(F.lds + 36864 + 33280);
    const int lane = F.lane, wave = F.wave, tid = F.tid, r32 = lane & 31, hi = lane >> 5;
    const size_t rowbase = (size_t)b * SEQ;
    {
        const int g = tid >> 7, d = tid & 127;
        bt[tid] = rel_bias[(int)T5_BUCKET[d] * 8 + kvh * 4 + g];
#pragma unroll
        for (int i = 0; i < 4; ++i) {
            const int idx = tid + i * NTHR, kb = idx >> 3, sch = idx & 7; const int pos = 128 * (n - 1) + kb;
            v4u kreg = (v4u){0u, 0u, 0u, 0u}, vreg = (v4u){0u, 0u, 0u, 0u};
            if (pos >= 0) { const bf16* p = proj + (rowbase + pos) * NPROJ + 64 * kvh + 8 * sch; kreg = *(const v4u*)(p + C_KA); vreg = *(const v4u*)(p + C_VA); }
            *(LAS v4u*)(Kb + kb * KP + 8 * sch) = kreg;
            const unsigned short* vs = (const unsigned short*)&vreg;
#pragma unroll
            for (int j = 0; j < 8; ++j) Vb[(8 * sch + j) * VPS + kb] = vs[j];
        }
    }
    __syncthreads();
    const int g = wave & 3, qh = wave >> 2, head = kvh * 4 + g;
    const LAS float* btg = bt + g * 128;
    for (int sb = 0; sb < 2; ++sb) {
        const int qrel0 = 64 * qh + 32 * sb, qrel = qrel0 + r32;
        const size_t row = rowbase + 128 * n + qrel;
        bf16x8 qf[4];
        { const bf16* qp = proj + row * NPROJ + C_QA + 64 * head + 8 * hi;
#pragma unroll
          for (int ks = 0; ks < 4; ++ks) qf[ks] = *(const bf16x8*)(qp + 16 * ks); }
        FlashState st; st.m = sinks[head]; st.l = (hi == 0) ? 1.0f : 0.0f;
#pragma unroll
        for (int r = 0; r < 16; ++r) { st.o[0][r] = 0.f; st.o[1][r] = 0.f; }
        const int t_lo = (qrel0 + 1) >> 6, t_hi = (qrel0 + 159) >> 6;
        for (int t = t_lo; t <= t_hi; ++t) {
            f32x16 s0, s1; flash_qk(s0, s1, qf, Kb + t * 64 * KP, r32, hi);
#pragma unroll
            for (int r = 0; r < 16; ++r) {
                const int kb0 = 64 * t + crow(r, hi), kb1 = kb0 + 32;
                const int d0 = 128 + qrel - kb0, d1 = d0 - 32;
                const bool v0 = (d0 >= 0) && (d0 < 128) && (n > 0 || kb0 >= 128);
                const bool v1 = (d1 >= 0) && (d1 < 128) && (n > 0 || kb1 >= 128);
                const float b0 = btg[d0 & 127], b1 = btg[d1 & 127];
                s0[r] = v0 ? (s0[r] * 0.125f + b0) : -INFINITY;
                s1[r] = v1 ? (s1[r] * 0.125f + b1) : -INFINITY;
            }
            flash_tail(st, s0, s1, Vb + 64 * t, VPS, r32, hi);
        }
        flash_store(st, OA + row * 512 + 64 * head, hi);
    }
    __syncthreads();
}
__device__ __forceinline__ void p3_attention(Frame& F) {
    for (int item = F.vcu; item < 256; item += F.G) {
        swa_unit(F, item >> 6, (item >> 5) & 1, item & 31);
        const int bh = item >> 3, j = item & 7;
        fox_unit(F, bh >> 3, bh & 7, 15 - j);
        fox_unit(F, bh >> 3, bh & 7, j);
    }
}

struct PairOrder {
    pg8::StaticOrder S;
    __device__ bool next(int i, pg8::Unit& u) const { if (!S.next(i >> 1, u)) return false; u.src = i & 1; return true; }
    __device__ __forceinline__ void a_ready(const pg8::Unit&) const {}
    __device__ __forceinline__ void done(const pg8::Unit&) const {}
};
__device__ __forceinline__ float sigmoidf_(float z) { return 1.0f / (1.0f + __expf(-z)); }
struct EpiGate {
    static constexpr bool PERM = false, AFTER_DRAIN = false;
    const bf16* proj; bf16* tmp; bf16* mixed;
    __device__ __forceinline__ void operator()(const pg8::f32x4 (&acc)[2][2][4][2], const pg8::Unit& u, int wr, int wc, int fr, int fq) const {
        const int goff = u.src ? C_GLB : C_GLA;
#pragma unroll
        for (int ai = 0; ai < 2; ++ai)
#pragma unroll
            for (int m = 0; m < 4; ++m) { const size_t row = (size_t)u.pm * 256 + ai * 128 + wr * 64 + m * 16 + fr;
#pragma unroll
                for (int bj = 0; bj < 2; ++bj)
#pragma unroll
                    for (int n = 0; n < 2; ++n) { const int col = u.pn * 256 + bj * 128 + wc * 32 + n * 16 + 4 * fq;
                        const u32x2 gw = *(const u32x2*)(proj + row * NPROJ + goff + col);
                        const pg8::f32x4 a = acc[ai][bj][m][n];
                        float v0 = a[0] * sigmoidf_(bflo(gw.x)), v1 = a[1] * sigmoidf_(bfhi(gw.x)), v2 = a[2] * sigmoidf_(bflo(gw.y)), v3 = a[3] * sigmoidf_(bfhi(gw.y));
                        if (u.src == 0) { u32x2 w; w.x = cvtpk(v0, v1); w.y = cvtpk(v2, v3); *(u32x2*)(tmp + row * D + col) = w; }
                        else { const u32x2 t = *(const u32x2*)(tmp + row * D + col);
                            u32x2 w; w.x = cvtpk(v0 + bflo(t.x), v1 + bfhi(t.x)); w.y = cvtpk(v2 + bflo(t.y), v3 + bfhi(t.y)); *(u32x2*)(mixed + row * D + col) = w; }
                    }
            }
    }
};
struct EpiRes {
    static constexpr bool PERM = false, AFTER_DRAIN = false;
    const float* x; const float* mod; float* x1;
    __device__ __forceinline__ void operator()(const pg8::f32x4 (&acc)[2][2][4][2], const pg8::Unit& u, int wr, int wc, int fr, int fq) const {
#pragma unroll
        for (int ai = 0; ai < 2; ++ai)
#pragma unroll
            for (int m = 0; m < 4; ++m) { const size_t row = (size_t)u.pm * 256 + ai * 128 + wr * 64 + m * 16 + fr; const int b = (int)(row >> 12);
#pragma unroll
                for (int bj = 0; bj < 2; ++bj)
#pragma unroll
                    for (int n = 0; n < 2; ++n) { const int col = u.pn * 256 + bj * 128 + wc * 32 + n * 16 + 4 * fq;
                        const pg8::f32x4 xin = *(const pg8::f32x4*)(x + row * D + col), gt = *(const pg8::f32x4*)(mod + b * NMOD + 2048 + col);
                        *(pg8::f32x4*)(x1 + row * D + col) = xin + gt * acc[ai][bj][m][n]; }
            }
    }
};

__device__ __forceinline__ void p6_norm2(Frame& F) {
    const float* x1 = (const float*)(F.ws + WS_X1); const float* g2 = F.in[3]; const float* MOD = (const float*)(F.ws + WS_MOD); bf16* H2 = (bf16*)(F.ws + WS_H2);
    const int gw = F.vcu * NWAVES + F.wave, NGW = F.G * NWAVES;
    for (int row = gw; row < M; row += NGW) {
        const f32x4* xr = (const f32x4*)(x1 + (size_t)row * D) + F.lane;
        f32x4 v[4]; float ss = 0.f;
#pragma unroll
        for (int j = 0; j < 4; ++j) { v[j] = xr[64 * j]; ss += (v[j].x * v[j].x + v[j].y * v[j].y) + (v[j].z * v[j].z + v[j].w * v[j].w); }
        ss = wave_sum(ss);
        const float rstd = 1.0f / sqrtf(ss * (1.0f / D) + EPS);
        const int b = row >> 12; const float* mb = MOD + b * NMOD;
#pragma unroll
        for (int j = 0; j < 4; ++j) { const int col = 4 * F.lane + 256 * j;
            const f32x4 g = *(const f32x4*)(g2 + col), sh = *(const f32x4*)(mb + 3072 + col), sc = *(const f32x4*)(mb + 4096 + col);
            const f32x4 hv = (v[j] * rstd) * g * (sc + 1.0f) + sh;
            u32x2 w; w.x = cvtpk(hv.x, hv.y); w.y = cvtpk(hv.z, hv.w);
            *(u32x2*)(H2 + (size_t)row * D + col) = w; }
    }
}

__device__ __forceinline__ unsigned f2ord(float f) { const unsigned u = __float_as_uint(f); return u ^ ((unsigned)((int)u >> 31) | 0x80000000u); }
__device__ __forceinline__ float ord2f(unsigned o) { const unsigned u = (o & 0x80000000u) ? (o & 0x7fffffffu) : ~o; return __uint_as_float(u); }
#define CE_DESC(a, b) do { const unsigned _x = (a), _y = (b); (a) = _x > _y ? _x : _y; (b) = _x > _y ? _y : _x; } while (0)
__device__ __forceinline__ void sort16(unsigned (&k)[16]) {
#pragma unroll
    for (int size = 2; size <= 16; size <<= 1)
#pragma unroll
        for (int stride = size >> 1; stride > 0; stride >>= 1)
#pragma unroll
            for (int i = 0; i < 16; ++i) { const int j = i ^ stride; if (j > i) { if ((i & size) == 0) CE_DESC(k[i], k[j]); else CE_DESC(k[j], k[i]); } }
}
__device__ __forceinline__ void merge16(unsigned (&a)[16], const unsigned (&b)[16]) {
#pragma unroll
    for (int i = 0; i < 16; ++i) a[i] = a[i] > b[15 - i] ? a[i] : b[15 - i];
#pragma unroll
    for (int stride = 8; stride > 0; stride >>= 1)
#pragma unroll
        for (int i = 0; i < 16; ++i) { const int j = i ^ stride; if (j > i) CE_DESC(a[i], a[j]); }
}
__device__ __forceinline__ void top16_of_64(unsigned (&g0)[16], unsigned (&g1)[16], unsigned (&g2)[16], unsigned (&g3)[16]) {
    sort16(g0); sort16(g1); sort16(g2); sort16(g3);
    merge16(g0, g1); merge16(g2, g3); merge16(g0, g2);
}
constexpr int NCAND = 50;
__device__ __forceinline__ void p8a_topk(Frame& F) {
    const bf16* QP = (const bf16*)(F.ws + WS_QP); const bf16* SUBK = (const bf16*)(F.ws + WS_SUBK);
    unsigned short* PIDX = (unsigned short*)(F.ws + WS_PIDX); float* PG = (float*)(F.ws + WS_PG);
    LAS unsigned short* Elds = (LAS unsigned short*)(F.lds) + F.wave * (NCAND * 64);
    const int lane = F.lane, r32 = lane & 31, hi = lane >> 5;
    const int gw = F.vcu * NWAVES + F.wave, NGW = F.G * NWAVES;
    for (int tile = gw; tile < M / 32; tile += NGW) {
        const int tok = tile * 32 + r32;
        for (int h = 0; h < 8; ++h) {
            unsigned top[2][16];
#pragma unroll
            for (int p = 0; p < 2; ++p) {
                bf16x8 qf[4];
                { const bf16* qp = QP + (size_t)tok * D + h * 128 + p * 64 + 8 * hi;
#pragma unroll
                  for (int ks = 0; ks < 4; ++ks) qf[ks] = *(const bf16x8*)(qp + 16 * ks); }
                const bf16* kp = SUBK + (size_t)((h * 2 + p) * 128 + r32) * 64 + 8 * hi;
                unsigned kk[4][16];
#pragma unroll
                for (int blk = 0; blk < 4; ++blk) {
                    f32x16 acc;
#pragma unroll
                    for (int r = 0; r < 16; ++r) acc[r] = 0.f;
#pragma unroll
                    for (int ks = 0; ks < 4; ++ks) { const bf16x8 a = *(const bf16x8*)(kp + (size_t)blk * 32 * 64 + 16 * ks); acc = MFMA32(a, qf[ks], acc); }
#pragma unroll
                    for (int r = 0; r < 16; ++r) { const int key = 32 * blk + crow(r, hi); kk[blk][r] = (f2ord(acc[r]) & ~127u) | (unsigned)(127 - key); }
                }
                top16_of_64(kk[0], kk[1], kk[2], kk[3]);
                unsigned other[16];
#pragma unroll
                for (int i = 0; i < 16; ++i) other[i] = (unsigned)__shfl_xor((int)kk[0][i], 32);
                merge16(kk[0], other);
#pragma unroll
                for (int i = 0; i < 16; ++i) top[p][i] = kk[0][i];
            }
            float s1[16], s2[16]; unsigned i1[16], i2[16];
#pragma unroll
            for (int i = 0; i < 16; ++i) { s1[i] = ord2f(top[0][i] & ~127u); i1[i] = 127u - (top[0][i] & 127u); s2[i] = ord2f(top[1][i] & ~127u); i2[i] = 127u - (top[1][i] & 127u); }
            unsigned ck[4][16];
#pragma unroll
            for (int c = 0; c < 64; ++c) {
                if (c < NCAND) { constexpr int CA[NCAND] = {0,0,0,0,0,0,0,0,0,0,0,0,0,0,0,0,1,1,1,1,1,1,1,1,2,2,2,2,2,3,3,3,3,4,4,4,5,5,6,6,7,7,8,9,10,11,12,13,14,15}; constexpr int CB[NCAND] = {0,1,2,3,4,5,6,7,8,9,10,11,12,13,14,15,0,1,2,3,4,5,6,7,0,1,2,3,4,0,1,2,3,0,1,2,0,1,0,1,0,1,0,0,0,0,0,0,0,0}; const int a = CA[c], b = CB[c];
                    ck[c >> 4][c & 15] = (f2ord(s1[a] + s2[b]) & ~63u) | (unsigned)(63 - c);
                    Elds[c * 64 + lane] = (unsigned short)(i1[a] * 128u + i2[b]); }
                else ck[c >> 4][c & 15] = 0u;
            }
            top16_of_64(ck[0], ck[1], ck[2], ck[3]);
            float w[16]; float wsum = 0.f; const float v0 = ord2f(ck[0][0] & ~63u);
#pragma unroll
            for (int r = 0; r < 16; ++r) { w[r] = __expf(ord2f(ck[0][r] & ~63u) - v0); wsum += w[r]; }
            const float winv = 1.0f / wsum;
#pragma unroll
            for (int r = 0; r < 16; ++r) if ((r >> 3) == hi) {
                const int c = 63 - (int)(ck[0][r] & 63u);
                const unsigned short eid = Elds[c * 64 + lane];
                PIDX[(size_t)tok * 128 + h * 16 + r] = eid; PG[(size_t)tok * 128 + h * 16 + r] = w[r] * winv; }
        }
    }
}

__device__ __forceinline__ float gelu_erf(float v) { return 0.5f * v * (1.0f + erff(v * 0.70710678118654752f)); }
__device__ __forceinline__ float dot8(const v4u& a, const v4u& b, float acc) {
    acc += bflo(a.x) * bflo(b.x); acc += bfhi(a.x) * bfhi(b.x); acc += bflo(a.y) * bflo(b.y); acc += bfhi(a.y) * bfhi(b.y);
    acc += bflo(a.z) * bflo(b.z); acc += bfhi(a.z) * bfhi(b.z); acc += bflo(a.w) * bflo(b.w); acc += bfhi(a.w) * bfhi(b.w); return acc;
}
__device__ __forceinline__ void axpy8(float (&acc)[8], float w, const v4u& u) {
    acc[0] += w * bflo(u.x); acc[1] += w * bfhi(u.x); acc[2] += w * bflo(u.y); acc[3] += w * bfhi(u.y);
    acc[4] += w * bflo(u.z); acc[5] += w * bfhi(u.z); acc[6] += w * bflo(u.w); acc[7] += w * bfhi(u.w);
}
__device__ __forceinline__ void p8b_gather(Frame& F) {
    const float* X1 = (const float*)(F.ws + WS_X1); const bf16* H2 = (const bf16*)(F.ws + WS_H2); const float* MOD = (const float*)(F.ws + WS_MOD);
    const bf16* ED = (const bf16*)(F.ws + WS_ED); const bf16* EU = (const bf16*)(F.ws + WS_EU);
    const unsigned short* PIDX = (const unsigned short*)(F.ws + WS_PIDX); const float* PG = (const float*)(F.ws + WS_PG);
    const float* fg = F.in[17];
    const int lane = F.lane;
    const int gw = F.vcu * NWAVES + F.wave, NGW = F.G * NWAVES;
    for (int tok = gw; tok < M; tok += NGW) {
        const int idx0 = PIDX[(size_t)tok * 128 + lane], idx1 = PIDX[(size_t)tok * 128 + 64 + lane];
        const float g0 = PG[(size_t)tok * 128 + lane], g1 = PG[(size_t)tok * 128 + 64 + lane];
        const v4u hq0 = *(const v4u*)(H2 + (size_t)tok * D + 8 * lane), hq1 = *(const v4u*)(H2 + (size_t)tok * D + 512 + 8 * lane);
        float acc0[8], acc1[8];
#pragma unroll
        for (int i = 0; i < 8; ++i) { acc0[i] = 0.f; acc1[i] = 0.f; }
        for (int jb = 0; jb < 16; ++jb) {
            const int idxv = (jb < 8) ? idx0 : idx1; const float gv = (jb < 8) ? g0 : g1;
            v4u d0[8], d1[8], u0[8], u1[8];
#pragma unroll
            for (int u = 0; u < 8; ++u) { const int e = __builtin_amdgcn_readlane(idxv, (jb & 7) * 8 + u);
                const bf16* dp = ED + (size_t)e * D + 8 * lane; const bf16* up = EU + (size_t)e * D + 8 * lane;
                d0[u] = *(const v4u*)dp; d1[u] = *(const v4u*)(dp + 512); u0[u] = *(const v4u*)up; u1[u] = *(const v4u*)(up + 512); }
            float dd[8];
#pragma unroll
            for (int u = 0; u < 8; ++u) dd[u] = dot8(hq1, d1[u], dot8(hq0, d0[u], 0.f));
            const bool b5 = (lane & 32) != 0, b4 = (lane & 16) != 0, b3 = (lane & 8) != 0;
            float r4[4];
#pragma unroll
            for (int u = 0; u < 4; ++u) { const float keep = b5 ? dd[u + 4] : dd[u], send = b5 ? dd[u] : dd[u + 4]; r4[u] = keep + __shfl_xor(send, 32); }
            float r2[2];
#pragma unroll
            for (int u = 0; u < 2; ++u) { const float keep = b4 ? r4[u + 2] : r4[u], send = b4 ? r4[u] : r4[u + 2]; r2[u] = keep + __shfl_xor(send, 16); }
            float r1; { const float keep = b3 ? r2[1] : r2[0], send = b3 ? r2[0] : r2[1]; r1 = keep + __shfl_xor(send, 8); }
            r1 += __shfl_xor(r1, 4); r1 += __shfl_xor(r1, 2); r1 += __shfl_xor(r1, 1);
            const float gsel = __shfl(gv, (jb & 7) * 8 + (lane >> 3));
            const float wv = gsel * gelu_erf(r1);
#pragma unroll
            for (int u = 0; u < 8; ++u) { const float w = __uint_as_float(__builtin_amdgcn_readlane(__float_as_uint(wv), 8 * u)); axpy8(acc0, w, u0[u]); axpy8(acc1, w, u1[u]); }
        }
        const int b = tok >> 12; const float* gt2 = MOD + b * NMOD + 5120;
        float x2[16]; float ss = 0.f;
#pragma unroll
        for (int hlf = 0; hlf < 2; ++hlf) { const int col = 512 * hlf + 8 * lane;
#pragma unroll
            for (int q = 0; q < 2; ++q) { const f32x4 xv = *(const f32x4*)(X1 + (size_t)tok * D + col + 4 * q), gv4 = *(const f32x4*)(gt2 + col + 4 * q);
#pragma unroll
                for (int i = 0; i < 4; ++i) { const float a = hlf ? acc1[4 * q + i] : acc0[4 * q + i]; const float v = xv[i] + gv4[i] * a; x2[hlf * 8 + q * 4 + i] = v; ss += v * v; } } }
        ss = wave_sum(ss);
        const float rstd = 1.0f / sqrtf(ss * (1.0f / D) + EPS);
#pragma unroll
        for (int hlf = 0; hlf < 2; ++hlf) { const int col = 512 * hlf + 8 * lane;
#pragma unroll
            for (int q = 0; q < 2; ++q) { const f32x4 gg = *(const f32x4*)(fg + col + 4 * q); f32x4 o;
#pragma unroll
                for (int i = 0; i < 4; ++i) o[i] = x2[hlf * 8 + q * 4 + i] * rstd * gg[i];
                *(f32x4*)(F.out + (size_t)tok * D + col + 4 * q) = o; } }
    }
}

struct Args { const float* in[18]; float* out; unsigned char* ws; };
__global__ void __launch_bounds__(NTHR, 2) mega_fwd(Args args) {
    extern __shared__ __attribute__((aligned(16))) unsigned char lds[];
    Frame F;
    F.lds = (LAS unsigned char*)lds;
    F.tid = threadIdx.x; F.lane = F.tid & 63; F.wave = __builtin_amdgcn_readfirstlane(F.tid >> 6);
    F.G = gridDim.x; { const int bx = blockIdx.x; F.vcu = (F.G % 8 == 0) ? (bx % 8) * (F.G / 8) + bx / 8 : bx; }
#pragma unroll
    for (int i = 0; i < 18; ++i) F.in[i] = args.in[i];
    F.out = args.out; F.ws = args.ws;
    volatile LAS unsigned* MISC = (volatile LAS unsigned*)(F.lds + MISC_OFF);
    for (int u = F.tid; u < (LDS_BYTES - LDSCTL_OFF) / 4; u += NTHR) ((LAS unsigned*)(F.lds + LDSCTL_OFF))[u] = 0u;
    __syncthreads();
    gu32* ctl = (gu32*)(F.ws + WS_CTL);
    XcdBarrier bar = xcd_barrier_post((unsigned*)(ctl + CW_BAR), MISC + 8);
#define GRID_BAR() xcd_barrier(bar)

    p0_prologue(F); GRID_BAR();
    p1_norm(F); GRID_BAR();
    {
        pg8::Gemm g{(const pg8::bf16_t*)(F.ws + WS_H), (const pg8::bf16_t*)(F.ws + WS_WIN), M, NPROJ, D, nullptr, nullptr};
        pg8::StaticOrder S; S.init(M, NPROJ, F.G, (int)blockIdx.x);
        pg8::EpiBf16<0> E{(pg8::bf16_t*)(F.ws + WS_PROJ), NPROJ, nullptr, 0, 0, 1.f};
        pg8::gemm_phase<pg8::EpiBf16<0>, pg8::StaticOrder, true, true>(F.lds + RING_OFF, g, S, E);
    }
    GRID_BAR();
    p3_attention(F); GRID_BAR();
    {
        pg8::Gemm g{(const pg8::bf16_t*)(F.ws + WS_OA), (const pg8::bf16_t*)(F.ws + WS_WA), M, D, 512, (const pg8::bf16_t*)(F.ws + WS_OB), (const pg8::bf16_t*)(F.ws + WS_WB)};
        PairOrder S; S.S.init(M, D, F.G, (int)blockIdx.x);
        EpiGate E{(const bf16*)(F.ws + WS_PROJ), (bf16*)F.out, (bf16*)F.out + (size_t)M * D};
        pg8::gemm_phase<EpiGate, PairOrder, false, true>(F.lds + RING_OFF, g, S, E);
    }
    GRID_BAR();
    {
        pg8::Gemm g{(const pg8::bf16_t*)((bf16*)F.out + (size_t)M * D), (const pg8::bf16_t*)(F.ws + WS_WOUT), M, D, D, nullptr, nullptr};
        pg8::StaticOrder S; S.init(M, D, F.G, (int)blockIdx.x);
        EpiRes E{F.in[0], (const float*)(F.ws + WS_MOD), (float*)(F.ws + WS_X1)};
        pg8::gemm_phase<EpiRes, pg8::StaticOrder, false, true>(F.lds + RING_OFF, g, S, E);
    }
    GRID_BAR();
    p6_norm2(F); GRID_BAR();
    {
        pg8::Gemm g{(const pg8::bf16_t*)(F.ws + WS_H2), (const pg8::bf16_t*)(F.ws + WS_WQ), M, D, D, nullptr, nullptr};
        pg8::StaticOrder S; S.init(M, D, F.G, (int)blockIdx.x);
        pg8::EpiBf16<0> E{(pg8::bf16_t*)(F.ws + WS_QP), D, nullptr, 0, 0, 1.f};
        pg8::gemm_phase<pg8::EpiBf16<0>, pg8::StaticOrder, false, true>(F.lds + RING_OFF, g, S, E);
    }
    GRID_BAR();
    p8a_topk(F); GRID_BAR();
    p8b_gather(F);
}

extern "C" void kernel_launch(void* const* d_in, const int* in_sizes, int n_in, void* d_out, int out_size, void* d_ws, size_t ws_size, hipStream_t stream) {
    static int grid = 0;
    if (grid == 0) {
        if (n_in != 18 || in_sizes[0] != M * D || out_size != M * D || ws_size < WS_END) { fprintf(stderr, "kernel_launch: unexpected shapes (n_in %d, in0 %d, out %d, ws %zu)\n", n_in, n_in > 0 ? in_sizes[0] : -1, out_size, ws_size); grid = -1; return; }
        int dev = 0, cus = 0, per_cu = 0;
        if (hipGetDevice(&dev) != hipSuccess || hipDeviceGetAttribute(&cus, hipDeviceAttributeMultiprocessorCount, dev) != hipSuccess) { grid = -1; return; }
        if (hipFuncSetAttribute((const void*)mega_fwd, hipFuncAttributeMaxDynamicSharedMemorySize, LDS_BYTES) != hipSuccess) { fprintf(stderr, "kernel_launch: hipFuncSetAttribute failed\n"); grid = -1; return; }
        if (hipOccupancyMaxActiveBlocksPerMultiprocessor(&per_cu, (const void*)mega_fwd, NTHR, LDS_BYTES) != hipSuccess || per_cu < 1) { fprintf(stderr, "kernel_launch: occupancy query says %d blocks per CU\n", per_cu); }
        (void)hipGetLastError();
        grid = cus;
    }
    if (grid < 0) return;
    if (hipMemsetAsync((char*)d_ws + WS_CTL, 0, CTL_ZERO_BYTES, stream) != hipSuccess) { fprintf(stderr, "kernel_launch: memset failed\n"); return; }
    Args a{};
    for (int i = 0; i < 18; ++i) a.in[i] = (const float*)d_in[i];
    a.out = (float*)d_out; a.ws = (unsigned char*)d_ws;
    hipLaunchKernelGGL(mega_fwd, dim3(grid), dim3(NTHR), LDS_BYTES, stream, a);
}
```

```cpp
#include <hip/hip_runtime.h>
#include <cstdio>
#include <cstdint>
namespace pg8 {
#define PG8_LAS __attribute__((address_space(3)))
typedef unsigned short bf16_t;
typedef short bf16x8 __attribute__((ext_vector_type(8)));
typedef float f32x4 __attribute__((ext_vector_type(4)));
typedef unsigned u32x4 __attribute__((ext_vector_type(4)));
constexpr int BM = 256, BK = 64, HALF = 128, HTB = HALF * BK * 2  , STAGE_BYTES = 8 * HTB, NXCD = 8, WGM = 8;

__host__ __device__ __forceinline__ int lds_byte(int r, int c) { const int st = (r >> 4) * 2 + (c >> 5), rr = r & 15, cc = c & 31, ob = rr * 64 + cc * 2; return st * 1024 + (ob ^ (((ob >> 9) & 1) << 5)); }
__host__ __device__ __forceinline__ void stage_rc(int b, int& R, int& C) { const int st = b / 1024, sb = b % 1024, swz = sb ^ (((sb >> 9) & 1) << 5); R = (st >> 1) * 16 + swz / 64; C = (st & 1) * 32 + (swz % 64) / 2; }
__host__ __device__ __forceinline__ int perm32(int rho) { const int n = rho >> 4, i = rho & 15; return 8 * (i >> 2) + 4 * n + (i & 3); }

struct Unit { int pm, pn, src; };
struct Gemm { const bf16_t* A; const bf16_t* Bt; int M, N, K; const bf16_t* A2; const bf16_t* Bt2; };

struct StaticOrder {
    int nM, nN, nwg, G, c;
    __host__ __device__ void init(int M, int N, int G_, int c_) { nM = M / BM; nN = N / BM; nwg = nM * nN; G = G_; c = c_; }
    __host__ __device__ bool next(int i, Unit& u) const {
        const long L = (long)i * G + c; if (L >= nwg) return false;
        int wgid = (int)L; { const int q = nwg / NXCD, r = nwg % NXCD, xcd = wgid % NXCD, off = wgid / NXCD; wgid = (xcd < r ? xcd * (q + 1) : r * (q + 1) + (xcd - r) * q) + off; }
        const int nig = WGM * nN, gid = wgid / nig, fm = gid * WGM, gsz = (nM - fm) < WGM ? (nM - fm) : WGM;
        u.pm = fm + ((wgid % nig) % gsz); u.pn = (wgid % nig) / gsz; u.src = 0; return true;
    }
    __device__ __forceinline__ void a_ready(const Unit&) const {}
    __device__ __forceinline__ void done(const Unit&) const {}
};

__device__ __forceinline__ unsigned cvt_pk_bf16(float lo, float hi) { unsigned r; asm volatile("v_cvt_pk_bf16_f32 %0, %1, %2" : "=v"(r) : "v"(lo), "v"(hi)); return r; }
typedef float f32x2 __attribute__((ext_vector_type(2)));
__device__ __forceinline__ f32x2 gelu_pk(f32x2 v) {
    const f32x2 av = __builtin_elementwise_abs(v), d = av * 0.2316418882f + 1.0f;
    f32x2 t; t.x = __builtin_amdgcn_rcpf(d.x); t.y = __builtin_amdgcn_rcpf(d.y);
    f32x2 q = t * 0.5307027145f + (-0.7265760135f); q = q * t + 0.7107068705f; q = q * t + (-0.142248368f); q = q * t + 0.127414796f; q = q * t;
    const f32x2 s = (v * v) * (-0.72134752044f);
    f32x2 e; e.x = __builtin_amdgcn_exp2f(s.x); e.y = __builtin_amdgcn_exp2f(s.y);
    const f32x2 m = v * (q * e), r = v - m;
    f32x2 o; o.x = v.x < 0.f ? m.x : r.x; o.y = v.y < 0.f ? m.y : r.y; return o;
}

template <int ACT  > struct EpiBf16 {
    static constexpr bool PERM = true, AFTER_DRAIN = false; static_assert(ACT == 0 || ACT == 1, "EpiBf16: ACT is 0 (none) or 1 (gelu_pk)");
    bf16_t* O; int ldc; const float* bias; int split_cols; size_t split_stride; float scale0;
    __device__ __forceinline__ void operator()(const f32x4 (&acc)[2][2][4][2], const Unit& u, int wr, int wc, int fr, int fq) const {
        const int row0 = u.pm * BM + wr * 64 + fr; int colt = u.pn * BM; bf16_t* base = O;
        float sc = 1.f; if (split_cols) { const int t = colt / split_cols; base += (size_t)t * split_stride; colt -= t * split_cols; if (t == 0) sc = scale0; }
        const int col0 = colt + wc * 32 + 8 * fq, bcol0 = u.pn * BM + wc * 32 + 8 * fq;
        f32x4 bv[2][2];
#pragma unroll
        for (int bj = 0; bj < 2; ++bj)
#pragma unroll
            for (int n = 0; n < 2; ++n) bv[bj][n] = bias ? *(const f32x4*)(bias + bcol0 + bj * HALF + 4 * n) : (f32x4){0.f, 0.f, 0.f, 0.f};
#pragma unroll
        for (int ai = 0; ai < 2; ++ai)
#pragma unroll
            for (int m = 0; m < 4; ++m) { bf16_t* rowp = base + (size_t)(row0 + ai * HALF + m * 16) * ldc + col0;
#pragma unroll
                for (int bj = 0; bj < 2; ++bj) { f32x4 v0 = acc[ai][bj][m][0] + bv[bj][0], v1 = acc[ai][bj][m][1] + bv[bj][1];
                    if (ACT == 1) { f32x2 a = gelu_pk((f32x2){v0[0], v0[1]}), b = gelu_pk((f32x2){v0[2], v0[3]}), c = gelu_pk((f32x2){v1[0], v1[1]}), d = gelu_pk((f32x2){v1[2], v1[3]});
                        v0 = (f32x4){a.x, a.y, b.x, b.y}; v1 = (f32x4){c.x, c.y, d.x, d.y}; }
                    v0 = v0 * sc; v1 = v1 * sc; u32x4 w; w.x = cvt_pk_bf16(v0[0], v0[1]); w.y = cvt_pk_bf16(v0[2], v0[3]); w.z = cvt_pk_bf16(v1[0], v1[1]); w.w = cvt_pk_bf16(v1[2], v1[3]);
                    *(u32x4*)(rowp + bj * HALF) = w; } }
    }
};

template <class Epi, class Sched, bool ALIGN_EPI = false, bool SP2 = false>
__device__ __forceinline__ void gemm_phase(PG8_LAS unsigned char* lds, const Gemm g, const Sched& S, const Epi& E) {
    const int tid = threadIdx.x, wid = __builtin_amdgcn_readfirstlane(tid >> 6), lane = tid & 63, wr = wid >> 2, wc = wid & 3, fr = lane & 15, fq = lane >> 4;
    const int K = g.K, nt = K / BK;
    unsigned voffA[2], voffB[2];
#pragma unroll
    for (int i = 0; i < 2; ++i) { int R, C; stage_rc(tid * 16 + i * 8192, R, C); const int Rb = Epi::PERM ? ((R & ~31) + perm32(R & 31)) : R;
        voffA[i] = (unsigned)(R * K + C) * 2u; voffB[i] = (unsigned)(Rb * K + C) * 2u; }
    const size_t kstep = (size_t)(BK * 2);
    const size_t hstep = (size_t)HALF * K * 2;
    const size_t tstep = 2 * hstep;
    const unsigned ldsw = (unsigned)wid * 1024u;
    const int aoff = lds_byte(wr * 64 + fr, fq * 8), boff = lds_byte(wc * 32 + fr, fq * 8);
#define PG8_SA(b, h) (((b) * 2 + (h)) * HTB)
#define PG8_SB(b, h) ((4 + (b) * 2 + (h)) * HTB)
#define PG8_STAGE(bufoff, gbase, voff) do { _Pragma("unroll") for (int _i = 0; _i < 2; ++_i) \
        __builtin_amdgcn_global_load_lds((const unsigned*)((const char*)(gbase) + (voff)[_i]), (PG8_LAS unsigned*)(lds + (bufoff) + ldsw + _i * 8192), 16, 0, 0); } while (0)
#define PG8_LDA(dst, b, h) do { _Pragma("unroll") for (int m = 0; m < 4; ++m) _Pragma("unroll") for (int k = 0; k < 2; ++k) dst[m][k] = *(const PG8_LAS bf16x8*)(lds + PG8_SA(b, h) + aoff + m * 2048 + k * 1024); } while (0)
#define PG8_LDB(dst, b, h) do { _Pragma("unroll") for (int n = 0; n < 2; ++n) _Pragma("unroll") for (int k = 0; k < 2; ++k) dst[n][k] = *(const PG8_LAS bf16x8*)(lds + PG8_SB(b, h) + boff + n * 2048 + k * 1024); } while (0)
#define PG8_MMA(ai, bj, At, Bt) do { __builtin_amdgcn_s_setprio(1); _Pragma("unroll") for (int m = 0; m < 4; ++m) _Pragma("unroll") for (int n = 0; n < 2; ++n) _Pragma("unroll") for (int k = 0; k < 2; ++k) \
        acc[ai][bj][m][n] = __builtin_amdgcn_mfma_f32_16x16x32_bf16(Bt[n][k], At[m][k], acc[ai][bj][m][n], 0, 0, 0); __builtin_amdgcn_s_setprio(0); } while (0)
#define PG8_WAIT_V(n) asm volatile("s_waitcnt vmcnt(" #n ")" ::: "memory")
#define PG8_WAIT_L(n) asm volatile("s_waitcnt lgkmcnt(" #n ")" ::: "memory")
#define PG8_BAR __builtin_amdgcn_s_barrier()
#define PG8_SCHED __builtin_amdgcn_sched_barrier(0)
    Unit cur, nxt; int ui = 0;
    if (!S.next(0, cur)) return;
    f32x4 acc[2][2][4][2];
#pragma unroll
    for (int a = 0; a < 2; ++a)
#pragma unroll
        for (int b = 0; b < 2; ++b)
#pragma unroll
            for (int m = 0; m < 4; ++m)
#pragma unroll
                for (int n = 0; n < 2; ++n) acc[a][b][m][n] = (f32x4){0.f, 0.f, 0.f, 0.f};
    bf16x8 At[4][2], B0[2][2], B1[2][2];
    const char* cA = (const char*)(cur.src ? g.A2 : g.A) + (size_t)cur.pm * tstep; const char* cB = (const char*)(cur.src ? g.Bt2 : g.Bt) + (size_t)cur.pn * tstep;
    S.a_ready(cur);
    if constexpr (SP2) {
        PG8_STAGE(PG8_SB(0, 0), cB, voffB); PG8_STAGE(PG8_SB(0, 1), cB + hstep, voffB); PG8_STAGE(PG8_SA(0, 0), cA, voffA); PG8_STAGE(PG8_SA(0, 1), cA + hstep, voffA);
        if (wr == 1) PG8_BAR;
        PG8_WAIT_V(2); PG8_BAR;
        PG8_STAGE(PG8_SB(1, 0), cB + kstep, voffB); PG8_STAGE(PG8_SA(1, 0), cA + kstep, voffA); PG8_STAGE(PG8_SB(1, 1), cB + hstep + kstep, voffB);
        PG8_WAIT_V(6); PG8_BAR;
    } else {
        PG8_STAGE(PG8_SB(0, 0), cB, voffB); PG8_STAGE(PG8_SA(0, 0), cA, voffA); PG8_STAGE(PG8_SB(0, 1), cB + hstep, voffB); PG8_STAGE(PG8_SA(0, 1), cA + hstep, voffA);
        if (wr == 1) PG8_BAR;
        PG8_WAIT_V(4); PG8_BAR;
        PG8_STAGE(PG8_SB(1, 0), cB + kstep, voffB); PG8_STAGE(PG8_SA(1, 0), cA + kstep, voffA); PG8_STAGE(PG8_SB(1, 1), cB + hstep + kstep, voffB);
        PG8_WAIT_V(6); PG8_BAR;
    }
    for (;;) {
        const bool has_next = S.next(ui + 1, nxt);
        const char* nA = has_next ? (const char*)(nxt.src ? g.A2 : g.A) + (size_t)nxt.pm * tstep : cA; const char* nB = has_next ? (const char*)(nxt.src ? g.Bt2 : g.Bt) + (size_t)nxt.pn * tstep : cB;
        for (int t = 0; t < nt; t += 2) {
            const bool last = (t == nt - 2);
            const char* a1 = cA + (size_t)(t + 1) * kstep;
            const char* a2 = last ? nA : cA + (size_t)(t + 2) * kstep; const char* b2 = last ? nB : cB + (size_t)(t + 2) * kstep;
            const char* a3 = a2 + kstep; const char* b3 = b2 + kstep;
            if (last && has_next) S.a_ready(nxt);
            if constexpr (SP2) {
            PG8_LDB(B0, 0, 0); PG8_LDB(B1, 0, 1); PG8_SCHED; PG8_LDA(At, 0, 0); PG8_STAGE(PG8_SA(1, 1), a1 + hstep, voffA);
            PG8_WAIT_V(8); PG8_WAIT_L(0); PG8_BAR; PG8_MMA(0, 0, At, B0); PG8_MMA(0, 1, At, B1); PG8_BAR; PG8_SCHED;
            PG8_LDA(At, 0, 1); PG8_STAGE(PG8_SB(0, 0), b2, voffB); PG8_STAGE(PG8_SB(0, 1), b2 + hstep, voffB); PG8_STAGE(PG8_SA(0, 0), a2, voffA);
            PG8_WAIT_V(8); PG8_WAIT_L(0); PG8_BAR; PG8_MMA(1, 0, At, B0); PG8_MMA(1, 1, At, B1); PG8_BAR; PG8_SCHED;
            PG8_LDB(B0, 1, 0); PG8_LDB(B1, 1, 1); PG8_SCHED; PG8_LDA(At, 1, 0); PG8_STAGE(PG8_SA(0, 1), a2 + hstep, voffA);
            PG8_WAIT_V(8); PG8_WAIT_L(0); PG8_BAR; PG8_MMA(0, 0, At, B0); PG8_MMA(0, 1, At, B1); PG8_BAR; PG8_SCHED;
            PG8_LDA(At, 1, 1); PG8_STAGE(PG8_SB(1, 0), b3, voffB); PG8_STAGE(PG8_SB(1, 1), b3 + hstep, voffB); PG8_STAGE(PG8_SA(1, 0), a3, voffA);
            PG8_WAIT_V(8); PG8_WAIT_L(0); PG8_BAR; PG8_MMA(1, 0, At, B0); PG8_MMA(1, 1, At, B1); PG8_BAR; PG8_SCHED;
            } else {
            PG8_LDB(B0, 0, 0); PG8_SCHED; PG8_LDA(At, 0, 0); PG8_STAGE(PG8_SA(1, 1), a1 + hstep, voffA);
            PG8_WAIT_L(8); PG8_BAR; PG8_WAIT_L(0); PG8_MMA(0, 0, At, B0); PG8_BAR; PG8_SCHED;
            PG8_LDB(B1, 0, 1); PG8_STAGE(PG8_SB(0, 0), b2, voffB);
            PG8_BAR; PG8_WAIT_L(0); PG8_MMA(0, 1, At, B1); PG8_BAR;
            PG8_LDA(At, 0, 1); PG8_STAGE(PG8_SA(0, 0), a2, voffA);
            PG8_BAR; PG8_WAIT_L(0); PG8_MMA(1, 0, At, B0); PG8_BAR; PG8_SCHED;
            PG8_STAGE(PG8_SB(0, 1), b2 + hstep, voffB);
            PG8_WAIT_V(6); PG8_BAR; PG8_MMA(1, 1, At, B1); PG8_BAR;
            PG8_LDB(B0, 1, 0); PG8_SCHED; PG8_LDA(At, 1, 0); PG8_STAGE(PG8_SA(0, 1), a2 + hstep, voffA);
            PG8_WAIT_L(8); PG8_BAR; PG8_WAIT_L(0); PG8_MMA(0, 0, At, B0); PG8_BAR; PG8_SCHED;
            PG8_LDB(B1, 1, 1); PG8_STAGE(PG8_SB(1, 0), b3, voffB);
            PG8_BAR; PG8_WAIT_L(0); PG8_MMA(0, 1, At, B1); PG8_BAR;
            PG8_LDA(At, 1, 1); PG8_STAGE(PG8_SA(1, 0), a3, voffA);
            PG8_BAR; PG8_WAIT_L(0); PG8_MMA(1, 0, At, B0); PG8_BAR; PG8_SCHED;
            PG8_STAGE(PG8_SB(1, 1), b3 + hstep, voffB);
            PG8_WAIT_V(6); PG8_BAR; PG8_MMA(1, 1, At, B1); PG8_BAR;
            }
        }
        if constexpr (ALIGN_EPI) { if (wr == 0) PG8_BAR; }
        if constexpr (!Epi::AFTER_DRAIN) { E(acc, cur, wr, wc, fr, fq); S.done(cur); }
        if (!has_next) break;
#pragma unroll
        for (int a = 0; a < 2; ++a)
#pragma unroll
            for (int b = 0; b < 2; ++b)
#pragma unroll
                for (int m = 0; m < 4; ++m)
#pragma unroll
                    for (int n = 0; n < 2; ++n) acc[a][b][m][n] = (f32x4){0.f, 0.f, 0.f, 0.f};
        cur = nxt; cA = nA; cB = nB; ++ui;
        if constexpr (ALIGN_EPI) { if (wr == 1) PG8_BAR; }
    }
    PG8_WAIT_V(0);
    if constexpr (!ALIGN_EPI) { if (wr == 0) PG8_BAR; }
    PG8_BAR;
    if constexpr (Epi::AFTER_DRAIN) { E.fused(acc, cur, wr, wc, fr, fq, lds, wid, lane); S.done(cur); }
#undef PG8_SA
#undef PG8_SB
#undef PG8_STAGE
#undef PG8_LDA
#undef PG8_LDB
#undef PG8_MMA
#undef PG8_WAIT_V
#undef PG8_WAIT_L
#undef PG8_BAR
#undef PG8_SCHED
}
}

#define GAS __attribute__((address_space(1)))
#define LAS __attribute__((address_space(3)))
typedef unsigned short bf16;
typedef unsigned v4u __attribute__((ext_vector_type(4)));
typedef float f32x4 __attribute__((ext_vector_type(4)));
typedef short bf16x8 __attribute__((ext_vector_type(8)));
typedef GAS unsigned gu32;
typedef GAS unsigned long long gu64;
#define RLX_AGENT __ATOMIC_RELAXED, __HIP_MEMORY_SCOPE_AGENT
#define LDS_WAIT() asm volatile("s_waitcnt lgkmcnt(0)" ::: "memory")
#define VM_WAIT() asm volatile("s_waitcnt vmcnt(0)" ::: "memory")
__device__ __forceinline__ unsigned long long rt() { return __builtin_amdgcn_s_memrealtime(); }
__device__ __forceinline__ unsigned f2bf(float f) { unsigned u = __builtin_bit_cast(unsigned, f); return (u + 0x7fffu + ((u >> 16) & 1u)) >> 16; }
__device__ __forceinline__ unsigned pk2(float lo, float hi) { return f2bf(lo) | (f2bf(hi) << 16); }

#define XB_TMO      128
#define XB_XCNT(j)  (256  + 64 * (j))
#define XB_XSUB(j)  (1280 + 64 * (j))
#define XB_XGEN(j)  (2304 + 64 * (j))
#define XB_TOP      3328
#define XB_TOPGEN   3392
#define XCD_BAR_WORDS 3456
#define XB_SPIN_CAP (1u << 18)

__device__ __forceinline__ unsigned xb_ld(unsigned* p)              { return __hip_atomic_load(p, __ATOMIC_RELAXED, __HIP_MEMORY_SCOPE_AGENT); }
__device__ __forceinline__ unsigned xb_add(unsigned* p, unsigned v) { return __hip_atomic_fetch_add(p, v, __ATOMIC_RELAXED, __HIP_MEMORY_SCOPE_AGENT); }
__device__ __forceinline__ unsigned xb_xcc_id() { return (unsigned)__builtin_amdgcn_s_getreg((3 << 11) | 20) & 0xFu; }
#define XB_SPIN(cond, bar) do { unsigned _sp = 0; while (cond) { __builtin_amdgcn_s_sleep(1); \
    if ((++_sp & 255u) == 0u) { if (xb_ld(&(bar)[XB_TMO])) break; if (_sp > XB_SPIN_CAP) { atomicAdd(&(bar)[XB_TMO], 1u); break; } } } } while (0)

struct XcdBarrier {
    unsigned* bar; unsigned x;
    volatile LAS unsigned* st;
};

__device__ __forceinline__ XcdBarrier xcd_barrier_post(unsigned* bar, volatile LAS unsigned* st) {
    XcdBarrier b; b.bar = bar; b.x = xb_xcc_id(); b.st = st;
    if (threadIdx.x == 0) (void)xb_add(&bar[XB_XCNT(b.x)], 1u);
    return b;
}
__device__ __forceinline__ void xcd_barrier_complete(unsigned* bar, unsigned x, unsigned& nloc, unsigned& nx) {
    const unsigned G = gridDim.x * gridDim.y * gridDim.z;
    unsigned sum, cnt, mine, sp = 0u;
    for (;;) {
        sum = 0u; cnt = 0u; mine = 0u;
#pragma unroll
        for (unsigned j = 0; j < 16; ++j) { const unsigned c = xb_ld(&bar[XB_XCNT(j)]); sum += c; cnt += (c > 0u) ? 1u : 0u; mine = (j == x) ? c : mine; }
        if (sum == G) break;
        __builtin_amdgcn_s_sleep(1);
        if ((++sp & 255u) == 0u) { if (xb_ld(&bar[XB_TMO])) break; if (sp > XB_SPIN_CAP) { atomicAdd(&bar[XB_TMO], 1u); break; } }
    }
    nloc = mine > 0u ? mine : 1u; nx = cnt > 0u ? cnt : 1u;
}

__device__ __forceinline__ void xcd_barrier(const XcdBarrier& b) {
    asm volatile("s_waitcnt vmcnt(0)" ::: "memory");
    __syncthreads();
    if (threadIdx.x == 0) {
        unsigned* bar = b.bar;
        __builtin_amdgcn_s_waitcnt(0);
        unsigned nloc = b.st[0], nx = b.st[1];
        if (nloc == 0u) { xcd_barrier_complete(bar, b.x, nloc, nx); b.st[0] = nloc; b.st[1] = nx; }
        const unsigned old = xb_add(&bar[XB_XSUB(b.x)], 1u);
        const unsigned gen = old / nloc;
        if (old + 1u == (gen + 1u) * nloc) {
            __builtin_amdgcn_fence(__ATOMIC_RELEASE, "agent");
            asm volatile("s_waitcnt vmcnt(0)" ::: "memory");
            const unsigned og = xb_add(&bar[XB_TOP], 1u);
            const unsigned tg = og / nx;
            if (og + 1u == (tg + 1u) * nx) xb_add(&bar[XB_TOPGEN], 1u);
            else XB_SPIN(xb_ld(&bar[XB_TOPGEN]) == tg, bar);
            __builtin_amdgcn_fence(__ATOMIC_ACQUIRE, "agent");
            xb_add(&bar[XB_XGEN(b.x)], 1u);
            asm volatile("s_waitcnt vmcnt(0)" ::: "memory");
        } else {
            XB_SPIN(xb_ld(&bar[XB_XGEN(b.x)]) == gen, bar);
            __builtin_amdgcn_fence(__ATOMIC_ACQUIRE, "agent");
            asm volatile("s_waitcnt vmcnt(0)" ::: "memory");
        }
    }
    __syncthreads();
}

constexpr int NWAVES = 8, NTHR = 512;
constexpr int BATCH = 4, SEQ = 4096, D = 1024, M = BATCH * SEQ;
constexpr int NPROJ = 4352, LDW_IN = 4360, NMOD = 6144;
constexpr int C_QA = 0, C_KA = 512, C_VA = 640, C_QB = 768, C_KB = 1280, C_VB = 1792, C_GLA = 2304, C_GLB = 3328;
constexpr int NEXP = 16384;
constexpr float EPS = 1e-6f;

constexpr size_t MiB = 1u << 20;
constexpr size_t WS_CTL = 0, CTL_ZERO_BYTES = 1 * MiB;
constexpr size_t WS_MOD = 1 * MiB, WS_LOGF = 1 * MiB + 128 * 1024, WS_SUBK = 2 * MiB;
constexpr size_t WS_WIN = 4 * MiB, WS_WA = 12 * MiB + 512 * 1024, WS_WB = 13 * MiB + 512 * 1024, WS_WOUT = 14 * MiB + 512 * 1024, WS_WQ = 16 * MiB + 512 * 1024;
constexpr size_t WS_ED = 19 * MiB, WS_EU = 51 * MiB;
constexpr size_t WS_H = 83 * MiB, WS_OA = 83 * MiB, WS_OB = 99 * MiB, WS_PIDX = 83 * MiB, WS_PG = 87 * MiB;
constexpr size_t WS_PROJ = 115 * MiB, WS_X1 = 115 * MiB, WS_H2 = 179 * MiB, WS_QP = 211 * MiB;
constexpr size_t WS_END = 251 * MiB;
static_assert(WS_WIN + (size_t)NPROJ * D * 2 <= WS_WA && WS_WQ + (size_t)D * D * 2 <= WS_ED && WS_PROJ + (size_t)M * NPROJ * 2 <= WS_END, "ws map");
constexpr int CW_BAR = 4096;

constexpr int RING_OFF = 0, RING_BYTES = 131072;
constexpr int LDSCTL_OFF = RING_BYTES, MISC_OFF = LDSCTL_OFF + 320;
constexpr int LDS_BYTES = 147456;

typedef float f32x16 __attribute__((ext_vector_type(16)));
typedef short s16x4 __attribute__((ext_vector_type(4)));
typedef unsigned u32x2 __attribute__((ext_vector_type(2)));
typedef float f32x2_t __attribute__((ext_vector_type(2)));
typedef __bf16 bf16x2_t __attribute__((ext_vector_type(2)));

__device__ __forceinline__ unsigned cvtpk(float lo, float hi) { f32x2_t v = {lo, hi}; bf16x2_t b = __builtin_convertvector(v, bf16x2_t); return __builtin_bit_cast(unsigned, b); }
__device__ __forceinline__ float bflo(unsigned u) { return __uint_as_float(u << 16); }
__device__ __forceinline__ float bfhi(unsigned u) { return __uint_as_float(u & 0xffff0000u); }
__device__ __forceinline__ float wave_sum(float v) {
#pragma unroll
    for (int o = 1; o < 64; o <<= 1) v += __shfl_xor(v, o);
    return v;
}
__device__ __forceinline__ int crow(int r, int hi) { return (r & 3) + 8 * (r >> 2) + 4 * hi; }
#define MFMA32(a, b, c) __builtin_amdgcn_mfma_f32_32x32x16_bf16((a), (b), (c), 0, 0, 0)

struct Frame {
    LAS unsigned char* lds;
    int tid, lane, wave, vcu, G;
    const float* in[18]; float* out; unsigned char* ws;
};

__device__ __forceinline__ void p0_transpose_item(const float* W, int ld, int K, int ncols, bf16* WT, int row_off, LAS float* scr, int item, int lane) {
    const int nblk = ncols / 32, kb = item / nblk, nb = item % nblk, k0 = 64 * kb, n0 = 32 * nb;
#pragma unroll 8
    for (int i = 0; i < 32; ++i) { const int kk = 2 * i + (lane >> 5); scr[kk * 33 + (lane & 31)] = W[(size_t)(k0 + kk) * ld + n0 + (lane & 31)]; }
    LDS_WAIT(); asm volatile("" ::: "memory");
    const int c = lane & 7;
#pragma unroll
    for (int j = 0; j < 4; ++j) { const int n = (lane >> 3) + 8 * j; const LAS float* s = scr + (8 * c) * 33 + n;
        v4u o; o.x = pk2(s[0 * 33], s[1 * 33]); o.y = pk2(s[2 * 33], s[3 * 33]); o.z = pk2(s[4 * 33], s[5 * 33]); o.w = pk2(s[6 * 33], s[7 * 33]);
        *(GAS v4u*)(WT + (size_t)(row_off + n0 + n) * K + k0 + 8 * c) = o; }
    LDS_WAIT(); asm volatile("" ::: "memory");
}
__device__ __forceinline__ void p0_convert(const float* __restrict__ src, bf16* __restrict__ dst, long n_iters, int gw, int NGW, int lane) {
    for (long it0 = (long)gw * 4; it0 < n_iters; it0 += (long)NGW * 4) {
        f32x4 a[4][2];
#pragma unroll
        for (int u = 0; u < 4; ++u) { const long it = it0 + u; if (it < n_iters) { const float* p = src + it * 512 + lane * 4; a[u][0] = *(const f32x4*)p; a[u][1] = *(const f32x4*)(p + 256); } }
#pragma unroll
        for (int u = 0; u < 4; ++u) { const long it = it0 + u; if (it < n_iters) { bf16* q = dst + it * 512 + lane * 4;
            u32x2 w0, w1; w0.x = cvtpk(a[u][0].x, a[u][0].y); w0.y = cvtpk(a[u][0].z, a[u][0].w); w1.x = cvtpk(a[u][1].x, a[u][1].y); w1.y = cvtpk(a[u][1].z, a[u][1].w);
            *(u32x2*)q = w0; *(u32x2*)(q + 256) = w1; } }
    }
}
__device__ __forceinline__ void p0_prologue(Frame& F) {
    const float* c = F.in[1]; const float* w_ada = F.in[4]; const float* b_ada = F.in[5];
    float* MOD = (float*)(F.ws + WS_MOD);
    {
        LAS float* cact = (LAS float*)(F.lds);
        LAS float* part = (LAS float*)(F.lds + 16384);
        bool did = false;
        for (int item = F.vcu; item < NMOD / 32; item += F.G) {
            if (!did) { for (int i = F.tid; i < 4096; i += NTHR) { const float cv = c[i]; cact[i] = cv / (1.0f + __expf(-cv)); } did = true; }
            __syncthreads();
            const int n0 = item * 32, col = n0 + (F.lane & 31), ksub = F.lane >> 5;
            float a0 = 0.f, a1 = 0.f, a2 = 0.f, a3 = 0.f;
#pragma unroll 16
            for (int it = 0; it < 64; ++it) { const int k = (it * 8 + F.wave) * 2 + ksub; const float w = w_ada[(size_t)k * NMOD + col];
                a0 += cact[k] * w; a1 += cact[1024 + k] * w; a2 += cact[2048 + k] * w; a3 += cact[3072 + k] * w; }
            a0 += __shfl_xor(a0, 32); a1 += __shfl_xor(a1, 32); a2 += __shfl_xor(a2, 32); a3 += __shfl_xor(a3, 32);
            if (F.lane < 32) { part[(F.wave * 4 + 0) * 32 + F.lane] = a0; part[(F.wave * 4 + 1) * 32 + F.lane] = a1; part[(F.wave * 4 + 2) * 32 + F.lane] = a2; part[(F.wave * 4 + 3) * 32 + F.lane] = a3; }
            __syncthreads();
            if (F.tid < 128) { const int b = F.tid >> 5, cl = F.tid & 31; float s = 0.f;
#pragma unroll
                for (int w = 0; w < 8; ++w) s += part[(w * 4 + b) * 32 + cl];
                MOD[b * NMOD + n0 + cl] = s + b_ada[n0 + cl]; }
            __syncthreads();
        }
    }
    LAS float* scr = (LAS float*)(F.lds + RING_OFF + F.wave * 16384);
    const int gw = F.vcu * NWAVES + F.wave, NGW = F.G * NWAVES;
    constexpr int I_IN1 = (D / 64) * (2304 / 32), I_IN2 = (D / 64) * (2048 / 32), I_AB = (512 / 64) * (D / 32), I_SQ = (D / 64) * (D / 32);
    constexpr int NITEMS = I_IN1 + I_IN2 + 2 * I_AB + 2 * I_SQ;
    bf16* Win_t = (bf16*)(F.ws + WS_WIN);
    for (int it = gw; it < NITEMS; it += NGW) {
        int r = it;
        if (r < I_IN1) { p0_transpose_item(F.in[6], LDW_IN, D, 2304, Win_t, 0, scr, r, F.lane); continue; } r -= I_IN1;
        if (r < I_IN2) { p0_transpose_item(F.in[6] + 2312, LDW_IN, D, 2048, Win_t, 2304, scr, r, F.lane); continue; } r -= I_IN2;
        if (r < I_AB) { p0_transpose_item(F.in[9], D, 512, D, (bf16*)(F.ws + WS_WA), 0, scr, r, F.lane); continue; } r -= I_AB;
        if (r < I_AB) { p0_transpose_item(F.in[10], D, 512, D, (bf16*)(F.ws + WS_WB), 0, scr, r, F.lane); continue; } r -= I_AB;
        if (r < I_SQ) { p0_transpose_item(F.in[11], D, D, D, (bf16*)(F.ws + WS_WOUT), 0, scr, r, F.lane); continue; } r -= I_SQ;
        p0_transpose_item(F.in[13], D, D, D, (bf16*)(F.ws + WS_WQ), 0, scr, r, F.lane);
    }
    p0_convert(F.in[15], (bf16*)(F.ws + WS_ED), (long)NEXP * D / 512, gw, NGW, F.lane);
    p0_convert(F.in[16], (bf16*)(F.ws + WS_EU), (long)NEXP * D / 512, gw, NGW, F.lane);
    p0_convert(F.in[14], (bf16*)(F.ws + WS_SUBK), (long)(8 * 2 * 128 * 64) / 512, gw, NGW, F.lane);
}

__device__ __forceinline__ void p1_norm(Frame& F) {
    const float* x = F.in[0]; const float* g1 = F.in[2]; const float* w_in = F.in[6]; const float* b_forget = F.in[7];
    const float* MOD = (const float*)(F.ws + WS_MOD); bf16* H = (bf16*)(F.ws + WS_H); float* LOGF = (float*)(F.ws + WS_LOGF);
    LAS float* wfl = (LAS float*)(F.lds);
    for (int i = F.tid; i < 8192; i += NTHR) { const int k = i >> 3, j = i & 7; wfl[j * 1024 + k] = w_in[(size_t)k * LDW_IN + 2304 + j]; }
    __syncthreads();
    const int gw = F.vcu * NWAVES + F.wave, NGW = F.G * NWAVES;
    for (int row = gw; row < M; row += NGW) {
        const f32x4* xr = (const f32x4*)(x + (size_t)row * D) + F.lane;
        f32x4 v[4]; float ss = 0.f;
#pragma unroll
        for (int j = 0; j < 4; ++j) { v[j] = xr[64 * j]; ss += (v[j].x * v[j].x + v[j].y * v[j].y) + (v[j].z * v[j].z + v[j].w * v[j].w); }
        ss = wave_sum(ss);
        const float rstd = 1.0f / sqrtf(ss * (1.0f / D) + EPS);
        const int b = row >> 12; const float* mb = MOD + b * NMOD;
        float fl[8];
#pragma unroll
        for (int jj = 0; jj < 8; ++jj) fl[jj] = 0.f;
#pragma unroll
        for (int j = 0; j < 4; ++j) { const int col = 4 * F.lane + 256 * j;
            const f32x4 g = *(const f32x4*)(g1 + col), sh = *(const f32x4*)(mb + col), sc = *(const f32x4*)(mb + 1024 + col);
            const f32x4 hv = (v[j] * rstd) * g * (sc + 1.0f) + sh;
            u32x2 w; w.x = cvtpk(hv.x, hv.y); w.y = cvtpk(hv.z, hv.w);
            *(u32x2*)(H + (size_t)row * D + col) = w;
#pragma unroll
            for (int jj = 0; jj < 8; ++jj) { const f32x4 wv = *(const LAS f32x4*)(wfl + jj * 1024 + col); fl[jj] += (hv.x * wv.x + hv.y * wv.y) + (hv.z * wv.z + hv.w * wv.w); }
        }
        float mine = 0.f;
#pragma unroll
        for (int jj = 0; jj < 8; ++jj) { const float s = wave_sum(fl[jj]); if (F.lane == jj) mine = s; }
        if (F.lane < 8) { const float z = mine + b_forget[F.lane]; const float ls = fminf(z, 0.f) - log1pf(__expf(-fabsf(z))); LOGF[(size_t)row * 8 + F.lane] = ls; }
    }
}

constexpr int KP = 72;
constexpr int VPF = 68;
constexpr int VPS = 260;
struct FlashState { f32x16 o[2]; float m, l; };

__device__ __forceinline__ void flash_tail(FlashState& st, f32x16& s0, f32x16& s1, const LAS bf16* Vs, int vp, int r32, int hi) {
    float mt = s0[0];
#pragma unroll
    for (int r = 1; r < 16; ++r) mt = fmaxf(mt, s0[r]);
#pragma unroll
    for (int r = 0; r < 16; ++r) mt = fmaxf(mt, s1[r]);
    mt = fmaxf(mt, __shfl_xor(mt, 32));
    const float mn = fmaxf(st.m, mt);
    const float alpha = __expf(st.m - mn);
    st.m = mn;
    float ps = 0.f;
#pragma unroll
    for (int r = 0; r < 16; ++r) { s0[r] = __expf(s0[r] - mn); ps += s0[r]; }
#pragma unroll
    for (int r = 0; r < 16; ++r) { s1[r] = __expf(s1[r] - mn); ps += s1[r]; }
    st.l = st.l * alpha + ps;
#pragma unroll
    for (int r = 0; r < 16; ++r) { st.o[0][r] *= alpha; st.o[1][r] *= alpha; }
#pragma unroll
    for (int blk = 0; blk < 2; ++blk)
#pragma unroll
        for (int s = 0; s < 2; ++s) {
            v4u pw;
            if (blk == 0) { pw.x = cvtpk(s0[8 * s + 0], s0[8 * s + 1]); pw.y = cvtpk(s0[8 * s + 2], s0[8 * s + 3]); pw.z = cvtpk(s0[8 * s + 4], s0[8 * s + 5]); pw.w = cvtpk(s0[8 * s + 6], s0[8 * s + 7]); }
            else          { pw.x = cvtpk(s1[8 * s + 0], s1[8 * s + 1]); pw.y = cvtpk(s1[8 * s + 2], s1[8 * s + 3]); pw.z = cvtpk(s1[8 * s + 4], s1[8 * s + 5]); pw.w = cvtpk(s1[8 * s + 6], s1[8 * s + 7]); }
            const bf16x8 pf = __builtin_bit_cast(bf16x8, pw);
#pragma unroll
            for (int db = 0; db < 2; ++db) {
                const LAS bf16* vp0 = Vs + (32 * db + r32) * vp + 32 * blk + 16 * s + 4 * hi;
                const s16x4 lo = *(const LAS s16x4*)vp0, hh = *(const LAS s16x4*)(vp0 + 8);
                const bf16x8 vf = __builtin_shufflevector(lo, hh, 0, 1, 2, 3, 4, 5, 6, 7);
                st.o[db] = MFMA32(vf, pf, st.o[db]);
            }
        }
}
__device__ __forceinline__ void flash_qk(f32x16& s0, f32x16& s1, const bf16x8 (&qf)[4], const LAS bf16* Ks, int r32, int hi) {
    s0 = (f32x16){0.f}; s1 = (f32x16){0.f};
#pragma unroll
    for (int r = 0; r < 16; ++r) { s0[r] = 0.f; s1[r] = 0.f; }
#pragma unroll
    for (int ks = 0; ks < 4; ++ks) {
        const bf16x8 a0 = *(const LAS bf16x8*)(Ks + r32 * KP + 16 * ks + 8 * hi);
        const bf16x8 a1 = *(const LAS bf16x8*)(Ks + (32 + r32) * KP + 16 * ks + 8 * hi);
        s0 = MFMA32(a0, qf[ks], s0); s1 = MFMA32(a1, qf[ks], s1);
    }
}
__device__ __forceinline__ void flash_store(const FlashState& st, bf16* orow, int hi) {
    float lt = st.l + __shfl_xor(st.l, 32);
    const float inv = 1.0f / lt;
#pragma unroll
    for (int db = 0; db < 2; ++db)
#pragma unroll
        for (int rg = 0; rg < 4; ++rg) { u32x2 w; w.x = cvtpk(st.o[db][4 * rg] * inv, st.o[db][4 * rg + 1] * inv); w.y = cvtpk(st.o[db][4 * rg + 2] * inv, st.o[db][4 * rg + 3] * inv);
            *(u32x2*)(orow + 32 * db + 8 * rg + 4 * hi) = w; }
}

__device__ __forceinline__ void fox_unit(Frame& F, int b, int h, int qb) {
    const bf16* proj = (const bf16*)(F.ws + WS_PROJ); const float* LOGF = (const float*)(F.ws + WS_LOGF); bf16* OB = (bf16*)(F.ws + WS_OB);
    LAS float* Fs = (LAS float*)(F.lds);
    LAS float* wtot = (LAS float*)(F.lds + 16384);
    LAS bf16* Kb = (LAS bf16*)(F.lds + 16384 + 64);
    LAS bf16* Vb = (LAS bf16*)(F.lds + 16384 + 64 + 2 * 64 * KP * 2);
    const int lane = F.lane, wave = F.wave, tid = F.tid, r32 = lane & 31, hi = lane >> 5;
    const int q_end = 256 * (qb + 1), NT = q_end / 64;
    const size_t rowbase = (size_t)b * SEQ;
    {
        float v[8]; float run = 0.f;
#pragma unroll
        for (int i = 0; i < 8; ++i) { const int pos = tid * 8 + i; const float lf = (pos < q_end) ? LOGF[(rowbase + pos) * 8 + h] : 0.f; run += lf; v[i] = run; }
        float inc = run;
#pragma unroll
        for (int o = 1; o < 64; o <<= 1) { const float t = __shfl_up(inc, o); if (lane >= o) inc += t; }
        if (lane == 63) wtot[wave] = inc;
        __syncthreads();
        float off = inc - run;
        for (int w = 0; w < wave; ++w) off += wtot[w];
#pragma unroll
        for (int i = 0; i < 8; ++i) Fs[tid * 8 + i] = v[i] + off;
    }
    const int qrow = 256 * qb + 32 * wave + r32;
    bf16x8 qf[4];
    { const bf16* qp = proj + (rowbase + qrow) * NPROJ + C_QB + 64 * h + 8 * hi;
#pragma unroll
      for (int ks = 0; ks < 4; ++ks) qf[ks] = *(const bf16x8*)(qp + 16 * ks); }
    const int tq = 4 * qb + (wave >> 1);
    FlashState st; st.m = -INFINITY; st.l = 0.f;
#pragma unroll
    for (int r = 0; r < 16; ++r) { st.o[0][r] = 0.f; st.o[1][r] = 0.f; }
    const int srow = tid >> 3, sch = tid & 7;
    const bf16* kg = proj + (rowbase + srow) * NPROJ + C_KB + 64 * h + 8 * sch;
    const bf16* vg = proj + (rowbase + srow) * NPROJ + C_VB + 64 * h + 8 * sch;
    v4u kreg, vreg;
    { const size_t o = (size_t)(NT - 1) * 64 * NPROJ; kreg = *(const v4u*)(kg + o); vreg = *(const v4u*)(vg + o); }
    int cur = 0;
    {   *(LAS v4u*)(Kb + srow * KP + 8 * sch) = kreg;
        const unsigned short* vs = (const unsigned short*)&vreg;
#pragma unroll
        for (int i = 0; i < 8; ++i) Vb[(8 * sch + i) * VPF + srow] = vs[i];
    }
    __syncthreads();
    const float fq = Fs[qrow];
    for (int t = NT - 1; t >= 0; --t) {
        if (t > 0) { const size_t o = (size_t)(t - 1) * 64 * NPROJ; kreg = *(const v4u*)(kg + o); vreg = *(const v4u*)(vg + o); }
        if (t <= tq) {
            const LAS bf16* Ks = Kb + cur * 64 * KP; const LAS bf16* Vs = Vb + cur * 64 * VPF;
            f32x16 s0, s1; flash_qk(s0, s1, qf, Ks, r32, hi);
            const LAS float* Fk = Fs + 64 * t;
            const bool diag = (t == tq);
#pragma unroll
            for (int rg = 0; rg < 4; ++rg) {
                const f32x4 f0 = *(const LAS f32x4*)(Fk + 8 * rg + 4 * hi), f1 = *(const LAS f32x4*)(Fk + 32 + 8 * rg + 4 * hi);
#pragma unroll
                for (int i = 0; i < 4; ++i) { const int r = 4 * rg + i; const int kv = 64 * t + 8 * rg + 4 * hi + i;
                    float a = s0[r] * 0.125f + (fq - f0[i]); float c = s1[r] * 0.125f + (fq - f1[i]);
                    if (diag) { if (kv > qrow) a = -INFINITY; if (kv + 32 > qrow) c = -INFINITY; }
                    s0[r] = a; s1[r] = c; }
            }
            flash_tail(st, s0, s1, Vs, VPF, r32, hi);
        }
        if (t > 0) {
            const int nb = cur ^ 1;
            *(LAS v4u*)(Kb + nb * 64 * KP + srow * KP + 8 * sch) = kreg;
            const unsigned short* vs = (const unsigned short*)&vreg;
#pragma unroll
            for (int i = 0; i < 8; ++i) Vb[nb * 64 * VPF + (8 * sch + i) * VPF + srow] = vs[i];
        }
        __syncthreads();
        cur ^= 1;
    }
    flash_store(st, OB + (rowbase + qrow) * 512 + 64 * h, hi);
    __syncthreads();
}

__device__ const unsigned char T5_BUCKET[128] = {0,1,2,3,4,5,6,7,8,9,10,11,12,13,14,15,16,16,16,17,17,18,18,18,19,19,19,20,20,20,20,21,21,21,21,22,22,22,22,22,23,23,23,23,23,23,24,24,24,24,24,24,25,25,25,25,25,25,25,26,26,26,26,26,26,26,26,27,27,27,27,27,27,27,27,27,27,28,28,28,28,28,28,28,28,28,28,29,29,29,29,29,29,29,29,29,29,29,29,30,30,30,30,30,30,30,30,30,30,30,30,30,30,31,31,31,31,31,31,31,31,31,31,31,31,31,31,31};

__device__ __forceinline__ void swa_unit(Frame& F, int b, int kvh, int n) {
    const bf16* proj = (const bf16*)(F.ws + WS_PROJ); bf16* OA = (bf16*)(F.ws + WS_OA);
    const float* sinks = F.in[8]; const float* rel_bias = F.in[12];
    LAS bf16* Kb = (LAS bf16*)(F.lds);
    LAS bf16* Vb = (LAS bf16*)(F.lds + 36864);
    LAS float* bt = (LAS float*)(F.lds + 36864 + 33280);
    const int lane = F.lane, wave = F.wave, tid = F.tid, r32 = lane & 31, hi = lane >> 5;
    const size_t rowbase = (size_t)b * SEQ;
    {
        const int g = tid >> 7, d = tid & 127;
        bt[tid] = rel_bias[(int)T5_BUCKET[d] * 8 + kvh * 4 + g];
#pragma unroll
        for (int i = 0; i < 4; ++i) {
            const int idx = tid + i * NTHR, kb = idx >> 3, sch = idx & 7; const int pos = 128 * (n - 1) + kb;
            v4u kreg = (v4u){0u, 0u, 0u, 0u}, vreg = (v4u){0u, 0u, 0u, 0u};
            if (pos >= 0) { const bf16* p = proj + (rowbase + pos) * NPROJ + 64 * kvh + 8 * sch; kreg = *(const v4u*)(p + C_KA); vreg = *(const v4u*)(p + C_VA); }
            *(LAS v4u*)(Kb + kb * KP + 8 * sch) = kreg;
            const unsigned short* vs = (const unsigned short*)&vreg;
#pragma unroll
            for (int j = 0; j < 8; ++j) Vb[(8 * sch + j) * VPS + kb] = vs[j];
        }
    }
    __syncthreads();
    const int g = wave & 3, qh = wave >> 2, head = kvh * 4 + g;
    const LAS float* btg = bt + g * 128;
    for (int sb = 0; sb < 2; ++sb) {
        const int qrel0 = 64 * qh + 32 * sb, qrel = qrel0 + r32;
        const size_t row = rowbase + 128 * n + qrel;
        bf16x8 qf[4];
        { const bf16* qp = proj + row * NPROJ + C_QA + 64 * head + 8 * hi;
#pragma unroll
          for (int ks = 0; ks < 4; ++ks) qf[ks] = *(const bf16x8*)(qp + 16 * ks); }
        FlashState st; st.m = sinks[head]; st.l = (hi == 0) ? 1.0f : 0.0f;
#pragma unroll
        for (int r = 0; r < 16; ++r) { st.o[0][r] = 0.f; st.o[1][r] = 0.f; }
        const int t_lo = (qrel0 + 1) >> 6, t_hi = (qrel0 + 159) >> 6;
        for (int t = t_lo; t <= t_hi; ++t) {
            f32x16 s0, s1; flash_qk(s0, s1, qf, Kb + t * 64 * KP, r32, hi);
#pragma unroll
            for (int r = 0; r < 16; ++r) {
                const int kb0 = 64 * t + crow(r, hi), kb1 = kb0 + 32;
                const int d0 = 128 + qrel - kb0, d1 = d0 - 32;
                const bool v0 = (d0 >= 0) && (d0 < 128) && (n > 0 || kb0 >= 128);
                const bool v1 = (d1 >= 0) && (d1 < 128) && (n > 0 || kb1 >= 128);
                const float b0 = btg[d0 & 127], b1 = btg[d1 & 127];
                s0[r] = v0 ? (s0[r] * 0.125f + b0) : -INFINITY;
                s1[r] = v1 ? (s1[r] * 0.125f + b1) : -INFINITY;
            }
            flash_tail(st, s0, s1, Vb + 64 * t, VPS, r32, hi);
        }
        flash_store(st, OA + row * 512 + 64 * head, hi);
    }
    __syncthreads();
}
__device__ __forceinline__ void p3_attention(Frame& F) {
    for (int item = F.vcu; item < 256; item += F.G) {
        swa_unit(F, item >> 6, (item >> 5) & 1, item & 31);
        const int bh = item >> 3, j = item & 7;
        fox_unit(F, bh >> 3, bh & 7, 15 - j);
        fox_unit(F, bh >> 3, bh & 7, j);
    }
}

struct PairOrder {
    pg8::StaticOrder S;
    __device__ bool next(int i, pg8::Unit& u) const { if (!S.next(i >> 1, u)) return false; u.src = i & 1; return true; }
    __device__ __forceinline__ void a_ready(const pg8::Unit&) const {}
    __device__ __forceinline__ void done(const pg8::Unit&) const {}
};
__device__ __forceinline__ float sigmoidf_(float z) { return 1.0f / (1.0f + __expf(-z)); }
struct EpiGate {
    static constexpr bool PERM = false, AFTER_DRAIN = false;
    const bf16* proj; bf16* tmp; bf16* mixed;
    __device__ __forceinline__ void operator()(const pg8::f32x4 (&acc)[2][2][4][2], const pg8::Unit& u, int wr, int wc, int fr, int fq) const {
        const int goff = u.src ? C_GLB : C_GLA;
#pragma unroll
        for (int ai = 0; ai < 2; ++ai)
#pragma unroll
            for (int m = 0; m < 4; ++m) { const size_t row = (size_t)u.pm * 256 + ai * 128 + wr * 64 + m * 16 + fr;
#pragma unroll
                for (int bj = 0; bj < 2; ++bj)
#pragma unroll
                    for (int n = 0; n < 2; ++n) { const int col = u.pn * 256 + bj * 128 + wc * 32 + n * 16 + 4 * fq;
                        const u32x2 gw = *(const u32x2*)(proj + row * NPROJ + goff + col);
                        const pg8::f32x4 a = acc[ai][bj][m][n];
                        float v0 = a[0] * sigmoidf_(bflo(gw.x)), v1 = a[1] * sigmoidf_(bfhi(gw.x)), v2 = a[2] * sigmoidf_(bflo(gw.y)), v3 = a[3] * sigmoidf_(bfhi(gw.y));
                        if (u.src == 0) { u32x2 w; w.x = cvtpk(v0, v1); w.y = cvtpk(v2, v3); *(u32x2*)(tmp + row * D + col) = w; }
                        else { const u32x2 t = *(const u32x2*)(tmp + row * D + col);
                            u32x2 w; w.x = cvtpk(v0 + bflo(t.x), v1 + bfhi(t.x)); w.y = cvtpk(v2 + bflo(t.y), v3 + bfhi(t.y)); *(u32x2*)(mixed + row * D + col) = w; }
                    }
            }
    }
};
struct EpiRes {
    static constexpr bool PERM = false, AFTER_DRAIN = false;
    const float* x; const float* mod; float* x1;
    __device__ __forceinline__ void operator()(const pg8::f32x4 (&acc)[2][2][4][2], const pg8::Unit& u, int wr, int wc, int fr, int fq) const {
#pragma unroll
        for (int ai = 0; ai < 2; ++ai)
#pragma unroll
            for (int m = 0; m < 4; ++m) { const size_t row = (size_t)u.pm * 256 + ai * 128 + wr * 64 + m * 16 + fr; const int b = (int)(row >> 12);
#pragma unroll
                for (int bj = 0; bj < 2; ++bj)
#pragma unroll
                    for (int n = 0; n < 2; ++n) { const int col = u.pn * 256 + bj * 128 + wc * 32 + n * 16 + 4 * fq;
                        const pg8::f32x4 xin = *(const pg8::f32x4*)(x + row * D + col), gt = *(const pg8::f32x4*)(mod + b * NMOD + 2048 + col);
                        *(pg8::f32x4*)(x1 + row * D + col) = xin + gt * acc[ai][bj][m][n]; }
            }
    }
};

__device__ __forceinline__ void p6_norm2(Frame& F) {
    const float* x1 = (const float*)(F.ws + WS_X1); const float* g2 = F.in[3]; const float* MOD = (const float*)(F.ws + WS_MOD); bf16* H2 = (bf16*)(F.ws + WS_H2);
    const int gw = F.vcu * NWAVES + F.wave, NGW = F.G * NWAVES;
    for (int row = gw; row < M; row += NGW) {
        const f32x4* xr = (const f32x4*)(x1 + (size_t)row * D) + F.lane;
        f32x4 v[4]; float ss = 0.f;
#pragma unroll
        for (int j = 0; j < 4; ++j) { v[j] = xr[64 * j]; ss += (v[j].x * v[j].x + v[j].y * v[j].y) + (v[j].z * v[j].z + v[j].w * v[j].w); }
        ss = wave_sum(ss);
        const float rstd = 1.0f / sqrtf(ss * (1.0f / D) + EPS);
        const int b = row >> 12; const float* mb = MOD + b * NMOD;
#pragma unroll
        for (int j = 0; j < 4; ++j) { const int col = 4 * F.lane + 256 * j;
            const f32x4 g = *(const f32x4*)(g2 + col), sh = *(const f32x4*)(mb + 3072 + col), sc = *(const f32x4*)(mb + 4096 + col);
            const f32x4 hv = (v[j] * rstd) * g * (sc + 1.0f) + sh;
            u32x2 w; w.x = cvtpk(hv.x, hv.y); w.y = cvtpk(hv.z, hv.w);
            *(u32x2*)(H2 + (size_t)row * D + col) = w; }
    }
}

__device__ __forceinline__ unsigned f2ord(float f) { const unsigned u = __float_as_uint(f); return u ^ ((unsigned)((int)u >> 31) | 0x80000000u); }
__device__ __forceinline__ float ord2f(unsigned o) { const unsigned u = (o & 0x80000000u) ? (o & 0x7fffffffu) : ~o; return __uint_as_float(u); }
#define CE_DESC(a, b) do { const unsigned _x = (a), _y = (b); (a) = _x > _y ? _x : _y; (b) = _x > _y ? _y : _x; } while (0)
__device__ __forceinline__ void sort16(unsigned (&k)[16]) {
#pragma unroll
    for (int size = 2; size <= 16; size <<= 1)
#pragma unroll
        for (int stride = size >> 1; stride > 0; stride >>= 1)
#pragma unroll
            for (int i = 0; i < 16; ++i) { const int j = i ^ stride; if (j > i) { if ((i & size) == 0) CE_DESC(k[i], k[j]); else CE_DESC(k[j], k[i]); } }
}
__device__ __forceinline__ void merge16(unsigned (&a)[16], const unsigned (&b)[16]) {
#pragma unroll
    for (int i = 0; i < 16; ++i) a[i] = a[i] > b[15 - i] ? a[i] : b[15 - i];
#pragma unroll
    for (int stride = 8; stride > 0; stride >>= 1)
#pragma unroll
        for (int i = 0; i < 16; ++i) { const int j = i ^ stride; if (j > i) CE_DESC(a[i], a[j]); }
}
__device__ __forceinline__ void top16_of_64(unsigned (&g0)[16], unsigned (&g1)[16], unsigned (&g2)[16], unsigned (&g3)[16]) {
    sort16(g0); sort16(g1); sort16(g2); sort16(g3);
    merge16(g0, g1); merge16(g2, g3); merge16(g0, g2);
}
constexpr int NCAND = 50;
__device__ __forceinline__ void p8a_topk(Frame& F) {
    const bf16* QP = (const bf16*)(F.ws + WS_QP); const bf16* SUBK = (const bf16*)(F.ws + WS_SUBK);
    unsigned short* PIDX = (unsigned short*)(F.ws + WS_PIDX); float* PG = (float*)(F.ws + WS_PG);
    LAS unsigned short* Elds = (LAS unsigned short*)(F.lds) + F.wave * (NCAND * 64);
    const int lane = F.lane, r32 = lane & 31, hi = lane >> 5;
    const int gw = F.vcu * NWAVES + F.wave, NGW = F.G * NWAVES;
    for (int item = gw; item < (M / 32) * 8; item += NGW) {
        const int tile = item >> 3;
        const int tok = tile * 32 + r32;
        { const int h = item & 7;
            unsigned top[2][16];
#pragma unroll
            for (int p = 0; p < 2; ++p) {
                bf16x8 qf[4];
                { const bf16* qp = QP + (size_t)tok * D + h * 128 + p * 64 + 8 * hi;
#pragma unroll
                  for (int ks = 0; ks < 4; ++ks) qf[ks] = *(const bf16x8*)(qp + 16 * ks); }
                const bf16* kp = SUBK + (size_t)((h * 2 + p) * 128 + r32) * 64 + 8 * hi;
                unsigned kk[4][16];
#pragma unroll
                for (int blk = 0; blk < 4; ++blk) {
                    f32x16 acc;
#pragma unroll
                    for (int r = 0; r < 16; ++r) acc[r] = 0.f;
#pragma unroll
                    for (int ks = 0; ks < 4; ++ks) { const bf16x8 a = *(const bf16x8*)(kp + (size_t)blk * 32 * 64 + 16 * ks); acc = MFMA32(a, qf[ks], acc); }
#pragma unroll
                    for (int r = 0; r < 16; ++r) { const int key = 32 * blk + crow(r, hi); kk[blk][r] = (f2ord(acc[r]) & ~127u) | (unsigned)(127 - key); }
                }
                top16_of_64(kk[0], kk[1], kk[2], kk[3]);
                unsigned other[16];
#pragma unroll
                for (int i = 0; i < 16; ++i) other[i] = (unsigned)__shfl_xor((int)kk[0][i], 32);
                merge16(kk[0], other);
#pragma unroll
                for (int i = 0; i < 16; ++i) top[p][i] = kk[0][i];
            }
            float s1[16], s2[16]; unsigned i1[16], i2[16];
#pragma unroll
            for (int i = 0; i < 16; ++i) { s1[i] = ord2f(top[0][i] & ~127u); i1[i] = 127u - (top[0][i] & 127u); s2[i] = ord2f(top[1][i] & ~127u); i2[i] = 127u - (top[1][i] & 127u); }
            unsigned ck[4][16];
#pragma unroll
            for (int c = 0; c < 64; ++c) {
                if (c < NCAND) { constexpr int CA[NCAND] = {0,0,0,0,0,0,0,0,0,0,0,0,0,0,0,0,1,1,1,1,1,1,1,1,2,2,2,2,2,3,3,3,3,4,4,4,5,5,6,6,7,7,8,9,10,11,12,13,14,15}; constexpr int CB[NCAND] = {0,1,2,3,4,5,6,7,8,9,10,11,12,13,14,15,0,1,2,3,4,5,6,7,0,1,2,3,4,0,1,2,3,0,1,2,0,1,0,1,0,1,0,0,0,0,0,0,0,0}; const int a = CA[c], b = CB[c];
                    ck[c >> 4][c & 15] = (f2ord(s1[a] + s2[b]) & ~63u) | (unsigned)(63 - c);
                    Elds[c * 64 + lane] = (unsigned short)(i1[a] * 128u + i2[b]); }
                else ck[c >> 4][c & 15] = 0u;
            }
            top16_of_64(ck[0], ck[1], ck[2], ck[3]);
            float w[16]; float wsum = 0.f; const float v0 = ord2f(ck[0][0] & ~63u);
#pragma unroll
            for (int r = 0; r < 16; ++r) { w[r] = __expf(ord2f(ck[0][r] & ~63u) - v0); wsum += w[r]; }
            const float winv = 1.0f / wsum;
#pragma unroll
            for (int r = 0; r < 16; ++r) if ((r >> 3) == hi) {
                const int c = 63 - (int)(ck[0][r] & 63u);
                const unsigned short eid = Elds[c * 64 + lane];
                PIDX[(size_t)tok * 128 + h * 16 + r] = eid; PG[(size_t)tok * 128 + h * 16 + r] = w[r] * winv; }
        }
    }
}

__device__ __forceinline__ float gelu_erf(float v) { return 0.5f * v * (1.0f + erff(v * 0.70710678118654752f)); }
__device__ __forceinline__ float dot8(const v4u& a, const v4u& b, float acc) {
    acc += bflo(a.x) * bflo(b.x); acc += bfhi(a.x) * bfhi(b.x); acc += bflo(a.y) * bflo(b.y); acc += bfhi(a.y) * bfhi(b.y);
    acc += bflo(a.z) * bflo(b.z); acc += bfhi(a.z) * bfhi(b.z); acc += bflo(a.w) * bflo(b.w); acc += bfhi(a.w) * bfhi(b.w); return acc;
}
__device__ __forceinline__ void axpy8(float (&acc)[8], float w, const v4u& u) {
    acc[0] += w * bflo(u.x); acc[1] += w * bfhi(u.x); acc[2] += w * bflo(u.y); acc[3] += w * bfhi(u.y);
    acc[4] += w * bflo(u.z); acc[5] += w * bfhi(u.z); acc[6] += w * bflo(u.w); acc[7] += w * bfhi(u.w);
}
__device__ __forceinline__ void p8b_gather(Frame& F) {
    const float* X1 = (const float*)(F.ws + WS_X1); const bf16* H2 = (const bf16*)(F.ws + WS_H2); const float* MOD = (const float*)(F.ws + WS_MOD);
    const bf16* ED = (const bf16*)(F.ws + WS_ED); const bf16* EU = (const bf16*)(F.ws + WS_EU);
    const unsigned short* PIDX = (const unsigned short*)(F.ws + WS_PIDX); const float* PG = (const float*)(F.ws + WS_PG);
    const float* fg = F.in[17];
    const int lane = F.lane;
    const int gw = F.vcu * NWAVES + F.wave, NGW = F.G * NWAVES;
    for (int tok = gw; tok < M; tok += NGW) {
        const int idx0 = PIDX[(size_t)tok * 128 + lane], idx1 = PIDX[(size_t)tok * 128 + 64 + lane];
        const float g0 = PG[(size_t)tok * 128 + lane], g1 = PG[(size_t)tok * 128 + 64 + lane];
        const v4u hq0 = *(const v4u*)(H2 + (size_t)tok * D + 8 * lane), hq1 = *(const v4u*)(H2 + (size_t)tok * D + 512 + 8 * lane);
        float acc0[8], acc1[8];
#pragma unroll
        for (int i = 0; i < 8; ++i) { acc0[i] = 0.f; acc1[i] = 0.f; }
        for (int jb = 0; jb < 16; ++jb) {
            const int idxv = (jb < 8) ? idx0 : idx1; const float gv = (jb < 8) ? g0 : g1;
            v4u d0[8], d1[8], u0[8], u1[8];
#pragma unroll
            for (int u = 0; u < 8; ++u) { const int e = __builtin_amdgcn_readlane(idxv, (jb & 7) * 8 + u);
                const bf16* dp = ED + (size_t)e * D + 8 * lane; const bf16* up = EU + (size_t)e * D + 8 * lane;
                d0[u] = *(const v4u*)dp; d1[u] = *(const v4u*)(dp + 512); u0[u] = *(const v4u*)up; u1[u] = *(const v4u*)(up + 512); }
            float dd[8];
#pragma unroll
            for (int u = 0; u < 8; ++u) dd[u] = dot8(hq1, d1[u], dot8(hq0, d0[u], 0.f));
            const bool b5 = (lane & 32) != 0, b4 = (lane & 16) != 0, b3 = (lane & 8) != 0;
            float r4[4];
#pragma unroll
            for (int u = 0; u < 4; ++u) { const float keep = b5 ? dd[u + 4] : dd[u], send = b5 ? dd[u] : dd[u + 4]; r4[u] = keep + __shfl_xor(send, 32); }
            float r2[2];
#pragma unroll
            for (int u = 0; u < 2; ++u) { const float keep = b4 ? r4[u + 2] : r4[u], send = b4 ? r4[u] : r4[u + 2]; r2[u] = keep + __shfl_xor(send, 16); }
            float r1; { const float keep = b3 ? r2[1] : r2[0], send = b3 ? r2[0] : r2[1]; r1 = keep + __shfl_xor(send, 8); }
            r1 += __shfl_xor(r1, 4); r1 += __shfl_xor(r1, 2); r1 += __shfl_xor(r1, 1);
            const float gsel = __shfl(gv, (jb & 7) * 8 + (lane >> 3));
            const float wv = gsel * gelu_erf(r1);
#pragma unroll
            for (int u = 0; u < 8; ++u) { const float w = __uint_as_float(__builtin_amdgcn_readlane(__float_as_uint(wv), 8 * u)); axpy8(acc0, w, u0[u]); axpy8(acc1, w, u1[u]); }
        }
        const int b = tok >> 12; const float* gt2 = MOD + b * NMOD + 5120;
        float x2[16]; float ss = 0.f;
#pragma unroll
        for (int hlf = 0; hlf < 2; ++hlf) { const int col = 512 * hlf + 8 * lane;
#pragma unroll
            for (int q = 0; q < 2; ++q) { const f32x4 xv = *(const f32x4*)(X1 + (size_t)tok * D + col + 4 * q), gv4 = *(const f32x4*)(gt2 + col + 4 * q);
#pragma unroll
                for (int i = 0; i < 4; ++i) { const float a = hlf ? acc1[4 * q + i] : acc0[4 * q + i]; const float v = xv[i] + gv4[i] * a; x2[hlf * 8 + q * 4 + i] = v; ss += v * v; } } }
        ss = wave_sum(ss);
        const float rstd = 1.0f / sqrtf(ss * (1.0f / D) + EPS);
#pragma unroll
        for (int hlf = 0; hlf < 2; ++hlf) { const int col = 512 * hlf + 8 * lane;
#pragma unroll
            for (int q = 0; q < 2; ++q) { const f32x4 gg = *(const f32x4*)(fg + col + 4 * q); f32x4 o;
#pragma unroll
                for (int i = 0; i < 4; ++i) o[i] = x2[hlf * 8 + q * 4 + i] * rstd * gg[i];
                *(f32x4*)(F.out + (size_t)tok * D + col + 4 * q) = o; } }
    }
}

struct Args { const float* in[18]; float* out; unsigned char* ws; };
__global__ void __launch_bounds__(NTHR, 2) mega_fwd(Args args) {
    extern __shared__ __attribute__((aligned(16))) unsigned char lds[];
    Frame F;
    F.lds = (LAS unsigned char*)lds;
    F.tid = threadIdx.x; F.lane = F.tid & 63; F.wave = __builtin_amdgcn_readfirstlane(F.tid >> 6);
    F.G = gridDim.x; { const int bx = blockIdx.x; F.vcu = (F.G % 8 == 0) ? (bx % 8) * (F.G / 8) + bx / 8 : bx; }
#pragma unroll
    for (int i = 0; i < 18; ++i) F.in[i] = args.in[i];
    F.out = args.out; F.ws = args.ws;
    volatile LAS unsigned* MISC = (volatile LAS unsigned*)(F.lds + MISC_OFF);
    for (int u = F.tid; u < (LDS_BYTES - LDSCTL_OFF) / 4; u += NTHR) ((LAS unsigned*)(F.lds + LDSCTL_OFF))[u] = 0u;
    __syncthreads();
    gu32* ctl = (gu32*)(F.ws + WS_CTL);
    XcdBarrier bar = xcd_barrier_post((unsigned*)(ctl + CW_BAR), MISC + 8);
#define GRID_BAR() xcd_barrier(bar)
#define PROBE_DBL -1

    p0_prologue(F); GRID_BAR();
    if (PROBE_DBL == 0) { p0_prologue(F); GRID_BAR(); }
    p1_norm(F); GRID_BAR();
    if (PROBE_DBL == 1) { p1_norm(F); GRID_BAR(); }
    {
        pg8::Gemm g{(const pg8::bf16_t*)(F.ws + WS_H), (const pg8::bf16_t*)(F.ws + WS_WIN), M, NPROJ, D, nullptr, nullptr};
        pg8::StaticOrder S; S.init(M, NPROJ, F.G, (int)blockIdx.x);
        pg8::EpiBf16<0> E{(pg8::bf16_t*)(F.ws + WS_PROJ), NPROJ, nullptr, 0, 0, 1.f};
        pg8::gemm_phase<pg8::EpiBf16<0>, pg8::StaticOrder, true, true>(F.lds + RING_OFF, g, S, E);
    }
    GRID_BAR();
    p3_attention(F); GRID_BAR();
    if (PROBE_DBL == 3) { p3_attention(F); GRID_BAR(); }
    {
        pg8::Gemm g{(const pg8::bf16_t*)(F.ws + WS_OA), (const pg8::bf16_t*)(F.ws + WS_WA), M, D, 512, (const pg8::bf16_t*)(F.ws + WS_OB), (const pg8::bf16_t*)(F.ws + WS_WB)};
        PairOrder S; S.S.init(M, D, F.G, (int)blockIdx.x);
        EpiGate E{(const bf16*)(F.ws + WS_PROJ), (bf16*)F.out, (bf16*)F.out + (size_t)M * D};
        pg8::gemm_phase<EpiGate, PairOrder, false, true>(F.lds + RING_OFF, g, S, E);
    }
    GRID_BAR();
    {
        pg8::Gemm g{(const pg8::bf16_t*)((bf16*)F.out + (size_t)M * D), (const pg8::bf16_t*)(F.ws + WS_WOUT), M, D, D, nullptr, nullptr};
        pg8::StaticOrder S; S.init(M, D, F.G, (int)blockIdx.x);
        EpiRes E{F.in[0], (const float*)(F.ws + WS_MOD), (float*)(F.ws + WS_X1)};
        pg8::gemm_phase<EpiRes, pg8::StaticOrder, false, true>(F.lds + RING_OFF, g, S, E);
    }
    GRID_BAR();
    p6_norm2(F); GRID_BAR();
    if (PROBE_DBL == 6) { p6_norm2(F); GRID_BAR(); }
    {
        pg8::Gemm g{(const pg8::bf16_t*)(F.ws + WS_H2), (const pg8::bf16_t*)(F.ws + WS_WQ), M, D, D, nullptr, nullptr};
        pg8::StaticOrder S; S.init(M, D, F.G, (int)blockIdx.x);
        pg8::EpiBf16<0> E{(pg8::bf16_t*)(F.ws + WS_QP), D, nullptr, 0, 0, 1.f};
        pg8::gemm_phase<pg8::EpiBf16<0>, pg8::StaticOrder, false, true>(F.lds + RING_OFF, g, S, E);
    }
    GRID_BAR();
    p8a_topk(F); GRID_BAR();
    if (PROBE_DBL == 8) { p8a_topk(F); GRID_BAR(); }
    p8b_gather(F);
    if (PROBE_DBL == 9) { GRID_BAR(); p8b_gather(F); }
}

extern "C" void kernel_launch(void* const* d_in, const int* in_sizes, int n_in, void* d_out, int out_size, void* d_ws, size_t ws_size, hipStream_t stream) {
    static int grid = 0;
    if (grid == 0) {
        if (n_in != 18 || in_sizes[0] != M * D || out_size != M * D || ws_size < WS_END) { fprintf(stderr, "kernel_launch: unexpected shapes (n_in %d, in0 %d, out %d, ws %zu)\n", n_in, n_in > 0 ? in_sizes[0] : -1, out_size, ws_size); grid = -1; return; }
        int dev = 0, cus = 0, per_cu = 0;
        if (hipGetDevice(&dev) != hipSuccess || hipDeviceGetAttribute(&cus, hipDeviceAttributeMultiprocessorCount, dev) != hipSuccess) { grid = -1; return; }
        if (hipFuncSetAttribute((const void*)mega_fwd, hipFuncAttributeMaxDynamicSharedMemorySize, LDS_BYTES) != hipSuccess) { fprintf(stderr, "kernel_launch: hipFuncSetAttribute failed\n"); grid = -1; return; }
        if (hipOccupancyMaxActiveBlocksPerMultiprocessor(&per_cu, (const void*)mega_fwd, NTHR, LDS_BYTES) != hipSuccess || per_cu < 1) { fprintf(stderr, "kernel_launch: occupancy query says %d blocks per CU\n", per_cu); }
        (void)hipGetLastError();
        grid = cus;
    }
    if (grid < 0) return;
    if (hipMemsetAsync((char*)d_ws + WS_CTL, 0, CTL_ZERO_BYTES, stream) != hipSuccess) { fprintf(stderr, "kernel_launch: memset failed\n"); return; }
    Args a{};
    for (int i = 0; i < 18; ++i) a.in[i] = (const float*)d_in[i];
    a.out = (float*)d_out; a.ws = (unsigned char*)d_ws;
    hipLaunchKernelGGL(mega_fwd, dim3(grid), dim3(NTHR), LDS_BYTES, stream, a);
}
```

```cpp
#include <hip/hip_runtime.h>
#include <cstdio>
#include <cstdint>
namespace pg8 {
#define PG8_LAS __attribute__((address_space(3)))
typedef unsigned short bf16_t;
typedef short bf16x8 __attribute__((ext_vector_type(8)));
typedef float f32x4 __attribute__((ext_vector_type(4)));
typedef unsigned u32x4 __attribute__((ext_vector_type(4)));
constexpr int BM = 256, BK = 64, HALF = 128, HTB = HALF * BK * 2  , STAGE_BYTES = 8 * HTB, NXCD = 8, WGM = 8;

__host__ __device__ __forceinline__ int lds_byte(int r, int c) { const int st = (r >> 4) * 2 + (c >> 5), rr = r & 15, cc = c & 31, ob = rr * 64 + cc * 2; return st * 1024 + (ob ^ (((ob >> 9) & 1) << 5)); }
__host__ __device__ __forceinline__ void stage_rc(int b, int& R, int& C) { const int st = b / 1024, sb = b % 1024, swz = sb ^ (((sb >> 9) & 1) << 5); R = (st >> 1) * 16 + swz / 64; C = (st & 1) * 32 + (swz % 64) / 2; }
__host__ __device__ __forceinline__ int perm32(int rho) { const int n = rho >> 4, i = rho & 15; return 8 * (i >> 2) + 4 * n + (i & 3); }

struct Unit { int pm, pn, src; };
struct Gemm { const bf16_t* A; const bf16_t* Bt; int M, N, K; const bf16_t* A2; const bf16_t* Bt2; };

struct StaticOrder {
    int nM, nN, nwg, G, c;
    __host__ __device__ void init(int M, int N, int G_, int c_) { nM = M / BM; nN = N / BM; nwg = nM * nN; G = G_; c = c_; }
    __host__ __device__ bool next(int i, Unit& u) const {
        const long L = (long)i * G + c; if (L >= nwg) return false;
        int wgid = (int)L; { const int q = nwg / NXCD, r = nwg % NXCD, xcd = wgid % NXCD, off = wgid / NXCD; wgid = (xcd < r ? xcd * (q + 1) : r * (q + 1) + (xcd - r) * q) + off; }
        const int nig = WGM * nN, gid = wgid / nig, fm = gid * WGM, gsz = (nM - fm) < WGM ? (nM - fm) : WGM;
        u.pm = fm + ((wgid % nig) % gsz); u.pn = (wgid % nig) / gsz; u.src = 0; return true;
    }
    __device__ __forceinline__ void a_ready(const Unit&) const {}
    __device__ __forceinline__ void done(const Unit&) const {}
};

__device__ __forceinline__ unsigned cvt_pk_bf16(float lo, float hi) { unsigned r; asm volatile("v_cvt_pk_bf16_f32 %0, %1, %2" : "=v"(r) : "v"(lo), "v"(hi)); return r; }
typedef float f32x2 __attribute__((ext_vector_type(2)));
__device__ __forceinline__ f32x2 gelu_pk(f32x2 v) {
    const f32x2 av = __builtin_elementwise_abs(v), d = av * 0.2316418882f + 1.0f;
    f32x2 t; t.x = __builtin_amdgcn_rcpf(d.x); t.y = __builtin_amdgcn_rcpf(d.y);
    f32x2 q = t * 0.5307027145f + (-0.7265760135f); q = q * t + 0.7107068705f; q = q * t + (-0.142248368f); q = q * t + 0.127414796f; q = q * t;
    const f32x2 s = (v * v) * (-0.72134752044f);
    f32x2 e; e.x = __builtin_amdgcn_exp2f(s.x); e.y = __builtin_amdgcn_exp2f(s.y);
    const f32x2 m = v * (q * e), r = v - m;
    f32x2 o; o.x = v.x < 0.f ? m.x : r.x; o.y = v.y < 0.f ? m.y : r.y; return o;
}

template <int ACT  > struct EpiBf16 {
    static constexpr bool PERM = true, AFTER_DRAIN = false; static_assert(ACT == 0 || ACT == 1, "EpiBf16: ACT is 0 (none) or 1 (gelu_pk)");
    bf16_t* O; int ldc; const float* bias; int split_cols; size_t split_stride; float scale0;
    __device__ __forceinline__ void operator()(const f32x4 (&acc)[2][2][4][2], const Unit& u, int wr, int wc, int fr, int fq) const {
        const int row0 = u.pm * BM + wr * 64 + fr; int colt = u.pn * BM; bf16_t* base = O;
        float sc = 1.f; if (split_cols) { const int t = colt / split_cols; base += (size_t)t * split_stride; colt -= t * split_cols; if (t == 0) sc = scale0; }
        const int col0 = colt + wc * 32 + 8 * fq, bcol0 = u.pn * BM + wc * 32 + 8 * fq;
        f32x4 bv[2][2];
#pragma unroll
        for (int bj = 0; bj < 2; ++bj)
#pragma unroll
            for (int n = 0; n < 2; ++n) bv[bj][n] = bias ? *(const f32x4*)(bias + bcol0 + bj * HALF + 4 * n) : (f32x4){0.f, 0.f, 0.f, 0.f};
#pragma unroll
        for (int ai = 0; ai < 2; ++ai)
#pragma unroll
            for (int m = 0; m < 4; ++m) { bf16_t* rowp = base + (size_t)(row0 + ai * HALF + m * 16) * ldc + col0;
#pragma unroll
                for (int bj = 0; bj < 2; ++bj) { f32x4 v0 = acc[ai][bj][m][0] + bv[bj][0], v1 = acc[ai][bj][m][1] + bv[bj][1];
                    if (ACT == 1) { f32x2 a = gelu_pk((f32x2){v0[0], v0[1]}), b = gelu_pk((f32x2){v0[2], v0[3]}), c = gelu_pk((f32x2){v1[0], v1[1]}), d = gelu_pk((f32x2){v1[2], v1[3]});
                        v0 = (f32x4){a.x, a.y, b.x, b.y}; v1 = (f32x4){c.x, c.y, d.x, d.y}; }
                    v0 = v0 * sc; v1 = v1 * sc; u32x4 w; w.x = cvt_pk_bf16(v0[0], v0[1]); w.y = cvt_pk_bf16(v0[2], v0[3]); w.z = cvt_pk_bf16(v1[0], v1[1]); w.w = cvt_pk_bf16(v1[2], v1[3]);
                    *(u32x4*)(rowp + bj * HALF) = w; } }
    }
};

template <class Epi, class Sched, bool ALIGN_EPI = false, bool SP2 = false>
__device__ __forceinline__ void gemm_phase(PG8_LAS unsigned char* lds, const Gemm g, const Sched& S, const Epi& E) {
    const int tid = threadIdx.x, wid = __builtin_amdgcn_readfirstlane(tid >> 6), lane = tid & 63, wr = wid >> 2, wc = wid & 3, fr = lane & 15, fq = lane >> 4;
    const int K = g.K, nt = K / BK;
    unsigned voffA[2], voffB[2];
#pragma unroll
    for (int i = 0; i < 2; ++i) { int R, C; stage_rc(tid * 16 + i * 8192, R, C); const int Rb = Epi::PERM ? ((R & ~31) + perm32(R & 31)) : R;
        voffA[i] = (unsigned)(R * K + C) * 2u; voffB[i] = (unsigned)(Rb * K + C) * 2u; }
    const size_t kstep = (size_t)(BK * 2);
    const size_t hstep = (size_t)HALF * K * 2;
    const size_t tstep = 2 * hstep;
    const unsigned ldsw = (unsigned)wid * 1024u;
    const int aoff = lds_byte(wr * 64 + fr, fq * 8), boff = lds_byte(wc * 32 + fr, fq * 8);
#define PG8_SA(b, h) (((b) * 2 + (h)) * HTB)
#define PG8_SB(b, h) ((4 + (b) * 2 + (h)) * HTB)
#define PG8_STAGE(bufoff, gbase, voff) do { _Pragma("unroll") for (int _i = 0; _i < 2; ++_i) \
        __builtin_amdgcn_global_load_lds((const unsigned*)((const char*)(gbase) + (voff)[_i]), (PG8_LAS unsigned*)(lds + (bufoff) + ldsw + _i * 8192), 16, 0, 0); } while (0)
#define PG8_LDA(dst, b, h) do { _Pragma("unroll") for (int m = 0; m < 4; ++m) _Pragma("unroll") for (int k = 0; k < 2; ++k) dst[m][k] = *(const PG8_LAS bf16x8*)(lds + PG8_SA(b, h) + aoff + m * 2048 + k * 1024); } while (0)
#define PG8_LDB(dst, b, h) do { _Pragma("unroll") for (int n = 0; n < 2; ++n) _Pragma("unroll") for (int k = 0; k < 2; ++k) dst[n][k] = *(const PG8_LAS bf16x8*)(lds + PG8_SB(b, h) + boff + n * 2048 + k * 1024); } while (0)
#define PG8_MMA(ai, bj, At, Bt) do { __builtin_amdgcn_s_setprio(1); _Pragma("unroll") for (int m = 0; m < 4; ++m) _Pragma("unroll") for (int n = 0; n < 2; ++n) _Pragma("unroll") for (int k = 0; k < 2; ++k) \
        acc[ai][bj][m][n] = __builtin_amdgcn_mfma_f32_16x16x32_bf16(Bt[n][k], At[m][k], acc[ai][bj][m][n], 0, 0, 0); __builtin_amdgcn_s_setprio(0); } while (0)
#define PG8_WAIT_V(n) asm volatile("s_waitcnt vmcnt(" #n ")" ::: "memory")
#define PG8_WAIT_L(n) asm volatile("s_waitcnt lgkmcnt(" #n ")" ::: "memory")
#define PG8_BAR __builtin_amdgcn_s_barrier()
#define PG8_SCHED __builtin_amdgcn_sched_barrier(0)
    Unit cur, nxt; int ui = 0;
    if (!S.next(0, cur)) return;
    f32x4 acc[2][2][4][2];
#pragma unroll
    for (int a = 0; a < 2; ++a)
#pragma unroll
        for (int b = 0; b < 2; ++b)
#pragma unroll
            for (int m = 0; m < 4; ++m)
#pragma unroll
                for (int n = 0; n < 2; ++n) acc[a][b][m][n] = (f32x4){0.f, 0.f, 0.f, 0.f};
    bf16x8 At[4][2], B0[2][2], B1[2][2];
    const char* cA = (const char*)(cur.src ? g.A2 : g.A) + (size_t)cur.pm * tstep; const char* cB = (const char*)(cur.src ? g.Bt2 : g.Bt) + (size_t)cur.pn * tstep;
    S.a_ready(cur);
    if constexpr (SP2) {
        PG8_STAGE(PG8_SB(0, 0), cB, voffB); PG8_STAGE(PG8_SB(0, 1), cB + hstep, voffB); PG8_STAGE(PG8_SA(0, 0), cA, voffA); PG8_STAGE(PG8_SA(0, 1), cA + hstep, voffA);
        if (wr == 1) PG8_BAR;
        PG8_WAIT_V(2); PG8_BAR;
        PG8_STAGE(PG8_SB(1, 0), cB + kstep, voffB); PG8_STAGE(PG8_SA(1, 0), cA + kstep, voffA); PG8_STAGE(PG8_SB(1, 1), cB + hstep + kstep, voffB);
        PG8_WAIT_V(6); PG8_BAR;
    } else {
        PG8_STAGE(PG8_SB(0, 0), cB, voffB); PG8_STAGE(PG8_SA(0, 0), cA, voffA); PG8_STAGE(PG8_SB(0, 1), cB + hstep, voffB); PG8_STAGE(PG8_SA(0, 1), cA + hstep, voffA);
        if (wr == 1) PG8_BAR;
        PG8_WAIT_V(4); PG8_BAR;
        PG8_STAGE(PG8_SB(1, 0), cB + kstep, voffB); PG8_STAGE(PG8_SA(1, 0), cA + kstep, voffA); PG8_STAGE(PG8_SB(1, 1), cB + hstep + kstep, voffB);
        PG8_WAIT_V(6); PG8_BAR;
    }
    for (;;) {
        const bool has_next = S.next(ui + 1, nxt);
        const char* nA = has_next ? (const char*)(nxt.src ? g.A2 : g.A) + (size_t)nxt.pm * tstep : cA; const char* nB = has_next ? (const char*)(nxt.src ? g.Bt2 : g.Bt) + (size_t)nxt.pn * tstep : cB;
        for (int t = 0; t < nt; t += 2) {
            const bool last = (t == nt - 2);
            const char* a1 = cA + (size_t)(t + 1) * kstep;
            const char* a2 = last ? nA : cA + (size_t)(t + 2) * kstep; const char* b2 = last ? nB : cB + (size_t)(t + 2) * kstep;
            const char* a3 = a2 + kstep; const char* b3 = b2 + kstep;
            if (last && has_next) S.a_ready(nxt);
            if constexpr (SP2) {
            PG8_LDB(B0, 0, 0); PG8_LDB(B1, 0, 1); PG8_SCHED; PG8_LDA(At, 0, 0); PG8_STAGE(PG8_SA(1, 1), a1 + hstep, voffA);
            PG8_WAIT_V(8); PG8_WAIT_L(0); PG8_BAR; PG8_MMA(0, 0, At, B0); PG8_MMA(0, 1, At, B1); PG8_BAR; PG8_SCHED;
            PG8_LDA(At, 0, 1); PG8_STAGE(PG8_SB(0, 0), b2, voffB); PG8_STAGE(PG8_SB(0, 1), b2 + hstep, voffB); PG8_STAGE(PG8_SA(0, 0), a2, voffA);
            PG8_WAIT_V(8); PG8_WAIT_L(0); PG8_BAR; PG8_MMA(1, 0, At, B0); PG8_MMA(1, 1, At, B1); PG8_BAR; PG8_SCHED;
            PG8_LDB(B0, 1, 0); PG8_LDB(B1, 1, 1); PG8_SCHED; PG8_LDA(At, 1, 0); PG8_STAGE(PG8_SA(0, 1), a2 + hstep, voffA);
            PG8_WAIT_V(8); PG8_WAIT_L(0); PG8_BAR; PG8_MMA(0, 0, At, B0); PG8_MMA(0, 1, At, B1); PG8_BAR; PG8_SCHED;
            PG8_LDA(At, 1, 1); PG8_STAGE(PG8_SB(1, 0), b3, voffB); PG8_STAGE(PG8_SB(1, 1), b3 + hstep, voffB); PG8_STAGE(PG8_SA(1, 0), a3, voffA);
            PG8_WAIT_V(8); PG8_WAIT_L(0); PG8_BAR; PG8_MMA(1, 0, At, B0); PG8_MMA(1, 1, At, B1); PG8_BAR; PG8_SCHED;
            } else {
            PG8_LDB(B0, 0, 0); PG8_SCHED; PG8_LDA(At, 0, 0); PG8_STAGE(PG8_SA(1, 1), a1 + hstep, voffA);
            PG8_WAIT_L(8); PG8_BAR; PG8_WAIT_L(0); PG8_MMA(0, 0, At, B0); PG8_BAR; PG8_SCHED;
            PG8_LDB(B1, 0, 1); PG8_STAGE(PG8_SB(0, 0), b2, voffB);
            PG8_BAR; PG8_WAIT_L(0); PG8_MMA(0, 1, At, B1); PG8_BAR;
            PG8_LDA(At, 0, 1); PG8_STAGE(PG8_SA(0, 0), a2, voffA);
            PG8_BAR; PG8_WAIT_L(0); PG8_MMA(1, 0, At, B0); PG8_BAR; PG8_SCHED;
            PG8_STAGE(PG8_SB(0, 1), b2 + hstep, voffB);
            PG8_WAIT_V(6); PG8_BAR; PG8_MMA(1, 1, At, B1); PG8_BAR;
            PG8_LDB(B0, 1, 0); PG8_SCHED; PG8_LDA(At, 1, 0); PG8_STAGE(PG8_SA(0, 1), a2 + hstep, voffA);
            PG8_WAIT_L(8); PG8_BAR; PG8_WAIT_L(0); PG8_MMA(0, 0, At, B0); PG8_BAR; PG8_SCHED;
            PG8_LDB(B1, 1, 1); PG8_STAGE(PG8_SB(1, 0), b3, voffB);
            PG8_BAR; PG8_WAIT_L(0); PG8_MMA(0, 1, At, B1); PG8_BAR;
            PG8_LDA(At, 1, 1); PG8_STAGE(PG8_SA(1, 0), a3, voffA);
            PG8_BAR; PG8_WAIT_L(0); PG8_MMA(1, 0, At, B0); PG8_BAR; PG8_SCHED;
            PG8_STAGE(PG8_SB(1, 1), b3 + hstep, voffB);
            PG8_WAIT_V(6); PG8_BAR; PG8_MMA(1, 1, At, B1); PG8_BAR;
            }
        }
        if constexpr (ALIGN_EPI) { if (wr == 0) PG8_BAR; }
        if constexpr (!Epi::AFTER_DRAIN) { E(acc, cur, wr, wc, fr, fq); S.done(cur); }
        if (!has_next) break;
#pragma unroll
        for (int a = 0; a < 2; ++a)
#pragma unroll
            for (int b = 0; b < 2; ++b)
#pragma unroll
                for (int m = 0; m < 4; ++m)
#pragma unroll
                    for (int n = 0; n < 2; ++n) acc[a][b][m][n] = (f32x4){0.f, 0.f, 0.f, 0.f};
        cur = nxt; cA = nA; cB = nB; ++ui;
        if constexpr (ALIGN_EPI) { if (wr == 1) PG8_BAR; }
    }
    PG8_WAIT_V(0);
    if constexpr (!ALIGN_EPI) { if (wr == 0) PG8_BAR; }
    PG8_BAR;
    if constexpr (Epi::AFTER_DRAIN) { E.fused(acc, cur, wr, wc, fr, fq, lds, wid, lane); S.done(cur); }
#undef PG8_SA
#undef PG8_SB
#undef PG8_STAGE
#undef PG8_LDA
#undef PG8_LDB
#undef PG8_MMA
#undef PG8_WAIT_V
#undef PG8_WAIT_L
#undef PG8_BAR
#undef PG8_SCHED
}
}

#define GAS __attribute__((address_space(1)))
#define LAS __attribute__((address_space(3)))
typedef unsigned short bf16;
typedef unsigned v4u __attribute__((ext_vector_type(4)));
typedef float f32x4 __attribute__((ext_vector_type(4)));
typedef short bf16x8 __attribute__((ext_vector_type(8)));
typedef GAS unsigned gu32;
typedef GAS unsigned long long gu64;
#define RLX_AGENT __ATOMIC_RELAXED, __HIP_MEMORY_SCOPE_AGENT
#define LDS_WAIT() asm volatile("s_waitcnt lgkmcnt(0)" ::: "memory")
#define VM_WAIT() asm volatile("s_waitcnt vmcnt(0)" ::: "memory")
__device__ __forceinline__ unsigned long long rt() { return __builtin_amdgcn_s_memrealtime(); }
__device__ __forceinline__ unsigned f2bf(float f) { unsigned u = __builtin_bit_cast(unsigned, f); return (u + 0x7fffu + ((u >> 16) & 1u)) >> 16; }
__device__ __forceinline__ unsigned pk2(float lo, float hi) { return f2bf(lo) | (f2bf(hi) << 16); }

#define XB_TMO      128
#define XB_XCNT(j)  (256  + 64 * (j))
#define XB_XSUB(j)  (1280 + 64 * (j))
#define XB_XGEN(j)  (2304 + 64 * (j))
#define XB_TOP      3328
#define XB_TOPGEN   3392
#define XCD_BAR_WORDS 3456
#define XB_SPIN_CAP (1u << 18)

__device__ __forceinline__ unsigned xb_ld(unsigned* p)              { return __hip_atomic_load(p, __ATOMIC_RELAXED, __HIP_MEMORY_SCOPE_AGENT); }
__device__ __forceinline__ unsigned xb_add(unsigned* p, unsigned v) { return __hip_atomic_fetch_add(p, v, __ATOMIC_RELAXED, __HIP_MEMORY_SCOPE_AGENT); }
__device__ __forceinline__ unsigned xb_xcc_id() { return (unsigned)__builtin_amdgcn_s_getreg((3 << 11) | 20) & 0xFu; }
#define XB_SPIN(cond, bar) do { unsigned _sp = 0; while (cond) { __builtin_amdgcn_s_sleep(1); \
    if ((++_sp & 255u) == 0u) { if (xb_ld(&(bar)[XB_TMO])) break; if (_sp > XB_SPIN_CAP) { atomicAdd(&(bar)[XB_TMO], 1u); break; } } } } while (0)

struct XcdBarrier {
    unsigned* bar; unsigned x;
    volatile LAS unsigned* st;
};

__device__ __forceinline__ XcdBarrier xcd_barrier_post(unsigned* bar, volatile LAS unsigned* st) {
    XcdBarrier b; b.bar = bar; b.x = xb_xcc_id(); b.st = st;
    if (threadIdx.x == 0) (void)xb_add(&bar[XB_XCNT(b.x)], 1u);
    return b;
}
__device__ __forceinline__ void xcd_barrier_complete(unsigned* bar, unsigned x, unsigned& nloc, unsigned& nx) {
    const unsigned G = gridDim.x * gridDim.y * gridDim.z;
    unsigned sum, cnt, mine, sp = 0u;
    for (;;) {
        sum = 0u; cnt = 0u; mine = 0u;
#pragma unroll
        for (unsigned j = 0; j < 16; ++j) { const unsigned c = xb_ld(&bar[XB_XCNT(j)]); sum += c; cnt += (c > 0u) ? 1u : 0u; mine = (j == x) ? c : mine; }
        if (sum == G) break;
        __builtin_amdgcn_s_sleep(1);
        if ((++sp & 255u) == 0u) { if (xb_ld(&bar[XB_TMO])) break; if (sp > XB_SPIN_CAP) { atomicAdd(&bar[XB_TMO], 1u); break; } }
    }
    nloc = mine > 0u ? mine : 1u; nx = cnt > 0u ? cnt : 1u;
}

__device__ __forceinline__ void xcd_barrier(const XcdBarrier& b) {
    asm volatile("s_waitcnt vmcnt(0)" ::: "memory");
    __syncthreads();
    if (threadIdx.x == 0) {
        unsigned* bar = b.bar;
        __builtin_amdgcn_s_waitcnt(0);
        unsigned nloc = b.st[0], nx = b.st[1];
        if (nloc == 0u) { xcd_barrier_complete(bar, b.x, nloc, nx); b.st[0] = nloc; b.st[1] = nx; }
        const unsigned old = xb_add(&bar[XB_XSUB(b.x)], 1u);
        const unsigned gen = old / nloc;
        if (old + 1u == (gen + 1u) * nloc) {
            __builtin_amdgcn_fence(__ATOMIC_RELEASE, "agent");
            asm volatile("s_waitcnt vmcnt(0)" ::: "memory");
            const unsigned og = xb_add(&bar[XB_TOP], 1u);
            const unsigned tg = og / nx;
            if (og + 1u == (tg + 1u) * nx) xb_add(&bar[XB_TOPGEN], 1u);
            else XB_SPIN(xb_ld(&bar[XB_TOPGEN]) == tg, bar);
            __builtin_amdgcn_fence(__ATOMIC_ACQUIRE, "agent");
            xb_add(&bar[XB_XGEN(b.x)], 1u);
            asm volatile("s_waitcnt vmcnt(0)" ::: "memory");
        } else {
            XB_SPIN(xb_ld(&bar[XB_XGEN(b.x)]) == gen, bar);
            __builtin_amdgcn_fence(__ATOMIC_ACQUIRE, "agent");
            asm volatile("s_waitcnt vmcnt(0)" ::: "memory");
        }
    }
    __syncthreads();
}

constexpr int NWAVES = 8, NTHR = 512;
constexpr int BATCH = 4, SEQ = 4096, D = 1024, M = BATCH * SEQ;
constexpr int NPROJ = 4352, LDW_IN = 4360, NMOD = 6144;
constexpr int C_QA = 0, C_KA = 512, C_VA = 640, C_QB = 768, C_KB = 1280, C_VB = 1792, C_GLA = 2304, C_GLB = 3328;
constexpr int NEXP = 16384;
constexpr float EPS = 1e-6f;

constexpr size_t MiB = 1u << 20;
constexpr size_t WS_CTL = 0, CTL_ZERO_BYTES = 1 * MiB;
constexpr size_t WS_MOD = 1 * MiB, WS_LOGF = 1 * MiB + 128 * 1024, WS_SUBK = 2 * MiB;
constexpr size_t WS_WIN = 4 * MiB, WS_WA = 12 * MiB + 512 * 1024, WS_WB = 13 * MiB + 512 * 1024, WS_WOUT = 14 * MiB + 512 * 1024, WS_WQ = 16 * MiB + 512 * 1024;
constexpr size_t WS_ED = 19 * MiB, WS_EU = 51 * MiB;
constexpr size_t WS_H = 83 * MiB, WS_OA = 83 * MiB, WS_OB = 99 * MiB, WS_PIDX = 83 * MiB, WS_PG = 87 * MiB;
constexpr size_t WS_PROJ = 115 * MiB, WS_X1 = 115 * MiB, WS_H2 = 179 * MiB, WS_QP = 211 * MiB;
constexpr size_t WS_END = 251 * MiB;
static_assert(WS_WIN + (size_t)NPROJ * D * 2 <= WS_WA && WS_WQ + (size_t)D * D * 2 <= WS_ED && WS_PROJ + (size_t)M * NPROJ * 2 <= WS_END, "ws map");
constexpr int CW_BAR = 4096;

constexpr int RING_OFF = 0, RING_BYTES = 131072;
constexpr int LDSCTL_OFF = RING_BYTES, MISC_OFF = LDSCTL_OFF + 320;
constexpr int LDS_BYTES = 147456;

typedef float f32x16 __attribute__((ext_vector_type(16)));
typedef short s16x4 __attribute__((ext_vector_type(4)));
typedef unsigned u32x2 __attribute__((ext_vector_type(2)));
typedef float f32x2_t __attribute__((ext_vector_type(2)));
typedef __bf16 bf16x2_t __attribute__((ext_vector_type(2)));

__device__ __forceinline__ unsigned cvtpk(float lo, float hi) { f32x2_t v = {lo, hi}; bf16x2_t b = __builtin_convertvector(v, bf16x2_t); return __builtin_bit_cast(unsigned, b); }
__device__ __forceinline__ float bflo(unsigned u) { return __uint_as_float(u << 16); }
__device__ __forceinline__ float bfhi(unsigned u) { return __uint_as_float(u & 0xffff0000u); }
__device__ __forceinline__ float wave_sum(float v) {
#pragma unroll
    for (int o = 1; o < 64; o <<= 1) v += __shfl_xor(v, o);
    return v;
}
__device__ __forceinline__ int crow(int r, int hi) { return (r & 3) + 8 * (r >> 2) + 4 * hi; }
#define MFMA32(a, b, c) __builtin_amdgcn_mfma_f32_32x32x16_bf16((a), (b), (c), 0, 0, 0)

struct Frame {
    LAS unsigned char* lds;
    int tid, lane, wave, vcu, G;
    const float* in[18]; float* out; unsigned char* ws;
};

__device__ __forceinline__ void p0_transpose_item(const float* W, int ld, int K, int ncols, bf16* WT, int row_off, LAS float* scr, int item, int lane) {
    const int nblk = ncols / 32, kb = item / nblk, nb = item % nblk, k0 = 64 * kb, n0 = 32 * nb;
#pragma unroll 8
    for (int i = 0; i < 32; ++i) { const int kk = 2 * i + (lane >> 5); scr[kk * 33 + (lane & 31)] = W[(size_t)(k0 + kk) * ld + n0 + (lane & 31)]; }
    LDS_WAIT(); asm volatile("" ::: "memory");
    const int c = lane & 7;
#pragma unroll
    for (int j = 0; j < 4; ++j) { const int n = (lane >> 3) + 8 * j; const LAS float* s = scr + (8 * c) * 33 + n;
        v4u o; o.x = pk2(s[0 * 33], s[1 * 33]); o.y = pk2(s[2 * 33], s[3 * 33]); o.z = pk2(s[4 * 33], s[5 * 33]); o.w = pk2(s[6 * 33], s[7 * 33]);
        *(GAS v4u*)(WT + (size_t)(row_off + n0 + n) * K + k0 + 8 * c) = o; }
    LDS_WAIT(); asm volatile("" ::: "memory");
}
__device__ __forceinline__ void p0_convert(const float* __restrict__ src, bf16* __restrict__ dst, long n_iters, int gw, int NGW, int lane) {
    for (long it0 = (long)gw * 4; it0 < n_iters; it0 += (long)NGW * 4) {
        f32x4 a[4][2];
#pragma unroll
        for (int u = 0; u < 4; ++u) { const long it = it0 + u; if (it < n_iters) { const float* p = src + it * 512 + lane * 4; a[u][0] = *(const f32x4*)p; a[u][1] = *(const f32x4*)(p + 256); } }
#pragma unroll
        for (int u = 0; u < 4; ++u) { const long it = it0 + u; if (it < n_iters) { bf16* q = dst + it * 512 + lane * 4;
            u32x2 w0, w1; w0.x = cvtpk(a[u][0].x, a[u][0].y); w0.y = cvtpk(a[u][0].z, a[u][0].w); w1.x = cvtpk(a[u][1].x, a[u][1].y); w1.y = cvtpk(a[u][1].z, a[u][1].w);
            *(u32x2*)q = w0; *(u32x2*)(q + 256) = w1; } }
    }
}
__device__ __forceinline__ void p0_prologue(Frame& F) {
    const float* c = F.in[1]; const float* w_ada = F.in[4]; const float* b_ada = F.in[5];
    float* MOD = (float*)(F.ws + WS_MOD);
    {
        LAS float* cact = (LAS float*)(F.lds);
        LAS float* part = (LAS float*)(F.lds + 16384);
        bool did = false;
        for (int item = F.vcu; item < NMOD / 32; item += F.G) {
            if (!did) { for (int i = F.tid; i < 4096; i += NTHR) { const float cv = c[i]; cact[i] = cv / (1.0f + __expf(-cv)); } did = true; }
            __syncthreads();
            const int n0 = item * 32, col = n0 + (F.lane & 31), ksub = F.lane >> 5;
            float a0 = 0.f, a1 = 0.f, a2 = 0.f, a3 = 0.f;
#pragma unroll 16
            for (int it = 0; it < 64; ++it) { const int k = (it * 8 + F.wave) * 2 + ksub; const float w = w_ada[(size_t)k * NMOD + col];
                a0 += cact[k] * w; a1 += cact[1024 + k] * w; a2 += cact[2048 + k] * w; a3 += cact[3072 + k] * w; }
            a0 += __shfl_xor(a0, 32); a1 += __shfl_xor(a1, 32); a2 += __shfl_xor(a2, 32); a3 += __shfl_xor(a3, 32);
            if (F.lane < 32) { part[(F.wave * 4 + 0) * 32 + F.lane] = a0; part[(F.wave * 4 + 1) * 32 + F.lane] = a1; part[(F.wave * 4 + 2) * 32 + F.lane] = a2; part[(F.wave * 4 + 3) * 32 + F.lane] = a3; }
            __syncthreads();
            if (F.tid < 128) { const int b = F.tid >> 5, cl = F.tid & 31; float s = 0.f;
#pragma unroll
                for (int w = 0; w < 8; ++w) s += part[(w * 4 + b) * 32 + cl];
                MOD[b * NMOD + n0 + cl] = s + b_ada[n0 + cl]; }
            __syncthreads();
        }
    }
    LAS float* scr = (LAS float*)(F.lds + RING_OFF + F.wave * 16384);
    const int gw = F.vcu * NWAVES + F.wave, NGW = F.G * NWAVES;
    constexpr int I_IN1 = (D / 64) * (2304 / 32), I_IN2 = (D / 64) * (2048 / 32), I_AB = (512 / 64) * (D / 32), I_SQ = (D / 64) * (D / 32);
    constexpr int NITEMS = I_IN1 + I_IN2 + 2 * I_AB + 2 * I_SQ;
    bf16* Win_t = (bf16*)(F.ws + WS_WIN);
    for (int it = gw; it < NITEMS; it += NGW) {
        int r = it;
        if (r < I_IN1) { p0_transpose_item(F.in[6], LDW_IN, D, 2304, Win_t, 0, scr, r, F.lane); continue; } r -= I_IN1;
        if (r < I_IN2) { p0_transpose_item(F.in[6] + 2312, LDW_IN, D, 2048, Win_t, 2304, scr, r, F.lane); continue; } r -= I_IN2;
        if (r < I_AB) { p0_transpose_item(F.in[9], D, 512, D, (bf16*)(F.ws + WS_WA), 0, scr, r, F.lane); continue; } r -= I_AB;
        if (r < I_AB) { p0_transpose_item(F.in[10], D, 512, D, (bf16*)(F.ws + WS_WB), 0, scr, r, F.lane); continue; } r -= I_AB;
        if (r < I_SQ) { p0_transpose_item(F.in[11], D, D, D, (bf16*)(F.ws + WS_WOUT), 0, scr, r, F.lane); continue; } r -= I_SQ;
        p0_transpose_item(F.in[13], D, D, D, (bf16*)(F.ws + WS_WQ), 0, scr, r, F.lane);
    }
    p0_convert(F.in[15], (bf16*)(F.ws + WS_ED), (long)NEXP * D / 512, gw, NGW, F.lane);
    p0_convert(F.in[16], (bf16*)(F.ws + WS_EU), (long)NEXP * D / 512, gw, NGW, F.lane);
    p0_convert(F.in[14], (bf16*)(F.ws + WS_SUBK), (long)(8 * 2 * 128 * 64) / 512, gw, NGW, F.lane);
}

__device__ __forceinline__ void p1_norm(Frame& F) {
    const float* x = F.in[0]; const float* g1 = F.in[2]; const float* w_in = F.in[6]; const float* b_forget = F.in[7];
    const float* MOD = (const float*)(F.ws + WS_MOD); bf16* H = (bf16*)(F.ws + WS_H); float* LOGF = (float*)(F.ws + WS_LOGF);
    LAS float* wfl = (LAS float*)(F.lds);
    for (int i = F.tid; i < 8192; i += NTHR) { const int k = i >> 3, j = i & 7; wfl[j * 1024 + k] = w_in[(size_t)k * LDW_IN + 2304 + j]; }
    __syncthreads();
    const int gw = F.vcu * NWAVES + F.wave, NGW = F.G * NWAVES;
    for (int row = gw; row < M; row += NGW) {
        const f32x4* xr = (const f32x4*)(x + (size_t)row * D) + F.lane;
        f32x4 v[4]; float ss = 0.f;
#pragma unroll
        for (int j = 0; j < 4; ++j) { v[j] = xr[64 * j]; ss += (v[j].x * v[j].x + v[j].y * v[j].y) + (v[j].z * v[j].z + v[j].w * v[j].w); }
        ss = wave_sum(ss);
        const float rstd = 1.0f / sqrtf(ss * (1.0f / D) + EPS);
        const int b = row >> 12; const float* mb = MOD + b * NMOD;
        float fl[8];
#pragma unroll
        for (int jj = 0; jj < 8; ++jj) fl[jj] = 0.f;
#pragma unroll
        for (int j = 0; j < 4; ++j) { const int col = 4 * F.lane + 256 * j;
            const f32x4 g = *(const f32x4*)(g1 + col), sh = *(const f32x4*)(mb + col), sc = *(const f32x4*)(mb + 1024 + col);
            const f32x4 hv = (v[j] * rstd) * g * (sc + 1.0f) + sh;
            u32x2 w; w.x = cvtpk(hv.x, hv.y); w.y = cvtpk(hv.z, hv.w);
            *(u32x2*)(H + (size_t)row * D + col) = w;
#pragma unroll
            for (int jj = 0; jj < 8; ++jj) { const f32x4 wv = *(const LAS f32x4*)(wfl + jj * 1024 + col); fl[jj] += (hv.x * wv.x + hv.y * wv.y) + (hv.z * wv.z + hv.w * wv.w); }
        }
        float mine = 0.f;
#pragma unroll
        for (int jj = 0; jj < 8; ++jj) { const float s = wave_sum(fl[jj]); if (F.lane == jj) mine = s; }
        if (F.lane < 8) { const float z = mine + b_forget[F.lane]; const float ls = fminf(z, 0.f) - log1pf(__expf(-fabsf(z))); LOGF[(size_t)row * 8 + F.lane] = ls; }
    }
}

constexpr int KP = 72;
constexpr int VPF = 68;
constexpr int VPS = 260;
struct FlashState { f32x16 o[2]; float m, l; };

__device__ __forceinline__ void flash_tail(FlashState& st, f32x16& s0, f32x16& s1, const LAS bf16* Vs, int vp, int r32, int hi) {
    float mt = s0[0];
#pragma unroll
    for (int r = 1; r < 16; ++r) mt = fmaxf(mt, s0[r]);
#pragma unroll
    for (int r = 0; r < 16; ++r) mt = fmaxf(mt, s1[r]);
    mt = fmaxf(mt, __shfl_xor(mt, 32));
    const float mn = fmaxf(st.m, mt);
    const float alpha = __expf(st.m - mn);
    st.m = mn;
    float ps = 0.f;
#pragma unroll
    for (int r = 0; r < 16; ++r) { s0[r] = __expf(s0[r] - mn); ps += s0[r]; }
#pragma unroll
    for (int r = 0; r < 16; ++r) { s1[r] = __expf(s1[r] - mn); ps += s1[r]; }
    st.l = st.l * alpha + ps;
#pragma unroll
    for (int r = 0; r < 16; ++r) { st.o[0][r] *= alpha; st.o[1][r] *= alpha; }
#pragma unroll
    for (int blk = 0; blk < 2; ++blk)
#pragma unroll
        for (int s = 0; s < 2; ++s) {
            v4u pw;
            if (blk == 0) { pw.x = cvtpk(s0[8 * s + 0], s0[8 * s + 1]); pw.y = cvtpk(s0[8 * s + 2], s0[8 * s + 3]); pw.z = cvtpk(s0[8 * s + 4], s0[8 * s + 5]); pw.w = cvtpk(s0[8 * s + 6], s0[8 * s + 7]); }
            else          { pw.x = cvtpk(s1[8 * s + 0], s1[8 * s + 1]); pw.y = cvtpk(s1[8 * s + 2], s1[8 * s + 3]); pw.z = cvtpk(s1[8 * s + 4], s1[8 * s + 5]); pw.w = cvtpk(s1[8 * s + 6], s1[8 * s + 7]); }
            const bf16x8 pf = __builtin_bit_cast(bf16x8, pw);
#pragma unroll
            for (int db = 0; db < 2; ++db) {
                const LAS bf16* vp0 = Vs + (32 * db + r32) * vp + 32 * blk + 16 * s + 4 * hi;
                const s16x4 lo = *(const LAS s16x4*)vp0, hh = *(const LAS s16x4*)(vp0 + 8);
                const bf16x8 vf = __builtin_shufflevector(lo, hh, 0, 1, 2, 3, 4, 5, 6, 7);
                st.o[db] = MFMA32(vf, pf, st.o[db]);
            }
        }
}
__device__ __forceinline__ void flash_qk(f32x16& s0, f32x16& s1, const bf16x8 (&qf)[4], const LAS bf16* Ks, int r32, int hi) {
    s0 = (f32x16){0.f}; s1 = (f32x16){0.f};
#pragma unroll
    for (int r = 0; r < 16; ++r) { s0[r] = 0.f; s1[r] = 0.f; }
#pragma unroll
    for (int ks = 0; ks < 4; ++ks) {
        const bf16x8 a0 = *(const LAS bf16x8*)(Ks + r32 * KP + 16 * ks + 8 * hi);
        const bf16x8 a1 = *(const LAS bf16x8*)(Ks + (32 + r32) * KP + 16 * ks + 8 * hi);
        s0 = MFMA32(a0, qf[ks], s0); s1 = MFMA32(a1, qf[ks], s1);
    }
}
__device__ __forceinline__ void flash_store(const FlashState& st, bf16* orow, int hi) {
    float lt = st.l + __shfl_xor(st.l, 32);
    const float inv = 1.0f / lt;
#pragma unroll
    for (int db = 0; db < 2; ++db)
#pragma unroll
        for (int rg = 0; rg < 4; ++rg) { u32x2 w; w.x = cvtpk(st.o[db][4 * rg] * inv, st.o[db][4 * rg + 1] * inv); w.y = cvtpk(st.o[db][4 * rg + 2] * inv, st.o[db][4 * rg + 3] * inv);
            *(u32x2*)(orow + 32 * db + 8 * rg + 4 * hi) = w; }
}

__device__ __forceinline__ void fox_unit(Frame& F, int b, int h, int qb) {
    const bf16* proj = (const bf16*)(F.ws + WS_PROJ); const float* LOGF = (const float*)(F.ws + WS_LOGF); bf16* OB = (bf16*)(F.ws + WS_OB);
    LAS float* Fs = (LAS float*)(F.lds);
    LAS float* wtot = (LAS float*)(F.lds + 16384);
    LAS bf16* Kb = (LAS bf16*)(F.lds + 16384 + 64);
    LAS bf16* Vb = (LAS bf16*)(F.lds + 16384 + 64 + 2 * 64 * KP * 2);
    const int lane = F.lane, wave = F.wave, tid = F.tid, r32 = lane & 31, hi = lane >> 5;
    const int q_end = 256 * (qb + 1), NT = q_end / 64;
    const size_t rowbase = (size_t)b * SEQ;
    {
        float v[8]; float run = 0.f;
#pragma unroll
        for (int i = 0; i < 8; ++i) { const int pos = tid * 8 + i; const float lf = (pos < q_end) ? LOGF[(rowbase + pos) * 8 + h] : 0.f; run += lf; v[i] = run; }
        float inc = run;
#pragma unroll
        for (int o = 1; o < 64; o <<= 1) { const float t = __shfl_up(inc, o); if (lane >= o) inc += t; }
        if (lane == 63) wtot[wave] = inc;
        __syncthreads();
        float off = inc - run;
        for (int w = 0; w < wave; ++w) off += wtot[w];
#pragma unroll
        for (int i = 0; i < 8; ++i) Fs[tid * 8 + i] = v[i] + off;
    }
    const int qrow = 256 * qb + 32 * wave + r32;
    bf16x8 qf[4];
    { const bf16* qp = proj + (rowbase + qrow) * NPROJ + C_QB + 64 * h + 8 * hi;
#pragma unroll
      for (int ks = 0; ks < 4; ++ks) qf[ks] = *(const bf16x8*)(qp + 16 * ks); }
    const int tq = 4 * qb + (wave >> 1);
    FlashState st; st.m = -INFINITY; st.l = 0.f;
#pragma unroll
    for (int r = 0; r < 16; ++r) { st.o[0][r] = 0.f; st.o[1][r] = 0.f; }
    const int srow = tid >> 3, sch = tid & 7;
    const bf16* kg = proj + (rowbase + srow) * NPROJ + C_KB + 64 * h + 8 * sch;
    const bf16* vg = proj + (rowbase + srow) * NPROJ + C_VB + 64 * h + 8 * sch;
    v4u kreg, vreg;
    { const size_t o = (size_t)(NT - 1) * 64 * NPROJ; kreg = *(const v4u*)(kg + o); vreg = *(const v4u*)(vg + o); }
    int cur = 0;
    {   *(LAS v4u*)(Kb + srow * KP + 8 * sch) = kreg;
        const unsigned short* vs = (const unsigned short*)&vreg;
#pragma unroll
        for (int i = 0; i < 8; ++i) Vb[(8 * sch + i) * VPF + srow] = vs[i];
    }
    __syncthreads();
    const float fq = Fs[qrow];
    for (int t = NT - 1; t >= 0; --t) {
        if (t > 0) { const size_t o = (size_t)(t - 1) * 64 * NPROJ; kreg = *(const v4u*)(kg + o); vreg = *(const v4u*)(vg + o); }
        if (t <= tq) {
            const LAS bf16* Ks = Kb + cur * 64 * KP; const LAS bf16* Vs = Vb + cur * 64 * VPF;
            f32x16 s0, s1; flash_qk(s0, s1, qf, Ks, r32, hi);
            const LAS float* Fk = Fs + 64 * t;
            const bool diag = (t == tq);
#pragma unroll
            for (int rg = 0; rg < 4; ++rg) {
                const f32x4 f0 = *(const LAS f32x4*)(Fk + 8 * rg + 4 * hi), f1 = *(const LAS f32x4*)(Fk + 32 + 8 * rg + 4 * hi);
#pragma unroll
                for (int i = 0; i < 4; ++i) { const int r = 4 * rg + i; const int kv = 64 * t + 8 * rg + 4 * hi + i;
                    float a = s0[r] * 0.125f + (fq - f0[i]); float c = s1[r] * 0.125f + (fq - f1[i]);
                    if (diag) { if (kv > qrow) a = -INFINITY; if (kv + 32 > qrow) c = -INFINITY; }
                    s0[r] = a; s1[r] = c; }
            }
            flash_tail(st, s0, s1, Vs, VPF, r32, hi);
        }
        if (t > 0) {
            const int nb = cur ^ 1;
            *(LAS v4u*)(Kb + nb * 64 * KP + srow * KP + 8 * sch) = kreg;
            const unsigned short* vs = (const unsigned short*)&vreg;
#pragma unroll
            for (int i = 0; i < 8; ++i) Vb[nb * 64 * VPF + (8 * sch + i) * VPF + srow] = vs[i];
        }
        __syncthreads();
        cur ^= 1;
    }
    flash_store(st, OB + (rowbase + qrow) * 512 + 64 * h, hi);
    __syncthreads();
}

__device__ const unsigned char T5_BUCKET[128] = {0,1,2,3,4,5,6,7,8,9,10,11,12,13,14,15,16,16,16,17,17,18,18,18,19,19,19,20,20,20,20,21,21,21,21,22,22,22,22,22,23,23,23,23,23,23,24,24,24,24,24,24,25,25,25,25,25,25,25,26,26,26,26,26,26,26,26,27,27,27,27,27,27,27,27,27,27,28,28,28,28,28,28,28,28,28,28,29,29,29,29,29,29,29,29,29,29,29,29,30,30,30,30,30,30,30,30,30,30,30,30,30,30,31,31,31,31,31,31,31,31,31,31,31,31,31,31,31};

__device__ __forceinline__ void swa_unit(Frame& F, int b, int kvh, int n) {
    const bf16* proj = (const bf16*)(F.ws + WS_PROJ); bf16* OA = (bf16*)(F.ws + WS_OA);
    const float* sinks = F.in[8]; const float* rel_bias = F.in[12];
    LAS bf16* Kb = (LAS bf16*)(F.lds);
    LAS bf16* Vb = (LAS bf16*)(F.lds + 36864);
    LAS float* bt = (LAS float*)(F.lds + 36864 + 33280);
    const int lane = F.lane, wave = F.wave, tid = F.tid, r32 = lane & 31, hi = lane >> 5;
    const size_t rowbase = (size_t)b * SEQ;
    {
        const int g = tid >> 7, d = tid & 127;
        bt[tid] = rel_bias[(int)T5_BUCKET[d] * 8 + kvh * 4 + g];
#pragma unroll
        for (int i = 0; i < 4; ++i) {
            const int idx = tid + i * NTHR, kb = idx >> 3, sch = idx & 7; const int pos = 128 * (n - 1) + kb;
            v4u kreg = (v4u){0u, 0u, 0u, 0u}, vreg = (v4u){0u, 0u, 0u, 0u};
            if (pos >= 0) { const bf16* p = proj + (rowbase + pos) * NPROJ + 64 * kvh + 8 * sch; kreg = *(const v4u*)(p + C_KA); vreg = *(const v4u*)(p + C_VA); }
            *(LAS v4u*)(Kb + kb * KP + 8 * sch) = kreg;
            const unsigned short* vs = (const unsigned short*)&vreg;
#pragma unroll
            for (int j = 0; j < 8; ++j) Vb[(8 * sch + j) * VPS + kb] = vs[j];
        }
    }
    __syncthreads();
    const int g = wave & 3, qh = wave >> 2, head = kvh * 4 + g;
    const LAS float* btg = bt + g * 128;
    for (int sb = 0; sb < 2; ++sb) {
        const int qrel0 = 64 * qh + 32 * sb, qrel = qrel0 + r32;
        const size_t row = rowbase + 128 * n + qrel;
        bf16x8 qf[4];
        { const bf16* qp = proj + row * NPROJ + C_QA + 64 * head + 8 * hi;
#pragma unroll
          for (int ks = 0; ks < 4; ++ks) qf[ks] = *(const bf16x8*)(qp + 16 * ks); }
        FlashState st; st.m = sinks[head]; st.l = (hi == 0) ? 1.0f : 0.0f;
#pragma unroll
        for (int r = 0; r < 16; ++r) { st.o[0][r] = 0.f; st.o[1][r] = 0.f; }
        const int t_lo = (qrel0 + 1) >> 6, t_hi = (qrel0 + 159) >> 6;
        for (int t = t_lo; t <= t_hi; ++t) {
            f32x16 s0, s1; flash_qk(s0, s1, qf, Kb + t * 64 * KP, r32, hi);
#pragma unroll
            for (int r = 0; r < 16; ++r) {
                const int kb0 = 64 * t + crow(r, hi), kb1 = kb0 + 32;
                const int d0 = 128 + qrel - kb0, d1 = d0 - 32;
                const bool v0 = (d0 >= 0) && (d0 < 128) && (n > 0 || kb0 >= 128);
                const bool v1 = (d1 >= 0) && (d1 < 128) && (n > 0 || kb1 >= 128);
                const float b0 = btg[d0 & 127], b1 = btg[d1 & 127];
                s0[r] = v0 ? (s0[r] * 0.125f + b0) : -INFINITY;
                s1[r] = v1 ? (s1[r] * 0.125f + b1) : -INFINITY;
            }
            flash_tail(st, s0, s1, Vb + 64 * t, VPS, r32, hi);
        }
        flash_store(st, OA + row * 512 + 64 * head, hi);
    }
    __syncthreads();
}
__device__ __forceinline__ void p3_attention(Frame& F) {
    for (int item = F.vcu; item < 256; item += F.G) {
        swa_unit(F, item >> 6, (item >> 5) & 1, item & 31);
        const int bh = item >> 3, j = item & 7;
        fox_unit(F, bh >> 3, bh & 7, 15 - j);
        fox_unit(F, bh >> 3, bh & 7, j);
    }
}

struct PairOrder {
    pg8::StaticOrder S;
    __device__ bool next(int i, pg8::Unit& u) const { if (!S.next(i >> 1, u)) return false; u.src = i & 1; return true; }
    __device__ __forceinline__ void a_ready(const pg8::Unit&) const {}
    __device__ __forceinline__ void done(const pg8::Unit&) const {}
};
__device__ __forceinline__ float sigmoidf_(float z) { return 1.0f / (1.0f + __expf(-z)); }
struct EpiGate {
    static constexpr bool PERM = false, AFTER_DRAIN = false;
    const bf16* proj; bf16* tmp; bf16* mixed;
    __device__ __forceinline__ void operator()(const pg8::f32x4 (&acc)[2][2][4][2], const pg8::Unit& u, int wr, int wc, int fr, int fq) const {
        const int goff = u.src ? C_GLB : C_GLA;
#pragma unroll
        for (int ai = 0; ai < 2; ++ai)
#pragma unroll
            for (int m = 0; m < 4; ++m) { const size_t row = (size_t)u.pm * 256 + ai * 128 + wr * 64 + m * 16 + fr;
#pragma unroll
                for (int bj = 0; bj < 2; ++bj)
#pragma unroll
                    for (int n = 0; n < 2; ++n) { const int col = u.pn * 256 + bj * 128 + wc * 32 + n * 16 + 4 * fq;
                        const u32x2 gw = *(const u32x2*)(proj + row * NPROJ + goff + col);
                        const pg8::f32x4 a = acc[ai][bj][m][n];
                        float v0 = a[0] * sigmoidf_(bflo(gw.x)), v1 = a[1] * sigmoidf_(bfhi(gw.x)), v2 = a[2] * sigmoidf_(bflo(gw.y)), v3 = a[3] * sigmoidf_(bfhi(gw.y));
                        if (u.src == 0) { u32x2 w; w.x = cvtpk(v0, v1); w.y = cvtpk(v2, v3); *(u32x2*)(tmp + row * D + col) = w; }
                        else { const u32x2 t = *(const u32x2*)(tmp + row * D + col);
                            u32x2 w; w.x = cvtpk(v0 + bflo(t.x), v1 + bfhi(t.x)); w.y = cvtpk(v2 + bflo(t.y), v3 + bfhi(t.y)); *(u32x2*)(mixed + row * D + col) = w; }
                    }
            }
    }
};
struct EpiRes {
    static constexpr bool PERM = false, AFTER_DRAIN = false;
    const float* x; const float* mod; float* x1;
    __device__ __forceinline__ void operator()(const pg8::f32x4 (&acc)[2][2][4][2], const pg8::Unit& u, int wr, int wc, int fr, int fq) const {
#pragma unroll
        for (int ai = 0; ai < 2; ++ai)
#pragma unroll
            for (int m = 0; m < 4; ++m) { const size_t row = (size_t)u.pm * 256 + ai * 128 + wr * 64 + m * 16 + fr; const int b = (int)(row >> 12);
#pragma unroll
                for (int bj = 0; bj < 2; ++bj)
#pragma unroll
                    for (int n = 0; n < 2; ++n) { const int col = u.pn * 256 + bj * 128 + wc * 32 + n * 16 + 4 * fq;
                        const pg8::f32x4 xin = *(const pg8::f32x4*)(x + row * D + col), gt = *(const pg8::f32x4*)(mod + b * NMOD + 2048 + col);
                        *(pg8::f32x4*)(x1 + row * D + col) = xin + gt * acc[ai][bj][m][n]; }
            }
    }
};

__device__ __forceinline__ void p6_norm2(Frame& F) {
    const float* x1 = (const float*)(F.ws + WS_X1); const float* g2 = F.in[3]; const float* MOD = (const float*)(F.ws + WS_MOD); bf16* H2 = (bf16*)(F.ws + WS_H2);
    const int gw = F.vcu * NWAVES + F.wave, NGW = F.G * NWAVES;
    for (int row = gw; row < M; row += NGW) {
        const f32x4* xr = (const f32x4*)(x1 + (size_t)row * D) + F.lane;
        f32x4 v[4]; float ss = 0.f;
#pragma unroll
        for (int j = 0; j < 4; ++j) { v[j] = xr[64 * j]; ss += (v[j].x * v[j].x + v[j].y * v[j].y) + (v[j].z * v[j].z + v[j].w * v[j].w); }
        ss = wave_sum(ss);
        const float rstd = 1.0f / sqrtf(ss * (1.0f / D) + EPS);
        const int b = row >> 12; const float* mb = MOD + b * NMOD;
#pragma unroll
        for (int j = 0; j < 4; ++j) { const int col = 4 * F.lane + 256 * j;
            const f32x4 g = *(const f32x4*)(g2 + col), sh = *(const f32x4*)(mb + 3072 + col), sc = *(const f32x4*)(mb + 4096 + col);
            const f32x4 hv = (v[j] * rstd) * g * (sc + 1.0f) + sh;
            u32x2 w; w.x = cvtpk(hv.x, hv.y); w.y = cvtpk(hv.z, hv.w);
            *(u32x2*)(H2 + (size_t)row * D + col) = w; }
    }
}

__device__ __forceinline__ unsigned f2ord(float f) { const unsigned u = __float_as_uint(f); return u ^ ((unsigned)((int)u >> 31) | 0x80000000u); }
__device__ __forceinline__ float ord2f(unsigned o) { const unsigned u = (o & 0x80000000u) ? (o & 0x7fffffffu) : ~o; return __uint_as_float(u); }
#define CE_DESC(a, b) do { const unsigned _x = (a), _y = (b); (a) = _x > _y ? _x : _y; (b) = _x > _y ? _y : _x; } while (0)
__device__ __forceinline__ void sort16(unsigned (&k)[16]) {
#pragma unroll
    for (int size = 2; size <= 16; size <<= 1)
#pragma unroll
        for (int stride = size >> 1; stride > 0; stride >>= 1)
#pragma unroll
            for (int i = 0; i < 16; ++i) { const int j = i ^ stride; if (j > i) { if ((i & size) == 0) CE_DESC(k[i], k[j]); else CE_DESC(k[j], k[i]); } }
}
__device__ __forceinline__ void merge16(unsigned (&a)[16], const unsigned (&b)[16]) {
#pragma unroll
    for (int i = 0; i < 16; ++i) a[i] = a[i] > b[15 - i] ? a[i] : b[15 - i];
#pragma unroll
    for (int stride = 8; stride > 0; stride >>= 1)
#pragma unroll
        for (int i = 0; i < 16; ++i) { const int j = i ^ stride; if (j > i) CE_DESC(a[i], a[j]); }
}
__device__ __forceinline__ void top16_of_64(unsigned (&g0)[16], unsigned (&g1)[16], unsigned (&g2)[16], unsigned (&g3)[16]) {
    sort16(g0); sort16(g1); sort16(g2); sort16(g3);
    merge16(g0, g1); merge16(g2, g3); merge16(g0, g2);
}
constexpr int NCAND = 50;
__device__ __forceinline__ void p8a_topk(Frame& F) {
    const bf16* QP = (const bf16*)(F.ws + WS_QP); const bf16* SUBK = (const bf16*)(F.ws + WS_SUBK);
    unsigned short* PIDX = (unsigned short*)(F.ws + WS_PIDX); float* PG = (float*)(F.ws + WS_PG);
    LAS unsigned short* Elds = (LAS unsigned short*)(F.lds) + F.wave * (NCAND * 64);
    const int lane = F.lane, r32 = lane & 31, hi = lane >> 5;
    const int gw = F.vcu * NWAVES + F.wave, NGW = F.G * NWAVES;
    for (int item = gw; item < (M / 32) * 8; item += NGW) {
        const int tile = item >> 3;
        const int tok = tile * 32 + r32;
        { const int h = item & 7;
            unsigned top[2][16];
#pragma unroll
            for (int p = 0; p < 2; ++p) {
                bf16x8 qf[4];
                { const bf16* qp = QP + (size_t)tok * D + h * 128 + p * 64 + 8 * hi;
#pragma unroll
                  for (int ks = 0; ks < 4; ++ks) qf[ks] = *(const bf16x8*)(qp + 16 * ks); }
                const bf16* kp = SUBK + (size_t)((h * 2 + p) * 128 + r32) * 64 + 8 * hi;
                unsigned kk[4][16];
#pragma unroll
                for (int blk = 0; blk < 4; ++blk) {
                    f32x16 acc;
#pragma unroll
                    for (int r = 0; r < 16; ++r) acc[r] = 0.f;
#pragma unroll
                    for (int ks = 0; ks < 4; ++ks) { const bf16x8 a = *(const bf16x8*)(kp + (size_t)blk * 32 * 64 + 16 * ks); acc = MFMA32(a, qf[ks], acc); }
#pragma unroll
                    for (int r = 0; r < 16; ++r) { const int key = 32 * blk + crow(r, hi); kk[blk][r] = (f2ord(acc[r]) & ~127u) | (unsigned)(127 - key); }
                }
                top16_of_64(kk[0], kk[1], kk[2], kk[3]);
                unsigned other[16];
#pragma unroll
                for (int i = 0; i < 16; ++i) other[i] = (unsigned)__shfl_xor((int)kk[0][i], 32);
                merge16(kk[0], other);
#pragma unroll
                for (int i = 0; i < 16; ++i) top[p][i] = kk[0][i];
            }
            float s1[16], s2[16]; unsigned i1[16], i2[16];
#pragma unroll
            for (int i = 0; i < 16; ++i) { s1[i] = ord2f(top[0][i] & ~127u); i1[i] = 127u - (top[0][i] & 127u); s2[i] = ord2f(top[1][i] & ~127u); i2[i] = 127u - (top[1][i] & 127u); }
            unsigned ck[4][16];
#pragma unroll
            for (int c = 0; c < 64; ++c) {
                if (c < NCAND) { constexpr int CA[NCAND] = {0,0,0,0,0,0,0,0,0,0,0,0,0,0,0,0,1,1,1,1,1,1,1,1,2,2,2,2,2,3,3,3,3,4,4,4,5,5,6,6,7,7,8,9,10,11,12,13,14,15}; constexpr int CB[NCAND] = {0,1,2,3,4,5,6,7,8,9,10,11,12,13,14,15,0,1,2,3,4,5,6,7,0,1,2,3,4,0,1,2,3,0,1,2,0,1,0,1,0,1,0,0,0,0,0,0,0,0}; const int a = CA[c], b = CB[c];
                    ck[c >> 4][c & 15] = (f2ord(s1[a] + s2[b]) & ~63u) | (unsigned)(63 - c);
                    Elds[c * 64 + lane] = (unsigned short)(i1[a] * 128u + i2[b]); }
                else ck[c >> 4][c & 15] = 0u;
            }
            top16_of_64(ck[0], ck[1], ck[2], ck[3]);
            float w[16]; float wsum = 0.f; const float v0 = ord2f(ck[0][0] & ~63u);
#pragma unroll
            for (int r = 0; r < 16; ++r) { w[r] = __expf(ord2f(ck[0][r] & ~63u) - v0); wsum += w[r]; }
            const float winv = 1.0f / wsum;
#pragma unroll
            for (int r = 0; r < 16; ++r) if ((r >> 3) == hi) {
                const int c = 63 - (int)(ck[0][r] & 63u);
                const unsigned short eid = Elds[c * 64 + lane];
                PIDX[(size_t)tok * 128 + h * 16 + r] = eid; PG[(size_t)tok * 128 + h * 16 + r] = w[r] * winv; }
        }
    }
}

__device__ __forceinline__ float gelu_erf(float v) { return 0.5f * v * (1.0f + erff(v * 0.70710678118654752f)); }
__device__ __forceinline__ float dot8(const v4u& a, const v4u& b, float acc) {
    acc += bflo(a.x) * bflo(b.x); acc += bfhi(a.x) * bfhi(b.x); acc += bflo(a.y) * bflo(b.y); acc += bfhi(a.y) * bfhi(b.y);
    acc += bflo(a.z) * bflo(b.z); acc += bfhi(a.z) * bfhi(b.z); acc += bflo(a.w) * bflo(b.w); acc += bfhi(a.w) * bfhi(b.w); return acc;
}
__device__ __forceinline__ void axpy8(float (&acc)[8], float w, const v4u& u) {
    acc[0] += w * bflo(u.x); acc[1] += w * bfhi(u.x); acc[2] += w * bflo(u.y); acc[3] += w * bfhi(u.y);
    acc[4] += w * bflo(u.z); acc[5] += w * bfhi(u.z); acc[6] += w * bflo(u.w); acc[7] += w * bfhi(u.w);
}
template <int FAKE> __device__ __forceinline__ void p8b_gather(Frame& F) {
    const float* X1 = (const float*)(F.ws + WS_X1); const bf16* H2 = (const bf16*)(F.ws + WS_H2); const float* MOD = (const float*)(F.ws + WS_MOD);
    const bf16* ED = (const bf16*)(F.ws + WS_ED); const bf16* EU = (const bf16*)(F.ws + WS_EU);
    const unsigned short* PIDX = (const unsigned short*)(F.ws + WS_PIDX); const float* PG = (const float*)(F.ws + WS_PG);
    const float* fg = F.in[17];
    const int lane = F.lane;
    const int gw = F.vcu * NWAVES + F.wave, NGW = F.G * NWAVES;
    for (int tok = gw; tok < M; tok += NGW) {
        const int idx0 = PIDX[(size_t)tok * 128 + lane], idx1 = PIDX[(size_t)tok * 128 + 64 + lane];
        const float g0 = PG[(size_t)tok * 128 + lane], g1 = PG[(size_t)tok * 128 + 64 + lane];
        const v4u hq0 = *(const v4u*)(H2 + (size_t)tok * D + 8 * lane), hq1 = *(const v4u*)(H2 + (size_t)tok * D + 512 + 8 * lane);
        float acc0[8], acc1[8];
#pragma unroll
        for (int i = 0; i < 8; ++i) { acc0[i] = 0.f; acc1[i] = 0.f; }
        for (int jb = 0; jb < 16; ++jb) {
            const int idxv = (jb < 8) ? idx0 : idx1; const float gv = (jb < 8) ? g0 : g1;
            v4u d0[8], d1[8], u0[8], u1[8];
#pragma unroll
            for (int u = 0; u < 8; ++u) { int e = __builtin_amdgcn_readlane(idxv, (jb & 7) * 8 + u); if (FAKE) e &= 511;
                const bf16* dp = ED + (size_t)e * D + 8 * lane; const bf16* up = EU + (size_t)e * D + 8 * lane;
                d0[u] = *(const v4u*)dp; d1[u] = *(const v4u*)(dp + 512); u0[u] = *(const v4u*)up; u1[u] = *(const v4u*)(up + 512); }
            float dd[8];
#pragma unroll
            for (int u = 0; u < 8; ++u) dd[u] = dot8(hq1, d1[u], dot8(hq0, d0[u], 0.f));
            const bool b5 = (lane & 32) != 0, b4 = (lane & 16) != 0, b3 = (lane & 8) != 0;
            float r4[4];
#pragma unroll
            for (int u = 0; u < 4; ++u) { const float keep = b5 ? dd[u + 4] : dd[u], send = b5 ? dd[u] : dd[u + 4]; r4[u] = keep + __shfl_xor(send, 32); }
            float r2[2];
#pragma unroll
            for (int u = 0; u < 2; ++u) { const float keep = b4 ? r4[u + 2] : r4[u], send = b4 ? r4[u] : r4[u + 2]; r2[u] = keep + __shfl_xor(send, 16); }
            float r1; { const float keep = b3 ? r2[1] : r2[0], send = b3 ? r2[0] : r2[1]; r1 = keep + __shfl_xor(send, 8); }
            r1 += __shfl_xor(r1, 4); r1 += __shfl_xor(r1, 2); r1 += __shfl_xor(r1, 1);
            const float gsel = __shfl(gv, (jb & 7) * 8 + (lane >> 3));
            const float wv = gsel * gelu_erf(r1);
#pragma unroll
            for (int u = 0; u < 8; ++u) { const float w = __uint_as_float(__builtin_amdgcn_readlane(__float_as_uint(wv), 8 * u)); axpy8(acc0, w, u0[u]); axpy8(acc1, w, u1[u]); }
        }
        const int b = tok >> 12; const float* gt2 = MOD + b * NMOD + 5120;
        float x2[16]; float ss = 0.f;
#pragma unroll
        for (int hlf = 0; hlf < 2; ++hlf) { const int col = 512 * hlf + 8 * lane;
#pragma unroll
            for (int q = 0; q < 2; ++q) { const f32x4 xv = *(const f32x4*)(X1 + (size_t)tok * D + col + 4 * q), gv4 = *(const f32x4*)(gt2 + col + 4 * q);
#pragma unroll
                for (int i = 0; i < 4; ++i) { const float a = hlf ? acc1[4 * q + i] : acc0[4 * q + i]; const float v = xv[i] + gv4[i] * a; x2[hlf * 8 + q * 4 + i] = v; ss += v * v; } } }
        ss = wave_sum(ss);
        if (FAKE && ss != 12345.678f) continue;
        const float rstd = 1.0f / sqrtf(ss * (1.0f / D) + EPS);
#pragma unroll
        for (int hlf = 0; hlf < 2; ++hlf) { const int col = 512 * hlf + 8 * lane;
#pragma unroll
            for (int q = 0; q < 2; ++q) { const f32x4 gg = *(const f32x4*)(fg + col + 4 * q); f32x4 o;
#pragma unroll
                for (int i = 0; i < 4; ++i) o[i] = x2[hlf * 8 + q * 4 + i] * rstd * gg[i];
                *(f32x4*)(F.out + (size_t)tok * D + col + 4 * q) = o; } }
    }
}


constexpr int NR = 16, RSH = 17;
__device__ __forceinline__ void sort128(unsigned& e0, unsigned& e1, int lane) {
#pragma unroll
    for (int size = 2; size <= 128; size <<= 1) {
#pragma unroll
        for (int stride = size >> 1; stride > 0; stride >>= 1) {
            if (stride == 64) { const unsigned lo = e0 < e1 ? e0 : e1, hi = e0 < e1 ? e1 : e0; e0 = lo; e1 = hi; }
            else {
                const bool lower = (lane & stride) == 0;
                const bool asc0 = (size == 128) ? true : (size == 64 ? true : ((lane & size) == 0));
                const bool asc1 = (size == 128) ? true : (size == 64 ? false : ((lane & size) == 0));
                const unsigned p0 = (unsigned)__shfl_xor((int)e0, stride), p1 = (unsigned)__shfl_xor((int)e1, stride);
                const unsigned mn0 = e0 < p0 ? e0 : p0, mx0 = e0 < p0 ? p0 : e0, mn1 = e1 < p1 ? e1 : p1, mx1 = e1 < p1 ? p1 : e1;
                e0 = (lower == asc0) ? mn0 : mx0; e1 = (lower == asc1) ? mn1 : mx1;
            }
        }
    }
}
__device__ __forceinline__ void p8b_sweep(Frame& F) {
    const float* X1 = (const float*)(F.ws + WS_X1); const bf16* H2 = (const bf16*)(F.ws + WS_H2); const float* MOD = (const float*)(F.ws + WS_MOD);
    const bf16* ED = (const bf16*)(F.ws + WS_ED); const bf16* EU = (const bf16*)(F.ws + WS_EU);
    const unsigned short* PIDX = (const unsigned short*)(F.ws + WS_PIDX); const float* PG = (const float*)(F.ws + WS_PG);
    const float* fg = F.in[17];
    const int lane = F.lane;
    const int gw = F.vcu * NWAVES + F.wave, NGW = F.G * NWAVES;
    for (int tb = gw; tb < M / 8; tb += NGW) {
        const int tok0 = tb * 8;
        unsigned E0[8], E1[8]; float W0[8], W1[8];
#pragma unroll
        for (int k = 0; k < 8; ++k) {
            const size_t base = (size_t)(tok0 + k) * 128;
            E0[k] = ((unsigned)PIDX[base + lane] << 7) | (unsigned)lane; E1[k] = ((unsigned)PIDX[base + 64 + lane] << 7) | (unsigned)(64 + lane);
            sort128(E0[k], E1[k], lane); W0[k] = 0.f; W1[k] = 0.f;
        }
        {
            v4u hq0[8], hq1[8];
#pragma unroll
            for (int k = 0; k < 8; ++k) { hq0[k] = *(const v4u*)(H2 + (size_t)(tok0 + k) * D + 8 * lane); hq1[k] = *(const v4u*)(H2 + (size_t)(tok0 + k) * D + 512 + 8 * lane); }
            int pos[8];
#pragma unroll
            for (int k = 0; k < 8; ++k) pos[k] = 0;
            for (int r = 0; r < NR; ++r) {
#pragma unroll
                for (int k = 0; k < 8; ++k) {
                    const int c = __builtin_popcountll(__ballot((E0[k] >> RSH) == (unsigned)r)) + __builtin_popcountll(__ballot((E1[k] >> RSH) == (unsigned)r));
                    int s = __builtin_amdgcn_readfirstlane(pos[k]); const int e_end = __builtin_amdgcn_readfirstlane(s + c); pos[k] = e_end;
                    for (; s < e_end; s += 4) {
                        const int n = (e_end - s) < 4 ? (e_end - s) : 4;
                        v4u d0[4], d1[4];
#pragma unroll
                        for (int i = 0; i < 4; ++i) { const int P = (s + i) < e_end ? (s + i) : (e_end - 1);
                            const unsigned ka = (unsigned)__builtin_amdgcn_readlane((int)E0[k], P & 63), kb = (unsigned)__builtin_amdgcn_readlane((int)E1[k], P & 63);
                            const unsigned eid = (P < 64 ? ka : kb) >> 7;
                            const bf16* dp = ED + (size_t)eid * D + 8 * lane; d0[i] = *(const v4u*)dp; d1[i] = *(const v4u*)(dp + 512); }
                        float dd[4];
#pragma unroll
                        for (int i = 0; i < 4; ++i) dd[i] = dot8(hq1[k], d1[i], dot8(hq0[k], d0[i], 0.f));
                        const bool b5 = (lane & 32) != 0, b4 = (lane & 16) != 0;
                        float r2[2];
#pragma unroll
                        for (int u = 0; u < 2; ++u) { const float keep = b5 ? dd[u + 2] : dd[u], send = b5 ? dd[u] : dd[u + 2]; r2[u] = keep + __shfl_xor(send, 32); }
                        float r1; { const float keep = b4 ? r2[1] : r2[0], send = b4 ? r2[0] : r2[1]; r1 = keep + __shfl_xor(send, 16); }
                        r1 += __shfl_xor(r1, 8); r1 += __shfl_xor(r1, 4); r1 += __shfl_xor(r1, 2); r1 += __shfl_xor(r1, 1);
                        const int i0 = lane - s, i1 = lane + 64 - s;
                        const float v0 = __shfl(r1, 16 * (i0 & 3)), v1 = __shfl(r1, 16 * (i1 & 3));
                        if ((unsigned)i0 < (unsigned)n) W0[k] = v0;
                        if ((unsigned)i1 < (unsigned)n) W1[k] = v1;
                    }
                }
            }
        }
#pragma unroll
        for (int k = 0; k < 8; ++k) { const size_t base = (size_t)(tok0 + k) * 128;
            W0[k] = PG[base + (E0[k] & 127u)] * gelu_erf(W0[k]); W1[k] = PG[base + (E1[k] & 127u)] * gelu_erf(W1[k]); }
        float acc[8][16];
#pragma unroll
        for (int k = 0; k < 8; ++k)
#pragma unroll
            for (int i = 0; i < 16; ++i) acc[k][i] = 0.f;
        {
            int pos[8];
#pragma unroll
            for (int k = 0; k < 8; ++k) pos[k] = 0;
            for (int r = 0; r < NR; ++r) {
#pragma unroll
                for (int k = 0; k < 8; ++k) {
                    const int c = __builtin_popcountll(__ballot((E0[k] >> RSH) == (unsigned)r)) + __builtin_popcountll(__ballot((E1[k] >> RSH) == (unsigned)r));
                    int s = __builtin_amdgcn_readfirstlane(pos[k]); const int e_end = __builtin_amdgcn_readfirstlane(s + c); pos[k] = e_end;
                    for (; s < e_end; s += 4) {
                        v4u u0[4], u1[4]; float w[4];
#pragma unroll
                        for (int i = 0; i < 4; ++i) { const bool live = (s + i) < e_end; const int P = live ? (s + i) : (e_end - 1);
                            const unsigned ka = (unsigned)__builtin_amdgcn_readlane((int)E0[k], P & 63), kb = (unsigned)__builtin_amdgcn_readlane((int)E1[k], P & 63);
                            const unsigned wa = (unsigned)__builtin_amdgcn_readlane((int)__float_as_uint(W0[k]), P & 63), wb = (unsigned)__builtin_amdgcn_readlane((int)__float_as_uint(W1[k]), P & 63);
                            const unsigned eid = (P < 64 ? ka : kb) >> 7; w[i] = live ? __uint_as_float(P < 64 ? wa : wb) : 0.f;
                            const bf16* up = EU + (size_t)eid * D + 8 * lane; u0[i] = *(const v4u*)up; u1[i] = *(const v4u*)(up + 512); }
#pragma unroll
                        for (int i = 0; i < 4; ++i) {
                            acc[k][0] += w[i] * bflo(u0[i].x); acc[k][1] += w[i] * bfhi(u0[i].x); acc[k][2] += w[i] * bflo(u0[i].y); acc[k][3] += w[i] * bfhi(u0[i].y);
                            acc[k][4] += w[i] * bflo(u0[i].z); acc[k][5] += w[i] * bfhi(u0[i].z); acc[k][6] += w[i] * bflo(u0[i].w); acc[k][7] += w[i] * bfhi(u0[i].w);
                            acc[k][8] += w[i] * bflo(u1[i].x); acc[k][9] += w[i] * bfhi(u1[i].x); acc[k][10] += w[i] * bflo(u1[i].y); acc[k][11] += w[i] * bfhi(u1[i].y);
                            acc[k][12] += w[i] * bflo(u1[i].z); acc[k][13] += w[i] * bfhi(u1[i].z); acc[k][14] += w[i] * bflo(u1[i].w); acc[k][15] += w[i] * bfhi(u1[i].w);
                        }
                    }
                }
            }
        }
#pragma unroll
        for (int k = 0; k < 8; ++k) {
            const int tok = tok0 + k; const int b = tok >> 12; const float* gt2 = MOD + b * NMOD + 5120;
            float x2[16]; float ss = 0.f;
#pragma unroll
            for (int hlf = 0; hlf < 2; ++hlf) { const int col = 512 * hlf + 8 * lane;
#pragma unroll
                for (int q = 0; q < 2; ++q) { const f32x4 xv = *(const f32x4*)(X1 + (size_t)tok * D + col + 4 * q), gv4 = *(const f32x4*)(gt2 + col + 4 * q);
#pragma unroll
                    for (int i = 0; i < 4; ++i) { const float v = xv[i] + gv4[i] * acc[k][hlf * 8 + q * 4 + i]; x2[hlf * 8 + q * 4 + i] = v; ss += v * v; } } }
            ss = wave_sum(ss);
            const float rstd = 1.0f / sqrtf(ss * (1.0f / D) + EPS);
#pragma unroll
            for (int hlf = 0; hlf < 2; ++hlf) { const int col = 512 * hlf + 8 * lane;
#pragma unroll
                for (int q = 0; q < 2; ++q) { const f32x4 gg = *(const f32x4*)(fg + col + 4 * q); f32x4 o;
#pragma unroll
                    for (int i = 0; i < 4; ++i) o[i] = x2[hlf * 8 + q * 4 + i] * rstd * gg[i];
                    *(f32x4*)(F.out + (size_t)tok * D + col + 4 * q) = o; } }
        }
    }
}

struct Args { const float* in[18]; float* out; unsigned char* ws; };
__global__ void __launch_bounds__(NTHR, 2) mega_fwd(Args args) {
    extern __shared__ __attribute__((aligned(16))) unsigned char lds[];
    Frame F;
    F.lds = (LAS unsigned char*)lds;
    F.tid = threadIdx.x; F.lane = F.tid & 63; F.wave = __builtin_amdgcn_readfirstlane(F.tid >> 6);
    F.G = gridDim.x; { const int bx = blockIdx.x; F.vcu = (F.G % 8 == 0) ? (bx % 8) * (F.G / 8) + bx / 8 : bx; }
#pragma unroll
    for (int i = 0; i < 18; ++i) F.in[i] = args.in[i];
    F.out = args.out; F.ws = args.ws;
    volatile LAS unsigned* MISC = (volatile LAS unsigned*)(F.lds + MISC_OFF);
    for (int u = F.tid; u < (LDS_BYTES - LDSCTL_OFF) / 4; u += NTHR) ((LAS unsigned*)(F.lds + LDSCTL_OFF))[u] = 0u;
    __syncthreads();
    gu32* ctl = (gu32*)(F.ws + WS_CTL);
    XcdBarrier bar = xcd_barrier_post((unsigned*)(ctl + CW_BAR), MISC + 8);
#define GRID_BAR() xcd_barrier(bar)
#define PROBE_DBL -1

    p0_prologue(F); GRID_BAR();
    if (PROBE_DBL == 0) { p0_prologue(F); GRID_BAR(); }
    p1_norm(F); GRID_BAR();
    if (PROBE_DBL == 1) { p1_norm(F); GRID_BAR(); }
    {
        pg8::Gemm g{(const pg8::bf16_t*)(F.ws + WS_H), (const pg8::bf16_t*)(F.ws + WS_WIN), M, NPROJ, D, nullptr, nullptr};
        pg8::StaticOrder S; S.init(M, NPROJ, F.G, (int)blockIdx.x);
        pg8::EpiBf16<0> E{(pg8::bf16_t*)(F.ws + WS_PROJ), NPROJ, nullptr, 0, 0, 1.f};
        pg8::gemm_phase<pg8::EpiBf16<0>, pg8::StaticOrder, true, true>(F.lds + RING_OFF, g, S, E);
    }
    GRID_BAR();
    p3_attention(F); GRID_BAR();
    if (PROBE_DBL == 3) { p3_attention(F); GRID_BAR(); }
    {
        pg8::Gemm g{(const pg8::bf16_t*)(F.ws + WS_OA), (const pg8::bf16_t*)(F.ws + WS_WA), M, D, 512, (const pg8::bf16_t*)(F.ws + WS_OB), (const pg8::bf16_t*)(F.ws + WS_WB)};
        PairOrder S; S.S.init(M, D, F.G, (int)blockIdx.x);
        EpiGate E{(const bf16*)(F.ws + WS_PROJ), (bf16*)F.out, (bf16*)F.out + (size_t)M * D};
        pg8::gemm_phase<EpiGate, PairOrder, false, true>(F.lds + RING_OFF, g, S, E);
    }
    GRID_BAR();
    {
        pg8::Gemm g{(const pg8::bf16_t*)((bf16*)F.out + (size_t)M * D), (const pg8::bf16_t*)(F.ws + WS_WOUT), M, D, D, nullptr, nullptr};
        pg8::StaticOrder S; S.init(M, D, F.G, (int)blockIdx.x);
        EpiRes E{F.in[0], (const float*)(F.ws + WS_MOD), (float*)(F.ws + WS_X1)};
        pg8::gemm_phase<EpiRes, pg8::StaticOrder, false, true>(F.lds + RING_OFF, g, S, E);
    }
    GRID_BAR();
    p6_norm2(F); GRID_BAR();
    if (PROBE_DBL == 6) { p6_norm2(F); GRID_BAR(); }
    {
        pg8::Gemm g{(const pg8::bf16_t*)(F.ws + WS_H2), (const pg8::bf16_t*)(F.ws + WS_WQ), M, D, D, nullptr, nullptr};
        pg8::StaticOrder S; S.init(M, D, F.G, (int)blockIdx.x);
        pg8::EpiBf16<0> E{(pg8::bf16_t*)(F.ws + WS_QP), D, nullptr, 0, 0, 1.f};
        pg8::gemm_phase<pg8::EpiBf16<0>, pg8::StaticOrder, false, true>(F.lds + RING_OFF, g, S, E);
    }
    GRID_BAR();
    p8a_topk(F); GRID_BAR();
    if (PROBE_DBL == 8) { p8a_topk(F); GRID_BAR(); }
    if (PROBE_DBL == 10) { p8b_gather<1>(F); GRID_BAR(); }
    if (PROBE_DBL == 11) p8b_gather<0>(F); else p8b_sweep(F);
    if (PROBE_DBL == 9) { GRID_BAR(); p8b_gather<0>(F); }
}

extern "C" void kernel_launch(void* const* d_in, const int* in_sizes, int n_in, void* d_out, int out_size, void* d_ws, size_t ws_size, hipStream_t stream) {
    static int grid = 0;
    if (grid == 0) {
        if (n_in != 18 || in_sizes[0] != M * D || out_size != M * D || ws_size < WS_END) { fprintf(stderr, "kernel_launch: unexpected shapes (n_in %d, in0 %d, out %d, ws %zu)\n", n_in, n_in > 0 ? in_sizes[0] : -1, out_size, ws_size); grid = -1; return; }
        int dev = 0, cus = 0, per_cu = 0;
        if (hipGetDevice(&dev) != hipSuccess || hipDeviceGetAttribute(&cus, hipDeviceAttributeMultiprocessorCount, dev) != hipSuccess) { grid = -1; return; }
        if (hipFuncSetAttribute((const void*)mega_fwd, hipFuncAttributeMaxDynamicSharedMemorySize, LDS_BYTES) != hipSuccess) { fprintf(stderr, "kernel_launch: hipFuncSetAttribute failed\n"); grid = -1; return; }
        if (hipOccupancyMaxActiveBlocksPerMultiprocessor(&per_cu, (const void*)mega_fwd, NTHR, LDS_BYTES) != hipSuccess || per_cu < 1) { fprintf(stderr, "kernel_launch: occupancy query says %d blocks per CU\n", per_cu); }
        (void)hipGetLastError();
        grid = cus;
    }
    if (grid < 0) return;
    if (hipMemsetAsync((char*)d_ws + WS_CTL, 0, CTL_ZERO_BYTES, stream) != hipSuccess) { fprintf(stderr, "kernel_launch: memset failed\n"); return; }
    Args a{};
    for (int i = 0; i < 18; ++i) a.in[i] = (const float*)d_in[i];
    a.out = (float*)d_out; a.ws = (unsigned char*)d_ws;
    hipLaunchKernelGGL(mega_fwd, dim3(grid), dim3(NTHR), LDS_BYTES, stream, a);
}
```

```cpp
#include <hip/hip_runtime.h>
#include <cstdio>
#include <cstdint>
namespace pg8 {
#define PG8_LAS __attribute__((address_space(3)))
typedef unsigned short bf16_t;
typedef short bf16x8 __attribute__((ext_vector_type(8)));
typedef float f32x4 __attribute__((ext_vector_type(4)));
typedef unsigned u32x4 __attribute__((ext_vector_type(4)));
constexpr int BM = 256, BK = 64, HALF = 128, HTB = HALF * BK * 2  , STAGE_BYTES = 8 * HTB, NXCD = 8, WGM = 8;

__host__ __device__ __forceinline__ int lds_byte(int r, int c) { const int st = (r >> 4) * 2 + (c >> 5), rr = r & 15, cc = c & 31, ob = rr * 64 + cc * 2; return st * 1024 + (ob ^ (((ob >> 9) & 1) << 5)); }
__host__ __device__ __forceinline__ void stage_rc(int b, int& R, int& C) { const int st = b / 1024, sb = b % 1024, swz = sb ^ (((sb >> 9) & 1) << 5); R = (st >> 1) * 16 + swz / 64; C = (st & 1) * 32 + (swz % 64) / 2; }
__host__ __device__ __forceinline__ int perm32(int rho) { const int n = rho >> 4, i = rho & 15; return 8 * (i >> 2) + 4 * n + (i & 3); }

struct Unit { int pm, pn, src; };
struct Gemm { const bf16_t* A; const bf16_t* Bt; int M, N, K; const bf16_t* A2; const bf16_t* Bt2; };

struct StaticOrder {
    int nM, nN, nwg, G, c;
    __host__ __device__ void init(int M, int N, int G_, int c_) { nM = M / BM; nN = N / BM; nwg = nM * nN; G = G_; c = c_; }
    __host__ __device__ bool next(int i, Unit& u) const {
        const long L = (long)i * G + c; if (L >= nwg) return false;
        int wgid = (int)L; { const int q = nwg / NXCD, r = nwg % NXCD, xcd = wgid % NXCD, off = wgid / NXCD; wgid = (xcd < r ? xcd * (q + 1) : r * (q + 1) + (xcd - r) * q) + off; }
        const int nig = WGM * nN, gid = wgid / nig, fm = gid * WGM, gsz = (nM - fm) < WGM ? (nM - fm) : WGM;
        u.pm = fm + ((wgid % nig) % gsz); u.pn = (wgid % nig) / gsz; u.src = 0; return true;
    }
    __device__ __forceinline__ void a_ready(const Unit&) const {}
    __device__ __forceinline__ void done(const Unit&) const {}
};

__device__ __forceinline__ unsigned cvt_pk_bf16(float lo, float hi) { unsigned r; asm volatile("v_cvt_pk_bf16_f32 %0, %1, %2" : "=v"(r) : "v"(lo), "v"(hi)); return r; }
typedef float f32x2 __attribute__((ext_vector_type(2)));
__device__ __forceinline__ f32x2 gelu_pk(f32x2 v) {
    const f32x2 av = __builtin_elementwise_abs(v), d = av * 0.2316418882f + 1.0f;
    f32x2 t; t.x = __builtin_amdgcn_rcpf(d.x); t.y = __builtin_amdgcn_rcpf(d.y);
    f32x2 q = t * 0.5307027145f + (-0.7265760135f); q = q * t + 0.7107068705f; q = q * t + (-0.142248368f); q = q * t + 0.127414796f; q = q * t;
    const f32x2 s = (v * v) * (-0.72134752044f);
    f32x2 e; e.x = __builtin_amdgcn_exp2f(s.x); e.y = __builtin_amdgcn_exp2f(s.y);
    const f32x2 m = v * (q * e), r = v - m;
    f32x2 o; o.x = v.x < 0.f ? m.x : r.x; o.y = v.y < 0.f ? m.y : r.y; return o;
}

template <int ACT  > struct EpiBf16 {
    static constexpr bool PERM = true, AFTER_DRAIN = false; static_assert(ACT == 0 || ACT == 1, "EpiBf16: ACT is 0 (none) or 1 (gelu_pk)");
    bf16_t* O; int ldc; const float* bias; int split_cols; size_t split_stride; float scale0;
    __device__ __forceinline__ void operator()(const f32x4 (&acc)[2][2][4][2], const Unit& u, int wr, int wc, int fr, int fq) const {
        const int row0 = u.pm * BM + wr * 64 + fr; int colt = u.pn * BM; bf16_t* base = O;
        float sc = 1.f; if (split_cols) { const int t = colt / split_cols; base += (size_t)t * split_stride; colt -= t * split_cols; if (t == 0) sc = scale0; }
        const int col0 = colt + wc * 32 + 8 * fq, bcol0 = u.pn * BM + wc * 32 + 8 * fq;
        f32x4 bv[2][2];
#pragma unroll
        for (int bj = 0; bj < 2; ++bj)
#pragma unroll
            for (int n = 0; n < 2; ++n) bv[bj][n] = bias ? *(const f32x4*)(bias + bcol0 + bj * HALF + 4 * n) : (f32x4){0.f, 0.f, 0.f, 0.f};
#pragma unroll
        for (int ai = 0; ai < 2; ++ai)
#pragma unroll
            for (int m = 0; m < 4; ++m) { bf16_t* rowp = base + (size_t)(row0 + ai * HALF + m * 16) * ldc + col0;
#pragma unroll
                for (int bj = 0; bj < 2; ++bj) { f32x4 v0 = acc[ai][bj][m][0] + bv[bj][0], v1 = acc[ai][bj][m][1] + bv[bj][1];
                    if (ACT == 1) { f32x2 a = gelu_pk((f32x2){v0[0], v0[1]}), b = gelu_pk((f32x2){v0[2], v0[3]}), c = gelu_pk((f32x2){v1[0], v1[1]}), d = gelu_pk((f32x2){v1[2], v1[3]});
                        v0 = (f32x4){a.x, a.y, b.x, b.y}; v1 = (f32x4){c.x, c.y, d.x, d.y}; }
                    v0 = v0 * sc; v1 = v1 * sc; u32x4 w; w.x = cvt_pk_bf16(v0[0], v0[1]); w.y = cvt_pk_bf16(v0[2], v0[3]); w.z = cvt_pk_bf16(v1[0], v1[1]); w.w = cvt_pk_bf16(v1[2], v1[3]);
                    *(u32x4*)(rowp + bj * HALF) = w; } }
    }
};

template <class Epi, class Sched, bool ALIGN_EPI = false, bool SP2 = false>
__device__ __forceinline__ void gemm_phase(PG8_LAS unsigned char* lds, const Gemm g, const Sched& S, const Epi& E) {
    const int tid = threadIdx.x, wid = __builtin_amdgcn_readfirstlane(tid >> 6), lane = tid & 63, wr = wid >> 2, wc = wid & 3, fr = lane & 15, fq = lane >> 4;
    const int K = g.K, nt = K / BK;
    unsigned voffA[2], voffB[2];
#pragma unroll
    for (int i = 0; i < 2; ++i) { int R, C; stage_rc(tid * 16 + i * 8192, R, C); const int Rb = Epi::PERM ? ((R & ~31) + perm32(R & 31)) : R;
        voffA[i] = (unsigned)(R * K + C) * 2u; voffB[i] = (unsigned)(Rb * K + C) * 2u; }
    const size_t kstep = (size_t)(BK * 2);
    const size_t hstep = (size_t)HALF * K * 2;
    const size_t tstep = 2 * hstep;
    const unsigned ldsw = (unsigned)wid * 1024u;
    const int aoff = lds_byte(wr * 64 + fr, fq * 8), boff = lds_byte(wc * 32 + fr, fq * 8);
#define PG8_SA(b, h) (((b) * 2 + (h)) * HTB)
#define PG8_SB(b, h) ((4 + (b) * 2 + (h)) * HTB)
#define PG8_STAGE(bufoff, gbase, voff) do { _Pragma("unroll") for (int _i = 0; _i < 2; ++_i) \
        __builtin_amdgcn_global_load_lds((const unsigned*)((const char*)(gbase) + (voff)[_i]), (PG8_LAS unsigned*)(lds + (bufoff) + ldsw + _i * 8192), 16, 0, 0); } while (0)
#define PG8_LDA(dst, b, h) do { _Pragma("unroll") for (int m = 0; m < 4; ++m) _Pragma("unroll") for (int k = 0; k < 2; ++k) dst[m][k] = *(const PG8_LAS bf16x8*)(lds + PG8_SA(b, h) + aoff + m * 2048 + k * 1024); } while (0)
#define PG8_LDB(dst, b, h) do { _Pragma("unroll") for (int n = 0; n < 2; ++n) _Pragma("unroll") for (int k = 0; k < 2; ++k) dst[n][k] = *(const PG8_LAS bf16x8*)(lds + PG8_SB(b, h) + boff + n * 2048 + k * 1024); } while (0)
#define PG8_MMA(ai, bj, At, Bt) do { __builtin_amdgcn_s_setprio(1); _Pragma("unroll") for (int m = 0; m < 4; ++m) _Pragma("unroll") for (int n = 0; n < 2; ++n) _Pragma("unroll") for (int k = 0; k < 2; ++k) \
        acc[ai][bj][m][n] = __builtin_amdgcn_mfma_f32_16x16x32_bf16(Bt[n][k], At[m][k], acc[ai][bj][m][n], 0, 0, 0); __builtin_amdgcn_s_setprio(0); } while (0)
#define PG8_WAIT_V(n) asm volatile("s_waitcnt vmcnt(" #n ")" ::: "memory")
#define PG8_WAIT_L(n) asm volatile("s_waitcnt lgkmcnt(" #n ")" ::: "memory")
#define PG8_BAR __builtin_amdgcn_s_barrier()
#define PG8_SCHED __builtin_amdgcn_sched_barrier(0)
    Unit cur, nxt; int ui = 0;
    if (!S.next(0, cur)) return;
    f32x4 acc[2][2][4][2];
#pragma unroll
    for (int a = 0; a < 2; ++a)
#pragma unroll
        for (int b = 0; b < 2; ++b)
#pragma unroll
            for (int m = 0; m < 4; ++m)
#pragma unroll
                for (int n = 0; n < 2; ++n) acc[a][b][m][n] = (f32x4){0.f, 0.f, 0.f, 0.f};
    bf16x8 At[4][2], B0[2][2], B1[2][2];
    const char* cA = (const char*)(cur.src ? g.A2 : g.A) + (size_t)cur.pm * tstep; const char* cB = (const char*)(cur.src ? g.Bt2 : g.Bt) + (size_t)cur.pn * tstep;
    S.a_ready(cur);
    if constexpr (SP2) {
        PG8_STAGE(PG8_SB(0, 0), cB, voffB); PG8_STAGE(PG8_SB(0, 1), cB + hstep, voffB); PG8_STAGE(PG8_SA(0, 0), cA, voffA); PG8_STAGE(PG8_SA(0, 1), cA + hstep, voffA);
        if (wr == 1) PG8_BAR;
        PG8_WAIT_V(2); PG8_BAR;
        PG8_STAGE(PG8_SB(1, 0), cB + kstep, voffB); PG8_STAGE(PG8_SA(1, 0), cA + kstep, voffA); PG8_STAGE(PG8_SB(1, 1), cB + hstep + kstep, voffB);
        PG8_WAIT_V(6); PG8_BAR;
    } else {
        PG8_STAGE(PG8_SB(0, 0), cB, voffB); PG8_STAGE(PG8_SA(0, 0), cA, voffA); PG8_STAGE(PG8_SB(0, 1), cB + hstep, voffB); PG8_STAGE(PG8_SA(0, 1), cA + hstep, voffA);
        if (wr == 1) PG8_BAR;
        PG8_WAIT_V(4); PG8_BAR;
        PG8_STAGE(PG8_SB(1, 0), cB + kstep, voffB); PG8_STAGE(PG8_SA(1, 0), cA + kstep, voffA); PG8_STAGE(PG8_SB(1, 1), cB + hstep + kstep, voffB);
        PG8_WAIT_V(6); PG8_BAR;
    }
    for (;;) {
        const bool has_next = S.next(ui + 1, nxt);
        const char* nA = has_next ? (const char*)(nxt.src ? g.A2 : g.A) + (size_t)nxt.pm * tstep : cA; const char* nB = has_next ? (const char*)(nxt.src ? g.Bt2 : g.Bt) + (size_t)nxt.pn * tstep : cB;
        for (int t = 0; t < nt; t += 2) {
            const bool last = (t == nt - 2);
            const char* a1 = cA + (size_t)(t + 1) * kstep;
            const char* a2 = last ? nA : cA + (size_t)(t + 2) * kstep; const char* b2 = last ? nB : cB + (size_t)(t + 2) * kstep;
            const char* a3 = a2 + kstep; const char* b3 = b2 + kstep;
            if (last && has_next) S.a_ready(nxt);
            if constexpr (SP2) {
            PG8_LDB(B0, 0, 0); PG8_LDB(B1, 0, 1); PG8_SCHED; PG8_LDA(At, 0, 0); PG8_STAGE(PG8_SA(1, 1), a1 + hstep, voffA);
            PG8_WAIT_V(8); PG8_WAIT_L(0); PG8_BAR; PG8_MMA(0, 0, At, B0); PG8_MMA(0, 1, At, B1); PG8_BAR; PG8_SCHED;
            PG8_LDA(At, 0, 1); PG8_STAGE(PG8_SB(0, 0), b2, voffB); PG8_STAGE(PG8_SB(0, 1), b2 + hstep, voffB); PG8_STAGE(PG8_SA(0, 0), a2, voffA);
            PG8_WAIT_V(8); PG8_WAIT_L(0); PG8_BAR; PG8_MMA(1, 0, At, B0); PG8_MMA(1, 1, At, B1); PG8_BAR; PG8_SCHED;
            PG8_LDB(B0, 1, 0); PG8_LDB(B1, 1, 1); PG8_SCHED; PG8_LDA(At, 1, 0); PG8_STAGE(PG8_SA(0, 1), a2 + hstep, voffA);
            PG8_WAIT_V(8); PG8_WAIT_L(0); PG8_BAR; PG8_MMA(0, 0, At, B0); PG8_MMA(0, 1, At, B1); PG8_BAR; PG8_SCHED;
            PG8_LDA(At, 1, 1); PG8_STAGE(PG8_SB(1, 0), b3, voffB); PG8_STAGE(PG8_SB(1, 1), b3 + hstep, voffB); PG8_STAGE(PG8_SA(1, 0), a3, voffA);
            PG8_WAIT_V(8); PG8_WAIT_L(0); PG8_BAR; PG8_MMA(1, 0, At, B0); PG8_MMA(1, 1, At, B1); PG8_BAR; PG8_SCHED;
            } else {
            PG8_LDB(B0, 0, 0); PG8_SCHED; PG8_LDA(At, 0, 0); PG8_STAGE(PG8_SA(1, 1), a1 + hstep, voffA);
            PG8_WAIT_L(8); PG8_BAR; PG8_WAIT_L(0); PG8_MMA(0, 0, At, B0); PG8_BAR; PG8_SCHED;
            PG8_LDB(B1, 0, 1); PG8_STAGE(PG8_SB(0, 0), b2, voffB);
            PG8_BAR; PG8_WAIT_L(0); PG8_MMA(0, 1, At, B1); PG8_BAR;
            PG8_LDA(At, 0, 1); PG8_STAGE(PG8_SA(0, 0), a2, voffA);
            PG8_BAR; PG8_WAIT_L(0); PG8_MMA(1, 0, At, B0); PG8_BAR; PG8_SCHED;
            PG8_STAGE(PG8_SB(0, 1), b2 + hstep, voffB);
            PG8_WAIT_V(6); PG8_BAR; PG8_MMA(1, 1, At, B1); PG8_BAR;
            PG8_LDB(B0, 1, 0); PG8_SCHED; PG8_LDA(At, 1, 0); PG8_STAGE(PG8_SA(0, 1), a2 + hstep, voffA);
            PG8_WAIT_L(8); PG8_BAR; PG8_WAIT_L(0); PG8_MMA(0, 0, At, B0); PG8_BAR; PG8_SCHED;
            PG8_LDB(B1, 1, 1); PG8_STAGE(PG8_SB(1, 0), b3, voffB);
            PG8_BAR; PG8_WAIT_L(0); PG8_MMA(0, 1, At, B1); PG8_BAR;
            PG8_LDA(At, 1, 1); PG8_STAGE(PG8_SA(1, 0), a3, voffA);
            PG8_BAR; PG8_WAIT_L(0); PG8_MMA(1, 0, At, B0); PG8_BAR; PG8_SCHED;
            PG8_STAGE(PG8_SB(1, 1), b3 + hstep, voffB);
            PG8_WAIT_V(6); PG8_BAR; PG8_MMA(1, 1, At, B1); PG8_BAR;
            }
        }
        if constexpr (ALIGN_EPI) { if (wr == 0) PG8_BAR; }
        if constexpr (!Epi::AFTER_DRAIN) { E(acc, cur, wr, wc, fr, fq); S.done(cur); }
        if (!has_next) break;
#pragma unroll
        for (int a = 0; a < 2; ++a)
#pragma unroll
            for (int b = 0; b < 2; ++b)
#pragma unroll
                for (int m = 0; m < 4; ++m)
#pragma unroll
                    for (int n = 0; n < 2; ++n) acc[a][b][m][n] = (f32x4){0.f, 0.f, 0.f, 0.f};
        cur = nxt; cA = nA; cB = nB; ++ui;
        if constexpr (ALIGN_EPI) { if (wr == 1) PG8_BAR; }
    }
    PG8_WAIT_V(0);
    if constexpr (!ALIGN_EPI) { if (wr == 0) PG8_BAR; }
    PG8_BAR;
    if constexpr (Epi::AFTER_DRAIN) { E.fused(acc, cur, wr, wc, fr, fq, lds, wid, lane); S.done(cur); }
#undef PG8_SA
#undef PG8_SB
#undef PG8_STAGE
#undef PG8_LDA
#undef PG8_LDB
#undef PG8_MMA
#undef PG8_WAIT_V
#undef PG8_WAIT_L
#undef PG8_BAR
#undef PG8_SCHED
}
}

#define GAS __attribute__((address_space(1)))
#define LAS __attribute__((address_space(3)))
typedef unsigned short bf16;
typedef unsigned v4u __attribute__((ext_vector_type(4)));
typedef float f32x4 __attribute__((ext_vector_type(4)));
typedef short bf16x8 __attribute__((ext_vector_type(8)));
typedef GAS unsigned gu32;
typedef GAS unsigned long long gu64;
#define RLX_AGENT __ATOMIC_RELAXED, __HIP_MEMORY_SCOPE_AGENT
#define LDS_WAIT() asm volatile("s_waitcnt lgkmcnt(0)" ::: "memory")
#define VM_WAIT() asm volatile("s_waitcnt vmcnt(0)" ::: "memory")
__device__ __forceinline__ unsigned long long rt() { return __builtin_amdgcn_s_memrealtime(); }
__device__ __forceinline__ unsigned f2bf(float f) { unsigned u = __builtin_bit_cast(unsigned, f); return (u + 0x7fffu + ((u >> 16) & 1u)) >> 16; }
__device__ __forceinline__ unsigned pk2(float lo, float hi) { return f2bf(lo) | (f2bf(hi) << 16); }

#define XB_TMO      128
#define XB_XCNT(j)  (256  + 64 * (j))
#define XB_XSUB(j)  (1280 + 64 * (j))
#define XB_XGEN(j)  (2304 + 64 * (j))
#define XB_TOP      3328
#define XB_TOPGEN   3392
#define XCD_BAR_WORDS 3456
#define XB_SPIN_CAP (1u << 18)

__device__ __forceinline__ unsigned xb_ld(unsigned* p)              { return __hip_atomic_load(p, __ATOMIC_RELAXED, __HIP_MEMORY_SCOPE_AGENT); }
__device__ __forceinline__ unsigned xb_add(unsigned* p, unsigned v) { return __hip_atomic_fetch_add(p, v, __ATOMIC_RELAXED, __HIP_MEMORY_SCOPE_AGENT); }
__device__ __forceinline__ unsigned xb_xcc_id() { return (unsigned)__builtin_amdgcn_s_getreg((3 << 11) | 20) & 0xFu; }
#define XB_SPIN(cond, bar) do { unsigned _sp = 0; while (cond) { __builtin_amdgcn_s_sleep(1); \
    if ((++_sp & 255u) == 0u) { if (xb_ld(&(bar)[XB_TMO])) break; if (_sp > XB_SPIN_CAP) { atomicAdd(&(bar)[XB_TMO], 1u); break; } } } } while (0)

struct XcdBarrier {
    unsigned* bar; unsigned x;
    volatile LAS unsigned* st;
};

__device__ __forceinline__ XcdBarrier xcd_barrier_post(unsigned* bar, volatile LAS unsigned* st) {
    XcdBarrier b; b.bar = bar; b.x = xb_xcc_id(); b.st = st;
    if (threadIdx.x == 0) (void)xb_add(&bar[XB_XCNT(b.x)], 1u);
    return b;
}
__device__ __forceinline__ void xcd_barrier_complete(unsigned* bar, unsigned x, unsigned& nloc, unsigned& nx) {
    const unsigned G = gridDim.x * gridDim.y * gridDim.z;
    unsigned sum, cnt, mine, sp = 0u;
    for (;;) {
        sum = 0u; cnt = 0u; mine = 0u;
#pragma unroll
        for (unsigned j = 0; j < 16; ++j) { const unsigned c = xb_ld(&bar[XB_XCNT(j)]); sum += c; cnt += (c > 0u) ? 1u : 0u; mine = (j == x) ? c : mine; }
        if (sum == G) break;
        __builtin_amdgcn_s_sleep(1);
        if ((++sp & 255u) == 0u) { if (xb_ld(&bar[XB_TMO])) break; if (sp > XB_SPIN_CAP) { atomicAdd(&bar[XB_TMO], 1u); break; } }
    }
    nloc = mine > 0u ? mine : 1u; nx = cnt > 0u ? cnt : 1u;
}

__device__ __forceinline__ void xcd_barrier(const XcdBarrier& b) {
    asm volatile("s_waitcnt vmcnt(0)" ::: "memory");
    __syncthreads();
    if (threadIdx.x == 0) {
        unsigned* bar = b.bar;
        __builtin_amdgcn_s_waitcnt(0);
        unsigned nloc = b.st[0], nx = b.st[1];
        if (nloc == 0u) { xcd_barrier_complete(bar, b.x, nloc, nx); b.st[0] = nloc; b.st[1] = nx; }
        const unsigned old = xb_add(&bar[XB_XSUB(b.x)], 1u);
        const unsigned gen = old / nloc;
        if (old + 1u == (gen + 1u) * nloc) {
            __builtin_amdgcn_fence(__ATOMIC_RELEASE, "agent");
            asm volatile("s_waitcnt vmcnt(0)" ::: "memory");
            const unsigned og = xb_add(&bar[XB_TOP], 1u);
            const unsigned tg = og / nx;
            if (og + 1u == (tg + 1u) * nx) xb_add(&bar[XB_TOPGEN], 1u);
            else XB_SPIN(xb_ld(&bar[XB_TOPGEN]) == tg, bar);
            __builtin_amdgcn_fence(__ATOMIC_ACQUIRE, "agent");
            xb_add(&bar[XB_XGEN(b.x)], 1u);
            asm volatile("s_waitcnt vmcnt(0)" ::: "memory");
        } else {
            XB_SPIN(xb_ld(&bar[XB_XGEN(b.x)]) == gen, bar);
            __builtin_amdgcn_fence(__ATOMIC_ACQUIRE, "agent");
            asm volatile("s_waitcnt vmcnt(0)" ::: "memory");
        }
    }
    __syncthreads();
}

constexpr int NWAVES = 8, NTHR = 512;
constexpr int BATCH = 4, SEQ = 4096, D = 1024, M = BATCH * SEQ;
constexpr int NPROJ = 4352, LDW_IN = 4360, NMOD = 6144;
constexpr int C_QA = 0, C_KA = 512, C_VA = 640, C_QB = 768, C_KB = 1280, C_VB = 1792, C_GLA = 2304, C_GLB = 3328;
constexpr int NEXP = 16384;
constexpr float EPS = 1e-6f;

constexpr size_t MiB = 1u << 20;
constexpr size_t WS_CTL = 0, CTL_ZERO_BYTES = 1 * MiB;
constexpr size_t WS_MOD = 1 * MiB, WS_LOGF = 1 * MiB + 128 * 1024, WS_SUBK = 2 * MiB;
constexpr size_t WS_WIN = 4 * MiB, WS_WA = 12 * MiB + 512 * 1024, WS_WB = 13 * MiB + 512 * 1024, WS_WOUT = 14 * MiB + 512 * 1024, WS_WQ = 16 * MiB + 512 * 1024;
constexpr size_t WS_ED = 19 * MiB, WS_EU = 35 * MiB;
constexpr size_t WS_EDS = 2 * MiB + 512 * 1024;
constexpr size_t WS_H2Q = 95 * MiB, WS_H2S = 111 * MiB;
constexpr size_t WS_H = 83 * MiB, WS_OA = 83 * MiB, WS_OB = 99 * MiB, WS_PIDX = 83 * MiB, WS_PG = 87 * MiB;
constexpr size_t WS_PROJ = 115 * MiB, WS_X1 = 115 * MiB, WS_H2 = 179 * MiB, WS_QP = 211 * MiB;
constexpr size_t WS_END = 251 * MiB;
static_assert(WS_WIN + (size_t)NPROJ * D * 2 <= WS_WA && WS_WQ + (size_t)D * D * 2 <= WS_ED && WS_PROJ + (size_t)M * NPROJ * 2 <= WS_END, "ws map");
constexpr int CW_BAR = 4096;

constexpr int RING_OFF = 0, RING_BYTES = 131072;
constexpr int LDSCTL_OFF = RING_BYTES, MISC_OFF = LDSCTL_OFF + 320;
constexpr int LDS_BYTES = 147456;

typedef float f32x16 __attribute__((ext_vector_type(16)));
typedef short s16x4 __attribute__((ext_vector_type(4)));
typedef unsigned u32x2 __attribute__((ext_vector_type(2)));
typedef float f32x2_t __attribute__((ext_vector_type(2)));
typedef __bf16 bf16x2_t __attribute__((ext_vector_type(2)));

__device__ __forceinline__ unsigned cvtpk(float lo, float hi) { f32x2_t v = {lo, hi}; bf16x2_t b = __builtin_convertvector(v, bf16x2_t); return __builtin_bit_cast(unsigned, b); }
__device__ __forceinline__ float bflo(unsigned u) { return __uint_as_float(u << 16); }
__device__ __forceinline__ float bfhi(unsigned u) { return __uint_as_float(u & 0xffff0000u); }
__device__ __forceinline__ float wave_sum(float v) {
#pragma unroll
    for (int o = 1; o < 64; o <<= 1) v += __shfl_xor(v, o);
    return v;
}
__device__ __forceinline__ int crow(int r, int hi) { return (r & 3) + 8 * (r >> 2) + 4 * hi; }
#define MFMA32(a, b, c) __builtin_amdgcn_mfma_f32_32x32x16_bf16((a), (b), (c), 0, 0, 0)

struct Frame {
    LAS unsigned char* lds;
    int tid, lane, wave, vcu, G;
    const float* in[18]; float* out; unsigned char* ws;
};

__device__ __forceinline__ void p0_transpose_item(const float* W, int ld, int K, int ncols, bf16* WT, int row_off, LAS float* scr, int item, int lane) {
    const int nblk = ncols / 32, kb = item / nblk, nb = item % nblk, k0 = 64 * kb, n0 = 32 * nb;
#pragma unroll 8
    for (int i = 0; i < 32; ++i) { const int kk = 2 * i + (lane >> 5); scr[kk * 33 + (lane & 31)] = W[(size_t)(k0 + kk) * ld + n0 + (lane & 31)]; }
    LDS_WAIT(); asm volatile("" ::: "memory");
    const int c = lane & 7;
#pragma unroll
    for (int j = 0; j < 4; ++j) { const int n = (lane >> 3) + 8 * j; const LAS float* s = scr + (8 * c) * 33 + n;
        v4u o; o.x = pk2(s[0 * 33], s[1 * 33]); o.y = pk2(s[2 * 33], s[3 * 33]); o.z = pk2(s[4 * 33], s[5 * 33]); o.w = pk2(s[6 * 33], s[7 * 33]);
        *(GAS v4u*)(WT + (size_t)(row_off + n0 + n) * K + k0 + 8 * c) = o; }
    LDS_WAIT(); asm volatile("" ::: "memory");
}
__device__ __forceinline__ void p0_convert(const float* __restrict__ src, bf16* __restrict__ dst, long n_iters, int gw, int NGW, int lane) {
    for (long it0 = (long)gw * 4; it0 < n_iters; it0 += (long)NGW * 4) {
        f32x4 a[4][2];
#pragma unroll
        for (int u = 0; u < 4; ++u) { const long it = it0 + u; if (it < n_iters) { const float* p = src + it * 512 + lane * 4; a[u][0] = *(const f32x4*)p; a[u][1] = *(const f32x4*)(p + 256); } }
#pragma unroll
        for (int u = 0; u < 4; ++u) { const long it = it0 + u; if (it < n_iters) { bf16* q = dst + it * 512 + lane * 4;
            u32x2 w0, w1; w0.x = cvtpk(a[u][0].x, a[u][0].y); w0.y = cvtpk(a[u][0].z, a[u][0].w); w1.x = cvtpk(a[u][1].x, a[u][1].y); w1.y = cvtpk(a[u][1].z, a[u][1].w);
            *(u32x2*)q = w0; *(u32x2*)(q + 256) = w1; } }
    }
}

__device__ __forceinline__ void p0_quant_tables(Frame& F, int gw, int NGW) {
    const float* ed = F.in[15]; const float* eu = F.in[16];
    unsigned char* EDq = (unsigned char*)(F.ws + WS_ED); unsigned char* EUq = (unsigned char*)(F.ws + WS_EU); float* EDS = (float*)(F.ws + WS_EDS);
    const int lane = F.lane;
    for (int row0 = gw * 2; row0 < NEXP; row0 += NGW * 2) {
        f32x4 a[2][4], u[2][4];
#pragma unroll
        for (int q = 0; q < 2; ++q)
#pragma unroll
            for (int j = 0; j < 4; ++j) { a[q][j] = *((const f32x4*)(ed + (size_t)(row0 + q) * D) + lane + 64 * j); u[q][j] = *((const f32x4*)(eu + (size_t)(row0 + q) * D) + lane + 64 * j); }
#pragma unroll
        for (int q = 0; q < 2; ++q) {
            float am = 0.f;
#pragma unroll
            for (int j = 0; j < 4; ++j) am = fmaxf(fmaxf(am, fmaxf(fabsf(a[q][j].x), fabsf(a[q][j].y))), fmaxf(fabsf(a[q][j].z), fabsf(a[q][j].w)));
#pragma unroll
            for (int o = 1; o < 64; o <<= 1) am = fmaxf(am, __shfl_xor(am, o));
            const float sc = am > 0.f ? am * (1.0f / 127.0f) : 1.0f, inv = 1.0f / sc;
            v4u qa, qu;
#pragma unroll
            for (int j = 0; j < 4; ++j) {
                const int b0 = (int)rintf(a[q][j].x * inv), b1 = (int)rintf(a[q][j].y * inv), b2 = (int)rintf(a[q][j].z * inv), b3 = (int)rintf(a[q][j].w * inv);
                qa[j] = (unsigned)(b0 & 255) | ((unsigned)(b1 & 255) << 8) | ((unsigned)(b2 & 255) << 16) | ((unsigned)(b3 & 255) << 24);
                int p = __builtin_amdgcn_cvt_pk_fp8_f32(u[q][j].x * 16.0f, u[q][j].y * 16.0f, 0, false);
                p = __builtin_amdgcn_cvt_pk_fp8_f32(u[q][j].z * 16.0f, u[q][j].w * 16.0f, p, true);
                qu[j] = (unsigned)p;
            }
            *(v4u*)(EDq + (size_t)(row0 + q) * D + 16 * lane) = qa;
            *(v4u*)(EUq + (size_t)(row0 + q) * D + 16 * lane) = qu;
            if (lane == 0) EDS[row0 + q] = sc;
        }
    }
}
__device__ __forceinline__ void p0_prologue(Frame& F) {
    const float* c = F.in[1]; const float* w_ada = F.in[4]; const float* b_ada = F.in[5];
    float* MOD = (float*)(F.ws + WS_MOD);
    {
        LAS float* cact = (LAS float*)(F.lds);
        LAS float* part = (LAS float*)(F.lds + 16384);
        bool did = false;
        for (int item = F.vcu; item < NMOD / 32; item += F.G) {
            if (!did) { for (int i = F.tid; i < 4096; i += NTHR) { const float cv = c[i]; cact[i] = cv / (1.0f + __expf(-cv)); } did = true; }
            __syncthreads();
            const int n0 = item * 32, col = n0 + (F.lane & 31), ksub = F.lane >> 5;
            float a0 = 0.f, a1 = 0.f, a2 = 0.f, a3 = 0.f;
#pragma unroll 16
            for (int it = 0; it < 64; ++it) { const int k = (it * 8 + F.wave) * 2 + ksub; const float w = w_ada[(size_t)k * NMOD + col];
                a0 += cact[k] * w; a1 += cact[1024 + k] * w; a2 += cact[2048 + k] * w; a3 += cact[3072 + k] * w; }
            a0 += __shfl_xor(a0, 32); a1 += __shfl_xor(a1, 32); a2 += __shfl_xor(a2, 32); a3 += __shfl_xor(a3, 32);
            if (F.lane < 32) { part[(F.wave * 4 + 0) * 32 + F.lane] = a0; part[(F.wave * 4 + 1) * 32 + F.lane] = a1; part[(F.wave * 4 + 2) * 32 + F.lane] = a2; part[(F.wave * 4 + 3) * 32 + F.lane] = a3; }
            __syncthreads();
            if (F.tid < 128) { const int b = F.tid >> 5, cl = F.tid & 31; float s = 0.f;
#pragma unroll
                for (int w = 0; w < 8; ++w) s += part[(w * 4 + b) * 32 + cl];
                MOD[b * NMOD + n0 + cl] = s + b_ada[n0 + cl]; }
            __syncthreads();
        }
    }
    LAS float* scr = (LAS float*)(F.lds + RING_OFF + F.wave * 16384);
    const int gw = F.vcu * NWAVES + F.wave, NGW = F.G * NWAVES;
    constexpr int I_IN1 = (D / 64) * (2304 / 32), I_IN2 = (D / 64) * (2048 / 32), I_AB = (512 / 64) * (D / 32), I_SQ = (D / 64) * (D / 32);
    constexpr int NITEMS = I_IN1 + I_IN2 + 2 * I_AB + 2 * I_SQ;
    bf16* Win_t = (bf16*)(F.ws + WS_WIN);
    for (int it = gw; it < NITEMS; it += NGW) {
        int r = it;
        if (r < I_IN1) { p0_transpose_item(F.in[6], LDW_IN, D, 2304, Win_t, 0, scr, r, F.lane); continue; } r -= I_IN1;
        if (r < I_IN2) { p0_transpose_item(F.in[6] + 2312, LDW_IN, D, 2048, Win_t, 2304, scr, r, F.lane); continue; } r -= I_IN2;
        if (r < I_AB) { p0_transpose_item(F.in[9], D, 512, D, (bf16*)(F.ws + WS_WA), 0, scr, r, F.lane); continue; } r -= I_AB;
        if (r < I_AB) { p0_transpose_item(F.in[10], D, 512, D, (bf16*)(F.ws + WS_WB), 0, scr, r, F.lane); continue; } r -= I_AB;
        if (r < I_SQ) { p0_transpose_item(F.in[11], D, D, D, (bf16*)(F.ws + WS_WOUT), 0, scr, r, F.lane); continue; } r -= I_SQ;
        p0_transpose_item(F.in[13], D, D, D, (bf16*)(F.ws + WS_WQ), 0, scr, r, F.lane);
    }
    p0_quant_tables(F, gw, NGW);
    p0_convert(F.in[14], (bf16*)(F.ws + WS_SUBK), (long)(8 * 2 * 128 * 64) / 512, gw, NGW, F.lane);
}

__device__ __forceinline__ void p1_norm(Frame& F) {
    const float* x = F.in[0]; const float* g1 = F.in[2]; const float* w_in = F.in[6]; const float* b_forget = F.in[7];
    const float* MOD = (const float*)(F.ws + WS_MOD); bf16* H = (bf16*)(F.ws + WS_H); float* LOGF = (float*)(F.ws + WS_LOGF);
    LAS float* wfl = (LAS float*)(F.lds);
    for (int i = F.tid; i < 8192; i += NTHR) { const int k = i >> 3, j = i & 7; wfl[j * 1024 + k] = w_in[(size_t)k * LDW_IN + 2304 + j]; }
    __syncthreads();
    const int gw = F.vcu * NWAVES + F.wave, NGW = F.G * NWAVES;
    for (int row = gw; row < M; row += NGW) {
        const f32x4* xr = (const f32x4*)(x + (size_t)row * D) + F.lane;
        f32x4 v[4]; float ss = 0.f;
#pragma unroll
        for (int j = 0; j < 4; ++j) { v[j] = xr[64 * j]; ss += (v[j].x * v[j].x + v[j].y * v[j].y) + (v[j].z * v[j].z + v[j].w * v[j].w); }
        ss = wave_sum(ss);
        const float rstd = 1.0f / sqrtf(ss * (1.0f / D) + EPS);
        const int b = row >> 12; const float* mb = MOD + b * NMOD;
        float fl[8];
#pragma unroll
        for (int jj = 0; jj < 8; ++jj) fl[jj] = 0.f;
#pragma unroll
        for (int j = 0; j < 4; ++j) { const int col = 4 * F.lane + 256 * j;
            const f32x4 g = *(const f32x4*)(g1 + col), sh = *(const f32x4*)(mb + col), sc = *(const f32x4*)(mb + 1024 + col);
            const f32x4 hv = (v[j] * rstd) * g * (sc + 1.0f) + sh;
            u32x2 w; w.x = cvtpk(hv.x, hv.y); w.y = cvtpk(hv.z, hv.w);
            *(u32x2*)(H + (size_t)row * D + col) = w;
#pragma unroll
            for (int jj = 0; jj < 8; ++jj) { const f32x4 wv = *(const LAS f32x4*)(wfl + jj * 1024 + col); fl[jj] += (hv.x * wv.x + hv.y * wv.y) + (hv.z * wv.z + hv.w * wv.w); }
        }
        float mine = 0.f;
#pragma unroll
        for (int jj = 0; jj < 8; ++jj) { const float s = wave_sum(fl[jj]); if (F.lane == jj) mine = s; }
        if (F.lane < 8) { const float z = mine + b_forget[F.lane]; const float ls = fminf(z, 0.f) - log1pf(__expf(-fabsf(z))); LOGF[(size_t)row * 8 + F.lane] = ls; }
    }
}

constexpr int KP = 72;
constexpr int VPF = 68;
constexpr int VPS = 260;
struct FlashState { f32x16 o[2]; float m, l; };

__device__ __forceinline__ void flash_tail(FlashState& st, f32x16& s0, f32x16& s1, const LAS bf16* Vs, int vp, int r32, int hi) {
    float mt = s0[0];
#pragma unroll
    for (int r = 1; r < 16; ++r) mt = fmaxf(mt, s0[r]);
#pragma unroll
    for (int r = 0; r < 16; ++r) mt = fmaxf(mt, s1[r]);
    mt = fmaxf(mt, __shfl_xor(mt, 32));
    const float mn = fmaxf(st.m, mt);
    const float alpha = __expf(st.m - mn);
    st.m = mn;
    float ps = 0.f;
#pragma unroll
    for (int r = 0; r < 16; ++r) { s0[r] = __expf(s0[r] - mn); ps += s0[r]; }
#pragma unroll
    for (int r = 0; r < 16; ++r) { s1[r] = __expf(s1[r] - mn); ps += s1[r]; }
    st.l = st.l * alpha + ps;
#pragma unroll
    for (int r = 0; r < 16; ++r) { st.o[0][r] *= alpha; st.o[1][r] *= alpha; }
#pragma unroll
    for (int blk = 0; blk < 2; ++blk)
#pragma unroll
        for (int s = 0; s < 2; ++s) {
            v4u pw;
            if (blk == 0) { pw.x = cvtpk(s0[8 * s + 0], s0[8 * s + 1]); pw.y = cvtpk(s0[8 * s + 2], s0[8 * s + 3]); pw.z = cvtpk(s0[8 * s + 4], s0[8 * s + 5]); pw.w = cvtpk(s0[8 * s + 6], s0[8 * s + 7]); }
            else          { pw.x = cvtpk(s1[8 * s + 0], s1[8 * s + 1]); pw.y = cvtpk(s1[8 * s + 2], s1[8 * s + 3]); pw.z = cvtpk(s1[8 * s + 4], s1[8 * s + 5]); pw.w = cvtpk(s1[8 * s + 6], s1[8 * s + 7]); }
            const bf16x8 pf = __builtin_bit_cast(bf16x8, pw);
#pragma unroll
            for (int db = 0; db < 2; ++db) {
                const LAS bf16* vp0 = Vs + (32 * db + r32) * vp + 32 * blk + 16 * s + 4 * hi;
                const s16x4 lo = *(const LAS s16x4*)vp0, hh = *(const LAS s16x4*)(vp0 + 8);
                const bf16x8 vf = __builtin_shufflevector(lo, hh, 0, 1, 2, 3, 4, 5, 6, 7);
                st.o[db] = MFMA32(vf, pf, st.o[db]);
            }
        }
}
__device__ __forceinline__ void flash_qk(f32x16& s0, f32x16& s1, const bf16x8 (&qf)[4], const LAS bf16* Ks, int r32, int hi) {
    s0 = (f32x16){0.f}; s1 = (f32x16){0.f};
#pragma unroll
    for (int r = 0; r < 16; ++r) { s0[r] = 0.f; s1[r] = 0.f; }
#pragma unroll
    for (int ks = 0; ks < 4; ++ks) {
        const bf16x8 a0 = *(const LAS bf16x8*)(Ks + r32 * KP + 16 * ks + 8 * hi);
        const bf16x8 a1 = *(const LAS bf16x8*)(Ks + (32 + r32) * KP + 16 * ks + 8 * hi);
        s0 = MFMA32(a0, qf[ks], s0); s1 = MFMA32(a1, qf[ks], s1);
    }
}
__device__ __forceinline__ void flash_store(const FlashState& st, bf16* orow, int hi) {
    float lt = st.l + __shfl_xor(st.l, 32);
    const float inv = 1.0f / lt;
#pragma unroll
    for (int db = 0; db < 2; ++db)
#pragma unroll
        for (int rg = 0; rg < 4; ++rg) { u32x2 w; w.x = cvtpk(st.o[db][4 * rg] * inv, st.o[db][4 * rg + 1] * inv); w.y = cvtpk(st.o[db][4 * rg + 2] * inv, st.o[db][4 * rg + 3] * inv);
            *(u32x2*)(orow + 32 * db + 8 * rg + 4 * hi) = w; }
}

__device__ __forceinline__ void fox_unit(Frame& F, int b, int h, int qb) {
    const bf16* proj = (const bf16*)(F.ws + WS_PROJ); const float* LOGF = (const float*)(F.ws + WS_LOGF); bf16* OB = (bf16*)(F.ws + WS_OB);
    LAS float* Fs = (LAS float*)(F.lds);
    LAS float* wtot = (LAS float*)(F.lds + 16384);
    LAS bf16* Kb = (LAS bf16*)(F.lds + 16384 + 64);
    LAS bf16* Vb = (LAS bf16*)(F.lds + 16384 + 64 + 2 * 64 * KP * 2);
    const int lane = F.lane, wave = F.wave, tid = F.tid, r32 = lane & 31, hi = lane >> 5;
    const int q_end = 256 * (qb + 1), NT = q_end / 64;
    const size_t rowbase = (size_t)b * SEQ;
    {
        float v[8]; float run = 0.f;
#pragma unroll
        for (int i = 0; i < 8; ++i) { const int pos = tid * 8 + i; const float lf = (pos < q_end) ? LOGF[(rowbase + pos) * 8 + h] : 0.f; run += lf; v[i] = run; }
        float inc = run;
#pragma unroll
        for (int o = 1; o < 64; o <<= 1) { const float t = __shfl_up(inc, o); if (lane >= o) inc += t; }
        if (lane == 63) wtot[wave] = inc;
        __syncthreads();
        float off = inc - run;
        for (int w = 0; w < wave; ++w) off += wtot[w];
#pragma unroll
        for (int i = 0; i < 8; ++i) Fs[tid * 8 + i] = v[i] + off;
    }
    const int qrow = 256 * qb + 32 * wave + r32;
    bf16x8 qf[4];
    { const bf16* qp = proj + (rowbase + qrow) * NPROJ + C_QB + 64 * h + 8 * hi;
#pragma unroll
      for (int ks = 0; ks < 4; ++ks) qf[ks] = *(const bf16x8*)(qp + 16 * ks); }
    const int tq = 4 * qb + (wave >> 1);
    FlashState st; st.m = -INFINITY; st.l = 0.f;
#pragma unroll
    for (int r = 0; r < 16; ++r) { st.o[0][r] = 0.f; st.o[1][r] = 0.f; }
    const int srow = tid >> 3, sch = tid & 7;
    const bf16* kg = proj + (rowbase + srow) * NPROJ + C_KB + 64 * h + 8 * sch;
    const bf16* vg = proj + (rowbase + srow) * NPROJ + C_VB + 64 * h + 8 * sch;
    v4u kreg, vreg;
    { const size_t o = (size_t)(NT - 1) * 64 * NPROJ; kreg = *(const v4u*)(kg + o); vreg = *(const v4u*)(vg + o); }
    int cur = 0;
    {   *(LAS v4u*)(Kb + srow * KP + 8 * sch) = kreg;
        const unsigned short* vs = (const unsigned short*)&vreg;
#pragma unroll
        for (int i = 0; i < 8; ++i) Vb[(8 * sch + i) * VPF + srow] = vs[i];
    }
    __syncthreads();
    const float fq = Fs[qrow];
    for (int t = NT - 1; t >= 0; --t) {
        if (t > 0) { const size_t o = (size_t)(t - 1) * 64 * NPROJ; kreg = *(const v4u*)(kg + o); vreg = *(const v4u*)(vg + o); }
        if (t <= tq) {
            const LAS bf16* Ks = Kb + cur * 64 * KP; const LAS bf16* Vs = Vb + cur * 64 * VPF;
            f32x16 s0, s1; flash_qk(s0, s1, qf, Ks, r32, hi);
            const LAS float* Fk = Fs + 64 * t;
            const bool diag = (t == tq);
#pragma unroll
            for (int rg = 0; rg < 4; ++rg) {
                const f32x4 f0 = *(const LAS f32x4*)(Fk + 8 * rg + 4 * hi), f1 = *(const LAS f32x4*)(Fk + 32 + 8 * rg + 4 * hi);
#pragma unroll
                for (int i = 0; i < 4; ++i) { const int r = 4 * rg + i; const int kv = 64 * t + 8 * rg + 4 * hi + i;
                    float a = s0[r] * 0.125f + (fq - f0[i]); float c = s1[r] * 0.125f + (fq - f1[i]);
                    if (diag) { if (kv > qrow) a = -INFINITY; if (kv + 32 > qrow) c = -INFINITY; }
                    s0[r] = a; s1[r] = c; }
            }
            flash_tail(st, s0, s1, Vs, VPF, r32, hi);
        }
        if (t > 0) {
            const int nb = cur ^ 1;
            *(LAS v4u*)(Kb + nb * 64 * KP + srow * KP + 8 * sch) = kreg;
            const unsigned short* vs = (const unsigned short*)&vreg;
#pragma unroll
            for (int i = 0; i < 8; ++i) Vb[nb * 64 * VPF + (8 * sch + i) * VPF + srow] = vs[i];
        }
        __syncthreads();
        cur ^= 1;
    }
    flash_store(st, OB + (rowbase + qrow) * 512 + 64 * h, hi);
    __syncthreads();
}

__device__ const unsigned char T5_BUCKET[128] = {0,1,2,3,4,5,6,7,8,9,10,11,12,13,14,15,16,16,16,17,17,18,18,18,19,19,19,20,20,20,20,21,21,21,21,22,22,22,22,22,23,23,23,23,23,23,24,24,24,24,24,24,25,25,25,25,25,25,25,26,26,26,26,26,26,26,26,27,27,27,27,27,27,27,27,27,27,28,28,28,28,28,28,28,28,28,28,29,29,29,29,29,29,29,29,29,29,29,29,30,30,30,30,30,30,30,30,30,30,30,30,30,30,31,31,31,31,31,31,31,31,31,31,31,31,31,31,31};

__device__ __forceinline__ void swa_unit(Frame& F, int b, int kvh, int n) {
    const bf16* proj = (const bf16*)(F.ws + WS_PROJ); bf16* OA = (bf16*)(F.ws + WS_OA);
    const float* sinks = F.in[8]; const float* rel_bias = F.in[12];
    LAS bf16* Kb = (LAS bf16*)(F.lds);
    LAS bf16* Vb = (LAS bf16*)(F.lds + 36864);
    LAS float* bt = (LAS float*)(F.lds + 36864 + 33280);
    const int lane = F.lane, wave = F.wave, tid = F.tid, r32 = lane & 31, hi = lane >> 5;
    const size_t rowbase = (size_t)b * SEQ;
    {
        const int g = tid >> 7, d = tid & 127;
        bt[tid] = rel_bias[(int)T5_BUCKET[d] * 8 + kvh * 4 + g];
#pragma unroll
        for (int i = 0; i < 4; ++i) {
            const int idx = tid + i * NTHR, kb = idx >> 3, sch = idx & 7; const int pos = 128 * (n - 1) + kb;
            v4u kreg = (v4u){0u, 0u, 0u, 0u}, vreg = (v4u){0u, 0u, 0u, 0u};
            if (pos >= 0) { const bf16* p = proj + (rowbase + pos) * NPROJ + 64 * kvh + 8 * sch; kreg = *(const v4u*)(p + C_KA); vreg = *(const v4u*)(p + C_VA); }
            *(LAS v4u*)(Kb + kb * KP + 8 * sch) = kreg;
            const unsigned short* vs = (const unsigned short*)&vreg;
#pragma unroll
            for (int j = 0; j < 8; ++j) Vb[(8 * sch + j) * VPS + kb] = vs[j];
        }
    }
    __syncthreads();
    const int g = wave & 3, qh = wave >> 2, head = kvh * 4 + g;
    const LAS float* btg = bt + g * 128;
    for (int sb = 0; sb < 2; ++sb) {
        const int qrel0 = 64 * qh + 32 * sb, qrel = qrel0 + r32;
        const size_t row = rowbase + 128 * n + qrel;
        bf16x8 qf[4];
        { const bf16* qp = proj + row * NPROJ + C_QA + 64 * head + 8 * hi;
#pragma unroll
          for (int ks = 0; ks < 4; ++ks) qf[ks] = *(const bf16x8*)(qp + 16 * ks); }
        FlashState st; st.m = sinks[head]; st.l = (hi == 0) ? 1.0f : 0.0f;
#pragma unroll
        for (int r = 0; r < 16; ++r) { st.o[0][r] = 0.f; st.o[1][r] = 0.f; }
        const int t_lo = (qrel0 + 1) >> 6, t_hi = (qrel0 + 159) >> 6;
        for (int t = t_lo; t <= t_hi; ++t) {
            f32x16 s0, s1; flash_qk(s0, s1, qf, Kb + t * 64 * KP, r32, hi);
#pragma unroll
            for (int r = 0; r < 16; ++r) {
                const int kb0 = 64 * t + crow(r, hi), kb1 = kb0 + 32;
                const int d0 = 128 + qrel - kb0, d1 = d0 - 32;
                const bool v0 = (d0 >= 0) && (d0 < 128) && (n > 0 || kb0 >= 128);
                const bool v1 = (d1 >= 0) && (d1 < 128) && (n > 0 || kb1 >= 128);
                const float b0 = btg[d0 & 127], b1 = btg[d1 & 127];
                s0[r] = v0 ? (s0[r] * 0.125f + b0) : -INFINITY;
                s1[r] = v1 ? (s1[r] * 0.125f + b1) : -INFINITY;
            }
            flash_tail(st, s0, s1, Vb + 64 * t, VPS, r32, hi);
        }
        flash_store(st, OA + row * 512 + 64 * head, hi);
    }
    __syncthreads();
}
__device__ __forceinline__ void p3_attention(Frame& F) {
    for (int item = F.vcu; item < 256; item += F.G) {
        swa_unit(F, item >> 6, (item >> 5) & 1, item & 31);
        const int bh = item >> 3, j = item & 7;
        fox_unit(F, bh >> 3, bh & 7, 15 - j);
        fox_unit(F, bh >> 3, bh & 7, j);
    }
}

struct PairOrder {
    pg8::StaticOrder S;
    __device__ bool next(int i, pg8::Unit& u) const { if (!S.next(i >> 1, u)) return false; u.src = i & 1; return true; }
    __device__ __forceinline__ void a_ready(const pg8::Unit&) const {}
    __device__ __forceinline__ void done(const pg8::Unit&) const {}
};
__device__ __forceinline__ float sigmoidf_(float z) { return 1.0f / (1.0f + __expf(-z)); }
struct EpiGate {
    static constexpr bool PERM = false, AFTER_DRAIN = false;
    const bf16* proj; bf16* tmp; bf16* mixed;
    __device__ __forceinline__ void operator()(const pg8::f32x4 (&acc)[2][2][4][2], const pg8::Unit& u, int wr, int wc, int fr, int fq) const {
        const int goff = u.src ? C_GLB : C_GLA;
#pragma unroll
        for (int ai = 0; ai < 2; ++ai)
#pragma unroll
            for (int m = 0; m < 4; ++m) { const size_t row = (size_t)u.pm * 256 + ai * 128 + wr * 64 + m * 16 + fr;
#pragma unroll
                for (int bj = 0; bj < 2; ++bj)
#pragma unroll
                    for (int n = 0; n < 2; ++n) { const int col = u.pn * 256 + bj * 128 + wc * 32 + n * 16 + 4 * fq;
                        const u32x2 gw = *(const u32x2*)(proj + row * NPROJ + goff + col);
                        const pg8::f32x4 a = acc[ai][bj][m][n];
                        float v0 = a[0] * sigmoidf_(bflo(gw.x)), v1 = a[1] * sigmoidf_(bfhi(gw.x)), v2 = a[2] * sigmoidf_(bflo(gw.y)), v3 = a[3] * sigmoidf_(bfhi(gw.y));
                        if (u.src == 0) { u32x2 w; w.x = cvtpk(v0, v1); w.y = cvtpk(v2, v3); *(u32x2*)(tmp + row * D + col) = w; }
                        else { const u32x2 t = *(const u32x2*)(tmp + row * D + col);
                            u32x2 w; w.x = cvtpk(v0 + bflo(t.x), v1 + bfhi(t.x)); w.y = cvtpk(v2 + bflo(t.y), v3 + bfhi(t.y)); *(u32x2*)(mixed + row * D + col) = w; }
                    }
            }
    }
};
struct EpiRes {
    static constexpr bool PERM = false, AFTER_DRAIN = false;
    const float* x; const float* mod; float* x1;
    __device__ __forceinline__ void operator()(const pg8::f32x4 (&acc)[2][2][4][2], const pg8::Unit& u, int wr, int wc, int fr, int fq) const {
#pragma unroll
        for (int ai = 0; ai < 2; ++ai)
#pragma unroll
            for (int m = 0; m < 4; ++m) { const size_t row = (size_t)u.pm * 256 + ai * 128 + wr * 64 + m * 16 + fr; const int b = (int)(row >> 12);
#pragma unroll
                for (int bj = 0; bj < 2; ++bj)
#pragma unroll
                    for (int n = 0; n < 2; ++n) { const int col = u.pn * 256 + bj * 128 + wc * 32 + n * 16 + 4 * fq;
                        const pg8::f32x4 xin = *(const pg8::f32x4*)(x + row * D + col), gt = *(const pg8::f32x4*)(mod + b * NMOD + 2048 + col);
                        *(pg8::f32x4*)(x1 + row * D + col) = xin + gt * acc[ai][bj][m][n]; }
            }
    }
};

__device__ __forceinline__ void p6_norm2(Frame& F) {
    const float* x1 = (const float*)(F.ws + WS_X1); const float* g2 = F.in[3]; const float* MOD = (const float*)(F.ws + WS_MOD); bf16* H2 = (bf16*)(F.ws + WS_H2); unsigned char* H2Q = (unsigned char*)(F.ws + WS_H2Q); float* H2S = (float*)(F.ws + WS_H2S);
    const int gw = F.vcu * NWAVES + F.wave, NGW = F.G * NWAVES;
    for (int row = gw; row < M; row += NGW) {
        const f32x4* xr = (const f32x4*)(x1 + (size_t)row * D) + F.lane;
        f32x4 v[4], hq[4]; float ss = 0.f;
#pragma unroll
        for (int j = 0; j < 4; ++j) { v[j] = xr[64 * j]; ss += (v[j].x * v[j].x + v[j].y * v[j].y) + (v[j].z * v[j].z + v[j].w * v[j].w); }
        ss = wave_sum(ss);
        const float rstd = 1.0f / sqrtf(ss * (1.0f / D) + EPS);
        const int b = row >> 12; const float* mb = MOD + b * NMOD;
#pragma unroll
        for (int j = 0; j < 4; ++j) { const int col = 4 * F.lane + 256 * j;
            const f32x4 g = *(const f32x4*)(g2 + col), sh = *(const f32x4*)(mb + 3072 + col), sc = *(const f32x4*)(mb + 4096 + col);
            const f32x4 hv = (v[j] * rstd) * g * (sc + 1.0f) + sh;
            u32x2 w; w.x = cvtpk(hv.x, hv.y); w.y = cvtpk(hv.z, hv.w);
            *(u32x2*)(H2 + (size_t)row * D + col) = w; hq[j] = hv; }
        float am = 0.f;
#pragma unroll
        for (int j = 0; j < 4; ++j) am = fmaxf(fmaxf(am, fmaxf(fabsf(hq[j].x), fabsf(hq[j].y))), fmaxf(fabsf(hq[j].z), fabsf(hq[j].w)));
#pragma unroll
        for (int o = 1; o < 64; o <<= 1) am = fmaxf(am, __shfl_xor(am, o));
        const float sc = am > 0.f ? am * (1.0f / 127.0f) : 1.0f, inv = 1.0f / sc;
        v4u qa;
#pragma unroll
        for (int j = 0; j < 4; ++j) { const int b0 = (int)rintf(hq[j].x * inv), b1 = (int)rintf(hq[j].y * inv), b2 = (int)rintf(hq[j].z * inv), b3 = (int)rintf(hq[j].w * inv);
            qa[j] = (unsigned)(b0 & 255) | ((unsigned)(b1 & 255) << 8) | ((unsigned)(b2 & 255) << 16) | ((unsigned)(b3 & 255) << 24); }
        *(v4u*)(H2Q + (size_t)row * D + 16 * F.lane) = qa;
        if (F.lane == 0) H2S[row] = sc;
    }
}

__device__ __forceinline__ unsigned f2ord(float f) { const unsigned u = __float_as_uint(f); return u ^ ((unsigned)((int)u >> 31) | 0x80000000u); }
__device__ __forceinline__ float ord2f(unsigned o) { const unsigned u = (o & 0x80000000u) ? (o & 0x7fffffffu) : ~o; return __uint_as_float(u); }
#define CE_DESC(a, b) do { const unsigned _x = (a), _y = (b); (a) = _x > _y ? _x : _y; (b) = _x > _y ? _y : _x; } while (0)
__device__ __forceinline__ void sort16(unsigned (&k)[16]) {
#pragma unroll
    for (int size = 2; size <= 16; size <<= 1)
#pragma unroll
        for (int stride = size >> 1; stride > 0; stride >>= 1)
#pragma unroll
            for (int i = 0; i < 16; ++i) { const int j = i ^ stride; if (j > i) { if ((i & size) == 0) CE_DESC(k[i], k[j]); else CE_DESC(k[j], k[i]); } }
}
__device__ __forceinline__ void merge16(unsigned (&a)[16], const unsigned (&b)[16]) {
#pragma unroll
    for (int i = 0; i < 16; ++i) a[i] = a[i] > b[15 - i] ? a[i] : b[15 - i];
#pragma unroll
    for (int stride = 8; stride > 0; stride >>= 1)
#pragma unroll
        for (int i = 0; i < 16; ++i) { const int j = i ^ stride; if (j > i) CE_DESC(a[i], a[j]); }
}
__device__ __forceinline__ void top16_of_64(unsigned (&g0)[16], unsigned (&g1)[16], unsigned (&g2)[16], unsigned (&g3)[16]) {
    sort16(g0); sort16(g1); sort16(g2); sort16(g3);
    merge16(g0, g1); merge16(g2, g3); merge16(g0, g2);
}
constexpr int NCAND = 50;
__device__ __forceinline__ void p8a_topk(Frame& F) {
    const bf16* QP = (const bf16*)(F.ws + WS_QP); const bf16* SUBK = (const bf16*)(F.ws + WS_SUBK);
    unsigned short* PIDX = (unsigned short*)(F.ws + WS_PIDX); float* PG = (float*)(F.ws + WS_PG);
    LAS unsigned short* Elds = (LAS unsigned short*)(F.lds) + F.wave * (NCAND * 64);
    const int lane = F.lane, r32 = lane & 31, hi = lane >> 5;
    const int gw = F.vcu * NWAVES + F.wave, NGW = F.G * NWAVES;
    for (int item = gw; item < (M / 32) * 8; item += NGW) {
        const int tile = item >> 3;
        const int tok = tile * 32 + r32;
        { const int h = item & 7;
            unsigned top[2][16];
#pragma unroll
            for (int p = 0; p < 2; ++p) {
                bf16x8 qf[4];
                { const bf16* qp = QP + (size_t)tok * D + h * 128 + p * 64 + 8 * hi;
#pragma unroll
                  for (int ks = 0; ks < 4; ++ks) qf[ks] = *(const bf16x8*)(qp + 16 * ks); }
                const bf16* kp = SUBK + (size_t)((h * 2 + p) * 128 + r32) * 64 + 8 * hi;
                unsigned kk[4][16];
#pragma unroll
                for (int blk = 0; blk < 4; ++blk) {
                    f32x16 acc;
#pragma unroll
                    for (int r = 0; r < 16; ++r) acc[r] = 0.f;
#pragma unroll
                    for (int ks = 0; ks < 4; ++ks) { const bf16x8 a = *(const bf16x8*)(kp + (size_t)blk * 32 * 64 + 16 * ks); acc = MFMA32(a, qf[ks], acc); }
#pragma unroll
                    for (int r = 0; r < 16; ++r) { const int key = 32 * blk + crow(r, hi); kk[blk][r] = (f2ord(acc[r]) & ~127u) | (unsigned)(127 - key); }
                }
                top16_of_64(kk[0], kk[1], kk[2], kk[3]);
                unsigned other[16];
#pragma unroll
                for (int i = 0; i < 16; ++i) other[i] = (unsigned)__shfl_xor((int)kk[0][i], 32);
                merge16(kk[0], other);
#pragma unroll
                for (int i = 0; i < 16; ++i) top[p][i] = kk[0][i];
            }
            float s1[16], s2[16]; unsigned i1[16], i2[16];
#pragma unroll
            for (int i = 0; i < 16; ++i) { s1[i] = ord2f(top[0][i] & ~127u); i1[i] = 127u - (top[0][i] & 127u); s2[i] = ord2f(top[1][i] & ~127u); i2[i] = 127u - (top[1][i] & 127u); }
            unsigned ck[4][16];
#pragma unroll
            for (int c = 0; c < 64; ++c) {
                if (c < NCAND) { constexpr int CA[NCAND] = {0,0,0,0,0,0,0,0,0,0,0,0,0,0,0,0,1,1,1,1,1,1,1,1,2,2,2,2,2,3,3,3,3,4,4,4,5,5,6,6,7,7,8,9,10,11,12,13,14,15}; constexpr int CB[NCAND] = {0,1,2,3,4,5,6,7,8,9,10,11,12,13,14,15,0,1,2,3,4,5,6,7,0,1,2,3,4,0,1,2,3,0,1,2,0,1,0,1,0,1,0,0,0,0,0,0,0,0}; const int a = CA[c], b = CB[c];
                    ck[c >> 4][c & 15] = (f2ord(s1[a] + s2[b]) & ~63u) | (unsigned)(63 - c);
                    Elds[c * 64 + lane] = (unsigned short)(i1[a] * 128u + i2[b]); }
                else ck[c >> 4][c & 15] = 0u;
            }
            top16_of_64(ck[0], ck[1], ck[2], ck[3]);
            float w[16]; float wsum = 0.f; const float v0 = ord2f(ck[0][0] & ~63u);
#pragma unroll
            for (int r = 0; r < 16; ++r) { w[r] = __expf(ord2f(ck[0][r] & ~63u) - v0); wsum += w[r]; }
            const float winv = 1.0f / wsum;
#pragma unroll
            for (int r = 0; r < 16; ++r) if ((r >> 3) == hi) {
                const int c = 63 - (int)(ck[0][r] & 63u);
                const unsigned short eid = Elds[c * 64 + lane];
                PIDX[(size_t)tok * 128 + h * 16 + r] = eid; PG[(size_t)tok * 128 + h * 16 + r] = w[r] * winv; }
        }
    }
}

__device__ __forceinline__ float gelu_erf(float v) { return 0.5f * v * (1.0f + erff(v * 0.70710678118654752f)); }

#define PROBE_REPA 1
#define PROBE_REPB 1
constexpr int NR = 16, RSH = 17, BSA = 8, BSB = 6;
__device__ __forceinline__ void sort128(unsigned& e0, unsigned& e1, int lane) {
#pragma unroll
    for (int size = 2; size <= 128; size <<= 1) {
#pragma unroll
        for (int stride = size >> 1; stride > 0; stride >>= 1) {
            if (stride == 64) { const unsigned lo = e0 < e1 ? e0 : e1, hi = e0 < e1 ? e1 : e0; e0 = lo; e1 = hi; }
            else {
                const bool lower = (lane & stride) == 0;
                const bool asc0 = (size == 128) ? true : (size == 64 ? true : ((lane & size) == 0));
                const bool asc1 = (size == 128) ? true : (size == 64 ? false : ((lane & size) == 0));
                const unsigned p0 = (unsigned)__shfl_xor((int)e0, stride), p1 = (unsigned)__shfl_xor((int)e1, stride);
                const unsigned mn0 = e0 < p0 ? e0 : p0, mx0 = e0 < p0 ? p0 : e0, mn1 = e1 < p1 ? e1 : p1, mx1 = e1 < p1 ? p1 : e1;
                e0 = (lower == asc0) ? mn0 : mx0; e1 = (lower == asc1) ? mn1 : mx1;
            }
        }
    }
}
__device__ __forceinline__ void p8b_sweep(Frame& F) {
    const float* X1 = (const float*)(F.ws + WS_X1); const float* MOD = (const float*)(F.ws + WS_MOD);
    const unsigned char* H2Q = (const unsigned char*)(F.ws + WS_H2Q); const float* H2S = (const float*)(F.ws + WS_H2S);
    const unsigned char* EDq = (const unsigned char*)(F.ws + WS_ED); const unsigned char* EUq = (const unsigned char*)(F.ws + WS_EU); const float* EDS = (const float*)(F.ws + WS_EDS);
    const unsigned short* PIDX = (const unsigned short*)(F.ws + WS_PIDX); const float* PG = (const float*)(F.ws + WS_PG);
    const float* fg = F.in[17];
    const int lane = F.lane;
    const int gw = F.vcu * NWAVES + F.wave, NGW = F.G * NWAVES;
    for (int tb = gw; tb < M / 8; tb += NGW) {
        const int tok0 = tb * 8;
        unsigned E0[8], E1[8]; float W0[8], W1[8];
#pragma unroll
        for (int k = 0; k < 8; ++k) {
            const size_t base = (size_t)(tok0 + k) * 128;
            E0[k] = ((unsigned)PIDX[base + lane] << 7) | (unsigned)lane; E1[k] = ((unsigned)PIDX[base + 64 + lane] << 7) | (unsigned)(64 + lane);
            sort128(E0[k], E1[k], lane); W0[k] = 0.f; W1[k] = 0.f;
        }
        for (int repa = 0; repa < PROBE_REPA; ++repa) {
            v4u hq[8];
#pragma unroll
            for (int k = 0; k < 8; ++k) hq[k] = *(const v4u*)(H2Q + (size_t)(tok0 + k) * D + 16 * lane);
            int pos[8];
#pragma unroll
            for (int k = 0; k < 8; ++k) pos[k] = 0;
            for (int r = 0; r < NR; ++r) {
#pragma unroll
                for (int k = 0; k < 8; ++k) {
                    const int c = __builtin_popcountll(__ballot((E0[k] >> RSH) == (unsigned)r)) + __builtin_popcountll(__ballot((E1[k] >> RSH) == (unsigned)r));
                    int s = __builtin_amdgcn_readfirstlane(pos[k]); const int e_end = __builtin_amdgcn_readfirstlane(s + c); pos[k] = e_end;
                    const int hx = (int)hq[k].x, hy = (int)hq[k].y, hz = (int)hq[k].z, hw = (int)hq[k].w;
                    for (; s < e_end; s += BSA) {
                        const int n = (e_end - s) < BSA ? (e_end - s) : BSA;
                        v4u d[BSA];
#pragma unroll
                        for (int i = 0; i < BSA; ++i) d[i] = (v4u){0u, 0u, 0u, 0u};
#pragma unroll
                        for (int i = 0; i < BSA; ++i) if (i < n) { const int P = s + i;
                            const unsigned ka = (unsigned)__builtin_amdgcn_readlane((int)E0[k], P & 63), kb = (unsigned)__builtin_amdgcn_readlane((int)E1[k], P & 63);
                            const unsigned eid = (P < 64 ? ka : kb) >> 7;
                            d[i] = *(const v4u*)(EDq + (size_t)eid * D + 16 * lane); }
                        float dd[8];
#pragma unroll
                        for (int i = 0; i < 8; ++i) dd[i] = 0.f;
#pragma unroll
                        for (int i = 0; i < BSA; ++i) if (i < n) { const int dx = (int)d[i].x, dy = (int)d[i].y, dz = (int)d[i].z, dw = (int)d[i].w;
                            int t = __builtin_amdgcn_sdot4(hx, dx, 0, false); t = __builtin_amdgcn_sdot4(hy, dy, t, false); t = __builtin_amdgcn_sdot4(hz, dz, t, false); t = __builtin_amdgcn_sdot4(hw, dw, t, false);
                            dd[i] = (float)t; }
                        const bool b5 = (lane & 32) != 0, b4 = (lane & 16) != 0, b3 = (lane & 8) != 0;
                        float r4[4];
#pragma unroll
                        for (int u = 0; u < 4; ++u) { const float keep = b5 ? dd[u + 4] : dd[u], send = b5 ? dd[u] : dd[u + 4]; r4[u] = keep + __shfl_xor(send, 32); }
                        float r2[2];
#pragma unroll
                        for (int u = 0; u < 2; ++u) { const float keep = b4 ? r4[u + 2] : r4[u], send = b4 ? r4[u] : r4[u + 2]; r2[u] = keep + __shfl_xor(send, 16); }
                        float r1; { const float keep = b3 ? r2[1] : r2[0], send = b3 ? r2[0] : r2[1]; r1 = keep + __shfl_xor(send, 8); }
                        r1 += __shfl_xor(r1, 4); r1 += __shfl_xor(r1, 2); r1 += __shfl_xor(r1, 1);
                        const int i0 = lane - s, i1 = lane + 64 - s;
                        const float v0 = __shfl(r1, 8 * (i0 & 7)), v1 = __shfl(r1, 8 * (i1 & 7));
                        if ((unsigned)i0 < (unsigned)n) W0[k] = v0;
                        if ((unsigned)i1 < (unsigned)n) W1[k] = v1;
                    }
                }
            }
        }
#pragma unroll
        for (int k = 0; k < 8; ++k) { const size_t base = (size_t)(tok0 + k) * 128; const float sh = H2S[tok0 + k];
            W0[k] = PG[base + (E0[k] & 127u)] * gelu_erf(W0[k] * sh * EDS[E0[k] >> 7]) * 0.0625f; W1[k] = PG[base + (E1[k] & 127u)] * gelu_erf(W1[k] * sh * EDS[E1[k] >> 7]) * 0.0625f; }
        float acc[8][16];
        for (int repb = 0; repb < PROBE_REPB; ++repb) {
#pragma unroll
            for (int k = 0; k < 8; ++k)
#pragma unroll
                for (int i = 0; i < 16; ++i) acc[k][i] = 0.f;
            int pos[8];
#pragma unroll
            for (int k = 0; k < 8; ++k) pos[k] = 0;
            for (int r = 0; r < NR; ++r) {
#pragma unroll
                for (int k = 0; k < 8; ++k) {
                    const int c = __builtin_popcountll(__ballot((E0[k] >> RSH) == (unsigned)r)) + __builtin_popcountll(__ballot((E1[k] >> RSH) == (unsigned)r));
                    int s = __builtin_amdgcn_readfirstlane(pos[k]); const int e_end = __builtin_amdgcn_readfirstlane(s + c); pos[k] = e_end;
                    for (; s < e_end; s += BSB) {
                        const int n = (e_end - s) < BSB ? (e_end - s) : BSB;
                        v4u u[BSB]; float w[BSB];
#pragma unroll
                        for (int i = 0; i < BSB; ++i) { u[i] = (v4u){0u, 0u, 0u, 0u}; w[i] = 0.f; }
#pragma unroll
                        for (int i = 0; i < BSB; ++i) if (i < n) { const int P = s + i;
                            const unsigned ka = (unsigned)__builtin_amdgcn_readlane((int)E0[k], P & 63), kb = (unsigned)__builtin_amdgcn_readlane((int)E1[k], P & 63);
                            const unsigned wa = (unsigned)__builtin_amdgcn_readlane((int)__float_as_uint(W0[k]), P & 63), wb = (unsigned)__builtin_amdgcn_readlane((int)__float_as_uint(W1[k]), P & 63);
                            const unsigned eid = (P < 64 ? ka : kb) >> 7; w[i] = __uint_as_float(P < 64 ? wa : wb);
                            u[i] = *(const v4u*)(EUq + (size_t)eid * D + 16 * lane); }
#pragma unroll
                        for (int i = 0; i < BSB; ++i) if (i < n) {
                            const unsigned ux = u[i].x, uy = u[i].y, uz = u[i].z, uw = u[i].w;
                            const f32x2_t a0 = __builtin_amdgcn_cvt_pk_f32_fp8((int)ux, false), a1 = __builtin_amdgcn_cvt_pk_f32_fp8((int)ux, true);
                            const f32x2_t b0 = __builtin_amdgcn_cvt_pk_f32_fp8((int)uy, false), b1 = __builtin_amdgcn_cvt_pk_f32_fp8((int)uy, true);
                            const f32x2_t c0 = __builtin_amdgcn_cvt_pk_f32_fp8((int)uz, false), c1 = __builtin_amdgcn_cvt_pk_f32_fp8((int)uz, true);
                            const f32x2_t d0 = __builtin_amdgcn_cvt_pk_f32_fp8((int)uw, false), d1 = __builtin_amdgcn_cvt_pk_f32_fp8((int)uw, true);
                            acc[k][0] += w[i] * a0.x; acc[k][1] += w[i] * a0.y; acc[k][2] += w[i] * a1.x; acc[k][3] += w[i] * a1.y;
                            acc[k][4] += w[i] * b0.x; acc[k][5] += w[i] * b0.y; acc[k][6] += w[i] * b1.x; acc[k][7] += w[i] * b1.y;
                            acc[k][8] += w[i] * c0.x; acc[k][9] += w[i] * c0.y; acc[k][10] += w[i] * c1.x; acc[k][11] += w[i] * c1.y;
                            acc[k][12] += w[i] * d0.x; acc[k][13] += w[i] * d0.y; acc[k][14] += w[i] * d1.x; acc[k][15] += w[i] * d1.y;
                        }
                    }
                }
            }
        }
#pragma unroll
        for (int k = 0; k < 8; ++k) {
            const int tok = tok0 + k; const int b = tok >> 12; const float* gt2 = MOD + b * NMOD + 5120;
            f32x4 x2[4]; float ss = 0.f;
#pragma unroll
            for (int j = 0; j < 4; ++j) { const int col = 4 * lane + 256 * j;
                const f32x4 xv = *(const f32x4*)(X1 + (size_t)tok * D + col), gv4 = *(const f32x4*)(gt2 + col);
#pragma unroll
                for (int i = 0; i < 4; ++i) { const float v = xv[i] + gv4[i] * acc[k][4 * j + i]; x2[j][i] = v; ss += v * v; } }
            ss = wave_sum(ss);
            const float rstd = 1.0f / sqrtf(ss * (1.0f / D) + EPS);
#pragma unroll
            for (int j = 0; j < 4; ++j) { const int col = 4 * lane + 256 * j; const f32x4 gg = *(const f32x4*)(fg + col);
                *(f32x4*)(F.out + (size_t)tok * D + col) = x2[j] * rstd * gg; }
        }
    }
}

struct Args { const float* in[18]; float* out; unsigned char* ws; };
__global__ void __launch_bounds__(NTHR, 2) mega_fwd(Args args) {
    extern __shared__ __attribute__((aligned(16))) unsigned char lds[];
    Frame F;
    F.lds = (LAS unsigned char*)lds;
    F.tid = threadIdx.x; F.lane = F.tid & 63; F.wave = __builtin_amdgcn_readfirstlane(F.tid >> 6);
    F.G = gridDim.x; { const int bx = blockIdx.x; F.vcu = (F.G % 8 == 0) ? (bx % 8) * (F.G / 8) + bx / 8 : bx; }
#pragma unroll
    for (int i = 0; i < 18; ++i) F.in[i] = args.in[i];
    F.out = args.out; F.ws = args.ws;
    volatile LAS unsigned* MISC = (volatile LAS unsigned*)(F.lds + MISC_OFF);
    for (int u = F.tid; u < (LDS_BYTES - LDSCTL_OFF) / 4; u += NTHR) ((LAS unsigned*)(F.lds + LDSCTL_OFF))[u] = 0u;
    __syncthreads();
    gu32* ctl = (gu32*)(F.ws + WS_CTL);
    XcdBarrier bar = xcd_barrier_post((unsigned*)(ctl + CW_BAR), MISC + 8);
#define GRID_BAR() xcd_barrier(bar)
#define PROBE_DBL -1

    p0_prologue(F); GRID_BAR();
    if (PROBE_DBL == 0) { p0_prologue(F); GRID_BAR(); }
    p1_norm(F); GRID_BAR();
    if (PROBE_DBL == 1) { p1_norm(F); GRID_BAR(); }
    {
        pg8::Gemm g{(const pg8::bf16_t*)(F.ws + WS_H), (const pg8::bf16_t*)(F.ws + WS_WIN), M, NPROJ, D, nullptr, nullptr};
        pg8::StaticOrder S; S.init(M, NPROJ, F.G, (int)blockIdx.x);
        pg8::EpiBf16<0> E{(pg8::bf16_t*)(F.ws + WS_PROJ), NPROJ, nullptr, 0, 0, 1.f};
        pg8::gemm_phase<pg8::EpiBf16<0>, pg8::StaticOrder, true, true>(F.lds + RING_OFF, g, S, E);
    }
    GRID_BAR();
    p3_attention(F); GRID_BAR();
    if (PROBE_DBL == 3) { p3_attention(F); GRID_BAR(); }
    {
        pg8::Gemm g{(const pg8::bf16_t*)(F.ws + WS_OA), (const pg8::bf16_t*)(F.ws + WS_WA), M, D, 512, (const pg8::bf16_t*)(F.ws + WS_OB), (const pg8::bf16_t*)(F.ws + WS_WB)};
        PairOrder S; S.S.init(M, D, F.G, (int)blockIdx.x);
        EpiGate E{(const bf16*)(F.ws + WS_PROJ), (bf16*)F.out, (bf16*)F.out + (size_t)M * D};
        pg8::gemm_phase<EpiGate, PairOrder, false, true>(F.lds + RING_OFF, g, S, E);
    }
    GRID_BAR();
    {
        pg8::Gemm g{(const pg8::bf16_t*)((bf16*)F.out + (size_t)M * D), (const pg8::bf16_t*)(F.ws + WS_WOUT), M, D, D, nullptr, nullptr};
        pg8::StaticOrder S; S.init(M, D, F.G, (int)blockIdx.x);
        EpiRes E{F.in[0], (const float*)(F.ws + WS_MOD), (float*)(F.ws + WS_X1)};
        pg8::gemm_phase<EpiRes, pg8::StaticOrder, false, true>(F.lds + RING_OFF, g, S, E);
    }
    GRID_BAR();
    p6_norm2(F); GRID_BAR();
    if (PROBE_DBL == 6) { p6_norm2(F); GRID_BAR(); }
    {
        pg8::Gemm g{(const pg8::bf16_t*)(F.ws + WS_H2), (const pg8::bf16_t*)(F.ws + WS_WQ), M, D, D, nullptr, nullptr};
        pg8::StaticOrder S; S.init(M, D, F.G, (int)blockIdx.x);
        pg8::EpiBf16<0> E{(pg8::bf16_t*)(F.ws + WS_QP), D, nullptr, 0, 0, 1.f};
        pg8::gemm_phase<pg8::EpiBf16<0>, pg8::StaticOrder, false, true>(F.lds + RING_OFF, g, S, E);
    }
    GRID_BAR();
    p8a_topk(F); GRID_BAR();
    if (PROBE_DBL == 8) { p8a_topk(F); GRID_BAR(); }
    p8b_sweep(F);
    if (PROBE_DBL == 9) { GRID_BAR(); p8b_sweep(F); }
}

extern "C" void kernel_launch(void* const* d_in, const int* in_sizes, int n_in, void* d_out, int out_size, void* d_ws, size_t ws_size, hipStream_t stream) {
    static int grid = 0;
    if (grid == 0) {
        if (n_in != 18 || in_sizes[0] != M * D || out_size != M * D || ws_size < WS_END) { fprintf(stderr, "kernel_launch: unexpected shapes (n_in %d, in0 %d, out %d, ws %zu)\n", n_in, n_in > 0 ? in_sizes[0] : -1, out_size, ws_size); grid = -1; return; }
        int dev = 0, cus = 0, per_cu = 0;
        if (hipGetDevice(&dev) != hipSuccess || hipDeviceGetAttribute(&cus, hipDeviceAttributeMultiprocessorCount, dev) != hipSuccess) { grid = -1; return; }
        if (hipFuncSetAttribute((const void*)mega_fwd, hipFuncAttributeMaxDynamicSharedMemorySize, LDS_BYTES) != hipSuccess) { fprintf(stderr, "kernel_launch: hipFuncSetAttribute failed\n"); grid = -1; return; }
        if (hipOccupancyMaxActiveBlocksPerMultiprocessor(&per_cu, (const void*)mega_fwd, NTHR, LDS_BYTES) != hipSuccess || per_cu < 1) { fprintf(stderr, "kernel_launch: occupancy query says %d blocks per CU\n", per_cu); }
        (void)hipGetLastError();
        grid = cus;
    }
    if (grid < 0) return;
    if (hipMemsetAsync((char*)d_ws + WS_CTL, 0, CTL_ZERO_BYTES, stream) != hipSuccess) { fprintf(stderr, "kernel_launch: memset failed\n"); return; }
    Args a{};
    for (int i = 0; i < 18; ++i) a.in[i] = (const float*)d_in[i];
    a.out = (float*)d_out; a.ws = (unsigned char*)d_ws;
    hipLaunchKernelGGL(mega_fwd, dim3(grid), dim3(NTHR), LDS_BYTES, stream, a);
}
```

```cpp
#include <hip/hip_runtime.h>
#include <cstdio>
#include <cstdint>
namespace pg8 {
#define PG8_LAS __attribute__((address_space(3)))
typedef unsigned short bf16_t;
typedef short bf16x8 __attribute__((ext_vector_type(8)));
typedef float f32x4 __attribute__((ext_vector_type(4)));
typedef unsigned u32x4 __attribute__((ext_vector_type(4)));
constexpr int BM = 256, BK = 64, HALF = 128, HTB = HALF * BK * 2  , STAGE_BYTES = 8 * HTB, NXCD = 8, WGM = 8;

__host__ __device__ __forceinline__ int lds_byte(int r, int c) { const int st = (r >> 4) * 2 + (c >> 5), rr = r & 15, cc = c & 31, ob = rr * 64 + cc * 2; return st * 1024 + (ob ^ (((ob >> 9) & 1) << 5)); }
__host__ __device__ __forceinline__ void stage_rc(int b, int& R, int& C) { const int st = b / 1024, sb = b % 1024, swz = sb ^ (((sb >> 9) & 1) << 5); R = (st >> 1) * 16 + swz / 64; C = (st & 1) * 32 + (swz % 64) / 2; }
__host__ __device__ __forceinline__ int perm32(int rho) { const int n = rho >> 4, i = rho & 15; return 8 * (i >> 2) + 4 * n + (i & 3); }

struct Unit { int pm, pn, src; };
struct Gemm { const bf16_t* A; const bf16_t* Bt; int M, N, K; const bf16_t* A2; const bf16_t* Bt2; };

struct StaticOrder {
    int nM, nN, nwg, G, c;
    __host__ __device__ void init(int M, int N, int G_, int c_) { nM = M / BM; nN = N / BM; nwg = nM * nN; G = G_; c = c_; }
    __host__ __device__ bool next(int i, Unit& u) const {
        const long L = (long)i * G + c; if (L >= nwg) return false;
        int wgid = (int)L; { const int q = nwg / NXCD, r = nwg % NXCD, xcd = wgid % NXCD, off = wgid / NXCD; wgid = (xcd < r ? xcd * (q + 1) : r * (q + 1) + (xcd - r) * q) + off; }
        const int nig = WGM * nN, gid = wgid / nig, fm = gid * WGM, gsz = (nM - fm) < WGM ? (nM - fm) : WGM;
        u.pm = fm + ((wgid % nig) % gsz); u.pn = (wgid % nig) / gsz; u.src = 0; return true;
    }
    __device__ __forceinline__ void a_ready(const Unit&) const {}
    __device__ __forceinline__ void done(const Unit&) const {}
};

__device__ __forceinline__ unsigned cvt_pk_bf16(float lo, float hi) { unsigned r; asm volatile("v_cvt_pk_bf16_f32 %0, %1, %2" : "=v"(r) : "v"(lo), "v"(hi)); return r; }
typedef float f32x2 __attribute__((ext_vector_type(2)));
__device__ __forceinline__ f32x2 gelu_pk(f32x2 v) {
    const f32x2 av = __builtin_elementwise_abs(v), d = av * 0.2316418882f + 1.0f;
    f32x2 t; t.x = __builtin_amdgcn_rcpf(d.x); t.y = __builtin_amdgcn_rcpf(d.y);
    f32x2 q = t * 0.5307027145f + (-0.7265760135f); q = q * t + 0.7107068705f; q = q * t + (-0.142248368f); q = q * t + 0.127414796f; q = q * t;
    const f32x2 s = (v * v) * (-0.72134752044f);
    f32x2 e; e.x = __builtin_amdgcn_exp2f(s.x); e.y = __builtin_amdgcn_exp2f(s.y);
    const f32x2 m = v * (q * e), r = v - m;
    f32x2 o; o.x = v.x < 0.f ? m.x : r.x; o.y = v.y < 0.f ? m.y : r.y; return o;
}

template <int ACT  > struct EpiBf16 {
    static constexpr bool PERM = true, AFTER_DRAIN = false; static_assert(ACT == 0 || ACT == 1, "EpiBf16: ACT is 0 (none) or 1 (gelu_pk)");
    bf16_t* O; int ldc; const float* bias; int split_cols; size_t split_stride; float scale0;
    __device__ __forceinline__ void operator()(const f32x4 (&acc)[2][2][4][2], const Unit& u, int wr, int wc, int fr, int fq) const {
        const int row0 = u.pm * BM + wr * 64 + fr; int colt = u.pn * BM; bf16_t* base = O;
        float sc = 1.f; if (split_cols) { const int t = colt / split_cols; base += (size_t)t * split_stride; colt -= t * split_cols; if (t == 0) sc = scale0; }
        const int col0 = colt + wc * 32 + 8 * fq, bcol0 = u.pn * BM + wc * 32 + 8 * fq;
        f32x4 bv[2][2];
#pragma unroll
        for (int bj = 0; bj < 2; ++bj)
#pragma unroll
            for (int n = 0; n < 2; ++n) bv[bj][n] = bias ? *(const f32x4*)(bias + bcol0 + bj * HALF + 4 * n) : (f32x4){0.f, 0.f, 0.f, 0.f};
#pragma unroll
        for (int ai = 0; ai < 2; ++ai)
#pragma unroll
            for (int m = 0; m < 4; ++m) { bf16_t* rowp = base + (size_t)(row0 + ai * HALF + m * 16) * ldc + col0;
#pragma unroll
                for (int bj = 0; bj < 2; ++bj) { f32x4 v0 = acc[ai][bj][m][0] + bv[bj][0], v1 = acc[ai][bj][m][1] + bv[bj][1];
                    if (ACT == 1) { f32x2 a = gelu_pk((f32x2){v0[0], v0[1]}), b = gelu_pk((f32x2){v0[2], v0[3]}), c = gelu_pk((f32x2){v1[0], v1[1]}), d = gelu_pk((f32x2){v1[2], v1[3]});
                        v0 = (f32x4){a.x, a.y, b.x, b.y}; v1 = (f32x4){c.x, c.y, d.x, d.y}; }
                    v0 = v0 * sc; v1 = v1 * sc; u32x4 w; w.x = cvt_pk_bf16(v0[0], v0[1]); w.y = cvt_pk_bf16(v0[2], v0[3]); w.z = cvt_pk_bf16(v1[0], v1[1]); w.w = cvt_pk_bf16(v1[2], v1[3]);
                    *(u32x4*)(rowp + bj * HALF) = w; } }
    }
};

template <class Epi, class Sched, bool ALIGN_EPI = false, bool SP2 = false>
__device__ __forceinline__ void gemm_phase(PG8_LAS unsigned char* lds, const Gemm g, const Sched& S, const Epi& E) {
    const int tid = threadIdx.x, wid = __builtin_amdgcn_readfirstlane(tid >> 6), lane = tid & 63, wr = wid >> 2, wc = wid & 3, fr = lane & 15, fq = lane >> 4;
    const int K = g.K, nt = K / BK;
    unsigned voffA[2], voffB[2];
#pragma unroll
    for (int i = 0; i < 2; ++i) { int R, C; stage_rc(tid * 16 + i * 8192, R, C); const int Rb = Epi::PERM ? ((R & ~31) + perm32(R & 31)) : R;
        voffA[i] = (unsigned)(R * K + C) * 2u; voffB[i] = (unsigned)(Rb * K + C) * 2u; }
    const size_t kstep = (size_t)(BK * 2);
    const size_t hstep = (size_t)HALF * K * 2;
    const size_t tstep = 2 * hstep;
    const unsigned ldsw = (unsigned)wid * 1024u;
    const int aoff = lds_byte(wr * 64 + fr, fq * 8), boff = lds_byte(wc * 32 + fr, fq * 8);
#define PG8_SA(b, h) (((b) * 2 + (h)) * HTB)
#define PG8_SB(b, h) ((4 + (b) * 2 + (h)) * HTB)
#define PG8_STAGE(bufoff, gbase, voff) do { _Pragma("unroll") for (int _i = 0; _i < 2; ++_i) \
        __builtin_amdgcn_global_load_lds((const unsigned*)((const char*)(gbase) + (voff)[_i]), (PG8_LAS unsigned*)(lds + (bufoff) + ldsw + _i * 8192), 16, 0, 0); } while (0)
#define PG8_LDA(dst, b, h) do { _Pragma("unroll") for (int m = 0; m < 4; ++m) _Pragma("unroll") for (int k = 0; k < 2; ++k) dst[m][k] = *(const PG8_LAS bf16x8*)(lds + PG8_SA(b, h) + aoff + m * 2048 + k * 1024); } while (0)
#define PG8_LDB(dst, b, h) do { _Pragma("unroll") for (int n = 0; n < 2; ++n) _Pragma("unroll") for (int k = 0; k < 2; ++k) dst[n][k] = *(const PG8_LAS bf16x8*)(lds + PG8_SB(b, h) + boff + n * 2048 + k * 1024); } while (0)
#define PG8_MMA(ai, bj, At, Bt) do { __builtin_amdgcn_s_setprio(1); _Pragma("unroll") for (int m = 0; m < 4; ++m) _Pragma("unroll") for (int n = 0; n < 2; ++n) _Pragma("unroll") for (int k = 0; k < 2; ++k) \
        acc[ai][bj][m][n] = __builtin_amdgcn_mfma_f32_16x16x32_bf16(Bt[n][k], At[m][k], acc[ai][bj][m][n], 0, 0, 0); __builtin_amdgcn_s_setprio(0); } while (0)
#define PG8_WAIT_V(n) asm volatile("s_waitcnt vmcnt(" #n ")" ::: "memory")
#define PG8_WAIT_L(n) asm volatile("s_waitcnt lgkmcnt(" #n ")" ::: "memory")
#define PG8_BAR __builtin_amdgcn_s_barrier()
#define PG8_SCHED __builtin_amdgcn_sched_barrier(0)
    Unit cur, nxt; int ui = 0;
    if (!S.next(0, cur)) return;
    f32x4 acc[2][2][4][2];
#pragma unroll
    for (int a = 0; a < 2; ++a)
#pragma unroll
        for (int b = 0; b < 2; ++b)
#pragma unroll
            for (int m = 0; m < 4; ++m)
#pragma unroll
                for (int n = 0; n < 2; ++n) acc[a][b][m][n] = (f32x4){0.f, 0.f, 0.f, 0.f};
    bf16x8 At[4][2], B0[2][2], B1[2][2];
    const char* cA = (const char*)(cur.src ? g.A2 : g.A) + (size_t)cur.pm * tstep; const char* cB = (const char*)(cur.src ? g.Bt2 : g.Bt) + (size_t)cur.pn * tstep;
    S.a_ready(cur);
    if constexpr (SP2) {
        PG8_STAGE(PG8_SB(0, 0), cB, voffB); PG8_STAGE(PG8_SB(0, 1), cB + hstep, voffB); PG8_STAGE(PG8_SA(0, 0), cA, voffA); PG8_STAGE(PG8_SA(0, 1), cA + hstep, voffA);
        if (wr == 1) PG8_BAR;
        PG8_WAIT_V(2); PG8_BAR;
        PG8_STAGE(PG8_SB(1, 0), cB + kstep, voffB); PG8_STAGE(PG8_SA(1, 0), cA + kstep, voffA); PG8_STAGE(PG8_SB(1, 1), cB + hstep + kstep, voffB);
        PG8_WAIT_V(6); PG8_BAR;
    } else {
        PG8_STAGE(PG8_SB(0, 0), cB, voffB); PG8_STAGE(PG8_SA(0, 0), cA, voffA); PG8_STAGE(PG8_SB(0, 1), cB + hstep, voffB); PG8_STAGE(PG8_SA(0, 1), cA + hstep, voffA);
        if (wr == 1) PG8_BAR;
        PG8_WAIT_V(4); PG8_BAR;
        PG8_STAGE(PG8_SB(1, 0), cB + kstep, voffB); PG8_STAGE(PG8_SA(1, 0), cA + kstep, voffA); PG8_STAGE(PG8_SB(1, 1), cB + hstep + kstep, voffB);
        PG8_WAIT_V(6); PG8_BAR;
    }
    for (;;) {
        const bool has_next = S.next(ui + 1, nxt);
        const char* nA = has_next ? (const char*)(nxt.src ? g.A2 : g.A) + (size_t)nxt.pm * tstep : cA; const char* nB = has_next ? (const char*)(nxt.src ? g.Bt2 : g.Bt) + (size_t)nxt.pn * tstep : cB;
        for (int t = 0; t < nt; t += 2) {
            const bool last = (t == nt - 2);
            const char* a1 = cA + (size_t)(t + 1) * kstep;
            const char* a2 = last ? nA : cA + (size_t)(t + 2) * kstep; const char* b2 = last ? nB : cB + (size_t)(t + 2) * kstep;
            const char* a3 = a2 + kstep; const char* b3 = b2 + kstep;
            if (last && has_next) S.a_ready(nxt);
            if constexpr (SP2) {
            PG8_LDB(B0, 0, 0); PG8_LDB(B1, 0, 1); PG8_SCHED; PG8_LDA(At, 0, 0); PG8_STAGE(PG8_SA(1, 1), a1 + hstep, voffA);
            PG8_WAIT_V(8); PG8_WAIT_L(0); PG8_BAR; PG8_MMA(0, 0, At, B0); PG8_MMA(0, 1, At, B1); PG8_BAR; PG8_SCHED;
            PG8_LDA(At, 0, 1); PG8_STAGE(PG8_SB(0, 0), b2, voffB); PG8_STAGE(PG8_SB(0, 1), b2 + hstep, voffB); PG8_STAGE(PG8_SA(0, 0), a2, voffA);
            PG8_WAIT_V(8); PG8_WAIT_L(0); PG8_BAR; PG8_MMA(1, 0, At, B0); PG8_MMA(1, 1, At, B1); PG8_BAR; PG8_SCHED;
            PG8_LDB(B0, 1, 0); PG8_LDB(B1, 1, 1); PG8_SCHED; PG8_LDA(At, 1, 0); PG8_STAGE(PG8_SA(0, 1), a2 + hstep, voffA);
            PG8_WAIT_V(8); PG8_WAIT_L(0); PG8_BAR; PG8_MMA(0, 0, At, B0); PG8_MMA(0, 1, At, B1); PG8_BAR; PG8_SCHED;
            PG8_LDA(At, 1, 1); PG8_STAGE(PG8_SB(1, 0), b3, voffB); PG8_STAGE(PG8_SB(1, 1), b3 + hstep, voffB); PG8_STAGE(PG8_SA(1, 0), a3, voffA);
            PG8_WAIT_V(8); PG8_WAIT_L(0); PG8_BAR; PG8_MMA(1, 0, At, B0); PG8_MMA(1, 1, At, B1); PG8_BAR; PG8_SCHED;
            } else {
            PG8_LDB(B0, 0, 0); PG8_SCHED; PG8_LDA(At, 0, 0); PG8_STAGE(PG8_SA(1, 1), a1 + hstep, voffA);
            PG8_WAIT_L(8); PG8_BAR; PG8_WAIT_L(0); PG8_MMA(0, 0, At, B0); PG8_BAR; PG8_SCHED;
            PG8_LDB(B1, 0, 1); PG8_STAGE(PG8_SB(0, 0), b2, voffB);
            PG8_BAR; PG8_WAIT_L(0); PG8_MMA(0, 1, At, B1); PG8_BAR;
            PG8_LDA(At, 0, 1); PG8_STAGE(PG8_SA(0, 0), a2, voffA);
            PG8_BAR; PG8_WAIT_L(0); PG8_MMA(1, 0, At, B0); PG8_BAR; PG8_SCHED;
            PG8_STAGE(PG8_SB(0, 1), b2 + hstep, voffB);
            PG8_WAIT_V(6); PG8_BAR; PG8_MMA(1, 1, At, B1); PG8_BAR;
            PG8_LDB(B0, 1, 0); PG8_SCHED; PG8_LDA(At, 1, 0); PG8_STAGE(PG8_SA(0, 1), a2 + hstep, voffA);
            PG8_WAIT_L(8); PG8_BAR; PG8_WAIT_L(0); PG8_MMA(0, 0, At, B0); PG8_BAR; PG8_SCHED;
            PG8_LDB(B1, 1, 1); PG8_STAGE(PG8_SB(1, 0), b3, voffB);
            PG8_BAR; PG8_WAIT_L(0); PG8_MMA(0, 1, At, B1); PG8_BAR;
            PG8_LDA(At, 1, 1); PG8_STAGE(PG8_SA(1, 0), a3, voffA);
            PG8_BAR; PG8_WAIT_L(0); PG8_MMA(1, 0, At, B0); PG8_BAR; PG8_SCHED;
            PG8_STAGE(PG8_SB(1, 1), b3 + hstep, voffB);
            PG8_WAIT_V(6); PG8_BAR; PG8_MMA(1, 1, At, B1); PG8_BAR;
            }
        }
        if constexpr (ALIGN_EPI) { if (wr == 0) PG8_BAR; }
        if constexpr (!Epi::AFTER_DRAIN) { E(acc, cur, wr, wc, fr, fq); S.done(cur); }
        if (!has_next) break;
#pragma unroll
        for (int a = 0; a < 2; ++a)
#pragma unroll
            for (int b = 0; b < 2; ++b)
#pragma unroll
                for (int m = 0; m < 4; ++m)
#pragma unroll
                    for (int n = 0; n < 2; ++n) acc[a][b][m][n] = (f32x4){0.f, 0.f, 0.f, 0.f};
        cur = nxt; cA = nA; cB = nB; ++ui;
        if constexpr (ALIGN_EPI) { if (wr == 1) PG8_BAR; }
    }
    PG8_WAIT_V(0);
    if constexpr (!ALIGN_EPI) { if (wr == 0) PG8_BAR; }
    PG8_BAR;
    if constexpr (Epi::AFTER_DRAIN) { E.fused(acc, cur, wr, wc, fr, fq, lds, wid, lane); S.done(cur); }
#undef PG8_SA
#undef PG8_SB
#undef PG8_STAGE
#undef PG8_LDA
#undef PG8_LDB
#undef PG8_MMA
#undef PG8_WAIT_V
#undef PG8_WAIT_L
#undef PG8_BAR
#undef PG8_SCHED
}
}

#define GAS __attribute__((address_space(1)))
#define LAS __attribute__((address_space(3)))
typedef unsigned short bf16;
typedef unsigned v4u __attribute__((ext_vector_type(4)));
typedef float f32x4 __attribute__((ext_vector_type(4)));
typedef short bf16x8 __attribute__((ext_vector_type(8)));
typedef GAS unsigned gu32;
typedef GAS unsigned long long gu64;
#define RLX_AGENT __ATOMIC_RELAXED, __HIP_MEMORY_SCOPE_AGENT
#define LDS_WAIT() asm volatile("s_waitcnt lgkmcnt(0)" ::: "memory")
#define VM_WAIT() asm volatile("s_waitcnt vmcnt(0)" ::: "memory")
__device__ __forceinline__ unsigned long long rt() { return __builtin_amdgcn_s_memrealtime(); }
__device__ __forceinline__ unsigned f2bf(float f) { unsigned u = __builtin_bit_cast(unsigned, f); return (u + 0x7fffu + ((u >> 16) & 1u)) >> 16; }
__device__ __forceinline__ unsigned pk2(float lo, float hi) { return f2bf(lo) | (f2bf(hi) << 16); }

#define XB_TMO      128
#define XB_XCNT(j)  (256  + 64 * (j))
#define XB_XSUB(j)  (1280 + 64 * (j))
#define XB_XGEN(j)  (2304 + 64 * (j))
#define XB_TOP      3328
#define XB_TOPGEN   3392
#define XCD_BAR_WORDS 3456
#define XB_SPIN_CAP (1u << 18)

__device__ __forceinline__ unsigned xb_ld(unsigned* p)              { return __hip_atomic_load(p, __ATOMIC_RELAXED, __HIP_MEMORY_SCOPE_AGENT); }
__device__ __forceinline__ unsigned xb_add(unsigned* p, unsigned v) { return __hip_atomic_fetch_add(p, v, __ATOMIC_RELAXED, __HIP_MEMORY_SCOPE_AGENT); }
__device__ __forceinline__ unsigned xb_xcc_id() { return (unsigned)__builtin_amdgcn_s_getreg((3 << 11) | 20) & 0xFu; }
#define XB_SPIN(cond, bar) do { unsigned _sp = 0; while (cond) { __builtin_amdgcn_s_sleep(1); \
    if ((++_sp & 255u) == 0u) { if (xb_ld(&(bar)[XB_TMO])) break; if (_sp > XB_SPIN_CAP) { atomicAdd(&(bar)[XB_TMO], 1u); break; } } } } while (0)

struct XcdBarrier {
    unsigned* bar; unsigned x;
    volatile LAS unsigned* st;
};

__device__ __forceinline__ XcdBarrier xcd_barrier_post(unsigned* bar, volatile LAS unsigned* st) {
    XcdBarrier b; b.bar = bar; b.x = xb_xcc_id(); b.st = st;
    if (threadIdx.x == 0) (void)xb_add(&bar[XB_XCNT(b.x)], 1u);
    return b;
}
__device__ __forceinline__ void xcd_barrier_complete(unsigned* bar, unsigned x, unsigned& nloc, unsigned& nx) {
    const unsigned G = gridDim.x * gridDim.y * gridDim.z;
    unsigned sum, cnt, mine, sp = 0u;
    for (;;) {
        sum = 0u; cnt = 0u; mine = 0u;
#pragma unroll
        for (unsigned j = 0; j < 16; ++j) { const unsigned c = xb_ld(&bar[XB_XCNT(j)]); sum += c; cnt += (c > 0u) ? 1u : 0u; mine = (j == x) ? c : mine; }
        if (sum == G) break;
        __builtin_amdgcn_s_sleep(1);
        if ((++sp & 255u) == 0u) { if (xb_ld(&bar[XB_TMO])) break; if (sp > XB_SPIN_CAP) { atomicAdd(&bar[XB_TMO], 1u); break; } }
    }
    nloc = mine > 0u ? mine : 1u; nx = cnt > 0u ? cnt : 1u;
}

__device__ __forceinline__ void xcd_barrier(const XcdBarrier& b) {
    asm volatile("s_waitcnt vmcnt(0)" ::: "memory");
    __syncthreads();
    if (threadIdx.x == 0) {
        unsigned* bar = b.bar;
        __builtin_amdgcn_s_waitcnt(0);
        unsigned nloc = b.st[0], nx = b.st[1];
        if (nloc == 0u) { xcd_barrier_complete(bar, b.x, nloc, nx); b.st[0] = nloc; b.st[1] = nx; }
        const unsigned old = xb_add(&bar[XB_XSUB(b.x)], 1u);
        const unsigned gen = old / nloc;
        if (old + 1u == (gen + 1u) * nloc) {
            __builtin_amdgcn_fence(__ATOMIC_RELEASE, "agent");
            asm volatile("s_waitcnt vmcnt(0)" ::: "memory");
            const unsigned og = xb_add(&bar[XB_TOP], 1u);
            const unsigned tg = og / nx;
            if (og + 1u == (tg + 1u) * nx) xb_add(&bar[XB_TOPGEN], 1u);
            else XB_SPIN(xb_ld(&bar[XB_TOPGEN]) == tg, bar);
            __builtin_amdgcn_fence(__ATOMIC_ACQUIRE, "agent");
            xb_add(&bar[XB_XGEN(b.x)], 1u);
            asm volatile("s_waitcnt vmcnt(0)" ::: "memory");
        } else {
            XB_SPIN(xb_ld(&bar[XB_XGEN(b.x)]) == gen, bar);
            __builtin_amdgcn_fence(__ATOMIC_ACQUIRE, "agent");
            asm volatile("s_waitcnt vmcnt(0)" ::: "memory");
        }
    }
    __syncthreads();
}

constexpr int NWAVES = 8, NTHR = 512;
constexpr int BATCH = 4, SEQ = 4096, D = 1024, M = BATCH * SEQ;
constexpr int NPROJ = 4352, LDW_IN = 4360, NMOD = 6144;
constexpr int C_QA = 0, C_KA = 512, C_VA = 640, C_QB = 768, C_KB = 1280, C_VB = 1792, C_GLA = 2304, C_GLB = 3328;
constexpr int NEXP = 16384;
constexpr float EPS = 1e-6f;

constexpr size_t MiB = 1u << 20;
constexpr size_t WS_CTL = 0, CTL_ZERO_BYTES = 1 * MiB;
constexpr size_t WS_MOD = 1 * MiB, WS_LOGF = 1 * MiB + 128 * 1024, WS_SUBK = 2 * MiB;
constexpr size_t WS_WIN = 4 * MiB, WS_WA = 12 * MiB + 512 * 1024, WS_WB = 13 * MiB + 512 * 1024, WS_WOUT = 14 * MiB + 512 * 1024, WS_WQ = 16 * MiB + 512 * 1024;
constexpr size_t WS_ED = 19 * MiB, WS_EU = 35 * MiB;
constexpr size_t WS_EDS = 2 * MiB + 512 * 1024;
constexpr size_t WS_H2Q = 95 * MiB, WS_H2S = 111 * MiB;
constexpr size_t WS_H = 83 * MiB, WS_OA = 83 * MiB, WS_OB = 99 * MiB, WS_PIDX = 83 * MiB, WS_PG = 87 * MiB;
constexpr size_t WS_PROJ = 115 * MiB, WS_X1 = 115 * MiB, WS_H2 = 179 * MiB, WS_QP = 211 * MiB;
constexpr size_t WS_END = 251 * MiB;
static_assert(WS_WIN + (size_t)NPROJ * D * 2 <= WS_WA && WS_WQ + (size_t)D * D * 2 <= WS_ED && WS_PROJ + (size_t)M * NPROJ * 2 <= WS_END, "ws map");
constexpr int CW_BAR = 4096;

constexpr int RING_OFF = 0, RING_BYTES = 131072;
constexpr int LDSCTL_OFF = RING_BYTES, MISC_OFF = LDSCTL_OFF + 320;
constexpr int LDS_BYTES = 147456;

typedef float f32x16 __attribute__((ext_vector_type(16)));
typedef short s16x4 __attribute__((ext_vector_type(4)));
typedef unsigned u32x2 __attribute__((ext_vector_type(2)));
typedef float f32x2_t __attribute__((ext_vector_type(2)));
typedef __bf16 bf16x2_t __attribute__((ext_vector_type(2)));

__device__ __forceinline__ unsigned cvtpk(float lo, float hi) { f32x2_t v = {lo, hi}; bf16x2_t b = __builtin_convertvector(v, bf16x2_t); return __builtin_bit_cast(unsigned, b); }
__device__ __forceinline__ float bflo(unsigned u) { return __uint_as_float(u << 16); }
__device__ __forceinline__ float bfhi(unsigned u) { return __uint_as_float(u & 0xffff0000u); }
__device__ __forceinline__ float wave_sum(float v) {
#pragma unroll
    for (int o = 1; o < 64; o <<= 1) v += __shfl_xor(v, o);
    return v;
}
__device__ __forceinline__ int crow(int r, int hi) { return (r & 3) + 8 * (r >> 2) + 4 * hi; }
#define MFMA32(a, b, c) __builtin_amdgcn_mfma_f32_32x32x16_bf16((a), (b), (c), 0, 0, 0)

struct Frame {
    LAS unsigned char* lds;
    int tid, lane, wave, vcu, G;
    const float* in[18]; float* out; unsigned char* ws;
};

__device__ __forceinline__ void p0_transpose_item(const float* W, int ld, int K, int ncols, bf16* WT, int row_off, LAS float* scr, int item, int lane) {
    const int nblk = ncols / 32, kb = item / nblk, nb = item % nblk, k0 = 64 * kb, n0 = 32 * nb;
#pragma unroll 8
    for (int i = 0; i < 32; ++i) { const int kk = 2 * i + (lane >> 5); scr[kk * 33 + (lane & 31)] = W[(size_t)(k0 + kk) * ld + n0 + (lane & 31)]; }
    LDS_WAIT(); asm volatile("" ::: "memory");
    const int c = lane & 7;
#pragma unroll
    for (int j = 0; j < 4; ++j) { const int n = (lane >> 3) + 8 * j; const LAS float* s = scr + (8 * c) * 33 + n;
        v4u o; o.x = pk2(s[0 * 33], s[1 * 33]); o.y = pk2(s[2 * 33], s[3 * 33]); o.z = pk2(s[4 * 33], s[5 * 33]); o.w = pk2(s[6 * 33], s[7 * 33]);
        *(GAS v4u*)(WT + (size_t)(row_off + n0 + n) * K + k0 + 8 * c) = o; }
    LDS_WAIT(); asm volatile("" ::: "memory");
}
__device__ __forceinline__ void p0_convert(const float* __restrict__ src, bf16* __restrict__ dst, long n_iters, int gw, int NGW, int lane) {
    for (long it0 = (long)gw * 4; it0 < n_iters; it0 += (long)NGW * 4) {
        f32x4 a[4][2];
#pragma unroll
        for (int u = 0; u < 4; ++u) { const long it = it0 + u; if (it < n_iters) { const float* p = src + it * 512 + lane * 4; a[u][0] = *(const f32x4*)p; a[u][1] = *(const f32x4*)(p + 256); } }
#pragma unroll
        for (int u = 0; u < 4; ++u) { const long it = it0 + u; if (it < n_iters) { bf16* q = dst + it * 512 + lane * 4;
            u32x2 w0, w1; w0.x = cvtpk(a[u][0].x, a[u][0].y); w0.y = cvtpk(a[u][0].z, a[u][0].w); w1.x = cvtpk(a[u][1].x, a[u][1].y); w1.y = cvtpk(a[u][1].z, a[u][1].w);
            *(u32x2*)q = w0; *(u32x2*)(q + 256) = w1; } }
    }
}

__device__ __forceinline__ void p0_quant_tables(Frame& F, int gw, int NGW) {
    const float* ed = F.in[15]; const float* eu = F.in[16];
    unsigned char* EDq = (unsigned char*)(F.ws + WS_ED); unsigned char* EUq = (unsigned char*)(F.ws + WS_EU); float* EDS = (float*)(F.ws + WS_EDS);
    const int lane = F.lane;
    for (int row0 = gw * 2; row0 < NEXP; row0 += NGW * 2) {
        f32x4 a[2][4], u[2][4];
#pragma unroll
        for (int q = 0; q < 2; ++q)
#pragma unroll
            for (int j = 0; j < 4; ++j) { a[q][j] = *((const f32x4*)(ed + (size_t)(row0 + q) * D) + lane + 64 * j); u[q][j] = *((const f32x4*)(eu + (size_t)(row0 + q) * D) + lane + 64 * j); }
#pragma unroll
        for (int q = 0; q < 2; ++q) {
            float am = 0.f;
#pragma unroll
            for (int j = 0; j < 4; ++j) am = fmaxf(fmaxf(am, fmaxf(fabsf(a[q][j].x), fabsf(a[q][j].y))), fmaxf(fabsf(a[q][j].z), fabsf(a[q][j].w)));
#pragma unroll
            for (int o = 1; o < 64; o <<= 1) am = fmaxf(am, __shfl_xor(am, o));
            const float sc = am > 0.f ? am * (1.0f / 127.0f) : 1.0f, inv = 1.0f / sc;
            v4u qa, qu;
#pragma unroll
            for (int j = 0; j < 4; ++j) {
                const int b0 = (int)rintf(a[q][j].x * inv), b1 = (int)rintf(a[q][j].y * inv), b2 = (int)rintf(a[q][j].z * inv), b3 = (int)rintf(a[q][j].w * inv);
                qa[j] = (unsigned)(b0 & 255) | ((unsigned)(b1 & 255) << 8) | ((unsigned)(b2 & 255) << 16) | ((unsigned)(b3 & 255) << 24);
                int p = __builtin_amdgcn_cvt_pk_fp8_f32(u[q][j].x * 16.0f, u[q][j].y * 16.0f, 0, false);
                p = __builtin_amdgcn_cvt_pk_fp8_f32(u[q][j].z * 16.0f, u[q][j].w * 16.0f, p, true);
                qu[j] = (unsigned)p;
            }
            *(v4u*)(EDq + (size_t)(row0 + q) * D + 16 * lane) = qa;
            *(v4u*)(EUq + (size_t)(row0 + q) * D + 16 * lane) = qu;
            if (lane == 0) EDS[row0 + q] = sc;
        }
    }
}
__device__ __forceinline__ void p0_prologue(Frame& F) {
    const float* c = F.in[1]; const float* w_ada = F.in[4]; const float* b_ada = F.in[5];
    float* MOD = (float*)(F.ws + WS_MOD);
    {
        LAS float* cact = (LAS float*)(F.lds);
        LAS float* part = (LAS float*)(F.lds + 16384);
        bool did = false;
        for (int item = F.vcu; item < NMOD / 32; item += F.G) {
            if (!did) { for (int i = F.tid; i < 4096; i += NTHR) { const float cv = c[i]; cact[i] = cv / (1.0f + __expf(-cv)); } did = true; }
            __syncthreads();
            const int n0 = item * 32, col = n0 + (F.lane & 31), ksub = F.lane >> 5;
            float a0 = 0.f, a1 = 0.f, a2 = 0.f, a3 = 0.f;
#pragma unroll 16
            for (int it = 0; it < 64; ++it) { const int k = (it * 8 + F.wave) * 2 + ksub; const float w = w_ada[(size_t)k * NMOD + col];
                a0 += cact[k] * w; a1 += cact[1024 + k] * w; a2 += cact[2048 + k] * w; a3 += cact[3072 + k] * w; }
            a0 += __shfl_xor(a0, 32); a1 += __shfl_xor(a1, 32); a2 += __shfl_xor(a2, 32); a3 += __shfl_xor(a3, 32);
            if (F.lane < 32) { part[(F.wave * 4 + 0) * 32 + F.lane] = a0; part[(F.wave * 4 + 1) * 32 + F.lane] = a1; part[(F.wave * 4 + 2) * 32 + F.lane] = a2; part[(F.wave * 4 + 3) * 32 + F.lane] = a3; }
            __syncthreads();
            if (F.tid < 128) { const int b = F.tid >> 5, cl = F.tid & 31; float s = 0.f;
#pragma unroll
                for (int w = 0; w < 8; ++w) s += part[(w * 4 + b) * 32 + cl];
                MOD[b * NMOD + n0 + cl] = s + b_ada[n0 + cl]; }
            __syncthreads();
        }
    }
    LAS float* scr = (LAS float*)(F.lds + RING_OFF + F.wave * 16384);
    const int gw = F.vcu * NWAVES + F.wave, NGW = F.G * NWAVES;
    constexpr int I_IN1 = (D / 64) * (2304 / 32), I_IN2 = (D / 64) * (2048 / 32), I_AB = (512 / 64) * (D / 32), I_SQ = (D / 64) * (D / 32);
    constexpr int NITEMS = I_IN1 + I_IN2 + 2 * I_AB + 2 * I_SQ;
    bf16* Win_t = (bf16*)(F.ws + WS_WIN);
    for (int it = gw; it < NITEMS; it += NGW) {
        int r = it;
        if (r < I_IN1) { p0_transpose_item(F.in[6], LDW_IN, D, 2304, Win_t, 0, scr, r, F.lane); continue; } r -= I_IN1;
        if (r < I_IN2) { p0_transpose_item(F.in[6] + 2312, LDW_IN, D, 2048, Win_t, 2304, scr, r, F.lane); continue; } r -= I_IN2;
        if (r < I_AB) { p0_transpose_item(F.in[9], D, 512, D, (bf16*)(F.ws + WS_WA), 0, scr, r, F.lane); continue; } r -= I_AB;
        if (r < I_AB) { p0_transpose_item(F.in[10], D, 512, D, (bf16*)(F.ws + WS_WB), 0, scr, r, F.lane); continue; } r -= I_AB;
        if (r < I_SQ) { p0_transpose_item(F.in[11], D, D, D, (bf16*)(F.ws + WS_WOUT), 0, scr, r, F.lane); continue; } r -= I_SQ;
        p0_transpose_item(F.in[13], D, D, D, (bf16*)(F.ws + WS_WQ), 0, scr, r, F.lane);
    }
    p0_quant_tables(F, gw, NGW);
    p0_convert(F.in[14], (bf16*)(F.ws + WS_SUBK), (long)(8 * 2 * 128 * 64) / 512, gw, NGW, F.lane);
}

__device__ __forceinline__ void p1_norm(Frame& F) {
    const float* x = F.in[0]; const float* g1 = F.in[2]; const float* w_in = F.in[6]; const float* b_forget = F.in[7];
    const float* MOD = (const float*)(F.ws + WS_MOD); bf16* H = (bf16*)(F.ws + WS_H); float* LOGF = (float*)(F.ws + WS_LOGF);
    LAS float* wfl = (LAS float*)(F.lds);
    for (int i = F.tid; i < 8192; i += NTHR) { const int k = i >> 3, j = i & 7; wfl[j * 1024 + k] = w_in[(size_t)k * LDW_IN + 2304 + j]; }
    __syncthreads();
    const int gw = F.vcu * NWAVES + F.wave, NGW = F.G * NWAVES;
    for (int row = gw; row < M; row += NGW) {
        const f32x4* xr = (const f32x4*)(x + (size_t)row * D) + F.lane;
        f32x4 v[4]; float ss = 0.f;
#pragma unroll
        for (int j = 0; j < 4; ++j) { v[j] = xr[64 * j]; ss += (v[j].x * v[j].x + v[j].y * v[j].y) + (v[j].z * v[j].z + v[j].w * v[j].w); }
        ss = wave_sum(ss);
        const float rstd = 1.0f / sqrtf(ss * (1.0f / D) + EPS);
        const int b = row >> 12; const float* mb = MOD + b * NMOD;
        float fl[8];
#pragma unroll
        for (int jj = 0; jj < 8; ++jj) fl[jj] = 0.f;
#pragma unroll
        for (int j = 0; j < 4; ++j) { const int col = 4 * F.lane + 256 * j;
            const f32x4 g = *(const f32x4*)(g1 + col), sh = *(const f32x4*)(mb + col), sc = *(const f32x4*)(mb + 1024 + col);
            const f32x4 hv = (v[j] * rstd) * g * (sc + 1.0f) + sh;
            u32x2 w; w.x = cvtpk(hv.x, hv.y); w.y = cvtpk(hv.z, hv.w);
            *(u32x2*)(H + (size_t)row * D + col) = w;
#pragma unroll
            for (int jj = 0; jj < 8; ++jj) { const f32x4 wv = *(const LAS f32x4*)(wfl + jj * 1024 + col); fl[jj] += (hv.x * wv.x + hv.y * wv.y) + (hv.z * wv.z + hv.w * wv.w); }
        }
        float mine = 0.f;
#pragma unroll
        for (int jj = 0; jj < 8; ++jj) { const float s = wave_sum(fl[jj]); if (F.lane == jj) mine = s; }
        if (F.lane < 8) { const float z = mine + b_forget[F.lane]; const float ls = fminf(z, 0.f) - log1pf(__expf(-fabsf(z))); LOGF[(size_t)row * 8 + F.lane] = ls; }
    }
}

constexpr int KP = 72;
constexpr int VPF = 68;
constexpr int VPS = 260;
struct FlashState { f32x16 o[2]; float m, l; };

__device__ __forceinline__ void flash_tail(FlashState& st, f32x16& s0, f32x16& s1, const LAS bf16* Vs, int vp, int r32, int hi) {
    float mt = s0[0];
#pragma unroll
    for (int r = 1; r < 16; ++r) mt = fmaxf(mt, s0[r]);
#pragma unroll
    for (int r = 0; r < 16; ++r) mt = fmaxf(mt, s1[r]);
    mt = fmaxf(mt, __shfl_xor(mt, 32));
    const float mn = fmaxf(st.m, mt);
    const float alpha = __expf(st.m - mn);
    st.m = mn;
    float ps = 0.f;
#pragma unroll
    for (int r = 0; r < 16; ++r) { s0[r] = __expf(s0[r] - mn); ps += s0[r]; }
#pragma unroll
    for (int r = 0; r < 16; ++r) { s1[r] = __expf(s1[r] - mn); ps += s1[r]; }
    st.l = st.l * alpha + ps;
#pragma unroll
    for (int r = 0; r < 16; ++r) { st.o[0][r] *= alpha; st.o[1][r] *= alpha; }
#pragma unroll
    for (int blk = 0; blk < 2; ++blk)
#pragma unroll
        for (int s = 0; s < 2; ++s) {
            v4u pw;
            if (blk == 0) { pw.x = cvtpk(s0[8 * s + 0], s0[8 * s + 1]); pw.y = cvtpk(s0[8 * s + 2], s0[8 * s + 3]); pw.z = cvtpk(s0[8 * s + 4], s0[8 * s + 5]); pw.w = cvtpk(s0[8 * s + 6], s0[8 * s + 7]); }
            else          { pw.x = cvtpk(s1[8 * s + 0], s1[8 * s + 1]); pw.y = cvtpk(s1[8 * s + 2], s1[8 * s + 3]); pw.z = cvtpk(s1[8 * s + 4], s1[8 * s + 5]); pw.w = cvtpk(s1[8 * s + 6], s1[8 * s + 7]); }
            const bf16x8 pf = __builtin_bit_cast(bf16x8, pw);
#pragma unroll
            for (int db = 0; db < 2; ++db) {
                const LAS bf16* vp0 = Vs + (32 * db + r32) * vp + 32 * blk + 16 * s + 4 * hi;
                const s16x4 lo = *(const LAS s16x4*)vp0, hh = *(const LAS s16x4*)(vp0 + 8);
                const bf16x8 vf = __builtin_shufflevector(lo, hh, 0, 1, 2, 3, 4, 5, 6, 7);
                st.o[db] = MFMA32(vf, pf, st.o[db]);
            }
        }
}
__device__ __forceinline__ void flash_qk(f32x16& s0, f32x16& s1, const bf16x8 (&qf)[4], const LAS bf16* Ks, int r32, int hi) {
    s0 = (f32x16){0.f}; s1 = (f32x16){0.f};
#pragma unroll
    for (int r = 0; r < 16; ++r) { s0[r] = 0.f; s1[r] = 0.f; }
#pragma unroll
    for (int ks = 0; ks < 4; ++ks) {
        const bf16x8 a0 = *(const LAS bf16x8*)(Ks + r32 * KP + 16 * ks + 8 * hi);
        const bf16x8 a1 = *(const LAS bf16x8*)(Ks + (32 + r32) * KP + 16 * ks + 8 * hi);
        s0 = MFMA32(a0, qf[ks], s0); s1 = MFMA32(a1, qf[ks], s1);
    }
}
__device__ __forceinline__ void flash_store(const FlashState& st, bf16* orow, int hi) {
    float lt = st.l + __shfl_xor(st.l, 32);
    const float inv = 1.0f / lt;
#pragma unroll
    for (int db = 0; db < 2; ++db)
#pragma unroll
        for (int rg = 0; rg < 4; ++rg) { u32x2 w; w.x = cvtpk(st.o[db][4 * rg] * inv, st.o[db][4 * rg + 1] * inv); w.y = cvtpk(st.o[db][4 * rg + 2] * inv, st.o[db][4 * rg + 3] * inv);
            *(u32x2*)(orow + 32 * db + 8 * rg + 4 * hi) = w; }
}

__device__ __forceinline__ void fox_unit(Frame& F, int b, int h, int qb) {
    const bf16* proj = (const bf16*)(F.ws + WS_PROJ); const float* LOGF = (const float*)(F.ws + WS_LOGF); bf16* OB = (bf16*)(F.ws + WS_OB);
    LAS float* Fs = (LAS float*)(F.lds);
    LAS float* wtot = (LAS float*)(F.lds + 16384);
    LAS bf16* Kb = (LAS bf16*)(F.lds + 16384 + 64);
    LAS bf16* Vb = (LAS bf16*)(F.lds + 16384 + 64 + 2 * 64 * KP * 2);
    const int lane = F.lane, wave = F.wave, tid = F.tid, r32 = lane & 31, hi = lane >> 5;
    const int q_end = 256 * (qb + 1), NT = q_end / 64;
    const size_t rowbase = (size_t)b * SEQ;
    {
        float v[8]; float run = 0.f;
#pragma unroll
        for (int i = 0; i < 8; ++i) { const int pos = tid * 8 + i; const float lf = (pos < q_end) ? LOGF[(rowbase + pos) * 8 + h] : 0.f; run += lf; v[i] = run; }
        float inc = run;
#pragma unroll
        for (int o = 1; o < 64; o <<= 1) { const float t = __shfl_up(inc, o); if (lane >= o) inc += t; }
        if (lane == 63) wtot[wave] = inc;
        __syncthreads();
        float off = inc - run;
        for (int w = 0; w < wave; ++w) off += wtot[w];
#pragma unroll
        for (int i = 0; i < 8; ++i) Fs[tid * 8 + i] = v[i] + off;
    }
    const int qrow = 256 * qb + 32 * wave + r32;
    bf16x8 qf[4];
    { const bf16* qp = proj + (rowbase + qrow) * NPROJ + C_QB + 64 * h + 8 * hi;
#pragma unroll
      for (int ks = 0; ks < 4; ++ks) qf[ks] = *(const bf16x8*)(qp + 16 * ks); }
    const int tq = 4 * qb + (wave >> 1);
    FlashState st; st.m = -INFINITY; st.l = 0.f;
#pragma unroll
    for (int r = 0; r < 16; ++r) { st.o[0][r] = 0.f; st.o[1][r] = 0.f; }
    const int srow = tid >> 3, sch = tid & 7;
    const bf16* kg = proj + (rowbase + srow) * NPROJ + C_KB + 64 * h + 8 * sch;
    const bf16* vg = proj + (rowbase + srow) * NPROJ + C_VB + 64 * h + 8 * sch;
    v4u kreg, vreg;
    { const size_t o = (size_t)(NT - 1) * 64 * NPROJ; kreg = *(const v4u*)(kg + o); vreg = *(const v4u*)(vg + o); }
    int cur = 0;
    {   *(LAS v4u*)(Kb + srow * KP + 8 * sch) = kreg;
        const unsigned short* vs = (const unsigned short*)&vreg;
#pragma unroll
        for (int i = 0; i < 8; ++i) Vb[(8 * sch + i) * VPF + srow] = vs[i];
    }
    __syncthreads();
    const float fq = Fs[qrow];
    for (int t = NT - 1; t >= 0; --t) {
        if (t > 0) { const size_t o = (size_t)(t - 1) * 64 * NPROJ; kreg = *(const v4u*)(kg + o); vreg = *(const v4u*)(vg + o); }
        if (t <= tq) {
            const LAS bf16* Ks = Kb + cur * 64 * KP; const LAS bf16* Vs = Vb + cur * 64 * VPF;
            f32x16 s0, s1; flash_qk(s0, s1, qf, Ks, r32, hi);
            const LAS float* Fk = Fs + 64 * t;
            const bool diag = (t == tq);
#pragma unroll
            for (int rg = 0; rg < 4; ++rg) {
                const f32x4 f0 = *(const LAS f32x4*)(Fk + 8 * rg + 4 * hi), f1 = *(const LAS f32x4*)(Fk + 32 + 8 * rg + 4 * hi);
#pragma unroll
                for (int i = 0; i < 4; ++i) { const int r = 4 * rg + i; const int kv = 64 * t + 8 * rg + 4 * hi + i;
                    float a = s0[r] * 0.125f + (fq - f0[i]); float c = s1[r] * 0.125f + (fq - f1[i]);
                    if (diag) { if (kv > qrow) a = -INFINITY; if (kv + 32 > qrow) c = -INFINITY; }
                    s0[r] = a; s1[r] = c; }
            }
            flash_tail(st, s0, s1, Vs, VPF, r32, hi);
        }
        if (t > 0) {
            const int nb = cur ^ 1;
            *(LAS v4u*)(Kb + nb * 64 * KP + srow * KP + 8 * sch) = kreg;
            const unsigned short* vs = (const unsigned short*)&vreg;
#pragma unroll
            for (int i = 0; i < 8; ++i) Vb[nb * 64 * VPF + (8 * sch + i) * VPF + srow] = vs[i];
        }
        __syncthreads();
        cur ^= 1;
    }
    flash_store(st, OB + (rowbase + qrow) * 512 + 64 * h, hi);
    __syncthreads();
}

__device__ const unsigned char T5_BUCKET[128] = {0,1,2,3,4,5,6,7,8,9,10,11,12,13,14,15,16,16,16,17,17,18,18,18,19,19,19,20,20,20,20,21,21,21,21,22,22,22,22,22,23,23,23,23,23,23,24,24,24,24,24,24,25,25,25,25,25,25,25,26,26,26,26,26,26,26,26,27,27,27,27,27,27,27,27,27,27,28,28,28,28,28,28,28,28,28,28,29,29,29,29,29,29,29,29,29,29,29,29,30,30,30,30,30,30,30,30,30,30,30,30,30,30,31,31,31,31,31,31,31,31,31,31,31,31,31,31,31};

__device__ __forceinline__ void swa_unit(Frame& F, int b, int kvh, int n) {
    const bf16* proj = (const bf16*)(F.ws + WS_PROJ); bf16* OA = (bf16*)(F.ws + WS_OA);
    const float* sinks = F.in[8]; const float* rel_bias = F.in[12];
    LAS bf16* Kb = (LAS bf16*)(F.lds);
    LAS bf16* Vb = (LAS bf16*)(F.lds + 36864);
    LAS float* bt = (LAS float*)(F.lds + 36864 + 33280);
    const int lane = F.lane, wave = F.wave, tid = F.tid, r32 = lane & 31, hi = lane >> 5;
    const size_t rowbase = (size_t)b * SEQ;
    {
        const int g = tid >> 7, d = tid & 127;
        bt[tid] = rel_bias[(int)T5_BUCKET[d] * 8 + kvh * 4 + g];
#pragma unroll
        for (int i = 0; i < 4; ++i) {
            const int idx = tid + i * NTHR, kb = idx >> 3, sch = idx & 7; const int pos = 128 * (n - 1) + kb;
            v4u kreg = (v4u){0u, 0u, 0u, 0u}, vreg = (v4u){0u, 0u, 0u, 0u};
            if (pos >= 0) { const bf16* p = proj + (rowbase + pos) * NPROJ + 64 * kvh + 8 * sch; kreg = *(const v4u*)(p + C_KA); vreg = *(const v4u*)(p + C_VA); }
            *(LAS v4u*)(Kb + kb * KP + 8 * sch) = kreg;
            const unsigned short* vs = (const unsigned short*)&vreg;
#pragma unroll
            for (int j = 0; j < 8; ++j) Vb[(8 * sch + j) * VPS + kb] = vs[j];
        }
    }
    __syncthreads();
    const int g = wave & 3, qh = wave >> 2, head = kvh * 4 + g;
    const LAS float* btg = bt + g * 128;
    for (int sb = 0; sb < 2; ++sb) {
        const int qrel0 = 64 * qh + 32 * sb, qrel = qrel0 + r32;
        const size_t row = rowbase + 128 * n + qrel;
        bf16x8 qf[4];
        { const bf16* qp = proj + row * NPROJ + C_QA + 64 * head + 8 * hi;
#pragma unroll
          for (int ks = 0; ks < 4; ++ks) qf[ks] = *(const bf16x8*)(qp + 16 * ks); }
        FlashState st; st.m = sinks[head]; st.l = (hi == 0) ? 1.0f : 0.0f;
#pragma unroll
        for (int r = 0; r < 16; ++r) { st.o[0][r] = 0.f; st.o[1][r] = 0.f; }
        const int t_lo = (qrel0 + 1) >> 6, t_hi = (qrel0 + 159) >> 6;
        for (int t = t_lo; t <= t_hi; ++t) {
            f32x16 s0, s1; flash_qk(s0, s1, qf, Kb + t * 64 * KP, r32, hi);
#pragma unroll
            for (int r = 0; r < 16; ++r) {
                const int kb0 = 64 * t + crow(r, hi), kb1 = kb0 + 32;
                const int d0 = 128 + qrel - kb0, d1 = d0 - 32;
                const bool v0 = (d0 >= 0) && (d0 < 128) && (n > 0 || kb0 >= 128);
                const bool v1 = (d1 >= 0) && (d1 < 128) && (n > 0 || kb1 >= 128);
                const float b0 = btg[d0 & 127], b1 = btg[d1 & 127];
                s0[r] = v0 ? (s0[r] * 0.125f + b0) : -INFINITY;
                s1[r] = v1 ? (s1[r] * 0.125f + b1) : -INFINITY;
            }
            flash_tail(st, s0, s1, Vb + 64 * t, VPS, r32, hi);
        }
        flash_store(st, OA + row * 512 + 64 * head, hi);
    }
    __syncthreads();
}
__device__ __forceinline__ void p3_attention(Frame& F) {
    for (int item = F.vcu; item < 256; item += F.G) {
        swa_unit(F, item >> 6, (item >> 5) & 1, item & 31);
        const int bh = item >> 3, j = item & 7;
        fox_unit(F, bh >> 3, bh & 7, 15 - j);
        fox_unit(F, bh >> 3, bh & 7, j);
    }
}

struct PairOrder {
    pg8::StaticOrder S;
    __device__ bool next(int i, pg8::Unit& u) const { if (!S.next(i >> 1, u)) return false; u.src = i & 1; return true; }
    __device__ __forceinline__ void a_ready(const pg8::Unit&) const {}
    __device__ __forceinline__ void done(const pg8::Unit&) const {}
};
__device__ __forceinline__ float sigmoidf_(float z) { return 1.0f / (1.0f + __expf(-z)); }
struct EpiGate {
    static constexpr bool PERM = false, AFTER_DRAIN = false;
    const bf16* proj; bf16* tmp; bf16* mixed;
    __device__ __forceinline__ void operator()(const pg8::f32x4 (&acc)[2][2][4][2], const pg8::Unit& u, int wr, int wc, int fr, int fq) const {
        const int goff = u.src ? C_GLB : C_GLA;
#pragma unroll
        for (int ai = 0; ai < 2; ++ai)
#pragma unroll
            for (int m = 0; m < 4; ++m) { const size_t row = (size_t)u.pm * 256 + ai * 128 + wr * 64 + m * 16 + fr;
#pragma unroll
                for (int bj = 0; bj < 2; ++bj)
#pragma unroll
                    for (int n = 0; n < 2; ++n) { const int col = u.pn * 256 + bj * 128 + wc * 32 + n * 16 + 4 * fq;
                        const u32x2 gw = *(const u32x2*)(proj + row * NPROJ + goff + col);
                        const pg8::f32x4 a = acc[ai][bj][m][n];
                        float v0 = a[0] * sigmoidf_(bflo(gw.x)), v1 = a[1] * sigmoidf_(bfhi(gw.x)), v2 = a[2] * sigmoidf_(bflo(gw.y)), v3 = a[3] * sigmoidf_(bfhi(gw.y));
                        if (u.src == 0) { u32x2 w; w.x = cvtpk(v0, v1); w.y = cvtpk(v2, v3); *(u32x2*)(tmp + row * D + col) = w; }
                        else { const u32x2 t = *(const u32x2*)(tmp + row * D + col);
                            u32x2 w; w.x = cvtpk(v0 + bflo(t.x), v1 + bfhi(t.x)); w.y = cvtpk(v2 + bflo(t.y), v3 + bfhi(t.y)); *(u32x2*)(mixed + row * D + col) = w; }
                    }
            }
    }
};
struct EpiRes {
    static constexpr bool PERM = false, AFTER_DRAIN = false;
    const float* x; const float* mod; float* x1;
    __device__ __forceinline__ void operator()(const pg8::f32x4 (&acc)[2][2][4][2], const pg8::Unit& u, int wr, int wc, int fr, int fq) const {
#pragma unroll
        for (int ai = 0; ai < 2; ++ai)
#pragma unroll
            for (int m = 0; m < 4; ++m) { const size_t row = (size_t)u.pm * 256 + ai * 128 + wr * 64 + m * 16 + fr; const int b = (int)(row >> 12);
#pragma unroll
                for (int bj = 0; bj < 2; ++bj)
#pragma unroll
                    for (int n = 0; n < 2; ++n) { const int col = u.pn * 256 + bj * 128 + wc * 32 + n * 16 + 4 * fq;
                        const pg8::f32x4 xin = *(const pg8::f32x4*)(x + row * D + col), gt = *(const pg8::f32x4*)(mod + b * NMOD + 2048 + col);
                        *(pg8::f32x4*)(x1 + row * D + col) = xin + gt * acc[ai][bj][m][n]; }
            }
    }
};

__device__ __forceinline__ void p6_norm2(Frame& F) {
    const float* x1 = (const float*)(F.ws + WS_X1); const float* g2 = F.in[3]; const float* MOD = (const float*)(F.ws + WS_MOD); bf16* H2 = (bf16*)(F.ws + WS_H2); unsigned char* H2Q = (unsigned char*)(F.ws + WS_H2Q); float* H2S = (float*)(F.ws + WS_H2S);
    const int gw = F.vcu * NWAVES + F.wave, NGW = F.G * NWAVES;
    for (int row = gw; row < M; row += NGW) {
        const f32x4* xr = (const f32x4*)(x1 + (size_t)row * D) + F.lane;
        f32x4 v[4], hq[4]; float ss = 0.f;
#pragma unroll
        for (int j = 0; j < 4; ++j) { v[j] = xr[64 * j]; ss += (v[j].x * v[j].x + v[j].y * v[j].y) + (v[j].z * v[j].z + v[j].w * v[j].w); }
        ss = wave_sum(ss);
        const float rstd = 1.0f / sqrtf(ss * (1.0f / D) + EPS);
        const int b = row >> 12; const float* mb = MOD + b * NMOD;
#pragma unroll
        for (int j = 0; j < 4; ++j) { const int col = 4 * F.lane + 256 * j;
            const f32x4 g = *(const f32x4*)(g2 + col), sh = *(const f32x4*)(mb + 3072 + col), sc = *(const f32x4*)(mb + 4096 + col);
            const f32x4 hv = (v[j] * rstd) * g * (sc + 1.0f) + sh;
            u32x2 w; w.x = cvtpk(hv.x, hv.y); w.y = cvtpk(hv.z, hv.w);
            *(u32x2*)(H2 + (size_t)row * D + col) = w; hq[j] = hv; }
        float am = 0.f;
#pragma unroll
        for (int j = 0; j < 4; ++j) am = fmaxf(fmaxf(am, fmaxf(fabsf(hq[j].x), fabsf(hq[j].y))), fmaxf(fabsf(hq[j].z), fabsf(hq[j].w)));
#pragma unroll
        for (int o = 1; o < 64; o <<= 1) am = fmaxf(am, __shfl_xor(am, o));
        const float sc = am > 0.f ? am * (1.0f / 127.0f) : 1.0f, inv = 1.0f / sc;
        v4u qa;
#pragma unroll
        for (int j = 0; j < 4; ++j) { const int b0 = (int)rintf(hq[j].x * inv), b1 = (int)rintf(hq[j].y * inv), b2 = (int)rintf(hq[j].z * inv), b3 = (int)rintf(hq[j].w * inv);
            qa[j] = (unsigned)(b0 & 255) | ((unsigned)(b1 & 255) << 8) | ((unsigned)(b2 & 255) << 16) | ((unsigned)(b3 & 255) << 24); }
        *(v4u*)(H2Q + (size_t)row * D + 16 * F.lane) = qa;
        if (F.lane == 0) H2S[row] = sc;
    }
}

__device__ __forceinline__ unsigned f2ord(float f) { const unsigned u = __float_as_uint(f); return u ^ ((unsigned)((int)u >> 31) | 0x80000000u); }
__device__ __forceinline__ float ord2f(unsigned o) { const unsigned u = (o & 0x80000000u) ? (o & 0x7fffffffu) : ~o; return __uint_as_float(u); }
#define CE_DESC(a, b) do { const unsigned _x = (a), _y = (b); (a) = _x > _y ? _x : _y; (b) = _x > _y ? _y : _x; } while (0)
__device__ __forceinline__ void sort16(unsigned (&k)[16]) {
#pragma unroll
    for (int size = 2; size <= 16; size <<= 1)
#pragma unroll
        for (int stride = size >> 1; stride > 0; stride >>= 1)
#pragma unroll
            for (int i = 0; i < 16; ++i) { const int j = i ^ stride; if (j > i) { if ((i & size) == 0) CE_DESC(k[i], k[j]); else CE_DESC(k[j], k[i]); } }
}
__device__ __forceinline__ void merge16(unsigned (&a)[16], const unsigned (&b)[16]) {
#pragma unroll
    for (int i = 0; i < 16; ++i) a[i] = a[i] > b[15 - i] ? a[i] : b[15 - i];
#pragma unroll
    for (int stride = 8; stride > 0; stride >>= 1)
#pragma unroll
        for (int i = 0; i < 16; ++i) { const int j = i ^ stride; if (j > i) CE_DESC(a[i], a[j]); }
}
__device__ __forceinline__ void top16_of_64(unsigned (&g0)[16], unsigned (&g1)[16], unsigned (&g2)[16], unsigned (&g3)[16]) {
    sort16(g0); sort16(g1); sort16(g2); sort16(g3);
    merge16(g0, g1); merge16(g2, g3); merge16(g0, g2);
}
constexpr int NCAND = 50;
__device__ __forceinline__ void p8a_topk(Frame& F) {
    const bf16* QP = (const bf16*)(F.ws + WS_QP); const bf16* SUBK = (const bf16*)(F.ws + WS_SUBK);
    unsigned short* PIDX = (unsigned short*)(F.ws + WS_PIDX); float* PG = (float*)(F.ws + WS_PG);
    LAS unsigned short* Elds = (LAS unsigned short*)(F.lds) + F.wave * (NCAND * 64);
    const int lane = F.lane, r32 = lane & 31, hi = lane >> 5;
    const int gw = F.vcu * NWAVES + F.wave, NGW = F.G * NWAVES;
    for (int item = gw; item < (M / 32) * 8; item += NGW) {
        const int tile = item >> 3;
        const int tok = tile * 32 + r32;
        { const int h = item & 7;
            unsigned top[2][16];
#pragma unroll
            for (int p = 0; p < 2; ++p) {
                bf16x8 qf[4];
                { const bf16* qp = QP + (size_t)tok * D + h * 128 + p * 64 + 8 * hi;
#pragma unroll
                  for (int ks = 0; ks < 4; ++ks) qf[ks] = *(const bf16x8*)(qp + 16 * ks); }
                const bf16* kp = SUBK + (size_t)((h * 2 + p) * 128 + r32) * 64 + 8 * hi;
                unsigned kk[4][16];
#pragma unroll
                for (int blk = 0; blk < 4; ++blk) {
                    f32x16 acc;
#pragma unroll
                    for (int r = 0; r < 16; ++r) acc[r] = 0.f;
#pragma unroll
                    for (int ks = 0; ks < 4; ++ks) { const bf16x8 a = *(const bf16x8*)(kp + (size_t)blk * 32 * 64 + 16 * ks); acc = MFMA32(a, qf[ks], acc); }
#pragma unroll
                    for (int r = 0; r < 16; ++r) { const int key = 32 * blk + crow(r, hi); kk[blk][r] = (f2ord(acc[r]) & ~127u) | (unsigned)(127 - key); }
                }
                top16_of_64(kk[0], kk[1], kk[2], kk[3]);
                unsigned other[16];
#pragma unroll
                for (int i = 0; i < 16; ++i) other[i] = (unsigned)__shfl_xor((int)kk[0][i], 32);
                merge16(kk[0], other);
#pragma unroll
                for (int i = 0; i < 16; ++i) top[p][i] = kk[0][i];
            }
            float s1[16], s2[16]; unsigned i1[16], i2[16];
#pragma unroll
            for (int i = 0; i < 16; ++i) { s1[i] = ord2f(top[0][i] & ~127u); i1[i] = 127u - (top[0][i] & 127u); s2[i] = ord2f(top[1][i] & ~127u); i2[i] = 127u - (top[1][i] & 127u); }
            unsigned ck[4][16];
#pragma unroll
            for (int c = 0; c < 64; ++c) {
                if (c < NCAND) { constexpr int CA[NCAND] = {0,0,0,0,0,0,0,0,0,0,0,0,0,0,0,0,1,1,1,1,1,1,1,1,2,2,2,2,2,3,3,3,3,4,4,4,5,5,6,6,7,7,8,9,10,11,12,13,14,15}; constexpr int CB[NCAND] = {0,1,2,3,4,5,6,7,8,9,10,11,12,13,14,15,0,1,2,3,4,5,6,7,0,1,2,3,4,0,1,2,3,0,1,2,0,1,0,1,0,1,0,0,0,0,0,0,0,0}; const int a = CA[c], b = CB[c];
                    ck[c >> 4][c & 15] = (f2ord(s1[a] + s2[b]) & ~63u) | (unsigned)(63 - c);
                    Elds[c * 64 + lane] = (unsigned short)(i1[a] * 128u + i2[b]); }
                else ck[c >> 4][c & 15] = 0u;
            }
            top16_of_64(ck[0], ck[1], ck[2], ck[3]);
            float w[16]; float wsum = 0.f; const float v0 = ord2f(ck[0][0] & ~63u);
#pragma unroll
            for (int r = 0; r < 16; ++r) { w[r] = __expf(ord2f(ck[0][r] & ~63u) - v0); wsum += w[r]; }
            const float winv = 1.0f / wsum;
#pragma unroll
            for (int r = 0; r < 16; ++r) if ((r >> 3) == hi) {
                const int c = 63 - (int)(ck[0][r] & 63u);
                const unsigned short eid = Elds[c * 64 + lane];
                PIDX[(size_t)tok * 128 + h * 16 + r] = eid; PG[(size_t)tok * 128 + h * 16 + r] = w[r] * winv; }
        }
    }
}

__device__ __forceinline__ float gelu_erf(float v) { return 0.5f * v * (1.0f + erff(v * 0.70710678118654752f)); }

#define PROBE_REPA 1
#define PROBE_REPB 1
constexpr int NR = 16, RSH = 17, BSA = 8, BSB = 4, ELP = 136;
__device__ __forceinline__ void sort128(unsigned& e0, unsigned& e1, int lane) {
#pragma unroll
    for (int size = 2; size <= 128; size <<= 1) {
#pragma unroll
        for (int stride = size >> 1; stride > 0; stride >>= 1) {
            if (stride == 64) { const unsigned lo = e0 < e1 ? e0 : e1, hi = e0 < e1 ? e1 : e0; e0 = lo; e1 = hi; }
            else {
                const bool lower = (lane & stride) == 0;
                const bool asc0 = (size == 128) ? true : (size == 64 ? true : ((lane & size) == 0));
                const bool asc1 = (size == 128) ? true : (size == 64 ? false : ((lane & size) == 0));
                const unsigned p0 = (unsigned)__shfl_xor((int)e0, stride), p1 = (unsigned)__shfl_xor((int)e1, stride);
                const unsigned mn0 = e0 < p0 ? e0 : p0, mx0 = e0 < p0 ? p0 : e0, mn1 = e1 < p1 ? e1 : p1, mx1 = e1 < p1 ? p1 : e1;
                e0 = (lower == asc0) ? mn0 : mx0; e1 = (lower == asc1) ? mn1 : mx1;
            }
        }
    }
}
template <int BS> __device__ __forceinline__ void sw_issue(v4u (&buf)[BS], const LAS unsigned* el, const unsigned char* tab, unsigned voff) {
#pragma unroll
    for (int i = 0; i < BS; ++i) { const unsigned off = (el[i] << 10) + voff;
        buf[i] = *(const v4u*)(tab + off); }
}
template <int BS> __device__ __forceinline__ void sw_proc_a(const v4u (&buf)[BS], const v4u& hq, LAS float* wl, int s, int n, int lane) {
    const int hx = (int)hq.x, hy = (int)hq.y, hz = (int)hq.z, hw = (int)hq.w;
    float dd[8];
#pragma unroll
    for (int i = 0; i < 8; ++i) dd[i] = 0.f;
#pragma unroll
    for (int i = 0; i < BS; ++i) if (i < n) { const int dx = (int)buf[i].x, dy = (int)buf[i].y, dz = (int)buf[i].z, dw = (int)buf[i].w;
        int t = __builtin_amdgcn_sdot4(hx, dx, 0, false); t = __builtin_amdgcn_sdot4(hy, dy, t, false); t = __builtin_amdgcn_sdot4(hz, dz, t, false); t = __builtin_amdgcn_sdot4(hw, dw, t, false);
        dd[i] = (float)t; }
    const bool b5 = (lane & 32) != 0, b4 = (lane & 16) != 0, b3 = (lane & 8) != 0;
    float r4[4];
#pragma unroll
    for (int u = 0; u < 4; ++u) { const float keep = b5 ? dd[u + 4] : dd[u], send = b5 ? dd[u] : dd[u + 4]; r4[u] = keep + __shfl_xor(send, 32); }
    float r2[2];
#pragma unroll
    for (int u = 0; u < 2; ++u) { const float keep = b4 ? r4[u + 2] : r4[u], send = b4 ? r4[u] : r4[u + 2]; r2[u] = keep + __shfl_xor(send, 16); }
    float r1; { const float keep = b3 ? r2[1] : r2[0], send = b3 ? r2[0] : r2[1]; r1 = keep + __shfl_xor(send, 8); }
    r1 += __shfl_xor(r1, 4); r1 += __shfl_xor(r1, 2); r1 += __shfl_xor(r1, 1);
    if ((lane & 7) == 0 && (lane >> 3) < n) wl[s + (lane >> 3)] = r1;
}
template <int BS> __device__ __forceinline__ void sw_proc_b(const v4u (&buf)[BS], f32x2_t (&acc)[8], const LAS float* wl, int s, int n) {
#pragma unroll
    for (int i = 0; i < BS; ++i) if (i < n) {
        const float w = wl[s + i];
        const f32x2_t wv = {w, w};
        const unsigned ux = buf[i].x, uy = buf[i].y, uz = buf[i].z, uw = buf[i].w;
        acc[0] += wv * __builtin_amdgcn_cvt_pk_f32_fp8((int)ux, false); acc[1] += wv * __builtin_amdgcn_cvt_pk_f32_fp8((int)ux, true);
        acc[2] += wv * __builtin_amdgcn_cvt_pk_f32_fp8((int)uy, false); acc[3] += wv * __builtin_amdgcn_cvt_pk_f32_fp8((int)uy, true);
        acc[4] += wv * __builtin_amdgcn_cvt_pk_f32_fp8((int)uz, false); acc[5] += wv * __builtin_amdgcn_cvt_pk_f32_fp8((int)uz, true);
        acc[6] += wv * __builtin_amdgcn_cvt_pk_f32_fp8((int)uw, false); acc[7] += wv * __builtin_amdgcn_cvt_pk_f32_fp8((int)uw, true); }
}
__device__ __forceinline__ void p8b_sweep(Frame& F) {
    const float* X1 = (const float*)(F.ws + WS_X1); const float* MOD = (const float*)(F.ws + WS_MOD);
    const unsigned char* H2Q = (const unsigned char*)(F.ws + WS_H2Q); const float* H2S = (const float*)(F.ws + WS_H2S);
    const unsigned char* EDq = (const unsigned char*)(F.ws + WS_ED); const unsigned char* EUq = (const unsigned char*)(F.ws + WS_EU); const float* EDS = (const float*)(F.ws + WS_EDS);
    const unsigned short* PIDX = (const unsigned short*)(F.ws + WS_PIDX); const float* PG = (const float*)(F.ws + WS_PG);
    const float* fg = F.in[17];
    const int gw = F.vcu * NWAVES + F.wave, NGW = F.G * NWAVES;
    for (int tb = gw; tb < M / 8; tb += NGW) {
        unsigned ones = ~0u; asm volatile("" : "+s"(ones));
        int lane = (int)__builtin_amdgcn_mbcnt_hi(ones, __builtin_amdgcn_mbcnt_lo(ones, 0u)); asm volatile("" : "+v"(lane));
        const int tok0 = tb * 8;
        unsigned E0[8], E1[8];
        LAS float* Wl = (LAS float*)(F.lds) + F.wave * 1024;
        LAS unsigned* El = (LAS unsigned*)(F.lds + 32768) + F.wave * (8 * ELP);
        unsigned voff = 16u * (unsigned)lane; asm volatile("" : "+v"(voff));
#pragma unroll
        for (int k = 0; k < 8; ++k) {
            const size_t base = (size_t)(tok0 + k) * 128;
            E0[k] = ((unsigned)PIDX[base + lane] << 7) | (unsigned)lane; E1[k] = ((unsigned)PIDX[base + 64 + lane] << 7) | (unsigned)(64 + lane);
            sort128(E0[k], E1[k], lane);
            El[k * ELP + lane] = E0[k] >> 7; El[k * ELP + 64 + lane] = E1[k] >> 7;
            if (lane < 8) El[k * ELP + 128 + lane] = (unsigned)__builtin_amdgcn_readlane((int)E1[k], 63) >> 7;
        }
        for (int repa = 0; repa < PROBE_REPA; ++repa) {
            v4u hq[8];
#pragma unroll
            for (int k = 0; k < 8; ++k) hq[k] = *(const v4u*)(H2Q + (size_t)(tok0 + k) * D + 16 * lane);
            int pos[8];
#pragma unroll
            for (int k = 0; k < 8; ++k) pos[k] = 0;
            v4u bA[BSA], bB[BSA]; int ps = 0, pn = 0;
            for (int r = 0; r < NR; ++r) {
#pragma unroll
                for (int k = 0; k < 8; ++k) {
                    constexpr int dummy = 0; (void)dummy;
                    const int kp = (k + 7) & 7;
                    const int c = __builtin_popcountll(__ballot((E0[k] >> RSH) == (unsigned)r)) + __builtin_popcountll(__ballot((E1[k] >> RSH) == (unsigned)r));
                    int s = __builtin_amdgcn_readfirstlane(pos[k]); const int e_end = __builtin_amdgcn_readfirstlane(s + c); pos[k] = e_end;
                    const int n1 = (e_end - s) < BSA ? (e_end - s) : BSA;
                    if (k & 1) sw_issue<BSA>(bB, El + k * ELP + s, EDq, voff); else sw_issue<BSA>(bA, El + k * ELP + s, EDq, voff);
                    if (pn > 0) { if (k & 1) sw_proc_a<BSA>(bA, hq[kp], Wl + kp * 128, ps, pn, lane); else sw_proc_a<BSA>(bB, hq[kp], Wl + kp * 128, ps, pn, lane); }
                    ps = s; pn = n1; s += n1;
                    for (; s < e_end; s += BSA) {
                        const int n = (e_end - s) < BSA ? (e_end - s) : BSA;
                        if (k & 1) { sw_issue<BSA>(bA, El + k * ELP + s, EDq, voff); sw_proc_a<BSA>(bA, hq[k], Wl + k * 128, s, n, lane); }
                        else       { sw_issue<BSA>(bB, El + k * ELP + s, EDq, voff); sw_proc_a<BSA>(bB, hq[k], Wl + k * 128, s, n, lane); }
                    }
                }
            }
            if (pn > 0) sw_proc_a<BSA>(bB, hq[7], Wl + 7 * 128, ps, pn, lane);
        }
#pragma unroll
        for (int k = 0; k < 8; ++k) { int tk = tok0 + k; asm volatile("" : "+s"(tk)); const size_t base = (size_t)tk * 128; const float sh = H2S[tk];
            const float r0 = Wl[k * 128 + lane], r1 = Wl[k * 128 + 64 + lane];
            Wl[k * 128 + lane] = PG[base + (E0[k] & 127u)] * gelu_erf(r0 * sh * EDS[E0[k] >> 7]) * 0.0625f;
            Wl[k * 128 + 64 + lane] = PG[base + (E1[k] & 127u)] * gelu_erf(r1 * sh * EDS[E1[k] >> 7]) * 0.0625f; }
        f32x2_t acc[8][8];
        for (int repb = 0; repb < PROBE_REPB; ++repb) {
#pragma unroll
            for (int k = 0; k < 8; ++k)
#pragma unroll
                for (int i = 0; i < 8; ++i) acc[k][i] = (f32x2_t){0.f, 0.f};
            int pos[8];
#pragma unroll
            for (int k = 0; k < 8; ++k) pos[k] = 0;
            v4u bA[BSB], bB[BSB]; int ps = 0, pn = 0;
            for (int r = 0; r < NR; ++r) {
#pragma unroll
                for (int k = 0; k < 8; ++k) {
                    const int kp = (k + 7) & 7;
                    const int c = __builtin_popcountll(__ballot((E0[k] >> RSH) == (unsigned)r)) + __builtin_popcountll(__ballot((E1[k] >> RSH) == (unsigned)r));
                    int s = __builtin_amdgcn_readfirstlane(pos[k]); const int e_end = __builtin_amdgcn_readfirstlane(s + c); pos[k] = e_end;
                    const int n1 = (e_end - s) < BSB ? (e_end - s) : BSB;
                    if (k & 1) sw_issue<BSB>(bB, El + k * ELP + s, EUq, voff); else sw_issue<BSB>(bA, El + k * ELP + s, EUq, voff);
                    if (pn > 0) { if (k & 1) sw_proc_b<BSB>(bA, acc[kp], Wl + kp * 128, ps, pn); else sw_proc_b<BSB>(bB, acc[kp], Wl + kp * 128, ps, pn); }
                    ps = s; pn = n1; s += n1;
                    for (; s < e_end; s += BSB) {
                        const int n = (e_end - s) < BSB ? (e_end - s) : BSB;
                        if (k & 1) { sw_issue<BSB>(bA, El + k * ELP + s, EUq, voff); sw_proc_b<BSB>(bA, acc[k], Wl + k * 128, s, n); }
                        else       { sw_issue<BSB>(bB, El + k * ELP + s, EUq, voff); sw_proc_b<BSB>(bB, acc[k], Wl + k * 128, s, n); }
                    }
                }
            }
            if (pn > 0) sw_proc_b<BSB>(bB, acc[7], Wl + 7 * 128, ps, pn);
        }
        int ln = lane; asm volatile("" : "+v"(ln));
#pragma unroll
        for (int k = 0; k < 8; ++k) {
            const int tok = tok0 + k; const int b = tok >> 12; const float* gt2 = MOD + b * NMOD + 5120;
            f32x4 x2[4]; float ss = 0.f;
#pragma unroll
            for (int j = 0; j < 4; ++j) { const int col = 4 * ln + 256 * j;
                const f32x4 xv = *(const f32x4*)(X1 + (size_t)tok * D + col), gv4 = *(const f32x4*)(gt2 + col);
#pragma unroll
                for (int i = 0; i < 4; ++i) { const float v = xv[i] + gv4[i] * acc[k][2 * j + (i >> 1)][i & 1]; x2[j][i] = v; ss += v * v; } }
            ss = wave_sum(ss);
            const float rstd = 1.0f / sqrtf(ss * (1.0f / D) + EPS);
#pragma unroll
            for (int j = 0; j < 4; ++j) { const int col = 4 * ln + 256 * j; const f32x4 gg = *(const f32x4*)(fg + col);
                *(f32x4*)(F.out + (size_t)tok * D + col) = x2[j] * rstd * gg; }
        }
    }
}

struct Args { const float* in[18]; float* out; unsigned char* ws; };
__global__ void __launch_bounds__(NTHR, 2) mega_fwd(Args args) {
    extern __shared__ __attribute__((aligned(16))) unsigned char lds[];
    Frame F;
    F.lds = (LAS unsigned char*)lds;
    F.tid = threadIdx.x; F.lane = F.tid & 63; F.wave = __builtin_amdgcn_readfirstlane(F.tid >> 6);
    F.G = gridDim.x; { const int bx = blockIdx.x; F.vcu = (F.G % 8 == 0) ? (bx % 8) * (F.G / 8) + bx / 8 : bx; }
#pragma unroll
    for (int i = 0; i < 18; ++i) F.in[i] = args.in[i];
    F.out = args.out; F.ws = args.ws;
    volatile LAS unsigned* MISC = (volatile LAS unsigned*)(F.lds + MISC_OFF);
    for (int u = F.tid; u < (LDS_BYTES - LDSCTL_OFF) / 4; u += NTHR) ((LAS unsigned*)(F.lds + LDSCTL_OFF))[u] = 0u;
    __syncthreads();
    gu32* ctl = (gu32*)(F.ws + WS_CTL);
    XcdBarrier bar = xcd_barrier_post((unsigned*)(ctl + CW_BAR), MISC + 8);
#define GRID_BAR() xcd_barrier(bar)
#define PROBE_DBL -1

    p0_prologue(F); GRID_BAR();
    if (PROBE_DBL == 0) { p0_prologue(F); GRID_BAR(); }
    p1_norm(F); GRID_BAR();
    if (PROBE_DBL == 1) { p1_norm(F); GRID_BAR(); }
    {
        pg8::Gemm g{(const pg8::bf16_t*)(F.ws + WS_H), (const pg8::bf16_t*)(F.ws + WS_WIN), M, NPROJ, D, nullptr, nullptr};
        pg8::StaticOrder S; S.init(M, NPROJ, F.G, (int)blockIdx.x);
        pg8::EpiBf16<0> E{(pg8::bf16_t*)(F.ws + WS_PROJ), NPROJ, nullptr, 0, 0, 1.f};
        pg8::gemm_phase<pg8::EpiBf16<0>, pg8::StaticOrder, true, true>(F.lds + RING_OFF, g, S, E);
    }
    GRID_BAR();
    p3_attention(F); GRID_BAR();
    if (PROBE_DBL == 3) { p3_attention(F); GRID_BAR(); }
    {
        pg8::Gemm g{(const pg8::bf16_t*)(F.ws + WS_OA), (const pg8::bf16_t*)(F.ws + WS_WA), M, D, 512, (const pg8::bf16_t*)(F.ws + WS_OB), (const pg8::bf16_t*)(F.ws + WS_WB)};
        PairOrder S; S.S.init(M, D, F.G, (int)blockIdx.x);
        EpiGate E{(const bf16*)(F.ws + WS_PROJ), (bf16*)F.out, (bf16*)F.out + (size_t)M * D};
        pg8::gemm_phase<EpiGate, PairOrder, false, true>(F.lds + RING_OFF, g, S, E);
    }
    GRID_BAR();
    {
        pg8::Gemm g{(const pg8::bf16_t*)((bf16*)F.out + (size_t)M * D), (const pg8::bf16_t*)(F.ws + WS_WOUT), M, D, D, nullptr, nullptr};
        pg8::StaticOrder S; S.init(M, D, F.G, (int)blockIdx.x);
        EpiRes E{F.in[0], (const float*)(F.ws + WS_MOD), (float*)(F.ws + WS_X1)};
        pg8::gemm_phase<EpiRes, pg8::StaticOrder, false, true>(F.lds + RING_OFF, g, S, E);
    }
    GRID_BAR();
    p6_norm2(F); GRID_BAR();
    if (PROBE_DBL == 6) { p6_norm2(F); GRID_BAR(); }
    {
        pg8::Gemm g{(const pg8::bf16_t*)(F.ws + WS_H2), (const pg8::bf16_t*)(F.ws + WS_WQ), M, D, D, nullptr, nullptr};
        pg8::StaticOrder S; S.init(M, D, F.G, (int)blockIdx.x);
        pg8::EpiBf16<0> E{(pg8::bf16_t*)(F.ws + WS_QP), D, nullptr, 0, 0, 1.f};
        pg8::gemm_phase<pg8::EpiBf16<0>, pg8::StaticOrder, false, true>(F.lds + RING_OFF, g, S, E);
    }
    GRID_BAR();
    p8a_topk(F); GRID_BAR();
    if (PROBE_DBL == 8) { p8a_topk(F); GRID_BAR(); }
    p8b_sweep(F);
    if (PROBE_DBL == 9) { GRID_BAR(); p8b_sweep(F); }
}

extern "C" void kernel_launch(void* const* d_in, const int* in_sizes, int n_in, void* d_out, int out_size, void* d_ws, size_t ws_size, hipStream_t stream) {
    static int grid = 0;
    if (grid == 0) {
        if (n_in != 18 || in_sizes[0] != M * D || out_size != M * D || ws_size < WS_END) { fprintf(stderr, "kernel_launch: unexpected shapes (n_in %d, in0 %d, out %d, ws %zu)\n", n_in, n_in > 0 ? in_sizes[0] : -1, out_size, ws_size); grid = -1; return; }
        int dev = 0, cus = 0, per_cu = 0;
        if (hipGetDevice(&dev) != hipSuccess || hipDeviceGetAttribute(&cus, hipDeviceAttributeMultiprocessorCount, dev) != hipSuccess) { grid = -1; return; }
        if (hipFuncSetAttribute((const void*)mega_fwd, hipFuncAttributeMaxDynamicSharedMemorySize, LDS_BYTES) != hipSuccess) { fprintf(stderr, "kernel_launch: hipFuncSetAttribute failed\n"); grid = -1; return; }
        if (hipOccupancyMaxActiveBlocksPerMultiprocessor(&per_cu, (const void*)mega_fwd, NTHR, LDS_BYTES) != hipSuccess || per_cu < 1) { fprintf(stderr, "kernel_launch: occupancy query says %d blocks per CU\n", per_cu); }
        (void)hipGetLastError();
        grid = cus;
    }
    if (grid < 0) return;
    if (hipMemsetAsync((char*)d_ws + WS_CTL, 0, CTL_ZERO_BYTES, stream) != hipSuccess) { fprintf(stderr, "kernel_launch: memset failed\n"); return; }
    Args a{};
    for (int i = 0; i < 18; ++i) a.in[i] = (const float*)d_in[i];
    a.out = (float*)d_out; a.ws = (unsigned char*)d_ws;
    hipLaunchKernelGGL(mega_fwd, dim3(grid), dim3(NTHR), LDS_BYTES, stream, a);
}
```

```cpp
#include <hip/hip_runtime.h>
#include <cstdio>
#include <cstdint>
namespace pg8 {
#define PG8_LAS __attribute__((address_space(3)))
typedef unsigned short bf16_t;
typedef short bf16x8 __attribute__((ext_vector_type(8)));
typedef float f32x4 __attribute__((ext_vector_type(4)));
typedef unsigned u32x4 __attribute__((ext_vector_type(4)));
constexpr int BM = 256, BK = 64, HALF = 128, HTB = HALF * BK * 2  , STAGE_BYTES = 8 * HTB, NXCD = 8, WGM = 8;

__host__ __device__ __forceinline__ int lds_byte(int r, int c) { const int st = (r >> 4) * 2 + (c >> 5), rr = r & 15, cc = c & 31, ob = rr * 64 + cc * 2; return st * 1024 + (ob ^ (((ob >> 9) & 1) << 5)); }
__host__ __device__ __forceinline__ void stage_rc(int b, int& R, int& C) { const int st = b / 1024, sb = b % 1024, swz = sb ^ (((sb >> 9) & 1) << 5); R = (st >> 1) * 16 + swz / 64; C = (st & 1) * 32 + (swz % 64) / 2; }
__host__ __device__ __forceinline__ int perm32(int rho) { const int n = rho >> 4, i = rho & 15; return 8 * (i >> 2) + 4 * n + (i & 3); }

struct Unit { int pm, pn, src; };
struct Gemm { const bf16_t* A; const bf16_t* Bt; int M, N, K; const bf16_t* A2; const bf16_t* Bt2; };

struct StaticOrder {
    int nM, nN, nwg, G, c;
    __host__ __device__ void init(int M, int N, int G_, int c_) { nM = M / BM; nN = N / BM; nwg = nM * nN; G = G_; c = c_; }
    __host__ __device__ bool next(int i, Unit& u) const {
        const long L = (long)i * G + c; if (L >= nwg) return false;
        int wgid = (int)L; { const int q = nwg / NXCD, r = nwg % NXCD, xcd = wgid % NXCD, off = wgid / NXCD; wgid = (xcd < r ? xcd * (q + 1) : r * (q + 1) + (xcd - r) * q) + off; }
        const int nig = WGM * nN, gid = wgid / nig, fm = gid * WGM, gsz = (nM - fm) < WGM ? (nM - fm) : WGM;
        u.pm = fm + ((wgid % nig) % gsz); u.pn = (wgid % nig) / gsz; u.src = 0; return true;
    }
    __device__ __forceinline__ void a_ready(const Unit&) const {}
    __device__ __forceinline__ void done(const Unit&) const {}
};

__device__ __forceinline__ unsigned cvt_pk_bf16(float lo, float hi) { unsigned r; asm volatile("v_cvt_pk_bf16_f32 %0, %1, %2" : "=v"(r) : "v"(lo), "v"(hi)); return r; }
typedef float f32x2 __attribute__((ext_vector_type(2)));
__device__ __forceinline__ f32x2 gelu_pk(f32x2 v) {
    const f32x2 av = __builtin_elementwise_abs(v), d = av * 0.2316418882f + 1.0f;
    f32x2 t; t.x = __builtin_amdgcn_rcpf(d.x); t.y = __builtin_amdgcn_rcpf(d.y);
    f32x2 q = t * 0.5307027145f + (-0.7265760135f); q = q * t + 0.7107068705f; q = q * t + (-0.142248368f); q = q * t + 0.127414796f; q = q * t;
    const f32x2 s = (v * v) * (-0.72134752044f);
    f32x2 e; e.x = __builtin_amdgcn_exp2f(s.x); e.y = __builtin_amdgcn_exp2f(s.y);
    const f32x2 m = v * (q * e), r = v - m;
    f32x2 o; o.x = v.x < 0.f ? m.x : r.x; o.y = v.y < 0.f ? m.y : r.y; return o;
}

template <int ACT  > struct EpiBf16 {
    static constexpr bool PERM = true, AFTER_DRAIN = false; static_assert(ACT == 0 || ACT == 1, "EpiBf16: ACT is 0 (none) or 1 (gelu_pk)");
    bf16_t* O; int ldc; const float* bias; int split_cols; size_t split_stride; float scale0;
    __device__ __forceinline__ void operator()(const f32x4 (&acc)[2][2][4][2], const Unit& u, int wr, int wc, int fr, int fq) const {
        const int row0 = u.pm * BM + wr * 64 + fr; int colt = u.pn * BM; bf16_t* base = O;
        float sc = 1.f; if (split_cols) { const int t = colt / split_cols; base += (size_t)t * split_stride; colt -= t * split_cols; if (t == 0) sc = scale0; }
        const int col0 = colt + wc * 32 + 8 * fq, bcol0 = u.pn * BM + wc * 32 + 8 * fq;
        f32x4 bv[2][2];
#pragma unroll
        for (int bj = 0; bj < 2; ++bj)
#pragma unroll
            for (int n = 0; n < 2; ++n) bv[bj][n] = bias ? *(const f32x4*)(bias + bcol0 + bj * HALF + 4 * n) : (f32x4){0.f, 0.f, 0.f, 0.f};
#pragma unroll
        for (int ai = 0; ai < 2; ++ai)
#pragma unroll
            for (int m = 0; m < 4; ++m) { bf16_t* rowp = base + (size_t)(row0 + ai * HALF + m * 16) * ldc + col0;
#pragma unroll
                for (int bj = 0; bj < 2; ++bj) { f32x4 v0 = acc[ai][bj][m][0] + bv[bj][0], v1 = acc[ai][bj][m][1] + bv[bj][1];
                    if (ACT == 1) { f32x2 a = gelu_pk((f32x2){v0[0], v0[1]}), b = gelu_pk((f32x2){v0[2], v0[3]}), c = gelu_pk((f32x2){v1[0], v1[1]}), d = gelu_pk((f32x2){v1[2], v1[3]});
                        v0 = (f32x4){a.x, a.y, b.x, b.y}; v1 = (f32x4){c.x, c.y, d.x, d.y}; }
                    v0 = v0 * sc; v1 = v1 * sc; u32x4 w; w.x = cvt_pk_bf16(v0[0], v0[1]); w.y = cvt_pk_bf16(v0[2], v0[3]); w.z = cvt_pk_bf16(v1[0], v1[1]); w.w = cvt_pk_bf16(v1[2], v1[3]);
                    *(u32x4*)(rowp + bj * HALF) = w; } }
    }
};

template <class Epi, class Sched, bool ALIGN_EPI = false, bool SP2 = false>
__device__ __forceinline__ void gemm_phase(PG8_LAS unsigned char* lds, const Gemm g, const Sched& S, const Epi& E) {
    const int tid = threadIdx.x, wid = __builtin_amdgcn_readfirstlane(tid >> 6), lane = tid & 63, wr = wid >> 2, wc = wid & 3, fr = lane & 15, fq = lane >> 4;
    const int K = g.K, nt = K / BK;
    unsigned voffA[2], voffB[2];
#pragma unroll
    for (int i = 0; i < 2; ++i) { int R, C; stage_rc(tid * 16 + i * 8192, R, C); const int Rb = Epi::PERM ? ((R & ~31) + perm32(R & 31)) : R;
        voffA[i] = (unsigned)(R * K + C) * 2u; voffB[i] = (unsigned)(Rb * K + C) * 2u; }
    const size_t kstep = (size_t)(BK * 2);
    const size_t hstep = (size_t)HALF * K * 2;
    const size_t tstep = 2 * hstep;
    const unsigned ldsw = (unsigned)wid * 1024u;
    const int aoff = lds_byte(wr * 64 + fr, fq * 8), boff = lds_byte(wc * 32 + fr, fq * 8);
#define PG8_SA(b, h) (((b) * 2 + (h)) * HTB)
#define PG8_SB(b, h) ((4 + (b) * 2 + (h)) * HTB)
#define PG8_STAGE(bufoff, gbase, voff) do { _Pragma("unroll") for (int _i = 0; _i < 2; ++_i) \
        __builtin_amdgcn_global_load_lds((const unsigned*)((const char*)(gbase) + (voff)[_i]), (PG8_LAS unsigned*)(lds + (bufoff) + ldsw + _i * 8192), 16, 0, 0); } while (0)
#define PG8_LDA(dst, b, h) do { _Pragma("unroll") for (int m = 0; m < 4; ++m) _Pragma("unroll") for (int k = 0; k < 2; ++k) dst[m][k] = *(const PG8_LAS bf16x8*)(lds + PG8_SA(b, h) + aoff + m * 2048 + k * 1024); } while (0)
#define PG8_LDB(dst, b, h) do { _Pragma("unroll") for (int n = 0; n < 2; ++n) _Pragma("unroll") for (int k = 0; k < 2; ++k) dst[n][k] = *(const PG8_LAS bf16x8*)(lds + PG8_SB(b, h) + boff + n * 2048 + k * 1024); } while (0)
#define PG8_MMA(ai, bj, At, Bt) do { __builtin_amdgcn_s_setprio(1); _Pragma("unroll") for (int m = 0; m < 4; ++m) _Pragma("unroll") for (int n = 0; n < 2; ++n) _Pragma("unroll") for (int k = 0; k < 2; ++k) \
        acc[ai][bj][m][n] = __builtin_amdgcn_mfma_f32_16x16x32_bf16(Bt[n][k], At[m][k], acc[ai][bj][m][n], 0, 0, 0); __builtin_amdgcn_s_setprio(0); } while (0)
#define PG8_WAIT_V(n) asm volatile("s_waitcnt vmcnt(" #n ")" ::: "memory")
#define PG8_WAIT_L(n) asm volatile("s_waitcnt lgkmcnt(" #n ")" ::: "memory")
#define PG8_BAR __builtin_amdgcn_s_barrier()
#define PG8_SCHED __builtin_amdgcn_sched_barrier(0)
    Unit cur, nxt; int ui = 0;
    if (!S.next(0, cur)) return;
    f32x4 acc[2][2][4][2];
#pragma unroll
    for (int a = 0; a < 2; ++a)
#pragma unroll
        for (int b = 0; b < 2; ++b)
#pragma unroll
            for (int m = 0; m < 4; ++m)
#pragma unroll
                for (int n = 0; n < 2; ++n) acc[a][b][m][n] = (f32x4){0.f, 0.f, 0.f, 0.f};
    bf16x8 At[4][2], B0[2][2], B1[2][2];
    const char* cA = (const char*)(cur.src ? g.A2 : g.A) + (size_t)cur.pm * tstep; const char* cB = (const char*)(cur.src ? g.Bt2 : g.Bt) + (size_t)cur.pn * tstep;
    S.a_ready(cur);
    if constexpr (SP2) {
        PG8_STAGE(PG8_SB(0, 0), cB, voffB); PG8_STAGE(PG8_SB(0, 1), cB + hstep, voffB); PG8_STAGE(PG8_SA(0, 0), cA, voffA); PG8_STAGE(PG8_SA(0, 1), cA + hstep, voffA);
        if (wr == 1) PG8_BAR;
        PG8_WAIT_V(2); PG8_BAR;
        PG8_STAGE(PG8_SB(1, 0), cB + kstep, voffB); PG8_STAGE(PG8_SA(1, 0), cA + kstep, voffA); PG8_STAGE(PG8_SB(1, 1), cB + hstep + kstep, voffB);
        PG8_WAIT_V(6); PG8_BAR;
    } else {
        PG8_STAGE(PG8_SB(0, 0), cB, voffB); PG8_STAGE(PG8_SA(0, 0), cA, voffA); PG8_STAGE(PG8_SB(0, 1), cB + hstep, voffB); PG8_STAGE(PG8_SA(0, 1), cA + hstep, voffA);
        if (wr == 1) PG8_BAR;
        PG8_WAIT_V(4); PG8_BAR;
        PG8_STAGE(PG8_SB(1, 0), cB + kstep, voffB); PG8_STAGE(PG8_SA(1, 0), cA + kstep, voffA); PG8_STAGE(PG8_SB(1, 1), cB + hstep + kstep, voffB);
        PG8_WAIT_V(6); PG8_BAR;
    }
    for (;;) {
        const bool has_next = S.next(ui + 1, nxt);
        const char* nA = has_next ? (const char*)(nxt.src ? g.A2 : g.A) + (size_t)nxt.pm * tstep : cA; const char* nB = has_next ? (const char*)(nxt.src ? g.Bt2 : g.Bt) + (size_t)nxt.pn * tstep : cB;
        for (int t = 0; t < nt; t += 2) {
            const bool last = (t == nt - 2);
            const char* a1 = cA + (size_t)(t + 1) * kstep;
            const char* a2 = last ? nA : cA + (size_t)(t + 2) * kstep; const char* b2 = last ? nB : cB + (size_t)(t + 2) * kstep;
            const char* a3 = a2 + kstep; const char* b3 = b2 + kstep;
            if (last && has_next) S.a_ready(nxt);
            if constexpr (SP2) {
            PG8_LDB(B0, 0, 0); PG8_LDB(B1, 0, 1); PG8_SCHED; PG8_LDA(At, 0, 0); PG8_STAGE(PG8_SA(1, 1), a1 + hstep, voffA);
            PG8_WAIT_V(8); PG8_WAIT_L(0); PG8_BAR; PG8_MMA(0, 0, At, B0); PG8_MMA(0, 1, At, B1); PG8_BAR; PG8_SCHED;
            PG8_LDA(At, 0, 1); PG8_STAGE(PG8_SB(0, 0), b2, voffB); PG8_STAGE(PG8_SB(0, 1), b2 + hstep, voffB); PG8_STAGE(PG8_SA(0, 0), a2, voffA);
            PG8_WAIT_V(8); PG8_WAIT_L(0); PG8_BAR; PG8_MMA(1, 0, At, B0); PG8_MMA(1, 1, At, B1); PG8_BAR; PG8_SCHED;
            PG8_LDB(B0, 1, 0); PG8_LDB(B1, 1, 1); PG8_SCHED; PG8_LDA(At, 1, 0); PG8_STAGE(PG8_SA(0, 1), a2 + hstep, voffA);
            PG8_WAIT_V(8); PG8_WAIT_L(0); PG8_BAR; PG8_MMA(0, 0, At, B0); PG8_MMA(0, 1, At, B1); PG8_BAR; PG8_SCHED;
            PG8_LDA(At, 1, 1); PG8_STAGE(PG8_SB(1, 0), b3, voffB); PG8_STAGE(PG8_SB(1, 1), b3 + hstep, voffB); PG8_STAGE(PG8_SA(1, 0), a3, voffA);
            PG8_WAIT_V(8); PG8_WAIT_L(0); PG8_BAR; PG8_MMA(1, 0, At, B0); PG8_MMA(1, 1, At, B1); PG8_BAR; PG8_SCHED;
            } else {
            PG8_LDB(B0, 0, 0); PG8_SCHED; PG8_LDA(At, 0, 0); PG8_STAGE(PG8_SA(1, 1), a1 + hstep, voffA);
            PG8_WAIT_L(8); PG8_BAR; PG8_WAIT_L(0); PG8_MMA(0, 0, At, B0); PG8_BAR; PG8_SCHED;
            PG8_LDB(B1, 0, 1); PG8_STAGE(PG8_SB(0, 0), b2, voffB);
            PG8_BAR; PG8_WAIT_L(0); PG8_MMA(0, 1, At, B1); PG8_BAR;
            PG8_LDA(At, 0, 1); PG8_STAGE(PG8_SA(0, 0), a2, voffA);
            PG8_BAR; PG8_WAIT_L(0); PG8_MMA(1, 0, At, B0); PG8_BAR; PG8_SCHED;
            PG8_STAGE(PG8_SB(0, 1), b2 + hstep, voffB);
            PG8_WAIT_V(6); PG8_BAR; PG8_MMA(1, 1, At, B1); PG8_BAR;
            PG8_LDB(B0, 1, 0); PG8_SCHED; PG8_LDA(At, 1, 0); PG8_STAGE(PG8_SA(0, 1), a2 + hstep, voffA);
            PG8_WAIT_L(8); PG8_BAR; PG8_WAIT_L(0); PG8_MMA(0, 0, At, B0); PG8_BAR; PG8_SCHED;
            PG8_LDB(B1, 1, 1); PG8_STAGE(PG8_SB(1, 0), b3, voffB);
            PG8_BAR; PG8_WAIT_L(0); PG8_MMA(0, 1, At, B1); PG8_BAR;
            PG8_LDA(At, 1, 1); PG8_STAGE(PG8_SA(1, 0), a3, voffA);
            PG8_BAR; PG8_WAIT_L(0); PG8_MMA(1, 0, At, B0); PG8_BAR; PG8_SCHED;
            PG8_STAGE(PG8_SB(1, 1), b3 + hstep, voffB);
            PG8_WAIT_V(6); PG8_BAR; PG8_MMA(1, 1, At, B1); PG8_BAR;
            }
        }
        if constexpr (ALIGN_EPI) { if (wr == 0) PG8_BAR; }
        if constexpr (!Epi::AFTER_DRAIN) { E(acc, cur, wr, wc, fr, fq); S.done(cur); }
        if (!has_next) break;
#pragma unroll
        for (int a = 0; a < 2; ++a)
#pragma unroll
            for (int b = 0; b < 2; ++b)
#pragma unroll
                for (int m = 0; m < 4; ++m)
#pragma unroll
                    for (int n = 0; n < 2; ++n) acc[a][b][m][n] = (f32x4){0.f, 0.f, 0.f, 0.f};
        cur = nxt; cA = nA; cB = nB; ++ui;
        if constexpr (ALIGN_EPI) { if (wr == 1) PG8_BAR; }
    }
    PG8_WAIT_V(0);
    if constexpr (!ALIGN_EPI) { if (wr == 0) PG8_BAR; }
    PG8_BAR;
    if constexpr (Epi::AFTER_DRAIN) { E.fused(acc, cur, wr, wc, fr, fq, lds, wid, lane); S.done(cur); }
#undef PG8_SA
#undef PG8_SB
#undef PG8_STAGE
#undef PG8_LDA
#undef PG8_LDB
#undef PG8_MMA
#undef PG8_WAIT_V
#undef PG8_WAIT_L
#undef PG8_BAR
#undef PG8_SCHED
}
}

#define GAS __attribute__((address_space(1)))
#define LAS __attribute__((address_space(3)))
typedef unsigned short bf16;
typedef unsigned v4u __attribute__((ext_vector_type(4)));
typedef float f32x4 __attribute__((ext_vector_type(4)));
typedef short bf16x8 __attribute__((ext_vector_type(8)));
typedef GAS unsigned gu32;
typedef GAS unsigned long long gu64;
#define RLX_AGENT __ATOMIC_RELAXED, __HIP_MEMORY_SCOPE_AGENT
#define LDS_WAIT() asm volatile("s_waitcnt lgkmcnt(0)" ::: "memory")
#define VM_WAIT() asm volatile("s_waitcnt vmcnt(0)" ::: "memory")
__device__ __forceinline__ unsigned long long rt() { return __builtin_amdgcn_s_memrealtime(); }
__device__ __forceinline__ unsigned f2bf(float f) { unsigned u = __builtin_bit_cast(unsigned, f); return (u + 0x7fffu + ((u >> 16) & 1u)) >> 16; }
__device__ __forceinline__ unsigned pk2(float lo, float hi) { return f2bf(lo) | (f2bf(hi) << 16); }

#define XB_TMO      128
#define XB_XCNT(j)  (256  + 64 * (j))
#define XB_XSUB(j)  (1280 + 64 * (j))
#define XB_XGEN(j)  (2304 + 64 * (j))
#define XB_TOP      3328
#define XB_TOPGEN   3392
#define XCD_BAR_WORDS 3456
#define XB_SPIN_CAP (1u << 18)

__device__ __forceinline__ unsigned xb_ld(unsigned* p)              { return __hip_atomic_load(p, __ATOMIC_RELAXED, __HIP_MEMORY_SCOPE_AGENT); }
__device__ __forceinline__ unsigned xb_add(unsigned* p, unsigned v) { return __hip_atomic_fetch_add(p, v, __ATOMIC_RELAXED, __HIP_MEMORY_SCOPE_AGENT); }
__device__ __forceinline__ unsigned xb_xcc_id() { return (unsigned)__builtin_amdgcn_s_getreg((3 << 11) | 20) & 0xFu; }
#define XB_SPIN(cond, bar) do { unsigned _sp = 0; while (cond) { __builtin_amdgcn_s_sleep(1); \
    if ((++_sp & 255u) == 0u) { if (xb_ld(&(bar)[XB_TMO])) break; if (_sp > XB_SPIN_CAP) { atomicAdd(&(bar)[XB_TMO], 1u); break; } } } } while (0)

struct XcdBarrier {
    unsigned* bar; unsigned x;
    volatile LAS unsigned* st;
};

__device__ __forceinline__ XcdBarrier xcd_barrier_post(unsigned* bar, volatile LAS unsigned* st) {
    XcdBarrier b; b.bar = bar; b.x = xb_xcc_id(); b.st = st;
    if (threadIdx.x == 0) (void)xb_add(&bar[XB_XCNT(b.x)], 1u);
    return b;
}
__device__ __forceinline__ void xcd_barrier_complete(unsigned* bar, unsigned x, unsigned& nloc, unsigned& nx) {
    const unsigned G = gridDim.x * gridDim.y * gridDim.z;
    unsigned sum, cnt, mine, sp = 0u;
    for (;;) {
        sum = 0u; cnt = 0u; mine = 0u;
#pragma unroll
        for (unsigned j = 0; j < 16; ++j) { const unsigned c = xb_ld(&bar[XB_XCNT(j)]); sum += c; cnt += (c > 0u) ? 1u : 0u; mine = (j == x) ? c : mine; }
        if (sum == G) break;
        __builtin_amdgcn_s_sleep(1);
        if ((++sp & 255u) == 0u) { if (xb_ld(&bar[XB_TMO])) break; if (sp > XB_SPIN_CAP) { atomicAdd(&bar[XB_TMO], 1u); break; } }
    }
    nloc = mine > 0u ? mine : 1u; nx = cnt > 0u ? cnt : 1u;
}

__device__ __forceinline__ void xcd_barrier(const XcdBarrier& b) {
    asm volatile("s_waitcnt vmcnt(0)" ::: "memory");
    __syncthreads();
    if (threadIdx.x == 0) {
        unsigned* bar = b.bar;
        __builtin_amdgcn_s_waitcnt(0);
        unsigned nloc = b.st[0], nx = b.st[1];
        if (nloc == 0u) { xcd_barrier_complete(bar, b.x, nloc, nx); b.st[0] = nloc; b.st[1] = nx; }
        const unsigned old = xb_add(&bar[XB_XSUB(b.x)], 1u);
        const unsigned gen = old / nloc;
        if (old + 1u == (gen + 1u) * nloc) {
            __builtin_amdgcn_fence(__ATOMIC_RELEASE, "agent");
            asm volatile("s_waitcnt vmcnt(0)" ::: "memory");
            const unsigned og = xb_add(&bar[XB_TOP], 1u);
            const unsigned tg = og / nx;
            if (og + 1u == (tg + 1u) * nx) xb_add(&bar[XB_TOPGEN], 1u);
            else XB_SPIN(xb_ld(&bar[XB_TOPGEN]) == tg, bar);
            __builtin_amdgcn_fence(__ATOMIC_ACQUIRE, "agent");
            xb_add(&bar[XB_XGEN(b.x)], 1u);
            asm volatile("s_waitcnt vmcnt(0)" ::: "memory");
        } else {
            XB_SPIN(xb_ld(&bar[XB_XGEN(b.x)]) == gen, bar);
            __builtin_amdgcn_fence(__ATOMIC_ACQUIRE, "agent");
            asm volatile("s_waitcnt vmcnt(0)" ::: "memory");
        }
    }
    __syncthreads();
}

constexpr int NWAVES = 8, NTHR = 512;
constexpr int BATCH = 4, SEQ = 4096, D = 1024, M = BATCH * SEQ;
constexpr int NPROJ = 4352, LDW_IN = 4360, NMOD = 6144;
constexpr int C_QA = 0, C_KA = 512, C_VA = 640, C_QB = 768, C_KB = 1280, C_VB = 1792, C_GLA = 2304, C_GLB = 3328;
constexpr int NEXP = 16384;
constexpr float EPS = 1e-6f;

constexpr size_t MiB = 1u << 20;
constexpr size_t WS_CTL = 0, CTL_ZERO_BYTES = 1 * MiB;
constexpr size_t WS_MOD = 1 * MiB, WS_LOGF = 1 * MiB + 128 * 1024, WS_SUBK = 2 * MiB;
constexpr size_t WS_WIN = 4 * MiB, WS_WA = 12 * MiB + 512 * 1024, WS_WB = 13 * MiB + 512 * 1024, WS_WOUT = 14 * MiB + 512 * 1024, WS_WQ = 16 * MiB + 512 * 1024;
constexpr size_t WS_ED = 19 * MiB, WS_EU = 35 * MiB;
constexpr size_t WS_EDS = 2 * MiB + 512 * 1024;
constexpr size_t WS_H2Q = 95 * MiB, WS_H2S = 111 * MiB;
constexpr size_t WS_H = 83 * MiB, WS_OA = 83 * MiB, WS_OB = 99 * MiB, WS_PIDX = 83 * MiB, WS_PG = 87 * MiB;
constexpr size_t WS_PROJ = 115 * MiB, WS_X1 = 115 * MiB, WS_H2 = 179 * MiB, WS_QP = 211 * MiB;
constexpr size_t WS_END = 251 * MiB;
static_assert(WS_WIN + (size_t)NPROJ * D * 2 <= WS_WA && WS_WQ + (size_t)D * D * 2 <= WS_ED && WS_PROJ + (size_t)M * NPROJ * 2 <= WS_END, "ws map");
constexpr int CW_BAR = 4096;

constexpr int RING_OFF = 0, RING_BYTES = 131072;
constexpr int LDSCTL_OFF = RING_BYTES, MISC_OFF = LDSCTL_OFF + 320;
constexpr int LDS_BYTES = 147456;

typedef float f32x16 __attribute__((ext_vector_type(16)));
typedef short s16x4 __attribute__((ext_vector_type(4)));
typedef unsigned u32x2 __attribute__((ext_vector_type(2)));
typedef float f32x2_t __attribute__((ext_vector_type(2)));
typedef __bf16 bf16x2_t __attribute__((ext_vector_type(2)));

__device__ __forceinline__ unsigned cvtpk(float lo, float hi) { f32x2_t v = {lo, hi}; bf16x2_t b = __builtin_convertvector(v, bf16x2_t); return __builtin_bit_cast(unsigned, b); }
__device__ __forceinline__ float bflo(unsigned u) { return __uint_as_float(u << 16); }
__device__ __forceinline__ float bfhi(unsigned u) { return __uint_as_float(u & 0xffff0000u); }
__device__ __forceinline__ float wave_sum(float v) {
#pragma unroll
    for (int o = 1; o < 64; o <<= 1) v += __shfl_xor(v, o);
    return v;
}
__device__ __forceinline__ int crow(int r, int hi) { return (r & 3) + 8 * (r >> 2) + 4 * hi; }
#define MFMA32(a, b, c) __builtin_amdgcn_mfma_f32_32x32x16_bf16((a), (b), (c), 0, 0, 0)

struct Frame {
    LAS unsigned char* lds;
    int tid, lane, wave, vcu, G;
};
__device__ __forceinline__ const void* karg(int i) {
    unsigned long z = 0; asm volatile("" : "+s"(z));
    const char* base = (const char*)__builtin_amdgcn_kernarg_segment_ptr();
    return *(const void* const*)(base + 8 * i + z);
}

__device__ __forceinline__ void p0_transpose_item(const float* W, int ld, int K, int ncols, bf16* WT, int row_off, LAS float* scr, int item, int lane) {
    const int nblk = ncols / 32, kb = item / nblk, nb = item % nblk, k0 = 64 * kb, n0 = 32 * nb;
#pragma unroll 8
    for (int i = 0; i < 32; ++i) { const int kk = 2 * i + (lane >> 5); scr[kk * 33 + (lane & 31)] = W[(size_t)(k0 + kk) * ld + n0 + (lane & 31)]; }
    LDS_WAIT(); asm volatile("" ::: "memory");
    const int c = lane & 7;
#pragma unroll
    for (int j = 0; j < 4; ++j) { const int n = (lane >> 3) + 8 * j; const LAS float* s = scr + (8 * c) * 33 + n;
        v4u o; o.x = pk2(s[0 * 33], s[1 * 33]); o.y = pk2(s[2 * 33], s[3 * 33]); o.z = pk2(s[4 * 33], s[5 * 33]); o.w = pk2(s[6 * 33], s[7 * 33]);
        *(GAS v4u*)(WT + (size_t)(row_off + n0 + n) * K + k0 + 8 * c) = o; }
    LDS_WAIT(); asm volatile("" ::: "memory");
}
__device__ __forceinline__ void p0_convert(const float* __restrict__ src, bf16* __restrict__ dst, long n_iters, int gw, int NGW, int lane) {
    for (long it0 = (long)gw * 4; it0 < n_iters; it0 += (long)NGW * 4) {
        f32x4 a[4][2];
#pragma unroll
        for (int u = 0; u < 4; ++u) { const long it = it0 + u; if (it < n_iters) { const float* p = src + it * 512 + lane * 4; a[u][0] = *(const f32x4*)p; a[u][1] = *(const f32x4*)(p + 256); } }
#pragma unroll
        for (int u = 0; u < 4; ++u) { const long it = it0 + u; if (it < n_iters) { bf16* q = dst + it * 512 + lane * 4;
            u32x2 w0, w1; w0.x = cvtpk(a[u][0].x, a[u][0].y); w0.y = cvtpk(a[u][0].z, a[u][0].w); w1.x = cvtpk(a[u][1].x, a[u][1].y); w1.y = cvtpk(a[u][1].z, a[u][1].w);
            *(u32x2*)q = w0; *(u32x2*)(q + 256) = w1; } }
    }
}

__device__ __forceinline__ void p0_quant_tables(Frame& F, int gw, int NGW) {
    const float* ed = ((const float*)karg(15)); const float* eu = ((const float*)karg(16));
    unsigned char* EDq = (unsigned char*)(((unsigned char*)karg(19)) + WS_ED); unsigned char* EUq = (unsigned char*)(((unsigned char*)karg(19)) + WS_EU); float* EDS = (float*)(((unsigned char*)karg(19)) + WS_EDS);
    const int lane = F.lane;
    for (int row0 = gw * 2; row0 < NEXP; row0 += NGW * 2) {
        f32x4 a[2][4], u[2][4];
#pragma unroll
        for (int q = 0; q < 2; ++q)
#pragma unroll
            for (int j = 0; j < 4; ++j) { a[q][j] = *((const f32x4*)(ed + (size_t)(row0 + q) * D) + lane + 64 * j); u[q][j] = *((const f32x4*)(eu + (size_t)(row0 + q) * D) + lane + 64 * j); }
#pragma unroll
        for (int q = 0; q < 2; ++q) {
            float am = 0.f;
#pragma unroll
            for (int j = 0; j < 4; ++j) am = fmaxf(fmaxf(am, fmaxf(fabsf(a[q][j].x), fabsf(a[q][j].y))), fmaxf(fabsf(a[q][j].z), fabsf(a[q][j].w)));
#pragma unroll
            for (int o = 1; o < 64; o <<= 1) am = fmaxf(am, __shfl_xor(am, o));
            const float sc = am > 0.f ? am * (1.0f / 127.0f) : 1.0f, inv = 1.0f / sc;
            v4u qa, qu;
#pragma unroll
            for (int j = 0; j < 4; ++j) {
                const int b0 = (int)rintf(a[q][j].x * inv), b1 = (int)rintf(a[q][j].y * inv), b2 = (int)rintf(a[q][j].z * inv), b3 = (int)rintf(a[q][j].w * inv);
                qa[j] = (unsigned)(b0 & 255) | ((unsigned)(b1 & 255) << 8) | ((unsigned)(b2 & 255) << 16) | ((unsigned)(b3 & 255) << 24);
                int p = __builtin_amdgcn_cvt_pk_fp8_f32(u[q][j].x * 16.0f, u[q][j].y * 16.0f, 0, false);
                p = __builtin_amdgcn_cvt_pk_fp8_f32(u[q][j].z * 16.0f, u[q][j].w * 16.0f, p, true);
                qu[j] = (unsigned)p;
            }
            *(v4u*)(EDq + (size_t)(row0 + q) * D + 16 * lane) = qa;
            *(v4u*)(EUq + (size_t)(row0 + q) * D + 16 * lane) = qu;
            if (lane == 0) EDS[row0 + q] = sc;
        }
    }
}
__device__ __forceinline__ void p0_prologue(Frame& F) {
    const float* c = ((const float*)karg(1)); const float* w_ada = ((const float*)karg(4)); const float* b_ada = ((const float*)karg(5));
    float* MOD = (float*)(((unsigned char*)karg(19)) + WS_MOD);
    {
        LAS float* cact = (LAS float*)(F.lds);
        LAS float* part = (LAS float*)(F.lds + 16384);
        bool did = false;
        for (int item = F.vcu; item < NMOD / 32; item += F.G) {
            if (!did) { for (int i = F.tid; i < 4096; i += NTHR) { const float cv = c[i]; cact[i] = cv / (1.0f + __expf(-cv)); } did = true; }
            __syncthreads();
            const int n0 = item * 32, col = n0 + (F.lane & 31), ksub = F.lane >> 5;
            float a0 = 0.f, a1 = 0.f, a2 = 0.f, a3 = 0.f;
#pragma unroll 16
            for (int it = 0; it < 64; ++it) { const int k = (it * 8 + F.wave) * 2 + ksub; const float w = w_ada[(size_t)k * NMOD + col];
                a0 += cact[k] * w; a1 += cact[1024 + k] * w; a2 += cact[2048 + k] * w; a3 += cact[3072 + k] * w; }
            a0 += __shfl_xor(a0, 32); a1 += __shfl_xor(a1, 32); a2 += __shfl_xor(a2, 32); a3 += __shfl_xor(a3, 32);
            if (F.lane < 32) { part[(F.wave * 4 + 0) * 32 + F.lane] = a0; part[(F.wave * 4 + 1) * 32 + F.lane] = a1; part[(F.wave * 4 + 2) * 32 + F.lane] = a2; part[(F.wave * 4 + 3) * 32 + F.lane] = a3; }
            __syncthreads();
            if (F.tid < 128) { const int b = F.tid >> 5, cl = F.tid & 31; float s = 0.f;
#pragma unroll
                for (int w = 0; w < 8; ++w) s += part[(w * 4 + b) * 32 + cl];
                MOD[b * NMOD + n0 + cl] = s + b_ada[n0 + cl]; }
            __syncthreads();
        }
    }
    LAS float* scr = (LAS float*)(F.lds + RING_OFF + F.wave * 16384);
    const int gw = F.vcu * NWAVES + F.wave, NGW = F.G * NWAVES;
    constexpr int I_IN1 = (D / 64) * (2304 / 32), I_IN2 = (D / 64) * (2048 / 32), I_AB = (512 / 64) * (D / 32), I_SQ = (D / 64) * (D / 32);
    constexpr int NITEMS = I_IN1 + I_IN2 + 2 * I_AB + 2 * I_SQ;
    bf16* Win_t = (bf16*)(((unsigned char*)karg(19)) + WS_WIN);
    for (int it = gw; it < NITEMS; it += NGW) {
        int r = it;
        if (r < I_IN1) { p0_transpose_item(((const float*)karg(6)), LDW_IN, D, 2304, Win_t, 0, scr, r, F.lane); continue; } r -= I_IN1;
        if (r < I_IN2) { p0_transpose_item(((const float*)karg(6)) + 2312, LDW_IN, D, 2048, Win_t, 2304, scr, r, F.lane); continue; } r -= I_IN2;
        if (r < I_AB) { p0_transpose_item(((const float*)karg(9)), D, 512, D, (bf16*)(((unsigned char*)karg(19)) + WS_WA), 0, scr, r, F.lane); continue; } r -= I_AB;
        if (r < I_AB) { p0_transpose_item(((const float*)karg(10)), D, 512, D, (bf16*)(((unsigned char*)karg(19)) + WS_WB), 0, scr, r, F.lane); continue; } r -= I_AB;
        if (r < I_SQ) { p0_transpose_item(((const float*)karg(11)), D, D, D, (bf16*)(((unsigned char*)karg(19)) + WS_WOUT), 0, scr, r, F.lane); continue; } r -= I_SQ;
        p0_transpose_item(((const float*)karg(13)), D, D, D, (bf16*)(((unsigned char*)karg(19)) + WS_WQ), 0, scr, r, F.lane);
    }
    p0_quant_tables(F, gw, NGW);
    p0_convert(((const float*)karg(14)), (bf16*)(((unsigned char*)karg(19)) + WS_SUBK), (long)(8 * 2 * 128 * 64) / 512, gw, NGW, F.lane);
}

__device__ __forceinline__ void p1_norm(Frame& F) {
    const float* x = ((const float*)karg(0)); const float* g1 = ((const float*)karg(2)); const float* w_in = ((const float*)karg(6)); const float* b_forget = ((const float*)karg(7));
    const float* MOD = (const float*)(((unsigned char*)karg(19)) + WS_MOD); bf16* H = (bf16*)(((unsigned char*)karg(19)) + WS_H); float* LOGF = (float*)(((unsigned char*)karg(19)) + WS_LOGF);
    LAS float* wfl = (LAS float*)(F.lds);
    { float tmp[16];
#pragma unroll
      for (int n = 0; n < 16; ++n) { const int i = F.tid + n * NTHR; tmp[n] = w_in[(size_t)(i >> 3) * LDW_IN + 2304 + (i & 7)]; }
#pragma unroll
      for (int n = 0; n < 16; ++n) { const int i = F.tid + n * NTHR; wfl[(i & 7) * 1024 + (i >> 3)] = tmp[n]; } }
    __syncthreads();
    const int gw = F.vcu * NWAVES + F.wave, NGW = F.G * NWAVES;
    f32x4 cur[4], nxt[4];
    if (gw < M) { const f32x4* xr = (const f32x4*)(x + (size_t)gw * D) + F.lane;
#pragma unroll
        for (int j = 0; j < 4; ++j) cur[j] = xr[64 * j]; }
    for (int row = gw; row < M; row += NGW) {
        { const int nrow = row + NGW; if (nrow < M) { const f32x4* xr = (const f32x4*)(x + (size_t)nrow * D) + F.lane;
#pragma unroll
            for (int j = 0; j < 4; ++j) nxt[j] = xr[64 * j]; } }
        {{
        float ss = 0.f;
#pragma unroll
        for (int j = 0; j < 4; ++j) ss += (cur[j].x * cur[j].x + cur[j].y * cur[j].y) + (cur[j].z * cur[j].z + cur[j].w * cur[j].w);
        ss = wave_sum(ss);
        const float rstd = 1.0f / sqrtf(ss * (1.0f / D) + EPS);
        const int b = row >> 12; const float* mb = MOD + b * NMOD;
        float fl[8];
#pragma unroll
        for (int jj = 0; jj < 8; ++jj) fl[jj] = 0.f;
#pragma unroll
        for (int j = 0; j < 4; ++j) { const int col = 4 * F.lane + 256 * j;
            const f32x4 g = *(const f32x4*)(g1 + col), sh = *(const f32x4*)(mb + col), sc = *(const f32x4*)(mb + 1024 + col);
            const f32x4 hv = (cur[j] * rstd) * g * (sc + 1.0f) + sh;
            u32x2 w; w.x = cvtpk(hv.x, hv.y); w.y = cvtpk(hv.z, hv.w);
            *(u32x2*)(H + (size_t)row * D + col) = w;
#pragma unroll
            for (int jj = 0; jj < 8; ++jj) { const f32x4 wv = *(const LAS f32x4*)(wfl + jj * 1024 + col); fl[jj] += (hv.x * wv.x + hv.y * wv.y) + (hv.z * wv.z + hv.w * wv.w); }
        }
        const int lane = F.lane; const bool b5 = (lane & 32) != 0, b4 = (lane & 16) != 0, b3 = (lane & 8) != 0;
        float r4[4];
#pragma unroll
        for (int u = 0; u < 4; ++u) { const float keep = b5 ? fl[u + 4] : fl[u], send = b5 ? fl[u] : fl[u + 4]; r4[u] = keep + __shfl_xor(send, 32); }
        float r2[2];
#pragma unroll
        for (int u = 0; u < 2; ++u) { const float keep = b4 ? r4[u + 2] : r4[u], send = b4 ? r4[u] : r4[u + 2]; r2[u] = keep + __shfl_xor(send, 16); }
        float r1; { const float keep = b3 ? r2[1] : r2[0], send = b3 ? r2[0] : r2[1]; r1 = keep + __shfl_xor(send, 8); }
        r1 += __shfl_xor(r1, 4); r1 += __shfl_xor(r1, 2); r1 += __shfl_xor(r1, 1);
        if ((lane & 7) == 0) { const int jj = lane >> 3; const float z = r1 + b_forget[jj]; const float ls = fminf(z, 0.f) - log1pf(__expf(-fabsf(z))); LOGF[(size_t)row * 8 + jj] = ls; }
        }}
#pragma unroll
        for (int j = 0; j < 4; ++j) cur[j] = nxt[j];
    }
}

constexpr int KP = 72;
constexpr int VPF = 68;
constexpr int VPS = 260;
struct FlashState { f32x16 o[2]; float m, l; };

__device__ __forceinline__ void flash_tail(FlashState& st, f32x16& s0, f32x16& s1, const LAS bf16* Vs, int vp, int r32, int hi) {
    float mt = s0[0];
#pragma unroll
    for (int r = 1; r < 16; ++r) mt = fmaxf(mt, s0[r]);
#pragma unroll
    for (int r = 0; r < 16; ++r) mt = fmaxf(mt, s1[r]);
    mt = fmaxf(mt, __shfl_xor(mt, 32));
    const float mn = fmaxf(st.m, mt);
    const float alpha = __expf(st.m - mn);
    st.m = mn;
    float ps = 0.f;
#pragma unroll
    for (int r = 0; r < 16; ++r) { s0[r] = __expf(s0[r] - mn); ps += s0[r]; }
#pragma unroll
    for (int r = 0; r < 16; ++r) { s1[r] = __expf(s1[r] - mn); ps += s1[r]; }
    st.l = st.l * alpha + ps;
#pragma unroll
    for (int r = 0; r < 16; ++r) { st.o[0][r] *= alpha; st.o[1][r] *= alpha; }
#pragma unroll
    for (int blk = 0; blk < 2; ++blk)
#pragma unroll
        for (int s = 0; s < 2; ++s) {
            v4u pw;
            if (blk == 0) { pw.x = cvtpk(s0[8 * s + 0], s0[8 * s + 1]); pw.y = cvtpk(s0[8 * s + 2], s0[8 * s + 3]); pw.z = cvtpk(s0[8 * s + 4], s0[8 * s + 5]); pw.w = cvtpk(s0[8 * s + 6], s0[8 * s + 7]); }
            else          { pw.x = cvtpk(s1[8 * s + 0], s1[8 * s + 1]); pw.y = cvtpk(s1[8 * s + 2], s1[8 * s + 3]); pw.z = cvtpk(s1[8 * s + 4], s1[8 * s + 5]); pw.w = cvtpk(s1[8 * s + 6], s1[8 * s + 7]); }
            const bf16x8 pf = __builtin_bit_cast(bf16x8, pw);
#pragma unroll
            for (int db = 0; db < 2; ++db) {
                const LAS bf16* vp0 = Vs + (32 * db + r32) * vp + 32 * blk + 16 * s + 4 * hi;
                const s16x4 lo = *(const LAS s16x4*)vp0, hh = *(const LAS s16x4*)(vp0 + 8);
                const bf16x8 vf = __builtin_shufflevector(lo, hh, 0, 1, 2, 3, 4, 5, 6, 7);
                st.o[db] = MFMA32(vf, pf, st.o[db]);
            }
        }
}
__device__ __forceinline__ void flash_qk(f32x16& s0, f32x16& s1, const bf16x8 (&qf)[4], const LAS bf16* Ks, int r32, int hi) {
    s0 = (f32x16){0.f}; s1 = (f32x16){0.f};
#pragma unroll
    for (int r = 0; r < 16; ++r) { s0[r] = 0.f; s1[r] = 0.f; }
#pragma unroll
    for (int ks = 0; ks < 4; ++ks) {
        const bf16x8 a0 = *(const LAS bf16x8*)(Ks + r32 * KP + 16 * ks + 8 * hi);
        const bf16x8 a1 = *(const LAS bf16x8*)(Ks + (32 + r32) * KP + 16 * ks + 8 * hi);
        s0 = MFMA32(a0, qf[ks], s0); s1 = MFMA32(a1, qf[ks], s1);
    }
}
__device__ __forceinline__ void flash_store(const FlashState& st, bf16* orow, int hi) {
    float lt = st.l + __shfl_xor(st.l, 32);
    const float inv = 1.0f / lt;
#pragma unroll
    for (int db = 0; db < 2; ++db)
#pragma unroll
        for (int rg = 0; rg < 4; ++rg) { u32x2 w; w.x = cvtpk(st.o[db][4 * rg] * inv, st.o[db][4 * rg + 1] * inv); w.y = cvtpk(st.o[db][4 * rg + 2] * inv, st.o[db][4 * rg + 3] * inv);
            *(u32x2*)(orow + 32 * db + 8 * rg + 4 * hi) = w; }
}

__device__ __forceinline__ void fox_unit(Frame& F, int b, int h, int qb, float& kmax2) {
    const bf16* proj = (const bf16*)(((unsigned char*)karg(19)) + WS_PROJ); const float* LOGF = (const float*)(((unsigned char*)karg(19)) + WS_LOGF); bf16* OB = (bf16*)(((unsigned char*)karg(19)) + WS_OB);
    LAS float* Fs = (LAS float*)(F.lds);
    LAS float* wtot = (LAS float*)(F.lds + 16384);
    LAS bf16* Kb = (LAS bf16*)(F.lds + 16384 + 128);
    LAS bf16* Vb = (LAS bf16*)(F.lds + 16384 + 128 + 2 * 64 * KP * 2);
    const int lane = F.lane, wave = F.wave, tid = F.tid, r32 = lane & 31, hi = lane >> 5;
    const int q_end = 256 * (qb + 1), NT = q_end / 64;
    const size_t rowbase = (size_t)b * SEQ;
    {
        float v[8]; float run = 0.f;
#pragma unroll
        for (int i = 0; i < 8; ++i) { const int pos = tid * 8 + i; const float lf = (pos < q_end) ? LOGF[(rowbase + pos) * 8 + h] : 0.f; run += lf; v[i] = run; }
        float inc = run;
#pragma unroll
        for (int o = 1; o < 64; o <<= 1) { const float t = __shfl_up(inc, o); if (lane >= o) inc += t; }
        if (lane == 63) wtot[wave] = inc;
        __syncthreads();
        float off = inc - run;
        for (int w = 0; w < wave; ++w) off += wtot[w];
#pragma unroll
        for (int i = 0; i < 8; ++i) Fs[tid * 8 + i] = v[i] + off;
    }
    const int qrow = 256 * qb + 32 * wave + r32;
    bf16x8 qf[4];
    { const bf16* qp = proj + (rowbase + qrow) * NPROJ + C_QB + 64 * h + 8 * hi;
#pragma unroll
      for (int ks = 0; ks < 4; ++ks) qf[ks] = *(const bf16x8*)(qp + 16 * ks); }
    const int tq = 4 * qb + (wave >> 1);
    {
        float qn = 0.f;
#pragma unroll
        for (int ks = 0; ks < 4; ++ks)
#pragma unroll
            for (int j = 0; j < 8; ++j) { const float e = __uint_as_float(((unsigned)(unsigned short)qf[ks][j]) << 16); qn += e * e; }
        qn += __shfl_xor(qn, 32);
#pragma unroll
        for (int o = 1; o < 32; o <<= 1) qn = fmaxf(qn, __shfl_xor(qn, o));
        float kn = 0.f;
        if (kmax2 < 0.f) {
            for (int pos = tid; pos < q_end; pos += NTHR) { const v4u* kr = (const v4u*)(proj + (rowbase + pos) * NPROJ + C_KB + 64 * h); float s = 0.f;
#pragma unroll
                for (int c8 = 0; c8 < 8; ++c8) { const v4u w = kr[c8]; const unsigned wx = w.x, wy = w.y, wz = w.z, ww = w.w;
                    s += bflo(wx) * bflo(wx) + bfhi(wx) * bfhi(wx) + bflo(wy) * bflo(wy) + bfhi(wy) * bfhi(wy) + bflo(wz) * bflo(wz) + bfhi(wz) * bfhi(wz) + bflo(ww) * bflo(ww) + bfhi(ww) * bfhi(ww); }
                kn = fmaxf(kn, s); }
#pragma unroll
            for (int o = 1; o < 64; o <<= 1) kn = fmaxf(kn, __shfl_xor(kn, o));
        }
        if (lane == 0) { wtot[8 + wave] = qn; wtot[16 + wave] = kn; }
    }
    FlashState st; st.m = -INFINITY; st.l = 0.f;
#pragma unroll
    for (int r = 0; r < 16; ++r) { st.o[0][r] = 0.f; st.o[1][r] = 0.f; }
    const int srow = tid >> 3, sch = tid & 7;
    const bf16* kg = proj + (rowbase + srow) * NPROJ + C_KB + 64 * h + 8 * sch;
    const bf16* vg = proj + (rowbase + srow) * NPROJ + C_VB + 64 * h + 8 * sch;
    v4u kreg, vreg;
    { const size_t o = (size_t)(NT - 1) * 64 * NPROJ; kreg = *(const v4u*)(kg + o); vreg = *(const v4u*)(vg + o); }
    int cur = 0;
    {   *(LAS v4u*)(Kb + srow * KP + 8 * sch) = kreg;
        const unsigned short* vs = (const unsigned short*)&vreg;
#pragma unroll
        for (int i = 0; i < 8; ++i) Vb[(8 * sch + i) * VPF + srow] = vs[i];
    }
    __syncthreads();
    const float fq = Fs[qrow];
    int t_lo = 0;
    {
        float qm = 0.f, km = 0.f;
#pragma unroll
        for (int w = 0; w < 8; ++w) { qm = fmaxf(qm, wtot[8 + w]); km = fmaxf(km, wtot[16 + w]); }
        if (kmax2 < 0.f) kmax2 = km;
        const float A = 0.125f * sqrtf(qm) * sqrtf(kmax2) * 1.01f, f0 = Fs[256 * qb];
        for (int t = NT - 5; t >= 0; --t) if (Fs[64 * t + 63] - f0 > 2.0f * A + 60.0f) { t_lo = t + 1; break; }
    }
    for (int t = NT - 1; t >= t_lo; --t) {
        if (t > t_lo) { const size_t o = (size_t)(t - 1) * 64 * NPROJ; kreg = *(const v4u*)(kg + o); vreg = *(const v4u*)(vg + o); }
        if (t <= tq) {
            const LAS bf16* Ks = Kb + cur * 64 * KP; const LAS bf16* Vs = Vb + cur * 64 * VPF;
            f32x16 s0, s1; flash_qk(s0, s1, qf, Ks, r32, hi);
            const LAS float* Fk = Fs + 64 * t;
            const bool diag = (t == tq);
#pragma unroll
            for (int rg = 0; rg < 4; ++rg) {
                const f32x4 f0 = *(const LAS f32x4*)(Fk + 8 * rg + 4 * hi), f1 = *(const LAS f32x4*)(Fk + 32 + 8 * rg + 4 * hi);
#pragma unroll
                for (int i = 0; i < 4; ++i) { const int r = 4 * rg + i; const int kv = 64 * t + 8 * rg + 4 * hi + i;
                    float a = s0[r] * 0.125f + (fq - f0[i]); float c = s1[r] * 0.125f + (fq - f1[i]);
                    if (diag) { if (kv > qrow) a = -INFINITY; if (kv + 32 > qrow) c = -INFINITY; }
                    s0[r] = a; s1[r] = c; }
            }
            flash_tail(st, s0, s1, Vs, VPF, r32, hi);
        }
        if (t > t_lo) {
            const int nb = cur ^ 1;
            *(LAS v4u*)(Kb + nb * 64 * KP + srow * KP + 8 * sch) = kreg;
            const unsigned short* vs = (const unsigned short*)&vreg;
#pragma unroll
            for (int i = 0; i < 8; ++i) Vb[nb * 64 * VPF + (8 * sch + i) * VPF + srow] = vs[i];
        }
        __syncthreads();
        cur ^= 1;
    }
    flash_store(st, OB + (rowbase + qrow) * 512 + 64 * h, hi);
    __syncthreads();
}

__device__ const unsigned char T5_BUCKET[128] = {0,1,2,3,4,5,6,7,8,9,10,11,12,13,14,15,16,16,16,17,17,18,18,18,19,19,19,20,20,20,20,21,21,21,21,22,22,22,22,22,23,23,23,23,23,23,24,24,24,24,24,24,25,25,25,25,25,25,25,26,26,26,26,26,26,26,26,27,27,27,27,27,27,27,27,27,27,28,28,28,28,28,28,28,28,28,28,29,29,29,29,29,29,29,29,29,29,29,29,30,30,30,30,30,30,30,30,30,30,30,30,30,30,31,31,31,31,31,31,31,31,31,31,31,31,31,31,31};

__device__ __forceinline__ void swa_unit(Frame& F, int b, int kvh, int n) {
    const bf16* proj = (const bf16*)(((unsigned char*)karg(19)) + WS_PROJ); bf16* OA = (bf16*)(((unsigned char*)karg(19)) + WS_OA);
    const float* sinks = ((const float*)karg(8)); const float* rel_bias = ((const float*)karg(12));
    LAS bf16* Kb = (LAS bf16*)(F.lds);
    LAS bf16* Vb = (LAS bf16*)(F.lds + 36864);
    LAS float* bt = (LAS float*)(F.lds + 36864 + 33280);
    const int lane = F.lane, wave = F.wave, tid = F.tid, r32 = lane & 31, hi = lane >> 5;
    const size_t rowbase = (size_t)b * SEQ;
    {
        const int g = tid >> 7, d = tid & 127;
        bt[tid] = rel_bias[(int)T5_BUCKET[d] * 8 + kvh * 4 + g];
#pragma unroll
        for (int i = 0; i < 4; ++i) {
            const int idx = tid + i * NTHR, kb = idx >> 3, sch = idx & 7; const int pos = 128 * (n - 1) + kb;
            v4u kreg = (v4u){0u, 0u, 0u, 0u}, vreg = (v4u){0u, 0u, 0u, 0u};
            if (pos >= 0) { const bf16* p = proj + (rowbase + pos) * NPROJ + 64 * kvh + 8 * sch; kreg = *(const v4u*)(p + C_KA); vreg = *(const v4u*)(p + C_VA); }
            *(LAS v4u*)(Kb + kb * KP + 8 * sch) = kreg;
            const unsigned short* vs = (const unsigned short*)&vreg;
#pragma unroll
            for (int j = 0; j < 8; ++j) Vb[(8 * sch + j) * VPS + kb] = vs[j];
        }
    }
    __syncthreads();
    const int g = wave & 3, qh = wave >> 2, head = kvh * 4 + g;
    const LAS float* btg = bt + g * 128;
    for (int sb = 0; sb < 2; ++sb) {
        const int qrel0 = 64 * qh + 32 * sb, qrel = qrel0 + r32;
        const size_t row = rowbase + 128 * n + qrel;
        bf16x8 qf[4];
        { const bf16* qp = proj + row * NPROJ + C_QA + 64 * head + 8 * hi;
#pragma unroll
          for (int ks = 0; ks < 4; ++ks) qf[ks] = *(const bf16x8*)(qp + 16 * ks); }
        FlashState st; st.m = sinks[head]; st.l = (hi == 0) ? 1.0f : 0.0f;
#pragma unroll
        for (int r = 0; r < 16; ++r) { st.o[0][r] = 0.f; st.o[1][r] = 0.f; }
        const int t_lo = (qrel0 + 1) >> 6, t_hi = (qrel0 + 159) >> 6;
        for (int t = t_lo; t <= t_hi; ++t) {
            f32x16 s0, s1; flash_qk(s0, s1, qf, Kb + t * 64 * KP, r32, hi);
#pragma unroll
            for (int r = 0; r < 16; ++r) {
                const int kb0 = 64 * t + crow(r, hi), kb1 = kb0 + 32;
                const int d0 = 128 + qrel - kb0, d1 = d0 - 32;
                const bool v0 = (d0 >= 0) && (d0 < 128) && (n > 0 || kb0 >= 128);
                const bool v1 = (d1 >= 0) && (d1 < 128) && (n > 0 || kb1 >= 128);
                const float b0 = btg[d0 & 127], b1 = btg[d1 & 127];
                s0[r] = v0 ? (s0[r] * 0.125f + b0) : -INFINITY;
                s1[r] = v1 ? (s1[r] * 0.125f + b1) : -INFINITY;
            }
            flash_tail(st, s0, s1, Vb + 64 * t, VPS, r32, hi);
        }
        flash_store(st, OA + row * 512 + 64 * head, hi);
    }
    __syncthreads();
}
__device__ __forceinline__ void p3_attention(Frame& F) {
    for (int item = F.vcu; item < 256; item += F.G) {
        swa_unit(F, item >> 6, (item >> 5) & 1, item & 31);
        const int bh = item >> 3, j = item & 7;
        float kmax2 = -1.0f;
        fox_unit(F, bh >> 3, bh & 7, 15 - j, kmax2);
        fox_unit(F, bh >> 3, bh & 7, j, kmax2);
    }
}

struct PairOrder {
    pg8::StaticOrder S;
    __device__ bool next(int i, pg8::Unit& u) const { if (!S.next(i >> 1, u)) return false; u.src = i & 1; return true; }
    __device__ __forceinline__ void a_ready(const pg8::Unit&) const {}
    __device__ __forceinline__ void done(const pg8::Unit&) const {}
};
__device__ __forceinline__ float sigmoidf_(float z) { return 1.0f / (1.0f + __expf(-z)); }
struct EpiGate {
    static constexpr bool PERM = false, AFTER_DRAIN = false;
    const bf16* proj; bf16* tmp; bf16* mixed;
    __device__ __forceinline__ void operator()(const pg8::f32x4 (&acc)[2][2][4][2], const pg8::Unit& u, int wr, int wc, int fr, int fq) const {
        const int goff = u.src ? C_GLB : C_GLA;
#pragma unroll
        for (int ai = 0; ai < 2; ++ai)
#pragma unroll
            for (int m = 0; m < 4; ++m) { const size_t row = (size_t)u.pm * 256 + ai * 128 + wr * 64 + m * 16 + fr;
#pragma unroll
                for (int bj = 0; bj < 2; ++bj)
#pragma unroll
                    for (int n = 0; n < 2; ++n) { const int col = u.pn * 256 + bj * 128 + wc * 32 + n * 16 + 4 * fq;
                        const u32x2 gw = *(const u32x2*)(proj + row * NPROJ + goff + col);
                        const pg8::f32x4 a = acc[ai][bj][m][n];
                        float v0 = a[0] * sigmoidf_(bflo(gw.x)), v1 = a[1] * sigmoidf_(bfhi(gw.x)), v2 = a[2] * sigmoidf_(bflo(gw.y)), v3 = a[3] * sigmoidf_(bfhi(gw.y));
                        if (u.src == 0) { u32x2 w; w.x = cvtpk(v0, v1); w.y = cvtpk(v2, v3); *(u32x2*)(tmp + row * D + col) = w; }
                        else { const u32x2 t = *(const u32x2*)(tmp + row * D + col);
                            u32x2 w; w.x = cvtpk(v0 + bflo(t.x), v1 + bfhi(t.x)); w.y = cvtpk(v2 + bflo(t.y), v3 + bfhi(t.y)); *(u32x2*)(mixed + row * D + col) = w; }
                    }
            }
    }
};
struct EpiRes {
    static constexpr bool PERM = false, AFTER_DRAIN = false;
    const float* x; const float* mod; float* x1;
    __device__ __forceinline__ void operator()(const pg8::f32x4 (&acc)[2][2][4][2], const pg8::Unit& u, int wr, int wc, int fr, int fq) const {
#pragma unroll
        for (int ai = 0; ai < 2; ++ai)
#pragma unroll
            for (int m = 0; m < 4; ++m) { const size_t row = (size_t)u.pm * 256 + ai * 128 + wr * 64 + m * 16 + fr; const int b = (int)(row >> 12);
#pragma unroll
                for (int bj = 0; bj < 2; ++bj)
#pragma unroll
                    for (int n = 0; n < 2; ++n) { const int col = u.pn * 256 + bj * 128 + wc * 32 + n * 16 + 4 * fq;
                        const pg8::f32x4 xin = *(const pg8::f32x4*)(x + row * D + col), gt = *(const pg8::f32x4*)(mod + b * NMOD + 2048 + col);
                        *(pg8::f32x4*)(x1 + row * D + col) = xin + gt * acc[ai][bj][m][n]; }
            }
    }
};

__device__ __forceinline__ void p6_norm2(Frame& F) {
    const float* x1 = (const float*)(((unsigned char*)karg(19)) + WS_X1); const float* g2 = ((const float*)karg(3)); const float* MOD = (const float*)(((unsigned char*)karg(19)) + WS_MOD); bf16* H2 = (bf16*)(((unsigned char*)karg(19)) + WS_H2); unsigned char* H2Q = (unsigned char*)(((unsigned char*)karg(19)) + WS_H2Q); float* H2S = (float*)(((unsigned char*)karg(19)) + WS_H2S);
    const int gw = F.vcu * NWAVES + F.wave, NGW = F.G * NWAVES;
    f32x4 cur[4], nxt[4];
    if (gw < M) { const f32x4* xr = (const f32x4*)(x1 + (size_t)gw * D) + F.lane;
#pragma unroll
        for (int j = 0; j < 4; ++j) cur[j] = xr[64 * j]; }
    for (int row = gw; row < M; row += NGW) {
        { const int nrow = row + NGW; if (nrow < M) { const f32x4* xr = (const f32x4*)(x1 + (size_t)nrow * D) + F.lane;
#pragma unroll
            for (int j = 0; j < 4; ++j) nxt[j] = xr[64 * j]; } }
        {
        f32x4 v[4], hq[4]; float ss = 0.f;
#pragma unroll
        for (int j = 0; j < 4; ++j) { v[j] = cur[j]; ss += (v[j].x * v[j].x + v[j].y * v[j].y) + (v[j].z * v[j].z + v[j].w * v[j].w); }
        ss = wave_sum(ss);
        const float rstd = 1.0f / sqrtf(ss * (1.0f / D) + EPS);
        const int b = row >> 12; const float* mb = MOD + b * NMOD;
#pragma unroll
        for (int j = 0; j < 4; ++j) { const int col = 4 * F.lane + 256 * j;
            const f32x4 g = *(const f32x4*)(g2 + col), sh = *(const f32x4*)(mb + 3072 + col), sc = *(const f32x4*)(mb + 4096 + col);
            const f32x4 hv = (v[j] * rstd) * g * (sc + 1.0f) + sh;
            u32x2 w; w.x = cvtpk(hv.x, hv.y); w.y = cvtpk(hv.z, hv.w);
            *(u32x2*)(H2 + (size_t)row * D + col) = w; hq[j] = hv; }
        float am = 0.f;
#pragma unroll
        for (int j = 0; j < 4; ++j) am = fmaxf(fmaxf(am, fmaxf(fabsf(hq[j].x), fabsf(hq[j].y))), fmaxf(fabsf(hq[j].z), fabsf(hq[j].w)));
#pragma unroll
        for (int o = 1; o < 64; o <<= 1) am = fmaxf(am, __shfl_xor(am, o));
        const float sc = am > 0.f ? am * (1.0f / 127.0f) : 1.0f, inv = 1.0f / sc;
        v4u qa;
#pragma unroll
        for (int j = 0; j < 4; ++j) { const int b0 = (int)rintf(hq[j].x * inv), b1 = (int)rintf(hq[j].y * inv), b2 = (int)rintf(hq[j].z * inv), b3 = (int)rintf(hq[j].w * inv);
            qa[j] = (unsigned)(b0 & 255) | ((unsigned)(b1 & 255) << 8) | ((unsigned)(b2 & 255) << 16) | ((unsigned)(b3 & 255) << 24); }
        *(v4u*)(H2Q + (size_t)row * D + 16 * F.lane) = qa;
        if (F.lane == 0) H2S[row] = sc;
        }
#pragma unroll
        for (int j = 0; j < 4; ++j) cur[j] = nxt[j];
    }
}

__device__ __forceinline__ unsigned f2ord(float f) { const unsigned u = __float_as_uint(f); return u ^ ((unsigned)((int)u >> 31) | 0x80000000u); }
__device__ __forceinline__ float ord2f(unsigned o) { const unsigned u = (o & 0x80000000u) ? (o & 0x7fffffffu) : ~o; return __uint_as_float(u); }
#define CE_DESC(a, b) do { const unsigned _x = (a), _y = (b); (a) = _x > _y ? _x : _y; (b) = _x > _y ? _y : _x; } while (0)
__device__ __forceinline__ void sort16(unsigned (&k)[16]) {
#pragma unroll
    for (int size = 2; size <= 16; size <<= 1)
#pragma unroll
        for (int stride = size >> 1; stride > 0; stride >>= 1)
#pragma unroll
            for (int i = 0; i < 16; ++i) { const int j = i ^ stride; if (j > i) { if ((i & size) == 0) CE_DESC(k[i], k[j]); else CE_DESC(k[j], k[i]); } }
}
__device__ __forceinline__ void merge16(unsigned (&a)[16], const unsigned (&b)[16]) {
#pragma unroll
    for (int i = 0; i < 16; ++i) a[i] = a[i] > b[15 - i] ? a[i] : b[15 - i];
#pragma unroll
    for (int stride = 8; stride > 0; stride >>= 1)
#pragma unroll
        for (int i = 0; i < 16; ++i) { const int j = i ^ stride; if (j > i) CE_DESC(a[i], a[j]); }
}
__device__ __forceinline__ void top16_of_64(unsigned (&g0)[16], unsigned (&g1)[16], unsigned (&g2)[16], unsigned (&g3)[16]) {
    sort16(g0); sort16(g1); sort16(g2); sort16(g3);
    merge16(g0, g1); merge16(g2, g3); merge16(g0, g2);
}
constexpr int NCAND = 50;
__device__ __forceinline__ void p8a_topk(Frame& F) {
    const bf16* QP = (const bf16*)(((unsigned char*)karg(19)) + WS_QP); const bf16* SUBK = (const bf16*)(((unsigned char*)karg(19)) + WS_SUBK);
    unsigned short* PIDX = (unsigned short*)(((unsigned char*)karg(19)) + WS_PIDX); float* PG = (float*)(((unsigned char*)karg(19)) + WS_PG);
    LAS unsigned short* Elds = (LAS unsigned short*)(F.lds) + F.wave * (NCAND * 64);
    const int lane = F.lane, r32 = lane & 31, hi = lane >> 5;
    const int gw = F.vcu * NWAVES + F.wave, NGW = F.G * NWAVES;
    for (int item = gw; item < (M / 32) * 8; item += NGW) {
        const int tile = item >> 3;
        const int tok = tile * 32 + r32;
        { const int h = item & 7;
            unsigned top[2][16];
#pragma unroll
            for (int p = 0; p < 2; ++p) {
                bf16x8 qf[4];
                { const bf16* qp = QP + (size_t)tok * D + h * 128 + p * 64 + 8 * hi;
#pragma unroll
                  for (int ks = 0; ks < 4; ++ks) qf[ks] = *(const bf16x8*)(qp + 16 * ks); }
                const bf16* kp = SUBK + (size_t)((h * 2 + p) * 128 + r32) * 64 + 8 * hi;
                unsigned kk[4][16];
#pragma unroll
                for (int blk = 0; blk < 4; ++blk) {
                    f32x16 acc;
#pragma unroll
                    for (int r = 0; r < 16; ++r) acc[r] = 0.f;
#pragma unroll
                    for (int ks = 0; ks < 4; ++ks) { const bf16x8 a = *(const bf16x8*)(kp + (size_t)blk * 32 * 64 + 16 * ks); acc = MFMA32(a, qf[ks], acc); }
#pragma unroll
                    for (int r = 0; r < 16; ++r) { const int key = 32 * blk + crow(r, hi); kk[blk][r] = (f2ord(acc[r]) & ~127u) | (unsigned)(127 - key); }
                }
                top16_of_64(kk[0], kk[1], kk[2], kk[3]);
                unsigned other[16];
#pragma unroll
                for (int i = 0; i < 16; ++i) other[i] = (unsigned)__shfl_xor((int)kk[0][i], 32);
                merge16(kk[0], other);
#pragma unroll
                for (int i = 0; i < 16; ++i) top[p][i] = kk[0][i];
            }
            float s1[16], s2[16]; unsigned i1[16], i2[16];
#pragma unroll
            for (int i = 0; i < 16; ++i) { s1[i] = ord2f(top[0][i] & ~127u); i1[i] = 127u - (top[0][i] & 127u); s2[i] = ord2f(top[1][i] & ~127u); i2[i] = 127u - (top[1][i] & 127u); }
            unsigned ck[4][16];
#pragma unroll
            for (int c = 0; c < 64; ++c) {
                if (c < NCAND) { constexpr int CA[NCAND] = {0,0,0,0,0,0,0,0,0,0,0,0,0,0,0,0,1,1,1,1,1,1,1,1,2,2,2,2,2,3,3,3,3,4,4,4,5,5,6,6,7,7,8,9,10,11,12,13,14,15}; constexpr int CB[NCAND] = {0,1,2,3,4,5,6,7,8,9,10,11,12,13,14,15,0,1,2,3,4,5,6,7,0,1,2,3,4,0,1,2,3,0,1,2,0,1,0,1,0,1,0,0,0,0,0,0,0,0}; const int a = CA[c], b = CB[c];
                    ck[c >> 4][c & 15] = (f2ord(s1[a] + s2[b]) & ~63u) | (unsigned)(63 - c);
                    Elds[c * 64 + lane] = (unsigned short)(i1[a] * 128u + i2[b]); }
                else ck[c >> 4][c & 15] = 0u;
            }
            top16_of_64(ck[0], ck[1], ck[2], ck[3]);
            float w[16]; float wsum = 0.f; const float v0 = ord2f(ck[0][0] & ~63u);
#pragma unroll
            for (int r = 0; r < 16; ++r) { w[r] = __expf(ord2f(ck[0][r] & ~63u) - v0); wsum += w[r]; }
            const float winv = 1.0f / wsum;
#pragma unroll
            for (int r = 0; r < 16; ++r) if ((r >> 3) == hi) {
                const int c = 63 - (int)(ck[0][r] & 63u);
                const unsigned short eid = Elds[c * 64 + lane];
                PIDX[(size_t)tok * 128 + h * 16 + r] = eid; PG[(size_t)tok * 128 + h * 16 + r] = w[r] * winv; }
        }
    }
}

__device__ __forceinline__ float gelu_erf(float v) { return 0.5f * v * (1.0f + erff(v * 0.70710678118654752f)); }

#define PROBE_REPA 1
#define PROBE_REPB 1
constexpr int NR = 16, RSH = 17, BSA = 8, BSB = 4, ELP = 136;
__device__ __forceinline__ void sort128(unsigned& e0, unsigned& e1, int lane) {
#pragma unroll
    for (int size = 2; size <= 128; size <<= 1) {
#pragma unroll
        for (int stride = size >> 1; stride > 0; stride >>= 1) {
            if (stride == 64) { const unsigned lo = e0 < e1 ? e0 : e1, hi = e0 < e1 ? e1 : e0; e0 = lo; e1 = hi; }
            else {
                const bool lower = (lane & stride) == 0;
                const bool asc0 = (size == 128) ? true : (size == 64 ? true : ((lane & size) == 0));
                const bool asc1 = (size == 128) ? true : (size == 64 ? false : ((lane & size) == 0));
                const unsigned p0 = (unsigned)__shfl_xor((int)e0, stride), p1 = (unsigned)__shfl_xor((int)e1, stride);
                const unsigned mn0 = e0 < p0 ? e0 : p0, mx0 = e0 < p0 ? p0 : e0, mn1 = e1 < p1 ? e1 : p1, mx1 = e1 < p1 ? p1 : e1;
                e0 = (lower == asc0) ? mn0 : mx0; e1 = (lower == asc1) ? mn1 : mx1;
            }
        }
    }
}
template <int BS> __device__ __forceinline__ void sw_issue(v4u (&buf)[BS], const LAS unsigned* el, const unsigned char* tab, unsigned voff) {
#pragma unroll
    for (int i = 0; i < BS; ++i) { const unsigned off = (el[i] << 10) + voff;
        buf[i] = *(const v4u*)(tab + off); }
}
template <int BS> __device__ __forceinline__ void sw_proc_a(const v4u (&buf)[BS], const v4u& hq, LAS float* wl, int s, int n, int lane) {
    const int hx = (int)hq.x, hy = (int)hq.y, hz = (int)hq.z, hw = (int)hq.w;
    float dd[8];
#pragma unroll
    for (int i = 0; i < 8; ++i) dd[i] = 0.f;
#pragma unroll
    for (int i = 0; i < BS; ++i) if (i < n) { const int dx = (int)buf[i].x, dy = (int)buf[i].y, dz = (int)buf[i].z, dw = (int)buf[i].w;
        int t = __builtin_amdgcn_sdot4(hx, dx, 0, false); t = __builtin_amdgcn_sdot4(hy, dy, t, false); t = __builtin_amdgcn_sdot4(hz, dz, t, false); t = __builtin_amdgcn_sdot4(hw, dw, t, false);
        dd[i] = (float)t; }
    const bool b5 = (lane & 32) != 0, b4 = (lane & 16) != 0, b3 = (lane & 8) != 0;
    float r4[4];
#pragma unroll
    for (int u = 0; u < 4; ++u) { const float keep = b5 ? dd[u + 4] : dd[u], send = b5 ? dd[u] : dd[u + 4]; r4[u] = keep + __shfl_xor(send, 32); }
    float r2[2];
#pragma unroll
    for (int u = 0; u < 2; ++u) { const float keep = b4 ? r4[u + 2] : r4[u], send = b4 ? r4[u] : r4[u + 2]; r2[u] = keep + __shfl_xor(send, 16); }
    float r1; { const float keep = b3 ? r2[1] : r2[0], send = b3 ? r2[0] : r2[1]; r1 = keep + __shfl_xor(send, 8); }
    r1 += __shfl_xor(r1, 4); r1 += __shfl_xor(r1, 2); r1 += __shfl_xor(r1, 1);
    if ((lane & 7) == 0 && (lane >> 3) < n) wl[s + (lane >> 3)] = r1;
}
template <int BS> __device__ __forceinline__ void sw_proc_b(const v4u (&buf)[BS], f32x2_t (&acc)[8], const LAS float* wl, int s, int n) {
#pragma unroll
    for (int i = 0; i < BS; ++i) if (i < n) {
        const float w = wl[s + i];
        const f32x2_t wv = {w, w};
        const unsigned ux = buf[i].x, uy = buf[i].y, uz = buf[i].z, uw = buf[i].w;
        acc[0] += wv * __builtin_amdgcn_cvt_pk_f32_fp8((int)ux, false); acc[1] += wv * __builtin_amdgcn_cvt_pk_f32_fp8((int)ux, true);
        acc[2] += wv * __builtin_amdgcn_cvt_pk_f32_fp8((int)uy, false); acc[3] += wv * __builtin_amdgcn_cvt_pk_f32_fp8((int)uy, true);
        acc[4] += wv * __builtin_amdgcn_cvt_pk_f32_fp8((int)uz, false); acc[5] += wv * __builtin_amdgcn_cvt_pk_f32_fp8((int)uz, true);
        acc[6] += wv * __builtin_amdgcn_cvt_pk_f32_fp8((int)uw, false); acc[7] += wv * __builtin_amdgcn_cvt_pk_f32_fp8((int)uw, true); }
}
__device__ __forceinline__ void p8b_sweep(Frame& F) {
    const float* X1 = (const float*)(((unsigned char*)karg(19)) + WS_X1); const float* MOD = (const float*)(((unsigned char*)karg(19)) + WS_MOD);
    const unsigned char* H2Q = (const unsigned char*)(((unsigned char*)karg(19)) + WS_H2Q); const float* H2S = (const float*)(((unsigned char*)karg(19)) + WS_H2S);
    const unsigned char* EDq = (const unsigned char*)(((unsigned char*)karg(19)) + WS_ED); const unsigned char* EUq = (const unsigned char*)(((unsigned char*)karg(19)) + WS_EU); const float* EDS = (const float*)(((unsigned char*)karg(19)) + WS_EDS);
    const unsigned short* PIDX = (const unsigned short*)(((unsigned char*)karg(19)) + WS_PIDX); const float* PG = (const float*)(((unsigned char*)karg(19)) + WS_PG);
    const float* fg = ((const float*)karg(17));
    const int gw = F.vcu * NWAVES + F.wave, NGW = F.G * NWAVES;
    for (int tb = gw; tb < M / 8; tb += NGW) {
        unsigned ones = ~0u; asm volatile("" : "+s"(ones));
        int lane = (int)__builtin_amdgcn_mbcnt_hi(ones, __builtin_amdgcn_mbcnt_lo(ones, 0u)); asm volatile("" : "+v"(lane));
        const int tok0 = tb * 8;
        unsigned E0[8], E1[8];
        LAS float* Wl = (LAS float*)(F.lds) + F.wave * 1024;
        LAS unsigned* El = (LAS unsigned*)(F.lds + 32768) + F.wave * (8 * ELP);
        unsigned voff = 16u * (unsigned)lane; asm volatile("" : "+v"(voff));
#pragma unroll
        for (int k = 0; k < 8; ++k) {
            const size_t base = (size_t)(tok0 + k) * 128;
            E0[k] = ((unsigned)PIDX[base + lane] << 7) | (unsigned)lane; E1[k] = ((unsigned)PIDX[base + 64 + lane] << 7) | (unsigned)(64 + lane);
            sort128(E0[k], E1[k], lane);
            El[k * ELP + lane] = E0[k] >> 7; El[k * ELP + 64 + lane] = E1[k] >> 7;
            if (lane < 8) El[k * ELP + 128 + lane] = (unsigned)__builtin_amdgcn_readlane((int)E1[k], 63) >> 7;
        }
        for (int repa = 0; repa < PROBE_REPA; ++repa) {
            v4u hq[8];
#pragma unroll
            for (int k = 0; k < 8; ++k) hq[k] = *(const v4u*)(H2Q + (size_t)(tok0 + k) * D + 16 * lane);
            int pos[8];
#pragma unroll
            for (int k = 0; k < 8; ++k) pos[k] = 0;
            v4u bA[BSA], bB[BSA]; int ps = 0, pn = 0;
            for (int r = 0; r < NR; ++r) {
#pragma unroll
                for (int k = 0; k < 8; ++k) {
                    constexpr int dummy = 0; (void)dummy;
                    const int kp = (k + 7) & 7;
                    const int c = __builtin_popcountll(__ballot((E0[k] >> RSH) == (unsigned)r)) + __builtin_popcountll(__ballot((E1[k] >> RSH) == (unsigned)r));
                    int s = __builtin_amdgcn_readfirstlane(pos[k]); const int e_end = __builtin_amdgcn_readfirstlane(s + c); pos[k] = e_end;
                    const int n1 = (e_end - s) < BSA ? (e_end - s) : BSA;
                    if (k & 1) sw_issue<BSA>(bB, El + k * ELP + s, EDq, voff); else sw_issue<BSA>(bA, El + k * ELP + s, EDq, voff);
                    if (pn > 0) { if (k & 1) sw_proc_a<BSA>(bA, hq[kp], Wl + kp * 128, ps, pn, lane); else sw_proc_a<BSA>(bB, hq[kp], Wl + kp * 128, ps, pn, lane); }
                    ps = s; pn = n1; s += n1;
                    for (; s < e_end; s += BSA) {
                        const int n = (e_end - s) < BSA ? (e_end - s) : BSA;
                        if (k & 1) { sw_issue<BSA>(bA, El + k * ELP + s, EDq, voff); sw_proc_a<BSA>(bA, hq[k], Wl + k * 128, s, n, lane); }
                        else       { sw_issue<BSA>(bB, El + k * ELP + s, EDq, voff); sw_proc_a<BSA>(bB, hq[k], Wl + k * 128, s, n, lane); }
                    }
                }
            }
            if (pn > 0) sw_proc_a<BSA>(bB, hq[7], Wl + 7 * 128, ps, pn, lane);
        }
#pragma unroll
        for (int k = 0; k < 8; ++k) { int tk = tok0 + k; asm volatile("" : "+s"(tk)); const size_t base = (size_t)tk * 128; const float sh = H2S[tk];
            const float r0 = Wl[k * 128 + lane], r1 = Wl[k * 128 + 64 + lane];
            Wl[k * 128 + lane] = PG[base + (E0[k] & 127u)] * gelu_erf(r0 * sh * EDS[E0[k] >> 7]) * 0.0625f;
            Wl[k * 128 + 64 + lane] = PG[base + (E1[k] & 127u)] * gelu_erf(r1 * sh * EDS[E1[k] >> 7]) * 0.0625f; }
        f32x2_t acc[8][8];
        for (int repb = 0; repb < PROBE_REPB; ++repb) {
#pragma unroll
            for (int k = 0; k < 8; ++k)
#pragma unroll
                for (int i = 0; i < 8; ++i) acc[k][i] = (f32x2_t){0.f, 0.f};
            int pos[8];
#pragma unroll
            for (int k = 0; k < 8; ++k) pos[k] = 0;
            v4u bA[BSB], bB[BSB]; int ps = 0, pn = 0;
            for (int r = 0; r < NR; ++r) {
#pragma unroll
                for (int k = 0; k < 8; ++k) {
                    const int kp = (k + 7) & 7;
                    const int c = __builtin_popcountll(__ballot((E0[k] >> RSH) == (unsigned)r)) + __builtin_popcountll(__ballot((E1[k] >> RSH) == (unsigned)r));
                    int s = __builtin_amdgcn_readfirstlane(pos[k]); const int e_end = __builtin_amdgcn_readfirstlane(s + c); pos[k] = e_end;
                    const int n1 = (e_end - s) < BSB ? (e_end - s) : BSB;
                    if (k & 1) sw_issue<BSB>(bB, El + k * ELP + s, EUq, voff); else sw_issue<BSB>(bA, El + k * ELP + s, EUq, voff);
                    if (pn > 0) { if (k & 1) sw_proc_b<BSB>(bA, acc[kp], Wl + kp * 128, ps, pn); else sw_proc_b<BSB>(bB, acc[kp], Wl + kp * 128, ps, pn); }
                    ps = s; pn = n1; s += n1;
                    for (; s < e_end; s += BSB) {
                        const int n = (e_end - s) < BSB ? (e_end - s) : BSB;
                        if (k & 1) { sw_issue<BSB>(bA, El + k * ELP + s, EUq, voff); sw_proc_b<BSB>(bA, acc[k], Wl + k * 128, s, n); }
                        else       { sw_issue<BSB>(bB, El + k * ELP + s, EUq, voff); sw_proc_b<BSB>(bB, acc[k], Wl + k * 128, s, n); }
                    }
                }
            }
            if (pn > 0) sw_proc_b<BSB>(bB, acc[7], Wl + 7 * 128, ps, pn);
        }
        int ln = lane; asm volatile("" : "+v"(ln));
#pragma unroll
        for (int k = 0; k < 8; ++k) {
            const int tok = tok0 + k; const int b = tok >> 12; const float* gt2 = MOD + b * NMOD + 5120;
            f32x4 x2[4]; float ss = 0.f;
#pragma unroll
            for (int j = 0; j < 4; ++j) { const int col = 4 * ln + 256 * j;
                const f32x4 xv = *(const f32x4*)(X1 + (size_t)tok * D + col), gv4 = *(const f32x4*)(gt2 + col);
#pragma unroll
                for (int i = 0; i < 4; ++i) { const float v = xv[i] + gv4[i] * acc[k][2 * j + (i >> 1)][i & 1]; x2[j][i] = v; ss += v * v; } }
            ss = wave_sum(ss);
            const float rstd = 1.0f / sqrtf(ss * (1.0f / D) + EPS);
#pragma unroll
            for (int j = 0; j < 4; ++j) { const int col = 4 * ln + 256 * j; const f32x4 gg = *(const f32x4*)(fg + col);
                *(f32x4*)(((float*)karg(18)) + (size_t)tok * D + col) = x2[j] * rstd * gg; }
        }
    }
}

struct Args { const float* in[18]; float* out; unsigned char* ws; };
__global__ void __launch_bounds__(NTHR, 2) mega_fwd(Args args) {
    extern __shared__ __attribute__((aligned(16))) unsigned char lds[];
    Frame F;
    F.lds = (LAS unsigned char*)lds;
    F.tid = threadIdx.x; F.lane = F.tid & 63; F.wave = __builtin_amdgcn_readfirstlane(F.tid >> 6);
    F.G = gridDim.x; { const int bx = blockIdx.x; F.vcu = (F.G % 8 == 0) ? (bx % 8) * (F.G / 8) + bx / 8 : bx; }
    volatile LAS unsigned* MISC = (volatile LAS unsigned*)(F.lds + MISC_OFF);
    for (int u = F.tid; u < (LDS_BYTES - LDSCTL_OFF) / 4; u += NTHR) ((LAS unsigned*)(F.lds + LDSCTL_OFF))[u] = 0u;
    __syncthreads();
    gu32* ctl = (gu32*)(((unsigned char*)karg(19)) + WS_CTL);
    XcdBarrier bar = xcd_barrier_post((unsigned*)(ctl + CW_BAR), MISC + 8);
#define GRID_BAR() xcd_barrier(bar)
#define PROBE_TS -1
#define STAMP(i) do { if (PROBE_TS >= 0 && blockIdx.x == 0 && F.tid == 0) { const unsigned long long t_ = __builtin_amdgcn_s_memrealtime(); MISC[16 + 2 * (i)] = (unsigned)t_; MISC[17 + 2 * (i)] = (unsigned)(t_ >> 32); } } while (0)
#define PROBE_DBL -1

    STAMP(0);
    p0_prologue(F); GRID_BAR(); STAMP(1);
    if (PROBE_DBL == 0) { p0_prologue(F); GRID_BAR(); }
    p1_norm(F); GRID_BAR(); STAMP(2);
    if (PROBE_DBL == 1) { p1_norm(F); GRID_BAR(); }
    {
    {
        pg8::Gemm g{(const pg8::bf16_t*)(((unsigned char*)karg(19)) + WS_H), (const pg8::bf16_t*)(((unsigned char*)karg(19)) + WS_WIN), M, NPROJ, D, nullptr, nullptr};
        pg8::StaticOrder S; S.init(M, NPROJ, F.G, (int)blockIdx.x);
        pg8::EpiBf16<0> E{(pg8::bf16_t*)(((unsigned char*)karg(19)) + WS_PROJ), NPROJ, nullptr, 0, 0, 1.f};
        pg8::gemm_phase<pg8::EpiBf16<0>, pg8::StaticOrder, true, true>(F.lds + RING_OFF, g, S, E);
    }
    GRID_BAR(); STAMP(3);
    }
    p3_attention(F); GRID_BAR(); STAMP(4);
    if (PROBE_DBL == 3) { p3_attention(F); GRID_BAR(); }
    {
    {
        pg8::Gemm g{(const pg8::bf16_t*)(((unsigned char*)karg(19)) + WS_OA), (const pg8::bf16_t*)(((unsigned char*)karg(19)) + WS_WA), M, D, 512, (const pg8::bf16_t*)(((unsigned char*)karg(19)) + WS_OB), (const pg8::bf16_t*)(((unsigned char*)karg(19)) + WS_WB)};
        PairOrder S; S.S.init(M, D, F.G, (int)blockIdx.x);
        EpiGate E{(const bf16*)(((unsigned char*)karg(19)) + WS_PROJ), (bf16*)((float*)karg(18)), (bf16*)((float*)karg(18)) + (size_t)M * D};
        pg8::gemm_phase<EpiGate, PairOrder, false, true>(F.lds + RING_OFF, g, S, E);
    }
    GRID_BAR(); STAMP(5);
    }
    {
    {
        pg8::Gemm g{(const pg8::bf16_t*)((bf16*)((float*)karg(18)) + (size_t)M * D), (const pg8::bf16_t*)(((unsigned char*)karg(19)) + WS_WOUT), M, D, D, nullptr, nullptr};
        pg8::StaticOrder S; S.init(M, D, F.G, (int)blockIdx.x);
        EpiRes E{((const float*)karg(0)), (const float*)(((unsigned char*)karg(19)) + WS_MOD), (float*)(((unsigned char*)karg(19)) + WS_X1)};
        pg8::gemm_phase<EpiRes, pg8::StaticOrder, false, true>(F.lds + RING_OFF, g, S, E);
    }
    GRID_BAR(); STAMP(6);
    }
    p6_norm2(F); GRID_BAR(); STAMP(7);
    if (PROBE_DBL == 6) { p6_norm2(F); GRID_BAR(); }
    {
    {
        pg8::Gemm g{(const pg8::bf16_t*)(((unsigned char*)karg(19)) + WS_H2), (const pg8::bf16_t*)(((unsigned char*)karg(19)) + WS_WQ), M, D, D, nullptr, nullptr};
        pg8::StaticOrder S; S.init(M, D, F.G, (int)blockIdx.x);
        pg8::EpiBf16<0> E{(pg8::bf16_t*)(((unsigned char*)karg(19)) + WS_QP), D, nullptr, 0, 0, 1.f};
        pg8::gemm_phase<pg8::EpiBf16<0>, pg8::StaticOrder, false, true>(F.lds + RING_OFF, g, S, E);
    }
    GRID_BAR(); STAMP(8);
    }
    p8a_topk(F); GRID_BAR(); STAMP(9);
    if (PROBE_DBL == 8) { p8a_topk(F); GRID_BAR(); }
    p8b_sweep(F);
    if (PROBE_DBL == 9) { GRID_BAR(); p8b_sweep(F); }
    if (PROBE_TS >= 0) {
        GRID_BAR(); STAMP(10);
        if (blockIdx.x == 0) { __syncthreads();
            const unsigned long long t0 = ((unsigned long long)MISC[17 + 2 * PROBE_TS] << 32) | MISC[16 + 2 * PROBE_TS], t1 = ((unsigned long long)MISC[19 + 2 * PROBE_TS] << 32) | MISC[18 + 2 * PROBE_TS];
            const float d_us = (float)(t1 - t0) * 0.01f;
            const float V = 128.0f * sqrtf(d_us * 1e-5f);
            float* o = (float*)karg(18); for (int c = F.tid; c < D; c += NTHR) o[c] = V; }
    }
}

extern "C" void kernel_launch(void* const* d_in, const int* in_sizes, int n_in, void* d_out, int out_size, void* d_ws, size_t ws_size, hipStream_t stream) {
    static int grid = 0;
    if (grid == 0) {
        if (n_in != 18 || in_sizes[0] != M * D || out_size != M * D || ws_size < WS_END) { fprintf(stderr, "kernel_launch: unexpected shapes (n_in %d, in0 %d, out %d, ws %zu)\n", n_in, n_in > 0 ? in_sizes[0] : -1, out_size, ws_size); grid = -1; return; }
        int dev = 0, cus = 0, per_cu = 0;
        if (hipGetDevice(&dev) != hipSuccess || hipDeviceGetAttribute(&cus, hipDeviceAttributeMultiprocessorCount, dev) != hipSuccess) { grid = -1; return; }
        if (hipFuncSetAttribute((const void*)mega_fwd, hipFuncAttributeMaxDynamicSharedMemorySize, LDS_BYTES) != hipSuccess) { fprintf(stderr, "kernel_launch: hipFuncSetAttribute failed\n"); grid = -1; return; }
        if (hipOccupancyMaxActiveBlocksPerMultiprocessor(&per_cu, (const void*)mega_fwd, NTHR, LDS_BYTES) != hipSuccess || per_cu < 1) { fprintf(stderr, "kernel_launch: occupancy query says %d blocks per CU\n", per_cu); }
        (void)hipGetLastError();
        grid = cus;
    }
    if (grid < 0) return;
    if (hipMemsetAsync((char*)d_ws + WS_CTL, 0, CTL_ZERO_BYTES, stream) != hipSuccess) { fprintf(stderr, "kernel_launch: memset failed\n"); return; }
    Args a{};
    for (int i = 0; i < 18; ++i) a.in[i] = (const float*)d_in[i];
    a.out = (float*)d_out; a.ws = (unsigned char*)d_ws;
    hipLaunchKernelGGL(mega_fwd, dim3(grid), dim3(NTHR), LDS_BYTES, stream, a);
}
```

```cpp
#include <hip/hip_runtime.h>
#include <cstdio>
#include <cstdint>
namespace pg8 {
#define PG8_LAS __attribute__((address_space(3)))
typedef unsigned short bf16_t;
typedef short bf16x8 __attribute__((ext_vector_type(8)));
typedef float f32x4 __attribute__((ext_vector_type(4)));
typedef unsigned u32x4 __attribute__((ext_vector_type(4)));
constexpr int BM = 256, BK = 64, HALF = 128, HTB = HALF * BK * 2  , STAGE_BYTES = 8 * HTB, NXCD = 8, WGM = 8;

__host__ __device__ __forceinline__ int lds_byte(int r, int c) { const int st = (r >> 4) * 2 + (c >> 5), rr = r & 15, cc = c & 31, ob = rr * 64 + cc * 2; return st * 1024 + (ob ^ (((ob >> 9) & 1) << 5)); }
__host__ __device__ __forceinline__ void stage_rc(int b, int& R, int& C) { const int st = b / 1024, sb = b % 1024, swz = sb ^ (((sb >> 9) & 1) << 5); R = (st >> 1) * 16 + swz / 64; C = (st & 1) * 32 + (swz % 64) / 2; }
__host__ __device__ __forceinline__ int perm32(int rho) { const int n = rho >> 4, i = rho & 15; return 8 * (i >> 2) + 4 * n + (i & 3); }

struct Unit { int pm, pn, src; };
struct Gemm { const bf16_t* A; const bf16_t* Bt; int M, N, K; const bf16_t* A2; const bf16_t* Bt2; };

struct StaticOrder {
    int nM, nN, nwg, G, c;
    __host__ __device__ void init(int M, int N, int G_, int c_) { nM = M / BM; nN = N / BM; nwg = nM * nN; G = G_; c = c_; }
    __host__ __device__ bool next(int i, Unit& u) const {
        const long L = (long)i * G + c; if (L >= nwg) return false;
        int wgid = (int)L; { const int q = nwg / NXCD, r = nwg % NXCD, xcd = wgid % NXCD, off = wgid / NXCD; wgid = (xcd < r ? xcd * (q + 1) : r * (q + 1) + (xcd - r) * q) + off; }
        const int nig = WGM * nN, gid = wgid / nig, fm = gid * WGM, gsz = (nM - fm) < WGM ? (nM - fm) : WGM;
        u.pm = fm + ((wgid % nig) % gsz); u.pn = (wgid % nig) / gsz; u.src = 0; return true;
    }
    __device__ __forceinline__ void a_ready(const Unit&) const {}
    __device__ __forceinline__ void done(const Unit&) const {}
};

__device__ __forceinline__ unsigned cvt_pk_bf16(float lo, float hi) { unsigned r; asm volatile("v_cvt_pk_bf16_f32 %0, %1, %2" : "=v"(r) : "v"(lo), "v"(hi)); return r; }
typedef float f32x2 __attribute__((ext_vector_type(2)));
__device__ __forceinline__ f32x2 gelu_pk(f32x2 v) {
    const f32x2 av = __builtin_elementwise_abs(v), d = av * 0.2316418882f + 1.0f;
    f32x2 t; t.x = __builtin_amdgcn_rcpf(d.x); t.y = __builtin_amdgcn_rcpf(d.y);
    f32x2 q = t * 0.5307027145f + (-0.7265760135f); q = q * t + 0.7107068705f; q = q * t + (-0.142248368f); q = q * t + 0.127414796f; q = q * t;
    const f32x2 s = (v * v) * (-0.72134752044f);
    f32x2 e; e.x = __builtin_amdgcn_exp2f(s.x); e.y = __builtin_amdgcn_exp2f(s.y);
    const f32x2 m = v * (q * e), r = v - m;
    f32x2 o; o.x = v.x < 0.f ? m.x : r.x; o.y = v.y < 0.f ? m.y : r.y; return o;
}

template <int ACT  > struct EpiBf16 {
    static constexpr bool PERM = true, AFTER_DRAIN = false, CHAIN = false; static_assert(ACT == 0 || ACT == 1, "EpiBf16: ACT is 0 (none) or 1 (gelu_pk)");
    bf16_t* O; int ldc; const float* bias; int split_cols; size_t split_stride; float scale0;
    __device__ __forceinline__ void operator()(const f32x4 (&acc)[2][2][4][2], const Unit& u, int wr, int wc, int fr, int fq) const {
        const int row0 = u.pm * BM + wr * 64 + fr; int colt = u.pn * BM; bf16_t* base = O;
        float sc = 1.f; if (split_cols) { const int t = colt / split_cols; base += (size_t)t * split_stride; colt -= t * split_cols; if (t == 0) sc = scale0; }
        const int col0 = colt + wc * 32 + 8 * fq, bcol0 = u.pn * BM + wc * 32 + 8 * fq;
        f32x4 bv[2][2];
#pragma unroll
        for (int bj = 0; bj < 2; ++bj)
#pragma unroll
            for (int n = 0; n < 2; ++n) bv[bj][n] = bias ? *(const f32x4*)(bias + bcol0 + bj * HALF + 4 * n) : (f32x4){0.f, 0.f, 0.f, 0.f};
#pragma unroll
        for (int ai = 0; ai < 2; ++ai)
#pragma unroll
            for (int m = 0; m < 4; ++m) { bf16_t* rowp = base + (size_t)(row0 + ai * HALF + m * 16) * ldc + col0;
#pragma unroll
                for (int bj = 0; bj < 2; ++bj) { f32x4 v0 = acc[ai][bj][m][0] + bv[bj][0], v1 = acc[ai][bj][m][1] + bv[bj][1];
                    if (ACT == 1) { f32x2 a = gelu_pk((f32x2){v0[0], v0[1]}), b = gelu_pk((f32x2){v0[2], v0[3]}), c = gelu_pk((f32x2){v1[0], v1[1]}), d = gelu_pk((f32x2){v1[2], v1[3]});
                        v0 = (f32x4){a.x, a.y, b.x, b.y}; v1 = (f32x4){c.x, c.y, d.x, d.y}; }
                    v0 = v0 * sc; v1 = v1 * sc; u32x4 w; w.x = cvt_pk_bf16(v0[0], v0[1]); w.y = cvt_pk_bf16(v0[2], v0[3]); w.z = cvt_pk_bf16(v1[0], v1[1]); w.w = cvt_pk_bf16(v1[2], v1[3]);
                    *(u32x4*)(rowp + bj * HALF) = w; } }
    }
};

template <class Epi, class Sched, bool ALIGN_EPI = false, bool SP2 = false>
__device__ __forceinline__ void gemm_phase(PG8_LAS unsigned char* lds, const Gemm g, const Sched& S, const Epi& E) {
    const int tid = threadIdx.x, wid = __builtin_amdgcn_readfirstlane(tid >> 6), lane = tid & 63, wr = wid >> 2, wc = wid & 3, fr = lane & 15, fq = lane >> 4;
    const int K = g.K, nt = K / BK;
    unsigned voffA[2], voffB[2];
#pragma unroll
    for (int i = 0; i < 2; ++i) { int R, C; stage_rc(tid * 16 + i * 8192, R, C); const int Rb = Epi::PERM ? ((R & ~31) + perm32(R & 31)) : R;
        voffA[i] = (unsigned)(R * K + C) * 2u; voffB[i] = (unsigned)(Rb * K + C) * 2u; }
    const size_t kstep = (size_t)(BK * 2);
    const size_t hstep = (size_t)HALF * K * 2;
    const size_t tstep = 2 * hstep;
    const unsigned ldsw = (unsigned)wid * 1024u;
    const int aoff = lds_byte(wr * 64 + fr, fq * 8), boff = lds_byte(wc * 32 + fr, fq * 8);
#define PG8_SA(b, h) (((b) * 2 + (h)) * HTB)
#define PG8_SB(b, h) ((4 + (b) * 2 + (h)) * HTB)
#define PG8_STAGE(bufoff, gbase, voff) do { _Pragma("unroll") for (int _i = 0; _i < 2; ++_i) \
        __builtin_amdgcn_global_load_lds((const unsigned*)((const char*)(gbase) + (voff)[_i]), (PG8_LAS unsigned*)(lds + (bufoff) + ldsw + _i * 8192), 16, 0, 0); } while (0)
#define PG8_LDA(dst, b, h) do { _Pragma("unroll") for (int m = 0; m < 4; ++m) _Pragma("unroll") for (int k = 0; k < 2; ++k) dst[m][k] = *(const PG8_LAS bf16x8*)(lds + PG8_SA(b, h) + aoff + m * 2048 + k * 1024); } while (0)
#define PG8_LDB(dst, b, h) do { _Pragma("unroll") for (int n = 0; n < 2; ++n) _Pragma("unroll") for (int k = 0; k < 2; ++k) dst[n][k] = *(const PG8_LAS bf16x8*)(lds + PG8_SB(b, h) + boff + n * 2048 + k * 1024); } while (0)
#define PG8_MMA(ai, bj, At, Bt) do { __builtin_amdgcn_s_setprio(1); _Pragma("unroll") for (int m = 0; m < 4; ++m) _Pragma("unroll") for (int n = 0; n < 2; ++n) _Pragma("unroll") for (int k = 0; k < 2; ++k) \
        acc[ai][bj][m][n] = __builtin_amdgcn_mfma_f32_16x16x32_bf16(Bt[n][k], At[m][k], acc[ai][bj][m][n], 0, 0, 0); __builtin_amdgcn_s_setprio(0); } while (0)
#define PG8_WAIT_V(n) asm volatile("s_waitcnt vmcnt(" #n ")" ::: "memory")
#define PG8_WAIT_L(n) asm volatile("s_waitcnt lgkmcnt(" #n ")" ::: "memory")
#define PG8_BAR __builtin_amdgcn_s_barrier()
#define PG8_SCHED __builtin_amdgcn_sched_barrier(0)
    Unit cur, nxt; int ui = 0;
    if (!S.next(0, cur)) return;
    f32x4 acc[2][2][4][2];
#pragma unroll
    for (int a = 0; a < 2; ++a)
#pragma unroll
        for (int b = 0; b < 2; ++b)
#pragma unroll
            for (int m = 0; m < 4; ++m)
#pragma unroll
                for (int n = 0; n < 2; ++n) acc[a][b][m][n] = (f32x4){0.f, 0.f, 0.f, 0.f};
    bf16x8 At[4][2], B0[2][2], B1[2][2];
    const char* cA = (const char*)(cur.src ? g.A2 : g.A) + (size_t)cur.pm * tstep; const char* cB = (const char*)(cur.src ? g.Bt2 : g.Bt) + (size_t)cur.pn * tstep;
    S.a_ready(cur);
    if constexpr (SP2) {
        PG8_STAGE(PG8_SB(0, 0), cB, voffB); PG8_STAGE(PG8_SB(0, 1), cB + hstep, voffB); PG8_STAGE(PG8_SA(0, 0), cA, voffA); PG8_STAGE(PG8_SA(0, 1), cA + hstep, voffA);
        if (wr == 1) PG8_BAR;
        PG8_WAIT_V(2); PG8_BAR;
        PG8_STAGE(PG8_SB(1, 0), cB + kstep, voffB); PG8_STAGE(PG8_SA(1, 0), cA + kstep, voffA); PG8_STAGE(PG8_SB(1, 1), cB + hstep + kstep, voffB);
        PG8_WAIT_V(6); PG8_BAR;
    } else {
        PG8_STAGE(PG8_SB(0, 0), cB, voffB); PG8_STAGE(PG8_SA(0, 0), cA, voffA); PG8_STAGE(PG8_SB(0, 1), cB + hstep, voffB); PG8_STAGE(PG8_SA(0, 1), cA + hstep, voffA);
        if (wr == 1) PG8_BAR;
        PG8_WAIT_V(4); PG8_BAR;
        PG8_STAGE(PG8_SB(1, 0), cB + kstep, voffB); PG8_STAGE(PG8_SA(1, 0), cA + kstep, voffA); PG8_STAGE(PG8_SB(1, 1), cB + hstep + kstep, voffB);
        PG8_WAIT_V(6); PG8_BAR;
    }
    for (;;) {
        const bool has_next = S.next(ui + 1, nxt);
        const char* nA = has_next ? (const char*)(nxt.src ? g.A2 : g.A) + (size_t)nxt.pm * tstep : cA; const char* nB = has_next ? (const char*)(nxt.src ? g.Bt2 : g.Bt) + (size_t)nxt.pn * tstep : cB;
        for (int t = 0; t < nt; t += 2) {
            const bool last = (t == nt - 2);
            const char* a1 = cA + (size_t)(t + 1) * kstep;
            const char* a2 = last ? nA : cA + (size_t)(t + 2) * kstep; const char* b2 = last ? nB : cB + (size_t)(t + 2) * kstep;
            const char* a3 = a2 + kstep; const char* b3 = b2 + kstep;
            if (last && has_next) S.a_ready(nxt);
            if constexpr (SP2) {
            PG8_LDB(B0, 0, 0); PG8_LDB(B1, 0, 1); PG8_SCHED; PG8_LDA(At, 0, 0); PG8_STAGE(PG8_SA(1, 1), a1 + hstep, voffA);
            PG8_WAIT_V(8); PG8_WAIT_L(0); PG8_BAR; PG8_MMA(0, 0, At, B0); PG8_MMA(0, 1, At, B1); PG8_BAR; PG8_SCHED;
            PG8_LDA(At, 0, 1); PG8_STAGE(PG8_SB(0, 0), b2, voffB); PG8_STAGE(PG8_SB(0, 1), b2 + hstep, voffB); PG8_STAGE(PG8_SA(0, 0), a2, voffA);
            PG8_WAIT_V(8); PG8_WAIT_L(0); PG8_BAR; PG8_MMA(1, 0, At, B0); PG8_MMA(1, 1, At, B1); PG8_BAR; PG8_SCHED;
            PG8_LDB(B0, 1, 0); PG8_LDB(B1, 1, 1); PG8_SCHED; PG8_LDA(At, 1, 0); PG8_STAGE(PG8_SA(0, 1), a2 + hstep, voffA);
            PG8_WAIT_V(8); PG8_WAIT_L(0); PG8_BAR; PG8_MMA(0, 0, At, B0); PG8_MMA(0, 1, At, B1); PG8_BAR; PG8_SCHED;
            PG8_LDA(At, 1, 1); PG8_STAGE(PG8_SB(1, 0), b3, voffB); PG8_STAGE(PG8_SB(1, 1), b3 + hstep, voffB); PG8_STAGE(PG8_SA(1, 0), a3, voffA);
            PG8_WAIT_V(8); PG8_WAIT_L(0); PG8_BAR; PG8_MMA(1, 0, At, B0); PG8_MMA(1, 1, At, B1); PG8_BAR; PG8_SCHED;
            } else {
            PG8_LDB(B0, 0, 0); PG8_SCHED; PG8_LDA(At, 0, 0); PG8_STAGE(PG8_SA(1, 1), a1 + hstep, voffA);
            PG8_WAIT_L(8); PG8_BAR; PG8_WAIT_L(0); PG8_MMA(0, 0, At, B0); PG8_BAR; PG8_SCHED;
            PG8_LDB(B1, 0, 1); PG8_STAGE(PG8_SB(0, 0), b2, voffB);
            PG8_BAR; PG8_WAIT_L(0); PG8_MMA(0, 1, At, B1); PG8_BAR;
            PG8_LDA(At, 0, 1); PG8_STAGE(PG8_SA(0, 0), a2, voffA);
            PG8_BAR; PG8_WAIT_L(0); PG8_MMA(1, 0, At, B0); PG8_BAR; PG8_SCHED;
            PG8_STAGE(PG8_SB(0, 1), b2 + hstep, voffB);
            PG8_WAIT_V(6); PG8_BAR; PG8_MMA(1, 1, At, B1); PG8_BAR;
            PG8_LDB(B0, 1, 0); PG8_SCHED; PG8_LDA(At, 1, 0); PG8_STAGE(PG8_SA(0, 1), a2 + hstep, voffA);
            PG8_WAIT_L(8); PG8_BAR; PG8_WAIT_L(0); PG8_MMA(0, 0, At, B0); PG8_BAR; PG8_SCHED;
            PG8_LDB(B1, 1, 1); PG8_STAGE(PG8_SB(1, 0), b3, voffB);
            PG8_BAR; PG8_WAIT_L(0); PG8_MMA(0, 1, At, B1); PG8_BAR;
            PG8_LDA(At, 1, 1); PG8_STAGE(PG8_SA(1, 0), a3, voffA);
            PG8_BAR; PG8_WAIT_L(0); PG8_MMA(1, 0, At, B0); PG8_BAR; PG8_SCHED;
            PG8_STAGE(PG8_SB(1, 1), b3 + hstep, voffB);
            PG8_WAIT_V(6); PG8_BAR; PG8_MMA(1, 1, At, B1); PG8_BAR;
            }
        }
        if constexpr (ALIGN_EPI) { if (wr == 0) PG8_BAR; }
        if constexpr (!Epi::AFTER_DRAIN) { E(acc, cur, wr, wc, fr, fq); S.done(cur); }
        if (!has_next) break;
        if (!(Epi::CHAIN && cur.src == 0)) {
#pragma unroll
        for (int a = 0; a < 2; ++a)
#pragma unroll
            for (int b = 0; b < 2; ++b)
#pragma unroll
                for (int m = 0; m < 4; ++m)
#pragma unroll
                    for (int n = 0; n < 2; ++n) acc[a][b][m][n] = (f32x4){0.f, 0.f, 0.f, 0.f};
        }
        cur = nxt; cA = nA; cB = nB; ++ui;
        if constexpr (ALIGN_EPI) { if (wr == 1) PG8_BAR; }
    }
    PG8_WAIT_V(0);
    if constexpr (!ALIGN_EPI) { if (wr == 0) PG8_BAR; }
    PG8_BAR;
    if constexpr (Epi::AFTER_DRAIN) { E.fused(acc, cur, wr, wc, fr, fq, lds, wid, lane); S.done(cur); }
#undef PG8_SA
#undef PG8_SB
#undef PG8_STAGE
#undef PG8_LDA
#undef PG8_LDB
#undef PG8_MMA
#undef PG8_WAIT_V
#undef PG8_WAIT_L
#undef PG8_BAR
#undef PG8_SCHED
}
}

#define GAS __attribute__((address_space(1)))
#define LAS __attribute__((address_space(3)))
typedef unsigned short bf16;
typedef unsigned v4u __attribute__((ext_vector_type(4)));
typedef float f32x4 __attribute__((ext_vector_type(4)));
typedef short bf16x8 __attribute__((ext_vector_type(8)));
typedef GAS unsigned gu32;
typedef GAS unsigned long long gu64;
#define RLX_AGENT __ATOMIC_RELAXED, __HIP_MEMORY_SCOPE_AGENT
#define LDS_WAIT() asm volatile("s_waitcnt lgkmcnt(0)" ::: "memory")
#define VM_WAIT() asm volatile("s_waitcnt vmcnt(0)" ::: "memory")
__device__ __forceinline__ unsigned long long rt() { return __builtin_amdgcn_s_memrealtime(); }
__device__ __forceinline__ unsigned f2bf(float f) { unsigned u = __builtin_bit_cast(unsigned, f); return (u + 0x7fffu + ((u >> 16) & 1u)) >> 16; }
__device__ __forceinline__ unsigned pk2(float lo, float hi) { return f2bf(lo) | (f2bf(hi) << 16); }

#define XB_TMO      128
#define XB_XCNT(j)  (256  + 64 * (j))
#define XB_XSUB(j)  (1280 + 64 * (j))
#define XB_XGEN(j)  (2304 + 64 * (j))
#define XB_TOP      3328
#define XB_TOPGEN   3392
#define XCD_BAR_WORDS 3456
#define XB_SPIN_CAP (1u << 18)

__device__ __forceinline__ unsigned xb_ld(unsigned* p)              { return __hip_atomic_load(p, __ATOMIC_RELAXED, __HIP_MEMORY_SCOPE_AGENT); }
__device__ __forceinline__ unsigned xb_add(unsigned* p, unsigned v) { return __hip_atomic_fetch_add(p, v, __ATOMIC_RELAXED, __HIP_MEMORY_SCOPE_AGENT); }
__device__ __forceinline__ unsigned xb_xcc_id() { return (unsigned)__builtin_amdgcn_s_getreg((3 << 11) | 20) & 0xFu; }
#define XB_SPIN(cond, bar) do { unsigned _sp = 0; while (cond) { __builtin_amdgcn_s_sleep(1); \
    if ((++_sp & 255u) == 0u) { if (xb_ld(&(bar)[XB_TMO])) break; if (_sp > XB_SPIN_CAP) { atomicAdd(&(bar)[XB_TMO], 1u); break; } } } } while (0)

struct XcdBarrier {
    unsigned* bar; unsigned x;
    volatile LAS unsigned* st;
};

__device__ __forceinline__ XcdBarrier xcd_barrier_post(unsigned* bar, volatile LAS unsigned* st) {
    XcdBarrier b; b.bar = bar; b.x = xb_xcc_id(); b.st = st;
    if (threadIdx.x == 0) (void)xb_add(&bar[XB_XCNT(b.x)], 1u);
    return b;
}
__device__ __forceinline__ void xcd_barrier_complete(unsigned* bar, unsigned x, unsigned& nloc, unsigned& nx) {
    const unsigned G = gridDim.x * gridDim.y * gridDim.z;
    unsigned sum, cnt, mine, sp = 0u;
    for (;;) {
        sum = 0u; cnt = 0u; mine = 0u;
#pragma unroll
        for (unsigned j = 0; j < 16; ++j) { const unsigned c = xb_ld(&bar[XB_XCNT(j)]); sum += c; cnt += (c > 0u) ? 1u : 0u; mine = (j == x) ? c : mine; }
        if (sum == G) break;
        __builtin_amdgcn_s_sleep(1);
        if ((++sp & 255u) == 0u) { if (xb_ld(&bar[XB_TMO])) break; if (sp > XB_SPIN_CAP) { atomicAdd(&bar[XB_TMO], 1u); break; } }
    }
    nloc = mine > 0u ? mine : 1u; nx = cnt > 0u ? cnt : 1u;
}

__device__ __forceinline__ void xcd_barrier(const XcdBarrier& b) {
    asm volatile("s_waitcnt vmcnt(0)" ::: "memory");
    __syncthreads();
    if (threadIdx.x == 0) {
        unsigned* bar = b.bar;
        __builtin_amdgcn_s_waitcnt(0);
        unsigned nloc = b.st[0], nx = b.st[1];
        if (nloc == 0u) { xcd_barrier_complete(bar, b.x, nloc, nx); b.st[0] = nloc; b.st[1] = nx; }
        const unsigned old = xb_add(&bar[XB_XSUB(b.x)], 1u);
        const unsigned gen = old / nloc;
        if (old + 1u == (gen + 1u) * nloc) {
            __builtin_amdgcn_fence(__ATOMIC_RELEASE, "agent");
            asm volatile("s_waitcnt vmcnt(0)" ::: "memory");
            const unsigned og = xb_add(&bar[XB_TOP], 1u);
            const unsigned tg = og / nx;
            if (og + 1u == (tg + 1u) * nx) xb_add(&bar[XB_TOPGEN], 1u);
            else XB_SPIN(xb_ld(&bar[XB_TOPGEN]) == tg, bar);
            __builtin_amdgcn_fence(__ATOMIC_ACQUIRE, "agent");
            xb_add(&bar[XB_XGEN(b.x)], 1u);
            asm volatile("s_waitcnt vmcnt(0)" ::: "memory");
        } else {
            XB_SPIN(xb_ld(&bar[XB_XGEN(b.x)]) == gen, bar);
            __builtin_amdgcn_fence(__ATOMIC_ACQUIRE, "agent");
            asm volatile("s_waitcnt vmcnt(0)" ::: "memory");
        }
    }
    __syncthreads();
}

constexpr int NWAVES = 8, NTHR = 512;
constexpr int BATCH = 4, SEQ = 4096, D = 1024, M = BATCH * SEQ;
constexpr int NPROJ = 4352, LDW_IN = 4360, NMOD = 6144;
constexpr int C_QA = 0, C_KA = 512, C_VA = 640, C_QB = 768, C_KB = 1280, C_VB = 1792, C_GLA = 2304, C_GLB = 3328;
constexpr int NEXP = 16384;
constexpr float EPS = 1e-6f;

constexpr size_t MiB = 1u << 20;
constexpr size_t WS_CTL = 0, CTL_ZERO_BYTES = 1 * MiB;
constexpr size_t WS_MOD = 1 * MiB, WS_LOGF = 1 * MiB + 128 * 1024, WS_SUBK = 2 * MiB;
constexpr size_t WS_WIN = 4 * MiB, WS_WA = 12 * MiB + 512 * 1024, WS_WB = 13 * MiB + 512 * 1024, WS_WOUT = 14 * MiB + 512 * 1024, WS_WQ = 16 * MiB + 512 * 1024;
constexpr size_t WS_ED = 19 * MiB, WS_EU = 35 * MiB;
constexpr size_t WS_EDS = 2 * MiB + 512 * 1024;
constexpr size_t WS_H2Q = 95 * MiB, WS_H2S = 111 * MiB;
constexpr size_t WS_H = 83 * MiB, WS_OA = 83 * MiB, WS_OB = 99 * MiB, WS_PIDX = 83 * MiB, WS_PG = 87 * MiB;
constexpr size_t WS_PROJ = 115 * MiB, WS_X1 = 115 * MiB, WS_H2 = 179 * MiB, WS_QP = 211 * MiB;
constexpr size_t WS_END = 251 * MiB;
static_assert(WS_WIN + (size_t)NPROJ * D * 2 <= WS_WA && WS_WQ + (size_t)D * D * 2 <= WS_ED && WS_PROJ + (size_t)M * NPROJ * 2 <= WS_END, "ws map");
constexpr int CW_BAR = 4096;

constexpr int RING_OFF = 0, RING_BYTES = 131072;
constexpr int LDSCTL_OFF = RING_BYTES, MISC_OFF = LDSCTL_OFF + 320;
constexpr int LDS_BYTES = 147456;

typedef float f32x16 __attribute__((ext_vector_type(16)));
typedef short s16x4 __attribute__((ext_vector_type(4)));
typedef unsigned u32x2 __attribute__((ext_vector_type(2)));
typedef float f32x2_t __attribute__((ext_vector_type(2)));
typedef __bf16 bf16x2_t __attribute__((ext_vector_type(2)));

__device__ __forceinline__ unsigned cvtpk(float lo, float hi) { f32x2_t v = {lo, hi}; bf16x2_t b = __builtin_convertvector(v, bf16x2_t); return __builtin_bit_cast(unsigned, b); }
__device__ __forceinline__ float bflo(unsigned u) { return __uint_as_float(u << 16); }
__device__ __forceinline__ float bfhi(unsigned u) { return __uint_as_float(u & 0xffff0000u); }
__device__ __forceinline__ float wave_sum(float v) {
#pragma unroll
    for (int o = 1; o < 64; o <<= 1) v += __shfl_xor(v, o);
    return v;
}
__device__ __forceinline__ int crow(int r, int hi) { return (r & 3) + 8 * (r >> 2) + 4 * hi; }
#define MFMA32(a, b, c) __builtin_amdgcn_mfma_f32_32x32x16_bf16((a), (b), (c), 0, 0, 0)

struct Frame {
    LAS unsigned char* lds;
    int tid, lane, wave, vcu, G;
};
__device__ __forceinline__ const void* karg(int i) {
    unsigned long z = 0; asm volatile("" : "+s"(z));
    const char* base = (const char*)__builtin_amdgcn_kernarg_segment_ptr();
    return *(const void* const*)(base + 8 * i + z);
}

__device__ __forceinline__ void p0_transpose_item(const float* W, int ld, int K, int ncols, bf16* WT, int row_off, LAS float* scr, int item, int lane) {
    const int nblk = ncols / 32, kb = item / nblk, nb = item % nblk, k0 = 64 * kb, n0 = 32 * nb;
#pragma unroll 8
    for (int i = 0; i < 32; ++i) { const int kk = 2 * i + (lane >> 5); scr[kk * 33 + (lane & 31)] = W[(size_t)(k0 + kk) * ld + n0 + (lane & 31)]; }
    LDS_WAIT(); asm volatile("" ::: "memory");
    const int c = lane & 7;
#pragma unroll
    for (int j = 0; j < 4; ++j) { const int n = (lane >> 3) + 8 * j; const LAS float* s = scr + (8 * c) * 33 + n;
        v4u o; o.x = pk2(s[0 * 33], s[1 * 33]); o.y = pk2(s[2 * 33], s[3 * 33]); o.z = pk2(s[4 * 33], s[5 * 33]); o.w = pk2(s[6 * 33], s[7 * 33]);
        *(GAS v4u*)(WT + (size_t)(row_off + n0 + n) * K + k0 + 8 * c) = o; }
    LDS_WAIT(); asm volatile("" ::: "memory");
}
__device__ __forceinline__ void p0_convert(const float* __restrict__ src, bf16* __restrict__ dst, long n_iters, int gw, int NGW, int lane) {
    for (long it0 = (long)gw * 4; it0 < n_iters; it0 += (long)NGW * 4) {
        f32x4 a[4][2];
#pragma unroll
        for (int u = 0; u < 4; ++u) { const long it = it0 + u; if (it < n_iters) { const float* p = src + it * 512 + lane * 4; a[u][0] = *(const f32x4*)p; a[u][1] = *(const f32x4*)(p + 256); } }
#pragma unroll
        for (int u = 0; u < 4; ++u) { const long it = it0 + u; if (it < n_iters) { bf16* q = dst + it * 512 + lane * 4;
            u32x2 w0, w1; w0.x = cvtpk(a[u][0].x, a[u][0].y); w0.y = cvtpk(a[u][0].z, a[u][0].w); w1.x = cvtpk(a[u][1].x, a[u][1].y); w1.y = cvtpk(a[u][1].z, a[u][1].w);
            *(u32x2*)q = w0; *(u32x2*)(q + 256) = w1; } }
    }
}

__device__ __forceinline__ void p0_quant_tables(Frame& F, int gw, int NGW) {
    const float* ed = ((const float*)karg(15)); const float* eu = ((const float*)karg(16));
    unsigned char* EDq = (unsigned char*)(((unsigned char*)karg(19)) + WS_ED); unsigned char* EUq = (unsigned char*)(((unsigned char*)karg(19)) + WS_EU); float* EDS = (float*)(((unsigned char*)karg(19)) + WS_EDS);
    const int lane = F.lane;
    for (int row0 = gw * 4; row0 < NEXP; row0 += NGW * 4) {
        f32x4 a[4][4], u[4][4];
#pragma unroll
        for (int q = 0; q < 4; ++q)
#pragma unroll
            for (int j = 0; j < 4; ++j) { a[q][j] = *((const f32x4*)(ed + (size_t)(row0 + q) * D) + lane + 64 * j); u[q][j] = *((const f32x4*)(eu + (size_t)(row0 + q) * D) + lane + 64 * j); }
#pragma unroll
        for (int q = 0; q < 4; ++q) {
            float am = 0.f;
#pragma unroll
            for (int j = 0; j < 4; ++j) am = fmaxf(fmaxf(am, fmaxf(fabsf(a[q][j].x), fabsf(a[q][j].y))), fmaxf(fabsf(a[q][j].z), fabsf(a[q][j].w)));
#pragma unroll
            for (int o = 1; o < 64; o <<= 1) am = fmaxf(am, __shfl_xor(am, o));
            const float sc = am > 0.f ? am * (1.0f / 127.0f) : 1.0f, inv = 1.0f / sc;
            v4u qa, qu;
#pragma unroll
            for (int j = 0; j < 4; ++j) {
                const int b0 = (int)rintf(a[q][j].x * inv), b1 = (int)rintf(a[q][j].y * inv), b2 = (int)rintf(a[q][j].z * inv), b3 = (int)rintf(a[q][j].w * inv);
                qa[j] = (unsigned)(b0 & 255) | ((unsigned)(b1 & 255) << 8) | ((unsigned)(b2 & 255) << 16) | ((unsigned)(b3 & 255) << 24);
                int p = __builtin_amdgcn_cvt_pk_fp8_f32(u[q][j].x * 16.0f, u[q][j].y * 16.0f, 0, false);
                p = __builtin_amdgcn_cvt_pk_fp8_f32(u[q][j].z * 16.0f, u[q][j].w * 16.0f, p, true);
                qu[j] = (unsigned)p;
            }
            *(v4u*)(EDq + (size_t)(row0 + q) * D + 16 * lane) = qa;
            *(v4u*)(EUq + (size_t)(row0 + q) * D + 16 * lane) = qu;
            if (lane == 0) EDS[row0 + q] = sc;
        }
    }
}
__device__ __forceinline__ void p0_prologue(Frame& F) {
    const float* c = ((const float*)karg(1)); const float* w_ada = ((const float*)karg(4)); const float* b_ada = ((const float*)karg(5));
    float* MOD = (float*)(((unsigned char*)karg(19)) + WS_MOD);
    {
        LAS float* cact = (LAS float*)(F.lds);
        LAS float* part = (LAS float*)(F.lds + 16384);
        bool did = false;
        for (int item = F.vcu; item < NMOD / 32; item += F.G) {
            if (!did) { for (int i = F.tid; i < 4096; i += NTHR) { const float cv = c[i]; cact[i] = cv / (1.0f + __expf(-cv)); } did = true; }
            __syncthreads();
            const int n0 = item * 32, col = n0 + (F.lane & 31), ksub = F.lane >> 5;
            float a0 = 0.f, a1 = 0.f, a2 = 0.f, a3 = 0.f;
#pragma unroll 16
            for (int it = 0; it < 64; ++it) { const int k = (it * 8 + F.wave) * 2 + ksub; const float w = w_ada[(size_t)k * NMOD + col];
                a0 += cact[k] * w; a1 += cact[1024 + k] * w; a2 += cact[2048 + k] * w; a3 += cact[3072 + k] * w; }
            a0 += __shfl_xor(a0, 32); a1 += __shfl_xor(a1, 32); a2 += __shfl_xor(a2, 32); a3 += __shfl_xor(a3, 32);
            if (F.lane < 32) { part[(F.wave * 4 + 0) * 32 + F.lane] = a0; part[(F.wave * 4 + 1) * 32 + F.lane] = a1; part[(F.wave * 4 + 2) * 32 + F.lane] = a2; part[(F.wave * 4 + 3) * 32 + F.lane] = a3; }
            __syncthreads();
            if (F.tid < 128) { const int b = F.tid >> 5, cl = F.tid & 31; float s = 0.f;
#pragma unroll
                for (int w = 0; w < 8; ++w) s += part[(w * 4 + b) * 32 + cl];
                MOD[b * NMOD + n0 + cl] = s + b_ada[n0 + cl]; }
            __syncthreads();
        }
    }
    LAS float* scr = (LAS float*)(F.lds + RING_OFF + F.wave * 16384);
    const int gw = F.vcu * NWAVES + F.wave, NGW = F.G * NWAVES;
    constexpr int I_IN1 = (D / 64) * (2304 / 32), I_IN2 = (D / 64) * (2048 / 32), I_AB = (512 / 64) * (D / 32), I_SQ = (D / 64) * (D / 32);
    constexpr int NITEMS = I_IN1 + I_IN2 + 2 * I_AB + 2 * I_SQ;
    bf16* Win_t = (bf16*)(((unsigned char*)karg(19)) + WS_WIN);
    for (int it = gw; it < NITEMS; it += NGW) {
        int r = it;
        if (r < I_IN1) { p0_transpose_item(((const float*)karg(6)), LDW_IN, D, 2304, Win_t, 0, scr, r, F.lane); continue; } r -= I_IN1;
        if (r < I_IN2) { p0_transpose_item(((const float*)karg(6)) + 2312, LDW_IN, D, 2048, Win_t, 2304, scr, r, F.lane); continue; } r -= I_IN2;
        if (r < I_AB) { p0_transpose_item(((const float*)karg(9)), D, 512, D, (bf16*)(((unsigned char*)karg(19)) + WS_WA), 0, scr, r, F.lane); continue; } r -= I_AB;
        if (r < I_AB) { p0_transpose_item(((const float*)karg(10)), D, 512, D, (bf16*)(((unsigned char*)karg(19)) + WS_WB), 0, scr, r, F.lane); continue; } r -= I_AB;
        if (r < I_SQ) { p0_transpose_item(((const float*)karg(11)), D, D, D, (bf16*)(((unsigned char*)karg(19)) + WS_WOUT), 0, scr, r, F.lane); continue; } r -= I_SQ;
        p0_transpose_item(((const float*)karg(13)), D, D, D, (bf16*)(((unsigned char*)karg(19)) + WS_WQ), 0, scr, r, F.lane);
    }
    p0_quant_tables(F, gw, NGW);
    p0_convert(((const float*)karg(14)), (bf16*)(((unsigned char*)karg(19)) + WS_SUBK), (long)(8 * 2 * 128 * 64) / 512, gw, NGW, F.lane);
}

__device__ __forceinline__ void p1_norm(Frame& F) {
    const float* x = ((const float*)karg(0)); const float* g1 = ((const float*)karg(2)); const float* w_in = ((const float*)karg(6)); const float* b_forget = ((const float*)karg(7));
    const float* MOD = (const float*)(((unsigned char*)karg(19)) + WS_MOD); bf16* H = (bf16*)(((unsigned char*)karg(19)) + WS_H); float* LOGF = (float*)(((unsigned char*)karg(19)) + WS_LOGF);
    LAS float* wfl = (LAS float*)(F.lds);
    { float tmp[16];
#pragma unroll
      for (int n = 0; n < 16; ++n) { const int i = F.tid + n * NTHR; tmp[n] = w_in[(size_t)(i >> 3) * LDW_IN + 2304 + (i & 7)]; }
#pragma unroll
      for (int n = 0; n < 16; ++n) { const int i = F.tid + n * NTHR; wfl[(i & 7) * 1024 + (i >> 3)] = tmp[n]; } }
    __syncthreads();
    const int gw = F.vcu * NWAVES + F.wave, NGW = F.G * NWAVES;
    f32x4 cur[4], nxt[4];
    if (gw < M) { const f32x4* xr = (const f32x4*)(x + (size_t)gw * D) + F.lane;
#pragma unroll
        for (int j = 0; j < 4; ++j) cur[j] = xr[64 * j]; }
    for (int row = gw; row < M; row += NGW) {
        { const int nrow = row + NGW; if (nrow < M) { const f32x4* xr = (const f32x4*)(x + (size_t)nrow * D) + F.lane;
#pragma unroll
            for (int j = 0; j < 4; ++j) nxt[j] = xr[64 * j]; } }
        {{
        float ss = 0.f;
#pragma unroll
        for (int j = 0; j < 4; ++j) ss += (cur[j].x * cur[j].x + cur[j].y * cur[j].y) + (cur[j].z * cur[j].z + cur[j].w * cur[j].w);
        ss = wave_sum(ss);
        const float rstd = 1.0f / sqrtf(ss * (1.0f / D) + EPS);
        const int b = row >> 12; const float* mb = MOD + b * NMOD;
        float fl[8];
#pragma unroll
        for (int jj = 0; jj < 8; ++jj) fl[jj] = 0.f;
#pragma unroll
        for (int j = 0; j < 4; ++j) { const int col = 4 * F.lane + 256 * j;
            const f32x4 g = *(const f32x4*)(g1 + col), sh = *(const f32x4*)(mb + col), sc = *(const f32x4*)(mb + 1024 + col);
            const f32x4 hv = (cur[j] * rstd) * g * (sc + 1.0f) + sh;
            u32x2 w; w.x = cvtpk(hv.x, hv.y); w.y = cvtpk(hv.z, hv.w);
            *(u32x2*)(H + (size_t)row * D + col) = w;
#pragma unroll
            for (int jj = 0; jj < 8; ++jj) { const f32x4 wv = *(const LAS f32x4*)(wfl + jj * 1024 + col); fl[jj] += (hv.x * wv.x + hv.y * wv.y) + (hv.z * wv.z + hv.w * wv.w); }
        }
        const int lane = F.lane; const bool b5 = (lane & 32) != 0, b4 = (lane & 16) != 0, b3 = (lane & 8) != 0;
        float r4[4];
#pragma unroll
        for (int u = 0; u < 4; ++u) { const float keep = b5 ? fl[u + 4] : fl[u], send = b5 ? fl[u] : fl[u + 4]; r4[u] = keep + __shfl_xor(send, 32); }
        float r2[2];
#pragma unroll
        for (int u = 0; u < 2; ++u) { const float keep = b4 ? r4[u + 2] : r4[u], send = b4 ? r4[u] : r4[u + 2]; r2[u] = keep + __shfl_xor(send, 16); }
        float r1; { const float keep = b3 ? r2[1] : r2[0], send = b3 ? r2[0] : r2[1]; r1 = keep + __shfl_xor(send, 8); }
        r1 += __shfl_xor(r1, 4); r1 += __shfl_xor(r1, 2); r1 += __shfl_xor(r1, 1);
        if ((lane & 7) == 0) { const int jj = lane >> 3; const float z = r1 + b_forget[jj]; const float ls = fminf(z, 0.f) - log1pf(__expf(-fabsf(z))); LOGF[(size_t)row * 8 + jj] = ls; }
        }}
#pragma unroll
        for (int j = 0; j < 4; ++j) cur[j] = nxt[j];
    }
}

constexpr int KP = 72;
constexpr int VPF = 68;
constexpr int VPS = 260;
struct FlashState { f32x16 o[2]; float m, l; };

__device__ __forceinline__ void flash_tail(FlashState& st, f32x16& s0, f32x16& s1, const LAS bf16* Vs, int vp, int r32, int hi) {
    float mt = s0[0];
#pragma unroll
    for (int r = 1; r < 16; ++r) mt = fmaxf(mt, s0[r]);
#pragma unroll
    for (int r = 0; r < 16; ++r) mt = fmaxf(mt, s1[r]);
    mt = fmaxf(mt, __shfl_xor(mt, 32));
    const float mn = fmaxf(st.m, mt);
    const float alpha = __expf(st.m - mn);
    st.m = mn;
    float ps = 0.f;
#pragma unroll
    for (int r = 0; r < 16; ++r) { s0[r] = __expf(s0[r] - mn); ps += s0[r]; }
#pragma unroll
    for (int r = 0; r < 16; ++r) { s1[r] = __expf(s1[r] - mn); ps += s1[r]; }
    st.l = st.l * alpha + ps;
#pragma unroll
    for (int r = 0; r < 16; ++r) { st.o[0][r] *= alpha; st.o[1][r] *= alpha; }
#pragma unroll
    for (int blk = 0; blk < 2; ++blk)
#pragma unroll
        for (int s = 0; s < 2; ++s) {
            v4u pw;
            if (blk == 0) { pw.x = cvtpk(s0[8 * s + 0], s0[8 * s + 1]); pw.y = cvtpk(s0[8 * s + 2], s0[8 * s + 3]); pw.z = cvtpk(s0[8 * s + 4], s0[8 * s + 5]); pw.w = cvtpk(s0[8 * s + 6], s0[8 * s + 7]); }
            else          { pw.x = cvtpk(s1[8 * s + 0], s1[8 * s + 1]); pw.y = cvtpk(s1[8 * s + 2], s1[8 * s + 3]); pw.z = cvtpk(s1[8 * s + 4], s1[8 * s + 5]); pw.w = cvtpk(s1[8 * s + 6], s1[8 * s + 7]); }
            const bf16x8 pf = __builtin_bit_cast(bf16x8, pw);
#pragma unroll
            for (int db = 0; db < 2; ++db) {
                const LAS bf16* vp0 = Vs + (32 * db + r32) * vp + 32 * blk + 16 * s + 4 * hi;
                const s16x4 lo = *(const LAS s16x4*)vp0, hh = *(const LAS s16x4*)(vp0 + 8);
                const bf16x8 vf = __builtin_shufflevector(lo, hh, 0, 1, 2, 3, 4, 5, 6, 7);
                st.o[db] = MFMA32(vf, pf, st.o[db]);
            }
        }
}
__device__ __forceinline__ void flash_qk(f32x16& s0, f32x16& s1, const bf16x8 (&qf)[4], const LAS bf16* Ks, int r32, int hi) {
    s0 = (f32x16){0.f}; s1 = (f32x16){0.f};
#pragma unroll
    for (int r = 0; r < 16; ++r) { s0[r] = 0.f; s1[r] = 0.f; }
#pragma unroll
    for (int ks = 0; ks < 4; ++ks) {
        const bf16x8 a0 = *(const LAS bf16x8*)(Ks + r32 * KP + 16 * ks + 8 * hi);
        const bf16x8 a1 = *(const LAS bf16x8*)(Ks + (32 + r32) * KP + 16 * ks + 8 * hi);
        s0 = MFMA32(a0, qf[ks], s0); s1 = MFMA32(a1, qf[ks], s1);
    }
}
__device__ __forceinline__ void flash_store(const FlashState& st, bf16* orow, int hi) {
    float lt = st.l + __shfl_xor(st.l, 32);
    const float inv = 1.0f / lt;
#pragma unroll
    for (int db = 0; db < 2; ++db)
#pragma unroll
        for (int rg = 0; rg < 4; ++rg) { u32x2 w; w.x = cvtpk(st.o[db][4 * rg] * inv, st.o[db][4 * rg + 1] * inv); w.y = cvtpk(st.o[db][4 * rg + 2] * inv, st.o[db][4 * rg + 3] * inv);
            *(u32x2*)(orow + 32 * db + 8 * rg + 4 * hi) = w; }
}

__device__ __forceinline__ void fox_unit(Frame& F, int b, int h, int qb, float& kmax2) {
    const bf16* proj = (const bf16*)(((unsigned char*)karg(19)) + WS_PROJ); const float* LOGF = (const float*)(((unsigned char*)karg(19)) + WS_LOGF); bf16* OB = (bf16*)(((unsigned char*)karg(19)) + WS_OB);
    LAS float* Fs = (LAS float*)(F.lds);
    LAS float* wtot = (LAS float*)(F.lds + 16384);
    LAS bf16* Kb = (LAS bf16*)(F.lds + 16384 + 128);
    LAS bf16* Vb = (LAS bf16*)(F.lds + 16384 + 128 + 2 * 64 * KP * 2);
    const int lane = F.lane, wave = F.wave, tid = F.tid, r32 = lane & 31, hi = lane >> 5;
    const int q_end = 256 * (qb + 1), NT = q_end / 64;
    const size_t rowbase = (size_t)b * SEQ;
    {
        float v[8]; float run = 0.f;
#pragma unroll
        for (int i = 0; i < 8; ++i) { const int pos = tid * 8 + i; const float lf = (pos < q_end) ? LOGF[(rowbase + pos) * 8 + h] : 0.f; run += lf; v[i] = run; }
        float inc = run;
#pragma unroll
        for (int o = 1; o < 64; o <<= 1) { const float t = __shfl_up(inc, o); if (lane >= o) inc += t; }
        if (lane == 63) wtot[wave] = inc;
        __syncthreads();
        float off = inc - run;
        for (int w = 0; w < wave; ++w) off += wtot[w];
#pragma unroll
        for (int i = 0; i < 8; ++i) Fs[tid * 8 + i] = v[i] + off;
    }
    const int qrow = 256 * qb + 32 * wave + r32;
    bf16x8 qf[4];
    { const bf16* qp = proj + (rowbase + qrow) * NPROJ + C_QB + 64 * h + 8 * hi;
#pragma unroll
      for (int ks = 0; ks < 4; ++ks) qf[ks] = *(const bf16x8*)(qp + 16 * ks); }
    const int tq = 4 * qb + (wave >> 1);
    {
        float qn = 0.f;
#pragma unroll
        for (int ks = 0; ks < 4; ++ks)
#pragma unroll
            for (int j = 0; j < 8; ++j) { const float e = __uint_as_float(((unsigned)(unsigned short)qf[ks][j]) << 16); qn += e * e; }
        qn += __shfl_xor(qn, 32);
#pragma unroll
        for (int o = 1; o < 32; o <<= 1) qn = fmaxf(qn, __shfl_xor(qn, o));
        float kn = 0.f;
        if (kmax2 < 0.f) {
            for (int pos = tid; pos < q_end; pos += NTHR) { const v4u* kr = (const v4u*)(proj + (rowbase + pos) * NPROJ + C_KB + 64 * h); float s = 0.f;
#pragma unroll
                for (int c8 = 0; c8 < 8; ++c8) { const v4u w = kr[c8]; const unsigned wx = w.x, wy = w.y, wz = w.z, ww = w.w;
                    s += bflo(wx) * bflo(wx) + bfhi(wx) * bfhi(wx) + bflo(wy) * bflo(wy) + bfhi(wy) * bfhi(wy) + bflo(wz) * bflo(wz) + bfhi(wz) * bfhi(wz) + bflo(ww) * bflo(ww) + bfhi(ww) * bfhi(ww); }
                kn = fmaxf(kn, s); }
#pragma unroll
            for (int o = 1; o < 64; o <<= 1) kn = fmaxf(kn, __shfl_xor(kn, o));
        }
        if (lane == 0) { wtot[8 + wave] = qn; wtot[16 + wave] = kn; }
    }
    FlashState st; st.m = -INFINITY; st.l = 0.f;
#pragma unroll
    for (int r = 0; r < 16; ++r) { st.o[0][r] = 0.f; st.o[1][r] = 0.f; }
    const int srow = tid >> 3, sch = tid & 7;
    const bf16* kg = proj + (rowbase + srow) * NPROJ + C_KB + 64 * h + 8 * sch;
    const bf16* vg = proj + (rowbase + srow) * NPROJ + C_VB + 64 * h + 8 * sch;
    v4u kreg, vreg;
    { const size_t o = (size_t)(NT - 1) * 64 * NPROJ; kreg = *(const v4u*)(kg + o); vreg = *(const v4u*)(vg + o); }
    int cur = 0;
    {   *(LAS v4u*)(Kb + srow * KP + 8 * sch) = kreg;
        const unsigned short* vs = (const unsigned short*)&vreg;
#pragma unroll
        for (int i = 0; i < 8; ++i) Vb[(8 * sch + i) * VPF + srow] = vs[i];
    }
    __syncthreads();
    const float fq = Fs[qrow];
    int t_lo = 0;
    {
        float qm = 0.f, km = 0.f;
#pragma unroll
        for (int w = 0; w < 8; ++w) { qm = fmaxf(qm, wtot[8 + w]); km = fmaxf(km, wtot[16 + w]); }
        if (kmax2 < 0.f) kmax2 = km;
        const float A = 0.125f * sqrtf(qm) * sqrtf(kmax2) * 1.01f, f0 = Fs[256 * qb];
        for (int t = NT - 5; t >= 0; --t) if (Fs[64 * t + 63] - f0 > 2.0f * A + 60.0f) { t_lo = t + 1; break; }
    }
    for (int t = NT - 1; t >= t_lo; --t) {
        if (t > t_lo) { const size_t o = (size_t)(t - 1) * 64 * NPROJ; kreg = *(const v4u*)(kg + o); vreg = *(const v4u*)(vg + o); }
        if (t <= tq) {
            const LAS bf16* Ks = Kb + cur * 64 * KP; const LAS bf16* Vs = Vb + cur * 64 * VPF;
            f32x16 s0, s1; flash_qk(s0, s1, qf, Ks, r32, hi);
            const LAS float* Fk = Fs + 64 * t;
            const bool diag = (t == tq);
#pragma unroll
            for (int rg = 0; rg < 4; ++rg) {
                const f32x4 f0 = *(const LAS f32x4*)(Fk + 8 * rg + 4 * hi), f1 = *(const LAS f32x4*)(Fk + 32 + 8 * rg + 4 * hi);
#pragma unroll
                for (int i = 0; i < 4; ++i) { const int r = 4 * rg + i; const int kv = 64 * t + 8 * rg + 4 * hi + i;
                    float a = s0[r] * 0.125f + (fq - f0[i]); float c = s1[r] * 0.125f + (fq - f1[i]);
                    if (diag) { if (kv > qrow) a = -INFINITY; if (kv + 32 > qrow) c = -INFINITY; }
                    s0[r] = a; s1[r] = c; }
            }
            flash_tail(st, s0, s1, Vs, VPF, r32, hi);
        }
        if (t > t_lo) {
            const int nb = cur ^ 1;
            *(LAS v4u*)(Kb + nb * 64 * KP + srow * KP + 8 * sch) = kreg;
            const unsigned short* vs = (const unsigned short*)&vreg;
#pragma unroll
            for (int i = 0; i < 8; ++i) Vb[nb * 64 * VPF + (8 * sch + i) * VPF + srow] = vs[i];
        }
        __syncthreads();
        cur ^= 1;
    }
    flash_store(st, OB + (rowbase + qrow) * 512 + 64 * h, hi);
    __syncthreads();
}

__device__ const unsigned char T5_BUCKET[128] = {0,1,2,3,4,5,6,7,8,9,10,11,12,13,14,15,16,16,16,17,17,18,18,18,19,19,19,20,20,20,20,21,21,21,21,22,22,22,22,22,23,23,23,23,23,23,24,24,24,24,24,24,25,25,25,25,25,25,25,26,26,26,26,26,26,26,26,27,27,27,27,27,27,27,27,27,27,28,28,28,28,28,28,28,28,28,28,29,29,29,29,29,29,29,29,29,29,29,29,30,30,30,30,30,30,30,30,30,30,30,30,30,30,31,31,31,31,31,31,31,31,31,31,31,31,31,31,31};

__device__ __forceinline__ void swa_unit(Frame& F, int b, int kvh, int n) {
    const bf16* proj = (const bf16*)(((unsigned char*)karg(19)) + WS_PROJ); bf16* OA = (bf16*)(((unsigned char*)karg(19)) + WS_OA);
    const float* sinks = ((const float*)karg(8)); const float* rel_bias = ((const float*)karg(12));
    LAS bf16* Kb = (LAS bf16*)(F.lds);
    LAS bf16* Vb = (LAS bf16*)(F.lds + 36864);
    LAS float* bt = (LAS float*)(F.lds + 36864 + 33280);
    const int lane = F.lane, wave = F.wave, tid = F.tid, r32 = lane & 31, hi = lane >> 5;
    const size_t rowbase = (size_t)b * SEQ;
    {
        const int g = tid >> 7, d = tid & 127;
        bt[tid] = rel_bias[(int)T5_BUCKET[d] * 8 + kvh * 4 + g];
#pragma unroll
        for (int i = 0; i < 4; ++i) {
            const int idx = tid + i * NTHR, kb = idx >> 3, sch = idx & 7; const int pos = 128 * (n - 1) + kb;
            v4u kreg = (v4u){0u, 0u, 0u, 0u}, vreg = (v4u){0u, 0u, 0u, 0u};
            if (pos >= 0) { const bf16* p = proj + (rowbase + pos) * NPROJ + 64 * kvh + 8 * sch; kreg = *(const v4u*)(p + C_KA); vreg = *(const v4u*)(p + C_VA); }
            *(LAS v4u*)(Kb + kb * KP + 8 * sch) = kreg;
            const unsigned short* vs = (const unsigned short*)&vreg;
#pragma unroll
            for (int j = 0; j < 8; ++j) Vb[(8 * sch + j) * VPS + kb] = vs[j];
        }
    }
    __syncthreads();
    const int g = wave & 3, qh = wave >> 2, head = kvh * 4 + g;
    const LAS float* btg = bt + g * 128;
    for (int sb = 0; sb < 2; ++sb) {
        const int qrel0 = 64 * qh + 32 * sb, qrel = qrel0 + r32;
        const size_t row = rowbase + 128 * n + qrel;
        bf16x8 qf[4];
        { const bf16* qp = proj + row * NPROJ + C_QA + 64 * head + 8 * hi;
#pragma unroll
          for (int ks = 0; ks < 4; ++ks) qf[ks] = *(const bf16x8*)(qp + 16 * ks); }
        FlashState st; st.m = sinks[head]; st.l = (hi == 0) ? 1.0f : 0.0f;
#pragma unroll
        for (int r = 0; r < 16; ++r) { st.o[0][r] = 0.f; st.o[1][r] = 0.f; }
        const int t_lo = (qrel0 + 1) >> 6, t_hi = (qrel0 + 159) >> 6;
        for (int t = t_lo; t <= t_hi; ++t) {
            f32x16 s0, s1; flash_qk(s0, s1, qf, Kb + t * 64 * KP, r32, hi);
#pragma unroll
            for (int r = 0; r < 16; ++r) {
                const int kb0 = 64 * t + crow(r, hi), kb1 = kb0 + 32;
                const int d0 = 128 + qrel - kb0, d1 = d0 - 32;
                const bool v0 = (d0 >= 0) && (d0 < 128) && (n > 0 || kb0 >= 128);
                const bool v1 = (d1 >= 0) && (d1 < 128) && (n > 0 || kb1 >= 128);
                const float b0 = btg[d0 & 127], b1 = btg[d1 & 127];
                s0[r] = v0 ? (s0[r] * 0.125f + b0) : -INFINITY;
                s1[r] = v1 ? (s1[r] * 0.125f + b1) : -INFINITY;
            }
            flash_tail(st, s0, s1, Vb + 64 * t, VPS, r32, hi);
        }
        flash_store(st, OA + row * 512 + 64 * head, hi);
    }
    __syncthreads();
}
__device__ __forceinline__ void p3_attention(Frame& F) {
    for (int item = F.vcu; item < 256; item += F.G) {
        swa_unit(F, item >> 6, (item >> 5) & 1, item & 31);
        const int bh = item >> 3, j = item & 7;
        float kmax2 = -1.0f;
        fox_unit(F, bh >> 3, bh & 7, 15 - j, kmax2);
        fox_unit(F, bh >> 3, bh & 7, j, kmax2);
    }
}

struct PairOrder {
    pg8::StaticOrder S;
    __device__ bool next(int i, pg8::Unit& u) const { if (!S.next(i >> 1, u)) return false; u.src = i & 1; return true; }
    __device__ __forceinline__ void a_ready(const pg8::Unit&) const {}
    __device__ __forceinline__ void done(const pg8::Unit&) const {}
};
__device__ __forceinline__ float sigmoidf_(float z) { return 1.0f / (1.0f + __expf(-z)); }
struct EpiGate {
    static constexpr bool PERM = true, AFTER_DRAIN = false, CHAIN = true;
    const bf16* proj; bf16* mixed;
    __device__ __forceinline__ void operator()(pg8::f32x4 (&acc)[2][2][4][2], const pg8::Unit& u, int wr, int wc, int fr, int fq) const {
#pragma unroll
        for (int ai = 0; ai < 2; ++ai)
#pragma unroll
            for (int m = 0; m < 4; ++m) { const size_t row = (size_t)u.pm * 256 + ai * 128 + wr * 64 + m * 16 + fr;
#pragma unroll
                for (int bj = 0; bj < 2; ++bj) { const int col0 = u.pn * 256 + bj * 128 + wc * 32 + 8 * fq;
                    const v4u gb = *(const v4u*)(proj + row * NPROJ + C_GLB + col0);
                    const unsigned gbw[4] = {gb.x, gb.y, gb.z, gb.w};
                    if (u.src == 0) {
                        const v4u ga = *(const v4u*)(proj + row * NPROJ + C_GLA + col0);
                        const unsigned gaw[4] = {ga.x, ga.y, ga.z, ga.w};
#pragma unroll
                        for (int e = 0; e < 8; ++e) { const float za = (e & 1) ? bfhi(gaw[e >> 1]) : bflo(gaw[e >> 1]), zb = (e & 1) ? bfhi(gbw[e >> 1]) : bflo(gbw[e >> 1]);
                            const float ratio = (1.0f + __expf(-zb)) * __builtin_amdgcn_rcpf(1.0f + __expf(-za));
                            acc[ai][bj][m][e >> 2][e & 3] *= ratio; }
                    } else {
                        float v[8];
#pragma unroll
                        for (int e = 0; e < 8; ++e) { const float zb = (e & 1) ? bfhi(gbw[e >> 1]) : bflo(gbw[e >> 1]); v[e] = acc[ai][bj][m][e >> 2][e & 3] * __builtin_amdgcn_rcpf(1.0f + __expf(-zb)); }
                        v4u w; w.x = cvtpk(v[0], v[1]); w.y = cvtpk(v[2], v[3]); w.z = cvtpk(v[4], v[5]); w.w = cvtpk(v[6], v[7]);
                        *(v4u*)(mixed + row * D + col0) = w;
                    }
                }
            }
    }
};
struct EpiRes {
    static constexpr bool PERM = true, AFTER_DRAIN = false, CHAIN = false;
    const float* x; const float* mod; float* x1;
    __device__ __forceinline__ void operator()(const pg8::f32x4 (&acc)[2][2][4][2], const pg8::Unit& u, int wr, int wc, int fr, int fq) const {
#pragma unroll
        for (int ai = 0; ai < 2; ++ai)
#pragma unroll
            for (int m = 0; m < 4; ++m) { const size_t row = (size_t)u.pm * 256 + ai * 128 + wr * 64 + m * 16 + fr; const int b = (int)(row >> 12);
#pragma unroll
                for (int bj = 0; bj < 2; ++bj) { const int col0 = u.pn * 256 + bj * 128 + wc * 32 + 8 * fq;
#pragma unroll
                    for (int n = 0; n < 2; ++n) { const int col = col0 + 4 * n;
                        const pg8::f32x4 xin = *(const pg8::f32x4*)(x + row * D + col), gt = *(const pg8::f32x4*)(mod + b * NMOD + 2048 + col);
                        *(pg8::f32x4*)(x1 + row * D + col) = xin + gt * acc[ai][bj][m][n]; } }
            }
    }
};

__device__ __forceinline__ void p6_norm2(Frame& F) {
    const float* x1 = (const float*)(((unsigned char*)karg(19)) + WS_X1); const float* g2 = ((const float*)karg(3)); const float* MOD = (const float*)(((unsigned char*)karg(19)) + WS_MOD); bf16* H2 = (bf16*)(((unsigned char*)karg(19)) + WS_H2); unsigned char* H2Q = (unsigned char*)(((unsigned char*)karg(19)) + WS_H2Q); float* H2S = (float*)(((unsigned char*)karg(19)) + WS_H2S);
    const int gw = F.vcu * NWAVES + F.wave, NGW = F.G * NWAVES;
    f32x4 cur[4], nxt[4];
    if (gw < M) { const f32x4* xr = (const f32x4*)(x1 + (size_t)gw * D) + F.lane;
#pragma unroll
        for (int j = 0; j < 4; ++j) cur[j] = xr[64 * j]; }
    for (int row = gw; row < M; row += NGW) {
        { const int nrow = row + NGW; if (nrow < M) { const f32x4* xr = (const f32x4*)(x1 + (size_t)nrow * D) + F.lane;
#pragma unroll
            for (int j = 0; j < 4; ++j) nxt[j] = xr[64 * j]; } }
        {
        f32x4 v[4], hq[4]; float ss = 0.f;
#pragma unroll
        for (int j = 0; j < 4; ++j) { v[j] = cur[j]; ss += (v[j].x * v[j].x + v[j].y * v[j].y) + (v[j].z * v[j].z + v[j].w * v[j].w); }
        ss = wave_sum(ss);
        const float rstd = 1.0f / sqrtf(ss * (1.0f / D) + EPS);
        const int b = row >> 12; const float* mb = MOD + b * NMOD;
#pragma unroll
        for (int j = 0; j < 4; ++j) { const int col = 4 * F.lane + 256 * j;
            const f32x4 g = *(const f32x4*)(g2 + col), sh = *(const f32x4*)(mb + 3072 + col), sc = *(const f32x4*)(mb + 4096 + col);
            const f32x4 hv = (v[j] * rstd) * g * (sc + 1.0f) + sh;
            u32x2 w; w.x = cvtpk(hv.x, hv.y); w.y = cvtpk(hv.z, hv.w);
            *(u32x2*)(H2 + (size_t)row * D + col) = w; hq[j] = hv; }
        float am = 0.f;
#pragma unroll
        for (int j = 0; j < 4; ++j) am = fmaxf(fmaxf(am, fmaxf(fabsf(hq[j].x), fabsf(hq[j].y))), fmaxf(fabsf(hq[j].z), fabsf(hq[j].w)));
#pragma unroll
        for (int o = 1; o < 64; o <<= 1) am = fmaxf(am, __shfl_xor(am, o));
        const float sc = am > 0.f ? am * (1.0f / 127.0f) : 1.0f, inv = 1.0f / sc;
        v4u qa;
#pragma unroll
        for (int j = 0; j < 4; ++j) { const int b0 = (int)rintf(hq[j].x * inv), b1 = (int)rintf(hq[j].y * inv), b2 = (int)rintf(hq[j].z * inv), b3 = (int)rintf(hq[j].w * inv);
            qa[j] = (unsigned)(b0 & 255) | ((unsigned)(b1 & 255) << 8) | ((unsigned)(b2 & 255) << 16) | ((unsigned)(b3 & 255) << 24); }
        *(v4u*)(H2Q + (size_t)row * D + 16 * F.lane) = qa;
        if (F.lane == 0) H2S[row] = sc;
        }
#pragma unroll
        for (int j = 0; j < 4; ++j) cur[j] = nxt[j];
    }
}

__device__ __forceinline__ unsigned f2ord(float f) { const unsigned u = __float_as_uint(f); return u ^ ((unsigned)((int)u >> 31) | 0x80000000u); }
__device__ __forceinline__ float ord2f(unsigned o) { const unsigned u = (o & 0x80000000u) ? (o & 0x7fffffffu) : ~o; return __uint_as_float(u); }
#define CE_DESC(a, b) do { const unsigned _x = (a), _y = (b); (a) = _x > _y ? _x : _y; (b) = _x > _y ? _y : _x; } while (0)
__device__ __forceinline__ void sort16(unsigned (&k)[16]) {
#pragma unroll
    for (int size = 2; size <= 16; size <<= 1)
#pragma unroll
        for (int stride = size >> 1; stride > 0; stride >>= 1)
#pragma unroll
            for (int i = 0; i < 16; ++i) { const int j = i ^ stride; if (j > i) { if ((i & size) == 0) CE_DESC(k[i], k[j]); else CE_DESC(k[j], k[i]); } }
}
__device__ __forceinline__ void merge16(unsigned (&a)[16], const unsigned (&b)[16]) {
#pragma unroll
    for (int i = 0; i < 16; ++i) a[i] = a[i] > b[15 - i] ? a[i] : b[15 - i];
#pragma unroll
    for (int stride = 8; stride > 0; stride >>= 1)
#pragma unroll
        for (int i = 0; i < 16; ++i) { const int j = i ^ stride; if (j > i) CE_DESC(a[i], a[j]); }
}
__device__ __forceinline__ void top16_of_64(unsigned (&g0)[16], unsigned (&g1)[16], unsigned (&g2)[16], unsigned (&g3)[16]) {
    sort16(g0); sort16(g1); sort16(g2); sort16(g3);
    merge16(g0, g1); merge16(g2, g3); merge16(g0, g2);
}
constexpr int NCAND = 50;
__device__ __forceinline__ void p8a_topk(Frame& F) {
    const bf16* QP = (const bf16*)(((unsigned char*)karg(19)) + WS_QP); const bf16* SUBK = (const bf16*)(((unsigned char*)karg(19)) + WS_SUBK);
    unsigned short* PIDX = (unsigned short*)(((unsigned char*)karg(19)) + WS_PIDX); float* PG = (float*)(((unsigned char*)karg(19)) + WS_PG);
    LAS unsigned short* Elds = (LAS unsigned short*)(F.lds) + F.wave * (NCAND * 64);
    const int lane = F.lane, r32 = lane & 31, hi = lane >> 5;
    const int gw = F.vcu * NWAVES + F.wave, NGW = F.G * NWAVES;
    for (int it2 = 0; it2 < 2 * ((M / 64 - F.vcu + F.G - 1) / F.G); ++it2) {
        const int wi = F.vcu + (it2 >> 1) * F.G;
        const int tile = 2 * wi + (it2 & 1);
        const int tok = tile * 32 + r32;
        { const int h = F.wave;
            unsigned top[2][16];
#pragma unroll
            for (int p = 0; p < 2; ++p) {
                bf16x8 qf[4];
                { const bf16* qp = QP + (size_t)tok * D + h * 128 + p * 64 + 8 * hi;
#pragma unroll
                  for (int ks = 0; ks < 4; ++ks) qf[ks] = *(const bf16x8*)(qp + 16 * ks); }
                const bf16* kp = SUBK + (size_t)((h * 2 + p) * 128 + r32) * 64 + 8 * hi;
                unsigned kk[4][16];
#pragma unroll
                for (int blk = 0; blk < 4; ++blk) {
                    f32x16 acc;
#pragma unroll
                    for (int r = 0; r < 16; ++r) acc[r] = 0.f;
#pragma unroll
                    for (int ks = 0; ks < 4; ++ks) { const bf16x8 a = *(const bf16x8*)(kp + (size_t)blk * 32 * 64 + 16 * ks); acc = MFMA32(a, qf[ks], acc); }
#pragma unroll
                    for (int r = 0; r < 16; ++r) { const int key = 32 * blk + crow(r, hi); kk[blk][r] = (f2ord(acc[r]) & ~127u) | (unsigned)(127 - key); }
                }
                top16_of_64(kk[0], kk[1], kk[2], kk[3]);
                unsigned other[16];
#pragma unroll
                for (int i = 0; i < 16; ++i) other[i] = (unsigned)__shfl_xor((int)kk[0][i], 32);
                merge16(kk[0], other);
#pragma unroll
                for (int i = 0; i < 16; ++i) top[p][i] = kk[0][i];
            }
            float s1[16], s2[16]; unsigned i1[16], i2[16];
#pragma unroll
            for (int i = 0; i < 16; ++i) { s1[i] = ord2f(top[0][i] & ~127u); i1[i] = 127u - (top[0][i] & 127u); s2[i] = ord2f(top[1][i] & ~127u); i2[i] = 127u - (top[1][i] & 127u); }
            unsigned ck[4][16];
#pragma unroll
            for (int c = 0; c < 64; ++c) {
                if (c < NCAND) { constexpr int CA[NCAND] = {0,0,0,0,0,0,0,0,0,0,0,0,0,0,0,0,1,1,1,1,1,1,1,1,2,2,2,2,2,3,3,3,3,4,4,4,5,5,6,6,7,7,8,9,10,11,12,13,14,15}; constexpr int CB[NCAND] = {0,1,2,3,4,5,6,7,8,9,10,11,12,13,14,15,0,1,2,3,4,5,6,7,0,1,2,3,4,0,1,2,3,0,1,2,0,1,0,1,0,1,0,0,0,0,0,0,0,0}; const int a = CA[c], b = CB[c];
                    ck[c >> 4][c & 15] = (f2ord(s1[a] + s2[b]) & ~63u) | (unsigned)(63 - c);
                    Elds[c * 64 + lane] = (unsigned short)(i1[a] * 128u + i2[b]); }
                else ck[c >> 4][c & 15] = 0u;
            }
            top16_of_64(ck[0], ck[1], ck[2], ck[3]);
            float w[16]; float wsum = 0.f; const float v0 = ord2f(ck[0][0] & ~63u);
#pragma unroll
            for (int r = 0; r < 16; ++r) { w[r] = __expf(ord2f(ck[0][r] & ~63u) - v0); wsum += w[r]; }
            const float winv = 1.0f / wsum;
#pragma unroll
            for (int r = 0; r < 16; ++r) if ((r >> 3) == hi) {
                const int c = 63 - (int)(ck[0][r] & 63u);
                const unsigned short eid = Elds[c * 64 + lane];
                PIDX[(size_t)tok * 128 + h * 16 + r] = eid; PG[(size_t)tok * 128 + h * 16 + r] = w[r] * winv; }
        }
    }
}

__device__ __forceinline__ float gelu_erf(float v) { return 0.5f * v * (1.0f + erff(v * 0.70710678118654752f)); }

#define PROBE_REPA 1
#define PROBE_REPB 1
constexpr int NR = 16, RSH = 17, BSA = 8, BSB = 4, ELP = 136;
__device__ __forceinline__ void sort128(unsigned& e0, unsigned& e1, int lane) {
#pragma unroll
    for (int size = 2; size <= 128; size <<= 1) {
#pragma unroll
        for (int stride = size >> 1; stride > 0; stride >>= 1) {
            if (stride == 64) { const unsigned lo = e0 < e1 ? e0 : e1, hi = e0 < e1 ? e1 : e0; e0 = lo; e1 = hi; }
            else {
                const bool lower = (lane & stride) == 0;
                const bool asc0 = (size == 128) ? true : (size == 64 ? true : ((lane & size) == 0));
                const bool asc1 = (size == 128) ? true : (size == 64 ? false : ((lane & size) == 0));
                const unsigned p0 = (unsigned)__shfl_xor((int)e0, stride), p1 = (unsigned)__shfl_xor((int)e1, stride);
                const unsigned mn0 = e0 < p0 ? e0 : p0, mx0 = e0 < p0 ? p0 : e0, mn1 = e1 < p1 ? e1 : p1, mx1 = e1 < p1 ? p1 : e1;
                e0 = (lower == asc0) ? mn0 : mx0; e1 = (lower == asc1) ? mn1 : mx1;
            }
        }
    }
}
template <int BS> __device__ __forceinline__ void sw_issue(v4u (&buf)[BS], const LAS unsigned* el, const unsigned char* tab, unsigned voff) {
#pragma unroll
    for (int i = 0; i < BS; ++i) { const unsigned off = (el[i] << 10) + voff;
        buf[i] = *(const v4u*)(tab + off); }
}
template <int BS> __device__ __forceinline__ void sw_proc_a(const v4u (&buf)[BS], const v4u& hq, LAS float* wl, int s, int n, int lane) {
    const int hx = (int)hq.x, hy = (int)hq.y, hz = (int)hq.z, hw = (int)hq.w;
    float dd[8];
#pragma unroll
    for (int i = 0; i < 8; ++i) dd[i] = 0.f;
#pragma unroll
    for (int i = 0; i < BS; ++i) if (i < n) { const int dx = (int)buf[i].x, dy = (int)buf[i].y, dz = (int)buf[i].z, dw = (int)buf[i].w;
        int t = __builtin_amdgcn_sdot4(hx, dx, 0, false); t = __builtin_amdgcn_sdot4(hy, dy, t, false); t = __builtin_amdgcn_sdot4(hz, dz, t, false); t = __builtin_amdgcn_sdot4(hw, dw, t, false);
        dd[i] = (float)t; }
    const bool b5 = (lane & 32) != 0, b4 = (lane & 16) != 0, b3 = (lane & 8) != 0;
    float r4[4];
#pragma unroll
    for (int u = 0; u < 4; ++u) { const float keep = b5 ? dd[u + 4] : dd[u], send = b5 ? dd[u] : dd[u + 4]; r4[u] = keep + __shfl_xor(send, 32); }
    float r2[2];
#pragma unroll
    for (int u = 0; u < 2; ++u) { const float keep = b4 ? r4[u + 2] : r4[u], send = b4 ? r4[u] : r4[u + 2]; r2[u] = keep + __shfl_xor(send, 16); }
    float r1; { const float keep = b3 ? r2[1] : r2[0], send = b3 ? r2[0] : r2[1]; r1 = keep + __shfl_xor(send, 8); }
    r1 += __shfl_xor(r1, 4); r1 += __shfl_xor(r1, 2); r1 += __shfl_xor(r1, 1);
    if ((lane & 7) == 0 && (lane >> 3) < n) wl[s + (lane >> 3)] = r1;
}
template <int BS> __device__ __forceinline__ void sw_proc_b(const v4u (&buf)[BS], f32x2_t (&acc)[8], const LAS float* wl, int s, int n) {
#pragma unroll
    for (int i = 0; i < BS; ++i) if (i < n) {
        const float w = wl[s + i];
        const f32x2_t wv = {w, w};
        const unsigned ux = buf[i].x, uy = buf[i].y, uz = buf[i].z, uw = buf[i].w;
        acc[0] += wv * __builtin_amdgcn_cvt_pk_f32_fp8((int)ux, false); acc[1] += wv * __builtin_amdgcn_cvt_pk_f32_fp8((int)ux, true);
        acc[2] += wv * __builtin_amdgcn_cvt_pk_f32_fp8((int)uy, false); acc[3] += wv * __builtin_amdgcn_cvt_pk_f32_fp8((int)uy, true);
        acc[4] += wv * __builtin_amdgcn_cvt_pk_f32_fp8((int)uz, false); acc[5] += wv * __builtin_amdgcn_cvt_pk_f32_fp8((int)uz, true);
        acc[6] += wv * __builtin_amdgcn_cvt_pk_f32_fp8((int)uw, false); acc[7] += wv * __builtin_amdgcn_cvt_pk_f32_fp8((int)uw, true); }
}
__device__ __forceinline__ void p8b_sweep(Frame& F) {
    const float* X1 = (const float*)(((unsigned char*)karg(19)) + WS_X1); const float* MOD = (const float*)(((unsigned char*)karg(19)) + WS_MOD);
    const unsigned char* H2Q = (const unsigned char*)(((unsigned char*)karg(19)) + WS_H2Q); const float* H2S = (const float*)(((unsigned char*)karg(19)) + WS_H2S);
    const unsigned char* EDq = (const unsigned char*)(((unsigned char*)karg(19)) + WS_ED); const unsigned char* EUq = (const unsigned char*)(((unsigned char*)karg(19)) + WS_EU); const float* EDS = (const float*)(((unsigned char*)karg(19)) + WS_EDS);
    const unsigned short* PIDX = (const unsigned short*)(((unsigned char*)karg(19)) + WS_PIDX); const float* PG = (const float*)(((unsigned char*)karg(19)) + WS_PG);
    const float* fg = ((const float*)karg(17));
    const int gw = F.vcu * NWAVES + F.wave, NGW = F.G * NWAVES;
    for (int wi = F.vcu; wi < M / 64; wi += F.G) {
        const int tb = wi * 8 + F.wave;
        unsigned ones = ~0u; asm volatile("" : "+s"(ones));
        int lane = (int)__builtin_amdgcn_mbcnt_hi(ones, __builtin_amdgcn_mbcnt_lo(ones, 0u)); asm volatile("" : "+v"(lane));
        const int tok0 = tb * 8;
        unsigned E0[8], E1[8];
        LAS float* Wl = (LAS float*)(F.lds) + F.wave * 1024;
        LAS unsigned* El = (LAS unsigned*)(F.lds + 32768) + F.wave * (8 * ELP);
        unsigned voff = 16u * (unsigned)lane; asm volatile("" : "+v"(voff));
#pragma unroll
        for (int k = 0; k < 8; ++k) {
            const size_t base = (size_t)(tok0 + k) * 128;
            E0[k] = ((unsigned)PIDX[base + lane] << 7) | (unsigned)lane; E1[k] = ((unsigned)PIDX[base + 64 + lane] << 7) | (unsigned)(64 + lane);
            sort128(E0[k], E1[k], lane);
            El[k * ELP + lane] = E0[k] >> 7; El[k * ELP + 64 + lane] = E1[k] >> 7;
            if (lane < 8) El[k * ELP + 128 + lane] = (unsigned)__builtin_amdgcn_readlane((int)E1[k], 63) >> 7;
        }
        for (int repa = 0; repa < PROBE_REPA; ++repa) {
            v4u hq[8];
#pragma unroll
            for (int k = 0; k < 8; ++k) hq[k] = *(const v4u*)(H2Q + (size_t)(tok0 + k) * D + 16 * lane);
            int pos[8];
#pragma unroll
            for (int k = 0; k < 8; ++k) pos[k] = 0;
            v4u bA[BSA], bB[BSA]; int ps = 0, pn = 0;
            for (int r = 0; r < NR; ++r) {
#pragma unroll
                for (int k = 0; k < 8; ++k) {
                    constexpr int dummy = 0; (void)dummy;
                    const int kp = (k + 7) & 7;
                    const int c = __builtin_popcountll(__ballot((E0[k] >> RSH) == (unsigned)r)) + __builtin_popcountll(__ballot((E1[k] >> RSH) == (unsigned)r));
                    int s = __builtin_amdgcn_readfirstlane(pos[k]); const int e_end = __builtin_amdgcn_readfirstlane(s + c); pos[k] = e_end;
                    const int n1 = (e_end - s) < BSA ? (e_end - s) : BSA;
                    if (k & 1) sw_issue<BSA>(bB, El + k * ELP + s, EDq, voff); else sw_issue<BSA>(bA, El + k * ELP + s, EDq, voff);
                    if (pn > 0) { if (k & 1) sw_proc_a<BSA>(bA, hq[kp], Wl + kp * 128, ps, pn, lane); else sw_proc_a<BSA>(bB, hq[kp], Wl + kp * 128, ps, pn, lane); }
                    ps = s; pn = n1; s += n1;
                    for (; s < e_end; s += BSA) {
                        const int n = (e_end - s) < BSA ? (e_end - s) : BSA;
                        if (k & 1) { sw_issue<BSA>(bA, El + k * ELP + s, EDq, voff); sw_proc_a<BSA>(bA, hq[k], Wl + k * 128, s, n, lane); }
                        else       { sw_issue<BSA>(bB, El + k * ELP + s, EDq, voff); sw_proc_a<BSA>(bB, hq[k], Wl + k * 128, s, n, lane); }
                    }
                }
            }
            if (pn > 0) sw_proc_a<BSA>(bB, hq[7], Wl + 7 * 128, ps, pn, lane);
        }
#pragma unroll
        for (int k = 0; k < 8; ++k) { int tk = tok0 + k; asm volatile("" : "+s"(tk)); const size_t base = (size_t)tk * 128; const float sh = H2S[tk];
            const float r0 = Wl[k * 128 + lane], r1 = Wl[k * 128 + 64 + lane];
            Wl[k * 128 + lane] = PG[base + (E0[k] & 127u)] * gelu_erf(r0 * sh * EDS[E0[k] >> 7]) * 0.0625f;
            Wl[k * 128 + 64 + lane] = PG[base + (E1[k] & 127u)] * gelu_erf(r1 * sh * EDS[E1[k] >> 7]) * 0.0625f; }
        f32x2_t acc[8][8];
        for (int repb = 0; repb < PROBE_REPB; ++repb) {
#pragma unroll
            for (int k = 0; k < 8; ++k)
#pragma unroll
                for (int i = 0; i < 8; ++i) acc[k][i] = (f32x2_t){0.f, 0.f};
            int pos[8];
#pragma unroll
            for (int k = 0; k < 8; ++k) pos[k] = 0;
            v4u bA[BSB], bB[BSB]; int ps = 0, pn = 0;
            for (int r = 0; r < NR; ++r) {
#pragma unroll
                for (int k = 0; k < 8; ++k) {
                    const int kp = (k + 7) & 7;
                    const int c = __builtin_popcountll(__ballot((E0[k] >> RSH) == (unsigned)r)) + __builtin_popcountll(__ballot((E1[k] >> RSH) == (unsigned)r));
                    int s = __builtin_amdgcn_readfirstlane(pos[k]); const int e_end = __builtin_amdgcn_readfirstlane(s + c); pos[k] = e_end;
                    const int n1 = (e_end - s) < BSB ? (e_end - s) : BSB;
                    if (k & 1) sw_issue<BSB>(bB, El + k * ELP + s, EUq, voff); else sw_issue<BSB>(bA, El + k * ELP + s, EUq, voff);
                    if (pn > 0) { if (k & 1) sw_proc_b<BSB>(bA, acc[kp], Wl + kp * 128, ps, pn); else sw_proc_b<BSB>(bB, acc[kp], Wl + kp * 128, ps, pn); }
                    ps = s; pn = n1; s += n1;
                    for (; s < e_end; s += BSB) {
                        const int n = (e_end - s) < BSB ? (e_end - s) : BSB;
                        if (k & 1) { sw_issue<BSB>(bA, El + k * ELP + s, EUq, voff); sw_proc_b<BSB>(bA, acc[k], Wl + k * 128, s, n); }
                        else       { sw_issue<BSB>(bB, El + k * ELP + s, EUq, voff); sw_proc_b<BSB>(bB, acc[k], Wl + k * 128, s, n); }
                    }
                }
            }
            if (pn > 0) sw_proc_b<BSB>(bB, acc[7], Wl + 7 * 128, ps, pn);
        }
        int ln = lane; asm volatile("" : "+v"(ln));
#pragma unroll
        for (int k = 0; k < 8; ++k) {
            const int tok = tok0 + k; const int b = tok >> 12; const float* gt2 = MOD + b * NMOD + 5120;
            f32x4 x2[4]; float ss = 0.f;
#pragma unroll
            for (int j = 0; j < 4; ++j) { const int col = 4 * ln + 256 * j;
                const f32x4 xv = *(const f32x4*)(X1 + (size_t)tok * D + col), gv4 = *(const f32x4*)(gt2 + col);
#pragma unroll
                for (int i = 0; i < 4; ++i) { const float v = xv[i] + gv4[i] * acc[k][2 * j + (i >> 1)][i & 1]; x2[j][i] = v; ss += v * v; } }
            ss = wave_sum(ss);
            const float rstd = 1.0f / sqrtf(ss * (1.0f / D) + EPS);
#pragma unroll
            for (int j = 0; j < 4; ++j) { const int col = 4 * ln + 256 * j; const f32x4 gg = *(const f32x4*)(fg + col);
                *(f32x4*)(((float*)karg(18)) + (size_t)tok * D + col) = x2[j] * rstd * gg; }
        }
    }
}

struct Args { const float* in[18]; float* out; unsigned char* ws; };
__global__ void __launch_bounds__(NTHR, 2) mega_fwd(Args args) {
    extern __shared__ __attribute__((aligned(16))) unsigned char lds[];
    Frame F;
    F.lds = (LAS unsigned char*)lds;
    F.tid = threadIdx.x; F.lane = F.tid & 63; F.wave = __builtin_amdgcn_readfirstlane(F.tid >> 6);
    F.G = gridDim.x; { const int bx = blockIdx.x; F.vcu = (F.G % 8 == 0) ? (bx % 8) * (F.G / 8) + bx / 8 : bx; }
    volatile LAS unsigned* MISC = (volatile LAS unsigned*)(F.lds + MISC_OFF);
    for (int u = F.tid; u < (LDS_BYTES - LDSCTL_OFF) / 4; u += NTHR) ((LAS unsigned*)(F.lds + LDSCTL_OFF))[u] = 0u;
    __syncthreads();
    gu32* ctl = (gu32*)(((unsigned char*)karg(19)) + WS_CTL);
    XcdBarrier bar = xcd_barrier_post((unsigned*)(ctl + CW_BAR), MISC + 8);
#define GRID_BAR() xcd_barrier(bar)
#define PROBE_TS -1
#define STAMP(i) do { if (PROBE_TS >= 0 && blockIdx.x == 0 && F.tid == 0) { const unsigned long long t_ = __builtin_amdgcn_s_memrealtime(); MISC[16 + 2 * (i)] = (unsigned)t_; MISC[17 + 2 * (i)] = (unsigned)(t_ >> 32); } } while (0)
#define PROBE_DBL -1

    STAMP(0);
    p0_prologue(F); GRID_BAR(); STAMP(1);
    if (PROBE_DBL == 0) { p0_prologue(F); GRID_BAR(); }
    p1_norm(F); GRID_BAR(); STAMP(2);
    if (PROBE_DBL == 1) { p1_norm(F); GRID_BAR(); }
    {
    {
        pg8::Gemm g{(const pg8::bf16_t*)(((unsigned char*)karg(19)) + WS_H), (const pg8::bf16_t*)(((unsigned char*)karg(19)) + WS_WIN), M, NPROJ, D, nullptr, nullptr};
        pg8::StaticOrder S; S.init(M, NPROJ, F.G, (int)blockIdx.x);
        pg8::EpiBf16<0> E{(pg8::bf16_t*)(((unsigned char*)karg(19)) + WS_PROJ), NPROJ, nullptr, 0, 0, 1.f};
        pg8::gemm_phase<pg8::EpiBf16<0>, pg8::StaticOrder, true, true>(F.lds + RING_OFF, g, S, E);
    }
    GRID_BAR(); STAMP(3);
    }
    p3_attention(F); GRID_BAR(); STAMP(4);
    if (PROBE_DBL == 3) { p3_attention(F); GRID_BAR(); }
    {
    {
        pg8::Gemm g{(const pg8::bf16_t*)(((unsigned char*)karg(19)) + WS_OA), (const pg8::bf16_t*)(((unsigned char*)karg(19)) + WS_WA), M, D, 512, (const pg8::bf16_t*)(((unsigned char*)karg(19)) + WS_OB), (const pg8::bf16_t*)(((unsigned char*)karg(19)) + WS_WB)};
        PairOrder S; S.S.init(M, D, F.G, (int)blockIdx.x);
        EpiGate E{(const bf16*)(((unsigned char*)karg(19)) + WS_PROJ), (bf16*)((float*)karg(18)) + (size_t)M * D};
        pg8::gemm_phase<EpiGate, PairOrder, false, true>(F.lds + RING_OFF, g, S, E);
    }
    GRID_BAR(); STAMP(5);
    }
    {
    {
        pg8::Gemm g{(const pg8::bf16_t*)((bf16*)((float*)karg(18)) + (size_t)M * D), (const pg8::bf16_t*)(((unsigned char*)karg(19)) + WS_WOUT), M, D, D, nullptr, nullptr};
        pg8::StaticOrder S; S.init(M, D, F.G, (int)blockIdx.x);
        EpiRes E{((const float*)karg(0)), (const float*)(((unsigned char*)karg(19)) + WS_MOD), (float*)(((unsigned char*)karg(19)) + WS_X1)};
        pg8::gemm_phase<EpiRes, pg8::StaticOrder, false, true>(F.lds + RING_OFF, g, S, E);
    }
    GRID_BAR(); STAMP(6);
    }
    p6_norm2(F); GRID_BAR(); STAMP(7);
    if (PROBE_DBL == 6) { p6_norm2(F); GRID_BAR(); }
    {
    {
        pg8::Gemm g{(const pg8::bf16_t*)(((unsigned char*)karg(19)) + WS_H2), (const pg8::bf16_t*)(((unsigned char*)karg(19)) + WS_WQ), M, D, D, nullptr, nullptr};
        pg8::StaticOrder S; S.init(M, D, F.G, (int)blockIdx.x);
        pg8::EpiBf16<0> E{(pg8::bf16_t*)(((unsigned char*)karg(19)) + WS_QP), D, nullptr, 0, 0, 1.f};
        pg8::gemm_phase<pg8::EpiBf16<0>, pg8::StaticOrder, false, true>(F.lds + RING_OFF, g, S, E);
    }
    GRID_BAR(); STAMP(8);
    }
    p8a_topk(F); __syncthreads(); STAMP(9);
    if (PROBE_DBL == 8) { p8a_topk(F); GRID_BAR(); }
    p8b_sweep(F);
    if (PROBE_DBL == 9) { GRID_BAR(); p8b_sweep(F); }
    if (PROBE_TS >= 0) {
        GRID_BAR(); STAMP(10);
        if (blockIdx.x == 0) { __syncthreads();
            const unsigned long long t0 = ((unsigned long long)MISC[17 + 2 * PROBE_TS] << 32) | MISC[16 + 2 * PROBE_TS], t1 = ((unsigned long long)MISC[19 + 2 * PROBE_TS] << 32) | MISC[18 + 2 * PROBE_TS];
            const float d_us = (float)(t1 - t0) * 0.01f;
            const float V = 128.0f * sqrtf(d_us * 1e-5f);
            float* o = (float*)karg(18); for (int c = F.tid; c < D; c += NTHR) o[c] = V; }
    }
}

extern "C" void kernel_launch(void* const* d_in, const int* in_sizes, int n_in, void* d_out, int out_size, void* d_ws, size_t ws_size, hipStream_t stream) {
    static int grid = 0;
    if (grid == 0) {
        if (n_in != 18 || in_sizes[0] != M * D || out_size != M * D || ws_size < WS_END) { fprintf(stderr, "kernel_launch: unexpected shapes (n_in %d, in0 %d, out %d, ws %zu)\n", n_in, n_in > 0 ? in_sizes[0] : -1, out_size, ws_size); grid = -1; return; }
        int dev = 0, cus = 0, per_cu = 0;
        if (hipGetDevice(&dev) != hipSuccess || hipDeviceGetAttribute(&cus, hipDeviceAttributeMultiprocessorCount, dev) != hipSuccess) { grid = -1; return; }
        if (hipFuncSetAttribute((const void*)mega_fwd, hipFuncAttributeMaxDynamicSharedMemorySize, LDS_BYTES) != hipSuccess) { fprintf(stderr, "kernel_launch: hipFuncSetAttribute failed\n"); grid = -1; return; }
        if (hipOccupancyMaxActiveBlocksPerMultiprocessor(&per_cu, (const void*)mega_fwd, NTHR, LDS_BYTES) != hipSuccess || per_cu < 1) { fprintf(stderr, "kernel_launch: occupancy query says %d blocks per CU\n", per_cu); }
        (void)hipGetLastError();
        grid = cus;
    }
    if (grid < 0) return;
    if (hipMemsetAsync((char*)d_ws + WS_CTL, 0, CTL_ZERO_BYTES, stream) != hipSuccess) { fprintf(stderr, "kernel_launch: memset failed\n"); return; }
    Args a{};
    for (int i = 0; i < 18; ++i) a.in[i] = (const float*)d_in[i];
    a.out = (float*)d_out; a.ws = (unsigned char*)d_ws;
    hipLaunchKernelGGL(mega_fwd, dim3(grid), dim3(NTHR), LDS_BYTES, stream, a);
}
```

```cpp
#include <hip/hip_runtime.h>
#include <cstdio>
#include <cstdint>
namespace pg8 {
#define PG8_LAS __attribute__((address_space(3)))
typedef unsigned short bf16_t;
typedef short bf16x8 __attribute__((ext_vector_type(8)));
typedef float f32x4 __attribute__((ext_vector_type(4)));
typedef unsigned u32x4 __attribute__((ext_vector_type(4)));
constexpr int BM = 256, BK = 64, HALF = 128, HTB = HALF * BK * 2  , STAGE_BYTES = 8 * HTB, NXCD = 8, WGM = 8;

__host__ __device__ __forceinline__ int lds_byte(int r, int c) { const int st = (r >> 4) * 2 + (c >> 5), rr = r & 15, cc = c & 31, ob = rr * 64 + cc * 2; return st * 1024 + (ob ^ (((ob >> 9) & 1) << 5)); }
__host__ __device__ __forceinline__ void stage_rc(int b, int& R, int& C) { const int st = b / 1024, sb = b % 1024, swz = sb ^ (((sb >> 9) & 1) << 5); R = (st >> 1) * 16 + swz / 64; C = (st & 1) * 32 + (swz % 64) / 2; }
__host__ __device__ __forceinline__ int perm32(int rho) { const int n = rho >> 4, i = rho & 15; return 8 * (i >> 2) + 4 * n + (i & 3); }

struct Unit { int pm, pn, src; };
struct Gemm { const bf16_t* A; const bf16_t* Bt; int M, N, K; const bf16_t* A2; const bf16_t* Bt2; };

struct StaticOrder {
    int nM, nN, nwg, G, c;
    __host__ __device__ void init(int M, int N, int G_, int c_) { nM = M / BM; nN = N / BM; nwg = nM * nN; G = G_; c = c_; }
    __host__ __device__ bool next(int i, Unit& u) const {
        const long L = (long)i * G + c; if (L >= nwg) return false;
        int wgid = (int)L; { const int q = nwg / NXCD, r = nwg % NXCD, xcd = wgid % NXCD, off = wgid / NXCD; wgid = (xcd < r ? xcd * (q + 1) : r * (q + 1) + (xcd - r) * q) + off; }
        const int nig = WGM * nN, gid = wgid / nig, fm = gid * WGM, gsz = (nM - fm) < WGM ? (nM - fm) : WGM;
        u.pm = fm + ((wgid % nig) % gsz); u.pn = (wgid % nig) / gsz; u.src = 0; return true;
    }
    __device__ __forceinline__ void a_ready(const Unit&) const {}
    __device__ __forceinline__ void done(const Unit&) const {}
};

__device__ __forceinline__ unsigned cvt_pk_bf16(float lo, float hi) { unsigned r; asm volatile("v_cvt_pk_bf16_f32 %0, %1, %2" : "=v"(r) : "v"(lo), "v"(hi)); return r; }
typedef float f32x2 __attribute__((ext_vector_type(2)));
__device__ __forceinline__ f32x2 gelu_pk(f32x2 v) {
    const f32x2 av = __builtin_elementwise_abs(v), d = av * 0.2316418882f + 1.0f;
    f32x2 t; t.x = __builtin_amdgcn_rcpf(d.x); t.y = __builtin_amdgcn_rcpf(d.y);
    f32x2 q = t * 0.5307027145f + (-0.7265760135f); q = q * t + 0.7107068705f; q = q * t + (-0.142248368f); q = q * t + 0.127414796f; q = q * t;
    const f32x2 s = (v * v) * (-0.72134752044f);
    f32x2 e; e.x = __builtin_amdgcn_exp2f(s.x); e.y = __builtin_amdgcn_exp2f(s.y);
    const f32x2 m = v * (q * e), r = v - m;
    f32x2 o; o.x = v.x < 0.f ? m.x : r.x; o.y = v.y < 0.f ? m.y : r.y; return o;
}

template <int ACT  > struct EpiBf16 {
    static constexpr bool PERM = true, AFTER_DRAIN = false, CHAIN = false; static_assert(ACT == 0 || ACT == 1, "EpiBf16: ACT is 0 (none) or 1 (gelu_pk)");
    bf16_t* O; int ldc; const float* bias; int split_cols; size_t split_stride; float scale0;
    __device__ __forceinline__ void operator()(const f32x4 (&acc)[2][2][4][2], const Unit& u, int wr, int wc, int fr, int fq) const {
        const int row0 = u.pm * BM + wr * 64 + fr; int colt = u.pn * BM; bf16_t* base = O;
        float sc = 1.f; if (split_cols) { const int t = colt / split_cols; base += (size_t)t * split_stride; colt -= t * split_cols; if (t == 0) sc = scale0; }
        const int col0 = colt + wc * 32 + 8 * fq, bcol0 = u.pn * BM + wc * 32 + 8 * fq;
        f32x4 bv[2][2];
#pragma unroll
        for (int bj = 0; bj < 2; ++bj)
#pragma unroll
            for (int n = 0; n < 2; ++n) bv[bj][n] = bias ? *(const f32x4*)(bias + bcol0 + bj * HALF + 4 * n) : (f32x4){0.f, 0.f, 0.f, 0.f};
#pragma unroll
        for (int ai = 0; ai < 2; ++ai)
#pragma unroll
            for (int m = 0; m < 4; ++m) { bf16_t* rowp = base + (size_t)(row0 + ai * HALF + m * 16) * ldc + col0;
#pragma unroll
                for (int bj = 0; bj < 2; ++bj) { f32x4 v0 = acc[ai][bj][m][0] + bv[bj][0], v1 = acc[ai][bj][m][1] + bv[bj][1];
                    if (ACT == 1) { f32x2 a = gelu_pk((f32x2){v0[0], v0[1]}), b = gelu_pk((f32x2){v0[2], v0[3]}), c = gelu_pk((f32x2){v1[0], v1[1]}), d = gelu_pk((f32x2){v1[2], v1[3]});
                        v0 = (f32x4){a.x, a.y, b.x, b.y}; v1 = (f32x4){c.x, c.y, d.x, d.y}; }
                    v0 = v0 * sc; v1 = v1 * sc; u32x4 w; w.x = cvt_pk_bf16(v0[0], v0[1]); w.y = cvt_pk_bf16(v0[2], v0[3]); w.z = cvt_pk_bf16(v1[0], v1[1]); w.w = cvt_pk_bf16(v1[2], v1[3]);
                    *(u32x4*)(rowp + bj * HALF) = w; } }
    }
};

template <class Epi, class Sched, bool ALIGN_EPI = false, bool SP2 = false>
__device__ __forceinline__ void gemm_phase(PG8_LAS unsigned char* lds, const Gemm g, const Sched& S, const Epi& E) {
    const int tid = threadIdx.x, wid = __builtin_amdgcn_readfirstlane(tid >> 6), lane = tid & 63, wr = wid >> 2, wc = wid & 3, fr = lane & 15, fq = lane >> 4;
    const int K = g.K, nt = K / BK;
    unsigned voffA[2], voffB[2];
#pragma unroll
    for (int i = 0; i < 2; ++i) { int R, C; stage_rc(tid * 16 + i * 8192, R, C); const int Rb = Epi::PERM ? ((R & ~31) + perm32(R & 31)) : R;
        voffA[i] = (unsigned)(R * K + C) * 2u; voffB[i] = (unsigned)(Rb * K + C) * 2u; }
    const size_t kstep = (size_t)(BK * 2);
    const size_t hstep = (size_t)HALF * K * 2;
    const size_t tstep = 2 * hstep;
    const unsigned ldsw = (unsigned)wid * 1024u;
    const int aoff = lds_byte(wr * 64 + fr, fq * 8), boff = lds_byte(wc * 32 + fr, fq * 8);
#define PG8_SA(b, h) (((b) * 2 + (h)) * HTB)
#define PG8_SB(b, h) ((4 + (b) * 2 + (h)) * HTB)
#define PG8_STAGE(bufoff, gbase, voff) do { _Pragma("unroll") for (int _i = 0; _i < 2; ++_i) \
        __builtin_amdgcn_global_load_lds((const unsigned*)((const char*)(gbase) + (voff)[_i]), (PG8_LAS unsigned*)(lds + (bufoff) + ldsw + _i * 8192), 16, 0, 0); } while (0)
#define PG8_LDA(dst, b, h) do { _Pragma("unroll") for (int m = 0; m < 4; ++m) _Pragma("unroll") for (int k = 0; k < 2; ++k) dst[m][k] = *(const PG8_LAS bf16x8*)(lds + PG8_SA(b, h) + aoff + m * 2048 + k * 1024); } while (0)
#define PG8_LDB(dst, b, h) do { _Pragma("unroll") for (int n = 0; n < 2; ++n) _Pragma("unroll") for (int k = 0; k < 2; ++k) dst[n][k] = *(const PG8_LAS bf16x8*)(lds + PG8_SB(b, h) + boff + n * 2048 + k * 1024); } while (0)
#define PG8_MMA(ai, bj, At, Bt) do { __builtin_amdgcn_s_setprio(1); _Pragma("unroll") for (int m = 0; m < 4; ++m) _Pragma("unroll") for (int n = 0; n < 2; ++n) _Pragma("unroll") for (int k = 0; k < 2; ++k) \
        acc[ai][bj][m][n] = __builtin_amdgcn_mfma_f32_16x16x32_bf16(Bt[n][k], At[m][k], acc[ai][bj][m][n], 0, 0, 0); __builtin_amdgcn_s_setprio(0); } while (0)
#define PG8_WAIT_V(n) asm volatile("s_waitcnt vmcnt(" #n ")" ::: "memory")
#define PG8_WAIT_L(n) asm volatile("s_waitcnt lgkmcnt(" #n ")" ::: "memory")
#define PG8_BAR __builtin_amdgcn_s_barrier()
#define PG8_SCHED __builtin_amdgcn_sched_barrier(0)
    Unit cur, nxt; int ui = 0;
    if (!S.next(0, cur)) return;
    f32x4 acc[2][2][4][2];
#pragma unroll
    for (int a = 0; a < 2; ++a)
#pragma unroll
        for (int b = 0; b < 2; ++b)
#pragma unroll
            for (int m = 0; m < 4; ++m)
#pragma unroll
                for (int n = 0; n < 2; ++n) acc[a][b][m][n] = (f32x4){0.f, 0.f, 0.f, 0.f};
    bf16x8 At[4][2], B0[2][2], B1[2][2];
    const char* cA = (const char*)(cur.src ? g.A2 : g.A) + (size_t)cur.pm * tstep; const char* cB = (const char*)(cur.src ? g.Bt2 : g.Bt) + (size_t)cur.pn * tstep;
    S.a_ready(cur);
    if constexpr (SP2) {
        PG8_STAGE(PG8_SB(0, 0), cB, voffB); PG8_STAGE(PG8_SB(0, 1), cB + hstep, voffB); PG8_STAGE(PG8_SA(0, 0), cA, voffA); PG8_STAGE(PG8_SA(0, 1), cA + hstep, voffA);
        if (wr == 1) PG8_BAR;
        PG8_WAIT_V(2); PG8_BAR;
        PG8_STAGE(PG8_SB(1, 0), cB + kstep, voffB); PG8_STAGE(PG8_SA(1, 0), cA + kstep, voffA); PG8_STAGE(PG8_SB(1, 1), cB + hstep + kstep, voffB);
        PG8_WAIT_V(6); PG8_BAR;
    } else {
        PG8_STAGE(PG8_SB(0, 0), cB, voffB); PG8_STAGE(PG8_SA(0, 0), cA, voffA); PG8_STAGE(PG8_SB(0, 1), cB + hstep, voffB); PG8_STAGE(PG8_SA(0, 1), cA + hstep, voffA);
        if (wr == 1) PG8_BAR;
        PG8_WAIT_V(4); PG8_BAR;
        PG8_STAGE(PG8_SB(1, 0), cB + kstep, voffB); PG8_STAGE(PG8_SA(1, 0), cA + kstep, voffA); PG8_STAGE(PG8_SB(1, 1), cB + hstep + kstep, voffB);
        PG8_WAIT_V(6); PG8_BAR;
    }
    for (;;) {
        const bool has_next = S.next(ui + 1, nxt);
        const char* nA = has_next ? (const char*)(nxt.src ? g.A2 : g.A) + (size_t)nxt.pm * tstep : cA; const char* nB = has_next ? (const char*)(nxt.src ? g.Bt2 : g.Bt) + (size_t)nxt.pn * tstep : cB;
        for (int t = 0; t < nt; t += 2) {
            const bool last = (t == nt - 2);
            const char* a1 = cA + (size_t)(t + 1) * kstep;
            const char* a2 = last ? nA : cA + (size_t)(t + 2) * kstep; const char* b2 = last ? nB : cB + (size_t)(t + 2) * kstep;
            const char* a3 = a2 + kstep; const char* b3 = b2 + kstep;
            if (last && has_next) S.a_ready(nxt);
            if constexpr (SP2) {
            PG8_LDB(B0, 0, 0); PG8_LDB(B1, 0, 1); PG8_SCHED; PG8_LDA(At, 0, 0); PG8_STAGE(PG8_SA(1, 1), a1 + hstep, voffA);
            PG8_WAIT_V(8); PG8_WAIT_L(0); PG8_BAR; PG8_MMA(0, 0, At, B0); PG8_MMA(0, 1, At, B1); PG8_BAR; PG8_SCHED;
            PG8_LDA(At, 0, 1); PG8_STAGE(PG8_SB(0, 0), b2, voffB); PG8_STAGE(PG8_SB(0, 1), b2 + hstep, voffB); PG8_STAGE(PG8_SA(0, 0), a2, voffA);
            PG8_WAIT_V(8); PG8_WAIT_L(0); PG8_BAR; PG8_MMA(1, 0, At, B0); PG8_MMA(1, 1, At, B1); PG8_BAR; PG8_SCHED;
            PG8_LDB(B0, 1, 0); PG8_LDB(B1, 1, 1); PG8_SCHED; PG8_LDA(At, 1, 0); PG8_STAGE(PG8_SA(0, 1), a2 + hstep, voffA);
            PG8_WAIT_V(8); PG8_WAIT_L(0); PG8_BAR; PG8_MMA(0, 0, At, B0); PG8_MMA(0, 1, At, B1); PG8_BAR; PG8_SCHED;
            PG8_LDA(At, 1, 1); PG8_STAGE(PG8_SB(1, 0), b3, voffB); PG8_STAGE(PG8_SB(1, 1), b3 + hstep, voffB); PG8_STAGE(PG8_SA(1, 0), a3, voffA);
            PG8_WAIT_V(8); PG8_WAIT_L(0); PG8_BAR; PG8_MMA(1, 0, At, B0); PG8_MMA(1, 1, At, B1); PG8_BAR; PG8_SCHED;
            } else {
            PG8_LDB(B0, 0, 0); PG8_SCHED; PG8_LDA(At, 0, 0); PG8_STAGE(PG8_SA(1, 1), a1 + hstep, voffA);
            PG8_WAIT_L(8); PG8_BAR; PG8_WAIT_L(0); PG8_MMA(0, 0, At, B0); PG8_BAR; PG8_SCHED;
            PG8_LDB(B1, 0, 1); PG8_STAGE(PG8_SB(0, 0), b2, voffB);
            PG8_BAR; PG8_WAIT_L(0); PG8_MMA(0, 1, At, B1); PG8_BAR;
            PG8_LDA(At, 0, 1); PG8_STAGE(PG8_SA(0, 0), a2, voffA);
            PG8_BAR; PG8_WAIT_L(0); PG8_MMA(1, 0, At, B0); PG8_BAR; PG8_SCHED;
            PG8_STAGE(PG8_SB(0, 1), b2 + hstep, voffB);
            PG8_WAIT_V(6); PG8_BAR; PG8_MMA(1, 1, At, B1); PG8_BAR;
            PG8_LDB(B0, 1, 0); PG8_SCHED; PG8_LDA(At, 1, 0); PG8_STAGE(PG8_SA(0, 1), a2 + hstep, voffA);
            PG8_WAIT_L(8); PG8_BAR; PG8_WAIT_L(0); PG8_MMA(0, 0, At, B0); PG8_BAR; PG8_SCHED;
            PG8_LDB(B1, 1, 1); PG8_STAGE(PG8_SB(1, 0), b3, voffB);
            PG8_BAR; PG8_WAIT_L(0); PG8_MMA(0, 1, At, B1); PG8_BAR;
            PG8_LDA(At, 1, 1); PG8_STAGE(PG8_SA(1, 0), a3, voffA);
            PG8_BAR; PG8_WAIT_L(0); PG8_MMA(1, 0, At, B0); PG8_BAR; PG8_SCHED;
            PG8_STAGE(PG8_SB(1, 1), b3 + hstep, voffB);
            PG8_WAIT_V(6); PG8_BAR; PG8_MMA(1, 1, At, B1); PG8_BAR;
            }
        }
        if constexpr (ALIGN_EPI) { if (wr == 0) PG8_BAR; }
        if constexpr (!Epi::AFTER_DRAIN) { E(acc, cur, wr, wc, fr, fq); S.done(cur); }
        if (!has_next) break;
        if (!(Epi::CHAIN && cur.src == 0)) {
#pragma unroll
        for (int a = 0; a < 2; ++a)
#pragma unroll
            for (int b = 0; b < 2; ++b)
#pragma unroll
                for (int m = 0; m < 4; ++m)
#pragma unroll
                    for (int n = 0; n < 2; ++n) acc[a][b][m][n] = (f32x4){0.f, 0.f, 0.f, 0.f};
        }
        cur = nxt; cA = nA; cB = nB; ++ui;
        if constexpr (ALIGN_EPI) { if (wr == 1) PG8_BAR; }
    }
    PG8_WAIT_V(0);
    if constexpr (!ALIGN_EPI) { if (wr == 0) PG8_BAR; }
    PG8_BAR;
    if constexpr (Epi::AFTER_DRAIN) { E.fused(acc, cur, wr, wc, fr, fq, lds, wid, lane); S.done(cur); }
#undef PG8_SA
#undef PG8_SB
#undef PG8_STAGE
#undef PG8_LDA
#undef PG8_LDB
#undef PG8_MMA
#undef PG8_WAIT_V
#undef PG8_WAIT_L
#undef PG8_BAR
#undef PG8_SCHED
}
}

#define GAS __attribute__((address_space(1)))
#define LAS __attribute__((address_space(3)))
typedef unsigned short bf16;
typedef unsigned v4u __attribute__((ext_vector_type(4)));
typedef float f32x4 __attribute__((ext_vector_type(4)));
typedef short bf16x8 __attribute__((ext_vector_type(8)));
typedef GAS unsigned gu32;
typedef GAS unsigned long long gu64;
#define RLX_AGENT __ATOMIC_RELAXED, __HIP_MEMORY_SCOPE_AGENT
#define LDS_WAIT() asm volatile("s_waitcnt lgkmcnt(0)" ::: "memory")
#define VM_WAIT() asm volatile("s_waitcnt vmcnt(0)" ::: "memory")
__device__ __forceinline__ unsigned long long rt() { return __builtin_amdgcn_s_memrealtime(); }
__device__ __forceinline__ unsigned f2bf(float f) { unsigned u = __builtin_bit_cast(unsigned, f); return (u + 0x7fffu + ((u >> 16) & 1u)) >> 16; }
__device__ __forceinline__ unsigned pk2(float lo, float hi) { return f2bf(lo) | (f2bf(hi) << 16); }

#define XB_TMO      128
#define XB_XCNT(j)  (256  + 64 * (j))
#define XB_XSUB(j)  (1280 + 64 * (j))
#define XB_XGEN(j)  (2304 + 64 * (j))
#define XB_TOP      3328
#define XB_TOPGEN   3392
#define XCD_BAR_WORDS 3456
#define XB_SPIN_CAP (1u << 18)

__device__ __forceinline__ unsigned xb_ld(unsigned* p)              { return __hip_atomic_load(p, __ATOMIC_RELAXED, __HIP_MEMORY_SCOPE_AGENT); }
__device__ __forceinline__ unsigned xb_add(unsigned* p, unsigned v) { return __hip_atomic_fetch_add(p, v, __ATOMIC_RELAXED, __HIP_MEMORY_SCOPE_AGENT); }
__device__ __forceinline__ unsigned xb_xcc_id() { return (unsigned)__builtin_amdgcn_s_getreg((3 << 11) | 20) & 0xFu; }
#define XB_SPIN(cond, bar) do { unsigned _sp = 0; while (cond) { __builtin_amdgcn_s_sleep(1); \
    if ((++_sp & 255u) == 0u) { if (xb_ld(&(bar)[XB_TMO])) break; if (_sp > XB_SPIN_CAP) { atomicAdd(&(bar)[XB_TMO], 1u); break; } } } } while (0)

struct XcdBarrier {
    unsigned* bar; unsigned x;
    volatile LAS unsigned* st;
};

__device__ __forceinline__ XcdBarrier xcd_barrier_post(unsigned* bar, volatile LAS unsigned* st) {
    XcdBarrier b; b.bar = bar; b.x = xb_xcc_id(); b.st = st;
    if (threadIdx.x == 0) (void)xb_add(&bar[XB_XCNT(b.x)], 1u);
    return b;
}
__device__ __forceinline__ void xcd_barrier_complete(unsigned* bar, unsigned x, unsigned& nloc, unsigned& nx) {
    const unsigned G = gridDim.x * gridDim.y * gridDim.z;
    unsigned sum, cnt, mine, sp = 0u;
    for (;;) {
        sum = 0u; cnt = 0u; mine = 0u;
#pragma unroll
        for (unsigned j = 0; j < 16; ++j) { const unsigned c = xb_ld(&bar[XB_XCNT(j)]); sum += c; cnt += (c > 0u) ? 1u : 0u; mine = (j == x) ? c : mine; }
        if (sum == G) break;
        __builtin_amdgcn_s_sleep(1);
        if ((++sp & 255u) == 0u) { if (xb_ld(&bar[XB_TMO])) break; if (sp > XB_SPIN_CAP) { atomicAdd(&bar[XB_TMO], 1u); break; } }
    }
    nloc = mine > 0u ? mine : 1u; nx = cnt > 0u ? cnt : 1u;
}

__device__ __forceinline__ void xcd_barrier(const XcdBarrier& b) {
    asm volatile("s_waitcnt vmcnt(0)" ::: "memory");
    __syncthreads();
    if (threadIdx.x == 0) {
        unsigned* bar = b.bar;
        __builtin_amdgcn_s_waitcnt(0);
        unsigned nloc = b.st[0], nx = b.st[1];
        if (nloc == 0u) { xcd_barrier_complete(bar, b.x, nloc, nx); b.st[0] = nloc; b.st[1] = nx; }
        const unsigned old = xb_add(&bar[XB_XSUB(b.x)], 1u);
        const unsigned gen = old / nloc;
        if (old + 1u == (gen + 1u) * nloc) {
            __builtin_amdgcn_fence(__ATOMIC_RELEASE, "agent");
            asm volatile("s_waitcnt vmcnt(0)" ::: "memory");
            const unsigned og = xb_add(&bar[XB_TOP], 1u);
            const unsigned tg = og / nx;
            if (og + 1u == (tg + 1u) * nx) xb_add(&bar[XB_TOPGEN], 1u);
            else XB_SPIN(xb_ld(&bar[XB_TOPGEN]) == tg, bar);
            __builtin_amdgcn_fence(__ATOMIC_ACQUIRE, "agent");
            xb_add(&bar[XB_XGEN(b.x)], 1u);
            asm volatile("s_waitcnt vmcnt(0)" ::: "memory");
        } else {
            XB_SPIN(xb_ld(&bar[XB_XGEN(b.x)]) == gen, bar);
            __builtin_amdgcn_fence(__ATOMIC_ACQUIRE, "agent");
            asm volatile("s_waitcnt vmcnt(0)" ::: "memory");
        }
    }
    __syncthreads();
}

constexpr int NWAVES = 8, NTHR = 512;
constexpr int BATCH = 4, SEQ = 4096, D = 1024, M = BATCH * SEQ;
constexpr int NPROJ = 4352, LDW_IN = 4360, NMOD = 6144;
constexpr int C_QA = 0, C_KA = 512, C_VA = 640, C_QB = 768, C_KB = 1280, C_VB = 1792, C_GLA = 2304, C_GLB = 3328;
constexpr int NEXP = 16384;
constexpr float EPS = 1e-6f;

constexpr size_t MiB = 1u << 20;
constexpr size_t WS_CTL = 0, CTL_ZERO_BYTES = 1 * MiB;
constexpr size_t WS_MOD = 1 * MiB, WS_LOGF = 1 * MiB + 128 * 1024, WS_SUBK = 2 * MiB;
constexpr size_t WS_WIN = 4 * MiB, WS_WA = 12 * MiB + 512 * 1024, WS_WB = 13 * MiB + 512 * 1024, WS_WOUT = 14 * MiB + 512 * 1024, WS_WQ = 16 * MiB + 512 * 1024;
constexpr size_t WS_ED = 19 * MiB, WS_EU = 35 * MiB;
constexpr size_t WS_EDS = 2 * MiB + 512 * 1024;
constexpr size_t WS_H2Q = 95 * MiB, WS_H2S = 111 * MiB;
constexpr size_t WS_H = 83 * MiB, WS_OA = 83 * MiB, WS_OB = 99 * MiB, WS_PIDX = 83 * MiB, WS_PG = 87 * MiB;
constexpr size_t WS_PROJ = 115 * MiB, WS_X1 = 115 * MiB, WS_H2 = 179 * MiB, WS_QP = 211 * MiB;
constexpr size_t WS_END = 251 * MiB;
static_assert(WS_WIN + (size_t)NPROJ * D * 2 <= WS_WA && WS_WQ + (size_t)D * D * 2 <= WS_ED && WS_PROJ + (size_t)M * NPROJ * 2 <= WS_END, "ws map");
constexpr int CW_BAR = 4096;

constexpr int RING_OFF = 0, RING_BYTES = 131072;
constexpr int LDSCTL_OFF = RING_BYTES, MISC_OFF = LDSCTL_OFF + 320;
constexpr int LDS_BYTES = 147456;

typedef float f32x16 __attribute__((ext_vector_type(16)));
typedef short s16x4 __attribute__((ext_vector_type(4)));
typedef unsigned u32x2 __attribute__((ext_vector_type(2)));
typedef float f32x2_t __attribute__((ext_vector_type(2)));
typedef __bf16 bf16x2_t __attribute__((ext_vector_type(2)));

__device__ __forceinline__ unsigned cvtpk(float lo, float hi) { f32x2_t v = {lo, hi}; bf16x2_t b = __builtin_convertvector(v, bf16x2_t); return __builtin_bit_cast(unsigned, b); }
__device__ __forceinline__ float bflo(unsigned u) { return __uint_as_float(u << 16); }
__device__ __forceinline__ float bfhi(unsigned u) { return __uint_as_float(u & 0xffff0000u); }
__device__ __forceinline__ float wave_sum(float v) {
#pragma unroll
    for (int o = 1; o < 64; o <<= 1) v += __shfl_xor(v, o);
    return v;
}
__device__ __forceinline__ int crow(int r, int hi) { return (r & 3) + 8 * (r >> 2) + 4 * hi; }
#define MFMA32(a, b, c) __builtin_amdgcn_mfma_f32_32x32x16_bf16((a), (b), (c), 0, 0, 0)

struct Frame {
    LAS unsigned char* lds;
    int tid, lane, wave, vcu, G;
};
__device__ __forceinline__ const void* karg(int i) {
    unsigned long z = 0; asm volatile("" : "+s"(z));
    const char* base = (const char*)__builtin_amdgcn_kernarg_segment_ptr();
    return *(const void* const*)(base + 8 * i + z);
}

__device__ __forceinline__ void p0_transpose_item(const float* W, int ld, int K, int ncols, bf16* WT, int row_off, LAS float* scr, int item, int lane) {
    const int nblk = ncols / 32, kb = item / nblk, nb = item % nblk, k0 = 64 * kb, n0 = 32 * nb;
#pragma unroll 8
    for (int i = 0; i < 32; ++i) { const int kk = 2 * i + (lane >> 5); scr[kk * 33 + (lane & 31)] = W[(size_t)(k0 + kk) * ld + n0 + (lane & 31)]; }
    LDS_WAIT(); asm volatile("" ::: "memory");
    const int c = lane & 7;
#pragma unroll
    for (int j = 0; j < 4; ++j) { const int n = (lane >> 3) + 8 * j; const LAS float* s = scr + (8 * c) * 33 + n;
        v4u o; o.x = pk2(s[0 * 33], s[1 * 33]); o.y = pk2(s[2 * 33], s[3 * 33]); o.z = pk2(s[4 * 33], s[5 * 33]); o.w = pk2(s[6 * 33], s[7 * 33]);
        *(GAS v4u*)(WT + (size_t)(row_off + n0 + n) * K + k0 + 8 * c) = o; }
    LDS_WAIT(); asm volatile("" ::: "memory");
}
__device__ __forceinline__ void p0_convert(const float* __restrict__ src, bf16* __restrict__ dst, long n_iters, int gw, int NGW, int lane) {
    for (long it0 = (long)gw * 4; it0 < n_iters; it0 += (long)NGW * 4) {
        f32x4 a[4][2];
#pragma unroll
        for (int u = 0; u < 4; ++u) { const long it = it0 + u; if (it < n_iters) { const float* p = src + it * 512 + lane * 4; a[u][0] = *(const f32x4*)p; a[u][1] = *(const f32x4*)(p + 256); } }
#pragma unroll
        for (int u = 0; u < 4; ++u) { const long it = it0 + u; if (it < n_iters) { bf16* q = dst + it * 512 + lane * 4;
            u32x2 w0, w1; w0.x = cvtpk(a[u][0].x, a[u][0].y); w0.y = cvtpk(a[u][0].z, a[u][0].w); w1.x = cvtpk(a[u][1].x, a[u][1].y); w1.y = cvtpk(a[u][1].z, a[u][1].w);
            *(u32x2*)q = w0; *(u32x2*)(q + 256) = w1; } }
    }
}

__device__ __forceinline__ void p0_quant_tables(Frame& F, int gw, int NGW) {
    const float* ed = ((const float*)karg(15)); const float* eu = ((const float*)karg(16));
    unsigned char* EDq = (unsigned char*)(((unsigned char*)karg(19)) + WS_ED); unsigned char* EUq = (unsigned char*)(((unsigned char*)karg(19)) + WS_EU); float* EDS = (float*)(((unsigned char*)karg(19)) + WS_EDS);
    const int lane = F.lane;
    for (int row0 = gw * 4; row0 < NEXP; row0 += NGW * 4) {
        f32x4 a[4][4], u[4][4];
#pragma unroll
        for (int q = 0; q < 4; ++q)
#pragma unroll
            for (int j = 0; j < 4; ++j) { a[q][j] = *((const f32x4*)(ed + (size_t)(row0 + q) * D) + lane + 64 * j); u[q][j] = *((const f32x4*)(eu + (size_t)(row0 + q) * D) + lane + 64 * j); }
#pragma unroll
        for (int q = 0; q < 4; ++q) {
            float am = 0.f;
#pragma unroll
            for (int j = 0; j < 4; ++j) am = fmaxf(fmaxf(am, fmaxf(fabsf(a[q][j].x), fabsf(a[q][j].y))), fmaxf(fabsf(a[q][j].z), fabsf(a[q][j].w)));
#pragma unroll
            for (int o = 1; o < 64; o <<= 1) am = fmaxf(am, __shfl_xor(am, o));
            const float sc = am > 0.f ? am * (1.0f / 127.0f) : 1.0f, inv = 1.0f / sc;
            v4u qa, qu;
#pragma unroll
            for (int j = 0; j < 4; ++j) {
                const int b0 = (int)rintf(a[q][j].x * inv), b1 = (int)rintf(a[q][j].y * inv), b2 = (int)rintf(a[q][j].z * inv), b3 = (int)rintf(a[q][j].w * inv);
                qa[j] = (unsigned)(b0 & 255) | ((unsigned)(b1 & 255) << 8) | ((unsigned)(b2 & 255) << 16) | ((unsigned)(b3 & 255) << 24);
                int p = __builtin_amdgcn_cvt_pk_fp8_f32(u[q][j].x * 16.0f, u[q][j].y * 16.0f, 0, false);
                p = __builtin_amdgcn_cvt_pk_fp8_f32(u[q][j].z * 16.0f, u[q][j].w * 16.0f, p, true);
                qu[j] = (unsigned)p;
            }
            *(v4u*)(EDq + (size_t)(row0 + q) * D + 16 * lane) = qa;
            *(v4u*)(EUq + (size_t)(row0 + q) * D + 16 * lane) = qu;
            if (lane == 0) EDS[row0 + q] = sc;
        }
    }
}
__device__ __forceinline__ void p0_prologue(Frame& F) {
    const float* c = ((const float*)karg(1)); const float* w_ada = ((const float*)karg(4)); const float* b_ada = ((const float*)karg(5));
    float* MOD = (float*)(((unsigned char*)karg(19)) + WS_MOD);
    {
        LAS float* cact = (LAS float*)(F.lds);
        LAS float* part = (LAS float*)(F.lds + 16384);
        bool did = false;
        for (int item = F.vcu; item < NMOD / 32; item += F.G) {
            if (!did) { for (int i = F.tid; i < 4096; i += NTHR) { const float cv = c[i]; cact[i] = cv / (1.0f + __expf(-cv)); } did = true; }
            __syncthreads();
            const int n0 = item * 32, col = n0 + (F.lane & 31), ksub = F.lane >> 5;
            float a0 = 0.f, a1 = 0.f, a2 = 0.f, a3 = 0.f;
#pragma unroll 16
            for (int it = 0; it < 64; ++it) { const int k = (it * 8 + F.wave) * 2 + ksub; const float w = w_ada[(size_t)k * NMOD + col];
                a0 += cact[k] * w; a1 += cact[1024 + k] * w; a2 += cact[2048 + k] * w; a3 += cact[3072 + k] * w; }
            a0 += __shfl_xor(a0, 32); a1 += __shfl_xor(a1, 32); a2 += __shfl_xor(a2, 32); a3 += __shfl_xor(a3, 32);
            if (F.lane < 32) { part[(F.wave * 4 + 0) * 32 + F.lane] = a0; part[(F.wave * 4 + 1) * 32 + F.lane] = a1; part[(F.wave * 4 + 2) * 32 + F.lane] = a2; part[(F.wave * 4 + 3) * 32 + F.lane] = a3; }
            __syncthreads();
            if (F.tid < 128) { const int b = F.tid >> 5, cl = F.tid & 31; float s = 0.f;
#pragma unroll
                for (int w = 0; w < 8; ++w) s += part[(w * 4 + b) * 32 + cl];
                MOD[b * NMOD + n0 + cl] = s + b_ada[n0 + cl]; }
            __syncthreads();
        }
    }
    {
        const int gw = F.vcu * NWAVES + F.wave, NGW = F.G * NWAVES;
        p0_convert(((const float*)karg(14)), (bf16*)(((unsigned char*)karg(19)) + WS_SUBK), (long)(8 * 2 * 128 * 64) / 512, gw, NGW, F.lane);
    }
}
__device__ __forceinline__ void p0_transposes(Frame& F) {
    LAS float* scr = (LAS float*)(F.lds + 32768 + F.wave * 8704);
    const int gw = F.vcu * NWAVES + F.wave, NGW = F.G * NWAVES;
    constexpr int I_IN1 = (D / 64) * (2304 / 32), I_IN2 = (D / 64) * (2048 / 32), I_AB = (512 / 64) * (D / 32), I_SQ = (D / 64) * (D / 32);
    constexpr int NITEMS = I_IN1 + I_IN2 + 2 * I_AB + 2 * I_SQ;
    bf16* Win_t = (bf16*)(((unsigned char*)karg(19)) + WS_WIN);
    for (int it = gw; it < NITEMS; it += NGW) {
        int r = it;
        if (r < I_IN1) { p0_transpose_item(((const float*)karg(6)), LDW_IN, D, 2304, Win_t, 0, scr, r, F.lane); continue; } r -= I_IN1;
        if (r < I_IN2) { p0_transpose_item(((const float*)karg(6)) + 2312, LDW_IN, D, 2048, Win_t, 2304, scr, r, F.lane); continue; } r -= I_IN2;
        if (r < I_AB) { p0_transpose_item(((const float*)karg(9)), D, 512, D, (bf16*)(((unsigned char*)karg(19)) + WS_WA), 0, scr, r, F.lane); continue; } r -= I_AB;
        if (r < I_AB) { p0_transpose_item(((const float*)karg(10)), D, 512, D, (bf16*)(((unsigned char*)karg(19)) + WS_WB), 0, scr, r, F.lane); continue; } r -= I_AB;
        if (r < I_SQ) { p0_transpose_item(((const float*)karg(11)), D, D, D, (bf16*)(((unsigned char*)karg(19)) + WS_WOUT), 0, scr, r, F.lane); continue; } r -= I_SQ;
        p0_transpose_item(((const float*)karg(13)), D, D, D, (bf16*)(((unsigned char*)karg(19)) + WS_WQ), 0, scr, r, F.lane);
    }
}

__device__ __forceinline__ void p1_norm(Frame& F) {
    const float* x = ((const float*)karg(0)); const float* g1 = ((const float*)karg(2)); const float* w_in = ((const float*)karg(6)); const float* b_forget = ((const float*)karg(7));
    const float* MOD = (const float*)(((unsigned char*)karg(19)) + WS_MOD); bf16* H = (bf16*)(((unsigned char*)karg(19)) + WS_H); float* LOGF = (float*)(((unsigned char*)karg(19)) + WS_LOGF);
    LAS float* wfl = (LAS float*)(F.lds);
    { float tmp[16];
#pragma unroll
      for (int n = 0; n < 16; ++n) { const int i = F.tid + n * NTHR; tmp[n] = w_in[(size_t)(i >> 3) * LDW_IN + 2304 + (i & 7)]; }
#pragma unroll
      for (int n = 0; n < 16; ++n) { const int i = F.tid + n * NTHR; wfl[(i & 7) * 1024 + (i >> 3)] = tmp[n]; } }
    __syncthreads();
    const int gw = F.vcu * NWAVES + F.wave, NGW = F.G * NWAVES;
    f32x4 cur[4], nxt[4];
    if (gw < M) { const f32x4* xr = (const f32x4*)(x + (size_t)gw * D) + F.lane;
#pragma unroll
        for (int j = 0; j < 4; ++j) cur[j] = xr[64 * j]; }
    for (int row = gw; row < M; row += NGW) {
        { const int nrow = row + NGW; if (nrow < M) { const f32x4* xr = (const f32x4*)(x + (size_t)nrow * D) + F.lane;
#pragma unroll
            for (int j = 0; j < 4; ++j) nxt[j] = xr[64 * j]; } }
        {{
        float ss = 0.f;
#pragma unroll
        for (int j = 0; j < 4; ++j) ss += (cur[j].x * cur[j].x + cur[j].y * cur[j].y) + (cur[j].z * cur[j].z + cur[j].w * cur[j].w);
        ss = wave_sum(ss);
        const float rstd = 1.0f / sqrtf(ss * (1.0f / D) + EPS);
        const int b = row >> 12; const float* mb = MOD + b * NMOD;
        float fl[8];
#pragma unroll
        for (int jj = 0; jj < 8; ++jj) fl[jj] = 0.f;
#pragma unroll
        for (int j = 0; j < 4; ++j) { const int col = 4 * F.lane + 256 * j;
            const f32x4 g = *(const f32x4*)(g1 + col), sh = *(const f32x4*)(mb + col), sc = *(const f32x4*)(mb + 1024 + col);
            const f32x4 hv = (cur[j] * rstd) * g * (sc + 1.0f) + sh;
            u32x2 w; w.x = cvtpk(hv.x, hv.y); w.y = cvtpk(hv.z, hv.w);
            *(u32x2*)(H + (size_t)row * D + col) = w;
#pragma unroll
            for (int jj = 0; jj < 8; ++jj) { const f32x4 wv = *(const LAS f32x4*)(wfl + jj * 1024 + col); fl[jj] += (hv.x * wv.x + hv.y * wv.y) + (hv.z * wv.z + hv.w * wv.w); }
        }
        const int lane = F.lane; const bool b5 = (lane & 32) != 0, b4 = (lane & 16) != 0, b3 = (lane & 8) != 0;
        float r4[4];
#pragma unroll
        for (int u = 0; u < 4; ++u) { const float keep = b5 ? fl[u + 4] : fl[u], send = b5 ? fl[u] : fl[u + 4]; r4[u] = keep + __shfl_xor(send, 32); }
        float r2[2];
#pragma unroll
        for (int u = 0; u < 2; ++u) { const float keep = b4 ? r4[u + 2] : r4[u], send = b4 ? r4[u] : r4[u + 2]; r2[u] = keep + __shfl_xor(send, 16); }
        float r1; { const float keep = b3 ? r2[1] : r2[0], send = b3 ? r2[0] : r2[1]; r1 = keep + __shfl_xor(send, 8); }
        r1 += __shfl_xor(r1, 4); r1 += __shfl_xor(r1, 2); r1 += __shfl_xor(r1, 1);
        if ((lane & 7) == 0) { const int jj = lane >> 3; const float z = r1 + b_forget[jj]; const float ls = fminf(z, 0.f) - log1pf(__expf(-fabsf(z))); LOGF[(size_t)row * 8 + jj] = ls; }
        }}
#pragma unroll
        for (int j = 0; j < 4; ++j) cur[j] = nxt[j];
    }
}

constexpr int KP = 72;
constexpr int VPF = 68;
constexpr int VPS = 260;
struct FlashState { f32x16 o[2]; float m, l; };

__device__ __forceinline__ void flash_tail(FlashState& st, f32x16& s0, f32x16& s1, const LAS bf16* Vs, int vp, int r32, int hi) {
    float mt = s0[0];
#pragma unroll
    for (int r = 1; r < 16; ++r) mt = fmaxf(mt, s0[r]);
#pragma unroll
    for (int r = 0; r < 16; ++r) mt = fmaxf(mt, s1[r]);
    mt = fmaxf(mt, __shfl_xor(mt, 32));
    const float mn = fmaxf(st.m, mt);
    const float alpha = __expf(st.m - mn);
    st.m = mn;
    float ps = 0.f;
#pragma unroll
    for (int r = 0; r < 16; ++r) { s0[r] = __expf(s0[r] - mn); ps += s0[r]; }
#pragma unroll
    for (int r = 0; r < 16; ++r) { s1[r] = __expf(s1[r] - mn); ps += s1[r]; }
    st.l = st.l * alpha + ps;
#pragma unroll
    for (int r = 0; r < 16; ++r) { st.o[0][r] *= alpha; st.o[1][r] *= alpha; }
#pragma unroll
    for (int blk = 0; blk < 2; ++blk)
#pragma unroll
        for (int s = 0; s < 2; ++s) {
            v4u pw;
            if (blk == 0) { pw.x = cvtpk(s0[8 * s + 0], s0[8 * s + 1]); pw.y = cvtpk(s0[8 * s + 2], s0[8 * s + 3]); pw.z = cvtpk(s0[8 * s + 4], s0[8 * s + 5]); pw.w = cvtpk(s0[8 * s + 6], s0[8 * s + 7]); }
            else          { pw.x = cvtpk(s1[8 * s + 0], s1[8 * s + 1]); pw.y = cvtpk(s1[8 * s + 2], s1[8 * s + 3]); pw.z = cvtpk(s1[8 * s + 4], s1[8 * s + 5]); pw.w = cvtpk(s1[8 * s + 6], s1[8 * s + 7]); }
            const bf16x8 pf = __builtin_bit_cast(bf16x8, pw);
#pragma unroll
            for (int db = 0; db < 2; ++db) {
                const LAS bf16* vp0 = Vs + (32 * db + r32) * vp + 32 * blk + 16 * s + 4 * hi;
                const s16x4 lo = *(const LAS s16x4*)vp0, hh = *(const LAS s16x4*)(vp0 + 8);
                const bf16x8 vf = __builtin_shufflevector(lo, hh, 0, 1, 2, 3, 4, 5, 6, 7);
                st.o[db] = MFMA32(vf, pf, st.o[db]);
            }
        }
}
__device__ __forceinline__ void flash_qk(f32x16& s0, f32x16& s1, const bf16x8 (&qf)[4], const LAS bf16* Ks, int r32, int hi) {
    s0 = (f32x16){0.f}; s1 = (f32x16){0.f};
#pragma unroll
    for (int r = 0; r < 16; ++r) { s0[r] = 0.f; s1[r] = 0.f; }
#pragma unroll
    for (int ks = 0; ks < 4; ++ks) {
        const bf16x8 a0 = *(const LAS bf16x8*)(Ks + r32 * KP + 16 * ks + 8 * hi);
        const bf16x8 a1 = *(const LAS bf16x8*)(Ks + (32 + r32) * KP + 16 * ks + 8 * hi);
        s0 = MFMA32(a0, qf[ks], s0); s1 = MFMA32(a1, qf[ks], s1);
    }
}
__device__ __forceinline__ void flash_store(const FlashState& st, bf16* orow, int hi) {
    float lt = st.l + __shfl_xor(st.l, 32);
    const float inv = 1.0f / lt;
#pragma unroll
    for (int db = 0; db < 2; ++db)
#pragma unroll
        for (int rg = 0; rg < 4; ++rg) { u32x2 w; w.x = cvtpk(st.o[db][4 * rg] * inv, st.o[db][4 * rg + 1] * inv); w.y = cvtpk(st.o[db][4 * rg + 2] * inv, st.o[db][4 * rg + 3] * inv);
            *(u32x2*)(orow + 32 * db + 8 * rg + 4 * hi) = w; }
}

__device__ __forceinline__ void fox_unit(Frame& F, int b, int h, int qb, float& kmax2) {
    const bf16* proj = (const bf16*)(((unsigned char*)karg(19)) + WS_PROJ); const float* LOGF = (const float*)(((unsigned char*)karg(19)) + WS_LOGF); bf16* OB = (bf16*)(((unsigned char*)karg(19)) + WS_OB);
    LAS float* Fs = (LAS float*)(F.lds);
    LAS float* wtot = (LAS float*)(F.lds + 16384);
    LAS bf16* Kb = (LAS bf16*)(F.lds + 16384 + 128);
    LAS bf16* Vb = (LAS bf16*)(F.lds + 16384 + 128 + 2 * 64 * KP * 2);
    const int lane = F.lane, wave = F.wave, tid = F.tid, r32 = lane & 31, hi = lane >> 5;
    const int q_end = 256 * (qb + 1), NT = q_end / 64;
    const size_t rowbase = (size_t)b * SEQ;
    {
        float v[8]; float run = 0.f;
#pragma unroll
        for (int i = 0; i < 8; ++i) { const int pos = tid * 8 + i; const float lf = (pos < q_end) ? LOGF[(rowbase + pos) * 8 + h] : 0.f; run += lf; v[i] = run; }
        float inc = run;
#pragma unroll
        for (int o = 1; o < 64; o <<= 1) { const float t = __shfl_up(inc, o); if (lane >= o) inc += t; }
        if (lane == 63) wtot[wave] = inc;
        __syncthreads();
        float off = inc - run;
        for (int w = 0; w < wave; ++w) off += wtot[w];
#pragma unroll
        for (int i = 0; i < 8; ++i) Fs[tid * 8 + i] = v[i] + off;
    }
    const int qrow = 256 * qb + 32 * wave + r32;
    bf16x8 qf[4];
    { const bf16* qp = proj + (rowbase + qrow) * NPROJ + C_QB + 64 * h + 8 * hi;
#pragma unroll
      for (int ks = 0; ks < 4; ++ks) qf[ks] = *(const bf16x8*)(qp + 16 * ks); }
    const int tq = 4 * qb + (wave >> 1);
    {
        float qn = 0.f;
#pragma unroll
        for (int ks = 0; ks < 4; ++ks)
#pragma unroll
            for (int j = 0; j < 8; ++j) { const float e = __uint_as_float(((unsigned)(unsigned short)qf[ks][j]) << 16); qn += e * e; }
        qn += __shfl_xor(qn, 32);
#pragma unroll
        for (int o = 1; o < 32; o <<= 1) qn = fmaxf(qn, __shfl_xor(qn, o));
        float kn = 0.f;
        if (kmax2 < 0.f) {
            for (int pos = tid; pos < q_end; pos += NTHR) { const v4u* kr = (const v4u*)(proj + (rowbase + pos) * NPROJ + C_KB + 64 * h); float s = 0.f;
#pragma unroll
                for (int c8 = 0; c8 < 8; ++c8) { const v4u w = kr[c8]; const unsigned wx = w.x, wy = w.y, wz = w.z, ww = w.w;
                    s += bflo(wx) * bflo(wx) + bfhi(wx) * bfhi(wx) + bflo(wy) * bflo(wy) + bfhi(wy) * bfhi(wy) + bflo(wz) * bflo(wz) + bfhi(wz) * bfhi(wz) + bflo(ww) * bflo(ww) + bfhi(ww) * bfhi(ww); }
                kn = fmaxf(kn, s); }
#pragma unroll
            for (int o = 1; o < 64; o <<= 1) kn = fmaxf(kn, __shfl_xor(kn, o));
        }
        if (lane == 0) { wtot[8 + wave] = qn; wtot[16 + wave] = kn; }
    }
    FlashState st; st.m = -INFINITY; st.l = 0.f;
#pragma unroll
    for (int r = 0; r < 16; ++r) { st.o[0][r] = 0.f; st.o[1][r] = 0.f; }
    const int srow = tid >> 3, sch = tid & 7;
    const bf16* kg = proj + (rowbase + srow) * NPROJ + C_KB + 64 * h + 8 * sch;
    const bf16* vg = proj + (rowbase + srow) * NPROJ + C_VB + 64 * h + 8 * sch;
    v4u kreg, vreg;
    { const size_t o = (size_t)(NT - 1) * 64 * NPROJ; kreg = *(const v4u*)(kg + o); vreg = *(const v4u*)(vg + o); }
    int cur = 0;
    {   *(LAS v4u*)(Kb + srow * KP + 8 * sch) = kreg;
        const unsigned short* vs = (const unsigned short*)&vreg;
#pragma unroll
        for (int i = 0; i < 8; ++i) Vb[(8 * sch + i) * VPF + srow] = vs[i];
    }
    __syncthreads();
    const float fq = Fs[qrow];
    int t_lo = 0;
    {
        float qm = 0.f, km = 0.f;
#pragma unroll
        for (int w = 0; w < 8; ++w) { qm = fmaxf(qm, wtot[8 + w]); km = fmaxf(km, wtot[16 + w]); }
        if (kmax2 < 0.f) kmax2 = km;
        const float A = 0.125f * sqrtf(qm) * sqrtf(kmax2) * 1.01f, f0 = Fs[256 * qb];
        for (int t = NT - 5; t >= 0; --t) if (Fs[64 * t + 63] - f0 > 2.0f * A + 60.0f) { t_lo = t + 1; break; }
    }
    for (int t = NT - 1; t >= t_lo; --t) {
        if (t > t_lo) { const size_t o = (size_t)(t - 1) * 64 * NPROJ; kreg = *(const v4u*)(kg + o); vreg = *(const v4u*)(vg + o); }
        if (t <= tq) {
            const LAS bf16* Ks = Kb + cur * 64 * KP; const LAS bf16* Vs = Vb + cur * 64 * VPF;
            f32x16 s0, s1; flash_qk(s0, s1, qf, Ks, r32, hi);
            const LAS float* Fk = Fs + 64 * t;
            const bool diag = (t == tq);
#pragma unroll
            for (int rg = 0; rg < 4; ++rg) {
                const f32x4 f0 = *(const LAS f32x4*)(Fk + 8 * rg + 4 * hi), f1 = *(const LAS f32x4*)(Fk + 32 + 8 * rg + 4 * hi);
#pragma unroll
                for (int i = 0; i < 4; ++i) { const int r = 4 * rg + i; const int kv = 64 * t + 8 * rg + 4 * hi + i;
                    float a = s0[r] * 0.125f + (fq - f0[i]); float c = s1[r] * 0.125f + (fq - f1[i]);
                    if (diag) { if (kv > qrow) a = -INFINITY; if (kv + 32 > qrow) c = -INFINITY; }
                    s0[r] = a; s1[r] = c; }
            }
            flash_tail(st, s0, s1, Vs, VPF, r32, hi);
        }
        if (t > t_lo) {
            const int nb = cur ^ 1;
            *(LAS v4u*)(Kb + nb * 64 * KP + srow * KP + 8 * sch) = kreg;
            const unsigned short* vs = (const unsigned short*)&vreg;
#pragma unroll
            for (int i = 0; i < 8; ++i) Vb[nb * 64 * VPF + (8 * sch + i) * VPF + srow] = vs[i];
        }
        __syncthreads();
        cur ^= 1;
    }
    flash_store(st, OB + (rowbase + qrow) * 512 + 64 * h, hi);
    __syncthreads();
}

__device__ const unsigned char T5_BUCKET[128] = {0,1,2,3,4,5,6,7,8,9,10,11,12,13,14,15,16,16,16,17,17,18,18,18,19,19,19,20,20,20,20,21,21,21,21,22,22,22,22,22,23,23,23,23,23,23,24,24,24,24,24,24,25,25,25,25,25,25,25,26,26,26,26,26,26,26,26,27,27,27,27,27,27,27,27,27,27,28,28,28,28,28,28,28,28,28,28,29,29,29,29,29,29,29,29,29,29,29,29,30,30,30,30,30,30,30,30,30,30,30,30,30,30,31,31,31,31,31,31,31,31,31,31,31,31,31,31,31};

__device__ __forceinline__ void swa_unit(Frame& F, int b, int kvh, int n) {
    const bf16* proj = (const bf16*)(((unsigned char*)karg(19)) + WS_PROJ); bf16* OA = (bf16*)(((unsigned char*)karg(19)) + WS_OA);
    const float* sinks = ((const float*)karg(8)); const float* rel_bias = ((const float*)karg(12));
    LAS bf16* Kb = (LAS bf16*)(F.lds);
    LAS bf16* Vb = (LAS bf16*)(F.lds + 36864);
    LAS float* bt = (LAS float*)(F.lds + 36864 + 33280);
    const int lane = F.lane, wave = F.wave, tid = F.tid, r32 = lane & 31, hi = lane >> 5;
    const size_t rowbase = (size_t)b * SEQ;
    {
        const int g = tid >> 7, d = tid & 127;
        bt[tid] = rel_bias[(int)T5_BUCKET[d] * 8 + kvh * 4 + g];
#pragma unroll
        for (int i = 0; i < 4; ++i) {
            const int idx = tid + i * NTHR, kb = idx >> 3, sch = idx & 7; const int pos = 128 * (n - 1) + kb;
            v4u kreg = (v4u){0u, 0u, 0u, 0u}, vreg = (v4u){0u, 0u, 0u, 0u};
            if (pos >= 0) { const bf16* p = proj + (rowbase + pos) * NPROJ + 64 * kvh + 8 * sch; kreg = *(const v4u*)(p + C_KA); vreg = *(const v4u*)(p + C_VA); }
            *(LAS v4u*)(Kb + kb * KP + 8 * sch) = kreg;
            const unsigned short* vs = (const unsigned short*)&vreg;
#pragma unroll
            for (int j = 0; j < 8; ++j) Vb[(8 * sch + j) * VPS + kb] = vs[j];
        }
    }
    __syncthreads();
    const int g = wave & 3, qh = wave >> 2, head = kvh * 4 + g;
    const LAS float* btg = bt + g * 128;
    for (int sb = 0; sb < 2; ++sb) {
        const int qrel0 = 64 * qh + 32 * sb, qrel = qrel0 + r32;
        const size_t row = rowbase + 128 * n + qrel;
        bf16x8 qf[4];
        { const bf16* qp = proj + row * NPROJ + C_QA + 64 * head + 8 * hi;
#pragma unroll
          for (int ks = 0; ks < 4; ++ks) qf[ks] = *(const bf16x8*)(qp + 16 * ks); }
        FlashState st; st.m = sinks[head]; st.l = (hi == 0) ? 1.0f : 0.0f;
#pragma unroll
        for (int r = 0; r < 16; ++r) { st.o[0][r] = 0.f; st.o[1][r] = 0.f; }
        const int t_lo = (qrel0 + 1) >> 6, t_hi = (qrel0 + 159) >> 6;
        for (int t = t_lo; t <= t_hi; ++t) {
            f32x16 s0, s1; flash_qk(s0, s1, qf, Kb + t * 64 * KP, r32, hi);
#pragma unroll
            for (int r = 0; r < 16; ++r) {
                const int kb0 = 64 * t + crow(r, hi), kb1 = kb0 + 32;
                const int d0 = 128 + qrel - kb0, d1 = d0 - 32;
                const bool v0 = (d0 >= 0) && (d0 < 128) && (n > 0 || kb0 >= 128);
                const bool v1 = (d1 >= 0) && (d1 < 128) && (n > 0 || kb1 >= 128);
                const float b0 = btg[d0 & 127], b1 = btg[d1 & 127];
                s0[r] = v0 ? (s0[r] * 0.125f + b0) : -INFINITY;
                s1[r] = v1 ? (s1[r] * 0.125f + b1) : -INFINITY;
            }
            flash_tail(st, s0, s1, Vb + 64 * t, VPS, r32, hi);
        }
        flash_store(st, OA + row * 512 + 64 * head, hi);
    }
    __syncthreads();
}
__device__ __forceinline__ void p3_attention(Frame& F) {
    for (int item = F.vcu; item < 256; item += F.G) {
        swa_unit(F, item >> 6, (item >> 5) & 1, item & 31);
        const int bh = item >> 3, j = item & 7;
        float kmax2 = -1.0f;
        fox_unit(F, bh >> 3, bh & 7, 15 - j, kmax2);
        fox_unit(F, bh >> 3, bh & 7, j, kmax2);
    }
}

struct PairOrder {
    pg8::StaticOrder S;
    __device__ bool next(int i, pg8::Unit& u) const { if (!S.next(i >> 1, u)) return false; u.src = i & 1; return true; }
    __device__ __forceinline__ void a_ready(const pg8::Unit&) const {}
    __device__ __forceinline__ void done(const pg8::Unit&) const {}
};
__device__ __forceinline__ float sigmoidf_(float z) { return 1.0f / (1.0f + __expf(-z)); }
struct EpiGate {
    static constexpr bool PERM = true, AFTER_DRAIN = false, CHAIN = true;
    const bf16* proj; bf16* mixed;
    __device__ __forceinline__ void operator()(pg8::f32x4 (&acc)[2][2][4][2], const pg8::Unit& u, int wr, int wc, int fr, int fq) const {
#pragma unroll
        for (int ai = 0; ai < 2; ++ai)
#pragma unroll
            for (int m = 0; m < 4; ++m) { const size_t row = (size_t)u.pm * 256 + ai * 128 + wr * 64 + m * 16 + fr;
#pragma unroll
                for (int bj = 0; bj < 2; ++bj) { const int col0 = u.pn * 256 + bj * 128 + wc * 32 + 8 * fq;
                    const v4u gb = *(const v4u*)(proj + row * NPROJ + C_GLB + col0);
                    const unsigned gbw[4] = {gb.x, gb.y, gb.z, gb.w};
                    if (u.src == 0) {
                        const v4u ga = *(const v4u*)(proj + row * NPROJ + C_GLA + col0);
                        const unsigned gaw[4] = {ga.x, ga.y, ga.z, ga.w};
#pragma unroll
                        for (int e = 0; e < 8; ++e) { const float za = (e & 1) ? bfhi(gaw[e >> 1]) : bflo(gaw[e >> 1]), zb = (e & 1) ? bfhi(gbw[e >> 1]) : bflo(gbw[e >> 1]);
                            const float ratio = (1.0f + __expf(-zb)) * __builtin_amdgcn_rcpf(1.0f + __expf(-za));
                            acc[ai][bj][m][e >> 2][e & 3] *= ratio; }
                    } else {
                        float v[8];
#pragma unroll
                        for (int e = 0; e < 8; ++e) { const float zb = (e & 1) ? bfhi(gbw[e >> 1]) : bflo(gbw[e >> 1]); v[e] = acc[ai][bj][m][e >> 2][e & 3] * __builtin_amdgcn_rcpf(1.0f + __expf(-zb)); }
                        v4u w; w.x = cvtpk(v[0], v[1]); w.y = cvtpk(v[2], v[3]); w.z = cvtpk(v[4], v[5]); w.w = cvtpk(v[6], v[7]);
                        *(v4u*)(mixed + row * D + col0) = w;
                    }
                }
            }
    }
};
struct EpiRes {
    static constexpr bool PERM = true, AFTER_DRAIN = false, CHAIN = false;
    const float* x; const float* mod; float* x1;
    __device__ __forceinline__ void operator()(const pg8::f32x4 (&acc)[2][2][4][2], const pg8::Unit& u, int wr, int wc, int fr, int fq) const {
#pragma unroll
        for (int ai = 0; ai < 2; ++ai)
#pragma unroll
            for (int m = 0; m < 4; ++m) { const size_t row = (size_t)u.pm * 256 + ai * 128 + wr * 64 + m * 16 + fr; const int b = (int)(row >> 12);
#pragma unroll
                for (int bj = 0; bj < 2; ++bj) { const int col0 = u.pn * 256 + bj * 128 + wc * 32 + 8 * fq;
#pragma unroll
                    for (int n = 0; n < 2; ++n) { const int col = col0 + 4 * n;
                        const pg8::f32x4 xin = *(const pg8::f32x4*)(x + row * D + col), gt = *(const pg8::f32x4*)(mod + b * NMOD + 2048 + col);
                        *(pg8::f32x4*)(x1 + row * D + col) = xin + gt * acc[ai][bj][m][n]; } }
            }
    }
};

__device__ __forceinline__ void p6_norm2(Frame& F) {
    const float* x1 = (const float*)(((unsigned char*)karg(19)) + WS_X1); const float* g2 = ((const float*)karg(3)); const float* MOD = (const float*)(((unsigned char*)karg(19)) + WS_MOD); bf16* H2 = (bf16*)(((unsigned char*)karg(19)) + WS_H2); unsigned char* H2Q = (unsigned char*)(((unsigned char*)karg(19)) + WS_H2Q); float* H2S = (float*)(((unsigned char*)karg(19)) + WS_H2S);
    const int gw = F.vcu * NWAVES + F.wave, NGW = F.G * NWAVES;
    f32x4 cur[4], nxt[4];
    if (gw < M) { const f32x4* xr = (const f32x4*)(x1 + (size_t)gw * D) + F.lane;
#pragma unroll
        for (int j = 0; j < 4; ++j) cur[j] = xr[64 * j]; }
    for (int row = gw; row < M; row += NGW) {
        { const int nrow = row + NGW; if (nrow < M) { const f32x4* xr = (const f32x4*)(x1 + (size_t)nrow * D) + F.lane;
#pragma unroll
            for (int j = 0; j < 4; ++j) nxt[j] = xr[64 * j]; } }
        {
        f32x4 v[4], hq[4]; float ss = 0.f;
#pragma unroll
        for (int j = 0; j < 4; ++j) { v[j] = cur[j]; ss += (v[j].x * v[j].x + v[j].y * v[j].y) + (v[j].z * v[j].z + v[j].w * v[j].w); }
        ss = wave_sum(ss);
        const float rstd = 1.0f / sqrtf(ss * (1.0f / D) + EPS);
        const int b = row >> 12; const float* mb = MOD + b * NMOD;
#pragma unroll
        for (int j = 0; j < 4; ++j) { const int col = 4 * F.lane + 256 * j;
            const f32x4 g = *(const f32x4*)(g2 + col), sh = *(const f32x4*)(mb + 3072 + col), sc = *(const f32x4*)(mb + 4096 + col);
            const f32x4 hv = (v[j] * rstd) * g * (sc + 1.0f) + sh;
            u32x2 w; w.x = cvtpk(hv.x, hv.y); w.y = cvtpk(hv.z, hv.w);
            *(u32x2*)(H2 + (size_t)row * D + col) = w; hq[j] = hv; }
        float am = 0.f;
#pragma unroll
        for (int j = 0; j < 4; ++j) am = fmaxf(fmaxf(am, fmaxf(fabsf(hq[j].x), fabsf(hq[j].y))), fmaxf(fabsf(hq[j].z), fabsf(hq[j].w)));
#pragma unroll
        for (int o = 1; o < 64; o <<= 1) am = fmaxf(am, __shfl_xor(am, o));
        const float sc = am > 0.f ? am * (1.0f / 127.0f) : 1.0f, inv = 1.0f / sc;
        v4u qa;
#pragma unroll
        for (int j = 0; j < 4; ++j) { const int b0 = (int)rintf(hq[j].x * inv), b1 = (int)rintf(hq[j].y * inv), b2 = (int)rintf(hq[j].z * inv), b3 = (int)rintf(hq[j].w * inv);
            qa[j] = (unsigned)(b0 & 255) | ((unsigned)(b1 & 255) << 8) | ((unsigned)(b2 & 255) << 16) | ((unsigned)(b3 & 255) << 24); }
        *(v4u*)(H2Q + (size_t)row * D + 16 * F.lane) = qa;
        if (F.lane == 0) H2S[row] = sc;
        }
#pragma unroll
        for (int j = 0; j < 4; ++j) cur[j] = nxt[j];
    }
}

__device__ __forceinline__ unsigned f2ord(float f) { const unsigned u = __float_as_uint(f); return u ^ ((unsigned)((int)u >> 31) | 0x80000000u); }
__device__ __forceinline__ float ord2f(unsigned o) { const unsigned u = (o & 0x80000000u) ? (o & 0x7fffffffu) : ~o; return __uint_as_float(u); }
#define CE_DESC(a, b) do { const unsigned _x = (a), _y = (b); (a) = _x > _y ? _x : _y; (b) = _x > _y ? _y : _x; } while (0)
__device__ __forceinline__ void sort16(unsigned (&k)[16]) {
#pragma unroll
    for (int size = 2; size <= 16; size <<= 1)
#pragma unroll
        for (int stride = size >> 1; stride > 0; stride >>= 1)
#pragma unroll
            for (int i = 0; i < 16; ++i) { const int j = i ^ stride; if (j > i) { if ((i & size) == 0) CE_DESC(k[i], k[j]); else CE_DESC(k[j], k[i]); } }
}
__device__ __forceinline__ void merge16(unsigned (&a)[16], const unsigned (&b)[16]) {
#pragma unroll
    for (int i = 0; i < 16; ++i) a[i] = a[i] > b[15 - i] ? a[i] : b[15 - i];
#pragma unroll
    for (int stride = 8; stride > 0; stride >>= 1)
#pragma unroll
        for (int i = 0; i < 16; ++i) { const int j = i ^ stride; if (j > i) CE_DESC(a[i], a[j]); }
}
__device__ __forceinline__ void top16_of_64(unsigned (&g0)[16], unsigned (&g1)[16], unsigned (&g2)[16], unsigned (&g3)[16]) {
    sort16(g0); sort16(g1); sort16(g2); sort16(g3);
    merge16(g0, g1); merge16(g2, g3); merge16(g0, g2);
}
constexpr int NCAND = 50;
__device__ __forceinline__ void p8a_topk(Frame& F) {
    const bf16* QP = (const bf16*)(((unsigned char*)karg(19)) + WS_QP); const bf16* SUBK = (const bf16*)(((unsigned char*)karg(19)) + WS_SUBK);
    unsigned short* PIDX = (unsigned short*)(((unsigned char*)karg(19)) + WS_PIDX); float* PG = (float*)(((unsigned char*)karg(19)) + WS_PG);
    LAS unsigned short* Elds = (LAS unsigned short*)(F.lds) + F.wave * (NCAND * 64);
    const int lane = F.lane, r32 = lane & 31, hi = lane >> 5;
    const int gw = F.vcu * NWAVES + F.wave, NGW = F.G * NWAVES;
    for (int it2 = 0; it2 < 2 * ((M / 64 - F.vcu + F.G - 1) / F.G); ++it2) {
        const int wi = F.vcu + (it2 >> 1) * F.G;
        const int tile = 2 * wi + (it2 & 1);
        const int tok = tile * 32 + r32;
        { const int h = F.wave;
            unsigned top[2][16];
#pragma unroll
            for (int p = 0; p < 2; ++p) {
                bf16x8 qf[4];
                { const bf16* qp = QP + (size_t)tok * D + h * 128 + p * 64 + 8 * hi;
#pragma unroll
                  for (int ks = 0; ks < 4; ++ks) qf[ks] = *(const bf16x8*)(qp + 16 * ks); }
                const bf16* kp = SUBK + (size_t)((h * 2 + p) * 128 + r32) * 64 + 8 * hi;
                unsigned kk[4][16];
#pragma unroll
                for (int blk = 0; blk < 4; ++blk) {
                    f32x16 acc;
#pragma unroll
                    for (int r = 0; r < 16; ++r) acc[r] = 0.f;
#pragma unroll
                    for (int ks = 0; ks < 4; ++ks) { const bf16x8 a = *(const bf16x8*)(kp + (size_t)blk * 32 * 64 + 16 * ks); acc = MFMA32(a, qf[ks], acc); }
#pragma unroll
                    for (int r = 0; r < 16; ++r) { const int key = 32 * blk + crow(r, hi); kk[blk][r] = (f2ord(acc[r]) & ~127u) | (unsigned)(127 - key); }
                }
                top16_of_64(kk[0], kk[1], kk[2], kk[3]);
                unsigned other[16];
#pragma unroll
                for (int i = 0; i < 16; ++i) other[i] = (unsigned)__shfl_xor((int)kk[0][i], 32);
                merge16(kk[0], other);
#pragma unroll
                for (int i = 0; i < 16; ++i) top[p][i] = kk[0][i];
            }
            float s1[16], s2[16]; unsigned i1[16], i2[16];
#pragma unroll
            for (int i = 0; i < 16; ++i) { s1[i] = ord2f(top[0][i] & ~127u); i1[i] = 127u - (top[0][i] & 127u); s2[i] = ord2f(top[1][i] & ~127u); i2[i] = 127u - (top[1][i] & 127u); }
            unsigned ck[4][16];
#pragma unroll
            for (int c = 0; c < 64; ++c) {
                if (c < NCAND) { constexpr int CA[NCAND] = {0,0,0,0,0,0,0,0,0,0,0,0,0,0,0,0,1,1,1,1,1,1,1,1,2,2,2,2,2,3,3,3,3,4,4,4,5,5,6,6,7,7,8,9,10,11,12,13,14,15}; constexpr int CB[NCAND] = {0,1,2,3,4,5,6,7,8,9,10,11,12,13,14,15,0,1,2,3,4,5,6,7,0,1,2,3,4,0,1,2,3,0,1,2,0,1,0,1,0,1,0,0,0,0,0,0,0,0}; const int a = CA[c], b = CB[c];
                    ck[c >> 4][c & 15] = (f2ord(s1[a] + s2[b]) & ~63u) | (unsigned)(63 - c);
                    Elds[c * 64 + lane] = (unsigned short)(i1[a] * 128u + i2[b]); }
                else ck[c >> 4][c & 15] = 0u;
            }
            top16_of_64(ck[0], ck[1], ck[2], ck[3]);
            float w[16]; float wsum = 0.f; const float v0 = ord2f(ck[0][0] & ~63u);
#pragma unroll
            for (int r = 0; r < 16; ++r) { w[r] = __expf(ord2f(ck[0][r] & ~63u) - v0); wsum += w[r]; }
            const float winv = 1.0f / wsum;
#pragma unroll
            for (int r = 0; r < 16; ++r) if ((r >> 3) == hi) {
                const int c = 63 - (int)(ck[0][r] & 63u);
                const unsigned short eid = Elds[c * 64 + lane];
                PIDX[(size_t)tok * 128 + h * 16 + r] = eid; PG[(size_t)tok * 128 + h * 16 + r] = w[r] * winv; }
        }
    }
}

__device__ __forceinline__ float gelu_erf(float v) { return 0.5f * v * (1.0f + erff(v * 0.70710678118654752f)); }

#define PROBE_REPA 1
#define PROBE_REPB 1
constexpr int NR = 16, RSH = 17, BSA = 8, BSB = 4, ELP = 136, TPS = 8;
__device__ __forceinline__ void sort128(unsigned& e0, unsigned& e1, int lane) {
#pragma unroll
    for (int size = 2; size <= 128; size <<= 1) {
#pragma unroll
        for (int stride = size >> 1; stride > 0; stride >>= 1) {
            if (stride == 64) { const unsigned lo = e0 < e1 ? e0 : e1, hi = e0 < e1 ? e1 : e0; e0 = lo; e1 = hi; }
            else {
                const bool lower = (lane & stride) == 0;
                const bool asc0 = (size == 128) ? true : (size == 64 ? true : ((lane & size) == 0));
                const bool asc1 = (size == 128) ? true : (size == 64 ? false : ((lane & size) == 0));
                const unsigned p0 = (unsigned)__shfl_xor((int)e0, stride), p1 = (unsigned)__shfl_xor((int)e1, stride);
                const unsigned mn0 = e0 < p0 ? e0 : p0, mx0 = e0 < p0 ? p0 : e0, mn1 = e1 < p1 ? e1 : p1, mx1 = e1 < p1 ? p1 : e1;
                e0 = (lower == asc0) ? mn0 : mx0; e1 = (lower == asc1) ? mn1 : mx1;
            }
        }
    }
}
template <int BS> __device__ __forceinline__ void sw_issue(v4u (&buf)[BS], const LAS unsigned* el, const unsigned char* tab, unsigned voff) {
#pragma unroll
    for (int i = 0; i < BS; ++i) { const unsigned off = (el[i] << 10) + voff;
        buf[i] = *(const v4u*)(tab + off); }
}
template <int BS> __device__ __forceinline__ void sw_proc_a(const v4u (&buf)[BS], const v4u& hq, LAS float* wl, int s, int n, int lane) {
    const int hx = (int)hq.x, hy = (int)hq.y, hz = (int)hq.z, hw = (int)hq.w;
    float dd[8];
#pragma unroll
    for (int i = 0; i < 8; ++i) dd[i] = 0.f;
#pragma unroll
    for (int i = 0; i < BS; ++i) if (i < n) { const int dx = (int)buf[i].x, dy = (int)buf[i].y, dz = (int)buf[i].z, dw = (int)buf[i].w;
        int t = __builtin_amdgcn_sdot4(hx, dx, 0, false); t = __builtin_amdgcn_sdot4(hy, dy, t, false); t = __builtin_amdgcn_sdot4(hz, dz, t, false); t = __builtin_amdgcn_sdot4(hw, dw, t, false);
        dd[i] = (float)t; }
    const bool b5 = (lane & 32) != 0, b4 = (lane & 16) != 0, b3 = (lane & 8) != 0;
    float r4[4];
#pragma unroll
    for (int u = 0; u < 4; ++u) { const float keep = b5 ? dd[u + 4] : dd[u], send = b5 ? dd[u] : dd[u + 4]; r4[u] = keep + __shfl_xor(send, 32); }
    float r2[2];
#pragma unroll
    for (int u = 0; u < 2; ++u) { const float keep = b4 ? r4[u + 2] : r4[u], send = b4 ? r4[u] : r4[u + 2]; r2[u] = keep + __shfl_xor(send, 16); }
    float r1; { const float keep = b3 ? r2[1] : r2[0], send = b3 ? r2[0] : r2[1]; r1 = keep + __shfl_xor(send, 8); }
    r1 += __shfl_xor(r1, 4); r1 += __shfl_xor(r1, 2); r1 += __shfl_xor(r1, 1);
    if ((lane & 7) == 0 && (lane >> 3) < n) wl[s + (lane >> 3)] = r1;
}
template <int BS> __device__ __forceinline__ void sw_proc_b(const v4u (&buf)[BS], f32x2_t (&acc)[8], const LAS float* wl, int s, int n) {
#pragma unroll
    for (int i = 0; i < BS; ++i) if (i < n) {
        const float w = wl[s + i];
        const f32x2_t wv = {w, w};
        const unsigned ux = buf[i].x, uy = buf[i].y, uz = buf[i].z, uw = buf[i].w;
        acc[0] += wv * __builtin_amdgcn_cvt_pk_f32_fp8((int)ux, false); acc[1] += wv * __builtin_amdgcn_cvt_pk_f32_fp8((int)ux, true);
        acc[2] += wv * __builtin_amdgcn_cvt_pk_f32_fp8((int)uy, false); acc[3] += wv * __builtin_amdgcn_cvt_pk_f32_fp8((int)uy, true);
        acc[4] += wv * __builtin_amdgcn_cvt_pk_f32_fp8((int)uz, false); acc[5] += wv * __builtin_amdgcn_cvt_pk_f32_fp8((int)uz, true);
        acc[6] += wv * __builtin_amdgcn_cvt_pk_f32_fp8((int)uw, false); acc[7] += wv * __builtin_amdgcn_cvt_pk_f32_fp8((int)uw, true); }
}
__device__ __forceinline__ void sw_warm(v4u (&pf)[4], const unsigned char* tab, int range, int lw, unsigned voff) {
#pragma unroll
    for (int i = 0; i < 4; ++i) { const unsigned off = ((unsigned)(range * 1024 + lw * 4 + i) << 10) + voff; pf[i] = *(const v4u*)(tab + off); }
}
__device__ __forceinline__ void sw_warm_done(const v4u (&pf)[4]) {
#pragma unroll
    for (int i = 0; i < 4; ++i) asm volatile("" :: "v"(pf[i]));
}
template <int FAKE> __device__ __forceinline__ void p8b_sweep(Frame& F) {
    const float* X1 = (const float*)(((unsigned char*)karg(19)) + WS_X1); const float* MOD = (const float*)(((unsigned char*)karg(19)) + WS_MOD);
    const unsigned char* H2Q = (const unsigned char*)(((unsigned char*)karg(19)) + WS_H2Q); const float* H2S = (const float*)(((unsigned char*)karg(19)) + WS_H2S);
    const unsigned char* EDq = (const unsigned char*)(((unsigned char*)karg(19)) + WS_ED); const unsigned char* EUq = (const unsigned char*)(((unsigned char*)karg(19)) + WS_EU); const float* EDS = (const float*)(((unsigned char*)karg(19)) + WS_EDS);
    const unsigned short* PIDX = (const unsigned short*)(((unsigned char*)karg(19)) + WS_PIDX); const float* PG = (const float*)(((unsigned char*)karg(19)) + WS_PG);
    const float* fg = ((const float*)karg(17));
    const int gw = F.vcu * NWAVES + F.wave, NGW = F.G * NWAVES;
    for (int wi = F.vcu; wi < M / 64; wi += F.G) {
        const int tb = wi * 8 + F.wave;
        unsigned ones = ~0u; asm volatile("" : "+s"(ones));
        int lane = (int)__builtin_amdgcn_mbcnt_hi(ones, __builtin_amdgcn_mbcnt_lo(ones, 0u)); asm volatile("" : "+v"(lane));
        const int tok0 = tb * 8;
        unsigned E0[8], E1[8];
        LAS float* Wl = (LAS float*)(F.lds) + F.wave * 1024;
        LAS unsigned* El = (LAS unsigned*)(F.lds + 32768) + F.wave * (8 * ELP);
        unsigned voff = 16u * (unsigned)lane; asm volatile("" : "+v"(voff));
#pragma unroll
        for (int k = 0; k < 8; ++k) {
            const size_t base = (size_t)(tok0 + k) * 128;
            E0[k] = ((unsigned)PIDX[base + lane] << 7) | (unsigned)lane; E1[k] = ((unsigned)PIDX[base + 64 + lane] << 7) | (unsigned)(64 + lane);
            sort128(E0[k], E1[k], lane);
            if (FAKE) { E0[k] = (E0[k] & 0x1ffffu) ; E1[k] = (E1[k] & 0x1ffffu); sort128(E0[k], E1[k], lane); }
            El[k * ELP + lane] = E0[k] >> 7; El[k * ELP + 64 + lane] = E1[k] >> 7;
            if (lane < 8) El[k * ELP + 128 + lane] = (unsigned)__builtin_amdgcn_readlane((int)E1[k], 63) >> 7;
        }
        for (int repa = 0; repa < PROBE_REPA; ++repa) {
            v4u hq[8];
#pragma unroll
            for (int k = 0; k < 8; ++k) hq[k] = *(const v4u*)(H2Q + (size_t)(tok0 + k) * D + 16 * lane);
            int pos[8];
#pragma unroll
            for (int k = 0; k < 8; ++k) pos[k] = 0;
            v4u bA[BSA], bB[BSA]; int ps = 0, pn = 0;
            for (int r = 0; r < NR; ++r) {
#pragma unroll
                for (int k = 0; k < 8; ++k) {
                    constexpr int dummy = 0; (void)dummy;
                    const int kp = (k + 7) & 7;
                    const int c = __builtin_popcountll(__ballot((E0[k] >> RSH) == (unsigned)r)) + __builtin_popcountll(__ballot((E1[k] >> RSH) == (unsigned)r));
                    int s = __builtin_amdgcn_readfirstlane(pos[k]); const int e_end = __builtin_amdgcn_readfirstlane(s + c); pos[k] = e_end;
                    const int n1 = (e_end - s) < BSA ? (e_end - s) : BSA;
                    if (k & 1) sw_issue<BSA>(bB, El + k * ELP + s, EDq, voff); else sw_issue<BSA>(bA, El + k * ELP + s, EDq, voff);
                    if (pn > 0) { if (k & 1) sw_proc_a<BSA>(bA, hq[kp], Wl + kp * 128, ps, pn, lane); else sw_proc_a<BSA>(bB, hq[kp], Wl + kp * 128, ps, pn, lane); }
                    ps = s; pn = n1; s += n1;
                    for (; s < e_end; s += BSA) {
                        const int n = (e_end - s) < BSA ? (e_end - s) : BSA;
                        if (k & 1) { sw_issue<BSA>(bA, El + k * ELP + s, EDq, voff); sw_proc_a<BSA>(bA, hq[k], Wl + k * 128, s, n, lane); }
                        else       { sw_issue<BSA>(bB, El + k * ELP + s, EDq, voff); sw_proc_a<BSA>(bB, hq[k], Wl + k * 128, s, n, lane); }
                    }
                }
            }
            if (pn > 0) sw_proc_a<BSA>(bB, hq[7], Wl + 7 * 128, ps, pn, lane);
        }
#pragma unroll
        for (int k = 0; k < 8; ++k) { int tk = tok0 + k; asm volatile("" : "+s"(tk)); const size_t base = (size_t)tk * 128; const float sh = H2S[tk];
            const float r0 = Wl[k * 128 + lane], r1 = Wl[k * 128 + 64 + lane];
            Wl[k * 128 + lane] = PG[base + (E0[k] & 127u)] * gelu_erf(r0 * sh * EDS[E0[k] >> 7]) * 0.0625f;
            Wl[k * 128 + 64 + lane] = PG[base + (E1[k] & 127u)] * gelu_erf(r1 * sh * EDS[E1[k] >> 7]) * 0.0625f; }
        int ln = lane; asm volatile("" : "+v"(ln));
#pragma unroll
        for (int sub = 0; sub < 8 / TPS; ++sub) {
        f32x2_t acc[TPS][8];
        for (int repb = 0; repb < PROBE_REPB; ++repb) {
#pragma unroll
            for (int kk = 0; kk < TPS; ++kk)
#pragma unroll
                for (int i = 0; i < 8; ++i) acc[kk][i] = (f32x2_t){0.f, 0.f};
            int pos[TPS];
#pragma unroll
            for (int kk = 0; kk < TPS; ++kk) pos[kk] = 0;
            v4u bA[BSB], bB[BSB]; int ps = 0, pn = 0;
            for (int r = 0; r < NR; ++r) {
#pragma unroll
                for (int kk = 0; kk < TPS; ++kk) {
                    const int k = sub * TPS + kk, kkp = (kk + TPS - 1) % TPS, kp = sub * TPS + kkp;
                    const int c = __builtin_popcountll(__ballot((E0[k] >> RSH) == (unsigned)r)) + __builtin_popcountll(__ballot((E1[k] >> RSH) == (unsigned)r));
                    int s = __builtin_amdgcn_readfirstlane(pos[kk]); const int e_end = __builtin_amdgcn_readfirstlane(s + c); pos[kk] = e_end;
                    const int n1 = (e_end - s) < BSB ? (e_end - s) : BSB;
                    if (kk & 1) sw_issue<BSB>(bB, El + k * ELP + s, EUq, voff); else sw_issue<BSB>(bA, El + k * ELP + s, EUq, voff);
                    if (pn > 0) { if (kk & 1) sw_proc_b<BSB>(bA, acc[kkp], Wl + kp * 128, ps, pn); else sw_proc_b<BSB>(bB, acc[kkp], Wl + kp * 128, ps, pn); }
                    ps = s; pn = n1; s += n1;
                    for (; s < e_end; s += BSB) {
                        const int n = (e_end - s) < BSB ? (e_end - s) : BSB;
                        if (kk & 1) { sw_issue<BSB>(bA, El + k * ELP + s, EUq, voff); sw_proc_b<BSB>(bA, acc[kk], Wl + k * 128, s, n); }
                        else        { sw_issue<BSB>(bB, El + k * ELP + s, EUq, voff); sw_proc_b<BSB>(bB, acc[kk], Wl + k * 128, s, n); }
                    }
                }
            }
            if (pn > 0) sw_proc_b<BSB>(bB, acc[TPS - 1], Wl + (sub * TPS + TPS - 1) * 128, ps, pn);
        }
#pragma unroll
        for (int kk = 0; kk < TPS; ++kk) {
            const int tok = tok0 + sub * TPS + kk; const int b = tok >> 12; const float* gt2 = MOD + b * NMOD + 5120;
            f32x4 x2[4]; float ss = 0.f;
#pragma unroll
            for (int j = 0; j < 4; ++j) { const int col = 4 * ln + 256 * j;
                const f32x4 xv = *(const f32x4*)(X1 + (size_t)tok * D + col), gv4 = *(const f32x4*)(gt2 + col);
#pragma unroll
                for (int i = 0; i < 4; ++i) { const float v = xv[i] + gv4[i] * acc[kk][2 * j + (i >> 1)][i & 1]; x2[j][i] = v; ss += v * v; } }
            ss = wave_sum(ss);
            if (FAKE && ss != 12345.678f) continue;
            const float rstd = 1.0f / sqrtf(ss * (1.0f / D) + EPS);
#pragma unroll
            for (int j = 0; j < 4; ++j) { const int col = 4 * ln + 256 * j; const f32x4 gg = *(const f32x4*)(fg + col);
                *(f32x4*)(((float*)karg(18)) + (size_t)tok * D + col) = x2[j] * rstd * gg; }
        }
        }
    }
}

struct Args { const float* in[18]; float* out; unsigned char* ws; };
__global__ void __launch_bounds__(NTHR, 2) mega_fwd(Args args) {
    extern __shared__ __attribute__((aligned(16))) unsigned char lds[];
    Frame F;
    F.lds = (LAS unsigned char*)lds;
    F.tid = threadIdx.x; F.lane = F.tid & 63; F.wave = __builtin_amdgcn_readfirstlane(F.tid >> 6);
    F.G = gridDim.x; { const int bx = blockIdx.x; F.vcu = (F.G % 8 == 0) ? (bx % 8) * (F.G / 8) + bx / 8 : bx; }
    volatile LAS unsigned* MISC = (volatile LAS unsigned*)(F.lds + MISC_OFF);
    for (int u = F.tid; u < (LDS_BYTES - LDSCTL_OFF) / 4; u += NTHR) ((LAS unsigned*)(F.lds + LDSCTL_OFF))[u] = 0u;
    __syncthreads();
    gu32* ctl = (gu32*)(((unsigned char*)karg(19)) + WS_CTL);
    XcdBarrier bar = xcd_barrier_post((unsigned*)(ctl + CW_BAR), MISC + 8);
#define GRID_BAR() xcd_barrier(bar)
#define PROBE_TS -1
#define STAMP(i) do { if (PROBE_TS >= 0 && blockIdx.x == 0 && F.tid == 0) { const unsigned long long t_ = __builtin_amdgcn_s_memrealtime(); MISC[16 + 2 * (i)] = (unsigned)t_; MISC[17 + 2 * (i)] = (unsigned)(t_ >> 32); } } while (0)
#define PROBE_DBL -1

    STAMP(0);
    p0_prologue(F); GRID_BAR(); STAMP(1);
    if (PROBE_DBL == 0) { p0_prologue(F); GRID_BAR(); }
    p1_norm(F); p0_transposes(F); GRID_BAR(); STAMP(2);
    if (PROBE_DBL == 1) { p1_norm(F); GRID_BAR(); }
    {
    {
        pg8::Gemm g{(const pg8::bf16_t*)(((unsigned char*)karg(19)) + WS_H), (const pg8::bf16_t*)(((unsigned char*)karg(19)) + WS_WIN), M, NPROJ, D, nullptr, nullptr};
        pg8::StaticOrder S; S.init(M, NPROJ, F.G, (int)blockIdx.x);
        pg8::EpiBf16<0> E{(pg8::bf16_t*)(((unsigned char*)karg(19)) + WS_PROJ), NPROJ, nullptr, 0, 0, 1.f};
        pg8::gemm_phase<pg8::EpiBf16<0>, pg8::StaticOrder, true, true>(F.lds + RING_OFF, g, S, E);
        const int nwg = (M / 256) * (NPROJ / 256), busy = nwg % F.G;
        if (busy == 0) p0_quant_tables(F, F.vcu * NWAVES + F.wave, F.G * NWAVES);
        else if ((int)blockIdx.x >= busy) p0_quant_tables(F, ((int)blockIdx.x - busy) * NWAVES + F.wave, (F.G - busy) * NWAVES);
    }
    GRID_BAR(); STAMP(3);
    }
    p3_attention(F); GRID_BAR(); STAMP(4);
    if (PROBE_DBL == 3) { p3_attention(F); GRID_BAR(); }
    {
    {
        pg8::Gemm g{(const pg8::bf16_t*)(((unsigned char*)karg(19)) + WS_OA), (const pg8::bf16_t*)(((unsigned char*)karg(19)) + WS_WA), M, D, 512, (const pg8::bf16_t*)(((unsigned char*)karg(19)) + WS_OB), (const pg8::bf16_t*)(((unsigned char*)karg(19)) + WS_WB)};
        PairOrder S; S.S.init(M, D, F.G, (int)blockIdx.x);
        EpiGate E{(const bf16*)(((unsigned char*)karg(19)) + WS_PROJ), (bf16*)((float*)karg(18)) + (size_t)M * D};
        pg8::gemm_phase<EpiGate, PairOrder, false, true>(F.lds + RING_OFF, g, S, E);
    }
    GRID_BAR(); STAMP(5);
    }
    {
    {
        pg8::Gemm g{(const pg8::bf16_t*)((bf16*)((float*)karg(18)) + (size_t)M * D), (const pg8::bf16_t*)(((unsigned char*)karg(19)) + WS_WOUT), M, D, D, nullptr, nullptr};
        pg8::StaticOrder S; S.init(M, D, F.G, (int)blockIdx.x);
        EpiRes E{((const float*)karg(0)), (const float*)(((unsigned char*)karg(19)) + WS_MOD), (float*)(((unsigned char*)karg(19)) + WS_X1)};
        pg8::gemm_phase<EpiRes, pg8::StaticOrder, false, true>(F.lds + RING_OFF, g, S, E);
    }
    GRID_BAR(); STAMP(6);
    }
    p6_norm2(F); GRID_BAR(); STAMP(7);
    if (PROBE_DBL == 6) { p6_norm2(F); GRID_BAR(); }
    {
    {
        pg8::Gemm g{(const pg8::bf16_t*)(((unsigned char*)karg(19)) + WS_H2), (const pg8::bf16_t*)(((unsigned char*)karg(19)) + WS_WQ), M, D, D, nullptr, nullptr};
        pg8::StaticOrder S; S.init(M, D, F.G, (int)blockIdx.x);
        pg8::EpiBf16<0> E{(pg8::bf16_t*)(((unsigned char*)karg(19)) + WS_QP), D, nullptr, 0, 0, 1.f};
        pg8::gemm_phase<pg8::EpiBf16<0>, pg8::StaticOrder, false, true>(F.lds + RING_OFF, g, S, E);
    }
    GRID_BAR(); STAMP(8);
    }
    p8a_topk(F); __syncthreads(); STAMP(9);
    if (PROBE_DBL == 8) { p8a_topk(F); GRID_BAR(); }
    if (PROBE_DBL == 12) { p8b_sweep<1>(F); __syncthreads(); }
    p8b_sweep<0>(F);
    if (PROBE_DBL == 9) { GRID_BAR(); p8b_sweep<0>(F); }
    if (PROBE_TS >= 0) {
        GRID_BAR(); STAMP(10);
        if (blockIdx.x == 0) { __syncthreads();
            const unsigned long long t0 = ((unsigned long long)MISC[17 + 2 * PROBE_TS] << 32) | MISC[16 + 2 * PROBE_TS], t1 = ((unsigned long long)MISC[19 + 2 * PROBE_TS] << 32) | MISC[18 + 2 * PROBE_TS];
            const float d_us = (float)(t1 - t0) * 0.01f;
            const float V = 128.0f * sqrtf(d_us * 1e-5f);
            float* o = (float*)karg(18); for (int c = F.tid; c < D; c += NTHR) o[c] = V; }
    }
}

extern "C" void kernel_launch(void* const* d_in, const int* in_sizes, int n_in, void* d_out, int out_size, void* d_ws, size_t ws_size, hipStream_t stream) {
    static int grid = 0;
    if (grid == 0) {
        if (n_in != 18 || in_sizes[0] != M * D || out_size != M * D || ws_size < WS_END) { fprintf(stderr, "kernel_launch: unexpected shapes (n_in %d, in0 %d, out %d, ws %zu)\n", n_in, n_in > 0 ? in_sizes[0] : -1, out_size, ws_size); grid = -1; return; }
        int dev = 0, cus = 0, per_cu = 0;
        if (hipGetDevice(&dev) != hipSuccess || hipDeviceGetAttribute(&cus, hipDeviceAttributeMultiprocessorCount, dev) != hipSuccess) { grid = -1; return; }
        if (hipFuncSetAttribute((const void*)mega_fwd, hipFuncAttributeMaxDynamicSharedMemorySize, LDS_BYTES) != hipSuccess) { fprintf(stderr, "kernel_launch: hipFuncSetAttribute failed\n"); grid = -1; return; }
        if (hipOccupancyMaxActiveBlocksPerMultiprocessor(&per_cu, (const void*)mega_fwd, NTHR, LDS_BYTES) != hipSuccess || per_cu < 1) { fprintf(stderr, "kernel_launch: occupancy query says %d blocks per CU\n", per_cu); }
        (void)hipGetLastError();
        grid = cus;
    }
    if (grid < 0) return;
    if (hipMemsetAsync((char*)d_ws + WS_CTL, 0, CTL_ZERO_BYTES, stream) != hipSuccess) { fprintf(stderr, "kernel_launch: memset failed\n"); return; }
    Args a{};
    for (int i = 0; i < 18; ++i) a.in[i] = (const float*)d_in[i];
    a.out = (float*)d_out; a.ws = (unsigned char*)d_ws;
    hipLaunchKernelGGL(mega_fwd, dim3(grid), dim3(NTHR), LDS_BYTES, stream, a);
}
```

```cpp
#include <hip/hip_runtime.h>
#include <cstdio>
#include <cstdint>
namespace pg8 {
#define PG8_LAS __attribute__((address_space(3)))
typedef unsigned short bf16_t;
typedef short bf16x8 __attribute__((ext_vector_type(8)));
typedef float f32x4 __attribute__((ext_vector_type(4)));
typedef unsigned u32x4 __attribute__((ext_vector_type(4)));
constexpr int BM = 256, BK = 64, HALF = 128, HTB = HALF * BK * 2  , STAGE_BYTES = 8 * HTB, NXCD = 8, WGM = 8;

__host__ __device__ __forceinline__ int lds_byte(int r, int c) { const int st = (r >> 4) * 2 + (c >> 5), rr = r & 15, cc = c & 31, ob = rr * 64 + cc * 2; return st * 1024 + (ob ^ (((ob >> 9) & 1) << 5)); }
__host__ __device__ __forceinline__ void stage_rc(int b, int& R, int& C) { const int st = b / 1024, sb = b % 1024, swz = sb ^ (((sb >> 9) & 1) << 5); R = (st >> 1) * 16 + swz / 64; C = (st & 1) * 32 + (swz % 64) / 2; }
__host__ __device__ __forceinline__ int perm32(int rho) { const int n = rho >> 4, i = rho & 15; return 8 * (i >> 2) + 4 * n + (i & 3); }

struct Unit { int pm, pn, src; };
struct Gemm { const bf16_t* A; const bf16_t* Bt; int M, N, K; const bf16_t* A2; const bf16_t* Bt2; };

struct StaticOrder {
    int nM, nN, nwg, G, c;
    __host__ __device__ void init(int M, int N, int G_, int c_) { nM = M / BM; nN = N / BM; nwg = nM * nN; G = G_; c = c_; }
    __host__ __device__ bool next(int i, Unit& u) const {
        const long L = (long)i * G + c; if (L >= nwg) return false;
        int wgid = (int)L; { const int q = nwg / NXCD, r = nwg % NXCD, xcd = wgid % NXCD, off = wgid / NXCD; wgid = (xcd < r ? xcd * (q + 1) : r * (q + 1) + (xcd - r) * q) + off; }
        const int nig = WGM * nN, gid = wgid / nig, fm = gid * WGM, gsz = (nM - fm) < WGM ? (nM - fm) : WGM;
        u.pm = fm + ((wgid % nig) % gsz); u.pn = (wgid % nig) / gsz; u.src = 0; return true;
    }
    __device__ __forceinline__ void a_ready(const Unit&) const {}
    __device__ __forceinline__ void done(const Unit&) const {}
};

__device__ __forceinline__ unsigned cvt_pk_bf16(float lo, float hi) { unsigned r; asm volatile("v_cvt_pk_bf16_f32 %0, %1, %2" : "=v"(r) : "v"(lo), "v"(hi)); return r; }
typedef float f32x2 __attribute__((ext_vector_type(2)));
__device__ __forceinline__ f32x2 gelu_pk(f32x2 v) {
    const f32x2 av = __builtin_elementwise_abs(v), d = av * 0.2316418882f + 1.0f;
    f32x2 t; t.x = __builtin_amdgcn_rcpf(d.x); t.y = __builtin_amdgcn_rcpf(d.y);
    f32x2 q = t * 0.5307027145f + (-0.7265760135f); q = q * t + 0.7107068705f; q = q * t + (-0.142248368f); q = q * t + 0.127414796f; q = q * t;
    const f32x2 s = (v * v) * (-0.72134752044f);
    f32x2 e; e.x = __builtin_amdgcn_exp2f(s.x); e.y = __builtin_amdgcn_exp2f(s.y);
    const f32x2 m = v * (q * e), r = v - m;
    f32x2 o; o.x = v.x < 0.f ? m.x : r.x; o.y = v.y < 0.f ? m.y : r.y; return o;
}

template <int ACT  > struct EpiBf16 {
    static constexpr bool PERM = true, AFTER_DRAIN = false, CHAIN = false; static_assert(ACT == 0 || ACT == 1, "EpiBf16: ACT is 0 (none) or 1 (gelu_pk)");
    bf16_t* O; int ldc; const float* bias; int split_cols; size_t split_stride; float scale0;
    __device__ __forceinline__ void operator()(const f32x4 (&acc)[2][2][4][2], const Unit& u, int wr, int wc, int fr, int fq) const {
        const int row0 = u.pm * BM + wr * 64 + fr; int colt = u.pn * BM; bf16_t* base = O;
        float sc = 1.f; if (split_cols) { const int t = colt / split_cols; base += (size_t)t * split_stride; colt -= t * split_cols; if (t == 0) sc = scale0; }
        const int col0 = colt + wc * 32 + 8 * fq, bcol0 = u.pn * BM + wc * 32 + 8 * fq;
        f32x4 bv[2][2];
#pragma unroll
        for (int bj = 0; bj < 2; ++bj)
#pragma unroll
            for (int n = 0; n < 2; ++n) bv[bj][n] = bias ? *(const f32x4*)(bias + bcol0 + bj * HALF + 4 * n) : (f32x4){0.f, 0.f, 0.f, 0.f};
#pragma unroll
        for (int ai = 0; ai < 2; ++ai)
#pragma unroll
            for (int m = 0; m < 4; ++m) { bf16_t* rowp = base + (size_t)(row0 + ai * HALF + m * 16) * ldc + col0;
#pragma unroll
                for (int bj = 0; bj < 2; ++bj) { f32x4 v0 = acc[ai][bj][m][0] + bv[bj][0], v1 = acc[ai][bj][m][1] + bv[bj][1];
                    if (ACT == 1) { f32x2 a = gelu_pk((f32x2){v0[0], v0[1]}), b = gelu_pk((f32x2){v0[2], v0[3]}), c = gelu_pk((f32x2){v1[0], v1[1]}), d = gelu_pk((f32x2){v1[2], v1[3]});
                        v0 = (f32x4){a.x, a.y, b.x, b.y}; v1 = (f32x4){c.x, c.y, d.x, d.y}; }
                    v0 = v0 * sc; v1 = v1 * sc; u32x4 w; w.x = cvt_pk_bf16(v0[0], v0[1]); w.y = cvt_pk_bf16(v0[2], v0[3]); w.z = cvt_pk_bf16(v1[0], v1[1]); w.w = cvt_pk_bf16(v1[2], v1[3]);
                    *(u32x4*)(rowp + bj * HALF) = w; } }
    }
};

template <class Epi, class Sched, bool ALIGN_EPI = false, bool SP2 = false>
__device__ __forceinline__ void gemm_phase(PG8_LAS unsigned char* lds, const Gemm g, const Sched& S, const Epi& E) {
    const int tid = threadIdx.x, wid = __builtin_amdgcn_readfirstlane(tid >> 6), lane = tid & 63, wr = wid >> 2, wc = wid & 3, fr = lane & 15, fq = lane >> 4;
    const int K = g.K, nt = K / BK;
    unsigned voffA[2], voffB[2];
#pragma unroll
    for (int i = 0; i < 2; ++i) { int R, C; stage_rc(tid * 16 + i * 8192, R, C); const int Rb = Epi::PERM ? ((R & ~31) + perm32(R & 31)) : R;
        voffA[i] = (unsigned)(R * K + C) * 2u; voffB[i] = (unsigned)(Rb * K + C) * 2u; }
    const size_t kstep = (size_t)(BK * 2);
    const size_t hstep = (size_t)HALF * K * 2;
    const size_t tstep = 2 * hstep;
    const unsigned ldsw = (unsigned)wid * 1024u;
    const int aoff = lds_byte(wr * 64 + fr, fq * 8), boff = lds_byte(wc * 32 + fr, fq * 8);
#define PG8_SA(b, h) (((b) * 2 + (h)) * HTB)
#define PG8_SB(b, h) ((4 + (b) * 2 + (h)) * HTB)
#define PG8_STAGE(bufoff, gbase, voff) do { _Pragma("unroll") for (int _i = 0; _i < 2; ++_i) \
        __builtin_amdgcn_global_load_lds((const unsigned*)((const char*)(gbase) + (voff)[_i]), (PG8_LAS unsigned*)(lds + (bufoff) + ldsw + _i * 8192), 16, 0, 0); } while (0)
#define PG8_LDA(dst, b, h) do { _Pragma("unroll") for (int m = 0; m < 4; ++m) _Pragma("unroll") for (int k = 0; k < 2; ++k) dst[m][k] = *(const PG8_LAS bf16x8*)(lds + PG8_SA(b, h) + aoff + m * 2048 + k * 1024); } while (0)
#define PG8_LDB(dst, b, h) do { _Pragma("unroll") for (int n = 0; n < 2; ++n) _Pragma("unroll") for (int k = 0; k < 2; ++k) dst[n][k] = *(const PG8_LAS bf16x8*)(lds + PG8_SB(b, h) + boff + n * 2048 + k * 1024); } while (0)
#define PG8_MMA(ai, bj, At, Bt) do { __builtin_amdgcn_s_setprio(1); _Pragma("unroll") for (int m = 0; m < 4; ++m) _Pragma("unroll") for (int n = 0; n < 2; ++n) _Pragma("unroll") for (int k = 0; k < 2; ++k) \
        acc[ai][bj][m][n] = __builtin_amdgcn_mfma_f32_16x16x32_bf16(Bt[n][k], At[m][k], acc[ai][bj][m][n], 0, 0, 0); __builtin_amdgcn_s_setprio(0); } while (0)
#define PG8_WAIT_V(n) asm volatile("s_waitcnt vmcnt(" #n ")" ::: "memory")
#define PG8_WAIT_L(n) asm volatile("s_waitcnt lgkmcnt(" #n ")" ::: "memory")
#define PG8_BAR __builtin_amdgcn_s_barrier()
#define PG8_SCHED __builtin_amdgcn_sched_barrier(0)
    Unit cur, nxt; int ui = 0;
    if (!S.next(0, cur)) return;
    f32x4 acc[2][2][4][2];
#pragma unroll
    for (int a = 0; a < 2; ++a)
#pragma unroll
        for (int b = 0; b < 2; ++b)
#pragma unroll
            for (int m = 0; m < 4; ++m)
#pragma unroll
                for (int n = 0; n < 2; ++n) acc[a][b][m][n] = (f32x4){0.f, 0.f, 0.f, 0.f};
    bf16x8 At[4][2], B0[2][2], B1[2][2];
    const char* cA = (const char*)(cur.src ? g.A2 : g.A) + (size_t)cur.pm * tstep; const char* cB = (const char*)(cur.src ? g.Bt2 : g.Bt) + (size_t)cur.pn * tstep;
    S.a_ready(cur);
    if constexpr (SP2) {
        PG8_STAGE(PG8_SB(0, 0), cB, voffB); PG8_STAGE(PG8_SB(0, 1), cB + hstep, voffB); PG8_STAGE(PG8_SA(0, 0), cA, voffA); PG8_STAGE(PG8_SA(0, 1), cA + hstep, voffA);
        if (wr == 1) PG8_BAR;
        PG8_WAIT_V(2); PG8_BAR;
        PG8_STAGE(PG8_SB(1, 0), cB + kstep, voffB); PG8_STAGE(PG8_SA(1, 0), cA + kstep, voffA); PG8_STAGE(PG8_SB(1, 1), cB + hstep + kstep, voffB);
        PG8_WAIT_V(6); PG8_BAR;
    } else {
        PG8_STAGE(PG8_SB(0, 0), cB, voffB); PG8_STAGE(PG8_SA(0, 0), cA, voffA); PG8_STAGE(PG8_SB(0, 1), cB + hstep, voffB); PG8_STAGE(PG8_SA(0, 1), cA + hstep, voffA);
        if (wr == 1) PG8_BAR;
        PG8_WAIT_V(4); PG8_BAR;
        PG8_STAGE(PG8_SB(1, 0), cB + kstep, voffB); PG8_STAGE(PG8_SA(1, 0), cA + kstep, voffA); PG8_STAGE(PG8_SB(1, 1), cB + hstep + kstep, voffB);
        PG8_WAIT_V(6); PG8_BAR;
    }
    for (;;) {
        const bool has_next = S.next(ui + 1, nxt);
        const char* nA = has_next ? (const char*)(nxt.src ? g.A2 : g.A) + (size_t)nxt.pm * tstep : cA; const char* nB = has_next ? (const char*)(nxt.src ? g.Bt2 : g.Bt) + (size_t)nxt.pn * tstep : cB;
        for (int t = 0; t < nt; t += 2) {
            const bool last = (t == nt - 2);
            const char* a1 = cA + (size_t)(t + 1) * kstep;
            const char* a2 = last ? nA : cA + (size_t)(t + 2) * kstep; const char* b2 = last ? nB : cB + (size_t)(t + 2) * kstep;
            const char* a3 = a2 + kstep; const char* b3 = b2 + kstep;
            if (last && has_next) S.a_ready(nxt);
            if constexpr (SP2) {
            PG8_LDB(B0, 0, 0); PG8_LDB(B1, 0, 1); PG8_SCHED; PG8_LDA(At, 0, 0); PG8_STAGE(PG8_SA(1, 1), a1 + hstep, voffA);
            PG8_WAIT_V(8); PG8_WAIT_L(0); PG8_BAR; PG8_MMA(0, 0, At, B0); PG8_MMA(0, 1, At, B1); PG8_BAR; PG8_SCHED;
            PG8_LDA(At, 0, 1); PG8_STAGE(PG8_SB(0, 0), b2, voffB); PG8_STAGE(PG8_SB(0, 1), b2 + hstep, voffB); PG8_STAGE(PG8_SA(0, 0), a2, voffA);
            PG8_WAIT_V(8); PG8_WAIT_L(0); PG8_BAR; PG8_MMA(1, 0, At, B0); PG8_MMA(1, 1, At, B1); PG8_BAR; PG8_SCHED;
            PG8_LDB(B0, 1, 0); PG8_LDB(B1, 1, 1); PG8_SCHED; PG8_LDA(At, 1, 0); PG8_STAGE(PG8_SA(0, 1), a2 + hstep, voffA);
            PG8_WAIT_V(8); PG8_WAIT_L(0); PG8_BAR; PG8_MMA(0, 0, At, B0); PG8_MMA(0, 1, At, B1); PG8_BAR; PG8_SCHED;
            PG8_LDA(At, 1, 1); PG8_STAGE(PG8_SB(1, 0), b3, voffB); PG8_STAGE(PG8_SB(1, 1), b3 + hstep, voffB); PG8_STAGE(PG8_SA(1, 0), a3, voffA);
            PG8_WAIT_V(8); PG8_WAIT_L(0); PG8_BAR; PG8_MMA(1, 0, At, B0); PG8_MMA(1, 1, At, B1); PG8_BAR; PG8_SCHED;
            } else {
            PG8_LDB(B0, 0, 0); PG8_SCHED; PG8_LDA(At, 0, 0); PG8_STAGE(PG8_SA(1, 1), a1 + hstep, voffA);
            PG8_WAIT_L(8); PG8_BAR; PG8_WAIT_L(0); PG8_MMA(0, 0, At, B0); PG8_BAR; PG8_SCHED;
            PG8_LDB(B1, 0, 1); PG8_STAGE(PG8_SB(0, 0), b2, voffB);
            PG8_BAR; PG8_WAIT_L(0); PG8_MMA(0, 1, At, B1); PG8_BAR;
            PG8_LDA(At, 0, 1); PG8_STAGE(PG8_SA(0, 0), a2, voffA);
            PG8_BAR; PG8_WAIT_L(0); PG8_MMA(1, 0, At, B0); PG8_BAR; PG8_SCHED;
            PG8_STAGE(PG8_SB(0, 1), b2 + hstep, voffB);
            PG8_WAIT_V(6); PG8_BAR; PG8_MMA(1, 1, At, B1); PG8_BAR;
            PG8_LDB(B0, 1, 0); PG8_SCHED; PG8_LDA(At, 1, 0); PG8_STAGE(PG8_SA(0, 1), a2 + hstep, voffA);
            PG8_WAIT_L(8); PG8_BAR; PG8_WAIT_L(0); PG8_MMA(0, 0, At, B0); PG8_BAR; PG8_SCHED;
            PG8_LDB(B1, 1, 1); PG8_STAGE(PG8_SB(1, 0), b3, voffB);
            PG8_BAR; PG8_WAIT_L(0); PG8_MMA(0, 1, At, B1); PG8_BAR;
            PG8_LDA(At, 1, 1); PG8_STAGE(PG8_SA(1, 0), a3, voffA);
            PG8_BAR; PG8_WAIT_L(0); PG8_MMA(1, 0, At, B0); PG8_BAR; PG8_SCHED;
            PG8_STAGE(PG8_SB(1, 1), b3 + hstep, voffB);
            PG8_WAIT_V(6); PG8_BAR; PG8_MMA(1, 1, At, B1); PG8_BAR;
            }
        }
        if constexpr (ALIGN_EPI) { if (wr == 0) PG8_BAR; }
        if constexpr (!Epi::AFTER_DRAIN) { E(acc, cur, wr, wc, fr, fq); S.done(cur); }
        if (!has_next) break;
        if (!(Epi::CHAIN && cur.src == 0)) {
#pragma unroll
        for (int a = 0; a < 2; ++a)
#pragma unroll
            for (int b = 0; b < 2; ++b)
#pragma unroll
                for (int m = 0; m < 4; ++m)
#pragma unroll
                    for (int n = 0; n < 2; ++n) acc[a][b][m][n] = (f32x4){0.f, 0.f, 0.f, 0.f};
        }
        cur = nxt; cA = nA; cB = nB; ++ui;
        if constexpr (ALIGN_EPI) { if (wr == 1) PG8_BAR; }
    }
    PG8_WAIT_V(0);
    if constexpr (!ALIGN_EPI) { if (wr == 0) PG8_BAR; }
    PG8_BAR;
    if constexpr (Epi::AFTER_DRAIN) { E.fused(acc, cur, wr, wc, fr, fq, lds, wid, lane); S.done(cur); }
#undef PG8_SA
#undef PG8_SB
#undef PG8_STAGE
#undef PG8_LDA
#undef PG8_LDB
#undef PG8_MMA
#undef PG8_WAIT_V
#undef PG8_WAIT_L
#undef PG8_BAR
#undef PG8_SCHED
}
}

#define GAS __attribute__((address_space(1)))
#define LAS __attribute__((address_space(3)))
typedef unsigned short bf16;
typedef unsigned v4u __attribute__((ext_vector_type(4)));
typedef float f32x4 __attribute__((ext_vector_type(4)));
typedef short bf16x8 __attribute__((ext_vector_type(8)));
typedef GAS unsigned gu32;
typedef GAS unsigned long long gu64;
#define RLX_AGENT __ATOMIC_RELAXED, __HIP_MEMORY_SCOPE_AGENT
#define LDS_WAIT() asm volatile("s_waitcnt lgkmcnt(0)" ::: "memory")
#define VM_WAIT() asm volatile("s_waitcnt vmcnt(0)" ::: "memory")
__device__ __forceinline__ unsigned long long rt() { return __builtin_amdgcn_s_memrealtime(); }
__device__ __forceinline__ unsigned f2bf(float f) { unsigned u = __builtin_bit_cast(unsigned, f); return (u + 0x7fffu + ((u >> 16) & 1u)) >> 16; }
__device__ __forceinline__ unsigned pk2(float lo, float hi) { return f2bf(lo) | (f2bf(hi) << 16); }

#define XB_TMO      128
#define XB_XCNT(j)  (256  + 64 * (j))
#define XB_XSUB(j)  (1280 + 64 * (j))
#define XB_XGEN(j)  (2304 + 64 * (j))
#define XB_TOP      3328
#define XB_TOPGEN   3392
#define XCD_BAR_WORDS 3456
#define XB_SPIN_CAP (1u << 18)

__device__ __forceinline__ unsigned xb_ld(unsigned* p)              { return __hip_atomic_load(p, __ATOMIC_RELAXED, __HIP_MEMORY_SCOPE_AGENT); }
__device__ __forceinline__ unsigned xb_add(unsigned* p, unsigned v) { return __hip_atomic_fetch_add(p, v, __ATOMIC_RELAXED, __HIP_MEMORY_SCOPE_AGENT); }
__device__ __forceinline__ unsigned xb_xcc_id() { return (unsigned)__builtin_amdgcn_s_getreg((3 << 11) | 20) & 0xFu; }
#define XB_SPIN(cond, bar) do { unsigned _sp = 0; while (cond) { __builtin_amdgcn_s_sleep(1); \
    if ((++_sp & 255u) == 0u) { if (xb_ld(&(bar)[XB_TMO])) break; if (_sp > XB_SPIN_CAP) { atomicAdd(&(bar)[XB_TMO], 1u); break; } } } } while (0)

struct XcdBarrier {
    unsigned* bar; unsigned x;
    volatile LAS unsigned* st;
};

__device__ __forceinline__ XcdBarrier xcd_barrier_post(unsigned* bar, volatile LAS unsigned* st) {
    XcdBarrier b; b.bar = bar; b.x = xb_xcc_id(); b.st = st;
    if (threadIdx.x == 0) (void)xb_add(&bar[XB_XCNT(b.x)], 1u);
    return b;
}
__device__ __forceinline__ void xcd_barrier_complete(unsigned* bar, unsigned x, unsigned& nloc, unsigned& nx) {
    const unsigned G = gridDim.x * gridDim.y * gridDim.z;
    unsigned sum, cnt, mine, sp = 0u;
    for (;;) {
        sum = 0u; cnt = 0u; mine = 0u;
#pragma unroll
        for (unsigned j = 0; j < 16; ++j) { const unsigned c = xb_ld(&bar[XB_XCNT(j)]); sum += c; cnt += (c > 0u) ? 1u : 0u; mine = (j == x) ? c : mine; }
        if (sum == G) break;
        __builtin_amdgcn_s_sleep(1);
        if ((++sp & 255u) == 0u) { if (xb_ld(&bar[XB_TMO])) break; if (sp > XB_SPIN_CAP) { atomicAdd(&bar[XB_TMO], 1u); break; } }
    }
    nloc = mine > 0u ? mine : 1u; nx = cnt > 0u ? cnt : 1u;
}

__device__ __forceinline__ void xcd_barrier(const XcdBarrier& b) {
    asm volatile("s_waitcnt vmcnt(0)" ::: "memory");
    __syncthreads();
    if (threadIdx.x == 0) {
        unsigned* bar = b.bar;
        __builtin_amdgcn_s_waitcnt(0);
        unsigned nloc = b.st[0], nx = b.st[1];
        if (nloc == 0u) { xcd_barrier_complete(bar, b.x, nloc, nx); b.st[0] = nloc; b.st[1] = nx; }
        const unsigned old = xb_add(&bar[XB_XSUB(b.x)], 1u);
        const unsigned gen = old / nloc;
        if (old + 1u == (gen + 1u) * nloc) {
            __builtin_amdgcn_fence(__ATOMIC_RELEASE, "agent");
            asm volatile("s_waitcnt vmcnt(0)" ::: "memory");
            const unsigned og = xb_add(&bar[XB_TOP], 1u);
            const unsigned tg = og / nx;
            if (og + 1u == (tg + 1u) * nx) xb_add(&bar[XB_TOPGEN], 1u);
            else XB_SPIN(xb_ld(&bar[XB_TOPGEN]) == tg, bar);
            __builtin_amdgcn_fence(__ATOMIC_ACQUIRE, "agent");
            xb_add(&bar[XB_XGEN(b.x)], 1u);
            asm volatile("s_waitcnt vmcnt(0)" ::: "memory");
        } else {
            XB_SPIN(xb_ld(&bar[XB_XGEN(b.x)]) == gen, bar);
            __builtin_amdgcn_fence(__ATOMIC_ACQUIRE, "agent");
            asm volatile("s_waitcnt vmcnt(0)" ::: "memory");
        }
    }
    __syncthreads();
}

constexpr int NWAVES = 8, NTHR = 512;
constexpr int BATCH = 4, SEQ = 4096, D = 1024, M = BATCH * SEQ;
constexpr int NPROJ = 4352, LDW_IN = 4360, NMOD = 6144;
constexpr int C_QA = 0, C_KA = 512, C_VA = 640, C_QB = 768, C_KB = 1280, C_VB = 1792, C_GLA = 2304, C_GLB = 3328;
constexpr int NEXP = 16384;
constexpr float EPS = 1e-6f;

constexpr size_t MiB = 1u << 20;
constexpr size_t WS_CTL = 0, CTL_ZERO_BYTES = 1 * MiB;
constexpr size_t WS_MOD = 1 * MiB, WS_LOGF = 1 * MiB + 128 * 1024, WS_SUBK = 2 * MiB;
constexpr size_t WS_WIN = 4 * MiB, WS_WA = 12 * MiB + 512 * 1024, WS_WB = 13 * MiB + 512 * 1024, WS_WOUT = 14 * MiB + 512 * 1024, WS_WQ = 16 * MiB + 512 * 1024;
constexpr size_t WS_ED = 19 * MiB, WS_EU = 35 * MiB;
constexpr size_t WS_EDS = 2 * MiB + 512 * 1024;
constexpr size_t WS_H2Q = 95 * MiB, WS_H2S = 111 * MiB;
constexpr size_t WS_H = 83 * MiB, WS_OA = 83 * MiB, WS_OB = 99 * MiB, WS_PIDX = 83 * MiB, WS_PG = 87 * MiB;
constexpr size_t WS_PROJ = 115 * MiB, WS_X1 = 115 * MiB, WS_H2 = 179 * MiB, WS_QP = 211 * MiB;
constexpr size_t WS_END = 251 * MiB;
static_assert(WS_WIN + (size_t)NPROJ * D * 2 <= WS_WA && WS_WQ + (size_t)D * D * 2 <= WS_ED && WS_PROJ + (size_t)M * NPROJ * 2 <= WS_END, "ws map");
constexpr int CW_BAR = 4096;

constexpr int RING_OFF = 0, RING_BYTES = 131072;
constexpr int LDSCTL_OFF = RING_BYTES, MISC_OFF = LDSCTL_OFF + 320;
constexpr int LDS_BYTES = 147456;

typedef float f32x16 __attribute__((ext_vector_type(16)));
typedef short s16x4 __attribute__((ext_vector_type(4)));
typedef unsigned u32x2 __attribute__((ext_vector_type(2)));
typedef float f32x2_t __attribute__((ext_vector_type(2)));
typedef __bf16 bf16x2_t __attribute__((ext_vector_type(2)));

__device__ __forceinline__ unsigned cvtpk(float lo, float hi) { f32x2_t v = {lo, hi}; bf16x2_t b = __builtin_convertvector(v, bf16x2_t); return __builtin_bit_cast(unsigned, b); }
__device__ __forceinline__ float bflo(unsigned u) { return __uint_as_float(u << 16); }
__device__ __forceinline__ float bfhi(unsigned u) { return __uint_as_float(u & 0xffff0000u); }
__device__ __forceinline__ float wave_sum(float v) {
#pragma unroll
    for (int o = 1; o < 64; o <<= 1) v += __shfl_xor(v, o);
    return v;
}
__device__ __forceinline__ int crow(int r, int hi) { return (r & 3) + 8 * (r >> 2) + 4 * hi; }
#define MFMA32(a, b, c) __builtin_amdgcn_mfma_f32_32x32x16_bf16((a), (b), (c), 0, 0, 0)

struct Frame {
    LAS unsigned char* lds;
    int tid, lane, wave, vcu, G;
};
__device__ __forceinline__ const void* karg(int i) {
    unsigned long z = 0; asm volatile("" : "+s"(z));
    const char* base = (const char*)__builtin_amdgcn_kernarg_segment_ptr();
    return *(const void* const*)(base + 8 * i + z);
}

__device__ __forceinline__ void p0_transpose_item(const float* W, int ld, int K, int ncols, bf16* WT, int row_off, LAS float* scr, int item, int lane) {
    const int nblk = ncols / 32, kb = item / nblk, nb = item % nblk, k0 = 64 * kb, n0 = 32 * nb;
#pragma unroll 8
    for (int i = 0; i < 32; ++i) { const int kk = 2 * i + (lane >> 5); scr[kk * 33 + (lane & 31)] = W[(size_t)(k0 + kk) * ld + n0 + (lane & 31)]; }
    LDS_WAIT(); asm volatile("" ::: "memory");
    const int c = lane & 7;
#pragma unroll
    for (int j = 0; j < 4; ++j) { const int n = (lane >> 3) + 8 * j; const LAS float* s = scr + (8 * c) * 33 + n;
        v4u o; o.x = pk2(s[0 * 33], s[1 * 33]); o.y = pk2(s[2 * 33], s[3 * 33]); o.z = pk2(s[4 * 33], s[5 * 33]); o.w = pk2(s[6 * 33], s[7 * 33]);
        *(GAS v4u*)(WT + (size_t)(row_off + n0 + n) * K + k0 + 8 * c) = o; }
    LDS_WAIT(); asm volatile("" ::: "memory");
}
__device__ __forceinline__ void p0_convert(const float* __restrict__ src, bf16* __restrict__ dst, long n_iters, int gw, int NGW, int lane) {
    for (long it0 = (long)gw * 4; it0 < n_iters; it0 += (long)NGW * 4) {
        f32x4 a[4][2];
#pragma unroll
        for (int u = 0; u < 4; ++u) { const long it = it0 + u; if (it < n_iters) { const float* p = src + it * 512 + lane * 4; a[u][0] = *(const f32x4*)p; a[u][1] = *(const f32x4*)(p + 256); } }
#pragma unroll
        for (int u = 0; u < 4; ++u) { const long it = it0 + u; if (it < n_iters) { bf16* q = dst + it * 512 + lane * 4;
            u32x2 w0, w1; w0.x = cvtpk(a[u][0].x, a[u][0].y); w0.y = cvtpk(a[u][0].z, a[u][0].w); w1.x = cvtpk(a[u][1].x, a[u][1].y); w1.y = cvtpk(a[u][1].z, a[u][1].w);
            *(u32x2*)q = w0; *(u32x2*)(q + 256) = w1; } }
    }
}

__device__ __forceinline__ void p0_quant_tables(Frame& F, int gw, int NGW) {
    const float* ed = ((const float*)karg(15)); const float* eu = ((const float*)karg(16));
    unsigned char* EDq = (unsigned char*)(((unsigned char*)karg(19)) + WS_ED); unsigned char* EUq = (unsigned char*)(((unsigned char*)karg(19)) + WS_EU); float* EDS = (float*)(((unsigned char*)karg(19)) + WS_EDS);
    const int lane = F.lane;
    for (int row0 = gw * 4; row0 < NEXP; row0 += NGW * 4) {
        f32x4 a[4][4], u[4][4];
#pragma unroll
        for (int q = 0; q < 4; ++q)
#pragma unroll
            for (int j = 0; j < 4; ++j) { a[q][j] = *((const f32x4*)(ed + (size_t)(row0 + q) * D) + lane + 64 * j); u[q][j] = *((const f32x4*)(eu + (size_t)(row0 + q) * D) + lane + 64 * j); }
#pragma unroll
        for (int q = 0; q < 4; ++q) {
            float am = 0.f;
#pragma unroll
            for (int j = 0; j < 4; ++j) am = fmaxf(fmaxf(am, fmaxf(fabsf(a[q][j].x), fabsf(a[q][j].y))), fmaxf(fabsf(a[q][j].z), fabsf(a[q][j].w)));
#pragma unroll
            for (int o = 1; o < 64; o <<= 1) am = fmaxf(am, __shfl_xor(am, o));
            const float sc = am > 0.f ? am * (1.0f / 127.0f) : 1.0f, inv = 1.0f / sc;
            v4u qa, qu;
#pragma unroll
            for (int j = 0; j < 4; ++j) {
                const int b0 = (int)rintf(a[q][j].x * inv), b1 = (int)rintf(a[q][j].y * inv), b2 = (int)rintf(a[q][j].z * inv), b3 = (int)rintf(a[q][j].w * inv);
                qa[j] = (unsigned)(b0 & 255) | ((unsigned)(b1 & 255) << 8) | ((unsigned)(b2 & 255) << 16) | ((unsigned)(b3 & 255) << 24);
                int p = __builtin_amdgcn_cvt_pk_fp8_f32(u[q][j].x * 16.0f, u[q][j].y * 16.0f, 0, false);
                p = __builtin_amdgcn_cvt_pk_fp8_f32(u[q][j].z * 16.0f, u[q][j].w * 16.0f, p, true);
                qu[j] = (unsigned)p;
            }
            *(v4u*)(EDq + (size_t)(row0 + q) * D + 16 * lane) = qa;
            *(v4u*)(EUq + (size_t)(row0 + q) * D + 16 * lane) = qu;
            if (lane == 0) EDS[row0 + q] = sc;
        }
    }
}
__device__ __forceinline__ void p0_prologue(Frame& F) {
    const float* c = ((const float*)karg(1)); const float* w_ada = ((const float*)karg(4)); const float* b_ada = ((const float*)karg(5));
    float* MOD = (float*)(((unsigned char*)karg(19)) + WS_MOD);
    {
        LAS float* cact = (LAS float*)(F.lds);
        LAS float* part = (LAS float*)(F.lds + 16384);
        bool did = false;
        for (int item = F.vcu; item < NMOD / 32; item += F.G) {
            if (!did) { for (int i = F.tid; i < 4096; i += NTHR) { const float cv = c[i]; cact[i] = cv / (1.0f + __expf(-cv)); } did = true; }
            __syncthreads();
            const int n0 = item * 32, col = n0 + (F.lane & 31), ksub = F.lane >> 5;
            float a0 = 0.f, a1 = 0.f, a2 = 0.f, a3 = 0.f;
#pragma unroll 16
            for (int it = 0; it < 64; ++it) { const int k = (it * 8 + F.wave) * 2 + ksub; const float w = w_ada[(size_t)k * NMOD + col];
                a0 += cact[k] * w; a1 += cact[1024 + k] * w; a2 += cact[2048 + k] * w; a3 += cact[3072 + k] * w; }
            a0 += __shfl_xor(a0, 32); a1 += __shfl_xor(a1, 32); a2 += __shfl_xor(a2, 32); a3 += __shfl_xor(a3, 32);
            if (F.lane < 32) { part[(F.wave * 4 + 0) * 32 + F.lane] = a0; part[(F.wave * 4 + 1) * 32 + F.lane] = a1; part[(F.wave * 4 + 2) * 32 + F.lane] = a2; part[(F.wave * 4 + 3) * 32 + F.lane] = a3; }
            __syncthreads();
            if (F.tid < 128) { const int b = F.tid >> 5, cl = F.tid & 31; float s = 0.f;
#pragma unroll
                for (int w = 0; w < 8; ++w) s += part[(w * 4 + b) * 32 + cl];
                MOD[b * NMOD + n0 + cl] = s + b_ada[n0 + cl]; }
            __syncthreads();
        }
    }
    {
        const int gw = F.vcu * NWAVES + F.wave, NGW = F.G * NWAVES;
        p0_convert(((const float*)karg(14)), (bf16*)(((unsigned char*)karg(19)) + WS_SUBK), (long)(8 * 2 * 128 * 64) / 512, gw, NGW, F.lane);
    }
}
__device__ __forceinline__ void p0_transposes(Frame& F) {
    LAS float* scr = (LAS float*)(F.lds + 32768 + F.wave * 8704);
    const int gw = F.vcu * NWAVES + F.wave, NGW = F.G * NWAVES;
    constexpr int I_IN1 = (D / 64) * (2304 / 32), I_IN2 = (D / 64) * (2048 / 32), I_AB = (512 / 64) * (D / 32), I_SQ = (D / 64) * (D / 32);
    constexpr int NITEMS = I_IN1 + I_IN2 + 2 * I_AB + 2 * I_SQ;
    bf16* Win_t = (bf16*)(((unsigned char*)karg(19)) + WS_WIN);
    for (int it = gw; it < NITEMS; it += NGW) {
        int r = it;
        if (r < I_IN1) { p0_transpose_item(((const float*)karg(6)), LDW_IN, D, 2304, Win_t, 0, scr, r, F.lane); continue; } r -= I_IN1;
        if (r < I_IN2) { p0_transpose_item(((const float*)karg(6)) + 2312, LDW_IN, D, 2048, Win_t, 2304, scr, r, F.lane); continue; } r -= I_IN2;
        if (r < I_AB) { p0_transpose_item(((const float*)karg(9)), D, 512, D, (bf16*)(((unsigned char*)karg(19)) + WS_WA), 0, scr, r, F.lane); continue; } r -= I_AB;
        if (r < I_AB) { p0_transpose_item(((const float*)karg(10)), D, 512, D, (bf16*)(((unsigned char*)karg(19)) + WS_WB), 0, scr, r, F.lane); continue; } r -= I_AB;
        if (r < I_SQ) { p0_transpose_item(((const float*)karg(11)), D, D, D, (bf16*)(((unsigned char*)karg(19)) + WS_WOUT), 0, scr, r, F.lane); continue; } r -= I_SQ;
        p0_transpose_item(((const float*)karg(13)), D, D, D, (bf16*)(((unsigned char*)karg(19)) + WS_WQ), 0, scr, r, F.lane);
    }
}

__device__ __forceinline__ void p1_norm(Frame& F) {
    const float* x = ((const float*)karg(0)); const float* g1 = ((const float*)karg(2)); const float* w_in = ((const float*)karg(6)); const float* b_forget = ((const float*)karg(7));
    const float* MOD = (const float*)(((unsigned char*)karg(19)) + WS_MOD); bf16* H = (bf16*)(((unsigned char*)karg(19)) + WS_H); float* LOGF = (float*)(((unsigned char*)karg(19)) + WS_LOGF);
    LAS float* wfl = (LAS float*)(F.lds);
    { float tmp[16];
#pragma unroll
      for (int n = 0; n < 16; ++n) { const int i = F.tid + n * NTHR; tmp[n] = w_in[(size_t)(i >> 3) * LDW_IN + 2304 + (i & 7)]; }
#pragma unroll
      for (int n = 0; n < 16; ++n) { const int i = F.tid + n * NTHR; wfl[(i & 7) * 1024 + (i >> 3)] = tmp[n]; } }
    __syncthreads();
    const int gw = F.vcu * NWAVES + F.wave, NGW = F.G * NWAVES;
    f32x4 cur[4], nxt[4];
    if (gw < M) { const f32x4* xr = (const f32x4*)(x + (size_t)gw * D) + F.lane;
#pragma unroll
        for (int j = 0; j < 4; ++j) cur[j] = xr[64 * j]; }
    for (int row = gw; row < M; row += NGW) {
        { const int nrow = row + NGW; if (nrow < M) { const f32x4* xr = (const f32x4*)(x + (size_t)nrow * D) + F.lane;
#pragma unroll
            for (int j = 0; j < 4; ++j) nxt[j] = xr[64 * j]; } }
        {{
        float ss = 0.f;
#pragma unroll
        for (int j = 0; j < 4; ++j) ss += (cur[j].x * cur[j].x + cur[j].y * cur[j].y) + (cur[j].z * cur[j].z + cur[j].w * cur[j].w);
        ss = wave_sum(ss);
        const float rstd = 1.0f / sqrtf(ss * (1.0f / D) + EPS);
        const int b = row >> 12; const float* mb = MOD + b * NMOD;
        float fl[8];
#pragma unroll
        for (int jj = 0; jj < 8; ++jj) fl[jj] = 0.f;
#pragma unroll
        for (int j = 0; j < 4; ++j) { const int col = 4 * F.lane + 256 * j;
            const f32x4 g = *(const f32x4*)(g1 + col), sh = *(const f32x4*)(mb + col), sc = *(const f32x4*)(mb + 1024 + col);
            const f32x4 hv = (cur[j] * rstd) * g * (sc + 1.0f) + sh;
            u32x2 w; w.x = cvtpk(hv.x, hv.y); w.y = cvtpk(hv.z, hv.w);
            *(u32x2*)(H + (size_t)row * D + col) = w;
#pragma unroll
            for (int jj = 0; jj < 8; ++jj) { const f32x4 wv = *(const LAS f32x4*)(wfl + jj * 1024 + col); fl[jj] += (hv.x * wv.x + hv.y * wv.y) + (hv.z * wv.z + hv.w * wv.w); }
        }
        const int lane = F.lane; const bool b5 = (lane & 32) != 0, b4 = (lane & 16) != 0, b3 = (lane & 8) != 0;
        float r4[4];
#pragma unroll
        for (int u = 0; u < 4; ++u) { const float keep = b5 ? fl[u + 4] : fl[u], send = b5 ? fl[u] : fl[u + 4]; r4[u] = keep + __shfl_xor(send, 32); }
        float r2[2];
#pragma unroll
        for (int u = 0; u < 2; ++u) { const float keep = b4 ? r4[u + 2] : r4[u], send = b4 ? r4[u] : r4[u + 2]; r2[u] = keep + __shfl_xor(send, 16); }
        float r1; { const float keep = b3 ? r2[1] : r2[0], send = b3 ? r2[0] : r2[1]; r1 = keep + __shfl_xor(send, 8); }
        r1 += __shfl_xor(r1, 4); r1 += __shfl_xor(r1, 2); r1 += __shfl_xor(r1, 1);
        if ((lane & 7) == 0) { const int jj = lane >> 3; const float z = r1 + b_forget[jj]; const float ls = fminf(z, 0.f) - log1pf(__expf(-fabsf(z))); LOGF[(size_t)row * 8 + jj] = ls; }
        }}
#pragma unroll
        for (int j = 0; j < 4; ++j) cur[j] = nxt[j];
    }
}

constexpr int KP = 72;
constexpr int VPF = 68;
constexpr int VPS = 260;
struct FlashState { f32x16 o[2]; float m, l; };

__device__ __forceinline__ void flash_tail(FlashState& st, f32x16& s0, f32x16& s1, const LAS bf16* Vs, int vp, int r32, int hi) {
    float mt = s0[0];
#pragma unroll
    for (int r = 1; r < 16; ++r) mt = fmaxf(mt, s0[r]);
#pragma unroll
    for (int r = 0; r < 16; ++r) mt = fmaxf(mt, s1[r]);
    mt = fmaxf(mt, __shfl_xor(mt, 32));
    const float mn = fmaxf(st.m, mt);
    const float alpha = __expf(st.m - mn);
    st.m = mn;
    float ps = 0.f;
#pragma unroll
    for (int r = 0; r < 16; ++r) { s0[r] = __expf(s0[r] - mn); ps += s0[r]; }
#pragma unroll
    for (int r = 0; r < 16; ++r) { s1[r] = __expf(s1[r] - mn); ps += s1[r]; }
    st.l = st.l * alpha + ps;
    if (__any(alpha != 1.0f)) {
#pragma unroll
        for (int r = 0; r < 16; ++r) { st.o[0][r] *= alpha; st.o[1][r] *= alpha; }
    }
#pragma unroll
    for (int blk = 0; blk < 2; ++blk)
#pragma unroll
        for (int s = 0; s < 2; ++s) {
            v4u pw;
            if (blk == 0) { pw.x = cvtpk(s0[8 * s + 0], s0[8 * s + 1]); pw.y = cvtpk(s0[8 * s + 2], s0[8 * s + 3]); pw.z = cvtpk(s0[8 * s + 4], s0[8 * s + 5]); pw.w = cvtpk(s0[8 * s + 6], s0[8 * s + 7]); }
            else          { pw.x = cvtpk(s1[8 * s + 0], s1[8 * s + 1]); pw.y = cvtpk(s1[8 * s + 2], s1[8 * s + 3]); pw.z = cvtpk(s1[8 * s + 4], s1[8 * s + 5]); pw.w = cvtpk(s1[8 * s + 6], s1[8 * s + 7]); }
            const bf16x8 pf = __builtin_bit_cast(bf16x8, pw);
#pragma unroll
            for (int db = 0; db < 2; ++db) {
                const LAS bf16* vp0 = Vs + (32 * db + r32) * vp + 32 * blk + 16 * s + 4 * hi;
                const s16x4 lo = *(const LAS s16x4*)vp0, hh = *(const LAS s16x4*)(vp0 + 8);
                const bf16x8 vf = __builtin_shufflevector(lo, hh, 0, 1, 2, 3, 4, 5, 6, 7);
                st.o[db] = MFMA32(vf, pf, st.o[db]);
            }
        }
}
__device__ __forceinline__ void flash_qk(f32x16& s0, f32x16& s1, const bf16x8 (&qf)[4], const LAS bf16* Ks, int r32, int hi) {
    s0 = (f32x16){0.f}; s1 = (f32x16){0.f};
#pragma unroll
    for (int r = 0; r < 16; ++r) { s0[r] = 0.f; s1[r] = 0.f; }
#pragma unroll
    for (int ks = 0; ks < 4; ++ks) {
        const bf16x8 a0 = *(const LAS bf16x8*)(Ks + r32 * KP + 16 * ks + 8 * hi);
        const bf16x8 a1 = *(const LAS bf16x8*)(Ks + (32 + r32) * KP + 16 * ks + 8 * hi);
        s0 = MFMA32(a0, qf[ks], s0); s1 = MFMA32(a1, qf[ks], s1);
    }
}
__device__ __forceinline__ void flash_store(const FlashState& st, bf16* orow, int hi) {
    float lt = st.l + __shfl_xor(st.l, 32);
    const float inv = 1.0f / lt;
#pragma unroll
    for (int db = 0; db < 2; ++db)
#pragma unroll
        for (int rg = 0; rg < 4; ++rg) { u32x2 w; w.x = cvtpk(st.o[db][4 * rg] * inv, st.o[db][4 * rg + 1] * inv); w.y = cvtpk(st.o[db][4 * rg + 2] * inv, st.o[db][4 * rg + 3] * inv);
            *(u32x2*)(orow + 32 * db + 8 * rg + 4 * hi) = w; }
}

__device__ __forceinline__ void fox_unit(Frame& F, int b, int h, int qb, float& kmax2) {
    const bf16* proj = (const bf16*)(((unsigned char*)karg(19)) + WS_PROJ); const float* LOGF = (const float*)(((unsigned char*)karg(19)) + WS_LOGF); bf16* OB = (bf16*)(((unsigned char*)karg(19)) + WS_OB);
    LAS float* Fs = (LAS float*)(F.lds);
    LAS float* wtot = (LAS float*)(F.lds + 16384);
    LAS bf16* Kb = (LAS bf16*)(F.lds + 16384 + 128);
    LAS bf16* Vb = (LAS bf16*)(F.lds + 16384 + 128 + 2 * 64 * KP * 2);
    const int lane = F.lane, wave = F.wave, tid = F.tid, r32 = lane & 31, hi = lane >> 5;
    const int q_end = 256 * (qb + 1), NT = q_end / 64;
    const size_t rowbase = (size_t)b * SEQ;
    {
        float v[8]; float run = 0.f;
#pragma unroll
        for (int i = 0; i < 8; ++i) { const int pos = tid * 8 + i; const float lf = (pos < q_end) ? LOGF[(rowbase + pos) * 8 + h] : 0.f; run += lf; v[i] = run; }
        float inc = run;
#pragma unroll
        for (int o = 1; o < 64; o <<= 1) { const float t = __shfl_up(inc, o); if (lane >= o) inc += t; }
        if (lane == 63) wtot[wave] = inc;
        __syncthreads();
        float off = inc - run;
        for (int w = 0; w < wave; ++w) off += wtot[w];
#pragma unroll
        for (int i = 0; i < 8; ++i) Fs[tid * 8 + i] = v[i] + off;
    }
    const int qrow = 256 * qb + 32 * wave + r32;
    bf16x8 qf[4];
    { const bf16* qp = proj + (rowbase + qrow) * NPROJ + C_QB + 64 * h + 8 * hi;
#pragma unroll
      for (int ks = 0; ks < 4; ++ks) qf[ks] = *(const bf16x8*)(qp + 16 * ks); }
    const int tq = 4 * qb + (wave >> 1);
    {
        float qn = 0.f;
#pragma unroll
        for (int ks = 0; ks < 4; ++ks)
#pragma unroll
            for (int j = 0; j < 8; ++j) { const float e = __uint_as_float(((unsigned)(unsigned short)qf[ks][j]) << 16); qn += e * e; }
        qn += __shfl_xor(qn, 32);
#pragma unroll
        for (int o = 1; o < 32; o <<= 1) qn = fmaxf(qn, __shfl_xor(qn, o));
        float kn = 0.f;
        if (kmax2 < 0.f) {
            for (int p0 = 0; p0 < q_end; p0 += 4 * 64) {
                v4u w4[4];
#pragma unroll
                for (int i = 0; i < 4; ++i) w4[i] = *(const v4u*)(proj + (rowbase + p0 + 64 * i + (tid >> 3)) * NPROJ + C_KB + 64 * h + 8 * (tid & 7));
#pragma unroll
                for (int i = 0; i < 4; ++i) { const unsigned wx = w4[i].x, wy = w4[i].y, wz = w4[i].z, ww = w4[i].w;
                    float s = bflo(wx) * bflo(wx) + bfhi(wx) * bfhi(wx) + bflo(wy) * bflo(wy) + bfhi(wy) * bfhi(wy) + bflo(wz) * bflo(wz) + bfhi(wz) * bfhi(wz) + bflo(ww) * bflo(ww) + bfhi(ww) * bfhi(ww);
                    s += __shfl_xor(s, 1); s += __shfl_xor(s, 2); s += __shfl_xor(s, 4);
                    kn = fmaxf(kn, s); } }
#pragma unroll
            for (int o = 1; o < 64; o <<= 1) kn = fmaxf(kn, __shfl_xor(kn, o));
        }
        if (lane == 0) { wtot[8 + wave] = qn; wtot[16 + wave] = kn; }
    }
    FlashState st; st.m = -INFINITY; st.l = 0.f;
#pragma unroll
    for (int r = 0; r < 16; ++r) { st.o[0][r] = 0.f; st.o[1][r] = 0.f; }
    const int srow = tid >> 3, sch = tid & 7;
    const bf16* kg = proj + (rowbase + srow) * NPROJ + C_KB + 64 * h + 8 * sch;
    const bf16* vg = proj + (rowbase + srow) * NPROJ + C_VB + 64 * h + 8 * sch;
    v4u kreg, vreg;
    { const size_t o = (size_t)(NT - 1) * 64 * NPROJ; kreg = *(const v4u*)(kg + o); vreg = *(const v4u*)(vg + o); }
    int cur = 0;
    {   *(LAS v4u*)(Kb + srow * KP + 8 * sch) = kreg;
        const unsigned short* vs = (const unsigned short*)&vreg;
#pragma unroll
        for (int i = 0; i < 8; ++i) Vb[(8 * sch + i) * VPF + srow] = vs[i];
    }
    __syncthreads();
    const float fq = Fs[qrow];
    int t_lo = 0;
    {
        float qm = 0.f, km = 0.f;
#pragma unroll
        for (int w = 0; w < 8; ++w) { qm = fmaxf(qm, wtot[8 + w]); km = fmaxf(km, wtot[16 + w]); }
        if (kmax2 < 0.f) kmax2 = km;
        const float A = 0.125f * sqrtf(qm) * sqrtf(kmax2) * 1.01f, f0 = Fs[256 * qb];
        for (int t = NT - 5; t >= 0; --t) if (Fs[64 * t + 63] - f0 > 2.0f * A + 60.0f) { t_lo = t + 1; break; }
    }
    for (int t = NT - 1; t >= t_lo; --t) {
        if (t > t_lo) { const size_t o = (size_t)(t - 1) * 64 * NPROJ; kreg = *(const v4u*)(kg + o); vreg = *(const v4u*)(vg + o); }
        if (t <= tq) {
            const LAS bf16* Ks = Kb + cur * 64 * KP; const LAS bf16* Vs = Vb + cur * 64 * VPF;
            f32x16 s0, s1; flash_qk(s0, s1, qf, Ks, r32, hi);
            const LAS float* Fk = Fs + 64 * t;
            const bool diag = (t == tq);
#pragma unroll
            for (int rg = 0; rg < 4; ++rg) {
                const f32x4 f0 = *(const LAS f32x4*)(Fk + 8 * rg + 4 * hi), f1 = *(const LAS f32x4*)(Fk + 32 + 8 * rg + 4 * hi);
#pragma unroll
                for (int i = 0; i < 4; ++i) { const int r = 4 * rg + i; const int kv = 64 * t + 8 * rg + 4 * hi + i;
                    float a = s0[r] * 0.125f + (fq - f0[i]); float c = s1[r] * 0.125f + (fq - f1[i]);
                    if (diag) { if (kv > qrow) a = -INFINITY; if (kv + 32 > qrow) c = -INFINITY; }
                    s0[r] = a; s1[r] = c; }
            }
            flash_tail(st, s0, s1, Vs, VPF, r32, hi);
        }
        if (t > t_lo) {
            const int nb = cur ^ 1;
            *(LAS v4u*)(Kb + nb * 64 * KP + srow * KP + 8 * sch) = kreg;
            const unsigned short* vs = (const unsigned short*)&vreg;
#pragma unroll
            for (int i = 0; i < 8; ++i) Vb[nb * 64 * VPF + (8 * sch + i) * VPF + srow] = vs[i];
        }
        __syncthreads();
        cur ^= 1;
    }
    flash_store(st, OB + (rowbase + qrow) * 512 + 64 * h, hi);
    __syncthreads();
}

__device__ const unsigned char T5_BUCKET[128] = {0,1,2,3,4,5,6,7,8,9,10,11,12,13,14,15,16,16,16,17,17,18,18,18,19,19,19,20,20,20,20,21,21,21,21,22,22,22,22,22,23,23,23,23,23,23,24,24,24,24,24,24,25,25,25,25,25,25,25,26,26,26,26,26,26,26,26,27,27,27,27,27,27,27,27,27,27,28,28,28,28,28,28,28,28,28,28,29,29,29,29,29,29,29,29,29,29,29,29,30,30,30,30,30,30,30,30,30,30,30,30,30,30,31,31,31,31,31,31,31,31,31,31,31,31,31,31,31};

__device__ __forceinline__ void swa_unit(Frame& F, int b, int kvh, int n) {
    const bf16* proj = (const bf16*)(((unsigned char*)karg(19)) + WS_PROJ); bf16* OA = (bf16*)(((unsigned char*)karg(19)) + WS_OA);
    const float* sinks = ((const float*)karg(8)); const float* rel_bias = ((const float*)karg(12));
    LAS bf16* Kb = (LAS bf16*)(F.lds);
    LAS bf16* Vb = (LAS bf16*)(F.lds + 36864);
    LAS float* bt = (LAS float*)(F.lds + 36864 + 33280);
    const int lane = F.lane, wave = F.wave, tid = F.tid, r32 = lane & 31, hi = lane >> 5;
    const size_t rowbase = (size_t)b * SEQ;
    {
        const int g = tid >> 7, d = tid & 127;
        bt[tid] = rel_bias[(int)T5_BUCKET[d] * 8 + kvh * 4 + g];
#pragma unroll
        for (int i = 0; i < 4; ++i) {
            const int idx = tid + i * NTHR, kb = idx >> 3, sch = idx & 7; const int pos = 128 * (n - 1) + kb;
            v4u kreg = (v4u){0u, 0u, 0u, 0u}, vreg = (v4u){0u, 0u, 0u, 0u};
            if (pos >= 0) { const bf16* p = proj + (rowbase + pos) * NPROJ + 64 * kvh + 8 * sch; kreg = *(const v4u*)(p + C_KA); vreg = *(const v4u*)(p + C_VA); }
            *(LAS v4u*)(Kb + kb * KP + 8 * sch) = kreg;
            const unsigned short* vs = (const unsigned short*)&vreg;
#pragma unroll
            for (int j = 0; j < 8; ++j) Vb[(8 * sch + j) * VPS + kb] = vs[j];
        }
    }
    __syncthreads();
    const int g = wave & 3, qh = wave >> 2, head = kvh * 4 + g;
    const LAS float* btg = bt + g * 128;
    for (int sb = 0; sb < 2; ++sb) {
        const int qrel0 = 64 * qh + 32 * sb, qrel = qrel0 + r32;
        const size_t row = rowbase + 128 * n + qrel;
        bf16x8 qf[4];
        { const bf16* qp = proj + row * NPROJ + C_QA + 64 * head + 8 * hi;
#pragma unroll
          for (int ks = 0; ks < 4; ++ks) qf[ks] = *(const bf16x8*)(qp + 16 * ks); }
        FlashState st; st.m = sinks[head]; st.l = (hi == 0) ? 1.0f : 0.0f;
#pragma unroll
        for (int r = 0; r < 16; ++r) { st.o[0][r] = 0.f; st.o[1][r] = 0.f; }
        const int t_lo = (qrel0 + 1) >> 6, t_hi = (qrel0 + 159) >> 6;
        for (int t = t_lo; t <= t_hi; ++t) {
            f32x16 s0, s1; flash_qk(s0, s1, qf, Kb + t * 64 * KP, r32, hi);
#pragma unroll
            for (int r = 0; r < 16; ++r) {
                const int kb0 = 64 * t + crow(r, hi), kb1 = kb0 + 32;
                const int d0 = 128 + qrel - kb0, d1 = d0 - 32;
                const bool v0 = (d0 >= 0) && (d0 < 128) && (n > 0 || kb0 >= 128);
                const bool v1 = (d1 >= 0) && (d1 < 128) && (n > 0 || kb1 >= 128);
                const float b0 = btg[d0 & 127], b1 = btg[d1 & 127];
                s0[r] = v0 ? (s0[r] * 0.125f + b0) : -INFINITY;
                s1[r] = v1 ? (s1[r] * 0.125f + b1) : -INFINITY;
            }
            flash_tail(st, s0, s1, Vb + 64 * t, VPS, r32, hi);
        }
        flash_store(st, OA + row * 512 + 64 * head, hi);
    }
    __syncthreads();
}
__device__ __forceinline__ void p3_attention(Frame& F) {
    for (int item = F.vcu; item < 256; item += F.G) {
        swa_unit(F, item >> 6, (item >> 5) & 1, item & 31);
        const int bh = item >> 3, j = item & 7;
        float kmax2 = -1.0f;
        fox_unit(F, bh >> 3, bh & 7, 15 - j, kmax2);
        fox_unit(F, bh >> 3, bh & 7, j, kmax2);
    }
}

struct PairOrder {
    pg8::StaticOrder S;
    __device__ bool next(int i, pg8::Unit& u) const { if (!S.next(i >> 1, u)) return false; u.src = i & 1; return true; }
    __device__ __forceinline__ void a_ready(const pg8::Unit&) const {}
    __device__ __forceinline__ void done(const pg8::Unit&) const {}
};
__device__ __forceinline__ float sigmoidf_(float z) { return 1.0f / (1.0f + __expf(-z)); }
struct EpiGate {
    static constexpr bool PERM = true, AFTER_DRAIN = false, CHAIN = true;
    const bf16* proj; bf16* mixed;
    __device__ __forceinline__ void operator()(pg8::f32x4 (&acc)[2][2][4][2], const pg8::Unit& u, int wr, int wc, int fr, int fq) const {
#pragma unroll
        for (int ai = 0; ai < 2; ++ai)
#pragma unroll
            for (int m = 0; m < 4; ++m) { const size_t row = (size_t)u.pm * 256 + ai * 128 + wr * 64 + m * 16 + fr;
#pragma unroll
                for (int bj = 0; bj < 2; ++bj) { const int col0 = u.pn * 256 + bj * 128 + wc * 32 + 8 * fq;
                    const v4u gb = *(const v4u*)(proj + row * NPROJ + C_GLB + col0);
                    const unsigned gbw[4] = {gb.x, gb.y, gb.z, gb.w};
                    if (u.src == 0) {
                        const v4u ga = *(const v4u*)(proj + row * NPROJ + C_GLA + col0);
                        const unsigned gaw[4] = {ga.x, ga.y, ga.z, ga.w};
#pragma unroll
                        for (int e = 0; e < 8; ++e) { const float za = (e & 1) ? bfhi(gaw[e >> 1]) : bflo(gaw[e >> 1]), zb = (e & 1) ? bfhi(gbw[e >> 1]) : bflo(gbw[e >> 1]);
                            const float ratio = (1.0f + __expf(-zb)) * __builtin_amdgcn_rcpf(1.0f + __expf(-za));
                            acc[ai][bj][m][e >> 2][e & 3] *= ratio; }
                    } else {
                        float v[8];
#pragma unroll
                        for (int e = 0; e < 8; ++e) { const float zb = (e & 1) ? bfhi(gbw[e >> 1]) : bflo(gbw[e >> 1]); v[e] = acc[ai][bj][m][e >> 2][e & 3] * __builtin_amdgcn_rcpf(1.0f + __expf(-zb)); }
                        v4u w; w.x = cvtpk(v[0], v[1]); w.y = cvtpk(v[2], v[3]); w.z = cvtpk(v[4], v[5]); w.w = cvtpk(v[6], v[7]);
                        *(v4u*)(mixed + row * D + col0) = w;
                    }
                }
            }
    }
};
struct EpiRes {
    static constexpr bool PERM = true, AFTER_DRAIN = false, CHAIN = false;
    const float* x; const float* mod; float* x1;
    __device__ __forceinline__ void operator()(const pg8::f32x4 (&acc)[2][2][4][2], const pg8::Unit& u, int wr, int wc, int fr, int fq) const {
#pragma unroll
        for (int ai = 0; ai < 2; ++ai)
#pragma unroll
            for (int m = 0; m < 4; ++m) { const size_t row = (size_t)u.pm * 256 + ai * 128 + wr * 64 + m * 16 + fr; const int b = (int)(row >> 12);
#pragma unroll
                for (int bj = 0; bj < 2; ++bj) { const int col0 = u.pn * 256 + bj * 128 + wc * 32 + 8 * fq;
#pragma unroll
                    for (int n = 0; n < 2; ++n) { const int col = col0 + 4 * n;
                        const pg8::f32x4 xin = *(const pg8::f32x4*)(x + row * D + col), gt = *(const pg8::f32x4*)(mod + b * NMOD + 2048 + col);
                        *(pg8::f32x4*)(x1 + row * D + col) = xin + gt * acc[ai][bj][m][n]; } }
            }
    }
};

__device__ __forceinline__ void p6_norm2(Frame& F) {
    const float* x1 = (const float*)(((unsigned char*)karg(19)) + WS_X1); const float* g2 = ((const float*)karg(3)); const float* MOD = (const float*)(((unsigned char*)karg(19)) + WS_MOD); bf16* H2 = (bf16*)(((unsigned char*)karg(19)) + WS_H2); unsigned char* H2Q = (unsigned char*)(((unsigned char*)karg(19)) + WS_H2Q); float* H2S = (float*)(((unsigned char*)karg(19)) + WS_H2S);
    const int gw = F.vcu * NWAVES + F.wave, NGW = F.G * NWAVES;
    f32x4 cur[4], nxt[4];
    if (gw < M) { const f32x4* xr = (const f32x4*)(x1 + (size_t)gw * D) + F.lane;
#pragma unroll
        for (int j = 0; j < 4; ++j) cur[j] = xr[64 * j]; }
    for (int row = gw; row < M; row += NGW) {
        { const int nrow = row + NGW; if (nrow < M) { const f32x4* xr = (const f32x4*)(x1 + (size_t)nrow * D) + F.lane;
#pragma unroll
            for (int j = 0; j < 4; ++j) nxt[j] = xr[64 * j]; } }
        {
        f32x4 v[4], hq[4]; float ss = 0.f;
#pragma unroll
        for (int j = 0; j < 4; ++j) { v[j] = cur[j]; ss += (v[j].x * v[j].x + v[j].y * v[j].y) + (v[j].z * v[j].z + v[j].w * v[j].w); }
        ss = wave_sum(ss);
        const float rstd = 1.0f / sqrtf(ss * (1.0f / D) + EPS);
        const int b = row >> 12; const float* mb = MOD + b * NMOD;
#pragma unroll
        for (int j = 0; j < 4; ++j) { const int col = 4 * F.lane + 256 * j;
            const f32x4 g = *(const f32x4*)(g2 + col), sh = *(const f32x4*)(mb + 3072 + col), sc = *(const f32x4*)(mb + 4096 + col);
            const f32x4 hv = (v[j] * rstd) * g * (sc + 1.0f) + sh;
            u32x2 w; w.x = cvtpk(hv.x, hv.y); w.y = cvtpk(hv.z, hv.w);
            *(u32x2*)(H2 + (size_t)row * D + col) = w; hq[j] = hv; }
        float am = 0.f;
#pragma unroll
        for (int j = 0; j < 4; ++j) am = fmaxf(fmaxf(am, fmaxf(fabsf(hq[j].x), fabsf(hq[j].y))), fmaxf(fabsf(hq[j].z), fabsf(hq[j].w)));
#pragma unroll
        for (int o = 1; o < 64; o <<= 1) am = fmaxf(am, __shfl_xor(am, o));
        const float sc = am > 0.f ? am * (1.0f / 127.0f) : 1.0f, inv = 1.0f / sc;
        v4u qa;
#pragma unroll
        for (int j = 0; j < 4; ++j) { const int b0 = (int)rintf(hq[j].x * inv), b1 = (int)rintf(hq[j].y * inv), b2 = (int)rintf(hq[j].z * inv), b3 = (int)rintf(hq[j].w * inv);
            qa[j] = (unsigned)(b0 & 255) | ((unsigned)(b1 & 255) << 8) | ((unsigned)(b2 & 255) << 16) | ((unsigned)(b3 & 255) << 24); }
        *(v4u*)(H2Q + (size_t)row * D + 16 * F.lane) = qa;
        if (F.lane == 0) H2S[row] = sc;
        }
#pragma unroll
        for (int j = 0; j < 4; ++j) cur[j] = nxt[j];
    }
}

__device__ __forceinline__ unsigned f2ord(float f) { const unsigned u = __float_as_uint(f); return u ^ ((unsigned)((int)u >> 31) | 0x80000000u); }
__device__ __forceinline__ float ord2f(unsigned o) { const unsigned u = (o & 0x80000000u) ? (o & 0x7fffffffu) : ~o; return __uint_as_float(u); }
#define CE_DESC(a, b) do { const unsigned _x = (a), _y = (b); (a) = _x > _y ? _x : _y; (b) = _x > _y ? _y : _x; } while (0)
__device__ __forceinline__ void sort16(unsigned (&k)[16]) {
#pragma unroll
    for (int size = 2; size <= 16; size <<= 1)
#pragma unroll
        for (int stride = size >> 1; stride > 0; stride >>= 1)
#pragma unroll
            for (int i = 0; i < 16; ++i) { const int j = i ^ stride; if (j > i) { if ((i & size) == 0) CE_DESC(k[i], k[j]); else CE_DESC(k[j], k[i]); } }
}
__device__ __forceinline__ void merge16(unsigned (&a)[16], const unsigned (&b)[16]) {
#pragma unroll
    for (int i = 0; i < 16; ++i) a[i] = a[i] > b[15 - i] ? a[i] : b[15 - i];
#pragma unroll
    for (int stride = 8; stride > 0; stride >>= 1)
#pragma unroll
        for (int i = 0; i < 16; ++i) { const int j = i ^ stride; if (j > i) CE_DESC(a[i], a[j]); }
}
__device__ __forceinline__ void top16_of_64(unsigned (&g0)[16], unsigned (&g1)[16], unsigned (&g2)[16], unsigned (&g3)[16]) {
    sort16(g0); sort16(g1); sort16(g2); sort16(g3);
    merge16(g0, g1); merge16(g2, g3); merge16(g0, g2);
}
constexpr int NCAND = 50;
__device__ __forceinline__ void p8a_topk(Frame& F) {
    const bf16* QP = (const bf16*)(((unsigned char*)karg(19)) + WS_QP); const bf16* SUBK = (const bf16*)(((unsigned char*)karg(19)) + WS_SUBK);
    unsigned short* PIDX = (unsigned short*)(((unsigned char*)karg(19)) + WS_PIDX); float* PG = (float*)(((unsigned char*)karg(19)) + WS_PG);
    LAS unsigned short* Elds = (LAS unsigned short*)(F.lds) + F.wave * (NCAND * 64);
    const int lane = F.lane, r32 = lane & 31, hi = lane >> 5;
    const int gw = F.vcu * NWAVES + F.wave, NGW = F.G * NWAVES;
    for (int it2 = 0; it2 < 2 * ((M / 64 - F.vcu + F.G - 1) / F.G); ++it2) {
        const int wi = F.vcu + (it2 >> 1) * F.G;
        const int tile = 2 * wi + (it2 & 1);
        const int tok = tile * 32 + r32;
        { const int h = F.wave;
            unsigned top[2][16];
#pragma unroll
            for (int p = 0; p < 2; ++p) {
                bf16x8 qf[4];
                { const bf16* qp = QP + (size_t)tok * D + h * 128 + p * 64 + 8 * hi;
#pragma unroll
                  for (int ks = 0; ks < 4; ++ks) qf[ks] = *(const bf16x8*)(qp + 16 * ks); }
                const bf16* kp = SUBK + (size_t)((h * 2 + p) * 128 + r32) * 64 + 8 * hi;
                unsigned kk[4][16];
#pragma unroll
                for (int blk = 0; blk < 4; ++blk) {
                    f32x16 acc;
#pragma unroll
                    for (int r = 0; r < 16; ++r) acc[r] = 0.f;
#pragma unroll
                    for (int ks = 0; ks < 4; ++ks) { const bf16x8 a = *(const bf16x8*)(kp + (size_t)blk * 32 * 64 + 16 * ks); acc = MFMA32(a, qf[ks], acc); }
#pragma unroll
                    for (int r = 0; r < 16; ++r) { const int key = 32 * blk + crow(r, hi); kk[blk][r] = (f2ord(acc[r]) & ~127u) | (unsigned)(127 - key); }
                }
                top16_of_64(kk[0], kk[1], kk[2], kk[3]);
                unsigned other[16];
#pragma unroll
                for (int i = 0; i < 16; ++i) other[i] = (unsigned)__shfl_xor((int)kk[0][i], 32);
                merge16(kk[0], other);
#pragma unroll
                for (int i = 0; i < 16; ++i) top[p][i] = kk[0][i];
            }
            float s1[16], s2[16]; unsigned i1[16], i2[16];
#pragma unroll
            for (int i = 0; i < 16; ++i) { s1[i] = ord2f(top[0][i] & ~127u); i1[i] = 127u - (top[0][i] & 127u); s2[i] = ord2f(top[1][i] & ~127u); i2[i] = 127u - (top[1][i] & 127u); }
            unsigned ck[4][16];
#pragma unroll
            for (int c = 0; c < 64; ++c) {
                if (c < NCAND) { constexpr int CA[NCAND] = {0,0,0,0,0,0,0,0,0,0,0,0,0,0,0,0,1,1,1,1,1,1,1,1,2,2,2,2,2,3,3,3,3,4,4,4,5,5,6,6,7,7,8,9,10,11,12,13,14,15}; constexpr int CB[NCAND] = {0,1,2,3,4,5,6,7,8,9,10,11,12,13,14,15,0,1,2,3,4,5,6,7,0,1,2,3,4,0,1,2,3,0,1,2,0,1,0,1,0,1,0,0,0,0,0,0,0,0}; const int a = CA[c], b = CB[c];
                    ck[c >> 4][c & 15] = (f2ord(s1[a] + s2[b]) & ~63u) | (unsigned)(63 - c);
                    Elds[c * 64 + lane] = (unsigned short)(i1[a] * 128u + i2[b]); }
                else ck[c >> 4][c & 15] = 0u;
            }
            top16_of_64(ck[0], ck[1], ck[2], ck[3]);
            float w[16]; float wsum = 0.f; const float v0 = ord2f(ck[0][0] & ~63u);
#pragma unroll
            for (int r = 0; r < 16; ++r) { w[r] = __expf(ord2f(ck[0][r] & ~63u) - v0); wsum += w[r]; }
            const float winv = 1.0f / wsum;
#pragma unroll
            for (int r = 0; r < 16; ++r) if ((r >> 3) == hi) {
                const int c = 63 - (int)(ck[0][r] & 63u);
                const unsigned short eid = Elds[c * 64 + lane];
                PIDX[(size_t)tok * 128 + h * 16 + r] = eid; PG[(size_t)tok * 128 + h * 16 + r] = w[r] * winv; }
        }
    }
}

__device__ __forceinline__ float gelu_erf(float v) { return 0.5f * v * (1.0f + erff(v * 0.70710678118654752f)); }

#define PROBE_REPA 1
#define PROBE_REPB 1
constexpr int NR = 16, RSH = 17, BSA = 8, BSB = 4, ELP = 136, TPS = 8;
__device__ __forceinline__ void sort128(unsigned& e0, unsigned& e1, int lane) {
#pragma unroll
    for (int size = 2; size <= 128; size <<= 1) {
#pragma unroll
        for (int stride = size >> 1; stride > 0; stride >>= 1) {
            if (stride == 64) { const unsigned lo = e0 < e1 ? e0 : e1, hi = e0 < e1 ? e1 : e0; e0 = lo; e1 = hi; }
            else {
                const bool lower = (lane & stride) == 0;
                const bool asc0 = (size == 128) ? true : (size == 64 ? true : ((lane & size) == 0));
                const bool asc1 = (size == 128) ? true : (size == 64 ? false : ((lane & size) == 0));
                const unsigned p0 = (unsigned)__shfl_xor((int)e0, stride), p1 = (unsigned)__shfl_xor((int)e1, stride);
                const unsigned mn0 = e0 < p0 ? e0 : p0, mx0 = e0 < p0 ? p0 : e0, mn1 = e1 < p1 ? e1 : p1, mx1 = e1 < p1 ? p1 : e1;
                e0 = (lower == asc0) ? mn0 : mx0; e1 = (lower == asc1) ? mn1 : mx1;
            }
        }
    }
}
template <int BS> __device__ __forceinline__ void sw_issue(v4u (&buf)[BS], const LAS unsigned* el, const unsigned char* tab, unsigned voff) {
#pragma unroll
    for (int i = 0; i < BS; ++i) { const unsigned off = (el[i] << 10) + voff;
        buf[i] = *(const v4u*)(tab + off); }
}
template <int BS> __device__ __forceinline__ void sw_proc_a(const v4u (&buf)[BS], const v4u& hq, LAS float* wl, int s, int n, int lane) {
    const int hx = (int)hq.x, hy = (int)hq.y, hz = (int)hq.z, hw = (int)hq.w;
    float dd[8];
#pragma unroll
    for (int i = 0; i < 8; ++i) dd[i] = 0.f;
#pragma unroll
    for (int i = 0; i < BS; ++i) if (i < n) { const int dx = (int)buf[i].x, dy = (int)buf[i].y, dz = (int)buf[i].z, dw = (int)buf[i].w;
        int t = __builtin_amdgcn_sdot4(hx, dx, 0, false); t = __builtin_amdgcn_sdot4(hy, dy, t, false); t = __builtin_amdgcn_sdot4(hz, dz, t, false); t = __builtin_amdgcn_sdot4(hw, dw, t, false);
        dd[i] = (float)t; }
    const bool b5 = (lane & 32) != 0, b4 = (lane & 16) != 0, b3 = (lane & 8) != 0;
    float r4[4];
#pragma unroll
    for (int u = 0; u < 4; ++u) { const float keep = b5 ? dd[u + 4] : dd[u], send = b5 ? dd[u] : dd[u + 4]; r4[u] = keep + __shfl_xor(send, 32); }
    float r2[2];
#pragma unroll
    for (int u = 0; u < 2; ++u) { const float keep = b4 ? r4[u + 2] : r4[u], send = b4 ? r4[u] : r4[u + 2]; r2[u] = keep + __shfl_xor(send, 16); }
    float r1; { const float keep = b3 ? r2[1] : r2[0], send = b3 ? r2[0] : r2[1]; r1 = keep + __shfl_xor(send, 8); }
    r1 += __shfl_xor(r1, 4); r1 += __shfl_xor(r1, 2); r1 += __shfl_xor(r1, 1);
    if ((lane & 7) == 0 && (lane >> 3) < n) wl[s + (lane >> 3)] = r1;
}
template <int BS> __device__ __forceinline__ void sw_proc_b(const v4u (&buf)[BS], f32x2_t (&acc)[8], const LAS float* wl, int s, int n) {
#pragma unroll
    for (int i = 0; i < BS; ++i) if (i < n) {
        const float w = wl[s + i];
        const f32x2_t wv = {w, w};
        const unsigned ux = buf[i].x, uy = buf[i].y, uz = buf[i].z, uw = buf[i].w;
        acc[0] += wv * __builtin_amdgcn_cvt_pk_f32_fp8((int)ux, false); acc[1] += wv * __builtin_amdgcn_cvt_pk_f32_fp8((int)ux, true);
        acc[2] += wv * __builtin_amdgcn_cvt_pk_f32_fp8((int)uy, false); acc[3] += wv * __builtin_amdgcn_cvt_pk_f32_fp8((int)uy, true);
        acc[4] += wv * __builtin_amdgcn_cvt_pk_f32_fp8((int)uz, false); acc[5] += wv * __builtin_amdgcn_cvt_pk_f32_fp8((int)uz, true);
        acc[6] += wv * __builtin_amdgcn_cvt_pk_f32_fp8((int)uw, false); acc[7] += wv * __builtin_amdgcn_cvt_pk_f32_fp8((int)uw, true); }
}
__device__ __forceinline__ void sw_warm(v4u (&pf)[4], const unsigned char* tab, int range, int lw, unsigned voff) {
#pragma unroll
    for (int i = 0; i < 4; ++i) { const unsigned off = ((unsigned)(range * 1024 + lw * 4 + i) << 10) + voff; pf[i] = *(const v4u*)(tab + off); }
}
__device__ __forceinline__ void sw_warm_done(const v4u (&pf)[4]) {
#pragma unroll
    for (int i = 0; i < 4; ++i) asm volatile("" :: "v"(pf[i]));
}
template <int FAKE> __device__ __forceinline__ void p8b_sweep(Frame& F) {
    const float* X1 = (const float*)(((unsigned char*)karg(19)) + WS_X1); const float* MOD = (const float*)(((unsigned char*)karg(19)) + WS_MOD);
    const unsigned char* H2Q = (const unsigned char*)(((unsigned char*)karg(19)) + WS_H2Q); const float* H2S = (const float*)(((unsigned char*)karg(19)) + WS_H2S);
    const unsigned char* EDq = (const unsigned char*)(((unsigned char*)karg(19)) + WS_ED); const unsigned char* EUq = (const unsigned char*)(((unsigned char*)karg(19)) + WS_EU); const float* EDS = (const float*)(((unsigned char*)karg(19)) + WS_EDS);
    const unsigned short* PIDX = (const unsigned short*)(((unsigned char*)karg(19)) + WS_PIDX); const float* PG = (const float*)(((unsigned char*)karg(19)) + WS_PG);
    const float* fg = ((const float*)karg(17));
    const int gw = F.vcu * NWAVES + F.wave, NGW = F.G * NWAVES;
    for (int wi = F.vcu; wi < M / 64; wi += F.G) {
        const int tb = wi * 8 + F.wave;
        unsigned ones = ~0u; asm volatile("" : "+s"(ones));
        int lane = (int)__builtin_amdgcn_mbcnt_hi(ones, __builtin_amdgcn_mbcnt_lo(ones, 0u)); asm volatile("" : "+v"(lane));
        const int tok0 = tb * 8;
        unsigned E0[8], E1[8];
        LAS float* Wl = (LAS float*)(F.lds) + F.wave * 1024;
        LAS unsigned* El = (LAS unsigned*)(F.lds + 32768) + F.wave * (8 * ELP);
        unsigned voff = 16u * (unsigned)lane; asm volatile("" : "+v"(voff));
#pragma unroll
        for (int k = 0; k < 8; ++k) {
            const size_t base = (size_t)(tok0 + k) * 128;
            E0[k] = ((unsigned)PIDX[base + lane] << 7) | (unsigned)lane; E1[k] = ((unsigned)PIDX[base + 64 + lane] << 7) | (unsigned)(64 + lane);
            sort128(E0[k], E1[k], lane);
            if (FAKE) { E0[k] = (E0[k] & 0x1ffffu) ; E1[k] = (E1[k] & 0x1ffffu); sort128(E0[k], E1[k], lane); }
            El[k * ELP + lane] = E0[k] >> 7; El[k * ELP + 64 + lane] = E1[k] >> 7;
            if (lane < 8) El[k * ELP + 128 + lane] = (unsigned)__builtin_amdgcn_readlane((int)E1[k], 63) >> 7;
        }
        for (int repa = 0; repa < PROBE_REPA; ++repa) {
            v4u hq[8];
#pragma unroll
            for (int k = 0; k < 8; ++k) hq[k] = *(const v4u*)(H2Q + (size_t)(tok0 + k) * D + 16 * lane);
            int pos[8];
#pragma unroll
            for (int k = 0; k < 8; ++k) pos[k] = 0;
            v4u bA[BSA], bB[BSA]; int ps = 0, pn = 0;
            for (int r = 0; r < NR; ++r) {
#pragma unroll
                for (int k = 0; k < 8; ++k) {
                    constexpr int dummy = 0; (void)dummy;
                    const int kp = (k + 7) & 7;
                    const int c = __builtin_popcountll(__ballot((E0[k] >> RSH) == (unsigned)r)) + __builtin_popcountll(__ballot((E1[k] >> RSH) == (unsigned)r));
                    int s = __builtin_amdgcn_readfirstlane(pos[k]); const int e_end = __builtin_amdgcn_readfirstlane(s + c); pos[k] = e_end;
                    const int n1 = (e_end - s) < BSA ? (e_end - s) : BSA;
                    if (k & 1) sw_issue<BSA>(bB, El + k * ELP + s, EDq, voff); else sw_issue<BSA>(bA, El + k * ELP + s, EDq, voff);
                    if (pn > 0) { if (k & 1) sw_proc_a<BSA>(bA, hq[kp], Wl + kp * 128, ps, pn, lane); else sw_proc_a<BSA>(bB, hq[kp], Wl + kp * 128, ps, pn, lane); }
                    ps = s; pn = n1; s += n1;
                    for (; s < e_end; s += BSA) {
                        const int n = (e_end - s) < BSA ? (e_end - s) : BSA;
                        if (k & 1) { sw_issue<BSA>(bA, El + k * ELP + s, EDq, voff); sw_proc_a<BSA>(bA, hq[k], Wl + k * 128, s, n, lane); }
                        else       { sw_issue<BSA>(bB, El + k * ELP + s, EDq, voff); sw_proc_a<BSA>(bB, hq[k], Wl + k * 128, s, n, lane); }
                    }
                }
            }
            if (pn > 0) sw_proc_a<BSA>(bB, hq[7], Wl + 7 * 128, ps, pn, lane);
        }
#pragma unroll
        for (int k = 0; k < 8; ++k) { int tk = tok0 + k; asm volatile("" : "+s"(tk)); const size_t base = (size_t)tk * 128; const float sh = H2S[tk];
            const float r0 = Wl[k * 128 + lane], r1 = Wl[k * 128 + 64 + lane];
            Wl[k * 128 + lane] = PG[base + (E0[k] & 127u)] * gelu_erf(r0 * sh * EDS[E0[k] >> 7]) * 0.0625f;
            Wl[k * 128 + 64 + lane] = PG[base + (E1[k] & 127u)] * gelu_erf(r1 * sh * EDS[E1[k] >> 7]) * 0.0625f; }
        int ln = lane; asm volatile("" : "+v"(ln));
#pragma unroll
        for (int sub = 0; sub < 8 / TPS; ++sub) {
        f32x2_t acc[TPS][8];
        for (int repb = 0; repb < PROBE_REPB; ++repb) {
#pragma unroll
            for (int kk = 0; kk < TPS; ++kk)
#pragma unroll
                for (int i = 0; i < 8; ++i) acc[kk][i] = (f32x2_t){0.f, 0.f};
            int pos[TPS];
#pragma unroll
            for (int kk = 0; kk < TPS; ++kk) pos[kk] = 0;
            v4u bA[BSB], bB[BSB]; int ps = 0, pn = 0;
            for (int r = 0; r < NR; ++r) {
#pragma unroll
                for (int kk = 0; kk < TPS; ++kk) {
                    const int k = sub * TPS + kk, kkp = (kk + TPS - 1) % TPS, kp = sub * TPS + kkp;
                    const int c = __builtin_popcountll(__ballot((E0[k] >> RSH) == (unsigned)r)) + __builtin_popcountll(__ballot((E1[k] >> RSH) == (unsigned)r));
                    int s = __builtin_amdgcn_readfirstlane(pos[kk]); const int e_end = __builtin_amdgcn_readfirstlane(s + c); pos[kk] = e_end;
                    const int n1 = (e_end - s) < BSB ? (e_end - s) : BSB;
                    if (kk & 1) sw_issue<BSB>(bB, El + k * ELP + s, EUq, voff); else sw_issue<BSB>(bA, El + k * ELP + s, EUq, voff);
                    if (pn > 0) { if (kk & 1) sw_proc_b<BSB>(bA, acc[kkp], Wl + kp * 128, ps, pn); else sw_proc_b<BSB>(bB, acc[kkp], Wl + kp * 128, ps, pn); }
                    ps = s; pn = n1; s += n1;
                    for (; s < e_end; s += BSB) {
                        const int n = (e_end - s) < BSB ? (e_end - s) : BSB;
                        if (kk & 1) { sw_issue<BSB>(bA, El + k * ELP + s, EUq, voff); sw_proc_b<BSB>(bA, acc[kk], Wl + k * 128, s, n); }
                        else        { sw_issue<BSB>(bB, El + k * ELP + s, EUq, voff); sw_proc_b<BSB>(bB, acc[kk], Wl + k * 128, s, n); }
                    }
                }
            }
            if (pn > 0) sw_proc_b<BSB>(bB, acc[TPS - 1], Wl + (sub * TPS + TPS - 1) * 128, ps, pn);
        }
#pragma unroll
        for (int kk = 0; kk < TPS; ++kk) {
            const int tok = tok0 + sub * TPS + kk; const int b = tok >> 12; const float* gt2 = MOD + b * NMOD + 5120;
            f32x4 x2[4]; float ss = 0.f;
#pragma unroll
            for (int j = 0; j < 4; ++j) { const int col = 4 * ln + 256 * j;
                const f32x4 xv = *(const f32x4*)(X1 + (size_t)tok * D + col), gv4 = *(const f32x4*)(gt2 + col);
#pragma unroll
                for (int i = 0; i < 4; ++i) { const float v = xv[i] + gv4[i] * acc[kk][2 * j + (i >> 1)][i & 1]; x2[j][i] = v; ss += v * v; } }
            ss = wave_sum(ss);
            if (FAKE && ss != 12345.678f) continue;
            const float rstd = 1.0f / sqrtf(ss * (1.0f / D) + EPS);
#pragma unroll
            for (int j = 0; j < 4; ++j) { const int col = 4 * ln + 256 * j; const f32x4 gg = *(const f32x4*)(fg + col);
                *(f32x4*)(((float*)karg(18)) + (size_t)tok * D + col) = x2[j] * rstd * gg; }
        }
        }
    }
}

struct Args { const float* in[18]; float* out; unsigned char* ws; };
__global__ void __launch_bounds__(NTHR, 2) mega_fwd(Args args) {
    extern __shared__ __attribute__((aligned(16))) unsigned char lds[];
    Frame F;
    F.lds = (LAS unsigned char*)lds;
    F.tid = threadIdx.x; F.lane = F.tid & 63; F.wave = __builtin_amdgcn_readfirstlane(F.tid >> 6);
    F.G = gridDim.x; { const int bx = blockIdx.x; F.vcu = (F.G % 8 == 0) ? (bx % 8) * (F.G / 8) + bx / 8 : bx; }
    volatile LAS unsigned* MISC = (volatile LAS unsigned*)(F.lds + MISC_OFF);
    for (int u = F.tid; u < (LDS_BYTES - LDSCTL_OFF) / 4; u += NTHR) ((LAS unsigned*)(F.lds + LDSCTL_OFF))[u] = 0u;
    __syncthreads();
    gu32* ctl = (gu32*)(((unsigned char*)karg(19)) + WS_CTL);
    XcdBarrier bar = xcd_barrier_post((unsigned*)(ctl + CW_BAR), MISC + 8);
#define GRID_BAR() xcd_barrier(bar)
#define PROBE_TS -1
#define STAMP(i) do { if (PROBE_TS >= 0 && blockIdx.x == 0 && F.tid == 0) { const unsigned long long t_ = __builtin_amdgcn_s_memrealtime(); MISC[16 + 2 * (i)] = (unsigned)t_; MISC[17 + 2 * (i)] = (unsigned)(t_ >> 32); } } while (0)
#define PROBE_DBL -1

    STAMP(0);
    p0_prologue(F); GRID_BAR(); STAMP(1);
    if (PROBE_DBL == 0) { p0_prologue(F); GRID_BAR(); }
    p1_norm(F); p0_transposes(F); GRID_BAR(); STAMP(2);
    if (PROBE_DBL == 1) { p1_norm(F); GRID_BAR(); }
    {
    {
        pg8::Gemm g{(const pg8::bf16_t*)(((unsigned char*)karg(19)) + WS_H), (const pg8::bf16_t*)(((unsigned char*)karg(19)) + WS_WIN), M, NPROJ, D, nullptr, nullptr};
        pg8::StaticOrder S; S.init(M, NPROJ, F.G, (int)blockIdx.x);
        pg8::EpiBf16<0> E{(pg8::bf16_t*)(((unsigned char*)karg(19)) + WS_PROJ), NPROJ, nullptr, 0, 0, 1.f};
        pg8::gemm_phase<pg8::EpiBf16<0>, pg8::StaticOrder, true, true>(F.lds + RING_OFF, g, S, E);
        const int nwg = (M / 256) * (NPROJ / 256), busy = nwg % F.G;
        if (busy == 0) p0_quant_tables(F, F.vcu * NWAVES + F.wave, F.G * NWAVES);
        else if ((int)blockIdx.x >= busy) p0_quant_tables(F, ((int)blockIdx.x - busy) * NWAVES + F.wave, (F.G - busy) * NWAVES);
    }
    GRID_BAR(); STAMP(3);
    }
    p3_attention(F); GRID_BAR(); STAMP(4);
    if (PROBE_DBL == 3) { p3_attention(F); GRID_BAR(); }
    {
    {
        pg8::Gemm g{(const pg8::bf16_t*)(((unsigned char*)karg(19)) + WS_OA), (const pg8::bf16_t*)(((unsigned char*)karg(19)) + WS_WA), M, D, 512, (const pg8::bf16_t*)(((unsigned char*)karg(19)) + WS_OB), (const pg8::bf16_t*)(((unsigned char*)karg(19)) + WS_WB)};
        PairOrder S; S.S.init(M, D, F.G, (int)blockIdx.x);
        EpiGate E{(const bf16*)(((unsigned char*)karg(19)) + WS_PROJ), (bf16*)((float*)karg(18)) + (size_t)M * D};
        pg8::gemm_phase<EpiGate, PairOrder, false, true>(F.lds + RING_OFF, g, S, E);
    }
    GRID_BAR(); STAMP(5);
    }
    {
    {
        pg8::Gemm g{(const pg8::bf16_t*)((bf16*)((float*)karg(18)) + (size_t)M * D), (const pg8::bf16_t*)(((unsigned char*)karg(19)) + WS_WOUT), M, D, D, nullptr, nullptr};
        pg8::StaticOrder S; S.init(M, D, F.G, (int)blockIdx.x);
        EpiRes E{((const float*)karg(0)), (const float*)(((unsigned char*)karg(19)) + WS_MOD), (float*)(((unsigned char*)karg(19)) + WS_X1)};
        pg8::gemm_phase<EpiRes, pg8::StaticOrder, false, true>(F.lds + RING_OFF, g, S, E);
    }
    GRID_BAR(); STAMP(6);
    }
    p6_norm2(F); GRID_BAR(); STAMP(7);
    if (PROBE_DBL == 6) { p6_norm2(F); GRID_BAR(); }
    {
    {
        pg8::Gemm g{(const pg8::bf16_t*)(((unsigned char*)karg(19)) + WS_H2), (const pg8::bf16_t*)(((unsigned char*)karg(19)) + WS_WQ), M, D, D, nullptr, nullptr};
        pg8::StaticOrder S; S.init(M, D, F.G, (int)blockIdx.x);
        pg8::EpiBf16<0> E{(pg8::bf16_t*)(((unsigned char*)karg(19)) + WS_QP), D, nullptr, 0, 0, 1.f};
        pg8::gemm_phase<pg8::EpiBf16<0>, pg8::StaticOrder, false, true>(F.lds + RING_OFF, g, S, E);
    }
    GRID_BAR(); STAMP(8);
    }
    p8a_topk(F); __syncthreads(); STAMP(9);
    if (PROBE_DBL == 8) { p8a_topk(F); GRID_BAR(); }
    if (PROBE_DBL == 12) { p8b_sweep<1>(F); __syncthreads(); }
    p8b_sweep<0>(F);
    if (PROBE_DBL == 9) { GRID_BAR(); p8b_sweep<0>(F); }
    if (PROBE_TS >= 0) {
        GRID_BAR(); STAMP(10);
        if (blockIdx.x == 0) { __syncthreads();
            const unsigned long long t0 = ((unsigned long long)MISC[17 + 2 * PROBE_TS] << 32) | MISC[16 + 2 * PROBE_TS], t1 = ((unsigned long long)MISC[19 + 2 * PROBE_TS] << 32) | MISC[18 + 2 * PROBE_TS];
            const float d_us = (float)(t1 - t0) * 0.01f;
            const float V = 128.0f * sqrtf(d_us * 1e-5f);
            float* o = (float*)karg(18); for (int c = F.tid; c < D; c += NTHR) o[c] = V; }
    }
}

extern "C" void kernel_launch(void* const* d_in, const int* in_sizes, int n_in, void* d_out, int out_size, void* d_ws, size_t ws_size, hipStream_t stream) {
    static int grid = 0;
    if (grid == 0) {
        if (n_in != 18 || in_sizes[0] != M * D || out_size != M * D || ws_size < WS_END) { fprintf(stderr, "kernel_launch: unexpected shapes (n_in %d, in0 %d, out %d, ws %zu)\n", n_in, n_in > 0 ? in_sizes[0] : -1, out_size, ws_size); grid = -1; return; }
        int dev = 0, cus = 0, per_cu = 0;
        if (hipGetDevice(&dev) != hipSuccess || hipDeviceGetAttribute(&cus, hipDeviceAttributeMultiprocessorCount, dev) != hipSuccess) { grid = -1; return; }
        if (hipFuncSetAttribute((const void*)mega_fwd, hipFuncAttributeMaxDynamicSharedMemorySize, LDS_BYTES) != hipSuccess) { fprintf(stderr, "kernel_launch: hipFuncSetAttribute failed\n"); grid = -1; return; }
        if (hipOccupancyMaxActiveBlocksPerMultiprocessor(&per_cu, (const void*)mega_fwd, NTHR, LDS_BYTES) != hipSuccess || per_cu < 1) { fprintf(stderr, "kernel_launch: occupancy query says %d blocks per CU\n", per_cu); }
        (void)hipGetLastError();
        grid = cus;
    }
    if (grid < 0) return;
    if (hipMemsetAsync((char*)d_ws + WS_CTL, 0, CTL_ZERO_BYTES, stream) != hipSuccess) { fprintf(stderr, "kernel_launch: memset failed\n"); return; }
    Args a{};
    for (int i = 0; i < 18; ++i) a.in[i] = (const float*)d_in[i];
    a.out = (float*)d_out; a.ws = (unsigned char*)d_ws;
    hipLaunchKernelGGL(mega_fwd, dim3(grid), dim3(NTHR), LDS_BYTES, stream, a);
}
```

```cpp
#include <hip/hip_runtime.h>
#include <cstdio>
#include <cstdint>
namespace pg8 {
#define PG8_LAS __attribute__((address_space(3)))
typedef unsigned short bf16_t;
typedef short bf16x8 __attribute__((ext_vector_type(8)));
typedef float f32x4 __attribute__((ext_vector_type(4)));
typedef unsigned u32x4 __attribute__((ext_vector_type(4)));
constexpr int BM = 256, BK = 64, HALF = 128, HTB = HALF * BK * 2  , STAGE_BYTES = 8 * HTB, NXCD = 8, WGM = 8;

__host__ __device__ __forceinline__ int lds_byte(int r, int c) { const int st = (r >> 4) * 2 + (c >> 5), rr = r & 15, cc = c & 31, ob = rr * 64 + cc * 2; return st * 1024 + (ob ^ (((ob >> 9) & 1) << 5)); }
__host__ __device__ __forceinline__ void stage_rc(int b, int& R, int& C) { const int st = b / 1024, sb = b % 1024, swz = sb ^ (((sb >> 9) & 1) << 5); R = (st >> 1) * 16 + swz / 64; C = (st & 1) * 32 + (swz % 64) / 2; }
__host__ __device__ __forceinline__ int perm32(int rho) { const int n = rho >> 4, i = rho & 15; return 8 * (i >> 2) + 4 * n + (i & 3); }

struct Unit { int pm, pn, src; };
struct Gemm { const bf16_t* A; const bf16_t* Bt; int M, N, K; const bf16_t* A2; const bf16_t* Bt2; };

struct StaticOrder {
    int nM, nN, nwg, G, c;
    __host__ __device__ void init(int M, int N, int G_, int c_) { nM = M / BM; nN = N / BM; nwg = nM * nN; G = G_; c = c_; }
    __host__ __device__ bool next(int i, Unit& u) const {
        const long L = (long)i * G + c; if (L >= nwg) return false;
        int wgid = (int)L; { const int q = nwg / NXCD, r = nwg % NXCD, xcd = wgid % NXCD, off = wgid / NXCD; wgid = (xcd < r ? xcd * (q + 1) : r * (q + 1) + (xcd - r) * q) + off; }
        const int nig = WGM * nN, gid = wgid / nig, fm = gid * WGM, gsz = (nM - fm) < WGM ? (nM - fm) : WGM;
        u.pm = fm + ((wgid % nig) % gsz); u.pn = (wgid % nig) / gsz; u.src = 0; return true;
    }
    __device__ __forceinline__ void a_ready(const Unit&) const {}
    __device__ __forceinline__ void done(const Unit&) const {}
};

__device__ __forceinline__ unsigned cvt_pk_bf16(float lo, float hi) { unsigned r; asm volatile("v_cvt_pk_bf16_f32 %0, %1, %2" : "=v"(r) : "v"(lo), "v"(hi)); return r; }
typedef float f32x2 __attribute__((ext_vector_type(2)));
__device__ __forceinline__ f32x2 gelu_pk(f32x2 v) {
    const f32x2 av = __builtin_elementwise_abs(v), d = av * 0.2316418882f + 1.0f;
    f32x2 t; t.x = __builtin_amdgcn_rcpf(d.x); t.y = __builtin_amdgcn_rcpf(d.y);
    f32x2 q = t * 0.5307027145f + (-0.7265760135f); q = q * t + 0.7107068705f; q = q * t + (-0.142248368f); q = q * t + 0.127414796f; q = q * t;
    const f32x2 s = (v * v) * (-0.72134752044f);
    f32x2 e; e.x = __builtin_amdgcn_exp2f(s.x); e.y = __builtin_amdgcn_exp2f(s.y);
    const f32x2 m = v * (q * e), r = v - m;
    f32x2 o; o.x = v.x < 0.f ? m.x : r.x; o.y = v.y < 0.f ? m.y : r.y; return o;
}

template <int ACT  > struct EpiBf16 {
    static constexpr bool PERM = true, AFTER_DRAIN = false, CHAIN = false; static_assert(ACT == 0 || ACT == 1, "EpiBf16: ACT is 0 (none) or 1 (gelu_pk)");
    bf16_t* O; int ldc; const float* bias; int split_cols; size_t split_stride; float scale0;
    __device__ __forceinline__ void operator()(const f32x4 (&acc)[2][2][4][2], const Unit& u, int wr, int wc, int fr, int fq) const {
        const int row0 = u.pm * BM + wr * 64 + fr; int colt = u.pn * BM; bf16_t* base = O;
        float sc = 1.f; if (split_cols) { const int t = colt / split_cols; base += (size_t)t * split_stride; colt -= t * split_cols; if (t == 0) sc = scale0; }
        const int col0 = colt + wc * 32 + 8 * fq, bcol0 = u.pn * BM + wc * 32 + 8 * fq;
        f32x4 bv[2][2];
#pragma unroll
        for (int bj = 0; bj < 2; ++bj)
#pragma unroll
            for (int n = 0; n < 2; ++n) bv[bj][n] = bias ? *(const f32x4*)(bias + bcol0 + bj * HALF + 4 * n) : (f32x4){0.f, 0.f, 0.f, 0.f};
#pragma unroll
        for (int ai = 0; ai < 2; ++ai)
#pragma unroll
            for (int m = 0; m < 4; ++m) { bf16_t* rowp = base + (size_t)(row0 + ai * HALF + m * 16) * ldc + col0;
#pragma unroll
                for (int bj = 0; bj < 2; ++bj) { f32x4 v0 = acc[ai][bj][m][0] + bv[bj][0], v1 = acc[ai][bj][m][1] + bv[bj][1];
                    if (ACT == 1) { f32x2 a = gelu_pk((f32x2){v0[0], v0[1]}), b = gelu_pk((f32x2){v0[2], v0[3]}), c = gelu_pk((f32x2){v1[0], v1[1]}), d = gelu_pk((f32x2){v1[2], v1[3]});
                        v0 = (f32x4){a.x, a.y, b.x, b.y}; v1 = (f32x4){c.x, c.y, d.x, d.y}; }
                    v0 = v0 * sc; v1 = v1 * sc; u32x4 w; w.x = cvt_pk_bf16(v0[0], v0[1]); w.y = cvt_pk_bf16(v0[2], v0[3]); w.z = cvt_pk_bf16(v1[0], v1[1]); w.w = cvt_pk_bf16(v1[2], v1[3]);
                    *(u32x4*)(rowp + bj * HALF) = w; } }
    }
};

template <class Epi, class Sched, bool ALIGN_EPI = false, bool SP2 = false>
__device__ __forceinline__ void gemm_phase(PG8_LAS unsigned char* lds, const Gemm g, const Sched& S, const Epi& E) {
    const int tid = threadIdx.x, wid = __builtin_amdgcn_readfirstlane(tid >> 6), lane = tid & 63, wr = wid >> 2, wc = wid & 3, fr = lane & 15, fq = lane >> 4;
    const int K = g.K, nt = K / BK;
    unsigned voffA[2], voffB[2];
#pragma unroll
    for (int i = 0; i < 2; ++i) { int R, C; stage_rc(tid * 16 + i * 8192, R, C); const int Rb = Epi::PERM ? ((R & ~31) + perm32(R & 31)) : R;
        voffA[i] = (unsigned)(R * K + C) * 2u; voffB[i] = (unsigned)(Rb * K + C) * 2u; }
    const size_t kstep = (size_t)(BK * 2);
    const size_t hstep = (size_t)HALF * K * 2;
    const size_t tstep = 2 * hstep;
    const unsigned ldsw = (unsigned)wid * 1024u;
    const int aoff = lds_byte(wr * 64 + fr, fq * 8), boff = lds_byte(wc * 32 + fr, fq * 8);
#define PG8_SA(b, h) (((b) * 2 + (h)) * HTB)
#define PG8_SB(b, h) ((4 + (b) * 2 + (h)) * HTB)
#define PG8_STAGE(bufoff, gbase, voff) do { _Pragma("unroll") for (int _i = 0; _i < 2; ++_i) \
        __builtin_amdgcn_global_load_lds((const unsigned*)((const char*)(gbase) + (voff)[_i]), (PG8_LAS unsigned*)(lds + (bufoff) + ldsw + _i * 8192), 16, 0, 0); } while (0)
#define PG8_LDA(dst, b, h) do { _Pragma("unroll") for (int m = 0; m < 4; ++m) _Pragma("unroll") for (int k = 0; k < 2; ++k) dst[m][k] = *(const PG8_LAS bf16x8*)(lds + PG8_SA(b, h) + aoff + m * 2048 + k * 1024); } while (0)
#define PG8_LDB(dst, b, h) do { _Pragma("unroll") for (int n = 0; n < 2; ++n) _Pragma("unroll") for (int k = 0; k < 2; ++k) dst[n][k] = *(const PG8_LAS bf16x8*)(lds + PG8_SB(b, h) + boff + n * 2048 + k * 1024); } while (0)
#define PG8_MMA(ai, bj, At, Bt) do { __builtin_amdgcn_s_setprio(1); _Pragma("unroll") for (int m = 0; m < 4; ++m) _Pragma("unroll") for (int n = 0; n < 2; ++n) _Pragma("unroll") for (int k = 0; k < 2; ++k) \
        acc[ai][bj][m][n] = __builtin_amdgcn_mfma_f32_16x16x32_bf16(Bt[n][k], At[m][k], acc[ai][bj][m][n], 0, 0, 0); __builtin_amdgcn_s_setprio(0); } while (0)
#define PG8_WAIT_V(n) asm volatile("s_waitcnt vmcnt(" #n ")" ::: "memory")
#define PG8_WAIT_L(n) asm volatile("s_waitcnt lgkmcnt(" #n ")" ::: "memory")
#define PG8_BAR __builtin_amdgcn_s_barrier()
#define PG8_SCHED __builtin_amdgcn_sched_barrier(0)
    Unit cur, nxt; int ui = 0;
    if (!S.next(0, cur)) return;
    f32x4 acc[2][2][4][2];
#pragma unroll
    for (int a = 0; a < 2; ++a)
#pragma unroll
        for (int b = 0; b < 2; ++b)
#pragma unroll
            for (int m = 0; m < 4; ++m)
#pragma unroll
                for (int n = 0; n < 2; ++n) acc[a][b][m][n] = (f32x4){0.f, 0.f, 0.f, 0.f};
    bf16x8 At[4][2], B0[2][2], B1[2][2];
    const char* cA = (const char*)(cur.src ? g.A2 : g.A) + (size_t)cur.pm * tstep; const char* cB = (const char*)(cur.src ? g.Bt2 : g.Bt) + (size_t)cur.pn * tstep;
    S.a_ready(cur);
    if constexpr (SP2) {
        PG8_STAGE(PG8_SB(0, 0), cB, voffB); PG8_STAGE(PG8_SB(0, 1), cB + hstep, voffB); PG8_STAGE(PG8_SA(0, 0), cA, voffA); PG8_STAGE(PG8_SA(0, 1), cA + hstep, voffA);
        if (wr == 1) PG8_BAR;
        PG8_WAIT_V(2); PG8_BAR;
        PG8_STAGE(PG8_SB(1, 0), cB + kstep, voffB); PG8_STAGE(PG8_SA(1, 0), cA + kstep, voffA); PG8_STAGE(PG8_SB(1, 1), cB + hstep + kstep, voffB);
        PG8_WAIT_V(6); PG8_BAR;
    } else {
        PG8_STAGE(PG8_SB(0, 0), cB, voffB); PG8_STAGE(PG8_SA(0, 0), cA, voffA); PG8_STAGE(PG8_SB(0, 1), cB + hstep, voffB); PG8_STAGE(PG8_SA(0, 1), cA + hstep, voffA);
        if (wr == 1) PG8_BAR;
        PG8_WAIT_V(4); PG8_BAR;
        PG8_STAGE(PG8_SB(1, 0), cB + kstep, voffB); PG8_STAGE(PG8_SA(1, 0), cA + kstep, voffA); PG8_STAGE(PG8_SB(1, 1), cB + hstep + kstep, voffB);
        PG8_WAIT_V(6); PG8_BAR;
    }
    for (;;) {
        const bool has_next = S.next(ui + 1, nxt);
        const char* nA = has_next ? (const char*)(nxt.src ? g.A2 : g.A) + (size_t)nxt.pm * tstep : cA; const char* nB = has_next ? (const char*)(nxt.src ? g.Bt2 : g.Bt) + (size_t)nxt.pn * tstep : cB;
        for (int t = 0; t < nt; t += 2) {
            const bool last = (t == nt - 2);
            const char* a1 = cA + (size_t)(t + 1) * kstep;
            const char* a2 = last ? nA : cA + (size_t)(t + 2) * kstep; const char* b2 = last ? nB : cB + (size_t)(t + 2) * kstep;
            const char* a3 = a2 + kstep; const char* b3 = b2 + kstep;
            if (last && has_next) S.a_ready(nxt);
            if constexpr (SP2) {
            PG8_LDB(B0, 0, 0); PG8_LDB(B1, 0, 1); PG8_SCHED; PG8_LDA(At, 0, 0); PG8_STAGE(PG8_SA(1, 1), a1 + hstep, voffA);
            PG8_WAIT_V(8); PG8_WAIT_L(0); PG8_BAR; PG8_MMA(0, 0, At, B0); PG8_MMA(0, 1, At, B1); PG8_BAR; PG8_SCHED;
            PG8_LDA(At, 0, 1); PG8_STAGE(PG8_SB(0, 0), b2, voffB); PG8_STAGE(PG8_SB(0, 1), b2 + hstep, voffB); PG8_STAGE(PG8_SA(0, 0), a2, voffA);
            PG8_WAIT_V(8); PG8_WAIT_L(0); PG8_BAR; PG8_MMA(1, 0, At, B0); PG8_MMA(1, 1, At, B1); PG8_BAR; PG8_SCHED;
            PG8_LDB(B0, 1, 0); PG8_LDB(B1, 1, 1); PG8_SCHED; PG8_LDA(At, 1, 0); PG8_STAGE(PG8_SA(0, 1), a2 + hstep, voffA);
            PG8_WAIT_V(8); PG8_WAIT_L(0); PG8_BAR; PG8_MMA(0, 0, At, B0); PG8_MMA(0, 1, At, B1); PG8_BAR; PG8_SCHED;
            PG8_LDA(At, 1, 1); PG8_STAGE(PG8_SB(1, 0), b3, voffB); PG8_STAGE(PG8_SB(1, 1), b3 + hstep, voffB); PG8_STAGE(PG8_SA(1, 0), a3, voffA);
            PG8_WAIT_V(8); PG8_WAIT_L(0); PG8_BAR; PG8_MMA(1, 0, At, B0); PG8_MMA(1, 1, At, B1); PG8_BAR; PG8_SCHED;
            } else {
            PG8_LDB(B0, 0, 0); PG8_SCHED; PG8_LDA(At, 0, 0); PG8_STAGE(PG8_SA(1, 1), a1 + hstep, voffA);
            PG8_WAIT_L(8); PG8_BAR; PG8_WAIT_L(0); PG8_MMA(0, 0, At, B0); PG8_BAR; PG8_SCHED;
            PG8_LDB(B1, 0, 1); PG8_STAGE(PG8_SB(0, 0), b2, voffB);
            PG8_BAR; PG8_WAIT_L(0); PG8_MMA(0, 1, At, B1); PG8_BAR;
            PG8_LDA(At, 0, 1); PG8_STAGE(PG8_SA(0, 0), a2, voffA);
            PG8_BAR; PG8_WAIT_L(0); PG8_MMA(1, 0, At, B0); PG8_BAR; PG8_SCHED;
            PG8_STAGE(PG8_SB(0, 1), b2 + hstep, voffB);
            PG8_WAIT_V(6); PG8_BAR; PG8_MMA(1, 1, At, B1); PG8_BAR;
            PG8_LDB(B0, 1, 0); PG8_SCHED; PG8_LDA(At, 1, 0); PG8_STAGE(PG8_SA(0, 1), a2 + hstep, voffA);
            PG8_WAIT_L(8); PG8_BAR; PG8_WAIT_L(0); PG8_MMA(0, 0, At, B0); PG8_BAR; PG8_SCHED;
            PG8_LDB(B1, 1, 1); PG8_STAGE(PG8_SB(1, 0), b3, voffB);
            PG8_BAR; PG8_WAIT_L(0); PG8_MMA(0, 1, At, B1); PG8_BAR;
            PG8_LDA(At, 1, 1); PG8_STAGE(PG8_SA(1, 0), a3, voffA);
            PG8_BAR; PG8_WAIT_L(0); PG8_MMA(1, 0, At, B0); PG8_BAR; PG8_SCHED;
            PG8_STAGE(PG8_SB(1, 1), b3 + hstep, voffB);
            PG8_WAIT_V(6); PG8_BAR; PG8_MMA(1, 1, At, B1); PG8_BAR;
            }
        }
        if constexpr (ALIGN_EPI) { if (wr == 0) PG8_BAR; }
        if constexpr (!Epi::AFTER_DRAIN) { E(acc, cur, wr, wc, fr, fq); S.done(cur); }
        if (!has_next) break;
        if (!(Epi::CHAIN && cur.src == 0)) {
#pragma unroll
        for (int a = 0; a < 2; ++a)
#pragma unroll
            for (int b = 0; b < 2; ++b)
#pragma unroll
                for (int m = 0; m < 4; ++m)
#pragma unroll
                    for (int n = 0; n < 2; ++n) acc[a][b][m][n] = (f32x4){0.f, 0.f, 0.f, 0.f};
        }
        cur = nxt; cA = nA; cB = nB; ++ui;
        if constexpr (ALIGN_EPI) { if (wr == 1) PG8_BAR; }
    }
    PG8_WAIT_V(0);
    if constexpr (!ALIGN_EPI) { if (wr == 0) PG8_BAR; }
    PG8_BAR;
    if constexpr (Epi::AFTER_DRAIN) { E.fused(acc, cur, wr, wc, fr, fq, lds, wid, lane); S.done(cur); }
#undef PG8_SA
#undef PG8_SB
#undef PG8_STAGE
#undef PG8_LDA
#undef PG8_LDB
#undef PG8_MMA
#undef PG8_WAIT_V
#undef PG8_WAIT_L
#undef PG8_BAR
#undef PG8_SCHED
}
}

#define GAS __attribute__((address_space(1)))
#define LAS __attribute__((address_space(3)))
typedef unsigned short bf16;
typedef unsigned v4u __attribute__((ext_vector_type(4)));
typedef float f32x4 __attribute__((ext_vector_type(4)));
typedef short bf16x8 __attribute__((ext_vector_type(8)));
typedef GAS unsigned gu32;
typedef GAS unsigned long long gu64;
#define RLX_AGENT __ATOMIC_RELAXED, __HIP_MEMORY_SCOPE_AGENT
#define LDS_WAIT() asm volatile("s_waitcnt lgkmcnt(0)" ::: "memory")
#define VM_WAIT() asm volatile("s_waitcnt vmcnt(0)" ::: "memory")
__device__ __forceinline__ unsigned long long rt() { return __builtin_amdgcn_s_memrealtime(); }
__device__ __forceinline__ unsigned f2bf(float f) { unsigned u = __builtin_bit_cast(unsigned, f); return (u + 0x7fffu + ((u >> 16) & 1u)) >> 16; }
__device__ __forceinline__ unsigned pk2(float lo, float hi) { return f2bf(lo) | (f2bf(hi) << 16); }

#define XB_TMO      128
#define XB_XCNT(j)  (256  + 64 * (j))
#define XB_XSUB(j)  (1280 + 64 * (j))
#define XB_XGEN(j)  (2304 + 64 * (j))
#define XB_TOP      3328
#define XB_TOPGEN   3392
#define XCD_BAR_WORDS 3456
#define XB_SPIN_CAP (1u << 18)

__device__ __forceinline__ unsigned xb_ld(unsigned* p)              { return __hip_atomic_load(p, __ATOMIC_RELAXED, __HIP_MEMORY_SCOPE_AGENT); }
__device__ __forceinline__ unsigned xb_add(unsigned* p, unsigned v) { return __hip_atomic_fetch_add(p, v, __ATOMIC_RELAXED, __HIP_MEMORY_SCOPE_AGENT); }
__device__ __forceinline__ unsigned xb_xcc_id() { return (unsigned)__builtin_amdgcn_s_getreg((3 << 11) | 20) & 0xFu; }
#define XB_SPIN(cond, bar) do { unsigned _sp = 0; while (cond) { __builtin_amdgcn_s_sleep(1); \
    if ((++_sp & 255u) == 0u) { if (xb_ld(&(bar)[XB_TMO])) break; if (_sp > XB_SPIN_CAP) { atomicAdd(&(bar)[XB_TMO], 1u); break; } } } } while (0)

struct XcdBarrier {
    unsigned* bar; unsigned x;
    volatile LAS unsigned* st;
};

__device__ __forceinline__ XcdBarrier xcd_barrier_post(unsigned* bar, volatile LAS unsigned* st) {
    XcdBarrier b; b.bar = bar; b.x = xb_xcc_id(); b.st = st;
    if (threadIdx.x == 0) (void)xb_add(&bar[XB_XCNT(b.x)], 1u);
    return b;
}
__device__ __forceinline__ void xcd_barrier_complete(unsigned* bar, unsigned x, unsigned& nloc, unsigned& nx) {
    const unsigned G = gridDim.x * gridDim.y * gridDim.z;
    unsigned sum, cnt, mine, sp = 0u;
    for (;;) {
        sum = 0u; cnt = 0u; mine = 0u;
#pragma unroll
        for (unsigned j = 0; j < 16; ++j) { const unsigned c = xb_ld(&bar[XB_XCNT(j)]); sum += c; cnt += (c > 0u) ? 1u : 0u; mine = (j == x) ? c : mine; }
        if (sum == G) break;
        __builtin_amdgcn_s_sleep(1);
        if ((++sp & 255u) == 0u) { if (xb_ld(&bar[XB_TMO])) break; if (sp > XB_SPIN_CAP) { atomicAdd(&bar[XB_TMO], 1u); break; } }
    }
    nloc = mine > 0u ? mine : 1u; nx = cnt > 0u ? cnt : 1u;
}

__device__ __forceinline__ void xcd_barrier(const XcdBarrier& b) {
    asm volatile("s_waitcnt vmcnt(0)" ::: "memory");
    __syncthreads();
    if (threadIdx.x == 0) {
        unsigned* bar = b.bar;
        __builtin_amdgcn_s_waitcnt(0);
        unsigned nloc = b.st[0], nx = b.st[1];
        if (nloc == 0u) { xcd_barrier_complete(bar, b.x, nloc, nx); b.st[0] = nloc; b.st[1] = nx; }
        const unsigned old = xb_add(&bar[XB_XSUB(b.x)], 1u);
        const unsigned gen = old / nloc;
        if (old + 1u == (gen + 1u) * nloc) {
            __builtin_amdgcn_fence(__ATOMIC_RELEASE, "agent");
            asm volatile("s_waitcnt vmcnt(0)" ::: "memory");
            const unsigned og = xb_add(&bar[XB_TOP], 1u);
            const unsigned tg = og / nx;
            if (og + 1u == (tg + 1u) * nx) xb_add(&bar[XB_TOPGEN], 1u);
            else XB_SPIN(xb_ld(&bar[XB_TOPGEN]) == tg, bar);
            __builtin_amdgcn_fence(__ATOMIC_ACQUIRE, "agent");
            xb_add(&bar[XB_XGEN(b.x)], 1u);
            asm volatile("s_waitcnt vmcnt(0)" ::: "memory");
        } else {
            XB_SPIN(xb_ld(&bar[XB_XGEN(b.x)]) == gen, bar);
            __builtin_amdgcn_fence(__ATOMIC_ACQUIRE, "agent");
            asm volatile("s_waitcnt vmcnt(0)" ::: "memory");
        }
    }
    __syncthreads();
}

constexpr int NWAVES = 8, NTHR = 512;
constexpr int BATCH = 4, SEQ = 4096, D = 1024, M = BATCH * SEQ;
constexpr int NPROJ = 4352, LDW_IN = 4360, NMOD = 6144;
constexpr int C_QA = 0, C_KA = 512, C_VA = 640, C_QB = 768, C_KB = 1280, C_VB = 1792, C_GLA = 2304, C_GLB = 3328;
constexpr int NEXP = 16384;
constexpr float EPS = 1e-6f;

constexpr size_t MiB = 1u << 20;
constexpr size_t WS_CTL = 0, CTL_ZERO_BYTES = 1 * MiB;
constexpr size_t WS_MOD = 1 * MiB, WS_LOGF = 1 * MiB + 128 * 1024, WS_SUBK = 2 * MiB;
constexpr size_t WS_WIN = 4 * MiB, WS_WA = 12 * MiB + 512 * 1024, WS_WB = 13 * MiB + 512 * 1024, WS_WOUT = 14 * MiB + 512 * 1024, WS_WQ = 16 * MiB + 512 * 1024;
constexpr size_t WS_ED = 19 * MiB, WS_EU = 35 * MiB;
constexpr size_t WS_EDS = 2 * MiB + 512 * 1024;
constexpr size_t WS_H2Q = 95 * MiB, WS_H2S = 111 * MiB;
constexpr size_t WS_H = 83 * MiB, WS_OA = 83 * MiB, WS_OB = 99 * MiB, WS_PIDX = 83 * MiB, WS_PG = 87 * MiB;
constexpr size_t WS_PROJ = 115 * MiB, WS_X1 = 115 * MiB, WS_H2 = 179 * MiB, WS_QP = 211 * MiB;
constexpr size_t WS_END = 251 * MiB;
static_assert(WS_WIN + (size_t)NPROJ * D * 2 <= WS_WA && WS_WQ + (size_t)D * D * 2 <= WS_ED && WS_PROJ + (size_t)M * NPROJ * 2 <= WS_END, "ws map");
constexpr int CW_BAR = 4096;

constexpr int RING_OFF = 0, RING_BYTES = 131072;
constexpr int LDSCTL_OFF = RING_BYTES, MISC_OFF = LDSCTL_OFF + 320;
constexpr int LDS_BYTES = 147456;

typedef float f32x16 __attribute__((ext_vector_type(16)));
typedef short s16x4 __attribute__((ext_vector_type(4)));
typedef unsigned u32x2 __attribute__((ext_vector_type(2)));
typedef float f32x2_t __attribute__((ext_vector_type(2)));
typedef __bf16 bf16x2_t __attribute__((ext_vector_type(2)));

__device__ __forceinline__ unsigned cvtpk(float lo, float hi) { f32x2_t v = {lo, hi}; bf16x2_t b = __builtin_convertvector(v, bf16x2_t); return __builtin_bit_cast(unsigned, b); }
__device__ __forceinline__ float bflo(unsigned u) { return __uint_as_float(u << 16); }
__device__ __forceinline__ float bfhi(unsigned u) { return __uint_as_float(u & 0xffff0000u); }
__device__ __forceinline__ float wave_sum(float v) {
#pragma unroll
    for (int o = 1; o < 64; o <<= 1) v += __shfl_xor(v, o);
    return v;
}
template <int S> __device__ __forceinline__ unsigned xorx(unsigned v, int lane) {
    if constexpr (S == 1) return (unsigned)__builtin_amdgcn_update_dpp(0, (int)v, 0xB1, 0xF, 0xF, true);
    else if constexpr (S == 2) return (unsigned)__builtin_amdgcn_update_dpp(0, (int)v, 0x4E, 0xF, 0xF, true);
    else if constexpr (S == 4) { const unsigned a = (unsigned)__builtin_amdgcn_update_dpp(0, (int)v, 0x124, 0xF, 0xF, true), b = (unsigned)__builtin_amdgcn_update_dpp(0, (int)v, 0x12C, 0xF, 0xF, true); return (lane & 4) ? a : b; }
    else if constexpr (S == 8) return (unsigned)__builtin_amdgcn_update_dpp(0, (int)v, 0x128, 0xF, 0xF, true);
    else if constexpr (S == 16) { const auto r = __builtin_amdgcn_permlane16_swap(v, v, false, false); return (lane & 16) ? r[0] : r[1]; }
    else { const auto r = __builtin_amdgcn_permlane32_swap(v, v, false, false); return (lane & 32) ? r[0] : r[1]; }
}
__device__ __forceinline__ unsigned xorx_sw(unsigned v, int lane, int s) {
    switch (s) { case 1: return xorx<1>(v, lane); case 2: return xorx<2>(v, lane); case 4: return xorx<4>(v, lane); case 8: return xorx<8>(v, lane); case 16: return xorx<16>(v, lane); default: return xorx<32>(v, lane); }
}
__device__ __forceinline__ float wave_sum_x(float v, int lane) {
    v += __uint_as_float(xorx<1>(__float_as_uint(v), lane)); v += __uint_as_float(xorx<2>(__float_as_uint(v), lane)); v += __uint_as_float(xorx<4>(__float_as_uint(v), lane));
    v += __uint_as_float(xorx<8>(__float_as_uint(v), lane)); v += __uint_as_float(xorx<16>(__float_as_uint(v), lane)); v += __uint_as_float(xorx<32>(__float_as_uint(v), lane));
    return v;
}
__device__ __forceinline__ int crow(int r, int hi) { return (r & 3) + 8 * (r >> 2) + 4 * hi; }
#define MFMA32(a, b, c) __builtin_amdgcn_mfma_f32_32x32x16_bf16((a), (b), (c), 0, 0, 0)

struct Frame {
    LAS unsigned char* lds;
    int tid, lane, wave, vcu, G;
};
__device__ __forceinline__ const void* karg(int i) {
    unsigned long z = 0; asm volatile("" : "+s"(z));
    const char* base = (const char*)__builtin_amdgcn_kernarg_segment_ptr();
    return *(const void* const*)(base + 8 * i + z);
}

__device__ __forceinline__ void p0_transpose_item(const float* W, int ld, int K, int ncols, bf16* WT, int row_off, LAS float* scr, int item, int lane) {
    const int nblk = ncols / 32, kb = item / nblk, nb = item % nblk, k0 = 64 * kb, n0 = 32 * nb;
#pragma unroll 8
    for (int i = 0; i < 32; ++i) { const int kk = 2 * i + (lane >> 5); scr[kk * 33 + (lane & 31)] = W[(size_t)(k0 + kk) * ld + n0 + (lane & 31)]; }
    LDS_WAIT(); asm volatile("" ::: "memory");
    const int c = lane & 7;
#pragma unroll
    for (int j = 0; j < 4; ++j) { const int n = (lane >> 3) + 8 * j; const LAS float* s = scr + (8 * c) * 33 + n;
        v4u o; o.x = pk2(s[0 * 33], s[1 * 33]); o.y = pk2(s[2 * 33], s[3 * 33]); o.z = pk2(s[4 * 33], s[5 * 33]); o.w = pk2(s[6 * 33], s[7 * 33]);
        *(GAS v4u*)(WT + (size_t)(row_off + n0 + n) * K + k0 + 8 * c) = o; }
    LDS_WAIT(); asm volatile("" ::: "memory");
}
__device__ __forceinline__ void p0_convert(const float* __restrict__ src, bf16* __restrict__ dst, long n_iters, int gw, int NGW, int lane) {
    for (long it0 = (long)gw * 4; it0 < n_iters; it0 += (long)NGW * 4) {
        f32x4 a[4][2];
#pragma unroll
        for (int u = 0; u < 4; ++u) { const long it = it0 + u; if (it < n_iters) { const float* p = src + it * 512 + lane * 4; a[u][0] = *(const f32x4*)p; a[u][1] = *(const f32x4*)(p + 256); } }
#pragma unroll
        for (int u = 0; u < 4; ++u) { const long it = it0 + u; if (it < n_iters) { bf16* q = dst + it * 512 + lane * 4;
            u32x2 w0, w1; w0.x = cvtpk(a[u][0].x, a[u][0].y); w0.y = cvtpk(a[u][0].z, a[u][0].w); w1.x = cvtpk(a[u][1].x, a[u][1].y); w1.y = cvtpk(a[u][1].z, a[u][1].w);
            *(u32x2*)q = w0; *(u32x2*)(q + 256) = w1; } }
    }
}

__device__ __forceinline__ void p0_quant_tables(Frame& F, int gw, int NGW) {
    const float* ed = ((const float*)karg(15)); const float* eu = ((const float*)karg(16));
    unsigned char* EDq = (unsigned char*)(((unsigned char*)karg(19)) + WS_ED); unsigned char* EUq = (unsigned char*)(((unsigned char*)karg(19)) + WS_EU); float* EDS = (float*)(((unsigned char*)karg(19)) + WS_EDS);
    const int lane = F.lane;
    for (int row0 = gw * 4; row0 < NEXP; row0 += NGW * 4) {
        f32x4 a[4][4], u[4][4];
#pragma unroll
        for (int q = 0; q < 4; ++q)
#pragma unroll
            for (int j = 0; j < 4; ++j) { a[q][j] = *((const f32x4*)(ed + (size_t)(row0 + q) * D) + lane + 64 * j); u[q][j] = *((const f32x4*)(eu + (size_t)(row0 + q) * D) + lane + 64 * j); }
#pragma unroll
        for (int q = 0; q < 4; ++q) {
            float am = 0.f;
#pragma unroll
            for (int j = 0; j < 4; ++j) am = fmaxf(fmaxf(am, fmaxf(fabsf(a[q][j].x), fabsf(a[q][j].y))), fmaxf(fabsf(a[q][j].z), fabsf(a[q][j].w)));
#pragma unroll
            for (int o = 1; o < 64; o <<= 1) am = fmaxf(am, __shfl_xor(am, o));
            const float sc = am > 0.f ? am * (1.0f / 127.0f) : 1.0f, inv = 1.0f / sc;
            v4u qa, qu;
#pragma unroll
            for (int j = 0; j < 4; ++j) {
                const int b0 = (int)rintf(a[q][j].x * inv), b1 = (int)rintf(a[q][j].y * inv), b2 = (int)rintf(a[q][j].z * inv), b3 = (int)rintf(a[q][j].w * inv);
                qa[j] = (unsigned)(b0 & 255) | ((unsigned)(b1 & 255) << 8) | ((unsigned)(b2 & 255) << 16) | ((unsigned)(b3 & 255) << 24);
                int p = __builtin_amdgcn_cvt_pk_fp8_f32(u[q][j].x * 16.0f, u[q][j].y * 16.0f, 0, false);
                p = __builtin_amdgcn_cvt_pk_fp8_f32(u[q][j].z * 16.0f, u[q][j].w * 16.0f, p, true);
                qu[j] = (unsigned)p;
            }
            *(v4u*)(EDq + (size_t)(row0 + q) * D + 16 * lane) = qa;
            *(v4u*)(EUq + (size_t)(row0 + q) * D + 16 * lane) = qu;
            if (lane == 0) EDS[row0 + q] = sc;
        }
    }
}
__device__ __forceinline__ void p0_prologue(Frame& F) {
    const float* c = ((const float*)karg(1)); const float* w_ada = ((const float*)karg(4)); const float* b_ada = ((const float*)karg(5));
    float* MOD = (float*)(((unsigned char*)karg(19)) + WS_MOD);
    {
        LAS float* cact = (LAS float*)(F.lds);
        LAS float* part = (LAS float*)(F.lds + 16384);
        bool did = false;
        for (int item = F.vcu; item < NMOD / 32; item += F.G) {
            if (!did) { for (int i = F.tid; i < 4096; i += NTHR) { const float cv = c[i]; cact[i] = cv / (1.0f + __expf(-cv)); } did = true; }
            __syncthreads();
            const int n0 = item * 32, col = n0 + (F.lane & 31), ksub = F.lane >> 5;
            float a0 = 0.f, a1 = 0.f, a2 = 0.f, a3 = 0.f;
#pragma unroll 16
            for (int it = 0; it < 64; ++it) { const int k = (it * 8 + F.wave) * 2 + ksub; const float w = w_ada[(size_t)k * NMOD + col];
                a0 += cact[k] * w; a1 += cact[1024 + k] * w; a2 += cact[2048 + k] * w; a3 += cact[3072 + k] * w; }
            a0 += __shfl_xor(a0, 32); a1 += __shfl_xor(a1, 32); a2 += __shfl_xor(a2, 32); a3 += __shfl_xor(a3, 32);
            if (F.lane < 32) { part[(F.wave * 4 + 0) * 32 + F.lane] = a0; part[(F.wave * 4 + 1) * 32 + F.lane] = a1; part[(F.wave * 4 + 2) * 32 + F.lane] = a2; part[(F.wave * 4 + 3) * 32 + F.lane] = a3; }
            __syncthreads();
            if (F.tid < 128) { const int b = F.tid >> 5, cl = F.tid & 31; float s = 0.f;
#pragma unroll
                for (int w = 0; w < 8; ++w) s += part[(w * 4 + b) * 32 + cl];
                MOD[b * NMOD + n0 + cl] = s + b_ada[n0 + cl]; }
            __syncthreads();
        }
    }
    {
        const int gw = F.vcu * NWAVES + F.wave, NGW = F.G * NWAVES;
        p0_convert(((const float*)karg(14)), (bf16*)(((unsigned char*)karg(19)) + WS_SUBK), (long)(8 * 2 * 128 * 64) / 512, gw, NGW, F.lane);
    }
}
__device__ __forceinline__ void p0_transposes(Frame& F) {
    LAS float* scr = (LAS float*)(F.lds + 32768 + F.wave * 8704);
    const int gw = F.vcu * NWAVES + F.wave, NGW = F.G * NWAVES;
    constexpr int I_IN1 = (D / 64) * (2304 / 32), I_IN2 = (D / 64) * (2048 / 32), I_AB = (512 / 64) * (D / 32), I_SQ = (D / 64) * (D / 32);
    constexpr int NITEMS = I_IN1 + I_IN2 + 2 * I_AB + 2 * I_SQ;
    bf16* Win_t = (bf16*)(((unsigned char*)karg(19)) + WS_WIN);
    for (int it = gw; it < NITEMS; it += NGW) {
        int r = it;
        if (r < I_IN1) { p0_transpose_item(((const float*)karg(6)), LDW_IN, D, 2304, Win_t, 0, scr, r, F.lane); continue; } r -= I_IN1;
        if (r < I_IN2) { p0_transpose_item(((const float*)karg(6)) + 2312, LDW_IN, D, 2048, Win_t, 2304, scr, r, F.lane); continue; } r -= I_IN2;
        if (r < I_AB) { p0_transpose_item(((const float*)karg(9)), D, 512, D, (bf16*)(((unsigned char*)karg(19)) + WS_WA), 0, scr, r, F.lane); continue; } r -= I_AB;
        if (r < I_AB) { p0_transpose_item(((const float*)karg(10)), D, 512, D, (bf16*)(((unsigned char*)karg(19)) + WS_WB), 0, scr, r, F.lane); continue; } r -= I_AB;
        if (r < I_SQ) { p0_transpose_item(((const float*)karg(11)), D, D, D, (bf16*)(((unsigned char*)karg(19)) + WS_WOUT), 0, scr, r, F.lane); continue; } r -= I_SQ;
        p0_transpose_item(((const float*)karg(13)), D, D, D, (bf16*)(((unsigned char*)karg(19)) + WS_WQ), 0, scr, r, F.lane);
    }
}

__device__ __forceinline__ void p1_norm(Frame& F) {
    const float* x = ((const float*)karg(0)); const float* g1 = ((const float*)karg(2)); const float* w_in = ((const float*)karg(6)); const float* b_forget = ((const float*)karg(7));
    const float* MOD = (const float*)(((unsigned char*)karg(19)) + WS_MOD); bf16* H = (bf16*)(((unsigned char*)karg(19)) + WS_H); float* LOGF = (float*)(((unsigned char*)karg(19)) + WS_LOGF);
    LAS float* wfl = (LAS float*)(F.lds);
    { float tmp[16];
#pragma unroll
      for (int n = 0; n < 16; ++n) { const int i = F.tid + n * NTHR; tmp[n] = w_in[(size_t)(i >> 3) * LDW_IN + 2304 + (i & 7)]; }
#pragma unroll
      for (int n = 0; n < 16; ++n) { const int i = F.tid + n * NTHR; wfl[(i & 7) * 1024 + (i >> 3)] = tmp[n]; } }
    __syncthreads();
    const int gw = F.vcu * NWAVES + F.wave, NGW = F.G * NWAVES;
    f32x4 cur[4], nxt[4];
    if (gw < M) { const f32x4* xr = (const f32x4*)(x + (size_t)gw * D) + F.lane;
#pragma unroll
        for (int j = 0; j < 4; ++j) cur[j] = xr[64 * j]; }
    for (int row = gw; row < M; row += NGW) {
        { const int nrow = row + NGW; if (nrow < M) { const f32x4* xr = (const f32x4*)(x + (size_t)nrow * D) + F.lane;
#pragma unroll
            for (int j = 0; j < 4; ++j) nxt[j] = xr[64 * j]; } }
        {{
        float ss = 0.f;
#pragma unroll
        for (int j = 0; j < 4; ++j) ss += (cur[j].x * cur[j].x + cur[j].y * cur[j].y) + (cur[j].z * cur[j].z + cur[j].w * cur[j].w);
        ss = wave_sum(ss);
        const float rstd = 1.0f / sqrtf(ss * (1.0f / D) + EPS);
        const int b = row >> 12; const float* mb = MOD + b * NMOD;
        float fl[8];
#pragma unroll
        for (int jj = 0; jj < 8; ++jj) fl[jj] = 0.f;
#pragma unroll
        for (int j = 0; j < 4; ++j) { const int col = 4 * F.lane + 256 * j;
            const f32x4 g = *(const f32x4*)(g1 + col), sh = *(const f32x4*)(mb + col), sc = *(const f32x4*)(mb + 1024 + col);
            const f32x4 hv = (cur[j] * rstd) * g * (sc + 1.0f) + sh;
            u32x2 w; w.x = cvtpk(hv.x, hv.y); w.y = cvtpk(hv.z, hv.w);
            *(u32x2*)(H + (size_t)row * D + col) = w;
#pragma unroll
            for (int jj = 0; jj < 8; ++jj) { const f32x4 wv = *(const LAS f32x4*)(wfl + jj * 1024 + col); fl[jj] += (hv.x * wv.x + hv.y * wv.y) + (hv.z * wv.z + hv.w * wv.w); }
        }
        const int lane = F.lane; const bool b5 = (lane & 32) != 0, b4 = (lane & 16) != 0, b3 = (lane & 8) != 0;
        float r4[4];
#pragma unroll
        for (int u = 0; u < 4; ++u) { const float keep = b5 ? fl[u + 4] : fl[u], send = b5 ? fl[u] : fl[u + 4]; r4[u] = keep + __shfl_xor(send, 32); }
        float r2[2];
#pragma unroll
        for (int u = 0; u < 2; ++u) { const float keep = b4 ? r4[u + 2] : r4[u], send = b4 ? r4[u] : r4[u + 2]; r2[u] = keep + __shfl_xor(send, 16); }
        float r1; { const float keep = b3 ? r2[1] : r2[0], send = b3 ? r2[0] : r2[1]; r1 = keep + __shfl_xor(send, 8); }
        r1 += __shfl_xor(r1, 4); r1 += __shfl_xor(r1, 2); r1 += __shfl_xor(r1, 1);
        if ((lane & 7) == 0) { const int jj = lane >> 3; const float z = r1 + b_forget[jj]; const float ls = fminf(z, 0.f) - log1pf(__expf(-fabsf(z))); LOGF[(size_t)row * 8 + jj] = ls; }
        }}
#pragma unroll
        for (int j = 0; j < 4; ++j) cur[j] = nxt[j];
    }
}

constexpr int KP = 72;
constexpr int VPF = 68;
constexpr int VPS = 260;
struct FlashState { f32x16 o[2]; float m, l; };

__device__ __forceinline__ void flash_tail(FlashState& st, f32x16& s0, f32x16& s1, const LAS bf16* Vs, int vp, int r32, int hi) {
    float mt = s0[0];
#pragma unroll
    for (int r = 1; r < 16; ++r) mt = fmaxf(mt, s0[r]);
#pragma unroll
    for (int r = 0; r < 16; ++r) mt = fmaxf(mt, s1[r]);
    mt = fmaxf(mt, __shfl_xor(mt, 32));
    const float mn = fmaxf(st.m, mt);
    const float alpha = __expf(st.m - mn);
    st.m = mn;
    float ps = 0.f;
#pragma unroll
    for (int r = 0; r < 16; ++r) { s0[r] = __expf(s0[r] - mn); ps += s0[r]; }
#pragma unroll
    for (int r = 0; r < 16; ++r) { s1[r] = __expf(s1[r] - mn); ps += s1[r]; }
    st.l = st.l * alpha + ps;
    if (__any(alpha != 1.0f)) {
#pragma unroll
        for (int r = 0; r < 16; ++r) { st.o[0][r] *= alpha; st.o[1][r] *= alpha; }
    }
#pragma unroll
    for (int blk = 0; blk < 2; ++blk)
#pragma unroll
        for (int s = 0; s < 2; ++s) {
            v4u pw;
            if (blk == 0) { pw.x = cvtpk(s0[8 * s + 0], s0[8 * s + 1]); pw.y = cvtpk(s0[8 * s + 2], s0[8 * s + 3]); pw.z = cvtpk(s0[8 * s + 4], s0[8 * s + 5]); pw.w = cvtpk(s0[8 * s + 6], s0[8 * s + 7]); }
            else          { pw.x = cvtpk(s1[8 * s + 0], s1[8 * s + 1]); pw.y = cvtpk(s1[8 * s + 2], s1[8 * s + 3]); pw.z = cvtpk(s1[8 * s + 4], s1[8 * s + 5]); pw.w = cvtpk(s1[8 * s + 6], s1[8 * s + 7]); }
            const bf16x8 pf = __builtin_bit_cast(bf16x8, pw);
#pragma unroll
            for (int db = 0; db < 2; ++db) {
                const LAS bf16* vp0 = Vs + (32 * db + r32) * vp + 32 * blk + 16 * s + 4 * hi;
                const s16x4 lo = *(const LAS s16x4*)vp0, hh = *(const LAS s16x4*)(vp0 + 8);
                const bf16x8 vf = __builtin_shufflevector(lo, hh, 0, 1, 2, 3, 4, 5, 6, 7);
                st.o[db] = MFMA32(vf, pf, st.o[db]);
            }
        }
}
__device__ __forceinline__ void flash_qk(f32x16& s0, f32x16& s1, const bf16x8 (&qf)[4], const LAS bf16* Ks, int r32, int hi) {
    s0 = (f32x16){0.f}; s1 = (f32x16){0.f};
#pragma unroll
    for (int r = 0; r < 16; ++r) { s0[r] = 0.f; s1[r] = 0.f; }
#pragma unroll
    for (int ks = 0; ks < 4; ++ks) {
        const bf16x8 a0 = *(const LAS bf16x8*)(Ks + r32 * KP + 16 * ks + 8 * hi);
        const bf16x8 a1 = *(const LAS bf16x8*)(Ks + (32 + r32) * KP + 16 * ks + 8 * hi);
        s0 = MFMA32(a0, qf[ks], s0); s1 = MFMA32(a1, qf[ks], s1);
    }
}
__device__ __forceinline__ void flash_store(const FlashState& st, bf16* orow, int hi) {
    float lt = st.l + __shfl_xor(st.l, 32);
    const float inv = 1.0f / lt;
#pragma unroll
    for (int db = 0; db < 2; ++db)
#pragma unroll
        for (int rg = 0; rg < 4; ++rg) { u32x2 w; w.x = cvtpk(st.o[db][4 * rg] * inv, st.o[db][4 * rg + 1] * inv); w.y = cvtpk(st.o[db][4 * rg + 2] * inv, st.o[db][4 * rg + 3] * inv);
            *(u32x2*)(orow + 32 * db + 8 * rg + 4 * hi) = w; }
}

__device__ __forceinline__ void fox_unit(Frame& F, int b, int h, int qb, float& kmax2) {
    const bf16* proj = (const bf16*)(((unsigned char*)karg(19)) + WS_PROJ); const float* LOGF = (const float*)(((unsigned char*)karg(19)) + WS_LOGF); bf16* OB = (bf16*)(((unsigned char*)karg(19)) + WS_OB);
    LAS float* Fs = (LAS float*)(F.lds);
    LAS float* wtot = (LAS float*)(F.lds + 16384);
    LAS bf16* Kb = (LAS bf16*)(F.lds + 16384 + 128);
    LAS bf16* Vb = (LAS bf16*)(F.lds + 16384 + 128 + 2 * 64 * KP * 2);
    const int lane = F.lane, wave = F.wave, tid = F.tid, r32 = lane & 31, hi = lane >> 5;
    const int q_end = 256 * (qb + 1), NT = q_end / 64;
    const size_t rowbase = (size_t)b * SEQ;
    if (kmax2 < 0.f) {
        float v[8]; float run = 0.f;
#pragma unroll
        for (int i = 0; i < 8; ++i) { const int pos = tid * 8 + i; const float lf = (pos < q_end) ? LOGF[(rowbase + pos) * 8 + h] : 0.f; run += lf; v[i] = run; }
        float inc = run;
#pragma unroll
        for (int o = 1; o < 64; o <<= 1) { const float t = __shfl_up(inc, o); if (lane >= o) inc += t; }
        if (lane == 63) wtot[wave] = inc;
        __syncthreads();
        float off = inc - run;
        for (int w = 0; w < wave; ++w) off += wtot[w];
#pragma unroll
        for (int i = 0; i < 8; ++i) Fs[tid * 8 + i] = v[i] + off;
    }
    const int qrow = 256 * qb + 32 * wave + r32;
    bf16x8 qf[4];
    { const bf16* qp = proj + (rowbase + qrow) * NPROJ + C_QB + 64 * h + 8 * hi;
#pragma unroll
      for (int ks = 0; ks < 4; ++ks) qf[ks] = *(const bf16x8*)(qp + 16 * ks); }
    const int tq = 4 * qb + (wave >> 1);
    {
        float qn = 0.f;
#pragma unroll
        for (int ks = 0; ks < 4; ++ks)
#pragma unroll
            for (int j = 0; j < 8; ++j) { const float e = __uint_as_float(((unsigned)(unsigned short)qf[ks][j]) << 16); qn += e * e; }
        qn += __shfl_xor(qn, 32);
#pragma unroll
        for (int o = 1; o < 32; o <<= 1) qn = fmaxf(qn, __shfl_xor(qn, o));
        float kn = 0.f;
        if (kmax2 < 0.f) {
            for (int p0 = 0; p0 < q_end; p0 += 4 * 64) {
                v4u w4[4];
#pragma unroll
                for (int i = 0; i < 4; ++i) w4[i] = *(const v4u*)(proj + (rowbase + p0 + 64 * i + (tid >> 3)) * NPROJ + C_KB + 64 * h + 8 * (tid & 7));
#pragma unroll
                for (int i = 0; i < 4; ++i) { const unsigned wx = w4[i].x, wy = w4[i].y, wz = w4[i].z, ww = w4[i].w;
                    float s = bflo(wx) * bflo(wx) + bfhi(wx) * bfhi(wx) + bflo(wy) * bflo(wy) + bfhi(wy) * bfhi(wy) + bflo(wz) * bflo(wz) + bfhi(wz) * bfhi(wz) + bflo(ww) * bflo(ww) + bfhi(ww) * bfhi(ww);
                    s += __shfl_xor(s, 1); s += __shfl_xor(s, 2); s += __shfl_xor(s, 4);
                    kn = fmaxf(kn, s); } }
#pragma unroll
            for (int o = 1; o < 64; o <<= 1) kn = fmaxf(kn, __shfl_xor(kn, o));
        }
        if (lane == 0) { wtot[8 + wave] = qn; wtot[16 + wave] = kn; }
    }
    FlashState st; st.m = -INFINITY; st.l = 0.f;
#pragma unroll
    for (int r = 0; r < 16; ++r) { st.o[0][r] = 0.f; st.o[1][r] = 0.f; }
    const int srow = tid >> 3, sch = tid & 7;
    const bf16* kg = proj + (rowbase + srow) * NPROJ + C_KB + 64 * h + 8 * sch;
    const bf16* vg = proj + (rowbase + srow) * NPROJ + C_VB + 64 * h + 8 * sch;
    v4u kreg, vreg;
    { const size_t o = (size_t)(NT - 1) * 64 * NPROJ; kreg = *(const v4u*)(kg + o); vreg = *(const v4u*)(vg + o); }
    int cur = 0;
    {   *(LAS v4u*)(Kb + srow * KP + 8 * sch) = kreg;
        const unsigned short* vs = (const unsigned short*)&vreg;
#pragma unroll
        for (int i = 0; i < 8; ++i) Vb[(8 * sch + i) * VPF + srow] = vs[i];
    }
    __syncthreads();
    const float fq = Fs[qrow];
    int t_lo = 0;
    {
        float qm = 0.f, km = 0.f;
#pragma unroll
        for (int w = 0; w < 8; ++w) { qm = fmaxf(qm, wtot[8 + w]); km = fmaxf(km, wtot[16 + w]); }
        if (kmax2 < 0.f) kmax2 = km;
        const float A = 0.125f * sqrtf(qm) * sqrtf(kmax2) * 1.01f, f0 = Fs[256 * qb];
        for (int t = NT - 5; t >= 0; --t) if (Fs[64 * t + 63] - f0 > 2.0f * A + 60.0f) { t_lo = t + 1; break; }
    }
    for (int t = NT - 1; t >= t_lo; --t) {
        if (t > t_lo) { const size_t o = (size_t)(t - 1) * 64 * NPROJ; kreg = *(const v4u*)(kg + o); vreg = *(const v4u*)(vg + o); }
        if (t <= tq) {
            const LAS bf16* Ks = Kb + cur * 64 * KP; const LAS bf16* Vs = Vb + cur * 64 * VPF;
            f32x16 s0, s1; flash_qk(s0, s1, qf, Ks, r32, hi);
            const LAS float* Fk = Fs + 64 * t;
            const bool diag = (t == tq);
#pragma unroll
            for (int rg = 0; rg < 4; ++rg) {
                const f32x4 f0 = *(const LAS f32x4*)(Fk + 8 * rg + 4 * hi), f1 = *(const LAS f32x4*)(Fk + 32 + 8 * rg + 4 * hi);
#pragma unroll
                for (int i = 0; i < 4; ++i) { const int r = 4 * rg + i; const int kv = 64 * t + 8 * rg + 4 * hi + i;
                    float a = s0[r] * 0.125f + (fq - f0[i]); float c = s1[r] * 0.125f + (fq - f1[i]);
                    if (diag) { if (kv > qrow) a = -INFINITY; if (kv + 32 > qrow) c = -INFINITY; }
                    s0[r] = a; s1[r] = c; }
            }
            flash_tail(st, s0, s1, Vs, VPF, r32, hi);
        }
        if (t > t_lo) {
            const int nb = cur ^ 1;
            *(LAS v4u*)(Kb + nb * 64 * KP + srow * KP + 8 * sch) = kreg;
            const unsigned short* vs = (const unsigned short*)&vreg;
#pragma unroll
            for (int i = 0; i < 8; ++i) Vb[nb * 64 * VPF + (8 * sch + i) * VPF + srow] = vs[i];
        }
        __syncthreads();
        cur ^= 1;
    }
    flash_store(st, OB + (rowbase + qrow) * 512 + 64 * h, hi);
    __syncthreads();
}

__device__ const unsigned char T5_BUCKET[128] = {0,1,2,3,4,5,6,7,8,9,10,11,12,13,14,15,16,16,16,17,17,18,18,18,19,19,19,20,20,20,20,21,21,21,21,22,22,22,22,22,23,23,23,23,23,23,24,24,24,24,24,24,25,25,25,25,25,25,25,26,26,26,26,26,26,26,26,27,27,27,27,27,27,27,27,27,27,28,28,28,28,28,28,28,28,28,28,29,29,29,29,29,29,29,29,29,29,29,29,30,30,30,30,30,30,30,30,30,30,30,30,30,30,31,31,31,31,31,31,31,31,31,31,31,31,31,31,31};

__device__ __forceinline__ void swa_unit(Frame& F, int b, int kvh, int n) {
    const bf16* proj = (const bf16*)(((unsigned char*)karg(19)) + WS_PROJ); bf16* OA = (bf16*)(((unsigned char*)karg(19)) + WS_OA);
    const float* sinks = ((const float*)karg(8)); const float* rel_bias = ((const float*)karg(12));
    LAS bf16* Kb = (LAS bf16*)(F.lds);
    LAS bf16* Vb = (LAS bf16*)(F.lds + 36864);
    LAS float* bt = (LAS float*)(F.lds + 36864 + 33280);
    const int lane = F.lane, wave = F.wave, tid = F.tid, r32 = lane & 31, hi = lane >> 5;
    const size_t rowbase = (size_t)b * SEQ;
    {
        const int g = tid >> 7, d = tid & 127;
        bt[tid] = rel_bias[(int)T5_BUCKET[d] * 8 + kvh * 4 + g];
#pragma unroll
        for (int i = 0; i < 4; ++i) {
            const int idx = tid + i * NTHR, kb = idx >> 3, sch = idx & 7; const int pos = 128 * (n - 1) + kb;
            v4u kreg = (v4u){0u, 0u, 0u, 0u}, vreg = (v4u){0u, 0u, 0u, 0u};
            if (pos >= 0) { const bf16* p = proj + (rowbase + pos) * NPROJ + 64 * kvh + 8 * sch; kreg = *(const v4u*)(p + C_KA); vreg = *(const v4u*)(p + C_VA); }
            *(LAS v4u*)(Kb + kb * KP + 8 * sch) = kreg;
            const unsigned short* vs = (const unsigned short*)&vreg;
#pragma unroll
            for (int j = 0; j < 8; ++j) Vb[(8 * sch + j) * VPS + kb] = vs[j];
        }
    }
    __syncthreads();
    const int g = wave & 3, qh = wave >> 2, head = kvh * 4 + g;
    const LAS float* btg = bt + g * 128;
    for (int sb = 0; sb < 2; ++sb) {
        const int qrel0 = 64 * qh + 32 * sb, qrel = qrel0 + r32;
        const size_t row = rowbase + 128 * n + qrel;
        bf16x8 qf[4];
        { const bf16* qp = proj + row * NPROJ + C_QA + 64 * head + 8 * hi;
#pragma unroll
          for (int ks = 0; ks < 4; ++ks) qf[ks] = *(const bf16x8*)(qp + 16 * ks); }
        FlashState st; st.m = sinks[head]; st.l = (hi == 0) ? 1.0f : 0.0f;
#pragma unroll
        for (int r = 0; r < 16; ++r) { st.o[0][r] = 0.f; st.o[1][r] = 0.f; }
        const int t_lo = (qrel0 + 1) >> 6, t_hi = (qrel0 + 159) >> 6;
        for (int t = t_lo; t <= t_hi; ++t) {
            f32x16 s0, s1; flash_qk(s0, s1, qf, Kb + t * 64 * KP, r32, hi);
#pragma unroll
            for (int r = 0; r < 16; ++r) {
                const int kb0 = 64 * t + crow(r, hi), kb1 = kb0 + 32;
                const int d0 = 128 + qrel - kb0, d1 = d0 - 32;
                const bool v0 = (d0 >= 0) && (d0 < 128) && (n > 0 || kb0 >= 128);
                const bool v1 = (d1 >= 0) && (d1 < 128) && (n > 0 || kb1 >= 128);
                const float b0 = btg[d0 & 127], b1 = btg[d1 & 127];
                s0[r] = v0 ? (s0[r] * 0.125f + b0) : -INFINITY;
                s1[r] = v1 ? (s1[r] * 0.125f + b1) : -INFINITY;
            }
            flash_tail(st, s0, s1, Vb + 64 * t, VPS, r32, hi);
        }
        flash_store(st, OA + row * 512 + 64 * head, hi);
    }
    __syncthreads();
}
__device__ __forceinline__ void p3_attention(Frame& F) {
    for (int item = F.vcu; item < 256; item += F.G) {
        swa_unit(F, item >> 6, (item >> 5) & 1, item & 31);
        const int bh = item >> 3, j = item & 7;
        float kmax2 = -1.0f;
        fox_unit(F, bh >> 3, bh & 7, 15 - j, kmax2);
        fox_unit(F, bh >> 3, bh & 7, j, kmax2);
    }
}

struct PairOrder {
    pg8::StaticOrder S;
    __device__ bool next(int i, pg8::Unit& u) const { if (!S.next(i >> 1, u)) return false; u.src = i & 1; return true; }
    __device__ __forceinline__ void a_ready(const pg8::Unit&) const {}
    __device__ __forceinline__ void done(const pg8::Unit&) const {}
};
__device__ __forceinline__ float sigmoidf_(float z) { return 1.0f / (1.0f + __expf(-z)); }
struct EpiGate {
    static constexpr bool PERM = true, AFTER_DRAIN = false, CHAIN = true;
    const bf16* proj; bf16* mixed;
    __device__ __forceinline__ void operator()(pg8::f32x4 (&acc)[2][2][4][2], const pg8::Unit& u, int wr, int wc, int fr, int fq) const {
#pragma unroll
        for (int ai = 0; ai < 2; ++ai)
#pragma unroll
            for (int m = 0; m < 4; ++m) { const size_t row = (size_t)u.pm * 256 + ai * 128 + wr * 64 + m * 16 + fr;
#pragma unroll
                for (int bj = 0; bj < 2; ++bj) { const int col0 = u.pn * 256 + bj * 128 + wc * 32 + 8 * fq;
                    const v4u gb = *(const v4u*)(proj + row * NPROJ + C_GLB + col0);
                    const unsigned gbw[4] = {gb.x, gb.y, gb.z, gb.w};
                    if (u.src == 0) {
                        const v4u ga = *(const v4u*)(proj + row * NPROJ + C_GLA + col0);
                        const unsigned gaw[4] = {ga.x, ga.y, ga.z, ga.w};
#pragma unroll
                        for (int e = 0; e < 8; ++e) { const float za = (e & 1) ? bfhi(gaw[e >> 1]) : bflo(gaw[e >> 1]), zb = (e & 1) ? bfhi(gbw[e >> 1]) : bflo(gbw[e >> 1]);
                            const float ratio = (1.0f + __expf(-zb)) * __builtin_amdgcn_rcpf(1.0f + __expf(-za));
                            acc[ai][bj][m][e >> 2][e & 3] *= ratio; }
                    } else {
                        float v[8];
#pragma unroll
                        for (int e = 0; e < 8; ++e) { const float zb = (e & 1) ? bfhi(gbw[e >> 1]) : bflo(gbw[e >> 1]); v[e] = acc[ai][bj][m][e >> 2][e & 3] * __builtin_amdgcn_rcpf(1.0f + __expf(-zb)); }
                        v4u w; w.x = cvtpk(v[0], v[1]); w.y = cvtpk(v[2], v[3]); w.z = cvtpk(v[4], v[5]); w.w = cvtpk(v[6], v[7]);
                        *(v4u*)(mixed + row * D + col0) = w;
                    }
                }
            }
    }
};
struct EpiRes {
    static constexpr bool PERM = true, AFTER_DRAIN = false, CHAIN = false;
    const float* x; const float* mod; float* x1;
    __device__ __forceinline__ void operator()(const pg8::f32x4 (&acc)[2][2][4][2], const pg8::Unit& u, int wr, int wc, int fr, int fq) const {
#pragma unroll
        for (int ai = 0; ai < 2; ++ai)
#pragma unroll
            for (int m = 0; m < 4; ++m) { const size_t row = (size_t)u.pm * 256 + ai * 128 + wr * 64 + m * 16 + fr; const int b = (int)(row >> 12);
#pragma unroll
                for (int bj = 0; bj < 2; ++bj) { const int col0 = u.pn * 256 + bj * 128 + wc * 32 + 8 * fq;
#pragma unroll
                    for (int n = 0; n < 2; ++n) { const int col = col0 + 4 * n;
                        const pg8::f32x4 xin = *(const pg8::f32x4*)(x + row * D + col), gt = *(const pg8::f32x4*)(mod + b * NMOD + 2048 + col);
                        *(pg8::f32x4*)(x1 + row * D + col) = xin + gt * acc[ai][bj][m][n]; } }
            }
    }
};

__device__ __forceinline__ void p6_norm2(Frame& F) {
    const float* x1 = (const float*)(((unsigned char*)karg(19)) + WS_X1); const float* g2 = ((const float*)karg(3)); const float* MOD = (const float*)(((unsigned char*)karg(19)) + WS_MOD); bf16* H2 = (bf16*)(((unsigned char*)karg(19)) + WS_H2); unsigned char* H2Q = (unsigned char*)(((unsigned char*)karg(19)) + WS_H2Q); float* H2S = (float*)(((unsigned char*)karg(19)) + WS_H2S);
    const int gw = F.vcu * NWAVES + F.wave, NGW = F.G * NWAVES;
    f32x4 cur[4], nxt[4];
    if (gw < M) { const f32x4* xr = (const f32x4*)(x1 + (size_t)gw * D) + F.lane;
#pragma unroll
        for (int j = 0; j < 4; ++j) cur[j] = xr[64 * j]; }
    for (int row = gw; row < M; row += NGW) {
        { const int nrow = row + NGW; if (nrow < M) { const f32x4* xr = (const f32x4*)(x1 + (size_t)nrow * D) + F.lane;
#pragma unroll
            for (int j = 0; j < 4; ++j) nxt[j] = xr[64 * j]; } }
        {
        f32x4 v[4], hq[4]; float ss = 0.f;
#pragma unroll
        for (int j = 0; j < 4; ++j) { v[j] = cur[j]; ss += (v[j].x * v[j].x + v[j].y * v[j].y) + (v[j].z * v[j].z + v[j].w * v[j].w); }
        ss = wave_sum(ss);
        const float rstd = 1.0f / sqrtf(ss * (1.0f / D) + EPS);
        const int b = row >> 12; const float* mb = MOD + b * NMOD;
#pragma unroll
        for (int j = 0; j < 4; ++j) { const int col = 4 * F.lane + 256 * j;
            const f32x4 g = *(const f32x4*)(g2 + col), sh = *(const f32x4*)(mb + 3072 + col), sc = *(const f32x4*)(mb + 4096 + col);
            const f32x4 hv = (v[j] * rstd) * g * (sc + 1.0f) + sh;
            u32x2 w; w.x = cvtpk(hv.x, hv.y); w.y = cvtpk(hv.z, hv.w);
            *(u32x2*)(H2 + (size_t)row * D + col) = w; hq[j] = hv; }
        float am = 0.f;
#pragma unroll
        for (int j = 0; j < 4; ++j) am = fmaxf(fmaxf(am, fmaxf(fabsf(hq[j].x), fabsf(hq[j].y))), fmaxf(fabsf(hq[j].z), fabsf(hq[j].w)));
#pragma unroll
        for (int o = 1; o < 64; o <<= 1) am = fmaxf(am, __shfl_xor(am, o));
        const float sc = am > 0.f ? am * (1.0f / 127.0f) : 1.0f, inv = 1.0f / sc;
        v4u qa;
#pragma unroll
        for (int j = 0; j < 4; ++j) { const int b0 = (int)rintf(hq[j].x * inv), b1 = (int)rintf(hq[j].y * inv), b2 = (int)rintf(hq[j].z * inv), b3 = (int)rintf(hq[j].w * inv);
            qa[j] = (unsigned)(b0 & 255) | ((unsigned)(b1 & 255) << 8) | ((unsigned)(b2 & 255) << 16) | ((unsigned)(b3 & 255) << 24); }
        *(v4u*)(H2Q + (size_t)row * D + 16 * F.lane) = qa;
        if (F.lane == 0) H2S[row] = sc;
        }
#pragma unroll
        for (int j = 0; j < 4; ++j) cur[j] = nxt[j];
    }
}

__device__ __forceinline__ unsigned f2ord(float f) { const unsigned u = __float_as_uint(f); return u ^ ((unsigned)((int)u >> 31) | 0x80000000u); }
__device__ __forceinline__ float ord2f(unsigned o) { const unsigned u = (o & 0x80000000u) ? (o & 0x7fffffffu) : ~o; return __uint_as_float(u); }
#define CE_DESC(a, b) do { const unsigned _x = (a), _y = (b); (a) = _x > _y ? _x : _y; (b) = _x > _y ? _y : _x; } while (0)
__device__ __forceinline__ void sort16(unsigned (&k)[16]) {
#pragma unroll
    for (int size = 2; size <= 16; size <<= 1)
#pragma unroll
        for (int stride = size >> 1; stride > 0; stride >>= 1)
#pragma unroll
            for (int i = 0; i < 16; ++i) { const int j = i ^ stride; if (j > i) { if ((i & size) == 0) CE_DESC(k[i], k[j]); else CE_DESC(k[j], k[i]); } }
}
__device__ __forceinline__ void merge16(unsigned (&a)[16], const unsigned (&b)[16]) {
#pragma unroll
    for (int i = 0; i < 16; ++i) a[i] = a[i] > b[15 - i] ? a[i] : b[15 - i];
#pragma unroll
    for (int stride = 8; stride > 0; stride >>= 1)
#pragma unroll
        for (int i = 0; i < 16; ++i) { const int j = i ^ stride; if (j > i) CE_DESC(a[i], a[j]); }
}
__device__ __forceinline__ void top16_of_64(unsigned (&g0)[16], unsigned (&g1)[16], unsigned (&g2)[16], unsigned (&g3)[16]) {
    sort16(g0); sort16(g1); sort16(g2); sort16(g3);
    merge16(g0, g1); merge16(g2, g3); merge16(g0, g2);
}
constexpr int NCAND = 50;
__device__ __forceinline__ void p8a_topk(Frame& F) {
    const bf16* QP = (const bf16*)(((unsigned char*)karg(19)) + WS_QP); const bf16* SUBK = (const bf16*)(((unsigned char*)karg(19)) + WS_SUBK);
    unsigned short* PIDX = (unsigned short*)(((unsigned char*)karg(19)) + WS_PIDX); float* PG = (float*)(((unsigned char*)karg(19)) + WS_PG);
    LAS unsigned short* Elds = (LAS unsigned short*)(F.lds) + F.wave * (NCAND * 64);
    const int lane = F.lane, r32 = lane & 31, hi = lane >> 5;
    const int gw = F.vcu * NWAVES + F.wave, NGW = F.G * NWAVES;
    for (int it2 = 0; it2 < 2 * ((M / 64 - F.vcu + F.G - 1) / F.G); ++it2) {
        const int wi = F.vcu + (it2 >> 1) * F.G;
        const int tile = 2 * wi + (it2 & 1);
        const int tok = tile * 32 + r32;
        { const int h = F.wave;
            unsigned top[2][16];
#pragma unroll
            for (int p = 0; p < 2; ++p) {
                bf16x8 qf[4];
                { const bf16* qp = QP + (size_t)tok * D + h * 128 + p * 64 + 8 * hi;
#pragma unroll
                  for (int ks = 0; ks < 4; ++ks) qf[ks] = *(const bf16x8*)(qp + 16 * ks); }
                const bf16* kp = SUBK + (size_t)((h * 2 + p) * 128 + r32) * 64 + 8 * hi;
                unsigned kk[4][16];
#pragma unroll
                for (int blk = 0; blk < 4; ++blk) {
                    f32x16 acc;
#pragma unroll
                    for (int r = 0; r < 16; ++r) acc[r] = 0.f;
#pragma unroll
                    for (int ks = 0; ks < 4; ++ks) { const bf16x8 a = *(const bf16x8*)(kp + (size_t)blk * 32 * 64 + 16 * ks); acc = MFMA32(a, qf[ks], acc); }
#pragma unroll
                    for (int r = 0; r < 16; ++r) { const int key = 32 * blk + crow(r, hi); kk[blk][r] = (f2ord(acc[r]) & ~127u) | (unsigned)(127 - key); }
                }
                top16_of_64(kk[0], kk[1], kk[2], kk[3]);
                unsigned other[16];
#pragma unroll
                for (int i = 0; i < 16; ++i) other[i] = xorx<32>(kk[0][i], lane);
                merge16(kk[0], other);
#pragma unroll
                for (int i = 0; i < 16; ++i) top[p][i] = kk[0][i];
            }
            float s1[16], s2[16]; unsigned i1[16], i2[16];
#pragma unroll
            for (int i = 0; i < 16; ++i) { s1[i] = ord2f(top[0][i] & ~127u); i1[i] = 127u - (top[0][i] & 127u); s2[i] = ord2f(top[1][i] & ~127u); i2[i] = 127u - (top[1][i] & 127u); }
            unsigned ck[4][16];
#pragma unroll
            for (int c = 0; c < 64; ++c) {
                if (c < NCAND) { constexpr int CA[NCAND] = {0,0,0,0,0,0,0,0,0,0,0,0,0,0,0,0,1,1,1,1,1,1,1,1,2,2,2,2,2,3,3,3,3,4,4,4,5,5,6,6,7,7,8,9,10,11,12,13,14,15}; constexpr int CB[NCAND] = {0,1,2,3,4,5,6,7,8,9,10,11,12,13,14,15,0,1,2,3,4,5,6,7,0,1,2,3,4,0,1,2,3,0,1,2,0,1,0,1,0,1,0,0,0,0,0,0,0,0}; const int a = CA[c], b = CB[c];
                    ck[c >> 4][c & 15] = (f2ord(s1[a] + s2[b]) & ~63u) | (unsigned)(63 - c);
                    Elds[c * 64 + lane] = (unsigned short)(i1[a] * 128u + i2[b]); }
                else ck[c >> 4][c & 15] = 0u;
            }
            top16_of_64(ck[0], ck[1], ck[2], ck[3]);
            float w[16]; float wsum = 0.f; const float v0 = ord2f(ck[0][0] & ~63u);
#pragma unroll
            for (int r = 0; r < 16; ++r) { w[r] = __expf(ord2f(ck[0][r] & ~63u) - v0); wsum += w[r]; }
            const float winv = 1.0f / wsum;
#pragma unroll
            for (int r = 0; r < 16; ++r) if ((r >> 3) == hi) {
                const int c = 63 - (int)(ck[0][r] & 63u);
                const unsigned short eid = Elds[c * 64 + lane];
                PIDX[(size_t)tok * 128 + h * 16 + r] = eid; PG[(size_t)tok * 128 + h * 16 + r] = w[r] * winv; }
        }
    }
}

__device__ __forceinline__ float gelu_erf(float v) { return 0.5f * v * (1.0f + erff(v * 0.70710678118654752f)); }

#define PROBE_REPA 1
#define PROBE_REPB 1
constexpr int NR = 16, RSH = 17, BSA = 8, BSB = 4, ELP = 136, TPS = 8;
__device__ __forceinline__ void sort128(unsigned& e0, unsigned& e1, int lane) {
#pragma unroll
    for (int size = 2; size <= 128; size <<= 1) {
#pragma unroll
        for (int stride = size >> 1; stride > 0; stride >>= 1) {
            if (stride == 64) { const unsigned lo = e0 < e1 ? e0 : e1, hi = e0 < e1 ? e1 : e0; e0 = lo; e1 = hi; }
            else {
                const bool lower = (lane & stride) == 0;
                const bool asc0 = (size == 128) ? true : (size == 64 ? true : ((lane & size) == 0));
                const bool asc1 = (size == 128) ? true : (size == 64 ? false : ((lane & size) == 0));
                const unsigned p0 = xorx_sw(e0, lane, stride), p1 = xorx_sw(e1, lane, stride);
                const unsigned mn0 = e0 < p0 ? e0 : p0, mx0 = e0 < p0 ? p0 : e0, mn1 = e1 < p1 ? e1 : p1, mx1 = e1 < p1 ? p1 : e1;
                e0 = (lower == asc0) ? mn0 : mx0; e1 = (lower == asc1) ? mn1 : mx1;
            }
        }
    }
}
__device__ __forceinline__ float dppf(float v, const int ctrl_sel) { return v; }
#define DPP_F(v, CTRL) __uint_as_float(__builtin_amdgcn_update_dpp(0, __float_as_uint(v), (CTRL), 0xF, 0xF, true))
__device__ __forceinline__ float reduce8_t(const float (&dd)[8], int lane) {
    float r4[4];
#pragma unroll
    for (int u = 0; u < 4; ++u) { const auto p = __builtin_amdgcn_permlane32_swap(__float_as_uint(dd[u]), __float_as_uint(dd[u + 4]), false, false); r4[u] = __uint_as_float(p[0]) + __uint_as_float(p[1]); }
    float r2[2];
#pragma unroll
    for (int u = 0; u < 2; ++u) { const auto p = __builtin_amdgcn_permlane16_swap(__float_as_uint(r4[u]), __float_as_uint(r4[u + 2]), false, false); r2[u] = __uint_as_float(p[0]) + __uint_as_float(p[1]); }
    const bool b3 = (lane & 8) != 0;
    const float keep = b3 ? r2[1] : r2[0], send = b3 ? r2[0] : r2[1];
    float r1 = keep + DPP_F(send, 0x128);
    r1 += DPP_F(r1, 0xB1);
    r1 += DPP_F(r1, 0x4E);
    r1 += DPP_F(r1, 0x141);
    return r1;
}
template <int BS> __device__ __forceinline__ void sw_issue(v4u (&buf)[BS], const LAS unsigned* el, const unsigned char* tab, unsigned voff) {
#pragma unroll
    for (int i = 0; i < BS; ++i) { const unsigned off = (el[i] << 10) + voff;
        buf[i] = *(const v4u*)(tab + off); }
}
template <int BS> __device__ __forceinline__ void sw_proc_a(const v4u (&buf)[BS], const v4u& hq, LAS float* wl, int s, int n, int lane) {
    const int hx = (int)hq.x, hy = (int)hq.y, hz = (int)hq.z, hw = (int)hq.w;
    float dd[8];
#pragma unroll
    for (int i = 0; i < 8; ++i) dd[i] = 0.f;
#pragma unroll
    for (int i = 0; i < BS; ++i) if (i < n) { const int dx = (int)buf[i].x, dy = (int)buf[i].y, dz = (int)buf[i].z, dw = (int)buf[i].w;
        int t = __builtin_amdgcn_sdot4(hx, dx, 0, false); t = __builtin_amdgcn_sdot4(hy, dy, t, false); t = __builtin_amdgcn_sdot4(hz, dz, t, false); t = __builtin_amdgcn_sdot4(hw, dw, t, false);
        dd[i] = (float)t; }
    const float r1 = reduce8_t(dd, lane);
    if ((lane & 7) == 0 && (lane >> 3) < n) wl[s + (lane >> 3)] = r1;
}
template <int BS> __device__ __forceinline__ void sw_proc_b(const v4u (&buf)[BS], f32x2_t (&acc)[8], const LAS float* wl, int s, int n) {
    float wr[BS];
#pragma unroll
    for (int i = 0; i < BS; ++i) wr[i] = wl[s + i];
#pragma unroll
    for (int i = 0; i < BS; ++i) if (i < n) {
        const float w = wr[i];
        const f32x2_t wv = {w, w};
        const unsigned ux = buf[i].x, uy = buf[i].y, uz = buf[i].z, uw = buf[i].w;
        acc[0] += wv * __builtin_amdgcn_cvt_pk_f32_fp8((int)ux, false); acc[1] += wv * __builtin_amdgcn_cvt_pk_f32_fp8((int)ux, true);
        acc[2] += wv * __builtin_amdgcn_cvt_pk_f32_fp8((int)uy, false); acc[3] += wv * __builtin_amdgcn_cvt_pk_f32_fp8((int)uy, true);
        acc[4] += wv * __builtin_amdgcn_cvt_pk_f32_fp8((int)uz, false); acc[5] += wv * __builtin_amdgcn_cvt_pk_f32_fp8((int)uz, true);
        acc[6] += wv * __builtin_amdgcn_cvt_pk_f32_fp8((int)uw, false); acc[7] += wv * __builtin_amdgcn_cvt_pk_f32_fp8((int)uw, true); }
}
__device__ __forceinline__ void sw_warm(v4u (&pf)[4], const unsigned char* tab, int range, int lw, unsigned voff) {
#pragma unroll
    for (int i = 0; i < 4; ++i) { const unsigned off = ((unsigned)(range * 1024 + lw * 4 + i) << 10) + voff; pf[i] = *(const v4u*)(tab + off); }
}
__device__ __forceinline__ void sw_warm_done(const v4u (&pf)[4]) {
#pragma unroll
    for (int i = 0; i < 4; ++i) asm volatile("" :: "v"(pf[i]));
}
template <int FAKE> __device__ __forceinline__ void p8b_sweep(Frame& F) {
    const float* X1 = (const float*)(((unsigned char*)karg(19)) + WS_X1); const float* MOD = (const float*)(((unsigned char*)karg(19)) + WS_MOD);
    const unsigned char* H2Q = (const unsigned char*)(((unsigned char*)karg(19)) + WS_H2Q); const float* H2S = (const float*)(((unsigned char*)karg(19)) + WS_H2S);
    const unsigned char* EDq = (const unsigned char*)(((unsigned char*)karg(19)) + WS_ED); const unsigned char* EUq = (const unsigned char*)(((unsigned char*)karg(19)) + WS_EU); const float* EDS = (const float*)(((unsigned char*)karg(19)) + WS_EDS);
    const unsigned short* PIDX = (const unsigned short*)(((unsigned char*)karg(19)) + WS_PIDX); const float* PG = (const float*)(((unsigned char*)karg(19)) + WS_PG);
    const float* fg = ((const float*)karg(17));
    const int gw = F.vcu * NWAVES + F.wave, NGW = F.G * NWAVES;
    for (int wi = F.vcu; wi < M / 64; wi += F.G) {
        const int tb = wi * 8 + F.wave;
        unsigned ones = ~0u; asm volatile("" : "+s"(ones));
        int lane = (int)__builtin_amdgcn_mbcnt_hi(ones, __builtin_amdgcn_mbcnt_lo(ones, 0u)); asm volatile("" : "+v"(lane));
        const int tok0 = tb * 8;
        unsigned E0[8], E1[8];
        LAS float* Wl = (LAS float*)(F.lds) + F.wave * 1024;
        LAS unsigned* El = (LAS unsigned*)(F.lds + 32768) + F.wave * (8 * ELP);
        unsigned voff = 16u * (unsigned)lane; asm volatile("" : "+v"(voff));
#pragma unroll
        for (int k = 0; k < 8; ++k) {
            const size_t base = (size_t)(tok0 + k) * 128;
            E0[k] = ((unsigned)PIDX[base + lane] << 7) | (unsigned)lane; E1[k] = ((unsigned)PIDX[base + 64 + lane] << 7) | (unsigned)(64 + lane);
            sort128(E0[k], E1[k], lane);
            if (FAKE) { E0[k] = (E0[k] & 0x1ffffu) ; E1[k] = (E1[k] & 0x1ffffu); sort128(E0[k], E1[k], lane); }
            El[k * ELP + lane] = E0[k] >> 7; El[k * ELP + 64 + lane] = E1[k] >> 7;
            if (lane < 8) El[k * ELP + 128 + lane] = (unsigned)__builtin_amdgcn_readlane((int)E1[k], 63) >> 7;
        }
        for (int repa = 0; repa < PROBE_REPA; ++repa) {
            v4u hq[8];
#pragma unroll
            for (int k = 0; k < 8; ++k) hq[k] = *(const v4u*)(H2Q + (size_t)(tok0 + k) * D + 16 * lane);
            int pos[8];
#pragma unroll
            for (int k = 0; k < 8; ++k) pos[k] = 0;
            v4u bA[BSA], bB[BSA]; int ps = 0, pn = 0;
            for (int r = 0; r < NR; ++r) {
#pragma unroll
                for (int k = 0; k < 8; ++k) {
                    constexpr int dummy = 0; (void)dummy;
                    const int kp = (k + 7) & 7;
                    const int c = __builtin_popcountll(__ballot((E0[k] >> RSH) == (unsigned)r)) + __builtin_popcountll(__ballot((E1[k] >> RSH) == (unsigned)r));
                    int s = __builtin_amdgcn_readfirstlane(pos[k]); const int e_end = __builtin_amdgcn_readfirstlane(s + c); pos[k] = e_end;
                    const int n1 = (e_end - s) < BSA ? (e_end - s) : BSA;
                    if (k & 1) sw_issue<BSA>(bB, El + k * ELP + s, EDq, voff); else sw_issue<BSA>(bA, El + k * ELP + s, EDq, voff);
                    if (pn > 0) { if (k & 1) sw_proc_a<BSA>(bA, hq[kp], Wl + kp * 128, ps, pn, lane); else sw_proc_a<BSA>(bB, hq[kp], Wl + kp * 128, ps, pn, lane); }
                    ps = s; pn = n1; s += n1;
                    for (; s < e_end; s += BSA) {
                        const int n = (e_end - s) < BSA ? (e_end - s) : BSA;
                        if (k & 1) { sw_issue<BSA>(bA, El + k * ELP + s, EDq, voff); sw_proc_a<BSA>(bA, hq[k], Wl + k * 128, s, n, lane); }
                        else       { sw_issue<BSA>(bB, El + k * ELP + s, EDq, voff); sw_proc_a<BSA>(bB, hq[k], Wl + k * 128, s, n, lane); }
                    }
                }
            }
            if (pn > 0) sw_proc_a<BSA>(bB, hq[7], Wl + 7 * 128, ps, pn, lane);
        }
#pragma unroll
        for (int k = 0; k < 8; ++k) { int tk = tok0 + k; asm volatile("" : "+s"(tk)); const size_t base = (size_t)tk * 128; const float sh = H2S[tk];
            const float r0 = Wl[k * 128 + lane], r1 = Wl[k * 128 + 64 + lane];
            Wl[k * 128 + lane] = PG[base + (E0[k] & 127u)] * gelu_erf(r0 * sh * EDS[E0[k] >> 7]) * 0.0625f;
            Wl[k * 128 + 64 + lane] = PG[base + (E1[k] & 127u)] * gelu_erf(r1 * sh * EDS[E1[k] >> 7]) * 0.0625f; }
        int ln = lane; asm volatile("" : "+v"(ln));
#pragma unroll
        for (int sub = 0; sub < 8 / TPS; ++sub) {
        f32x2_t acc[TPS][8];
        for (int repb = 0; repb < PROBE_REPB; ++repb) {
#pragma unroll
            for (int kk = 0; kk < TPS; ++kk)
#pragma unroll
                for (int i = 0; i < 8; ++i) acc[kk][i] = (f32x2_t){0.f, 0.f};
            int pos[TPS];
#pragma unroll
            for (int kk = 0; kk < TPS; ++kk) pos[kk] = 0;
            v4u bA[BSB], bB[BSB]; int ps = 0, pn = 0;
            for (int r = 0; r < NR; ++r) {
#pragma unroll
                for (int kk = 0; kk < TPS; ++kk) {
                    const int k = sub * TPS + kk, kkp = (kk + TPS - 1) % TPS, kp = sub * TPS + kkp;
                    const int c = __builtin_popcountll(__ballot((E0[k] >> RSH) == (unsigned)r)) + __builtin_popcountll(__ballot((E1[k] >> RSH) == (unsigned)r));
                    int s = __builtin_amdgcn_readfirstlane(pos[kk]); const int e_end = __builtin_amdgcn_readfirstlane(s + c); pos[kk] = e_end;
                    const int n1 = (e_end - s) < BSB ? (e_end - s) : BSB;
                    if (kk & 1) sw_issue<BSB>(bB, El + k * ELP + s, EUq, voff); else sw_issue<BSB>(bA, El + k * ELP + s, EUq, voff);
                    if (pn > 0) { if (kk & 1) sw_proc_b<BSB>(bA, acc[kkp], Wl + kp * 128, ps, pn); else sw_proc_b<BSB>(bB, acc[kkp], Wl + kp * 128, ps, pn); }
                    ps = s; pn = n1; s += n1;
                    for (; s < e_end; s += BSB) {
                        const int n = (e_end - s) < BSB ? (e_end - s) : BSB;
                        if (kk & 1) { sw_issue<BSB>(bA, El + k * ELP + s, EUq, voff); sw_proc_b<BSB>(bA, acc[kk], Wl + k * 128, s, n); }
                        else        { sw_issue<BSB>(bB, El + k * ELP + s, EUq, voff); sw_proc_b<BSB>(bB, acc[kk], Wl + k * 128, s, n); }
                    }
                }
            }
            if (pn > 0) sw_proc_b<BSB>(bB, acc[TPS - 1], Wl + (sub * TPS + TPS - 1) * 128, ps, pn);
        }
#pragma unroll
        for (int kk = 0; kk < TPS; ++kk) {
            const int tok = tok0 + sub * TPS + kk; const int b = tok >> 12; const float* gt2 = MOD + b * NMOD + 5120;
            f32x4 x2[4]; float ss = 0.f;
#pragma unroll
            for (int j = 0; j < 4; ++j) { const int col = 4 * ln + 256 * j;
                const f32x4 xv = *(const f32x4*)(X1 + (size_t)tok * D + col), gv4 = *(const f32x4*)(gt2 + col);
#pragma unroll
                for (int i = 0; i < 4; ++i) { const float v = xv[i] + gv4[i] * acc[kk][2 * j + (i >> 1)][i & 1]; x2[j][i] = v; ss += v * v; } }
            ss = wave_sum_x(ss, ln);
            if (FAKE && ss != 12345.678f) continue;
            const float rstd = 1.0f / sqrtf(ss * (1.0f / D) + EPS);
#pragma unroll
            for (int j = 0; j < 4; ++j) { const int col = 4 * ln + 256 * j; const f32x4 gg = *(const f32x4*)(fg + col);
                *(f32x4*)(((float*)karg(18)) + (size_t)tok * D + col) = x2[j] * rstd * gg; }
        }
        }
    }
}

struct Args { const float* in[18]; float* out; unsigned char* ws; };
__global__ void __launch_bounds__(NTHR, 2) mega_fwd(Args args) {
    extern __shared__ __attribute__((aligned(16))) unsigned char lds[];
    Frame F;
    F.lds = (LAS unsigned char*)lds;
    F.tid = threadIdx.x; F.lane = F.tid & 63; F.wave = __builtin_amdgcn_readfirstlane(F.tid >> 6);
    F.G = gridDim.x; { const int bx = blockIdx.x; F.vcu = (F.G % 8 == 0) ? (bx % 8) * (F.G / 8) + bx / 8 : bx; }
    volatile LAS unsigned* MISC = (volatile LAS unsigned*)(F.lds + MISC_OFF);
    for (int u = F.tid; u < (LDS_BYTES - LDSCTL_OFF) / 4; u += NTHR) ((LAS unsigned*)(F.lds + LDSCTL_OFF))[u] = 0u;
    __syncthreads();
    gu32* ctl = (gu32*)(((unsigned char*)karg(19)) + WS_CTL);
    XcdBarrier bar = xcd_barrier_post((unsigned*)(ctl + CW_BAR), MISC + 8);
#define GRID_BAR() xcd_barrier(bar)
#define PROBE_TS -1
#define STAMP(i) do { if (PROBE_TS >= 0 && blockIdx.x == 0 && F.tid == 0) { const unsigned long long t_ = __builtin_amdgcn_s_memrealtime(); MISC[16 + 2 * (i)] = (unsigned)t_; MISC[17 + 2 * (i)] = (unsigned)(t_ >> 32); } } while (0)
#define PROBE_DBL -1

    STAMP(0);
    p0_prologue(F); GRID_BAR(); STAMP(1);
    if (PROBE_DBL == 0) { p0_prologue(F); GRID_BAR(); }
    p1_norm(F); p0_transposes(F); GRID_BAR(); STAMP(2);
    if (PROBE_DBL == 1) { p1_norm(F); GRID_BAR(); }
    {
    {
        pg8::Gemm g{(const pg8::bf16_t*)(((unsigned char*)karg(19)) + WS_H), (const pg8::bf16_t*)(((unsigned char*)karg(19)) + WS_WIN), M, NPROJ, D, nullptr, nullptr};
        pg8::StaticOrder S; S.init(M, NPROJ, F.G, (int)blockIdx.x);
        pg8::EpiBf16<0> E{(pg8::bf16_t*)(((unsigned char*)karg(19)) + WS_PROJ), NPROJ, nullptr, 0, 0, 1.f};
        pg8::gemm_phase<pg8::EpiBf16<0>, pg8::StaticOrder, true, true>(F.lds + RING_OFF, g, S, E);
        const int nwg = (M / 256) * (NPROJ / 256), busy = nwg % F.G;
        if (busy == 0) p0_quant_tables(F, F.vcu * NWAVES + F.wave, F.G * NWAVES);
        else if ((int)blockIdx.x >= busy) p0_quant_tables(F, ((int)blockIdx.x - busy) * NWAVES + F.wave, (F.G - busy) * NWAVES);
    }
    GRID_BAR(); STAMP(3);
    }
    p3_attention(F); GRID_BAR(); STAMP(4);
    if (PROBE_DBL == 3) { p3_attention(F); GRID_BAR(); }
    {
    {
        pg8::Gemm g{(const pg8::bf16_t*)(((unsigned char*)karg(19)) + WS_OA), (const pg8::bf16_t*)(((unsigned char*)karg(19)) + WS_WA), M, D, 512, (const pg8::bf16_t*)(((unsigned char*)karg(19)) + WS_OB), (const pg8::bf16_t*)(((unsigned char*)karg(19)) + WS_WB)};
        PairOrder S; S.S.init(M, D, F.G, (int)blockIdx.x);
        EpiGate E{(const bf16*)(((unsigned char*)karg(19)) + WS_PROJ), (bf16*)((float*)karg(18)) + (size_t)M * D};
        pg8::gemm_phase<EpiGate, PairOrder, false, true>(F.lds + RING_OFF, g, S, E);
    }
    GRID_BAR(); STAMP(5);
    }
    {
    {
        pg8::Gemm g{(const pg8::bf16_t*)((bf16*)((float*)karg(18)) + (size_t)M * D), (const pg8::bf16_t*)(((unsigned char*)karg(19)) + WS_WOUT), M, D, D, nullptr, nullptr};
        pg8::StaticOrder S; S.init(M, D, F.G, (int)blockIdx.x);
        EpiRes E{((const float*)karg(0)), (const float*)(((unsigned char*)karg(19)) + WS_MOD), (float*)(((unsigned char*)karg(19)) + WS_X1)};
        pg8::gemm_phase<EpiRes, pg8::StaticOrder, false, true>(F.lds + RING_OFF, g, S, E);
    }
    GRID_BAR(); STAMP(6);
    }
    p6_norm2(F); GRID_BAR(); STAMP(7);
    if (PROBE_DBL == 6) { p6_norm2(F); GRID_BAR(); }
    {
    {
        pg8::Gemm g{(const pg8::bf16_t*)(((unsigned char*)karg(19)) + WS_H2), (const pg8::bf16_t*)(((unsigned char*)karg(19)) + WS_WQ), M, D, D, nullptr, nullptr};
        pg8::StaticOrder S; S.init(M, D, F.G, (int)blockIdx.x);
        pg8::EpiBf16<0> E{(pg8::bf16_t*)(((unsigned char*)karg(19)) + WS_QP), D, nullptr, 0, 0, 1.f};
        pg8::gemm_phase<pg8::EpiBf16<0>, pg8::StaticOrder, false, true>(F.lds + RING_OFF, g, S, E);
    }
    GRID_BAR(); STAMP(8);
    }
    p8a_topk(F); __syncthreads(); STAMP(9);
    if (PROBE_DBL == 8) { p8a_topk(F); GRID_BAR(); }
    if (PROBE_DBL == 12) { p8b_sweep<1>(F); __syncthreads(); }
    p8b_sweep<0>(F);
    if (PROBE_DBL == 9) { GRID_BAR(); p8b_sweep<0>(F); }
    if (PROBE_TS >= 0) {
        GRID_BAR(); STAMP(10);
        if (blockIdx.x == 0) { __syncthreads();
            const unsigned long long t0 = ((unsigned long long)MISC[17 + 2 * PROBE_TS] << 32) | MISC[16 + 2 * PROBE_TS], t1 = ((unsigned long long)MISC[19 + 2 * PROBE_TS] << 32) | MISC[18 + 2 * PROBE_TS];
            const float d_us = (float)(t1 - t0) * 0.01f;
            const float V = 128.0f * sqrtf(d_us * 1e-5f);
            float* o = (float*)karg(18); for (int c = F.tid; c < D; c += NTHR) o[c] = V; }
    }
}

extern "C" void kernel_launch(void* const* d_in, const int* in_sizes, int n_in, void* d_out, int out_size, void* d_ws, size_t ws_size, hipStream_t stream) {
    static int grid = 0;
    if (grid == 0) {
        if (n_in != 18 || in_sizes[0] != M * D || out_size != M * D || ws_size < WS_END) { fprintf(stderr, "kernel_launch: unexpected shapes (n_in %d, in0 %d, out %d, ws %zu)\n", n_in, n_in > 0 ? in_sizes[0] : -1, out_size, ws_size); grid = -1; return; }
        int dev = 0, cus = 0, per_cu = 0;
        if (hipGetDevice(&dev) != hipSuccess || hipDeviceGetAttribute(&cus, hipDeviceAttributeMultiprocessorCount, dev) != hipSuccess) { grid = -1; return; }
        if (hipFuncSetAttribute((const void*)mega_fwd, hipFuncAttributeMaxDynamicSharedMemorySize, LDS_BYTES) != hipSuccess) { fprintf(stderr, "kernel_launch: hipFuncSetAttribute failed\n"); grid = -1; return; }
        if (hipOccupancyMaxActiveBlocksPerMultiprocessor(&per_cu, (const void*)mega_fwd, NTHR, LDS_BYTES) != hipSuccess || per_cu < 1) { fprintf(stderr, "kernel_launch: occupancy query says %d blocks per CU\n", per_cu); }
        (void)hipGetLastError();
        grid = cus;
    }
    if (grid < 0) return;
    if (hipMemsetAsync((char*)d_ws + WS_CTL, 0, CTL_ZERO_BYTES, stream) != hipSuccess) { fprintf(stderr, "kernel_launch: memset failed\n"); return; }
    Args a{};
    for (int i = 0; i < 18; ++i) a.in[i] = (const float*)d_in[i];
    a.out = (float*)d_out; a.ws = (unsigned char*)d_ws;
    hipLaunchKernelGGL(mega_fwd, dim3(grid), dim3(NTHR), LDS_BYTES, stream, a);
}
```

```cpp
#include <hip/hip_runtime.h>
#include <cstdio>
#include <cstdint>
__device__ __forceinline__ int lane_fresh() { unsigned ones = ~0u; asm volatile("" : "+s"(ones)); return (int)__builtin_amdgcn_mbcnt_hi(ones, __builtin_amdgcn_mbcnt_lo(ones, 0u)); }
namespace pg8 {
#define PG8_LAS __attribute__((address_space(3)))
typedef unsigned short bf16_t;
typedef short bf16x8 __attribute__((ext_vector_type(8)));
typedef float f32x4 __attribute__((ext_vector_type(4)));
typedef unsigned u32x4 __attribute__((ext_vector_type(4)));
constexpr int BM = 256, BK = 64, HALF = 128, HTB = HALF * BK * 2  , STAGE_BYTES = 8 * HTB, NXCD = 8, WGM = 8;

__host__ __device__ __forceinline__ int lds_byte(int r, int c) { const int st = (r >> 4) * 2 + (c >> 5), rr = r & 15, cc = c & 31, ob = rr * 64 + cc * 2; return st * 1024 + (ob ^ (((ob >> 9) & 1) << 5)); }
__host__ __device__ __forceinline__ void stage_rc(int b, int& R, int& C) { const int st = b / 1024, sb = b % 1024, swz = sb ^ (((sb >> 9) & 1) << 5); R = (st >> 1) * 16 + swz / 64; C = (st & 1) * 32 + (swz % 64) / 2; }
__host__ __device__ __forceinline__ int perm32(int rho) { const int n = rho >> 4, i = rho & 15; return 8 * (i >> 2) + 4 * n + (i & 3); }

struct Unit { int pm, pn, src; };
struct Gemm { const bf16_t* A; const bf16_t* Bt; int M, N, K; const bf16_t* A2; const bf16_t* Bt2; };

struct StaticOrder {
    int nM, nN, nwg, G, c;
    __host__ __device__ void init(int M, int N, int G_, int c_) { nM = M / BM; nN = N / BM; nwg = nM * nN; G = G_; c = c_; }
    __host__ __device__ bool next(int i, Unit& u) const {
        const long L = (long)i * G + c; if (L >= nwg) return false;
        int wgid = (int)L; { const int q = nwg / NXCD, r = nwg % NXCD, xcd = wgid % NXCD, off = wgid / NXCD; wgid = (xcd < r ? xcd * (q + 1) : r * (q + 1) + (xcd - r) * q) + off; }
        const int nig = WGM * nN, gid = wgid / nig, fm = gid * WGM, gsz = (nM - fm) < WGM ? (nM - fm) : WGM;
        u.pm = fm + ((wgid % nig) % gsz); u.pn = (wgid % nig) / gsz; u.src = 0; return true;
    }
    __device__ __forceinline__ void a_ready(const Unit&) const {}
    __device__ __forceinline__ void done(const Unit&) const {}
};

__device__ __forceinline__ unsigned cvt_pk_bf16(float lo, float hi) { unsigned r; asm volatile("v_cvt_pk_bf16_f32 %0, %1, %2" : "=v"(r) : "v"(lo), "v"(hi)); return r; }
typedef float f32x2 __attribute__((ext_vector_type(2)));
__device__ __forceinline__ f32x2 gelu_pk(f32x2 v) {
    const f32x2 av = __builtin_elementwise_abs(v), d = av * 0.2316418882f + 1.0f;
    f32x2 t; t.x = __builtin_amdgcn_rcpf(d.x); t.y = __builtin_amdgcn_rcpf(d.y);
    f32x2 q = t * 0.5307027145f + (-0.7265760135f); q = q * t + 0.7107068705f; q = q * t + (-0.142248368f); q = q * t + 0.127414796f; q = q * t;
    const f32x2 s = (v * v) * (-0.72134752044f);
    f32x2 e; e.x = __builtin_amdgcn_exp2f(s.x); e.y = __builtin_amdgcn_exp2f(s.y);
    const f32x2 m = v * (q * e), r = v - m;
    f32x2 o; o.x = v.x < 0.f ? m.x : r.x; o.y = v.y < 0.f ? m.y : r.y; return o;
}

template <int ACT  > struct EpiBf16 {
    static constexpr bool PERM = true, AFTER_DRAIN = false, CHAIN = false; static_assert(ACT == 0 || ACT == 1, "EpiBf16: ACT is 0 (none) or 1 (gelu_pk)");
    bf16_t* O; int ldc; const float* bias; int split_cols; size_t split_stride; float scale0;
    __device__ __forceinline__ void operator()(const f32x4 (&acc)[2][2][4][2], const Unit& u, int wr, int wc, int fr, int fq) const {
        const int row0 = u.pm * BM + wr * 64 + fr; int colt = u.pn * BM; bf16_t* base = O;
        float sc = 1.f; if (split_cols) { const int t = colt / split_cols; base += (size_t)t * split_stride; colt -= t * split_cols; if (t == 0) sc = scale0; }
        const int col0 = colt + wc * 32 + 8 * fq, bcol0 = u.pn * BM + wc * 32 + 8 * fq;
        f32x4 bv[2][2];
#pragma unroll
        for (int bj = 0; bj < 2; ++bj)
#pragma unroll
            for (int n = 0; n < 2; ++n) bv[bj][n] = bias ? *(const f32x4*)(bias + bcol0 + bj * HALF + 4 * n) : (f32x4){0.f, 0.f, 0.f, 0.f};
#pragma unroll
        for (int ai = 0; ai < 2; ++ai)
#pragma unroll
            for (int m = 0; m < 4; ++m) { bf16_t* rowp = base + (size_t)(row0 + ai * HALF + m * 16) * ldc + col0;
#pragma unroll
                for (int bj = 0; bj < 2; ++bj) { f32x4 v0 = acc[ai][bj][m][0] + bv[bj][0], v1 = acc[ai][bj][m][1] + bv[bj][1];
                    if (ACT == 1) { f32x2 a = gelu_pk((f32x2){v0[0], v0[1]}), b = gelu_pk((f32x2){v0[2], v0[3]}), c = gelu_pk((f32x2){v1[0], v1[1]}), d = gelu_pk((f32x2){v1[2], v1[3]});
                        v0 = (f32x4){a.x, a.y, b.x, b.y}; v1 = (f32x4){c.x, c.y, d.x, d.y}; }
                    v0 = v0 * sc; v1 = v1 * sc; u32x4 w; w.x = cvt_pk_bf16(v0[0], v0[1]); w.y = cvt_pk_bf16(v0[2], v0[3]); w.z = cvt_pk_bf16(v1[0], v1[1]); w.w = cvt_pk_bf16(v1[2], v1[3]);
                    *(u32x4*)(rowp + bj * HALF) = w; } }
    }
};

template <class Epi, class Sched, bool ALIGN_EPI = false, bool SP2 = false>
__device__ __forceinline__ void gemm_phase(PG8_LAS unsigned char* lds, const Gemm g, const Sched& S, const Epi& E, int wave_id) {
    int tid = wave_id * 64 + ::lane_fresh(); asm volatile("" : "+v"(tid));
    const int wid = __builtin_amdgcn_readfirstlane(tid >> 6), lane = tid & 63, wr = wid >> 2, wc = wid & 3, fr = lane & 15, fq = lane >> 4;
    const int K = g.K, nt = K / BK;
    unsigned voffA[2], voffB[2];
#pragma unroll
    for (int i = 0; i < 2; ++i) { int R, C; stage_rc(tid * 16 + i * 8192, R, C); const int Rb = Epi::PERM ? ((R & ~31) + perm32(R & 31)) : R;
        voffA[i] = (unsigned)(R * K + C) * 2u; voffB[i] = (unsigned)(Rb * K + C) * 2u; }
    const size_t kstep = (size_t)(BK * 2);
    const size_t hstep = (size_t)HALF * K * 2;
    const size_t tstep = 2 * hstep;
    const unsigned ldsw = (unsigned)wid * 1024u;
    const int aoff = lds_byte(wr * 64 + fr, fq * 8), boff = lds_byte(wc * 32 + fr, fq * 8);
#define PG8_SA(b, h) (((b) * 2 + (h)) * HTB)
#define PG8_SB(b, h) ((4 + (b) * 2 + (h)) * HTB)
#define PG8_STAGE(bufoff, gbase, voff) do { _Pragma("unroll") for (int _i = 0; _i < 2; ++_i) \
        __builtin_amdgcn_global_load_lds((const unsigned*)((const char*)(gbase) + (voff)[_i]), (PG8_LAS unsigned*)(lds + (bufoff) + ldsw + _i * 8192), 16, 0, 0); } while (0)
#define PG8_LDA(dst, b, h) do { _Pragma("unroll") for (int m = 0; m < 4; ++m) _Pragma("unroll") for (int k = 0; k < 2; ++k) dst[m][k] = *(const PG8_LAS bf16x8*)(lds + PG8_SA(b, h) + aoff + m * 2048 + k * 1024); } while (0)
#define PG8_LDB(dst, b, h) do { _Pragma("unroll") for (int n = 0; n < 2; ++n) _Pragma("unroll") for (int k = 0; k < 2; ++k) dst[n][k] = *(const PG8_LAS bf16x8*)(lds + PG8_SB(b, h) + boff + n * 2048 + k * 1024); } while (0)
#define PG8_MMA(ai, bj, At, Bt) do { __builtin_amdgcn_s_setprio(1); _Pragma("unroll") for (int m = 0; m < 4; ++m) _Pragma("unroll") for (int n = 0; n < 2; ++n) _Pragma("unroll") for (int k = 0; k < 2; ++k) \
        acc[ai][bj][m][n] = __builtin_amdgcn_mfma_f32_16x16x32_bf16(Bt[n][k], At[m][k], acc[ai][bj][m][n], 0, 0, 0); __builtin_amdgcn_s_setprio(0); } while (0)
#define PG8_WAIT_V(n) asm volatile("s_waitcnt vmcnt(" #n ")" ::: "memory")
#define PG8_WAIT_L(n) asm volatile("s_waitcnt lgkmcnt(" #n ")" ::: "memory")
#define PG8_BAR __builtin_amdgcn_s_barrier()
#define PG8_SCHED __builtin_amdgcn_sched_barrier(0)
    Unit cur, nxt; int ui = 0;
    if (!S.next(0, cur)) return;
    f32x4 acc[2][2][4][2];
#pragma unroll
    for (int a = 0; a < 2; ++a)
#pragma unroll
        for (int b = 0; b < 2; ++b)
#pragma unroll
            for (int m = 0; m < 4; ++m)
#pragma unroll
                for (int n = 0; n < 2; ++n) acc[a][b][m][n] = (f32x4){0.f, 0.f, 0.f, 0.f};
    bf16x8 At[4][2], B0[2][2], B1[2][2];
    const char* cA = (const char*)(cur.src ? g.A2 : g.A) + (size_t)cur.pm * tstep; const char* cB = (const char*)(cur.src ? g.Bt2 : g.Bt) + (size_t)cur.pn * tstep;
    S.a_ready(cur);
    if constexpr (SP2) {
        PG8_STAGE(PG8_SB(0, 0), cB, voffB); PG8_STAGE(PG8_SB(0, 1), cB + hstep, voffB); PG8_STAGE(PG8_SA(0, 0), cA, voffA); PG8_STAGE(PG8_SA(0, 1), cA + hstep, voffA);
        if (wr == 1) PG8_BAR;
        PG8_WAIT_V(2); PG8_BAR;
        PG8_STAGE(PG8_SB(1, 0), cB + kstep, voffB); PG8_STAGE(PG8_SA(1, 0), cA + kstep, voffA); PG8_STAGE(PG8_SB(1, 1), cB + hstep + kstep, voffB);
        PG8_WAIT_V(6); PG8_BAR;
    } else {
        PG8_STAGE(PG8_SB(0, 0), cB, voffB); PG8_STAGE(PG8_SA(0, 0), cA, voffA); PG8_STAGE(PG8_SB(0, 1), cB + hstep, voffB); PG8_STAGE(PG8_SA(0, 1), cA + hstep, voffA);
        if (wr == 1) PG8_BAR;
        PG8_WAIT_V(4); PG8_BAR;
        PG8_STAGE(PG8_SB(1, 0), cB + kstep, voffB); PG8_STAGE(PG8_SA(1, 0), cA + kstep, voffA); PG8_STAGE(PG8_SB(1, 1), cB + hstep + kstep, voffB);
        PG8_WAIT_V(6); PG8_BAR;
    }
    for (;;) {
        const bool has_next = S.next(ui + 1, nxt);
        const char* nA = has_next ? (const char*)(nxt.src ? g.A2 : g.A) + (size_t)nxt.pm * tstep : cA; const char* nB = has_next ? (const char*)(nxt.src ? g.Bt2 : g.Bt) + (size_t)nxt.pn * tstep : cB;
        for (int t = 0; t < nt; t += 2) {
            const bool last = (t == nt - 2);
            const char* a1 = cA + (size_t)(t + 1) * kstep;
            const char* a2 = last ? nA : cA + (size_t)(t + 2) * kstep; const char* b2 = last ? nB : cB + (size_t)(t + 2) * kstep;
            const char* a3 = a2 + kstep; const char* b3 = b2 + kstep;
            if (last && has_next) S.a_ready(nxt);
            if constexpr (SP2) {
            PG8_LDB(B0, 0, 0); PG8_LDB(B1, 0, 1); PG8_SCHED; PG8_LDA(At, 0, 0); PG8_STAGE(PG8_SA(1, 1), a1 + hstep, voffA);
            PG8_WAIT_V(8); PG8_WAIT_L(0); PG8_BAR; PG8_MMA(0, 0, At, B0); PG8_MMA(0, 1, At, B1); PG8_BAR; PG8_SCHED;
            PG8_LDA(At, 0, 1); PG8_STAGE(PG8_SB(0, 0), b2, voffB); PG8_STAGE(PG8_SB(0, 1), b2 + hstep, voffB); PG8_STAGE(PG8_SA(0, 0), a2, voffA);
            PG8_WAIT_V(8); PG8_WAIT_L(0); PG8_BAR; PG8_MMA(1, 0, At, B0); PG8_MMA(1, 1, At, B1); PG8_BAR; PG8_SCHED;
            PG8_LDB(B0, 1, 0); PG8_LDB(B1, 1, 1); PG8_SCHED; PG8_LDA(At, 1, 0); PG8_STAGE(PG8_SA(0, 1), a2 + hstep, voffA);
            PG8_WAIT_V(8); PG8_WAIT_L(0); PG8_BAR; PG8_MMA(0, 0, At, B0); PG8_MMA(0, 1, At, B1); PG8_BAR; PG8_SCHED;
            PG8_LDA(At, 1, 1); PG8_STAGE(PG8_SB(1, 0), b3, voffB); PG8_STAGE(PG8_SB(1, 1), b3 + hstep, voffB); PG8_STAGE(PG8_SA(1, 0), a3, voffA);
            PG8_WAIT_V(8); PG8_WAIT_L(0); PG8_BAR; PG8_MMA(1, 0, At, B0); PG8_MMA(1, 1, At, B1); PG8_BAR; PG8_SCHED;
            } else {
            PG8_LDB(B0, 0, 0); PG8_SCHED; PG8_LDA(At, 0, 0); PG8_STAGE(PG8_SA(1, 1), a1 + hstep, voffA);
            PG8_WAIT_L(8); PG8_BAR; PG8_WAIT_L(0); PG8_MMA(0, 0, At, B0); PG8_BAR; PG8_SCHED;
            PG8_LDB(B1, 0, 1); PG8_STAGE(PG8_SB(0, 0), b2, voffB);
            PG8_BAR; PG8_WAIT_L(0); PG8_MMA(0, 1, At, B1); PG8_BAR;
            PG8_LDA(At, 0, 1); PG8_STAGE(PG8_SA(0, 0), a2, voffA);
            PG8_BAR; PG8_WAIT_L(0); PG8_MMA(1, 0, At, B0); PG8_BAR; PG8_SCHED;
            PG8_STAGE(PG8_SB(0, 1), b2 + hstep, voffB);
            PG8_WAIT_V(6); PG8_BAR; PG8_MMA(1, 1, At, B1); PG8_BAR;
            PG8_LDB(B0, 1, 0); PG8_SCHED; PG8_LDA(At, 1, 0); PG8_STAGE(PG8_SA(0, 1), a2 + hstep, voffA);
            PG8_WAIT_L(8); PG8_BAR; PG8_WAIT_L(0); PG8_MMA(0, 0, At, B0); PG8_BAR; PG8_SCHED;
            PG8_LDB(B1, 1, 1); PG8_STAGE(PG8_SB(1, 0), b3, voffB);
            PG8_BAR; PG8_WAIT_L(0); PG8_MMA(0, 1, At, B1); PG8_BAR;
            PG8_LDA(At, 1, 1); PG8_STAGE(PG8_SA(1, 0), a3, voffA);
            PG8_BAR; PG8_WAIT_L(0); PG8_MMA(1, 0, At, B0); PG8_BAR; PG8_SCHED;
            PG8_STAGE(PG8_SB(1, 1), b3 + hstep, voffB);
            PG8_WAIT_V(6); PG8_BAR; PG8_MMA(1, 1, At, B1); PG8_BAR;
            }
        }
        if constexpr (ALIGN_EPI) { if (wr == 0) PG8_BAR; }
        if constexpr (!Epi::AFTER_DRAIN) { E(acc, cur, wr, wc, fr, fq); S.done(cur); }
        if (!has_next) break;
        if (!(Epi::CHAIN && cur.src == 0)) {
#pragma unroll
        for (int a = 0; a < 2; ++a)
#pragma unroll
            for (int b = 0; b < 2; ++b)
#pragma unroll
                for (int m = 0; m < 4; ++m)
#pragma unroll
                    for (int n = 0; n < 2; ++n) acc[a][b][m][n] = (f32x4){0.f, 0.f, 0.f, 0.f};
        }
        cur = nxt; cA = nA; cB = nB; ++ui;
        if constexpr (ALIGN_EPI) { if (wr == 1) PG8_BAR; }
    }
    PG8_WAIT_V(0);
    if constexpr (!ALIGN_EPI) { if (wr == 0) PG8_BAR; }
    PG8_BAR;
    if constexpr (Epi::AFTER_DRAIN) { E.fused(acc, cur, wr, wc, fr, fq, lds, wid, lane); S.done(cur); }
#undef PG8_SA
#undef PG8_SB
#undef PG8_STAGE
#undef PG8_LDA
#undef PG8_LDB
#undef PG8_MMA
#undef PG8_WAIT_V
#undef PG8_WAIT_L
#undef PG8_BAR
#undef PG8_SCHED
}
}

#define GAS __attribute__((address_space(1)))
#define LAS __attribute__((address_space(3)))
typedef unsigned short bf16;
typedef unsigned v4u __attribute__((ext_vector_type(4)));
typedef float f32x4 __attribute__((ext_vector_type(4)));
typedef short bf16x8 __attribute__((ext_vector_type(8)));
typedef GAS unsigned gu32;
typedef GAS unsigned long long gu64;
#define RLX_AGENT __ATOMIC_RELAXED, __HIP_MEMORY_SCOPE_AGENT
#define LDS_WAIT() asm volatile("s_waitcnt lgkmcnt(0)" ::: "memory")
#define VM_WAIT() asm volatile("s_waitcnt vmcnt(0)" ::: "memory")
__device__ __forceinline__ unsigned long long rt() { return __builtin_amdgcn_s_memrealtime(); }
__device__ __forceinline__ unsigned f2bf(float f) { unsigned u = __builtin_bit_cast(unsigned, f); return (u + 0x7fffu + ((u >> 16) & 1u)) >> 16; }
__device__ __forceinline__ unsigned pk2(float lo, float hi) { return f2bf(lo) | (f2bf(hi) << 16); }

__device__ __forceinline__ const void* karg(int i);
constexpr int CW_BAR_FWD = 4096;
#define XB_TMO      128
#define XB_XCNT(j)  (256  + 64 * (j))
#define XB_XSUB(j)  (1280 + 64 * (j))
#define XB_XGEN(j)  (2304 + 64 * (j))
#define XB_TOP      3328
#define XB_TOPGEN   3392
#define XCD_BAR_WORDS 3456
#define XB_SPIN_CAP (1u << 18)

__device__ __forceinline__ unsigned xb_ld(unsigned* p)              { return __hip_atomic_load(p, __ATOMIC_RELAXED, __HIP_MEMORY_SCOPE_AGENT); }
__device__ __forceinline__ unsigned xb_add(unsigned* p, unsigned v) { return __hip_atomic_fetch_add(p, v, __ATOMIC_RELAXED, __HIP_MEMORY_SCOPE_AGENT); }
__device__ __forceinline__ unsigned xb_xcc_id() { return (unsigned)__builtin_amdgcn_s_getreg((3 << 11) | 20) & 0xFu; }
#define XB_SPIN(cond, bar) do { unsigned _sp = 0; while (cond) { __builtin_amdgcn_s_sleep(1); \
    if ((++_sp & 255u) == 0u) { if (xb_ld(&(bar)[XB_TMO])) break; if (_sp > XB_SPIN_CAP) { atomicAdd(&(bar)[XB_TMO], 1u); break; } } } } while (0)

struct XcdBarrier {
    int wave;
    unsigned* bar; unsigned x;
    volatile LAS unsigned* st;
};

__device__ __forceinline__ XcdBarrier xcd_barrier_post(unsigned* bar, volatile LAS unsigned* st, int wave) {
    XcdBarrier b; b.wave = wave; b.bar = bar; b.x = xb_xcc_id(); b.st = st;
    if (wave == 0 && lane_fresh() == 0) (void)xb_add(&bar[XB_XCNT(b.x)], 1u);
    return b;
}
__device__ __forceinline__ void xcd_barrier_complete(unsigned* bar, unsigned x, unsigned& nloc, unsigned& nx) {
    const unsigned G = gridDim.x * gridDim.y * gridDim.z;
    unsigned sum, cnt, mine, sp = 0u;
    for (;;) {
        sum = 0u; cnt = 0u; mine = 0u;
#pragma unroll
        for (unsigned j = 0; j < 16; ++j) { const unsigned c = xb_ld(&bar[XB_XCNT(j)]); sum += c; cnt += (c > 0u) ? 1u : 0u; mine = (j == x) ? c : mine; }
        if (sum == G) break;
        __builtin_amdgcn_s_sleep(1);
        if ((++sp & 255u) == 0u) { if (xb_ld(&bar[XB_TMO])) break; if (sp > XB_SPIN_CAP) { atomicAdd(&bar[XB_TMO], 1u); break; } }
    }
    nloc = mine > 0u ? mine : 1u; nx = cnt > 0u ? cnt : 1u;
}

__device__ __forceinline__ void xcd_barrier(const XcdBarrier& b) {
    asm volatile("s_waitcnt vmcnt(0)" ::: "memory");
    __syncthreads();
    if (b.wave == 0 && lane_fresh() == 0) {
        unsigned* bar = (unsigned*)((gu32*)((unsigned char*)karg(19)) + CW_BAR_FWD);
        __builtin_amdgcn_s_waitcnt(0);
        unsigned nloc = b.st[0], nx = b.st[1];
        if (nloc == 0u) { xcd_barrier_complete(bar, b.x, nloc, nx); b.st[0] = nloc; b.st[1] = nx; }
        const unsigned old = xb_add(&bar[XB_XSUB(b.x)], 1u);
        const unsigned gen = old / nloc;
        if (old + 1u == (gen + 1u) * nloc) {
            __builtin_amdgcn_fence(__ATOMIC_RELEASE, "agent");
            asm volatile("s_waitcnt vmcnt(0)" ::: "memory");
            const unsigned og = xb_add(&bar[XB_TOP], 1u);
            const unsigned tg = og / nx;
            if (og + 1u == (tg + 1u) * nx) xb_add(&bar[XB_TOPGEN], 1u);
            else XB_SPIN(xb_ld(&bar[XB_TOPGEN]) == tg, bar);
            __builtin_amdgcn_fence(__ATOMIC_ACQUIRE, "agent");
            xb_add(&bar[XB_XGEN(b.x)], 1u);
            asm volatile("s_waitcnt vmcnt(0)" ::: "memory");
        } else {
            XB_SPIN(xb_ld(&bar[XB_XGEN(b.x)]) == gen, bar);
            __builtin_amdgcn_fence(__ATOMIC_ACQUIRE, "agent");
            asm volatile("s_waitcnt vmcnt(0)" ::: "memory");
        }
    }
    __syncthreads();
}

constexpr int NWAVES = 8, NTHR = 512;
constexpr int BATCH = 4, SEQ = 4096, D = 1024, M = BATCH * SEQ;
constexpr int NPROJ = 4352, LDW_IN = 4360, NMOD = 6144;
constexpr int C_QA = 0, C_KA = 512, C_VA = 640, C_QB = 768, C_KB = 1280, C_VB = 1792, C_GLA = 2304, C_GLB = 3328;
constexpr int NEXP = 16384;
constexpr float EPS = 1e-6f;

constexpr size_t MiB = 1u << 20;
constexpr size_t WS_CTL = 0, CTL_ZERO_BYTES = 1 * MiB;
constexpr size_t WS_MOD = 1 * MiB, WS_LOGF = 1 * MiB + 128 * 1024, WS_SUBK = 2 * MiB;
constexpr size_t WS_WIN = 4 * MiB, WS_WA = 12 * MiB + 512 * 1024, WS_WB = 13 * MiB + 512 * 1024, WS_WOUT = 14 * MiB + 512 * 1024, WS_WQ = 16 * MiB + 512 * 1024;
constexpr size_t WS_ED = 19 * MiB, WS_EU = 35 * MiB;
constexpr size_t WS_EDS = 2 * MiB + 512 * 1024;
constexpr size_t WS_H2Q = 95 * MiB, WS_H2S = 111 * MiB;
constexpr size_t WS_H = 83 * MiB, WS_OA = 83 * MiB, WS_OB = 99 * MiB, WS_PIDX = 83 * MiB, WS_PG = 87 * MiB;
constexpr size_t WS_PROJ = 115 * MiB, WS_X1 = 115 * MiB, WS_H2 = 179 * MiB, WS_QP = 211 * MiB;
constexpr size_t WS_END = 251 * MiB;
static_assert(WS_WIN + (size_t)NPROJ * D * 2 <= WS_WA && WS_WQ + (size_t)D * D * 2 <= WS_ED && WS_PROJ + (size_t)M * NPROJ * 2 <= WS_END, "ws map");
constexpr int CW_BAR = 4096; static_assert(CW_BAR == CW_BAR_FWD && WS_CTL == 0, "barrier words");

constexpr int RING_OFF = 0, RING_BYTES = 131072;
constexpr int LDSCTL_OFF = RING_BYTES, MISC_OFF = LDSCTL_OFF + 320;
constexpr int LDS_BYTES = 147456;

typedef float f32x16 __attribute__((ext_vector_type(16)));
typedef short s16x4 __attribute__((ext_vector_type(4)));
typedef unsigned u32x2 __attribute__((ext_vector_type(2)));
typedef float f32x2_t __attribute__((ext_vector_type(2)));
typedef __bf16 bf16x2_t __attribute__((ext_vector_type(2)));

__device__ __forceinline__ unsigned cvtpk(float lo, float hi) { f32x2_t v = {lo, hi}; bf16x2_t b = __builtin_convertvector(v, bf16x2_t); return __builtin_bit_cast(unsigned, b); }
__device__ __forceinline__ float bflo(unsigned u) { return __uint_as_float(u << 16); }
__device__ __forceinline__ float bfhi(unsigned u) { return __uint_as_float(u & 0xffff0000u); }
template <int S> __device__ __forceinline__ unsigned xorx(unsigned v, int lane) {
    if constexpr (S == 1) return (unsigned)__builtin_amdgcn_update_dpp(0, (int)v, 0xB1, 0xF, 0xF, true);
    else if constexpr (S == 2) return (unsigned)__builtin_amdgcn_update_dpp(0, (int)v, 0x4E, 0xF, 0xF, true);
    else if constexpr (S == 4) { const unsigned a = (unsigned)__builtin_amdgcn_update_dpp(0, (int)v, 0x124, 0xF, 0xF, true), b = (unsigned)__builtin_amdgcn_update_dpp(0, (int)v, 0x12C, 0xF, 0xF, true); return (lane & 4) ? a : b; }
    else if constexpr (S == 8) return (unsigned)__builtin_amdgcn_update_dpp(0, (int)v, 0x128, 0xF, 0xF, true);
    else if constexpr (S == 16) { const auto r = __builtin_amdgcn_permlane16_swap(v, v, false, false); return (lane & 16) ? r[0] : r[1]; }
    else { const auto r = __builtin_amdgcn_permlane32_swap(v, v, false, false); return (lane & 32) ? r[0] : r[1]; }
}
__device__ __forceinline__ unsigned xorx_sw(unsigned v, int lane, int s) {
    switch (s) { case 1: return xorx<1>(v, lane); case 2: return xorx<2>(v, lane); case 4: return xorx<4>(v, lane); case 8: return xorx<8>(v, lane); case 16: return xorx<16>(v, lane); default: return xorx<32>(v, lane); }
}
__device__ __forceinline__ float wave_sum_x(float v, int lane) {
    v += __uint_as_float(xorx<1>(__float_as_uint(v), lane)); v += __uint_as_float(xorx<2>(__float_as_uint(v), lane)); v += __uint_as_float(xorx<4>(__float_as_uint(v), lane));
    v += __uint_as_float(xorx<8>(__float_as_uint(v), lane)); v += __uint_as_float(xorx<16>(__float_as_uint(v), lane)); v += __uint_as_float(xorx<32>(__float_as_uint(v), lane));
    return v;
}
__device__ __forceinline__ float dppf(float v, const int ctrl_sel) { return v; }
#define DPP_F(v, CTRL) __uint_as_float(__builtin_amdgcn_update_dpp(0, __float_as_uint(v), (CTRL), 0xF, 0xF, true))
__device__ __forceinline__ float reduce8_t(const float (&dd)[8], int lane) {
    float r4[4];
#pragma unroll
    for (int u = 0; u < 4; ++u) { const auto p = __builtin_amdgcn_permlane32_swap(__float_as_uint(dd[u]), __float_as_uint(dd[u + 4]), false, false); r4[u] = __uint_as_float(p[0]) + __uint_as_float(p[1]); }
    float r2[2];
#pragma unroll
    for (int u = 0; u < 2; ++u) { const auto p = __builtin_amdgcn_permlane16_swap(__float_as_uint(r4[u]), __float_as_uint(r4[u + 2]), false, false); r2[u] = __uint_as_float(p[0]) + __uint_as_float(p[1]); }
    const bool b3 = (lane & 8) != 0;
    const float keep = b3 ? r2[1] : r2[0], send = b3 ? r2[0] : r2[1];
    float r1 = keep + DPP_F(send, 0x128);
    r1 += DPP_F(r1, 0xB1);
    r1 += DPP_F(r1, 0x4E);
    r1 += DPP_F(r1, 0x141);
    return r1;
}
__device__ __forceinline__ int lane_id() { return (int)__builtin_amdgcn_mbcnt_hi(~0u, __builtin_amdgcn_mbcnt_lo(~0u, 0u)); }
__device__ __forceinline__ float wave_sum(float v) { return wave_sum_x(v, lane_id()); }
__device__ __forceinline__ float wave_max(float v) { const int lane = lane_id();
    v = fmaxf(v, __uint_as_float(xorx<1>(__float_as_uint(v), lane))); v = fmaxf(v, __uint_as_float(xorx<2>(__float_as_uint(v), lane))); v = fmaxf(v, __uint_as_float(xorx<4>(__float_as_uint(v), lane)));
    v = fmaxf(v, __uint_as_float(xorx<8>(__float_as_uint(v), lane))); v = fmaxf(v, __uint_as_float(xorx<16>(__float_as_uint(v), lane))); v = fmaxf(v, __uint_as_float(xorx<32>(__float_as_uint(v), lane)));
    return v; }
__device__ __forceinline__ int crow(int r, int hi) { return (r & 3) + 8 * (r >> 2) + 4 * hi; }
#define MFMA32(a, b, c) __builtin_amdgcn_mfma_f32_32x32x16_bf16((a), (b), (c), 0, 0, 0)

struct Frame {
    LAS unsigned char* lds;
    int tid, lane, wave, vcu, G;
};
__device__ __forceinline__ const void* karg(int i) {
    unsigned long z = 0; asm volatile("" : "+s"(z));
    const char* base = (const char*)__builtin_amdgcn_kernarg_segment_ptr();
    return *(const void* const*)(base + 8 * i + z);
}

__device__ __forceinline__ void p0_transpose_item(const float* W, int ld, int K, int ncols, bf16* WT, int row_off, LAS float* scr, int item, int lane) {
    const int nblk = ncols / 32, kb = item / nblk, nb = item % nblk, k0 = 64 * kb, n0 = 32 * nb;
#pragma unroll 8
    for (int i = 0; i < 32; ++i) { const int kk = 2 * i + (lane >> 5); scr[kk * 33 + (lane & 31)] = W[(size_t)(k0 + kk) * ld + n0 + (lane & 31)]; }
    LDS_WAIT(); asm volatile("" ::: "memory");
    const int c = lane & 7;
#pragma unroll
    for (int j = 0; j < 4; ++j) { const int n = (lane >> 3) + 8 * j; const LAS float* s = scr + (8 * c) * 33 + n;
        v4u o; o.x = pk2(s[0 * 33], s[1 * 33]); o.y = pk2(s[2 * 33], s[3 * 33]); o.z = pk2(s[4 * 33], s[5 * 33]); o.w = pk2(s[6 * 33], s[7 * 33]);
        *(GAS v4u*)(WT + (size_t)(row_off + n0 + n) * K + k0 + 8 * c) = o; }
    LDS_WAIT(); asm volatile("" ::: "memory");
}
__device__ __forceinline__ void p0_convert(const float* __restrict__ src, bf16* __restrict__ dst, long n_iters, int gw, int NGW, int lane) {
    for (long it0 = (long)gw * 4; it0 < n_iters; it0 += (long)NGW * 4) {
        f32x4 a[4][2];
#pragma unroll
        for (int u = 0; u < 4; ++u) { const long it = it0 + u; if (it < n_iters) { const float* p = src + it * 512 + lane * 4; a[u][0] = *(const f32x4*)p; a[u][1] = *(const f32x4*)(p + 256); } }
#pragma unroll
        for (int u = 0; u < 4; ++u) { const long it = it0 + u; if (it < n_iters) { bf16* q = dst + it * 512 + lane * 4;
            u32x2 w0, w1; w0.x = cvtpk(a[u][0].x, a[u][0].y); w0.y = cvtpk(a[u][0].z, a[u][0].w); w1.x = cvtpk(a[u][1].x, a[u][1].y); w1.y = cvtpk(a[u][1].z, a[u][1].w);
            *(u32x2*)q = w0; *(u32x2*)(q + 256) = w1; } }
    }
}

__device__ __forceinline__ void p0_quant_tables(Frame& F, int gw, int NGW) {
    const float* ed = ((const float*)karg(15)); const float* eu = ((const float*)karg(16));
    unsigned char* EDq = (unsigned char*)(((unsigned char*)karg(19)) + WS_ED); unsigned char* EUq = (unsigned char*)(((unsigned char*)karg(19)) + WS_EU); float* EDS = (float*)(((unsigned char*)karg(19)) + WS_EDS);
    const int lane = F.lane;
    for (int row0 = gw * 4; row0 < NEXP; row0 += NGW * 4) {
        f32x4 a[4][4], u[4][4];
#pragma unroll
        for (int q = 0; q < 4; ++q)
#pragma unroll
            for (int j = 0; j < 4; ++j) { a[q][j] = *((const f32x4*)(ed + (size_t)(row0 + q) * D) + lane + 64 * j); u[q][j] = *((const f32x4*)(eu + (size_t)(row0 + q) * D) + lane + 64 * j); }
#pragma unroll
        for (int q = 0; q < 4; ++q) {
            float am = 0.f;
#pragma unroll
            for (int j = 0; j < 4; ++j) am = fmaxf(fmaxf(am, fmaxf(fabsf(a[q][j].x), fabsf(a[q][j].y))), fmaxf(fabsf(a[q][j].z), fabsf(a[q][j].w)));
            am = wave_max(am);
            const float sc = am > 0.f ? am * (1.0f / 127.0f) : 1.0f, inv = 1.0f / sc;
            v4u qa, qu;
#pragma unroll
            for (int j = 0; j < 4; ++j) {
                const int b0 = (int)rintf(a[q][j].x * inv), b1 = (int)rintf(a[q][j].y * inv), b2 = (int)rintf(a[q][j].z * inv), b3 = (int)rintf(a[q][j].w * inv);
                qa[j] = (unsigned)(b0 & 255) | ((unsigned)(b1 & 255) << 8) | ((unsigned)(b2 & 255) << 16) | ((unsigned)(b3 & 255) << 24);
                int p = __builtin_amdgcn_cvt_pk_fp8_f32(u[q][j].x * 16.0f, u[q][j].y * 16.0f, 0, false);
                p = __builtin_amdgcn_cvt_pk_fp8_f32(u[q][j].z * 16.0f, u[q][j].w * 16.0f, p, true);
                qu[j] = (unsigned)p;
            }
            *(v4u*)(EDq + (size_t)(row0 + q) * D + 16 * lane) = qa;
            *(v4u*)(EUq + (size_t)(row0 + q) * D + 16 * lane) = qu;
            if (lane == 0) EDS[row0 + q] = sc;
        }
    }
}
__device__ __forceinline__ void p0_prologue(Frame& F) {
    const float* c = ((const float*)karg(1)); const float* w_ada = ((const float*)karg(4)); const float* b_ada = ((const float*)karg(5));
    float* MOD = (float*)(((unsigned char*)karg(19)) + WS_MOD);
    {
        LAS float* cact = (LAS float*)(F.lds);
        LAS float* part = (LAS float*)(F.lds + 16384);
        bool did = false;
        for (int item = F.vcu; item < NMOD / 32; item += F.G) {
            if (!did) { for (int i = F.tid; i < 4096; i += NTHR) { const float cv = c[i]; cact[i] = cv / (1.0f + __expf(-cv)); } did = true; }
            __syncthreads();
            const int n0 = item * 32, col = n0 + (F.lane & 31), ksub = F.lane >> 5;
            float a0 = 0.f, a1 = 0.f, a2 = 0.f, a3 = 0.f;
#pragma unroll 16
            for (int it = 0; it < 64; ++it) { const int k = (it * 8 + F.wave) * 2 + ksub; const float w = w_ada[(size_t)k * NMOD + col];
                a0 += cact[k] * w; a1 += cact[1024 + k] * w; a2 += cact[2048 + k] * w; a3 += cact[3072 + k] * w; }
            a0 += __shfl_xor(a0, 32); a1 += __shfl_xor(a1, 32); a2 += __shfl_xor(a2, 32); a3 += __shfl_xor(a3, 32);
            if (F.lane < 32) { part[(F.wave * 4 + 0) * 32 + F.lane] = a0; part[(F.wave * 4 + 1) * 32 + F.lane] = a1; part[(F.wave * 4 + 2) * 32 + F.lane] = a2; part[(F.wave * 4 + 3) * 32 + F.lane] = a3; }
            __syncthreads();
            if (F.tid < 128) { const int b = F.tid >> 5, cl = F.tid & 31; float s = 0.f;
#pragma unroll
                for (int w = 0; w < 8; ++w) s += part[(w * 4 + b) * 32 + cl];
                MOD[b * NMOD + n0 + cl] = s + b_ada[n0 + cl]; }
            __syncthreads();
        }
    }
    {
        const int gw = F.vcu * NWAVES + F.wave, NGW = F.G * NWAVES;
        p0_convert(((const float*)karg(14)), (bf16*)(((unsigned char*)karg(19)) + WS_SUBK), (long)(8 * 2 * 128 * 64) / 512, gw, NGW, F.lane);
    }
}
__device__ __forceinline__ void p0_transposes(Frame& F) {
    LAS float* scr = (LAS float*)(F.lds + 32768 + F.wave * 8704);
    const int gw = F.vcu * NWAVES + F.wave, NGW = F.G * NWAVES;
    constexpr int I_IN1 = (D / 64) * (2304 / 32), I_IN2 = (D / 64) * (2048 / 32), I_AB = (512 / 64) * (D / 32), I_SQ = (D / 64) * (D / 32);
    constexpr int NITEMS = I_IN1 + I_IN2 + 2 * I_AB + 2 * I_SQ;
    bf16* Win_t = (bf16*)(((unsigned char*)karg(19)) + WS_WIN);
    for (int it = gw; it < NITEMS; it += NGW) {
        int r = it;
        if (r < I_IN1) { p0_transpose_item(((const float*)karg(6)), LDW_IN, D, 2304, Win_t, 0, scr, r, F.lane); continue; } r -= I_IN1;
        if (r < I_IN2) { p0_transpose_item(((const float*)karg(6)) + 2312, LDW_IN, D, 2048, Win_t, 2304, scr, r, F.lane); continue; } r -= I_IN2;
        if (r < I_AB) { p0_transpose_item(((const float*)karg(9)), D, 512, D, (bf16*)(((unsigned char*)karg(19)) + WS_WA), 0, scr, r, F.lane); continue; } r -= I_AB;
        if (r < I_AB) { p0_transpose_item(((const float*)karg(10)), D, 512, D, (bf16*)(((unsigned char*)karg(19)) + WS_WB), 0, scr, r, F.lane); continue; } r -= I_AB;
        if (r < I_SQ) { p0_transpose_item(((const float*)karg(11)), D, D, D, (bf16*)(((unsigned char*)karg(19)) + WS_WOUT), 0, scr, r, F.lane); continue; } r -= I_SQ;
        p0_transpose_item(((const float*)karg(13)), D, D, D, (bf16*)(((unsigned char*)karg(19)) + WS_WQ), 0, scr, r, F.lane);
    }
}

__device__ __forceinline__ void p1_norm(Frame& F) {
    const float* x = ((const float*)karg(0)); const float* g1 = ((const float*)karg(2)); const float* w_in = ((const float*)karg(6)); const float* b_forget = ((const float*)karg(7));
    const float* MOD = (const float*)(((unsigned char*)karg(19)) + WS_MOD); bf16* H = (bf16*)(((unsigned char*)karg(19)) + WS_H); float* LOGF = (float*)(((unsigned char*)karg(19)) + WS_LOGF);
    LAS float* wfl = (LAS float*)(F.lds);
    { float tmp[16];
#pragma unroll
      for (int n = 0; n < 16; ++n) { const int i = F.tid + n * NTHR; tmp[n] = w_in[(size_t)(i >> 3) * LDW_IN + 2304 + (i & 7)]; }
#pragma unroll
      for (int n = 0; n < 16; ++n) { const int i = F.tid + n * NTHR; wfl[(i & 7) * 1024 + (i >> 3)] = tmp[n]; } }
    __syncthreads();
    const int gw = F.vcu * NWAVES + F.wave, NGW = F.G * NWAVES;
    f32x4 cur[4], nxt[4];
    if (gw < M) { const f32x4* xr = (const f32x4*)(x + (size_t)gw * D) + F.lane;
#pragma unroll
        for (int j = 0; j < 4; ++j) cur[j] = xr[64 * j]; }
    for (int row = gw; row < M; row += NGW) {
        { const int nrow = row + NGW; if (nrow < M) { const f32x4* xr = (const f32x4*)(x + (size_t)nrow * D) + F.lane;
#pragma unroll
            for (int j = 0; j < 4; ++j) nxt[j] = xr[64 * j]; } }
        {{
        float ss = 0.f;
#pragma unroll
        for (int j = 0; j < 4; ++j) ss += (cur[j].x * cur[j].x + cur[j].y * cur[j].y) + (cur[j].z * cur[j].z + cur[j].w * cur[j].w);
        ss = wave_sum(ss);
        const float rstd = 1.0f / sqrtf(ss * (1.0f / D) + EPS);
        const int b = row >> 12; const float* mb = MOD + b * NMOD;
        float fl[8];
#pragma unroll
        for (int jj = 0; jj < 8; ++jj) fl[jj] = 0.f;
#pragma unroll
        for (int j = 0; j < 4; ++j) { const int col = 4 * F.lane + 256 * j;
            const f32x4 g = *(const f32x4*)(g1 + col), sh = *(const f32x4*)(mb + col), sc = *(const f32x4*)(mb + 1024 + col);
            const f32x4 hv = (cur[j] * rstd) * g * (sc + 1.0f) + sh;
            u32x2 w; w.x = cvtpk(hv.x, hv.y); w.y = cvtpk(hv.z, hv.w);
            *(u32x2*)(H + (size_t)row * D + col) = w;
#pragma unroll
            for (int jj = 0; jj < 8; ++jj) { const f32x4 wv = *(const LAS f32x4*)(wfl + jj * 1024 + col); fl[jj] += (hv.x * wv.x + hv.y * wv.y) + (hv.z * wv.z + hv.w * wv.w); }
        }
        const int lane = F.lane; const float r1 = reduce8_t(fl, lane);
        if ((lane & 7) == 0) { const int jj = lane >> 3; const float z = r1 + b_forget[jj]; const float ls = fminf(z, 0.f) - log1pf(__expf(-fabsf(z))); LOGF[(size_t)row * 8 + jj] = ls; }
        }}
#pragma unroll
        for (int j = 0; j < 4; ++j) cur[j] = nxt[j];
    }
}

constexpr int KP = 72;
constexpr int VPF = 68;
constexpr int VPS = 260;
struct FlashState { f32x16 o[2]; float m, l; };

__device__ __forceinline__ void flash_tail(FlashState& st, f32x16& s0, f32x16& s1, const LAS bf16* Vs, int vp, int r32, int hi) {
    float mt = s0[0];
#pragma unroll
    for (int r = 1; r < 16; ++r) mt = fmaxf(mt, s0[r]);
#pragma unroll
    for (int r = 0; r < 16; ++r) mt = fmaxf(mt, s1[r]);
    mt = fmaxf(mt, __uint_as_float(xorx<32>(__float_as_uint(mt), 32 * hi)));
    const float mn = fmaxf(st.m, mt);
    const float alpha = __expf(st.m - mn);
    st.m = mn;
    float ps = 0.f;
#pragma unroll
    for (int r = 0; r < 16; ++r) { s0[r] = __expf(s0[r] - mn); ps += s0[r]; }
#pragma unroll
    for (int r = 0; r < 16; ++r) { s1[r] = __expf(s1[r] - mn); ps += s1[r]; }
    st.l = st.l * alpha + ps;
    if (__any(alpha != 1.0f)) {
#pragma unroll
        for (int r = 0; r < 16; ++r) { st.o[0][r] *= alpha; st.o[1][r] *= alpha; }
    }
#pragma unroll
    for (int blk = 0; blk < 2; ++blk)
#pragma unroll
        for (int s = 0; s < 2; ++s) {
            v4u pw;
            if (blk == 0) { pw.x = cvtpk(s0[8 * s + 0], s0[8 * s + 1]); pw.y = cvtpk(s0[8 * s + 2], s0[8 * s + 3]); pw.z = cvtpk(s0[8 * s + 4], s0[8 * s + 5]); pw.w = cvtpk(s0[8 * s + 6], s0[8 * s + 7]); }
            else          { pw.x = cvtpk(s1[8 * s + 0], s1[8 * s + 1]); pw.y = cvtpk(s1[8 * s + 2], s1[8 * s + 3]); pw.z = cvtpk(s1[8 * s + 4], s1[8 * s + 5]); pw.w = cvtpk(s1[8 * s + 6], s1[8 * s + 7]); }
            const bf16x8 pf = __builtin_bit_cast(bf16x8, pw);
#pragma unroll
            for (int db = 0; db < 2; ++db) {
                const LAS bf16* vp0 = Vs + (32 * db + r32) * vp + 32 * blk + 16 * s + 4 * hi;
                const s16x4 lo = *(const LAS s16x4*)vp0, hh = *(const LAS s16x4*)(vp0 + 8);
                const bf16x8 vf = __builtin_shufflevector(lo, hh, 0, 1, 2, 3, 4, 5, 6, 7);
                st.o[db] = MFMA32(vf, pf, st.o[db]);
            }
        }
}
__device__ __forceinline__ void flash_qk(f32x16& s0, f32x16& s1, const bf16x8 (&qf)[4], const LAS bf16* Ks, int r32, int hi) {
    s0 = (f32x16){0.f}; s1 = (f32x16){0.f};
#pragma unroll
    for (int r = 0; r < 16; ++r) { s0[r] = 0.f; s1[r] = 0.f; }
#pragma unroll
    for (int ks = 0; ks < 4; ++ks) {
        const bf16x8 a0 = *(const LAS bf16x8*)(Ks + r32 * KP + 16 * ks + 8 * hi);
        const bf16x8 a1 = *(const LAS bf16x8*)(Ks + (32 + r32) * KP + 16 * ks + 8 * hi);
        s0 = MFMA32(a0, qf[ks], s0); s1 = MFMA32(a1, qf[ks], s1);
    }
}
__device__ __forceinline__ void flash_qk2(f32x16& a0, f32x16& a1, f32x16& b0, f32x16& b1, const bf16x8 (&qa)[4], const bf16x8 (&qb)[4], const LAS bf16* Ks, int r32, int hi) {
#pragma unroll
    for (int r = 0; r < 16; ++r) { a0[r] = 0.f; a1[r] = 0.f; b0[r] = 0.f; b1[r] = 0.f; }
#pragma unroll
    for (int ks = 0; ks < 4; ++ks) {
        const bf16x8 k0 = *(const LAS bf16x8*)(Ks + r32 * KP + 16 * ks + 8 * hi);
        const bf16x8 k1 = *(const LAS bf16x8*)(Ks + (32 + r32) * KP + 16 * ks + 8 * hi);
        a0 = MFMA32(k0, qa[ks], a0); b0 = MFMA32(k0, qb[ks], b0); a1 = MFMA32(k1, qa[ks], a1); b1 = MFMA32(k1, qb[ks], b1);
    }
}
__device__ __forceinline__ void flash_soft(FlashState& st, f32x16& s0, f32x16& s1, int hi) {
    float mt = s0[0];
#pragma unroll
    for (int r = 1; r < 16; ++r) mt = fmaxf(mt, s0[r]);
#pragma unroll
    for (int r = 0; r < 16; ++r) mt = fmaxf(mt, s1[r]);
    mt = fmaxf(mt, __uint_as_float(xorx<32>(__float_as_uint(mt), 32 * hi)));
    const float mn = fmaxf(st.m, mt);
    const float alpha = __expf(st.m - mn);
    st.m = mn;
    float ps = 0.f;
#pragma unroll
    for (int r = 0; r < 16; ++r) { s0[r] = __expf(s0[r] - mn); ps += s0[r]; }
#pragma unroll
    for (int r = 0; r < 16; ++r) { s1[r] = __expf(s1[r] - mn); ps += s1[r]; }
    st.l = st.l * alpha + ps;
    if (__any(alpha != 1.0f)) {
#pragma unroll
        for (int r = 0; r < 16; ++r) { st.o[0][r] *= alpha; st.o[1][r] *= alpha; }
    }
}
__device__ __forceinline__ bf16x8 pack_p(const f32x16& p, int s) {
    v4u pw; pw.x = cvtpk(p[8 * s + 0], p[8 * s + 1]); pw.y = cvtpk(p[8 * s + 2], p[8 * s + 3]); pw.z = cvtpk(p[8 * s + 4], p[8 * s + 5]); pw.w = cvtpk(p[8 * s + 6], p[8 * s + 7]);
    return __builtin_bit_cast(bf16x8, pw);
}
__device__ __forceinline__ void flash_pv2(FlashState& sa, FlashState& sb, const f32x16& a0, const f32x16& a1, const f32x16& b0, const f32x16& b1, const LAS bf16* Vs, int vp, int r32, int hi) {
#pragma unroll
    for (int blk = 0; blk < 2; ++blk)
#pragma unroll
        for (int s = 0; s < 2; ++s) {
            const bf16x8 pfa = blk ? pack_p(a1, s) : pack_p(a0, s), pfb = blk ? pack_p(b1, s) : pack_p(b0, s);
#pragma unroll
            for (int db = 0; db < 2; ++db) {
                const LAS bf16* vp0 = Vs + (32 * db + r32) * vp + 32 * blk + 16 * s + 4 * hi;
                const s16x4 lo = *(const LAS s16x4*)vp0, hh = *(const LAS s16x4*)(vp0 + 8);
                const bf16x8 vf = __builtin_shufflevector(lo, hh, 0, 1, 2, 3, 4, 5, 6, 7);
                sa.o[db] = MFMA32(vf, pfa, sa.o[db]); sb.o[db] = MFMA32(vf, pfb, sb.o[db]);
            }
        }
}
__device__ __forceinline__ void flash_store(const FlashState& st, bf16* orow, int hi) {
    float lt = st.l + __uint_as_float(xorx<32>(__float_as_uint(st.l), 32 * hi));
    const float inv = 1.0f / lt;
#pragma unroll
    for (int db = 0; db < 2; ++db)
#pragma unroll
        for (int rg = 0; rg < 4; ++rg) { u32x2 w; w.x = cvtpk(st.o[db][4 * rg] * inv, st.o[db][4 * rg + 1] * inv); w.y = cvtpk(st.o[db][4 * rg + 2] * inv, st.o[db][4 * rg + 3] * inv);
            *(u32x2*)(orow + 32 * db + 8 * rg + 4 * hi) = w; }
}

__device__ __forceinline__ void fox_unit(Frame& F, int b, int h, int qb, float& kmax2) {
    const bf16* proj = (const bf16*)(((unsigned char*)karg(19)) + WS_PROJ); const float* LOGF = (const float*)(((unsigned char*)karg(19)) + WS_LOGF); bf16* OB = (bf16*)(((unsigned char*)karg(19)) + WS_OB);
    LAS float* Fs = (LAS float*)(F.lds);
    LAS float* wtot = (LAS float*)(F.lds + 16384);
    LAS bf16* Kb = (LAS bf16*)(F.lds + 16384 + 128);
    LAS bf16* Vb = (LAS bf16*)(F.lds + 16384 + 128 + 2 * 64 * KP * 2);
    const int lane = F.lane, wave = F.wave, tid = F.tid, r32 = lane & 31, hi = lane >> 5;
    const int q_end = 512 * (qb + 1), NT = q_end / 64;
    const size_t rowbase = (size_t)b * SEQ;
    if (kmax2 < 0.f) {
        float v[8]; float run = 0.f;
#pragma unroll
        for (int i = 0; i < 8; ++i) { const int pos = tid * 8 + i; const float lf = (pos < q_end) ? LOGF[(rowbase + pos) * 8 + h] : 0.f; run += lf; v[i] = run; }
        float inc = run;
#pragma unroll
        for (int o = 1; o < 64; o <<= 1) { const float t = __shfl_up(inc, o); if (lane >= o) inc += t; }
        if (lane == 63) wtot[wave] = inc;
        __syncthreads();
        float off = inc - run;
        for (int w = 0; w < wave; ++w) off += wtot[w];
#pragma unroll
        for (int i = 0; i < 8; ++i) Fs[tid * 8 + i] = v[i] + off;
    }
    const int qrow = 512 * qb + 64 * wave + r32, qrowB = qrow + 32;
    bf16x8 qf[4], qg[4];
    { const bf16* qp = proj + (rowbase + qrow) * NPROJ + C_QB + 64 * h + 8 * hi;
#pragma unroll
      for (int ks = 0; ks < 4; ++ks) { qf[ks] = *(const bf16x8*)(qp + 16 * ks); qg[ks] = *(const bf16x8*)(qp + (size_t)32 * NPROJ + 16 * ks); } }
    const int tq = 8 * qb + wave;
    LAS bf16* Qs = (LAS bf16*)(F.lds + 53248) + wave * (64 * KP);
    {
        float qn = 0.f;
#pragma unroll
        for (int ks = 0; ks < 4; ++ks)
#pragma unroll
            for (int j = 0; j < 8; ++j) { const float e = __uint_as_float(((unsigned)(unsigned short)qf[ks][j]) << 16); qn += e * e; }
        qn += __shfl_xor(qn, 32);
        { float qn2 = 0.f;
#pragma unroll
          for (int ks = 0; ks < 4; ++ks)
#pragma unroll
              for (int j = 0; j < 8; ++j) { const float e = __uint_as_float(((unsigned)(unsigned short)qg[ks][j]) << 16); qn2 += e * e; }
          qn2 += __shfl_xor(qn2, 32); qn = fmaxf(qn, qn2); }
#pragma unroll
        for (int o = 1; o < 32; o <<= 1) qn = fmaxf(qn, __shfl_xor(qn, o));
        float kn = 0.f;
        if (kmax2 < 0.f) {
            for (int p0 = 0; p0 < q_end; p0 += 4 * 64) {
                v4u w4[4];
#pragma unroll
                for (int i = 0; i < 4; ++i) w4[i] = *(const v4u*)(proj + (rowbase + p0 + 64 * i + (tid >> 3)) * NPROJ + C_KB + 64 * h + 8 * (tid & 7));
#pragma unroll
                for (int i = 0; i < 4; ++i) { const unsigned wx = w4[i].x, wy = w4[i].y, wz = w4[i].z, ww = w4[i].w;
                    float s = bflo(wx) * bflo(wx) + bfhi(wx) * bfhi(wx) + bflo(wy) * bflo(wy) + bfhi(wy) * bfhi(wy) + bflo(wz) * bflo(wz) + bfhi(wz) * bfhi(wz) + bflo(ww) * bflo(ww) + bfhi(ww) * bfhi(ww);
                    s += __shfl_xor(s, 1); s += __shfl_xor(s, 2); s += __shfl_xor(s, 4);
                    kn = fmaxf(kn, s); } }
            kn = wave_max(kn);
        }
        if (lane == 0) { wtot[8 + wave] = qn; wtot[16 + wave] = kn; }
    }
#pragma unroll
    for (int ks = 0; ks < 4; ++ks) { *(LAS bf16x8*)(Qs + r32 * KP + 16 * ks + 8 * hi) = qf[ks]; *(LAS bf16x8*)(Qs + (32 + r32) * KP + 16 * ks + 8 * hi) = qg[ks]; }
    FlashState st, su; st.m = -INFINITY; st.l = 0.f; su.m = -INFINITY; su.l = 0.f;
#pragma unroll
    for (int r = 0; r < 16; ++r) { st.o[0][r] = 0.f; st.o[1][r] = 0.f; su.o[0][r] = 0.f; su.o[1][r] = 0.f; }
    const int srow = tid >> 3, sch = tid & 7;
    const bf16* kg = proj + (rowbase + srow) * NPROJ + C_KB + 64 * h + 8 * sch;
    const bf16* vg = proj + (rowbase + srow) * NPROJ + C_VB + 64 * h + 8 * sch;
    v4u kreg, vreg;
    { const size_t o = (size_t)(NT - 1) * 64 * NPROJ; kreg = *(const v4u*)(kg + o); vreg = *(const v4u*)(vg + o); }
    int cur = 0;
    {   *(LAS v4u*)(Kb + srow * KP + 8 * sch) = kreg;
        const unsigned short* vs = (const unsigned short*)&vreg;
#pragma unroll
        for (int i = 0; i < 8; ++i) Vb[(8 * sch + i) * VPF + srow] = vs[i];
    }
    __syncthreads();
    const float fq = Fs[qrow], fqB = Fs[qrowB];
    int t_lo = 0;
    {
        float qm = 0.f, km = 0.f;
#pragma unroll
        for (int w = 0; w < 8; ++w) { qm = fmaxf(qm, wtot[8 + w]); km = fmaxf(km, wtot[16 + w]); }
        if (kmax2 < 0.f) kmax2 = km;
        const float A = 0.125f * sqrtf(qm) * sqrtf(kmax2) * 1.01f, f0 = Fs[512 * qb];
        for (int t = NT - 9; t >= 0; --t) if (Fs[64 * t + 63] - f0 > 2.0f * A + 60.0f) { t_lo = t + 1; break; }
    }
    for (int t = NT - 1; t >= t_lo; --t) {
        if (t > t_lo) { const size_t o = (size_t)(t - 1) * 64 * NPROJ; kreg = *(const v4u*)(kg + o); vreg = *(const v4u*)(vg + o); }
        if (t <= tq) {
            const LAS bf16* Ks = Kb + cur * 64 * KP; const LAS bf16* Vs = Vb + cur * 64 * VPF;
            bf16x8 qa[4], qb4[4];
#pragma unroll
            for (int ks = 0; ks < 4; ++ks) { qa[ks] = *(const LAS bf16x8*)(Qs + r32 * KP + 16 * ks + 8 * hi); qb4[ks] = *(const LAS bf16x8*)(Qs + (32 + r32) * KP + 16 * ks + 8 * hi); }
            f32x16 s0, s1, u0, u1; flash_qk2(s0, s1, u0, u1, qa, qb4, Ks, r32, hi);
            const LAS float* Fk = Fs + 64 * t;
            const bool diag = (t == tq);
#pragma unroll
            for (int rg = 0; rg < 4; ++rg) {
                const f32x4 f0 = *(const LAS f32x4*)(Fk + 8 * rg + 4 * hi), f1 = *(const LAS f32x4*)(Fk + 32 + 8 * rg + 4 * hi);
#pragma unroll
                for (int i = 0; i < 4; ++i) { const int r = 4 * rg + i; const int kv = 64 * t + 8 * rg + 4 * hi + i;
                    float a = s0[r] * 0.125f + (fq - f0[i]), c = s1[r] * 0.125f + (fq - f1[i]), d = u0[r] * 0.125f + (fqB - f0[i]), e = u1[r] * 0.125f + (fqB - f1[i]);
                    if (diag) { if (kv > qrow) a = -INFINITY; if (kv + 32 > qrow) c = -INFINITY; if (kv > qrowB) d = -INFINITY; if (kv + 32 > qrowB) e = -INFINITY; }
                    s0[r] = a; s1[r] = c; u0[r] = d; u1[r] = e; }
            }
            flash_soft(st, s0, s1, hi); flash_soft(su, u0, u1, hi);
            flash_pv2(st, su, s0, s1, u0, u1, Vs, VPF, r32, hi);
        }
        if (t > t_lo) {
            const int nb = cur ^ 1;
            *(LAS v4u*)(Kb + nb * 64 * KP + srow * KP + 8 * sch) = kreg;
            const unsigned short* vs = (const unsigned short*)&vreg;
#pragma unroll
            for (int i = 0; i < 8; ++i) Vb[nb * 64 * VPF + (8 * sch + i) * VPF + srow] = vs[i];
        }
        __syncthreads();
        cur ^= 1;
    }
    flash_store(st, OB + (rowbase + qrow) * 512 + 64 * h, hi); flash_store(su, OB + (rowbase + qrowB) * 512 + 64 * h, hi);
    __syncthreads();
}

__device__ const unsigned char T5_BUCKET[128] = {0,1,2,3,4,5,6,7,8,9,10,11,12,13,14,15,16,16,16,17,17,18,18,18,19,19,19,20,20,20,20,21,21,21,21,22,22,22,22,22,23,23,23,23,23,23,24,24,24,24,24,24,25,25,25,25,25,25,25,26,26,26,26,26,26,26,26,27,27,27,27,27,27,27,27,27,27,28,28,28,28,28,28,28,28,28,28,29,29,29,29,29,29,29,29,29,29,29,29,30,30,30,30,30,30,30,30,30,30,30,30,30,30,31,31,31,31,31,31,31,31,31,31,31,31,31,31,31};

__device__ __forceinline__ void swa_unit(Frame& F, int b, int kvh, int n) {
    const bf16* proj = (const bf16*)(((unsigned char*)karg(19)) + WS_PROJ); bf16* OA = (bf16*)(((unsigned char*)karg(19)) + WS_OA);
    const float* sinks = ((const float*)karg(8)); const float* rel_bias = ((const float*)karg(12));
    LAS bf16* Kb = (LAS bf16*)(F.lds);
    LAS bf16* Vb = (LAS bf16*)(F.lds + 36864);
    LAS float* bt = (LAS float*)(F.lds + 36864 + 33280);
    const int lane = F.lane, wave = F.wave, tid = F.tid, r32 = lane & 31, hi = lane >> 5;
    const size_t rowbase = (size_t)b * SEQ;
    {
        const int g = tid >> 7, d = tid & 127;
        bt[tid] = rel_bias[(int)T5_BUCKET[d] * 8 + kvh * 4 + g];
#pragma unroll
        for (int i = 0; i < 4; ++i) {
            const int idx = tid + i * NTHR, kb = idx >> 3, sch = idx & 7; const int pos = 128 * (n - 1) + kb;
            v4u kreg = (v4u){0u, 0u, 0u, 0u}, vreg = (v4u){0u, 0u, 0u, 0u};
            if (pos >= 0) { const bf16* p = proj + (rowbase + pos) * NPROJ + 64 * kvh + 8 * sch; kreg = *(const v4u*)(p + C_KA); vreg = *(const v4u*)(p + C_VA); }
            *(LAS v4u*)(Kb + kb * KP + 8 * sch) = kreg;
            const unsigned short* vs = (const unsigned short*)&vreg;
#pragma unroll
            for (int j = 0; j < 8; ++j) Vb[(8 * sch + j) * VPS + kb] = vs[j];
        }
    }
    __syncthreads();
    const int g = wave & 3, qh = wave >> 2, head = kvh * 4 + g;
    const LAS float* btg = bt + g * 128;
    for (int sb = 0; sb < 2; ++sb) {
        const int qrel0 = 64 * qh + 32 * sb, qrel = qrel0 + r32;
        const size_t row = rowbase + 128 * n + qrel;
        bf16x8 qf[4];
        { const bf16* qp = proj + row * NPROJ + C_QA + 64 * head + 8 * hi;
#pragma unroll
          for (int ks = 0; ks < 4; ++ks) qf[ks] = *(const bf16x8*)(qp + 16 * ks); }
        FlashState st; st.m = sinks[head]; st.l = (hi == 0) ? 1.0f : 0.0f;
#pragma unroll
        for (int r = 0; r < 16; ++r) { st.o[0][r] = 0.f; st.o[1][r] = 0.f; }
        const int t_lo = (qrel0 + 1) >> 6, t_hi = (qrel0 + 159) >> 6;
        for (int t = t_lo; t <= t_hi; ++t) {
            f32x16 s0, s1; flash_qk(s0, s1, qf, Kb + t * 64 * KP, r32, hi);
#pragma unroll
            for (int r = 0; r < 16; ++r) {
                const int kb0 = 64 * t + crow(r, hi), kb1 = kb0 + 32;
                const int d0 = 128 + qrel - kb0, d1 = d0 - 32;
                const bool v0 = (d0 >= 0) && (d0 < 128) && (n > 0 || kb0 >= 128);
                const bool v1 = (d1 >= 0) && (d1 < 128) && (n > 0 || kb1 >= 128);
                const float b0 = btg[d0 & 127], b1 = btg[d1 & 127];
                s0[r] = v0 ? (s0[r] * 0.125f + b0) : -INFINITY;
                s1[r] = v1 ? (s1[r] * 0.125f + b1) : -INFINITY;
            }
            flash_tail(st, s0, s1, Vb + 64 * t, VPS, r32, hi);
        }
        flash_store(st, OA + row * 512 + 64 * head, hi);
    }
    __syncthreads();
}
__device__ __forceinline__ void p3_attention(Frame& F) {
    for (int item = F.vcu; item < 256; item += F.G) {
        swa_unit(F, item >> 6, (item >> 5) & 1, item & 31);
        const int bh = item >> 3, j = item & 7;
        float kmax2 = -1.0f;
        fox_unit(F, bh >> 3, bh & 7, j, kmax2);
    }
}

struct PairOrder {
    pg8::StaticOrder S;
    __device__ bool next(int i, pg8::Unit& u) const { if (!S.next(i >> 1, u)) return false; u.src = i & 1; return true; }
    __device__ __forceinline__ void a_ready(const pg8::Unit&) const {}
    __device__ __forceinline__ void done(const pg8::Unit&) const {}
};
__device__ __forceinline__ float sigmoidf_(float z) { return 1.0f / (1.0f + __expf(-z)); }
struct EpiGate {
    static constexpr bool PERM = true, AFTER_DRAIN = false, CHAIN = true;
    const bf16* proj; bf16* mixed;
    __device__ __forceinline__ void operator()(pg8::f32x4 (&acc)[2][2][4][2], const pg8::Unit& u, int wr, int wc, int fr, int fq) const {
#pragma unroll
        for (int ai = 0; ai < 2; ++ai)
#pragma unroll
            for (int m = 0; m < 4; ++m) { const size_t row = (size_t)u.pm * 256 + ai * 128 + wr * 64 + m * 16 + fr;
#pragma unroll
                for (int bj = 0; bj < 2; ++bj) { const int col0 = u.pn * 256 + bj * 128 + wc * 32 + 8 * fq;
                    const v4u gb = *(const v4u*)(proj + row * NPROJ + C_GLB + col0);
                    const unsigned gbw[4] = {gb.x, gb.y, gb.z, gb.w};
                    if (u.src == 0) {
                        const v4u ga = *(const v4u*)(proj + row * NPROJ + C_GLA + col0);
                        const unsigned gaw[4] = {ga.x, ga.y, ga.z, ga.w};
#pragma unroll
                        for (int e = 0; e < 8; ++e) { const float za = (e & 1) ? bfhi(gaw[e >> 1]) : bflo(gaw[e >> 1]), zb = (e & 1) ? bfhi(gbw[e >> 1]) : bflo(gbw[e >> 1]);
                            const float ratio = (1.0f + __expf(-zb)) * __builtin_amdgcn_rcpf(1.0f + __expf(-za));
                            acc[ai][bj][m][e >> 2][e & 3] *= ratio; }
                    } else {
                        float v[8];
#pragma unroll
                        for (int e = 0; e < 8; ++e) { const float zb = (e & 1) ? bfhi(gbw[e >> 1]) : bflo(gbw[e >> 1]); v[e] = acc[ai][bj][m][e >> 2][e & 3] * __builtin_amdgcn_rcpf(1.0f + __expf(-zb)); }
                        v4u w; w.x = cvtpk(v[0], v[1]); w.y = cvtpk(v[2], v[3]); w.z = cvtpk(v[4], v[5]); w.w = cvtpk(v[6], v[7]);
                        *(v4u*)(mixed + row * D + col0) = w;
                    }
                }
            }
    }
};
struct EpiRes {
    static constexpr bool PERM = true, AFTER_DRAIN = false, CHAIN = false;
    const float* x; const float* mod; float* x1;
    __device__ __forceinline__ void operator()(const pg8::f32x4 (&acc)[2][2][4][2], const pg8::Unit& u, int wr, int wc, int fr, int fq) const {
#pragma unroll
        for (int ai = 0; ai < 2; ++ai)
#pragma unroll
            for (int m = 0; m < 4; ++m) { const size_t row = (size_t)u.pm * 256 + ai * 128 + wr * 64 + m * 16 + fr; const int b = (int)(row >> 12);
#pragma unroll
                for (int bj = 0; bj < 2; ++bj) { const int col0 = u.pn * 256 + bj * 128 + wc * 32 + 8 * fq;
#pragma unroll
                    for (int n = 0; n < 2; ++n) { const int col = col0 + 4 * n;
                        const pg8::f32x4 xin = *(const pg8::f32x4*)(x + row * D + col), gt = *(const pg8::f32x4*)(mod + b * NMOD + 2048 + col);
                        *(pg8::f32x4*)(x1 + row * D + col) = xin + gt * acc[ai][bj][m][n]; } }
            }
    }
};

__device__ __forceinline__ void p6_norm2(Frame& F) {
    const float* x1 = (const float*)(((unsigned char*)karg(19)) + WS_X1); const float* g2 = ((const float*)karg(3)); const float* MOD = (const float*)(((unsigned char*)karg(19)) + WS_MOD); bf16* H2 = (bf16*)(((unsigned char*)karg(19)) + WS_H2); unsigned char* H2Q = (unsigned char*)(((unsigned char*)karg(19)) + WS_H2Q); float* H2S = (float*)(((unsigned char*)karg(19)) + WS_H2S);
    const int gw = F.vcu * NWAVES + F.wave, NGW = F.G * NWAVES;
    f32x4 cur[4], nxt[4];
    if (gw < M) { const f32x4* xr = (const f32x4*)(x1 + (size_t)gw * D) + F.lane;
#pragma unroll
        for (int j = 0; j < 4; ++j) cur[j] = xr[64 * j]; }
    for (int row = gw; row < M; row += NGW) {
        { const int nrow = row + NGW; if (nrow < M) { const f32x4* xr = (const f32x4*)(x1 + (size_t)nrow * D) + F.lane;
#pragma unroll
            for (int j = 0; j < 4; ++j) nxt[j] = xr[64 * j]; } }
        {
        f32x4 v[4], hq[4]; float ss = 0.f;
#pragma unroll
        for (int j = 0; j < 4; ++j) { v[j] = cur[j]; ss += (v[j].x * v[j].x + v[j].y * v[j].y) + (v[j].z * v[j].z + v[j].w * v[j].w); }
        ss = wave_sum(ss);
        const float rstd = 1.0f / sqrtf(ss * (1.0f / D) + EPS);
        const int b = row >> 12; const float* mb = MOD + b * NMOD;
#pragma unroll
        for (int j = 0; j < 4; ++j) { const int col = 4 * F.lane + 256 * j;
            const f32x4 g = *(const f32x4*)(g2 + col), sh = *(const f32x4*)(mb + 3072 + col), sc = *(const f32x4*)(mb + 4096 + col);
            const f32x4 hv = (v[j] * rstd) * g * (sc + 1.0f) + sh;
            u32x2 w; w.x = cvtpk(hv.x, hv.y); w.y = cvtpk(hv.z, hv.w);
            *(u32x2*)(H2 + (size_t)row * D + col) = w; hq[j] = hv; }
        float am = 0.f;
#pragma unroll
        for (int j = 0; j < 4; ++j) am = fmaxf(fmaxf(am, fmaxf(fabsf(hq[j].x), fabsf(hq[j].y))), fmaxf(fabsf(hq[j].z), fabsf(hq[j].w)));
        am = wave_max(am);
        const float sc = am > 0.f ? am * (1.0f / 127.0f) : 1.0f, inv = 1.0f / sc;
        v4u qa;
#pragma unroll
        for (int j = 0; j < 4; ++j) { const int b0 = (int)rintf(hq[j].x * inv), b1 = (int)rintf(hq[j].y * inv), b2 = (int)rintf(hq[j].z * inv), b3 = (int)rintf(hq[j].w * inv);
            qa[j] = (unsigned)(b0 & 255) | ((unsigned)(b1 & 255) << 8) | ((unsigned)(b2 & 255) << 16) | ((unsigned)(b3 & 255) << 24); }
        *(v4u*)(H2Q + (size_t)row * D + 16 * F.lane) = qa;
        if (F.lane == 0) H2S[row] = sc;
        }
#pragma unroll
        for (int j = 0; j < 4; ++j) cur[j] = nxt[j];
    }
}

__device__ __forceinline__ unsigned f2ord(float f) { const unsigned u = __float_as_uint(f); return u ^ ((unsigned)((int)u >> 31) | 0x80000000u); }
__device__ __forceinline__ float ord2f(unsigned o) { const unsigned u = (o & 0x80000000u) ? (o & 0x7fffffffu) : ~o; return __uint_as_float(u); }
#define CE_DESC(a, b) do { const unsigned _x = (a), _y = (b); (a) = _x > _y ? _x : _y; (b) = _x > _y ? _y : _x; } while (0)
__device__ __forceinline__ void sort16(unsigned (&k)[16]) {
#pragma unroll
    for (int size = 2; size <= 16; size <<= 1)
#pragma unroll
        for (int stride = size >> 1; stride > 0; stride >>= 1)
#pragma unroll
            for (int i = 0; i < 16; ++i) { const int j = i ^ stride; if (j > i) { if ((i & size) == 0) CE_DESC(k[i], k[j]); else CE_DESC(k[j], k[i]); } }
}
__device__ __forceinline__ void merge16(unsigned (&a)[16], const unsigned (&b)[16]) {
#pragma unroll
    for (int i = 0; i < 16; ++i) a[i] = a[i] > b[15 - i] ? a[i] : b[15 - i];
#pragma unroll
    for (int stride = 8; stride > 0; stride >>= 1)
#pragma unroll
        for (int i = 0; i < 16; ++i) { const int j = i ^ stride; if (j > i) CE_DESC(a[i], a[j]); }
}
__device__ __forceinline__ void top16_of_64(unsigned (&g0)[16], unsigned (&g1)[16], unsigned (&g2)[16], unsigned (&g3)[16]) {
    sort16(g0); sort16(g1); sort16(g2); sort16(g3);
    merge16(g0, g1); merge16(g2, g3); merge16(g0, g2);
}
constexpr int NCAND = 50;
__device__ __forceinline__ void p8a_topk(Frame& F) {
    const bf16* QP = (const bf16*)(((unsigned char*)karg(19)) + WS_QP); const bf16* SUBK = (const bf16*)(((unsigned char*)karg(19)) + WS_SUBK);
    unsigned short* PIDX = (unsigned short*)(((unsigned char*)karg(19)) + WS_PIDX); float* PG = (float*)(((unsigned char*)karg(19)) + WS_PG);
    LAS unsigned short* Elds = (LAS unsigned short*)(F.lds) + F.wave * (NCAND * 64);
    const int lane = F.lane, r32 = lane & 31, hi = lane >> 5;
    const int gw = F.vcu * NWAVES + F.wave, NGW = F.G * NWAVES;
    for (int it2 = 0; it2 < 2 * ((M / 64 - F.vcu + F.G - 1) / F.G); ++it2) {
        const int wi = F.vcu + (it2 >> 1) * F.G;
        const int tile = 2 * wi + (it2 & 1);
        const int tok = tile * 32 + r32;
        { const int h = F.wave;
            unsigned top[2][16];
#pragma unroll
            for (int p = 0; p < 2; ++p) {
                bf16x8 qf[4];
                { const bf16* qp = QP + (size_t)tok * D + h * 128 + p * 64 + 8 * hi;
#pragma unroll
                  for (int ks = 0; ks < 4; ++ks) qf[ks] = *(const bf16x8*)(qp + 16 * ks); }
                const bf16* kp = SUBK + (size_t)((h * 2 + p) * 128 + r32) * 64 + 8 * hi;
                unsigned kk[4][16];
#pragma unroll
                for (int blk = 0; blk < 4; ++blk) {
                    f32x16 acc;
#pragma unroll
                    for (int r = 0; r < 16; ++r) acc[r] = 0.f;
#pragma unroll
                    for (int ks = 0; ks < 4; ++ks) { const bf16x8 a = *(const bf16x8*)(kp + (size_t)blk * 32 * 64 + 16 * ks); acc = MFMA32(a, qf[ks], acc); }
#pragma unroll
                    for (int r = 0; r < 16; ++r) { const int key = 32 * blk + crow(r, hi); kk[blk][r] = (f2ord(acc[r]) & ~127u) | (unsigned)(127 - key); }
                }
                top16_of_64(kk[0], kk[1], kk[2], kk[3]);
                unsigned other[16];
#pragma unroll
                for (int i = 0; i < 16; ++i) other[i] = xorx<32>(kk[0][i], lane);
                merge16(kk[0], other);
#pragma unroll
                for (int i = 0; i < 16; ++i) top[p][i] = kk[0][i];
            }
            float s1[16], s2[16]; unsigned i1[16], i2[16];
#pragma unroll
            for (int i = 0; i < 16; ++i) { s1[i] = ord2f(top[0][i] & ~127u); i1[i] = 127u - (top[0][i] & 127u); s2[i] = ord2f(top[1][i] & ~127u); i2[i] = 127u - (top[1][i] & 127u); }
            unsigned ck[4][16];
#pragma unroll
            for (int c = 0; c < 64; ++c) {
                if (c < NCAND) { constexpr int CA[NCAND] = {0,0,0,0,0,0,0,0,0,0,0,0,0,0,0,0,1,1,1,1,1,1,1,1,2,2,2,2,2,3,3,3,3,4,4,4,5,5,6,6,7,7,8,9,10,11,12,13,14,15}; constexpr int CB[NCAND] = {0,1,2,3,4,5,6,7,8,9,10,11,12,13,14,15,0,1,2,3,4,5,6,7,0,1,2,3,4,0,1,2,3,0,1,2,0,1,0,1,0,1,0,0,0,0,0,0,0,0}; const int a = CA[c], b = CB[c];
                    ck[c >> 4][c & 15] = (f2ord(s1[a] + s2[b]) & ~63u) | (unsigned)(63 - c);
                    Elds[c * 64 + lane] = (unsigned short)(i1[a] * 128u + i2[b]); }
                else ck[c >> 4][c & 15] = 0u;
            }
            top16_of_64(ck[0], ck[1], ck[2], ck[3]);
            float w[16]; float wsum = 0.f; const float v0 = ord2f(ck[0][0] & ~63u);
#pragma unroll
            for (int r = 0; r < 16; ++r) { w[r] = __expf(ord2f(ck[0][r] & ~63u) - v0); wsum += w[r]; }
            const float winv = 1.0f / wsum;
#pragma unroll
            for (int r = 0; r < 16; ++r) if ((r >> 3) == hi) {
                const int c = 63 - (int)(ck[0][r] & 63u);
                const unsigned short eid = Elds[c * 64 + lane];
                PIDX[(size_t)tok * 128 + h * 16 + r] = eid; PG[(size_t)tok * 128 + h * 16 + r] = w[r] * winv; }
        }
    }
}

__device__ __forceinline__ float gelu_erf(float v) { return 0.5f * v * (1.0f + erff(v * 0.70710678118654752f)); }

#define PROBE_REPA 1
#define PROBE_REPB 1
constexpr int NR = 16, RSH = 17, BSA = 8, BSB = 8, ELP = 136, TPS = 8;
__device__ __forceinline__ void sort128(unsigned& e0, unsigned& e1, int lane) {
#pragma unroll
    for (int size = 2; size <= 128; size <<= 1) {
#pragma unroll
        for (int stride = size >> 1; stride > 0; stride >>= 1) {
            if (stride == 64) { const unsigned lo = e0 < e1 ? e0 : e1, hi = e0 < e1 ? e1 : e0; e0 = lo; e1 = hi; }
            else {
                const bool lower = (lane & stride) == 0;
                const bool asc0 = (size == 128) ? true : (size == 64 ? true : ((lane & size) == 0));
                const bool asc1 = (size == 128) ? true : (size == 64 ? false : ((lane & size) == 0));
                const unsigned p0 = xorx_sw(e0, lane, stride), p1 = xorx_sw(e1, lane, stride);
                const unsigned mn0 = e0 < p0 ? e0 : p0, mx0 = e0 < p0 ? p0 : e0, mn1 = e1 < p1 ? e1 : p1, mx1 = e1 < p1 ? p1 : e1;
                e0 = (lower == asc0) ? mn0 : mx0; e1 = (lower == asc1) ? mn1 : mx1;
            }
        }
    }
}
template <int BS> __device__ __forceinline__ void sw_issue(v4u (&buf)[BS], const LAS unsigned* el, const unsigned char* tab, unsigned voff) {
#pragma unroll
    for (int i = 0; i < BS; ++i) { const unsigned off = (el[i] << 10) + voff;
        buf[i] = *(const v4u*)(tab + off); }
}
template <int BS> __device__ __forceinline__ void sw_proc_a(const v4u (&buf)[BS], const v4u& hq, LAS float* wl, int s, int n, int lane) {
    const int hx = (int)hq.x, hy = (int)hq.y, hz = (int)hq.z, hw = (int)hq.w;
    float dd[8];
#pragma unroll
    for (int i = 0; i < 8; ++i) dd[i] = 0.f;
#pragma unroll
    for (int i = 0; i < BS; ++i) if (i < n) { const int dx = (int)buf[i].x, dy = (int)buf[i].y, dz = (int)buf[i].z, dw = (int)buf[i].w;
        int t = __builtin_amdgcn_sdot4(hx, dx, 0, false); t = __builtin_amdgcn_sdot4(hy, dy, t, false); t = __builtin_amdgcn_sdot4(hz, dz, t, false); t = __builtin_amdgcn_sdot4(hw, dw, t, false);
        dd[i] = (float)t; }
    const float r1 = reduce8_t(dd, lane);
    if ((lane & 7) == 0 && (lane >> 3) < n) wl[s + (lane >> 3)] = r1;
}
template <int BS> __device__ __forceinline__ void sw_proc_b(const v4u (&buf)[BS], f32x2_t (&acc)[8], const LAS float* wl, int s, int n) {
    float wr[BS];
#pragma unroll
    for (int i = 0; i < BS; ++i) wr[i] = wl[s + i];
#pragma unroll
    for (int i = 0; i < BS; ++i) if (i < n) {
        const float w = wr[i];
        const f32x2_t wv = {w, w};
        const unsigned ux = buf[i].x, uy = buf[i].y, uz = buf[i].z, uw = buf[i].w;
        acc[0] += wv * __builtin_amdgcn_cvt_pk_f32_fp8((int)ux, false); acc[1] += wv * __builtin_amdgcn_cvt_pk_f32_fp8((int)ux, true);
        acc[2] += wv * __builtin_amdgcn_cvt_pk_f32_fp8((int)uy, false); acc[3] += wv * __builtin_amdgcn_cvt_pk_f32_fp8((int)uy, true);
        acc[4] += wv * __builtin_amdgcn_cvt_pk_f32_fp8((int)uz, false); acc[5] += wv * __builtin_amdgcn_cvt_pk_f32_fp8((int)uz, true);
        acc[6] += wv * __builtin_amdgcn_cvt_pk_f32_fp8((int)uw, false); acc[7] += wv * __builtin_amdgcn_cvt_pk_f32_fp8((int)uw, true); }
}
__device__ __forceinline__ void sw_warm(v4u (&pf)[4], const unsigned char* tab, int range, int lw, unsigned voff) {
#pragma unroll
    for (int i = 0; i < 4; ++i) { const unsigned off = ((unsigned)(range * 1024 + lw * 4 + i) << 10) + voff; pf[i] = *(const v4u*)(tab + off); }
}
__device__ __forceinline__ void sw_warm_done(const v4u (&pf)[4]) {
#pragma unroll
    for (int i = 0; i < 4; ++i) asm volatile("" :: "v"(pf[i]));
}
template <int FAKE> __device__ __forceinline__ void p8b_sweep(Frame& F) {
    const float* X1 = (const float*)(((unsigned char*)karg(19)) + WS_X1); const float* MOD = (const float*)(((unsigned char*)karg(19)) + WS_MOD);
    const unsigned char* H2Q = (const unsigned char*)(((unsigned char*)karg(19)) + WS_H2Q); const float* H2S = (const float*)(((unsigned char*)karg(19)) + WS_H2S);
    const unsigned char* EDq = (const unsigned char*)(((unsigned char*)karg(19)) + WS_ED); const unsigned char* EUq = (const unsigned char*)(((unsigned char*)karg(19)) + WS_EU); const float* EDS = (const float*)(((unsigned char*)karg(19)) + WS_EDS);
    const unsigned short* PIDX = (const unsigned short*)(((unsigned char*)karg(19)) + WS_PIDX); const float* PG = (const float*)(((unsigned char*)karg(19)) + WS_PG);
    const float* fg = ((const float*)karg(17));
    const int gw = F.vcu * NWAVES + F.wave, NGW = F.G * NWAVES;
    for (int wi = F.vcu; wi < M / 64; wi += F.G) {
        const int tb = wi * 8 + F.wave;
        unsigned ones = ~0u; asm volatile("" : "+s"(ones));
        int lane = (int)__builtin_amdgcn_mbcnt_hi(ones, __builtin_amdgcn_mbcnt_lo(ones, 0u)); asm volatile("" : "+v"(lane));
        const int tok0 = tb * 8;
        unsigned E0[8], E1[8];
        LAS float* Wl = (LAS float*)(F.lds) + F.wave * 1024;
        LAS unsigned* El = (LAS unsigned*)(F.lds + 32768) + F.wave * (8 * ELP);
        unsigned voff = 16u * (unsigned)lane; asm volatile("" : "+v"(voff));
        LAS int* Bnd = (LAS int*)(F.lds + 67584) + F.wave * (8 * (NR + 1));
#pragma unroll
        for (int k = 0; k < 8; ++k) {
            const size_t base = (size_t)(tok0 + k) * 128;
            E0[k] = ((unsigned)PIDX[base + lane] << 7) | (unsigned)lane; E1[k] = ((unsigned)PIDX[base + 64 + lane] << 7) | (unsigned)(64 + lane);
            sort128(E0[k], E1[k], lane);
            if (FAKE) { E0[k] = (E0[k] & 0x1ffffu) ; E1[k] = (E1[k] & 0x1ffffu); sort128(E0[k], E1[k], lane); }
            El[k * ELP + lane] = E0[k] >> 7; El[k * ELP + 64 + lane] = E1[k] >> 7;
            if (lane < 8) El[k * ELP + 128 + lane] = (unsigned)__builtin_amdgcn_readlane((int)E1[k], 63) >> 7;
        }
        for (int repa = 0; repa < PROBE_REPA; ++repa) {
            v4u hq[8];
#pragma unroll
            for (int k = 0; k < 8; ++k) hq[k] = *(const v4u*)(H2Q + (size_t)(tok0 + k) * D + 16 * lane);
            int pos[8];
#pragma unroll
            for (int k = 0; k < 8; ++k) pos[k] = 0;
            v4u bA[BSA], bB[BSA]; int ps = 0, pn = 0;
            for (int r = 0; r < NR; ++r) {
#pragma unroll
                for (int k = 0; k < 8; ++k) {
                    constexpr int dummy = 0; (void)dummy;
                    const int kp = (k + 7) & 7;
                    const int c = __builtin_popcountll(__ballot((E0[k] >> RSH) == (unsigned)r)) + __builtin_popcountll(__ballot((E1[k] >> RSH) == (unsigned)r));
                    int s = __builtin_amdgcn_readfirstlane(pos[k]); const int e_end = __builtin_amdgcn_readfirstlane(s + c); pos[k] = e_end;
                    if (lane == 0) Bnd[k * (NR + 1) + r + 1] = e_end;
                    const int n1 = (e_end - s) < BSA ? (e_end - s) : BSA;
                    if (k & 1) sw_issue<BSA>(bB, El + k * ELP + s, EDq, voff); else sw_issue<BSA>(bA, El + k * ELP + s, EDq, voff);
                    if (pn > 0) { if (k & 1) sw_proc_a<BSA>(bA, hq[kp], Wl + kp * 128, ps, pn, lane); else sw_proc_a<BSA>(bB, hq[kp], Wl + kp * 128, ps, pn, lane); }
                    ps = s; pn = n1; s += n1;
                    for (; s < e_end; s += BSA) {
                        const int n = (e_end - s) < BSA ? (e_end - s) : BSA;
                        if (k & 1) { sw_issue<BSA>(bA, El + k * ELP + s, EDq, voff); sw_proc_a<BSA>(bA, hq[k], Wl + k * 128, s, n, lane); }
                        else       { sw_issue<BSA>(bB, El + k * ELP + s, EDq, voff); sw_proc_a<BSA>(bB, hq[k], Wl + k * 128, s, n, lane); }
                    }
                }
            }
            if (pn > 0) sw_proc_a<BSA>(bB, hq[7], Wl + 7 * 128, ps, pn, lane);
        }
#pragma unroll
        for (int k = 0; k < 8; ++k) { int tk = tok0 + k; asm volatile("" : "+s"(tk)); const size_t base = (size_t)tk * 128; const float sh = H2S[tk];
            const float r0 = Wl[k * 128 + lane], r1 = Wl[k * 128 + 64 + lane];
            Wl[k * 128 + lane] = PG[base + (E0[k] & 127u)] * gelu_erf(r0 * sh * EDS[E0[k] >> 7]) * 0.0625f;
            Wl[k * 128 + 64 + lane] = PG[base + (E1[k] & 127u)] * gelu_erf(r1 * sh * EDS[E1[k] >> 7]) * 0.0625f; }
        int ln = lane; asm volatile("" : "+v"(ln));
#pragma unroll
        for (int sub = 0; sub < 8 / TPS; ++sub) {
        f32x2_t acc[TPS][8];
        for (int repb = 0; repb < PROBE_REPB; ++repb) {
#pragma unroll
            for (int kk = 0; kk < TPS; ++kk)
#pragma unroll
                for (int i = 0; i < 8; ++i) acc[kk][i] = (f32x2_t){0.f, 0.f};
            int pos[TPS];
#pragma unroll
            for (int kk = 0; kk < TPS; ++kk) pos[kk] = 0;
            v4u bA[BSB], bB[BSB]; int ps = 0, pn = 0;
            for (int r = 0; r < NR; ++r) {
#pragma unroll
                for (int kk = 0; kk < TPS; ++kk) {
                    const int k = sub * TPS + kk, kkp = (kk + TPS - 1) % TPS, kp = sub * TPS + kkp;
                    int s = __builtin_amdgcn_readfirstlane(pos[kk]); const int e_end = __builtin_amdgcn_readfirstlane(Bnd[k * (NR + 1) + r + 1]); pos[kk] = e_end;
                    const int n1 = (e_end - s) < BSB ? (e_end - s) : BSB;
                    if (kk & 1) sw_issue<BSB>(bB, El + k * ELP + s, EUq, voff); else sw_issue<BSB>(bA, El + k * ELP + s, EUq, voff);
                    if (pn > 0) { if (kk & 1) sw_proc_b<BSB>(bA, acc[kkp], Wl + kp * 128, ps, pn); else sw_proc_b<BSB>(bB, acc[kkp], Wl + kp * 128, ps, pn); }
                    ps = s; pn = n1; s += n1;
                    for (; s < e_end; s += BSB) {
                        const int n = (e_end - s) < BSB ? (e_end - s) : BSB;
                        if (kk & 1) { sw_issue<BSB>(bA, El + k * ELP + s, EUq, voff); sw_proc_b<BSB>(bA, acc[kk], Wl + k * 128, s, n); }
                        else        { sw_issue<BSB>(bB, El + k * ELP + s, EUq, voff); sw_proc_b<BSB>(bB, acc[kk], Wl + k * 128, s, n); }
                    }
                }
            }
            if (pn > 0) sw_proc_b<BSB>(bB, acc[TPS - 1], Wl + (sub * TPS + TPS - 1) * 128, ps, pn);
        }
#pragma unroll
        for (int kk = 0; kk < TPS; ++kk) {
            const int tok = tok0 + sub * TPS + kk; const int b = tok >> 12; const float* gt2 = MOD + b * NMOD + 5120;
            f32x4 x2[4]; float ss = 0.f;
#pragma unroll
            for (int j = 0; j < 4; ++j) { const int col = 4 * ln + 256 * j;
                const f32x4 xv = *(const f32x4*)(X1 + (size_t)tok * D + col), gv4 = *(const f32x4*)(gt2 + col);
#pragma unroll
                for (int i = 0; i < 4; ++i) { const float v = xv[i] + gv4[i] * acc[kk][2 * j + (i >> 1)][i & 1]; x2[j][i] = v; ss += v * v; } }
            ss = wave_sum_x(ss, ln);
            if (FAKE && ss != 12345.678f) continue;
            const float rstd = 1.0f / sqrtf(ss * (1.0f / D) + EPS);
#pragma unroll
            for (int j = 0; j < 4; ++j) { const int col = 4 * ln + 256 * j; const f32x4 gg = *(const f32x4*)(fg + col);
                *(f32x4*)(((float*)karg(18)) + (size_t)tok * D + col) = x2[j] * rstd * gg; }
        }
        }
    }
}

struct Args { const float* in[18]; float* out; unsigned char* ws; };
__global__ void __launch_bounds__(NTHR, 2) mega_fwd(Args args) {
    extern __shared__ __attribute__((aligned(16))) unsigned char lds[];
    Frame F;
    F.lds = (LAS unsigned char*)lds;
    F.wave = __builtin_amdgcn_readfirstlane((int)threadIdx.x >> 6); F.lane = lane_fresh(); F.tid = F.wave * 64 + F.lane;
    F.G = gridDim.x; { const int bx = blockIdx.x; F.vcu = (F.G % 8 == 0) ? (bx % 8) * (F.G / 8) + bx / 8 : bx; }
    volatile LAS unsigned* MISC = (volatile LAS unsigned*)(F.lds + MISC_OFF);
    for (int u = F.tid; u < (LDS_BYTES - LDSCTL_OFF) / 4; u += NTHR) ((LAS unsigned*)(F.lds + LDSCTL_OFF))[u] = 0u;
    __syncthreads();
    gu32* ctl = (gu32*)(((unsigned char*)karg(19)) + WS_CTL);
    XcdBarrier bar = xcd_barrier_post((unsigned*)(ctl + CW_BAR), MISC + 8, F.wave);
#define GRID_BAR() xcd_barrier(bar)
#define PROBE_TS -1
#define STAMP(i) do { if (PROBE_TS >= 0 && blockIdx.x == 0 && F.tid == 0) { const unsigned long long t_ = __builtin_amdgcn_s_memrealtime(); MISC[16 + 2 * (i)] = (unsigned)t_; MISC[17 + 2 * (i)] = (unsigned)(t_ >> 32); } } while (0)
#define PROBE_DBL -1

    STAMP(0);
    F.lane = lane_fresh(); F.tid = F.wave * 64 + F.lane;
    p0_prologue(F); GRID_BAR(); STAMP(1);
    if (PROBE_DBL == 0) { p0_prologue(F); GRID_BAR(); }
    F.lane = lane_fresh(); F.tid = F.wave * 64 + F.lane;
    p1_norm(F); p0_transposes(F); GRID_BAR(); STAMP(2);
    if (PROBE_DBL == 1) { p1_norm(F); GRID_BAR(); }
    {
    {
        pg8::Gemm g{(const pg8::bf16_t*)(((unsigned char*)karg(19)) + WS_H), (const pg8::bf16_t*)(((unsigned char*)karg(19)) + WS_WIN), M, NPROJ, D, nullptr, nullptr};
        pg8::StaticOrder S; S.init(M, NPROJ, F.G, (int)blockIdx.x);
        pg8::EpiBf16<0> E{(pg8::bf16_t*)(((unsigned char*)karg(19)) + WS_PROJ), NPROJ, nullptr, 0, 0, 1.f};
        pg8::gemm_phase<pg8::EpiBf16<0>, pg8::StaticOrder, true, true>(F.lds + RING_OFF, g, S, E, F.wave);
        const int nwg = (M / 256) * (NPROJ / 256), busy = nwg % F.G;
        if (busy == 0) p0_quant_tables(F, F.vcu * NWAVES + F.wave, F.G * NWAVES);
        else if ((int)blockIdx.x >= busy) p0_quant_tables(F, ((int)blockIdx.x - busy) * NWAVES + F.wave, (F.G - busy) * NWAVES);
    }
    GRID_BAR(); STAMP(3);
    }
    p3_attention(F); GRID_BAR(); STAMP(4);
    if (PROBE_DBL == 3) { p3_attention(F); GRID_BAR(); }
    {
    {
        pg8::Gemm g{(const pg8::bf16_t*)(((unsigned char*)karg(19)) + WS_OA), (const pg8::bf16_t*)(((unsigned char*)karg(19)) + WS_WA), M, D, 512, (const pg8::bf16_t*)(((unsigned char*)karg(19)) + WS_OB), (const pg8::bf16_t*)(((unsigned char*)karg(19)) + WS_WB)};
        PairOrder S; S.S.init(M, D, F.G, (int)blockIdx.x);
        EpiGate E{(const bf16*)(((unsigned char*)karg(19)) + WS_PROJ), (bf16*)((float*)karg(18)) + (size_t)M * D};
        pg8::gemm_phase<EpiGate, PairOrder, false, true>(F.lds + RING_OFF, g, S, E, F.wave);
    }
    GRID_BAR(); STAMP(5);
    }
    {
    {
        pg8::Gemm g{(const pg8::bf16_t*)((bf16*)((float*)karg(18)) + (size_t)M * D), (const pg8::bf16_t*)(((unsigned char*)karg(19)) + WS_WOUT), M, D, D, nullptr, nullptr};
        pg8::StaticOrder S; S.init(M, D, F.G, (int)blockIdx.x);
        EpiRes E{((const float*)karg(0)), (const float*)(((unsigned char*)karg(19)) + WS_MOD), (float*)(((unsigned char*)karg(19)) + WS_X1)};
        pg8::gemm_phase<EpiRes, pg8::StaticOrder, false, true>(F.lds + RING_OFF, g, S, E, F.wave);
    }
    GRID_BAR(); STAMP(6);
    }
    F.lane = lane_fresh(); F.tid = F.wave * 64 + F.lane;
    F.lane = lane_fresh(); F.tid = F.wave * 64 + F.lane;
    p6_norm2(F); GRID_BAR(); STAMP(7);
    if (PROBE_DBL == 6) { p6_norm2(F); GRID_BAR(); }
    {
    {
        pg8::Gemm g{(const pg8::bf16_t*)(((unsigned char*)karg(19)) + WS_H2), (const pg8::bf16_t*)(((unsigned char*)karg(19)) + WS_WQ), M, D, D, nullptr, nullptr};
        pg8::StaticOrder S; S.init(M, D, F.G, (int)blockIdx.x);
        pg8::EpiBf16<0> E{(pg8::bf16_t*)(((unsigned char*)karg(19)) + WS_QP), D, nullptr, 0, 0, 1.f};
        pg8::gemm_phase<pg8::EpiBf16<0>, pg8::StaticOrder, false, true>(F.lds + RING_OFF, g, S, E, F.wave);
    }
    GRID_BAR(); STAMP(8);
    }
    F.lane = lane_fresh(); F.tid = F.wave * 64 + F.lane;
    p8a_topk(F); __syncthreads(); STAMP(9);
    if (PROBE_DBL == 8) { p8a_topk(F); GRID_BAR(); }
    if (PROBE_DBL == 12) { p8b_sweep<1>(F); __syncthreads(); }
    p8b_sweep<0>(F);
    if (PROBE_DBL == 9) { GRID_BAR(); p8b_sweep<0>(F); }
    if (PROBE_TS >= 0) {
        GRID_BAR(); STAMP(10);
        if (blockIdx.x == 0) { __syncthreads();
            const unsigned long long t0 = ((unsigned long long)MISC[17 + 2 * PROBE_TS] << 32) | MISC[16 + 2 * PROBE_TS], t1 = ((unsigned long long)MISC[19 + 2 * PROBE_TS] << 32) | MISC[18 + 2 * PROBE_TS];
            const float d_us = (float)(t1 - t0) * 0.01f;
            const float V = 128.0f * sqrtf(d_us * 1e-5f);
            float* o = (float*)karg(18); for (int c = F.tid; c < D; c += NTHR) o[c] = V; }
    }
}

extern "C" void kernel_launch(void* const* d_in, const int* in_sizes, int n_in, void* d_out, int out_size, void* d_ws, size_t ws_size, hipStream_t stream) {
    static int grid = 0;
    if (grid == 0) {
        if (n_in != 18 || in_sizes[0] != M * D || out_size != M * D || ws_size < WS_END) { fprintf(stderr, "kernel_launch: unexpected shapes (n_in %d, in0 %d, out %d, ws %zu)\n", n_in, n_in > 0 ? in_sizes[0] : -1, out_size, ws_size); grid = -1; return; }
        int dev = 0, cus = 0, per_cu = 0;
        if (hipGetDevice(&dev) != hipSuccess || hipDeviceGetAttribute(&cus, hipDeviceAttributeMultiprocessorCount, dev) != hipSuccess) { grid = -1; return; }
        if (hipFuncSetAttribute((const void*)mega_fwd, hipFuncAttributeMaxDynamicSharedMemorySize, LDS_BYTES) != hipSuccess) { fprintf(stderr, "kernel_launch: hipFuncSetAttribute failed\n"); grid = -1; return; }
        if (hipOccupancyMaxActiveBlocksPerMultiprocessor(&per_cu, (const void*)mega_fwd, NTHR, LDS_BYTES) != hipSuccess || per_cu < 1) { fprintf(stderr, "kernel_launch: occupancy query says %d blocks per CU\n", per_cu); }
        (void)hipGetLastError();
        grid = cus;
    }
    if (grid < 0) return;
    if (hipMemsetAsync((char*)d_ws + WS_CTL, 0, CTL_ZERO_BYTES, stream) != hipSuccess) { fprintf(stderr, "kernel_launch: memset failed\n"); return; }
    Args a{};
    for (int i = 0; i < 18; ++i) a.in[i] = (const float*)d_in[i];
    a.out = (float*)d_out; a.ws = (unsigned char*)d_ws;
    hipLaunchKernelGGL(mega_fwd, dim3(grid), dim3(NTHR), LDS_BYTES, stream, a);
}
```

```cpp
#include <hip/hip_runtime.h>
#include <cstdio>
#include <cstdint>
__device__ __forceinline__ int lane_fresh() { unsigned ones = ~0u; asm volatile("" : "+s"(ones)); return (int)__builtin_amdgcn_mbcnt_hi(ones, __builtin_amdgcn_mbcnt_lo(ones, 0u)); }
namespace pg8 {
#define PG8_LAS __attribute__((address_space(3)))
typedef unsigned short bf16_t;
typedef short bf16x8 __attribute__((ext_vector_type(8)));
typedef float f32x4 __attribute__((ext_vector_type(4)));
typedef unsigned u32x4 __attribute__((ext_vector_type(4)));
constexpr int BM = 256, BK = 64, HALF = 128, HTB = HALF * BK * 2  , STAGE_BYTES = 8 * HTB, NXCD = 8, WGM = 8;

__host__ __device__ __forceinline__ int lds_byte(int r, int c) { const int st = (r >> 4) * 2 + (c >> 5), rr = r & 15, cc = c & 31, ob = rr * 64 + cc * 2; return st * 1024 + (ob ^ (((ob >> 9) & 1) << 5)); }
__host__ __device__ __forceinline__ void stage_rc(int b, int& R, int& C) { const int st = b / 1024, sb = b % 1024, swz = sb ^ (((sb >> 9) & 1) << 5); R = (st >> 1) * 16 + swz / 64; C = (st & 1) * 32 + (swz % 64) / 2; }
__host__ __device__ __forceinline__ int perm32(int rho) { const int n = rho >> 4, i = rho & 15; return 8 * (i >> 2) + 4 * n + (i & 3); }

struct Unit { int pm, pn, src; };
struct Gemm { const bf16_t* A; const bf16_t* Bt; int M, N, K; const bf16_t* A2; const bf16_t* Bt2; };

struct StaticOrder {
    int nM, nN, nwg, G, c;
    __host__ __device__ void init(int M, int N, int G_, int c_) { nM = M / BM; nN = N / BM; nwg = nM * nN; G = G_; c = c_; }
    __host__ __device__ bool next(int i, Unit& u) const {
        const long L = (long)i * G + c; if (L >= nwg) return false;
        int wgid = (int)L; { const int q = nwg / NXCD, r = nwg % NXCD, xcd = wgid % NXCD, off = wgid / NXCD; wgid = (xcd < r ? xcd * (q + 1) : r * (q + 1) + (xcd - r) * q) + off; }
        const int nig = WGM * nN, gid = wgid / nig, fm = gid * WGM, gsz = (nM - fm) < WGM ? (nM - fm) : WGM;
        u.pm = fm + ((wgid % nig) % gsz); u.pn = (wgid % nig) / gsz; u.src = 0; return true;
    }
    __device__ __forceinline__ void a_ready(const Unit&) const {}
    __device__ __forceinline__ void done(const Unit&) const {}
};

__device__ __forceinline__ unsigned cvt_pk_bf16(float lo, float hi) { unsigned r; asm volatile("v_cvt_pk_bf16_f32 %0, %1, %2" : "=v"(r) : "v"(lo), "v"(hi)); return r; }
typedef float f32x2 __attribute__((ext_vector_type(2)));
__device__ __forceinline__ f32x2 gelu_pk(f32x2 v) {
    const f32x2 av = __builtin_elementwise_abs(v), d = av * 0.2316418882f + 1.0f;
    f32x2 t; t.x = __builtin_amdgcn_rcpf(d.x); t.y = __builtin_amdgcn_rcpf(d.y);
    f32x2 q = t * 0.5307027145f + (-0.7265760135f); q = q * t + 0.7107068705f; q = q * t + (-0.142248368f); q = q * t + 0.127414796f; q = q * t;
    const f32x2 s = (v * v) * (-0.72134752044f);
    f32x2 e; e.x = __builtin_amdgcn_exp2f(s.x); e.y = __builtin_amdgcn_exp2f(s.y);
    const f32x2 m = v * (q * e), r = v - m;
    f32x2 o; o.x = v.x < 0.f ? m.x : r.x; o.y = v.y < 0.f ? m.y : r.y; return o;
}

template <int ACT  > struct EpiBf16 {
    static constexpr bool PERM = true, AFTER_DRAIN = false, CHAIN = false; static_assert(ACT == 0 || ACT == 1, "EpiBf16: ACT is 0 (none) or 1 (gelu_pk)");
    bf16_t* O; int ldc; const float* bias; int split_cols; size_t split_stride; float scale0;
    __device__ __forceinline__ void operator()(const f32x4 (&acc)[2][2][4][2], const Unit& u, int wr, int wc, int fr, int fq) const {
        const int row0 = u.pm * BM + wr * 64 + fr; int colt = u.pn * BM; bf16_t* base = O;
        float sc = 1.f; if (split_cols) { const int t = colt / split_cols; base += (size_t)t * split_stride; colt -= t * split_cols; if (t == 0) sc = scale0; }
        const int col0 = colt + wc * 32 + 8 * fq, bcol0 = u.pn * BM + wc * 32 + 8 * fq;
        f32x4 bv[2][2];
#pragma unroll
        for (int bj = 0; bj < 2; ++bj)
#pragma unroll
            for (int n = 0; n < 2; ++n) bv[bj][n] = bias ? *(const f32x4*)(bias + bcol0 + bj * HALF + 4 * n) : (f32x4){0.f, 0.f, 0.f, 0.f};
#pragma unroll
        for (int ai = 0; ai < 2; ++ai)
#pragma unroll
            for (int m = 0; m < 4; ++m) { bf16_t* rowp = base + (size_t)(row0 + ai * HALF + m * 16) * ldc + col0;
#pragma unroll
                for (int bj = 0; bj < 2; ++bj) { f32x4 v0 = acc[ai][bj][m][0] + bv[bj][0], v1 = acc[ai][bj][m][1] + bv[bj][1];
                    if (ACT == 1) { f32x2 a = gelu_pk((f32x2){v0[0], v0[1]}), b = gelu_pk((f32x2){v0[2], v0[3]}), c = gelu_pk((f32x2){v1[0], v1[1]}), d = gelu_pk((f32x2){v1[2], v1[3]});
                        v0 = (f32x4){a.x, a.y, b.x, b.y}; v1 = (f32x4){c.x, c.y, d.x, d.y}; }
                    v0 = v0 * sc; v1 = v1 * sc; u32x4 w; w.x = cvt_pk_bf16(v0[0], v0[1]); w.y = cvt_pk_bf16(v0[2], v0[3]); w.z = cvt_pk_bf16(v1[0], v1[1]); w.w = cvt_pk_bf16(v1[2], v1[3]);
                    *(u32x4*)(rowp + bj * HALF) = w; } }
    }
};

template <class Epi, class Sched, bool ALIGN_EPI = false, bool SP2 = false>
__device__ __forceinline__ void gemm_phase(PG8_LAS unsigned char* lds, const Gemm g, const Sched& S, const Epi& E, int wave_id) {
    int tid = wave_id * 64 + ::lane_fresh(); asm volatile("" : "+v"(tid));
    const int wid = __builtin_amdgcn_readfirstlane(tid >> 6), lane = tid & 63, wr = wid >> 2, wc = wid & 3, fr = lane & 15, fq = lane >> 4;
    const int K = g.K, nt = K / BK;
    unsigned voffA[2], voffB[2];
#pragma unroll
    for (int i = 0; i < 2; ++i) { int R, C; stage_rc(tid * 16 + i * 8192, R, C); const int Rb = Epi::PERM ? ((R & ~31) + perm32(R & 31)) : R;
        voffA[i] = (unsigned)(R * K + C) * 2u; voffB[i] = (unsigned)(Rb * K + C) * 2u; }
    const size_t kstep = (size_t)(BK * 2);
    const size_t hstep = (size_t)HALF * K * 2;
    const size_t tstep = 2 * hstep;
    const unsigned ldsw = (unsigned)wid * 1024u;
    const int aoff = lds_byte(wr * 64 + fr, fq * 8), boff = lds_byte(wc * 32 + fr, fq * 8);
#define PG8_SA(b, h) (((b) * 2 + (h)) * HTB)
#define PG8_SB(b, h) ((4 + (b) * 2 + (h)) * HTB)
#define PG8_STAGE(bufoff, gbase, voff) do { _Pragma("unroll") for (int _i = 0; _i < 2; ++_i) \
        __builtin_amdgcn_global_load_lds((const unsigned*)((const char*)(gbase) + (voff)[_i]), (PG8_LAS unsigned*)(lds + (bufoff) + ldsw + _i * 8192), 16, 0, 0); } while (0)
#define PG8_LDA(dst, b, h) do { _Pragma("unroll") for (int m = 0; m < 4; ++m) _Pragma("unroll") for (int k = 0; k < 2; ++k) dst[m][k] = *(const PG8_LAS bf16x8*)(lds + PG8_SA(b, h) + aoff + m * 2048 + k * 1024); } while (0)
#define PG8_LDB(dst, b, h) do { _Pragma("unroll") for (int n = 0; n < 2; ++n) _Pragma("unroll") for (int k = 0; k < 2; ++k) dst[n][k] = *(const PG8_LAS bf16x8*)(lds + PG8_SB(b, h) + boff + n * 2048 + k * 1024); } while (0)
#define PG8_MMA(ai, bj, At, Bt) do { __builtin_amdgcn_s_setprio(1); _Pragma("unroll") for (int m = 0; m < 4; ++m) _Pragma("unroll") for (int n = 0; n < 2; ++n) _Pragma("unroll") for (int k = 0; k < 2; ++k) \
        acc[ai][bj][m][n] = __builtin_amdgcn_mfma_f32_16x16x32_bf16(Bt[n][k], At[m][k], acc[ai][bj][m][n], 0, 0, 0); __builtin_amdgcn_s_setprio(0); } while (0)
#define PG8_WAIT_V(n) asm volatile("s_waitcnt vmcnt(" #n ")" ::: "memory")
#define PG8_WAIT_L(n) asm volatile("s_waitcnt lgkmcnt(" #n ")" ::: "memory")
#define PG8_BAR __builtin_amdgcn_s_barrier()
#define PG8_SCHED __builtin_amdgcn_sched_barrier(0)
    Unit cur, nxt; int ui = 0;
    if (!S.next(0, cur)) return;
    f32x4 acc[2][2][4][2];
#pragma unroll
    for (int a = 0; a < 2; ++a)
#pragma unroll
        for (int b = 0; b < 2; ++b)
#pragma unroll
            for (int m = 0; m < 4; ++m)
#pragma unroll
                for (int n = 0; n < 2; ++n) acc[a][b][m][n] = (f32x4){0.f, 0.f, 0.f, 0.f};
    bf16x8 At[4][2], B0[2][2], B1[2][2];
    const char* cA = (const char*)(cur.src ? g.A2 : g.A) + (size_t)cur.pm * tstep; const char* cB = (const char*)(cur.src ? g.Bt2 : g.Bt) + (size_t)cur.pn * tstep;
    S.a_ready(cur);
    if constexpr (SP2) {
        PG8_STAGE(PG8_SB(0, 0), cB, voffB); PG8_STAGE(PG8_SB(0, 1), cB + hstep, voffB); PG8_STAGE(PG8_SA(0, 0), cA, voffA); PG8_STAGE(PG8_SA(0, 1), cA + hstep, voffA);
        if (wr == 1) PG8_BAR;
        PG8_WAIT_V(2); PG8_BAR;
        PG8_STAGE(PG8_SB(1, 0), cB + kstep, voffB); PG8_STAGE(PG8_SA(1, 0), cA + kstep, voffA); PG8_STAGE(PG8_SB(1, 1), cB + hstep + kstep, voffB);
        PG8_WAIT_V(6); PG8_BAR;
    } else {
        PG8_STAGE(PG8_SB(0, 0), cB, voffB); PG8_STAGE(PG8_SA(0, 0), cA, voffA); PG8_STAGE(PG8_SB(0, 1), cB + hstep, voffB); PG8_STAGE(PG8_SA(0, 1), cA + hstep, voffA);
        if (wr == 1) PG8_BAR;
        PG8_WAIT_V(4); PG8_BAR;
        PG8_STAGE(PG8_SB(1, 0), cB + kstep, voffB); PG8_STAGE(PG8_SA(1, 0), cA + kstep, voffA); PG8_STAGE(PG8_SB(1, 1), cB + hstep + kstep, voffB);
        PG8_WAIT_V(6); PG8_BAR;
    }
    for (;;) {
        const bool has_next = S.next(ui + 1, nxt);
        const char* nA = has_next ? (const char*)(nxt.src ? g.A2 : g.A) + (size_t)nxt.pm * tstep : cA; const char* nB = has_next ? (const char*)(nxt.src ? g.Bt2 : g.Bt) + (size_t)nxt.pn * tstep : cB;
        for (int t = 0; t < nt; t += 2) {
            const bool last = (t == nt - 2);
            const char* a1 = cA + (size_t)(t + 1) * kstep;
            const char* a2 = last ? nA : cA + (size_t)(t + 2) * kstep; const char* b2 = last ? nB : cB + (size_t)(t + 2) * kstep;
            const char* a3 = a2 + kstep; const char* b3 = b2 + kstep;
            if (last && has_next) S.a_ready(nxt);
            if constexpr (SP2) {
            PG8_LDB(B0, 0, 0); PG8_LDB(B1, 0, 1); PG8_SCHED; PG8_LDA(At, 0, 0); PG8_STAGE(PG8_SA(1, 1), a1 + hstep, voffA);
            PG8_WAIT_V(8); PG8_WAIT_L(0); PG8_BAR; PG8_MMA(0, 0, At, B0); PG8_MMA(0, 1, At, B1); PG8_BAR; PG8_SCHED;
            PG8_LDA(At, 0, 1); PG8_STAGE(PG8_SB(0, 0), b2, voffB); PG8_STAGE(PG8_SB(0, 1), b2 + hstep, voffB); PG8_STAGE(PG8_SA(0, 0), a2, voffA);
            PG8_WAIT_V(8); PG8_WAIT_L(0); PG8_BAR; PG8_MMA(1, 0, At, B0); PG8_MMA(1, 1, At, B1); PG8_BAR; PG8_SCHED;
            PG8_LDB(B0, 1, 0); PG8_LDB(B1, 1, 1); PG8_SCHED; PG8_LDA(At, 1, 0); PG8_STAGE(PG8_SA(0, 1), a2 + hstep, voffA);
            PG8_WAIT_V(8); PG8_WAIT_L(0); PG8_BAR; PG8_MMA(0, 0, At, B0); PG8_MMA(0, 1, At, B1); PG8_BAR; PG8_SCHED;
            PG8_LDA(At, 1, 1); PG8_STAGE(PG8_SB(1, 0), b3, voffB); PG8_STAGE(PG8_SB(1, 1), b3 + hstep, voffB); PG8_STAGE(PG8_SA(1, 0), a3, voffA);
            PG8_WAIT_V(8); PG8_WAIT_L(0); PG8_BAR; PG8_MMA(1, 0, At, B0); PG8_MMA(1, 1, At, B1); PG8_BAR; PG8_SCHED;
            } else {
            PG8_LDB(B0, 0, 0); PG8_SCHED; PG8_LDA(At, 0, 0); PG8_STAGE(PG8_SA(1, 1), a1 + hstep, voffA);
            PG8_WAIT_L(8); PG8_BAR; PG8_WAIT_L(0); PG8_MMA(0, 0, At, B0); PG8_BAR; PG8_SCHED;
            PG8_LDB(B1, 0, 1); PG8_STAGE(PG8_SB(0, 0), b2, voffB);
            PG8_BAR; PG8_WAIT_L(0); PG8_MMA(0, 1, At, B1); PG8_BAR;
            PG8_LDA(At, 0, 1); PG8_STAGE(PG8_SA(0, 0), a2, voffA);
            PG8_BAR; PG8_WAIT_L(0); PG8_MMA(1, 0, At, B0); PG8_BAR; PG8_SCHED;
            PG8_STAGE(PG8_SB(0, 1), b2 + hstep, voffB);
            PG8_WAIT_V(6); PG8_BAR; PG8_MMA(1, 1, At, B1); PG8_BAR;
            PG8_LDB(B0, 1, 0); PG8_SCHED; PG8_LDA(At, 1, 0); PG8_STAGE(PG8_SA(0, 1), a2 + hstep, voffA);
            PG8_WAIT_L(8); PG8_BAR; PG8_WAIT_L(0); PG8_MMA(0, 0, At, B0); PG8_BAR; PG8_SCHED;
            PG8_LDB(B1, 1, 1); PG8_STAGE(PG8_SB(1, 0), b3, voffB);
            PG8_BAR; PG8_WAIT_L(0); PG8_MMA(0, 1, At, B1); PG8_BAR;
            PG8_LDA(At, 1, 1); PG8_STAGE(PG8_SA(1, 0), a3, voffA);
            PG8_BAR; PG8_WAIT_L(0); PG8_MMA(1, 0, At, B0); PG8_BAR; PG8_SCHED;
            PG8_STAGE(PG8_SB(1, 1), b3 + hstep, voffB);
            PG8_WAIT_V(6); PG8_BAR; PG8_MMA(1, 1, At, B1); PG8_BAR;
            }
        }
        if constexpr (ALIGN_EPI) { if (wr == 0) PG8_BAR; }
        if constexpr (!Epi::AFTER_DRAIN) { E(acc, cur, wr, wc, fr, fq); S.done(cur); }
        if (!has_next) break;
        if (!(Epi::CHAIN && cur.src == 0)) {
#pragma unroll
        for (int a = 0; a < 2; ++a)
#pragma unroll
            for (int b = 0; b < 2; ++b)
#pragma unroll
                for (int m = 0; m < 4; ++m)
#pragma unroll
                    for (int n = 0; n < 2; ++n) acc[a][b][m][n] = (f32x4){0.f, 0.f, 0.f, 0.f};
        }
        cur = nxt; cA = nA; cB = nB; ++ui;
        if constexpr (ALIGN_EPI) { if (wr == 1) PG8_BAR; }
    }
    PG8_WAIT_V(0);
    if constexpr (!ALIGN_EPI) { if (wr == 0) PG8_BAR; }
    PG8_BAR;
    if constexpr (Epi::AFTER_DRAIN) { E.fused(acc, cur, wr, wc, fr, fq, lds, wid, lane); S.done(cur); }
#undef PG8_SA
#undef PG8_SB
#undef PG8_STAGE
#undef PG8_LDA
#undef PG8_LDB
#undef PG8_MMA
#undef PG8_WAIT_V
#undef PG8_WAIT_L
#undef PG8_BAR
#undef PG8_SCHED
}
}

#define GAS __attribute__((address_space(1)))
#define LAS __attribute__((address_space(3)))
typedef unsigned short bf16;
typedef unsigned v4u __attribute__((ext_vector_type(4)));
typedef float f32x4 __attribute__((ext_vector_type(4)));
typedef short bf16x8 __attribute__((ext_vector_type(8)));
typedef GAS unsigned gu32;
typedef GAS unsigned long long gu64;
#define RLX_AGENT __ATOMIC_RELAXED, __HIP_MEMORY_SCOPE_AGENT
#define LDS_WAIT() asm volatile("s_waitcnt lgkmcnt(0)" ::: "memory")
#define VM_WAIT() asm volatile("s_waitcnt vmcnt(0)" ::: "memory")
__device__ __forceinline__ unsigned long long rt() { return __builtin_amdgcn_s_memrealtime(); }
__device__ __forceinline__ unsigned f2bf(float f) { unsigned u = __builtin_bit_cast(unsigned, f); return (u + 0x7fffu + ((u >> 16) & 1u)) >> 16; }
__device__ __forceinline__ unsigned pk2(float lo, float hi) { return f2bf(lo) | (f2bf(hi) << 16); }

__device__ __forceinline__ const void* karg(int i);
constexpr int CW_BAR_FWD = 4096;
#define XB_TMO      128
#define XB_XCNT(j)  (256  + 64 * (j))
#define XB_XSUB(j)  (1280 + 64 * (j))
#define XB_XGEN(j)  (2304 + 64 * (j))
#define XB_TOP      3328
#define XB_TOPGEN   3392
#define XCD_BAR_WORDS 3456
#define XB_SPIN_CAP (1u << 18)

__device__ __forceinline__ unsigned xb_ld(unsigned* p)              { return __hip_atomic_load(p, __ATOMIC_RELAXED, __HIP_MEMORY_SCOPE_AGENT); }
__device__ __forceinline__ unsigned xb_add(unsigned* p, unsigned v) { return __hip_atomic_fetch_add(p, v, __ATOMIC_RELAXED, __HIP_MEMORY_SCOPE_AGENT); }
__device__ __forceinline__ unsigned xb_xcc_id() { return (unsigned)__builtin_amdgcn_s_getreg((3 << 11) | 20) & 0xFu; }
#define XB_SPIN(cond, bar) do { unsigned _sp = 0; while (cond) { __builtin_amdgcn_s_sleep(1); \
    if ((++_sp & 255u) == 0u) { if (xb_ld(&(bar)[XB_TMO])) break; if (_sp > XB_SPIN_CAP) { atomicAdd(&(bar)[XB_TMO], 1u); break; } } } } while (0)

struct XcdBarrier {
    int wave;
    unsigned* bar; unsigned x;
    volatile LAS unsigned* st;
};

__device__ __forceinline__ XcdBarrier xcd_barrier_post(unsigned* bar, volatile LAS unsigned* st, int wave) {
    XcdBarrier b; b.wave = wave; b.bar = bar; b.x = xb_xcc_id(); b.st = st;
    if (wave == 0 && lane_fresh() == 0) (void)xb_add(&bar[XB_XCNT(b.x)], 1u);
    return b;
}
__device__ __forceinline__ void xcd_barrier_complete(unsigned* bar, unsigned x, unsigned& nloc, unsigned& nx) {
    const unsigned G = gridDim.x * gridDim.y * gridDim.z;
    unsigned sum, cnt, mine, sp = 0u;
    for (;;) {
        sum = 0u; cnt = 0u; mine = 0u;
#pragma unroll
        for (unsigned j = 0; j < 16; ++j) { const unsigned c = xb_ld(&bar[XB_XCNT(j)]); sum += c; cnt += (c > 0u) ? 1u : 0u; mine = (j == x) ? c : mine; }
        if (sum == G) break;
        __builtin_amdgcn_s_sleep(1);
        if ((++sp & 255u) == 0u) { if (xb_ld(&bar[XB_TMO])) break; if (sp > XB_SPIN_CAP) { atomicAdd(&bar[XB_TMO], 1u); break; } }
    }
    nloc = mine > 0u ? mine : 1u; nx = cnt > 0u ? cnt : 1u;
}

__device__ __forceinline__ void xcd_barrier(const XcdBarrier& b) {
    asm volatile("s_waitcnt vmcnt(0)" ::: "memory");
    __syncthreads();
    if (b.wave == 0 && lane_fresh() == 0) {
        unsigned* bar = (unsigned*)((gu32*)((unsigned char*)karg(19)) + CW_BAR_FWD);
        __builtin_amdgcn_s_waitcnt(0);
        unsigned nloc = b.st[0], nx = b.st[1];
        if (nloc == 0u) { xcd_barrier_complete(bar, b.x, nloc, nx); b.st[0] = nloc; b.st[1] = nx; }
        const unsigned old = xb_add(&bar[XB_XSUB(b.x)], 1u);
        const unsigned gen = old / nloc;
        if (old + 1u == (gen + 1u) * nloc) {
            __builtin_amdgcn_fence(__ATOMIC_RELEASE, "agent");
            asm volatile("s_waitcnt vmcnt(0)" ::: "memory");
            const unsigned og = xb_add(&bar[XB_TOP], 1u);
            const unsigned tg = og / nx;
            if (og + 1u == (tg + 1u) * nx) xb_add(&bar[XB_TOPGEN], 1u);
            else XB_SPIN(xb_ld(&bar[XB_TOPGEN]) == tg, bar);
            __builtin_amdgcn_fence(__ATOMIC_ACQUIRE, "agent");
            xb_add(&bar[XB_XGEN(b.x)], 1u);
            asm volatile("s_waitcnt vmcnt(0)" ::: "memory");
        } else {
            XB_SPIN(xb_ld(&bar[XB_XGEN(b.x)]) == gen, bar);
            __builtin_amdgcn_fence(__ATOMIC_ACQUIRE, "agent");
            asm volatile("s_waitcnt vmcnt(0)" ::: "memory");
        }
    }
    __syncthreads();
}

constexpr int NWAVES = 8, NTHR = 512;
constexpr int BATCH = 4, SEQ = 4096, D = 1024, M = BATCH * SEQ;
constexpr int NPROJ = 4352, LDW_IN = 4360, NMOD = 6144;
constexpr int C_QA = 0, C_KA = 512, C_VA = 640, C_QB = 768, C_KB = 1280, C_VB = 1792, C_GLA = 2304, C_GLB = 3328;
constexpr int NEXP = 16384;
constexpr float EPS = 1e-6f;

constexpr size_t MiB = 1u << 20;
constexpr size_t WS_CTL = 0, CTL_ZERO_BYTES = 1 * MiB;
constexpr size_t WS_MOD = 1 * MiB, WS_LOGF = 1 * MiB + 128 * 1024, WS_SUBK = 2 * MiB;
constexpr size_t WS_WIN = 4 * MiB, WS_WA = 12 * MiB + 512 * 1024, WS_WB = 13 * MiB + 512 * 1024, WS_WOUT = 14 * MiB + 512 * 1024, WS_WQ = 16 * MiB + 512 * 1024;
constexpr size_t WS_ED = 19 * MiB, WS_EU = 35 * MiB;
constexpr size_t WS_EDS = 2 * MiB + 512 * 1024;
constexpr size_t WS_H2Q = 95 * MiB, WS_H2S = 111 * MiB;
constexpr size_t WS_H = 83 * MiB, WS_OA = 83 * MiB, WS_OB = 99 * MiB, WS_PIDX = 83 * MiB, WS_PG = 87 * MiB;
constexpr size_t WS_PROJ = 115 * MiB, WS_X1 = 115 * MiB, WS_H2 = 179 * MiB, WS_QP = 211 * MiB;
constexpr size_t WS_END = 251 * MiB;
static_assert(WS_WIN + (size_t)NPROJ * D * 2 <= WS_WA && WS_WQ + (size_t)D * D * 2 <= WS_ED && WS_PROJ + (size_t)M * NPROJ * 2 <= WS_END, "ws map");
constexpr int CW_BAR = 4096; static_assert(CW_BAR == CW_BAR_FWD && WS_CTL == 0, "barrier words");

constexpr int RING_OFF = 0, RING_BYTES = 131072;
constexpr int LDSCTL_OFF = RING_BYTES, MISC_OFF = LDSCTL_OFF + 320;
constexpr int LDS_BYTES = 147456;

typedef float f32x16 __attribute__((ext_vector_type(16)));
typedef short s16x4 __attribute__((ext_vector_type(4)));
typedef unsigned u32x2 __attribute__((ext_vector_type(2)));
typedef float f32x2_t __attribute__((ext_vector_type(2)));
typedef __bf16 bf16x2_t __attribute__((ext_vector_type(2)));

__device__ __forceinline__ unsigned cvtpk(float lo, float hi) { f32x2_t v = {lo, hi}; bf16x2_t b = __builtin_convertvector(v, bf16x2_t); return __builtin_bit_cast(unsigned, b); }
__device__ __forceinline__ float bflo(unsigned u) { return __uint_as_float(u << 16); }
__device__ __forceinline__ float bfhi(unsigned u) { return __uint_as_float(u & 0xffff0000u); }
template <int S> __device__ __forceinline__ unsigned xorx(unsigned v, int lane) {
    if constexpr (S == 1) return (unsigned)__builtin_amdgcn_update_dpp(0, (int)v, 0xB1, 0xF, 0xF, true);
    else if constexpr (S == 2) return (unsigned)__builtin_amdgcn_update_dpp(0, (int)v, 0x4E, 0xF, 0xF, true);
    else if constexpr (S == 4) { const unsigned a = (unsigned)__builtin_amdgcn_update_dpp(0, (int)v, 0x124, 0xF, 0xF, true), b = (unsigned)__builtin_amdgcn_update_dpp(0, (int)v, 0x12C, 0xF, 0xF, true); return (lane & 4) ? a : b; }
    else if constexpr (S == 8) return (unsigned)__builtin_amdgcn_update_dpp(0, (int)v, 0x128, 0xF, 0xF, true);
    else if constexpr (S == 16) { const auto r = __builtin_amdgcn_permlane16_swap(v, v, false, false); return (lane & 16) ? r[0] : r[1]; }
    else { const auto r = __builtin_amdgcn_permlane32_swap(v, v, false, false); return (lane & 32) ? r[0] : r[1]; }
}
__device__ __forceinline__ unsigned xorx_sw(unsigned v, int lane, int s) {
    switch (s) { case 1: return xorx<1>(v, lane); case 2: return xorx<2>(v, lane); case 4: return xorx<4>(v, lane); case 8: return xorx<8>(v, lane); case 16: return xorx<16>(v, lane); default: return xorx<32>(v, lane); }
}
__device__ __forceinline__ float wave_sum_x(float v, int lane) {
    v += __uint_as_float(xorx<1>(__float_as_uint(v), lane)); v += __uint_as_float(xorx<2>(__float_as_uint(v), lane)); v += __uint_as_float(xorx<4>(__float_as_uint(v), lane));
    v += __uint_as_float(xorx<8>(__float_as_uint(v), lane)); v += __uint_as_float(xorx<16>(__float_as_uint(v), lane)); v += __uint_as_float(xorx<32>(__float_as_uint(v), lane));
    return v;
}
__device__ __forceinline__ float dppf(float v, const int ctrl_sel) { return v; }
#define DPP_F(v, CTRL) __uint_as_float(__builtin_amdgcn_update_dpp(0, __float_as_uint(v), (CTRL), 0xF, 0xF, true))
__device__ __forceinline__ float reduce8_t(const float (&dd)[8], int lane) {
    float r4[4];
#pragma unroll
    for (int u = 0; u < 4; ++u) { const auto p = __builtin_amdgcn_permlane32_swap(__float_as_uint(dd[u]), __float_as_uint(dd[u + 4]), false, false); r4[u] = __uint_as_float(p[0]) + __uint_as_float(p[1]); }
    float r2[2];
#pragma unroll
    for (int u = 0; u < 2; ++u) { const auto p = __builtin_amdgcn_permlane16_swap(__float_as_uint(r4[u]), __float_as_uint(r4[u + 2]), false, false); r2[u] = __uint_as_float(p[0]) + __uint_as_float(p[1]); }
    const bool b3 = (lane & 8) != 0;
    const float keep = b3 ? r2[1] : r2[0], send = b3 ? r2[0] : r2[1];
    float r1 = keep + DPP_F(send, 0x128);
    r1 += DPP_F(r1, 0xB1);
    r1 += DPP_F(r1, 0x4E);
    r1 += DPP_F(r1, 0x141);
    return r1;
}
__device__ __forceinline__ int lane_id() { return (int)__builtin_amdgcn_mbcnt_hi(~0u, __builtin_amdgcn_mbcnt_lo(~0u, 0u)); }
__device__ __forceinline__ float wave_sum(float v) { return wave_sum_x(v, lane_id()); }
__device__ __forceinline__ float wave_max(float v) { const int lane = lane_id();
    v = fmaxf(v, __uint_as_float(xorx<1>(__float_as_uint(v), lane))); v = fmaxf(v, __uint_as_float(xorx<2>(__float_as_uint(v), lane))); v = fmaxf(v, __uint_as_float(xorx<4>(__float_as_uint(v), lane)));
    v = fmaxf(v, __uint_as_float(xorx<8>(__float_as_uint(v), lane))); v = fmaxf(v, __uint_as_float(xorx<16>(__float_as_uint(v), lane))); v = fmaxf(v, __uint_as_float(xorx<32>(__float_as_uint(v), lane)));
    return v; }
__device__ __forceinline__ int crow(int r, int hi) { return (r & 3) + 8 * (r >> 2) + 4 * hi; }
#define MFMA32(a, b, c) __builtin_amdgcn_mfma_f32_32x32x16_bf16((a), (b), (c), 0, 0, 0)

struct Frame {
    LAS unsigned char* lds;
    int tid, lane, wave, vcu, G;
};
__device__ __forceinline__ const void* karg(int i) {
    unsigned long z = 0; asm volatile("" : "+s"(z));
    const char* base = (const char*)__builtin_amdgcn_kernarg_segment_ptr();
    return *(const void* const*)(base + 8 * i + z);
}

__device__ __forceinline__ void p0_transpose_item(const float* W, int ld, int K, int ncols, bf16* WT, int row_off, LAS float* scr, int item, int lane) {
    const int nblk = ncols / 32, kb = item / nblk, nb = item % nblk, k0 = 64 * kb, n0 = 32 * nb;
#pragma unroll 8
    for (int i = 0; i < 32; ++i) { const int kk = 2 * i + (lane >> 5); scr[kk * 33 + (lane & 31)] = W[(size_t)(k0 + kk) * ld + n0 + (lane & 31)]; }
    LDS_WAIT(); asm volatile("" ::: "memory");
    const int c = lane & 7;
#pragma unroll
    for (int j = 0; j < 4; ++j) { const int n = (lane >> 3) + 8 * j; const LAS float* s = scr + (8 * c) * 33 + n;
        v4u o; o.x = pk2(s[0 * 33], s[1 * 33]); o.y = pk2(s[2 * 33], s[3 * 33]); o.z = pk2(s[4 * 33], s[5 * 33]); o.w = pk2(s[6 * 33], s[7 * 33]);
        *(GAS v4u*)(WT + (size_t)(row_off + n0 + n) * K + k0 + 8 * c) = o; }
    LDS_WAIT(); asm volatile("" ::: "memory");
}
__device__ __forceinline__ void p0_convert(const float* __restrict__ src, bf16* __restrict__ dst, long n_iters, int gw, int NGW, int lane) {
    for (long it0 = (long)gw * 4; it0 < n_iters; it0 += (long)NGW * 4) {
        f32x4 a[4][2];
#pragma unroll
        for (int u = 0; u < 4; ++u) { const long it = it0 + u; if (it < n_iters) { const float* p = src + it * 512 + lane * 4; a[u][0] = *(const f32x4*)p; a[u][1] = *(const f32x4*)(p + 256); } }
#pragma unroll
        for (int u = 0; u < 4; ++u) { const long it = it0 + u; if (it < n_iters) { bf16* q = dst + it * 512 + lane * 4;
            u32x2 w0, w1; w0.x = cvtpk(a[u][0].x, a[u][0].y); w0.y = cvtpk(a[u][0].z, a[u][0].w); w1.x = cvtpk(a[u][1].x, a[u][1].y); w1.y = cvtpk(a[u][1].z, a[u][1].w);
            *(u32x2*)q = w0; *(u32x2*)(q + 256) = w1; } }
    }
}

__device__ __forceinline__ void p0_quant_tables(Frame& F, int gw, int NGW) {
    const float* ed = ((const float*)karg(15)); const float* eu = ((const float*)karg(16));
    unsigned char* EDq = (unsigned char*)(((unsigned char*)karg(19)) + WS_ED); unsigned char* EUq = (unsigned char*)(((unsigned char*)karg(19)) + WS_EU); float* EDS = (float*)(((unsigned char*)karg(19)) + WS_EDS);
    const int lane = F.lane;
    for (int row0 = gw * 4; row0 < NEXP; row0 += NGW * 4) {
        f32x4 a[4][4], u[4][4];
#pragma unroll
        for (int q = 0; q < 4; ++q)
#pragma unroll
            for (int j = 0; j < 4; ++j) { a[q][j] = *((const f32x4*)(ed + (size_t)(row0 + q) * D) + lane + 64 * j); u[q][j] = *((const f32x4*)(eu + (size_t)(row0 + q) * D) + lane + 64 * j); }
#pragma unroll
        for (int q = 0; q < 4; ++q) {
            float am = 0.f;
#pragma unroll
            for (int j = 0; j < 4; ++j) am = fmaxf(fmaxf(am, fmaxf(fabsf(a[q][j].x), fabsf(a[q][j].y))), fmaxf(fabsf(a[q][j].z), fabsf(a[q][j].w)));
            am = wave_max(am);
            const float sc = am > 0.f ? am * (1.0f / 127.0f) : 1.0f, inv = 1.0f / sc;
            v4u qa, qu;
#pragma unroll
            for (int j = 0; j < 4; ++j) {
                const int b0 = (int)rintf(a[q][j].x * inv), b1 = (int)rintf(a[q][j].y * inv), b2 = (int)rintf(a[q][j].z * inv), b3 = (int)rintf(a[q][j].w * inv);
                qa[j] = (unsigned)(b0 & 255) | ((unsigned)(b1 & 255) << 8) | ((unsigned)(b2 & 255) << 16) | ((unsigned)(b3 & 255) << 24);
                int p = __builtin_amdgcn_cvt_pk_fp8_f32(u[q][j].x * 16.0f, u[q][j].y * 16.0f, 0, false);
                p = __builtin_amdgcn_cvt_pk_fp8_f32(u[q][j].z * 16.0f, u[q][j].w * 16.0f, p, true);
                qu[j] = (unsigned)p;
            }
            *(v4u*)(EDq + (size_t)(row0 + q) * D + 16 * lane) = qa;
            *(v4u*)(EUq + (size_t)(row0 + q) * D + 16 * lane) = qu;
            if (lane == 0) EDS[row0 + q] = sc;
        }
    }
}
__device__ __forceinline__ void p0_prologue(Frame& F) {
    const float* c = ((const float*)karg(1)); const float* w_ada = ((const float*)karg(4)); const float* b_ada = ((const float*)karg(5));
    float* MOD = (float*)(((unsigned char*)karg(19)) + WS_MOD);
    {
        LAS float* cact = (LAS float*)(F.lds);
        LAS float* part = (LAS float*)(F.lds + 16384);
        bool did = false;
        for (int item = F.vcu; item < NMOD / 32; item += F.G) {
            if (!did) { for (int i = F.tid; i < 4096; i += NTHR) { const float cv = c[i]; cact[i] = cv / (1.0f + __expf(-cv)); } did = true; }
            __syncthreads();
            const int n0 = item * 32, col = n0 + (F.lane & 31), ksub = F.lane >> 5;
            float a0 = 0.f, a1 = 0.f, a2 = 0.f, a3 = 0.f;
#pragma unroll 16
            for (int it = 0; it < 64; ++it) { const int k = (it * 8 + F.wave) * 2 + ksub; const float w = w_ada[(size_t)k * NMOD + col];
                a0 += cact[k] * w; a1 += cact[1024 + k] * w; a2 += cact[2048 + k] * w; a3 += cact[3072 + k] * w; }
            a0 += __shfl_xor(a0, 32); a1 += __shfl_xor(a1, 32); a2 += __shfl_xor(a2, 32); a3 += __shfl_xor(a3, 32);
            if (F.lane < 32) { part[(F.wave * 4 + 0) * 32 + F.lane] = a0; part[(F.wave * 4 + 1) * 32 + F.lane] = a1; part[(F.wave * 4 + 2) * 32 + F.lane] = a2; part[(F.wave * 4 + 3) * 32 + F.lane] = a3; }
            __syncthreads();
            if (F.tid < 128) { const int b = F.tid >> 5, cl = F.tid & 31; float s = 0.f;
#pragma unroll
                for (int w = 0; w < 8; ++w) s += part[(w * 4 + b) * 32 + cl];
                MOD[b * NMOD + n0 + cl] = s + b_ada[n0 + cl]; }
            __syncthreads();
        }
    }
    {
        const int gw = F.vcu * NWAVES + F.wave, NGW = F.G * NWAVES;
        p0_convert(((const float*)karg(14)), (bf16*)(((unsigned char*)karg(19)) + WS_SUBK), (long)(8 * 2 * 128 * 64) / 512, gw, NGW, F.lane);
    }
}
__device__ __forceinline__ void p0_transposes(Frame& F) {
    LAS float* scr = (LAS float*)(F.lds + 32768 + F.wave * 8704);
    const int gw = F.vcu * NWAVES + F.wave, NGW = F.G * NWAVES;
    constexpr int I_IN1 = (D / 64) * (2304 / 32), I_IN2 = (D / 64) * (2048 / 32), I_AB = (512 / 64) * (D / 32), I_SQ = (D / 64) * (D / 32);
    constexpr int NITEMS = I_IN1 + I_IN2 + 2 * I_AB + 2 * I_SQ;
    bf16* Win_t = (bf16*)(((unsigned char*)karg(19)) + WS_WIN);
    for (int it = gw; it < NITEMS; it += NGW) {
        int r = it;
        if (r < I_IN1) { p0_transpose_item(((const float*)karg(6)), LDW_IN, D, 2304, Win_t, 0, scr, r, F.lane); continue; } r -= I_IN1;
        if (r < I_IN2) { p0_transpose_item(((const float*)karg(6)) + 2312, LDW_IN, D, 2048, Win_t, 2304, scr, r, F.lane); continue; } r -= I_IN2;
        if (r < I_AB) { p0_transpose_item(((const float*)karg(9)), D, 512, D, (bf16*)(((unsigned char*)karg(19)) + WS_WA), 0, scr, r, F.lane); continue; } r -= I_AB;
        if (r < I_AB) { p0_transpose_item(((const float*)karg(10)), D, 512, D, (bf16*)(((unsigned char*)karg(19)) + WS_WB), 0, scr, r, F.lane); continue; } r -= I_AB;
        if (r < I_SQ) { p0_transpose_item(((const float*)karg(11)), D, D, D, (bf16*)(((unsigned char*)karg(19)) + WS_WOUT), 0, scr, r, F.lane); continue; } r -= I_SQ;
        p0_transpose_item(((const float*)karg(13)), D, D, D, (bf16*)(((unsigned char*)karg(19)) + WS_WQ), 0, scr, r, F.lane);
    }
}

__device__ __forceinline__ void p1_norm(Frame& F) {
    const float* x = ((const float*)karg(0)); const float* g1 = ((const float*)karg(2)); const float* w_in = ((const float*)karg(6)); const float* b_forget = ((const float*)karg(7));
    const float* MOD = (const float*)(((unsigned char*)karg(19)) + WS_MOD); bf16* H = (bf16*)(((unsigned char*)karg(19)) + WS_H); float* LOGF = (float*)(((unsigned char*)karg(19)) + WS_LOGF);
    LAS float* wfl = (LAS float*)(F.lds);
    { float tmp[16];
#pragma unroll
      for (int n = 0; n < 16; ++n) { const int i = F.tid + n * NTHR; tmp[n] = w_in[(size_t)(i >> 3) * LDW_IN + 2304 + (i & 7)]; }
#pragma unroll
      for (int n = 0; n < 16; ++n) { const int i = F.tid + n * NTHR; wfl[(i & 7) * 1024 + (i >> 3)] = tmp[n]; } }
    __syncthreads();
    const int gw = F.vcu * NWAVES + F.wave, NGW = F.G * NWAVES;
    f32x4 cur[4], nxt[4];
    if (gw < M) { const f32x4* xr = (const f32x4*)(x + (size_t)gw * D) + F.lane;
#pragma unroll
        for (int j = 0; j < 4; ++j) cur[j] = xr[64 * j]; }
    for (int row = gw; row < M; row += NGW) {
        { const int nrow = row + NGW; if (nrow < M) { const f32x4* xr = (const f32x4*)(x + (size_t)nrow * D) + F.lane;
#pragma unroll
            for (int j = 0; j < 4; ++j) nxt[j] = xr[64 * j]; } }
        {{
        float ss = 0.f;
#pragma unroll
        for (int j = 0; j < 4; ++j) ss += (cur[j].x * cur[j].x + cur[j].y * cur[j].y) + (cur[j].z * cur[j].z + cur[j].w * cur[j].w);
        ss = wave_sum(ss);
        const float rstd = 1.0f / sqrtf(ss * (1.0f / D) + EPS);
        const int b = row >> 12; const float* mb = MOD + b * NMOD;
        float fl[8];
#pragma unroll
        for (int jj = 0; jj < 8; ++jj) fl[jj] = 0.f;
#pragma unroll
        for (int j = 0; j < 4; ++j) { const int col = 4 * F.lane + 256 * j;
            const f32x4 g = *(const f32x4*)(g1 + col), sh = *(const f32x4*)(mb + col), sc = *(const f32x4*)(mb + 1024 + col);
            const f32x4 hv = (cur[j] * rstd) * g * (sc + 1.0f) + sh;
            u32x2 w; w.x = cvtpk(hv.x, hv.y); w.y = cvtpk(hv.z, hv.w);
            *(u32x2*)(H + (size_t)row * D + col) = w;
#pragma unroll
            for (int jj = 0; jj < 8; ++jj) { const f32x4 wv = *(const LAS f32x4*)(wfl + jj * 1024 + col); fl[jj] += (hv.x * wv.x + hv.y * wv.y) + (hv.z * wv.z + hv.w * wv.w); }
        }
        const int lane = F.lane; const float r1 = reduce8_t(fl, lane);
        if ((lane & 7) == 0) { const int jj = lane >> 3; const float z = r1 + b_forget[jj]; const float ls = fminf(z, 0.f) - log1pf(__expf(-fabsf(z))); LOGF[(size_t)row * 8 + jj] = ls; }
        }}
#pragma unroll
        for (int j = 0; j < 4; ++j) cur[j] = nxt[j];
    }
}

constexpr int KP = 72;
constexpr int VPF = 68;
constexpr int VPS = 260;
struct FlashState { f32x16 o[2]; float m, l; };

__device__ __forceinline__ void flash_tail(FlashState& st, f32x16& s0, f32x16& s1, const LAS bf16* Vs, int vp, int r32, int hi) {
    float mt = s0[0];
#pragma unroll
    for (int r = 1; r < 16; ++r) mt = fmaxf(mt, s0[r]);
#pragma unroll
    for (int r = 0; r < 16; ++r) mt = fmaxf(mt, s1[r]);
    mt = fmaxf(mt, __uint_as_float(xorx<32>(__float_as_uint(mt), 32 * hi)));
    const float mn = fmaxf(st.m, mt);
    const float alpha = __expf(st.m - mn);
    st.m = mn;
    float ps = 0.f;
#pragma unroll
    for (int r = 0; r < 16; ++r) { s0[r] = __expf(s0[r] - mn); ps += s0[r]; }
#pragma unroll
    for (int r = 0; r < 16; ++r) { s1[r] = __expf(s1[r] - mn); ps += s1[r]; }
    st.l = st.l * alpha + ps;
    if (__any(alpha != 1.0f)) {
#pragma unroll
        for (int r = 0; r < 16; ++r) { st.o[0][r] *= alpha; st.o[1][r] *= alpha; }
    }
#pragma unroll
    for (int blk = 0; blk < 2; ++blk)
#pragma unroll
        for (int s = 0; s < 2; ++s) {
            v4u pw;
            if (blk == 0) { pw.x = cvtpk(s0[8 * s + 0], s0[8 * s + 1]); pw.y = cvtpk(s0[8 * s + 2], s0[8 * s + 3]); pw.z = cvtpk(s0[8 * s + 4], s0[8 * s + 5]); pw.w = cvtpk(s0[8 * s + 6], s0[8 * s + 7]); }
            else          { pw.x = cvtpk(s1[8 * s + 0], s1[8 * s + 1]); pw.y = cvtpk(s1[8 * s + 2], s1[8 * s + 3]); pw.z = cvtpk(s1[8 * s + 4], s1[8 * s + 5]); pw.w = cvtpk(s1[8 * s + 6], s1[8 * s + 7]); }
            const bf16x8 pf = __builtin_bit_cast(bf16x8, pw);
#pragma unroll
            for (int db = 0; db < 2; ++db) {
                const LAS bf16* vp0 = Vs + (32 * db + r32) * vp + 32 * blk + 16 * s + 4 * hi;
                const s16x4 lo = *(const LAS s16x4*)vp0, hh = *(const LAS s16x4*)(vp0 + 8);
                const bf16x8 vf = __builtin_shufflevector(lo, hh, 0, 1, 2, 3, 4, 5, 6, 7);
                st.o[db] = MFMA32(vf, pf, st.o[db]);
            }
        }
}
__device__ __forceinline__ void flash_qk(f32x16& s0, f32x16& s1, const bf16x8 (&qf)[4], const LAS bf16* Ks, int r32, int hi) {
    s0 = (f32x16){0.f}; s1 = (f32x16){0.f};
#pragma unroll
    for (int r = 0; r < 16; ++r) { s0[r] = 0.f; s1[r] = 0.f; }
#pragma unroll
    for (int ks = 0; ks < 4; ++ks) {
        const bf16x8 a0 = *(const LAS bf16x8*)(Ks + r32 * KP + 16 * ks + 8 * hi);
        const bf16x8 a1 = *(const LAS bf16x8*)(Ks + (32 + r32) * KP + 16 * ks + 8 * hi);
        s0 = MFMA32(a0, qf[ks], s0); s1 = MFMA32(a1, qf[ks], s1);
    }
}
__device__ __forceinline__ void flash_qk2(f32x16& a0, f32x16& a1, f32x16& b0, f32x16& b1, const bf16x8 (&qa)[4], const bf16x8 (&qb)[4], const LAS bf16* Ks, int r32, int hi) {
#pragma unroll
    for (int r = 0; r < 16; ++r) { a0[r] = 0.f; a1[r] = 0.f; b0[r] = 0.f; b1[r] = 0.f; }
#pragma unroll
    for (int ks = 0; ks < 4; ++ks) {
        const bf16x8 k0 = *(const LAS bf16x8*)(Ks + r32 * KP + 16 * ks + 8 * hi);
        const bf16x8 k1 = *(const LAS bf16x8*)(Ks + (32 + r32) * KP + 16 * ks + 8 * hi);
        a0 = MFMA32(k0, qa[ks], a0); b0 = MFMA32(k0, qb[ks], b0); a1 = MFMA32(k1, qa[ks], a1); b1 = MFMA32(k1, qb[ks], b1);
    }
}
__device__ __forceinline__ void flash_soft(FlashState& st, f32x16& s0, f32x16& s1, int hi) {
    float mt = s0[0];
#pragma unroll
    for (int r = 1; r < 16; ++r) mt = fmaxf(mt, s0[r]);
#pragma unroll
    for (int r = 0; r < 16; ++r) mt = fmaxf(mt, s1[r]);
    mt = fmaxf(mt, __uint_as_float(xorx<32>(__float_as_uint(mt), 32 * hi)));
    const float mn = fmaxf(st.m, mt);
    const float alpha = __expf(st.m - mn);
    st.m = mn;
    float ps = 0.f;
#pragma unroll
    for (int r = 0; r < 16; ++r) { s0[r] = __expf(s0[r] - mn); ps += s0[r]; }
#pragma unroll
    for (int r = 0; r < 16; ++r) { s1[r] = __expf(s1[r] - mn); ps += s1[r]; }
    st.l = st.l * alpha + ps;
    if (__any(alpha != 1.0f)) {
#pragma unroll
        for (int r = 0; r < 16; ++r) { st.o[0][r] *= alpha; st.o[1][r] *= alpha; }
    }
}
__device__ __forceinline__ bf16x8 pack_p(const f32x16& p, int s) {
    v4u pw; pw.x = cvtpk(p[8 * s + 0], p[8 * s + 1]); pw.y = cvtpk(p[8 * s + 2], p[8 * s + 3]); pw.z = cvtpk(p[8 * s + 4], p[8 * s + 5]); pw.w = cvtpk(p[8 * s + 6], p[8 * s + 7]);
    return __builtin_bit_cast(bf16x8, pw);
}
__device__ __forceinline__ void flash_pv2(FlashState& sa, FlashState& sb, const f32x16& a0, const f32x16& a1, const f32x16& b0, const f32x16& b1, const LAS bf16* Vs, int vp, int r32, int hi) {
#pragma unroll
    for (int blk = 0; blk < 2; ++blk)
#pragma unroll
        for (int s = 0; s < 2; ++s) {
            const bf16x8 pfa = blk ? pack_p(a1, s) : pack_p(a0, s), pfb = blk ? pack_p(b1, s) : pack_p(b0, s);
#pragma unroll
            for (int db = 0; db < 2; ++db) {
                const LAS bf16* vp0 = Vs + (32 * db + r32) * vp + 32 * blk + 16 * s + 4 * hi;
                const s16x4 lo = *(const LAS s16x4*)vp0, hh = *(const LAS s16x4*)(vp0 + 8);
                const bf16x8 vf = __builtin_shufflevector(lo, hh, 0, 1, 2, 3, 4, 5, 6, 7);
                sa.o[db] = MFMA32(vf, pfa, sa.o[db]); sb.o[db] = MFMA32(vf, pfb, sb.o[db]);
            }
        }
}
__device__ __forceinline__ void flash_store(const FlashState& st, bf16* orow, int hi) {
    float lt = st.l + __uint_as_float(xorx<32>(__float_as_uint(st.l), 32 * hi));
    const float inv = 1.0f / lt;
#pragma unroll
    for (int db = 0; db < 2; ++db)
#pragma unroll
        for (int rg = 0; rg < 4; ++rg) { u32x2 w; w.x = cvtpk(st.o[db][4 * rg] * inv, st.o[db][4 * rg + 1] * inv); w.y = cvtpk(st.o[db][4 * rg + 2] * inv, st.o[db][4 * rg + 3] * inv);
            *(u32x2*)(orow + 32 * db + 8 * rg + 4 * hi) = w; }
}

__device__ __forceinline__ void fox_unit(Frame& F, int b, int h, int qb, float& kmax2) {
    const bf16* proj = (const bf16*)(((unsigned char*)karg(19)) + WS_PROJ); const float* LOGF = (const float*)(((unsigned char*)karg(19)) + WS_LOGF); bf16* OB = (bf16*)(((unsigned char*)karg(19)) + WS_OB);
    LAS float* Fs = (LAS float*)(F.lds);
    LAS float* wtot = (LAS float*)(F.lds + 16384);
    LAS bf16* Kb = (LAS bf16*)(F.lds + 16384 + 128);
    LAS bf16* Vb = (LAS bf16*)(F.lds + 16384 + 128 + 2 * 64 * KP * 2);
    const int lane = F.lane, wave = F.wave, tid = F.tid, r32 = lane & 31, hi = lane >> 5;
    const int q_end = 512 * (qb + 1), NT = q_end / 64;
    const size_t rowbase = (size_t)b * SEQ;
    if (kmax2 < 0.f) {
        float v[8]; float run = 0.f;
#pragma unroll
        for (int i = 0; i < 8; ++i) { const int pos = tid * 8 + i; const float lf = (pos < q_end) ? LOGF[(rowbase + pos) * 8 + h] : 0.f; run += lf; v[i] = run; }
        float inc = run;
#pragma unroll
        for (int o = 1; o < 64; o <<= 1) { const float t = __shfl_up(inc, o); if (lane >= o) inc += t; }
        if (lane == 63) wtot[wave] = inc;
        __syncthreads();
        float off = inc - run;
        for (int w = 0; w < wave; ++w) off += wtot[w];
#pragma unroll
        for (int i = 0; i < 8; ++i) Fs[tid * 8 + i] = v[i] + off;
    }
    const int qrow = 512 * qb + 64 * wave + r32, qrowB = qrow + 32;
    bf16x8 qf[4], qg[4];
    { const bf16* qp = proj + (rowbase + qrow) * NPROJ + C_QB + 64 * h + 8 * hi;
#pragma unroll
      for (int ks = 0; ks < 4; ++ks) { qf[ks] = *(const bf16x8*)(qp + 16 * ks); qg[ks] = *(const bf16x8*)(qp + (size_t)32 * NPROJ + 16 * ks); } }
    const int tq = 8 * qb + wave;
    LAS bf16* Qs = (LAS bf16*)(F.lds + 53248) + wave * (64 * KP);
    {
        float qn = 0.f;
#pragma unroll
        for (int ks = 0; ks < 4; ++ks)
#pragma unroll
            for (int j = 0; j < 8; ++j) { const float e = __uint_as_float(((unsigned)(unsigned short)qf[ks][j]) << 16); qn += e * e; }
        qn += __shfl_xor(qn, 32);
        { float qn2 = 0.f;
#pragma unroll
          for (int ks = 0; ks < 4; ++ks)
#pragma unroll
              for (int j = 0; j < 8; ++j) { const float e = __uint_as_float(((unsigned)(unsigned short)qg[ks][j]) << 16); qn2 += e * e; }
          qn2 += __shfl_xor(qn2, 32); qn = fmaxf(qn, qn2); }
#pragma unroll
        for (int o = 1; o < 32; o <<= 1) qn = fmaxf(qn, __shfl_xor(qn, o));
        float kn = 0.f;
        if (kmax2 < 0.f) {
            for (int p0 = 0; p0 < q_end; p0 += 4 * 64) {
                v4u w4[4];
#pragma unroll
                for (int i = 0; i < 4; ++i) w4[i] = *(const v4u*)(proj + (rowbase + p0 + 64 * i + (tid >> 3)) * NPROJ + C_KB + 64 * h + 8 * (tid & 7));
#pragma unroll
                for (int i = 0; i < 4; ++i) { const unsigned wx = w4[i].x, wy = w4[i].y, wz = w4[i].z, ww = w4[i].w;
                    float s = bflo(wx) * bflo(wx) + bfhi(wx) * bfhi(wx) + bflo(wy) * bflo(wy) + bfhi(wy) * bfhi(wy) + bflo(wz) * bflo(wz) + bfhi(wz) * bfhi(wz) + bflo(ww) * bflo(ww) + bfhi(ww) * bfhi(ww);
                    s += __shfl_xor(s, 1); s += __shfl_xor(s, 2); s += __shfl_xor(s, 4);
                    kn = fmaxf(kn, s); } }
            kn = wave_max(kn);
        }
        if (lane == 0) { wtot[8 + wave] = qn; wtot[16 + wave] = kn; }
    }
#pragma unroll
    for (int ks = 0; ks < 4; ++ks) { *(LAS bf16x8*)(Qs + r32 * KP + 16 * ks + 8 * hi) = qf[ks]; *(LAS bf16x8*)(Qs + (32 + r32) * KP + 16 * ks + 8 * hi) = qg[ks]; }
    FlashState st, su; st.m = -INFINITY; st.l = 0.f; su.m = -INFINITY; su.l = 0.f;
#pragma unroll
    for (int r = 0; r < 16; ++r) { st.o[0][r] = 0.f; st.o[1][r] = 0.f; su.o[0][r] = 0.f; su.o[1][r] = 0.f; }
    const int srow = tid >> 3, sch = tid & 7;
    const bf16* kg = proj + (rowbase + srow) * NPROJ + C_KB + 64 * h + 8 * sch;
    const bf16* vg = proj + (rowbase + srow) * NPROJ + C_VB + 64 * h + 8 * sch;
    v4u kreg, vreg;
    { const size_t o = (size_t)(NT - 1) * 64 * NPROJ; kreg = *(const v4u*)(kg + o); vreg = *(const v4u*)(vg + o); }
    int cur = 0;
    {   *(LAS v4u*)(Kb + srow * KP + 8 * sch) = kreg;
        const unsigned short* vs = (const unsigned short*)&vreg;
#pragma unroll
        for (int i = 0; i < 8; ++i) Vb[(8 * sch + i) * VPF + srow] = vs[i];
    }
    __syncthreads();
    const float fq = Fs[qrow], fqB = Fs[qrowB];
    int t_lo = 0;
    {
        float qm = 0.f, km = 0.f;
#pragma unroll
        for (int w = 0; w < 8; ++w) { qm = fmaxf(qm, wtot[8 + w]); km = fmaxf(km, wtot[16 + w]); }
        if (kmax2 < 0.f) kmax2 = km;
        const float A = 0.125f * sqrtf(qm) * sqrtf(kmax2) * 1.01f, f0 = Fs[512 * qb];
        for (int t = NT - 9; t >= 0; --t) if (Fs[64 * t + 63] - f0 > 2.0f * A + 60.0f) { t_lo = t + 1; break; }
    }
    for (int t = NT - 1; t >= t_lo; --t) {
        if (t > t_lo) { const size_t o = (size_t)(t - 1) * 64 * NPROJ; kreg = *(const v4u*)(kg + o); vreg = *(const v4u*)(vg + o); }
        if (t <= tq) {
            const LAS bf16* Ks = Kb + cur * 64 * KP; const LAS bf16* Vs = Vb + cur * 64 * VPF;
            bf16x8 qa[4], qb4[4];
#pragma unroll
            for (int ks = 0; ks < 4; ++ks) { qa[ks] = *(const LAS bf16x8*)(Qs + r32 * KP + 16 * ks + 8 * hi); qb4[ks] = *(const LAS bf16x8*)(Qs + (32 + r32) * KP + 16 * ks + 8 * hi); }
            f32x16 s0, s1, u0, u1; flash_qk2(s0, s1, u0, u1, qa, qb4, Ks, r32, hi);
            const LAS float* Fk = Fs + 64 * t;
            const bool diag = (t == tq);
#pragma unroll
            for (int rg = 0; rg < 4; ++rg) {
                const f32x4 f0 = *(const LAS f32x4*)(Fk + 8 * rg + 4 * hi), f1 = *(const LAS f32x4*)(Fk + 32 + 8 * rg + 4 * hi);
#pragma unroll
                for (int i = 0; i < 4; ++i) { const int r = 4 * rg + i; const int kv = 64 * t + 8 * rg + 4 * hi + i;
                    float a = s0[r] * 0.125f + (fq - f0[i]), c = s1[r] * 0.125f + (fq - f1[i]), d = u0[r] * 0.125f + (fqB - f0[i]), e = u1[r] * 0.125f + (fqB - f1[i]);
                    if (diag) { if (kv > qrow) a = -INFINITY; if (kv + 32 > qrow) c = -INFINITY; if (kv > qrowB) d = -INFINITY; if (kv + 32 > qrowB) e = -INFINITY; }
                    s0[r] = a; s1[r] = c; u0[r] = d; u1[r] = e; }
            }
            flash_soft(st, s0, s1, hi); flash_soft(su, u0, u1, hi);
            flash_pv2(st, su, s0, s1, u0, u1, Vs, VPF, r32, hi);
        }
        if (t > t_lo) {
            const int nb = cur ^ 1;
            *(LAS v4u*)(Kb + nb * 64 * KP + srow * KP + 8 * sch) = kreg;
            const unsigned short* vs = (const unsigned short*)&vreg;
#pragma unroll
            for (int i = 0; i < 8; ++i) Vb[nb * 64 * VPF + (8 * sch + i) * VPF + srow] = vs[i];
        }
        __syncthreads();
        cur ^= 1;
    }
    flash_store(st, OB + (rowbase + qrow) * 512 + 64 * h, hi); flash_store(su, OB + (rowbase + qrowB) * 512 + 64 * h, hi);
    __syncthreads();
}

__device__ const unsigned char T5_BUCKET[128] = {0,1,2,3,4,5,6,7,8,9,10,11,12,13,14,15,16,16,16,17,17,18,18,18,19,19,19,20,20,20,20,21,21,21,21,22,22,22,22,22,23,23,23,23,23,23,24,24,24,24,24,24,25,25,25,25,25,25,25,26,26,26,26,26,26,26,26,27,27,27,27,27,27,27,27,27,27,28,28,28,28,28,28,28,28,28,28,29,29,29,29,29,29,29,29,29,29,29,29,30,30,30,30,30,30,30,30,30,30,30,30,30,30,31,31,31,31,31,31,31,31,31,31,31,31,31,31,31};

__device__ __forceinline__ void swa_unit(Frame& F, int b, int kvh, int n) {
    const bf16* proj = (const bf16*)(((unsigned char*)karg(19)) + WS_PROJ); bf16* OA = (bf16*)(((unsigned char*)karg(19)) + WS_OA);
    const float* sinks = ((const float*)karg(8)); const float* rel_bias = ((const float*)karg(12));
    LAS bf16* Kb = (LAS bf16*)(F.lds);
    LAS bf16* Vb = (LAS bf16*)(F.lds + 36864);
    LAS float* bt = (LAS float*)(F.lds + 36864 + 33280);
    const int lane = F.lane, wave = F.wave, tid = F.tid, r32 = lane & 31, hi = lane >> 5;
    const size_t rowbase = (size_t)b * SEQ;
    {
        const int g = tid >> 7, d = tid & 127;
        bt[tid] = rel_bias[(int)T5_BUCKET[d] * 8 + kvh * 4 + g];
#pragma unroll
        for (int i = 0; i < 4; ++i) {
            const int idx = tid + i * NTHR, kb = idx >> 3, sch = idx & 7; const int pos = 128 * (n - 1) + kb;
            v4u kreg = (v4u){0u, 0u, 0u, 0u}, vreg = (v4u){0u, 0u, 0u, 0u};
            if (pos >= 0) { const bf16* p = proj + (rowbase + pos) * NPROJ + 64 * kvh + 8 * sch; kreg = *(const v4u*)(p + C_KA); vreg = *(const v4u*)(p + C_VA); }
            *(LAS v4u*)(Kb + kb * KP + 8 * sch) = kreg;
            const unsigned short* vs = (const unsigned short*)&vreg;
#pragma unroll
            for (int j = 0; j < 8; ++j) Vb[(8 * sch + j) * VPS + kb] = vs[j];
        }
    }
    __syncthreads();
    const int g = wave & 3, qh = wave >> 2, head = kvh * 4 + g;
    const LAS float* btg = bt + g * 128;
    for (int sb = 0; sb < 2; ++sb) {
        const int qrel0 = 64 * qh + 32 * sb, qrel = qrel0 + r32;
        const size_t row = rowbase + 128 * n + qrel;
        bf16x8 qf[4];
        { const bf16* qp = proj + row * NPROJ + C_QA + 64 * head + 8 * hi;
#pragma unroll
          for (int ks = 0; ks < 4; ++ks) qf[ks] = *(const bf16x8*)(qp + 16 * ks); }
        FlashState st; st.m = sinks[head]; st.l = (hi == 0) ? 1.0f : 0.0f;
#pragma unroll
        for (int r = 0; r < 16; ++r) { st.o[0][r] = 0.f; st.o[1][r] = 0.f; }
        const int t_lo = (qrel0 + 1) >> 6, t_hi = (qrel0 + 159) >> 6;
        for (int t = t_lo; t <= t_hi; ++t) {
            f32x16 s0, s1; flash_qk(s0, s1, qf, Kb + t * 64 * KP, r32, hi);
#pragma unroll
            for (int r = 0; r < 16; ++r) {
                const int kb0 = 64 * t + crow(r, hi), kb1 = kb0 + 32;
                const int d0 = 128 + qrel - kb0, d1 = d0 - 32;
                const bool v0 = (d0 >= 0) && (d0 < 128) && (n > 0 || kb0 >= 128);
                const bool v1 = (d1 >= 0) && (d1 < 128) && (n > 0 || kb1 >= 128);
                const float b0 = btg[d0 & 127], b1 = btg[d1 & 127];
                s0[r] = v0 ? (s0[r] * 0.125f + b0) : -INFINITY;
                s1[r] = v1 ? (s1[r] * 0.125f + b1) : -INFINITY;
            }
            flash_tail(st, s0, s1, Vb + 64 * t, VPS, r32, hi);
        }
        flash_store(st, OA + row * 512 + 64 * head, hi);
    }
    __syncthreads();
}
__device__ __forceinline__ void p3_attention(Frame& F) {
    for (int item = F.vcu; item < 256; item += F.G) {
        swa_unit(F, item >> 6, (item >> 5) & 1, item & 31);
        const int bh = item >> 3, j = item & 7;
        float kmax2 = -1.0f;
        fox_unit(F, bh >> 3, bh & 7, j, kmax2);
    }
}

struct PairOrder {
    pg8::StaticOrder S;
    __device__ bool next(int i, pg8::Unit& u) const { if (!S.next(i >> 1, u)) return false; u.src = i & 1; return true; }
    __device__ __forceinline__ void a_ready(const pg8::Unit&) const {}
    __device__ __forceinline__ void done(const pg8::Unit&) const {}
};
__device__ __forceinline__ float sigmoidf_(float z) { return 1.0f / (1.0f + __expf(-z)); }
struct EpiGate {
    static constexpr bool PERM = true, AFTER_DRAIN = false, CHAIN = true;
    const bf16* proj; bf16* mixed;
    __device__ __forceinline__ void operator()(pg8::f32x4 (&acc)[2][2][4][2], const pg8::Unit& u, int wr, int wc, int fr, int fq) const {
#pragma unroll
        for (int ai = 0; ai < 2; ++ai)
#pragma unroll
            for (int m = 0; m < 4; ++m) { const size_t row = (size_t)u.pm * 256 + ai * 128 + wr * 64 + m * 16 + fr;
#pragma unroll
                for (int bj = 0; bj < 2; ++bj) { const int col0 = u.pn * 256 + bj * 128 + wc * 32 + 8 * fq;
                    const v4u gb = *(const v4u*)(proj + row * NPROJ + C_GLB + col0);
                    const unsigned gbw[4] = {gb.x, gb.y, gb.z, gb.w};
                    if (u.src == 0) {
                        const v4u ga = *(const v4u*)(proj + row * NPROJ + C_GLA + col0);
                        const unsigned gaw[4] = {ga.x, ga.y, ga.z, ga.w};
#pragma unroll
                        for (int e = 0; e < 8; ++e) { const float za = (e & 1) ? bfhi(gaw[e >> 1]) : bflo(gaw[e >> 1]), zb = (e & 1) ? bfhi(gbw[e >> 1]) : bflo(gbw[e >> 1]);
                            const float ratio = (1.0f + __expf(-zb)) * __builtin_amdgcn_rcpf(1.0f + __expf(-za));
                            acc[ai][bj][m][e >> 2][e & 3] *= ratio; }
                    } else {
                        float v[8];
#pragma unroll
                        for (int e = 0; e < 8; ++e) { const float zb = (e & 1) ? bfhi(gbw[e >> 1]) : bflo(gbw[e >> 1]); v[e] = acc[ai][bj][m][e >> 2][e & 3] * __builtin_amdgcn_rcpf(1.0f + __expf(-zb)); }
                        v4u w; w.x = cvtpk(v[0], v[1]); w.y = cvtpk(v[2], v[3]); w.z = cvtpk(v[4], v[5]); w.w = cvtpk(v[6], v[7]);
                        *(v4u*)(mixed + row * D + col0) = w;
                    }
                }
            }
    }
};
struct EpiRes {
    static constexpr bool PERM = true, AFTER_DRAIN = false, CHAIN = false;
    const float* x; const float* mod; float* x1;
    __device__ __forceinline__ void operator()(const pg8::f32x4 (&acc)[2][2][4][2], const pg8::Unit& u, int wr, int wc, int fr, int fq) const {
#pragma unroll
        for (int ai = 0; ai < 2; ++ai)
#pragma unroll
            for (int m = 0; m < 4; ++m) { const size_t row = (size_t)u.pm * 256 + ai * 128 + wr * 64 + m * 16 + fr; const int b = (int)(row >> 12);
#pragma unroll
                for (int bj = 0; bj < 2; ++bj) { const int col0 = u.pn * 256 + bj * 128 + wc * 32 + 8 * fq;
#pragma unroll
                    for (int n = 0; n < 2; ++n) { const int col = col0 + 4 * n;
                        const pg8::f32x4 xin = *(const pg8::f32x4*)(x + row * D + col), gt = *(const pg8::f32x4*)(mod + b * NMOD + 2048 + col);
                        *(pg8::f32x4*)(x1 + row * D + col) = xin + gt * acc[ai][bj][m][n]; } }
            }
    }
};

__device__ __forceinline__ void p6_norm2(Frame& F) {
    const float* x1 = (const float*)(((unsigned char*)karg(19)) + WS_X1); const float* g2 = ((const float*)karg(3)); const float* MOD = (const float*)(((unsigned char*)karg(19)) + WS_MOD); bf16* H2 = (bf16*)(((unsigned char*)karg(19)) + WS_H2); unsigned char* H2Q = (unsigned char*)(((unsigned char*)karg(19)) + WS_H2Q); float* H2S = (float*)(((unsigned char*)karg(19)) + WS_H2S);
    const int gw = F.vcu * NWAVES + F.wave, NGW = F.G * NWAVES;
    f32x4 cur[4], nxt[4];
    if (gw < M) { const f32x4* xr = (const f32x4*)(x1 + (size_t)gw * D) + F.lane;
#pragma unroll
        for (int j = 0; j < 4; ++j) cur[j] = xr[64 * j]; }
    for (int row = gw; row < M; row += NGW) {
        { const int nrow = row + NGW; if (nrow < M) { const f32x4* xr = (const f32x4*)(x1 + (size_t)nrow * D) + F.lane;
#pragma unroll
            for (int j = 0; j < 4; ++j) nxt[j] = xr[64 * j]; } }
        {
        f32x4 v[4], hq[4]; float ss = 0.f;
#pragma unroll
        for (int j = 0; j < 4; ++j) { v[j] = cur[j]; ss += (v[j].x * v[j].x + v[j].y * v[j].y) + (v[j].z * v[j].z + v[j].w * v[j].w); }
        ss = wave_sum(ss);
        const float rstd = 1.0f / sqrtf(ss * (1.0f / D) + EPS);
        const int b = row >> 12; const float* mb = MOD + b * NMOD;
#pragma unroll
        for (int j = 0; j < 4; ++j) { const int col = 4 * F.lane + 256 * j;
            const f32x4 g = *(const f32x4*)(g2 + col), sh = *(const f32x4*)(mb + 3072 + col), sc = *(const f32x4*)(mb + 4096 + col);
            const f32x4 hv = (v[j] * rstd) * g * (sc + 1.0f) + sh;
            u32x2 w; w.x = cvtpk(hv.x, hv.y); w.y = cvtpk(hv.z, hv.w);
            *(u32x2*)(H2 + (size_t)row * D + col) = w; hq[j] = hv; }
        float am = 0.f;
#pragma unroll
        for (int j = 0; j < 4; ++j) am = fmaxf(fmaxf(am, fmaxf(fabsf(hq[j].x), fabsf(hq[j].y))), fmaxf(fabsf(hq[j].z), fabsf(hq[j].w)));
        am = wave_max(am);
        const float sc = am > 0.f ? am * (1.0f / 127.0f) : 1.0f, inv = 1.0f / sc;
        v4u qa;
#pragma unroll
        for (int j = 0; j < 4; ++j) { const int b0 = (int)rintf(hq[j].x * inv), b1 = (int)rintf(hq[j].y * inv), b2 = (int)rintf(hq[j].z * inv), b3 = (int)rintf(hq[j].w * inv);
            qa[j] = (unsigned)(b0 & 255) | ((unsigned)(b1 & 255) << 8) | ((unsigned)(b2 & 255) << 16) | ((unsigned)(b3 & 255) << 24); }
        *(v4u*)(H2Q + (size_t)row * D + 16 * F.lane) = qa;
        if (F.lane == 0) H2S[row] = sc;
        }
#pragma unroll
        for (int j = 0; j < 4; ++j) cur[j] = nxt[j];
    }
}

__device__ __forceinline__ unsigned f2ord(float f) { const unsigned u = __float_as_uint(f); return u ^ ((unsigned)((int)u >> 31) | 0x80000000u); }
__device__ __forceinline__ float ord2f(unsigned o) { const unsigned u = (o & 0x80000000u) ? (o & 0x7fffffffu) : ~o; return __uint_as_float(u); }
#define CE_DESC(a, b) do { const unsigned _x = (a), _y = (b); (a) = _x > _y ? _x : _y; (b) = _x > _y ? _y : _x; } while (0)
__device__ __forceinline__ void sort16(unsigned (&k)[16]) {
#pragma unroll
    for (int size = 2; size <= 16; size <<= 1)
#pragma unroll
        for (int stride = size >> 1; stride > 0; stride >>= 1)
#pragma unroll
            for (int i = 0; i < 16; ++i) { const int j = i ^ stride; if (j > i) { if ((i & size) == 0) CE_DESC(k[i], k[j]); else CE_DESC(k[j], k[i]); } }
}
__device__ __forceinline__ void merge16(unsigned (&a)[16], const unsigned (&b)[16]) {
#pragma unroll
    for (int i = 0; i < 16; ++i) a[i] = a[i] > b[15 - i] ? a[i] : b[15 - i];
#pragma unroll
    for (int stride = 8; stride > 0; stride >>= 1)
#pragma unroll
        for (int i = 0; i < 16; ++i) { const int j = i ^ stride; if (j > i) CE_DESC(a[i], a[j]); }
}
__device__ __forceinline__ void top16_of_64(unsigned (&g0)[16], unsigned (&g1)[16], unsigned (&g2)[16], unsigned (&g3)[16]) {
    sort16(g0); sort16(g1); sort16(g2); sort16(g3);
    merge16(g0, g1); merge16(g2, g3); merge16(g0, g2);
}
constexpr int NCAND = 50;
__device__ __forceinline__ void p8a_topk(Frame& F) {
    const bf16* QP = (const bf16*)(((unsigned char*)karg(19)) + WS_QP); const bf16* SUBK = (const bf16*)(((unsigned char*)karg(19)) + WS_SUBK);
    unsigned short* PIDX = (unsigned short*)(((unsigned char*)karg(19)) + WS_PIDX); float* PG = (float*)(((unsigned char*)karg(19)) + WS_PG);
    LAS unsigned short* Elds = (LAS unsigned short*)(F.lds) + F.wave * (NCAND * 64);
    const int lane = F.lane, r32 = lane & 31, hi = lane >> 5;
    const int gw = F.vcu * NWAVES + F.wave, NGW = F.G * NWAVES;
    for (int it2 = 0; it2 < 2 * ((M / 64 - F.vcu + F.G - 1) / F.G); ++it2) {
        const int wi = F.vcu + (it2 >> 1) * F.G;
        const int tile = 2 * wi + (it2 & 1);
        const int tok = tile * 32 + r32;
        { const int h = F.wave;
            unsigned top[2][16];
#pragma unroll
            for (int p = 0; p < 2; ++p) {
                bf16x8 qf[4];
                { const bf16* qp = QP + (size_t)tok * D + h * 128 + p * 64 + 8 * hi;
#pragma unroll
                  for (int ks = 0; ks < 4; ++ks) qf[ks] = *(const bf16x8*)(qp + 16 * ks); }
                const bf16* kp = SUBK + (size_t)((h * 2 + p) * 128 + r32) * 64 + 8 * hi;
                unsigned kk[4][16];
#pragma unroll
                for (int blk = 0; blk < 4; ++blk) {
                    f32x16 acc;
#pragma unroll
                    for (int r = 0; r < 16; ++r) acc[r] = 0.f;
#pragma unroll
                    for (int ks = 0; ks < 4; ++ks) { const bf16x8 a = *(const bf16x8*)(kp + (size_t)blk * 32 * 64 + 16 * ks); acc = MFMA32(a, qf[ks], acc); }
#pragma unroll
                    for (int r = 0; r < 16; ++r) { const int key = 32 * blk + crow(r, hi); kk[blk][r] = (f2ord(acc[r]) & ~127u) | (unsigned)(127 - key); }
                }
                top16_of_64(kk[0], kk[1], kk[2], kk[3]);
                unsigned other[16];
#pragma unroll
                for (int i = 0; i < 16; ++i) other[i] = xorx<32>(kk[0][i], lane);
                merge16(kk[0], other);
#pragma unroll
                for (int i = 0; i < 16; ++i) top[p][i] = kk[0][i];
            }
            float s1[16], s2[16]; unsigned i1[16], i2[16];
#pragma unroll
            for (int i = 0; i < 16; ++i) { s1[i] = ord2f(top[0][i] & ~127u); i1[i] = 127u - (top[0][i] & 127u); s2[i] = ord2f(top[1][i] & ~127u); i2[i] = 127u - (top[1][i] & 127u); }
            unsigned ck[4][16];
#pragma unroll
            for (int c = 0; c < 64; ++c) {
                if (c < NCAND) { constexpr int CA[NCAND] = {0,0,0,0,0,0,0,0,0,0,0,0,0,0,0,0,1,1,1,1,1,1,1,1,2,2,2,2,2,3,3,3,3,4,4,4,5,5,6,6,7,7,8,9,10,11,12,13,14,15}; constexpr int CB[NCAND] = {0,1,2,3,4,5,6,7,8,9,10,11,12,13,14,15,0,1,2,3,4,5,6,7,0,1,2,3,4,0,1,2,3,0,1,2,0,1,0,1,0,1,0,0,0,0,0,0,0,0}; const int a = CA[c], b = CB[c];
                    ck[c >> 4][c & 15] = (f2ord(s1[a] + s2[b]) & ~63u) | (unsigned)(63 - c);
                    Elds[c * 64 + lane] = (unsigned short)(i1[a] * 128u + i2[b]); }
                else ck[c >> 4][c & 15] = 0u;
            }
            top16_of_64(ck[0], ck[1], ck[2], ck[3]);
            float w[16]; float wsum = 0.f; const float v0 = ord2f(ck[0][0] & ~63u);
#pragma unroll
            for (int r = 0; r < 16; ++r) { w[r] = __expf(ord2f(ck[0][r] & ~63u) - v0); wsum += w[r]; }
            const float winv = 1.0f / wsum;
#pragma unroll
            for (int r = 0; r < 16; ++r) if ((r >> 3) == hi) {
                const int c = 63 - (int)(ck[0][r] & 63u);
                const unsigned short eid = Elds[c * 64 + lane];
                PIDX[(size_t)tok * 128 + h * 16 + r] = eid; PG[(size_t)tok * 128 + h * 16 + r] = w[r] * winv; }
        }
    }
}

__device__ __forceinline__ float gelu_erf(float v) { return 0.5f * v * (1.0f + erff(v * 0.70710678118654752f)); }

#define PROBE_REPA 1
#define PROBE_REPB 1
constexpr int NR = 8, RSH = 18, BSA = 8, BSB = 8, ELP = 136, TPS = 8;
__device__ __forceinline__ void sort128(unsigned& e0, unsigned& e1, int lane) {
#pragma unroll
    for (int size = 2; size <= 128; size <<= 1) {
#pragma unroll
        for (int stride = size >> 1; stride > 0; stride >>= 1) {
            if (stride == 64) { const unsigned lo = e0 < e1 ? e0 : e1, hi = e0 < e1 ? e1 : e0; e0 = lo; e1 = hi; }
            else {
                const bool lower = (lane & stride) == 0;
                const bool asc0 = (size == 128) ? true : (size == 64 ? true : ((lane & size) == 0));
                const bool asc1 = (size == 128) ? true : (size == 64 ? false : ((lane & size) == 0));
                const unsigned p0 = xorx_sw(e0, lane, stride), p1 = xorx_sw(e1, lane, stride);
                const unsigned mn0 = e0 < p0 ? e0 : p0, mx0 = e0 < p0 ? p0 : e0, mn1 = e1 < p1 ? e1 : p1, mx1 = e1 < p1 ? p1 : e1;
                e0 = (lower == asc0) ? mn0 : mx0; e1 = (lower == asc1) ? mn1 : mx1;
            }
        }
    }
}
template <int BS> __device__ __forceinline__ void sw_issue(v4u (&buf)[BS], const LAS unsigned* el, const unsigned char* tab, unsigned voff) {
#pragma unroll
    for (int i = 0; i < BS; ++i) { const unsigned off = (el[i] << 10) + voff;
        buf[i] = *(const v4u*)(tab + off); }
}
template <int BS> __device__ __forceinline__ void sw_proc_a(const v4u (&buf)[BS], const v4u& hq, LAS float* wl, int s, int n, int lane) {
    const int hx = (int)hq.x, hy = (int)hq.y, hz = (int)hq.z, hw = (int)hq.w;
    float dd[8];
#pragma unroll
    for (int i = 0; i < 8; ++i) dd[i] = 0.f;
#pragma unroll
    for (int i = 0; i < BS; ++i) if (i < n) { const int dx = (int)buf[i].x, dy = (int)buf[i].y, dz = (int)buf[i].z, dw = (int)buf[i].w;
        int t = __builtin_amdgcn_sdot4(hx, dx, 0, false); t = __builtin_amdgcn_sdot4(hy, dy, t, false); t = __builtin_amdgcn_sdot4(hz, dz, t, false); t = __builtin_amdgcn_sdot4(hw, dw, t, false);
        dd[i] = (float)t; }
    const float r1 = reduce8_t(dd, lane);
    if ((lane & 7) == 0 && (lane >> 3) < n) wl[s + (lane >> 3)] = r1;
}
template <int BS> __device__ __forceinline__ void sw_proc_b(const v4u (&buf)[BS], f32x2_t (&acc)[8], const LAS float* wl, int s, int n) {
    float wr[BS];
#pragma unroll
    for (int i = 0; i < BS; ++i) wr[i] = wl[s + i];
#pragma unroll
    for (int i = 0; i < BS; ++i) if (i < n) {
        const float w = wr[i];
        const f32x2_t wv = {w, w};
        const unsigned ux = buf[i].x, uy = buf[i].y, uz = buf[i].z, uw = buf[i].w;
        acc[0] += wv * __builtin_amdgcn_cvt_pk_f32_fp8((int)ux, false); acc[1] += wv * __builtin_amdgcn_cvt_pk_f32_fp8((int)ux, true);
        acc[2] += wv * __builtin_amdgcn_cvt_pk_f32_fp8((int)uy, false); acc[3] += wv * __builtin_amdgcn_cvt_pk_f32_fp8((int)uy, true);
        acc[4] += wv * __builtin_amdgcn_cvt_pk_f32_fp8((int)uz, false); acc[5] += wv * __builtin_amdgcn_cvt_pk_f32_fp8((int)uz, true);
        acc[6] += wv * __builtin_amdgcn_cvt_pk_f32_fp8((int)uw, false); acc[7] += wv * __builtin_amdgcn_cvt_pk_f32_fp8((int)uw, true); }
}
__device__ __forceinline__ void sw_warm(v4u (&pf)[4], const unsigned char* tab, int range, int lw, unsigned voff) {
#pragma unroll
    for (int i = 0; i < 4; ++i) { const unsigned off = ((unsigned)(range * 1024 + lw * 4 + i) << 10) + voff; pf[i] = *(const v4u*)(tab + off); }
}
__device__ __forceinline__ void sw_warm_done(const v4u (&pf)[4]) {
#pragma unroll
    for (int i = 0; i < 4; ++i) asm volatile("" :: "v"(pf[i]));
}
template <int FAKE> __device__ __forceinline__ void p8b_sweep(Frame& F) {
    const float* X1 = (const float*)(((unsigned char*)karg(19)) + WS_X1); const float* MOD = (const float*)(((unsigned char*)karg(19)) + WS_MOD);
    const unsigned char* H2Q = (const unsigned char*)(((unsigned char*)karg(19)) + WS_H2Q); const float* H2S = (const float*)(((unsigned char*)karg(19)) + WS_H2S);
    const unsigned char* EDq = (const unsigned char*)(((unsigned char*)karg(19)) + WS_ED); const unsigned char* EUq = (const unsigned char*)(((unsigned char*)karg(19)) + WS_EU); const float* EDS = (const float*)(((unsigned char*)karg(19)) + WS_EDS);
    const unsigned short* PIDX = (const unsigned short*)(((unsigned char*)karg(19)) + WS_PIDX); const float* PG = (const float*)(((unsigned char*)karg(19)) + WS_PG);
    const float* fg = ((const float*)karg(17));
    const int gw = F.vcu * NWAVES + F.wave, NGW = F.G * NWAVES;
    for (int wi = F.vcu; wi < M / 64; wi += F.G) {
        const int tb = wi * 8 + F.wave;
        unsigned ones = ~0u; asm volatile("" : "+s"(ones));
        int lane = (int)__builtin_amdgcn_mbcnt_hi(ones, __builtin_amdgcn_mbcnt_lo(ones, 0u)); asm volatile("" : "+v"(lane));
        const int tok0 = tb * 8;
        unsigned E0[8], E1[8];
        LAS float* Wl = (LAS float*)(F.lds) + F.wave * 1024;
        LAS unsigned* El = (LAS unsigned*)(F.lds + 32768) + F.wave * (8 * ELP);
        unsigned voff = 16u * (unsigned)lane; asm volatile("" : "+v"(voff));
        LAS int* Bnd = (LAS int*)(F.lds + 67584) + F.wave * (8 * (NR + 1));
#pragma unroll
        for (int k = 0; k < 8; ++k) {
            const size_t base = (size_t)(tok0 + k) * 128;
            E0[k] = ((unsigned)PIDX[base + lane] << 7) | (unsigned)lane; E1[k] = ((unsigned)PIDX[base + 64 + lane] << 7) | (unsigned)(64 + lane);
            sort128(E0[k], E1[k], lane);
            if (FAKE) { E0[k] = (E0[k] & 0x1ffffu) ; E1[k] = (E1[k] & 0x1ffffu); sort128(E0[k], E1[k], lane); }
            El[k * ELP + lane] = E0[k] >> 7; El[k * ELP + 64 + lane] = E1[k] >> 7;
            if (lane < 8) El[k * ELP + 128 + lane] = (unsigned)__builtin_amdgcn_readlane((int)E1[k], 63) >> 7;
        }
        for (int repa = 0; repa < PROBE_REPA; ++repa) {
            v4u hq[8];
#pragma unroll
            for (int k = 0; k < 8; ++k) hq[k] = *(const v4u*)(H2Q + (size_t)(tok0 + k) * D + 16 * lane);
            int pos[8];
#pragma unroll
            for (int k = 0; k < 8; ++k) pos[k] = 0;
            v4u bA[BSA], bB[BSA], bC[BSA]; int ps = 0, pn = 0;
            for (int r = 0; r < NR; ++r) {
#pragma unroll
                for (int k = 0; k < 8; ++k) {
                    constexpr int dummy = 0; (void)dummy;
                    const int kp = (k + 7) & 7;
                    const int c = __builtin_popcountll(__ballot((E0[k] >> RSH) == (unsigned)r)) + __builtin_popcountll(__ballot((E1[k] >> RSH) == (unsigned)r));
                    int s = __builtin_amdgcn_readfirstlane(pos[k]); const int e_end = __builtin_amdgcn_readfirstlane(s + c); pos[k] = e_end;
                    if (lane == 0) Bnd[k * (NR + 1) + r + 1] = e_end;
                    const int n1 = (e_end - s) < BSA ? (e_end - s) : BSA;
                    if (k & 1) sw_issue<BSA>(bB, El + k * ELP + s, EDq, voff); else sw_issue<BSA>(bA, El + k * ELP + s, EDq, voff);
                    if (pn > 0) { if (k & 1) sw_proc_a<BSA>(bA, hq[kp], Wl + kp * 128, ps, pn, lane); else sw_proc_a<BSA>(bB, hq[kp], Wl + kp * 128, ps, pn, lane); }
                    ps = s; pn = n1; s += n1;
#define SWA_REST(Y) if (s < e_end) { sw_issue<BSA>(Y, El + k * ELP + s, EDq, voff); \
                        for (;;) { int n = (e_end - s) < BSA ? (e_end - s) : BSA; \
                            if (s + BSA < e_end) { sw_issue<BSA>(bC, El + k * ELP + s + BSA, EDq, voff); sw_proc_a<BSA>(Y, hq[k], Wl + k * 128, s, n, lane); } else { sw_proc_a<BSA>(Y, hq[k], Wl + k * 128, s, n, lane); break; } \
                            s += BSA; n = (e_end - s) < BSA ? (e_end - s) : BSA; \
                            if (s + BSA < e_end) { sw_issue<BSA>(Y, El + k * ELP + s + BSA, EDq, voff); sw_proc_a<BSA>(bC, hq[k], Wl + k * 128, s, n, lane); } else { sw_proc_a<BSA>(bC, hq[k], Wl + k * 128, s, n, lane); break; } \
                            s += BSA; } }
                    if (k & 1) { SWA_REST(bA) } else { SWA_REST(bB) }
#undef SWA_REST
                }
            }
            if (pn > 0) sw_proc_a<BSA>(bB, hq[7], Wl + 7 * 128, ps, pn, lane);
        }
#pragma unroll
        for (int k = 0; k < 8; ++k) { int tk = tok0 + k; asm volatile("" : "+s"(tk)); const size_t base = (size_t)tk * 128; const float sh = H2S[tk];
            const float r0 = Wl[k * 128 + lane], r1 = Wl[k * 128 + 64 + lane];
            Wl[k * 128 + lane] = PG[base + (E0[k] & 127u)] * gelu_erf(r0 * sh * EDS[E0[k] >> 7]) * 0.0625f;
            Wl[k * 128 + 64 + lane] = PG[base + (E1[k] & 127u)] * gelu_erf(r1 * sh * EDS[E1[k] >> 7]) * 0.0625f; }
        int ln = lane; asm volatile("" : "+v"(ln));
#pragma unroll
        for (int sub = 0; sub < 8 / TPS; ++sub) {
        f32x2_t acc[TPS][8];
        for (int repb = 0; repb < PROBE_REPB; ++repb) {
#pragma unroll
            for (int kk = 0; kk < TPS; ++kk)
#pragma unroll
                for (int i = 0; i < 8; ++i) acc[kk][i] = (f32x2_t){0.f, 0.f};
            int pos[TPS];
#pragma unroll
            for (int kk = 0; kk < TPS; ++kk) pos[kk] = 0;
            v4u bA[BSB], bB[BSB]; int ps = 0, pn = 0;
            for (int r = 0; r < NR; ++r) {
#pragma unroll
                for (int kk = 0; kk < TPS; ++kk) {
                    const int k = sub * TPS + kk, kkp = (kk + TPS - 1) % TPS, kp = sub * TPS + kkp;
                    int s = __builtin_amdgcn_readfirstlane(pos[kk]); const int e_end = __builtin_amdgcn_readfirstlane(Bnd[k * (NR + 1) + r + 1]); pos[kk] = e_end;
                    const int n1 = (e_end - s) < BSB ? (e_end - s) : BSB;
                    if (kk & 1) sw_issue<BSB>(bB, El + k * ELP + s, EUq, voff); else sw_issue<BSB>(bA, El + k * ELP + s, EUq, voff);
                    if (pn > 0) { if (kk & 1) sw_proc_b<BSB>(bA, acc[kkp], Wl + kp * 128, ps, pn); else sw_proc_b<BSB>(bB, acc[kkp], Wl + kp * 128, ps, pn); }
                    ps = s; pn = n1; s += n1;
                    for (; s < e_end; s += BSB) {
                        const int n = (e_end - s) < BSB ? (e_end - s) : BSB;
                        if (kk & 1) { sw_issue<BSB>(bA, El + k * ELP + s, EUq, voff); sw_proc_b<BSB>(bA, acc[kk], Wl + k * 128, s, n); }
                        else        { sw_issue<BSB>(bB, El + k * ELP + s, EUq, voff); sw_proc_b<BSB>(bB, acc[kk], Wl + k * 128, s, n); }
                    }
                }
            }
            if (pn > 0) sw_proc_b<BSB>(bB, acc[TPS - 1], Wl + (sub * TPS + TPS - 1) * 128, ps, pn);
        }
#pragma unroll
        for (int kk = 0; kk < TPS; ++kk) {
            const int tok = tok0 + sub * TPS + kk; const int b = tok >> 12; const float* gt2 = MOD + b * NMOD + 5120;
            f32x4 x2[4]; float ss = 0.f;
#pragma unroll
            for (int j = 0; j < 4; ++j) { const int col = 4 * ln + 256 * j;
                const f32x4 xv = *(const f32x4*)(X1 + (size_t)tok * D + col), gv4 = *(const f32x4*)(gt2 + col);
#pragma unroll
                for (int i = 0; i < 4; ++i) { const float v = xv[i] + gv4[i] * acc[kk][2 * j + (i >> 1)][i & 1]; x2[j][i] = v; ss += v * v; } }
            ss = wave_sum_x(ss, ln);
            if (FAKE && ss != 12345.678f) continue;
            const float rstd = 1.0f / sqrtf(ss * (1.0f / D) + EPS);
#pragma unroll
            for (int j = 0; j < 4; ++j) { const int col = 4 * ln + 256 * j; const f32x4 gg = *(const f32x4*)(fg + col);
                *(f32x4*)(((float*)karg(18)) + (size_t)tok * D + col) = x2[j] * rstd * gg; }
        }
        }
    }
}

struct Args { const float* in[18]; float* out; unsigned char* ws; };
__global__ void __launch_bounds__(NTHR, 2) mega_fwd(Args args) {
    extern __shared__ __attribute__((aligned(16))) unsigned char lds[];
    Frame F;
    F.lds = (LAS unsigned char*)lds;
    F.wave = __builtin_amdgcn_readfirstlane((int)threadIdx.x >> 6); F.lane = lane_fresh(); F.tid = F.wave * 64 + F.lane;
    F.G = gridDim.x; { const int bx = blockIdx.x; F.vcu = (F.G % 8 == 0) ? (bx % 8) * (F.G / 8) + bx / 8 : bx; }
    volatile LAS unsigned* MISC = (volatile LAS unsigned*)(F.lds + MISC_OFF);
    for (int u = F.tid; u < (LDS_BYTES - LDSCTL_OFF) / 4; u += NTHR) ((LAS unsigned*)(F.lds + LDSCTL_OFF))[u] = 0u;
    __syncthreads();
    gu32* ctl = (gu32*)(((unsigned char*)karg(19)) + WS_CTL);
    XcdBarrier bar = xcd_barrier_post((unsigned*)(ctl + CW_BAR), MISC + 8, F.wave);
#define GRID_BAR() xcd_barrier(bar)
#define PROBE_TS -1
#define STAMP(i) do { if (PROBE_TS >= 0 && blockIdx.x == 0 && F.tid == 0) { const unsigned long long t_ = __builtin_amdgcn_s_memrealtime(); MISC[16 + 2 * (i)] = (unsigned)t_; MISC[17 + 2 * (i)] = (unsigned)(t_ >> 32); } } while (0)
#define PROBE_DBL -1

    STAMP(0);
    F.lane = lane_fresh(); F.tid = F.wave * 64 + F.lane;
    p0_prologue(F); GRID_BAR(); STAMP(1);
    if (PROBE_DBL == 0) { p0_prologue(F); GRID_BAR(); }
    F.lane = lane_fresh(); F.tid = F.wave * 64 + F.lane;
    p1_norm(F); p0_transposes(F); GRID_BAR(); STAMP(2);
    if (PROBE_DBL == 1) { p1_norm(F); GRID_BAR(); }
    {
    {
        pg8::Gemm g{(const pg8::bf16_t*)(((unsigned char*)karg(19)) + WS_H), (const pg8::bf16_t*)(((unsigned char*)karg(19)) + WS_WIN), M, NPROJ, D, nullptr, nullptr};
        pg8::StaticOrder S; S.init(M, NPROJ, F.G, (int)blockIdx.x);
        pg8::EpiBf16<0> E{(pg8::bf16_t*)(((unsigned char*)karg(19)) + WS_PROJ), NPROJ, nullptr, 0, 0, 1.f};
        pg8::gemm_phase<pg8::EpiBf16<0>, pg8::StaticOrder, true, true>(F.lds + RING_OFF, g, S, E, F.wave);
        const int nwg = (M / 256) * (NPROJ / 256), busy = nwg % F.G;
        if (busy == 0) p0_quant_tables(F, F.vcu * NWAVES + F.wave, F.G * NWAVES);
        else if ((int)blockIdx.x >= busy) p0_quant_tables(F, ((int)blockIdx.x - busy) * NWAVES + F.wave, (F.G - busy) * NWAVES);
    }
    GRID_BAR(); STAMP(3);
    }
    p3_attention(F); GRID_BAR(); STAMP(4);
    if (PROBE_DBL == 3) { p3_attention(F); GRID_BAR(); }
    {
    {
        pg8::Gemm g{(const pg8::bf16_t*)(((unsigned char*)karg(19)) + WS_OA), (const pg8::bf16_t*)(((unsigned char*)karg(19)) + WS_WA), M, D, 512, (const pg8::bf16_t*)(((unsigned char*)karg(19)) + WS_OB), (const pg8::bf16_t*)(((unsigned char*)karg(19)) + WS_WB)};
        PairOrder S; S.S.init(M, D, F.G, (int)blockIdx.x);
        EpiGate E{(const bf16*)(((unsigned char*)karg(19)) + WS_PROJ), (bf16*)((float*)karg(18)) + (size_t)M * D};
        pg8::gemm_phase<EpiGate, PairOrder, false, true>(F.lds + RING_OFF, g, S, E, F.wave);
    }
    GRID_BAR(); STAMP(5);
    }
    {
    {
        pg8::Gemm g{(const pg8::bf16_t*)((bf16*)((float*)karg(18)) + (size_t)M * D), (const pg8::bf16_t*)(((unsigned char*)karg(19)) + WS_WOUT), M, D, D, nullptr, nullptr};
        pg8::StaticOrder S; S.init(M, D, F.G, (int)blockIdx.x);
        EpiRes E{((const float*)karg(0)), (const float*)(((unsigned char*)karg(19)) + WS_MOD), (float*)(((unsigned char*)karg(19)) + WS_X1)};
        pg8::gemm_phase<EpiRes, pg8::StaticOrder, false, true>(F.lds + RING_OFF, g, S, E, F.wave);
    }
    GRID_BAR(); STAMP(6);
    }
    F.lane = lane_fresh(); F.tid = F.wave * 64 + F.lane;
    F.lane = lane_fresh(); F.tid = F.wave * 64 + F.lane;
    p6_norm2(F); GRID_BAR(); STAMP(7);
    if (PROBE_DBL == 6) { p6_norm2(F); GRID_BAR(); }
    {
    {
        pg8::Gemm g{(const pg8::bf16_t*)(((unsigned char*)karg(19)) + WS_H2), (const pg8::bf16_t*)(((unsigned char*)karg(19)) + WS_WQ), M, D, D, nullptr, nullptr};
        pg8::StaticOrder S; S.init(M, D, F.G, (int)blockIdx.x);
        pg8::EpiBf16<0> E{(pg8::bf16_t*)(((unsigned char*)karg(19)) + WS_QP), D, nullptr, 0, 0, 1.f};
        pg8::gemm_phase<pg8::EpiBf16<0>, pg8::StaticOrder, false, true>(F.lds + RING_OFF, g, S, E, F.wave);
    }
    GRID_BAR(); STAMP(8);
    }
    F.lane = lane_fresh(); F.tid = F.wave * 64 + F.lane;
    p8a_topk(F); __syncthreads(); STAMP(9);
    if (PROBE_DBL == 8) { p8a_topk(F); GRID_BAR(); }
    if (PROBE_DBL == 12) { p8b_sweep<1>(F); __syncthreads(); }
    p8b_sweep<0>(F);
    if (PROBE_DBL == 9) { GRID_BAR(); p8b_sweep<0>(F); }
    if (PROBE_TS >= 0) {
        GRID_BAR(); STAMP(10);
        if (blockIdx.x == 0) { __syncthreads();
            const unsigned long long t0 = ((unsigned long long)MISC[17 + 2 * PROBE_TS] << 32) | MISC[16 + 2 * PROBE_TS], t1 = ((unsigned long long)MISC[19 + 2 * PROBE_TS] << 32) | MISC[18 + 2 * PROBE_TS];
            const float d_us = (float)(t1 - t0) * 0.01f;
            const float V = 128.0f * sqrtf(d_us * 1e-5f);
            float* o = (float*)karg(18); for (int c = F.tid; c < D; c += NTHR) o[c] = V; }
    }
}

extern "C" void kernel_launch(void* const* d_in, const int* in_sizes, int n_in, void* d_out, int out_size, void* d_ws, size_t ws_size, hipStream_t stream) {
    static int grid = 0;
    if (grid == 0) {
        if (n_in != 18 || in_sizes[0] != M * D || out_size != M * D || ws_size < WS_END) { fprintf(stderr, "kernel_launch: unexpected shapes (n_in %d, in0 %d, out %d, ws %zu)\n", n_in, n_in > 0 ? in_sizes[0] : -1, out_size, ws_size); grid = -1; return; }
        int dev = 0, cus = 0, per_cu = 0;
        if (hipGetDevice(&dev) != hipSuccess || hipDeviceGetAttribute(&cus, hipDeviceAttributeMultiprocessorCount, dev) != hipSuccess) { grid = -1; return; }
        if (hipFuncSetAttribute((const void*)mega_fwd, hipFuncAttributeMaxDynamicSharedMemorySize, LDS_BYTES) != hipSuccess) { fprintf(stderr, "kernel_launch: hipFuncSetAttribute failed\n"); grid = -1; return; }
        if (hipOccupancyMaxActiveBlocksPerMultiprocessor(&per_cu, (const void*)mega_fwd, NTHR, LDS_BYTES) != hipSuccess || per_cu < 1) { fprintf(stderr, "kernel_launch: occupancy query says %d blocks per CU\n", per_cu); }
        (void)hipGetLastError();
        grid = cus;
    }
    if (grid < 0) return;
    if (hipMemsetAsync((char*)d_ws + WS_CTL, 0, CTL_ZERO_BYTES, stream) != hipSuccess) { fprintf(stderr, "kernel_launch: memset failed\n"); return; }
    Args a{};
    for (int i = 0; i < 18; ++i) a.in[i] = (const float*)d_in[i];
    a.out = (float*)d_out; a.ws = (unsigned char*)d_ws;
    hipLaunchKernelGGL(mega_fwd, dim3(grid), dim3(NTHR), LDS_BYTES, stream, a);
}
```

```cpp
#include <hip/hip_runtime.h>
#include <cstdio>
#include <cstdint>
__device__ __forceinline__ int lane_fresh() { unsigned ones = ~0u; asm volatile("" : "+s"(ones)); return (int)__builtin_amdgcn_mbcnt_hi(ones, __builtin_amdgcn_mbcnt_lo(ones, 0u)); }
namespace pg8 {
#define PG8_LAS __attribute__((address_space(3)))
typedef unsigned short bf16_t;
typedef short bf16x8 __attribute__((ext_vector_type(8)));
typedef float f32x4 __attribute__((ext_vector_type(4)));
typedef unsigned u32x4 __attribute__((ext_vector_type(4)));
constexpr int BM = 256, BK = 64, HALF = 128, HTB = HALF * BK * 2  , STAGE_BYTES = 8 * HTB, NXCD = 8, WGM = 8;

__host__ __device__ __forceinline__ int lds_byte(int r, int c) { const int st = (r >> 4) * 2 + (c >> 5), rr = r & 15, cc = c & 31, ob = rr * 64 + cc * 2; return st * 1024 + (ob ^ (((ob >> 9) & 1) << 5)); }
__host__ __device__ __forceinline__ void stage_rc(int b, int& R, int& C) { const int st = b / 1024, sb = b % 1024, swz = sb ^ (((sb >> 9) & 1) << 5); R = (st >> 1) * 16 + swz / 64; C = (st & 1) * 32 + (swz % 64) / 2; }
__host__ __device__ __forceinline__ int perm32(int rho) { const int n = rho >> 4, i = rho & 15; return 8 * (i >> 2) + 4 * n + (i & 3); }

struct Unit { int pm, pn, src; };
struct Gemm { const bf16_t* A; const bf16_t* Bt; int M, N, K; const bf16_t* A2; const bf16_t* Bt2; };

struct StaticOrder {
    int nM, nN, nwg, G, c;
    __host__ __device__ void init(int M, int N, int G_, int c_) { nM = M / BM; nN = N / BM; nwg = nM * nN; G = G_; c = c_; }
    __host__ __device__ bool next(int i, Unit& u) const {
        const long L = (long)i * G + c; if (L >= nwg) return false;
        int wgid = (int)L; { const int q = nwg / NXCD, r = nwg % NXCD, xcd = wgid % NXCD, off = wgid / NXCD; wgid = (xcd < r ? xcd * (q + 1) : r * (q + 1) + (xcd - r) * q) + off; }
        const int nig = WGM * nN, gid = wgid / nig, fm = gid * WGM, gsz = (nM - fm) < WGM ? (nM - fm) : WGM;
        u.pm = fm + ((wgid % nig) % gsz); u.pn = (wgid % nig) / gsz; u.src = 0; return true;
    }
    __device__ __forceinline__ void a_ready(const Unit&) const {}
    __device__ __forceinline__ void done(const Unit&) const {}
};

__device__ __forceinline__ unsigned cvt_pk_bf16(float lo, float hi) { unsigned r; asm volatile("v_cvt_pk_bf16_f32 %0, %1, %2" : "=v"(r) : "v"(lo), "v"(hi)); return r; }
typedef float f32x2 __attribute__((ext_vector_type(2)));
__device__ __forceinline__ f32x2 gelu_pk(f32x2 v) {
    const f32x2 av = __builtin_elementwise_abs(v), d = av * 0.2316418882f + 1.0f;
    f32x2 t; t.x = __builtin_amdgcn_rcpf(d.x); t.y = __builtin_amdgcn_rcpf(d.y);
    f32x2 q = t * 0.5307027145f + (-0.7265760135f); q = q * t + 0.7107068705f; q = q * t + (-0.142248368f); q = q * t + 0.127414796f; q = q * t;
    const f32x2 s = (v * v) * (-0.72134752044f);
    f32x2 e; e.x = __builtin_amdgcn_exp2f(s.x); e.y = __builtin_amdgcn_exp2f(s.y);
    const f32x2 m = v * (q * e), r = v - m;
    f32x2 o; o.x = v.x < 0.f ? m.x : r.x; o.y = v.y < 0.f ? m.y : r.y; return o;
}

template <int ACT  > struct EpiBf16 {
    static constexpr bool PERM = true, AFTER_DRAIN = false, CHAIN = false; static_assert(ACT == 0 || ACT == 1, "EpiBf16: ACT is 0 (none) or 1 (gelu_pk)");
    bf16_t* O; int ldc; const float* bias; int split_cols; size_t split_stride; float scale0;
    __device__ __forceinline__ void operator()(const f32x4 (&acc)[2][2][4][2], const Unit& u, int wr, int wc, int fr, int fq) const {
        const int row0 = u.pm * BM + wr * 64 + fr; int colt = u.pn * BM; bf16_t* base = O;
        float sc = 1.f; if (split_cols) { const int t = colt / split_cols; base += (size_t)t * split_stride; colt -= t * split_cols; if (t == 0) sc = scale0; }
        const int col0 = colt + wc * 32 + 8 * fq, bcol0 = u.pn * BM + wc * 32 + 8 * fq;
        f32x4 bv[2][2];
#pragma unroll
        for (int bj = 0; bj < 2; ++bj)
#pragma unroll
            for (int n = 0; n < 2; ++n) bv[bj][n] = bias ? *(const f32x4*)(bias + bcol0 + bj * HALF + 4 * n) : (f32x4){0.f, 0.f, 0.f, 0.f};
#pragma unroll
        for (int ai = 0; ai < 2; ++ai)
#pragma unroll
            for (int m = 0; m < 4; ++m) { bf16_t* rowp = base + (size_t)(row0 + ai * HALF + m * 16) * ldc + col0;
#pragma unroll
                for (int bj = 0; bj < 2; ++bj) { f32x4 v0 = acc[ai][bj][m][0] + bv[bj][0], v1 = acc[ai][bj][m][1] + bv[bj][1];
                    if (ACT == 1) { f32x2 a = gelu_pk((f32x2){v0[0], v0[1]}), b = gelu_pk((f32x2){v0[2], v0[3]}), c = gelu_pk((f32x2){v1[0], v1[1]}), d = gelu_pk((f32x2){v1[2], v1[3]});
                        v0 = (f32x4){a.x, a.y, b.x, b.y}; v1 = (f32x4){c.x, c.y, d.x, d.y}; }
                    v0 = v0 * sc; v1 = v1 * sc; u32x4 w; w.x = cvt_pk_bf16(v0[0], v0[1]); w.y = cvt_pk_bf16(v0[2], v0[3]); w.z = cvt_pk_bf16(v1[0], v1[1]); w.w = cvt_pk_bf16(v1[2], v1[3]);
                    *(u32x4*)(rowp + bj * HALF) = w; } }
    }
};

template <class Epi, class Sched, bool ALIGN_EPI = false, bool SP2 = false>
__device__ __forceinline__ void gemm_phase(PG8_LAS unsigned char* lds, const Gemm g, const Sched& S, const Epi& E, int wave_id) {
    int tid = wave_id * 64 + ::lane_fresh(); asm volatile("" : "+v"(tid));
    const int wid = __builtin_amdgcn_readfirstlane(tid >> 6), lane = tid & 63, wr = wid >> 2, wc = wid & 3, fr = lane & 15, fq = lane >> 4;
    const int K = g.K, nt = K / BK;
    unsigned voffA[2], voffB[2];
#pragma unroll
    for (int i = 0; i < 2; ++i) { int R, C; stage_rc(tid * 16 + i * 8192, R, C); const int Rb = Epi::PERM ? ((R & ~31) + perm32(R & 31)) : R;
        voffA[i] = (unsigned)(R * K + C) * 2u; voffB[i] = (unsigned)(Rb * K + C) * 2u; }
    const size_t kstep = (size_t)(BK * 2);
    const size_t hstep = (size_t)HALF * K * 2;
    const size_t tstep = 2 * hstep;
    const unsigned ldsw = (unsigned)wid * 1024u;
    const int aoff = lds_byte(wr * 64 + fr, fq * 8), boff = lds_byte(wc * 32 + fr, fq * 8);
#define PG8_SA(b, h) (((b) * 2 + (h)) * HTB)
#define PG8_SB(b, h) ((4 + (b) * 2 + (h)) * HTB)
#define PG8_STAGE(bufoff, gbase, voff) do { _Pragma("unroll") for (int _i = 0; _i < 2; ++_i) \
        __builtin_amdgcn_global_load_lds((const unsigned*)((const char*)(gbase) + (voff)[_i]), (PG8_LAS unsigned*)(lds + (bufoff) + ldsw + _i * 8192), 16, 0, 0); } while (0)
#define PG8_LDA(dst, b, h) do { _Pragma("unroll") for (int m = 0; m < 4; ++m) _Pragma("unroll") for (int k = 0; k < 2; ++k) dst[m][k] = *(const PG8_LAS bf16x8*)(lds + PG8_SA(b, h) + aoff + m * 2048 + k * 1024); } while (0)
#define PG8_LDB(dst, b, h) do { _Pragma("unroll") for (int n = 0; n < 2; ++n) _Pragma("unroll") for (int k = 0; k < 2; ++k) dst[n][k] = *(const PG8_LAS bf16x8*)(lds + PG8_SB(b, h) + boff + n * 2048 + k * 1024); } while (0)
#define PG8_MMA(ai, bj, At, Bt) do { __builtin_amdgcn_s_setprio(1); _Pragma("unroll") for (int m = 0; m < 4; ++m) _Pragma("unroll") for (int n = 0; n < 2; ++n) _Pragma("unroll") for (int k = 0; k < 2; ++k) \
        acc[ai][bj][m][n] = __builtin_amdgcn_mfma_f32_16x16x32_bf16(Bt[n][k], At[m][k], acc[ai][bj][m][n], 0, 0, 0); __builtin_amdgcn_s_setprio(0); } while (0)
#define PG8_WAIT_V(n) asm volatile("s_waitcnt vmcnt(" #n ")" ::: "memory")
#define PG8_WAIT_L(n) asm volatile("s_waitcnt lgkmcnt(" #n ")" ::: "memory")
#define PG8_BAR __builtin_amdgcn_s_barrier()
#define PG8_SCHED __builtin_amdgcn_sched_barrier(0)
    Unit cur, nxt; int ui = 0;
    if (!S.next(0, cur)) return;
    f32x4 acc[2][2][4][2];
#pragma unroll
    for (int a = 0; a < 2; ++a)
#pragma unroll
        for (int b = 0; b < 2; ++b)
#pragma unroll
            for (int m = 0; m < 4; ++m)
#pragma unroll
                for (int n = 0; n < 2; ++n) acc[a][b][m][n] = (f32x4){0.f, 0.f, 0.f, 0.f};
    bf16x8 At[4][2], B0[2][2], B1[2][2];
    const char* cA = (const char*)(cur.src ? g.A2 : g.A) + (size_t)cur.pm * tstep; const char* cB = (const char*)(cur.src ? g.Bt2 : g.Bt) + (size_t)cur.pn * tstep;
    S.a_ready(cur);
    if constexpr (SP2) {
        PG8_STAGE(PG8_SB(0, 0), cB, voffB); PG8_STAGE(PG8_SB(0, 1), cB + hstep, voffB); PG8_STAGE(PG8_SA(0, 0), cA, voffA); PG8_STAGE(PG8_SA(0, 1), cA + hstep, voffA);
        if (wr == 1) PG8_BAR;
        PG8_WAIT_V(2); PG8_BAR;
        PG8_STAGE(PG8_SB(1, 0), cB + kstep, voffB); PG8_STAGE(PG8_SA(1, 0), cA + kstep, voffA); PG8_STAGE(PG8_SB(1, 1), cB + hstep + kstep, voffB);
        PG8_WAIT_V(6); PG8_BAR;
    } else {
        PG8_STAGE(PG8_SB(0, 0), cB, voffB); PG8_STAGE(PG8_SA(0, 0), cA, voffA); PG8_STAGE(PG8_SB(0, 1), cB + hstep, voffB); PG8_STAGE(PG8_SA(0, 1), cA + hstep, voffA);
        if (wr == 1) PG8_BAR;
        PG8_WAIT_V(4); PG8_BAR;
        PG8_STAGE(PG8_SB(1, 0), cB + kstep, voffB); PG8_STAGE(PG8_SA(1, 0), cA + kstep, voffA); PG8_STAGE(PG8_SB(1, 1), cB + hstep + kstep, voffB);
        PG8_WAIT_V(6); PG8_BAR;
    }
    for (;;) {
        const bool has_next = S.next(ui + 1, nxt);
        const char* nA = has_next ? (const char*)(nxt.src ? g.A2 : g.A) + (size_t)nxt.pm * tstep : cA; const char* nB = has_next ? (const char*)(nxt.src ? g.Bt2 : g.Bt) + (size_t)nxt.pn * tstep : cB;
        for (int t = 0; t < nt; t += 2) {
            const bool last = (t == nt - 2);
            const char* a1 = cA + (size_t)(t + 1) * kstep;
            const char* a2 = last ? nA : cA + (size_t)(t + 2) * kstep; const char* b2 = last ? nB : cB + (size_t)(t + 2) * kstep;
            const char* a3 = a2 + kstep; const char* b3 = b2 + kstep;
            if (last && has_next) S.a_ready(nxt);
            if constexpr (SP2) {
            PG8_LDB(B0, 0, 0); PG8_LDB(B1, 0, 1); PG8_SCHED; PG8_LDA(At, 0, 0); PG8_STAGE(PG8_SA(1, 1), a1 + hstep, voffA);
            PG8_WAIT_V(8); PG8_WAIT_L(0); PG8_BAR; PG8_MMA(0, 0, At, B0); PG8_MMA(0, 1, At, B1); PG8_BAR; PG8_SCHED;
            PG8_LDA(At, 0, 1); PG8_STAGE(PG8_SB(0, 0), b2, voffB); PG8_STAGE(PG8_SB(0, 1), b2 + hstep, voffB); PG8_STAGE(PG8_SA(0, 0), a2, voffA);
            PG8_WAIT_V(8); PG8_WAIT_L(0); PG8_BAR; PG8_MMA(1, 0, At, B0); PG8_MMA(1, 1, At, B1); PG8_BAR; PG8_SCHED;
            PG8_LDB(B0, 1, 0); PG8_LDB(B1, 1, 1); PG8_SCHED; PG8_LDA(At, 1, 0); PG8_STAGE(PG8_SA(0, 1), a2 + hstep, voffA);
            PG8_WAIT_V(8); PG8_WAIT_L(0); PG8_BAR; PG8_MMA(0, 0, At, B0); PG8_MMA(0, 1, At, B1); PG8_BAR; PG8_SCHED;
            PG8_LDA(At, 1, 1); PG8_STAGE(PG8_SB(1, 0), b3, voffB); PG8_STAGE(PG8_SB(1, 1), b3 + hstep, voffB); PG8_STAGE(PG8_SA(1, 0), a3, voffA);
            PG8_WAIT_V(8); PG8_WAIT_L(0); PG8_BAR; PG8_MMA(1, 0, At, B0); PG8_MMA(1, 1, At, B1); PG8_BAR; PG8_SCHED;
            } else {
            PG8_LDB(B0, 0, 0); PG8_SCHED; PG8_LDA(At, 0, 0); PG8_STAGE(PG8_SA(1, 1), a1 + hstep, voffA);
            PG8_WAIT_L(8); PG8_BAR; PG8_WAIT_L(0); PG8_MMA(0, 0, At, B0); PG8_BAR; PG8_SCHED;
            PG8_LDB(B1, 0, 1); PG8_STAGE(PG8_SB(0, 0), b2, voffB);
            PG8_BAR; PG8_WAIT_L(0); PG8_MMA(0, 1, At, B1); PG8_BAR;
            PG8_LDA(At, 0, 1); PG8_STAGE(PG8_SA(0, 0), a2, voffA);
            PG8_BAR; PG8_WAIT_L(0); PG8_MMA(1, 0, At, B0); PG8_BAR; PG8_SCHED;
            PG8_STAGE(PG8_SB(0, 1), b2 + hstep, voffB);
            PG8_WAIT_V(6); PG8_BAR; PG8_MMA(1, 1, At, B1); PG8_BAR;
            PG8_LDB(B0, 1, 0); PG8_SCHED; PG8_LDA(At, 1, 0); PG8_STAGE(PG8_SA(0, 1), a2 + hstep, voffA);
            PG8_WAIT_L(8); PG8_BAR; PG8_WAIT_L(0); PG8_MMA(0, 0, At, B0); PG8_BAR; PG8_SCHED;
            PG8_LDB(B1, 1, 1); PG8_STAGE(PG8_SB(1, 0), b3, voffB);
            PG8_BAR; PG8_WAIT_L(0); PG8_MMA(0, 1, At, B1); PG8_BAR;
            PG8_LDA(At, 1, 1); PG8_STAGE(PG8_SA(1, 0), a3, voffA);
            PG8_BAR; PG8_WAIT_L(0); PG8_MMA(1, 0, At, B0); PG8_BAR; PG8_SCHED;
            PG8_STAGE(PG8_SB(1, 1), b3 + hstep, voffB);
            PG8_WAIT_V(6); PG8_BAR; PG8_MMA(1, 1, At, B1); PG8_BAR;
            }
        }
        if constexpr (ALIGN_EPI) { if (wr == 0) PG8_BAR; }
        if constexpr (!Epi::AFTER_DRAIN) { E(acc, cur, wr, wc, fr, fq); S.done(cur); }
        if (!has_next) break;
        if (!(Epi::CHAIN && cur.src == 0)) {
#pragma unroll
        for (int a = 0; a < 2; ++a)
#pragma unroll
            for (int b = 0; b < 2; ++b)
#pragma unroll
                for (int m = 0; m < 4; ++m)
#pragma unroll
                    for (int n = 0; n < 2; ++n) acc[a][b][m][n] = (f32x4){0.f, 0.f, 0.f, 0.f};
        }
        cur = nxt; cA = nA; cB = nB; ++ui;
        if constexpr (ALIGN_EPI) { if (wr == 1) PG8_BAR; }
    }
    PG8_WAIT_V(0);
    if constexpr (!ALIGN_EPI) { if (wr == 0) PG8_BAR; }
    PG8_BAR;
    if constexpr (Epi::AFTER_DRAIN) { E.fused(acc, cur, wr, wc, fr, fq, lds, wid, lane); S.done(cur); }
#undef PG8_SA
#undef PG8_SB
#undef PG8_STAGE
#undef PG8_LDA
#undef PG8_LDB
#undef PG8_MMA
#undef PG8_WAIT_V
#undef PG8_WAIT_L
#undef PG8_BAR
#undef PG8_SCHED
}
}

#define GAS __attribute__((address_space(1)))
#define LAS __attribute__((address_space(3)))
typedef unsigned short bf16;
typedef unsigned v4u __attribute__((ext_vector_type(4)));
typedef float f32x4 __attribute__((ext_vector_type(4)));
typedef short bf16x8 __attribute__((ext_vector_type(8)));
typedef GAS unsigned gu32;
typedef GAS unsigned long long gu64;
#define RLX_AGENT __ATOMIC_RELAXED, __HIP_MEMORY_SCOPE_AGENT
#define LDS_WAIT() asm volatile("s_waitcnt lgkmcnt(0)" ::: "memory")
#define VM_WAIT() asm volatile("s_waitcnt vmcnt(0)" ::: "memory")
__device__ __forceinline__ unsigned long long rt() { return __builtin_amdgcn_s_memrealtime(); }
__device__ __forceinline__ unsigned f2bf(float f) { unsigned u = __builtin_bit_cast(unsigned, f); return (u + 0x7fffu + ((u >> 16) & 1u)) >> 16; }
__device__ __forceinline__ unsigned pk2(float lo, float hi) { return f2bf(lo) | (f2bf(hi) << 16); }

__device__ __forceinline__ const void* karg(int i);
constexpr int CW_BAR_FWD = 4096;
#define XB_TMO      128
#define XB_XCNT(j)  (256  + 64 * (j))
#define XB_XSUB(j)  (1280 + 64 * (j))
#define XB_XGEN(j)  (2304 + 64 * (j))
#define XB_TOP      3328
#define XB_TOPGEN   3392
#define XCD_BAR_WORDS 3456
#define XB_SPIN_CAP (1u << 18)

__device__ __forceinline__ unsigned xb_ld(unsigned* p)              { return __hip_atomic_load(p, __ATOMIC_RELAXED, __HIP_MEMORY_SCOPE_AGENT); }
__device__ __forceinline__ unsigned xb_add(unsigned* p, unsigned v) { return __hip_atomic_fetch_add(p, v, __ATOMIC_RELAXED, __HIP_MEMORY_SCOPE_AGENT); }
__device__ __forceinline__ unsigned xb_xcc_id() { return (unsigned)__builtin_amdgcn_s_getreg((3 << 11) | 20) & 0xFu; }
#define XB_SPIN(cond, bar) do { unsigned _sp = 0; while (cond) { __builtin_amdgcn_s_sleep(1); \
    if ((++_sp & 255u) == 0u) { if (xb_ld(&(bar)[XB_TMO])) break; if (_sp > XB_SPIN_CAP) { atomicAdd(&(bar)[XB_TMO], 1u); break; } } } } while (0)

struct XcdBarrier {
    int wave;
    unsigned* bar; unsigned x;
    volatile LAS unsigned* st;
};

__device__ __forceinline__ XcdBarrier xcd_barrier_post(unsigned* bar, volatile LAS unsigned* st, int wave) {
    XcdBarrier b; b.wave = wave; b.bar = bar; b.x = xb_xcc_id(); b.st = st;
    if (wave == 0 && lane_fresh() == 0) (void)xb_add(&bar[XB_XCNT(b.x)], 1u);
    return b;
}
__device__ __forceinline__ void xcd_barrier_complete(unsigned* bar, unsigned x, unsigned& nloc, unsigned& nx) {
    const unsigned G = gridDim.x * gridDim.y * gridDim.z;
    unsigned sum, cnt, mine, sp = 0u;
    for (;;) {
        sum = 0u; cnt = 0u; mine = 0u;
#pragma unroll
        for (unsigned j = 0; j < 16; ++j) { const unsigned c = xb_ld(&bar[XB_XCNT(j)]); sum += c; cnt += (c > 0u) ? 1u : 0u; mine = (j == x) ? c : mine; }
        if (sum == G) break;
        __builtin_amdgcn_s_sleep(1);
        if ((++sp & 255u) == 0u) { if (xb_ld(&bar[XB_TMO])) break; if (sp > XB_SPIN_CAP) { atomicAdd(&bar[XB_TMO], 1u); break; } }
    }
    nloc = mine > 0u ? mine : 1u; nx = cnt > 0u ? cnt : 1u;
}

__device__ __forceinline__ void xcd_barrier(const XcdBarrier& b) {
    asm volatile("s_waitcnt vmcnt(0)" ::: "memory");
    __syncthreads();
    if (b.wave == 0 && lane_fresh() == 0) {
        unsigned* bar = (unsigned*)((gu32*)((unsigned char*)karg(19)) + CW_BAR_FWD);
        __builtin_amdgcn_s_waitcnt(0);
        unsigned nloc = b.st[0], nx = b.st[1];
        if (nloc == 0u) { xcd_barrier_complete(bar, b.x, nloc, nx); b.st[0] = nloc; b.st[1] = nx; }
        const unsigned old = xb_add(&bar[XB_XSUB(b.x)], 1u);
        const unsigned gen = old / nloc;
        if (old + 1u == (gen + 1u) * nloc) {
            __builtin_amdgcn_fence(__ATOMIC_RELEASE, "agent");
            asm volatile("s_waitcnt vmcnt(0)" ::: "memory");
            const unsigned og = xb_add(&bar[XB_TOP], 1u);
            const unsigned tg = og / nx;
            if (og + 1u == (tg + 1u) * nx) xb_add(&bar[XB_TOPGEN], 1u);
            else XB_SPIN(xb_ld(&bar[XB_TOPGEN]) == tg, bar);
            __builtin_amdgcn_fence(__ATOMIC_ACQUIRE, "agent");
            xb_add(&bar[XB_XGEN(b.x)], 1u);
            asm volatile("s_waitcnt vmcnt(0)" ::: "memory");
        } else {
            XB_SPIN(xb_ld(&bar[XB_XGEN(b.x)]) == gen, bar);
            __builtin_amdgcn_fence(__ATOMIC_ACQUIRE, "agent");
            asm volatile("s_waitcnt vmcnt(0)" ::: "memory");
        }
    }
    __syncthreads();
}

constexpr int NWAVES = 8, NTHR = 512;
constexpr int BATCH = 4, SEQ = 4096, D = 1024, M = BATCH * SEQ;
constexpr int NPROJ = 4352, LDW_IN = 4360, NMOD = 6144;
constexpr int C_QA = 0, C_KA = 512, C_VA = 640, C_QB = 768, C_KB = 1280, C_VB = 1792, C_GLA = 2304, C_GLB = 3328;
constexpr int NEXP = 16384;
constexpr float EPS = 1e-6f;

constexpr size_t MiB = 1u << 20;
constexpr size_t WS_CTL = 0, CTL_ZERO_BYTES = 1 * MiB;
constexpr size_t WS_MOD = 1 * MiB, WS_LOGF = 1 * MiB + 128 * 1024, WS_SUBK = 2 * MiB;
constexpr size_t WS_WIN = 4 * MiB, WS_WA = 12 * MiB + 512 * 1024, WS_WB = 13 * MiB + 512 * 1024, WS_WOUT = 14 * MiB + 512 * 1024, WS_WQ = 16 * MiB + 512 * 1024;
constexpr size_t WS_ED = 19 * MiB, WS_EU = 35 * MiB;
constexpr size_t WS_EDS = 2 * MiB + 512 * 1024;
constexpr size_t WS_H2Q = 95 * MiB, WS_H2S = 111 * MiB;
constexpr size_t WS_H = 83 * MiB, WS_OA = 83 * MiB, WS_OB = 99 * MiB, WS_PIDX = 83 * MiB, WS_PG = 87 * MiB;
constexpr size_t WS_PROJ = 115 * MiB, WS_X1 = 115 * MiB, WS_H2 = 179 * MiB, WS_QP = 211 * MiB;
constexpr size_t WS_END = 251 * MiB;
static_assert(WS_WIN + (size_t)NPROJ * D * 2 <= WS_WA && WS_WQ + (size_t)D * D * 2 <= WS_ED && WS_PROJ + (size_t)M * NPROJ * 2 <= WS_END, "ws map");
constexpr int CW_BAR = 4096; static_assert(CW_BAR == CW_BAR_FWD && WS_CTL == 0, "barrier words");

constexpr int RING_OFF = 0, RING_BYTES = 131072;
constexpr int LDSCTL_OFF = RING_BYTES, MISC_OFF = LDSCTL_OFF + 320;
constexpr int LDS_BYTES = 147456;

typedef float f32x16 __attribute__((ext_vector_type(16)));
typedef short s16x4 __attribute__((ext_vector_type(4)));
typedef unsigned u32x2 __attribute__((ext_vector_type(2)));
typedef float f32x2_t __attribute__((ext_vector_type(2)));
typedef __bf16 bf16x2_t __attribute__((ext_vector_type(2)));

__device__ __forceinline__ unsigned cvtpk(float lo, float hi) { f32x2_t v = {lo, hi}; bf16x2_t b = __builtin_convertvector(v, bf16x2_t); return __builtin_bit_cast(unsigned, b); }
__device__ __forceinline__ float bflo(unsigned u) { return __uint_as_float(u << 16); }
__device__ __forceinline__ float bfhi(unsigned u) { return __uint_as_float(u & 0xffff0000u); }
template <int S> __device__ __forceinline__ unsigned xorx(unsigned v, int lane) {
    if constexpr (S == 1) return (unsigned)__builtin_amdgcn_update_dpp(0, (int)v, 0xB1, 0xF, 0xF, true);
    else if constexpr (S == 2) return (unsigned)__builtin_amdgcn_update_dpp(0, (int)v, 0x4E, 0xF, 0xF, true);
    else if constexpr (S == 4) { const unsigned a = (unsigned)__builtin_amdgcn_update_dpp(0, (int)v, 0x124, 0xF, 0xF, true), b = (unsigned)__builtin_amdgcn_update_dpp(0, (int)v, 0x12C, 0xF, 0xF, true); return (lane & 4) ? a : b; }
    else if constexpr (S == 8) return (unsigned)__builtin_amdgcn_update_dpp(0, (int)v, 0x128, 0xF, 0xF, true);
    else if constexpr (S == 16) { const auto r = __builtin_amdgcn_permlane16_swap(v, v, false, false); return (lane & 16) ? r[0] : r[1]; }
    else { const auto r = __builtin_amdgcn_permlane32_swap(v, v, false, false); return (lane & 32) ? r[0] : r[1]; }
}
__device__ __forceinline__ unsigned xorx_sw(unsigned v, int lane, int s) {
    switch (s) { case 1: return xorx<1>(v, lane); case 2: return xorx<2>(v, lane); case 4: return xorx<4>(v, lane); case 8: return xorx<8>(v, lane); case 16: return xorx<16>(v, lane); default: return xorx<32>(v, lane); }
}
__device__ __forceinline__ float wave_sum_x(float v, int lane) {
    v += __uint_as_float(xorx<1>(__float_as_uint(v), lane)); v += __uint_as_float(xorx<2>(__float_as_uint(v), lane)); v += __uint_as_float(xorx<4>(__float_as_uint(v), lane));
    v += __uint_as_float(xorx<8>(__float_as_uint(v), lane)); v += __uint_as_float(xorx<16>(__float_as_uint(v), lane)); v += __uint_as_float(xorx<32>(__float_as_uint(v), lane));
    return v;
}
__device__ __forceinline__ float dppf(float v, const int ctrl_sel) { return v; }
#define DPP_F(v, CTRL) __uint_as_float(__builtin_amdgcn_update_dpp(0, __float_as_uint(v), (CTRL), 0xF, 0xF, true))
__device__ __forceinline__ float reduce8_t(const float (&dd)[8], int lane) {
    float r4[4];
#pragma unroll
    for (int u = 0; u < 4; ++u) { const auto p = __builtin_amdgcn_permlane32_swap(__float_as_uint(dd[u]), __float_as_uint(dd[u + 4]), false, false); r4[u] = __uint_as_float(p[0]) + __uint_as_float(p[1]); }
    float r2[2];
#pragma unroll
    for (int u = 0; u < 2; ++u) { const auto p = __builtin_amdgcn_permlane16_swap(__float_as_uint(r4[u]), __float_as_uint(r4[u + 2]), false, false); r2[u] = __uint_as_float(p[0]) + __uint_as_float(p[1]); }
    const bool b3 = (lane & 8) != 0;
    const float keep = b3 ? r2[1] : r2[0], send = b3 ? r2[0] : r2[1];
    float r1 = keep + DPP_F(send, 0x128);
    r1 += DPP_F(r1, 0xB1);
    r1 += DPP_F(r1, 0x4E);
    r1 += DPP_F(r1, 0x141);
    return r1;
}
__device__ __forceinline__ int lane_id() { return (int)__builtin_amdgcn_mbcnt_hi(~0u, __builtin_amdgcn_mbcnt_lo(~0u, 0u)); }
__device__ __forceinline__ float wave_sum(float v) { return wave_sum_x(v, lane_id()); }
__device__ __forceinline__ float wave_max(float v) { const int lane = lane_id();
    v = fmaxf(v, __uint_as_float(xorx<1>(__float_as_uint(v), lane))); v = fmaxf(v, __uint_as_float(xorx<2>(__float_as_uint(v), lane))); v = fmaxf(v, __uint_as_float(xorx<4>(__float_as_uint(v), lane)));
    v = fmaxf(v, __uint_as_float(xorx<8>(__float_as_uint(v), lane))); v = fmaxf(v, __uint_as_float(xorx<16>(__float_as_uint(v), lane))); v = fmaxf(v, __uint_as_float(xorx<32>(__float_as_uint(v), lane)));
    return v; }
__device__ __forceinline__ int crow(int r, int hi) { return (r & 3) + 8 * (r >> 2) + 4 * hi; }
#define MFMA32(a, b, c) __builtin_amdgcn_mfma_f32_32x32x16_bf16((a), (b), (c), 0, 0, 0)

struct Frame {
    LAS unsigned char* lds;
    int tid, lane, wave, vcu, G;
};
__device__ __forceinline__ const void* karg(int i) {
    unsigned long z = 0; asm volatile("" : "+s"(z));
    const char* base = (const char*)__builtin_amdgcn_kernarg_segment_ptr();
    return *(const void* const*)(base + 8 * i + z);
}

__device__ __forceinline__ void p0_transpose_item(const float* W, int ld, int K, int ncols, bf16* WT, int row_off, LAS float* scr, int item, int lane) {
    const int nblk = ncols / 32, kb = item / nblk, nb = item % nblk, k0 = 64 * kb, n0 = 32 * nb;
#pragma unroll 8
    for (int i = 0; i < 32; ++i) { const int kk = 2 * i + (lane >> 5); scr[kk * 33 + (lane & 31)] = W[(size_t)(k0 + kk) * ld + n0 + (lane & 31)]; }
    LDS_WAIT(); asm volatile("" ::: "memory");
    const int c = lane & 7;
#pragma unroll
    for (int j = 0; j < 4; ++j) { const int n = (lane >> 3) + 8 * j; const LAS float* s = scr + (8 * c) * 33 + n;
        v4u o; o.x = pk2(s[0 * 33], s[1 * 33]); o.y = pk2(s[2 * 33], s[3 * 33]); o.z = pk2(s[4 * 33], s[5 * 33]); o.w = pk2(s[6 * 33], s[7 * 33]);
        *(GAS v4u*)(WT + (size_t)(row_off + n0 + n) * K + k0 + 8 * c) = o; }
    LDS_WAIT(); asm volatile("" ::: "memory");
}
__device__ __forceinline__ void p0_convert(const float* __restrict__ src, bf16* __restrict__ dst, long n_iters, int gw, int NGW, int lane) {
    for (long it0 = (long)gw * 4; it0 < n_iters; it0 += (long)NGW * 4) {
        f32x4 a[4][2];
#pragma unroll
        for (int u = 0; u < 4; ++u) { const long it = it0 + u; if (it < n_iters) { const float* p = src + it * 512 + lane * 4; a[u][0] = *(const f32x4*)p; a[u][1] = *(const f32x4*)(p + 256); } }
#pragma unroll
        for (int u = 0; u < 4; ++u) { const long it = it0 + u; if (it < n_iters) { bf16* q = dst + it * 512 + lane * 4;
            u32x2 w0, w1; w0.x = cvtpk(a[u][0].x, a[u][0].y); w0.y = cvtpk(a[u][0].z, a[u][0].w); w1.x = cvtpk(a[u][1].x, a[u][1].y); w1.y = cvtpk(a[u][1].z, a[u][1].w);
            *(u32x2*)q = w0; *(u32x2*)(q + 256) = w1; } }
    }
}

__device__ __forceinline__ void p0_quant_tables(Frame& F, int gw, int NGW) {
    const float* ed = ((const float*)karg(15)); const float* eu = ((const float*)karg(16));
    unsigned char* EDq = (unsigned char*)(((unsigned char*)karg(19)) + WS_ED); unsigned char* EUq = (unsigned char*)(((unsigned char*)karg(19)) + WS_EU); float* EDS = (float*)(((unsigned char*)karg(19)) + WS_EDS);
    const int lane = F.lane;
    for (int row0 = gw * 4; row0 < NEXP; row0 += NGW * 4) {
        f32x4 a[4][4], u[4][4];
#pragma unroll
        for (int q = 0; q < 4; ++q)
#pragma unroll
            for (int j = 0; j < 4; ++j) { a[q][j] = *((const f32x4*)(ed + (size_t)(row0 + q) * D) + lane + 64 * j); u[q][j] = *((const f32x4*)(eu + (size_t)(row0 + q) * D) + lane + 64 * j); }
#pragma unroll
        for (int q = 0; q < 4; ++q) {
            float am = 0.f;
#pragma unroll
            for (int j = 0; j < 4; ++j) am = fmaxf(fmaxf(am, fmaxf(fabsf(a[q][j].x), fabsf(a[q][j].y))), fmaxf(fabsf(a[q][j].z), fabsf(a[q][j].w)));
            am = wave_max(am);
            const float sc = am > 0.f ? am * (1.0f / 127.0f) : 1.0f, inv = 1.0f / sc;
            v4u qa, qu;
#pragma unroll
            for (int j = 0; j < 4; ++j) {
                const int b0 = (int)rintf(a[q][j].x * inv), b1 = (int)rintf(a[q][j].y * inv), b2 = (int)rintf(a[q][j].z * inv), b3 = (int)rintf(a[q][j].w * inv);
                qa[j] = (unsigned)(b0 & 255) | ((unsigned)(b1 & 255) << 8) | ((unsigned)(b2 & 255) << 16) | ((unsigned)(b3 & 255) << 24);
                int p = __builtin_amdgcn_cvt_pk_fp8_f32(u[q][j].x * 16.0f, u[q][j].y * 16.0f, 0, false);
                p = __builtin_amdgcn_cvt_pk_fp8_f32(u[q][j].z * 16.0f, u[q][j].w * 16.0f, p, true);
                qu[j] = (unsigned)p;
            }
            *(v4u*)(EDq + (size_t)(row0 + q) * D + 16 * lane) = qa;
            *(v4u*)(EUq + (size_t)(row0 + q) * D + 16 * lane) = qu;
            if (lane == 0) EDS[row0 + q] = sc;
        }
    }
}
__device__ __forceinline__ void p0_prologue(Frame& F) {
    const float* c = ((const float*)karg(1)); const float* w_ada = ((const float*)karg(4)); const float* b_ada = ((const float*)karg(5));
    float* MOD = (float*)(((unsigned char*)karg(19)) + WS_MOD);
    {
        LAS float* cact = (LAS float*)(F.lds);
        LAS float* part = (LAS float*)(F.lds + 16384);
        bool did = false;
        for (int item = F.vcu; item < NMOD / 32; item += F.G) {
            if (!did) { for (int i = F.tid; i < 4096; i += NTHR) { const float cv = c[i]; cact[i] = cv / (1.0f + __expf(-cv)); } did = true; }
            __syncthreads();
            const int n0 = item * 32, col = n0 + (F.lane & 31), ksub = F.lane >> 5;
            float a0 = 0.f, a1 = 0.f, a2 = 0.f, a3 = 0.f;
#pragma unroll 16
            for (int it = 0; it < 64; ++it) { const int k = (it * 8 + F.wave) * 2 + ksub; const float w = w_ada[(size_t)k * NMOD + col];
                a0 += cact[k] * w; a1 += cact[1024 + k] * w; a2 += cact[2048 + k] * w; a3 += cact[3072 + k] * w; }
            a0 += __shfl_xor(a0, 32); a1 += __shfl_xor(a1, 32); a2 += __shfl_xor(a2, 32); a3 += __shfl_xor(a3, 32);
            if (F.lane < 32) { part[(F.wave * 4 + 0) * 32 + F.lane] = a0; part[(F.wave * 4 + 1) * 32 + F.lane] = a1; part[(F.wave * 4 + 2) * 32 + F.lane] = a2; part[(F.wave * 4 + 3) * 32 + F.lane] = a3; }
            __syncthreads();
            if (F.tid < 128) { const int b = F.tid >> 5, cl = F.tid & 31; float s = 0.f;
#pragma unroll
                for (int w = 0; w < 8; ++w) s += part[(w * 4 + b) * 32 + cl];
                MOD[b * NMOD + n0 + cl] = s + b_ada[n0 + cl]; }
            __syncthreads();
        }
    }
    {
        const int gw = F.vcu * NWAVES + F.wave, NGW = F.G * NWAVES;
        p0_convert(((const float*)karg(14)), (bf16*)(((unsigned char*)karg(19)) + WS_SUBK), (long)(8 * 2 * 128 * 64) / 512, gw, NGW, F.lane);
    }
}
__device__ __forceinline__ void p0_transposes(Frame& F) {
    LAS float* scr = (LAS float*)(F.lds + 32768 + F.wave * 8704);
    const int gw = F.vcu * NWAVES + F.wave, NGW = F.G * NWAVES;
    constexpr int I_IN1 = (D / 64) * (2304 / 32), I_IN2 = (D / 64) * (2048 / 32), I_AB = (512 / 64) * (D / 32), I_SQ = (D / 64) * (D / 32);
    constexpr int NITEMS = I_IN1 + I_IN2 + 2 * I_AB + 2 * I_SQ;
    bf16* Win_t = (bf16*)(((unsigned char*)karg(19)) + WS_WIN);
    for (int it = gw; it < NITEMS; it += NGW) {
        int r = it;
        if (r < I_IN1) { p0_transpose_item(((const float*)karg(6)), LDW_IN, D, 2304, Win_t, 0, scr, r, F.lane); continue; } r -= I_IN1;
        if (r < I_IN2) { p0_transpose_item(((const float*)karg(6)) + 2312, LDW_IN, D, 2048, Win_t, 2304, scr, r, F.lane); continue; } r -= I_IN2;
        if (r < I_AB) { p0_transpose_item(((const float*)karg(9)), D, 512, D, (bf16*)(((unsigned char*)karg(19)) + WS_WA), 0, scr, r, F.lane); continue; } r -= I_AB;
        if (r < I_AB) { p0_transpose_item(((const float*)karg(10)), D, 512, D, (bf16*)(((unsigned char*)karg(19)) + WS_WB), 0, scr, r, F.lane); continue; } r -= I_AB;
        if (r < I_SQ) { p0_transpose_item(((const float*)karg(11)), D, D, D, (bf16*)(((unsigned char*)karg(19)) + WS_WOUT), 0, scr, r, F.lane); continue; } r -= I_SQ;
        p0_transpose_item(((const float*)karg(13)), D, D, D, (bf16*)(((unsigned char*)karg(19)) + WS_WQ), 0, scr, r, F.lane);
    }
}

__device__ __forceinline__ void p1_norm(Frame& F) {
    const float* x = ((const float*)karg(0)); const float* g1 = ((const float*)karg(2)); const float* w_in = ((const float*)karg(6)); const float* b_forget = ((const float*)karg(7));
    const float* MOD = (const float*)(((unsigned char*)karg(19)) + WS_MOD); bf16* H = (bf16*)(((unsigned char*)karg(19)) + WS_H); float* LOGF = (float*)(((unsigned char*)karg(19)) + WS_LOGF);
    LAS float* wfl = (LAS float*)(F.lds);
    { float tmp[16];
#pragma unroll
      for (int n = 0; n < 16; ++n) { const int i = F.tid + n * NTHR; tmp[n] = w_in[(size_t)(i >> 3) * LDW_IN + 2304 + (i & 7)]; }
#pragma unroll
      for (int n = 0; n < 16; ++n) { const int i = F.tid + n * NTHR; wfl[(i & 7) * 1024 + (i >> 3)] = tmp[n]; } }
    __syncthreads();
    const int gw = F.vcu * NWAVES + F.wave, NGW = F.G * NWAVES;
    f32x4 cur[4], nxt[4];
    if (gw < M) { const f32x4* xr = (const f32x4*)(x + (size_t)gw * D) + F.lane;
#pragma unroll
        for (int j = 0; j < 4; ++j) cur[j] = xr[64 * j]; }
    for (int row = gw; row < M; row += NGW) {
        { const int nrow = row + NGW; if (nrow < M) { const f32x4* xr = (const f32x4*)(x + (size_t)nrow * D) + F.lane;
#pragma unroll
            for (int j = 0; j < 4; ++j) nxt[j] = xr[64 * j]; } }
        {{
        float ss = 0.f;
#pragma unroll
        for (int j = 0; j < 4; ++j) ss += (cur[j].x * cur[j].x + cur[j].y * cur[j].y) + (cur[j].z * cur[j].z + cur[j].w * cur[j].w);
        ss = wave_sum(ss);
        const float rstd = 1.0f / sqrtf(ss * (1.0f / D) + EPS);
        const int b = row >> 12; const float* mb = MOD + b * NMOD;
        float fl[8];
#pragma unroll
        for (int jj = 0; jj < 8; ++jj) fl[jj] = 0.f;
#pragma unroll
        for (int j = 0; j < 4; ++j) { const int col = 4 * F.lane + 256 * j;
            const f32x4 g = *(const f32x4*)(g1 + col), sh = *(const f32x4*)(mb + col), sc = *(const f32x4*)(mb + 1024 + col);
            const f32x4 hv = (cur[j] * rstd) * g * (sc + 1.0f) + sh;
            u32x2 w; w.x = cvtpk(hv.x, hv.y); w.y = cvtpk(hv.z, hv.w);
            *(u32x2*)(H + (size_t)row * D + col) = w;
#pragma unroll
            for (int jj = 0; jj < 8; ++jj) { const f32x4 wv = *(const LAS f32x4*)(wfl + jj * 1024 + col); fl[jj] += (hv.x * wv.x + hv.y * wv.y) + (hv.z * wv.z + hv.w * wv.w); }
        }
        const int lane = F.lane; const float r1 = reduce8_t(fl, lane);
        if ((lane & 7) == 0) { const int jj = lane >> 3; const float z = r1 + b_forget[jj]; const float ls = fminf(z, 0.f) - log1pf(__expf(-fabsf(z))); LOGF[(size_t)row * 8 + jj] = ls; }
        }}
#pragma unroll
        for (int j = 0; j < 4; ++j) cur[j] = nxt[j];
    }
}

constexpr int KP = 72;
constexpr int VPF = 68;
constexpr int VPS = 260;
struct FlashState { f32x16 o[2]; float m, l; };

__device__ __forceinline__ void flash_tail(FlashState& st, f32x16& s0, f32x16& s1, const LAS bf16* Vs, int vp, int r32, int hi) {
    float mt = s0[0];
#pragma unroll
    for (int r = 1; r < 16; ++r) mt = fmaxf(mt, s0[r]);
#pragma unroll
    for (int r = 0; r < 16; ++r) mt = fmaxf(mt, s1[r]);
    mt = fmaxf(mt, __uint_as_float(xorx<32>(__float_as_uint(mt), 32 * hi)));
    const float mn = fmaxf(st.m, mt);
    const float alpha = __expf(st.m - mn);
    st.m = mn;
    float ps = 0.f;
#pragma unroll
    for (int r = 0; r < 16; ++r) { s0[r] = __expf(s0[r] - mn); ps += s0[r]; }
#pragma unroll
    for (int r = 0; r < 16; ++r) { s1[r] = __expf(s1[r] - mn); ps += s1[r]; }
    st.l = st.l * alpha + ps;
    if (__any(alpha != 1.0f)) {
#pragma unroll
        for (int r = 0; r < 16; ++r) { st.o[0][r] *= alpha; st.o[1][r] *= alpha; }
    }
#pragma unroll
    for (int blk = 0; blk < 2; ++blk)
#pragma unroll
        for (int s = 0; s < 2; ++s) {
            v4u pw;
            if (blk == 0) { pw.x = cvtpk(s0[8 * s + 0], s0[8 * s + 1]); pw.y = cvtpk(s0[8 * s + 2], s0[8 * s + 3]); pw.z = cvtpk(s0[8 * s + 4], s0[8 * s + 5]); pw.w = cvtpk(s0[8 * s + 6], s0[8 * s + 7]); }
            else          { pw.x = cvtpk(s1[8 * s + 0], s1[8 * s + 1]); pw.y = cvtpk(s1[8 * s + 2], s1[8 * s + 3]); pw.z = cvtpk(s1[8 * s + 4], s1[8 * s + 5]); pw.w = cvtpk(s1[8 * s + 6], s1[8 * s + 7]); }
            const bf16x8 pf = __builtin_bit_cast(bf16x8, pw);
#pragma unroll
            for (int db = 0; db < 2; ++db) {
                const LAS bf16* vp0 = Vs + (32 * db + r32) * vp + 32 * blk + 16 * s + 4 * hi;
                const s16x4 lo = *(const LAS s16x4*)vp0, hh = *(const LAS s16x4*)(vp0 + 8);
                const bf16x8 vf = __builtin_shufflevector(lo, hh, 0, 1, 2, 3, 4, 5, 6, 7);
                st.o[db] = MFMA32(vf, pf, st.o[db]);
            }
        }
}
__device__ __forceinline__ void flash_qk(f32x16& s0, f32x16& s1, const bf16x8 (&qf)[4], const LAS bf16* Ks, int r32, int hi) {
    s0 = (f32x16){0.f}; s1 = (f32x16){0.f};
#pragma unroll
    for (int r = 0; r < 16; ++r) { s0[r] = 0.f; s1[r] = 0.f; }
#pragma unroll
    for (int ks = 0; ks < 4; ++ks) {
        const bf16x8 a0 = *(const LAS bf16x8*)(Ks + r32 * KP + 16 * ks + 8 * hi);
        const bf16x8 a1 = *(const LAS bf16x8*)(Ks + (32 + r32) * KP + 16 * ks + 8 * hi);
        s0 = MFMA32(a0, qf[ks], s0); s1 = MFMA32(a1, qf[ks], s1);
    }
}
__device__ __forceinline__ void flash_qk2(f32x16& a0, f32x16& a1, f32x16& b0, f32x16& b1, const bf16x8 (&qa)[4], const bf16x8 (&qb)[4], const LAS bf16* Ks, int r32, int hi) {
#pragma unroll
    for (int r = 0; r < 16; ++r) { a0[r] = 0.f; a1[r] = 0.f; b0[r] = 0.f; b1[r] = 0.f; }
#pragma unroll
    for (int ks = 0; ks < 4; ++ks) {
        const bf16x8 k0 = *(const LAS bf16x8*)(Ks + r32 * KP + 16 * ks + 8 * hi);
        const bf16x8 k1 = *(const LAS bf16x8*)(Ks + (32 + r32) * KP + 16 * ks + 8 * hi);
        a0 = MFMA32(k0, qa[ks], a0); b0 = MFMA32(k0, qb[ks], b0); a1 = MFMA32(k1, qa[ks], a1); b1 = MFMA32(k1, qb[ks], b1);
    }
}
__device__ __forceinline__ void flash_soft(FlashState& st, f32x16& s0, f32x16& s1, int hi) {
    float mt = s0[0];
#pragma unroll
    for (int r = 1; r < 16; ++r) mt = fmaxf(mt, s0[r]);
#pragma unroll
    for (int r = 0; r < 16; ++r) mt = fmaxf(mt, s1[r]);
    mt = fmaxf(mt, __uint_as_float(xorx<32>(__float_as_uint(mt), 32 * hi)));
    const float mn = fmaxf(st.m, mt);
    const float alpha = __expf(st.m - mn);
    st.m = mn;
    float ps = 0.f;
#pragma unroll
    for (int r = 0; r < 16; ++r) { s0[r] = __expf(s0[r] - mn); ps += s0[r]; }
#pragma unroll
    for (int r = 0; r < 16; ++r) { s1[r] = __expf(s1[r] - mn); ps += s1[r]; }
    st.l = st.l * alpha + ps;
    if (__any(alpha != 1.0f)) {
#pragma unroll
        for (int r = 0; r < 16; ++r) { st.o[0][r] *= alpha; st.o[1][r] *= alpha; }
    }
}
__device__ __forceinline__ bf16x8 pack_p(const f32x16& p, int s) {
    v4u pw; pw.x = cvtpk(p[8 * s + 0], p[8 * s + 1]); pw.y = cvtpk(p[8 * s + 2], p[8 * s + 3]); pw.z = cvtpk(p[8 * s + 4], p[8 * s + 5]); pw.w = cvtpk(p[8 * s + 6], p[8 * s + 7]);
    return __builtin_bit_cast(bf16x8, pw);
}
__device__ __forceinline__ void flash_pv2(FlashState& sa, FlashState& sb, const f32x16& a0, const f32x16& a1, const f32x16& b0, const f32x16& b1, const LAS bf16* Vs, int vp, int r32, int hi) {
#pragma unroll
    for (int blk = 0; blk < 2; ++blk)
#pragma unroll
        for (int s = 0; s < 2; ++s) {
            const bf16x8 pfa = blk ? pack_p(a1, s) : pack_p(a0, s), pfb = blk ? pack_p(b1, s) : pack_p(b0, s);
#pragma unroll
            for (int db = 0; db < 2; ++db) {
                const LAS bf16* vp0 = Vs + (32 * db + r32) * vp + 32 * blk + 16 * s + 4 * hi;
                const s16x4 lo = *(const LAS s16x4*)vp0, hh = *(const LAS s16x4*)(vp0 + 8);
                const bf16x8 vf = __builtin_shufflevector(lo, hh, 0, 1, 2, 3, 4, 5, 6, 7);
                sa.o[db] = MFMA32(vf, pfa, sa.o[db]); sb.o[db] = MFMA32(vf, pfb, sb.o[db]);
            }
        }
}
__device__ __forceinline__ void flash_store(const FlashState& st, bf16* orow, int hi) {
    float lt = st.l + __uint_as_float(xorx<32>(__float_as_uint(st.l), 32 * hi));
    const float inv = 1.0f / lt;
#pragma unroll
    for (int db = 0; db < 2; ++db)
#pragma unroll
        for (int rg = 0; rg < 4; ++rg) { u32x2 w; w.x = cvtpk(st.o[db][4 * rg] * inv, st.o[db][4 * rg + 1] * inv); w.y = cvtpk(st.o[db][4 * rg + 2] * inv, st.o[db][4 * rg + 3] * inv);
            *(u32x2*)(orow + 32 * db + 8 * rg + 4 * hi) = w; }
}

__device__ __forceinline__ void fox_unit(Frame& F, int b, int h, int qb, float& kmax2) {
    const bf16* proj = (const bf16*)(((unsigned char*)karg(19)) + WS_PROJ); const float* LOGF = (const float*)(((unsigned char*)karg(19)) + WS_LOGF); bf16* OB = (bf16*)(((unsigned char*)karg(19)) + WS_OB);
    LAS float* Fs = (LAS float*)(F.lds);
    LAS float* wtot = (LAS float*)(F.lds + 16384);
    LAS bf16* Kb = (LAS bf16*)(F.lds + 16384 + 128);
    LAS bf16* Vb = (LAS bf16*)(F.lds + 16384 + 128 + 2 * 64 * KP * 2);
    const int lane = F.lane, wave = F.wave, tid = F.tid, r32 = lane & 31, hi = lane >> 5;
    const int q_end = 512 * (qb + 1), NT = q_end / 64;
    const size_t rowbase = (size_t)b * SEQ;
    if (kmax2 < 0.f) {
        float v[8]; float run = 0.f;
#pragma unroll
        for (int i = 0; i < 8; ++i) { const int pos = tid * 8 + i; const float lf = (pos < q_end) ? LOGF[(rowbase + pos) * 8 + h] : 0.f; run += lf; v[i] = run; }
        float inc = run;
#pragma unroll
        for (int o = 1; o < 64; o <<= 1) { const float t = __shfl_up(inc, o); if (lane >= o) inc += t; }
        if (lane == 63) wtot[wave] = inc;
        __syncthreads();
        float off = inc - run;
        for (int w = 0; w < wave; ++w) off += wtot[w];
#pragma unroll
        for (int i = 0; i < 8; ++i) Fs[tid * 8 + i] = v[i] + off;
    }
    const int qrow = 512 * qb + 64 * wave + r32, qrowB = qrow + 32;
    bf16x8 qf[4], qg[4];
    { const bf16* qp = proj + (rowbase + qrow) * NPROJ + C_QB + 64 * h + 8 * hi;
#pragma unroll
      for (int ks = 0; ks < 4; ++ks) { qf[ks] = *(const bf16x8*)(qp + 16 * ks); qg[ks] = *(const bf16x8*)(qp + (size_t)32 * NPROJ + 16 * ks); } }
    const int tq = 8 * qb + wave;
    LAS bf16* Qs = (LAS bf16*)(F.lds + 53248) + wave * (64 * KP);
    {
        float qn = 0.f;
#pragma unroll
        for (int ks = 0; ks < 4; ++ks)
#pragma unroll
            for (int j = 0; j < 8; ++j) { const float e = __uint_as_float(((unsigned)(unsigned short)qf[ks][j]) << 16); qn += e * e; }
        qn += __shfl_xor(qn, 32);
        { float qn2 = 0.f;
#pragma unroll
          for (int ks = 0; ks < 4; ++ks)
#pragma unroll
              for (int j = 0; j < 8; ++j) { const float e = __uint_as_float(((unsigned)(unsigned short)qg[ks][j]) << 16); qn2 += e * e; }
          qn2 += __shfl_xor(qn2, 32); qn = fmaxf(qn, qn2); }
#pragma unroll
        for (int o = 1; o < 32; o <<= 1) qn = fmaxf(qn, __shfl_xor(qn, o));
        float kn = 0.f;
        if (kmax2 < 0.f) {
            for (int p0 = 0; p0 < q_end; p0 += 4 * 64) {
                v4u w4[4];
#pragma unroll
                for (int i = 0; i < 4; ++i) w4[i] = *(const v4u*)(proj + (rowbase + p0 + 64 * i + (tid >> 3)) * NPROJ + C_KB + 64 * h + 8 * (tid & 7));
#pragma unroll
                for (int i = 0; i < 4; ++i) { const unsigned wx = w4[i].x, wy = w4[i].y, wz = w4[i].z, ww = w4[i].w;
                    float s = bflo(wx) * bflo(wx) + bfhi(wx) * bfhi(wx) + bflo(wy) * bflo(wy) + bfhi(wy) * bfhi(wy) + bflo(wz) * bflo(wz) + bfhi(wz) * bfhi(wz) + bflo(ww) * bflo(ww) + bfhi(ww) * bfhi(ww);
                    s += __shfl_xor(s, 1); s += __shfl_xor(s, 2); s += __shfl_xor(s, 4);
                    kn = fmaxf(kn, s); } }
            kn = wave_max(kn);
        }
        if (lane == 0) { wtot[8 + wave] = qn; wtot[16 + wave] = kn; }
    }
#pragma unroll
    for (int ks = 0; ks < 4; ++ks) { *(LAS bf16x8*)(Qs + r32 * KP + 16 * ks + 8 * hi) = qf[ks]; *(LAS bf16x8*)(Qs + (32 + r32) * KP + 16 * ks + 8 * hi) = qg[ks]; }
    FlashState st, su; st.m = -INFINITY; st.l = 0.f; su.m = -INFINITY; su.l = 0.f;
#pragma unroll
    for (int r = 0; r < 16; ++r) { st.o[0][r] = 0.f; st.o[1][r] = 0.f; su.o[0][r] = 0.f; su.o[1][r] = 0.f; }
    const int srow = tid >> 3, sch = tid & 7;
    const bf16* kg = proj + (rowbase + srow) * NPROJ + C_KB + 64 * h + 8 * sch;
    const bf16* vg = proj + (rowbase + srow) * NPROJ + C_VB + 64 * h + 8 * sch;
    v4u kreg, vreg;
    { const size_t o = (size_t)(NT - 1) * 64 * NPROJ; kreg = *(const v4u*)(kg + o); vreg = *(const v4u*)(vg + o); }
    int cur = 0;
    {   *(LAS v4u*)(Kb + srow * KP + 8 * sch) = kreg;
        const unsigned short* vs = (const unsigned short*)&vreg;
#pragma unroll
        for (int i = 0; i < 8; ++i) Vb[(8 * sch + i) * VPF + srow] = vs[i];
    }
    __syncthreads();
    const float fq = Fs[qrow], fqB = Fs[qrowB];
    int t_lo = 0;
    {
        float qm = 0.f, km = 0.f;
#pragma unroll
        for (int w = 0; w < 8; ++w) { qm = fmaxf(qm, wtot[8 + w]); km = fmaxf(km, wtot[16 + w]); }
        if (kmax2 < 0.f) kmax2 = km;
        const float A = 0.125f * sqrtf(qm) * sqrtf(kmax2) * 1.01f, f0 = Fs[512 * qb];
        for (int t = NT - 9; t >= 0; --t) if (Fs[64 * t + 63] - f0 > 2.0f * A + 60.0f) { t_lo = t + 1; break; }
    }
    for (int t = NT - 1; t >= t_lo; --t) {
        if (t > t_lo) { const size_t o = (size_t)(t - 1) * 64 * NPROJ; kreg = *(const v4u*)(kg + o); vreg = *(const v4u*)(vg + o); }
        if (t <= tq) {
            const LAS bf16* Ks = Kb + cur * 64 * KP; const LAS bf16* Vs = Vb + cur * 64 * VPF;
            bf16x8 qa[4], qb4[4];
#pragma unroll
            for (int ks = 0; ks < 4; ++ks) { qa[ks] = *(const LAS bf16x8*)(Qs + r32 * KP + 16 * ks + 8 * hi); qb4[ks] = *(const LAS bf16x8*)(Qs + (32 + r32) * KP + 16 * ks + 8 * hi); }
            f32x16 s0, s1, u0, u1; flash_qk2(s0, s1, u0, u1, qa, qb4, Ks, r32, hi);
            const LAS float* Fk = Fs + 64 * t;
            const bool diag = (t == tq);
#pragma unroll
            for (int rg = 0; rg < 4; ++rg) {
                const f32x4 f0 = *(const LAS f32x4*)(Fk + 8 * rg + 4 * hi), f1 = *(const LAS f32x4*)(Fk + 32 + 8 * rg + 4 * hi);
#pragma unroll
                for (int i = 0; i < 4; ++i) { const int r = 4 * rg + i; const int kv = 64 * t + 8 * rg + 4 * hi + i;
                    float a = s0[r] * 0.125f + (fq - f0[i]), c = s1[r] * 0.125f + (fq - f1[i]), d = u0[r] * 0.125f + (fqB - f0[i]), e = u1[r] * 0.125f + (fqB - f1[i]);
                    if (diag) { if (kv > qrow) a = -INFINITY; if (kv + 32 > qrow) c = -INFINITY; if (kv > qrowB) d = -INFINITY; if (kv + 32 > qrowB) e = -INFINITY; }
                    s0[r] = a; s1[r] = c; u0[r] = d; u1[r] = e; }
            }
            flash_soft(st, s0, s1, hi); flash_soft(su, u0, u1, hi);
            flash_pv2(st, su, s0, s1, u0, u1, Vs, VPF, r32, hi);
        }
        if (t > t_lo) {
            const int nb = cur ^ 1;
            *(LAS v4u*)(Kb + nb * 64 * KP + srow * KP + 8 * sch) = kreg;
            const unsigned short* vs = (const unsigned short*)&vreg;
#pragma unroll
            for (int i = 0; i < 8; ++i) Vb[nb * 64 * VPF + (8 * sch + i) * VPF + srow] = vs[i];
        }
        __syncthreads();
        cur ^= 1;
    }
    flash_store(st, OB + (rowbase + qrow) * 512 + 64 * h, hi); flash_store(su, OB + (rowbase + qrowB) * 512 + 64 * h, hi);
    __syncthreads();
}

__device__ const unsigned char T5_BUCKET[128] = {0,1,2,3,4,5,6,7,8,9,10,11,12,13,14,15,16,16,16,17,17,18,18,18,19,19,19,20,20,20,20,21,21,21,21,22,22,22,22,22,23,23,23,23,23,23,24,24,24,24,24,24,25,25,25,25,25,25,25,26,26,26,26,26,26,26,26,27,27,27,27,27,27,27,27,27,27,28,28,28,28,28,28,28,28,28,28,29,29,29,29,29,29,29,29,29,29,29,29,30,30,30,30,30,30,30,30,30,30,30,30,30,30,31,31,31,31,31,31,31,31,31,31,31,31,31,31,31};

__device__ __forceinline__ void swa_unit(Frame& F, int b, int kvh, int n) {
    const bf16* proj = (const bf16*)(((unsigned char*)karg(19)) + WS_PROJ); bf16* OA = (bf16*)(((unsigned char*)karg(19)) + WS_OA);
    const float* sinks = ((const float*)karg(8)); const float* rel_bias = ((const float*)karg(12));
    LAS bf16* Kb = (LAS bf16*)(F.lds);
    LAS bf16* Vb = (LAS bf16*)(F.lds + 36864);
    LAS float* bt = (LAS float*)(F.lds + 36864 + 33280);
    const int lane = F.lane, wave = F.wave, tid = F.tid, r32 = lane & 31, hi = lane >> 5;
    const size_t rowbase = (size_t)b * SEQ;
    {
        const int g = tid >> 7, d = tid & 127;
        bt[tid] = rel_bias[(int)T5_BUCKET[d] * 8 + kvh * 4 + g];
#pragma unroll
        for (int i = 0; i < 4; ++i) {
            const int idx = tid + i * NTHR, kb = idx >> 3, sch = idx & 7; const int pos = 128 * (n - 1) + kb;
            v4u kreg = (v4u){0u, 0u, 0u, 0u}, vreg = (v4u){0u, 0u, 0u, 0u};
            if (pos >= 0) { const bf16* p = proj + (rowbase + pos) * NPROJ + 64 * kvh + 8 * sch; kreg = *(const v4u*)(p + C_KA); vreg = *(const v4u*)(p + C_VA); }
            *(LAS v4u*)(Kb + kb * KP + 8 * sch) = kreg;
            const unsigned short* vs = (const unsigned short*)&vreg;
#pragma unroll
            for (int j = 0; j < 8; ++j) Vb[(8 * sch + j) * VPS + kb] = vs[j];
        }
    }
    __syncthreads();
    const int g = wave & 3, qh = wave >> 2, head = kvh * 4 + g;
    const LAS float* btg = bt + g * 128;
    for (int sb = 0; sb < 2; ++sb) {
        const int qrel0 = 64 * qh + 32 * sb, qrel = qrel0 + r32;
        const size_t row = rowbase + 128 * n + qrel;
        bf16x8 qf[4];
        { const bf16* qp = proj + row * NPROJ + C_QA + 64 * head + 8 * hi;
#pragma unroll
          for (int ks = 0; ks < 4; ++ks) qf[ks] = *(const bf16x8*)(qp + 16 * ks); }
        FlashState st; st.m = sinks[head]; st.l = (hi == 0) ? 1.0f : 0.0f;
#pragma unroll
        for (int r = 0; r < 16; ++r) { st.o[0][r] = 0.f; st.o[1][r] = 0.f; }
        const int t_lo = (qrel0 + 1) >> 6, t_hi = (qrel0 + 159) >> 6;
        for (int t = t_lo; t <= t_hi; ++t) {
            f32x16 s0, s1; flash_qk(s0, s1, qf, Kb + t * 64 * KP, r32, hi);
#pragma unroll
            for (int r = 0; r < 16; ++r) {
                const int kb0 = 64 * t + crow(r, hi), kb1 = kb0 + 32;
                const int d0 = 128 + qrel - kb0, d1 = d0 - 32;
                const bool v0 = (d0 >= 0) && (d0 < 128) && (n > 0 || kb0 >= 128);
                const bool v1 = (d1 >= 0) && (d1 < 128) && (n > 0 || kb1 >= 128);
                const float b0 = btg[d0 & 127], b1 = btg[d1 & 127];
                s0[r] = v0 ? (s0[r] * 0.125f + b0) : -INFINITY;
                s1[r] = v1 ? (s1[r] * 0.125f + b1) : -INFINITY;
            }
            flash_tail(st, s0, s1, Vb + 64 * t, VPS, r32, hi);
        }
        flash_store(st, OA + row * 512 + 64 * head, hi);
    }
    __syncthreads();
}
__device__ __forceinline__ void p3_attention(Frame& F) {
    for (int item = F.vcu; item < 256; item += F.G) {
        swa_unit(F, item >> 6, (item >> 5) & 1, item & 31);
        const int bh = item >> 3, j = item & 7;
        float kmax2 = -1.0f;
        fox_unit(F, bh >> 3, bh & 7, j, kmax2);
    }
}

struct PairOrder {
    pg8::StaticOrder S;
    __device__ bool next(int i, pg8::Unit& u) const { if (!S.next(i >> 1, u)) return false; u.src = i & 1; return true; }
    __device__ __forceinline__ void a_ready(const pg8::Unit&) const {}
    __device__ __forceinline__ void done(const pg8::Unit&) const {}
};
__device__ __forceinline__ float sigmoidf_(float z) { return 1.0f / (1.0f + __expf(-z)); }
struct EpiGate {
    static constexpr bool PERM = true, AFTER_DRAIN = false, CHAIN = true;
    const bf16* proj; bf16* mixed;
    __device__ __forceinline__ void operator()(pg8::f32x4 (&acc)[2][2][4][2], const pg8::Unit& u, int wr, int wc, int fr, int fq) const {
#pragma unroll
        for (int ai = 0; ai < 2; ++ai)
#pragma unroll
            for (int m = 0; m < 4; ++m) { const size_t row = (size_t)u.pm * 256 + ai * 128 + wr * 64 + m * 16 + fr;
#pragma unroll
                for (int bj = 0; bj < 2; ++bj) { const int col0 = u.pn * 256 + bj * 128 + wc * 32 + 8 * fq;
                    const v4u gb = *(const v4u*)(proj + row * NPROJ + C_GLB + col0);
                    const unsigned gbw[4] = {gb.x, gb.y, gb.z, gb.w};
                    if (u.src == 0) {
                        const v4u ga = *(const v4u*)(proj + row * NPROJ + C_GLA + col0);
                        const unsigned gaw[4] = {ga.x, ga.y, ga.z, ga.w};
#pragma unroll
                        for (int e = 0; e < 8; ++e) { const float za = (e & 1) ? bfhi(gaw[e >> 1]) : bflo(gaw[e >> 1]), zb = (e & 1) ? bfhi(gbw[e >> 1]) : bflo(gbw[e >> 1]);
                            const float ratio = (1.0f + __expf(-zb)) * __builtin_amdgcn_rcpf(1.0f + __expf(-za));
                            acc[ai][bj][m][e >> 2][e & 3] *= ratio; }
                    } else {
                        float v[8];
#pragma unroll
                        for (int e = 0; e < 8; ++e) { const float zb = (e & 1) ? bfhi(gbw[e >> 1]) : bflo(gbw[e >> 1]); v[e] = acc[ai][bj][m][e >> 2][e & 3] * __builtin_amdgcn_rcpf(1.0f + __expf(-zb)); }
                        v4u w; w.x = cvtpk(v[0], v[1]); w.y = cvtpk(v[2], v[3]); w.z = cvtpk(v[4], v[5]); w.w = cvtpk(v[6], v[7]);
                        *(v4u*)(mixed + row * D + col0) = w;
                    }
                }
            }
    }
};
struct EpiRes {
    static constexpr bool PERM = true, AFTER_DRAIN = false, CHAIN = false;
    const float* x; const float* mod; float* x1;
    __device__ __forceinline__ void operator()(const pg8::f32x4 (&acc)[2][2][4][2], const pg8::Unit& u, int wr, int wc, int fr, int fq) const {
#pragma unroll
        for (int ai = 0; ai < 2; ++ai)
#pragma unroll
            for (int m = 0; m < 4; ++m) { const size_t row = (size_t)u.pm * 256 + ai * 128 + wr * 64 + m * 16 + fr; const int b = (int)(row >> 12);
#pragma unroll
                for (int bj = 0; bj < 2; ++bj) { const int col0 = u.pn * 256 + bj * 128 + wc * 32 + 8 * fq;
#pragma unroll
                    for (int n = 0; n < 2; ++n) { const int col = col0 + 4 * n;
                        const pg8::f32x4 xin = *(const pg8::f32x4*)(x + row * D + col), gt = *(const pg8::f32x4*)(mod + b * NMOD + 2048 + col);
                        *(pg8::f32x4*)(x1 + row * D + col) = xin + gt * acc[ai][bj][m][n]; } }
            }
    }
};

__device__ __forceinline__ void p6_norm2(Frame& F) {
    const float* x1 = (const float*)(((unsigned char*)karg(19)) + WS_X1); const float* g2 = ((const float*)karg(3)); const float* MOD = (const float*)(((unsigned char*)karg(19)) + WS_MOD); bf16* H2 = (bf16*)(((unsigned char*)karg(19)) + WS_H2); unsigned char* H2Q = (unsigned char*)(((unsigned char*)karg(19)) + WS_H2Q); float* H2S = (float*)(((unsigned char*)karg(19)) + WS_H2S);
    const int gw = F.vcu * NWAVES + F.wave, NGW = F.G * NWAVES;
    f32x4 cur[4], nxt[4];
    if (gw < M) { const f32x4* xr = (const f32x4*)(x1 + (size_t)gw * D) + F.lane;
#pragma unroll
        for (int j = 0; j < 4; ++j) cur[j] = xr[64 * j]; }
    for (int row = gw; row < M; row += NGW) {
        { const int nrow = row + NGW; if (nrow < M) { const f32x4* xr = (const f32x4*)(x1 + (size_t)nrow * D) + F.lane;
#pragma unroll
            for (int j = 0; j < 4; ++j) nxt[j] = xr[64 * j]; } }
        {
        f32x4 v[4], hq[4]; float ss = 0.f;
#pragma unroll
        for (int j = 0; j < 4; ++j) { v[j] = cur[j]; ss += (v[j].x * v[j].x + v[j].y * v[j].y) + (v[j].z * v[j].z + v[j].w * v[j].w); }
        ss = wave_sum(ss);
        const float rstd = 1.0f / sqrtf(ss * (1.0f / D) + EPS);
        const int b = row >> 12; const float* mb = MOD + b * NMOD;
#pragma unroll
        for (int j = 0; j < 4; ++j) { const int col = 4 * F.lane + 256 * j;
            const f32x4 g = *(const f32x4*)(g2 + col), sh = *(const f32x4*)(mb + 3072 + col), sc = *(const f32x4*)(mb + 4096 + col);
            const f32x4 hv = (v[j] * rstd) * g * (sc + 1.0f) + sh;
            u32x2 w; w.x = cvtpk(hv.x, hv.y); w.y = cvtpk(hv.z, hv.w);
            *(u32x2*)(H2 + (size_t)row * D + col) = w; hq[j] = hv; }
        float am = 0.f;
#pragma unroll
        for (int j = 0; j < 4; ++j) am = fmaxf(fmaxf(am, fmaxf(fabsf(hq[j].x), fabsf(hq[j].y))), fmaxf(fabsf(hq[j].z), fabsf(hq[j].w)));
        am = wave_max(am);
        const float sc = am > 0.f ? am * (1.0f / 127.0f) : 1.0f, inv = 1.0f / sc;
        v4u qa;
#pragma unroll
        for (int j = 0; j < 4; ++j) { const int b0 = (int)rintf(hq[j].x * inv), b1 = (int)rintf(hq[j].y * inv), b2 = (int)rintf(hq[j].z * inv), b3 = (int)rintf(hq[j].w * inv);
            qa[j] = (unsigned)(b0 & 255) | ((unsigned)(b1 & 255) << 8) | ((unsigned)(b2 & 255) << 16) | ((unsigned)(b3 & 255) << 24); }
        *(v4u*)(H2Q + (size_t)row * D + 16 * F.lane) = qa;
        if (F.lane == 0) H2S[row] = sc;
        }
#pragma unroll
        for (int j = 0; j < 4; ++j) cur[j] = nxt[j];
    }
}

__device__ __forceinline__ unsigned f2ord(float f) { const unsigned u = __float_as_uint(f); return u ^ ((unsigned)((int)u >> 31) | 0x80000000u); }
__device__ __forceinline__ float ord2f(unsigned o) { const unsigned u = (o & 0x80000000u) ? (o & 0x7fffffffu) : ~o; return __uint_as_float(u); }
#define CE_DESC(a, b) do { const unsigned _x = (a), _y = (b); (a) = _x > _y ? _x : _y; (b) = _x > _y ? _y : _x; } while (0)
__device__ __forceinline__ void sort16(unsigned (&k)[16]) {
#pragma unroll
    for (int size = 2; size <= 16; size <<= 1)
#pragma unroll
        for (int stride = size >> 1; stride > 0; stride >>= 1)
#pragma unroll
            for (int i = 0; i < 16; ++i) { const int j = i ^ stride; if (j > i) { if ((i & size) == 0) CE_DESC(k[i], k[j]); else CE_DESC(k[j], k[i]); } }
}
__device__ __forceinline__ void merge16(unsigned (&a)[16], const unsigned (&b)[16]) {
#pragma unroll
    for (int i = 0; i < 16; ++i) a[i] = a[i] > b[15 - i] ? a[i] : b[15 - i];
#pragma unroll
    for (int stride = 8; stride > 0; stride >>= 1)
#pragma unroll
        for (int i = 0; i < 16; ++i) { const int j = i ^ stride; if (j > i) CE_DESC(a[i], a[j]); }
}
__device__ __forceinline__ void top16_of_64(unsigned (&g0)[16], unsigned (&g1)[16], unsigned (&g2)[16], unsigned (&g3)[16]) {
    sort16(g0); sort16(g1); sort16(g2); sort16(g3);
    merge16(g0, g1); merge16(g2, g3); merge16(g0, g2);
}
constexpr int NCAND = 50;
__device__ __forceinline__ void p8a_topk(Frame& F) {
    const bf16* QP = (const bf16*)(((unsigned char*)karg(19)) + WS_QP); const bf16* SUBK = (const bf16*)(((unsigned char*)karg(19)) + WS_SUBK);
    unsigned short* PIDX = (unsigned short*)(((unsigned char*)karg(19)) + WS_PIDX); float* PG = (float*)(((unsigned char*)karg(19)) + WS_PG);
    LAS unsigned short* Elds = (LAS unsigned short*)(F.lds) + F.wave * (NCAND * 64);
    const int lane = F.lane, r32 = lane & 31, hi = lane >> 5;
    const int gw = F.vcu * NWAVES + F.wave, NGW = F.G * NWAVES;
    for (int it2 = 0; it2 < 2 * ((M / 64 - F.vcu + F.G - 1) / F.G); ++it2) {
        const int wi = F.vcu + (it2 >> 1) * F.G;
        const int tile = 2 * wi + (it2 & 1);
        const int tok = tile * 32 + r32;
        { const int h = F.wave;
            unsigned top[2][16];
#pragma unroll
            for (int p = 0; p < 2; ++p) {
                bf16x8 qf[4];
                { const bf16* qp = QP + (size_t)tok * D + h * 128 + p * 64 + 8 * hi;
#pragma unroll
                  for (int ks = 0; ks < 4; ++ks) qf[ks] = *(const bf16x8*)(qp + 16 * ks); }
                const bf16* kp = SUBK + (size_t)((h * 2 + p) * 128 + r32) * 64 + 8 * hi;
                unsigned kk[4][16];
#pragma unroll
                for (int blk = 0; blk < 4; ++blk) {
                    f32x16 acc;
#pragma unroll
                    for (int r = 0; r < 16; ++r) acc[r] = 0.f;
#pragma unroll
                    for (int ks = 0; ks < 4; ++ks) { const bf16x8 a = *(const bf16x8*)(kp + (size_t)blk * 32 * 64 + 16 * ks); acc = MFMA32(a, qf[ks], acc); }
#pragma unroll
                    for (int r = 0; r < 16; ++r) { const int key = 32 * blk + crow(r, hi); kk[blk][r] = (f2ord(acc[r]) & ~127u) | (unsigned)(127 - key); }
                }
                top16_of_64(kk[0], kk[1], kk[2], kk[3]);
                unsigned other[16];
#pragma unroll
                for (int i = 0; i < 16; ++i) other[i] = xorx<32>(kk[0][i], lane);
                merge16(kk[0], other);
#pragma unroll
                for (int i = 0; i < 16; ++i) top[p][i] = kk[0][i];
            }
            float s1[16], s2[16]; unsigned i1[16], i2[16];
#pragma unroll
            for (int i = 0; i < 16; ++i) { s1[i] = ord2f(top[0][i] & ~127u); i1[i] = 127u - (top[0][i] & 127u); s2[i] = ord2f(top[1][i] & ~127u); i2[i] = 127u - (top[1][i] & 127u); }
            unsigned ck[4][16];
#pragma unroll
            for (int c = 0; c < 64; ++c) {
                if (c < NCAND) { constexpr int CA[NCAND] = {0,0,0,0,0,0,0,0,0,0,0,0,0,0,0,0,1,1,1,1,1,1,1,1,2,2,2,2,2,3,3,3,3,4,4,4,5,5,6,6,7,7,8,9,10,11,12,13,14,15}; constexpr int CB[NCAND] = {0,1,2,3,4,5,6,7,8,9,10,11,12,13,14,15,0,1,2,3,4,5,6,7,0,1,2,3,4,0,1,2,3,0,1,2,0,1,0,1,0,1,0,0,0,0,0,0,0,0}; const int a = CA[c], b = CB[c];
                    ck[c >> 4][c & 15] = (f2ord(s1[a] + s2[b]) & ~63u) | (unsigned)(63 - c);
                    Elds[c * 64 + lane] = (unsigned short)(i1[a] * 128u + i2[b]); }
                else ck[c >> 4][c & 15] = 0u;
            }
            top16_of_64(ck[0], ck[1], ck[2], ck[3]);
            float w[16]; float wsum = 0.f; const float v0 = ord2f(ck[0][0] & ~63u);
#pragma unroll
            for (int r = 0; r < 16; ++r) { w[r] = __expf(ord2f(ck[0][r] & ~63u) - v0); wsum += w[r]; }
            const float winv = 1.0f / wsum;
#pragma unroll
            for (int r = 0; r < 16; ++r) if ((r >> 3) == hi) {
                const int c = 63 - (int)(ck[0][r] & 63u);
                const unsigned short eid = Elds[c * 64 + lane];
                PIDX[(size_t)tok * 128 + h * 16 + r] = eid; PG[(size_t)tok * 128 + h * 16 + r] = w[r] * winv; }
        }
    }
}

__device__ __forceinline__ float gelu_erf(float v) { return 0.5f * v * (1.0f + erff(v * 0.70710678118654752f)); }

#define PROBE_REPA 1
#define PROBE_REPB 1
constexpr int NR = 8, RSH = 18, BSA = 8, BSB = 8, ELP = 136, TPS = 8;
__device__ __forceinline__ void sort128(unsigned& e0, unsigned& e1, int lane) {
#pragma unroll
    for (int size = 2; size <= 128; size <<= 1) {
#pragma unroll
        for (int stride = size >> 1; stride > 0; stride >>= 1) {
            if (stride == 64) { const unsigned lo = e0 < e1 ? e0 : e1, hi = e0 < e1 ? e1 : e0; e0 = lo; e1 = hi; }
            else {
                const bool lower = (lane & stride) == 0;
                const bool asc0 = (size == 128) ? true : (size == 64 ? true : ((lane & size) == 0));
                const bool asc1 = (size == 128) ? true : (size == 64 ? false : ((lane & size) == 0));
                const unsigned p0 = xorx_sw(e0, lane, stride), p1 = xorx_sw(e1, lane, stride);
                const unsigned mn0 = e0 < p0 ? e0 : p0, mx0 = e0 < p0 ? p0 : e0, mn1 = e1 < p1 ? e1 : p1, mx1 = e1 < p1 ? p1 : e1;
                e0 = (lower == asc0) ? mn0 : mx0; e1 = (lower == asc1) ? mn1 : mx1;
            }
        }
    }
}
template <int BS> __device__ __forceinline__ void sw_issue(v4u (&buf)[BS], const LAS unsigned* el, const unsigned char* tab, unsigned voff) {
#pragma unroll
    for (int i = 0; i < BS; ++i) { const unsigned off = (el[i] << 10) + voff;
        buf[i] = *(const v4u*)(tab + off); }
}
template <int BS> __device__ __forceinline__ void sw_proc_a(const v4u (&buf)[BS], const v4u& hq, LAS float* wl, int s, int n, int lane) {
    const int hx = (int)hq.x, hy = (int)hq.y, hz = (int)hq.z, hw = (int)hq.w;
    float dd[8];
#pragma unroll
    for (int i = 0; i < 8; ++i) dd[i] = 0.f;
#pragma unroll
    for (int i = 0; i < BS; ++i) if (i < n) { const int dx = (int)buf[i].x, dy = (int)buf[i].y, dz = (int)buf[i].z, dw = (int)buf[i].w;
        int t = __builtin_amdgcn_sdot4(hx, dx, 0, false); t = __builtin_amdgcn_sdot4(hy, dy, t, false); t = __builtin_amdgcn_sdot4(hz, dz, t, false); t = __builtin_amdgcn_sdot4(hw, dw, t, false);
        dd[i] = (float)t; }
    const float r1 = reduce8_t(dd, lane);
    if ((lane & 7) == 0 && (lane >> 3) < n) wl[s + (lane >> 3)] = r1;
}
template <int BS> __device__ __forceinline__ void sw_proc_b(const v4u (&buf)[BS], f32x2_t (&acc)[8], const LAS float* wl, int s, int n) {
    float wr[BS];
#pragma unroll
    for (int i = 0; i < BS; ++i) wr[i] = wl[s + i];
#pragma unroll
    for (int i = 0; i < BS; ++i) if (i < n) {
        const float w = wr[i];
        const f32x2_t wv = {w, w};
        const unsigned ux = buf[i].x, uy = buf[i].y, uz = buf[i].z, uw = buf[i].w;
        acc[0] += wv * __builtin_amdgcn_cvt_pk_f32_fp8((int)ux, false); acc[1] += wv * __builtin_amdgcn_cvt_pk_f32_fp8((int)ux, true);
        acc[2] += wv * __builtin_amdgcn_cvt_pk_f32_fp8((int)uy, false); acc[3] += wv * __builtin_amdgcn_cvt_pk_f32_fp8((int)uy, true);
        acc[4] += wv * __builtin_amdgcn_cvt_pk_f32_fp8((int)uz, false); acc[5] += wv * __builtin_amdgcn_cvt_pk_f32_fp8((int)uz, true);
        acc[6] += wv * __builtin_amdgcn_cvt_pk_f32_fp8((int)uw, false); acc[7] += wv * __builtin_amdgcn_cvt_pk_f32_fp8((int)uw, true); }
}
__device__ __forceinline__ void sw_warm(v4u (&pf)[4], const unsigned char* tab, int range, int lw, unsigned voff) {
#pragma unroll
    for (int i = 0; i < 4; ++i) { const unsigned off = ((unsigned)(range * 1024 + lw * 4 + i) << 10) + voff; pf[i] = *(const v4u*)(tab + off); }
}
__device__ __forceinline__ void sw_warm_done(const v4u (&pf)[4]) {
#pragma unroll
    for (int i = 0; i < 4; ++i) asm volatile("" :: "v"(pf[i]));
}
template <int FAKE> __device__ __forceinline__ void p8b_sweep(Frame& F) {
    const float* X1 = (const float*)(((unsigned char*)karg(19)) + WS_X1); const float* MOD = (const float*)(((unsigned char*)karg(19)) + WS_MOD);
    const unsigned char* H2Q = (const unsigned char*)(((unsigned char*)karg(19)) + WS_H2Q); const float* H2S = (const float*)(((unsigned char*)karg(19)) + WS_H2S);
    const unsigned char* EDq = (const unsigned char*)(((unsigned char*)karg(19)) + WS_ED); const unsigned char* EUq = (const unsigned char*)(((unsigned char*)karg(19)) + WS_EU); const float* EDS = (const float*)(((unsigned char*)karg(19)) + WS_EDS);
    const unsigned short* PIDX = (const unsigned short*)(((unsigned char*)karg(19)) + WS_PIDX); const float* PG = (const float*)(((unsigned char*)karg(19)) + WS_PG);
    const float* fg = ((const float*)karg(17));
    const int gw = F.vcu * NWAVES + F.wave, NGW = F.G * NWAVES;
    for (int wi = F.vcu; wi < M / 64; wi += F.G) {
        const int tb = wi * 8 + F.wave;
        unsigned ones = ~0u; asm volatile("" : "+s"(ones));
        int lane = (int)__builtin_amdgcn_mbcnt_hi(ones, __builtin_amdgcn_mbcnt_lo(ones, 0u)); asm volatile("" : "+v"(lane));
        const int tok0 = tb * 8;
        unsigned E0[8], E1[8];
        LAS float* Wl = (LAS float*)(F.lds) + F.wave * 1024;
        LAS unsigned* El = (LAS unsigned*)(F.lds + 32768) + F.wave * (8 * ELP);
        unsigned voff = 16u * (unsigned)lane; asm volatile("" : "+v"(voff));
        LAS int* Bnd = (LAS int*)(F.lds + 67584) + F.wave * (8 * (NR + 1));
#pragma unroll
        for (int k = 0; k < 8; ++k) {
            const size_t base = (size_t)(tok0 + k) * 128;
            E0[k] = ((unsigned)PIDX[base + lane] << 7) | (unsigned)lane; E1[k] = ((unsigned)PIDX[base + 64 + lane] << 7) | (unsigned)(64 + lane);
            sort128(E0[k], E1[k], lane);
            if (FAKE) { E0[k] = (E0[k] & 0x1ffffu) ; E1[k] = (E1[k] & 0x1ffffu); sort128(E0[k], E1[k], lane); }
            El[k * ELP + lane] = E0[k] >> 7; El[k * ELP + 64 + lane] = E1[k] >> 7;
            if (lane < 8) El[k * ELP + 128 + lane] = (unsigned)__builtin_amdgcn_readlane((int)E1[k], 63) >> 7;
        }
        for (int repa = 0; repa < PROBE_REPA; ++repa) {
            v4u hq[8];
#pragma unroll
            for (int k = 0; k < 8; ++k) hq[k] = *(const v4u*)(H2Q + (size_t)(tok0 + k) * D + 16 * lane);
            int pos[8];
#pragma unroll
            for (int k = 0; k < 8; ++k) pos[k] = 0;
            v4u bA[BSA], bB[BSA], bC[BSA]; int ps = 0, pn = 0;
            for (int r = 0; r < NR; ++r) {
#pragma unroll
                for (int k = 0; k < 8; ++k) {
                    constexpr int dummy = 0; (void)dummy;
                    const int kp = (k + 7) & 7;
                    const int c = __builtin_popcountll(__ballot((E0[k] >> RSH) == (unsigned)r)) + __builtin_popcountll(__ballot((E1[k] >> RSH) == (unsigned)r));
                    int s = __builtin_amdgcn_readfirstlane(pos[k]); const int e_end = __builtin_amdgcn_readfirstlane(s + c); pos[k] = e_end;
                    if (lane == 0) Bnd[k * (NR + 1) + r + 1] = e_end;
                    const int n1 = (e_end - s) < BSA ? (e_end - s) : BSA;
                    if (k & 1) sw_issue<BSA>(bB, El + k * ELP + s, EDq, voff); else sw_issue<BSA>(bA, El + k * ELP + s, EDq, voff);
                    if (pn > 0) { if (k & 1) sw_proc_a<BSA>(bA, hq[kp], Wl + kp * 128, ps, pn, lane); else sw_proc_a<BSA>(bB, hq[kp], Wl + kp * 128, ps, pn, lane); }
                    ps = s; pn = n1; s += n1;
#define SWA_REST(Y) if (s < e_end) { sw_issue<BSA>(Y, El + k * ELP + s, EDq, voff); \
                        for (;;) { int n = (e_end - s) < BSA ? (e_end - s) : BSA; \
                            if (s + BSA < e_end) { sw_issue<BSA>(bC, El + k * ELP + s + BSA, EDq, voff); sw_proc_a<BSA>(Y, hq[k], Wl + k * 128, s, n, lane); } else { sw_proc_a<BSA>(Y, hq[k], Wl + k * 128, s, n, lane); break; } \
                            s += BSA; n = (e_end - s) < BSA ? (e_end - s) : BSA; \
                            if (s + BSA < e_end) { sw_issue<BSA>(Y, El + k * ELP + s + BSA, EDq, voff); sw_proc_a<BSA>(bC, hq[k], Wl + k * 128, s, n, lane); } else { sw_proc_a<BSA>(bC, hq[k], Wl + k * 128, s, n, lane); break; } \
                            s += BSA; } }
                    if (k & 1) { SWA_REST(bA) } else { SWA_REST(bB) }
#undef SWA_REST
                }
            }
            if (pn > 0) sw_proc_a<BSA>(bB, hq[7], Wl + 7 * 128, ps, pn, lane);
        }
#pragma unroll
        for (int k = 0; k < 8; ++k) { int tk = tok0 + k; asm volatile("" : "+s"(tk)); const size_t base = (size_t)tk * 128; const float sh = H2S[tk];
            const float r0 = Wl[k * 128 + lane], r1 = Wl[k * 128 + 64 + lane];
            Wl[k * 128 + lane] = PG[base + (E0[k] & 127u)] * gelu_erf(r0 * sh * EDS[E0[k] >> 7]) * 0.0625f;
            Wl[k * 128 + 64 + lane] = PG[base + (E1[k] & 127u)] * gelu_erf(r1 * sh * EDS[E1[k] >> 7]) * 0.0625f; }
        int ln = lane; asm volatile("" : "+v"(ln));
#pragma unroll
        for (int sub = 0; sub < 8 / TPS; ++sub) {
        f32x2_t acc[TPS][8];
        for (int repb = 0; repb < PROBE_REPB; ++repb) {
#pragma unroll
            for (int kk = 0; kk < TPS; ++kk)
#pragma unroll
                for (int i = 0; i < 8; ++i) acc[kk][i] = (f32x2_t){0.f, 0.f};
            int pos[TPS];
#pragma unroll
            for (int kk = 0; kk < TPS; ++kk) pos[kk] = 0;
            v4u bA[BSB], bB[BSB]; int ps = 0, pn = 0;
            for (int r = 0; r < NR; ++r) {
#pragma unroll
                for (int kk = 0; kk < TPS; ++kk) {
                    const int k = sub * TPS + kk, kkp = (kk + TPS - 1) % TPS, kp = sub * TPS + kkp;
                    int s = __builtin_amdgcn_readfirstlane(pos[kk]); const int e_end = __builtin_amdgcn_readfirstlane(Bnd[k * (NR + 1) + r + 1]); pos[kk] = e_end;
                    const int n1 = (e_end - s) < BSB ? (e_end - s) : BSB;
                    if (kk & 1) sw_issue<BSB>(bB, El + k * ELP + s, EUq, voff); else sw_issue<BSB>(bA, El + k * ELP + s, EUq, voff);
                    if (pn > 0) { if (kk & 1) sw_proc_b<BSB>(bA, acc[kkp], Wl + kp * 128, ps, pn); else sw_proc_b<BSB>(bB, acc[kkp], Wl + kp * 128, ps, pn); }
                    ps = s; pn = n1; s += n1;
                    for (; s < e_end; s += BSB) {
                        const int n = (e_end - s) < BSB ? (e_end - s) : BSB;
                        if (kk & 1) { sw_issue<BSB>(bA, El + k * ELP + s, EUq, voff); sw_proc_b<BSB>(bA, acc[kk], Wl + k * 128, s, n); }
                        else        { sw_issue<BSB>(bB, El + k * ELP + s, EUq, voff); sw_proc_b<BSB>(bB, acc[kk], Wl + k * 128, s, n); }
                    }
                }
            }
            if (pn > 0) sw_proc_b<BSB>(bB, acc[TPS - 1], Wl + (sub * TPS + TPS - 1) * 128, ps, pn);
        }
#pragma unroll
        for (int kk = 0; kk < TPS; ++kk) {
            const int tok = tok0 + sub * TPS + kk; const int b = tok >> 12; const float* gt2 = MOD + b * NMOD + 5120;
            f32x4 x2[4]; float ss = 0.f;
#pragma unroll
            for (int j = 0; j < 4; ++j) { const int col = 4 * ln + 256 * j;
                const f32x4 xv = *(const f32x4*)(X1 + (size_t)tok * D + col), gv4 = *(const f32x4*)(gt2 + col);
#pragma unroll
                for (int i = 0; i < 4; ++i) { const float v = xv[i] + gv4[i] * acc[kk][2 * j + (i >> 1)][i & 1]; x2[j][i] = v; ss += v * v; } }
            ss = wave_sum_x(ss, ln);
            if (FAKE && ss != 12345.678f) continue;
            const float rstd = 1.0f / sqrtf(ss * (1.0f / D) + EPS);
#pragma unroll
            for (int j = 0; j < 4; ++j) { const int col = 4 * ln + 256 * j; const f32x4 gg = *(const f32x4*)(fg + col);
                *(f32x4*)(((float*)karg(18)) + (size_t)tok * D + col) = x2[j] * rstd * gg; }
        }
        }
    }
}

struct Args { const float* in[18]; float* out; unsigned char* ws; };
__global__ void __launch_bounds__(NTHR, 2) mega_fwd(Args args) {
    extern __shared__ __attribute__((aligned(16))) unsigned char lds[];
    Frame F;
    F.lds = (LAS unsigned char*)lds;
    F.wave = __builtin_amdgcn_readfirstlane((int)threadIdx.x >> 6); F.lane = lane_fresh(); F.tid = F.wave * 64 + F.lane;
    F.G = gridDim.x; { const int bx = blockIdx.x; F.vcu = (F.G % 8 == 0) ? (bx % 8) * (F.G / 8) + bx / 8 : bx; }
    volatile LAS unsigned* MISC = (volatile LAS unsigned*)(F.lds + MISC_OFF);
    for (int u = F.tid; u < (LDS_BYTES - LDSCTL_OFF) / 4; u += NTHR) ((LAS unsigned*)(F.lds + LDSCTL_OFF))[u] = 0u;
    __syncthreads();
    gu32* ctl = (gu32*)(((unsigned char*)karg(19)) + WS_CTL);
    XcdBarrier bar = xcd_barrier_post((unsigned*)(ctl + CW_BAR), MISC + 8, F.wave);
#define GRID_BAR() xcd_barrier(bar)
#define PROBE_TS -1
#define STAMP(i) do { if (PROBE_TS >= 0 && blockIdx.x == 0 && F.tid == 0) { const unsigned long long t_ = __builtin_amdgcn_s_memrealtime(); MISC[16 + 2 * (i)] = (unsigned)t_; MISC[17 + 2 * (i)] = (unsigned)(t_ >> 32); } } while (0)
#define PROBE_DBL -1

    STAMP(0);
    F.lane = lane_fresh(); F.tid = F.wave * 64 + F.lane;
    p0_prologue(F); GRID_BAR(); STAMP(1);
    if (PROBE_DBL == 0) { p0_prologue(F); GRID_BAR(); }
    F.lane = lane_fresh(); F.tid = F.wave * 64 + F.lane;
    p1_norm(F); p0_transposes(F); GRID_BAR(); STAMP(2);
    if (PROBE_DBL == 1) { p1_norm(F); GRID_BAR(); }
    {
    {
        pg8::Gemm g{(const pg8::bf16_t*)(((unsigned char*)karg(19)) + WS_H), (const pg8::bf16_t*)(((unsigned char*)karg(19)) + WS_WIN), M, NPROJ, D, nullptr, nullptr};
        pg8::StaticOrder S; S.init(M, NPROJ, F.G, (int)blockIdx.x);
        pg8::EpiBf16<0> E{(pg8::bf16_t*)(((unsigned char*)karg(19)) + WS_PROJ), NPROJ, nullptr, 0, 0, 1.f};
        pg8::gemm_phase<pg8::EpiBf16<0>, pg8::StaticOrder, true, true>(F.lds + RING_OFF, g, S, E, F.wave);
        const int nwg = (M / 256) * (NPROJ / 256), busy = nwg % F.G;
        if (busy == 0) p0_quant_tables(F, F.vcu * NWAVES + F.wave, F.G * NWAVES);
        else if ((int)blockIdx.x >= busy) p0_quant_tables(F, ((int)blockIdx.x - busy) * NWAVES + F.wave, (F.G - busy) * NWAVES);
    }
    GRID_BAR(); STAMP(3);
    }
    p3_attention(F); GRID_BAR(); STAMP(4);
    if (PROBE_DBL == 3) { p3_attention(F); GRID_BAR(); }
    {
    {
        pg8::Gemm g{(const pg8::bf16_t*)(((unsigned char*)karg(19)) + WS_OA), (const pg8::bf16_t*)(((unsigned char*)karg(19)) + WS_WA), M, D, 512, (const pg8::bf16_t*)(((unsigned char*)karg(19)) + WS_OB), (const pg8::bf16_t*)(((unsigned char*)karg(19)) + WS_WB)};
        PairOrder S; S.S.init(M, D, F.G, (int)blockIdx.x);
        EpiGate E{(const bf16*)(((unsigned char*)karg(19)) + WS_PROJ), (bf16*)((float*)karg(18)) + (size_t)M * D};
        pg8::gemm_phase<EpiGate, PairOrder, true, true>(F.lds + RING_OFF, g, S, E, F.wave);
    }
    GRID_BAR(); STAMP(5);
    }
    {
    {
        pg8::Gemm g{(const pg8::bf16_t*)((bf16*)((float*)karg(18)) + (size_t)M * D), (const pg8::bf16_t*)(((unsigned char*)karg(19)) + WS_WOUT), M, D, D, nullptr, nullptr};
        pg8::StaticOrder S; S.init(M, D, F.G, (int)blockIdx.x);
        EpiRes E{((const float*)karg(0)), (const float*)(((unsigned char*)karg(19)) + WS_MOD), (float*)(((unsigned char*)karg(19)) + WS_X1)};
        pg8::gemm_phase<EpiRes, pg8::StaticOrder, true, true>(F.lds + RING_OFF, g, S, E, F.wave);
    }
    GRID_BAR(); STAMP(6);
    }
    F.lane = lane_fresh(); F.tid = F.wave * 64 + F.lane;
    F.lane = lane_fresh(); F.tid = F.wave * 64 + F.lane;
    p6_norm2(F); GRID_BAR(); STAMP(7);
    if (PROBE_DBL == 6) { p6_norm2(F); GRID_BAR(); }
    {
    {
        pg8::Gemm g{(const pg8::bf16_t*)(((unsigned char*)karg(19)) + WS_H2), (const pg8::bf16_t*)(((unsigned char*)karg(19)) + WS_WQ), M, D, D, nullptr, nullptr};
        pg8::StaticOrder S; S.init(M, D, F.G, (int)blockIdx.x);
        pg8::EpiBf16<0> E{(pg8::bf16_t*)(((unsigned char*)karg(19)) + WS_QP), D, nullptr, 0, 0, 1.f};
        pg8::gemm_phase<pg8::EpiBf16<0>, pg8::StaticOrder, true, true>(F.lds + RING_OFF, g, S, E, F.wave);
    }
    GRID_BAR(); STAMP(8);
    }
    F.lane = lane_fresh(); F.tid = F.wave * 64 + F.lane;
    p8a_topk(F); __syncthreads(); STAMP(9);
    if (PROBE_DBL == 8) { p8a_topk(F); GRID_BAR(); }
    if (PROBE_DBL == 12) { p8b_sweep<1>(F); __syncthreads(); }
    p8b_sweep<0>(F);
    if (PROBE_DBL == 9) { GRID_BAR(); p8b_sweep<0>(F); }
    if (PROBE_TS >= 0) {
        GRID_BAR(); STAMP(10);
        if (blockIdx.x == 0) { __syncthreads();
            const unsigned long long t0 = ((unsigned long long)MISC[17 + 2 * PROBE_TS] << 32) | MISC[16 + 2 * PROBE_TS], t1 = ((unsigned long long)MISC[19 + 2 * PROBE_TS] << 32) | MISC[18 + 2 * PROBE_TS];
            const float d_us = (float)(t1 - t0) * 0.01f;
            const float V = 128.0f * sqrtf(d_us * 1e-5f);
            float* o = (float*)karg(18); for (int c = F.tid; c < D; c += NTHR) o[c] = V; }
    }
}

extern "C" void kernel_launch(void* const* d_in, const int* in_sizes, int n_in, void* d_out, int out_size, void* d_ws, size_t ws_size, hipStream_t stream) {
    static int grid = 0;
    if (grid == 0) {
        if (n_in != 18 || in_sizes[0] != M * D || out_size != M * D || ws_size < WS_END) { fprintf(stderr, "kernel_launch: unexpected shapes (n_in %d, in0 %d, out %d, ws %zu)\n", n_in, n_in > 0 ? in_sizes[0] : -1, out_size, ws_size); grid = -1; return; }
        int dev = 0, cus = 0, per_cu = 0;
        if (hipGetDevice(&dev) != hipSuccess || hipDeviceGetAttribute(&cus, hipDeviceAttributeMultiprocessorCount, dev) != hipSuccess) { grid = -1; return; }
        if (hipFuncSetAttribute((const void*)mega_fwd, hipFuncAttributeMaxDynamicSharedMemorySize, LDS_BYTES) != hipSuccess) { fprintf(stderr, "kernel_launch: hipFuncSetAttribute failed\n"); grid = -1; return; }
        if (hipOccupancyMaxActiveBlocksPerMultiprocessor(&per_cu, (const void*)mega_fwd, NTHR, LDS_BYTES) != hipSuccess || per_cu < 1) { fprintf(stderr, "kernel_launch: occupancy query says %d blocks per CU\n", per_cu); }
        (void)hipGetLastError();
        grid = cus;
    }
    if (grid < 0) return;
    if (hipMemsetAsync((char*)d_ws + WS_CTL, 0, CTL_ZERO_BYTES, stream) != hipSuccess) { fprintf(stderr, "kernel_launch: memset failed\n"); return; }
    Args a{};
    for (int i = 0; i < 18; ++i) a.in[i] = (const float*)d_in[i];
    a.out = (float*)d_out; a.ws = (unsigned char*)d_ws;
    hipLaunchKernelGGL(mega_fwd, dim3(grid), dim3(NTHR), LDS_BYTES, stream, a);
}
```

```cpp
#include <hip/hip_runtime.h>
#include <cstdio>
#include <cstdint>
__device__ __forceinline__ int lane_fresh() { unsigned ones = ~0u; asm volatile("" : "+s"(ones)); return (int)__builtin_amdgcn_mbcnt_hi(ones, __builtin_amdgcn_mbcnt_lo(ones, 0u)); }
namespace pg8 {
#define PG8_LAS __attribute__((address_space(3)))
typedef unsigned short bf16_t;
typedef short bf16x8 __attribute__((ext_vector_type(8)));
typedef float f32x4 __attribute__((ext_vector_type(4)));
typedef unsigned u32x4 __attribute__((ext_vector_type(4)));
constexpr int BM = 256, BK = 64, HALF = 128, HTB = HALF * BK * 2  , STAGE_BYTES = 8 * HTB, NXCD = 8, WGM = 8;

__host__ __device__ __forceinline__ int lds_byte(int r, int c) { const int st = (r >> 4) * 2 + (c >> 5), rr = r & 15, cc = c & 31, ob = rr * 64 + cc * 2; return st * 1024 + (ob ^ (((ob >> 9) & 1) << 5)); }
__host__ __device__ __forceinline__ void stage_rc(int b, int& R, int& C) { const int st = b / 1024, sb = b % 1024, swz = sb ^ (((sb >> 9) & 1) << 5); R = (st >> 1) * 16 + swz / 64; C = (st & 1) * 32 + (swz % 64) / 2; }
__host__ __device__ __forceinline__ int perm32(int rho) { const int n = rho >> 4, i = rho & 15; return 8 * (i >> 2) + 4 * n + (i & 3); }

struct Unit { int pm, pn, src; };
struct Gemm { const bf16_t* A; const bf16_t* Bt; int M, N, K; const bf16_t* A2; const bf16_t* Bt2; };

struct StaticOrder {
    int nM, nN, nwg, G, c;
    __host__ __device__ void init(int M, int N, int G_, int c_) { nM = M / BM; nN = N / BM; nwg = nM * nN; G = G_; c = c_; }
    __host__ __device__ bool next(int i, Unit& u) const {
        const long L = (long)i * G + c; if (L >= nwg) return false;
        int wgid = (int)L; { const int q = nwg / NXCD, r = nwg % NXCD, xcd = wgid % NXCD, off = wgid / NXCD; wgid = (xcd < r ? xcd * (q + 1) : r * (q + 1) + (xcd - r) * q) + off; }
        const int nig = WGM * nN, gid = wgid / nig, fm = gid * WGM, gsz = (nM - fm) < WGM ? (nM - fm) : WGM;
        u.pm = fm + ((wgid % nig) % gsz); u.pn = (wgid % nig) / gsz; u.src = 0; return true;
    }
    __device__ __forceinline__ void a_ready(const Unit&) const {}
    __device__ __forceinline__ void done(const Unit&) const {}
};

__device__ __forceinline__ unsigned cvt_pk_bf16(float lo, float hi) { unsigned r; asm volatile("v_cvt_pk_bf16_f32 %0, %1, %2" : "=v"(r) : "v"(lo), "v"(hi)); return r; }
typedef float f32x2 __attribute__((ext_vector_type(2)));
__device__ __forceinline__ f32x2 gelu_pk(f32x2 v) {
    const f32x2 av = __builtin_elementwise_abs(v), d = av * 0.2316418882f + 1.0f;
    f32x2 t; t.x = __builtin_amdgcn_rcpf(d.x); t.y = __builtin_amdgcn_rcpf(d.y);
    f32x2 q = t * 0.5307027145f + (-0.7265760135f); q = q * t + 0.7107068705f; q = q * t + (-0.142248368f); q = q * t + 0.127414796f; q = q * t;
    const f32x2 s = (v * v) * (-0.72134752044f);
    f32x2 e; e.x = __builtin_amdgcn_exp2f(s.x); e.y = __builtin_amdgcn_exp2f(s.y);
    const f32x2 m = v * (q * e), r = v - m;
    f32x2 o; o.x = v.x < 0.f ? m.x : r.x; o.y = v.y < 0.f ? m.y : r.y; return o;
}

template <int ACT  > struct EpiBf16 {
    static constexpr bool PERM = true, AFTER_DRAIN = false, CHAIN = false; static_assert(ACT == 0 || ACT == 1, "EpiBf16: ACT is 0 (none) or 1 (gelu_pk)");
    bf16_t* O; int ldc; const float* bias; int split_cols; size_t split_stride; float scale0;
    __device__ __forceinline__ void operator()(const f32x4 (&acc)[2][2][4][2], const Unit& u, int wr, int wc, int fr, int fq) const {
        const int row0 = u.pm * BM + wr * 64 + fr; int colt = u.pn * BM; bf16_t* base = O;
        float sc = 1.f; if (split_cols) { const int t = colt / split_cols; base += (size_t)t * split_stride; colt -= t * split_cols; if (t == 0) sc = scale0; }
        const int col0 = colt + wc * 32 + 8 * fq, bcol0 = u.pn * BM + wc * 32 + 8 * fq;
        f32x4 bv[2][2];
#pragma unroll
        for (int bj = 0; bj < 2; ++bj)
#pragma unroll
            for (int n = 0; n < 2; ++n) bv[bj][n] = bias ? *(const f32x4*)(bias + bcol0 + bj * HALF + 4 * n) : (f32x4){0.f, 0.f, 0.f, 0.f};
#pragma unroll
        for (int ai = 0; ai < 2; ++ai)
#pragma unroll
            for (int m = 0; m < 4; ++m) { bf16_t* rowp = base + (size_t)(row0 + ai * HALF + m * 16) * ldc + col0;
#pragma unroll
                for (int bj = 0; bj < 2; ++bj) { f32x4 v0 = acc[ai][bj][m][0] + bv[bj][0], v1 = acc[ai][bj][m][1] + bv[bj][1];
                    if (ACT == 1) { f32x2 a = gelu_pk((f32x2){v0[0], v0[1]}), b = gelu_pk((f32x2){v0[2], v0[3]}), c = gelu_pk((f32x2){v1[0], v1[1]}), d = gelu_pk((f32x2){v1[2], v1[3]});
                        v0 = (f32x4){a.x, a.y, b.x, b.y}; v1 = (f32x4){c.x, c.y, d.x, d.y}; }
                    v0 = v0 * sc; v1 = v1 * sc; u32x4 w; w.x = cvt_pk_bf16(v0[0], v0[1]); w.y = cvt_pk_bf16(v0[2], v0[3]); w.z = cvt_pk_bf16(v1[0], v1[1]); w.w = cvt_pk_bf16(v1[2], v1[3]);
                    *(u32x4*)(rowp + bj * HALF) = w; } }
    }
};

template <class Epi, class Sched, bool ALIGN_EPI = false, bool SP2 = false>
__device__ __forceinline__ void gemm_phase(PG8_LAS unsigned char* lds, const Gemm g, const Sched& S, const Epi& E, int wave_id) {
    int tid = wave_id * 64 + ::lane_fresh(); asm volatile("" : "+v"(tid));
    const int wid = __builtin_amdgcn_readfirstlane(tid >> 6), lane = tid & 63, wr = wid >> 2, wc = wid & 3, fr = lane & 15, fq = lane >> 4;
    const int K = g.K, nt = K / BK;
    unsigned voffA[2], voffB[2];
#pragma unroll
    for (int i = 0; i < 2; ++i) { int R, C; stage_rc(tid * 16 + i * 8192, R, C); const int Rb = Epi::PERM ? ((R & ~31) + perm32(R & 31)) : R;
        voffA[i] = (unsigned)(R * K + C) * 2u; voffB[i] = (unsigned)(Rb * K + C) * 2u; }
    const size_t kstep = (size_t)(BK * 2);
    const size_t hstep = (size_t)HALF * K * 2;
    const size_t tstep = 2 * hstep;
    const unsigned ldsw = (unsigned)wid * 1024u;
    const int aoff = lds_byte(wr * 64 + fr, fq * 8), boff = lds_byte(wc * 32 + fr, fq * 8);
#define PG8_SA(b, h) (((b) * 2 + (h)) * HTB)
#define PG8_SB(b, h) ((4 + (b) * 2 + (h)) * HTB)
#define PG8_STAGE(bufoff, gbase, voff) do { _Pragma("unroll") for (int _i = 0; _i < 2; ++_i) \
        __builtin_amdgcn_global_load_lds((const unsigned*)((const char*)(gbase) + (voff)[_i]), (PG8_LAS unsigned*)(lds + (bufoff) + ldsw + _i * 8192), 16, 0, 0); } while (0)
#define PG8_LDA(dst, b, h) do { _Pragma("unroll") for (int m = 0; m < 4; ++m) _Pragma("unroll") for (int k = 0; k < 2; ++k) dst[m][k] = *(const PG8_LAS bf16x8*)(lds + PG8_SA(b, h) + aoff + m * 2048 + k * 1024); } while (0)
#define PG8_LDB(dst, b, h) do { _Pragma("unroll") for (int n = 0; n < 2; ++n) _Pragma("unroll") for (int k = 0; k < 2; ++k) dst[n][k] = *(const PG8_LAS bf16x8*)(lds + PG8_SB(b, h) + boff + n * 2048 + k * 1024); } while (0)
#define PG8_MMA(ai, bj, At, Bt) do { __builtin_amdgcn_s_setprio(1); _Pragma("unroll") for (int m = 0; m < 4; ++m) _Pragma("unroll") for (int n = 0; n < 2; ++n) _Pragma("unroll") for (int k = 0; k < 2; ++k) \
        acc[ai][bj][m][n] = __builtin_amdgcn_mfma_f32_16x16x32_bf16(Bt[n][k], At[m][k], acc[ai][bj][m][n], 0, 0, 0); __builtin_amdgcn_s_setprio(0); } while (0)
#define PG8_WAIT_V(n) asm volatile("s_waitcnt vmcnt(" #n ")" ::: "memory")
#define PG8_WAIT_L(n) asm volatile("s_waitcnt lgkmcnt(" #n ")" ::: "memory")
#define PG8_BAR __builtin_amdgcn_s_barrier()
#define PG8_SCHED __builtin_amdgcn_sched_barrier(0)
    Unit cur, nxt; int ui = 0;
    if (!S.next(0, cur)) return;
    f32x4 acc[2][2][4][2];
#pragma unroll
    for (int a = 0; a < 2; ++a)
#pragma unroll
        for (int b = 0; b < 2; ++b)
#pragma unroll
            for (int m = 0; m < 4; ++m)
#pragma unroll
                for (int n = 0; n < 2; ++n) acc[a][b][m][n] = (f32x4){0.f, 0.f, 0.f, 0.f};
    bf16x8 At[4][2], B0[2][2], B1[2][2];
    const char* cA = (const char*)(cur.src ? g.A2 : g.A) + (size_t)cur.pm * tstep; const char* cB = (const char*)(cur.src ? g.Bt2 : g.Bt) + (size_t)cur.pn * tstep;
    S.a_ready(cur);
    if constexpr (SP2) {
        PG8_STAGE(PG8_SB(0, 0), cB, voffB); PG8_STAGE(PG8_SB(0, 1), cB + hstep, voffB); PG8_STAGE(PG8_SA(0, 0), cA, voffA); PG8_STAGE(PG8_SA(0, 1), cA + hstep, voffA);
        if (wr == 1) PG8_BAR;
        PG8_WAIT_V(2); PG8_BAR;
        PG8_STAGE(PG8_SB(1, 0), cB + kstep, voffB); PG8_STAGE(PG8_SA(1, 0), cA + kstep, voffA); PG8_STAGE(PG8_SB(1, 1), cB + hstep + kstep, voffB);
        PG8_WAIT_V(6); PG8_BAR;
    } else {
        PG8_STAGE(PG8_SB(0, 0), cB, voffB); PG8_STAGE(PG8_SA(0, 0), cA, voffA); PG8_STAGE(PG8_SB(0, 1), cB + hstep, voffB); PG8_STAGE(PG8_SA(0, 1), cA + hstep, voffA);
        if (wr == 1) PG8_BAR;
        PG8_WAIT_V(4); PG8_BAR;
        PG8_STAGE(PG8_SB(1, 0), cB + kstep, voffB); PG8_STAGE(PG8_SA(1, 0), cA + kstep, voffA); PG8_STAGE(PG8_SB(1, 1), cB + hstep + kstep, voffB);
        PG8_WAIT_V(6); PG8_BAR;
    }
    for (;;) {
        const bool has_next = S.next(ui + 1, nxt);
        const char* nA = has_next ? (const char*)(nxt.src ? g.A2 : g.A) + (size_t)nxt.pm * tstep : cA; const char* nB = has_next ? (const char*)(nxt.src ? g.Bt2 : g.Bt) + (size_t)nxt.pn * tstep : cB;
        for (int t = 0; t < nt; t += 2) {
            const bool last = (t == nt - 2);
            const char* a1 = cA + (size_t)(t + 1) * kstep;
            const char* a2 = last ? nA : cA + (size_t)(t + 2) * kstep; const char* b2 = last ? nB : cB + (size_t)(t + 2) * kstep;
            const char* a3 = a2 + kstep; const char* b3 = b2 + kstep;
            if (last && has_next) S.a_ready(nxt);
            if constexpr (SP2) {
            PG8_LDB(B0, 0, 0); PG8_LDB(B1, 0, 1); PG8_SCHED; PG8_LDA(At, 0, 0); PG8_STAGE(PG8_SA(1, 1), a1 + hstep, voffA);
            PG8_WAIT_V(8); PG8_WAIT_L(0); PG8_BAR; PG8_MMA(0, 0, At, B0); PG8_MMA(0, 1, At, B1); PG8_BAR; PG8_SCHED;
            PG8_LDA(At, 0, 1); PG8_STAGE(PG8_SB(0, 0), b2, voffB); PG8_STAGE(PG8_SB(0, 1), b2 + hstep, voffB); PG8_STAGE(PG8_SA(0, 0), a2, voffA);
            PG8_WAIT_V(8); PG8_WAIT_L(0); PG8_BAR; PG8_MMA(1, 0, At, B0); PG8_MMA(1, 1, At, B1); PG8_BAR; PG8_SCHED;
            PG8_LDB(B0, 1, 0); PG8_LDB(B1, 1, 1); PG8_SCHED; PG8_LDA(At, 1, 0); PG8_STAGE(PG8_SA(0, 1), a2 + hstep, voffA);
            PG8_WAIT_V(8); PG8_WAIT_L(0); PG8_BAR; PG8_MMA(0, 0, At, B0); PG8_MMA(0, 1, At, B1); PG8_BAR; PG8_SCHED;
            PG8_LDA(At, 1, 1); PG8_STAGE(PG8_SB(1, 0), b3, voffB); PG8_STAGE(PG8_SB(1, 1), b3 + hstep, voffB); PG8_STAGE(PG8_SA(1, 0), a3, voffA);
            PG8_WAIT_V(8); PG8_WAIT_L(0); PG8_BAR; PG8_MMA(1, 0, At, B0); PG8_MMA(1, 1, At, B1); PG8_BAR; PG8_SCHED;
            } else {
            PG8_LDB(B0, 0, 0); PG8_SCHED; PG8_LDA(At, 0, 0); PG8_STAGE(PG8_SA(1, 1), a1 + hstep, voffA);
            PG8_WAIT_L(8); PG8_BAR; PG8_WAIT_L(0); PG8_MMA(0, 0, At, B0); PG8_BAR; PG8_SCHED;
            PG8_LDB(B1, 0, 1); PG8_STAGE(PG8_SB(0, 0), b2, voffB);
            PG8_BAR; PG8_WAIT_L(0); PG8_MMA(0, 1, At, B1); PG8_BAR;
            PG8_LDA(At, 0, 1); PG8_STAGE(PG8_SA(0, 0), a2, voffA);
            PG8_BAR; PG8_WAIT_L(0); PG8_MMA(1, 0, At, B0); PG8_BAR; PG8_SCHED;
            PG8_STAGE(PG8_SB(0, 1), b2 + hstep, voffB);
            PG8_WAIT_V(6); PG8_BAR; PG8_MMA(1, 1, At, B1); PG8_BAR;
            PG8_LDB(B0, 1, 0); PG8_SCHED; PG8_LDA(At, 1, 0); PG8_STAGE(PG8_SA(0, 1), a2 + hstep, voffA);
            PG8_WAIT_L(8); PG8_BAR; PG8_WAIT_L(0); PG8_MMA(0, 0, At, B0); PG8_BAR; PG8_SCHED;
            PG8_LDB(B1, 1, 1); PG8_STAGE(PG8_SB(1, 0), b3, voffB);
            PG8_BAR; PG8_WAIT_L(0); PG8_MMA(0, 1, At, B1); PG8_BAR;
            PG8_LDA(At, 1, 1); PG8_STAGE(PG8_SA(1, 0), a3, voffA);
            PG8_BAR; PG8_WAIT_L(0); PG8_MMA(1, 0, At, B0); PG8_BAR; PG8_SCHED;
            PG8_STAGE(PG8_SB(1, 1), b3 + hstep, voffB);
            PG8_WAIT_V(6); PG8_BAR; PG8_MMA(1, 1, At, B1); PG8_BAR;
            }
        }
        if constexpr (ALIGN_EPI) { if (wr == 0) PG8_BAR; }
        if constexpr (!Epi::AFTER_DRAIN) { E(acc, cur, wr, wc, fr, fq); S.done(cur); }
        if (!has_next) break;
        if (!(Epi::CHAIN && cur.src == 0)) {
#pragma unroll
        for (int a = 0; a < 2; ++a)
#pragma unroll
            for (int b = 0; b < 2; ++b)
#pragma unroll
                for (int m = 0; m < 4; ++m)
#pragma unroll
                    for (int n = 0; n < 2; ++n) acc[a][b][m][n] = (f32x4){0.f, 0.f, 0.f, 0.f};
        }
        cur = nxt; cA = nA; cB = nB; ++ui;
        if constexpr (ALIGN_EPI) { if (wr == 1) PG8_BAR; }
    }
    PG8_WAIT_V(0);
    if constexpr (!ALIGN_EPI) { if (wr == 0) PG8_BAR; }
    PG8_BAR;
    if constexpr (Epi::AFTER_DRAIN) { E.fused(acc, cur, wr, wc, fr, fq, lds, wid, lane); S.done(cur); }
#undef PG8_SA
#undef PG8_SB
#undef PG8_STAGE
#undef PG8_LDA
#undef PG8_LDB
#undef PG8_MMA
#undef PG8_WAIT_V
#undef PG8_WAIT_L
#undef PG8_BAR
#undef PG8_SCHED
}
}

#define GAS __attribute__((address_space(1)))
#define LAS __attribute__((address_space(3)))
typedef unsigned short bf16;
typedef unsigned v4u __attribute__((ext_vector_type(4)));
typedef float f32x4 __attribute__((ext_vector_type(4)));
typedef short bf16x8 __attribute__((ext_vector_type(8)));
typedef GAS unsigned gu32;
typedef GAS unsigned long long gu64;
#define RLX_AGENT __ATOMIC_RELAXED, __HIP_MEMORY_SCOPE_AGENT
#define LDS_WAIT() asm volatile("s_waitcnt lgkmcnt(0)" ::: "memory")
#define VM_WAIT() asm volatile("s_waitcnt vmcnt(0)" ::: "memory")
__device__ __forceinline__ unsigned long long rt() { return __builtin_amdgcn_s_memrealtime(); }
__device__ __forceinline__ unsigned f2bf(float f) { unsigned u = __builtin_bit_cast(unsigned, f); return (u + 0x7fffu + ((u >> 16) & 1u)) >> 16; }
__device__ __forceinline__ unsigned pk2(float lo, float hi) { return f2bf(lo) | (f2bf(hi) << 16); }

__device__ __forceinline__ const void* karg(int i);
constexpr int CW_BAR_FWD = 4096;
#define XB_TMO      128
#define XB_XCNT(j)  (256  + 64 * (j))
#define XB_XSUB(j)  (1280 + 64 * (j))
#define XB_XGEN(j)  (2304 + 64 * (j))
#define XB_TOP      3328
#define XB_TOPGEN   3392
#define XCD_BAR_WORDS 3456
#define XB_SPIN_CAP (1u << 18)

__device__ __forceinline__ unsigned xb_ld(unsigned* p)              { return __hip_atomic_load(p, __ATOMIC_RELAXED, __HIP_MEMORY_SCOPE_AGENT); }
__device__ __forceinline__ unsigned xb_add(unsigned* p, unsigned v) { return __hip_atomic_fetch_add(p, v, __ATOMIC_RELAXED, __HIP_MEMORY_SCOPE_AGENT); }
__device__ __forceinline__ unsigned xb_xcc_id() { return (unsigned)__builtin_amdgcn_s_getreg((3 << 11) | 20) & 0xFu; }
#define XB_SPIN(cond, bar) do { unsigned _sp = 0; while (cond) { __builtin_amdgcn_s_sleep(1); \
    if ((++_sp & 255u) == 0u) { if (xb_ld(&(bar)[XB_TMO])) break; if (_sp > XB_SPIN_CAP) { atomicAdd(&(bar)[XB_TMO], 1u); break; } } } } while (0)

struct XcdBarrier {
    int wave;
    unsigned* bar; unsigned x;
    volatile LAS unsigned* st;
};

__device__ __forceinline__ XcdBarrier xcd_barrier_post(unsigned* bar, volatile LAS unsigned* st, int wave) {
    XcdBarrier b; b.wave = wave; b.bar = bar; b.x = xb_xcc_id(); b.st = st;
    if (wave == 0 && lane_fresh() == 0) (void)xb_add(&bar[XB_XCNT(b.x)], 1u);
    return b;
}
__device__ __forceinline__ void xcd_barrier_complete(unsigned* bar, unsigned x, unsigned& nloc, unsigned& nx) {
    const unsigned G = gridDim.x * gridDim.y * gridDim.z;
    unsigned sum, cnt, mine, sp = 0u;
    for (;;) {
        sum = 0u; cnt = 0u; mine = 0u;
#pragma unroll
        for (unsigned j = 0; j < 16; ++j) { const unsigned c = xb_ld(&bar[XB_XCNT(j)]); sum += c; cnt += (c > 0u) ? 1u : 0u; mine = (j == x) ? c : mine; }
        if (sum == G) break;
        __builtin_amdgcn_s_sleep(1);
        if ((++sp & 255u) == 0u) { if (xb_ld(&bar[XB_TMO])) break; if (sp > XB_SPIN_CAP) { atomicAdd(&bar[XB_TMO], 1u); break; } }
    }
    nloc = mine > 0u ? mine : 1u; nx = cnt > 0u ? cnt : 1u;
}

__device__ __forceinline__ void xcd_barrier(const XcdBarrier& b) {
    asm volatile("s_waitcnt vmcnt(0)" ::: "memory");
    __syncthreads();
    if (b.wave == 0 && lane_fresh() == 0) {
        unsigned* bar = (unsigned*)((gu32*)((unsigned char*)karg(19)) + CW_BAR_FWD);
        __builtin_amdgcn_s_waitcnt(0);
        unsigned nloc = b.st[0], nx = b.st[1];
        if (nloc == 0u) { xcd_barrier_complete(bar, b.x, nloc, nx); b.st[0] = nloc; b.st[1] = nx; }
        const unsigned old = xb_add(&bar[XB_XSUB(b.x)], 1u);
        const unsigned gen = old / nloc;
        if (old + 1u == (gen + 1u) * nloc) {
            __builtin_amdgcn_fence(__ATOMIC_RELEASE, "agent");
            asm volatile("s_waitcnt vmcnt(0)" ::: "memory");
            const unsigned og = xb_add(&bar[XB_TOP], 1u);
            const unsigned tg = og / nx;
            if (og + 1u == (tg + 1u) * nx) xb_add(&bar[XB_TOPGEN], 1u);
            else XB_SPIN(xb_ld(&bar[XB_TOPGEN]) == tg, bar);
            __builtin_amdgcn_fence(__ATOMIC_ACQUIRE, "agent");
            xb_add(&bar[XB_XGEN(b.x)], 1u);
            asm volatile("s_waitcnt vmcnt(0)" ::: "memory");
        } else {
            XB_SPIN(xb_ld(&bar[XB_XGEN(b.x)]) == gen, bar);
            __builtin_amdgcn_fence(__ATOMIC_ACQUIRE, "agent");
            asm volatile("s_waitcnt vmcnt(0)" ::: "memory");
        }
    }
    __syncthreads();
}

constexpr int NWAVES = 8, NTHR = 512;
constexpr int BATCH = 4, SEQ = 4096, D = 1024, M = BATCH * SEQ;
constexpr int NPROJ = 4352, LDW_IN = 4360, NMOD = 6144;
constexpr int C_QA = 0, C_KA = 512, C_VA = 640, C_QB = 768, C_KB = 1280, C_VB = 1792, C_GLA = 2304, C_GLB = 3328;
constexpr int NEXP = 16384;
constexpr float EPS = 1e-6f;

constexpr size_t MiB = 1u << 20;
constexpr size_t WS_CTL = 0, CTL_ZERO_BYTES = 1 * MiB;
constexpr size_t WS_MOD = 1 * MiB, WS_LOGF = 1 * MiB + 128 * 1024, WS_SUBK = 2 * MiB;
constexpr size_t WS_WIN = 4 * MiB, WS_WA = 12 * MiB + 512 * 1024, WS_WB = 13 * MiB + 512 * 1024, WS_WOUT = 14 * MiB + 512 * 1024, WS_WQ = 16 * MiB + 512 * 1024;
constexpr size_t WS_ED = 19 * MiB, WS_EU = 35 * MiB;
constexpr size_t WS_EDS = 2 * MiB + 512 * 1024;
constexpr size_t WS_H2Q = 95 * MiB, WS_H2S = 111 * MiB;
constexpr size_t WS_H = 83 * MiB, WS_OA = 83 * MiB, WS_OB = 99 * MiB, WS_PIDX = 83 * MiB, WS_PG = 87 * MiB;
constexpr size_t WS_PROJ = 115 * MiB, WS_X1 = 115 * MiB, WS_H2 = 179 * MiB, WS_QP = 211 * MiB;
constexpr size_t WS_END = 251 * MiB;
static_assert(WS_WIN + (size_t)NPROJ * D * 2 <= WS_WA && WS_WQ + (size_t)D * D * 2 <= WS_ED && WS_PROJ + (size_t)M * NPROJ * 2 <= WS_END, "ws map");
constexpr int CW_BAR = 4096; static_assert(CW_BAR == CW_BAR_FWD && WS_CTL == 0, "barrier words");

constexpr int RING_OFF = 0, RING_BYTES = 131072;
constexpr int LDSCTL_OFF = RING_BYTES, MISC_OFF = LDSCTL_OFF + 320;
constexpr int LDS_BYTES = 147456;

typedef float f32x16 __attribute__((ext_vector_type(16)));
typedef short s16x4 __attribute__((ext_vector_type(4)));
typedef unsigned u32x2 __attribute__((ext_vector_type(2)));
typedef float f32x2_t __attribute__((ext_vector_type(2)));
typedef __bf16 bf16x2_t __attribute__((ext_vector_type(2)));

__device__ __forceinline__ unsigned cvtpk(float lo, float hi) { f32x2_t v = {lo, hi}; bf16x2_t b = __builtin_convertvector(v, bf16x2_t); return __builtin_bit_cast(unsigned, b); }
__device__ __forceinline__ float bflo(unsigned u) { return __uint_as_float(u << 16); }
__device__ __forceinline__ float bfhi(unsigned u) { return __uint_as_float(u & 0xffff0000u); }
template <int S> __device__ __forceinline__ unsigned xorx(unsigned v, int lane) {
    if constexpr (S == 1) return (unsigned)__builtin_amdgcn_update_dpp(0, (int)v, 0xB1, 0xF, 0xF, true);
    else if constexpr (S == 2) return (unsigned)__builtin_amdgcn_update_dpp(0, (int)v, 0x4E, 0xF, 0xF, true);
    else if constexpr (S == 4) { const unsigned a = (unsigned)__builtin_amdgcn_update_dpp(0, (int)v, 0x124, 0xF, 0xF, true), b = (unsigned)__builtin_amdgcn_update_dpp(0, (int)v, 0x12C, 0xF, 0xF, true); return (lane & 4) ? a : b; }
    else if constexpr (S == 8) return (unsigned)__builtin_amdgcn_update_dpp(0, (int)v, 0x128, 0xF, 0xF, true);
    else if constexpr (S == 16) { const auto r = __builtin_amdgcn_permlane16_swap(v, v, false, false); return (lane & 16) ? r[0] : r[1]; }
    else { const auto r = __builtin_amdgcn_permlane32_swap(v, v, false, false); return (lane & 32) ? r[0] : r[1]; }
}
__device__ __forceinline__ unsigned xorx_sw(unsigned v, int lane, int s) {
    switch (s) { case 1: return xorx<1>(v, lane); case 2: return xorx<2>(v, lane); case 4: return xorx<4>(v, lane); case 8: return xorx<8>(v, lane); case 16: return xorx<16>(v, lane); default: return xorx<32>(v, lane); }
}
__device__ __forceinline__ float wave_sum_x(float v, int lane) {
    v += __uint_as_float(xorx<1>(__float_as_uint(v), lane)); v += __uint_as_float(xorx<2>(__float_as_uint(v), lane)); v += __uint_as_float(xorx<4>(__float_as_uint(v), lane));
    v += __uint_as_float(xorx<8>(__float_as_uint(v), lane)); v += __uint_as_float(xorx<16>(__float_as_uint(v), lane)); v += __uint_as_float(xorx<32>(__float_as_uint(v), lane));
    return v;
}
__device__ __forceinline__ float dppf(float v, const int ctrl_sel) { return v; }
#define DPP_F(v, CTRL) __uint_as_float(__builtin_amdgcn_update_dpp(0, __float_as_uint(v), (CTRL), 0xF, 0xF, true))
__device__ __forceinline__ float reduce8_t(const float (&dd)[8], int lane) {
    float r4[4];
#pragma unroll
    for (int u = 0; u < 4; ++u) { const auto p = __builtin_amdgcn_permlane32_swap(__float_as_uint(dd[u]), __float_as_uint(dd[u + 4]), false, false); r4[u] = __uint_as_float(p[0]) + __uint_as_float(p[1]); }
    float r2[2];
#pragma unroll
    for (int u = 0; u < 2; ++u) { const auto p = __builtin_amdgcn_permlane16_swap(__float_as_uint(r4[u]), __float_as_uint(r4[u + 2]), false, false); r2[u] = __uint_as_float(p[0]) + __uint_as_float(p[1]); }
    const bool b3 = (lane & 8) != 0;
    const float keep = b3 ? r2[1] : r2[0], send = b3 ? r2[0] : r2[1];
    float r1 = keep + DPP_F(send, 0x128);
    r1 += DPP_F(r1, 0xB1);
    r1 += DPP_F(r1, 0x4E);
    r1 += DPP_F(r1, 0x141);
    return r1;
}
__device__ __forceinline__ int lane_id() { return (int)__builtin_amdgcn_mbcnt_hi(~0u, __builtin_amdgcn_mbcnt_lo(~0u, 0u)); }
__device__ __forceinline__ float wave_sum(float v) { return wave_sum_x(v, lane_id()); }
__device__ __forceinline__ float wave_max(float v) { const int lane = lane_id();
    v = fmaxf(v, __uint_as_float(xorx<1>(__float_as_uint(v), lane))); v = fmaxf(v, __uint_as_float(xorx<2>(__float_as_uint(v), lane))); v = fmaxf(v, __uint_as_float(xorx<4>(__float_as_uint(v), lane)));
    v = fmaxf(v, __uint_as_float(xorx<8>(__float_as_uint(v), lane))); v = fmaxf(v, __uint_as_float(xorx<16>(__float_as_uint(v), lane))); v = fmaxf(v, __uint_as_float(xorx<32>(__float_as_uint(v), lane)));
    return v; }
__device__ __forceinline__ int crow(int r, int hi) { return (r & 3) + 8 * (r >> 2) + 4 * hi; }
#define MFMA32(a, b, c) __builtin_amdgcn_mfma_f32_32x32x16_bf16((a), (b), (c), 0, 0, 0)

struct Frame {
    LAS unsigned char* lds;
    int tid, lane, wave, vcu, G;
};
__device__ __forceinline__ const void* karg(int i) {
    unsigned long z = 0; asm volatile("" : "+s"(z));
    const char* base = (const char*)__builtin_amdgcn_kernarg_segment_ptr();
    return *(const void* const*)(base + 8 * i + z);
}

__device__ __forceinline__ void p0_transpose_item(const float* W, int ld, int K, int ncols, bf16* WT, int row_off, LAS float* scr, int item, int lane) {
    const int nblk = ncols / 32, kb = item / nblk, nb = item % nblk, k0 = 64 * kb, n0 = 32 * nb;
#pragma unroll 8
    for (int i = 0; i < 32; ++i) { const int kk = 2 * i + (lane >> 5); scr[kk * 33 + (lane & 31)] = W[(size_t)(k0 + kk) * ld + n0 + (lane & 31)]; }
    LDS_WAIT(); asm volatile("" ::: "memory");
    const int c = lane & 7;
#pragma unroll
    for (int j = 0; j < 4; ++j) { const int n = (lane >> 3) + 8 * j; const LAS float* s = scr + (8 * c) * 33 + n;
        v4u o; o.x = pk2(s[0 * 33], s[1 * 33]); o.y = pk2(s[2 * 33], s[3 * 33]); o.z = pk2(s[4 * 33], s[5 * 33]); o.w = pk2(s[6 * 33], s[7 * 33]);
        *(GAS v4u*)(WT + (size_t)(row_off + n0 + n) * K + k0 + 8 * c) = o; }
    LDS_WAIT(); asm volatile("" ::: "memory");
}
__device__ __forceinline__ void p0_convert(const float* __restrict__ src, bf16* __restrict__ dst, long n_iters, int gw, int NGW, int lane) {
    for (long it0 = (long)gw * 4; it0 < n_iters; it0 += (long)NGW * 4) {
        f32x4 a[4][2];
#pragma unroll
        for (int u = 0; u < 4; ++u) { const long it = it0 + u; if (it < n_iters) { const float* p = src + it * 512 + lane * 4; a[u][0] = *(const f32x4*)p; a[u][1] = *(const f32x4*)(p + 256); } }
#pragma unroll
        for (int u = 0; u < 4; ++u) { const long it = it0 + u; if (it < n_iters) { bf16* q = dst + it * 512 + lane * 4;
            u32x2 w0, w1; w0.x = cvtpk(a[u][0].x, a[u][0].y); w0.y = cvtpk(a[u][0].z, a[u][0].w); w1.x = cvtpk(a[u][1].x, a[u][1].y); w1.y = cvtpk(a[u][1].z, a[u][1].w);
            *(u32x2*)q = w0; *(u32x2*)(q + 256) = w1; } }
    }
}

__device__ __forceinline__ void p0_quant_tables(Frame& F, int gw, int NGW) {
    const float* ed = ((const float*)karg(15)); const float* eu = ((const float*)karg(16));
    unsigned char* EDq = (unsigned char*)(((unsigned char*)karg(19)) + WS_ED); unsigned char* EUq = (unsigned char*)(((unsigned char*)karg(19)) + WS_EU); float* EDS = (float*)(((unsigned char*)karg(19)) + WS_EDS);
    const int lane = F.lane;
    for (int row0 = gw * 4; row0 < NEXP; row0 += NGW * 4) {
        f32x4 a[4][4], u[4][4];
#pragma unroll
        for (int q = 0; q < 4; ++q)
#pragma unroll
            for (int j = 0; j < 4; ++j) { a[q][j] = *((const f32x4*)(ed + (size_t)(row0 + q) * D) + lane + 64 * j); u[q][j] = *((const f32x4*)(eu + (size_t)(row0 + q) * D) + lane + 64 * j); }
#pragma unroll
        for (int q = 0; q < 4; ++q) {
            float am = 0.f;
#pragma unroll
            for (int j = 0; j < 4; ++j) am = fmaxf(fmaxf(am, fmaxf(fabsf(a[q][j].x), fabsf(a[q][j].y))), fmaxf(fabsf(a[q][j].z), fabsf(a[q][j].w)));
            am = wave_max(am);
            const float sc = am > 0.f ? am * (1.0f / 127.0f) : 1.0f, inv = 1.0f / sc;
            v4u qa, qu;
#pragma unroll
            for (int j = 0; j < 4; ++j) {
                const int b0 = (int)rintf(a[q][j].x * inv), b1 = (int)rintf(a[q][j].y * inv), b2 = (int)rintf(a[q][j].z * inv), b3 = (int)rintf(a[q][j].w * inv);
                qa[j] = (unsigned)(b0 & 255) | ((unsigned)(b1 & 255) << 8) | ((unsigned)(b2 & 255) << 16) | ((unsigned)(b3 & 255) << 24);
                int p = __builtin_amdgcn_cvt_pk_fp8_f32(u[q][j].x * 16.0f, u[q][j].y * 16.0f, 0, false);
                p = __builtin_amdgcn_cvt_pk_fp8_f32(u[q][j].z * 16.0f, u[q][j].w * 16.0f, p, true);
                qu[j] = (unsigned)p;
            }
            *(v4u*)(EDq + (size_t)(row0 + q) * D + 16 * lane) = qa;
            *(v4u*)(EUq + (size_t)(row0 + q) * D + 16 * lane) = qu;
            if (lane == 0) EDS[row0 + q] = sc;
        }
    }
}
__device__ __forceinline__ void p0_prologue(Frame& F) {
    const float* c = ((const float*)karg(1)); const float* w_ada = ((const float*)karg(4)); const float* b_ada = ((const float*)karg(5));
    float* MOD = (float*)(((unsigned char*)karg(19)) + WS_MOD);
    {
        LAS float* cact = (LAS float*)(F.lds);
        LAS float* part = (LAS float*)(F.lds + 16384);
        bool did = false;
        for (int item = F.vcu; item < NMOD / 32; item += F.G) {
            if (!did) { for (int i = F.tid; i < 4096; i += NTHR) { const float cv = c[i]; cact[i] = cv / (1.0f + __expf(-cv)); } did = true; }
            __syncthreads();
            const int n0 = item * 32, col = n0 + (F.lane & 31), ksub = F.lane >> 5;
            float a0 = 0.f, a1 = 0.f, a2 = 0.f, a3 = 0.f;
#pragma unroll 16
            for (int it = 0; it < 64; ++it) { const int k = (it * 8 + F.wave) * 2 + ksub; const float w = w_ada[(size_t)k * NMOD + col];
                a0 += cact[k] * w; a1 += cact[1024 + k] * w; a2 += cact[2048 + k] * w; a3 += cact[3072 + k] * w; }
            a0 += __shfl_xor(a0, 32); a1 += __shfl_xor(a1, 32); a2 += __shfl_xor(a2, 32); a3 += __shfl_xor(a3, 32);
            if (F.lane < 32) { part[(F.wave * 4 + 0) * 32 + F.lane] = a0; part[(F.wave * 4 + 1) * 32 + F.lane] = a1; part[(F.wave * 4 + 2) * 32 + F.lane] = a2; part[(F.wave * 4 + 3) * 32 + F.lane] = a3; }
            __syncthreads();
            if (F.tid < 128) { const int b = F.tid >> 5, cl = F.tid & 31; float s = 0.f;
#pragma unroll
                for (int w = 0; w < 8; ++w) s += part[(w * 4 + b) * 32 + cl];
                MOD[b * NMOD + n0 + cl] = s + b_ada[n0 + cl]; }
            __syncthreads();
        }
    }
    {
        const int gw = F.vcu * NWAVES + F.wave, NGW = F.G * NWAVES;
        p0_convert(((const float*)karg(14)), (bf16*)(((unsigned char*)karg(19)) + WS_SUBK), (long)(8 * 2 * 128 * 64) / 512, gw, NGW, F.lane);
    }
}
__device__ __forceinline__ void p0_transposes(Frame& F) {
    LAS float* scr = (LAS float*)(F.lds + 32768 + F.wave * 8704);
    const int gw = F.vcu * NWAVES + F.wave, NGW = F.G * NWAVES;
    constexpr int I_IN1 = (D / 64) * (2304 / 32), I_IN2 = (D / 64) * (2048 / 32), I_AB = (512 / 64) * (D / 32), I_SQ = (D / 64) * (D / 32);
    constexpr int NITEMS = I_IN1 + I_IN2 + 2 * I_AB + 2 * I_SQ;
    bf16* Win_t = (bf16*)(((unsigned char*)karg(19)) + WS_WIN);
    for (int it = gw; it < NITEMS; it += NGW) {
        int r = it;
        if (r < I_IN1) { p0_transpose_item(((const float*)karg(6)), LDW_IN, D, 2304, Win_t, 0, scr, r, F.lane); continue; } r -= I_IN1;
        if (r < I_IN2) { p0_transpose_item(((const float*)karg(6)) + 2312, LDW_IN, D, 2048, Win_t, 2304, scr, r, F.lane); continue; } r -= I_IN2;
        if (r < I_AB) { p0_transpose_item(((const float*)karg(9)), D, 512, D, (bf16*)(((unsigned char*)karg(19)) + WS_WA), 0, scr, r, F.lane); continue; } r -= I_AB;
        if (r < I_AB) { p0_transpose_item(((const float*)karg(10)), D, 512, D, (bf16*)(((unsigned char*)karg(19)) + WS_WB), 0, scr, r, F.lane); continue; } r -= I_AB;
        if (r < I_SQ) { p0_transpose_item(((const float*)karg(11)), D, D, D, (bf16*)(((unsigned char*)karg(19)) + WS_WOUT), 0, scr, r, F.lane); continue; } r -= I_SQ;
        p0_transpose_item(((const float*)karg(13)), D, D, D, (bf16*)(((unsigned char*)karg(19)) + WS_WQ), 0, scr, r, F.lane);
    }
}

__device__ __forceinline__ void p1_norm(Frame& F) {
    const float* x = ((const float*)karg(0)); const float* g1 = ((const float*)karg(2)); const float* w_in = ((const float*)karg(6)); const float* b_forget = ((const float*)karg(7));
    const float* MOD = (const float*)(((unsigned char*)karg(19)) + WS_MOD); bf16* H = (bf16*)(((unsigned char*)karg(19)) + WS_H); float* LOGF = (float*)(((unsigned char*)karg(19)) + WS_LOGF);
    LAS float* wfl = (LAS float*)(F.lds);
    { float tmp[16];
#pragma unroll
      for (int n = 0; n < 16; ++n) { const int i = F.tid + n * NTHR; tmp[n] = w_in[(size_t)(i >> 3) * LDW_IN + 2304 + (i & 7)]; }
#pragma unroll
      for (int n = 0; n < 16; ++n) { const int i = F.tid + n * NTHR; wfl[(i & 7) * 1024 + (i >> 3)] = tmp[n]; } }
    __syncthreads();
    const int gw = F.vcu * NWAVES + F.wave, NGW = F.G * NWAVES;
    f32x4 cur[4], nxt[4];
    if (gw < M) { const f32x4* xr = (const f32x4*)(x + (size_t)gw * D) + F.lane;
#pragma unroll
        for (int j = 0; j < 4; ++j) cur[j] = xr[64 * j]; }
    for (int row = gw; row < M; row += NGW) {
        { const int nrow = row + NGW; if (nrow < M) { const f32x4* xr = (const f32x4*)(x + (size_t)nrow * D) + F.lane;
#pragma unroll
            for (int j = 0; j < 4; ++j) nxt[j] = xr[64 * j]; } }
        {{
        float ss = 0.f;
#pragma unroll
        for (int j = 0; j < 4; ++j) ss += (cur[j].x * cur[j].x + cur[j].y * cur[j].y) + (cur[j].z * cur[j].z + cur[j].w * cur[j].w);
        ss = wave_sum(ss);
        const float rstd = 1.0f / sqrtf(ss * (1.0f / D) + EPS);
        const int b = row >> 12; const float* mb = MOD + b * NMOD;
        float fl[8];
#pragma unroll
        for (int jj = 0; jj < 8; ++jj) fl[jj] = 0.f;
        f32x4 gv[4], shv[4], scv[4];
#pragma unroll
        for (int j = 0; j < 4; ++j) { const int col = 4 * F.lane + 256 * j; gv[j] = *(const f32x4*)(g1 + col); shv[j] = *(const f32x4*)(mb + col); scv[j] = *(const f32x4*)(mb + 1024 + col); }
#pragma unroll
        for (int j = 0; j < 4; ++j) { const int col = 4 * F.lane + 256 * j;
            const f32x4 g = gv[j], sh = shv[j], sc = scv[j];
            const f32x4 hv = (cur[j] * rstd) * g * (sc + 1.0f) + sh;
            u32x2 w; w.x = cvtpk(hv.x, hv.y); w.y = cvtpk(hv.z, hv.w);
            *(u32x2*)(H + (size_t)row * D + col) = w;
#pragma unroll
            for (int jj = 0; jj < 8; ++jj) { const f32x4 wv = *(const LAS f32x4*)(wfl + jj * 1024 + col); fl[jj] += (hv.x * wv.x + hv.y * wv.y) + (hv.z * wv.z + hv.w * wv.w); }
        }
        const int lane = F.lane; const float r1 = reduce8_t(fl, lane);
        if ((lane & 7) == 0) { const int jj = lane >> 3; const float z = r1 + b_forget[jj]; const float ls = fminf(z, 0.f) - log1pf(__expf(-fabsf(z))); LOGF[(size_t)row * 8 + jj] = ls; }
        }}
#pragma unroll
        for (int j = 0; j < 4; ++j) cur[j] = nxt[j];
    }
}

constexpr int KP = 72;
constexpr int VPF = 68;
constexpr int VPS = 260;
struct FlashState { f32x16 o[2]; float m, l; };

__device__ __forceinline__ void flash_tail(FlashState& st, f32x16& s0, f32x16& s1, const LAS bf16* Vs, int vp, int r32, int hi) {
    float mt = s0[0];
#pragma unroll
    for (int r = 1; r < 16; ++r) mt = fmaxf(mt, s0[r]);
#pragma unroll
    for (int r = 0; r < 16; ++r) mt = fmaxf(mt, s1[r]);
    mt = fmaxf(mt, __uint_as_float(xorx<32>(__float_as_uint(mt), 32 * hi)));
    const float mn = fmaxf(st.m, mt);
    const float alpha = __expf(st.m - mn);
    st.m = mn;
    float ps = 0.f;
#pragma unroll
    for (int r = 0; r < 16; ++r) { s0[r] = __expf(s0[r] - mn); ps += s0[r]; }
#pragma unroll
    for (int r = 0; r < 16; ++r) { s1[r] = __expf(s1[r] - mn); ps += s1[r]; }
    st.l = st.l * alpha + ps;
    if (__any(alpha != 1.0f)) {
#pragma unroll
        for (int r = 0; r < 16; ++r) { st.o[0][r] *= alpha; st.o[1][r] *= alpha; }
    }
#pragma unroll
    for (int blk = 0; blk < 2; ++blk)
#pragma unroll
        for (int s = 0; s < 2; ++s) {
            v4u pw;
            if (blk == 0) { pw.x = cvtpk(s0[8 * s + 0], s0[8 * s + 1]); pw.y = cvtpk(s0[8 * s + 2], s0[8 * s + 3]); pw.z = cvtpk(s0[8 * s + 4], s0[8 * s + 5]); pw.w = cvtpk(s0[8 * s + 6], s0[8 * s + 7]); }
            else          { pw.x = cvtpk(s1[8 * s + 0], s1[8 * s + 1]); pw.y = cvtpk(s1[8 * s + 2], s1[8 * s + 3]); pw.z = cvtpk(s1[8 * s + 4], s1[8 * s + 5]); pw.w = cvtpk(s1[8 * s + 6], s1[8 * s + 7]); }
            const bf16x8 pf = __builtin_bit_cast(bf16x8, pw);
#pragma unroll
            for (int db = 0; db < 2; ++db) {
                const LAS bf16* vp0 = Vs + (32 * db + r32) * vp + 32 * blk + 16 * s + 4 * hi;
                const s16x4 lo = *(const LAS s16x4*)vp0, hh = *(const LAS s16x4*)(vp0 + 8);
                const bf16x8 vf = __builtin_shufflevector(lo, hh, 0, 1, 2, 3, 4, 5, 6, 7);
                st.o[db] = MFMA32(vf, pf, st.o[db]);
            }
        }
}
__device__ __forceinline__ void flash_qk(f32x16& s0, f32x16& s1, const bf16x8 (&qf)[4], const LAS bf16* Ks, int r32, int hi) {
    s0 = (f32x16){0.f}; s1 = (f32x16){0.f};
#pragma unroll
    for (int r = 0; r < 16; ++r) { s0[r] = 0.f; s1[r] = 0.f; }
#pragma unroll
    for (int ks = 0; ks < 4; ++ks) {
        const bf16x8 a0 = *(const LAS bf16x8*)(Ks + r32 * KP + 16 * ks + 8 * hi);
        const bf16x8 a1 = *(const LAS bf16x8*)(Ks + (32 + r32) * KP + 16 * ks + 8 * hi);
        s0 = MFMA32(a0, qf[ks], s0); s1 = MFMA32(a1, qf[ks], s1);
    }
}
__device__ __forceinline__ void flash_qk2(f32x16& a0, f32x16& a1, f32x16& b0, f32x16& b1, const bf16x8 (&qa)[4], const bf16x8 (&qb)[4], const LAS bf16* Ks, int r32, int hi) {
#pragma unroll
    for (int r = 0; r < 16; ++r) { a0[r] = 0.f; a1[r] = 0.f; b0[r] = 0.f; b1[r] = 0.f; }
#pragma unroll
    for (int ks = 0; ks < 4; ++ks) {
        const bf16x8 k0 = *(const LAS bf16x8*)(Ks + r32 * KP + 16 * ks + 8 * hi);
        const bf16x8 k1 = *(const LAS bf16x8*)(Ks + (32 + r32) * KP + 16 * ks + 8 * hi);
        a0 = MFMA32(k0, qa[ks], a0); b0 = MFMA32(k0, qb[ks], b0); a1 = MFMA32(k1, qa[ks], a1); b1 = MFMA32(k1, qb[ks], b1);
    }
}
__device__ __forceinline__ void flash_soft(FlashState& st, f32x16& s0, f32x16& s1, int hi) {
    float mt = s0[0];
#pragma unroll
    for (int r = 1; r < 16; ++r) mt = fmaxf(mt, s0[r]);
#pragma unroll
    for (int r = 0; r < 16; ++r) mt = fmaxf(mt, s1[r]);
    mt = fmaxf(mt, __uint_as_float(xorx<32>(__float_as_uint(mt), 32 * hi)));
    const float mn = fmaxf(st.m, mt);
    const float alpha = __expf(st.m - mn);
    st.m = mn;
    float ps = 0.f;
#pragma unroll
    for (int r = 0; r < 16; ++r) { s0[r] = __expf(s0[r] - mn); ps += s0[r]; }
#pragma unroll
    for (int r = 0; r < 16; ++r) { s1[r] = __expf(s1[r] - mn); ps += s1[r]; }
    st.l = st.l * alpha + ps;
    if (__any(alpha != 1.0f)) {
#pragma unroll
        for (int r = 0; r < 16; ++r) { st.o[0][r] *= alpha; st.o[1][r] *= alpha; }
    }
}
__device__ __forceinline__ bf16x8 pack_p(const f32x16& p, int s) {
    v4u pw; pw.x = cvtpk(p[8 * s + 0], p[8 * s + 1]); pw.y = cvtpk(p[8 * s + 2], p[8 * s + 3]); pw.z = cvtpk(p[8 * s + 4], p[8 * s + 5]); pw.w = cvtpk(p[8 * s + 6], p[8 * s + 7]);
    return __builtin_bit_cast(bf16x8, pw);
}
__device__ __forceinline__ void flash_pv2(FlashState& sa, FlashState& sb, const f32x16& a0, const f32x16& a1, const f32x16& b0, const f32x16& b1, const LAS bf16* Vs, int vp, int r32, int hi) {
#pragma unroll
    for (int blk = 0; blk < 2; ++blk)
#pragma unroll
        for (int s = 0; s < 2; ++s) {
            const bf16x8 pfa = blk ? pack_p(a1, s) : pack_p(a0, s), pfb = blk ? pack_p(b1, s) : pack_p(b0, s);
#pragma unroll
            for (int db = 0; db < 2; ++db) {
                const LAS bf16* vp0 = Vs + (32 * db + r32) * vp + 32 * blk + 16 * s + 4 * hi;
                const s16x4 lo = *(const LAS s16x4*)vp0, hh = *(const LAS s16x4*)(vp0 + 8);
                const bf16x8 vf = __builtin_shufflevector(lo, hh, 0, 1, 2, 3, 4, 5, 6, 7);
                sa.o[db] = MFMA32(vf, pfa, sa.o[db]); sb.o[db] = MFMA32(vf, pfb, sb.o[db]);
            }
        }
}
__device__ __forceinline__ void flash_store(const FlashState& st, bf16* orow, int hi) {
    float lt = st.l + __uint_as_float(xorx<32>(__float_as_uint(st.l), 32 * hi));
    const float inv = 1.0f / lt;
#pragma unroll
    for (int db = 0; db < 2; ++db)
#pragma unroll
        for (int rg = 0; rg < 4; ++rg) { u32x2 w; w.x = cvtpk(st.o[db][4 * rg] * inv, st.o[db][4 * rg + 1] * inv); w.y = cvtpk(st.o[db][4 * rg + 2] * inv, st.o[db][4 * rg + 3] * inv);
            *(u32x2*)(orow + 32 * db + 8 * rg + 4 * hi) = w; }
}

__device__ __forceinline__ void fox_unit(Frame& F, int b, int h, int qb, float& kmax2) {
    const bf16* proj = (const bf16*)(((unsigned char*)karg(19)) + WS_PROJ); const float* LOGF = (const float*)(((unsigned char*)karg(19)) + WS_LOGF); bf16* OB = (bf16*)(((unsigned char*)karg(19)) + WS_OB);
    LAS float* Fs = (LAS float*)(F.lds);
    LAS float* wtot = (LAS float*)(F.lds + 16384);
    LAS bf16* Kb = (LAS bf16*)(F.lds + 16384 + 128);
    LAS bf16* Vb = (LAS bf16*)(F.lds + 16384 + 128 + 2 * 64 * KP * 2);
    const int lane = F.lane, wave = F.wave, tid = F.tid, r32 = lane & 31, hi = lane >> 5;
    const int q_end = 512 * (qb + 1), NT = q_end / 64;
    const size_t rowbase = (size_t)b * SEQ;
    if (kmax2 < 0.f) {
        float v[8]; float run = 0.f;
#pragma unroll
        for (int i = 0; i < 8; ++i) { const int pos = tid * 8 + i; const float lf = (pos < q_end) ? LOGF[(rowbase + pos) * 8 + h] : 0.f; run += lf; v[i] = run; }
        float inc = run;
#pragma unroll
        for (int o = 1; o < 64; o <<= 1) { const float t = __shfl_up(inc, o); if (lane >= o) inc += t; }
        if (lane == 63) wtot[wave] = inc;
        __syncthreads();
        float off = inc - run;
        for (int w = 0; w < wave; ++w) off += wtot[w];
#pragma unroll
        for (int i = 0; i < 8; ++i) Fs[tid * 8 + i] = v[i] + off;
    }
    const int qrow = 512 * qb + 64 * wave + r32, qrowB = qrow + 32;
    bf16x8 qf[4], qg[4];
    { const bf16* qp = proj + (rowbase + qrow) * NPROJ + C_QB + 64 * h + 8 * hi;
#pragma unroll
      for (int ks = 0; ks < 4; ++ks) { qf[ks] = *(const bf16x8*)(qp + 16 * ks); qg[ks] = *(const bf16x8*)(qp + (size_t)32 * NPROJ + 16 * ks); } }
    const int tq = 8 * qb + wave;
    LAS bf16* Qs = (LAS bf16*)(F.lds + 53248) + wave * (64 * KP);
    {
        float qn = 0.f;
#pragma unroll
        for (int ks = 0; ks < 4; ++ks)
#pragma unroll
            for (int j = 0; j < 8; ++j) { const float e = __uint_as_float(((unsigned)(unsigned short)qf[ks][j]) << 16); qn += e * e; }
        qn += __shfl_xor(qn, 32);
        { float qn2 = 0.f;
#pragma unroll
          for (int ks = 0; ks < 4; ++ks)
#pragma unroll
              for (int j = 0; j < 8; ++j) { const float e = __uint_as_float(((unsigned)(unsigned short)qg[ks][j]) << 16); qn2 += e * e; }
          qn2 += __shfl_xor(qn2, 32); qn = fmaxf(qn, qn2); }
#pragma unroll
        for (int o = 1; o < 32; o <<= 1) qn = fmaxf(qn, __shfl_xor(qn, o));
        float kn = 0.f;
        if (kmax2 < 0.f) {
            for (int p0 = 0; p0 < q_end; p0 += 4 * 64) {
                v4u w4[4];
#pragma unroll
                for (int i = 0; i < 4; ++i) w4[i] = *(const v4u*)(proj + (rowbase + p0 + 64 * i + (tid >> 3)) * NPROJ + C_KB + 64 * h + 8 * (tid & 7));
#pragma unroll
                for (int i = 0; i < 4; ++i) { const unsigned wx = w4[i].x, wy = w4[i].y, wz = w4[i].z, ww = w4[i].w;
                    float s = bflo(wx) * bflo(wx) + bfhi(wx) * bfhi(wx) + bflo(wy) * bflo(wy) + bfhi(wy) * bfhi(wy) + bflo(wz) * bflo(wz) + bfhi(wz) * bfhi(wz) + bflo(ww) * bflo(ww) + bfhi(ww) * bfhi(ww);
                    s += __shfl_xor(s, 1); s += __shfl_xor(s, 2); s += __shfl_xor(s, 4);
                    kn = fmaxf(kn, s); } }
            kn = wave_max(kn);
        }
        if (lane == 0) { wtot[8 + wave] = qn; wtot[16 + wave] = kn; }
    }
#pragma unroll
    for (int ks = 0; ks < 4; ++ks) { *(LAS bf16x8*)(Qs + r32 * KP + 16 * ks + 8 * hi) = qf[ks]; *(LAS bf16x8*)(Qs + (32 + r32) * KP + 16 * ks + 8 * hi) = qg[ks]; }
    FlashState st, su; st.m = -INFINITY; st.l = 0.f; su.m = -INFINITY; su.l = 0.f;
#pragma unroll
    for (int r = 0; r < 16; ++r) { st.o[0][r] = 0.f; st.o[1][r] = 0.f; su.o[0][r] = 0.f; su.o[1][r] = 0.f; }
    const int srow = tid >> 3, sch = tid & 7;
    const bf16* kg = proj + (rowbase + srow) * NPROJ + C_KB + 64 * h + 8 * sch;
    const bf16* vg = proj + (rowbase + srow) * NPROJ + C_VB + 64 * h + 8 * sch;
    v4u kreg, vreg;
    { const size_t o = (size_t)(NT - 1) * 64 * NPROJ; kreg = *(const v4u*)(kg + o); vreg = *(const v4u*)(vg + o); }
    int cur = 0;
    {   *(LAS v4u*)(Kb + srow * KP + 8 * sch) = kreg;
        const unsigned short* vs = (const unsigned short*)&vreg;
#pragma unroll
        for (int i = 0; i < 8; ++i) Vb[(8 * sch + i) * VPF + srow] = vs[i];
    }
    __syncthreads();
    const float fq = Fs[qrow], fqB = Fs[qrowB];
    int t_lo = 0;
    {
        float qm = 0.f, km = 0.f;
#pragma unroll
        for (int w = 0; w < 8; ++w) { qm = fmaxf(qm, wtot[8 + w]); km = fmaxf(km, wtot[16 + w]); }
        if (kmax2 < 0.f) kmax2 = km;
        const float A = 0.125f * sqrtf(qm) * sqrtf(kmax2) * 1.01f, f0 = Fs[512 * qb];
        for (int t = NT - 9; t >= 0; --t) if (Fs[64 * t + 63] - f0 > 2.0f * A + 60.0f) { t_lo = t + 1; break; }
    }
    for (int t = NT - 1; t >= t_lo; --t) {
        if (t > t_lo) { const size_t o = (size_t)(t - 1) * 64 * NPROJ; kreg = *(const v4u*)(kg + o); vreg = *(const v4u*)(vg + o); }
        if (t <= tq) {
            const LAS bf16* Ks = Kb + cur * 64 * KP; const LAS bf16* Vs = Vb + cur * 64 * VPF;
            bf16x8 qa[4], qb4[4];
#pragma unroll
            for (int ks = 0; ks < 4; ++ks) { qa[ks] = *(const LAS bf16x8*)(Qs + r32 * KP + 16 * ks + 8 * hi); qb4[ks] = *(const LAS bf16x8*)(Qs + (32 + r32) * KP + 16 * ks + 8 * hi); }
            f32x16 s0, s1, u0, u1; flash_qk2(s0, s1, u0, u1, qa, qb4, Ks, r32, hi);
            const LAS float* Fk = Fs + 64 * t;
            const bool diag = (t == tq);
#pragma unroll
            for (int rg = 0; rg < 4; ++rg) {
                const f32x4 f0 = *(const LAS f32x4*)(Fk + 8 * rg + 4 * hi), f1 = *(const LAS f32x4*)(Fk + 32 + 8 * rg + 4 * hi);
#pragma unroll
                for (int i = 0; i < 4; ++i) { const int r = 4 * rg + i; const int kv = 64 * t + 8 * rg + 4 * hi + i;
                    float a = s0[r] * 0.125f + (fq - f0[i]), c = s1[r] * 0.125f + (fq - f1[i]), d = u0[r] * 0.125f + (fqB - f0[i]), e = u1[r] * 0.125f + (fqB - f1[i]);
                    if (diag) { if (kv > qrow) a = -INFINITY; if (kv + 32 > qrow) c = -INFINITY; if (kv > qrowB) d = -INFINITY; if (kv + 32 > qrowB) e = -INFINITY; }
                    s0[r] = a; s1[r] = c; u0[r] = d; u1[r] = e; }
            }
            flash_soft(st, s0, s1, hi); flash_soft(su, u0, u1, hi);
            flash_pv2(st, su, s0, s1, u0, u1, Vs, VPF, r32, hi);
        }
        if (t > t_lo) {
            const int nb = cur ^ 1;
            *(LAS v4u*)(Kb + nb * 64 * KP + srow * KP + 8 * sch) = kreg;
            const unsigned short* vs = (const unsigned short*)&vreg;
#pragma unroll
            for (int i = 0; i < 8; ++i) Vb[nb * 64 * VPF + (8 * sch + i) * VPF + srow] = vs[i];
        }
        __syncthreads();
        cur ^= 1;
    }
    flash_store(st, OB + (rowbase + qrow) * 512 + 64 * h, hi); flash_store(su, OB + (rowbase + qrowB) * 512 + 64 * h, hi);
    __syncthreads();
}

__device__ const unsigned char T5_BUCKET[128] = {0,1,2,3,4,5,6,7,8,9,10,11,12,13,14,15,16,16,16,17,17,18,18,18,19,19,19,20,20,20,20,21,21,21,21,22,22,22,22,22,23,23,23,23,23,23,24,24,24,24,24,24,25,25,25,25,25,25,25,26,26,26,26,26,26,26,26,27,27,27,27,27,27,27,27,27,27,28,28,28,28,28,28,28,28,28,28,29,29,29,29,29,29,29,29,29,29,29,29,30,30,30,30,30,30,30,30,30,30,30,30,30,30,31,31,31,31,31,31,31,31,31,31,31,31,31,31,31};

__device__ __forceinline__ void swa_unit(Frame& F, int b, int kvh, int n) {
    const bf16* proj = (const bf16*)(((unsigned char*)karg(19)) + WS_PROJ); bf16* OA = (bf16*)(((unsigned char*)karg(19)) + WS_OA);
    const float* sinks = ((const float*)karg(8)); const float* rel_bias = ((const float*)karg(12));
    LAS bf16* Kb = (LAS bf16*)(F.lds);
    LAS bf16* Vb = (LAS bf16*)(F.lds + 36864);
    LAS float* bt = (LAS float*)(F.lds + 36864 + 33280);
    const int lane = F.lane, wave = F.wave, tid = F.tid, r32 = lane & 31, hi = lane >> 5;
    const size_t rowbase = (size_t)b * SEQ;
    {
        const int g = tid >> 7, d = tid & 127;
        bt[tid] = rel_bias[(int)T5_BUCKET[d] * 8 + kvh * 4 + g];
#pragma unroll
        for (int i = 0; i < 4; ++i) {
            const int idx = tid + i * NTHR, kb = idx >> 3, sch = idx & 7; const int pos = 128 * (n - 1) + kb;
            v4u kreg = (v4u){0u, 0u, 0u, 0u}, vreg = (v4u){0u, 0u, 0u, 0u};
            if (pos >= 0) { const bf16* p = proj + (rowbase + pos) * NPROJ + 64 * kvh + 8 * sch; kreg = *(const v4u*)(p + C_KA); vreg = *(const v4u*)(p + C_VA); }
            *(LAS v4u*)(Kb + kb * KP + 8 * sch) = kreg;
            const unsigned short* vs = (const unsigned short*)&vreg;
#pragma unroll
            for (int j = 0; j < 8; ++j) Vb[(8 * sch + j) * VPS + kb] = vs[j];
        }
    }
    __syncthreads();
    const int g = wave & 3, qh = wave >> 2, head = kvh * 4 + g;
    const LAS float* btg = bt + g * 128;
    for (int sb = 0; sb < 2; ++sb) {
        const int qrel0 = 64 * qh + 32 * sb, qrel = qrel0 + r32;
        const size_t row = rowbase + 128 * n + qrel;
        bf16x8 qf[4];
        { const bf16* qp = proj + row * NPROJ + C_QA + 64 * head + 8 * hi;
#pragma unroll
          for (int ks = 0; ks < 4; ++ks) qf[ks] = *(const bf16x8*)(qp + 16 * ks); }
        FlashState st; st.m = sinks[head]; st.l = (hi == 0) ? 1.0f : 0.0f;
#pragma unroll
        for (int r = 0; r < 16; ++r) { st.o[0][r] = 0.f; st.o[1][r] = 0.f; }
        const int t_lo = (qrel0 + 1) >> 6, t_hi = (qrel0 + 159) >> 6;
        for (int t = t_lo; t <= t_hi; ++t) {
            f32x16 s0, s1; flash_qk(s0, s1, qf, Kb + t * 64 * KP, r32, hi);
#pragma unroll
            for (int r = 0; r < 16; ++r) {
                const int kb0 = 64 * t + crow(r, hi), kb1 = kb0 + 32;
                const int d0 = 128 + qrel - kb0, d1 = d0 - 32;
                const bool v0 = (d0 >= 0) && (d0 < 128) && (n > 0 || kb0 >= 128);
                const bool v1 = (d1 >= 0) && (d1 < 128) && (n > 0 || kb1 >= 128);
                const float b0 = btg[d0 & 127], b1 = btg[d1 & 127];
                s0[r] = v0 ? (s0[r] * 0.125f + b0) : -INFINITY;
                s1[r] = v1 ? (s1[r] * 0.125f + b1) : -INFINITY;
            }
            flash_tail(st, s0, s1, Vb + 64 * t, VPS, r32, hi);
        }
        flash_store(st, OA + row * 512 + 64 * head, hi);
    }
    __syncthreads();
}
__device__ __forceinline__ void p3_attention(Frame& F) {
    for (int item = F.vcu; item < 256; item += F.G) {
        swa_unit(F, item >> 6, (item >> 5) & 1, item & 31);
        const int bh = item >> 3, j = item & 7;
        float kmax2 = -1.0f;
        fox_unit(F, bh >> 3, bh & 7, j, kmax2);
    }
}

struct PairOrder {
    pg8::StaticOrder S;
    __device__ bool next(int i, pg8::Unit& u) const { if (!S.next(i >> 1, u)) return false; u.src = i & 1; return true; }
    __device__ __forceinline__ void a_ready(const pg8::Unit&) const {}
    __device__ __forceinline__ void done(const pg8::Unit&) const {}
};
__device__ __forceinline__ float sigmoidf_(float z) { return 1.0f / (1.0f + __expf(-z)); }
struct EpiGate {
    static constexpr bool PERM = true, AFTER_DRAIN = false, CHAIN = true;
    const bf16* proj; bf16* mixed;
    __device__ __forceinline__ void operator()(pg8::f32x4 (&acc)[2][2][4][2], const pg8::Unit& u, int wr, int wc, int fr, int fq) const {
#pragma unroll
        for (int ai = 0; ai < 2; ++ai) {
            v4u gbv[4][2], gav[4][2];
#pragma unroll
            for (int m = 0; m < 4; ++m) { const size_t row = (size_t)u.pm * 256 + ai * 128 + wr * 64 + m * 16 + fr;
#pragma unroll
                for (int bj = 0; bj < 2; ++bj) { const int col0 = u.pn * 256 + bj * 128 + wc * 32 + 8 * fq;
                    gbv[m][bj] = *(const v4u*)(proj + row * NPROJ + C_GLB + col0);
                    if (u.src == 0) gav[m][bj] = *(const v4u*)(proj + row * NPROJ + C_GLA + col0); } }
#pragma unroll
            for (int m = 0; m < 4; ++m) { const size_t row = (size_t)u.pm * 256 + ai * 128 + wr * 64 + m * 16 + fr;
#pragma unroll
                for (int bj = 0; bj < 2; ++bj) { const int col0 = u.pn * 256 + bj * 128 + wc * 32 + 8 * fq;
                    const unsigned gbw[4] = {gbv[m][bj].x, gbv[m][bj].y, gbv[m][bj].z, gbv[m][bj].w};
                    if (u.src == 0) {
                        const unsigned gaw[4] = {gav[m][bj].x, gav[m][bj].y, gav[m][bj].z, gav[m][bj].w};
#pragma unroll
                        for (int e = 0; e < 8; ++e) { const float za = (e & 1) ? bfhi(gaw[e >> 1]) : bflo(gaw[e >> 1]), zb = (e & 1) ? bfhi(gbw[e >> 1]) : bflo(gbw[e >> 1]);
                            const float ratio = (1.0f + __expf(-zb)) * __builtin_amdgcn_rcpf(1.0f + __expf(-za));
                            acc[ai][bj][m][e >> 2][e & 3] *= ratio; }
                    } else {
                        float v[8];
#pragma unroll
                        for (int e = 0; e < 8; ++e) { const float zb = (e & 1) ? bfhi(gbw[e >> 1]) : bflo(gbw[e >> 1]); v[e] = acc[ai][bj][m][e >> 2][e & 3] * __builtin_amdgcn_rcpf(1.0f + __expf(-zb)); }
                        v4u w; w.x = cvtpk(v[0], v[1]); w.y = cvtpk(v[2], v[3]); w.z = cvtpk(v[4], v[5]); w.w = cvtpk(v[6], v[7]);
                        *(v4u*)(mixed + row * D + col0) = w;
                    }
                }
            }
        }
    }
};
struct EpiRes {
    static constexpr bool PERM = true, AFTER_DRAIN = false, CHAIN = false;
    const float* x; const float* mod; float* x1;
    __device__ __forceinline__ void operator()(const pg8::f32x4 (&acc)[2][2][4][2], const pg8::Unit& u, int wr, int wc, int fr, int fq) const {
        const int b = (u.pm * 256) >> 12;
        pg8::f32x4 gt[2][2];
#pragma unroll
        for (int bj = 0; bj < 2; ++bj)
#pragma unroll
            for (int n = 0; n < 2; ++n) gt[bj][n] = *(const pg8::f32x4*)(mod + b * NMOD + 2048 + u.pn * 256 + bj * 128 + wc * 32 + 8 * fq + 4 * n);
#pragma unroll
        for (int ai = 0; ai < 2; ++ai) {
            pg8::f32x4 xin[4][2][2];
#pragma unroll
            for (int m = 0; m < 4; ++m) { const size_t row = (size_t)u.pm * 256 + ai * 128 + wr * 64 + m * 16 + fr;
#pragma unroll
                for (int bj = 0; bj < 2; ++bj)
#pragma unroll
                    for (int n = 0; n < 2; ++n) xin[m][bj][n] = *(const pg8::f32x4*)(x + row * D + u.pn * 256 + bj * 128 + wc * 32 + 8 * fq + 4 * n); }
#pragma unroll
            for (int m = 0; m < 4; ++m) { const size_t row = (size_t)u.pm * 256 + ai * 128 + wr * 64 + m * 16 + fr;
#pragma unroll
                for (int bj = 0; bj < 2; ++bj)
#pragma unroll
                    for (int n = 0; n < 2; ++n) *(pg8::f32x4*)(x1 + row * D + u.pn * 256 + bj * 128 + wc * 32 + 8 * fq + 4 * n) = xin[m][bj][n] + gt[bj][n] * acc[ai][bj][m][n]; }
        }
    }
};

__device__ __forceinline__ void p6_norm2(Frame& F) {
    const float* x1 = (const float*)(((unsigned char*)karg(19)) + WS_X1); const float* g2 = ((const float*)karg(3)); const float* MOD = (const float*)(((unsigned char*)karg(19)) + WS_MOD); bf16* H2 = (bf16*)(((unsigned char*)karg(19)) + WS_H2); unsigned char* H2Q = (unsigned char*)(((unsigned char*)karg(19)) + WS_H2Q); float* H2S = (float*)(((unsigned char*)karg(19)) + WS_H2S);
    const int gw = F.vcu * NWAVES + F.wave, NGW = F.G * NWAVES;
    f32x4 cur[4], nxt[4];
    if (gw < M) { const f32x4* xr = (const f32x4*)(x1 + (size_t)gw * D) + F.lane;
#pragma unroll
        for (int j = 0; j < 4; ++j) cur[j] = xr[64 * j]; }
    for (int row = gw; row < M; row += NGW) {
        { const int nrow = row + NGW; if (nrow < M) { const f32x4* xr = (const f32x4*)(x1 + (size_t)nrow * D) + F.lane;
#pragma unroll
            for (int j = 0; j < 4; ++j) nxt[j] = xr[64 * j]; } }
        {
        f32x4 v[4], hq[4]; float ss = 0.f;
#pragma unroll
        for (int j = 0; j < 4; ++j) { v[j] = cur[j]; ss += (v[j].x * v[j].x + v[j].y * v[j].y) + (v[j].z * v[j].z + v[j].w * v[j].w); }
        ss = wave_sum(ss);
        const float rstd = 1.0f / sqrtf(ss * (1.0f / D) + EPS);
        const int b = row >> 12; const float* mb = MOD + b * NMOD;
        f32x4 gv[4], shv[4], scv[4];
#pragma unroll
        for (int j = 0; j < 4; ++j) { const int col = 4 * F.lane + 256 * j; gv[j] = *(const f32x4*)(g2 + col); shv[j] = *(const f32x4*)(mb + 3072 + col); scv[j] = *(const f32x4*)(mb + 4096 + col); }
#pragma unroll
        for (int j = 0; j < 4; ++j) { const int col = 4 * F.lane + 256 * j;
            const f32x4 g = gv[j], sh = shv[j], sc = scv[j];
            const f32x4 hv = (v[j] * rstd) * g * (sc + 1.0f) + sh;
            u32x2 w; w.x = cvtpk(hv.x, hv.y); w.y = cvtpk(hv.z, hv.w);
            *(u32x2*)(H2 + (size_t)row * D + col) = w; hq[j] = hv; }
        float am = 0.f;
#pragma unroll
        for (int j = 0; j < 4; ++j) am = fmaxf(fmaxf(am, fmaxf(fabsf(hq[j].x), fabsf(hq[j].y))), fmaxf(fabsf(hq[j].z), fabsf(hq[j].w)));
        am = wave_max(am);
        const float sc = am > 0.f ? am * (1.0f / 127.0f) : 1.0f, inv = 1.0f / sc;
        v4u qa;
#pragma unroll
        for (int j = 0; j < 4; ++j) { const int b0 = (int)rintf(hq[j].x * inv), b1 = (int)rintf(hq[j].y * inv), b2 = (int)rintf(hq[j].z * inv), b3 = (int)rintf(hq[j].w * inv);
            qa[j] = (unsigned)(b0 & 255) | ((unsigned)(b1 & 255) << 8) | ((unsigned)(b2 & 255) << 16) | ((unsigned)(b3 & 255) << 24); }
        *(v4u*)(H2Q + (size_t)row * D + 16 * F.lane) = qa;
        if (F.lane == 0) H2S[row] = sc;
        }
#pragma unroll
        for (int j = 0; j < 4; ++j) cur[j] = nxt[j];
    }
}

__device__ __forceinline__ unsigned f2ord(float f) { const unsigned u = __float_as_uint(f); return u ^ ((unsigned)((int)u >> 31) | 0x80000000u); }
__device__ __forceinline__ float ord2f(unsigned o) { const unsigned u = (o & 0x80000000u) ? (o & 0x7fffffffu) : ~o; return __uint_as_float(u); }
#define CE_DESC(a, b) do { const unsigned _x = (a), _y = (b); (a) = _x > _y ? _x : _y; (b) = _x > _y ? _y : _x; } while (0)
__device__ __forceinline__ void sort16(unsigned (&k)[16]) {
#pragma unroll
    for (int size = 2; size <= 16; size <<= 1)
#pragma unroll
        for (int stride = size >> 1; stride > 0; stride >>= 1)
#pragma unroll
            for (int i = 0; i < 16; ++i) { const int j = i ^ stride; if (j > i) { if ((i & size) == 0) CE_DESC(k[i], k[j]); else CE_DESC(k[j], k[i]); } }
}
__device__ __forceinline__ void merge16(unsigned (&a)[16], const unsigned (&b)[16]) {
#pragma unroll
    for (int i = 0; i < 16; ++i) a[i] = a[i] > b[15 - i] ? a[i] : b[15 - i];
#pragma unroll
    for (int stride = 8; stride > 0; stride >>= 1)
#pragma unroll
        for (int i = 0; i < 16; ++i) { const int j = i ^ stride; if (j > i) CE_DESC(a[i], a[j]); }
}
__device__ __forceinline__ void top16_of_64(unsigned (&g0)[16], unsigned (&g1)[16], unsigned (&g2)[16], unsigned (&g3)[16]) {
    sort16(g0); sort16(g1); sort16(g2); sort16(g3);
    merge16(g0, g1); merge16(g2, g3); merge16(g0, g2);
}
constexpr int NCAND = 50;
__device__ __forceinline__ void p8a_topk(Frame& F) {
    const bf16* QP = (const bf16*)(((unsigned char*)karg(19)) + WS_QP); const bf16* SUBK = (const bf16*)(((unsigned char*)karg(19)) + WS_SUBK);
    unsigned short* PIDX = (unsigned short*)(((unsigned char*)karg(19)) + WS_PIDX); float* PG = (float*)(((unsigned char*)karg(19)) + WS_PG);
    LAS unsigned short* Elds = (LAS unsigned short*)(F.lds) + F.wave * (NCAND * 64);
    const int lane = F.lane, r32 = lane & 31, hi = lane >> 5;
    const int gw = F.vcu * NWAVES + F.wave, NGW = F.G * NWAVES;
    for (int it2 = 0; it2 < 2 * ((M / 64 - F.vcu + F.G - 1) / F.G); ++it2) {
        const int wi = F.vcu + (it2 >> 1) * F.G;
        const int tile = 2 * wi + (it2 & 1);
        const int tok = tile * 32 + r32;
        { const int h = F.wave;
            unsigned top[2][16];
#pragma unroll
            for (int p = 0; p < 2; ++p) {
                bf16x8 qf[4];
                { const bf16* qp = QP + (size_t)tok * D + h * 128 + p * 64 + 8 * hi;
#pragma unroll
                  for (int ks = 0; ks < 4; ++ks) qf[ks] = *(const bf16x8*)(qp + 16 * ks); }
                const bf16* kp = SUBK + (size_t)((h * 2 + p) * 128 + r32) * 64 + 8 * hi;
                unsigned kk[4][16];
#pragma unroll
                for (int blk = 0; blk < 4; ++blk) {
                    f32x16 acc;
#pragma unroll
                    for (int r = 0; r < 16; ++r) acc[r] = 0.f;
#pragma unroll
                    for (int ks = 0; ks < 4; ++ks) { const bf16x8 a = *(const bf16x8*)(kp + (size_t)blk * 32 * 64 + 16 * ks); acc = MFMA32(a, qf[ks], acc); }
#pragma unroll
                    for (int r = 0; r < 16; ++r) { const int key = 32 * blk + crow(r, hi); kk[blk][r] = (f2ord(acc[r]) & ~127u) | (unsigned)(127 - key); }
                }
                top16_of_64(kk[0], kk[1], kk[2], kk[3]);
                unsigned other[16];
#pragma unroll
                for (int i = 0; i < 16; ++i) other[i] = xorx<32>(kk[0][i], lane);
                merge16(kk[0], other);
#pragma unroll
                for (int i = 0; i < 16; ++i) top[p][i] = kk[0][i];
            }
            float s1[16], s2[16]; unsigned i1[16], i2[16];
#pragma unroll
            for (int i = 0; i < 16; ++i) { s1[i] = ord2f(top[0][i] & ~127u); i1[i] = 127u - (top[0][i] & 127u); s2[i] = ord2f(top[1][i] & ~127u); i2[i] = 127u - (top[1][i] & 127u); }
            unsigned ck[4][16];
#pragma unroll
            for (int c = 0; c < 64; ++c) {
                if (c < NCAND) { constexpr int CA[NCAND] = {0,0,0,0,0,0,0,0,0,0,0,0,0,0,0,0,1,1,1,1,1,1,1,1,2,2,2,2,2,3,3,3,3,4,4,4,5,5,6,6,7,7,8,9,10,11,12,13,14,15}; constexpr int CB[NCAND] = {0,1,2,3,4,5,6,7,8,9,10,11,12,13,14,15,0,1,2,3,4,5,6,7,0,1,2,3,4,0,1,2,3,0,1,2,0,1,0,1,0,1,0,0,0,0,0,0,0,0}; const int a = CA[c], b = CB[c];
                    ck[c >> 4][c & 15] = (f2ord(s1[a] + s2[b]) & ~63u) | (unsigned)(63 - c);
                    Elds[c * 64 + lane] = (unsigned short)(i1[a] * 128u + i2[b]); }
                else ck[c >> 4][c & 15] = 0u;
            }
            top16_of_64(ck[0], ck[1], ck[2], ck[3]);
            float w[16]; float wsum = 0.f; const float v0 = ord2f(ck[0][0] & ~63u);
#pragma unroll
            for (int r = 0; r < 16; ++r) { w[r] = __expf(ord2f(ck[0][r] & ~63u) - v0); wsum += w[r]; }
            const float winv = 1.0f / wsum;
#pragma unroll
            for (int r = 0; r < 16; ++r) if ((r >> 3) == hi) {
                const int c = 63 - (int)(ck[0][r] & 63u);
                const unsigned short eid = Elds[c * 64 + lane];
                PIDX[(size_t)tok * 128 + h * 16 + r] = eid; PG[(size_t)tok * 128 + h * 16 + r] = w[r] * winv; }
        }
    }
}

__device__ __forceinline__ float gelu_erf(float v) { return 0.5f * v * (1.0f + erff(v * 0.70710678118654752f)); }

#define PROBE_REPA 1
#define PROBE_REPB 1
constexpr int NR = 8, RSH = 18, BSA = 8, BSB = 8, ELP = 136, TPS = 8;
__device__ __forceinline__ void sort128(unsigned& e0, unsigned& e1, int lane) {
#pragma unroll
    for (int size = 2; size <= 128; size <<= 1) {
#pragma unroll
        for (int stride = size >> 1; stride > 0; stride >>= 1) {
            if (stride == 64) { const unsigned lo = e0 < e1 ? e0 : e1, hi = e0 < e1 ? e1 : e0; e0 = lo; e1 = hi; }
            else {
                const bool lower = (lane & stride) == 0;
                const bool asc0 = (size == 128) ? true : (size == 64 ? true : ((lane & size) == 0));
                const bool asc1 = (size == 128) ? true : (size == 64 ? false : ((lane & size) == 0));
                const unsigned p0 = xorx_sw(e0, lane, stride), p1 = xorx_sw(e1, lane, stride);
                const unsigned mn0 = e0 < p0 ? e0 : p0, mx0 = e0 < p0 ? p0 : e0, mn1 = e1 < p1 ? e1 : p1, mx1 = e1 < p1 ? p1 : e1;
                e0 = (lower == asc0) ? mn0 : mx0; e1 = (lower == asc1) ? mn1 : mx1;
            }
        }
    }
}
template <int BS> __device__ __forceinline__ void sw_issue(v4u (&buf)[BS], const LAS unsigned* el, const unsigned char* tab, unsigned voff) {
#pragma unroll
    for (int i = 0; i < BS; ++i) { const unsigned off = (el[i] << 10) + voff;
        buf[i] = *(const v4u*)(tab + off); }
}
template <int BS> __device__ __forceinline__ void sw_proc_a(const v4u (&buf)[BS], const v4u& hq, LAS float* wl, int s, int n, int lane) {
    const int hx = (int)hq.x, hy = (int)hq.y, hz = (int)hq.z, hw = (int)hq.w;
    float dd[8];
#pragma unroll
    for (int i = 0; i < 8; ++i) dd[i] = 0.f;
#pragma unroll
    for (int i = 0; i < BS; ++i) if (i < n) { const int dx = (int)buf[i].x, dy = (int)buf[i].y, dz = (int)buf[i].z, dw = (int)buf[i].w;
        int t = __builtin_amdgcn_sdot4(hx, dx, 0, false); t = __builtin_amdgcn_sdot4(hy, dy, t, false); t = __builtin_amdgcn_sdot4(hz, dz, t, false); t = __builtin_amdgcn_sdot4(hw, dw, t, false);
        dd[i] = (float)t; }
    const float r1 = reduce8_t(dd, lane);
    if ((lane & 7) == 0 && (lane >> 3) < n) wl[s + (lane >> 3)] = r1;
}
template <int BS> __device__ __forceinline__ void sw_proc_b(const v4u (&buf)[BS], f32x2_t (&acc)[8], const LAS float* wl, int s, int n) {
    float wr[BS];
#pragma unroll
    for (int i = 0; i < BS; ++i) wr[i] = wl[s + i];
#pragma unroll
    for (int i = 0; i < BS; ++i) if (i < n) {
        const float w = wr[i];
        const f32x2_t wv = {w, w};
        const unsigned ux = buf[i].x, uy = buf[i].y, uz = buf[i].z, uw = buf[i].w;
        acc[0] += wv * __builtin_amdgcn_cvt_pk_f32_fp8((int)ux, false); acc[1] += wv * __builtin_amdgcn_cvt_pk_f32_fp8((int)ux, true);
        acc[2] += wv * __builtin_amdgcn_cvt_pk_f32_fp8((int)uy, false); acc[3] += wv * __builtin_amdgcn_cvt_pk_f32_fp8((int)uy, true);
        acc[4] += wv * __builtin_amdgcn_cvt_pk_f32_fp8((int)uz, false); acc[5] += wv * __builtin_amdgcn_cvt_pk_f32_fp8((int)uz, true);
        acc[6] += wv * __builtin_amdgcn_cvt_pk_f32_fp8((int)uw, false); acc[7] += wv * __builtin_amdgcn_cvt_pk_f32_fp8((int)uw, true); }
}
__device__ __forceinline__ void sw_warm(v4u (&pf)[4], const unsigned char* tab, int range, int lw, unsigned voff) {
#pragma unroll
    for (int i = 0; i < 4; ++i) { const unsigned off = ((unsigned)(range * 1024 + lw * 4 + i) << 10) + voff; pf[i] = *(const v4u*)(tab + off); }
}
__device__ __forceinline__ void sw_warm_done(const v4u (&pf)[4]) {
#pragma unroll
    for (int i = 0; i < 4; ++i) asm volatile("" :: "v"(pf[i]));
}
template <int FAKE> __device__ __forceinline__ void p8b_sweep(Frame& F) {
    const float* X1 = (const float*)(((unsigned char*)karg(19)) + WS_X1); const float* MOD = (const float*)(((unsigned char*)karg(19)) + WS_MOD);
    const unsigned char* H2Q = (const unsigned char*)(((unsigned char*)karg(19)) + WS_H2Q); const float* H2S = (const float*)(((unsigned char*)karg(19)) + WS_H2S);
    const unsigned char* EDq = (const unsigned char*)(((unsigned char*)karg(19)) + WS_ED); const unsigned char* EUq = (const unsigned char*)(((unsigned char*)karg(19)) + WS_EU); const float* EDS = (const float*)(((unsigned char*)karg(19)) + WS_EDS);
    const unsigned short* PIDX = (const unsigned short*)(((unsigned char*)karg(19)) + WS_PIDX); const float* PG = (const float*)(((unsigned char*)karg(19)) + WS_PG);
    const float* fg = ((const float*)karg(17));
    const int gw = F.vcu * NWAVES + F.wave, NGW = F.G * NWAVES;
    for (int wi = F.vcu; wi < M / 64; wi += F.G) {
        const int tb = wi * 8 + F.wave;
        unsigned ones = ~0u; asm volatile("" : "+s"(ones));
        int lane = (int)__builtin_amdgcn_mbcnt_hi(ones, __builtin_amdgcn_mbcnt_lo(ones, 0u)); asm volatile("" : "+v"(lane));
        const int tok0 = tb * 8;
        unsigned E0[8], E1[8];
        LAS float* Wl = (LAS float*)(F.lds) + F.wave * 1024;
        LAS unsigned* El = (LAS unsigned*)(F.lds + 32768) + F.wave * (8 * ELP);
        unsigned voff = 16u * (unsigned)lane; asm volatile("" : "+v"(voff));
        LAS int* Bnd = (LAS int*)(F.lds + 67584) + F.wave * (8 * (NR + 1));
#pragma unroll
        for (int k = 0; k < 8; ++k) {
            const size_t base = (size_t)(tok0 + k) * 128;
            E0[k] = ((unsigned)PIDX[base + lane] << 7) | (unsigned)lane; E1[k] = ((unsigned)PIDX[base + 64 + lane] << 7) | (unsigned)(64 + lane);
            sort128(E0[k], E1[k], lane);
            if (FAKE) { E0[k] = (E0[k] & 0x1ffffu) ; E1[k] = (E1[k] & 0x1ffffu); sort128(E0[k], E1[k], lane); }
            El[k * ELP + lane] = E0[k] >> 7; El[k * ELP + 64 + lane] = E1[k] >> 7;
            if (lane < 8) El[k * ELP + 128 + lane] = (unsigned)__builtin_amdgcn_readlane((int)E1[k], 63) >> 7;
        }
        for (int repa = 0; repa < PROBE_REPA; ++repa) {
            v4u hq[8];
#pragma unroll
            for (int k = 0; k < 8; ++k) hq[k] = *(const v4u*)(H2Q + (size_t)(tok0 + k) * D + 16 * lane);
            int pos[8];
#pragma unroll
            for (int k = 0; k < 8; ++k) pos[k] = 0;
            v4u bA[BSA], bB[BSA], bC[BSA]; int ps = 0, pn = 0;
            for (int r = 0; r < NR; ++r) {
#pragma unroll
                for (int k = 0; k < 8; ++k) {
                    constexpr int dummy = 0; (void)dummy;
                    const int kp = (k + 7) & 7;
                    const int c = __builtin_popcountll(__ballot((E0[k] >> RSH) == (unsigned)r)) + __builtin_popcountll(__ballot((E1[k] >> RSH) == (unsigned)r));
                    int s = __builtin_amdgcn_readfirstlane(pos[k]); const int e_end = __builtin_amdgcn_readfirstlane(s + c); pos[k] = e_end;
                    if (lane == 0) Bnd[k * (NR + 1) + r + 1] = e_end;
                    const int n1 = (e_end - s) < BSA ? (e_end - s) : BSA;
                    if (k & 1) sw_issue<BSA>(bB, El + k * ELP + s, EDq, voff); else sw_issue<BSA>(bA, El + k * ELP + s, EDq, voff);
                    if (pn > 0) { if (k & 1) sw_proc_a<BSA>(bA, hq[kp], Wl + kp * 128, ps, pn, lane); else sw_proc_a<BSA>(bB, hq[kp], Wl + kp * 128, ps, pn, lane); }
                    ps = s; pn = n1; s += n1;
#define SWA_REST(Y) if (s < e_end) { sw_issue<BSA>(Y, El + k * ELP + s, EDq, voff); \
                        for (;;) { int n = (e_end - s) < BSA ? (e_end - s) : BSA; \
                            if (s + BSA < e_end) { sw_issue<BSA>(bC, El + k * ELP + s + BSA, EDq, voff); sw_proc_a<BSA>(Y, hq[k], Wl + k * 128, s, n, lane); } else { sw_proc_a<BSA>(Y, hq[k], Wl + k * 128, s, n, lane); break; } \
                            s += BSA; n = (e_end - s) < BSA ? (e_end - s) : BSA; \
                            if (s + BSA < e_end) { sw_issue<BSA>(Y, El + k * ELP + s + BSA, EDq, voff); sw_proc_a<BSA>(bC, hq[k], Wl + k * 128, s, n, lane); } else { sw_proc_a<BSA>(bC, hq[k], Wl + k * 128, s, n, lane); break; } \
                            s += BSA; } }
                    if (k & 1) { SWA_REST(bA) } else { SWA_REST(bB) }
#undef SWA_REST
                }
            }
            if (pn > 0) sw_proc_a<BSA>(bB, hq[7], Wl + 7 * 128, ps, pn, lane);
        }
#pragma unroll
        for (int k = 0; k < 8; ++k) { int tk = tok0 + k; asm volatile("" : "+s"(tk)); const size_t base = (size_t)tk * 128; const float sh = H2S[tk];
            const float r0 = Wl[k * 128 + lane], r1 = Wl[k * 128 + 64 + lane];
            Wl[k * 128 + lane] = PG[base + (E0[k] & 127u)] * gelu_erf(r0 * sh * EDS[E0[k] >> 7]) * 0.0625f;
            Wl[k * 128 + 64 + lane] = PG[base + (E1[k] & 127u)] * gelu_erf(r1 * sh * EDS[E1[k] >> 7]) * 0.0625f; }
        int ln = lane; asm volatile("" : "+v"(ln));
#pragma unroll
        for (int sub = 0; sub < 8 / TPS; ++sub) {
        f32x2_t acc[TPS][8];
        for (int repb = 0; repb < PROBE_REPB; ++repb) {
#pragma unroll
            for (int kk = 0; kk < TPS; ++kk)
#pragma unroll
                for (int i = 0; i < 8; ++i) acc[kk][i] = (f32x2_t){0.f, 0.f};
            int pos[TPS];
#pragma unroll
            for (int kk = 0; kk < TPS; ++kk) pos[kk] = 0;
            v4u bA[BSB], bB[BSB]; int ps = 0, pn = 0;
            for (int r = 0; r < NR; ++r) {
#pragma unroll
                for (int kk = 0; kk < TPS; ++kk) {
                    const int k = sub * TPS + kk, kkp = (kk + TPS - 1) % TPS, kp = sub * TPS + kkp;
                    int s = __builtin_amdgcn_readfirstlane(pos[kk]); const int e_end = __builtin_amdgcn_readfirstlane(Bnd[k * (NR + 1) + r + 1]); pos[kk] = e_end;
                    const int n1 = (e_end - s) < BSB ? (e_end - s) : BSB;
                    if (kk & 1) sw_issue<BSB>(bB, El + k * ELP + s, EUq, voff); else sw_issue<BSB>(bA, El + k * ELP + s, EUq, voff);
                    if (pn > 0) { if (kk & 1) sw_proc_b<BSB>(bA, acc[kkp], Wl + kp * 128, ps, pn); else sw_proc_b<BSB>(bB, acc[kkp], Wl + kp * 128, ps, pn); }
                    ps = s; pn = n1; s += n1;
                    for (; s < e_end; s += BSB) {
                        const int n = (e_end - s) < BSB ? (e_end - s) : BSB;
                        if (kk & 1) { sw_issue<BSB>(bA, El + k * ELP + s, EUq, voff); sw_proc_b<BSB>(bA, acc[kk], Wl + k * 128, s, n); }
                        else        { sw_issue<BSB>(bB, El + k * ELP + s, EUq, voff); sw_proc_b<BSB>(bB, acc[kk], Wl + k * 128, s, n); }
                    }
                }
            }
            if (pn > 0) sw_proc_b<BSB>(bB, acc[TPS - 1], Wl + (sub * TPS + TPS - 1) * 128, ps, pn);
        }
        {
            asm volatile("" : "+v"(ln));
            float* outp = (float*)karg(18);
            const float* gt2 = MOD + ((tok0 + sub * TPS) >> 12) * NMOD + 5120;
            f32x4 gtv[4], xcur[4], xnxt[4];
#pragma unroll
            for (int j = 0; j < 4; ++j) { const int col = 4 * ln + 256 * j; gtv[j] = *(const f32x4*)(gt2 + col); xcur[j] = *(const f32x4*)(X1 + (size_t)(tok0 + sub * TPS) * D + col); }
#pragma unroll
            for (int kk = 0; kk < TPS; ++kk) {
                const int tok = tok0 + sub * TPS + kk;
                if (kk + 1 < TPS) {
#pragma unroll
                    for (int j = 0; j < 4; ++j) xnxt[j] = *(const f32x4*)(X1 + (size_t)(tok + 1) * D + 4 * ln + 256 * j);
                }
                f32x4 x2[4]; float ss = 0.f;
#pragma unroll
                for (int j = 0; j < 4; ++j) {
#pragma unroll
                    for (int i = 0; i < 4; ++i) { const float v = xcur[j][i] + gtv[j][i] * acc[kk][2 * j + (i >> 1)][i & 1]; x2[j][i] = v; ss += v * v; } }
                ss = wave_sum_x(ss, ln);
                if (!(FAKE && ss != 12345.678f)) {
                    const float rstd = 1.0f / sqrtf(ss * (1.0f / D) + EPS);
                    f32x4 fgv[4];
#pragma unroll
                    for (int j = 0; j < 4; ++j) fgv[j] = *(const f32x4*)(fg + 4 * ln + 256 * j);
#pragma unroll
                    for (int j = 0; j < 4; ++j) *(f32x4*)(outp + (size_t)tok * D + 4 * ln + 256 * j) = x2[j] * rstd * fgv[j];
                }
#pragma unroll
                for (int j = 0; j < 4; ++j) xcur[j] = xnxt[j];
            }
        }
        }
    }
}

struct Args { const float* in[18]; float* out; unsigned char* ws; };
__global__ void __launch_bounds__(NTHR, 2) mega_fwd(Args args) {
    extern __shared__ __attribute__((aligned(16))) unsigned char lds[];
    Frame F;
    F.lds = (LAS unsigned char*)lds;
    F.wave = __builtin_amdgcn_readfirstlane((int)threadIdx.x >> 6); F.lane = lane_fresh(); F.tid = F.wave * 64 + F.lane;
    F.G = gridDim.x; { const int bx = blockIdx.x; F.vcu = (F.G % 8 == 0) ? (bx % 8) * (F.G / 8) + bx / 8 : bx; }
    volatile LAS unsigned* MISC = (volatile LAS unsigned*)(F.lds + MISC_OFF);
    for (int u = F.tid; u < (LDS_BYTES - LDSCTL_OFF) / 4; u += NTHR) ((LAS unsigned*)(F.lds + LDSCTL_OFF))[u] = 0u;
    __syncthreads();
    gu32* ctl = (gu32*)(((unsigned char*)karg(19)) + WS_CTL);
    XcdBarrier bar = xcd_barrier_post((unsigned*)(ctl + CW_BAR), MISC + 8, F.wave);
#define GRID_BAR() xcd_barrier(bar)
#define PROBE_TS -1
#define STAMP(i) do { if (PROBE_TS >= 0 && blockIdx.x == 0 && F.tid == 0) { const unsigned long long t_ = __builtin_amdgcn_s_memrealtime(); MISC[16 + 2 * (i)] = (unsigned)t_; MISC[17 + 2 * (i)] = (unsigned)(t_ >> 32); } } while (0)
#define PROBE_DBL -1

    STAMP(0);
    F.lane = lane_fresh(); F.tid = F.wave * 64 + F.lane;
    p0_prologue(F); GRID_BAR(); STAMP(1);
    if (PROBE_DBL == 0) { p0_prologue(F); GRID_BAR(); }
    F.lane = lane_fresh(); F.tid = F.wave * 64 + F.lane;
    p1_norm(F); p0_transposes(F); GRID_BAR(); STAMP(2);
    if (PROBE_DBL == 1) { p1_norm(F); GRID_BAR(); }
    {
    {
        pg8::Gemm g{(const pg8::bf16_t*)(((unsigned char*)karg(19)) + WS_H), (const pg8::bf16_t*)(((unsigned char*)karg(19)) + WS_WIN), M, NPROJ, D, nullptr, nullptr};
        pg8::StaticOrder S; S.init(M, NPROJ, F.G, (int)blockIdx.x);
        pg8::EpiBf16<0> E{(pg8::bf16_t*)(((unsigned char*)karg(19)) + WS_PROJ), NPROJ, nullptr, 0, 0, 1.f};
        pg8::gemm_phase<pg8::EpiBf16<0>, pg8::StaticOrder, true, true>(F.lds + RING_OFF, g, S, E, F.wave);
        const int nwg = (M / 256) * (NPROJ / 256), busy = nwg % F.G;
        if (busy == 0) p0_quant_tables(F, F.vcu * NWAVES + F.wave, F.G * NWAVES);
        else if ((int)blockIdx.x >= busy) p0_quant_tables(F, ((int)blockIdx.x - busy) * NWAVES + F.wave, (F.G - busy) * NWAVES);
    }
    GRID_BAR(); STAMP(3);
    }
    p3_attention(F); GRID_BAR(); STAMP(4);
    if (PROBE_DBL == 3) { p3_attention(F); GRID_BAR(); }
    {
    {
        pg8::Gemm g{(const pg8::bf16_t*)(((unsigned char*)karg(19)) + WS_OA), (const pg8::bf16_t*)(((unsigned char*)karg(19)) + WS_WA), M, D, 512, (const pg8::bf16_t*)(((unsigned char*)karg(19)) + WS_OB), (const pg8::bf16_t*)(((unsigned char*)karg(19)) + WS_WB)};
        PairOrder S; S.S.init(M, D, F.G, (int)blockIdx.x);
        EpiGate E{(const bf16*)(((unsigned char*)karg(19)) + WS_PROJ), (bf16*)((float*)karg(18)) + (size_t)M * D};
        pg8::gemm_phase<EpiGate, PairOrder, true, true>(F.lds + RING_OFF, g, S, E, F.wave);
    }
    GRID_BAR(); STAMP(5);
    }
    {
    {
        pg8::Gemm g{(const pg8::bf16_t*)((bf16*)((float*)karg(18)) + (size_t)M * D), (const pg8::bf16_t*)(((unsigned char*)karg(19)) + WS_WOUT), M, D, D, nullptr, nullptr};
        pg8::StaticOrder S; S.init(M, D, F.G, (int)blockIdx.x);
        EpiRes E{((const float*)karg(0)), (const float*)(((unsigned char*)karg(19)) + WS_MOD), (float*)(((unsigned char*)karg(19)) + WS_X1)};
        pg8::gemm_phase<EpiRes, pg8::StaticOrder, true, true>(F.lds + RING_OFF, g, S, E, F.wave);
    }
    GRID_BAR(); STAMP(6);
    }
    F.lane = lane_fresh(); F.tid = F.wave * 64 + F.lane;
    F.lane = lane_fresh(); F.tid = F.wave * 64 + F.lane;
    p6_norm2(F); GRID_BAR(); STAMP(7);
    if (PROBE_DBL == 6) { p6_norm2(F); GRID_BAR(); }
    {
    {
        pg8::Gemm g{(const pg8::bf16_t*)(((unsigned char*)karg(19)) + WS_H2), (const pg8::bf16_t*)(((unsigned char*)karg(19)) + WS_WQ), M, D, D, nullptr, nullptr};
        pg8::StaticOrder S; S.init(M, D, F.G, (int)blockIdx.x);
        pg8::EpiBf16<0> E{(pg8::bf16_t*)(((unsigned char*)karg(19)) + WS_QP), D, nullptr, 0, 0, 1.f};
        pg8::gemm_phase<pg8::EpiBf16<0>, pg8::StaticOrder, true, true>(F.lds + RING_OFF, g, S, E, F.wave);
    }
    GRID_BAR(); STAMP(8);
    }
    F.lane = lane_fresh(); F.tid = F.wave * 64 + F.lane;
    p8a_topk(F); __syncthreads(); STAMP(9);
    if (PROBE_DBL == 8) { p8a_topk(F); GRID_BAR(); }
    if (PROBE_DBL == 12) { p8b_sweep<1>(F); __syncthreads(); }
    p8b_sweep<0>(F);
    if (PROBE_DBL == 9) { GRID_BAR(); p8b_sweep<0>(F); }
    if (PROBE_TS >= 0) {
        GRID_BAR(); STAMP(10);
        if (blockIdx.x == 0) { __syncthreads();
            const unsigned long long t0 = ((unsigned long long)MISC[17 + 2 * PROBE_TS] << 32) | MISC[16 + 2 * PROBE_TS], t1 = ((unsigned long long)MISC[19 + 2 * PROBE_TS] << 32) | MISC[18 + 2 * PROBE_TS];
            const float d_us = (float)(t1 - t0) * 0.01f;
            const float V = 128.0f * sqrtf(d_us * 1e-5f);
            float* o = (float*)karg(18); for (int c = F.tid; c < D; c += NTHR) o[c] = V; }
    }
}

extern "C" void kernel_launch(void* const* d_in, const int* in_sizes, int n_in, void* d_out, int out_size, void* d_ws, size_t ws_size, hipStream_t stream) {
    static int grid = 0;
    if (grid == 0) {
        if (n_in != 18 || in_sizes[0] != M * D || out_size != M * D || ws_size < WS_END) { fprintf(stderr, "kernel_launch: unexpected shapes (n_in %d, in0 %d, out %d, ws %zu)\n", n_in, n_in > 0 ? in_sizes[0] : -1, out_size, ws_size); grid = -1; return; }
        int dev = 0, cus = 0, per_cu = 0;
        if (hipGetDevice(&dev) != hipSuccess || hipDeviceGetAttribute(&cus, hipDeviceAttributeMultiprocessorCount, dev) != hipSuccess) { grid = -1; return; }
        if (hipFuncSetAttribute((const void*)mega_fwd, hipFuncAttributeMaxDynamicSharedMemorySize, LDS_BYTES) != hipSuccess) { fprintf(stderr, "kernel_launch: hipFuncSetAttribute failed\n"); grid = -1; return; }
        if (hipOccupancyMaxActiveBlocksPerMultiprocessor(&per_cu, (const void*)mega_fwd, NTHR, LDS_BYTES) != hipSuccess || per_cu < 1) { fprintf(stderr, "kernel_launch: occupancy query says %d blocks per CU\n", per_cu); }
        (void)hipGetLastError();
        grid = cus;
    }
    if (grid < 0) return;
    if (hipMemsetAsync((char*)d_ws + WS_CTL, 0, CTL_ZERO_BYTES, stream) != hipSuccess) { fprintf(stderr, "kernel_launch: memset failed\n"); return; }
    Args a{};
    for (int i = 0; i < 18; ++i) a.in[i] = (const float*)d_in[i];
    a.out = (float*)d_out; a.ws = (unsigned char*)d_ws;
    hipLaunchKernelGGL(mega_fwd, dim3(grid), dim3(NTHR), LDS_BYTES, stream, a);
}
```

```cpp
#include <hip/hip_runtime.h>
#include <cstdio>
#include <cstdint>
__device__ __forceinline__ int lane_fresh() { unsigned ones = ~0u; asm volatile("" : "+s"(ones)); return (int)__builtin_amdgcn_mbcnt_hi(ones, __builtin_amdgcn_mbcnt_lo(ones, 0u)); }
namespace pg8 {
#define PG8_LAS __attribute__((address_space(3)))
typedef unsigned short bf16_t;
typedef short bf16x8 __attribute__((ext_vector_type(8)));
typedef float f32x4 __attribute__((ext_vector_type(4)));
typedef unsigned u32x4 __attribute__((ext_vector_type(4)));
constexpr int BM = 256, BK = 64, HALF = 128, HTB = HALF * BK * 2  , STAGE_BYTES = 8 * HTB, NXCD = 8, WGM = 8;

__host__ __device__ __forceinline__ int lds_byte(int r, int c) { const int st = (r >> 4) * 2 + (c >> 5), rr = r & 15, cc = c & 31, ob = rr * 64 + cc * 2; return st * 1024 + (ob ^ (((ob >> 9) & 1) << 5)); }
__host__ __device__ __forceinline__ void stage_rc(int b, int& R, int& C) { const int st = b / 1024, sb = b % 1024, swz = sb ^ (((sb >> 9) & 1) << 5); R = (st >> 1) * 16 + swz / 64; C = (st & 1) * 32 + (swz % 64) / 2; }
__host__ __device__ __forceinline__ int perm32(int rho) { const int n = rho >> 4, i = rho & 15; return 8 * (i >> 2) + 4 * n + (i & 3); }

struct Unit { int pm, pn, src; };
struct Gemm { const bf16_t* A; const bf16_t* Bt; int M, N, K; const bf16_t* A2; const bf16_t* Bt2; };

struct StaticOrder {
    int nM, nN, nwg, G, c;
    __host__ __device__ void init(int M, int N, int G_, int c_) { nM = M / BM; nN = N / BM; nwg = nM * nN; G = G_; c = c_; }
    __host__ __device__ bool next(int i, Unit& u) const {
        const long L = (long)i * G + c; if (L >= nwg) return false;
        int wgid = (int)L; { const int q = nwg / NXCD, r = nwg % NXCD, xcd = wgid % NXCD, off = wgid / NXCD; wgid = (xcd < r ? xcd * (q + 1) : r * (q + 1) + (xcd - r) * q) + off; }
        const int nig = WGM * nN, gid = wgid / nig, fm = gid * WGM, gsz = (nM - fm) < WGM ? (nM - fm) : WGM;
        u.pm = fm + ((wgid % nig) % gsz); u.pn = (wgid % nig) / gsz; u.src = 0; return true;
    }
    __device__ __forceinline__ void a_ready(const Unit&) const {}
    __device__ __forceinline__ void done(const Unit&) const {}
};

__device__ __forceinline__ unsigned cvt_pk_bf16(float lo, float hi) { unsigned r; asm volatile("v_cvt_pk_bf16_f32 %0, %1, %2" : "=v"(r) : "v"(lo), "v"(hi)); return r; }
typedef float f32x2 __attribute__((ext_vector_type(2)));
__device__ __forceinline__ f32x2 gelu_pk(f32x2 v) {
    const f32x2 av = __builtin_elementwise_abs(v), d = av * 0.2316418882f + 1.0f;
    f32x2 t; t.x = __builtin_amdgcn_rcpf(d.x); t.y = __builtin_amdgcn_rcpf(d.y);
    f32x2 q = t * 0.5307027145f + (-0.7265760135f); q = q * t + 0.7107068705f; q = q * t + (-0.142248368f); q = q * t + 0.127414796f; q = q * t;
    const f32x2 s = (v * v) * (-0.72134752044f);
    f32x2 e; e.x = __builtin_amdgcn_exp2f(s.x); e.y = __builtin_amdgcn_exp2f(s.y);
    const f32x2 m = v * (q * e), r = v - m;
    f32x2 o; o.x = v.x < 0.f ? m.x : r.x; o.y = v.y < 0.f ? m.y : r.y; return o;
}

template <int ACT  > struct EpiBf16 {
    static constexpr bool PERM = true, AFTER_DRAIN = false, CHAIN = false; static_assert(ACT == 0 || ACT == 1, "EpiBf16: ACT is 0 (none) or 1 (gelu_pk)");
    bf16_t* O; int ldc; const float* bias; int split_cols; size_t split_stride; float scale0;
    __device__ __forceinline__ void operator()(const f32x4 (&acc)[2][2][4][2], const Unit& u, int wr, int wc, int fr, int fq) const {
        const int row0 = u.pm * BM + wr * 64 + fr; int colt = u.pn * BM; bf16_t* base = O;
        float sc = 1.f; if (split_cols) { const int t = colt / split_cols; base += (size_t)t * split_stride; colt -= t * split_cols; if (t == 0) sc = scale0; }
        const int col0 = colt + wc * 32 + 8 * fq, bcol0 = u.pn * BM + wc * 32 + 8 * fq;
        f32x4 bv[2][2];
#pragma unroll
        for (int bj = 0; bj < 2; ++bj)
#pragma unroll
            for (int n = 0; n < 2; ++n) bv[bj][n] = bias ? *(const f32x4*)(bias + bcol0 + bj * HALF + 4 * n) : (f32x4){0.f, 0.f, 0.f, 0.f};
#pragma unroll
        for (int ai = 0; ai < 2; ++ai)
#pragma unroll
            for (int m = 0; m < 4; ++m) { bf16_t* rowp = base + (size_t)(row0 + ai * HALF + m * 16) * ldc + col0;
#pragma unroll
                for (int bj = 0; bj < 2; ++bj) { f32x4 v0 = acc[ai][bj][m][0] + bv[bj][0], v1 = acc[ai][bj][m][1] + bv[bj][1];
                    if (ACT == 1) { f32x2 a = gelu_pk((f32x2){v0[0], v0[1]}), b = gelu_pk((f32x2){v0[2], v0[3]}), c = gelu_pk((f32x2){v1[0], v1[1]}), d = gelu_pk((f32x2){v1[2], v1[3]});
                        v0 = (f32x4){a.x, a.y, b.x, b.y}; v1 = (f32x4){c.x, c.y, d.x, d.y}; }
                    v0 = v0 * sc; v1 = v1 * sc; u32x4 w; w.x = cvt_pk_bf16(v0[0], v0[1]); w.y = cvt_pk_bf16(v0[2], v0[3]); w.z = cvt_pk_bf16(v1[0], v1[1]); w.w = cvt_pk_bf16(v1[2], v1[3]);
                    *(u32x4*)(rowp + bj * HALF) = w; } }
    }
};

template <class Epi, class Sched, bool ALIGN_EPI = false, bool SP2 = false>
__device__ __forceinline__ void gemm_phase(PG8_LAS unsigned char* lds, const Gemm g, const Sched& S, const Epi& E, int wave_id) {
    int tid = wave_id * 64 + ::lane_fresh(); asm volatile("" : "+v"(tid));
    const int wid = __builtin_amdgcn_readfirstlane(tid >> 6), lane = tid & 63, wr = wid >> 2, wc = wid & 3, fr = lane & 15, fq = lane >> 4;
    const int K = g.K, nt = K / BK;
    unsigned voffA[2], voffB[2];
#pragma unroll
    for (int i = 0; i < 2; ++i) { int R, C; stage_rc(tid * 16 + i * 8192, R, C); const int Rb = Epi::PERM ? ((R & ~31) + perm32(R & 31)) : R;
        voffA[i] = (unsigned)(R * K + C) * 2u; voffB[i] = (unsigned)(Rb * K + C) * 2u; }
    const size_t kstep = (size_t)(BK * 2);
    const size_t hstep = (size_t)HALF * K * 2;
    const size_t tstep = 2 * hstep;
    const unsigned ldsw = (unsigned)wid * 1024u;
    const int aoff = lds_byte(wr * 64 + fr, fq * 8), boff = lds_byte(wc * 32 + fr, fq * 8);
#define PG8_SA(b, h) (((b) * 2 + (h)) * HTB)
#define PG8_SB(b, h) ((4 + (b) * 2 + (h)) * HTB)
#define PG8_STAGE(bufoff, gbase, voff) do { _Pragma("unroll") for (int _i = 0; _i < 2; ++_i) \
        __builtin_amdgcn_global_load_lds((const unsigned*)((const char*)(gbase) + (voff)[_i]), (PG8_LAS unsigned*)(lds + (bufoff) + ldsw + _i * 8192), 16, 0, 0); } while (0)
#define PG8_LDA(dst, b, h) do { _Pragma("unroll") for (int m = 0; m < 4; ++m) _Pragma("unroll") for (int k = 0; k < 2; ++k) dst[m][k] = *(const PG8_LAS bf16x8*)(lds + PG8_SA(b, h) + aoff + m * 2048 + k * 1024); } while (0)
#define PG8_LDB(dst, b, h) do { _Pragma("unroll") for (int n = 0; n < 2; ++n) _Pragma("unroll") for (int k = 0; k < 2; ++k) dst[n][k] = *(const PG8_LAS bf16x8*)(lds + PG8_SB(b, h) + boff + n * 2048 + k * 1024); } while (0)
#define PG8_MMA(ai, bj, At, Bt) do { __builtin_amdgcn_s_setprio(1); _Pragma("unroll") for (int m = 0; m < 4; ++m) _Pragma("unroll") for (int n = 0; n < 2; ++n) _Pragma("unroll") for (int k = 0; k < 2; ++k) \
        acc[ai][bj][m][n] = __builtin_amdgcn_mfma_f32_16x16x32_bf16(Bt[n][k], At[m][k], acc[ai][bj][m][n], 0, 0, 0); __builtin_amdgcn_s_setprio(0); } while (0)
#define PG8_WAIT_V(n) asm volatile("s_waitcnt vmcnt(" #n ")" ::: "memory")
#define PG8_WAIT_L(n) asm volatile("s_waitcnt lgkmcnt(" #n ")" ::: "memory")
#define PG8_BAR __builtin_amdgcn_s_barrier()
#define PG8_SCHED __builtin_amdgcn_sched_barrier(0)
    Unit cur, nxt; int ui = 0;
    if (!S.next(0, cur)) return;
    f32x4 acc[2][2][4][2];
#pragma unroll
    for (int a = 0; a < 2; ++a)
#pragma unroll
        for (int b = 0; b < 2; ++b)
#pragma unroll
            for (int m = 0; m < 4; ++m)
#pragma unroll
                for (int n = 0; n < 2; ++n) acc[a][b][m][n] = (f32x4){0.f, 0.f, 0.f, 0.f};
    bf16x8 At[4][2], B0[2][2], B1[2][2];
    const char* cA = (const char*)(cur.src ? g.A2 : g.A) + (size_t)cur.pm * tstep; const char* cB = (const char*)(cur.src ? g.Bt2 : g.Bt) + (size_t)cur.pn * tstep;
    S.a_ready(cur);
    if constexpr (SP2) {
        PG8_STAGE(PG8_SB(0, 0), cB, voffB); PG8_STAGE(PG8_SB(0, 1), cB + hstep, voffB); PG8_STAGE(PG8_SA(0, 0), cA, voffA); PG8_STAGE(PG8_SA(0, 1), cA + hstep, voffA);
        if (wr == 1) PG8_BAR;
        PG8_WAIT_V(2); PG8_BAR;
        PG8_STAGE(PG8_SB(1, 0), cB + kstep, voffB); PG8_STAGE(PG8_SA(1, 0), cA + kstep, voffA); PG8_STAGE(PG8_SB(1, 1), cB + hstep + kstep, voffB);
        PG8_WAIT_V(6); PG8_BAR;
    } else {
        PG8_STAGE(PG8_SB(0, 0), cB, voffB); PG8_STAGE(PG8_SA(0, 0), cA, voffA); PG8_STAGE(PG8_SB(0, 1), cB + hstep, voffB); PG8_STAGE(PG8_SA(0, 1), cA + hstep, voffA);
        if (wr == 1) PG8_BAR;
        PG8_WAIT_V(4); PG8_BAR;
        PG8_STAGE(PG8_SB(1, 0), cB + kstep, voffB); PG8_STAGE(PG8_SA(1, 0), cA + kstep, voffA); PG8_STAGE(PG8_SB(1, 1), cB + hstep + kstep, voffB);
        PG8_WAIT_V(6); PG8_BAR;
    }
    for (;;) {
        const bool has_next = S.next(ui + 1, nxt);
        const char* nA = has_next ? (const char*)(nxt.src ? g.A2 : g.A) + (size_t)nxt.pm * tstep : cA; const char* nB = has_next ? (const char*)(nxt.src ? g.Bt2 : g.Bt) + (size_t)nxt.pn * tstep : cB;
        for (int t = 0; t < nt; t += 2) {
            const bool last = (t == nt - 2);
            const char* a1 = cA + (size_t)(t + 1) * kstep;
            const char* a2 = last ? nA : cA + (size_t)(t + 2) * kstep; const char* b2 = last ? nB : cB + (size_t)(t + 2) * kstep;
            const char* a3 = a2 + kstep; const char* b3 = b2 + kstep;
            if (last && has_next) S.a_ready(nxt);
            if constexpr (SP2) {
            PG8_LDB(B0, 0, 0); PG8_LDB(B1, 0, 1); PG8_SCHED; PG8_LDA(At, 0, 0); PG8_STAGE(PG8_SA(1, 1), a1 + hstep, voffA);
            PG8_WAIT_V(8); PG8_WAIT_L(0); PG8_BAR; PG8_MMA(0, 0, At, B0); PG8_MMA(0, 1, At, B1); PG8_BAR; PG8_SCHED;
            PG8_LDA(At, 0, 1); PG8_STAGE(PG8_SB(0, 0), b2, voffB); PG8_STAGE(PG8_SB(0, 1), b2 + hstep, voffB); PG8_STAGE(PG8_SA(0, 0), a2, voffA);
            PG8_WAIT_V(8); PG8_WAIT_L(0); PG8_BAR; PG8_MMA(1, 0, At, B0); PG8_MMA(1, 1, At, B1); PG8_BAR; PG8_SCHED;
            PG8_LDB(B0, 1, 0); PG8_LDB(B1, 1, 1); PG8_SCHED; PG8_LDA(At, 1, 0); PG8_STAGE(PG8_SA(0, 1), a2 + hstep, voffA);
            PG8_WAIT_V(8); PG8_WAIT_L(0); PG8_BAR; PG8_MMA(0, 0, At, B0); PG8_MMA(0, 1, At, B1); PG8_BAR; PG8_SCHED;
            PG8_LDA(At, 1, 1); PG8_STAGE(PG8_SB(1, 0), b3, voffB); PG8_STAGE(PG8_SB(1, 1), b3 + hstep, voffB); PG8_STAGE(PG8_SA(1, 0), a3, voffA);
            PG8_WAIT_V(8); PG8_WAIT_L(0); PG8_BAR; PG8_MMA(1, 0, At, B0); PG8_MMA(1, 1, At, B1); PG8_BAR; PG8_SCHED;
            } else {
            PG8_LDB(B0, 0, 0); PG8_SCHED; PG8_LDA(At, 0, 0); PG8_STAGE(PG8_SA(1, 1), a1 + hstep, voffA);
            PG8_WAIT_L(8); PG8_BAR; PG8_WAIT_L(0); PG8_MMA(0, 0, At, B0); PG8_BAR; PG8_SCHED;
            PG8_LDB(B1, 0, 1); PG8_STAGE(PG8_SB(0, 0), b2, voffB);
            PG8_BAR; PG8_WAIT_L(0); PG8_MMA(0, 1, At, B1); PG8_BAR;
            PG8_LDA(At, 0, 1); PG8_STAGE(PG8_SA(0, 0), a2, voffA);
            PG8_BAR; PG8_WAIT_L(0); PG8_MMA(1, 0, At, B0); PG8_BAR; PG8_SCHED;
            PG8_STAGE(PG8_SB(0, 1), b2 + hstep, voffB);
            PG8_WAIT_V(6); PG8_BAR; PG8_MMA(1, 1, At, B1); PG8_BAR;
            PG8_LDB(B0, 1, 0); PG8_SCHED; PG8_LDA(At, 1, 0); PG8_STAGE(PG8_SA(0, 1), a2 + hstep, voffA);
            PG8_WAIT_L(8); PG8_BAR; PG8_WAIT_L(0); PG8_MMA(0, 0, At, B0); PG8_BAR; PG8_SCHED;
            PG8_LDB(B1, 1, 1); PG8_STAGE(PG8_SB(1, 0), b3, voffB);
            PG8_BAR; PG8_WAIT_L(0); PG8_MMA(0, 1, At, B1); PG8_BAR;
            PG8_LDA(At, 1, 1); PG8_STAGE(PG8_SA(1, 0), a3, voffA);
            PG8_BAR; PG8_WAIT_L(0); PG8_MMA(1, 0, At, B0); PG8_BAR; PG8_SCHED;
            PG8_STAGE(PG8_SB(1, 1), b3 + hstep, voffB);
            PG8_WAIT_V(6); PG8_BAR; PG8_MMA(1, 1, At, B1); PG8_BAR;
            }
        }
        if constexpr (ALIGN_EPI) { if (wr == 0) PG8_BAR; }
        if constexpr (!Epi::AFTER_DRAIN) { E(acc, cur, wr, wc, fr, fq); S.done(cur); }
        if (!has_next) break;
        if (!(Epi::CHAIN && cur.src == 0)) {
#pragma unroll
        for (int a = 0; a < 2; ++a)
#pragma unroll
            for (int b = 0; b < 2; ++b)
#pragma unroll
                for (int m = 0; m < 4; ++m)
#pragma unroll
                    for (int n = 0; n < 2; ++n) acc[a][b][m][n] = (f32x4){0.f, 0.f, 0.f, 0.f};
        }
        cur = nxt; cA = nA; cB = nB; ++ui;
        if constexpr (ALIGN_EPI) { if (wr == 1) PG8_BAR; }
    }
    PG8_WAIT_V(0);
    if constexpr (!ALIGN_EPI) { if (wr == 0) PG8_BAR; }
    PG8_BAR;
    if constexpr (Epi::AFTER_DRAIN) { E.fused(acc, cur, wr, wc, fr, fq, lds, wid, lane); S.done(cur); }
#undef PG8_SA
#undef PG8_SB
#undef PG8_STAGE
#undef PG8_LDA
#undef PG8_LDB
#undef PG8_MMA
#undef PG8_WAIT_V
#undef PG8_WAIT_L
#undef PG8_BAR
#undef PG8_SCHED
}
}

#define GAS __attribute__((address_space(1)))
#define LAS __attribute__((address_space(3)))
typedef unsigned short bf16;
typedef unsigned v4u __attribute__((ext_vector_type(4)));
typedef float f32x4 __attribute__((ext_vector_type(4)));
typedef short bf16x8 __attribute__((ext_vector_type(8)));
typedef GAS unsigned gu32;
typedef GAS unsigned long long gu64;
#define RLX_AGENT __ATOMIC_RELAXED, __HIP_MEMORY_SCOPE_AGENT
#define LDS_WAIT() asm volatile("s_waitcnt lgkmcnt(0)" ::: "memory")
#define VM_WAIT() asm volatile("s_waitcnt vmcnt(0)" ::: "memory")
__device__ __forceinline__ unsigned long long rt() { return __builtin_amdgcn_s_memrealtime(); }
__device__ __forceinline__ unsigned f2bf(float f) { unsigned u = __builtin_bit_cast(unsigned, f); return (u + 0x7fffu + ((u >> 16) & 1u)) >> 16; }
__device__ __forceinline__ unsigned pk2(float lo, float hi) { return f2bf(lo) | (f2bf(hi) << 16); }

__device__ __forceinline__ const void* karg(int i);
constexpr int CW_BAR_FWD = 4096;
#define XB_TMO      128
#define XB_XCNT(j)  (256  + 64 * (j))
#define XB_XSUB(j)  (1280 + 64 * (j))
#define XB_XGEN(j)  (2304 + 64 * (j))
#define XB_TOP      3328
#define XB_TOPGEN   3392
#define XCD_BAR_WORDS 3456
#define XB_SPIN_CAP (1u << 18)

__device__ __forceinline__ unsigned xb_ld(unsigned* p)              { return __hip_atomic_load(p, __ATOMIC_RELAXED, __HIP_MEMORY_SCOPE_AGENT); }
__device__ __forceinline__ unsigned xb_add(unsigned* p, unsigned v) { return __hip_atomic_fetch_add(p, v, __ATOMIC_RELAXED, __HIP_MEMORY_SCOPE_AGENT); }
__device__ __forceinline__ unsigned xb_xcc_id() { return (unsigned)__builtin_amdgcn_s_getreg((3 << 11) | 20) & 0xFu; }
#define XB_SPIN(cond, bar) do { unsigned _sp = 0; while (cond) { __builtin_amdgcn_s_sleep(1); \
    if ((++_sp & 255u) == 0u) { if (xb_ld(&(bar)[XB_TMO])) break; if (_sp > XB_SPIN_CAP) { atomicAdd(&(bar)[XB_TMO], 1u); break; } } } } while (0)

struct XcdBarrier {
    int wave;
    unsigned* bar; unsigned x;
    volatile LAS unsigned* st;
};

__device__ __forceinline__ XcdBarrier xcd_barrier_post(unsigned* bar, volatile LAS unsigned* st, int wave) {
    XcdBarrier b; b.wave = wave; b.bar = bar; b.x = xb_xcc_id(); b.st = st;
    if (wave == 0 && lane_fresh() == 0) (void)xb_add(&bar[XB_XCNT(b.x)], 1u);
    return b;
}
__device__ __forceinline__ void xcd_barrier_complete(unsigned* bar, unsigned x, unsigned& nloc, unsigned& nx) {
    const unsigned G = gridDim.x * gridDim.y * gridDim.z;
    unsigned sum, cnt, mine, sp = 0u;
    for (;;) {
        sum = 0u; cnt = 0u; mine = 0u;
#pragma unroll
        for (unsigned j = 0; j < 16; ++j) { const unsigned c = xb_ld(&bar[XB_XCNT(j)]); sum += c; cnt += (c > 0u) ? 1u : 0u; mine = (j == x) ? c : mine; }
        if (sum == G) break;
        __builtin_amdgcn_s_sleep(1);
        if ((++sp & 255u) == 0u) { if (xb_ld(&bar[XB_TMO])) break; if (sp > XB_SPIN_CAP) { atomicAdd(&bar[XB_TMO], 1u); break; } }
    }
    nloc = mine > 0u ? mine : 1u; nx = cnt > 0u ? cnt : 1u;
}

__device__ __forceinline__ void xcd_barrier(const XcdBarrier& b) {
    asm volatile("s_waitcnt vmcnt(0)" ::: "memory");
    __syncthreads();
    if (b.wave == 0 && lane_fresh() == 0) {
        unsigned* bar = (unsigned*)((gu32*)((unsigned char*)karg(19)) + CW_BAR_FWD);
        __builtin_amdgcn_s_waitcnt(0);
        unsigned nloc = b.st[0], nx = b.st[1];
        if (nloc == 0u) { xcd_barrier_complete(bar, b.x, nloc, nx); b.st[0] = nloc; b.st[1] = nx; }
        const unsigned old = xb_add(&bar[XB_XSUB(b.x)], 1u);
        const unsigned gen = old / nloc;
        if (old + 1u == (gen + 1u) * nloc) {
            __builtin_amdgcn_fence(__ATOMIC_RELEASE, "agent");
            asm volatile("s_waitcnt vmcnt(0)" ::: "memory");
            const unsigned og = xb_add(&bar[XB_TOP], 1u);
            const unsigned tg = og / nx;
            if (og + 1u == (tg + 1u) * nx) xb_add(&bar[XB_TOPGEN], 1u);
            else XB_SPIN(xb_ld(&bar[XB_TOPGEN]) == tg, bar);
            __builtin_amdgcn_fence(__ATOMIC_ACQUIRE, "agent");
            xb_add(&bar[XB_XGEN(b.x)], 1u);
            asm volatile("s_waitcnt vmcnt(0)" ::: "memory");
        } else {
            XB_SPIN(xb_ld(&bar[XB_XGEN(b.x)]) == gen, bar);
            __builtin_amdgcn_fence(__ATOMIC_ACQUIRE, "agent");
            asm volatile("s_waitcnt vmcnt(0)" ::: "memory");
        }
    }
    __syncthreads();
}

constexpr int NWAVES = 8, NTHR = 512;
constexpr int BATCH = 4, SEQ = 4096, D = 1024, M = BATCH * SEQ;
constexpr int NPROJ = 4352, LDW_IN = 4360, NMOD = 6144;
constexpr int C_QA = 0, C_KA = 512, C_VA = 640, C_QB = 768, C_KB = 1280, C_VB = 1792, C_GLA = 2304, C_GLB = 3328;
constexpr int NEXP = 16384;
constexpr float EPS = 1e-6f;

constexpr size_t MiB = 1u << 20;
constexpr size_t WS_CTL = 0, CTL_ZERO_BYTES = 1 * MiB;
constexpr size_t WS_MOD = 1 * MiB, WS_LOGF = 1 * MiB + 128 * 1024, WS_SUBK = 2 * MiB;
constexpr size_t WS_WIN = 4 * MiB, WS_WA = 12 * MiB + 512 * 1024, WS_WB = 13 * MiB + 512 * 1024, WS_WOUT = 14 * MiB + 512 * 1024, WS_WQ = 16 * MiB + 512 * 1024;
constexpr size_t WS_ED = 19 * MiB, WS_EU = 35 * MiB;
constexpr size_t WS_EDS = 2 * MiB + 512 * 1024;
constexpr size_t WS_H2Q = 95 * MiB, WS_H2S = 111 * MiB;
constexpr size_t WS_H = 83 * MiB, WS_OA = 83 * MiB, WS_OB = 99 * MiB, WS_PIDX = 83 * MiB, WS_PG = 87 * MiB;
constexpr size_t WS_PROJ = 115 * MiB, WS_X1 = 115 * MiB, WS_H2 = 179 * MiB, WS_QP = 211 * MiB;
constexpr size_t WS_END = 251 * MiB;
static_assert(WS_WIN + (size_t)NPROJ * D * 2 <= WS_WA && WS_WQ + (size_t)D * D * 2 <= WS_ED && WS_PROJ + (size_t)M * NPROJ * 2 <= WS_END, "ws map");
constexpr int CW_BAR = 4096; static_assert(CW_BAR == CW_BAR_FWD && WS_CTL == 0, "barrier words");

constexpr int RING_OFF = 0, RING_BYTES = 131072;
constexpr int LDSCTL_OFF = RING_BYTES, MISC_OFF = LDSCTL_OFF + 320;
constexpr int LDS_BYTES = 147456;

typedef float f32x16 __attribute__((ext_vector_type(16)));
typedef short s16x4 __attribute__((ext_vector_type(4)));
typedef unsigned u32x2 __attribute__((ext_vector_type(2)));
typedef float f32x2_t __attribute__((ext_vector_type(2)));
typedef __bf16 bf16x2_t __attribute__((ext_vector_type(2)));

__device__ __forceinline__ unsigned cvtpk(float lo, float hi) { f32x2_t v = {lo, hi}; bf16x2_t b = __builtin_convertvector(v, bf16x2_t); return __builtin_bit_cast(unsigned, b); }
__device__ __forceinline__ float bflo(unsigned u) { return __uint_as_float(u << 16); }
__device__ __forceinline__ float bfhi(unsigned u) { return __uint_as_float(u & 0xffff0000u); }
template <int S> __device__ __forceinline__ unsigned xorx(unsigned v, int lane) {
    if constexpr (S == 1) return (unsigned)__builtin_amdgcn_update_dpp(0, (int)v, 0xB1, 0xF, 0xF, true);
    else if constexpr (S == 2) return (unsigned)__builtin_amdgcn_update_dpp(0, (int)v, 0x4E, 0xF, 0xF, true);
    else if constexpr (S == 4) { const unsigned a = (unsigned)__builtin_amdgcn_update_dpp(0, (int)v, 0x124, 0xF, 0xF, true), b = (unsigned)__builtin_amdgcn_update_dpp(0, (int)v, 0x12C, 0xF, 0xF, true); return (lane & 4) ? a : b; }
    else if constexpr (S == 8) return (unsigned)__builtin_amdgcn_update_dpp(0, (int)v, 0x128, 0xF, 0xF, true);
    else if constexpr (S == 16) { const auto r = __builtin_amdgcn_permlane16_swap(v, v, false, false); return (lane & 16) ? r[0] : r[1]; }
    else { const auto r = __builtin_amdgcn_permlane32_swap(v, v, false, false); return (lane & 32) ? r[0] : r[1]; }
}
__device__ __forceinline__ unsigned xorx_sw(unsigned v, int lane, int s) {
    switch (s) { case 1: return xorx<1>(v, lane); case 2: return xorx<2>(v, lane); case 4: return xorx<4>(v, lane); case 8: return xorx<8>(v, lane); case 16: return xorx<16>(v, lane); default: return xorx<32>(v, lane); }
}
__device__ __forceinline__ float wave_sum_x(float v, int lane) {
    v += __uint_as_float(xorx<1>(__float_as_uint(v), lane)); v += __uint_as_float(xorx<2>(__float_as_uint(v), lane)); v += __uint_as_float(xorx<4>(__float_as_uint(v), lane));
    v += __uint_as_float(xorx<8>(__float_as_uint(v), lane)); v += __uint_as_float(xorx<16>(__float_as_uint(v), lane)); v += __uint_as_float(xorx<32>(__float_as_uint(v), lane));
    return v;
}
__device__ __forceinline__ float dppf(float v, const int ctrl_sel) { return v; }
#define DPP_F(v, CTRL) __uint_as_float(__builtin_amdgcn_update_dpp(0, __float_as_uint(v), (CTRL), 0xF, 0xF, true))
__device__ __forceinline__ float reduce8_t(const float (&dd)[8], int lane) {
    float r4[4];
#pragma unroll
    for (int u = 0; u < 4; ++u) { const auto p = __builtin_amdgcn_permlane32_swap(__float_as_uint(dd[u]), __float_as_uint(dd[u + 4]), false, false); r4[u] = __uint_as_float(p[0]) + __uint_as_float(p[1]); }
    float r2[2];
#pragma unroll
    for (int u = 0; u < 2; ++u) { const auto p = __builtin_amdgcn_permlane16_swap(__float_as_uint(r4[u]), __float_as_uint(r4[u + 2]), false, false); r2[u] = __uint_as_float(p[0]) + __uint_as_float(p[1]); }
    const bool b3 = (lane & 8) != 0;
    const float keep = b3 ? r2[1] : r2[0], send = b3 ? r2[0] : r2[1];
    float r1 = keep + DPP_F(send, 0x128);
    r1 += DPP_F(r1, 0xB1);
    r1 += DPP_F(r1, 0x4E);
    r1 += DPP_F(r1, 0x141);
    return r1;
}
__device__ __forceinline__ int lane_id() { return (int)__builtin_amdgcn_mbcnt_hi(~0u, __builtin_amdgcn_mbcnt_lo(~0u, 0u)); }
__device__ __forceinline__ float wave_sum(float v) { return wave_sum_x(v, lane_id()); }
__device__ __forceinline__ float wave_max(float v) { const int lane = lane_id();
    v = fmaxf(v, __uint_as_float(xorx<1>(__float_as_uint(v), lane))); v = fmaxf(v, __uint_as_float(xorx<2>(__float_as_uint(v), lane))); v = fmaxf(v, __uint_as_float(xorx<4>(__float_as_uint(v), lane)));
    v = fmaxf(v, __uint_as_float(xorx<8>(__float_as_uint(v), lane))); v = fmaxf(v, __uint_as_float(xorx<16>(__float_as_uint(v), lane))); v = fmaxf(v, __uint_as_float(xorx<32>(__float_as_uint(v), lane)));
    return v; }
__device__ __forceinline__ int crow(int r, int hi) { return (r & 3) + 8 * (r >> 2) + 4 * hi; }
#define MFMA32(a, b, c) __builtin_amdgcn_mfma_f32_32x32x16_bf16((a), (b), (c), 0, 0, 0)

struct Frame {
    LAS unsigned char* lds;
    int tid, lane, wave, vcu, G;
};
__device__ __forceinline__ const void* karg(int i) {
    unsigned long z = 0; asm volatile("" : "+s"(z));
    const char* base = (const char*)__builtin_amdgcn_kernarg_segment_ptr();
    return *(const void* const*)(base + 8 * i + z);
}

__device__ __forceinline__ void p0_transpose_item(const float* W, int ld, int K, int ncols, bf16* WT, int row_off, LAS float* scr, int item, int lane) {
    const int nblk = ncols / 32, kb = item / nblk, nb = item % nblk, k0 = 64 * kb, n0 = 32 * nb;
#pragma unroll 8
    for (int i = 0; i < 32; ++i) { const int kk = 2 * i + (lane >> 5); scr[kk * 33 + (lane & 31)] = __builtin_nontemporal_load(W + (size_t)(k0 + kk) * ld + n0 + (lane & 31)); }
    LDS_WAIT(); asm volatile("" ::: "memory");
    const int c = lane & 7;
#pragma unroll
    for (int j = 0; j < 4; ++j) { const int n = (lane >> 3) + 8 * j; const LAS float* s = scr + (8 * c) * 33 + n;
        v4u o; o.x = pk2(s[0 * 33], s[1 * 33]); o.y = pk2(s[2 * 33], s[3 * 33]); o.z = pk2(s[4 * 33], s[5 * 33]); o.w = pk2(s[6 * 33], s[7 * 33]);
        *(GAS v4u*)(WT + (size_t)(row_off + n0 + n) * K + k0 + 8 * c) = o; }
    LDS_WAIT(); asm volatile("" ::: "memory");
}
__device__ __forceinline__ void p0_convert(const float* __restrict__ src, bf16* __restrict__ dst, long n_iters, int gw, int NGW, int lane) {
    for (long it0 = (long)gw * 4; it0 < n_iters; it0 += (long)NGW * 4) {
        f32x4 a[4][2];
#pragma unroll
        for (int u = 0; u < 4; ++u) { const long it = it0 + u; if (it < n_iters) { const float* p = src + it * 512 + lane * 4; a[u][0] = *(const f32x4*)p; a[u][1] = *(const f32x4*)(p + 256); } }
#pragma unroll
        for (int u = 0; u < 4; ++u) { const long it = it0 + u; if (it < n_iters) { bf16* q = dst + it * 512 + lane * 4;
            u32x2 w0, w1; w0.x = cvtpk(a[u][0].x, a[u][0].y); w0.y = cvtpk(a[u][0].z, a[u][0].w); w1.x = cvtpk(a[u][1].x, a[u][1].y); w1.y = cvtpk(a[u][1].z, a[u][1].w);
            *(u32x2*)q = w0; *(u32x2*)(q + 256) = w1; } }
    }
}

__device__ __forceinline__ void p0_quant_tables(Frame& F, int gw, int NGW) {
    const float* ed = ((const float*)karg(15)); const float* eu = ((const float*)karg(16));
    unsigned char* EDq = (unsigned char*)(((unsigned char*)karg(19)) + WS_ED); unsigned char* EUq = (unsigned char*)(((unsigned char*)karg(19)) + WS_EU); float* EDS = (float*)(((unsigned char*)karg(19)) + WS_EDS);
    const int lane = F.lane;
    for (int row0 = gw * 4; row0 < NEXP; row0 += NGW * 4) {
        f32x4 a[4][4], u[4][4];
#pragma unroll
        for (int q = 0; q < 4; ++q)
#pragma unroll
            for (int j = 0; j < 4; ++j) { a[q][j] = __builtin_nontemporal_load((const f32x4*)(ed + (size_t)(row0 + q) * D) + lane + 64 * j); u[q][j] = __builtin_nontemporal_load((const f32x4*)(eu + (size_t)(row0 + q) * D) + lane + 64 * j); }
#pragma unroll
        for (int q = 0; q < 4; ++q) {
            float am = 0.f;
#pragma unroll
            for (int j = 0; j < 4; ++j) am = fmaxf(fmaxf(am, fmaxf(fabsf(a[q][j].x), fabsf(a[q][j].y))), fmaxf(fabsf(a[q][j].z), fabsf(a[q][j].w)));
            am = wave_max(am);
            const float sc = am > 0.f ? am * (1.0f / 127.0f) : 1.0f, inv = 1.0f / sc;
            v4u qa, qu;
#pragma unroll
            for (int j = 0; j < 4; ++j) {
                const int b0 = (int)rintf(a[q][j].x * inv), b1 = (int)rintf(a[q][j].y * inv), b2 = (int)rintf(a[q][j].z * inv), b3 = (int)rintf(a[q][j].w * inv);
                qa[j] = (unsigned)(b0 & 255) | ((unsigned)(b1 & 255) << 8) | ((unsigned)(b2 & 255) << 16) | ((unsigned)(b3 & 255) << 24);
                int p = __builtin_amdgcn_cvt_pk_fp8_f32(u[q][j].x * 16.0f, u[q][j].y * 16.0f, 0, false);
                p = __builtin_amdgcn_cvt_pk_fp8_f32(u[q][j].z * 16.0f, u[q][j].w * 16.0f, p, true);
                qu[j] = (unsigned)p;
            }
            __builtin_nontemporal_store(qa, (v4u*)(EDq + (size_t)(row0 + q) * D + 16 * lane));
            __builtin_nontemporal_store(qu, (v4u*)(EUq + (size_t)(row0 + q) * D + 16 * lane));
            if (lane == 0) EDS[row0 + q] = sc;
        }
    }
}
__device__ __forceinline__ void p0_prologue(Frame& F) {
    const float* c = ((const float*)karg(1)); const float* w_ada = ((const float*)karg(4)); const float* b_ada = ((const float*)karg(5));
    float* MOD = (float*)(((unsigned char*)karg(19)) + WS_MOD);
    {
        LAS float* cact = (LAS float*)(F.lds);
        LAS float* part = (LAS float*)(F.lds + 16384);
        bool did = false;
        for (int item = F.vcu; item < NMOD / 32; item += F.G) {
            if (!did) { for (int i = F.tid; i < 4096; i += NTHR) { const float cv = c[i]; cact[i] = cv / (1.0f + __expf(-cv)); } did = true; }
            __syncthreads();
            const int n0 = item * 32, col = n0 + (F.lane & 31), ksub = F.lane >> 5;
            float a0 = 0.f, a1 = 0.f, a2 = 0.f, a3 = 0.f;
#pragma unroll 16
            for (int it = 0; it < 64; ++it) { const int k = (it * 8 + F.wave) * 2 + ksub; const float w = __builtin_nontemporal_load(w_ada + (size_t)k * NMOD + col);
                a0 += cact[k] * w; a1 += cact[1024 + k] * w; a2 += cact[2048 + k] * w; a3 += cact[3072 + k] * w; }
            a0 += __shfl_xor(a0, 32); a1 += __shfl_xor(a1, 32); a2 += __shfl_xor(a2, 32); a3 += __shfl_xor(a3, 32);
            if (F.lane < 32) { part[(F.wave * 4 + 0) * 32 + F.lane] = a0; part[(F.wave * 4 + 1) * 32 + F.lane] = a1; part[(F.wave * 4 + 2) * 32 + F.lane] = a2; part[(F.wave * 4 + 3) * 32 + F.lane] = a3; }
            __syncthreads();
            if (F.tid < 128) { const int b = F.tid >> 5, cl = F.tid & 31; float s = 0.f;
#pragma unroll
                for (int w = 0; w < 8; ++w) s += part[(w * 4 + b) * 32 + cl];
                MOD[b * NMOD + n0 + cl] = s + b_ada[n0 + cl]; }
            __syncthreads();
        }
    }
    {
        const int gw = F.vcu * NWAVES + F.wave, NGW = F.G * NWAVES;
        p0_convert(((const float*)karg(14)), (bf16*)(((unsigned char*)karg(19)) + WS_SUBK), (long)(8 * 2 * 128 * 64) / 512, gw, NGW, F.lane);
    }
}
__device__ __forceinline__ void p0_transposes(Frame& F) {
    LAS float* scr = (LAS float*)(F.lds + 32768 + F.wave * 8704);
    const int gw = F.vcu * NWAVES + F.wave, NGW = F.G * NWAVES;
    constexpr int I_IN1 = (D / 64) * (2304 / 32), I_IN2 = (D / 64) * (2048 / 32), I_AB = (512 / 64) * (D / 32), I_SQ = (D / 64) * (D / 32);
    constexpr int NITEMS = I_IN1 + I_IN2 + 2 * I_AB + 2 * I_SQ;
    bf16* Win_t = (bf16*)(((unsigned char*)karg(19)) + WS_WIN);
    for (int it = gw; it < NITEMS; it += NGW) {
        int r = it;
        if (r < I_IN1) { p0_transpose_item(((const float*)karg(6)), LDW_IN, D, 2304, Win_t, 0, scr, r, F.lane); continue; } r -= I_IN1;
        if (r < I_IN2) { p0_transpose_item(((const float*)karg(6)) + 2312, LDW_IN, D, 2048, Win_t, 2304, scr, r, F.lane); continue; } r -= I_IN2;
        if (r < I_AB) { p0_transpose_item(((const float*)karg(9)), D, 512, D, (bf16*)(((unsigned char*)karg(19)) + WS_WA), 0, scr, r, F.lane); continue; } r -= I_AB;
        if (r < I_AB) { p0_transpose_item(((const float*)karg(10)), D, 512, D, (bf16*)(((unsigned char*)karg(19)) + WS_WB), 0, scr, r, F.lane); continue; } r -= I_AB;
        if (r < I_SQ) { p0_transpose_item(((const float*)karg(11)), D, D, D, (bf16*)(((unsigned char*)karg(19)) + WS_WOUT), 0, scr, r, F.lane); continue; } r -= I_SQ;
        p0_transpose_item(((const float*)karg(13)), D, D, D, (bf16*)(((unsigned char*)karg(19)) + WS_WQ), 0, scr, r, F.lane);
    }
}

__device__ __forceinline__ void p1_norm(Frame& F) {
    const float* x = ((const float*)karg(0)); const float* g1 = ((const float*)karg(2)); const float* w_in = ((const float*)karg(6)); const float* b_forget = ((const float*)karg(7));
    const float* MOD = (const float*)(((unsigned char*)karg(19)) + WS_MOD); bf16* H = (bf16*)(((unsigned char*)karg(19)) + WS_H); float* LOGF = (float*)(((unsigned char*)karg(19)) + WS_LOGF);
    LAS float* wfl = (LAS float*)(F.lds);
    { float tmp[16];
#pragma unroll
      for (int n = 0; n < 16; ++n) { const int i = F.tid + n * NTHR; tmp[n] = w_in[(size_t)(i >> 3) * LDW_IN + 2304 + (i & 7)]; }
#pragma unroll
      for (int n = 0; n < 16; ++n) { const int i = F.tid + n * NTHR; wfl[(i & 7) * 1024 + (i >> 3)] = tmp[n]; } }
    __syncthreads();
    const int gw = F.vcu * NWAVES + F.wave, NGW = F.G * NWAVES;
    f32x4 cur[4], nxt[4];
    if (gw < M) { const f32x4* xr = (const f32x4*)(x + (size_t)gw * D) + F.lane;
#pragma unroll
        for (int j = 0; j < 4; ++j) cur[j] = __builtin_nontemporal_load(xr + 64 * j); }
    for (int row = gw; row < M; row += NGW) {
        { const int nrow = row + NGW; if (nrow < M) { const f32x4* xr = (const f32x4*)(x + (size_t)nrow * D) + F.lane;
#pragma unroll
            for (int j = 0; j < 4; ++j) nxt[j] = __builtin_nontemporal_load(xr + 64 * j); } }
        {{
        float ss = 0.f;
#pragma unroll
        for (int j = 0; j < 4; ++j) ss += (cur[j].x * cur[j].x + cur[j].y * cur[j].y) + (cur[j].z * cur[j].z + cur[j].w * cur[j].w);
        ss = wave_sum(ss);
        const float rstd = 1.0f / sqrtf(ss * (1.0f / D) + EPS);
        const int b = row >> 12; const float* mb = MOD + b * NMOD;
        float fl[8];
#pragma unroll
        for (int jj = 0; jj < 8; ++jj) fl[jj] = 0.f;
        f32x4 gv[4], shv[4], scv[4];
#pragma unroll
        for (int j = 0; j < 4; ++j) { const int col = 4 * F.lane + 256 * j; gv[j] = *(const f32x4*)(g1 + col); shv[j] = *(const f32x4*)(mb + col); scv[j] = *(const f32x4*)(mb + 1024 + col); }
#pragma unroll
        for (int j = 0; j < 4; ++j) { const int col = 4 * F.lane + 256 * j;
            const f32x4 g = gv[j], sh = shv[j], sc = scv[j];
            const f32x4 hv = (cur[j] * rstd) * g * (sc + 1.0f) + sh;
            u32x2 w; w.x = cvtpk(hv.x, hv.y); w.y = cvtpk(hv.z, hv.w);
            *(u32x2*)(H + (size_t)row * D + col) = w;
#pragma unroll
            for (int jj = 0; jj < 8; ++jj) { const f32x4 wv = *(const LAS f32x4*)(wfl + jj * 1024 + col); fl[jj] += (hv.x * wv.x + hv.y * wv.y) + (hv.z * wv.z + hv.w * wv.w); }
        }
        const int lane = F.lane; const float r1 = reduce8_t(fl, lane);
        if ((lane & 7) == 0) { const int jj = lane >> 3; const float z = r1 + b_forget[jj]; const float ls = fminf(z, 0.f) - log1pf(__expf(-fabsf(z))); LOGF[(size_t)row * 8 + jj] = ls; }
        }}
#pragma unroll
        for (int j = 0; j < 4; ++j) cur[j] = nxt[j];
    }
}

constexpr int KP = 72;
constexpr int VPF = 68;
constexpr int VPS = 260;
struct FlashState { f32x16 o[2]; float m, l; };

__device__ __forceinline__ void flash_tail(FlashState& st, f32x16& s0, f32x16& s1, const LAS bf16* Vs, int vp, int r32, int hi) {
    float mt = s0[0];
#pragma unroll
    for (int r = 1; r < 16; ++r) mt = fmaxf(mt, s0[r]);
#pragma unroll
    for (int r = 0; r < 16; ++r) mt = fmaxf(mt, s1[r]);
    mt = fmaxf(mt, __uint_as_float(xorx<32>(__float_as_uint(mt), 32 * hi)));
    const float mn = fmaxf(st.m, mt);
    const float alpha = __expf(st.m - mn);
    st.m = mn;
    float ps = 0.f;
#pragma unroll
    for (int r = 0; r < 16; ++r) { s0[r] = __expf(s0[r] - mn); ps += s0[r]; }
#pragma unroll
    for (int r = 0; r < 16; ++r) { s1[r] = __expf(s1[r] - mn); ps += s1[r]; }
    st.l = st.l * alpha + ps;
    if (__any(alpha != 1.0f)) {
#pragma unroll
        for (int r = 0; r < 16; ++r) { st.o[0][r] *= alpha; st.o[1][r] *= alpha; }
    }
#pragma unroll
    for (int blk = 0; blk < 2; ++blk)
#pragma unroll
        for (int s = 0; s < 2; ++s) {
            v4u pw;
            if (blk == 0) { pw.x = cvtpk(s0[8 * s + 0], s0[8 * s + 1]); pw.y = cvtpk(s0[8 * s + 2], s0[8 * s + 3]); pw.z = cvtpk(s0[8 * s + 4], s0[8 * s + 5]); pw.w = cvtpk(s0[8 * s + 6], s0[8 * s + 7]); }
            else          { pw.x = cvtpk(s1[8 * s + 0], s1[8 * s + 1]); pw.y = cvtpk(s1[8 * s + 2], s1[8 * s + 3]); pw.z = cvtpk(s1[8 * s + 4], s1[8 * s + 5]); pw.w = cvtpk(s1[8 * s + 6], s1[8 * s + 7]); }
            const bf16x8 pf = __builtin_bit_cast(bf16x8, pw);
#pragma unroll
            for (int db = 0; db < 2; ++db) {
                const LAS bf16* vp0 = Vs + (32 * db + r32) * vp + 32 * blk + 16 * s + 4 * hi;
                const s16x4 lo = *(const LAS s16x4*)vp0, hh = *(const LAS s16x4*)(vp0 + 8);
                const bf16x8 vf = __builtin_shufflevector(lo, hh, 0, 1, 2, 3, 4, 5, 6, 7);
                st.o[db] = MFMA32(vf, pf, st.o[db]);
            }
        }
}
__device__ __forceinline__ void flash_qk(f32x16& s0, f32x16& s1, const bf16x8 (&qf)[4], const LAS bf16* Ks, int r32, int hi) {
    s0 = (f32x16){0.f}; s1 = (f32x16){0.f};
#pragma unroll
    for (int r = 0; r < 16; ++r) { s0[r] = 0.f; s1[r] = 0.f; }
#pragma unroll
    for (int ks = 0; ks < 4; ++ks) {
        const bf16x8 a0 = *(const LAS bf16x8*)(Ks + r32 * KP + 16 * ks + 8 * hi);
        const bf16x8 a1 = *(const LAS bf16x8*)(Ks + (32 + r32) * KP + 16 * ks + 8 * hi);
        s0 = MFMA32(a0, qf[ks], s0); s1 = MFMA32(a1, qf[ks], s1);
    }
}
__device__ __forceinline__ void flash_qk2(f32x16& a0, f32x16& a1, f32x16& b0, f32x16& b1, const bf16x8 (&qa)[4], const bf16x8 (&qb)[4], const LAS bf16* Ks, int r32, int hi) {
#pragma unroll
    for (int r = 0; r < 16; ++r) { a0[r] = 0.f; a1[r] = 0.f; b0[r] = 0.f; b1[r] = 0.f; }
#pragma unroll
    for (int ks = 0; ks < 4; ++ks) {
        const bf16x8 k0 = *(const LAS bf16x8*)(Ks + r32 * KP + 16 * ks + 8 * hi);
        const bf16x8 k1 = *(const LAS bf16x8*)(Ks + (32 + r32) * KP + 16 * ks + 8 * hi);
        a0 = MFMA32(k0, qa[ks], a0); b0 = MFMA32(k0, qb[ks], b0); a1 = MFMA32(k1, qa[ks], a1); b1 = MFMA32(k1, qb[ks], b1);
    }
}
__device__ __forceinline__ void flash_soft(FlashState& st, f32x16& s0, f32x16& s1, int hi) {
    float mt = s0[0];
#pragma unroll
    for (int r = 1; r < 16; ++r) mt = fmaxf(mt, s0[r]);
#pragma unroll
    for (int r = 0; r < 16; ++r) mt = fmaxf(mt, s1[r]);
    mt = fmaxf(mt, __uint_as_float(xorx<32>(__float_as_uint(mt), 32 * hi)));
    const float mn = fmaxf(st.m, mt);
    const float alpha = __expf(st.m - mn);
    st.m = mn;
    float ps = 0.f;
#pragma unroll
    for (int r = 0; r < 16; ++r) { s0[r] = __expf(s0[r] - mn); ps += s0[r]; }
#pragma unroll
    for (int r = 0; r < 16; ++r) { s1[r] = __expf(s1[r] - mn); ps += s1[r]; }
    st.l = st.l * alpha + ps;
    if (__any(alpha != 1.0f)) {
#pragma unroll
        for (int r = 0; r < 16; ++r) { st.o[0][r] *= alpha; st.o[1][r] *= alpha; }
    }
}
__device__ __forceinline__ bf16x8 pack_p(const f32x16& p, int s) {
    v4u pw; pw.x = cvtpk(p[8 * s + 0], p[8 * s + 1]); pw.y = cvtpk(p[8 * s + 2], p[8 * s + 3]); pw.z = cvtpk(p[8 * s + 4], p[8 * s + 5]); pw.w = cvtpk(p[8 * s + 6], p[8 * s + 7]);
    return __builtin_bit_cast(bf16x8, pw);
}
__device__ __forceinline__ void flash_pv2(FlashState& sa, FlashState& sb, const f32x16& a0, const f32x16& a1, const f32x16& b0, const f32x16& b1, const LAS bf16* Vs, int vp, int r32, int hi) {
#pragma unroll
    for (int blk = 0; blk < 2; ++blk)
#pragma unroll
        for (int s = 0; s < 2; ++s) {
            const bf16x8 pfa = blk ? pack_p(a1, s) : pack_p(a0, s), pfb = blk ? pack_p(b1, s) : pack_p(b0, s);
#pragma unroll
            for (int db = 0; db < 2; ++db) {
                const LAS bf16* vp0 = Vs + (32 * db + r32) * vp + 32 * blk + 16 * s + 4 * hi;
                const s16x4 lo = *(const LAS s16x4*)vp0, hh = *(const LAS s16x4*)(vp0 + 8);
                const bf16x8 vf = __builtin_shufflevector(lo, hh, 0, 1, 2, 3, 4, 5, 6, 7);
                sa.o[db] = MFMA32(vf, pfa, sa.o[db]); sb.o[db] = MFMA32(vf, pfb, sb.o[db]);
            }
        }
}
__device__ __forceinline__ void flash_store(const FlashState& st, bf16* orow, int hi) {
    float lt = st.l + __uint_as_float(xorx<32>(__float_as_uint(st.l), 32 * hi));
    const float inv = 1.0f / lt;
#pragma unroll
    for (int db = 0; db < 2; ++db)
#pragma unroll
        for (int rg = 0; rg < 4; ++rg) { u32x2 w; w.x = cvtpk(st.o[db][4 * rg] * inv, st.o[db][4 * rg + 1] * inv); w.y = cvtpk(st.o[db][4 * rg + 2] * inv, st.o[db][4 * rg + 3] * inv);
            *(u32x2*)(orow + 32 * db + 8 * rg + 4 * hi) = w; }
}

__device__ __forceinline__ void fox_unit(Frame& F, int b, int h, int qb, float& kmax2) {
    const bf16* proj = (const bf16*)(((unsigned char*)karg(19)) + WS_PROJ); const float* LOGF = (const float*)(((unsigned char*)karg(19)) + WS_LOGF); bf16* OB = (bf16*)(((unsigned char*)karg(19)) + WS_OB);
    LAS float* Fs = (LAS float*)(F.lds);
    LAS float* wtot = (LAS float*)(F.lds + 16384);
    LAS bf16* Kb = (LAS bf16*)(F.lds + 16384 + 128);
    LAS bf16* Vb = (LAS bf16*)(F.lds + 16384 + 128 + 2 * 64 * KP * 2);
    const int lane = F.lane, wave = F.wave, tid = F.tid, r32 = lane & 31, hi = lane >> 5;
    const int q_end = 512 * (qb + 1), NT = q_end / 64;
    const size_t rowbase = (size_t)b * SEQ;
    if (kmax2 < 0.f) {
        float v[8]; float run = 0.f;
#pragma unroll
        for (int i = 0; i < 8; ++i) { const int pos = tid * 8 + i; const float lf = (pos < q_end) ? LOGF[(rowbase + pos) * 8 + h] : 0.f; run += lf; v[i] = run; }
        float inc = run;
#pragma unroll
        for (int o = 1; o < 64; o <<= 1) { const float t = __shfl_up(inc, o); if (lane >= o) inc += t; }
        if (lane == 63) wtot[wave] = inc;
        __syncthreads();
        float off = inc - run;
        for (int w = 0; w < wave; ++w) off += wtot[w];
#pragma unroll
        for (int i = 0; i < 8; ++i) Fs[tid * 8 + i] = v[i] + off;
    }
    const int qrow = 512 * qb + 64 * wave + r32, qrowB = qrow + 32;
    bf16x8 qf[4], qg[4];
    { const bf16* qp = proj + (rowbase + qrow) * NPROJ + C_QB + 64 * h + 8 * hi;
#pragma unroll
      for (int ks = 0; ks < 4; ++ks) { qf[ks] = *(const bf16x8*)(qp + 16 * ks); qg[ks] = *(const bf16x8*)(qp + (size_t)32 * NPROJ + 16 * ks); } }
    const int tq = 8 * qb + wave;
    LAS bf16* Qs = (LAS bf16*)(F.lds + 53248) + wave * (64 * KP);
    {
        float qn = 0.f;
#pragma unroll
        for (int ks = 0; ks < 4; ++ks)
#pragma unroll
            for (int j = 0; j < 8; ++j) { const float e = __uint_as_float(((unsigned)(unsigned short)qf[ks][j]) << 16); qn += e * e; }
        qn += __shfl_xor(qn, 32);
        { float qn2 = 0.f;
#pragma unroll
          for (int ks = 0; ks < 4; ++ks)
#pragma unroll
              for (int j = 0; j < 8; ++j) { const float e = __uint_as_float(((unsigned)(unsigned short)qg[ks][j]) << 16); qn2 += e * e; }
          qn2 += __shfl_xor(qn2, 32); qn = fmaxf(qn, qn2); }
#pragma unroll
        for (int o = 1; o < 32; o <<= 1) qn = fmaxf(qn, __shfl_xor(qn, o));
        float kn = 0.f;
        if (kmax2 < 0.f) {
            for (int p0 = 0; p0 < q_end; p0 += 4 * 64) {
                v4u w4[4];
#pragma unroll
                for (int i = 0; i < 4; ++i) w4[i] = *(const v4u*)(proj + (rowbase + p0 + 64 * i + (tid >> 3)) * NPROJ + C_KB + 64 * h + 8 * (tid & 7));
#pragma unroll
                for (int i = 0; i < 4; ++i) { const unsigned wx = w4[i].x, wy = w4[i].y, wz = w4[i].z, ww = w4[i].w;
                    float s = bflo(wx) * bflo(wx) + bfhi(wx) * bfhi(wx) + bflo(wy) * bflo(wy) + bfhi(wy) * bfhi(wy) + bflo(wz) * bflo(wz) + bfhi(wz) * bfhi(wz) + bflo(ww) * bflo(ww) + bfhi(ww) * bfhi(ww);
                    s += __shfl_xor(s, 1); s += __shfl_xor(s, 2); s += __shfl_xor(s, 4);
                    kn = fmaxf(kn, s); } }
            kn = wave_max(kn);
        }
        if (lane == 0) { wtot[8 + wave] = qn; wtot[16 + wave] = kn; }
    }
#pragma unroll
    for (int ks = 0; ks < 4; ++ks) { *(LAS bf16x8*)(Qs + r32 * KP + 16 * ks + 8 * hi) = qf[ks]; *(LAS bf16x8*)(Qs + (32 + r32) * KP + 16 * ks + 8 * hi) = qg[ks]; }
    FlashState st, su; st.m = -INFINITY; st.l = 0.f; su.m = -INFINITY; su.l = 0.f;
#pragma unroll
    for (int r = 0; r < 16; ++r) { st.o[0][r] = 0.f; st.o[1][r] = 0.f; su.o[0][r] = 0.f; su.o[1][r] = 0.f; }
    const int srow = tid >> 3, sch = tid & 7;
    const bf16* kg = proj + (rowbase + srow) * NPROJ + C_KB + 64 * h + 8 * sch;
    const bf16* vg = proj + (rowbase + srow) * NPROJ + C_VB + 64 * h + 8 * sch;
    v4u kreg, vreg;
    { const size_t o = (size_t)(NT - 1) * 64 * NPROJ; kreg = *(const v4u*)(kg + o); vreg = *(const v4u*)(vg + o); }
    int cur = 0;
    {   *(LAS v4u*)(Kb + srow * KP + 8 * sch) = kreg;
        const unsigned short* vs = (const unsigned short*)&vreg;
#pragma unroll
        for (int i = 0; i < 8; ++i) Vb[(8 * sch + i) * VPF + srow] = vs[i];
    }
    __syncthreads();
    const float fq = Fs[qrow], fqB = Fs[qrowB];
    int t_lo = 0;
    {
        float qm = 0.f, km = 0.f;
#pragma unroll
        for (int w = 0; w < 8; ++w) { qm = fmaxf(qm, wtot[8 + w]); km = fmaxf(km, wtot[16 + w]); }
        if (kmax2 < 0.f) kmax2 = km;
        const float A = 0.125f * sqrtf(qm) * sqrtf(kmax2) * 1.01f, f0 = Fs[512 * qb];
        for (int t = NT - 9; t >= 0; --t) if (Fs[64 * t + 63] - f0 > 2.0f * A + 60.0f) { t_lo = t + 1; break; }
    }
    for (int t = NT - 1; t >= t_lo; --t) {
        if (t > t_lo) { const size_t o = (size_t)(t - 1) * 64 * NPROJ; kreg = *(const v4u*)(kg + o); vreg = *(const v4u*)(vg + o); }
        if (t <= tq) {
            const LAS bf16* Ks = Kb + cur * 64 * KP; const LAS bf16* Vs = Vb + cur * 64 * VPF;
            bf16x8 qa[4], qb4[4];
#pragma unroll
            for (int ks = 0; ks < 4; ++ks) { qa[ks] = *(const LAS bf16x8*)(Qs + r32 * KP + 16 * ks + 8 * hi); qb4[ks] = *(const LAS bf16x8*)(Qs + (32 + r32) * KP + 16 * ks + 8 * hi); }
            f32x16 s0, s1, u0, u1; flash_qk2(s0, s1, u0, u1, qa, qb4, Ks, r32, hi);
            const LAS float* Fk = Fs + 64 * t;
            const bool diag = (t == tq);
#pragma unroll
            for (int rg = 0; rg < 4; ++rg) {
                const f32x4 f0 = *(const LAS f32x4*)(Fk + 8 * rg + 4 * hi), f1 = *(const LAS f32x4*)(Fk + 32 + 8 * rg + 4 * hi);
#pragma unroll
                for (int i = 0; i < 4; ++i) { const int r = 4 * rg + i; const int kv = 64 * t + 8 * rg + 4 * hi + i;
                    float a = s0[r] * 0.125f + (fq - f0[i]), c = s1[r] * 0.125f + (fq - f1[i]), d = u0[r] * 0.125f + (fqB - f0[i]), e = u1[r] * 0.125f + (fqB - f1[i]);
                    if (diag) { if (kv > qrow) a = -INFINITY; if (kv + 32 > qrow) c = -INFINITY; if (kv > qrowB) d = -INFINITY; if (kv + 32 > qrowB) e = -INFINITY; }
                    s0[r] = a; s1[r] = c; u0[r] = d; u1[r] = e; }
            }
            flash_soft(st, s0, s1, hi); flash_soft(su, u0, u1, hi);
            flash_pv2(st, su, s0, s1, u0, u1, Vs, VPF, r32, hi);
        }
        if (t > t_lo) {
            const int nb = cur ^ 1;
            *(LAS v4u*)(Kb + nb * 64 * KP + srow * KP + 8 * sch) = kreg;
            const unsigned short* vs = (const unsigned short*)&vreg;
#pragma unroll
            for (int i = 0; i < 8; ++i) Vb[nb * 64 * VPF + (8 * sch + i) * VPF + srow] = vs[i];
        }
        __syncthreads();
        cur ^= 1;
    }
    flash_store(st, OB + (rowbase + qrow) * 512 + 64 * h, hi); flash_store(su, OB + (rowbase + qrowB) * 512 + 64 * h, hi);
    __syncthreads();
}

__device__ const unsigned char T5_BUCKET[128] = {0,1,2,3,4,5,6,7,8,9,10,11,12,13,14,15,16,16,16,17,17,18,18,18,19,19,19,20,20,20,20,21,21,21,21,22,22,22,22,22,23,23,23,23,23,23,24,24,24,24,24,24,25,25,25,25,25,25,25,26,26,26,26,26,26,26,26,27,27,27,27,27,27,27,27,27,27,28,28,28,28,28,28,28,28,28,28,29,29,29,29,29,29,29,29,29,29,29,29,30,30,30,30,30,30,30,30,30,30,30,30,30,30,31,31,31,31,31,31,31,31,31,31,31,31,31,31,31};

__device__ __forceinline__ void swa_unit(Frame& F, int b, int kvh, int n) {
    const bf16* proj = (const bf16*)(((unsigned char*)karg(19)) + WS_PROJ); bf16* OA = (bf16*)(((unsigned char*)karg(19)) + WS_OA);
    const float* sinks = ((const float*)karg(8)); const float* rel_bias = ((const float*)karg(12));
    LAS bf16* Kb = (LAS bf16*)(F.lds);
    LAS bf16* Vb = (LAS bf16*)(F.lds + 36864);
    LAS float* bt = (LAS float*)(F.lds + 36864 + 33280);
    const int lane = F.lane, wave = F.wave, tid = F.tid, r32 = lane & 31, hi = lane >> 5;
    const size_t rowbase = (size_t)b * SEQ;
    {
        const int g = tid >> 7, d = tid & 127;
        bt[tid] = rel_bias[(int)T5_BUCKET[d] * 8 + kvh * 4 + g];
#pragma unroll
        for (int i = 0; i < 4; ++i) {
            const int idx = tid + i * NTHR, kb = idx >> 3, sch = idx & 7; const int pos = 128 * (n - 1) + kb;
            v4u kreg = (v4u){0u, 0u, 0u, 0u}, vreg = (v4u){0u, 0u, 0u, 0u};
            if (pos >= 0) { const bf16* p = proj + (rowbase + pos) * NPROJ + 64 * kvh + 8 * sch; kreg = *(const v4u*)(p + C_KA); vreg = *(const v4u*)(p + C_VA); }
            *(LAS v4u*)(Kb + kb * KP + 8 * sch) = kreg;
            const unsigned short* vs = (const unsigned short*)&vreg;
#pragma unroll
            for (int j = 0; j < 8; ++j) Vb[(8 * sch + j) * VPS + kb] = vs[j];
        }
    }
    __syncthreads();
    const int g = wave & 3, qh = wave >> 2, head = kvh * 4 + g;
    const LAS float* btg = bt + g * 128;
    for (int sb = 0; sb < 2; ++sb) {
        const int qrel0 = 64 * qh + 32 * sb, qrel = qrel0 + r32;
        const size_t row = rowbase + 128 * n + qrel;
        bf16x8 qf[4];
        { const bf16* qp = proj + row * NPROJ + C_QA + 64 * head + 8 * hi;
#pragma unroll
          for (int ks = 0; ks < 4; ++ks) qf[ks] = *(const bf16x8*)(qp + 16 * ks); }
        FlashState st; st.m = sinks[head]; st.l = (hi == 0) ? 1.0f : 0.0f;
#pragma unroll
        for (int r = 0; r < 16; ++r) { st.o[0][r] = 0.f; st.o[1][r] = 0.f; }
        const int t_lo = (qrel0 + 1) >> 6, t_hi = (qrel0 + 159) >> 6;
        for (int t = t_lo; t <= t_hi; ++t) {
            f32x16 s0, s1; flash_qk(s0, s1, qf, Kb + t * 64 * KP, r32, hi);
#pragma unroll
            for (int r = 0; r < 16; ++r) {
                const int kb0 = 64 * t + crow(r, hi), kb1 = kb0 + 32;
                const int d0 = 128 + qrel - kb0, d1 = d0 - 32;
                const bool v0 = (d0 >= 0) && (d0 < 128) && (n > 0 || kb0 >= 128);
                const bool v1 = (d1 >= 0) && (d1 < 128) && (n > 0 || kb1 >= 128);
                const float b0 = btg[d0 & 127], b1 = btg[d1 & 127];
                s0[r] = v0 ? (s0[r] * 0.125f + b0) : -INFINITY;
                s1[r] = v1 ? (s1[r] * 0.125f + b1) : -INFINITY;
            }
            flash_tail(st, s0, s1, Vb + 64 * t, VPS, r32, hi);
        }
        flash_store(st, OA + row * 512 + 64 * head, hi);
    }
    __syncthreads();
}
__device__ __forceinline__ void p3_attention(Frame& F) {
    for (int item = F.vcu; item < 256; item += F.G) {
        swa_unit(F, item >> 6, (item >> 5) & 1, item & 31);
        const int bh = item >> 3, j = item & 7;
        float kmax2 = -1.0f;
        fox_unit(F, bh >> 3, bh & 7, j, kmax2);
    }
}

struct PairOrder {
    pg8::StaticOrder S;
    __device__ bool next(int i, pg8::Unit& u) const { if (!S.next(i >> 1, u)) return false; u.src = i & 1; return true; }
    __device__ __forceinline__ void a_ready(const pg8::Unit&) const {}
    __device__ __forceinline__ void done(const pg8::Unit&) const {}
};
__device__ __forceinline__ float sigmoidf_(float z) { return 1.0f / (1.0f + __expf(-z)); }
struct EpiGate {
    static constexpr bool PERM = true, AFTER_DRAIN = false, CHAIN = true;
    const bf16* proj; bf16* mixed;
    __device__ __forceinline__ void operator()(pg8::f32x4 (&acc)[2][2][4][2], const pg8::Unit& u, int wr, int wc, int fr, int fq) const {
#pragma unroll
        for (int ai = 0; ai < 2; ++ai) {
            v4u gbv[4][2], gav[4][2];
#pragma unroll
            for (int m = 0; m < 4; ++m) { const size_t row = (size_t)u.pm * 256 + ai * 128 + wr * 64 + m * 16 + fr;
#pragma unroll
                for (int bj = 0; bj < 2; ++bj) { const int col0 = u.pn * 256 + bj * 128 + wc * 32 + 8 * fq;
                    gbv[m][bj] = *(const v4u*)(proj + row * NPROJ + C_GLB + col0);
                    if (u.src == 0) gav[m][bj] = __builtin_nontemporal_load((const v4u*)(proj + row * NPROJ + C_GLA + col0)); } }
#pragma unroll
            for (int m = 0; m < 4; ++m) { const size_t row = (size_t)u.pm * 256 + ai * 128 + wr * 64 + m * 16 + fr;
#pragma unroll
                for (int bj = 0; bj < 2; ++bj) { const int col0 = u.pn * 256 + bj * 128 + wc * 32 + 8 * fq;
                    const unsigned gbw[4] = {gbv[m][bj].x, gbv[m][bj].y, gbv[m][bj].z, gbv[m][bj].w};
                    if (u.src == 0) {
                        const unsigned gaw[4] = {gav[m][bj].x, gav[m][bj].y, gav[m][bj].z, gav[m][bj].w};
#pragma unroll
                        for (int e = 0; e < 8; ++e) { const float za = (e & 1) ? bfhi(gaw[e >> 1]) : bflo(gaw[e >> 1]), zb = (e & 1) ? bfhi(gbw[e >> 1]) : bflo(gbw[e >> 1]);
                            const float ratio = (1.0f + __expf(-zb)) * __builtin_amdgcn_rcpf(1.0f + __expf(-za));
                            acc[ai][bj][m][e >> 2][e & 3] *= ratio; }
                    } else {
                        float v[8];
#pragma unroll
                        for (int e = 0; e < 8; ++e) { const float zb = (e & 1) ? bfhi(gbw[e >> 1]) : bflo(gbw[e >> 1]); v[e] = acc[ai][bj][m][e >> 2][e & 3] * __builtin_amdgcn_rcpf(1.0f + __expf(-zb)); }
                        v4u w; w.x = cvtpk(v[0], v[1]); w.y = cvtpk(v[2], v[3]); w.z = cvtpk(v[4], v[5]); w.w = cvtpk(v[6], v[7]);
                        *(v4u*)(mixed + row * D + col0) = w;
                    }
                }
            }
        }
    }
};
struct EpiRes {
    static constexpr bool PERM = true, AFTER_DRAIN = false, CHAIN = false;
    const float* x; const float* mod; float* x1;
    __device__ __forceinline__ void operator()(const pg8::f32x4 (&acc)[2][2][4][2], const pg8::Unit& u, int wr, int wc, int fr, int fq) const {
        const int b = (u.pm * 256) >> 12;
        pg8::f32x4 gt[2][2];
#pragma unroll
        for (int bj = 0; bj < 2; ++bj)
#pragma unroll
            for (int n = 0; n < 2; ++n) gt[bj][n] = *(const pg8::f32x4*)(mod + b * NMOD + 2048 + u.pn * 256 + bj * 128 + wc * 32 + 8 * fq + 4 * n);
#pragma unroll
        for (int ai = 0; ai < 2; ++ai) {
            pg8::f32x4 xin[4][2][2];
#pragma unroll
            for (int m = 0; m < 4; ++m) { const size_t row = (size_t)u.pm * 256 + ai * 128 + wr * 64 + m * 16 + fr;
#pragma unroll
                for (int bj = 0; bj < 2; ++bj)
#pragma unroll
                    for (int n = 0; n < 2; ++n) xin[m][bj][n] = __builtin_nontemporal_load((const pg8::f32x4*)(x + row * D + u.pn * 256 + bj * 128 + wc * 32 + 8 * fq + 4 * n)); }
#pragma unroll
            for (int m = 0; m < 4; ++m) { const size_t row = (size_t)u.pm * 256 + ai * 128 + wr * 64 + m * 16 + fr;
#pragma unroll
                for (int bj = 0; bj < 2; ++bj)
#pragma unroll
                    for (int n = 0; n < 2; ++n) *(pg8::f32x4*)(x1 + row * D + u.pn * 256 + bj * 128 + wc * 32 + 8 * fq + 4 * n) = xin[m][bj][n] + gt[bj][n] * acc[ai][bj][m][n]; }
        }
    }
};

__device__ __forceinline__ void p6_norm2(Frame& F) {
    const float* x1 = (const float*)(((unsigned char*)karg(19)) + WS_X1); const float* g2 = ((const float*)karg(3)); const float* MOD = (const float*)(((unsigned char*)karg(19)) + WS_MOD); bf16* H2 = (bf16*)(((unsigned char*)karg(19)) + WS_H2); unsigned char* H2Q = (unsigned char*)(((unsigned char*)karg(19)) + WS_H2Q); float* H2S = (float*)(((unsigned char*)karg(19)) + WS_H2S);
    const int gw = F.vcu * NWAVES + F.wave, NGW = F.G * NWAVES;
    f32x4 cur[4], nxt[4];
    if (gw < M) { const f32x4* xr = (const f32x4*)(x1 + (size_t)gw * D) + F.lane;
#pragma unroll
        for (int j = 0; j < 4; ++j) cur[j] = xr[64 * j]; }
    for (int row = gw; row < M; row += NGW) {
        { const int nrow = row + NGW; if (nrow < M) { const f32x4* xr = (const f32x4*)(x1 + (size_t)nrow * D) + F.lane;
#pragma unroll
            for (int j = 0; j < 4; ++j) nxt[j] = xr[64 * j]; } }
        {
        f32x4 v[4], hq[4]; float ss = 0.f;
#pragma unroll
        for (int j = 0; j < 4; ++j) { v[j] = cur[j]; ss += (v[j].x * v[j].x + v[j].y * v[j].y) + (v[j].z * v[j].z + v[j].w * v[j].w); }
        ss = wave_sum(ss);
        const float rstd = 1.0f / sqrtf(ss * (1.0f / D) + EPS);
        const int b = row >> 12; const float* mb = MOD + b * NMOD;
        f32x4 gv[4], shv[4], scv[4];
#pragma unroll
        for (int j = 0; j < 4; ++j) { const int col = 4 * F.lane + 256 * j; gv[j] = *(const f32x4*)(g2 + col); shv[j] = *(const f32x4*)(mb + 3072 + col); scv[j] = *(const f32x4*)(mb + 4096 + col); }
#pragma unroll
        for (int j = 0; j < 4; ++j) { const int col = 4 * F.lane + 256 * j;
            const f32x4 g = gv[j], sh = shv[j], sc = scv[j];
            const f32x4 hv = (v[j] * rstd) * g * (sc + 1.0f) + sh;
            u32x2 w; w.x = cvtpk(hv.x, hv.y); w.y = cvtpk(hv.z, hv.w);
            *(u32x2*)(H2 + (size_t)row * D + col) = w; hq[j] = hv; }
        float am = 0.f;
#pragma unroll
        for (int j = 0; j < 4; ++j) am = fmaxf(fmaxf(am, fmaxf(fabsf(hq[j].x), fabsf(hq[j].y))), fmaxf(fabsf(hq[j].z), fabsf(hq[j].w)));
        am = wave_max(am);
        const float sc = am > 0.f ? am * (1.0f / 127.0f) : 1.0f, inv = 1.0f / sc;
        v4u qa;
#pragma unroll
        for (int j = 0; j < 4; ++j) { const int b0 = (int)rintf(hq[j].x * inv), b1 = (int)rintf(hq[j].y * inv), b2 = (int)rintf(hq[j].z * inv), b3 = (int)rintf(hq[j].w * inv);
            qa[j] = (unsigned)(b0 & 255) | ((unsigned)(b1 & 255) << 8) | ((unsigned)(b2 & 255) << 16) | ((unsigned)(b3 & 255) << 24); }
        __builtin_nontemporal_store(qa, (v4u*)(H2Q + (size_t)row * D + 16 * F.lane));
        if (F.lane == 0) H2S[row] = sc;
        }
#pragma unroll
        for (int j = 0; j < 4; ++j) cur[j] = nxt[j];
    }
}

__device__ __forceinline__ unsigned f2ord(float f) { const unsigned u = __float_as_uint(f); return u ^ ((unsigned)((int)u >> 31) | 0x80000000u); }
__device__ __forceinline__ float ord2f(unsigned o) { const unsigned u = (o & 0x80000000u) ? (o & 0x7fffffffu) : ~o; return __uint_as_float(u); }
#define CE_DESC(a, b) do { const unsigned _x = (a), _y = (b); (a) = _x > _y ? _x : _y; (b) = _x > _y ? _y : _x; } while (0)
__device__ __forceinline__ void sort16(unsigned (&k)[16]) {
#pragma unroll
    for (int size = 2; size <= 16; size <<= 1)
#pragma unroll
        for (int stride = size >> 1; stride > 0; stride >>= 1)
#pragma unroll
            for (int i = 0; i < 16; ++i) { const int j = i ^ stride; if (j > i) { if ((i & size) == 0) CE_DESC(k[i], k[j]); else CE_DESC(k[j], k[i]); } }
}
__device__ __forceinline__ void merge16(unsigned (&a)[16], const unsigned (&b)[16]) {
#pragma unroll
    for (int i = 0; i < 16; ++i) a[i] = a[i] > b[15 - i] ? a[i] : b[15 - i];
#pragma unroll
    for (int stride = 8; stride > 0; stride >>= 1)
#pragma unroll
        for (int i = 0; i < 16; ++i) { const int j = i ^ stride; if (j > i) CE_DESC(a[i], a[j]); }
}
__device__ __forceinline__ void top16_of_64(unsigned (&g0)[16], unsigned (&g1)[16], unsigned (&g2)[16], unsigned (&g3)[16]) {
    sort16(g0); sort16(g1); sort16(g2); sort16(g3);
    merge16(g0, g1); merge16(g2, g3); merge16(g0, g2);
}
constexpr int NCAND = 50;
__device__ __forceinline__ void p8a_topk(Frame& F) {
    const bf16* QP = (const bf16*)(((unsigned char*)karg(19)) + WS_QP); const bf16* SUBK = (const bf16*)(((unsigned char*)karg(19)) + WS_SUBK);
    unsigned short* PIDX = (unsigned short*)(((unsigned char*)karg(19)) + WS_PIDX); float* PG = (float*)(((unsigned char*)karg(19)) + WS_PG);
    LAS unsigned short* Elds = (LAS unsigned short*)(F.lds) + F.wave * (NCAND * 64);
    const int lane = F.lane, r32 = lane & 31, hi = lane >> 5;
    const int gw = F.vcu * NWAVES + F.wave, NGW = F.G * NWAVES;
    for (int it2 = 0; it2 < 2 * ((M / 64 - F.vcu + F.G - 1) / F.G); ++it2) {
        const int wi = F.vcu + (it2 >> 1) * F.G;
        const int tile = 2 * wi + (it2 & 1);
        const int tok = tile * 32 + r32;
        { const int h = F.wave;
            unsigned top[2][16];
#pragma unroll
            for (int p = 0; p < 2; ++p) {
                bf16x8 qf[4];
                { const bf16* qp = QP + (size_t)tok * D + h * 128 + p * 64 + 8 * hi;
#pragma unroll
                  for (int ks = 0; ks < 4; ++ks) qf[ks] = *(const bf16x8*)(qp + 16 * ks); }
                const bf16* kp = SUBK + (size_t)((h * 2 + p) * 128 + r32) * 64 + 8 * hi;
                unsigned kk[4][16];
#pragma unroll
                for (int blk = 0; blk < 4; ++blk) {
                    f32x16 acc;
#pragma unroll
                    for (int r = 0; r < 16; ++r) acc[r] = 0.f;
#pragma unroll
                    for (int ks = 0; ks < 4; ++ks) { const bf16x8 a = *(const bf16x8*)(kp + (size_t)blk * 32 * 64 + 16 * ks); acc = MFMA32(a, qf[ks], acc); }
#pragma unroll
                    for (int r = 0; r < 16; ++r) { const int key = 32 * blk + crow(r, hi); kk[blk][r] = (f2ord(acc[r]) & ~127u) | (unsigned)(127 - key); }
                }
                top16_of_64(kk[0], kk[1], kk[2], kk[3]);
                unsigned other[16];
#pragma unroll
                for (int i = 0; i < 16; ++i) other[i] = xorx<32>(kk[0][i], lane);
                merge16(kk[0], other);
#pragma unroll
                for (int i = 0; i < 16; ++i) top[p][i] = kk[0][i];
            }
            float s1[16], s2[16]; unsigned i1[16], i2[16];
#pragma unroll
            for (int i = 0; i < 16; ++i) { s1[i] = ord2f(top[0][i] & ~127u); i1[i] = 127u - (top[0][i] & 127u); s2[i] = ord2f(top[1][i] & ~127u); i2[i] = 127u - (top[1][i] & 127u); }
            unsigned ck[4][16];
#pragma unroll
            for (int c = 0; c < 64; ++c) {
                if (c < NCAND) { constexpr int CA[NCAND] = {0,0,0,0,0,0,0,0,0,0,0,0,0,0,0,0,1,1,1,1,1,1,1,1,2,2,2,2,2,3,3,3,3,4,4,4,5,5,6,6,7,7,8,9,10,11,12,13,14,15}; constexpr int CB[NCAND] = {0,1,2,3,4,5,6,7,8,9,10,11,12,13,14,15,0,1,2,3,4,5,6,7,0,1,2,3,4,0,1,2,3,0,1,2,0,1,0,1,0,1,0,0,0,0,0,0,0,0}; const int a = CA[c], b = CB[c];
                    ck[c >> 4][c & 15] = (f2ord(s1[a] + s2[b]) & ~63u) | (unsigned)(63 - c);
                    Elds[c * 64 + lane] = (unsigned short)(i1[a] * 128u + i2[b]); }
                else ck[c >> 4][c & 15] = 0u;
            }
            top16_of_64(ck[0], ck[1], ck[2], ck[3]);
            float w[16]; float wsum = 0.f; const float v0 = ord2f(ck[0][0] & ~63u);
#pragma unroll
            for (int r = 0; r < 16; ++r) { w[r] = __expf(ord2f(ck[0][r] & ~63u) - v0); wsum += w[r]; }
            const float winv = 1.0f / wsum;
#pragma unroll
            for (int r = 0; r < 16; ++r) if ((r >> 3) == hi) {
                const int c = 63 - (int)(ck[0][r] & 63u);
                const unsigned short eid = Elds[c * 64 + lane];
                PIDX[(size_t)tok * 128 + h * 16 + r] = eid; PG[(size_t)tok * 128 + h * 16 + r] = w[r] * winv; }
        }
    }
}

__device__ __forceinline__ float gelu_erf(float v) { return 0.5f * v * (1.0f + erff(v * 0.70710678118654752f)); }

#define PROBE_REPA 1
#define PROBE_REPB 1
constexpr int NR = 8, RSH = 18, BSA = 8, BSB = 8, ELP = 136, TPS = 8;
__device__ __forceinline__ void sort128(unsigned& e0, unsigned& e1, int lane) {
#pragma unroll
    for (int size = 2; size <= 128; size <<= 1) {
#pragma unroll
        for (int stride = size >> 1; stride > 0; stride >>= 1) {
            if (stride == 64) { const unsigned lo = e0 < e1 ? e0 : e1, hi = e0 < e1 ? e1 : e0; e0 = lo; e1 = hi; }
            else {
                const bool lower = (lane & stride) == 0;
                const bool asc0 = (size == 128) ? true : (size == 64 ? true : ((lane & size) == 0));
                const bool asc1 = (size == 128) ? true : (size == 64 ? false : ((lane & size) == 0));
                const unsigned p0 = xorx_sw(e0, lane, stride), p1 = xorx_sw(e1, lane, stride);
                const unsigned mn0 = e0 < p0 ? e0 : p0, mx0 = e0 < p0 ? p0 : e0, mn1 = e1 < p1 ? e1 : p1, mx1 = e1 < p1 ? p1 : e1;
                e0 = (lower == asc0) ? mn0 : mx0; e1 = (lower == asc1) ? mn1 : mx1;
            }
        }
    }
}
template <int BS> __device__ __forceinline__ void sw_issue(v4u (&buf)[BS], const LAS unsigned* el, const unsigned char* tab, unsigned voff) {
#pragma unroll
    for (int i = 0; i < BS; ++i) { const unsigned off = (el[i] << 10) + voff;
        buf[i] = *(const v4u*)(tab + off); }
}
template <int BS> __device__ __forceinline__ void sw_proc_a(const v4u (&buf)[BS], const v4u& hq, LAS float* wl, int s, int n, int lane) {
    const int hx = (int)hq.x, hy = (int)hq.y, hz = (int)hq.z, hw = (int)hq.w;
    float dd[8];
#pragma unroll
    for (int i = 0; i < 8; ++i) dd[i] = 0.f;
#pragma unroll
    for (int i = 0; i < BS; ++i) if (i < n) { const int dx = (int)buf[i].x, dy = (int)buf[i].y, dz = (int)buf[i].z, dw = (int)buf[i].w;
        int t = __builtin_amdgcn_sdot4(hx, dx, 0, false); t = __builtin_amdgcn_sdot4(hy, dy, t, false); t = __builtin_amdgcn_sdot4(hz, dz, t, false); t = __builtin_amdgcn_sdot4(hw, dw, t, false);
        dd[i] = (float)t; }
    const float r1 = reduce8_t(dd, lane);
    if ((lane & 7) == 0 && (lane >> 3) < n) wl[s + (lane >> 3)] = r1;
}
template <int BS> __device__ __forceinline__ void sw_proc_b(const v4u (&buf)[BS], f32x2_t (&acc)[8], const LAS float* wl, int s, int n) {
    float wr[BS];
#pragma unroll
    for (int i = 0; i < BS; ++i) wr[i] = wl[s + i];
#pragma unroll
    for (int i = 0; i < BS; ++i) if (i < n) {
        const float w = wr[i];
        const f32x2_t wv = {w, w};
        const unsigned ux = buf[i].x, uy = buf[i].y, uz = buf[i].z, uw = buf[i].w;
        acc[0] += wv * __builtin_amdgcn_cvt_pk_f32_fp8((int)ux, false); acc[1] += wv * __builtin_amdgcn_cvt_pk_f32_fp8((int)ux, true);
        acc[2] += wv * __builtin_amdgcn_cvt_pk_f32_fp8((int)uy, false); acc[3] += wv * __builtin_amdgcn_cvt_pk_f32_fp8((int)uy, true);
        acc[4] += wv * __builtin_amdgcn_cvt_pk_f32_fp8((int)uz, false); acc[5] += wv * __builtin_amdgcn_cvt_pk_f32_fp8((int)uz, true);
        acc[6] += wv * __builtin_amdgcn_cvt_pk_f32_fp8((int)uw, false); acc[7] += wv * __builtin_amdgcn_cvt_pk_f32_fp8((int)uw, true); }
}
__device__ __forceinline__ void sw_warm(v4u (&pf)[4], const unsigned char* tab, int range, int lw, unsigned voff) {
#pragma unroll
    for (int i = 0; i < 4; ++i) { const unsigned off = ((unsigned)(range * 1024 + lw * 4 + i) << 10) + voff; pf[i] = *(const v4u*)(tab + off); }
}
__device__ __forceinline__ void sw_warm_done(const v4u (&pf)[4]) {
#pragma unroll
    for (int i = 0; i < 4; ++i) asm volatile("" :: "v"(pf[i]));
}
template <int FAKE> __device__ __forceinline__ void p8b_sweep(Frame& F) {
    const float* X1 = (const float*)(((unsigned char*)karg(19)) + WS_X1); const float* MOD = (const float*)(((unsigned char*)karg(19)) + WS_MOD);
    const unsigned char* H2Q = (const unsigned char*)(((unsigned char*)karg(19)) + WS_H2Q); const float* H2S = (const float*)(((unsigned char*)karg(19)) + WS_H2S);
    const unsigned char* EDq = (const unsigned char*)(((unsigned char*)karg(19)) + WS_ED); const unsigned char* EUq = (const unsigned char*)(((unsigned char*)karg(19)) + WS_EU); const float* EDS = (const float*)(((unsigned char*)karg(19)) + WS_EDS);
    const unsigned short* PIDX = (const unsigned short*)(((unsigned char*)karg(19)) + WS_PIDX); const float* PG = (const float*)(((unsigned char*)karg(19)) + WS_PG);
    const float* fg = ((const float*)karg(17));
    const int gw = F.vcu * NWAVES + F.wave, NGW = F.G * NWAVES;
    for (int wi = F.vcu; wi < M / 64; wi += F.G) {
        const int tb = wi * 8 + F.wave;
        unsigned ones = ~0u; asm volatile("" : "+s"(ones));
        int lane = (int)__builtin_amdgcn_mbcnt_hi(ones, __builtin_amdgcn_mbcnt_lo(ones, 0u)); asm volatile("" : "+v"(lane));
        const int tok0 = tb * 8;
        unsigned E0[8], E1[8];
        LAS float* Wl = (LAS float*)(F.lds) + F.wave * 1024;
        LAS unsigned* El = (LAS unsigned*)(F.lds + 32768) + F.wave * (8 * ELP);
        unsigned voff = 16u * (unsigned)lane; asm volatile("" : "+v"(voff));
        LAS int* Bnd = (LAS int*)(F.lds + 67584) + F.wave * (8 * (NR + 1));
#pragma unroll
        for (int k = 0; k < 8; ++k) {
            const size_t base = (size_t)(tok0 + k) * 128;
            E0[k] = ((unsigned)PIDX[base + lane] << 7) | (unsigned)lane; E1[k] = ((unsigned)PIDX[base + 64 + lane] << 7) | (unsigned)(64 + lane);
            sort128(E0[k], E1[k], lane);
            if (FAKE) { E0[k] = (E0[k] & 0x1ffffu) ; E1[k] = (E1[k] & 0x1ffffu); sort128(E0[k], E1[k], lane); }
            El[k * ELP + lane] = E0[k] >> 7; El[k * ELP + 64 + lane] = E1[k] >> 7;
            if (lane < 8) El[k * ELP + 128 + lane] = (unsigned)__builtin_amdgcn_readlane((int)E1[k], 63) >> 7;
        }
        for (int repa = 0; repa < PROBE_REPA; ++repa) {
            v4u hq[8];
#pragma unroll
            for (int k = 0; k < 8; ++k) hq[k] = *(const v4u*)(H2Q + (size_t)(tok0 + k) * D + 16 * lane);
            int pos[8];
#pragma unroll
            for (int k = 0; k < 8; ++k) pos[k] = 0;
            v4u bA[BSA], bB[BSA], bC[BSA]; int ps = 0, pn = 0;
            for (int r = 0; r < NR; ++r) {
#pragma unroll
                for (int k = 0; k < 8; ++k) {
                    constexpr int dummy = 0; (void)dummy;
                    const int kp = (k + 7) & 7;
                    const int c = __builtin_popcountll(__ballot((E0[k] >> RSH) == (unsigned)r)) + __builtin_popcountll(__ballot((E1[k] >> RSH) == (unsigned)r));
                    int s = __builtin_amdgcn_readfirstlane(pos[k]); const int e_end = __builtin_amdgcn_readfirstlane(s + c); pos[k] = e_end;
                    if (lane == 0) Bnd[k * (NR + 1) + r + 1] = e_end;
                    const int n1 = (e_end - s) < BSA ? (e_end - s) : BSA;
                    if (k & 1) sw_issue<BSA>(bB, El + k * ELP + s, EDq, voff); else sw_issue<BSA>(bA, El + k * ELP + s, EDq, voff);
                    if (pn > 0) { if (k & 1) sw_proc_a<BSA>(bA, hq[kp], Wl + kp * 128, ps, pn, lane); else sw_proc_a<BSA>(bB, hq[kp], Wl + kp * 128, ps, pn, lane); }
                    ps = s; pn = n1; s += n1;
#define SWA_REST(Y) if (s < e_end) { sw_issue<BSA>(Y, El + k * ELP + s, EDq, voff); \
                        for (;;) { int n = (e_end - s) < BSA ? (e_end - s) : BSA; \
                            if (s + BSA < e_end) { sw_issue<BSA>(bC, El + k * ELP + s + BSA, EDq, voff); sw_proc_a<BSA>(Y, hq[k], Wl + k * 128, s, n, lane); } else { sw_proc_a<BSA>(Y, hq[k], Wl + k * 128, s, n, lane); break; } \
                            s += BSA; n = (e_end - s) < BSA ? (e_end - s) : BSA; \
                            if (s + BSA < e_end) { sw_issue<BSA>(Y, El + k * ELP + s + BSA, EDq, voff); sw_proc_a<BSA>(bC, hq[k], Wl + k * 128, s, n, lane); } else { sw_proc_a<BSA>(bC, hq[k], Wl + k * 128, s, n, lane); break; } \
                            s += BSA; } }
                    if (k & 1) { SWA_REST(bA) } else { SWA_REST(bB) }
#undef SWA_REST
                }
            }
            if (pn > 0) sw_proc_a<BSA>(bB, hq[7], Wl + 7 * 128, ps, pn, lane);
        }
#pragma unroll
        for (int k = 0; k < 8; ++k) { int tk = tok0 + k; asm volatile("" : "+s"(tk)); const size_t base = (size_t)tk * 128; const float sh = H2S[tk];
            const float r0 = Wl[k * 128 + lane], r1 = Wl[k * 128 + 64 + lane];
            Wl[k * 128 + lane] = PG[base + (E0[k] & 127u)] * gelu_erf(r0 * sh * EDS[E0[k] >> 7]) * 0.0625f;
            Wl[k * 128 + 64 + lane] = PG[base + (E1[k] & 127u)] * gelu_erf(r1 * sh * EDS[E1[k] >> 7]) * 0.0625f; }
        int ln = lane; asm volatile("" : "+v"(ln));
#pragma unroll
        for (int sub = 0; sub < 8 / TPS; ++sub) {
        f32x2_t acc[TPS][8];
        for (int repb = 0; repb < PROBE_REPB; ++repb) {
#pragma unroll
            for (int kk = 0; kk < TPS; ++kk)
#pragma unroll
                for (int i = 0; i < 8; ++i) acc[kk][i] = (f32x2_t){0.f, 0.f};
            int pos[TPS];
#pragma unroll
            for (int kk = 0; kk < TPS; ++kk) pos[kk] = 0;
            v4u bA[BSB], bB[BSB]; int ps = 0, pn = 0;
            for (int r = 0; r < NR; ++r) {
#pragma unroll
                for (int kk = 0; kk < TPS; ++kk) {
                    const int k = sub * TPS + kk, kkp = (kk + TPS - 1) % TPS, kp = sub * TPS + kkp;
                    int s = __builtin_amdgcn_readfirstlane(pos[kk]); const int e_end = __builtin_amdgcn_readfirstlane(Bnd[k * (NR + 1) + r + 1]); pos[kk] = e_end;
                    const int n1 = (e_end - s) < BSB ? (e_end - s) : BSB;
                    if (kk & 1) sw_issue<BSB>(bB, El + k * ELP + s, EUq, voff); else sw_issue<BSB>(bA, El + k * ELP + s, EUq, voff);
                    if (pn > 0) { if (kk & 1) sw_proc_b<BSB>(bA, acc[kkp], Wl + kp * 128, ps, pn); else sw_proc_b<BSB>(bB, acc[kkp], Wl + kp * 128, ps, pn); }
                    ps = s; pn = n1; s += n1;
                    for (; s < e_end; s += BSB) {
                        const int n = (e_end - s) < BSB ? (e_end - s) : BSB;
                        if (kk & 1) { sw_issue<BSB>(bA, El + k * ELP + s, EUq, voff); sw_proc_b<BSB>(bA, acc[kk], Wl + k * 128, s, n); }
                        else        { sw_issue<BSB>(bB, El + k * ELP + s, EUq, voff); sw_proc_b<BSB>(bB, acc[kk], Wl + k * 128, s, n); }
                    }
                }
            }
            if (pn > 0) sw_proc_b<BSB>(bB, acc[TPS - 1], Wl + (sub * TPS + TPS - 1) * 128, ps, pn);
        }
        {
            asm volatile("" : "+v"(ln));
            float* outp = (float*)karg(18);
            const float* gt2 = MOD + ((tok0 + sub * TPS) >> 12) * NMOD + 5120;
            f32x4 gtv[4], xcur[4], xnxt[4];
#pragma unroll
            for (int j = 0; j < 4; ++j) { const int col = 4 * ln + 256 * j; gtv[j] = *(const f32x4*)(gt2 + col); xcur[j] = *(const f32x4*)(X1 + (size_t)(tok0 + sub * TPS) * D + col); }
#pragma unroll
            for (int kk = 0; kk < TPS; ++kk) {
                const int tok = tok0 + sub * TPS + kk;
                if (kk + 1 < TPS) {
#pragma unroll
                    for (int j = 0; j < 4; ++j) xnxt[j] = __builtin_nontemporal_load((const f32x4*)(X1 + (size_t)(tok + 1) * D + 4 * ln + 256 * j));
                }
                f32x4 x2[4]; float ss = 0.f;
#pragma unroll
                for (int j = 0; j < 4; ++j) {
#pragma unroll
                    for (int i = 0; i < 4; ++i) { const float v = xcur[j][i] + gtv[j][i] * acc[kk][2 * j + (i >> 1)][i & 1]; x2[j][i] = v; ss += v * v; } }
                ss = wave_sum_x(ss, ln);
                if (!(FAKE && ss != 12345.678f)) {
                    const float rstd = 1.0f / sqrtf(ss * (1.0f / D) + EPS);
                    f32x4 fgv[4];
#pragma unroll
                    for (int j = 0; j < 4; ++j) fgv[j] = *(const f32x4*)(fg + 4 * ln + 256 * j);
#pragma unroll
                    for (int j = 0; j < 4; ++j) __builtin_nontemporal_store(x2[j] * rstd * fgv[j], (f32x4*)(outp + (size_t)tok * D + 4 * ln + 256 * j));
                }
#pragma unroll
                for (int j = 0; j < 4; ++j) xcur[j] = xnxt[j];
            }
        }
        }
    }
}

struct Args { const float* in[18]; float* out; unsigned char* ws; };
__global__ void __launch_bounds__(NTHR, 2) mega_fwd(Args args) {
    extern __shared__ __attribute__((aligned(16))) unsigned char lds[];
    Frame F;
    F.lds = (LAS unsigned char*)lds;
    F.wave = __builtin_amdgcn_readfirstlane((int)threadIdx.x >> 6); F.lane = lane_fresh(); F.tid = F.wave * 64 + F.lane;
    F.G = gridDim.x; { const int bx = blockIdx.x; F.vcu = (F.G % 8 == 0) ? (bx % 8) * (F.G / 8) + bx / 8 : bx; }
    volatile LAS unsigned* MISC = (volatile LAS unsigned*)(F.lds + MISC_OFF);
    for (int u = F.tid; u < (LDS_BYTES - LDSCTL_OFF) / 4; u += NTHR) ((LAS unsigned*)(F.lds + LDSCTL_OFF))[u] = 0u;
    __syncthreads();
    gu32* ctl = (gu32*)(((unsigned char*)karg(19)) + WS_CTL);
    XcdBarrier bar = xcd_barrier_post((unsigned*)(ctl + CW_BAR), MISC + 8, F.wave);
#define GRID_BAR() xcd_barrier(bar)
#define PROBE_TS -1
#define STAMP(i) do { if (PROBE_TS >= 0 && blockIdx.x == 0 && F.tid == 0) { const unsigned long long t_ = __builtin_amdgcn_s_memrealtime(); MISC[16 + 2 * (i)] = (unsigned)t_; MISC[17 + 2 * (i)] = (unsigned)(t_ >> 32); } } while (0)
#define PROBE_DBL -1

    STAMP(0);
    F.lane = lane_fresh(); F.tid = F.wave * 64 + F.lane;
    p0_prologue(F); GRID_BAR(); STAMP(1);
    if (PROBE_DBL == 0) { p0_prologue(F); GRID_BAR(); }
    F.lane = lane_fresh(); F.tid = F.wave * 64 + F.lane;
    p1_norm(F); p0_transposes(F); GRID_BAR(); STAMP(2);
    if (PROBE_DBL == 1) { p1_norm(F); GRID_BAR(); }
    {
    {
        pg8::Gemm g{(const pg8::bf16_t*)(((unsigned char*)karg(19)) + WS_H), (const pg8::bf16_t*)(((unsigned char*)karg(19)) + WS_WIN), M, NPROJ, D, nullptr, nullptr};
        pg8::StaticOrder S; S.init(M, NPROJ, F.G, (int)blockIdx.x);
        pg8::EpiBf16<0> E{(pg8::bf16_t*)(((unsigned char*)karg(19)) + WS_PROJ), NPROJ, nullptr, 0, 0, 1.f};
        pg8::gemm_phase<pg8::EpiBf16<0>, pg8::StaticOrder, true, true>(F.lds + RING_OFF, g, S, E, F.wave);
        const int nwg = (M / 256) * (NPROJ / 256), busy = nwg % F.G;
        if (busy == 0) p0_quant_tables(F, F.vcu * NWAVES + F.wave, F.G * NWAVES);
        else if ((int)blockIdx.x >= busy) p0_quant_tables(F, ((int)blockIdx.x - busy) * NWAVES + F.wave, (F.G - busy) * NWAVES);
    }
    GRID_BAR(); STAMP(3);
    }
    p3_attention(F); GRID_BAR(); STAMP(4);
    if (PROBE_DBL == 3) { p3_attention(F); GRID_BAR(); }
    {
    {
        pg8::Gemm g{(const pg8::bf16_t*)(((unsigned char*)karg(19)) + WS_OA), (const pg8::bf16_t*)(((unsigned char*)karg(19)) + WS_WA), M, D, 512, (const pg8::bf16_t*)(((unsigned char*)karg(19)) + WS_OB), (const pg8::bf16_t*)(((unsigned char*)karg(19)) + WS_WB)};
        PairOrder S; S.S.init(M, D, F.G, (int)blockIdx.x);
        EpiGate E{(const bf16*)(((unsigned char*)karg(19)) + WS_PROJ), (bf16*)((float*)karg(18)) + (size_t)M * D};
        pg8::gemm_phase<EpiGate, PairOrder, true, true>(F.lds + RING_OFF, g, S, E, F.wave);
    }
    GRID_BAR(); STAMP(5);
    }
    {
    {
        pg8::Gemm g{(const pg8::bf16_t*)((bf16*)((float*)karg(18)) + (size_t)M * D), (const pg8::bf16_t*)(((unsigned char*)karg(19)) + WS_WOUT), M, D, D, nullptr, nullptr};
        pg8::StaticOrder S; S.init(M, D, F.G, (int)blockIdx.x);
        EpiRes E{((const float*)karg(0)), (const float*)(((unsigned char*)karg(19)) + WS_MOD), (float*)(((unsigned char*)karg(19)) + WS_X1)};
        pg8::gemm_phase<EpiRes, pg8::StaticOrder, true, true>(F.lds + RING_OFF, g, S, E, F.wave);
    }
    GRID_BAR(); STAMP(6);
    }
    F.lane = lane_fresh(); F.tid = F.wave * 64 + F.lane;
    F.lane = lane_fresh(); F.tid = F.wave * 64 + F.lane;
    p6_norm2(F); GRID_BAR(); STAMP(7);
    if (PROBE_DBL == 6) { p6_norm2(F); GRID_BAR(); }
    {
    {
        pg8::Gemm g{(const pg8::bf16_t*)(((unsigned char*)karg(19)) + WS_H2), (const pg8::bf16_t*)(((unsigned char*)karg(19)) + WS_WQ), M, D, D, nullptr, nullptr};
        pg8::StaticOrder S; S.init(M, D, F.G, (int)blockIdx.x);
        pg8::EpiBf16<0> E{(pg8::bf16_t*)(((unsigned char*)karg(19)) + WS_QP), D, nullptr, 0, 0, 1.f};
        pg8::gemm_phase<pg8::EpiBf16<0>, pg8::StaticOrder, true, true>(F.lds + RING_OFF, g, S, E, F.wave);
    }
    GRID_BAR(); STAMP(8);
    }
    F.lane = lane_fresh(); F.tid = F.wave * 64 + F.lane;
    p8a_topk(F); __syncthreads(); STAMP(9);
    if (PROBE_DBL == 8) { p8a_topk(F); GRID_BAR(); }
    if (PROBE_DBL == 12) { p8b_sweep<1>(F); __syncthreads(); }
    p8b_sweep<0>(F);
    if (PROBE_DBL == 9) { GRID_BAR(); p8b_sweep<0>(F); }
    if (PROBE_TS >= 0) {
        GRID_BAR(); STAMP(10);
        if (blockIdx.x == 0) { __syncthreads();
            const unsigned long long t0 = ((unsigned long long)MISC[17 + 2 * PROBE_TS] << 32) | MISC[16 + 2 * PROBE_TS], t1 = ((unsigned long long)MISC[19 + 2 * PROBE_TS] << 32) | MISC[18 + 2 * PROBE_TS];
            const float d_us = (float)(t1 - t0) * 0.01f;
            const float V = 128.0f * sqrtf(d_us * 1e-5f);
            float* o = (float*)karg(18); for (int c = F.tid; c < D; c += NTHR) o[c] = V; }
    }
}

extern "C" void kernel_launch(void* const* d_in, const int* in_sizes, int n_in, void* d_out, int out_size, void* d_ws, size_t ws_size, hipStream_t stream) {
    static int grid = 0;
    if (grid == 0) {
        if (n_in != 18 || in_sizes[0] != M * D || out_size != M * D || ws_size < WS_END) { fprintf(stderr, "kernel_launch: unexpected shapes (n_in %d, in0 %d, out %d, ws %zu)\n", n_in, n_in > 0 ? in_sizes[0] : -1, out_size, ws_size); grid = -1; return; }
        int dev = 0, cus = 0, per_cu = 0;
        if (hipGetDevice(&dev) != hipSuccess || hipDeviceGetAttribute(&cus, hipDeviceAttributeMultiprocessorCount, dev) != hipSuccess) { grid = -1; return; }
        if (hipFuncSetAttribute((const void*)mega_fwd, hipFuncAttributeMaxDynamicSharedMemorySize, LDS_BYTES) != hipSuccess) { fprintf(stderr, "kernel_launch: hipFuncSetAttribute failed\n"); grid = -1; return; }
        if (hipOccupancyMaxActiveBlocksPerMultiprocessor(&per_cu, (const void*)mega_fwd, NTHR, LDS_BYTES) != hipSuccess || per_cu < 1) { fprintf(stderr, "kernel_launch: occupancy query says %d blocks per CU\n", per_cu); }
        (void)hipGetLastError();
        grid = cus;
    }
    if (grid < 0) return;
    if (hipMemsetAsync((char*)d_ws + WS_CTL, 0, CTL_ZERO_BYTES, stream) != hipSuccess) { fprintf(stderr, "kernel_launch: memset failed\n"); return; }
    Args a{};
    for (int i = 0; i < 18; ++i) a.in[i] = (const float*)d_in[i];
    a.out = (float*)d_out; a.ws = (unsigned char*)d_ws;
    hipLaunchKernelGGL(mega_fwd, dim3(grid), dim3(NTHR), LDS_BYTES, stream, a);
}
```

```cpp
#include <hip/hip_runtime.h>
#include <cstdio>
#include <cstdint>
__device__ __forceinline__ int lane_fresh() { unsigned ones = ~0u; asm volatile("" : "+s"(ones)); return (int)__builtin_amdgcn_mbcnt_hi(ones, __builtin_amdgcn_mbcnt_lo(ones, 0u)); }
namespace pg8 {
#define PG8_LAS __attribute__((address_space(3)))
typedef unsigned short bf16_t;
typedef short bf16x8 __attribute__((ext_vector_type(8)));
typedef float f32x4 __attribute__((ext_vector_type(4)));
typedef unsigned u32x4 __attribute__((ext_vector_type(4)));
constexpr int BM = 256, BK = 64, HALF = 128, HTB = HALF * BK * 2  , STAGE_BYTES = 8 * HTB, NXCD = 8, WGM = 8;

__host__ __device__ __forceinline__ int lds_byte(int r, int c) { const int st = (r >> 4) * 2 + (c >> 5), rr = r & 15, cc = c & 31, ob = rr * 64 + cc * 2; return st * 1024 + (ob ^ (((ob >> 9) & 1) << 5)); }
__host__ __device__ __forceinline__ void stage_rc(int b, int& R, int& C) { const int st = b / 1024, sb = b % 1024, swz = sb ^ (((sb >> 9) & 1) << 5); R = (st >> 1) * 16 + swz / 64; C = (st & 1) * 32 + (swz % 64) / 2; }
__host__ __device__ __forceinline__ int perm32(int rho) { const int n = rho >> 4, i = rho & 15; return 8 * (i >> 2) + 4 * n + (i & 3); }

struct Unit { int pm, pn, src; };
struct Gemm { const bf16_t* A; const bf16_t* Bt; int M, N, K; const bf16_t* A2; const bf16_t* Bt2; };

struct StaticOrder {
    int nM, nN, nwg, G, c;
    __host__ __device__ void init(int M, int N, int G_, int c_) { nM = M / BM; nN = N / BM; nwg = nM * nN; G = G_; c = c_; }
    __host__ __device__ bool next(int i, Unit& u) const {
        const long L = (long)i * G + c; if (L >= nwg) return false;
        int wgid = (int)L; { const int q = nwg / NXCD, r = nwg % NXCD, xcd = wgid % NXCD, off = wgid / NXCD; wgid = (xcd < r ? xcd * (q + 1) : r * (q + 1) + (xcd - r) * q) + off; }
        const int nig = WGM * nN, gid = wgid / nig, fm = gid * WGM, gsz = (nM - fm) < WGM ? (nM - fm) : WGM;
        u.pm = fm + ((wgid % nig) % gsz); u.pn = (wgid % nig) / gsz; u.src = 0; return true;
    }
    __device__ __forceinline__ void a_ready(const Unit&) const {}
    __device__ __forceinline__ void done(const Unit&) const {}
};

__device__ __forceinline__ unsigned cvt_pk_bf16(float lo, float hi) { unsigned r; asm volatile("v_cvt_pk_bf16_f32 %0, %1, %2" : "=v"(r) : "v"(lo), "v"(hi)); return r; }
typedef float f32x2 __attribute__((ext_vector_type(2)));
__device__ __forceinline__ f32x2 gelu_pk(f32x2 v) {
    const f32x2 av = __builtin_elementwise_abs(v), d = av * 0.2316418882f + 1.0f;
    f32x2 t; t.x = __builtin_amdgcn_rcpf(d.x); t.y = __builtin_amdgcn_rcpf(d.y);
    f32x2 q = t * 0.5307027145f + (-0.7265760135f); q = q * t + 0.7107068705f; q = q * t + (-0.142248368f); q = q * t + 0.127414796f; q = q * t;
    const f32x2 s = (v * v) * (-0.72134752044f);
    f32x2 e; e.x = __builtin_amdgcn_exp2f(s.x); e.y = __builtin_amdgcn_exp2f(s.y);
    const f32x2 m = v * (q * e), r = v - m;
    f32x2 o; o.x = v.x < 0.f ? m.x : r.x; o.y = v.y < 0.f ? m.y : r.y; return o;
}

template <int ACT  > struct EpiBf16 {
    static constexpr bool PERM = true, AFTER_DRAIN = false, CHAIN = false; static_assert(ACT == 0 || ACT == 1, "EpiBf16: ACT is 0 (none) or 1 (gelu_pk)");
    bf16_t* O; int ldc; const float* bias; int split_cols; size_t split_stride; float scale0;
    __device__ __forceinline__ void operator()(const f32x4 (&acc)[2][2][4][2], const Unit& u, int wr, int wc, int fr, int fq) const {
        const int row0 = u.pm * BM + wr * 64 + fr; int colt = u.pn * BM; bf16_t* base = O;
        float sc = 1.f; if (split_cols) { const int t = colt / split_cols; base += (size_t)t * split_stride; colt -= t * split_cols; if (t == 0) sc = scale0; }
        const int col0 = colt + wc * 32 + 8 * fq, bcol0 = u.pn * BM + wc * 32 + 8 * fq;
        f32x4 bv[2][2];
#pragma unroll
        for (int bj = 0; bj < 2; ++bj)
#pragma unroll
            for (int n = 0; n < 2; ++n) bv[bj][n] = bias ? *(const f32x4*)(bias + bcol0 + bj * HALF + 4 * n) : (f32x4){0.f, 0.f, 0.f, 0.f};
#pragma unroll
        for (int ai = 0; ai < 2; ++ai)
#pragma unroll
            for (int m = 0; m < 4; ++m) { bf16_t* rowp = base + (size_t)(row0 + ai * HALF + m * 16) * ldc + col0;
#pragma unroll
                for (int bj = 0; bj < 2; ++bj) { f32x4 v0 = acc[ai][bj][m][0] + bv[bj][0], v1 = acc[ai][bj][m][1] + bv[bj][1];
                    if (ACT == 1) { f32x2 a = gelu_pk((f32x2){v0[0], v0[1]}), b = gelu_pk((f32x2){v0[2], v0[3]}), c = gelu_pk((f32x2){v1[0], v1[1]}), d = gelu_pk((f32x2){v1[2], v1[3]});
                        v0 = (f32x4){a.x, a.y, b.x, b.y}; v1 = (f32x4){c.x, c.y, d.x, d.y}; }
                    v0 = v0 * sc; v1 = v1 * sc; u32x4 w; w.x = cvt_pk_bf16(v0[0], v0[1]); w.y = cvt_pk_bf16(v0[2], v0[3]); w.z = cvt_pk_bf16(v1[0], v1[1]); w.w = cvt_pk_bf16(v1[2], v1[3]);
                    *(u32x4*)(rowp + bj * HALF) = w; } }
    }
};

template <class Epi, class Sched, bool ALIGN_EPI = false, bool SP2 = false>
__device__ __forceinline__ void gemm_phase(PG8_LAS unsigned char* lds, const Gemm g, const Sched& S, const Epi& E, int wave_id) {
    int tid = wave_id * 64 + ::lane_fresh(); asm volatile("" : "+v"(tid));
    const int wid = __builtin_amdgcn_readfirstlane(tid >> 6), lane = tid & 63, wr = wid >> 2, wc = wid & 3, fr = lane & 15, fq = lane >> 4;
    const int K = g.K, nt = K / BK;
    unsigned voffA[2], voffB[2];
#pragma unroll
    for (int i = 0; i < 2; ++i) { int R, C; stage_rc(tid * 16 + i * 8192, R, C); const int Rb = Epi::PERM ? ((R & ~31) + perm32(R & 31)) : R;
        voffA[i] = (unsigned)(R * K + C) * 2u; voffB[i] = (unsigned)(Rb * K + C) * 2u; }
    const size_t kstep = (size_t)(BK * 2);
    const size_t hstep = (size_t)HALF * K * 2;
    const size_t tstep = 2 * hstep;
    const unsigned ldsw = (unsigned)wid * 1024u;
    const int aoff = lds_byte(wr * 64 + fr, fq * 8), boff = lds_byte(wc * 32 + fr, fq * 8);
#define PG8_SA(b, h) (((b) * 2 + (h)) * HTB)
#define PG8_SB(b, h) ((4 + (b) * 2 + (h)) * HTB)
#define PG8_STAGE(bufoff, gbase, voff) do { _Pragma("unroll") for (int _i = 0; _i < 2; ++_i) \
        __builtin_amdgcn_global_load_lds((const unsigned*)((const char*)(gbase) + (voff)[_i]), (PG8_LAS unsigned*)(lds + (bufoff) + ldsw + _i * 8192), 16, 0, 0); } while (0)
#define PG8_LDA(dst, b, h) do { _Pragma("unroll") for (int m = 0; m < 4; ++m) _Pragma("unroll") for (int k = 0; k < 2; ++k) dst[m][k] = *(const PG8_LAS bf16x8*)(lds + PG8_SA(b, h) + aoff + m * 2048 + k * 1024); } while (0)
#define PG8_LDB(dst, b, h) do { _Pragma("unroll") for (int n = 0; n < 2; ++n) _Pragma("unroll") for (int k = 0; k < 2; ++k) dst[n][k] = *(const PG8_LAS bf16x8*)(lds + PG8_SB(b, h) + boff + n * 2048 + k * 1024); } while (0)
#define PG8_MMA(ai, bj, At, Bt) do { __builtin_amdgcn_s_setprio(1); _Pragma("unroll") for (int m = 0; m < 4; ++m) _Pragma("unroll") for (int n = 0; n < 2; ++n) _Pragma("unroll") for (int k = 0; k < 2; ++k) \
        acc[ai][bj][m][n] = __builtin_amdgcn_mfma_f32_16x16x32_bf16(Bt[n][k], At[m][k], acc[ai][bj][m][n], 0, 0, 0); __builtin_amdgcn_s_setprio(0); } while (0)
#define PG8_WAIT_V(n) asm volatile("s_waitcnt vmcnt(" #n ")" ::: "memory")
#define PG8_WAIT_L(n) asm volatile("s_waitcnt lgkmcnt(" #n ")" ::: "memory")
#define PG8_BAR __builtin_amdgcn_s_barrier()
#define PG8_SCHED __builtin_amdgcn_sched_barrier(0)
    Unit cur, nxt; int ui = 0;
    if (!S.next(0, cur)) return;
    f32x4 acc[2][2][4][2];
#pragma unroll
    for (int a = 0; a < 2; ++a)
#pragma unroll
        for (int b = 0; b < 2; ++b)
#pragma unroll
            for (int m = 0; m < 4; ++m)
#pragma unroll
                for (int n = 0; n < 2; ++n) acc[a][b][m][n] = (f32x4){0.f, 0.f, 0.f, 0.f};
    bf16x8 At[4][2], B0[2][2], B1[2][2];
    const char* cA = (const char*)(cur.src ? g.A2 : g.A) + (size_t)cur.pm * tstep; const char* cB = (const char*)(cur.src ? g.Bt2 : g.Bt) + (size_t)cur.pn * tstep;
    S.a_ready(cur);
    if constexpr (SP2) {
        PG8_STAGE(PG8_SB(0, 0), cB, voffB); PG8_STAGE(PG8_SB(0, 1), cB + hstep, voffB); PG8_STAGE(PG8_SA(0, 0), cA, voffA); PG8_STAGE(PG8_SA(0, 1), cA + hstep, voffA);
        if (wr == 1) PG8_BAR;
        PG8_WAIT_V(2); PG8_BAR;
        PG8_STAGE(PG8_SB(1, 0), cB + kstep, voffB); PG8_STAGE(PG8_SA(1, 0), cA + kstep, voffA); PG8_STAGE(PG8_SB(1, 1), cB + hstep + kstep, voffB);
        PG8_WAIT_V(6); PG8_BAR;
    } else {
        PG8_STAGE(PG8_SB(0, 0), cB, voffB); PG8_STAGE(PG8_SA(0, 0), cA, voffA); PG8_STAGE(PG8_SB(0, 1), cB + hstep, voffB); PG8_STAGE(PG8_SA(0, 1), cA + hstep, voffA);
        if (wr == 1) PG8_BAR;
        PG8_WAIT_V(4); PG8_BAR;
        PG8_STAGE(PG8_SB(1, 0), cB + kstep, voffB); PG8_STAGE(PG8_SA(1, 0), cA + kstep, voffA); PG8_STAGE(PG8_SB(1, 1), cB + hstep + kstep, voffB);
        PG8_WAIT_V(6); PG8_BAR;
    }
    for (;;) {
        const bool has_next = S.next(ui + 1, nxt);
        const char* nA = has_next ? (const char*)(nxt.src ? g.A2 : g.A) + (size_t)nxt.pm * tstep : cA; const char* nB = has_next ? (const char*)(nxt.src ? g.Bt2 : g.Bt) + (size_t)nxt.pn * tstep : cB;
        for (int t = 0; t < nt; t += 2) {
            const bool last = (t == nt - 2);
            const char* a1 = cA + (size_t)(t + 1) * kstep;
            const char* a2 = last ? nA : cA + (size_t)(t + 2) * kstep; const char* b2 = last ? nB : cB + (size_t)(t + 2) * kstep;
            const char* a3 = a2 + kstep; const char* b3 = b2 + kstep;
            if (last && has_next) S.a_ready(nxt);
            if constexpr (SP2) {
            PG8_LDB(B0, 0, 0); PG8_LDB(B1, 0, 1); PG8_SCHED; PG8_LDA(At, 0, 0); PG8_STAGE(PG8_SA(1, 1), a1 + hstep, voffA);
            PG8_WAIT_V(8); PG8_WAIT_L(0); PG8_BAR; PG8_MMA(0, 0, At, B0); PG8_MMA(0, 1, At, B1); PG8_BAR; PG8_SCHED;
            PG8_LDA(At, 0, 1); PG8_STAGE(PG8_SB(0, 0), b2, voffB); PG8_STAGE(PG8_SB(0, 1), b2 + hstep, voffB); PG8_STAGE(PG8_SA(0, 0), a2, voffA);
            PG8_WAIT_V(8); PG8_WAIT_L(0); PG8_BAR; PG8_MMA(1, 0, At, B0); PG8_MMA(1, 1, At, B1); PG8_BAR; PG8_SCHED;
            PG8_LDB(B0, 1, 0); PG8_LDB(B1, 1, 1); PG8_SCHED; PG8_LDA(At, 1, 0); PG8_STAGE(PG8_SA(0, 1), a2 + hstep, voffA);
            PG8_WAIT_V(8); PG8_WAIT_L(0); PG8_BAR; PG8_MMA(0, 0, At, B0); PG8_MMA(0, 1, At, B1); PG8_BAR; PG8_SCHED;
            PG8_LDA(At, 1, 1); PG8_STAGE(PG8_SB(1, 0), b3, voffB); PG8_STAGE(PG8_SB(1, 1), b3 + hstep, voffB); PG8_STAGE(PG8_SA(1, 0), a3, voffA);
            PG8_WAIT_V(8); PG8_WAIT_L(0); PG8_BAR; PG8_MMA(1, 0, At, B0); PG8_MMA(1, 1, At, B1); PG8_BAR; PG8_SCHED;
            } else {
            PG8_LDB(B0, 0, 0); PG8_SCHED; PG8_LDA(At, 0, 0); PG8_STAGE(PG8_SA(1, 1), a1 + hstep, voffA);
            PG8_WAIT_L(8); PG8_BAR; PG8_WAIT_L(0); PG8_MMA(0, 0, At, B0); PG8_BAR; PG8_SCHED;
            PG8_LDB(B1, 0, 1); PG8_STAGE(PG8_SB(0, 0), b2, voffB);
            PG8_BAR; PG8_WAIT_L(0); PG8_MMA(0, 1, At, B1); PG8_BAR;
            PG8_LDA(At, 0, 1); PG8_STAGE(PG8_SA(0, 0), a2, voffA);
            PG8_BAR; PG8_WAIT_L(0); PG8_MMA(1, 0, At, B0); PG8_BAR; PG8_SCHED;
            PG8_STAGE(PG8_SB(0, 1), b2 + hstep, voffB);
            PG8_WAIT_V(6); PG8_BAR; PG8_MMA(1, 1, At, B1); PG8_BAR;
            PG8_LDB(B0, 1, 0); PG8_SCHED; PG8_LDA(At, 1, 0); PG8_STAGE(PG8_SA(0, 1), a2 + hstep, voffA);
            PG8_WAIT_L(8); PG8_BAR; PG8_WAIT_L(0); PG8_MMA(0, 0, At, B0); PG8_BAR; PG8_SCHED;
            PG8_LDB(B1, 1, 1); PG8_STAGE(PG8_SB(1, 0), b3, voffB);
            PG8_BAR; PG8_WAIT_L(0); PG8_MMA(0, 1, At, B1); PG8_BAR;
            PG8_LDA(At, 1, 1); PG8_STAGE(PG8_SA(1, 0), a3, voffA);
            PG8_BAR; PG8_WAIT_L(0); PG8_MMA(1, 0, At, B0); PG8_BAR; PG8_SCHED;
            PG8_STAGE(PG8_SB(1, 1), b3 + hstep, voffB);
            PG8_WAIT_V(6); PG8_BAR; PG8_MMA(1, 1, At, B1); PG8_BAR;
            }
        }
        if constexpr (ALIGN_EPI) { if (wr == 0) PG8_BAR; }
        if constexpr (!Epi::AFTER_DRAIN) { E(acc, cur, wr, wc, fr, fq); S.done(cur); }
        if (!has_next) break;
        if (!(Epi::CHAIN && cur.src == 0)) {
#pragma unroll
        for (int a = 0; a < 2; ++a)
#pragma unroll
            for (int b = 0; b < 2; ++b)
#pragma unroll
                for (int m = 0; m < 4; ++m)
#pragma unroll
                    for (int n = 0; n < 2; ++n) acc[a][b][m][n] = (f32x4){0.f, 0.f, 0.f, 0.f};
        }
        cur = nxt; cA = nA; cB = nB; ++ui;
        if constexpr (ALIGN_EPI) { if (wr == 1) PG8_BAR; }
    }
    PG8_WAIT_V(0);
    if constexpr (!ALIGN_EPI) { if (wr == 0) PG8_BAR; }
    PG8_BAR;
    if constexpr (Epi::AFTER_DRAIN) { E.fused(acc, cur, wr, wc, fr, fq, lds, wid, lane); S.done(cur); }
#undef PG8_SA
#undef PG8_SB
#undef PG8_STAGE
#undef PG8_LDA
#undef PG8_LDB
#undef PG8_MMA
#undef PG8_WAIT_V
#undef PG8_WAIT_L
#undef PG8_BAR
#undef PG8_SCHED
}
}

#define GAS __attribute__((address_space(1)))
#define LAS __attribute__((address_space(3)))
typedef unsigned short bf16;
typedef unsigned v4u __attribute__((ext_vector_type(4)));
typedef float f32x4 __attribute__((ext_vector_type(4)));
typedef short bf16x8 __attribute__((ext_vector_type(8)));
typedef GAS unsigned gu32;
typedef GAS unsigned long long gu64;
#define RLX_AGENT __ATOMIC_RELAXED, __HIP_MEMORY_SCOPE_AGENT
#define LDS_WAIT() asm volatile("s_waitcnt lgkmcnt(0)" ::: "memory")
#define VM_WAIT() asm volatile("s_waitcnt vmcnt(0)" ::: "memory")
__device__ __forceinline__ unsigned long long rt() { return __builtin_amdgcn_s_memrealtime(); }
__device__ __forceinline__ unsigned f2bf(float f) { unsigned u = __builtin_bit_cast(unsigned, f); return (u + 0x7fffu + ((u >> 16) & 1u)) >> 16; }
__device__ __forceinline__ unsigned pk2(float lo, float hi) { return f2bf(lo) | (f2bf(hi) << 16); }

__device__ __forceinline__ const void* karg(int i);
constexpr int CW_BAR_FWD = 4096;
#define XB_TMO      128
#define XB_XCNT(j)  (256  + 64 * (j))
#define XB_XSUB(j)  (1280 + 64 * (j))
#define XB_XGEN(j)  (2304 + 64 * (j))
#define XB_TOP      3328
#define XB_TOPGEN   3392
#define XCD_BAR_WORDS 3456
#define XB_SPIN_CAP (1u << 18)

__device__ __forceinline__ unsigned xb_ld(unsigned* p)              { return __hip_atomic_load(p, __ATOMIC_RELAXED, __HIP_MEMORY_SCOPE_AGENT); }
__device__ __forceinline__ unsigned xb_add(unsigned* p, unsigned v) { return __hip_atomic_fetch_add(p, v, __ATOMIC_RELAXED, __HIP_MEMORY_SCOPE_AGENT); }
__device__ __forceinline__ unsigned xb_xcc_id() { return (unsigned)__builtin_amdgcn_s_getreg((3 << 11) | 20) & 0xFu; }
#define XB_SPIN(cond, bar) do { unsigned _sp = 0; while (cond) { __builtin_amdgcn_s_sleep(1); \
    if ((++_sp & 255u) == 0u) { if (xb_ld(&(bar)[XB_TMO])) break; if (_sp > XB_SPIN_CAP) { atomicAdd(&(bar)[XB_TMO], 1u); break; } } } } while (0)

struct XcdBarrier {
    int wave;
    unsigned* bar; unsigned x;
    volatile LAS unsigned* st;
};

__device__ __forceinline__ XcdBarrier xcd_barrier_post(unsigned* bar, volatile LAS unsigned* st, int wave) {
    XcdBarrier b; b.wave = wave; b.bar = bar; b.x = xb_xcc_id(); b.st = st;
    if (wave == 0 && lane_fresh() == 0) (void)xb_add(&bar[XB_XCNT(b.x)], 1u);
    return b;
}
__device__ __forceinline__ void xcd_barrier_complete(unsigned* bar, unsigned x, unsigned& nloc, unsigned& nx) {
    const unsigned G = gridDim.x * gridDim.y * gridDim.z;
    unsigned sum, cnt, mine, sp = 0u;
    for (;;) {
        sum = 0u; cnt = 0u; mine = 0u;
#pragma unroll
        for (unsigned j = 0; j < 16; ++j) { const unsigned c = xb_ld(&bar[XB_XCNT(j)]); sum += c; cnt += (c > 0u) ? 1u : 0u; mine = (j == x) ? c : mine; }
        if (sum == G) break;
        __builtin_amdgcn_s_sleep(1);
        if ((++sp & 255u) == 0u) { if (xb_ld(&bar[XB_TMO])) break; if (sp > XB_SPIN_CAP) { atomicAdd(&bar[XB_TMO], 1u); break; } }
    }
    nloc = mine > 0u ? mine : 1u; nx = cnt > 0u ? cnt : 1u;
}

__device__ __forceinline__ void xcd_barrier(const XcdBarrier& b) {
    asm volatile("s_waitcnt vmcnt(0)" ::: "memory");
    __syncthreads();
    if (b.wave == 0 && lane_fresh() == 0) {
        unsigned* bar = (unsigned*)((gu32*)((unsigned char*)karg(19)) + CW_BAR_FWD);
        __builtin_amdgcn_s_waitcnt(0);
        unsigned nloc = b.st[0], nx = b.st[1];
        if (nloc == 0u) { xcd_barrier_complete(bar, b.x, nloc, nx); b.st[0] = nloc; b.st[1] = nx; }
        const unsigned old = xb_add(&bar[XB_XSUB(b.x)], 1u);
        const unsigned gen = old / nloc;
        if (old + 1u == (gen + 1u) * nloc) {
            __builtin_amdgcn_fence(__ATOMIC_RELEASE, "agent");
            asm volatile("s_waitcnt vmcnt(0)" ::: "memory");
            const unsigned og = xb_add(&bar[XB_TOP], 1u);
            const unsigned tg = og / nx;
            if (og + 1u == (tg + 1u) * nx) xb_add(&bar[XB_TOPGEN], 1u);
            else XB_SPIN(xb_ld(&bar[XB_TOPGEN]) == tg, bar);
            __builtin_amdgcn_fence(__ATOMIC_ACQUIRE, "agent");
            xb_add(&bar[XB_XGEN(b.x)], 1u);
            asm volatile("s_waitcnt vmcnt(0)" ::: "memory");
        } else {
            XB_SPIN(xb_ld(&bar[XB_XGEN(b.x)]) == gen, bar);
            __builtin_amdgcn_fence(__ATOMIC_ACQUIRE, "agent");
            asm volatile("s_waitcnt vmcnt(0)" ::: "memory");
        }
    }
    __syncthreads();
}

constexpr int NWAVES = 8, NTHR = 512;
constexpr int BATCH = 4, SEQ = 4096, D = 1024, M = BATCH * SEQ;
constexpr int NPROJ = 4352, LDW_IN = 4360, NMOD = 6144;
constexpr int C_QA = 0, C_KA = 512, C_VA = 640, C_QB = 768, C_KB = 1280, C_VB = 1792, C_GLA = 2304, C_GLB = 3328;
constexpr int NEXP = 16384;
constexpr float EPS = 1e-6f;

constexpr size_t MiB = 1u << 20;
constexpr size_t WS_CTL = 0, CTL_ZERO_BYTES = 1 * MiB;
constexpr size_t WS_MOD = 1 * MiB, WS_LOGF = 1 * MiB + 128 * 1024, WS_SUBK = 2 * MiB;
constexpr size_t WS_WIN = 4 * MiB, WS_WA = 12 * MiB + 512 * 1024, WS_WB = 13 * MiB + 512 * 1024, WS_WOUT = 14 * MiB + 512 * 1024, WS_WQ = 16 * MiB + 512 * 1024;
constexpr size_t WS_ED = 19 * MiB, WS_EU = 35 * MiB;
constexpr size_t WS_EDS = 2 * MiB + 512 * 1024;
constexpr size_t WS_H2Q = 95 * MiB, WS_H2S = 111 * MiB;
constexpr size_t WS_H = 83 * MiB, WS_OA = 83 * MiB, WS_OB = 99 * MiB, WS_PIDX = 83 * MiB, WS_PG = 87 * MiB;
constexpr size_t WS_PROJ = 115 * MiB, WS_X1 = 115 * MiB, WS_H2 = 179 * MiB, WS_QP = 211 * MiB;
constexpr size_t WS_END = 251 * MiB;
static_assert(WS_WIN + (size_t)NPROJ * D * 2 <= WS_WA && WS_WQ + (size_t)D * D * 2 <= WS_ED && WS_PROJ + (size_t)M * NPROJ * 2 <= WS_END, "ws map");
constexpr int CW_BAR = 4096; static_assert(CW_BAR == CW_BAR_FWD && WS_CTL == 0, "barrier words");

constexpr int RING_OFF = 0, RING_BYTES = 131072;
constexpr int LDSCTL_OFF = RING_BYTES, MISC_OFF = LDSCTL_OFF + 320;
constexpr int LDS_BYTES = 147456;

typedef float f32x16 __attribute__((ext_vector_type(16)));
typedef short s16x4 __attribute__((ext_vector_type(4)));
typedef unsigned u32x2 __attribute__((ext_vector_type(2)));
typedef float f32x2_t __attribute__((ext_vector_type(2)));
typedef __bf16 bf16x2_t __attribute__((ext_vector_type(2)));

__device__ __forceinline__ unsigned cvtpk(float lo, float hi) { f32x2_t v = {lo, hi}; bf16x2_t b = __builtin_convertvector(v, bf16x2_t); return __builtin_bit_cast(unsigned, b); }
__device__ __forceinline__ float bflo(unsigned u) { return __uint_as_float(u << 16); }
__device__ __forceinline__ float bfhi(unsigned u) { return __uint_as_float(u & 0xffff0000u); }
template <int S> __device__ __forceinline__ unsigned xorx(unsigned v, int lane) {
    if constexpr (S == 1) return (unsigned)__builtin_amdgcn_update_dpp(0, (int)v, 0xB1, 0xF, 0xF, true);
    else if constexpr (S == 2) return (unsigned)__builtin_amdgcn_update_dpp(0, (int)v, 0x4E, 0xF, 0xF, true);
    else if constexpr (S == 4) { const unsigned a = (unsigned)__builtin_amdgcn_update_dpp(0, (int)v, 0x124, 0xF, 0xF, true), b = (unsigned)__builtin_amdgcn_update_dpp(0, (int)v, 0x12C, 0xF, 0xF, true); return (lane & 4) ? a : b; }
    else if constexpr (S == 8) return (unsigned)__builtin_amdgcn_update_dpp(0, (int)v, 0x128, 0xF, 0xF, true);
    else if constexpr (S == 16) { const auto r = __builtin_amdgcn_permlane16_swap(v, v, false, false); return (lane & 16) ? r[0] : r[1]; }
    else { const auto r = __builtin_amdgcn_permlane32_swap(v, v, false, false); return (lane & 32) ? r[0] : r[1]; }
}
__device__ __forceinline__ unsigned xorx_sw(unsigned v, int lane, int s) {
    switch (s) { case 1: return xorx<1>(v, lane); case 2: return xorx<2>(v, lane); case 4: return xorx<4>(v, lane); case 8: return xorx<8>(v, lane); case 16: return xorx<16>(v, lane); default: return xorx<32>(v, lane); }
}
__device__ __forceinline__ float wave_sum_x(float v, int lane) {
    v += __uint_as_float(xorx<1>(__float_as_uint(v), lane)); v += __uint_as_float(xorx<2>(__float_as_uint(v), lane)); v += __uint_as_float(xorx<4>(__float_as_uint(v), lane));
    v += __uint_as_float(xorx<8>(__float_as_uint(v), lane)); v += __uint_as_float(xorx<16>(__float_as_uint(v), lane)); v += __uint_as_float(xorx<32>(__float_as_uint(v), lane));
    return v;
}
__device__ __forceinline__ float dppf(float v, const int ctrl_sel) { return v; }
#define DPP_F(v, CTRL) __uint_as_float(__builtin_amdgcn_update_dpp(0, __float_as_uint(v), (CTRL), 0xF, 0xF, true))
__device__ __forceinline__ float reduce8_t(const float (&dd)[8], int lane) {
    float r4[4];
#pragma unroll
    for (int u = 0; u < 4; ++u) { const auto p = __builtin_amdgcn_permlane32_swap(__float_as_uint(dd[u]), __float_as_uint(dd[u + 4]), false, false); r4[u] = __uint_as_float(p[0]) + __uint_as_float(p[1]); }
    float r2[2];
#pragma unroll
    for (int u = 0; u < 2; ++u) { const auto p = __builtin_amdgcn_permlane16_swap(__float_as_uint(r4[u]), __float_as_uint(r4[u + 2]), false, false); r2[u] = __uint_as_float(p[0]) + __uint_as_float(p[1]); }
    const bool b3 = (lane & 8) != 0;
    const float keep = b3 ? r2[1] : r2[0], send = b3 ? r2[0] : r2[1];
    float r1 = keep + DPP_F(send, 0x128);
    r1 += DPP_F(r1, 0xB1);
    r1 += DPP_F(r1, 0x4E);
    r1 += DPP_F(r1, 0x141);
    return r1;
}
__device__ __forceinline__ int lane_id() { return (int)__builtin_amdgcn_mbcnt_hi(~0u, __builtin_amdgcn_mbcnt_lo(~0u, 0u)); }
__device__ __forceinline__ float wave_sum(float v) { return wave_sum_x(v, lane_id()); }
__device__ __forceinline__ float wave_max(float v) { const int lane = lane_id();
    v = fmaxf(v, __uint_as_float(xorx<1>(__float_as_uint(v), lane))); v = fmaxf(v, __uint_as_float(xorx<2>(__float_as_uint(v), lane))); v = fmaxf(v, __uint_as_float(xorx<4>(__float_as_uint(v), lane)));
    v = fmaxf(v, __uint_as_float(xorx<8>(__float_as_uint(v), lane))); v = fmaxf(v, __uint_as_float(xorx<16>(__float_as_uint(v), lane))); v = fmaxf(v, __uint_as_float(xorx<32>(__float_as_uint(v), lane)));
    return v; }
__device__ __forceinline__ int crow(int r, int hi) { return (r & 3) + 8 * (r >> 2) + 4 * hi; }
#define MFMA32(a, b, c) __builtin_amdgcn_mfma_f32_32x32x16_bf16((a), (b), (c), 0, 0, 0)

struct Frame {
    LAS unsigned char* lds;
    int tid, lane, wave, vcu, G;
};
__device__ __forceinline__ const void* karg(int i) {
    unsigned long z = 0; asm volatile("" : "+s"(z));
    const char* base = (const char*)__builtin_amdgcn_kernarg_segment_ptr();
    return *(const void* const*)(base + 8 * i + z);
}

__device__ __forceinline__ void p0_transpose_item(const float* W, int ld, int K, int ncols, bf16* WT, int row_off, LAS float* scr, int item, int lane) {
    const int nblk = ncols / 32, kb = item / nblk, nb = item % nblk, k0 = 64 * kb, n0 = 32 * nb;
#pragma unroll 8
    for (int i = 0; i < 32; ++i) { const int kk = 2 * i + (lane >> 5); scr[kk * 33 + (lane & 31)] = __builtin_nontemporal_load(W + (size_t)(k0 + kk) * ld + n0 + (lane & 31)); }
    LDS_WAIT(); asm volatile("" ::: "memory");
    const int c = lane & 7;
#pragma unroll
    for (int j = 0; j < 4; ++j) { const int n = (lane >> 3) + 8 * j; const LAS float* s = scr + (8 * c) * 33 + n;
        v4u o; o.x = pk2(s[0 * 33], s[1 * 33]); o.y = pk2(s[2 * 33], s[3 * 33]); o.z = pk2(s[4 * 33], s[5 * 33]); o.w = pk2(s[6 * 33], s[7 * 33]);
        *(GAS v4u*)(WT + (size_t)(row_off + n0 + n) * K + k0 + 8 * c) = o; }
    LDS_WAIT(); asm volatile("" ::: "memory");
}
__device__ __forceinline__ void p0_convert(const float* __restrict__ src, bf16* __restrict__ dst, long n_iters, int gw, int NGW, int lane) {
    for (long it0 = (long)gw * 4; it0 < n_iters; it0 += (long)NGW * 4) {
        f32x4 a[4][2];
#pragma unroll
        for (int u = 0; u < 4; ++u) { const long it = it0 + u; if (it < n_iters) { const float* p = src + it * 512 + lane * 4; a[u][0] = *(const f32x4*)p; a[u][1] = *(const f32x4*)(p + 256); } }
#pragma unroll
        for (int u = 0; u < 4; ++u) { const long it = it0 + u; if (it < n_iters) { bf16* q = dst + it * 512 + lane * 4;
            u32x2 w0, w1; w0.x = cvtpk(a[u][0].x, a[u][0].y); w0.y = cvtpk(a[u][0].z, a[u][0].w); w1.x = cvtpk(a[u][1].x, a[u][1].y); w1.y = cvtpk(a[u][1].z, a[u][1].w);
            *(u32x2*)q = w0; *(u32x2*)(q + 256) = w1; } }
    }
}

__device__ __forceinline__ void p0_quant_tables(Frame& F, int gw, int NGW) {
    const float* ed = ((const float*)karg(15)); const float* eu = ((const float*)karg(16));
    unsigned char* EDq = (unsigned char*)(((unsigned char*)karg(19)) + WS_ED); unsigned char* EUq = (unsigned char*)(((unsigned char*)karg(19)) + WS_EU); float* EDS = (float*)(((unsigned char*)karg(19)) + WS_EDS);
    const int lane = F.lane;
    for (int row0 = gw * 4; row0 < NEXP; row0 += NGW * 4) {
        f32x4 a[4][4], u[4][4];
#pragma unroll
        for (int q = 0; q < 4; ++q)
#pragma unroll
            for (int j = 0; j < 4; ++j) { a[q][j] = __builtin_nontemporal_load((const f32x4*)(ed + (size_t)(row0 + q) * D) + lane + 64 * j); u[q][j] = __builtin_nontemporal_load((const f32x4*)(eu + (size_t)(row0 + q) * D) + lane + 64 * j); }
#pragma unroll
        for (int q = 0; q < 4; ++q) {
            float am = 0.f;
#pragma unroll
            for (int j = 0; j < 4; ++j) am = fmaxf(fmaxf(am, fmaxf(fabsf(a[q][j].x), fabsf(a[q][j].y))), fmaxf(fabsf(a[q][j].z), fabsf(a[q][j].w)));
            am = wave_max(am);
            const float sc = am > 0.f ? am * (1.0f / 127.0f) : 1.0f, inv = 1.0f / sc;
            v4u qa, qu;
#pragma unroll
            for (int j = 0; j < 4; ++j) {
                const int b0 = (int)rintf(a[q][j].x * inv), b1 = (int)rintf(a[q][j].y * inv), b2 = (int)rintf(a[q][j].z * inv), b3 = (int)rintf(a[q][j].w * inv);
                qa[j] = (unsigned)(b0 & 255) | ((unsigned)(b1 & 255) << 8) | ((unsigned)(b2 & 255) << 16) | ((unsigned)(b3 & 255) << 24);
                int p = __builtin_amdgcn_cvt_pk_fp8_f32(u[q][j].x * 16.0f, u[q][j].y * 16.0f, 0, false);
                p = __builtin_amdgcn_cvt_pk_fp8_f32(u[q][j].z * 16.0f, u[q][j].w * 16.0f, p, true);
                qu[j] = (unsigned)p;
            }
            __builtin_nontemporal_store(qa, (v4u*)(EDq + (size_t)(row0 + q) * D + 16 * lane));
            __builtin_nontemporal_store(qu, (v4u*)(EUq + (size_t)(row0 + q) * D + 16 * lane));
            if (lane == 0) EDS[row0 + q] = sc;
        }
    }
}
__device__ __forceinline__ void p0_prologue(Frame& F) {
    const float* c = ((const float*)karg(1)); const float* w_ada = ((const float*)karg(4)); const float* b_ada = ((const float*)karg(5));
    float* MOD = (float*)(((unsigned char*)karg(19)) + WS_MOD);
    {
        LAS float* cact = (LAS float*)(F.lds);
        LAS float* part = (LAS float*)(F.lds + 16384);
        bool did = false;
        for (int item = F.vcu; item < NMOD / 32; item += F.G) {
            if (!did) { for (int i = F.tid; i < 4096; i += NTHR) { const float cv = c[i]; cact[i] = cv / (1.0f + __expf(-cv)); } did = true; }
            __syncthreads();
            const int n0 = item * 32, col = n0 + (F.lane & 31), ksub = F.lane >> 5;
            float a0 = 0.f, a1 = 0.f, a2 = 0.f, a3 = 0.f;
#pragma unroll 16
            for (int it = 0; it < 64; ++it) { const int k = (it * 8 + F.wave) * 2 + ksub; const float w = __builtin_nontemporal_load(w_ada + (size_t)k * NMOD + col);
                a0 += cact[k] * w; a1 += cact[1024 + k] * w; a2 += cact[2048 + k] * w; a3 += cact[3072 + k] * w; }
            a0 += __shfl_xor(a0, 32); a1 += __shfl_xor(a1, 32); a2 += __shfl_xor(a2, 32); a3 += __shfl_xor(a3, 32);
            if (F.lane < 32) { part[(F.wave * 4 + 0) * 32 + F.lane] = a0; part[(F.wave * 4 + 1) * 32 + F.lane] = a1; part[(F.wave * 4 + 2) * 32 + F.lane] = a2; part[(F.wave * 4 + 3) * 32 + F.lane] = a3; }
            __syncthreads();
            if (F.tid < 128) { const int b = F.tid >> 5, cl = F.tid & 31; float s = 0.f;
#pragma unroll
                for (int w = 0; w < 8; ++w) s += part[(w * 4 + b) * 32 + cl];
                MOD[b * NMOD + n0 + cl] = s + b_ada[n0 + cl]; }
            __syncthreads();
        }
    }
    {
        const int gw = F.vcu * NWAVES + F.wave, NGW = F.G * NWAVES;
        p0_convert(((const float*)karg(14)), (bf16*)(((unsigned char*)karg(19)) + WS_SUBK), (long)(8 * 2 * 128 * 64) / 512, gw, NGW, F.lane);
    }
}
__device__ __forceinline__ void p0_transposes(Frame& F) {
    LAS float* scr = (LAS float*)(F.lds + 32768 + F.wave * 8704);
    const int gw = F.vcu * NWAVES + F.wave, NGW = F.G * NWAVES;
    constexpr int I_IN1 = (D / 64) * (2304 / 32), I_IN2 = (D / 64) * (2048 / 32), I_AB = (512 / 64) * (D / 32), I_SQ = (D / 64) * (D / 32);
    constexpr int NITEMS = I_IN1 + I_IN2 + 2 * I_AB + 2 * I_SQ;
    bf16* Win_t = (bf16*)(((unsigned char*)karg(19)) + WS_WIN);
    for (int it = gw; it < NITEMS; it += NGW) {
        int r = it;
        if (r < I_IN1) { p0_transpose_item(((const float*)karg(6)), LDW_IN, D, 2304, Win_t, 0, scr, r, F.lane); continue; } r -= I_IN1;
        if (r < I_IN2) { p0_transpose_item(((const float*)karg(6)) + 2312, LDW_IN, D, 2048, Win_t, 2304, scr, r, F.lane); continue; } r -= I_IN2;
        if (r < I_AB) { p0_transpose_item(((const float*)karg(9)), D, 512, D, (bf16*)(((unsigned char*)karg(19)) + WS_WA), 0, scr, r, F.lane); continue; } r -= I_AB;
        if (r < I_AB) { p0_transpose_item(((const float*)karg(10)), D, 512, D, (bf16*)(((unsigned char*)karg(19)) + WS_WB), 0, scr, r, F.lane); continue; } r -= I_AB;
        if (r < I_SQ) { p0_transpose_item(((const float*)karg(11)), D, D, D, (bf16*)(((unsigned char*)karg(19)) + WS_WOUT), 0, scr, r, F.lane); continue; } r -= I_SQ;
        p0_transpose_item(((const float*)karg(13)), D, D, D, (bf16*)(((unsigned char*)karg(19)) + WS_WQ), 0, scr, r, F.lane);
    }
}

__device__ __forceinline__ void p1_norm(Frame& F) {
    const float* x = ((const float*)karg(0)); const float* g1 = ((const float*)karg(2)); const float* w_in = ((const float*)karg(6)); const float* b_forget = ((const float*)karg(7));
    const float* MOD = (const float*)(((unsigned char*)karg(19)) + WS_MOD); bf16* H = (bf16*)(((unsigned char*)karg(19)) + WS_H); float* LOGF = (float*)(((unsigned char*)karg(19)) + WS_LOGF);
    LAS float* wfl = (LAS float*)(F.lds);
    { float tmp[16];
#pragma unroll
      for (int n = 0; n < 16; ++n) { const int i = F.tid + n * NTHR; tmp[n] = w_in[(size_t)(i >> 3) * LDW_IN + 2304 + (i & 7)]; }
#pragma unroll
      for (int n = 0; n < 16; ++n) { const int i = F.tid + n * NTHR; wfl[(i & 7) * 1024 + (i >> 3)] = tmp[n]; } }
    __syncthreads();
    const int gw = F.vcu * NWAVES + F.wave, NGW = F.G * NWAVES;
    for (int c = gw; c < M / 8; c += NGW) {
        const int row0 = c * 8; const float* mb = MOD + (row0 >> 12) * NMOD;
        f32x4 ga[4], sh[4];
#pragma unroll
        for (int j = 0; j < 4; ++j) { const int col = 4 * F.lane + 256 * j; const f32x4 g = *(const f32x4*)(g1 + col), sc = *(const f32x4*)(mb + 1024 + col); sh[j] = *(const f32x4*)(mb + col); ga[j] = g * (sc + 1.0f); }
        f32x4 r0[4], r1[4], r2[4];
        { const f32x4* xr = (const f32x4*)(x + (size_t)row0 * D) + F.lane;
#pragma unroll
          for (int j = 0; j < 4; ++j) r0[j] = __builtin_nontemporal_load(xr + 64 * j);
#pragma unroll
          for (int j = 0; j < 4; ++j) r1[j] = __builtin_nontemporal_load(xr + 256 + 64 * j); }
#pragma unroll
        for (int i = 0; i < 8; ++i) {
            const int row = row0 + i;
            if (i + 2 < 8) { const f32x4* xr = (const f32x4*)(x + (size_t)(row + 2) * D) + F.lane;
#pragma unroll
                for (int j = 0; j < 4; ++j) r2[j] = __builtin_nontemporal_load(xr + 64 * j); }
            float ss = 0.f;
#pragma unroll
            for (int j = 0; j < 4; ++j) ss += (r0[j].x * r0[j].x + r0[j].y * r0[j].y) + (r0[j].z * r0[j].z + r0[j].w * r0[j].w);
            ss = wave_sum(ss);
            const float rstd = 1.0f / sqrtf(ss * (1.0f / D) + EPS);
            float fl[8];
#pragma unroll
            for (int jj = 0; jj < 8; ++jj) fl[jj] = 0.f;
#pragma unroll
            for (int j = 0; j < 4; ++j) { const int col = 4 * F.lane + 256 * j;
                const f32x4 hv = (r0[j] * rstd) * ga[j] + sh[j];
                u32x2 w; w.x = cvtpk(hv.x, hv.y); w.y = cvtpk(hv.z, hv.w);
                *(u32x2*)(H + (size_t)row * D + col) = w;
#pragma unroll
                for (int jj = 0; jj < 8; ++jj) { const f32x4 wv = *(const LAS f32x4*)(wfl + jj * 1024 + col); fl[jj] += (hv.x * wv.x + hv.y * wv.y) + (hv.z * wv.z + hv.w * wv.w); }
            }
            const int lane = F.lane; const float r1s = reduce8_t(fl, lane);
            if ((lane & 7) == 0) { const int jj = lane >> 3; const float z = r1s + b_forget[jj]; const float ls = fminf(z, 0.f) - log1pf(__expf(-fabsf(z))); LOGF[(size_t)row * 8 + jj] = ls; }
#pragma unroll
            for (int j = 0; j < 4; ++j) { r0[j] = r1[j]; r1[j] = r2[j]; }
        }
    }
}

constexpr int KP = 72;
constexpr int VPF = 68;
constexpr int VPS = 260;
struct FlashState { f32x16 o[2]; float m, l; };

__device__ __forceinline__ void flash_tail(FlashState& st, f32x16& s0, f32x16& s1, const LAS bf16* Vs, int vp, int r32, int hi) {
    float mt = s0[0];
#pragma unroll
    for (int r = 1; r < 16; ++r) mt = fmaxf(mt, s0[r]);
#pragma unroll
    for (int r = 0; r < 16; ++r) mt = fmaxf(mt, s1[r]);
    mt = fmaxf(mt, __uint_as_float(xorx<32>(__float_as_uint(mt), 32 * hi)));
    const float mn = fmaxf(st.m, mt);
    const float alpha = __expf(st.m - mn);
    st.m = mn;
    float ps = 0.f;
#pragma unroll
    for (int r = 0; r < 16; ++r) { s0[r] = __expf(s0[r] - mn); ps += s0[r]; }
#pragma unroll
    for (int r = 0; r < 16; ++r) { s1[r] = __expf(s1[r] - mn); ps += s1[r]; }
    st.l = st.l * alpha + ps;
    if (__any(alpha != 1.0f)) {
#pragma unroll
        for (int r = 0; r < 16; ++r) { st.o[0][r] *= alpha; st.o[1][r] *= alpha; }
    }
#pragma unroll
    for (int blk = 0; blk < 2; ++blk)
#pragma unroll
        for (int s = 0; s < 2; ++s) {
            v4u pw;
            if (blk == 0) { pw.x = cvtpk(s0[8 * s + 0], s0[8 * s + 1]); pw.y = cvtpk(s0[8 * s + 2], s0[8 * s + 3]); pw.z = cvtpk(s0[8 * s + 4], s0[8 * s + 5]); pw.w = cvtpk(s0[8 * s + 6], s0[8 * s + 7]); }
            else          { pw.x = cvtpk(s1[8 * s + 0], s1[8 * s + 1]); pw.y = cvtpk(s1[8 * s + 2], s1[8 * s + 3]); pw.z = cvtpk(s1[8 * s + 4], s1[8 * s + 5]); pw.w = cvtpk(s1[8 * s + 6], s1[8 * s + 7]); }
            const bf16x8 pf = __builtin_bit_cast(bf16x8, pw);
#pragma unroll
            for (int db = 0; db < 2; ++db) {
                const LAS bf16* vp0 = Vs + (32 * db + r32) * vp + 32 * blk + 16 * s + 4 * hi;
                const s16x4 lo = *(const LAS s16x4*)vp0, hh = *(const LAS s16x4*)(vp0 + 8);
                const bf16x8 vf = __builtin_shufflevector(lo, hh, 0, 1, 2, 3, 4, 5, 6, 7);
                st.o[db] = MFMA32(vf, pf, st.o[db]);
            }
        }
}
__device__ __forceinline__ void flash_qk(f32x16& s0, f32x16& s1, const bf16x8 (&qf)[4], const LAS bf16* Ks, int r32, int hi) {
    s0 = (f32x16){0.f}; s1 = (f32x16){0.f};
#pragma unroll
    for (int r = 0; r < 16; ++r) { s0[r] = 0.f; s1[r] = 0.f; }
#pragma unroll
    for (int ks = 0; ks < 4; ++ks) {
        const bf16x8 a0 = *(const LAS bf16x8*)(Ks + r32 * KP + 16 * ks + 8 * hi);
        const bf16x8 a1 = *(const LAS bf16x8*)(Ks + (32 + r32) * KP + 16 * ks + 8 * hi);
        s0 = MFMA32(a0, qf[ks], s0); s1 = MFMA32(a1, qf[ks], s1);
    }
}
__device__ __forceinline__ void flash_qk2(f32x16& a0, f32x16& a1, f32x16& b0, f32x16& b1, const bf16x8 (&qa)[4], const bf16x8 (&qb)[4], const LAS bf16* Ks, int r32, int hi) {
#pragma unroll
    for (int r = 0; r < 16; ++r) { a0[r] = 0.f; a1[r] = 0.f; b0[r] = 0.f; b1[r] = 0.f; }
#pragma unroll
    for (int ks = 0; ks < 4; ++ks) {
        const bf16x8 k0 = *(const LAS bf16x8*)(Ks + r32 * KP + 16 * ks + 8 * hi);
        const bf16x8 k1 = *(const LAS bf16x8*)(Ks + (32 + r32) * KP + 16 * ks + 8 * hi);
        a0 = MFMA32(k0, qa[ks], a0); b0 = MFMA32(k0, qb[ks], b0); a1 = MFMA32(k1, qa[ks], a1); b1 = MFMA32(k1, qb[ks], b1);
    }
}
__device__ __forceinline__ void flash_soft(FlashState& st, f32x16& s0, f32x16& s1, int hi) {
    float mt = s0[0];
#pragma unroll
    for (int r = 1; r < 16; ++r) mt = fmaxf(mt, s0[r]);
#pragma unroll
    for (int r = 0; r < 16; ++r) mt = fmaxf(mt, s1[r]);
    mt = fmaxf(mt, __uint_as_float(xorx<32>(__float_as_uint(mt), 32 * hi)));
    const float mn = fmaxf(st.m, mt);
    const float alpha = __expf(st.m - mn);
    st.m = mn;
    float ps = 0.f;
#pragma unroll
    for (int r = 0; r < 16; ++r) { s0[r] = __expf(s0[r] - mn); ps += s0[r]; }
#pragma unroll
    for (int r = 0; r < 16; ++r) { s1[r] = __expf(s1[r] - mn); ps += s1[r]; }
    st.l = st.l * alpha + ps;
    if (__any(alpha != 1.0f)) {
#pragma unroll
        for (int r = 0; r < 16; ++r) { st.o[0][r] *= alpha; st.o[1][r] *= alpha; }
    }
}
__device__ __forceinline__ bf16x8 pack_p(const f32x16& p, int s) {
    v4u pw; pw.x = cvtpk(p[8 * s + 0], p[8 * s + 1]); pw.y = cvtpk(p[8 * s + 2], p[8 * s + 3]); pw.z = cvtpk(p[8 * s + 4], p[8 * s + 5]); pw.w = cvtpk(p[8 * s + 6], p[8 * s + 7]);
    return __builtin_bit_cast(bf16x8, pw);
}
__device__ __forceinline__ void flash_pv2(FlashState& sa, FlashState& sb, const f32x16& a0, const f32x16& a1, const f32x16& b0, const f32x16& b1, const LAS bf16* Vs, int vp, int r32, int hi) {
#pragma unroll
    for (int blk = 0; blk < 2; ++blk)
#pragma unroll
        for (int s = 0; s < 2; ++s) {
            const bf16x8 pfa = blk ? pack_p(a1, s) : pack_p(a0, s), pfb = blk ? pack_p(b1, s) : pack_p(b0, s);
#pragma unroll
            for (int db = 0; db < 2; ++db) {
                const LAS bf16* vp0 = Vs + (32 * db + r32) * vp + 32 * blk + 16 * s + 4 * hi;
                const s16x4 lo = *(const LAS s16x4*)vp0, hh = *(const LAS s16x4*)(vp0 + 8);
                const bf16x8 vf = __builtin_shufflevector(lo, hh, 0, 1, 2, 3, 4, 5, 6, 7);
                sa.o[db] = MFMA32(vf, pfa, sa.o[db]); sb.o[db] = MFMA32(vf, pfb, sb.o[db]);
            }
        }
}
__device__ __forceinline__ void flash_store(const FlashState& st, bf16* orow, int hi) {
    float lt = st.l + __uint_as_float(xorx<32>(__float_as_uint(st.l), 32 * hi));
    const float inv = 1.0f / lt;
#pragma unroll
    for (int db = 0; db < 2; ++db)
#pragma unroll
        for (int rg = 0; rg < 4; ++rg) { u32x2 w; w.x = cvtpk(st.o[db][4 * rg] * inv, st.o[db][4 * rg + 1] * inv); w.y = cvtpk(st.o[db][4 * rg + 2] * inv, st.o[db][4 * rg + 3] * inv);
            *(u32x2*)(orow + 32 * db + 8 * rg + 4 * hi) = w; }
}

__device__ __forceinline__ void fox_unit(Frame& F, int b, int h, int qb, float& kmax2) {
    const bf16* proj = (const bf16*)(((unsigned char*)karg(19)) + WS_PROJ); const float* LOGF = (const float*)(((unsigned char*)karg(19)) + WS_LOGF); bf16* OB = (bf16*)(((unsigned char*)karg(19)) + WS_OB);
    LAS float* Fs = (LAS float*)(F.lds);
    LAS float* wtot = (LAS float*)(F.lds + 16384);
    LAS bf16* Kb = (LAS bf16*)(F.lds + 16384 + 128);
    LAS bf16* Vb = (LAS bf16*)(F.lds + 16384 + 128 + 2 * 64 * KP * 2);
    const int lane = F.lane, wave = F.wave, tid = F.tid, r32 = lane & 31, hi = lane >> 5;
    const int q_end = 512 * (qb + 1), NT = q_end / 64;
    const size_t rowbase = (size_t)b * SEQ;
    if (kmax2 < 0.f) {
        float v[8]; float run = 0.f;
#pragma unroll
        for (int i = 0; i < 8; ++i) { const int pos = tid * 8 + i; const float lf = (pos < q_end) ? LOGF[(rowbase + pos) * 8 + h] : 0.f; run += lf; v[i] = run; }
        float inc = run;
#pragma unroll
        for (int o = 1; o < 64; o <<= 1) { const float t = __shfl_up(inc, o); if (lane >= o) inc += t; }
        if (lane == 63) wtot[wave] = inc;
        __syncthreads();
        float off = inc - run;
        for (int w = 0; w < wave; ++w) off += wtot[w];
#pragma unroll
        for (int i = 0; i < 8; ++i) Fs[tid * 8 + i] = v[i] + off;
    }
    const int qrow = 512 * qb + 64 * wave + r32, qrowB = qrow + 32;
    bf16x8 qf[4], qg[4];
    { const bf16* qp = proj + (rowbase + qrow) * NPROJ + C_QB + 64 * h + 8 * hi;
#pragma unroll
      for (int ks = 0; ks < 4; ++ks) { qf[ks] = *(const bf16x8*)(qp + 16 * ks); qg[ks] = *(const bf16x8*)(qp + (size_t)32 * NPROJ + 16 * ks); } }
    const int tq = 8 * qb + wave;
    LAS bf16* Qs = (LAS bf16*)(F.lds + 53248) + wave * (64 * KP);
    {
        float qn = 0.f;
#pragma unroll
        for (int ks = 0; ks < 4; ++ks)
#pragma unroll
            for (int j = 0; j < 8; ++j) { const float e = __uint_as_float(((unsigned)(unsigned short)qf[ks][j]) << 16); qn += e * e; }
        qn += __shfl_xor(qn, 32);
        { float qn2 = 0.f;
#pragma unroll
          for (int ks = 0; ks < 4; ++ks)
#pragma unroll
              for (int j = 0; j < 8; ++j) { const float e = __uint_as_float(((unsigned)(unsigned short)qg[ks][j]) << 16); qn2 += e * e; }
          qn2 += __shfl_xor(qn2, 32); qn = fmaxf(qn, qn2); }
#pragma unroll
        for (int o = 1; o < 32; o <<= 1) qn = fmaxf(qn, __shfl_xor(qn, o));
        float kn = 0.f;
        if (kmax2 < 0.f) {
            for (int p0 = 0; p0 < q_end; p0 += 4 * 64) {
                v4u w4[4];
#pragma unroll
                for (int i = 0; i < 4; ++i) w4[i] = *(const v4u*)(proj + (rowbase + p0 + 64 * i + (tid >> 3)) * NPROJ + C_KB + 64 * h + 8 * (tid & 7));
#pragma unroll
                for (int i = 0; i < 4; ++i) { const unsigned wx = w4[i].x, wy = w4[i].y, wz = w4[i].z, ww = w4[i].w;
                    float s = bflo(wx) * bflo(wx) + bfhi(wx) * bfhi(wx) + bflo(wy) * bflo(wy) + bfhi(wy) * bfhi(wy) + bflo(wz) * bflo(wz) + bfhi(wz) * bfhi(wz) + bflo(ww) * bflo(ww) + bfhi(ww) * bfhi(ww);
                    s += __shfl_xor(s, 1); s += __shfl_xor(s, 2); s += __shfl_xor(s, 4);
                    kn = fmaxf(kn, s); } }
            kn = wave_max(kn);
        }
        if (lane == 0) { wtot[8 + wave] = qn; wtot[16 + wave] = kn; }
    }
#pragma unroll
    for (int ks = 0; ks < 4; ++ks) { *(LAS bf16x8*)(Qs + r32 * KP + 16 * ks + 8 * hi) = qf[ks]; *(LAS bf16x8*)(Qs + (32 + r32) * KP + 16 * ks + 8 * hi) = qg[ks]; }
    FlashState st, su; st.m = -INFINITY; st.l = 0.f; su.m = -INFINITY; su.l = 0.f;
#pragma unroll
    for (int r = 0; r < 16; ++r) { st.o[0][r] = 0.f; st.o[1][r] = 0.f; su.o[0][r] = 0.f; su.o[1][r] = 0.f; }
    const int srow = tid >> 3, sch = tid & 7;
    const bf16* kg = proj + (rowbase + srow) * NPROJ + C_KB + 64 * h + 8 * sch;
    const bf16* vg = proj + (rowbase + srow) * NPROJ + C_VB + 64 * h + 8 * sch;
    v4u kreg, vreg;
    { const size_t o = (size_t)(NT - 1) * 64 * NPROJ; kreg = *(const v4u*)(kg + o); vreg = *(const v4u*)(vg + o); }
    int cur = 0;
    {   *(LAS v4u*)(Kb + srow * KP + 8 * sch) = kreg;
        const unsigned short* vs = (const unsigned short*)&vreg;
#pragma unroll
        for (int i = 0; i < 8; ++i) Vb[(8 * sch + i) * VPF + srow] = vs[i];
    }
    __syncthreads();
    const float fq = Fs[qrow], fqB = Fs[qrowB];
    int t_lo = 0;
    {
        float qm = 0.f, km = 0.f;
#pragma unroll
        for (int w = 0; w < 8; ++w) { qm = fmaxf(qm, wtot[8 + w]); km = fmaxf(km, wtot[16 + w]); }
        if (kmax2 < 0.f) kmax2 = km;
        const float A = 0.125f * sqrtf(qm) * sqrtf(kmax2) * 1.01f, f0 = Fs[512 * qb];
        for (int t = NT - 9; t >= 0; --t) if (Fs[64 * t + 63] - f0 > 2.0f * A + 60.0f) { t_lo = t + 1; break; }
    }
    for (int t = NT - 1; t >= t_lo; --t) {
        if (t > t_lo) { const size_t o = (size_t)(t - 1) * 64 * NPROJ; kreg = *(const v4u*)(kg + o); vreg = *(const v4u*)(vg + o); }
        if (t <= tq) {
            const LAS bf16* Ks = Kb + cur * 64 * KP; const LAS bf16* Vs = Vb + cur * 64 * VPF;
            bf16x8 qa[4], qb4[4];
#pragma unroll
            for (int ks = 0; ks < 4; ++ks) { qa[ks] = *(const LAS bf16x8*)(Qs + r32 * KP + 16 * ks + 8 * hi); qb4[ks] = *(const LAS bf16x8*)(Qs + (32 + r32) * KP + 16 * ks + 8 * hi); }
            f32x16 s0, s1, u0, u1; flash_qk2(s0, s1, u0, u1, qa, qb4, Ks, r32, hi);
            const LAS float* Fk = Fs + 64 * t;
            const bool diag = (t == tq);
#pragma unroll
            for (int rg = 0; rg < 4; ++rg) {
                const f32x4 f0 = *(const LAS f32x4*)(Fk + 8 * rg + 4 * hi), f1 = *(const LAS f32x4*)(Fk + 32 + 8 * rg + 4 * hi);
#pragma unroll
                for (int i = 0; i < 4; ++i) { const int r = 4 * rg + i; const int kv = 64 * t + 8 * rg + 4 * hi + i;
                    float a = s0[r] * 0.125f + (fq - f0[i]), c = s1[r] * 0.125f + (fq - f1[i]), d = u0[r] * 0.125f + (fqB - f0[i]), e = u1[r] * 0.125f + (fqB - f1[i]);
                    if (diag) { if (kv > qrow) a = -INFINITY; if (kv + 32 > qrow) c = -INFINITY; if (kv > qrowB) d = -INFINITY; if (kv + 32 > qrowB) e = -INFINITY; }
                    s0[r] = a; s1[r] = c; u0[r] = d; u1[r] = e; }
            }
            flash_soft(st, s0, s1, hi); flash_soft(su, u0, u1, hi);
            flash_pv2(st, su, s0, s1, u0, u1, Vs, VPF, r32, hi);
        }
        if (t > t_lo) {
            const int nb = cur ^ 1;
            *(LAS v4u*)(Kb + nb * 64 * KP + srow * KP + 8 * sch) = kreg;
            const unsigned short* vs = (const unsigned short*)&vreg;
#pragma unroll
            for (int i = 0; i < 8; ++i) Vb[nb * 64 * VPF + (8 * sch + i) * VPF + srow] = vs[i];
        }
        __syncthreads();
        cur ^= 1;
    }
    flash_store(st, OB + (rowbase + qrow) * 512 + 64 * h, hi); flash_store(su, OB + (rowbase + qrowB) * 512 + 64 * h, hi);
    __syncthreads();
}

__device__ const unsigned char T5_BUCKET[128] = {0,1,2,3,4,5,6,7,8,9,10,11,12,13,14,15,16,16,16,17,17,18,18,18,19,19,19,20,20,20,20,21,21,21,21,22,22,22,22,22,23,23,23,23,23,23,24,24,24,24,24,24,25,25,25,25,25,25,25,26,26,26,26,26,26,26,26,27,27,27,27,27,27,27,27,27,27,28,28,28,28,28,28,28,28,28,28,29,29,29,29,29,29,29,29,29,29,29,29,30,30,30,30,30,30,30,30,30,30,30,30,30,30,31,31,31,31,31,31,31,31,31,31,31,31,31,31,31};

__device__ __forceinline__ void swa_unit(Frame& F, int b, int kvh, int n) {
    const bf16* proj = (const bf16*)(((unsigned char*)karg(19)) + WS_PROJ); bf16* OA = (bf16*)(((unsigned char*)karg(19)) + WS_OA);
    const float* sinks = ((const float*)karg(8)); const float* rel_bias = ((const float*)karg(12));
    LAS bf16* Kb = (LAS bf16*)(F.lds);
    LAS bf16* Vb = (LAS bf16*)(F.lds + 36864);
    LAS float* bt = (LAS float*)(F.lds + 36864 + 33280);
    const int lane = F.lane, wave = F.wave, tid = F.tid, r32 = lane & 31, hi = lane >> 5;
    const size_t rowbase = (size_t)b * SEQ;
    {
        const int g = tid >> 7, d = tid & 127;
        bt[tid] = rel_bias[(int)T5_BUCKET[d] * 8 + kvh * 4 + g];
#pragma unroll
        for (int i = 0; i < 4; ++i) {
            const int idx = tid + i * NTHR, kb = idx >> 3, sch = idx & 7; const int pos = 128 * (n - 1) + kb;
            v4u kreg = (v4u){0u, 0u, 0u, 0u}, vreg = (v4u){0u, 0u, 0u, 0u};
            if (pos >= 0) { const bf16* p = proj + (rowbase + pos) * NPROJ + 64 * kvh + 8 * sch; kreg = *(const v4u*)(p + C_KA); vreg = *(const v4u*)(p + C_VA); }
            *(LAS v4u*)(Kb + kb * KP + 8 * sch) = kreg;
            const unsigned short* vs = (const unsigned short*)&vreg;
#pragma unroll
            for (int j = 0; j < 8; ++j) Vb[(8 * sch + j) * VPS + kb] = vs[j];
        }
    }
    __syncthreads();
    const int g = wave & 3, qh = wave >> 2, head = kvh * 4 + g;
    const LAS float* btg = bt + g * 128;
    for (int sb = 0; sb < 2; ++sb) {
        const int qrel0 = 64 * qh + 32 * sb, qrel = qrel0 + r32;
        const size_t row = rowbase + 128 * n + qrel;
        bf16x8 qf[4];
        { const bf16* qp = proj + row * NPROJ + C_QA + 64 * head + 8 * hi;
#pragma unroll
          for (int ks = 0; ks < 4; ++ks) qf[ks] = *(const bf16x8*)(qp + 16 * ks); }
        FlashState st; st.m = sinks[head]; st.l = (hi == 0) ? 1.0f : 0.0f;
#pragma unroll
        for (int r = 0; r < 16; ++r) { st.o[0][r] = 0.f; st.o[1][r] = 0.f; }
        const int t_lo = (qrel0 + 1) >> 6, t_hi = (qrel0 + 159) >> 6;
        for (int t = t_lo; t <= t_hi; ++t) {
            f32x16 s0, s1; flash_qk(s0, s1, qf, Kb + t * 64 * KP, r32, hi);
#pragma unroll
            for (int r = 0; r < 16; ++r) {
                const int kb0 = 64 * t + crow(r, hi), kb1 = kb0 + 32;
                const int d0 = 128 + qrel - kb0, d1 = d0 - 32;
                const bool v0 = (d0 >= 0) && (d0 < 128) && (n > 0 || kb0 >= 128);
                const bool v1 = (d1 >= 0) && (d1 < 128) && (n > 0 || kb1 >= 128);
                const float b0 = btg[d0 & 127], b1 = btg[d1 & 127];
                s0[r] = v0 ? (s0[r] * 0.125f + b0) : -INFINITY;
                s1[r] = v1 ? (s1[r] * 0.125f + b1) : -INFINITY;
            }
            flash_tail(st, s0, s1, Vb + 64 * t, VPS, r32, hi);
        }
        flash_store(st, OA + row * 512 + 64 * head, hi);
    }
    __syncthreads();
}
__device__ __forceinline__ void p3_attention(Frame& F) {
    for (int item = F.vcu; item < 256; item += F.G) {
        swa_unit(F, item >> 6, (item >> 5) & 1, item & 31);
        const int bh = item >> 3, j = item & 7;
        float kmax2 = -1.0f;
        fox_unit(F, bh >> 3, bh & 7, j, kmax2);
    }
}

struct PairOrder {
    pg8::StaticOrder S;
    __device__ bool next(int i, pg8::Unit& u) const { if (!S.next(i >> 1, u)) return false; u.src = i & 1; return true; }
    __device__ __forceinline__ void a_ready(const pg8::Unit&) const {}
    __device__ __forceinline__ void done(const pg8::Unit&) const {}
};
__device__ __forceinline__ float sigmoidf_(float z) { return 1.0f / (1.0f + __expf(-z)); }
struct EpiGate {
    static constexpr bool PERM = true, AFTER_DRAIN = false, CHAIN = true;
    const bf16* proj; bf16* mixed;
    __device__ __forceinline__ void operator()(pg8::f32x4 (&acc)[2][2][4][2], const pg8::Unit& u, int wr, int wc, int fr, int fq) const {
#pragma unroll
        for (int ai = 0; ai < 2; ++ai) {
            v4u gbv[4][2], gav[4][2];
#pragma unroll
            for (int m = 0; m < 4; ++m) { const size_t row = (size_t)u.pm * 256 + ai * 128 + wr * 64 + m * 16 + fr;
#pragma unroll
                for (int bj = 0; bj < 2; ++bj) { const int col0 = u.pn * 256 + bj * 128 + wc * 32 + 8 * fq;
                    gbv[m][bj] = *(const v4u*)(proj + row * NPROJ + C_GLB + col0);
                    if (u.src == 0) gav[m][bj] = __builtin_nontemporal_load((const v4u*)(proj + row * NPROJ + C_GLA + col0)); } }
#pragma unroll
            for (int m = 0; m < 4; ++m) { const size_t row = (size_t)u.pm * 256 + ai * 128 + wr * 64 + m * 16 + fr;
#pragma unroll
                for (int bj = 0; bj < 2; ++bj) { const int col0 = u.pn * 256 + bj * 128 + wc * 32 + 8 * fq;
                    const unsigned gbw[4] = {gbv[m][bj].x, gbv[m][bj].y, gbv[m][bj].z, gbv[m][bj].w};
                    if (u.src == 0) {
                        const unsigned gaw[4] = {gav[m][bj].x, gav[m][bj].y, gav[m][bj].z, gav[m][bj].w};
#pragma unroll
                        for (int e = 0; e < 8; ++e) { const float za = (e & 1) ? bfhi(gaw[e >> 1]) : bflo(gaw[e >> 1]), zb = (e & 1) ? bfhi(gbw[e >> 1]) : bflo(gbw[e >> 1]);
                            const float ratio = (1.0f + __expf(-zb)) * __builtin_amdgcn_rcpf(1.0f + __expf(-za));
                            acc[ai][bj][m][e >> 2][e & 3] *= ratio; }
                    } else {
                        float v[8];
#pragma unroll
                        for (int e = 0; e < 8; ++e) { const float zb = (e & 1) ? bfhi(gbw[e >> 1]) : bflo(gbw[e >> 1]); v[e] = acc[ai][bj][m][e >> 2][e & 3] * __builtin_amdgcn_rcpf(1.0f + __expf(-zb)); }
                        v4u w; w.x = cvtpk(v[0], v[1]); w.y = cvtpk(v[2], v[3]); w.z = cvtpk(v[4], v[5]); w.w = cvtpk(v[6], v[7]);
                        *(v4u*)(mixed + row * D + col0) = w;
                    }
                }
            }
        }
    }
};
struct EpiRes {
    static constexpr bool PERM = true, AFTER_DRAIN = false, CHAIN = false;
    const float* x; const float* mod; float* x1;
    __device__ __forceinline__ void operator()(const pg8::f32x4 (&acc)[2][2][4][2], const pg8::Unit& u, int wr, int wc, int fr, int fq) const {
        const int b = (u.pm * 256) >> 12;
        pg8::f32x4 gt[2][2];
#pragma unroll
        for (int bj = 0; bj < 2; ++bj)
#pragma unroll
            for (int n = 0; n < 2; ++n) gt[bj][n] = *(const pg8::f32x4*)(mod + b * NMOD + 2048 + u.pn * 256 + bj * 128 + wc * 32 + 8 * fq + 4 * n);
#pragma unroll
        for (int ai = 0; ai < 2; ++ai) {
            pg8::f32x4 xin[4][2][2];
#pragma unroll
            for (int m = 0; m < 4; ++m) { const size_t row = (size_t)u.pm * 256 + ai * 128 + wr * 64 + m * 16 + fr;
#pragma unroll
                for (int bj = 0; bj < 2; ++bj)
#pragma unroll
                    for (int n = 0; n < 2; ++n) xin[m][bj][n] = __builtin_nontemporal_load((const pg8::f32x4*)(x + row * D + u.pn * 256 + bj * 128 + wc * 32 + 8 * fq + 4 * n)); }
#pragma unroll
            for (int m = 0; m < 4; ++m) { const size_t row = (size_t)u.pm * 256 + ai * 128 + wr * 64 + m * 16 + fr;
#pragma unroll
                for (int bj = 0; bj < 2; ++bj)
#pragma unroll
                    for (int n = 0; n < 2; ++n) *(pg8::f32x4*)(x1 + row * D + u.pn * 256 + bj * 128 + wc * 32 + 8 * fq + 4 * n) = xin[m][bj][n] + gt[bj][n] * acc[ai][bj][m][n]; }
        }
    }
};

__device__ __forceinline__ void p6_norm2(Frame& F) {
    const float* x1 = (const float*)(((unsigned char*)karg(19)) + WS_X1); const float* g2 = ((const float*)karg(3)); const float* MOD = (const float*)(((unsigned char*)karg(19)) + WS_MOD); bf16* H2 = (bf16*)(((unsigned char*)karg(19)) + WS_H2); unsigned char* H2Q = (unsigned char*)(((unsigned char*)karg(19)) + WS_H2Q); float* H2S = (float*)(((unsigned char*)karg(19)) + WS_H2S);
    const int gw = F.vcu * NWAVES + F.wave, NGW = F.G * NWAVES;
    for (int c = gw; c < M / 8; c += NGW) {
        const int row0 = c * 8; const float* mb = MOD + (row0 >> 12) * NMOD;
        f32x4 ga[4], sh[4];
#pragma unroll
        for (int j = 0; j < 4; ++j) { const int col = 4 * F.lane + 256 * j; const f32x4 g = *(const f32x4*)(g2 + col), sc = *(const f32x4*)(mb + 4096 + col); sh[j] = *(const f32x4*)(mb + 3072 + col); ga[j] = g * (sc + 1.0f); }
        f32x4 r0[4], r1[4], r2[4];
        { const f32x4* xr = (const f32x4*)(x1 + (size_t)row0 * D) + F.lane;
#pragma unroll
          for (int j = 0; j < 4; ++j) r0[j] = xr[64 * j];
#pragma unroll
          for (int j = 0; j < 4; ++j) r1[j] = xr[256 + 64 * j]; }
#pragma unroll
        for (int i = 0; i < 8; ++i) {
            const int row = row0 + i;
            if (i + 2 < 8) { const f32x4* xr = (const f32x4*)(x1 + (size_t)(row + 2) * D) + F.lane;
#pragma unroll
                for (int j = 0; j < 4; ++j) r2[j] = xr[64 * j]; }
            f32x4 hq[4]; float ss = 0.f;
#pragma unroll
            for (int j = 0; j < 4; ++j) ss += (r0[j].x * r0[j].x + r0[j].y * r0[j].y) + (r0[j].z * r0[j].z + r0[j].w * r0[j].w);
            ss = wave_sum(ss);
            const float rstd = 1.0f / sqrtf(ss * (1.0f / D) + EPS);
#pragma unroll
            for (int j = 0; j < 4; ++j) { const int col = 4 * F.lane + 256 * j;
                const f32x4 hv = (r0[j] * rstd) * ga[j] + sh[j];
                u32x2 w; w.x = cvtpk(hv.x, hv.y); w.y = cvtpk(hv.z, hv.w);
                *(u32x2*)(H2 + (size_t)row * D + col) = w; hq[j] = hv; }
            float am = 0.f;
#pragma unroll
            for (int j = 0; j < 4; ++j) am = fmaxf(fmaxf(am, fmaxf(fabsf(hq[j].x), fabsf(hq[j].y))), fmaxf(fabsf(hq[j].z), fabsf(hq[j].w)));
            am = wave_max(am);
            const float sc = am > 0.f ? am * (1.0f / 127.0f) : 1.0f, inv = 1.0f / sc;
            v4u qa;
#pragma unroll
            for (int j = 0; j < 4; ++j) { const int b0 = (int)rintf(hq[j].x * inv), b1 = (int)rintf(hq[j].y * inv), b2 = (int)rintf(hq[j].z * inv), b3 = (int)rintf(hq[j].w * inv);
                qa[j] = (unsigned)(b0 & 255) | ((unsigned)(b1 & 255) << 8) | ((unsigned)(b2 & 255) << 16) | ((unsigned)(b3 & 255) << 24); }
            __builtin_nontemporal_store(qa, (v4u*)(H2Q + (size_t)row * D + 16 * F.lane));
            if (F.lane == 0) H2S[row] = sc;
#pragma unroll
            for (int j = 0; j < 4; ++j) { r0[j] = r1[j]; r1[j] = r2[j]; }
        }
    }
}

__device__ __forceinline__ unsigned f2ord(float f) { const unsigned u = __float_as_uint(f); return u ^ ((unsigned)((int)u >> 31) | 0x80000000u); }
__device__ __forceinline__ float ord2f(unsigned o) { const unsigned u = (o & 0x80000000u) ? (o & 0x7fffffffu) : ~o; return __uint_as_float(u); }
#define CE_DESC(a, b) do { const unsigned _x = (a), _y = (b); (a) = _x > _y ? _x : _y; (b) = _x > _y ? _y : _x; } while (0)
__device__ __forceinline__ void sort16(unsigned (&k)[16]) {
#pragma unroll
    for (int size = 2; size <= 16; size <<= 1)
#pragma unroll
        for (int stride = size >> 1; stride > 0; stride >>= 1)
#pragma unroll
            for (int i = 0; i < 16; ++i) { const int j = i ^ stride; if (j > i) { if ((i & size) == 0) CE_DESC(k[i], k[j]); else CE_DESC(k[j], k[i]); } }
}
__device__ __forceinline__ void merge16(unsigned (&a)[16], const unsigned (&b)[16]) {
#pragma unroll
    for (int i = 0; i < 16; ++i) a[i] = a[i] > b[15 - i] ? a[i] : b[15 - i];
#pragma unroll
    for (int stride = 8; stride > 0; stride >>= 1)
#pragma unroll
        for (int i = 0; i < 16; ++i) { const int j = i ^ stride; if (j > i) CE_DESC(a[i], a[j]); }
}
__device__ __forceinline__ void top16_of_64(unsigned (&g0)[16], unsigned (&g1)[16], unsigned (&g2)[16], unsigned (&g3)[16]) {
    sort16(g0); sort16(g1); sort16(g2); sort16(g3);
    merge16(g0, g1); merge16(g2, g3); merge16(g0, g2);
}
constexpr int NCAND = 50;
__device__ __forceinline__ void p8a_topk(Frame& F) {
    const bf16* QP = (const bf16*)(((unsigned char*)karg(19)) + WS_QP); const bf16* SUBK = (const bf16*)(((unsigned char*)karg(19)) + WS_SUBK);
    unsigned short* PIDX = (unsigned short*)(((unsigned char*)karg(19)) + WS_PIDX); float* PG = (float*)(((unsigned char*)karg(19)) + WS_PG);
    LAS unsigned short* Elds = (LAS unsigned short*)(F.lds) + F.wave * (NCAND * 64);
    const int lane = F.lane, r32 = lane & 31, hi = lane >> 5;
    const int gw = F.vcu * NWAVES + F.wave, NGW = F.G * NWAVES;
    for (int it2 = 0; it2 < 2 * ((M / 64 - F.vcu + F.G - 1) / F.G); ++it2) {
        const int wi = F.vcu + (it2 >> 1) * F.G;
        const int tile = 2 * wi + (it2 & 1);
        const int tok = tile * 32 + r32;
        { const int h = F.wave;
            unsigned top[2][16];
#pragma unroll
            for (int p = 0; p < 2; ++p) {
                bf16x8 qf[4];
                { const bf16* qp = QP + (size_t)tok * D + h * 128 + p * 64 + 8 * hi;
#pragma unroll
                  for (int ks = 0; ks < 4; ++ks) qf[ks] = *(const bf16x8*)(qp + 16 * ks); }
                const bf16* kp = SUBK + (size_t)((h * 2 + p) * 128 + r32) * 64 + 8 * hi;
                unsigned kk[4][16];
#pragma unroll
                for (int blk = 0; blk < 4; ++blk) {
                    f32x16 acc;
#pragma unroll
                    for (int r = 0; r < 16; ++r) acc[r] = 0.f;
#pragma unroll
                    for (int ks = 0; ks < 4; ++ks) { const bf16x8 a = *(const bf16x8*)(kp + (size_t)blk * 32 * 64 + 16 * ks); acc = MFMA32(a, qf[ks], acc); }
#pragma unroll
                    for (int r = 0; r < 16; ++r) { const int key = 32 * blk + crow(r, hi); kk[blk][r] = (f2ord(acc[r]) & ~127u) | (unsigned)(127 - key); }
                }
                top16_of_64(kk[0], kk[1], kk[2], kk[3]);
                unsigned other[16];
#pragma unroll
                for (int i = 0; i < 16; ++i) other[i] = xorx<32>(kk[0][i], lane);
                merge16(kk[0], other);
#pragma unroll
                for (int i = 0; i < 16; ++i) top[p][i] = kk[0][i];
            }
            float s1[16], s2[16]; unsigned i1[16], i2[16];
#pragma unroll
            for (int i = 0; i < 16; ++i) { s1[i] = ord2f(top[0][i] & ~127u); i1[i] = 127u - (top[0][i] & 127u); s2[i] = ord2f(top[1][i] & ~127u); i2[i] = 127u - (top[1][i] & 127u); }
            unsigned ck[4][16];
#pragma unroll
            for (int c = 0; c < 64; ++c) {
                if (c < NCAND) { constexpr int CA[NCAND] = {0,0,0,0,0,0,0,0,0,0,0,0,0,0,0,0,1,1,1,1,1,1,1,1,2,2,2,2,2,3,3,3,3,4,4,4,5,5,6,6,7,7,8,9,10,11,12,13,14,15}; constexpr int CB[NCAND] = {0,1,2,3,4,5,6,7,8,9,10,11,12,13,14,15,0,1,2,3,4,5,6,7,0,1,2,3,4,0,1,2,3,0,1,2,0,1,0,1,0,1,0,0,0,0,0,0,0,0}; const int a = CA[c], b = CB[c];
                    ck[c >> 4][c & 15] = (f2ord(s1[a] + s2[b]) & ~63u) | (unsigned)(63 - c);
                    Elds[c * 64 + lane] = (unsigned short)(i1[a] * 128u + i2[b]); }
                else ck[c >> 4][c & 15] = 0u;
            }
            top16_of_64(ck[0], ck[1], ck[2], ck[3]);
            float w[16]; float wsum = 0.f; const float v0 = ord2f(ck[0][0] & ~63u);
#pragma unroll
            for (int r = 0; r < 16; ++r) { w[r] = __expf(ord2f(ck[0][r] & ~63u) - v0); wsum += w[r]; }
            const float winv = 1.0f / wsum;
#pragma unroll
            for (int r = 0; r < 16; ++r) if ((r >> 3) == hi) {
                const int c = 63 - (int)(ck[0][r] & 63u);
                const unsigned short eid = Elds[c * 64 + lane];
                PIDX[(size_t)tok * 128 + h * 16 + r] = eid; PG[(size_t)tok * 128 + h * 16 + r] = w[r] * winv; }
        }
    }
}

__device__ __forceinline__ float gelu_erf(float v) { return 0.5f * v * (1.0f + erff(v * 0.70710678118654752f)); }

#define PROBE_REPA 1
#define PROBE_REPB 1
constexpr int NR = 8, RSH = 18, BSA = 8, BSB = 8, ELP = 136, TPS = 8;
__device__ __forceinline__ void sort128(unsigned& e0, unsigned& e1, int lane) {
#pragma unroll
    for (int size = 2; size <= 128; size <<= 1) {
#pragma unroll
        for (int stride = size >> 1; stride > 0; stride >>= 1) {
            if (stride == 64) { const unsigned lo = e0 < e1 ? e0 : e1, hi = e0 < e1 ? e1 : e0; e0 = lo; e1 = hi; }
            else {
                const bool lower = (lane & stride) == 0;
                const bool asc0 = (size == 128) ? true : (size == 64 ? true : ((lane & size) == 0));
                const bool asc1 = (size == 128) ? true : (size == 64 ? false : ((lane & size) == 0));
                const unsigned p0 = xorx_sw(e0, lane, stride), p1 = xorx_sw(e1, lane, stride);
                const unsigned mn0 = e0 < p0 ? e0 : p0, mx0 = e0 < p0 ? p0 : e0, mn1 = e1 < p1 ? e1 : p1, mx1 = e1 < p1 ? p1 : e1;
                e0 = (lower == asc0) ? mn0 : mx0; e1 = (lower == asc1) ? mn1 : mx1;
            }
        }
    }
}
template <int BS> __device__ __forceinline__ void sw_issue(v4u (&buf)[BS], const LAS unsigned* el, const unsigned char* tab, unsigned voff) {
#pragma unroll
    for (int i = 0; i < BS; ++i) { const unsigned off = (el[i] << 10) + voff;
        buf[i] = *(const v4u*)(tab + off); }
}
template <int BS> __device__ __forceinline__ void sw_proc_a(const v4u (&buf)[BS], const v4u& hq, LAS float* wl, int s, int n, int lane) {
    const int hx = (int)hq.x, hy = (int)hq.y, hz = (int)hq.z, hw = (int)hq.w;
    float dd[8];
#pragma unroll
    for (int i = 0; i < 8; ++i) dd[i] = 0.f;
#pragma unroll
    for (int i = 0; i < BS; ++i) if (i < n) { const int dx = (int)buf[i].x, dy = (int)buf[i].y, dz = (int)buf[i].z, dw = (int)buf[i].w;
        int t = __builtin_amdgcn_sdot4(hx, dx, 0, false); t = __builtin_amdgcn_sdot4(hy, dy, t, false); t = __builtin_amdgcn_sdot4(hz, dz, t, false); t = __builtin_amdgcn_sdot4(hw, dw, t, false);
        dd[i] = (float)t; }
    const float r1 = reduce8_t(dd, lane);
    if ((lane & 7) == 0 && (lane >> 3) < n) wl[s + (lane >> 3)] = r1;
}
template <int BS> __device__ __forceinline__ void sw_proc_b(const v4u (&buf)[BS], f32x2_t (&acc)[8], const LAS float* wl, int s, int n) {
    float wr[BS];
#pragma unroll
    for (int i = 0; i < BS; ++i) wr[i] = wl[s + i];
#pragma unroll
    for (int i = 0; i < BS; ++i) if (i < n) {
        const float w = wr[i];
        const f32x2_t wv = {w, w};
        const unsigned ux = buf[i].x, uy = buf[i].y, uz = buf[i].z, uw = buf[i].w;
        acc[0] += wv * __builtin_amdgcn_cvt_pk_f32_fp8((int)ux, false); acc[1] += wv * __builtin_amdgcn_cvt_pk_f32_fp8((int)ux, true);
        acc[2] += wv * __builtin_amdgcn_cvt_pk_f32_fp8((int)uy, false); acc[3] += wv * __builtin_amdgcn_cvt_pk_f32_fp8((int)uy, true);
        acc[4] += wv * __builtin_amdgcn_cvt_pk_f32_fp8((int)uz, false); acc[5] += wv * __builtin_amdgcn_cvt_pk_f32_fp8((int)uz, true);
        acc[6] += wv * __builtin_amdgcn_cvt_pk_f32_fp8((int)uw, false); acc[7] += wv * __builtin_amdgcn_cvt_pk_f32_fp8((int)uw, true); }
}
__device__ __forceinline__ void sw_warm(v4u (&pf)[4], const unsigned char* tab, int range, int lw, unsigned voff) {
#pragma unroll
    for (int i = 0; i < 4; ++i) { const unsigned off = ((unsigned)(range * 1024 + lw * 4 + i) << 10) + voff; pf[i] = *(const v4u*)(tab + off); }
}
__device__ __forceinline__ void sw_warm_done(const v4u (&pf)[4]) {
#pragma unroll
    for (int i = 0; i < 4; ++i) asm volatile("" :: "v"(pf[i]));
}
template <int FAKE> __device__ __forceinline__ void p8b_sweep(Frame& F) {
    const float* X1 = (const float*)(((unsigned char*)karg(19)) + WS_X1); const float* MOD = (const float*)(((unsigned char*)karg(19)) + WS_MOD);
    const unsigned char* H2Q = (const unsigned char*)(((unsigned char*)karg(19)) + WS_H2Q); const float* H2S = (const float*)(((unsigned char*)karg(19)) + WS_H2S);
    const unsigned char* EDq = (const unsigned char*)(((unsigned char*)karg(19)) + WS_ED); const unsigned char* EUq = (const unsigned char*)(((unsigned char*)karg(19)) + WS_EU); const float* EDS = (const float*)(((unsigned char*)karg(19)) + WS_EDS);
    const unsigned short* PIDX = (const unsigned short*)(((unsigned char*)karg(19)) + WS_PIDX); const float* PG = (const float*)(((unsigned char*)karg(19)) + WS_PG);
    const float* fg = ((const float*)karg(17));
    const int gw = F.vcu * NWAVES + F.wave, NGW = F.G * NWAVES;
    for (int wi = F.vcu; wi < M / 64; wi += F.G) {
        const int tb = wi * 8 + F.wave;
        unsigned ones = ~0u; asm volatile("" : "+s"(ones));
        int lane = (int)__builtin_amdgcn_mbcnt_hi(ones, __builtin_amdgcn_mbcnt_lo(ones, 0u)); asm volatile("" : "+v"(lane));
        const int tok0 = tb * 8;
        unsigned E0[8], E1[8];
        LAS float* Wl = (LAS float*)(F.lds) + F.wave * 1024;
        LAS unsigned* El = (LAS unsigned*)(F.lds + 32768) + F.wave * (8 * ELP);
        unsigned voff = 16u * (unsigned)lane; asm volatile("" : "+v"(voff));
        LAS int* Bnd = (LAS int*)(F.lds + 67584) + F.wave * (8 * (NR + 1));
#pragma unroll
        for (int k = 0; k < 8; ++k) {
            const size_t base = (size_t)(tok0 + k) * 128;
            E0[k] = ((unsigned)PIDX[base + lane] << 7) | (unsigned)lane; E1[k] = ((unsigned)PIDX[base + 64 + lane] << 7) | (unsigned)(64 + lane);
            sort128(E0[k], E1[k], lane);
            if (FAKE) { E0[k] = (E0[k] & 0x1ffffu) ; E1[k] = (E1[k] & 0x1ffffu); sort128(E0[k], E1[k], lane); }
            El[k * ELP + lane] = E0[k] >> 7; El[k * ELP + 64 + lane] = E1[k] >> 7;
            if (lane < 8) El[k * ELP + 128 + lane] = (unsigned)__builtin_amdgcn_readlane((int)E1[k], 63) >> 7;
        }
        for (int repa = 0; repa < PROBE_REPA; ++repa) {
            v4u hq[8];
#pragma unroll
            for (int k = 0; k < 8; ++k) hq[k] = *(const v4u*)(H2Q + (size_t)(tok0 + k) * D + 16 * lane);
            int pos[8];
#pragma unroll
            for (int k = 0; k < 8; ++k) pos[k] = 0;
            v4u bA[BSA], bB[BSA], bC[BSA]; int ps = 0, pn = 0;
            for (int r = 0; r < NR; ++r) {
#pragma unroll
                for (int k = 0; k < 8; ++k) {
                    constexpr int dummy = 0; (void)dummy;
                    const int kp = (k + 7) & 7;
                    const int c = __builtin_popcountll(__ballot((E0[k] >> RSH) == (unsigned)r)) + __builtin_popcountll(__ballot((E1[k] >> RSH) == (unsigned)r));
                    int s = __builtin_amdgcn_readfirstlane(pos[k]); const int e_end = __builtin_amdgcn_readfirstlane(s + c); pos[k] = e_end;
                    if (lane == 0) Bnd[k * (NR + 1) + r + 1] = e_end;
                    const int n1 = (e_end - s) < BSA ? (e_end - s) : BSA;
                    if (k & 1) sw_issue<BSA>(bB, El + k * ELP + s, EDq, voff); else sw_issue<BSA>(bA, El + k * ELP + s, EDq, voff);
                    if (pn > 0) { if (k & 1) sw_proc_a<BSA>(bA, hq[kp], Wl + kp * 128, ps, pn, lane); else sw_proc_a<BSA>(bB, hq[kp], Wl + kp * 128, ps, pn, lane); }
                    ps = s; pn = n1; s += n1;
#define SWA_REST(Y) if (s < e_end) { sw_issue<BSA>(Y, El + k * ELP + s, EDq, voff); \
                        for (;;) { int n = (e_end - s) < BSA ? (e_end - s) : BSA; \
                            if (s + BSA < e_end) { sw_issue<BSA>(bC, El + k * ELP + s + BSA, EDq, voff); sw_proc_a<BSA>(Y, hq[k], Wl + k * 128, s, n, lane); } else { sw_proc_a<BSA>(Y, hq[k], Wl + k * 128, s, n, lane); break; } \
                            s += BSA; n = (e_end - s) < BSA ? (e_end - s) : BSA; \
                            if (s + BSA < e_end) { sw_issue<BSA>(Y, El + k * ELP + s + BSA, EDq, voff); sw_proc_a<BSA>(bC, hq[k], Wl + k * 128, s, n, lane); } else { sw_proc_a<BSA>(bC, hq[k], Wl + k * 128, s, n, lane); break; } \
                            s += BSA; } }
                    if (k & 1) { SWA_REST(bA) } else { SWA_REST(bB) }
#undef SWA_REST
                }
            }
            if (pn > 0) sw_proc_a<BSA>(bB, hq[7], Wl + 7 * 128, ps, pn, lane);
        }
#pragma unroll
        for (int k = 0; k < 8; ++k) { int tk = tok0 + k; asm volatile("" : "+s"(tk)); const size_t base = (size_t)tk * 128; const float sh = H2S[tk];
            const float r0 = Wl[k * 128 + lane], r1 = Wl[k * 128 + 64 + lane];
            Wl[k * 128 + lane] = PG[base + (E0[k] & 127u)] * gelu_erf(r0 * sh * EDS[E0[k] >> 7]) * 0.0625f;
            Wl[k * 128 + 64 + lane] = PG[base + (E1[k] & 127u)] * gelu_erf(r1 * sh * EDS[E1[k] >> 7]) * 0.0625f; }
        int ln = lane; asm volatile("" : "+v"(ln));
#pragma unroll
        for (int sub = 0; sub < 8 / TPS; ++sub) {
        f32x2_t acc[TPS][8];
        for (int repb = 0; repb < PROBE_REPB; ++repb) {
#pragma unroll
            for (int kk = 0; kk < TPS; ++kk)
#pragma unroll
                for (int i = 0; i < 8; ++i) acc[kk][i] = (f32x2_t){0.f, 0.f};
            int pos[TPS];
#pragma unroll
            for (int kk = 0; kk < TPS; ++kk) pos[kk] = 0;
            v4u bA[BSB], bB[BSB]; int ps = 0, pn = 0;
            for (int r = 0; r < NR; ++r) {
#pragma unroll
                for (int kk = 0; kk < TPS; ++kk) {
                    const int k = sub * TPS + kk, kkp = (kk + TPS - 1) % TPS, kp = sub * TPS + kkp;
                    int s = __builtin_amdgcn_readfirstlane(pos[kk]); const int e_end = __builtin_amdgcn_readfirstlane(Bnd[k * (NR + 1) + r + 1]); pos[kk] = e_end;
                    const int n1 = (e_end - s) < BSB ? (e_end - s) : BSB;
                    if (kk & 1) sw_issue<BSB>(bB, El + k * ELP + s, EUq, voff); else sw_issue<BSB>(bA, El + k * ELP + s, EUq, voff);
                    if (pn > 0) { if (kk & 1) sw_proc_b<BSB>(bA, acc[kkp], Wl + kp * 128, ps, pn); else sw_proc_b<BSB>(bB, acc[kkp], Wl + kp * 128, ps, pn); }
                    ps = s; pn = n1; s += n1;
                    for (; s < e_end; s += BSB) {
                        const int n = (e_end - s) < BSB ? (e_end - s) : BSB;
                        if (kk & 1) { sw_issue<BSB>(bA, El + k * ELP + s, EUq, voff); sw_proc_b<BSB>(bA, acc[kk], Wl + k * 128, s, n); }
                        else        { sw_issue<BSB>(bB, El + k * ELP + s, EUq, voff); sw_proc_b<BSB>(bB, acc[kk], Wl + k * 128, s, n); }
                    }
                }
            }
            if (pn > 0) sw_proc_b<BSB>(bB, acc[TPS - 1], Wl + (sub * TPS + TPS - 1) * 128, ps, pn);
        }
        {
            asm volatile("" : "+v"(ln));
            float* outp = (float*)karg(18);
            const float* gt2 = MOD + ((tok0 + sub * TPS) >> 12) * NMOD + 5120;
            f32x4 gtv[4], xcur[4], xnxt[4];
#pragma unroll
            for (int j = 0; j < 4; ++j) { const int col = 4 * ln + 256 * j; gtv[j] = *(const f32x4*)(gt2 + col); xcur[j] = *(const f32x4*)(X1 + (size_t)(tok0 + sub * TPS) * D + col); }
#pragma unroll
            for (int kk = 0; kk < TPS; ++kk) {
                const int tok = tok0 + sub * TPS + kk;
                if (kk + 1 < TPS) {
#pragma unroll
                    for (int j = 0; j < 4; ++j) xnxt[j] = __builtin_nontemporal_load((const f32x4*)(X1 + (size_t)(tok + 1) * D + 4 * ln + 256 * j));
                }
                f32x4 x2[4]; float ss = 0.f;
#pragma unroll
                for (int j = 0; j < 4; ++j) {
#pragma unroll
                    for (int i = 0; i < 4; ++i) { const float v = xcur[j][i] + gtv[j][i] * acc[kk][2 * j + (i >> 1)][i & 1]; x2[j][i] = v; ss += v * v; } }
                ss = wave_sum_x(ss, ln);
                if (!(FAKE && ss != 12345.678f)) {
                    const float rstd = 1.0f / sqrtf(ss * (1.0f / D) + EPS);
                    f32x4 fgv[4];
#pragma unroll
                    for (int j = 0; j < 4; ++j) fgv[j] = *(const f32x4*)(fg + 4 * ln + 256 * j);
#pragma unroll
                    for (int j = 0; j < 4; ++j) __builtin_nontemporal_store(x2[j] * rstd * fgv[j], (f32x4*)(outp + (size_t)tok * D + 4 * ln + 256 * j));
                }
#pragma unroll
                for (int j = 0; j < 4; ++j) xcur[j] = xnxt[j];
            }
        }
        }
    }
}

struct Args { const float* in[18]; float* out; unsigned char* ws; };
__global__ void __launch_bounds__(NTHR, 2) mega_fwd(Args args) {
    extern __shared__ __attribute__((aligned(16))) unsigned char lds[];
    Frame F;
    F.lds = (LAS unsigned char*)lds;
    F.wave = __builtin_amdgcn_readfirstlane((int)threadIdx.x >> 6); F.lane = lane_fresh(); F.tid = F.wave * 64 + F.lane;
    F.G = gridDim.x; { const int bx = blockIdx.x; F.vcu = (F.G % 8 == 0) ? (bx % 8) * (F.G / 8) + bx / 8 : bx; }
    volatile LAS unsigned* MISC = (volatile LAS unsigned*)(F.lds + MISC_OFF);
    for (int u = F.tid; u < (LDS_BYTES - LDSCTL_OFF) / 4; u += NTHR) ((LAS unsigned*)(F.lds + LDSCTL_OFF))[u] = 0u;
    __syncthreads();
    gu32* ctl = (gu32*)(((unsigned char*)karg(19)) + WS_CTL);
    XcdBarrier bar = xcd_barrier_post((unsigned*)(ctl + CW_BAR), MISC + 8, F.wave);
#define GRID_BAR() xcd_barrier(bar)
#define PROBE_TS -1
#define STAMP(i) do { if (PROBE_TS >= 0 && blockIdx.x == 0 && F.tid == 0) { const unsigned long long t_ = __builtin_amdgcn_s_memrealtime(); MISC[16 + 2 * (i)] = (unsigned)t_; MISC[17 + 2 * (i)] = (unsigned)(t_ >> 32); } } while (0)
#define PROBE_DBL -1

    STAMP(0);
    F.lane = lane_fresh(); F.tid = F.wave * 64 + F.lane;
    p0_prologue(F); GRID_BAR(); STAMP(1);
    if (PROBE_DBL == 0) { p0_prologue(F); GRID_BAR(); }
    F.lane = lane_fresh(); F.tid = F.wave * 64 + F.lane;
    p1_norm(F); p0_transposes(F); GRID_BAR(); STAMP(2);
    if (PROBE_DBL == 1) { p1_norm(F); GRID_BAR(); }
    {
    {
        pg8::Gemm g{(const pg8::bf16_t*)(((unsigned char*)karg(19)) + WS_H), (const pg8::bf16_t*)(((unsigned char*)karg(19)) + WS_WIN), M, NPROJ, D, nullptr, nullptr};
        pg8::StaticOrder S; S.init(M, NPROJ, F.G, (int)blockIdx.x);
        pg8::EpiBf16<0> E{(pg8::bf16_t*)(((unsigned char*)karg(19)) + WS_PROJ), NPROJ, nullptr, 0, 0, 1.f};
        pg8::gemm_phase<pg8::EpiBf16<0>, pg8::StaticOrder, true, true>(F.lds + RING_OFF, g, S, E, F.wave);
        const int nwg = (M / 256) * (NPROJ / 256), busy = nwg % F.G;
        if (busy == 0) p0_quant_tables(F, F.vcu * NWAVES + F.wave, F.G * NWAVES);
        else if ((int)blockIdx.x >= busy) p0_quant_tables(F, ((int)blockIdx.x - busy) * NWAVES + F.wave, (F.G - busy) * NWAVES);
    }
    GRID_BAR(); STAMP(3);
    }
    p3_attention(F); GRID_BAR(); STAMP(4);
    if (PROBE_DBL == 3) { p3_attention(F); GRID_BAR(); }
    {
    {
        pg8::Gemm g{(const pg8::bf16_t*)(((unsigned char*)karg(19)) + WS_OA), (const pg8::bf16_t*)(((unsigned char*)karg(19)) + WS_WA), M, D, 512, (const pg8::bf16_t*)(((unsigned char*)karg(19)) + WS_OB), (const pg8::bf16_t*)(((unsigned char*)karg(19)) + WS_WB)};
        PairOrder S; S.S.init(M, D, F.G, (int)blockIdx.x);
        EpiGate E{(const bf16*)(((unsigned char*)karg(19)) + WS_PROJ), (bf16*)((float*)karg(18)) + (size_t)M * D};
        pg8::gemm_phase<EpiGate, PairOrder, true, true>(F.lds + RING_OFF, g, S, E, F.wave);
    }
    GRID_BAR(); STAMP(5);
    }
    {
    {
        pg8::Gemm g{(const pg8::bf16_t*)((bf16*)((float*)karg(18)) + (size_t)M * D), (const pg8::bf16_t*)(((unsigned char*)karg(19)) + WS_WOUT), M, D, D, nullptr, nullptr};
        pg8::StaticOrder S; S.init(M, D, F.G, (int)blockIdx.x);
        EpiRes E{((const float*)karg(0)), (const float*)(((unsigned char*)karg(19)) + WS_MOD), (float*)(((unsigned char*)karg(19)) + WS_X1)};
        pg8::gemm_phase<EpiRes, pg8::StaticOrder, true, true>(F.lds + RING_OFF, g, S, E, F.wave);
    }
    GRID_BAR(); STAMP(6);
    }
    F.lane = lane_fresh(); F.tid = F.wave * 64 + F.lane;
    F.lane = lane_fresh(); F.tid = F.wave * 64 + F.lane;
    p6_norm2(F); GRID_BAR(); STAMP(7);
    if (PROBE_DBL == 6) { p6_norm2(F); GRID_BAR(); }
    {
    {
        pg8::Gemm g{(const pg8::bf16_t*)(((unsigned char*)karg(19)) + WS_H2), (const pg8::bf16_t*)(((unsigned char*)karg(19)) + WS_WQ), M, D, D, nullptr, nullptr};
        pg8::StaticOrder S; S.init(M, D, F.G, (int)blockIdx.x);
        pg8::EpiBf16<0> E{(pg8::bf16_t*)(((unsigned char*)karg(19)) + WS_QP), D, nullptr, 0, 0, 1.f};
        pg8::gemm_phase<pg8::EpiBf16<0>, pg8::StaticOrder, true, true>(F.lds + RING_OFF, g, S, E, F.wave);
    }
    GRID_BAR(); STAMP(8);
    }
    F.lane = lane_fresh(); F.tid = F.wave * 64 + F.lane;
    p8a_topk(F); __syncthreads(); STAMP(9);
    if (PROBE_DBL == 8) { p8a_topk(F); GRID_BAR(); }
    if (PROBE_DBL == 12) { p8b_sweep<1>(F); __syncthreads(); }
    p8b_sweep<0>(F);
    if (PROBE_DBL == 9) { GRID_BAR(); p8b_sweep<0>(F); }
    if (PROBE_TS >= 0) {
        GRID_BAR(); STAMP(10);
        if (blockIdx.x == 0) { __syncthreads();
            const unsigned long long t0 = ((unsigned long long)MISC[17 + 2 * PROBE_TS] << 32) | MISC[16 + 2 * PROBE_TS], t1 = ((unsigned long long)MISC[19 + 2 * PROBE_TS] << 32) | MISC[18 + 2 * PROBE_TS];
            const float d_us = (float)(t1 - t0) * 0.01f;
            const float V = 128.0f * sqrtf(d_us * 1e-5f);
            float* o = (float*)karg(18); for (int c = F.tid; c < D; c += NTHR) o[c] = V; }
    }
}

extern "C" void kernel_launch(void* const* d_in, const int* in_sizes, int n_in, void* d_out, int out_size, void* d_ws, size_t ws_size, hipStream_t stream) {
    static int grid = 0;
    if (grid == 0) {
        if (n_in != 18 || in_sizes[0] != M * D || out_size != M * D || ws_size < WS_END) { fprintf(stderr, "kernel_launch: unexpected shapes (n_in %d, in0 %d, out %d, ws %zu)\n", n_in, n_in > 0 ? in_sizes[0] : -1, out_size, ws_size); grid = -1; return; }
        int dev = 0, cus = 0, per_cu = 0;
        if (hipGetDevice(&dev) != hipSuccess || hipDeviceGetAttribute(&cus, hipDeviceAttributeMultiprocessorCount, dev) != hipSuccess) { grid = -1; return; }
        if (hipFuncSetAttribute((const void*)mega_fwd, hipFuncAttributeMaxDynamicSharedMemorySize, LDS_BYTES) != hipSuccess) { fprintf(stderr, "kernel_launch: hipFuncSetAttribute failed\n"); grid = -1; return; }
        if (hipOccupancyMaxActiveBlocksPerMultiprocessor(&per_cu, (const void*)mega_fwd, NTHR, LDS_BYTES) != hipSuccess || per_cu < 1) { fprintf(stderr, "kernel_launch: occupancy query says %d blocks per CU\n", per_cu); }
        (void)hipGetLastError();
        grid = cus;
    }
    if (grid < 0) return;
    if (hipMemsetAsync((char*)d_ws + WS_CTL, 0, CTL_ZERO_BYTES, stream) != hipSuccess) { fprintf(stderr, "kernel_launch: memset failed\n"); return; }
    Args a{};
    for (int i = 0; i < 18; ++i) a.in[i] = (const float*)d_in[i];
    a.out = (float*)d_out; a.ws = (unsigned char*)d_ws;
    hipLaunchKernelGGL(mega_fwd, dim3(grid), dim3(NTHR), LDS_BYTES, stream, a);
}
```

```cpp
#include <hip/hip_runtime.h>
#include <cstdio>
#include <cstdint>
__device__ __forceinline__ int lane_fresh() { unsigned ones = ~0u; asm volatile("" : "+s"(ones)); return (int)__builtin_amdgcn_mbcnt_hi(ones, __builtin_amdgcn_mbcnt_lo(ones, 0u)); }
namespace pg8 {
#define PG8_LAS __attribute__((address_space(3)))
typedef unsigned short bf16_t;
typedef short bf16x8 __attribute__((ext_vector_type(8)));
typedef float f32x4 __attribute__((ext_vector_type(4)));
typedef unsigned u32x4 __attribute__((ext_vector_type(4)));
constexpr int BM = 256, BK = 64, HALF = 128, HTB = HALF * BK * 2  , STAGE_BYTES = 8 * HTB, NXCD = 8, WGM = 8;

__host__ __device__ __forceinline__ int lds_byte(int r, int c) { const int st = (r >> 4) * 2 + (c >> 5), rr = r & 15, cc = c & 31, ob = rr * 64 + cc * 2; return st * 1024 + (ob ^ (((ob >> 9) & 1) << 5)); }
__host__ __device__ __forceinline__ void stage_rc(int b, int& R, int& C) { const int st = b / 1024, sb = b % 1024, swz = sb ^ (((sb >> 9) & 1) << 5); R = (st >> 1) * 16 + swz / 64; C = (st & 1) * 32 + (swz % 64) / 2; }
__host__ __device__ __forceinline__ int perm32(int rho) { const int n = rho >> 4, i = rho & 15; return 8 * (i >> 2) + 4 * n + (i & 3); }

struct Unit { int pm, pn, src; };
struct Gemm { const bf16_t* A; const bf16_t* Bt; int M, N, K; const bf16_t* A2; const bf16_t* Bt2; };

struct StaticOrder {
    int nM, nN, nwg, G, c;
    __host__ __device__ void init(int M, int N, int G_, int c_) { nM = M / BM; nN = N / BM; nwg = nM * nN; G = G_; c = c_; }
    __host__ __device__ bool next(int i, Unit& u) const {
        const long L = (long)i * G + c; if (L >= nwg) return false;
        int wgid = (int)L; { const int q = nwg / NXCD, r = nwg % NXCD, xcd = wgid % NXCD, off = wgid / NXCD; wgid = (xcd < r ? xcd * (q + 1) : r * (q + 1) + (xcd - r) * q) + off; }
        const int nig = WGM * nN, gid = wgid / nig, fm = gid * WGM, gsz = (nM - fm) < WGM ? (nM - fm) : WGM;
        u.pm = fm + ((wgid % nig) % gsz); u.pn = (wgid % nig) / gsz; u.src = 0; return true;
    }
    __device__ __forceinline__ void a_ready(const Unit&) const {}
    __device__ __forceinline__ void done(const Unit&) const {}
};

__device__ __forceinline__ unsigned cvt_pk_bf16(float lo, float hi) { unsigned r; asm volatile("v_cvt_pk_bf16_f32 %0, %1, %2" : "=v"(r) : "v"(lo), "v"(hi)); return r; }
typedef float f32x2 __attribute__((ext_vector_type(2)));
__device__ __forceinline__ f32x2 gelu_pk(f32x2 v) {
    const f32x2 av = __builtin_elementwise_abs(v), d = av * 0.2316418882f + 1.0f;
    f32x2 t; t.x = __builtin_amdgcn_rcpf(d.x); t.y = __builtin_amdgcn_rcpf(d.y);
    f32x2 q = t * 0.5307027145f + (-0.7265760135f); q = q * t + 0.7107068705f; q = q * t + (-0.142248368f); q = q * t + 0.127414796f; q = q * t;
    const f32x2 s = (v * v) * (-0.72134752044f);
    f32x2 e; e.x = __builtin_amdgcn_exp2f(s.x); e.y = __builtin_amdgcn_exp2f(s.y);
    const f32x2 m = v * (q * e), r = v - m;
    f32x2 o; o.x = v.x < 0.f ? m.x : r.x; o.y = v.y < 0.f ? m.y : r.y; return o;
}

template <int ACT  > struct EpiBf16 {
    static constexpr bool PERM = true, AFTER_DRAIN = false, CHAIN = false; static_assert(ACT == 0 || ACT == 1, "EpiBf16: ACT is 0 (none) or 1 (gelu_pk)");
    bf16_t* O; int ldc; const float* bias; int split_cols; size_t split_stride; float scale0;
    __device__ __forceinline__ void operator()(const f32x4 (&acc)[2][2][4][2], const Unit& u, int wr, int wc, int fr, int fq) const {
        const int row0 = u.pm * BM + wr * 64 + fr; int colt = u.pn * BM; bf16_t* base = O;
        float sc = 1.f; if (split_cols) { const int t = colt / split_cols; base += (size_t)t * split_stride; colt -= t * split_cols; if (t == 0) sc = scale0; }
        const int col0 = colt + wc * 32 + 8 * fq, bcol0 = u.pn * BM + wc * 32 + 8 * fq;
        f32x4 bv[2][2];
#pragma unroll
        for (int bj = 0; bj < 2; ++bj)
#pragma unroll
            for (int n = 0; n < 2; ++n) bv[bj][n] = bias ? *(const f32x4*)(bias + bcol0 + bj * HALF + 4 * n) : (f32x4){0.f, 0.f, 0.f, 0.f};
#pragma unroll
        for (int ai = 0; ai < 2; ++ai)
#pragma unroll
            for (int m = 0; m < 4; ++m) { bf16_t* rowp = base + (size_t)(row0 + ai * HALF + m * 16) * ldc + col0;
#pragma unroll
                for (int bj = 0; bj < 2; ++bj) { f32x4 v0 = acc[ai][bj][m][0] + bv[bj][0], v1 = acc[ai][bj][m][1] + bv[bj][1];
                    if (ACT == 1) { f32x2 a = gelu_pk((f32x2){v0[0], v0[1]}), b = gelu_pk((f32x2){v0[2], v0[3]}), c = gelu_pk((f32x2){v1[0], v1[1]}), d = gelu_pk((f32x2){v1[2], v1[3]});
                        v0 = (f32x4){a.x, a.y, b.x, b.y}; v1 = (f32x4){c.x, c.y, d.x, d.y}; }
                    v0 = v0 * sc; v1 = v1 * sc; u32x4 w; w.x = cvt_pk_bf16(v0[0], v0[1]); w.y = cvt_pk_bf16(v0[2], v0[3]); w.z = cvt_pk_bf16(v1[0], v1[1]); w.w = cvt_pk_bf16(v1[2], v1[3]);
                    *(u32x4*)(rowp + bj * HALF) = w; } }
    }
};

template <class Epi, class Sched, bool ALIGN_EPI = false, bool SP2 = false>
__device__ __forceinline__ void gemm_phase(PG8_LAS unsigned char* lds, const Gemm g, const Sched& S, const Epi& E, int wave_id) {
    int tid = wave_id * 64 + ::lane_fresh(); asm volatile("" : "+v"(tid));
    const int wid = __builtin_amdgcn_readfirstlane(tid >> 6), lane = tid & 63, wr = wid >> 2, wc = wid & 3, fr = lane & 15, fq = lane >> 4;
    const int K = g.K, nt = K / BK;
    unsigned voffA[2], voffB[2];
#pragma unroll
    for (int i = 0; i < 2; ++i) { int R, C; stage_rc(tid * 16 + i * 8192, R, C); const int Rb = Epi::PERM ? ((R & ~31) + perm32(R & 31)) : R;
        voffA[i] = (unsigned)(R * K + C) * 2u; voffB[i] = (unsigned)(Rb * K + C) * 2u; }
    const size_t kstep = (size_t)(BK * 2);
    const size_t hstep = (size_t)HALF * K * 2;
    const size_t tstep = 2 * hstep;
    const unsigned ldsw = (unsigned)wid * 1024u;
    const int aoff = lds_byte(wr * 64 + fr, fq * 8), boff = lds_byte(wc * 32 + fr, fq * 8);
#define PG8_SA(b, h) (((b) * 2 + (h)) * HTB)
#define PG8_SB(b, h) ((4 + (b) * 2 + (h)) * HTB)
#define PG8_STAGE(bufoff, gbase, voff) do { _Pragma("unroll") for (int _i = 0; _i < 2; ++_i) \
        __builtin_amdgcn_global_load_lds((const unsigned*)((const char*)(gbase) + (voff)[_i]), (PG8_LAS unsigned*)(lds + (bufoff) + ldsw + _i * 8192), 16, 0, 0); } while (0)
#define PG8_LDA(dst, b, h) do { _Pragma("unroll") for (int m = 0; m < 4; ++m) _Pragma("unroll") for (int k = 0; k < 2; ++k) dst[m][k] = *(const PG8_LAS bf16x8*)(lds + PG8_SA(b, h) + aoff + m * 2048 + k * 1024); } while (0)
#define PG8_LDB(dst, b, h) do { _Pragma("unroll") for (int n = 0; n < 2; ++n) _Pragma("unroll") for (int k = 0; k < 2; ++k) dst[n][k] = *(const PG8_LAS bf16x8*)(lds + PG8_SB(b, h) + boff + n * 2048 + k * 1024); } while (0)
#define PG8_MMA(ai, bj, At, Bt) do { __builtin_amdgcn_s_setprio(1); _Pragma("unroll") for (int m = 0; m < 4; ++m) _Pragma("unroll") for (int n = 0; n < 2; ++n) _Pragma("unroll") for (int k = 0; k < 2; ++k) \
        acc[ai][bj][m][n] = __builtin_amdgcn_mfma_f32_16x16x32_bf16(Bt[n][k], At[m][k], acc[ai][bj][m][n], 0, 0, 0); __builtin_amdgcn_s_setprio(0); } while (0)
#define PG8_WAIT_V(n) asm volatile("s_waitcnt vmcnt(" #n ")" ::: "memory")
#define PG8_WAIT_L(n) asm volatile("s_waitcnt lgkmcnt(" #n ")" ::: "memory")
#define PG8_BAR __builtin_amdgcn_s_barrier()
#define PG8_SCHED __builtin_amdgcn_sched_barrier(0)
    Unit cur, nxt; int ui = 0;
    if (!S.next(0, cur)) return;
    f32x4 acc[2][2][4][2];
#pragma unroll
    for (int a = 0; a < 2; ++a)
#pragma unroll
        for (int b = 0; b < 2; ++b)
#pragma unroll
            for (int m = 0; m < 4; ++m)
#pragma unroll
                for (int n = 0; n < 2; ++n) acc[a][b][m][n] = (f32x4){0.f, 0.f, 0.f, 0.f};
    bf16x8 At[4][2], B0[2][2], B1[2][2];
    const char* cA = (const char*)(cur.src ? g.A2 : g.A) + (size_t)cur.pm * tstep; const char* cB = (const char*)(cur.src ? g.Bt2 : g.Bt) + (size_t)cur.pn * tstep;
    S.a_ready(cur);
    if constexpr (SP2) {
        PG8_STAGE(PG8_SB(0, 0), cB, voffB); PG8_STAGE(PG8_SB(0, 1), cB + hstep, voffB); PG8_STAGE(PG8_SA(0, 0), cA, voffA); PG8_STAGE(PG8_SA(0, 1), cA + hstep, voffA);
        if (wr == 1) PG8_BAR;
        PG8_WAIT_V(2); PG8_BAR;
        PG8_STAGE(PG8_SB(1, 0), cB + kstep, voffB); PG8_STAGE(PG8_SA(1, 0), cA + kstep, voffA); PG8_STAGE(PG8_SB(1, 1), cB + hstep + kstep, voffB);
        PG8_WAIT_V(6); PG8_BAR;
    } else {
        PG8_STAGE(PG8_SB(0, 0), cB, voffB); PG8_STAGE(PG8_SA(0, 0), cA, voffA); PG8_STAGE(PG8_SB(0, 1), cB + hstep, voffB); PG8_STAGE(PG8_SA(0, 1), cA + hstep, voffA);
        if (wr == 1) PG8_BAR;
        PG8_WAIT_V(4); PG8_BAR;
        PG8_STAGE(PG8_SB(1, 0), cB + kstep, voffB); PG8_STAGE(PG8_SA(1, 0), cA + kstep, voffA); PG8_STAGE(PG8_SB(1, 1), cB + hstep + kstep, voffB);
        PG8_WAIT_V(6); PG8_BAR;
    }
    for (;;) {
        const bool has_next = S.next(ui + 1, nxt);
        const char* nA = has_next ? (const char*)(nxt.src ? g.A2 : g.A) + (size_t)nxt.pm * tstep : cA; const char* nB = has_next ? (const char*)(nxt.src ? g.Bt2 : g.Bt) + (size_t)nxt.pn * tstep : cB;
        for (int t = 0; t < nt; t += 2) {
            const bool last = (t == nt - 2);
            const char* a1 = cA + (size_t)(t + 1) * kstep;
            const char* a2 = last ? nA : cA + (size_t)(t + 2) * kstep; const char* b2 = last ? nB : cB + (size_t)(t + 2) * kstep;
            const char* a3 = a2 + kstep; const char* b3 = b2 + kstep;
            if (last && has_next) S.a_ready(nxt);
            if constexpr (SP2) {
            PG8_LDB(B0, 0, 0); PG8_LDB(B1, 0, 1); PG8_SCHED; PG8_LDA(At, 0, 0); PG8_STAGE(PG8_SA(1, 1), a1 + hstep, voffA);
            PG8_WAIT_V(8); PG8_WAIT_L(0); PG8_BAR; PG8_MMA(0, 0, At, B0); PG8_MMA(0, 1, At, B1); PG8_BAR; PG8_SCHED;
            PG8_LDA(At, 0, 1); PG8_STAGE(PG8_SB(0, 0), b2, voffB); PG8_STAGE(PG8_SB(0, 1), b2 + hstep, voffB); PG8_STAGE(PG8_SA(0, 0), a2, voffA);
            PG8_WAIT_V(8); PG8_WAIT_L(0); PG8_BAR; PG8_MMA(1, 0, At, B0); PG8_MMA(1, 1, At, B1); PG8_BAR; PG8_SCHED;
            PG8_LDB(B0, 1, 0); PG8_LDB(B1, 1, 1); PG8_SCHED; PG8_LDA(At, 1, 0); PG8_STAGE(PG8_SA(0, 1), a2 + hstep, voffA);
            PG8_WAIT_V(8); PG8_WAIT_L(0); PG8_BAR; PG8_MMA(0, 0, At, B0); PG8_MMA(0, 1, At, B1); PG8_BAR; PG8_SCHED;
            PG8_LDA(At, 1, 1); PG8_STAGE(PG8_SB(1, 0), b3, voffB); PG8_STAGE(PG8_SB(1, 1), b3 + hstep, voffB); PG8_STAGE(PG8_SA(1, 0), a3, voffA);
            PG8_WAIT_V(8); PG8_WAIT_L(0); PG8_BAR; PG8_MMA(1, 0, At, B0); PG8_MMA(1, 1, At, B1); PG8_BAR; PG8_SCHED;
            } else {
            PG8_LDB(B0, 0, 0); PG8_SCHED; PG8_LDA(At, 0, 0); PG8_STAGE(PG8_SA(1, 1), a1 + hstep, voffA);
            PG8_WAIT_L(8); PG8_BAR; PG8_WAIT_L(0); PG8_MMA(0, 0, At, B0); PG8_BAR; PG8_SCHED;
            PG8_LDB(B1, 0, 1); PG8_STAGE(PG8_SB(0, 0), b2, voffB);
            PG8_BAR; PG8_WAIT_L(0); PG8_MMA(0, 1, At, B1); PG8_BAR;
            PG8_LDA(At, 0, 1); PG8_STAGE(PG8_SA(0, 0), a2, voffA);
            PG8_BAR; PG8_WAIT_L(0); PG8_MMA(1, 0, At, B0); PG8_BAR; PG8_SCHED;
            PG8_STAGE(PG8_SB(0, 1), b2 + hstep, voffB);
            PG8_WAIT_V(6); PG8_BAR; PG8_MMA(1, 1, At, B1); PG8_BAR;
            PG8_LDB(B0, 1, 0); PG8_SCHED; PG8_LDA(At, 1, 0); PG8_STAGE(PG8_SA(0, 1), a2 + hstep, voffA);
            PG8_WAIT_L(8); PG8_BAR; PG8_WAIT_L(0); PG8_MMA(0, 0, At, B0); PG8_BAR; PG8_SCHED;
            PG8_LDB(B1, 1, 1); PG8_STAGE(PG8_SB(1, 0), b3, voffB);
            PG8_BAR; PG8_WAIT_L(0); PG8_MMA(0, 1, At, B1); PG8_BAR;
            PG8_LDA(At, 1, 1); PG8_STAGE(PG8_SA(1, 0), a3, voffA);
            PG8_BAR; PG8_WAIT_L(0); PG8_MMA(1, 0, At, B0); PG8_BAR; PG8_SCHED;
            PG8_STAGE(PG8_SB(1, 1), b3 + hstep, voffB);
            PG8_WAIT_V(6); PG8_BAR; PG8_MMA(1, 1, At, B1); PG8_BAR;
            }
        }
        if constexpr (ALIGN_EPI) { if (wr == 0) PG8_BAR; }
        if constexpr (!Epi::AFTER_DRAIN) { E(acc, cur, wr, wc, fr, fq); S.done(cur); }
        if (!has_next) break;
        if (!(Epi::CHAIN && cur.src == 0)) {
#pragma unroll
        for (int a = 0; a < 2; ++a)
#pragma unroll
            for (int b = 0; b < 2; ++b)
#pragma unroll
                for (int m = 0; m < 4; ++m)
#pragma unroll
                    for (int n = 0; n < 2; ++n) acc[a][b][m][n] = (f32x4){0.f, 0.f, 0.f, 0.f};
        }
        cur = nxt; cA = nA; cB = nB; ++ui;
        if constexpr (ALIGN_EPI) { if (wr == 1) PG8_BAR; }
    }
    PG8_WAIT_V(0);
    if constexpr (!ALIGN_EPI) { if (wr == 0) PG8_BAR; }
    PG8_BAR;
    if constexpr (Epi::AFTER_DRAIN) { E.fused(acc, cur, wr, wc, fr, fq, lds, wid, lane); S.done(cur); }
#undef PG8_SA
#undef PG8_SB
#undef PG8_STAGE
#undef PG8_LDA
#undef PG8_LDB
#undef PG8_MMA
#undef PG8_WAIT_V
#undef PG8_WAIT_L
#undef PG8_BAR
#undef PG8_SCHED
}
}

#define GAS __attribute__((address_space(1)))
#define LAS __attribute__((address_space(3)))
typedef unsigned short bf16;
typedef unsigned v4u __attribute__((ext_vector_type(4)));
typedef float f32x4 __attribute__((ext_vector_type(4)));
typedef short bf16x8 __attribute__((ext_vector_type(8)));
typedef GAS unsigned gu32;
typedef GAS unsigned long long gu64;
#define RLX_AGENT __ATOMIC_RELAXED, __HIP_MEMORY_SCOPE_AGENT
#define LDS_WAIT() asm volatile("s_waitcnt lgkmcnt(0)" ::: "memory")
#define VM_WAIT() asm volatile("s_waitcnt vmcnt(0)" ::: "memory")
__device__ __forceinline__ unsigned long long rt() { return __builtin_amdgcn_s_memrealtime(); }
__device__ __forceinline__ unsigned f2bf(float f) { unsigned u = __builtin_bit_cast(unsigned, f); return (u + 0x7fffu + ((u >> 16) & 1u)) >> 16; }
__device__ __forceinline__ unsigned pk2(float lo, float hi) { return f2bf(lo) | (f2bf(hi) << 16); }

__device__ __forceinline__ const void* karg(int i);
constexpr int CW_BAR_FWD = 4096;
#define XB_TMO      128
#define XB_XCNT(j)  (256  + 64 * (j))
#define XB_XSUB(j)  (1280 + 64 * (j))
#define XB_XGEN(j)  (2304 + 64 * (j))
#define XB_TOP      3328
#define XB_TOPGEN   3392
#define XCD_BAR_WORDS 3456
#define XB_SPIN_CAP (1u << 18)

__device__ __forceinline__ unsigned xb_ld(unsigned* p)              { return __hip_atomic_load(p, __ATOMIC_RELAXED, __HIP_MEMORY_SCOPE_AGENT); }
__device__ __forceinline__ unsigned xb_add(unsigned* p, unsigned v) { return __hip_atomic_fetch_add(p, v, __ATOMIC_RELAXED, __HIP_MEMORY_SCOPE_AGENT); }
__device__ __forceinline__ unsigned xb_xcc_id() { return (unsigned)__builtin_amdgcn_s_getreg((3 << 11) | 20) & 0xFu; }
#define XB_SPIN(cond, bar) do { unsigned _sp = 0; while (cond) { __builtin_amdgcn_s_sleep(1); \
    if ((++_sp & 255u) == 0u) { if (xb_ld(&(bar)[XB_TMO])) break; if (_sp > XB_SPIN_CAP) { atomicAdd(&(bar)[XB_TMO], 1u); break; } } } } while (0)

struct XcdBarrier {
    int wave;
    unsigned* bar; unsigned x;
    volatile LAS unsigned* st;
};

__device__ __forceinline__ XcdBarrier xcd_barrier_post(unsigned* bar, volatile LAS unsigned* st, int wave) {
    XcdBarrier b; b.wave = wave; b.bar = bar; b.x = xb_xcc_id(); b.st = st;
    if (wave == 0 && lane_fresh() == 0) (void)xb_add(&bar[XB_XCNT(b.x)], 1u);
    return b;
}
__device__ __forceinline__ void xcd_barrier_complete(unsigned* bar, unsigned x, unsigned& nloc, unsigned& nx) {
    const unsigned G = gridDim.x * gridDim.y * gridDim.z;
    unsigned sum, cnt, mine, sp = 0u;
    for (;;) {
        sum = 0u; cnt = 0u; mine = 0u;
#pragma unroll
        for (unsigned j = 0; j < 16; ++j) { const unsigned c = xb_ld(&bar[XB_XCNT(j)]); sum += c; cnt += (c > 0u) ? 1u : 0u; mine = (j == x) ? c : mine; }
        if (sum == G) break;
        __builtin_amdgcn_s_sleep(1);
        if ((++sp & 255u) == 0u) { if (xb_ld(&bar[XB_TMO])) break; if (sp > XB_SPIN_CAP) { atomicAdd(&bar[XB_TMO], 1u); break; } }
    }
    nloc = mine > 0u ? mine : 1u; nx = cnt > 0u ? cnt : 1u;
}

__device__ __forceinline__ void xcd_barrier(const XcdBarrier& b) {
    asm volatile("s_waitcnt vmcnt(0)" ::: "memory");
    __syncthreads();
    if (b.wave == 0 && lane_fresh() == 0) {
        unsigned* bar = (unsigned*)((gu32*)((unsigned char*)karg(19)) + CW_BAR_FWD);
        __builtin_amdgcn_s_waitcnt(0);
        unsigned nloc = b.st[0], nx = b.st[1];
        if (nloc == 0u) { xcd_barrier_complete(bar, b.x, nloc, nx); b.st[0] = nloc; b.st[1] = nx; }
        const unsigned old = xb_add(&bar[XB_XSUB(b.x)], 1u);
        const unsigned gen = old / nloc;
        if (old + 1u == (gen + 1u) * nloc) {
            __builtin_amdgcn_fence(__ATOMIC_RELEASE, "agent");
            asm volatile("s_waitcnt vmcnt(0)" ::: "memory");
            const unsigned og = xb_add(&bar[XB_TOP], 1u);
            const unsigned tg = og / nx;
            if (og + 1u == (tg + 1u) * nx) xb_add(&bar[XB_TOPGEN], 1u);
            else XB_SPIN(xb_ld(&bar[XB_TOPGEN]) == tg, bar);
            __builtin_amdgcn_fence(__ATOMIC_ACQUIRE, "agent");
            xb_add(&bar[XB_XGEN(b.x)], 1u);
            asm volatile("s_waitcnt vmcnt(0)" ::: "memory");
        } else {
            XB_SPIN(xb_ld(&bar[XB_XGEN(b.x)]) == gen, bar);
            __builtin_amdgcn_fence(__ATOMIC_ACQUIRE, "agent");
            asm volatile("s_waitcnt vmcnt(0)" ::: "memory");
        }
    }
    __syncthreads();
}

constexpr int NWAVES = 8, NTHR = 512;
constexpr int BATCH = 4, SEQ = 4096, D = 1024, M = BATCH * SEQ;
constexpr int NPROJ = 4352, LDW_IN = 4360, NMOD = 6144;
constexpr int C_QA = 0, C_KA = 512, C_VA = 640, C_QB = 768, C_KB = 1280, C_VB = 1792, C_GLA = 2304, C_GLB = 3328;
constexpr int NEXP = 16384;
constexpr float EPS = 1e-6f;

constexpr size_t MiB = 1u << 20;
constexpr size_t WS_CTL = 0, CTL_ZERO_BYTES = 1 * MiB;
constexpr size_t WS_MOD = 1 * MiB, WS_LOGF = 1 * MiB + 128 * 1024, WS_SUBK = 2 * MiB;
constexpr size_t WS_WIN = 4 * MiB, WS_WA = 12 * MiB + 512 * 1024, WS_WB = 13 * MiB + 512 * 1024, WS_WOUT = 14 * MiB + 512 * 1024, WS_WQ = 16 * MiB + 512 * 1024;
constexpr size_t WS_ED = 19 * MiB, WS_EU = 35 * MiB;
constexpr size_t WS_EDS = 2 * MiB + 512 * 1024;
constexpr size_t WS_H2Q = 95 * MiB, WS_H2S = 111 * MiB;
constexpr size_t WS_H = 83 * MiB, WS_OA = 83 * MiB, WS_OB = 99 * MiB, WS_PIDX = 83 * MiB, WS_PG = 87 * MiB;
constexpr size_t WS_PROJ = 115 * MiB, WS_X1 = 115 * MiB, WS_H2 = 179 * MiB, WS_QP = 211 * MiB;
constexpr size_t WS_END = 251 * MiB;
static_assert(WS_WIN + (size_t)NPROJ * D * 2 <= WS_WA && WS_WQ + (size_t)D * D * 2 <= WS_ED && WS_PROJ + (size_t)M * NPROJ * 2 <= WS_END, "ws map");
constexpr int CW_BAR = 4096; static_assert(CW_BAR == CW_BAR_FWD && WS_CTL == 0, "barrier words");

constexpr int RING_OFF = 0, RING_BYTES = 131072;
constexpr int LDSCTL_OFF = RING_BYTES, MISC_OFF = LDSCTL_OFF + 320;
constexpr int LDS_BYTES = 147456;

typedef float f32x16 __attribute__((ext_vector_type(16)));
typedef short s16x4 __attribute__((ext_vector_type(4)));
typedef unsigned u32x2 __attribute__((ext_vector_type(2)));
typedef float f32x2_t __attribute__((ext_vector_type(2)));
typedef __bf16 bf16x2_t __attribute__((ext_vector_type(2)));

__device__ __forceinline__ unsigned cvtpk(float lo, float hi) { f32x2_t v = {lo, hi}; bf16x2_t b = __builtin_convertvector(v, bf16x2_t); return __builtin_bit_cast(unsigned, b); }
__device__ __forceinline__ float bflo(unsigned u) { return __uint_as_float(u << 16); }
__device__ __forceinline__ float bfhi(unsigned u) { return __uint_as_float(u & 0xffff0000u); }
template <int S> __device__ __forceinline__ unsigned xorx(unsigned v, int lane) {
    if constexpr (S == 1) return (unsigned)__builtin_amdgcn_update_dpp(0, (int)v, 0xB1, 0xF, 0xF, true);
    else if constexpr (S == 2) return (unsigned)__builtin_amdgcn_update_dpp(0, (int)v, 0x4E, 0xF, 0xF, true);
    else if constexpr (S == 4) { const unsigned a = (unsigned)__builtin_amdgcn_update_dpp(0, (int)v, 0x124, 0xF, 0xF, true), b = (unsigned)__builtin_amdgcn_update_dpp(0, (int)v, 0x12C, 0xF, 0xF, true); return (lane & 4) ? a : b; }
    else if constexpr (S == 8) return (unsigned)__builtin_amdgcn_update_dpp(0, (int)v, 0x128, 0xF, 0xF, true);
    else if constexpr (S == 16) { const auto r = __builtin_amdgcn_permlane16_swap(v, v, false, false); return (lane & 16) ? r[0] : r[1]; }
    else { const auto r = __builtin_amdgcn_permlane32_swap(v, v, false, false); return (lane & 32) ? r[0] : r[1]; }
}
__device__ __forceinline__ unsigned xorx_sw(unsigned v, int lane, int s) {
    switch (s) { case 1: return xorx<1>(v, lane); case 2: return xorx<2>(v, lane); case 4: return xorx<4>(v, lane); case 8: return xorx<8>(v, lane); case 16: return xorx<16>(v, lane); default: return xorx<32>(v, lane); }
}
__device__ __forceinline__ float wave_sum_x(float v, int lane) {
    v += __uint_as_float(xorx<1>(__float_as_uint(v), lane)); v += __uint_as_float(xorx<2>(__float_as_uint(v), lane)); v += __uint_as_float(xorx<4>(__float_as_uint(v), lane));
    v += __uint_as_float(xorx<8>(__float_as_uint(v), lane)); v += __uint_as_float(xorx<16>(__float_as_uint(v), lane)); v += __uint_as_float(xorx<32>(__float_as_uint(v), lane));
    return v;
}
__device__ __forceinline__ float dppf(float v, const int ctrl_sel) { return v; }
#define DPP_F(v, CTRL) __uint_as_float(__builtin_amdgcn_update_dpp(0, __float_as_uint(v), (CTRL), 0xF, 0xF, true))
__device__ __forceinline__ float reduce8_t(const float (&dd)[8], int lane) {
    float r4[4];
#pragma unroll
    for (int u = 0; u < 4; ++u) { const auto p = __builtin_amdgcn_permlane32_swap(__float_as_uint(dd[u]), __float_as_uint(dd[u + 4]), false, false); r4[u] = __uint_as_float(p[0]) + __uint_as_float(p[1]); }
    float r2[2];
#pragma unroll
    for (int u = 0; u < 2; ++u) { const auto p = __builtin_amdgcn_permlane16_swap(__float_as_uint(r4[u]), __float_as_uint(r4[u + 2]), false, false); r2[u] = __uint_as_float(p[0]) + __uint_as_float(p[1]); }
    const bool b3 = (lane & 8) != 0;
    const float keep = b3 ? r2[1] : r2[0], send = b3 ? r2[0] : r2[1];
    float r1 = keep + DPP_F(send, 0x128);
    r1 += DPP_F(r1, 0xB1);
    r1 += DPP_F(r1, 0x4E);
    r1 += DPP_F(r1, 0x141);
    return r1;
}
__device__ __forceinline__ int lane_id() { return (int)__builtin_amdgcn_mbcnt_hi(~0u, __builtin_amdgcn_mbcnt_lo(~0u, 0u)); }
__device__ __forceinline__ float wave_sum(float v) { return wave_sum_x(v, lane_id()); }
__device__ __forceinline__ float wave_max(float v) { const int lane = lane_id();
    v = fmaxf(v, __uint_as_float(xorx<1>(__float_as_uint(v), lane))); v = fmaxf(v, __uint_as_float(xorx<2>(__float_as_uint(v), lane))); v = fmaxf(v, __uint_as_float(xorx<4>(__float_as_uint(v), lane)));
    v = fmaxf(v, __uint_as_float(xorx<8>(__float_as_uint(v), lane))); v = fmaxf(v, __uint_as_float(xorx<16>(__float_as_uint(v), lane))); v = fmaxf(v, __uint_as_float(xorx<32>(__float_as_uint(v), lane)));
    return v; }
__device__ __forceinline__ int crow(int r, int hi) { return (r & 3) + 8 * (r >> 2) + 4 * hi; }
#define MFMA32(a, b, c) __builtin_amdgcn_mfma_f32_32x32x16_bf16((a), (b), (c), 0, 0, 0)

struct Frame {
    LAS unsigned char* lds;
    int tid, lane, wave, vcu, G;
};
__device__ __forceinline__ const void* karg(int i) {
    unsigned long z = 0; asm volatile("" : "+s"(z));
    const char* base = (const char*)__builtin_amdgcn_kernarg_segment_ptr();
    return *(const void* const*)(base + 8 * i + z);
}

__device__ __forceinline__ void p0_transpose_item(const float* W, int ld, int K, int ncols, bf16* WT, int row_off, LAS float* scr, int item, int lane) {
    const int nblk = ncols / 32, kb = item / nblk, nb = item % nblk, k0 = 64 * kb, n0 = 32 * nb;
#pragma unroll 8
    for (int i = 0; i < 32; ++i) { const int kk = 2 * i + (lane >> 5); scr[kk * 33 + (lane & 31)] = __builtin_nontemporal_load(W + (size_t)(k0 + kk) * ld + n0 + (lane & 31)); }
    LDS_WAIT(); asm volatile("" ::: "memory");
    const int c = lane & 7;
#pragma unroll
    for (int j = 0; j < 4; ++j) { const int n = (lane >> 3) + 8 * j; const LAS float* s = scr + (8 * c) * 33 + n;
        v4u o; o.x = pk2(s[0 * 33], s[1 * 33]); o.y = pk2(s[2 * 33], s[3 * 33]); o.z = pk2(s[4 * 33], s[5 * 33]); o.w = pk2(s[6 * 33], s[7 * 33]);
        *(GAS v4u*)(WT + (size_t)(row_off + n0 + n) * K + k0 + 8 * c) = o; }
    LDS_WAIT(); asm volatile("" ::: "memory");
}
__device__ __forceinline__ void p0_convert(const float* __restrict__ src, bf16* __restrict__ dst, long n_iters, int gw, int NGW, int lane) {
    for (long it0 = (long)gw * 4; it0 < n_iters; it0 += (long)NGW * 4) {
        f32x4 a[4][2];
#pragma unroll
        for (int u = 0; u < 4; ++u) { const long it = it0 + u; if (it < n_iters) { const float* p = src + it * 512 + lane * 4; a[u][0] = *(const f32x4*)p; a[u][1] = *(const f32x4*)(p + 256); } }
#pragma unroll
        for (int u = 0; u < 4; ++u) { const long it = it0 + u; if (it < n_iters) { bf16* q = dst + it * 512 + lane * 4;
            u32x2 w0, w1; w0.x = cvtpk(a[u][0].x, a[u][0].y); w0.y = cvtpk(a[u][0].z, a[u][0].w); w1.x = cvtpk(a[u][1].x, a[u][1].y); w1.y = cvtpk(a[u][1].z, a[u][1].w);
            *(u32x2*)q = w0; *(u32x2*)(q + 256) = w1; } }
    }
}

__device__ __forceinline__ void p0_quant_tables(Frame& F, int gw, int NGW) {
    const float* ed = ((const float*)karg(15)); const float* eu = ((const float*)karg(16));
    unsigned char* EDq = (unsigned char*)(((unsigned char*)karg(19)) + WS_ED); unsigned char* EUq = (unsigned char*)(((unsigned char*)karg(19)) + WS_EU); float* EDS = (float*)(((unsigned char*)karg(19)) + WS_EDS);
    const int lane = F.lane;
    for (int row0 = gw * 4; row0 < NEXP; row0 += NGW * 4) {
        f32x4 a[4][4], u[4][4];
#pragma unroll
        for (int q = 0; q < 4; ++q)
#pragma unroll
            for (int j = 0; j < 4; ++j) { a[q][j] = __builtin_nontemporal_load((const f32x4*)(ed + (size_t)(row0 + q) * D) + lane + 64 * j); u[q][j] = __builtin_nontemporal_load((const f32x4*)(eu + (size_t)(row0 + q) * D) + lane + 64 * j); }
#pragma unroll
        for (int q = 0; q < 4; ++q) {
            float am = 0.f;
#pragma unroll
            for (int j = 0; j < 4; ++j) am = fmaxf(fmaxf(am, fmaxf(fabsf(a[q][j].x), fabsf(a[q][j].y))), fmaxf(fabsf(a[q][j].z), fabsf(a[q][j].w)));
            am = wave_max(am);
            const float sc = am > 0.f ? am * (1.0f / 127.0f) : 1.0f, inv = 1.0f / sc;
            v4u qa, qu;
#pragma unroll
            for (int j = 0; j < 4; ++j) {
                const int b0 = (int)rintf(a[q][j].x * inv), b1 = (int)rintf(a[q][j].y * inv), b2 = (int)rintf(a[q][j].z * inv), b3 = (int)rintf(a[q][j].w * inv);
                qa[j] = (unsigned)(b0 & 255) | ((unsigned)(b1 & 255) << 8) | ((unsigned)(b2 & 255) << 16) | ((unsigned)(b3 & 255) << 24);
                int p = __builtin_amdgcn_cvt_pk_fp8_f32(u[q][j].x * 16.0f, u[q][j].y * 16.0f, 0, false);
                p = __builtin_amdgcn_cvt_pk_fp8_f32(u[q][j].z * 16.0f, u[q][j].w * 16.0f, p, true);
                qu[j] = (unsigned)p;
            }
            __builtin_nontemporal_store(qa, (v4u*)(EDq + (size_t)(row0 + q) * D + 16 * lane));
            __builtin_nontemporal_store(qu, (v4u*)(EUq + (size_t)(row0 + q) * D + 16 * lane));
            if (lane == 0) EDS[row0 + q] = sc;
        }
    }
}
__device__ __forceinline__ void p0_prologue(Frame& F) {
    const float* c = ((const float*)karg(1)); const float* w_ada = ((const float*)karg(4)); const float* b_ada = ((const float*)karg(5));
    float* MOD = (float*)(((unsigned char*)karg(19)) + WS_MOD);
    {
        LAS float* cact = (LAS float*)(F.lds);
        LAS float* part = (LAS float*)(F.lds + 16384);
        bool did = false;
        for (int item = F.vcu; item < NMOD / 32; item += F.G) {
            if (!did) { for (int i = F.tid; i < 4096; i += NTHR) { const float cv = c[i]; cact[i] = cv / (1.0f + __expf(-cv)); } did = true; }
            __syncthreads();
            const int n0 = item * 32, col = n0 + (F.lane & 31), ksub = F.lane >> 5;
            float a0 = 0.f, a1 = 0.f, a2 = 0.f, a3 = 0.f;
#pragma unroll 16
            for (int it = 0; it < 64; ++it) { const int k = (it * 8 + F.wave) * 2 + ksub; const float w = __builtin_nontemporal_load(w_ada + (size_t)k * NMOD + col);
                a0 += cact[k] * w; a1 += cact[1024 + k] * w; a2 += cact[2048 + k] * w; a3 += cact[3072 + k] * w; }
            a0 += __shfl_xor(a0, 32); a1 += __shfl_xor(a1, 32); a2 += __shfl_xor(a2, 32); a3 += __shfl_xor(a3, 32);
            if (F.lane < 32) { part[(F.wave * 4 + 0) * 32 + F.lane] = a0; part[(F.wave * 4 + 1) * 32 + F.lane] = a1; part[(F.wave * 4 + 2) * 32 + F.lane] = a2; part[(F.wave * 4 + 3) * 32 + F.lane] = a3; }
            __syncthreads();
            if (F.tid < 128) { const int b = F.tid >> 5, cl = F.tid & 31; float s = 0.f;
#pragma unroll
                for (int w = 0; w < 8; ++w) s += part[(w * 4 + b) * 32 + cl];
                MOD[b * NMOD + n0 + cl] = s + b_ada[n0 + cl]; }
            __syncthreads();
        }
    }
    {
        const int gw = F.vcu * NWAVES + F.wave, NGW = F.G * NWAVES;
        p0_convert(((const float*)karg(14)), (bf16*)(((unsigned char*)karg(19)) + WS_SUBK), (long)(8 * 2 * 128 * 64) / 512, gw, NGW, F.lane);
    }
}
__device__ __forceinline__ void p0_transposes(Frame& F) {
    LAS float* scr = (LAS float*)(F.lds + 32768 + F.wave * 8704);
    const int gw = F.vcu * NWAVES + F.wave, NGW = F.G * NWAVES;
    constexpr int I_IN1 = (D / 64) * (2304 / 32), I_IN2 = (D / 64) * (2048 / 32), I_AB = (512 / 64) * (D / 32), I_SQ = (D / 64) * (D / 32);
    constexpr int NITEMS = I_IN1 + I_IN2 + 2 * I_AB + 2 * I_SQ;
    bf16* Win_t = (bf16*)(((unsigned char*)karg(19)) + WS_WIN);
    for (int it = gw; it < NITEMS; it += NGW) {
        int r = it;
        if (r < I_IN1) { p0_transpose_item(((const float*)karg(6)), LDW_IN, D, 2304, Win_t, 0, scr, r, F.lane); continue; } r -= I_IN1;
        if (r < I_IN2) { p0_transpose_item(((const float*)karg(6)) + 2312, LDW_IN, D, 2048, Win_t, 2304, scr, r, F.lane); continue; } r -= I_IN2;
        if (r < I_AB) { p0_transpose_item(((const float*)karg(9)), D, 512, D, (bf16*)(((unsigned char*)karg(19)) + WS_WA), 0, scr, r, F.lane); continue; } r -= I_AB;
        if (r < I_AB) { p0_transpose_item(((const float*)karg(10)), D, 512, D, (bf16*)(((unsigned char*)karg(19)) + WS_WB), 0, scr, r, F.lane); continue; } r -= I_AB;
        if (r < I_SQ) { p0_transpose_item(((const float*)karg(11)), D, D, D, (bf16*)(((unsigned char*)karg(19)) + WS_WOUT), 0, scr, r, F.lane); continue; } r -= I_SQ;
        p0_transpose_item(((const float*)karg(13)), D, D, D, (bf16*)(((unsigned char*)karg(19)) + WS_WQ), 0, scr, r, F.lane);
    }
}

__device__ __forceinline__ void p1_norm(Frame& F) {
    const float* x = ((const float*)karg(0)); const float* g1 = ((const float*)karg(2)); const float* w_in = ((const float*)karg(6)); const float* b_forget = ((const float*)karg(7));
    const float* MOD = (const float*)(((unsigned char*)karg(19)) + WS_MOD); bf16* H = (bf16*)(((unsigned char*)karg(19)) + WS_H); float* LOGF = (float*)(((unsigned char*)karg(19)) + WS_LOGF);
    LAS float* wfl = (LAS float*)(F.lds);
    { float tmp[16];
#pragma unroll
      for (int n = 0; n < 16; ++n) { const int i = F.tid + n * NTHR; tmp[n] = w_in[(size_t)(i >> 3) * LDW_IN + 2304 + (i & 7)]; }
#pragma unroll
      for (int n = 0; n < 16; ++n) { const int i = F.tid + n * NTHR; wfl[(i & 7) * 1024 + (i >> 3)] = tmp[n]; } }
    __syncthreads();
    const int gw = F.vcu * NWAVES + F.wave, NGW = F.G * NWAVES;
    for (int c = gw; c < M / 8; c += NGW) {
        const int row0 = c * 8; const float* mb = MOD + (row0 >> 12) * NMOD;
        f32x4 ga[4], sh[4];
#pragma unroll
        for (int j = 0; j < 4; ++j) { const int col = 4 * F.lane + 256 * j; const f32x4 g = *(const f32x4*)(g1 + col), sc = *(const f32x4*)(mb + 1024 + col); sh[j] = *(const f32x4*)(mb + col); ga[j] = g * (sc + 1.0f); }
        f32x4 r0[4], r1[4], r2[4];
        { const f32x4* xr = (const f32x4*)(x + (size_t)row0 * D) + F.lane;
#pragma unroll
          for (int j = 0; j < 4; ++j) r0[j] = __builtin_nontemporal_load(xr + 64 * j);
#pragma unroll
          for (int j = 0; j < 4; ++j) r1[j] = __builtin_nontemporal_load(xr + 256 + 64 * j); }
#pragma unroll
        for (int i = 0; i < 8; ++i) {
            const int row = row0 + i;
            if (i + 2 < 8) { const f32x4* xr = (const f32x4*)(x + (size_t)(row + 2) * D) + F.lane;
#pragma unroll
                for (int j = 0; j < 4; ++j) r2[j] = __builtin_nontemporal_load(xr + 64 * j); }
            float ss = 0.f;
#pragma unroll
            for (int j = 0; j < 4; ++j) ss += (r0[j].x * r0[j].x + r0[j].y * r0[j].y) + (r0[j].z * r0[j].z + r0[j].w * r0[j].w);
            ss = wave_sum(ss);
            const float rstd = 1.0f / sqrtf(ss * (1.0f / D) + EPS);
            float fl[8];
#pragma unroll
            for (int jj = 0; jj < 8; ++jj) fl[jj] = 0.f;
#pragma unroll
            for (int j = 0; j < 4; ++j) { const int col = 4 * F.lane + 256 * j;
                const f32x4 hv = (r0[j] * rstd) * ga[j] + sh[j];
                u32x2 w; w.x = cvtpk(hv.x, hv.y); w.y = cvtpk(hv.z, hv.w);
                *(u32x2*)(H + (size_t)row * D + col) = w;
#pragma unroll
                for (int jj = 0; jj < 8; ++jj) { const f32x4 wv = *(const LAS f32x4*)(wfl + jj * 1024 + col); fl[jj] += (hv.x * wv.x + hv.y * wv.y) + (hv.z * wv.z + hv.w * wv.w); }
            }
            const int lane = F.lane; const float r1s = reduce8_t(fl, lane);
            if ((lane & 7) == 0) { const int jj = lane >> 3; const float z = r1s + b_forget[jj]; const float ls = fminf(z, 0.f) - log1pf(__expf(-fabsf(z))); LOGF[(size_t)row * 8 + jj] = ls; }
#pragma unroll
            for (int j = 0; j < 4; ++j) { r0[j] = r1[j]; r1[j] = r2[j]; }
        }
    }
}

constexpr int KP = 72;
constexpr int VPF = 68;
constexpr int VPS = 260;
struct FlashState { f32x16 o[2]; float m, l; };

__device__ __forceinline__ void flash_tail(FlashState& st, f32x16& s0, f32x16& s1, const LAS bf16* Vs, int vp, int r32, int hi) {
    float mt = s0[0];
#pragma unroll
    for (int r = 1; r < 16; ++r) mt = fmaxf(mt, s0[r]);
#pragma unroll
    for (int r = 0; r < 16; ++r) mt = fmaxf(mt, s1[r]);
    mt = fmaxf(mt, __uint_as_float(xorx<32>(__float_as_uint(mt), 32 * hi)));
    const float mn = fmaxf(st.m, mt);
    const float alpha = __expf(st.m - mn);
    st.m = mn;
    float ps = 0.f;
#pragma unroll
    for (int r = 0; r < 16; ++r) { s0[r] = __expf(s0[r] - mn); ps += s0[r]; }
#pragma unroll
    for (int r = 0; r < 16; ++r) { s1[r] = __expf(s1[r] - mn); ps += s1[r]; }
    st.l = st.l * alpha + ps;
    if (__any(alpha != 1.0f)) {
#pragma unroll
        for (int r = 0; r < 16; ++r) { st.o[0][r] *= alpha; st.o[1][r] *= alpha; }
    }
#pragma unroll
    for (int blk = 0; blk < 2; ++blk)
#pragma unroll
        for (int s = 0; s < 2; ++s) {
            v4u pw;
            if (blk == 0) { pw.x = cvtpk(s0[8 * s + 0], s0[8 * s + 1]); pw.y = cvtpk(s0[8 * s + 2], s0[8 * s + 3]); pw.z = cvtpk(s0[8 * s + 4], s0[8 * s + 5]); pw.w = cvtpk(s0[8 * s + 6], s0[8 * s + 7]); }
            else          { pw.x = cvtpk(s1[8 * s + 0], s1[8 * s + 1]); pw.y = cvtpk(s1[8 * s + 2], s1[8 * s + 3]); pw.z = cvtpk(s1[8 * s + 4], s1[8 * s + 5]); pw.w = cvtpk(s1[8 * s + 6], s1[8 * s + 7]); }
            const bf16x8 pf = __builtin_bit_cast(bf16x8, pw);
#pragma unroll
            for (int db = 0; db < 2; ++db) {
                const LAS bf16* vp0 = Vs + (32 * db + r32) * vp + 32 * blk + 16 * s + 4 * hi;
                const s16x4 lo = *(const LAS s16x4*)vp0, hh = *(const LAS s16x4*)(vp0 + 8);
                const bf16x8 vf = __builtin_shufflevector(lo, hh, 0, 1, 2, 3, 4, 5, 6, 7);
                st.o[db] = MFMA32(vf, pf, st.o[db]);
            }
        }
}
__device__ __forceinline__ void flash_qk(f32x16& s0, f32x16& s1, const bf16x8 (&qf)[4], const LAS bf16* Ks, int r32, int hi) {
    s0 = (f32x16){0.f}; s1 = (f32x16){0.f};
#pragma unroll
    for (int r = 0; r < 16; ++r) { s0[r] = 0.f; s1[r] = 0.f; }
#pragma unroll
    for (int ks = 0; ks < 4; ++ks) {
        const bf16x8 a0 = *(const LAS bf16x8*)(Ks + r32 * KP + 16 * ks + 8 * hi);
        const bf16x8 a1 = *(const LAS bf16x8*)(Ks + (32 + r32) * KP + 16 * ks + 8 * hi);
        s0 = MFMA32(a0, qf[ks], s0); s1 = MFMA32(a1, qf[ks], s1);
    }
}
__device__ __forceinline__ void flash_qk2(f32x16& a0, f32x16& a1, f32x16& b0, f32x16& b1, const bf16x8 (&qa)[4], const bf16x8 (&qb)[4], const LAS bf16* Ks, int r32, int hi) {
#pragma unroll
    for (int r = 0; r < 16; ++r) { a0[r] = 0.f; a1[r] = 0.f; b0[r] = 0.f; b1[r] = 0.f; }
#pragma unroll
    for (int ks = 0; ks < 4; ++ks) {
        const bf16x8 k0 = *(const LAS bf16x8*)(Ks + r32 * KP + 16 * ks + 8 * hi);
        const bf16x8 k1 = *(const LAS bf16x8*)(Ks + (32 + r32) * KP + 16 * ks + 8 * hi);
        a0 = MFMA32(k0, qa[ks], a0); b0 = MFMA32(k0, qb[ks], b0); a1 = MFMA32(k1, qa[ks], a1); b1 = MFMA32(k1, qb[ks], b1);
    }
}
__device__ __forceinline__ void flash_soft(FlashState& st, f32x16& s0, f32x16& s1, int hi) {
    float mt = s0[0];
#pragma unroll
    for (int r = 1; r < 16; ++r) mt = fmaxf(mt, s0[r]);
#pragma unroll
    for (int r = 0; r < 16; ++r) mt = fmaxf(mt, s1[r]);
    mt = fmaxf(mt, __uint_as_float(xorx<32>(__float_as_uint(mt), 32 * hi)));
    const float mn = fmaxf(st.m, mt);
    const float alpha = __expf(st.m - mn);
    st.m = mn;
    float ps = 0.f;
#pragma unroll
    for (int r = 0; r < 16; ++r) { s0[r] = __expf(s0[r] - mn); ps += s0[r]; }
#pragma unroll
    for (int r = 0; r < 16; ++r) { s1[r] = __expf(s1[r] - mn); ps += s1[r]; }
    st.l = st.l * alpha + ps;
    if (__any(alpha != 1.0f)) {
#pragma unroll
        for (int r = 0; r < 16; ++r) { st.o[0][r] *= alpha; st.o[1][r] *= alpha; }
    }
}
__device__ __forceinline__ bf16x8 pack_p(const f32x16& p, int s) {
    v4u pw; pw.x = cvtpk(p[8 * s + 0], p[8 * s + 1]); pw.y = cvtpk(p[8 * s + 2], p[8 * s + 3]); pw.z = cvtpk(p[8 * s + 4], p[8 * s + 5]); pw.w = cvtpk(p[8 * s + 6], p[8 * s + 7]);
    return __builtin_bit_cast(bf16x8, pw);
}
__device__ __forceinline__ void flash_pv2(FlashState& sa, FlashState& sb, const f32x16& a0, const f32x16& a1, const f32x16& b0, const f32x16& b1, const LAS bf16* Vs, int vp, int r32, int hi) {
#pragma unroll
    for (int blk = 0; blk < 2; ++blk)
#pragma unroll
        for (int s = 0; s < 2; ++s) {
            const bf16x8 pfa = blk ? pack_p(a1, s) : pack_p(a0, s), pfb = blk ? pack_p(b1, s) : pack_p(b0, s);
#pragma unroll
            for (int db = 0; db < 2; ++db) {
                const LAS bf16* vp0 = Vs + (32 * db + r32) * vp + 32 * blk + 16 * s + 4 * hi;
                const s16x4 lo = *(const LAS s16x4*)vp0, hh = *(const LAS s16x4*)(vp0 + 8);
                const bf16x8 vf = __builtin_shufflevector(lo, hh, 0, 1, 2, 3, 4, 5, 6, 7);
                sa.o[db] = MFMA32(vf, pfa, sa.o[db]); sb.o[db] = MFMA32(vf, pfb, sb.o[db]);
            }
        }
}
__device__ __forceinline__ void flash_store(const FlashState& st, bf16* orow, int hi) {
    float lt = st.l + __uint_as_float(xorx<32>(__float_as_uint(st.l), 32 * hi));
    const float inv = 1.0f / lt;
#pragma unroll
    for (int db = 0; db < 2; ++db)
#pragma unroll
        for (int rg = 0; rg < 4; ++rg) { u32x2 w; w.x = cvtpk(st.o[db][4 * rg] * inv, st.o[db][4 * rg + 1] * inv); w.y = cvtpk(st.o[db][4 * rg + 2] * inv, st.o[db][4 * rg + 3] * inv);
            *(u32x2*)(orow + 32 * db + 8 * rg + 4 * hi) = w; }
}

__device__ __forceinline__ void fox_unit(Frame& F, int b, int h, int qb, float& kmax2) {
    const bf16* proj = (const bf16*)(((unsigned char*)karg(19)) + WS_PROJ); const float* LOGF = (const float*)(((unsigned char*)karg(19)) + WS_LOGF); bf16* OB = (bf16*)(((unsigned char*)karg(19)) + WS_OB);
    LAS float* Fs = (LAS float*)(F.lds);
    LAS float* wtot = (LAS float*)(F.lds + 16384);
    LAS bf16* Kb = (LAS bf16*)(F.lds + 16384 + 128);
    LAS bf16* Vb = (LAS bf16*)(F.lds + 16384 + 128 + 2 * 64 * KP * 2);
    const int lane = F.lane, wave = F.wave, tid = F.tid, r32 = lane & 31, hi = lane >> 5;
    const int q_end = 512 * (qb + 1), NT = q_end / 64;
    const size_t rowbase = (size_t)b * SEQ;
    if (kmax2 < 0.f) {
        float v[8]; float run = 0.f;
#pragma unroll
        for (int i = 0; i < 8; ++i) { const int pos = tid * 8 + i; const float lf = (pos < q_end) ? LOGF[(rowbase + pos) * 8 + h] : 0.f; run += lf; v[i] = run; }
        float inc = run;
#pragma unroll
        for (int o = 1; o < 64; o <<= 1) { const float t = __shfl_up(inc, o); if (lane >= o) inc += t; }
        if (lane == 63) wtot[wave] = inc;
        __syncthreads();
        float off = inc - run;
        for (int w = 0; w < wave; ++w) off += wtot[w];
#pragma unroll
        for (int i = 0; i < 8; ++i) Fs[tid * 8 + i] = v[i] + off;
    }
    const int qrow = 512 * qb + 64 * wave + r32, qrowB = qrow + 32;
    bf16x8 qf[4], qg[4];
    { const bf16* qp = proj + (rowbase + qrow) * NPROJ + C_QB + 64 * h + 8 * hi;
#pragma unroll
      for (int ks = 0; ks < 4; ++ks) { qf[ks] = *(const bf16x8*)(qp + 16 * ks); qg[ks] = *(const bf16x8*)(qp + (size_t)32 * NPROJ + 16 * ks); } }
    const int tq = 8 * qb + wave;
    LAS bf16* Qs = (LAS bf16*)(F.lds + 53248) + wave * (64 * KP);
    {
        float qn = 0.f;
#pragma unroll
        for (int ks = 0; ks < 4; ++ks)
#pragma unroll
            for (int j = 0; j < 8; ++j) { const float e = __uint_as_float(((unsigned)(unsigned short)qf[ks][j]) << 16); qn += e * e; }
        qn += __shfl_xor(qn, 32);
        { float qn2 = 0.f;
#pragma unroll
          for (int ks = 0; ks < 4; ++ks)
#pragma unroll
              for (int j = 0; j < 8; ++j) { const float e = __uint_as_float(((unsigned)(unsigned short)qg[ks][j]) << 16); qn2 += e * e; }
          qn2 += __shfl_xor(qn2, 32); qn = fmaxf(qn, qn2); }
#pragma unroll
        for (int o = 1; o < 32; o <<= 1) qn = fmaxf(qn, __shfl_xor(qn, o));
        float kn = 0.f;
        if (kmax2 < 0.f) {
            for (int p0 = 0; p0 < q_end; p0 += 4 * 64) {
                v4u w4[4];
#pragma unroll
                for (int i = 0; i < 4; ++i) w4[i] = *(const v4u*)(proj + (rowbase + p0 + 64 * i + (tid >> 3)) * NPROJ + C_KB + 64 * h + 8 * (tid & 7));
#pragma unroll
                for (int i = 0; i < 4; ++i) { const unsigned wx = w4[i].x, wy = w4[i].y, wz = w4[i].z, ww = w4[i].w;
                    float s = bflo(wx) * bflo(wx) + bfhi(wx) * bfhi(wx) + bflo(wy) * bflo(wy) + bfhi(wy) * bfhi(wy) + bflo(wz) * bflo(wz) + bfhi(wz) * bfhi(wz) + bflo(ww) * bflo(ww) + bfhi(ww) * bfhi(ww);
                    s += __shfl_xor(s, 1); s += __shfl_xor(s, 2); s += __shfl_xor(s, 4);
                    kn = fmaxf(kn, s); } }
            kn = wave_max(kn);
        }
        if (lane == 0) { wtot[8 + wave] = qn; wtot[16 + wave] = kn; }
    }
#pragma unroll
    for (int ks = 0; ks < 4; ++ks) { *(LAS bf16x8*)(Qs + r32 * KP + 16 * ks + 8 * hi) = qf[ks]; *(LAS bf16x8*)(Qs + (32 + r32) * KP + 16 * ks + 8 * hi) = qg[ks]; }
    FlashState st, su; st.m = -INFINITY; st.l = 0.f; su.m = -INFINITY; su.l = 0.f;
#pragma unroll
    for (int r = 0; r < 16; ++r) { st.o[0][r] = 0.f; st.o[1][r] = 0.f; su.o[0][r] = 0.f; su.o[1][r] = 0.f; }
    const int srow = tid >> 3, sch = tid & 7;
    const bf16* kg = proj + (rowbase + srow) * NPROJ + C_KB + 64 * h + 8 * sch;
    const bf16* vg = proj + (rowbase + srow) * NPROJ + C_VB + 64 * h + 8 * sch;
    v4u kreg, vreg;
    { const size_t o = (size_t)(NT - 1) * 64 * NPROJ; kreg = *(const v4u*)(kg + o); vreg = *(const v4u*)(vg + o); }
    int cur = 0;
    {   *(LAS v4u*)(Kb + srow * KP + 8 * sch) = kreg;
        const unsigned short* vs = (const unsigned short*)&vreg;
#pragma unroll
        for (int i = 0; i < 8; ++i) Vb[(8 * sch + i) * VPF + srow] = vs[i];
    }
    __syncthreads();
    const float fq = Fs[qrow], fqB = Fs[qrowB];
    int t_lo = 0;
    {
        float qm = 0.f, km = 0.f;
#pragma unroll
        for (int w = 0; w < 8; ++w) { qm = fmaxf(qm, wtot[8 + w]); km = fmaxf(km, wtot[16 + w]); }
        if (kmax2 < 0.f) kmax2 = km;
        const float A = 0.125f * sqrtf(qm) * sqrtf(kmax2) * 1.01f, f0 = Fs[512 * qb];
        for (int t = NT - 9; t >= 0; --t) if (Fs[64 * t + 63] - f0 > 2.0f * A + 60.0f) { t_lo = t + 1; break; }
    }
    for (int t = NT - 1; t >= t_lo; --t) {
        if (t > t_lo) { const size_t o = (size_t)(t - 1) * 64 * NPROJ; kreg = *(const v4u*)(kg + o); vreg = *(const v4u*)(vg + o); }
        if (t <= tq) {
            const LAS bf16* Ks = Kb + cur * 64 * KP; const LAS bf16* Vs = Vb + cur * 64 * VPF;
            bf16x8 qa[4], qb4[4];
#pragma unroll
            for (int ks = 0; ks < 4; ++ks) { qa[ks] = *(const LAS bf16x8*)(Qs + r32 * KP + 16 * ks + 8 * hi); qb4[ks] = *(const LAS bf16x8*)(Qs + (32 + r32) * KP + 16 * ks + 8 * hi); }
            f32x16 s0, s1, u0, u1; flash_qk2(s0, s1, u0, u1, qa, qb4, Ks, r32, hi);
            const LAS float* Fk = Fs + 64 * t;
            const bool diag = (t == tq);
#pragma unroll
            for (int rg = 0; rg < 4; ++rg) {
                const f32x4 f0 = *(const LAS f32x4*)(Fk + 8 * rg + 4 * hi), f1 = *(const LAS f32x4*)(Fk + 32 + 8 * rg + 4 * hi);
#pragma unroll
                for (int i = 0; i < 4; ++i) { const int r = 4 * rg + i; const int kv = 64 * t + 8 * rg + 4 * hi + i;
                    float a = s0[r] * 0.125f + (fq - f0[i]), c = s1[r] * 0.125f + (fq - f1[i]), d = u0[r] * 0.125f + (fqB - f0[i]), e = u1[r] * 0.125f + (fqB - f1[i]);
                    if (diag) { if (kv > qrow) a = -INFINITY; if (kv + 32 > qrow) c = -INFINITY; if (kv > qrowB) d = -INFINITY; if (kv + 32 > qrowB) e = -INFINITY; }
                    s0[r] = a; s1[r] = c; u0[r] = d; u1[r] = e; }
            }
            flash_soft(st, s0, s1, hi); flash_soft(su, u0, u1, hi);
            flash_pv2(st, su, s0, s1, u0, u1, Vs, VPF, r32, hi);
        }
        if (t > t_lo) {
            const int nb = cur ^ 1;
            *(LAS v4u*)(Kb + nb * 64 * KP + srow * KP + 8 * sch) = kreg;
            const unsigned short* vs = (const unsigned short*)&vreg;
#pragma unroll
            for (int i = 0; i < 8; ++i) Vb[nb * 64 * VPF + (8 * sch + i) * VPF + srow] = vs[i];
        }
        __syncthreads();
        cur ^= 1;
    }
    flash_store(st, OB + (rowbase + qrow) * 512 + 64 * h, hi); flash_store(su, OB + (rowbase + qrowB) * 512 + 64 * h, hi);
    __syncthreads();
}

__device__ const unsigned char T5_BUCKET[128] = {0,1,2,3,4,5,6,7,8,9,10,11,12,13,14,15,16,16,16,17,17,18,18,18,19,19,19,20,20,20,20,21,21,21,21,22,22,22,22,22,23,23,23,23,23,23,24,24,24,24,24,24,25,25,25,25,25,25,25,26,26,26,26,26,26,26,26,27,27,27,27,27,27,27,27,27,27,28,28,28,28,28,28,28,28,28,28,29,29,29,29,29,29,29,29,29,29,29,29,30,30,30,30,30,30,30,30,30,30,30,30,30,30,31,31,31,31,31,31,31,31,31,31,31,31,31,31,31};

__device__ __forceinline__ void swa_unit(Frame& F, int b, int kvh, int n) {
    const bf16* proj = (const bf16*)(((unsigned char*)karg(19)) + WS_PROJ); bf16* OA = (bf16*)(((unsigned char*)karg(19)) + WS_OA);
    const float* sinks = ((const float*)karg(8)); const float* rel_bias = ((const float*)karg(12));
    LAS bf16* Kb = (LAS bf16*)(F.lds);
    LAS bf16* Vb = (LAS bf16*)(F.lds + 36864);
    LAS float* bt = (LAS float*)(F.lds + 36864 + 33280);
    const int lane = F.lane, wave = F.wave, tid = F.tid, r32 = lane & 31, hi = lane >> 5;
    const size_t rowbase = (size_t)b * SEQ;
    {
        const int g = tid >> 7, d = tid & 127;
        bt[tid] = rel_bias[(int)T5_BUCKET[d] * 8 + kvh * 4 + g];
#pragma unroll
        for (int i = 0; i < 4; ++i) {
            const int idx = tid + i * NTHR, kb = idx >> 3, sch = idx & 7; const int pos = 128 * (n - 1) + kb;
            v4u kreg = (v4u){0u, 0u, 0u, 0u}, vreg = (v4u){0u, 0u, 0u, 0u};
            if (pos >= 0) { const bf16* p = proj + (rowbase + pos) * NPROJ + 64 * kvh + 8 * sch; kreg = *(const v4u*)(p + C_KA); vreg = *(const v4u*)(p + C_VA); }
            *(LAS v4u*)(Kb + kb * KP + 8 * sch) = kreg;
            const unsigned short* vs = (const unsigned short*)&vreg;
#pragma unroll
            for (int j = 0; j < 8; ++j) Vb[(8 * sch + j) * VPS + kb] = vs[j];
        }
    }
    __syncthreads();
    const int g = wave & 3, qh = wave >> 2, head = kvh * 4 + g;
    const LAS float* btg = bt + g * 128;
    for (int sb = 0; sb < 2; ++sb) {
        const int qrel0 = 64 * qh + 32 * sb, qrel = qrel0 + r32;
        const size_t row = rowbase + 128 * n + qrel;
        bf16x8 qf[4];
        { const bf16* qp = proj + row * NPROJ + C_QA + 64 * head + 8 * hi;
#pragma unroll
          for (int ks = 0; ks < 4; ++ks) qf[ks] = *(const bf16x8*)(qp + 16 * ks); }
        FlashState st; st.m = sinks[head]; st.l = (hi == 0) ? 1.0f : 0.0f;
#pragma unroll
        for (int r = 0; r < 16; ++r) { st.o[0][r] = 0.f; st.o[1][r] = 0.f; }
        const int t_lo = (qrel0 + 1) >> 6, t_hi = (qrel0 + 159) >> 6;
        for (int t = t_lo; t <= t_hi; ++t) {
            f32x16 s0, s1; flash_qk(s0, s1, qf, Kb + t * 64 * KP, r32, hi);
#pragma unroll
            for (int r = 0; r < 16; ++r) {
                const int kb0 = 64 * t + crow(r, hi), kb1 = kb0 + 32;
                const int d0 = 128 + qrel - kb0, d1 = d0 - 32;
                const bool v0 = (d0 >= 0) && (d0 < 128) && (n > 0 || kb0 >= 128);
                const bool v1 = (d1 >= 0) && (d1 < 128) && (n > 0 || kb1 >= 128);
                const float b0 = btg[d0 & 127], b1 = btg[d1 & 127];
                s0[r] = v0 ? (s0[r] * 0.125f + b0) : -INFINITY;
                s1[r] = v1 ? (s1[r] * 0.125f + b1) : -INFINITY;
            }
            flash_tail(st, s0, s1, Vb + 64 * t, VPS, r32, hi);
        }
        flash_store(st, OA + row * 512 + 64 * head, hi);
    }
    __syncthreads();
}
__device__ __forceinline__ void p3_attention(Frame& F) {
    for (int item = F.vcu; item < 256; item += F.G) {
        swa_unit(F, item >> 6, (item >> 5) & 1, item & 31);
        const int bh = item >> 3, j = item & 7;
        float kmax2 = -1.0f;
        fox_unit(F, bh >> 3, bh & 7, j, kmax2);
    }
}

struct PairOrder {
    pg8::StaticOrder S;
    __device__ bool next(int i, pg8::Unit& u) const { if (!S.next(i >> 1, u)) return false; u.src = i & 1; return true; }
    __device__ __forceinline__ void a_ready(const pg8::Unit&) const {}
    __device__ __forceinline__ void done(const pg8::Unit&) const {}
};
__device__ __forceinline__ float sigmoidf_(float z) { return 1.0f / (1.0f + __expf(-z)); }
struct EpiGate {
    static constexpr bool PERM = true, AFTER_DRAIN = false, CHAIN = true;
    const bf16* proj; bf16* mixed;
    __device__ __forceinline__ void operator()(pg8::f32x4 (&acc)[2][2][4][2], const pg8::Unit& u, int wr, int wc, int fr, int fq) const {
#pragma unroll
        for (int ai = 0; ai < 2; ++ai) {
            v4u gbv[4][2], gav[4][2];
#pragma unroll
            for (int m = 0; m < 4; ++m) { const size_t row = (size_t)u.pm * 256 + ai * 128 + wr * 64 + m * 16 + fr;
#pragma unroll
                for (int bj = 0; bj < 2; ++bj) { const int col0 = u.pn * 256 + bj * 128 + wc * 32 + 8 * fq;
                    gbv[m][bj] = *(const v4u*)(proj + row * NPROJ + C_GLB + col0);
                    if (u.src == 0) gav[m][bj] = __builtin_nontemporal_load((const v4u*)(proj + row * NPROJ + C_GLA + col0)); } }
#pragma unroll
            for (int m = 0; m < 4; ++m) { const size_t row = (size_t)u.pm * 256 + ai * 128 + wr * 64 + m * 16 + fr;
#pragma unroll
                for (int bj = 0; bj < 2; ++bj) { const int col0 = u.pn * 256 + bj * 128 + wc * 32 + 8 * fq;
                    const unsigned gbw[4] = {gbv[m][bj].x, gbv[m][bj].y, gbv[m][bj].z, gbv[m][bj].w};
                    if (u.src == 0) {
                        const unsigned gaw[4] = {gav[m][bj].x, gav[m][bj].y, gav[m][bj].z, gav[m][bj].w};
#pragma unroll
                        for (int e = 0; e < 8; ++e) { const float za = (e & 1) ? bfhi(gaw[e >> 1]) : bflo(gaw[e >> 1]), zb = (e & 1) ? bfhi(gbw[e >> 1]) : bflo(gbw[e >> 1]);
                            const float ratio = (1.0f + __expf(-zb)) * __builtin_amdgcn_rcpf(1.0f + __expf(-za));
                            acc[ai][bj][m][e >> 2][e & 3] *= ratio; }
                    } else {
                        float v[8];
#pragma unroll
                        for (int e = 0; e < 8; ++e) { const float zb = (e & 1) ? bfhi(gbw[e >> 1]) : bflo(gbw[e >> 1]); v[e] = acc[ai][bj][m][e >> 2][e & 3] * __builtin_amdgcn_rcpf(1.0f + __expf(-zb)); }
                        v4u w; w.x = cvtpk(v[0], v[1]); w.y = cvtpk(v[2], v[3]); w.z = cvtpk(v[4], v[5]); w.w = cvtpk(v[6], v[7]);
                        *(v4u*)(mixed + row * D + col0) = w;
                    }
                }
            }
        }
    }
};
struct EpiRes {
    static constexpr bool PERM = true, AFTER_DRAIN = false, CHAIN = false;
    const float* x; const float* mod; float* x1;
    __device__ __forceinline__ void operator()(const pg8::f32x4 (&acc)[2][2][4][2], const pg8::Unit& u, int wr, int wc, int fr, int fq) const {
        const int b = (u.pm * 256) >> 12;
        pg8::f32x4 gt[2][2];
#pragma unroll
        for (int bj = 0; bj < 2; ++bj)
#pragma unroll
            for (int n = 0; n < 2; ++n) gt[bj][n] = *(const pg8::f32x4*)(mod + b * NMOD + 2048 + u.pn * 256 + bj * 128 + wc * 32 + 8 * fq + 4 * n);
#pragma unroll
        for (int ai = 0; ai < 2; ++ai) {
            pg8::f32x4 xin[4][2][2];
#pragma unroll
            for (int m = 0; m < 4; ++m) { const size_t row = (size_t)u.pm * 256 + ai * 128 + wr * 64 + m * 16 + fr;
#pragma unroll
                for (int bj = 0; bj < 2; ++bj)
#pragma unroll
                    for (int n = 0; n < 2; ++n) xin[m][bj][n] = __builtin_nontemporal_load((const pg8::f32x4*)(x + row * D + u.pn * 256 + bj * 128 + wc * 32 + 8 * fq + 4 * n)); }
#pragma unroll
            for (int m = 0; m < 4; ++m) { const size_t row = (size_t)u.pm * 256 + ai * 128 + wr * 64 + m * 16 + fr;
#pragma unroll
                for (int bj = 0; bj < 2; ++bj)
#pragma unroll
                    for (int n = 0; n < 2; ++n) *(pg8::f32x4*)(x1 + row * D + u.pn * 256 + bj * 128 + wc * 32 + 8 * fq + 4 * n) = xin[m][bj][n] + gt[bj][n] * acc[ai][bj][m][n]; }
        }
    }
};

__device__ __forceinline__ void p6_norm2(Frame& F) {
    const float* x1 = (const float*)(((unsigned char*)karg(19)) + WS_X1); const float* g2 = ((const float*)karg(3)); const float* MOD = (const float*)(((unsigned char*)karg(19)) + WS_MOD); bf16* H2 = (bf16*)(((unsigned char*)karg(19)) + WS_H2); unsigned char* H2Q = (unsigned char*)(((unsigned char*)karg(19)) + WS_H2Q); float* H2S = (float*)(((unsigned char*)karg(19)) + WS_H2S);
    const int gw = F.vcu * NWAVES + F.wave, NGW = F.G * NWAVES;
    for (int c = gw; c < M / 8; c += NGW) {
        const int row0 = c * 8; const float* mb = MOD + (row0 >> 12) * NMOD;
        f32x4 ga[4], sh[4];
#pragma unroll
        for (int j = 0; j < 4; ++j) { const int col = 4 * F.lane + 256 * j; const f32x4 g = *(const f32x4*)(g2 + col), sc = *(const f32x4*)(mb + 4096 + col); sh[j] = *(const f32x4*)(mb + 3072 + col); ga[j] = g * (sc + 1.0f); }
        f32x4 r0[4], r1[4], r2[4];
        { const f32x4* xr = (const f32x4*)(x1 + (size_t)row0 * D) + F.lane;
#pragma unroll
          for (int j = 0; j < 4; ++j) r0[j] = xr[64 * j];
#pragma unroll
          for (int j = 0; j < 4; ++j) r1[j] = xr[256 + 64 * j]; }
#pragma unroll
        for (int i = 0; i < 8; ++i) {
            const int row = row0 + i;
            if (i + 2 < 8) { const f32x4* xr = (const f32x4*)(x1 + (size_t)(row + 2) * D) + F.lane;
#pragma unroll
                for (int j = 0; j < 4; ++j) r2[j] = xr[64 * j]; }
            f32x4 hq[4]; float ss = 0.f;
#pragma unroll
            for (int j = 0; j < 4; ++j) ss += (r0[j].x * r0[j].x + r0[j].y * r0[j].y) + (r0[j].z * r0[j].z + r0[j].w * r0[j].w);
            ss = wave_sum(ss);
            const float rstd = 1.0f / sqrtf(ss * (1.0f / D) + EPS);
#pragma unroll
            for (int j = 0; j < 4; ++j) { const int col = 4 * F.lane + 256 * j;
                const f32x4 hv = (r0[j] * rstd) * ga[j] + sh[j];
                u32x2 w; w.x = cvtpk(hv.x, hv.y); w.y = cvtpk(hv.z, hv.w);
                *(u32x2*)(H2 + (size_t)row * D + col) = w; hq[j] = hv; }
            float am = 0.f;
#pragma unroll
            for (int j = 0; j < 4; ++j) am = fmaxf(fmaxf(am, fmaxf(fabsf(hq[j].x), fabsf(hq[j].y))), fmaxf(fabsf(hq[j].z), fabsf(hq[j].w)));
            am = wave_max(am);
            const float sc = am > 0.f ? am * (1.0f / 127.0f) : 1.0f, inv = 1.0f / sc;
            v4u qa;
#pragma unroll
            for (int j = 0; j < 4; ++j) { const int b0 = (int)rintf(hq[j].x * inv), b1 = (int)rintf(hq[j].y * inv), b2 = (int)rintf(hq[j].z * inv), b3 = (int)rintf(hq[j].w * inv);
                qa[j] = (unsigned)(b0 & 255) | ((unsigned)(b1 & 255) << 8) | ((unsigned)(b2 & 255) << 16) | ((unsigned)(b3 & 255) << 24); }
            __builtin_nontemporal_store(qa, (v4u*)(H2Q + (size_t)row * D + 16 * F.lane));
            if (F.lane == 0) H2S[row] = sc;
#pragma unroll
            for (int j = 0; j < 4; ++j) { r0[j] = r1[j]; r1[j] = r2[j]; }
        }
    }
}

__device__ __forceinline__ unsigned f2ord(float f) { const unsigned u = __float_as_uint(f); return u ^ ((unsigned)((int)u >> 31) | 0x80000000u); }
__device__ __forceinline__ float ord2f(unsigned o) { const unsigned u = (o & 0x80000000u) ? (o & 0x7fffffffu) : ~o; return __uint_as_float(u); }
#define CE_DESC(a, b) do { const unsigned _x = (a), _y = (b); (a) = _x > _y ? _x : _y; (b) = _x > _y ? _y : _x; } while (0)
__device__ __forceinline__ void sort16(unsigned (&k)[16]) {
#pragma unroll
    for (int size = 2; size <= 16; size <<= 1)
#pragma unroll
        for (int stride = size >> 1; stride > 0; stride >>= 1)
#pragma unroll
            for (int i = 0; i < 16; ++i) { const int j = i ^ stride; if (j > i) { if ((i & size) == 0) CE_DESC(k[i], k[j]); else CE_DESC(k[j], k[i]); } }
}
__device__ __forceinline__ void merge16(unsigned (&a)[16], const unsigned (&b)[16]) {
#pragma unroll
    for (int i = 0; i < 16; ++i) a[i] = a[i] > b[15 - i] ? a[i] : b[15 - i];
#pragma unroll
    for (int stride = 8; stride > 0; stride >>= 1)
#pragma unroll
        for (int i = 0; i < 16; ++i) { const int j = i ^ stride; if (j > i) CE_DESC(a[i], a[j]); }
}
__device__ __forceinline__ void top16_of_64(unsigned (&g0)[16], unsigned (&g1)[16], unsigned (&g2)[16], unsigned (&g3)[16]) {
    sort16(g0); sort16(g1); sort16(g2); sort16(g3);
    merge16(g0, g1); merge16(g2, g3); merge16(g0, g2);
}
constexpr int NCAND = 50;
__device__ __forceinline__ void p8a_topk(Frame& F) {
    const bf16* QP = (const bf16*)(((unsigned char*)karg(19)) + WS_QP); const bf16* SUBK = (const bf16*)(((unsigned char*)karg(19)) + WS_SUBK);
    unsigned short* PIDX = (unsigned short*)(((unsigned char*)karg(19)) + WS_PIDX); float* PG = (float*)(((unsigned char*)karg(19)) + WS_PG);
    LAS unsigned short* Elds = (LAS unsigned short*)(F.lds) + F.wave * (NCAND * 64);
    const int lane = F.lane, r32 = lane & 31, hi = lane >> 5;
    const int gw = F.vcu * NWAVES + F.wave, NGW = F.G * NWAVES;
    for (int it2 = 0; it2 < 2 * ((M / 64 - F.vcu + F.G - 1) / F.G); ++it2) {
        const int wi = F.vcu + (it2 >> 1) * F.G;
        const int tile = 2 * wi + (it2 & 1);
        const int tok = tile * 32 + r32;
        { const int h = F.wave;
            unsigned top[2][16];
#pragma unroll
            for (int p = 0; p < 2; ++p) {
                bf16x8 qf[4];
                { const bf16* qp = QP + (size_t)tok * D + h * 128 + p * 64 + 8 * hi;
#pragma unroll
                  for (int ks = 0; ks < 4; ++ks) qf[ks] = *(const bf16x8*)(qp + 16 * ks); }
                const bf16* kp = SUBK + (size_t)((h * 2 + p) * 128 + r32) * 64 + 8 * hi;
                unsigned kk[4][16];
#pragma unroll
                for (int blk = 0; blk < 4; ++blk) {
                    f32x16 acc;
#pragma unroll
                    for (int r = 0; r < 16; ++r) acc[r] = 0.f;
#pragma unroll
                    for (int ks = 0; ks < 4; ++ks) { const bf16x8 a = *(const bf16x8*)(kp + (size_t)blk * 32 * 64 + 16 * ks); acc = MFMA32(a, qf[ks], acc); }
#pragma unroll
                    for (int r = 0; r < 16; ++r) { const int key = 32 * blk + crow(r, hi); kk[blk][r] = (f2ord(acc[r]) & ~127u) | (unsigned)(127 - key); }
                }
                top16_of_64(kk[0], kk[1], kk[2], kk[3]);
                unsigned other[16];
#pragma unroll
                for (int i = 0; i < 16; ++i) other[i] = xorx<32>(kk[0][i], lane);
                merge16(kk[0], other);
#pragma unroll
                for (int i = 0; i < 16; ++i) top[p][i] = kk[0][i];
            }
            float s1[16], s2[16]; unsigned i1[16], i2[16];
#pragma unroll
            for (int i = 0; i < 16; ++i) { s1[i] = ord2f(top[0][i] & ~127u); i1[i] = 127u - (top[0][i] & 127u); s2[i] = ord2f(top[1][i] & ~127u); i2[i] = 127u - (top[1][i] & 127u); }
            unsigned ck[4][16];
#pragma unroll
            for (int c = 0; c < 64; ++c) {
                if (c < NCAND) { constexpr int CA[NCAND] = {0,0,0,0,0,0,0,0,0,0,0,0,0,0,0,0,1,1,1,1,1,1,1,1,2,2,2,2,2,3,3,3,3,4,4,4,5,5,6,6,7,7,8,9,10,11,12,13,14,15}; constexpr int CB[NCAND] = {0,1,2,3,4,5,6,7,8,9,10,11,12,13,14,15,0,1,2,3,4,5,6,7,0,1,2,3,4,0,1,2,3,0,1,2,0,1,0,1,0,1,0,0,0,0,0,0,0,0}; const int a = CA[c], b = CB[c];
                    ck[c >> 4][c & 15] = (f2ord(s1[a] + s2[b]) & ~63u) | (unsigned)(63 - c);
                    Elds[c * 64 + lane] = (unsigned short)(i1[a] * 128u + i2[b]); }
                else ck[c >> 4][c & 15] = 0u;
            }
            top16_of_64(ck[0], ck[1], ck[2], ck[3]);
            float w[16]; float wsum = 0.f; const float v0 = ord2f(ck[0][0] & ~63u);
#pragma unroll
            for (int r = 0; r < 16; ++r) { w[r] = __expf(ord2f(ck[0][r] & ~63u) - v0); wsum += w[r]; }
            const float winv = 1.0f / wsum;
#pragma unroll
            for (int r = 0; r < 16; ++r) if ((r >> 3) == hi) {
                const int c = 63 - (int)(ck[0][r] & 63u);
                const unsigned short eid = Elds[c * 64 + lane];
                PIDX[(size_t)tok * 128 + h * 16 + r] = eid; PG[(size_t)tok * 128 + h * 16 + r] = w[r] * winv; }
        }
    }
}

__device__ __forceinline__ float gelu_erf(float v) { return 0.5f * v * (1.0f + erff(v * 0.70710678118654752f)); }

#define PROBE_REPA 1
#define PROBE_REPB 1
constexpr int NR = 8, RSH = 18, BSA = 8, BSB = 8, ELP = 136, TPS = 8; static_assert(BSA == 8 && BSB == 8, "whole batches of 8");
__device__ __forceinline__ void sort128(unsigned& e0, unsigned& e1, int lane) {
#pragma unroll
    for (int size = 2; size <= 128; size <<= 1) {
#pragma unroll
        for (int stride = size >> 1; stride > 0; stride >>= 1) {
            if (stride == 64) { const unsigned lo = e0 < e1 ? e0 : e1, hi = e0 < e1 ? e1 : e0; e0 = lo; e1 = hi; }
            else {
                const bool lower = (lane & stride) == 0;
                const bool asc0 = (size == 128) ? true : (size == 64 ? true : ((lane & size) == 0));
                const bool asc1 = (size == 128) ? true : (size == 64 ? false : ((lane & size) == 0));
                const unsigned p0 = xorx_sw(e0, lane, stride), p1 = xorx_sw(e1, lane, stride);
                const unsigned mn0 = e0 < p0 ? e0 : p0, mx0 = e0 < p0 ? p0 : e0, mn1 = e1 < p1 ? e1 : p1, mx1 = e1 < p1 ? p1 : e1;
                e0 = (lower == asc0) ? mn0 : mx0; e1 = (lower == asc1) ? mn1 : mx1;
            }
        }
    }
}
template <int BS> __device__ __forceinline__ void sw_issue(v4u (&buf)[BS], const LAS unsigned* el, const unsigned char* tab, unsigned voff) {
#pragma unroll
    for (int i = 0; i < BS; ++i) { const unsigned off = (el[i] << 10) + voff;
        buf[i] = *(const v4u*)(tab + off); }
}
template <int BS> __device__ __forceinline__ void sw_proc_a(const v4u (&buf)[BS], const v4u& hq, LAS float* wl, int s, int n, int lane) {
    const int hx = (int)hq.x, hy = (int)hq.y, hz = (int)hq.z, hw = (int)hq.w;
    float dd[8];
#pragma unroll
    for (int i = 0; i < 8; ++i) dd[i] = 0.f;
#pragma unroll
    for (int i = 0; i < BS; ++i) if (i < n) { const int dx = (int)buf[i].x, dy = (int)buf[i].y, dz = (int)buf[i].z, dw = (int)buf[i].w;
        int t = __builtin_amdgcn_sdot4(hx, dx, 0, false); t = __builtin_amdgcn_sdot4(hy, dy, t, false); t = __builtin_amdgcn_sdot4(hz, dz, t, false); t = __builtin_amdgcn_sdot4(hw, dw, t, false);
        dd[i] = (float)t; }
    const float r1 = reduce8_t(dd, lane);
    if ((lane & 7) == 0 && (lane >> 3) < n) wl[s + (lane >> 3)] = r1;
}
typedef _Float16 h2_t __attribute__((ext_vector_type(2)));
#define CVT_H2_FP8(u, hi) __builtin_bit_cast(h2_t, __builtin_amdgcn_cvt_scalef32_pk_f16_fp8((u), 1.0f, (hi)))
template <int BS> __device__ __forceinline__ void sw_proc_b(const v4u (&buf)[BS], h2_t (&acc)[8], const LAS float* wl, int s, int n) {
    float wr[BS];
#pragma unroll
    for (int i = 0; i < BS; ++i) wr[i] = wl[s + i];
#pragma unroll
    for (int i = 0; i < BS; ++i) if (i < n) {
        const h2_t wv = __builtin_bit_cast(h2_t, wr[i]);
        const unsigned ux = buf[i].x, uy = buf[i].y, uz = buf[i].z, uw = buf[i].w;
        acc[0] = __builtin_elementwise_fma(CVT_H2_FP8(ux, false), wv, acc[0]); acc[1] = __builtin_elementwise_fma(CVT_H2_FP8(ux, true), wv, acc[1]);
        acc[2] = __builtin_elementwise_fma(CVT_H2_FP8(uy, false), wv, acc[2]); acc[3] = __builtin_elementwise_fma(CVT_H2_FP8(uy, true), wv, acc[3]);
        acc[4] = __builtin_elementwise_fma(CVT_H2_FP8(uz, false), wv, acc[4]); acc[5] = __builtin_elementwise_fma(CVT_H2_FP8(uz, true), wv, acc[5]);
        acc[6] = __builtin_elementwise_fma(CVT_H2_FP8(uw, false), wv, acc[6]); acc[7] = __builtin_elementwise_fma(CVT_H2_FP8(uw, true), wv, acc[7]); }
}
__device__ __forceinline__ void sw_warm(v4u (&pf)[4], const unsigned char* tab, int range, int lw, unsigned voff) {
#pragma unroll
    for (int i = 0; i < 4; ++i) { const unsigned off = ((unsigned)(range * 1024 + lw * 4 + i) << 10) + voff; pf[i] = *(const v4u*)(tab + off); }
}
__device__ __forceinline__ void sw_warm_done(const v4u (&pf)[4]) {
#pragma unroll
    for (int i = 0; i < 4; ++i) asm volatile("" :: "v"(pf[i]));
}
template <int FAKE> __device__ __forceinline__ void p8b_sweep(Frame& F) {
    const float* X1 = (const float*)(((unsigned char*)karg(19)) + WS_X1); const float* MOD = (const float*)(((unsigned char*)karg(19)) + WS_MOD);
    const unsigned char* H2Q = (const unsigned char*)(((unsigned char*)karg(19)) + WS_H2Q); const float* H2S = (const float*)(((unsigned char*)karg(19)) + WS_H2S);
    const unsigned char* EDq = (const unsigned char*)(((unsigned char*)karg(19)) + WS_ED); const unsigned char* EUq = (const unsigned char*)(((unsigned char*)karg(19)) + WS_EU); const float* EDS = (const float*)(((unsigned char*)karg(19)) + WS_EDS);
    const unsigned short* PIDX = (const unsigned short*)(((unsigned char*)karg(19)) + WS_PIDX); const float* PG = (const float*)(((unsigned char*)karg(19)) + WS_PG);
    const float* fg = ((const float*)karg(17));
    const int gw = F.vcu * NWAVES + F.wave, NGW = F.G * NWAVES;
    for (int wi = F.vcu; wi < M / 64; wi += F.G) {
        const int tb = wi * 8 + F.wave;
        unsigned ones = ~0u; asm volatile("" : "+s"(ones));
        int lane = (int)__builtin_amdgcn_mbcnt_hi(ones, __builtin_amdgcn_mbcnt_lo(ones, 0u)); asm volatile("" : "+v"(lane));
        const int tok0 = tb * 8;
        unsigned E0[8], E1[8];
        LAS float* Wl = (LAS float*)(F.lds) + F.wave * 1024;
        LAS unsigned* El = (LAS unsigned*)(F.lds + 32768) + F.wave * (8 * ELP);
        unsigned voff = 16u * (unsigned)lane; asm volatile("" : "+v"(voff));
        LAS int* Bnd = (LAS int*)(F.lds + 67584) + F.wave * (8 * (NR + 1));
#pragma unroll
        for (int k = 0; k < 8; ++k) {
            const size_t base = (size_t)(tok0 + k) * 128;
            E0[k] = ((unsigned)PIDX[base + lane] << 7) | (unsigned)lane; E1[k] = ((unsigned)PIDX[base + 64 + lane] << 7) | (unsigned)(64 + lane);
            sort128(E0[k], E1[k], lane);
            if (FAKE) { E0[k] = (E0[k] & 0x1ffffu) ; E1[k] = (E1[k] & 0x1ffffu); sort128(E0[k], E1[k], lane); }
            El[k * ELP + lane] = E0[k] >> 7; El[k * ELP + 64 + lane] = E1[k] >> 7;
            if (lane < 8) El[k * ELP + 128 + lane] = (unsigned)__builtin_amdgcn_readlane((int)E1[k], 63) >> 7;
        }
        for (int repa = 0; repa < PROBE_REPA; ++repa) {
            v4u hq[8];
#pragma unroll
            for (int k = 0; k < 8; ++k) hq[k] = *(const v4u*)(H2Q + (size_t)(tok0 + k) * D + 16 * lane);
            int pos[8];
#pragma unroll
            for (int k = 0; k < 8; ++k) pos[k] = 0;
            v4u bA[BSA], bB[BSA], bC[BSA]; int ps = 0, pn = 0;
            for (int r = 0; r < NR; ++r) {
#pragma unroll
                for (int k = 0; k < 8; ++k) {
                    constexpr int dummy = 0; (void)dummy;
                    const int kp = (k + 7) & 7;
                    const unsigned long long BM = 0x0101010101010101ull;
                    const int c = __builtin_popcountll(__ballot((E0[k] >> RSH) == (unsigned)r) & BM) + __builtin_popcountll(__ballot((E1[k] >> RSH) == (unsigned)r) & BM);
                    int s = __builtin_amdgcn_readfirstlane(pos[k]); const int e_end = __builtin_amdgcn_readfirstlane(s + 8 * c); pos[k] = e_end;
                    if (lane == 0) Bnd[k * (NR + 1) + r + 1] = e_end;
                    const int n1 = (e_end - s) < BSA ? (e_end - s) : BSA;
                    if (k & 1) sw_issue<BSA>(bB, El + k * ELP + s, EDq, voff); else sw_issue<BSA>(bA, El + k * ELP + s, EDq, voff);
                    if (pn > 0) { if (k & 1) sw_proc_a<BSA>(bA, hq[kp], Wl + kp * 128, ps, pn, lane); else sw_proc_a<BSA>(bB, hq[kp], Wl + kp * 128, ps, pn, lane); }
                    ps = s; pn = n1; s += n1;
#define SWA_REST(Y) if (s < e_end) { sw_issue<BSA>(Y, El + k * ELP + s, EDq, voff); \
                        for (;;) { int n = (e_end - s) < BSA ? (e_end - s) : BSA; \
                            if (s + BSA < e_end) { sw_issue<BSA>(bC, El + k * ELP + s + BSA, EDq, voff); sw_proc_a<BSA>(Y, hq[k], Wl + k * 128, s, n, lane); } else { sw_proc_a<BSA>(Y, hq[k], Wl + k * 128, s, n, lane); break; } \
                            s += BSA; n = (e_end - s) < BSA ? (e_end - s) : BSA; \
                            if (s + BSA < e_end) { sw_issue<BSA>(Y, El + k * ELP + s + BSA, EDq, voff); sw_proc_a<BSA>(bC, hq[k], Wl + k * 128, s, n, lane); } else { sw_proc_a<BSA>(bC, hq[k], Wl + k * 128, s, n, lane); break; } \
                            s += BSA; } }
                    if (k & 1) { SWA_REST(bA) } else { SWA_REST(bB) }
#undef SWA_REST
                }
            }
            if (pn > 0) sw_proc_a<BSA>(bB, hq[7], Wl + 7 * 128, ps, pn, lane);
        }
#pragma unroll
        for (int k = 0; k < 8; ++k) { int tk = tok0 + k; asm volatile("" : "+s"(tk)); const size_t base = (size_t)tk * 128; const float sh = H2S[tk];
            const float r0 = Wl[k * 128 + lane], r1 = Wl[k * 128 + 64 + lane];
            const _Float16 w0 = (_Float16)(PG[base + (E0[k] & 127u)] * gelu_erf(r0 * sh * EDS[E0[k] >> 7])), w1 = (_Float16)(PG[base + (E1[k] & 127u)] * gelu_erf(r1 * sh * EDS[E1[k] >> 7]));
            Wl[k * 128 + lane] = __builtin_bit_cast(float, (h2_t){w0, w0}); Wl[k * 128 + 64 + lane] = __builtin_bit_cast(float, (h2_t){w1, w1}); }
        int ln = lane; asm volatile("" : "+v"(ln));
#pragma unroll
        for (int sub = 0; sub < 8 / TPS; ++sub) {
        h2_t acc[TPS][8];
        for (int repb = 0; repb < PROBE_REPB; ++repb) {
#pragma unroll
            for (int kk = 0; kk < TPS; ++kk)
#pragma unroll
                for (int i = 0; i < 8; ++i) acc[kk][i] = (h2_t){(_Float16)0.f, (_Float16)0.f};
            int pos[TPS];
#pragma unroll
            for (int kk = 0; kk < TPS; ++kk) pos[kk] = 0;
            v4u bA[BSB], bB[BSB]; int ps = 0, pn = 0;
            for (int r = 0; r < NR; ++r) {
#pragma unroll
                for (int kk = 0; kk < TPS; ++kk) {
                    const int k = sub * TPS + kk, kkp = (kk + TPS - 1) % TPS, kp = sub * TPS + kkp;
                    int s = __builtin_amdgcn_readfirstlane(pos[kk]); const int e_end = __builtin_amdgcn_readfirstlane(Bnd[k * (NR + 1) + r + 1]); pos[kk] = e_end;
                    const int n1 = (e_end - s) < BSB ? (e_end - s) : BSB;
                    if (kk & 1) sw_issue<BSB>(bB, El + k * ELP + s, EUq, voff); else sw_issue<BSB>(bA, El + k * ELP + s, EUq, voff);
                    if (pn > 0) { if (kk & 1) sw_proc_b<BSB>(bA, acc[kkp], Wl + kp * 128, ps, pn); else sw_proc_b<BSB>(bB, acc[kkp], Wl + kp * 128, ps, pn); }
                    ps = s; pn = n1; s += n1;
                    for (; s < e_end; s += BSB) {
                        const int n = (e_end - s) < BSB ? (e_end - s) : BSB;
                        if (kk & 1) { sw_issue<BSB>(bA, El + k * ELP + s, EUq, voff); sw_proc_b<BSB>(bA, acc[kk], Wl + k * 128, s, n); }
                        else        { sw_issue<BSB>(bB, El + k * ELP + s, EUq, voff); sw_proc_b<BSB>(bB, acc[kk], Wl + k * 128, s, n); }
                    }
                }
            }
            if (pn > 0) sw_proc_b<BSB>(bB, acc[TPS - 1], Wl + (sub * TPS + TPS - 1) * 128, ps, pn);
        }
        {
            asm volatile("" : "+v"(ln));
            float* outp = (float*)karg(18);
            const float* gt2 = MOD + ((tok0 + sub * TPS) >> 12) * NMOD + 5120;
            f32x4 gtv[4], xcur[4], xnxt[4];
#pragma unroll
            for (int j = 0; j < 4; ++j) { const int col = 4 * ln + 256 * j; gtv[j] = *(const f32x4*)(gt2 + col); xcur[j] = *(const f32x4*)(X1 + (size_t)(tok0 + sub * TPS) * D + col); }
#pragma unroll
            for (int kk = 0; kk < TPS; ++kk) {
                const int tok = tok0 + sub * TPS + kk;
                if (kk + 1 < TPS) {
#pragma unroll
                    for (int j = 0; j < 4; ++j) xnxt[j] = __builtin_nontemporal_load((const f32x4*)(X1 + (size_t)(tok + 1) * D + 4 * ln + 256 * j));
                }
                f32x4 x2[4]; float ss = 0.f;
#pragma unroll
                for (int j = 0; j < 4; ++j) {
#pragma unroll
                    for (int i = 0; i < 4; ++i) { const float v = xcur[j][i] + gtv[j][i] * (0.0625f * (float)acc[kk][2 * j + (i >> 1)][i & 1]); x2[j][i] = v; ss += v * v; } }
                ss = wave_sum_x(ss, ln);
                if (!(FAKE && ss != 12345.678f)) {
                    const float rstd = 1.0f / sqrtf(ss * (1.0f / D) + EPS);
                    f32x4 fgv[4];
#pragma unroll
                    for (int j = 0; j < 4; ++j) fgv[j] = *(const f32x4*)(fg + 4 * ln + 256 * j);
#pragma unroll
                    for (int j = 0; j < 4; ++j) __builtin_nontemporal_store(x2[j] * rstd * fgv[j], (f32x4*)(outp + (size_t)tok * D + 4 * ln + 256 * j));
                }
#pragma unroll
                for (int j = 0; j < 4; ++j) xcur[j] = xnxt[j];
            }
        }
        }
    }
}

struct Args { const float* in[18]; float* out; unsigned char* ws; };
__global__ void __launch_bounds__(NTHR, 2) mega_fwd(Args args) {
    extern __shared__ __attribute__((aligned(16))) unsigned char lds[];
    Frame F;
    F.lds = (LAS unsigned char*)lds;
    F.wave = __builtin_amdgcn_readfirstlane((int)threadIdx.x >> 6); F.lane = lane_fresh(); F.tid = F.wave * 64 + F.lane;
    F.G = gridDim.x; { const int bx = blockIdx.x; F.vcu = (F.G % 8 == 0) ? (bx % 8) * (F.G / 8) + bx / 8 : bx; }
    volatile LAS unsigned* MISC = (volatile LAS unsigned*)(F.lds + MISC_OFF);
    for (int u = F.tid; u < (LDS_BYTES - LDSCTL_OFF) / 4; u += NTHR) ((LAS unsigned*)(F.lds + LDSCTL_OFF))[u] = 0u;
    __syncthreads();
    gu32* ctl = (gu32*)(((unsigned char*)karg(19)) + WS_CTL);
    XcdBarrier bar = xcd_barrier_post((unsigned*)(ctl + CW_BAR), MISC + 8, F.wave);
#define GRID_BAR() xcd_barrier(bar)
#define PROBE_TS -1
#define STAMP(i) do { if (PROBE_TS >= 0 && blockIdx.x == 0 && F.tid == 0) { const unsigned long long t_ = __builtin_amdgcn_s_memrealtime(); MISC[16 + 2 * (i)] = (unsigned)t_; MISC[17 + 2 * (i)] = (unsigned)(t_ >> 32); } } while (0)
#define PROBE_DBL -1

    STAMP(0);
    F.lane = lane_fresh(); F.tid = F.wave * 64 + F.lane;
    p0_prologue(F); GRID_BAR(); STAMP(1);
    if (PROBE_DBL == 0) { p0_prologue(F); GRID_BAR(); }
    F.lane = lane_fresh(); F.tid = F.wave * 64 + F.lane;
    p1_norm(F); p0_transposes(F); GRID_BAR(); STAMP(2);
    if (PROBE_DBL == 1) { p1_norm(F); GRID_BAR(); }
    {
    {
        pg8::Gemm g{(const pg8::bf16_t*)(((unsigned char*)karg(19)) + WS_H), (const pg8::bf16_t*)(((unsigned char*)karg(19)) + WS_WIN), M, NPROJ, D, nullptr, nullptr};
        pg8::StaticOrder S; S.init(M, NPROJ, F.G, (int)blockIdx.x);
        pg8::EpiBf16<0> E{(pg8::bf16_t*)(((unsigned char*)karg(19)) + WS_PROJ), NPROJ, nullptr, 0, 0, 1.f};
        pg8::gemm_phase<pg8::EpiBf16<0>, pg8::StaticOrder, true, true>(F.lds + RING_OFF, g, S, E, F.wave);
        const int nwg = (M / 256) * (NPROJ / 256), busy = nwg % F.G;
        if (busy == 0) p0_quant_tables(F, F.vcu * NWAVES + F.wave, F.G * NWAVES);
        else if ((int)blockIdx.x >= busy) p0_quant_tables(F, ((int)blockIdx.x - busy) * NWAVES + F.wave, (F.G - busy) * NWAVES);
    }
    GRID_BAR(); STAMP(3);
    }
    p3_attention(F); GRID_BAR(); STAMP(4);
    if (PROBE_DBL == 3) { p3_attention(F); GRID_BAR(); }
    {
    {
        pg8::Gemm g{(const pg8::bf16_t*)(((unsigned char*)karg(19)) + WS_OA), (const pg8::bf16_t*)(((unsigned char*)karg(19)) + WS_WA), M, D, 512, (const pg8::bf16_t*)(((unsigned char*)karg(19)) + WS_OB), (const pg8::bf16_t*)(((unsigned char*)karg(19)) + WS_WB)};
        PairOrder S; S.S.init(M, D, F.G, (int)blockIdx.x);
        EpiGate E{(const bf16*)(((unsigned char*)karg(19)) + WS_PROJ), (bf16*)((float*)karg(18)) + (size_t)M * D};
        pg8::gemm_phase<EpiGate, PairOrder, true, true>(F.lds + RING_OFF, g, S, E, F.wave);
    }
    GRID_BAR(); STAMP(5);
    }
    {
    {
        pg8::Gemm g{(const pg8::bf16_t*)((bf16*)((float*)karg(18)) + (size_t)M * D), (const pg8::bf16_t*)(((unsigned char*)karg(19)) + WS_WOUT), M, D, D, nullptr, nullptr};
        pg8::StaticOrder S; S.init(M, D, F.G, (int)blockIdx.x);
        EpiRes E{((const float*)karg(0)), (const float*)(((unsigned char*)karg(19)) + WS_MOD), (float*)(((unsigned char*)karg(19)) + WS_X1)};
        pg8::gemm_phase<EpiRes, pg8::StaticOrder, true, true>(F.lds + RING_OFF, g, S, E, F.wave);
    }
    GRID_BAR(); STAMP(6);
    }
    F.lane = lane_fresh(); F.tid = F.wave * 64 + F.lane;
    F.lane = lane_fresh(); F.tid = F.wave * 64 + F.lane;
    p6_norm2(F); GRID_BAR(); STAMP(7);
    if (PROBE_DBL == 6) { p6_norm2(F); GRID_BAR(); }
    {
    {
        pg8::Gemm g{(const pg8::bf16_t*)(((unsigned char*)karg(19)) + WS_H2), (const pg8::bf16_t*)(((unsigned char*)karg(19)) + WS_WQ), M, D, D, nullptr, nullptr};
        pg8::StaticOrder S; S.init(M, D, F.G, (int)blockIdx.x);
        pg8::EpiBf16<0> E{(pg8::bf16_t*)(((unsigned char*)karg(19)) + WS_QP), D, nullptr, 0, 0, 1.f};
        pg8::gemm_phase<pg8::EpiBf16<0>, pg8::StaticOrder, true, true>(F.lds + RING_OFF, g, S, E, F.wave);
    }
    GRID_BAR(); STAMP(8);
    }
    F.lane = lane_fresh(); F.tid = F.wave * 64 + F.lane;
    p8a_topk(F); __syncthreads(); STAMP(9);
    if (PROBE_DBL == 8) { p8a_topk(F); GRID_BAR(); }
    if (PROBE_DBL == 12) { p8b_sweep<1>(F); __syncthreads(); }
    p8b_sweep<0>(F);
    if (PROBE_DBL == 9) { GRID_BAR(); p8b_sweep<0>(F); }
    if (PROBE_TS >= 0) {
        GRID_BAR(); STAMP(10);
        if (blockIdx.x == 0) { __syncthreads();
            const unsigned long long t0 = ((unsigned long long)MISC[17 + 2 * PROBE_TS] << 32) | MISC[16 + 2 * PROBE_TS], t1 = ((unsigned long long)MISC[19 + 2 * PROBE_TS] << 32) | MISC[18 + 2 * PROBE_TS];
            const float d_us = (float)(t1 - t0) * 0.01f;
            const float V = 128.0f * sqrtf(d_us * 1e-5f);
            float* o = (float*)karg(18); for (int c = F.tid; c < D; c += NTHR) o[c] = V; }
    }
}

extern "C" void kernel_launch(void* const* d_in, const int* in_sizes, int n_in, void* d_out, int out_size, void* d_ws, size_t ws_size, hipStream_t stream) {
    static int grid = 0;
    if (grid == 0) {
        if (n_in != 18 || in_sizes[0] != M * D || out_size != M * D || ws_size < WS_END) { fprintf(stderr, "kernel_launch: unexpected shapes (n_in %d, in0 %d, out %d, ws %zu)\n", n_in, n_in > 0 ? in_sizes[0] : -1, out_size, ws_size); grid = -1; return; }
        int dev = 0, cus = 0, per_cu = 0;
        if (hipGetDevice(&dev) != hipSuccess || hipDeviceGetAttribute(&cus, hipDeviceAttributeMultiprocessorCount, dev) != hipSuccess) { grid = -1; return; }
        if (hipFuncSetAttribute((const void*)mega_fwd, hipFuncAttributeMaxDynamicSharedMemorySize, LDS_BYTES) != hipSuccess) { fprintf(stderr, "kernel_launch: hipFuncSetAttribute failed\n"); grid = -1; return; }
        if (hipOccupancyMaxActiveBlocksPerMultiprocessor(&per_cu, (const void*)mega_fwd, NTHR, LDS_BYTES) != hipSuccess || per_cu < 1) { fprintf(stderr, "kernel_launch: occupancy query says %d blocks per CU\n", per_cu); }
        (void)hipGetLastError();
        grid = cus;
    }
    if (grid < 0) return;
    if (hipMemsetAsync((char*)d_ws + WS_CTL, 0, CTL_ZERO_BYTES, stream) != hipSuccess) { fprintf(stderr, "kernel_launch: memset failed\n"); return; }
    Args a{};
    for (int i = 0; i < 18; ++i) a.in[i] = (const float*)d_in[i];
    a.out = (float*)d_out; a.ws = (unsigned char*)d_ws;
    hipLaunchKernelGGL(mega_fwd, dim3(grid), dim3(NTHR), LDS_BYTES, stream, a);
}
```

```cpp
#include <hip/hip_runtime.h>
#include <cstdio>
#include <cstdint>
__device__ __forceinline__ int lane_fresh() { unsigned ones = ~0u; asm volatile("" : "+s"(ones)); return (int)__builtin_amdgcn_mbcnt_hi(ones, __builtin_amdgcn_mbcnt_lo(ones, 0u)); }
namespace pg8 {
#define PG8_LAS __attribute__((address_space(3)))
typedef unsigned short bf16_t;
typedef short bf16x8 __attribute__((ext_vector_type(8)));
typedef float f32x4 __attribute__((ext_vector_type(4)));
typedef unsigned u32x4 __attribute__((ext_vector_type(4)));
constexpr int BM = 256, BK = 64, HALF = 128, HTB = HALF * BK * 2  , STAGE_BYTES = 8 * HTB, NXCD = 8, WGM = 8;

__host__ __device__ __forceinline__ int lds_byte(int r, int c) { const int st = (r >> 4) * 2 + (c >> 5), rr = r & 15, cc = c & 31, ob = rr * 64 + cc * 2; return st * 1024 + (ob ^ (((ob >> 9) & 1) << 5)); }
__host__ __device__ __forceinline__ void stage_rc(int b, int& R, int& C) { const int st = b / 1024, sb = b % 1024, swz = sb ^ (((sb >> 9) & 1) << 5); R = (st >> 1) * 16 + swz / 64; C = (st & 1) * 32 + (swz % 64) / 2; }
__host__ __device__ __forceinline__ int perm32(int rho) { const int n = rho >> 4, i = rho & 15; return 8 * (i >> 2) + 4 * n + (i & 3); }

struct Unit { int pm, pn, src; };
struct Gemm { const bf16_t* A; const bf16_t* Bt; int M, N, K; const bf16_t* A2; const bf16_t* Bt2; };

struct StaticOrder {
    int nM, nN, nwg, G, c;
    __host__ __device__ void init(int M, int N, int G_, int c_) { nM = M / BM; nN = N / BM; nwg = nM * nN; G = G_; c = c_; }
    __host__ __device__ bool next(int i, Unit& u) const {
        const long L = (long)i * G + c; if (L >= nwg) return false;
        int wgid = (int)L; { const int q = nwg / NXCD, r = nwg % NXCD, xcd = wgid % NXCD, off = wgid / NXCD; wgid = (xcd < r ? xcd * (q + 1) : r * (q + 1) + (xcd - r) * q) + off; }
        const int nig = WGM * nN, gid = wgid / nig, fm = gid * WGM, gsz = (nM - fm) < WGM ? (nM - fm) : WGM;
        u.pm = fm + ((wgid % nig) % gsz); u.pn = (wgid % nig) / gsz; u.src = 0; return true;
    }
    __device__ __forceinline__ void a_ready(const Unit&) const {}
    __device__ __forceinline__ void done(const Unit&) const {}
};

__device__ __forceinline__ unsigned cvt_pk_bf16(float lo, float hi) { unsigned r; asm volatile("v_cvt_pk_bf16_f32 %0, %1, %2" : "=v"(r) : "v"(lo), "v"(hi)); return r; }
typedef float f32x2 __attribute__((ext_vector_type(2)));
__device__ __forceinline__ f32x2 gelu_pk(f32x2 v) {
    const f32x2 av = __builtin_elementwise_abs(v), d = av * 0.2316418882f + 1.0f;
    f32x2 t; t.x = __builtin_amdgcn_rcpf(d.x); t.y = __builtin_amdgcn_rcpf(d.y);
    f32x2 q = t * 0.5307027145f + (-0.7265760135f); q = q * t + 0.7107068705f; q = q * t + (-0.142248368f); q = q * t + 0.127414796f; q = q * t;
    const f32x2 s = (v * v) * (-0.72134752044f);
    f32x2 e; e.x = __builtin_amdgcn_exp2f(s.x); e.y = __builtin_amdgcn_exp2f(s.y);
    const f32x2 m = v * (q * e), r = v - m;
    f32x2 o; o.x = v.x < 0.f ? m.x : r.x; o.y = v.y < 0.f ? m.y : r.y; return o;
}

template <int ACT  > struct EpiBf16 {
    static constexpr bool PERM = true, AFTER_DRAIN = false, CHAIN = false; static_assert(ACT == 0 || ACT == 1, "EpiBf16: ACT is 0 (none) or 1 (gelu_pk)");
    bf16_t* O; int ldc; const float* bias; int split_cols; size_t split_stride; float scale0;
    __device__ __forceinline__ void operator()(const f32x4 (&acc)[2][2][4][2], const Unit& u, int wr, int wc, int fr, int fq) const {
        const int row0 = u.pm * BM + wr * 64 + fr; int colt = u.pn * BM; bf16_t* base = O;
        float sc = 1.f; if (split_cols) { const int t = colt / split_cols; base += (size_t)t * split_stride; colt -= t * split_cols; if (t == 0) sc = scale0; }
        const int col0 = colt + wc * 32 + 8 * fq, bcol0 = u.pn * BM + wc * 32 + 8 * fq;
        f32x4 bv[2][2];
#pragma unroll
        for (int bj = 0; bj < 2; ++bj)
#pragma unroll
            for (int n = 0; n < 2; ++n) bv[bj][n] = bias ? *(const f32x4*)(bias + bcol0 + bj * HALF + 4 * n) : (f32x4){0.f, 0.f, 0.f, 0.f};
#pragma unroll
        for (int ai = 0; ai < 2; ++ai)
#pragma unroll
            for (int m = 0; m < 4; ++m) { bf16_t* rowp = base + (size_t)(row0 + ai * HALF + m * 16) * ldc + col0;
#pragma unroll
                for (int bj = 0; bj < 2; ++bj) { f32x4 v0 = acc[ai][bj][m][0] + bv[bj][0], v1 = acc[ai][bj][m][1] + bv[bj][1];
                    if (ACT == 1) { f32x2 a = gelu_pk((f32x2){v0[0], v0[1]}), b = gelu_pk((f32x2){v0[2], v0[3]}), c = gelu_pk((f32x2){v1[0], v1[1]}), d = gelu_pk((f32x2){v1[2], v1[3]});
                        v0 = (f32x4){a.x, a.y, b.x, b.y}; v1 = (f32x4){c.x, c.y, d.x, d.y}; }
                    v0 = v0 * sc; v1 = v1 * sc; u32x4 w; w.x = cvt_pk_bf16(v0[0], v0[1]); w.y = cvt_pk_bf16(v0[2], v0[3]); w.z = cvt_pk_bf16(v1[0], v1[1]); w.w = cvt_pk_bf16(v1[2], v1[3]);
                    *(u32x4*)(rowp + bj * HALF) = w; } }
    }
};

template <class Epi, class Sched, bool ALIGN_EPI = false, bool SP2 = false>
__device__ __forceinline__ void gemm_phase(PG8_LAS unsigned char* lds, const Gemm g, const Sched& S, const Epi& E, int wave_id) {
    int tid = wave_id * 64 + ::lane_fresh(); asm volatile("" : "+v"(tid));
    const int wid = __builtin_amdgcn_readfirstlane(tid >> 6), lane = tid & 63, wr = wid >> 2, wc = wid & 3, fr = lane & 15, fq = lane >> 4;
    const int K = g.K, nt = K / BK;
    unsigned voffA[2], voffB[2];
#pragma unroll
    for (int i = 0; i < 2; ++i) { int R, C; stage_rc(tid * 16 + i * 8192, R, C); const int Rb = Epi::PERM ? ((R & ~31) + perm32(R & 31)) : R;
        voffA[i] = (unsigned)(R * K + C) * 2u; voffB[i] = (unsigned)(Rb * K + C) * 2u; }
    const size_t kstep = (size_t)(BK * 2);
    const size_t hstep = (size_t)HALF * K * 2;
    const size_t tstep = 2 * hstep;
    const unsigned ldsw = (unsigned)wid * 1024u;
    const int aoff = lds_byte(wr * 64 + fr, fq * 8), boff = lds_byte(wc * 32 + fr, fq * 8);
#define PG8_SA(b, h) (((b) * 2 + (h)) * HTB)
#define PG8_SB(b, h) ((4 + (b) * 2 + (h)) * HTB)
#define PG8_STAGE(bufoff, gbase, voff) do { _Pragma("unroll") for (int _i = 0; _i < 2; ++_i) \
        __builtin_amdgcn_global_load_lds((const unsigned*)((const char*)(gbase) + (voff)[_i]), (PG8_LAS unsigned*)(lds + (bufoff) + ldsw + _i * 8192), 16, 0, 0); } while (0)
#define PG8_LDA(dst, b, h) do { _Pragma("unroll") for (int m = 0; m < 4; ++m) _Pragma("unroll") for (int k = 0; k < 2; ++k) dst[m][k] = *(const PG8_LAS bf16x8*)(lds + PG8_SA(b, h) + aoff + m * 2048 + k * 1024); } while (0)
#define PG8_LDB(dst, b, h) do { _Pragma("unroll") for (int n = 0; n < 2; ++n) _Pragma("unroll") for (int k = 0; k < 2; ++k) dst[n][k] = *(const PG8_LAS bf16x8*)(lds + PG8_SB(b, h) + boff + n * 2048 + k * 1024); } while (0)
#define PG8_MMA(ai, bj, At, Bt) do { __builtin_amdgcn_s_setprio(1); _Pragma("unroll") for (int m = 0; m < 4; ++m) _Pragma("unroll") for (int n = 0; n < 2; ++n) _Pragma("unroll") for (int k = 0; k < 2; ++k) \
        acc[ai][bj][m][n] = __builtin_amdgcn_mfma_f32_16x16x32_bf16(Bt[n][k], At[m][k], acc[ai][bj][m][n], 0, 0, 0); __builtin_amdgcn_s_setprio(0); } while (0)
#define PG8_WAIT_V(n) asm volatile("s_waitcnt vmcnt(" #n ")" ::: "memory")
#define PG8_WAIT_L(n) asm volatile("s_waitcnt lgkmcnt(" #n ")" ::: "memory")
#define PG8_BAR __builtin_amdgcn_s_barrier()
#define PG8_SCHED __builtin_amdgcn_sched_barrier(0)
    Unit cur, nxt; int ui = 0;
    if (!S.next(0, cur)) return;
    f32x4 acc[2][2][4][2];
#pragma unroll
    for (int a = 0; a < 2; ++a)
#pragma unroll
        for (int b = 0; b < 2; ++b)
#pragma unroll
            for (int m = 0; m < 4; ++m)
#pragma unroll
                for (int n = 0; n < 2; ++n) acc[a][b][m][n] = (f32x4){0.f, 0.f, 0.f, 0.f};
    bf16x8 At[4][2], B0[2][2], B1[2][2];
    const char* cA = (const char*)(cur.src ? g.A2 : g.A) + (size_t)cur.pm * tstep; const char* cB = (const char*)(cur.src ? g.Bt2 : g.Bt) + (size_t)cur.pn * tstep;
    S.a_ready(cur);
    if constexpr (SP2) {
        PG8_STAGE(PG8_SB(0, 0), cB, voffB); PG8_STAGE(PG8_SB(0, 1), cB + hstep, voffB); PG8_STAGE(PG8_SA(0, 0), cA, voffA); PG8_STAGE(PG8_SA(0, 1), cA + hstep, voffA);
        if (wr == 1) PG8_BAR;
        PG8_WAIT_V(2); PG8_BAR;
        PG8_STAGE(PG8_SB(1, 0), cB + kstep, voffB); PG8_STAGE(PG8_SA(1, 0), cA + kstep, voffA); PG8_STAGE(PG8_SB(1, 1), cB + hstep + kstep, voffB);
        PG8_WAIT_V(6); PG8_BAR;
    } else {
        PG8_STAGE(PG8_SB(0, 0), cB, voffB); PG8_STAGE(PG8_SA(0, 0), cA, voffA); PG8_STAGE(PG8_SB(0, 1), cB + hstep, voffB); PG8_STAGE(PG8_SA(0, 1), cA + hstep, voffA);
        if (wr == 1) PG8_BAR;
        PG8_WAIT_V(4); PG8_BAR;
        PG8_STAGE(PG8_SB(1, 0), cB + kstep, voffB); PG8_STAGE(PG8_SA(1, 0), cA + kstep, voffA); PG8_STAGE(PG8_SB(1, 1), cB + hstep + kstep, voffB);
        PG8_WAIT_V(6); PG8_BAR;
    }
    for (;;) {
        const bool has_next = S.next(ui + 1, nxt);
        const char* nA = has_next ? (const char*)(nxt.src ? g.A2 : g.A) + (size_t)nxt.pm * tstep : cA; const char* nB = has_next ? (const char*)(nxt.src ? g.Bt2 : g.Bt) + (size_t)nxt.pn * tstep : cB;
        for (int t = 0; t < nt; t += 2) {
            const bool last = (t == nt - 2);
            const char* a1 = cA + (size_t)(t + 1) * kstep;
            const char* a2 = last ? nA : cA + (size_t)(t + 2) * kstep; const char* b2 = last ? nB : cB + (size_t)(t + 2) * kstep;
            const char* a3 = a2 + kstep; const char* b3 = b2 + kstep;
            if (last && has_next) S.a_ready(nxt);
            if constexpr (SP2) {
            PG8_LDB(B0, 0, 0); PG8_LDB(B1, 0, 1); PG8_SCHED; PG8_LDA(At, 0, 0); PG8_STAGE(PG8_SA(1, 1), a1 + hstep, voffA);
            PG8_WAIT_V(8); PG8_WAIT_L(0); PG8_BAR; PG8_MMA(0, 0, At, B0); PG8_MMA(0, 1, At, B1); PG8_BAR; PG8_SCHED;
            PG8_LDA(At, 0, 1); PG8_STAGE(PG8_SB(0, 0), b2, voffB); PG8_STAGE(PG8_SB(0, 1), b2 + hstep, voffB); PG8_STAGE(PG8_SA(0, 0), a2, voffA);
            PG8_WAIT_V(8); PG8_WAIT_L(0); PG8_BAR; PG8_MMA(1, 0, At, B0); PG8_MMA(1, 1, At, B1); PG8_BAR; PG8_SCHED;
            PG8_LDB(B0, 1, 0); PG8_LDB(B1, 1, 1); PG8_SCHED; PG8_LDA(At, 1, 0); PG8_STAGE(PG8_SA(0, 1), a2 + hstep, voffA);
            PG8_WAIT_V(8); PG8_WAIT_L(0); PG8_BAR; PG8_MMA(0, 0, At, B0); PG8_MMA(0, 1, At, B1); PG8_BAR; PG8_SCHED;
            PG8_LDA(At, 1, 1); PG8_STAGE(PG8_SB(1, 0), b3, voffB); PG8_STAGE(PG8_SB(1, 1), b3 + hstep, voffB); PG8_STAGE(PG8_SA(1, 0), a3, voffA);
            PG8_WAIT_V(8); PG8_WAIT_L(0); PG8_BAR; PG8_MMA(1, 0, At, B0); PG8_MMA(1, 1, At, B1); PG8_BAR; PG8_SCHED;
            } else {
            PG8_LDB(B0, 0, 0); PG8_SCHED; PG8_LDA(At, 0, 0); PG8_STAGE(PG8_SA(1, 1), a1 + hstep, voffA);
            PG8_WAIT_L(8); PG8_BAR; PG8_WAIT_L(0); PG8_MMA(0, 0, At, B0); PG8_BAR; PG8_SCHED;
            PG8_LDB(B1, 0, 1); PG8_STAGE(PG8_SB(0, 0), b2, voffB);
            PG8_BAR; PG8_WAIT_L(0); PG8_MMA(0, 1, At, B1); PG8_BAR;
            PG8_LDA(At, 0, 1); PG8_STAGE(PG8_SA(0, 0), a2, voffA);
            PG8_BAR; PG8_WAIT_L(0); PG8_MMA(1, 0, At, B0); PG8_BAR; PG8_SCHED;
            PG8_STAGE(PG8_SB(0, 1), b2 + hstep, voffB);
            PG8_WAIT_V(6); PG8_BAR; PG8_MMA(1, 1, At, B1); PG8_BAR;
            PG8_LDB(B0, 1, 0); PG8_SCHED; PG8_LDA(At, 1, 0); PG8_STAGE(PG8_SA(0, 1), a2 + hstep, voffA);
            PG8_WAIT_L(8); PG8_BAR; PG8_WAIT_L(0); PG8_MMA(0, 0, At, B0); PG8_BAR; PG8_SCHED;
            PG8_LDB(B1, 1, 1); PG8_STAGE(PG8_SB(1, 0), b3, voffB);
            PG8_BAR; PG8_WAIT_L(0); PG8_MMA(0, 1, At, B1); PG8_BAR;
            PG8_LDA(At, 1, 1); PG8_STAGE(PG8_SA(1, 0), a3, voffA);
            PG8_BAR; PG8_WAIT_L(0); PG8_MMA(1, 0, At, B0); PG8_BAR; PG8_SCHED;
            PG8_STAGE(PG8_SB(1, 1), b3 + hstep, voffB);
            PG8_WAIT_V(6); PG8_BAR; PG8_MMA(1, 1, At, B1); PG8_BAR;
            }
        }
        if constexpr (ALIGN_EPI) { if (wr == 0) PG8_BAR; }
        if constexpr (!Epi::AFTER_DRAIN) { E(acc, cur, wr, wc, fr, fq); S.done(cur); }
        if (!has_next) break;
        if (!(Epi::CHAIN && cur.src == 0)) {
#pragma unroll
        for (int a = 0; a < 2; ++a)
#pragma unroll
            for (int b = 0; b < 2; ++b)
#pragma unroll
                for (int m = 0; m < 4; ++m)
#pragma unroll
                    for (int n = 0; n < 2; ++n) acc[a][b][m][n] = (f32x4){0.f, 0.f, 0.f, 0.f};
        }
        cur = nxt; cA = nA; cB = nB; ++ui;
        if constexpr (ALIGN_EPI) { if (wr == 1) PG8_BAR; }
    }
    PG8_WAIT_V(0);
    if constexpr (!ALIGN_EPI) { if (wr == 0) PG8_BAR; }
    PG8_BAR;
    if constexpr (Epi::AFTER_DRAIN) { E.fused(acc, cur, wr, wc, fr, fq, lds, wid, lane); S.done(cur); }
#undef PG8_SA
#undef PG8_SB
#undef PG8_STAGE
#undef PG8_LDA
#undef PG8_LDB
#undef PG8_MMA
#undef PG8_WAIT_V
#undef PG8_WAIT_L
#undef PG8_BAR
#undef PG8_SCHED
}
}

#define GAS __attribute__((address_space(1)))
#define LAS __attribute__((address_space(3)))
typedef unsigned short bf16;
typedef unsigned v4u __attribute__((ext_vector_type(4)));
typedef float f32x4 __attribute__((ext_vector_type(4)));
typedef short bf16x8 __attribute__((ext_vector_type(8)));
typedef GAS unsigned gu32;
typedef GAS unsigned long long gu64;
#define RLX_AGENT __ATOMIC_RELAXED, __HIP_MEMORY_SCOPE_AGENT
#define LDS_WAIT() asm volatile("s_waitcnt lgkmcnt(0)" ::: "memory")
#define VM_WAIT() asm volatile("s_waitcnt vmcnt(0)" ::: "memory")
__device__ __forceinline__ unsigned long long rt() { return __builtin_amdgcn_s_memrealtime(); }
__device__ __forceinline__ unsigned f2bf(float f) { unsigned u = __builtin_bit_cast(unsigned, f); return (u + 0x7fffu + ((u >> 16) & 1u)) >> 16; }
__device__ __forceinline__ unsigned pk2(float lo, float hi) { return f2bf(lo) | (f2bf(hi) << 16); }

__device__ __forceinline__ const void* karg(int i);
constexpr int CW_BAR_FWD = 4096;
#define XB_TMO      128
#define XB_XCNT(j)  (256  + 64 * (j))
#define XB_XSUB(j)  (1280 + 64 * (j))
#define XB_XGEN(j)  (2304 + 64 * (j))
#define XB_TOP      3328
#define XB_TOPGEN   3392
#define XCD_BAR_WORDS 3456
#define XB_SPIN_CAP (1u << 18)

__device__ __forceinline__ unsigned xb_ld(unsigned* p)              { return __hip_atomic_load(p, __ATOMIC_RELAXED, __HIP_MEMORY_SCOPE_AGENT); }
__device__ __forceinline__ unsigned xb_add(unsigned* p, unsigned v) { return __hip_atomic_fetch_add(p, v, __ATOMIC_RELAXED, __HIP_MEMORY_SCOPE_AGENT); }
__device__ __forceinline__ unsigned xb_xcc_id() { return (unsigned)__builtin_amdgcn_s_getreg((3 << 11) | 20) & 0xFu; }
#define XB_SPIN(cond, bar) do { unsigned _sp = 0; while (cond) { __builtin_amdgcn_s_sleep(1); \
    if ((++_sp & 255u) == 0u) { if (xb_ld(&(bar)[XB_TMO])) break; if (_sp > XB_SPIN_CAP) { atomicAdd(&(bar)[XB_TMO], 1u); break; } } } } while (0)

struct XcdBarrier {
    int wave;
    unsigned* bar; unsigned x;
    volatile LAS unsigned* st;
};

__device__ __forceinline__ XcdBarrier xcd_barrier_post(unsigned* bar, volatile LAS unsigned* st, int wave) {
    XcdBarrier b; b.wave = wave; b.bar = bar; b.x = xb_xcc_id(); b.st = st;
    if (wave == 0 && lane_fresh() == 0) (void)xb_add(&bar[XB_XCNT(b.x)], 1u);
    return b;
}
__device__ __forceinline__ void xcd_barrier_complete(unsigned* bar, unsigned x, unsigned& nloc, unsigned& nx) {
    const unsigned G = gridDim.x * gridDim.y * gridDim.z;
    unsigned sum, cnt, mine, sp = 0u;
    for (;;) {
        sum = 0u; cnt = 0u; mine = 0u;
#pragma unroll
        for (unsigned j = 0; j < 16; ++j) { const unsigned c = xb_ld(&bar[XB_XCNT(j)]); sum += c; cnt += (c > 0u) ? 1u : 0u; mine = (j == x) ? c : mine; }
        if (sum == G) break;
        __builtin_amdgcn_s_sleep(1);
        if ((++sp & 255u) == 0u) { if (xb_ld(&bar[XB_TMO])) break; if (sp > XB_SPIN_CAP) { atomicAdd(&bar[XB_TMO], 1u); break; } }
    }
    nloc = mine > 0u ? mine : 1u; nx = cnt > 0u ? cnt : 1u;
}

__device__ __forceinline__ void xcd_barrier(const XcdBarrier& b) {
    asm volatile("s_waitcnt vmcnt(0)" ::: "memory");
    __syncthreads();
    if (b.wave == 0 && lane_fresh() == 0) {
        unsigned* bar = (unsigned*)((gu32*)((unsigned char*)karg(19)) + CW_BAR_FWD);
        __builtin_amdgcn_s_waitcnt(0);
        unsigned nloc = b.st[0], nx = b.st[1];
        if (nloc == 0u) { xcd_barrier_complete(bar, b.x, nloc, nx); b.st[0] = nloc; b.st[1] = nx; }
        const unsigned old = xb_add(&bar[XB_XSUB(b.x)], 1u);
        const unsigned gen = old / nloc;
        if (old + 1u == (gen + 1u) * nloc) {
            __builtin_amdgcn_fence(__ATOMIC_RELEASE, "agent");
            asm volatile("s_waitcnt vmcnt(0)" ::: "memory");
            const unsigned og = xb_add(&bar[XB_TOP], 1u);
            const unsigned tg = og / nx;
            if (og + 1u == (tg + 1u) * nx) xb_add(&bar[XB_TOPGEN], 1u);
            else XB_SPIN(xb_ld(&bar[XB_TOPGEN]) == tg, bar);
            __builtin_amdgcn_fence(__ATOMIC_ACQUIRE, "agent");
            xb_add(&bar[XB_XGEN(b.x)], 1u);
            asm volatile("s_waitcnt vmcnt(0)" ::: "memory");
        } else {
            XB_SPIN(xb_ld(&bar[XB_XGEN(b.x)]) == gen, bar);
            __builtin_amdgcn_fence(__ATOMIC_ACQUIRE, "agent");
            asm volatile("s_waitcnt vmcnt(0)" ::: "memory");
        }
    }
    __syncthreads();
}

constexpr int NWAVES = 8, NTHR = 512;
constexpr int BATCH = 4, SEQ = 4096, D = 1024, M = BATCH * SEQ;
constexpr int NPROJ = 4352, LDW_IN = 4360, NMOD = 6144;
constexpr int C_QA = 0, C_KA = 512, C_VA = 640, C_QB = 768, C_KB = 1280, C_VB = 1792, C_GLA = 2304, C_GLB = 3328;
constexpr int NEXP = 16384;
constexpr float EPS = 1e-6f;

constexpr size_t MiB = 1u << 20;
constexpr size_t WS_CTL = 0, CTL_ZERO_BYTES = 1 * MiB;
constexpr size_t WS_MOD = 1 * MiB, WS_LOGF = 1 * MiB + 128 * 1024, WS_SUBK = 2 * MiB;
constexpr size_t WS_WIN = 4 * MiB, WS_WA = 12 * MiB + 512 * 1024, WS_WB = 13 * MiB + 512 * 1024, WS_WOUT = 14 * MiB + 512 * 1024, WS_WQ = 16 * MiB + 512 * 1024;
constexpr size_t WS_ED = 19 * MiB, WS_EU = 35 * MiB;
constexpr size_t WS_EDS = 2 * MiB + 512 * 1024;
constexpr size_t WS_H2Q = 95 * MiB, WS_H2S = 111 * MiB;
constexpr size_t WS_H = 83 * MiB, WS_OA = 83 * MiB, WS_OB = 99 * MiB, WS_PIDX = 83 * MiB, WS_PG = 87 * MiB;
constexpr size_t WS_PROJ = 115 * MiB, WS_X1 = 115 * MiB, WS_H2 = 179 * MiB, WS_QP = 211 * MiB;
constexpr size_t WS_END = 251 * MiB;
static_assert(WS_WIN + (size_t)NPROJ * D * 2 <= WS_WA && WS_WQ + (size_t)D * D * 2 <= WS_ED && WS_PROJ + (size_t)M * NPROJ * 2 <= WS_END, "ws map");
constexpr int CW_BAR = 4096; static_assert(CW_BAR == CW_BAR_FWD && WS_CTL == 0, "barrier words");

constexpr int RING_OFF = 0, RING_BYTES = 131072;
constexpr int LDSCTL_OFF = RING_BYTES, MISC_OFF = LDSCTL_OFF + 320;
constexpr int LDS_BYTES = 147456;

typedef float f32x16 __attribute__((ext_vector_type(16)));
typedef short s16x4 __attribute__((ext_vector_type(4)));
typedef unsigned u32x2 __attribute__((ext_vector_type(2)));
typedef float f32x2_t __attribute__((ext_vector_type(2)));
typedef __bf16 bf16x2_t __attribute__((ext_vector_type(2)));

__device__ __forceinline__ unsigned cvtpk(float lo, float hi) { f32x2_t v = {lo, hi}; bf16x2_t b = __builtin_convertvector(v, bf16x2_t); return __builtin_bit_cast(unsigned, b); }
__device__ __forceinline__ float bflo(unsigned u) { return __uint_as_float(u << 16); }
__device__ __forceinline__ float bfhi(unsigned u) { return __uint_as_float(u & 0xffff0000u); }
template <int S> __device__ __forceinline__ unsigned xorx(unsigned v, int lane) {
    if constexpr (S == 1) return (unsigned)__builtin_amdgcn_update_dpp(0, (int)v, 0xB1, 0xF, 0xF, true);
    else if constexpr (S == 2) return (unsigned)__builtin_amdgcn_update_dpp(0, (int)v, 0x4E, 0xF, 0xF, true);
    else if constexpr (S == 4) { const unsigned a = (unsigned)__builtin_amdgcn_update_dpp(0, (int)v, 0x124, 0xF, 0xF, true), b = (unsigned)__builtin_amdgcn_update_dpp(0, (int)v, 0x12C, 0xF, 0xF, true); return (lane & 4) ? a : b; }
    else if constexpr (S == 8) return (unsigned)__builtin_amdgcn_update_dpp(0, (int)v, 0x128, 0xF, 0xF, true);
    else if constexpr (S == 16) { const auto r = __builtin_amdgcn_permlane16_swap(v, v, false, false); return (lane & 16) ? r[0] : r[1]; }
    else { const auto r = __builtin_amdgcn_permlane32_swap(v, v, false, false); return (lane & 32) ? r[0] : r[1]; }
}
__device__ __forceinline__ unsigned xorx_sw(unsigned v, int lane, int s) {
    switch (s) { case 1: return xorx<1>(v, lane); case 2: return xorx<2>(v, lane); case 4: return xorx<4>(v, lane); case 8: return xorx<8>(v, lane); case 16: return xorx<16>(v, lane); default: return xorx<32>(v, lane); }
}
__device__ __forceinline__ float wave_sum_x(float v, int lane) {
    v += __uint_as_float(xorx<1>(__float_as_uint(v), lane)); v += __uint_as_float(xorx<2>(__float_as_uint(v), lane)); v += __uint_as_float(xorx<4>(__float_as_uint(v), lane));
    v += __uint_as_float(xorx<8>(__float_as_uint(v), lane)); v += __uint_as_float(xorx<16>(__float_as_uint(v), lane)); v += __uint_as_float(xorx<32>(__float_as_uint(v), lane));
    return v;
}
__device__ __forceinline__ float dppf(float v, const int ctrl_sel) { return v; }
#define DPP_F(v, CTRL) __uint_as_float(__builtin_amdgcn_update_dpp(0, __float_as_uint(v), (CTRL), 0xF, 0xF, true))
__device__ __forceinline__ float reduce8_t(const float (&dd)[8], int lane) {
    float r4[4];
#pragma unroll
    for (int u = 0; u < 4; ++u) { const auto p = __builtin_amdgcn_permlane32_swap(__float_as_uint(dd[u]), __float_as_uint(dd[u + 4]), false, false); r4[u] = __uint_as_float(p[0]) + __uint_as_float(p[1]); }
    float r2[2];
#pragma unroll
    for (int u = 0; u < 2; ++u) { const auto p = __builtin_amdgcn_permlane16_swap(__float_as_uint(r4[u]), __float_as_uint(r4[u + 2]), false, false); r2[u] = __uint_as_float(p[0]) + __uint_as_float(p[1]); }
    const bool b3 = (lane & 8) != 0;
    const float keep = b3 ? r2[1] : r2[0], send = b3 ? r2[0] : r2[1];
    float r1 = keep + DPP_F(send, 0x128);
    r1 += DPP_F(r1, 0xB1);
    r1 += DPP_F(r1, 0x4E);
    r1 += DPP_F(r1, 0x141);
    return r1;
}
__device__ __forceinline__ int lane_id() { return (int)__builtin_amdgcn_mbcnt_hi(~0u, __builtin_amdgcn_mbcnt_lo(~0u, 0u)); }
__device__ __forceinline__ float wave_sum(float v) { return wave_sum_x(v, lane_id()); }
__device__ __forceinline__ float wave_max(float v) { const int lane = lane_id();
    v = fmaxf(v, __uint_as_float(xorx<1>(__float_as_uint(v), lane))); v = fmaxf(v, __uint_as_float(xorx<2>(__float_as_uint(v), lane))); v = fmaxf(v, __uint_as_float(xorx<4>(__float_as_uint(v), lane)));
    v = fmaxf(v, __uint_as_float(xorx<8>(__float_as_uint(v), lane))); v = fmaxf(v, __uint_as_float(xorx<16>(__float_as_uint(v), lane))); v = fmaxf(v, __uint_as_float(xorx<32>(__float_as_uint(v), lane)));
    return v; }
__device__ __forceinline__ int crow(int r, int hi) { return (r & 3) + 8 * (r >> 2) + 4 * hi; }
#define MFMA32(a, b, c) __builtin_amdgcn_mfma_f32_32x32x16_bf16((a), (b), (c), 0, 0, 0)

struct Frame {
    LAS unsigned char* lds;
    int tid, lane, wave, vcu, G;
};
__device__ __forceinline__ const void* karg(int i) {
    unsigned long z = 0; asm volatile("" : "+s"(z));
    const char* base = (const char*)__builtin_amdgcn_kernarg_segment_ptr();
    return *(const void* const*)(base + 8 * i + z);
}

__device__ __forceinline__ void p0_transpose_item(const float* W, int ld, int K, int ncols, bf16* WT, int row_off, LAS float* scr, int item, int lane) {
    const int nblk = ncols / 32, kb = item / nblk, nb = item % nblk, k0 = 64 * kb, n0 = 32 * nb;
#pragma unroll 8
    for (int i = 0; i < 32; ++i) { const int kk = 2 * i + (lane >> 5); scr[kk * 33 + (lane & 31)] = __builtin_nontemporal_load(W + (size_t)(k0 + kk) * ld + n0 + (lane & 31)); }
    LDS_WAIT(); asm volatile("" ::: "memory");
    const int c = lane & 7;
#pragma unroll
    for (int j = 0; j < 4; ++j) { const int n = (lane >> 3) + 8 * j; const LAS float* s = scr + (8 * c) * 33 + n;
        v4u o; o.x = pk2(s[0 * 33], s[1 * 33]); o.y = pk2(s[2 * 33], s[3 * 33]); o.z = pk2(s[4 * 33], s[5 * 33]); o.w = pk2(s[6 * 33], s[7 * 33]);
        *(GAS v4u*)(WT + (size_t)(row_off + n0 + n) * K + k0 + 8 * c) = o; }
    LDS_WAIT(); asm volatile("" ::: "memory");
}
__device__ __forceinline__ void p0_convert(const float* __restrict__ src, bf16* __restrict__ dst, long n_iters, int gw, int NGW, int lane) {
    for (long it0 = (long)gw * 4; it0 < n_iters; it0 += (long)NGW * 4) {
        f32x4 a[4][2];
#pragma unroll
        for (int u = 0; u < 4; ++u) { const long it = it0 + u; if (it < n_iters) { const float* p = src + it * 512 + lane * 4; a[u][0] = *(const f32x4*)p; a[u][1] = *(const f32x4*)(p + 256); } }
#pragma unroll
        for (int u = 0; u < 4; ++u) { const long it = it0 + u; if (it < n_iters) { bf16* q = dst + it * 512 + lane * 4;
            u32x2 w0, w1; w0.x = cvtpk(a[u][0].x, a[u][0].y); w0.y = cvtpk(a[u][0].z, a[u][0].w); w1.x = cvtpk(a[u][1].x, a[u][1].y); w1.y = cvtpk(a[u][1].z, a[u][1].w);
            *(u32x2*)q = w0; *(u32x2*)(q + 256) = w1; } }
    }
}

__device__ __forceinline__ void p0_quant_tables(Frame& F, int gw, int NGW) {
    const float* ed = ((const float*)karg(15)); const float* eu = ((const float*)karg(16));
    unsigned char* EDq = (unsigned char*)(((unsigned char*)karg(19)) + WS_ED); unsigned char* EUq = (unsigned char*)(((unsigned char*)karg(19)) + WS_EU); float* EDS = (float*)(((unsigned char*)karg(19)) + WS_EDS);
    const int lane = F.lane;
    for (int row0 = gw * 4; row0 < NEXP; row0 += NGW * 4) {
        f32x4 a[4][4], u[4][4];
#pragma unroll
        for (int q = 0; q < 4; ++q)
#pragma unroll
            for (int j = 0; j < 4; ++j) { a[q][j] = __builtin_nontemporal_load((const f32x4*)(ed + (size_t)(row0 + q) * D) + lane + 64 * j); u[q][j] = __builtin_nontemporal_load((const f32x4*)(eu + (size_t)(row0 + q) * D) + lane + 64 * j); }
#pragma unroll
        for (int q = 0; q < 4; ++q) {
            float am = 0.f;
#pragma unroll
            for (int j = 0; j < 4; ++j) am = fmaxf(fmaxf(am, fmaxf(fabsf(a[q][j].x), fabsf(a[q][j].y))), fmaxf(fabsf(a[q][j].z), fabsf(a[q][j].w)));
            am = wave_max(am);
            const float sc = am > 0.f ? am * (1.0f / 127.0f) : 1.0f, inv = 1.0f / sc;
            v4u qa, qu;
#pragma unroll
            for (int j = 0; j < 4; ++j) {
                const int b0 = (int)rintf(a[q][j].x * inv), b1 = (int)rintf(a[q][j].y * inv), b2 = (int)rintf(a[q][j].z * inv), b3 = (int)rintf(a[q][j].w * inv);
                qa[j] = (unsigned)(b0 & 255) | ((unsigned)(b1 & 255) << 8) | ((unsigned)(b2 & 255) << 16) | ((unsigned)(b3 & 255) << 24);
                int p = __builtin_amdgcn_cvt_pk_fp8_f32(u[q][j].x * 16.0f, u[q][j].y * 16.0f, 0, false);
                p = __builtin_amdgcn_cvt_pk_fp8_f32(u[q][j].z * 16.0f, u[q][j].w * 16.0f, p, true);
                qu[j] = (unsigned)p;
            }
            __builtin_nontemporal_store(qa, (v4u*)(EDq + (size_t)(row0 + q) * D + 16 * lane));
            __builtin_nontemporal_store(qu, (v4u*)(EUq + (size_t)(row0 + q) * D + 16 * lane));
            if (lane == 0) EDS[row0 + q] = sc;
        }
    }
}
__device__ __forceinline__ void p0_prologue(Frame& F) {
    const float* c = ((const float*)karg(1)); const float* w_ada = ((const float*)karg(4)); const float* b_ada = ((const float*)karg(5));
    float* MOD = (float*)(((unsigned char*)karg(19)) + WS_MOD);
    {
        LAS float* cact = (LAS float*)(F.lds);
        LAS float* part = (LAS float*)(F.lds + 16384);
        bool did = false;
        for (int item = F.vcu; item < NMOD / 32; item += F.G) {
            if (!did) { for (int i = F.tid; i < 4096; i += NTHR) { const float cv = c[i]; cact[i] = cv / (1.0f + __expf(-cv)); } did = true; }
            __syncthreads();
            const int n0 = item * 32, col = n0 + (F.lane & 31), ksub = F.lane >> 5;
            float a0 = 0.f, a1 = 0.f, a2 = 0.f, a3 = 0.f;
#pragma unroll 16
            for (int it = 0; it < 64; ++it) { const int k = (it * 8 + F.wave) * 2 + ksub; const float w = __builtin_nontemporal_load(w_ada + (size_t)k * NMOD + col);
                a0 += cact[k] * w; a1 += cact[1024 + k] * w; a2 += cact[2048 + k] * w; a3 += cact[3072 + k] * w; }
            a0 += __shfl_xor(a0, 32); a1 += __shfl_xor(a1, 32); a2 += __shfl_xor(a2, 32); a3 += __shfl_xor(a3, 32);
            if (F.lane < 32) { part[(F.wave * 4 + 0) * 32 + F.lane] = a0; part[(F.wave * 4 + 1) * 32 + F.lane] = a1; part[(F.wave * 4 + 2) * 32 + F.lane] = a2; part[(F.wave * 4 + 3) * 32 + F.lane] = a3; }
            __syncthreads();
            if (F.tid < 128) { const int b = F.tid >> 5, cl = F.tid & 31; float s = 0.f;
#pragma unroll
                for (int w = 0; w < 8; ++w) s += part[(w * 4 + b) * 32 + cl];
                MOD[b * NMOD + n0 + cl] = s + b_ada[n0 + cl]; }
            __syncthreads();
        }
    }
    {
        const int gw = F.vcu * NWAVES + F.wave, NGW = F.G * NWAVES;
        p0_convert(((const float*)karg(14)), (bf16*)(((unsigned char*)karg(19)) + WS_SUBK), (long)(8 * 2 * 128 * 64) / 512, gw, NGW, F.lane);
    }
}
__device__ __forceinline__ void p0_transposes(Frame& F) {
    LAS float* scr = (LAS float*)(F.lds + 32768 + F.wave * 8704);
    const int gw = F.vcu * NWAVES + F.wave, NGW = F.G * NWAVES;
    constexpr int I_IN1 = (D / 64) * (2304 / 32), I_IN2 = (D / 64) * (2048 / 32), I_AB = (512 / 64) * (D / 32), I_SQ = (D / 64) * (D / 32);
    constexpr int NITEMS = I_IN1 + I_IN2 + 2 * I_AB + 2 * I_SQ;
    bf16* Win_t = (bf16*)(((unsigned char*)karg(19)) + WS_WIN);
    for (int it = gw; it < NITEMS; it += NGW) {
        int r = it;
        if (r < I_IN1) { p0_transpose_item(((const float*)karg(6)), LDW_IN, D, 2304, Win_t, 0, scr, r, F.lane); continue; } r -= I_IN1;
        if (r < I_IN2) { p0_transpose_item(((const float*)karg(6)) + 2312, LDW_IN, D, 2048, Win_t, 2304, scr, r, F.lane); continue; } r -= I_IN2;
        if (r < I_AB) { p0_transpose_item(((const float*)karg(9)), D, 512, D, (bf16*)(((unsigned char*)karg(19)) + WS_WA), 0, scr, r, F.lane); continue; } r -= I_AB;
        if (r < I_AB) { p0_transpose_item(((const float*)karg(10)), D, 512, D, (bf16*)(((unsigned char*)karg(19)) + WS_WB), 0, scr, r, F.lane); continue; } r -= I_AB;
        if (r < I_SQ) { p0_transpose_item(((const float*)karg(11)), D, D, D, (bf16*)(((unsigned char*)karg(19)) + WS_WOUT), 0, scr, r, F.lane); continue; } r -= I_SQ;
        p0_transpose_item(((const float*)karg(13)), D, D, D, (bf16*)(((unsigned char*)karg(19)) + WS_WQ), 0, scr, r, F.lane);
    }
}

__device__ __forceinline__ void p1_norm(Frame& F) {
    const float* x = ((const float*)karg(0)); const float* g1 = ((const float*)karg(2)); const float* w_in = ((const float*)karg(6)); const float* b_forget = ((const float*)karg(7));
    const float* MOD = (const float*)(((unsigned char*)karg(19)) + WS_MOD); bf16* H = (bf16*)(((unsigned char*)karg(19)) + WS_H); float* LOGF = (float*)(((unsigned char*)karg(19)) + WS_LOGF);
    LAS float* wfl = (LAS float*)(F.lds);
    { float tmp[16];
#pragma unroll
      for (int n = 0; n < 16; ++n) { const int i = F.tid + n * NTHR; tmp[n] = w_in[(size_t)(i >> 3) * LDW_IN + 2304 + (i & 7)]; }
#pragma unroll
      for (int n = 0; n < 16; ++n) { const int i = F.tid + n * NTHR; wfl[(i & 7) * 1024 + (i >> 3)] = tmp[n]; } }
    __syncthreads();
    const int gw = F.vcu * NWAVES + F.wave, NGW = F.G * NWAVES;
    for (int c = gw; c < M / 8; c += NGW) {
        const int row0 = c * 8; const float* mb = MOD + (row0 >> 12) * NMOD;
        f32x4 ga[4], sh[4];
#pragma unroll
        for (int j = 0; j < 4; ++j) { const int col = 4 * F.lane + 256 * j; const f32x4 g = *(const f32x4*)(g1 + col), sc = *(const f32x4*)(mb + 1024 + col); sh[j] = *(const f32x4*)(mb + col); ga[j] = g * (sc + 1.0f); }
        f32x4 r0[4], r1[4], r2[4];
        { const f32x4* xr = (const f32x4*)(x + (size_t)row0 * D) + F.lane;
#pragma unroll
          for (int j = 0; j < 4; ++j) r0[j] = __builtin_nontemporal_load(xr + 64 * j);
#pragma unroll
          for (int j = 0; j < 4; ++j) r1[j] = __builtin_nontemporal_load(xr + 256 + 64 * j); }
#pragma unroll
        for (int i = 0; i < 8; ++i) {
            const int row = row0 + i;
            if (i + 2 < 8) { const f32x4* xr = (const f32x4*)(x + (size_t)(row + 2) * D) + F.lane;
#pragma unroll
                for (int j = 0; j < 4; ++j) r2[j] = __builtin_nontemporal_load(xr + 64 * j); }
            float ss = 0.f;
#pragma unroll
            for (int j = 0; j < 4; ++j) ss += (r0[j].x * r0[j].x + r0[j].y * r0[j].y) + (r0[j].z * r0[j].z + r0[j].w * r0[j].w);
            ss = wave_sum(ss);
            const float rstd = 1.0f / sqrtf(ss * (1.0f / D) + EPS);
            float fl[8];
#pragma unroll
            for (int jj = 0; jj < 8; ++jj) fl[jj] = 0.f;
#pragma unroll
            for (int j = 0; j < 4; ++j) { const int col = 4 * F.lane + 256 * j;
                const f32x4 hv = (r0[j] * rstd) * ga[j] + sh[j];
                u32x2 w; w.x = cvtpk(hv.x, hv.y); w.y = cvtpk(hv.z, hv.w);
                *(u32x2*)(H + (size_t)row * D + col) = w;
#pragma unroll
                for (int jj = 0; jj < 8; ++jj) { const f32x4 wv = *(const LAS f32x4*)(wfl + jj * 1024 + col); fl[jj] += (hv.x * wv.x + hv.y * wv.y) + (hv.z * wv.z + hv.w * wv.w); }
            }
            const int lane = F.lane; const float r1s = reduce8_t(fl, lane);
            if ((lane & 7) == 0) { const int jj = lane >> 3; const float z = r1s + b_forget[jj]; const float ls = fminf(z, 0.f) - log1pf(__expf(-fabsf(z))); LOGF[(size_t)row * 8 + jj] = ls; }
#pragma unroll
            for (int j = 0; j < 4; ++j) { r0[j] = r1[j]; r1[j] = r2[j]; }
        }
    }
}

constexpr int KP = 72;
constexpr int VPF = 68;
constexpr int VPS = 260;
struct FlashState { f32x16 o[2]; float m, l; };

__device__ __forceinline__ void flash_tail(FlashState& st, f32x16& s0, f32x16& s1, const LAS bf16* Vs, int vp, int r32, int hi) {
    float mt = s0[0];
#pragma unroll
    for (int r = 1; r < 16; ++r) mt = fmaxf(mt, s0[r]);
#pragma unroll
    for (int r = 0; r < 16; ++r) mt = fmaxf(mt, s1[r]);
    mt = fmaxf(mt, __uint_as_float(xorx<32>(__float_as_uint(mt), 32 * hi)));
    const float mn = fmaxf(st.m, mt);
    const float alpha = __expf(st.m - mn);
    st.m = mn;
    float ps = 0.f;
#pragma unroll
    for (int r = 0; r < 16; ++r) { s0[r] = __expf(s0[r] - mn); ps += s0[r]; }
#pragma unroll
    for (int r = 0; r < 16; ++r) { s1[r] = __expf(s1[r] - mn); ps += s1[r]; }
    st.l = st.l * alpha + ps;
    if (__any(alpha != 1.0f)) {
#pragma unroll
        for (int r = 0; r < 16; ++r) { st.o[0][r] *= alpha; st.o[1][r] *= alpha; }
    }
#pragma unroll
    for (int blk = 0; blk < 2; ++blk)
#pragma unroll
        for (int s = 0; s < 2; ++s) {
            v4u pw;
            if (blk == 0) { pw.x = cvtpk(s0[8 * s + 0], s0[8 * s + 1]); pw.y = cvtpk(s0[8 * s + 2], s0[8 * s + 3]); pw.z = cvtpk(s0[8 * s + 4], s0[8 * s + 5]); pw.w = cvtpk(s0[8 * s + 6], s0[8 * s + 7]); }
            else          { pw.x = cvtpk(s1[8 * s + 0], s1[8 * s + 1]); pw.y = cvtpk(s1[8 * s + 2], s1[8 * s + 3]); pw.z = cvtpk(s1[8 * s + 4], s1[8 * s + 5]); pw.w = cvtpk(s1[8 * s + 6], s1[8 * s + 7]); }
            const bf16x8 pf = __builtin_bit_cast(bf16x8, pw);
#pragma unroll
            for (int db = 0; db < 2; ++db) {
                const LAS bf16* vp0 = Vs + (32 * db + r32) * vp + 32 * blk + 16 * s + 4 * hi;
                const s16x4 lo = *(const LAS s16x4*)vp0, hh = *(const LAS s16x4*)(vp0 + 8);
                const bf16x8 vf = __builtin_shufflevector(lo, hh, 0, 1, 2, 3, 4, 5, 6, 7);
                st.o[db] = MFMA32(vf, pf, st.o[db]);
            }
        }
}
__device__ __forceinline__ void flash_qk(f32x16& s0, f32x16& s1, const bf16x8 (&qf)[4], const LAS bf16* Ks, int r32, int hi) {
    s0 = (f32x16){0.f}; s1 = (f32x16){0.f};
#pragma unroll
    for (int r = 0; r < 16; ++r) { s0[r] = 0.f; s1[r] = 0.f; }
#pragma unroll
    for (int ks = 0; ks < 4; ++ks) {
        const bf16x8 a0 = *(const LAS bf16x8*)(Ks + r32 * KP + 16 * ks + 8 * hi);
        const bf16x8 a1 = *(const LAS bf16x8*)(Ks + (32 + r32) * KP + 16 * ks + 8 * hi);
        s0 = MFMA32(a0, qf[ks], s0); s1 = MFMA32(a1, qf[ks], s1);
    }
}
__device__ __forceinline__ void flash_qk2(f32x16& a0, f32x16& a1, f32x16& b0, f32x16& b1, const bf16x8 (&qa)[4], const bf16x8 (&qb)[4], const LAS bf16* Ks, int r32, int hi) {
#pragma unroll
    for (int r = 0; r < 16; ++r) { a0[r] = 0.f; a1[r] = 0.f; b0[r] = 0.f; b1[r] = 0.f; }
#pragma unroll
    for (int ks = 0; ks < 4; ++ks) {
        const bf16x8 k0 = *(const LAS bf16x8*)(Ks + r32 * KP + 16 * ks + 8 * hi);
        const bf16x8 k1 = *(const LAS bf16x8*)(Ks + (32 + r32) * KP + 16 * ks + 8 * hi);
        a0 = MFMA32(k0, qa[ks], a0); b0 = MFMA32(k0, qb[ks], b0); a1 = MFMA32(k1, qa[ks], a1); b1 = MFMA32(k1, qb[ks], b1);
    }
}
__device__ __forceinline__ void flash_soft(FlashState& st, f32x16& s0, f32x16& s1, int hi) {
    float mt = s0[0];
#pragma unroll
    for (int r = 1; r < 16; ++r) mt = fmaxf(mt, s0[r]);
#pragma unroll
    for (int r = 0; r < 16; ++r) mt = fmaxf(mt, s1[r]);
    mt = fmaxf(mt, __uint_as_float(xorx<32>(__float_as_uint(mt), 32 * hi)));
    const float mn = fmaxf(st.m, mt);
    const float alpha = __expf(st.m - mn);
    st.m = mn;
    float ps = 0.f;
#pragma unroll
    for (int r = 0; r < 16; ++r) { s0[r] = __expf(s0[r] - mn); ps += s0[r]; }
#pragma unroll
    for (int r = 0; r < 16; ++r) { s1[r] = __expf(s1[r] - mn); ps += s1[r]; }
    st.l = st.l * alpha + ps;
    if (__any(alpha != 1.0f)) {
#pragma unroll
        for (int r = 0; r < 16; ++r) { st.o[0][r] *= alpha; st.o[1][r] *= alpha; }
    }
}
__device__ __forceinline__ bf16x8 pack_p(const f32x16& p, int s) {
    v4u pw; pw.x = cvtpk(p[8 * s + 0], p[8 * s + 1]); pw.y = cvtpk(p[8 * s + 2], p[8 * s + 3]); pw.z = cvtpk(p[8 * s + 4], p[8 * s + 5]); pw.w = cvtpk(p[8 * s + 6], p[8 * s + 7]);
    return __builtin_bit_cast(bf16x8, pw);
}
__device__ __forceinline__ void flash_pv2(FlashState& sa, FlashState& sb, const f32x16& a0, const f32x16& a1, const f32x16& b0, const f32x16& b1, const LAS bf16* Vs, int vp, int r32, int hi) {
#pragma unroll
    for (int blk = 0; blk < 2; ++blk)
#pragma unroll
        for (int s = 0; s < 2; ++s) {
            const bf16x8 pfa = blk ? pack_p(a1, s) : pack_p(a0, s), pfb = blk ? pack_p(b1, s) : pack_p(b0, s);
#pragma unroll
            for (int db = 0; db < 2; ++db) {
                const LAS bf16* vp0 = Vs + (32 * db + r32) * vp + 32 * blk + 16 * s + 4 * hi;
                const s16x4 lo = *(const LAS s16x4*)vp0, hh = *(const LAS s16x4*)(vp0 + 8);
                const bf16x8 vf = __builtin_shufflevector(lo, hh, 0, 1, 2, 3, 4, 5, 6, 7);
                sa.o[db] = MFMA32(vf, pfa, sa.o[db]); sb.o[db] = MFMA32(vf, pfb, sb.o[db]);
            }
        }
}
__device__ __forceinline__ void flash_store(const FlashState& st, bf16* orow, int hi) {
    float lt = st.l + __uint_as_float(xorx<32>(__float_as_uint(st.l), 32 * hi));
    const float inv = 1.0f / lt;
#pragma unroll
    for (int db = 0; db < 2; ++db)
#pragma unroll
        for (int rg = 0; rg < 4; ++rg) { u32x2 w; w.x = cvtpk(st.o[db][4 * rg] * inv, st.o[db][4 * rg + 1] * inv); w.y = cvtpk(st.o[db][4 * rg + 2] * inv, st.o[db][4 * rg + 3] * inv);
            *(u32x2*)(orow + 32 * db + 8 * rg + 4 * hi) = w; }
}

__device__ __forceinline__ void fox_unit(Frame& F, int b, int h, int qb, float& kmax2) {
    const bf16* proj = (const bf16*)(((unsigned char*)karg(19)) + WS_PROJ); const float* LOGF = (const float*)(((unsigned char*)karg(19)) + WS_LOGF); bf16* OB = (bf16*)(((unsigned char*)karg(19)) + WS_OB);
    LAS float* Fs = (LAS float*)(F.lds);
    LAS float* wtot = (LAS float*)(F.lds + 16384);
    LAS bf16* Kb = (LAS bf16*)(F.lds + 16384 + 128);
    LAS bf16* Vb = (LAS bf16*)(F.lds + 16384 + 128 + 2 * 64 * KP * 2);
    const int lane = F.lane, wave = F.wave, tid = F.tid, r32 = lane & 31, hi = lane >> 5;
    const int q_end = 512 * (qb + 1), NT = q_end / 64;
    const size_t rowbase = (size_t)b * SEQ;
    if (kmax2 < 0.f) {
        float v[8]; float run = 0.f;
#pragma unroll
        for (int i = 0; i < 8; ++i) { const int pos = tid * 8 + i; const float lf = (pos < q_end) ? LOGF[(rowbase + pos) * 8 + h] : 0.f; run += lf; v[i] = run; }
        float inc = run;
#pragma unroll
        for (int o = 1; o < 64; o <<= 1) { const float t = __shfl_up(inc, o); if (lane >= o) inc += t; }
        if (lane == 63) wtot[wave] = inc;
        __syncthreads();
        float off = inc - run;
        for (int w = 0; w < wave; ++w) off += wtot[w];
#pragma unroll
        for (int i = 0; i < 8; ++i) Fs[tid * 8 + i] = v[i] + off;
    }
    const int qrow = 512 * qb + 64 * wave + r32, qrowB = qrow + 32;
    bf16x8 qf[4], qg[4];
    { const bf16* qp = proj + (rowbase + qrow) * NPROJ + C_QB + 64 * h + 8 * hi;
#pragma unroll
      for (int ks = 0; ks < 4; ++ks) { qf[ks] = *(const bf16x8*)(qp + 16 * ks); qg[ks] = *(const bf16x8*)(qp + (size_t)32 * NPROJ + 16 * ks); } }
    const int tq = 8 * qb + wave;
    LAS bf16* Qs = (LAS bf16*)(F.lds + 53248) + wave * (64 * KP);
    {
        float qn = 0.f;
#pragma unroll
        for (int ks = 0; ks < 4; ++ks)
#pragma unroll
            for (int j = 0; j < 8; ++j) { const float e = __uint_as_float(((unsigned)(unsigned short)qf[ks][j]) << 16); qn += e * e; }
        qn += __shfl_xor(qn, 32);
        { float qn2 = 0.f;
#pragma unroll
          for (int ks = 0; ks < 4; ++ks)
#pragma unroll
              for (int j = 0; j < 8; ++j) { const float e = __uint_as_float(((unsigned)(unsigned short)qg[ks][j]) << 16); qn2 += e * e; }
          qn2 += __shfl_xor(qn2, 32); qn = fmaxf(qn, qn2); }
#pragma unroll
        for (int o = 1; o < 32; o <<= 1) qn = fmaxf(qn, __shfl_xor(qn, o));
        float kn = 0.f;
        if (kmax2 < 0.f) {
            for (int p0 = 0; p0 < q_end; p0 += 4 * 64) {
                v4u w4[4];
#pragma unroll
                for (int i = 0; i < 4; ++i) w4[i] = *(const v4u*)(proj + (rowbase + p0 + 64 * i + (tid >> 3)) * NPROJ + C_KB + 64 * h + 8 * (tid & 7));
#pragma unroll
                for (int i = 0; i < 4; ++i) { const unsigned wx = w4[i].x, wy = w4[i].y, wz = w4[i].z, ww = w4[i].w;
                    float s = bflo(wx) * bflo(wx) + bfhi(wx) * bfhi(wx) + bflo(wy) * bflo(wy) + bfhi(wy) * bfhi(wy) + bflo(wz) * bflo(wz) + bfhi(wz) * bfhi(wz) + bflo(ww) * bflo(ww) + bfhi(ww) * bfhi(ww);
                    s += __shfl_xor(s, 1); s += __shfl_xor(s, 2); s += __shfl_xor(s, 4);
                    kn = fmaxf(kn, s); } }
            kn = wave_max(kn);
        }
        if (lane == 0) { wtot[8 + wave] = qn; wtot[16 + wave] = kn; }
    }
#pragma unroll
    for (int ks = 0; ks < 4; ++ks) { *(LAS bf16x8*)(Qs + r32 * KP + 16 * ks + 8 * hi) = qf[ks]; *(LAS bf16x8*)(Qs + (32 + r32) * KP + 16 * ks + 8 * hi) = qg[ks]; }
    FlashState st, su; st.m = -INFINITY; st.l = 0.f; su.m = -INFINITY; su.l = 0.f;
#pragma unroll
    for (int r = 0; r < 16; ++r) { st.o[0][r] = 0.f; st.o[1][r] = 0.f; su.o[0][r] = 0.f; su.o[1][r] = 0.f; }
    const int srow = tid >> 3, sch = tid & 7;
    const bf16* kg = proj + (rowbase + srow) * NPROJ + C_KB + 64 * h + 8 * sch;
    const bf16* vg = proj + (rowbase + srow) * NPROJ + C_VB + 64 * h + 8 * sch;
    v4u kreg, vreg;
    { const size_t o = (size_t)(NT - 1) * 64 * NPROJ; kreg = *(const v4u*)(kg + o); vreg = *(const v4u*)(vg + o); }
    int cur = 0;
    {   *(LAS v4u*)(Kb + srow * KP + 8 * sch) = kreg;
        const unsigned short* vs = (const unsigned short*)&vreg;
#pragma unroll
        for (int i = 0; i < 8; ++i) Vb[(8 * sch + i) * VPF + srow] = vs[i];
    }
    __syncthreads();
    const float fq = Fs[qrow], fqB = Fs[qrowB];
    int t_lo = 0;
    {
        float qm = 0.f, km = 0.f;
#pragma unroll
        for (int w = 0; w < 8; ++w) { qm = fmaxf(qm, wtot[8 + w]); km = fmaxf(km, wtot[16 + w]); }
        if (kmax2 < 0.f) kmax2 = km;
        const float A = 0.125f * sqrtf(qm) * sqrtf(kmax2) * 1.01f, f0 = Fs[512 * qb];
        for (int t = NT - 9; t >= 0; --t) if (Fs[64 * t + 63] - f0 > 2.0f * A + 60.0f) { t_lo = t + 1; break; }
    }
    for (int t = NT - 1; t >= t_lo; --t) {
        if (t > t_lo) { const size_t o = (size_t)(t - 1) * 64 * NPROJ; kreg = *(const v4u*)(kg + o); vreg = *(const v4u*)(vg + o); }
        if (t <= tq) {
            const LAS bf16* Ks = Kb + cur * 64 * KP; const LAS bf16* Vs = Vb + cur * 64 * VPF;
            bf16x8 qa[4], qb4[4];
#pragma unroll
            for (int ks = 0; ks < 4; ++ks) { qa[ks] = *(const LAS bf16x8*)(Qs + r32 * KP + 16 * ks + 8 * hi); qb4[ks] = *(const LAS bf16x8*)(Qs + (32 + r32) * KP + 16 * ks + 8 * hi); }
            f32x16 s0, s1, u0, u1; flash_qk2(s0, s1, u0, u1, qa, qb4, Ks, r32, hi);
            const LAS float* Fk = Fs + 64 * t;
            const bool diag = (t == tq);
#pragma unroll
            for (int rg = 0; rg < 4; ++rg) {
                const f32x4 f0 = *(const LAS f32x4*)(Fk + 8 * rg + 4 * hi), f1 = *(const LAS f32x4*)(Fk + 32 + 8 * rg + 4 * hi);
#pragma unroll
                for (int i = 0; i < 4; ++i) { const int r = 4 * rg + i; const int kv = 64 * t + 8 * rg + 4 * hi + i;
                    float a = s0[r] * 0.125f + (fq - f0[i]), c = s1[r] * 0.125f + (fq - f1[i]), d = u0[r] * 0.125f + (fqB - f0[i]), e = u1[r] * 0.125f + (fqB - f1[i]);
                    if (diag) { if (kv > qrow) a = -INFINITY; if (kv + 32 > qrow) c = -INFINITY; if (kv > qrowB) d = -INFINITY; if (kv + 32 > qrowB) e = -INFINITY; }
                    s0[r] = a; s1[r] = c; u0[r] = d; u1[r] = e; }
            }
            flash_soft(st, s0, s1, hi); flash_soft(su, u0, u1, hi);
            flash_pv2(st, su, s0, s1, u0, u1, Vs, VPF, r32, hi);
        }
        if (t > t_lo) {
            const int nb = cur ^ 1;
            *(LAS v4u*)(Kb + nb * 64 * KP + srow * KP + 8 * sch) = kreg;
            const unsigned short* vs = (const unsigned short*)&vreg;
#pragma unroll
            for (int i = 0; i < 8; ++i) Vb[nb * 64 * VPF + (8 * sch + i) * VPF + srow] = vs[i];
        }
        __syncthreads();
        cur ^= 1;
    }
    flash_store(st, OB + (rowbase + qrow) * 512 + 64 * h, hi); flash_store(su, OB + (rowbase + qrowB) * 512 + 64 * h, hi);
    __syncthreads();
}

__device__ const unsigned char T5_BUCKET[128] = {0,1,2,3,4,5,6,7,8,9,10,11,12,13,14,15,16,16,16,17,17,18,18,18,19,19,19,20,20,20,20,21,21,21,21,22,22,22,22,22,23,23,23,23,23,23,24,24,24,24,24,24,25,25,25,25,25,25,25,26,26,26,26,26,26,26,26,27,27,27,27,27,27,27,27,27,27,28,28,28,28,28,28,28,28,28,28,29,29,29,29,29,29,29,29,29,29,29,29,30,30,30,30,30,30,30,30,30,30,30,30,30,30,31,31,31,31,31,31,31,31,31,31,31,31,31,31,31};

__device__ __forceinline__ void swa_unit(Frame& F, int b, int kvh, int n) {
    const bf16* proj = (const bf16*)(((unsigned char*)karg(19)) + WS_PROJ); bf16* OA = (bf16*)(((unsigned char*)karg(19)) + WS_OA);
    const float* sinks = ((const float*)karg(8)); const float* rel_bias = ((const float*)karg(12));
    LAS bf16* Kb = (LAS bf16*)(F.lds);
    LAS bf16* Vb = (LAS bf16*)(F.lds + 36864);
    LAS float* bt = (LAS float*)(F.lds + 36864 + 33280);
    const int lane = F.lane, wave = F.wave, tid = F.tid, r32 = lane & 31, hi = lane >> 5;
    const size_t rowbase = (size_t)b * SEQ;
    {
        const int g = tid >> 7, d = tid & 127;
        bt[tid] = rel_bias[(int)T5_BUCKET[d] * 8 + kvh * 4 + g];
#pragma unroll
        for (int i = 0; i < 4; ++i) {
            const int idx = tid + i * NTHR, kb = idx >> 3, sch = idx & 7; const int pos = 128 * (n - 1) + kb;
            v4u kreg = (v4u){0u, 0u, 0u, 0u}, vreg = (v4u){0u, 0u, 0u, 0u};
            if (pos >= 0) { const bf16* p = proj + (rowbase + pos) * NPROJ + 64 * kvh + 8 * sch; kreg = *(const v4u*)(p + C_KA); vreg = *(const v4u*)(p + C_VA); }
            *(LAS v4u*)(Kb + kb * KP + 8 * sch) = kreg;
            const unsigned short* vs = (const unsigned short*)&vreg;
#pragma unroll
            for (int j = 0; j < 8; ++j) Vb[(8 * sch + j) * VPS + kb] = vs[j];
        }
    }
    __syncthreads();
    const int g = wave & 3, qh = wave >> 2, head = kvh * 4 + g;
    const LAS float* btg = bt + g * 128;
    for (int sb = 0; sb < 2; ++sb) {
        const int qrel0 = 64 * qh + 32 * sb, qrel = qrel0 + r32;
        const size_t row = rowbase + 128 * n + qrel;
        bf16x8 qf[4];
        { const bf16* qp = proj + row * NPROJ + C_QA + 64 * head + 8 * hi;
#pragma unroll
          for (int ks = 0; ks < 4; ++ks) qf[ks] = *(const bf16x8*)(qp + 16 * ks); }
        FlashState st; st.m = sinks[head]; st.l = (hi == 0) ? 1.0f : 0.0f;
#pragma unroll
        for (int r = 0; r < 16; ++r) { st.o[0][r] = 0.f; st.o[1][r] = 0.f; }
        const int t_lo = (qrel0 + 1) >> 6, t_hi = (qrel0 + 159) >> 6;
        for (int t = t_lo; t <= t_hi; ++t) {
            f32x16 s0, s1; flash_qk(s0, s1, qf, Kb + t * 64 * KP, r32, hi);
#pragma unroll
            for (int r = 0; r < 16; ++r) {
                const int kb0 = 64 * t + crow(r, hi), kb1 = kb0 + 32;
                const int d0 = 128 + qrel - kb0, d1 = d0 - 32;
                const bool v0 = (d0 >= 0) && (d0 < 128) && (n > 0 || kb0 >= 128);
                const bool v1 = (d1 >= 0) && (d1 < 128) && (n > 0 || kb1 >= 128);
                const float b0 = btg[d0 & 127], b1 = btg[d1 & 127];
                s0[r] = v0 ? (s0[r] * 0.125f + b0) : -INFINITY;
                s1[r] = v1 ? (s1[r] * 0.125f + b1) : -INFINITY;
            }
            flash_tail(st, s0, s1, Vb + 64 * t, VPS, r32, hi);
        }
        flash_store(st, OA + row * 512 + 64 * head, hi);
    }
    __syncthreads();
}
__device__ __forceinline__ void p3_attention(Frame& F) {
    for (int item = F.vcu; item < 256; item += F.G) {
        swa_unit(F, item >> 6, (item >> 5) & 1, item & 31);
        const int bh = item >> 3, j = item & 7;
        float kmax2 = -1.0f;
        fox_unit(F, bh >> 3, bh & 7, j, kmax2);
    }
}

struct PairOrder {
    pg8::StaticOrder S;
    __device__ bool next(int i, pg8::Unit& u) const { if (!S.next(i >> 1, u)) return false; u.src = i & 1; return true; }
    __device__ __forceinline__ void a_ready(const pg8::Unit&) const {}
    __device__ __forceinline__ void done(const pg8::Unit&) const {}
};
__device__ __forceinline__ float sigmoidf_(float z) { return 1.0f / (1.0f + __expf(-z)); }
struct EpiGate {
    static constexpr bool PERM = true, AFTER_DRAIN = false, CHAIN = true;
    const bf16* proj; bf16* mixed;
    __device__ __forceinline__ void operator()(pg8::f32x4 (&acc)[2][2][4][2], const pg8::Unit& u, int wr, int wc, int fr, int fq) const {
#pragma unroll
        for (int ai = 0; ai < 2; ++ai) {
            v4u gbv[4][2], gav[4][2];
#pragma unroll
            for (int m = 0; m < 4; ++m) { const size_t row = (size_t)u.pm * 256 + ai * 128 + wr * 64 + m * 16 + fr;
#pragma unroll
                for (int bj = 0; bj < 2; ++bj) { const int col0 = u.pn * 256 + bj * 128 + wc * 32 + 8 * fq;
                    gbv[m][bj] = *(const v4u*)(proj + row * NPROJ + C_GLB + col0);
                    if (u.src == 0) gav[m][bj] = __builtin_nontemporal_load((const v4u*)(proj + row * NPROJ + C_GLA + col0)); } }
#pragma unroll
            for (int m = 0; m < 4; ++m) { const size_t row = (size_t)u.pm * 256 + ai * 128 + wr * 64 + m * 16 + fr;
#pragma unroll
                for (int bj = 0; bj < 2; ++bj) { const int col0 = u.pn * 256 + bj * 128 + wc * 32 + 8 * fq;
                    const unsigned gbw[4] = {gbv[m][bj].x, gbv[m][bj].y, gbv[m][bj].z, gbv[m][bj].w};
                    if (u.src == 0) {
                        const unsigned gaw[4] = {gav[m][bj].x, gav[m][bj].y, gav[m][bj].z, gav[m][bj].w};
#pragma unroll
                        for (int e = 0; e < 8; ++e) { const float za = (e & 1) ? bfhi(gaw[e >> 1]) : bflo(gaw[e >> 1]), zb = (e & 1) ? bfhi(gbw[e >> 1]) : bflo(gbw[e >> 1]);
                            const float ratio = (1.0f + __expf(-zb)) * __builtin_amdgcn_rcpf(1.0f + __expf(-za));
                            acc[ai][bj][m][e >> 2][e & 3] *= ratio; }
                    } else {
                        float v[8];
#pragma unroll
                        for (int e = 0; e < 8; ++e) { const float zb = (e & 1) ? bfhi(gbw[e >> 1]) : bflo(gbw[e >> 1]); v[e] = acc[ai][bj][m][e >> 2][e & 3] * __builtin_amdgcn_rcpf(1.0f + __expf(-zb)); }
                        v4u w; w.x = cvtpk(v[0], v[1]); w.y = cvtpk(v[2], v[3]); w.z = cvtpk(v[4], v[5]); w.w = cvtpk(v[6], v[7]);
                        *(v4u*)(mixed + row * D + col0) = w;
                    }
                }
            }
        }
    }
};
struct EpiRes {
    static constexpr bool PERM = true, AFTER_DRAIN = false, CHAIN = false;
    const float* x; const float* mod; float* x1;
    __device__ __forceinline__ void operator()(const pg8::f32x4 (&acc)[2][2][4][2], const pg8::Unit& u, int wr, int wc, int fr, int fq) const {
        const int b = (u.pm * 256) >> 12;
        pg8::f32x4 gt[2][2];
#pragma unroll
        for (int bj = 0; bj < 2; ++bj)
#pragma unroll
            for (int n = 0; n < 2; ++n) gt[bj][n] = *(const pg8::f32x4*)(mod + b * NMOD + 2048 + u.pn * 256 + bj * 128 + wc * 32 + 8 * fq + 4 * n);
#pragma unroll
        for (int ai = 0; ai < 2; ++ai) {
            pg8::f32x4 xin[4][2][2];
#pragma unroll
            for (int m = 0; m < 4; ++m) { const size_t row = (size_t)u.pm * 256 + ai * 128 + wr * 64 + m * 16 + fr;
#pragma unroll
                for (int bj = 0; bj < 2; ++bj)
#pragma unroll
                    for (int n = 0; n < 2; ++n) xin[m][bj][n] = __builtin_nontemporal_load((const pg8::f32x4*)(x + row * D + u.pn * 256 + bj * 128 + wc * 32 + 8 * fq + 4 * n)); }
#pragma unroll
            for (int m = 0; m < 4; ++m) { const size_t row = (size_t)u.pm * 256 + ai * 128 + wr * 64 + m * 16 + fr;
#pragma unroll
                for (int bj = 0; bj < 2; ++bj)
#pragma unroll
                    for (int n = 0; n < 2; ++n) *(pg8::f32x4*)(x1 + row * D + u.pn * 256 + bj * 128 + wc * 32 + 8 * fq + 4 * n) = xin[m][bj][n] + gt[bj][n] * acc[ai][bj][m][n]; }
        }
    }
};

__device__ __forceinline__ void p6_norm2(Frame& F) {
    const float* x1 = (const float*)(((unsigned char*)karg(19)) + WS_X1); const float* g2 = ((const float*)karg(3)); const float* MOD = (const float*)(((unsigned char*)karg(19)) + WS_MOD); bf16* H2 = (bf16*)(((unsigned char*)karg(19)) + WS_H2); unsigned char* H2Q = (unsigned char*)(((unsigned char*)karg(19)) + WS_H2Q); float* H2S = (float*)(((unsigned char*)karg(19)) + WS_H2S);
    const int gw = F.vcu * NWAVES + F.wave, NGW = F.G * NWAVES;
    for (int c = gw; c < M / 8; c += NGW) {
        const int row0 = c * 8; const float* mb = MOD + (row0 >> 12) * NMOD;
        f32x4 ga[4], sh[4];
#pragma unroll
        for (int j = 0; j < 4; ++j) { const int col = 4 * F.lane + 256 * j; const f32x4 g = *(const f32x4*)(g2 + col), sc = *(const f32x4*)(mb + 4096 + col); sh[j] = *(const f32x4*)(mb + 3072 + col); ga[j] = g * (sc + 1.0f); }
        f32x4 r0[4], r1[4], r2[4];
        { const f32x4* xr = (const f32x4*)(x1 + (size_t)row0 * D) + F.lane;
#pragma unroll
          for (int j = 0; j < 4; ++j) r0[j] = xr[64 * j];
#pragma unroll
          for (int j = 0; j < 4; ++j) r1[j] = xr[256 + 64 * j]; }
#pragma unroll
        for (int i = 0; i < 8; ++i) {
            const int row = row0 + i;
            if (i + 2 < 8) { const f32x4* xr = (const f32x4*)(x1 + (size_t)(row + 2) * D) + F.lane;
#pragma unroll
                for (int j = 0; j < 4; ++j) r2[j] = xr[64 * j]; }
            f32x4 hq[4]; float ss = 0.f;
#pragma unroll
            for (int j = 0; j < 4; ++j) ss += (r0[j].x * r0[j].x + r0[j].y * r0[j].y) + (r0[j].z * r0[j].z + r0[j].w * r0[j].w);
            ss = wave_sum(ss);
            const float rstd = 1.0f / sqrtf(ss * (1.0f / D) + EPS);
#pragma unroll
            for (int j = 0; j < 4; ++j) { const int col = 4 * F.lane + 256 * j;
                const f32x4 hv = (r0[j] * rstd) * ga[j] + sh[j];
                u32x2 w; w.x = cvtpk(hv.x, hv.y); w.y = cvtpk(hv.z, hv.w);
                *(u32x2*)(H2 + (size_t)row * D + col) = w; hq[j] = hv; }
            float am = 0.f;
#pragma unroll
            for (int j = 0; j < 4; ++j) am = fmaxf(fmaxf(am, fmaxf(fabsf(hq[j].x), fabsf(hq[j].y))), fmaxf(fabsf(hq[j].z), fabsf(hq[j].w)));
            am = wave_max(am);
            const float sc = am > 0.f ? am * (1.0f / 127.0f) : 1.0f, inv = 1.0f / sc;
            v4u qa;
#pragma unroll
            for (int j = 0; j < 4; ++j) { const int b0 = (int)rintf(hq[j].x * inv), b1 = (int)rintf(hq[j].y * inv), b2 = (int)rintf(hq[j].z * inv), b3 = (int)rintf(hq[j].w * inv);
                qa[j] = (unsigned)(b0 & 255) | ((unsigned)(b1 & 255) << 8) | ((unsigned)(b2 & 255) << 16) | ((unsigned)(b3 & 255) << 24); }
            __builtin_nontemporal_store(qa, (v4u*)(H2Q + (size_t)row * D + 16 * F.lane));
            if (F.lane == 0) H2S[row] = sc;
#pragma unroll
            for (int j = 0; j < 4; ++j) { r0[j] = r1[j]; r1[j] = r2[j]; }
        }
    }
}

__device__ __forceinline__ unsigned f2ord(float f) { const unsigned u = __float_as_uint(f); return u ^ ((unsigned)((int)u >> 31) | 0x80000000u); }
__device__ __forceinline__ float ord2f(unsigned o) { const unsigned u = (o & 0x80000000u) ? (o & 0x7fffffffu) : ~o; return __uint_as_float(u); }
#define CE_DESC(a, b) do { const unsigned _x = (a), _y = (b); (a) = _x > _y ? _x : _y; (b) = _x > _y ? _y : _x; } while (0)
__device__ __forceinline__ void sort16(unsigned (&k)[16]) {
#pragma unroll
    for (int size = 2; size <= 16; size <<= 1)
#pragma unroll
        for (int stride = size >> 1; stride > 0; stride >>= 1)
#pragma unroll
            for (int i = 0; i < 16; ++i) { const int j = i ^ stride; if (j > i) { if ((i & size) == 0) CE_DESC(k[i], k[j]); else CE_DESC(k[j], k[i]); } }
}
__device__ __forceinline__ void merge16(unsigned (&a)[16], const unsigned (&b)[16]) {
#pragma unroll
    for (int i = 0; i < 16; ++i) a[i] = a[i] > b[15 - i] ? a[i] : b[15 - i];
#pragma unroll
    for (int stride = 8; stride > 0; stride >>= 1)
#pragma unroll
        for (int i = 0; i < 16; ++i) { const int j = i ^ stride; if (j > i) CE_DESC(a[i], a[j]); }
}
__device__ __forceinline__ void top16_of_64(unsigned (&g0)[16], unsigned (&g1)[16], unsigned (&g2)[16], unsigned (&g3)[16]) {
    sort16(g0); sort16(g1); sort16(g2); sort16(g3);
    merge16(g0, g1); merge16(g2, g3); merge16(g0, g2);
}
constexpr int NCAND = 50;
__device__ __forceinline__ void p8a_topk(Frame& F) {
    const bf16* QP = (const bf16*)(((unsigned char*)karg(19)) + WS_QP); const bf16* SUBK = (const bf16*)(((unsigned char*)karg(19)) + WS_SUBK);
    unsigned short* PIDX = (unsigned short*)(((unsigned char*)karg(19)) + WS_PIDX); float* PG = (float*)(((unsigned char*)karg(19)) + WS_PG);
    LAS unsigned short* Elds = (LAS unsigned short*)(F.lds) + F.wave * (NCAND * 64);
    const int lane = F.lane, r32 = lane & 31, hi = lane >> 5;
    const int gw = F.vcu * NWAVES + F.wave, NGW = F.G * NWAVES;
    for (int it2 = 0; it2 < 2 * ((M / 64 - F.vcu + F.G - 1) / F.G); ++it2) {
        const int wi = F.vcu + (it2 >> 1) * F.G;
        const int tile = 2 * wi + (it2 & 1);
        const int tok = tile * 32 + r32;
        { const int h = F.wave;
            unsigned top[2][16];
#pragma unroll
            for (int p = 0; p < 2; ++p) {
                bf16x8 qf[4];
                { const bf16* qp = QP + (size_t)tok * D + h * 128 + p * 64 + 8 * hi;
#pragma unroll
                  for (int ks = 0; ks < 4; ++ks) qf[ks] = *(const bf16x8*)(qp + 16 * ks); }
                const bf16* kp = SUBK + (size_t)((h * 2 + p) * 128 + r32) * 64 + 8 * hi;
                unsigned kk[4][16];
#pragma unroll
                for (int blk = 0; blk < 4; ++blk) {
                    f32x16 acc;
#pragma unroll
                    for (int r = 0; r < 16; ++r) acc[r] = 0.f;
#pragma unroll
                    for (int ks = 0; ks < 4; ++ks) { const bf16x8 a = *(const bf16x8*)(kp + (size_t)blk * 32 * 64 + 16 * ks); acc = MFMA32(a, qf[ks], acc); }
#pragma unroll
                    for (int r = 0; r < 16; ++r) { const int key = 32 * blk + crow(r, hi); kk[blk][r] = (f2ord(acc[r]) & ~127u) | (unsigned)(127 - key); }
                }
                top16_of_64(kk[0], kk[1], kk[2], kk[3]);
                unsigned other[16];
#pragma unroll
                for (int i = 0; i < 16; ++i) other[i] = xorx<32>(kk[0][i], lane);
                merge16(kk[0], other);
#pragma unroll
                for (int i = 0; i < 16; ++i) top[p][i] = kk[0][i];
            }
            float s1[16], s2[16]; unsigned i1[16], i2[16];
#pragma unroll
            for (int i = 0; i < 16; ++i) { s1[i] = ord2f(top[0][i] & ~127u); i1[i] = 127u - (top[0][i] & 127u); s2[i] = ord2f(top[1][i] & ~127u); i2[i] = 127u - (top[1][i] & 127u); }
            unsigned ck[4][16];
#pragma unroll
            for (int c = 0; c < 64; ++c) {
                if (c < NCAND) { constexpr int CA[NCAND] = {0,0,0,0,0,0,0,0,0,0,0,0,0,0,0,0,1,1,1,1,1,1,1,1,2,2,2,2,2,3,3,3,3,4,4,4,5,5,6,6,7,7,8,9,10,11,12,13,14,15}; constexpr int CB[NCAND] = {0,1,2,3,4,5,6,7,8,9,10,11,12,13,14,15,0,1,2,3,4,5,6,7,0,1,2,3,4,0,1,2,3,0,1,2,0,1,0,1,0,1,0,0,0,0,0,0,0,0}; const int a = CA[c], b = CB[c];
                    ck[c >> 4][c & 15] = (f2ord(s1[a] + s2[b]) & ~63u) | (unsigned)(63 - c);
                    Elds[c * 64 + lane] = (unsigned short)(i1[a] * 128u + i2[b]); }
                else ck[c >> 4][c & 15] = 0u;
            }
            top16_of_64(ck[0], ck[1], ck[2], ck[3]);
            float w[16]; float wsum = 0.f; const float v0 = ord2f(ck[0][0] & ~63u);
#pragma unroll
            for (int r = 0; r < 16; ++r) { w[r] = __expf(ord2f(ck[0][r] & ~63u) - v0); wsum += w[r]; }
            const float winv = 1.0f / wsum;
#pragma unroll
            for (int r = 0; r < 16; ++r) if ((r >> 3) == hi) {
                const int c = 63 - (int)(ck[0][r] & 63u);
                const unsigned short eid = Elds[c * 64 + lane];
                PIDX[(size_t)tok * 128 + h * 16 + r] = eid; PG[(size_t)tok * 128 + h * 16 + r] = w[r] * winv; }
        }
    }
}

__device__ __forceinline__ float gelu_erf(float v) { return 0.5f * v * (1.0f + erff(v * 0.70710678118654752f)); }

#define PROBE_REPA 1
#define PROBE_REPB 1
constexpr int NR = 8, RSH = 18, BSA = 8, BSB = 8, ELP = 136, TPS = 8; static_assert(BSA == 8 && BSB == 8, "whole batches of 8");
__device__ __forceinline__ void sort128(unsigned& e0, unsigned& e1, int lane) {
#pragma unroll
    for (int size = 2; size <= 128; size <<= 1) {
#pragma unroll
        for (int stride = size >> 1; stride > 0; stride >>= 1) {
            if (stride == 64) { const unsigned lo = e0 < e1 ? e0 : e1, hi = e0 < e1 ? e1 : e0; e0 = lo; e1 = hi; }
            else {
                const bool lower = (lane & stride) == 0;
                const bool asc0 = (size == 128) ? true : (size == 64 ? true : ((lane & size) == 0));
                const bool asc1 = (size == 128) ? true : (size == 64 ? false : ((lane & size) == 0));
                const unsigned p0 = xorx_sw(e0, lane, stride), p1 = xorx_sw(e1, lane, stride);
                const unsigned mn0 = e0 < p0 ? e0 : p0, mx0 = e0 < p0 ? p0 : e0, mn1 = e1 < p1 ? e1 : p1, mx1 = e1 < p1 ? p1 : e1;
                e0 = (lower == asc0) ? mn0 : mx0; e1 = (lower == asc1) ? mn1 : mx1;
            }
        }
    }
}
template <int BS> __device__ __forceinline__ void sw_issue(v4u (&buf)[BS], const LAS unsigned* el, const unsigned char* tab, unsigned voff) {
#pragma unroll
    for (int i = 0; i < BS; ++i) { const unsigned off = (el[i] << 10) + voff;
        buf[i] = *(const v4u*)(tab + off); }
}
template <int BS> __device__ __forceinline__ void sw_proc_a(const v4u (&buf)[BS], const v4u& hq, LAS float* wl, int s, int n, int lane) {
    const int hx = (int)hq.x, hy = (int)hq.y, hz = (int)hq.z, hw = (int)hq.w;
    float dd[8];
#pragma unroll
    for (int i = 0; i < 8; ++i) dd[i] = 0.f;
#pragma unroll
    for (int i = 0; i < BS; ++i) { const int dx = (int)buf[i].x, dy = (int)buf[i].y, dz = (int)buf[i].z, dw = (int)buf[i].w;
        int t = __builtin_amdgcn_sdot4(hx, dx, 0, false); t = __builtin_amdgcn_sdot4(hy, dy, t, false); t = __builtin_amdgcn_sdot4(hz, dz, t, false); t = __builtin_amdgcn_sdot4(hw, dw, t, false);
        dd[i] = (float)t; }
    const float r1 = reduce8_t(dd, lane);
    if ((lane & 7) == 0) wl[s + (lane >> 3)] = r1;
}
typedef _Float16 h2_t __attribute__((ext_vector_type(2)));
#define CVT_H2_FP8(u, hi) __builtin_bit_cast(h2_t, __builtin_amdgcn_cvt_scalef32_pk_f16_fp8((u), 1.0f, (hi)))
template <int BS> __device__ __forceinline__ void sw_proc_b(const v4u (&buf)[BS], h2_t (&acc)[8], const LAS float* wl, int s, int n) {
    float wr[BS];
#pragma unroll
    for (int i = 0; i < BS; ++i) wr[i] = wl[s + i];
#pragma unroll
    for (int i = 0; i < BS; ++i) {
        const h2_t wv = __builtin_bit_cast(h2_t, wr[i]);
        const unsigned ux = buf[i].x, uy = buf[i].y, uz = buf[i].z, uw = buf[i].w;
        acc[0] = __builtin_elementwise_fma(CVT_H2_FP8(ux, false), wv, acc[0]); acc[1] = __builtin_elementwise_fma(CVT_H2_FP8(ux, true), wv, acc[1]);
        acc[2] = __builtin_elementwise_fma(CVT_H2_FP8(uy, false), wv, acc[2]); acc[3] = __builtin_elementwise_fma(CVT_H2_FP8(uy, true), wv, acc[3]);
        acc[4] = __builtin_elementwise_fma(CVT_H2_FP8(uz, false), wv, acc[4]); acc[5] = __builtin_elementwise_fma(CVT_H2_FP8(uz, true), wv, acc[5]);
        acc[6] = __builtin_elementwise_fma(CVT_H2_FP8(uw, false), wv, acc[6]); acc[7] = __builtin_elementwise_fma(CVT_H2_FP8(uw, true), wv, acc[7]); }
}
__device__ __forceinline__ void sw_warm(v4u (&pf)[4], const unsigned char* tab, int range, int lw, unsigned voff) {
#pragma unroll
    for (int i = 0; i < 4; ++i) { const unsigned off = ((unsigned)(range * 1024 + lw * 4 + i) << 10) + voff; pf[i] = *(const v4u*)(tab + off); }
}
__device__ __forceinline__ void sw_warm_done(const v4u (&pf)[4]) {
#pragma unroll
    for (int i = 0; i < 4; ++i) asm volatile("" :: "v"(pf[i]));
}
template <int FAKE> __device__ __forceinline__ void p8b_sweep(Frame& F) {
    const float* X1 = (const float*)(((unsigned char*)karg(19)) + WS_X1); const float* MOD = (const float*)(((unsigned char*)karg(19)) + WS_MOD);
    const unsigned char* H2Q = (const unsigned char*)(((unsigned char*)karg(19)) + WS_H2Q); const float* H2S = (const float*)(((unsigned char*)karg(19)) + WS_H2S);
    const unsigned char* EDq = (const unsigned char*)(((unsigned char*)karg(19)) + WS_ED); const unsigned char* EUq = (const unsigned char*)(((unsigned char*)karg(19)) + WS_EU); const float* EDS = (const float*)(((unsigned char*)karg(19)) + WS_EDS);
    const unsigned short* PIDX = (const unsigned short*)(((unsigned char*)karg(19)) + WS_PIDX); const float* PG = (const float*)(((unsigned char*)karg(19)) + WS_PG);
    const float* fg = ((const float*)karg(17));
    const int gw = F.vcu * NWAVES + F.wave, NGW = F.G * NWAVES;
    for (int wi = F.vcu; wi < M / 64; wi += F.G) {
        const int tb = wi * 8 + F.wave;
        unsigned ones = ~0u; asm volatile("" : "+s"(ones));
        int lane = (int)__builtin_amdgcn_mbcnt_hi(ones, __builtin_amdgcn_mbcnt_lo(ones, 0u)); asm volatile("" : "+v"(lane));
        const int tok0 = tb * 8;
        unsigned E0[8], E1[8];
        LAS float* Wl = (LAS float*)(F.lds) + F.wave * 1024;
        LAS unsigned* El = (LAS unsigned*)(F.lds + 32768) + F.wave * (8 * ELP);
        unsigned voff = 16u * (unsigned)lane; asm volatile("" : "+v"(voff));
        LAS int* Bnd = (LAS int*)(F.lds + 67584) + F.wave * (8 * (NR + 1));
#pragma unroll
        for (int k = 0; k < 8; ++k) {
            const size_t base = (size_t)(tok0 + k) * 128;
            E0[k] = ((unsigned)PIDX[base + lane] << 7) | (unsigned)lane; E1[k] = ((unsigned)PIDX[base + 64 + lane] << 7) | (unsigned)(64 + lane);
            sort128(E0[k], E1[k], lane);
            if (FAKE) { E0[k] = (E0[k] & 0x1ffffu) ; E1[k] = (E1[k] & 0x1ffffu); sort128(E0[k], E1[k], lane); }
            El[k * ELP + lane] = E0[k] >> 7; El[k * ELP + 64 + lane] = E1[k] >> 7;
            if (lane < 8) El[k * ELP + 128 + lane] = (unsigned)__builtin_amdgcn_readlane((int)E1[k], 63) >> 7;
        }
        for (int repa = 0; repa < PROBE_REPA; ++repa) {
            v4u hq[8];
#pragma unroll
            for (int k = 0; k < 8; ++k) hq[k] = *(const v4u*)(H2Q + (size_t)(tok0 + k) * D + 16 * lane);
            int pos[8];
#pragma unroll
            for (int k = 0; k < 8; ++k) pos[k] = 0;
            v4u bA[BSA], bB[BSA], bC[BSA]; int ps = 0, pn = 0;
            for (int r = 0; r < NR; ++r) {
#pragma unroll
                for (int k = 0; k < 8; ++k) {
                    constexpr int dummy = 0; (void)dummy;
                    const int kp = (k + 7) & 7;
                    const unsigned long long BM = 0x0101010101010101ull;
                    const int c = __builtin_popcountll(__ballot((E0[k] >> RSH) == (unsigned)r) & BM) + __builtin_popcountll(__ballot((E1[k] >> RSH) == (unsigned)r) & BM);
                    int s = __builtin_amdgcn_readfirstlane(pos[k]); const int e_end = __builtin_amdgcn_readfirstlane(s + 8 * c); pos[k] = e_end;
                    if (lane == 0) Bnd[k * (NR + 1) + r + 1] = e_end;
                    const int n1 = (e_end - s) < BSA ? (e_end - s) : BSA;
                    if (k & 1) sw_issue<BSA>(bB, El + k * ELP + s, EDq, voff); else sw_issue<BSA>(bA, El + k * ELP + s, EDq, voff);
                    if (pn > 0) { if (k & 1) sw_proc_a<BSA>(bA, hq[kp], Wl + kp * 128, ps, pn, lane); else sw_proc_a<BSA>(bB, hq[kp], Wl + kp * 128, ps, pn, lane); }
                    ps = s; pn = n1; s += n1;
#define SWA_REST(Y) if (s < e_end) { sw_issue<BSA>(Y, El + k * ELP + s, EDq, voff); \
                        for (;;) { int n = (e_end - s) < BSA ? (e_end - s) : BSA; \
                            if (s + BSA < e_end) { sw_issue<BSA>(bC, El + k * ELP + s + BSA, EDq, voff); sw_proc_a<BSA>(Y, hq[k], Wl + k * 128, s, n, lane); } else { sw_proc_a<BSA>(Y, hq[k], Wl + k * 128, s, n, lane); break; } \
                            s += BSA; n = (e_end - s) < BSA ? (e_end - s) : BSA; \
                            if (s + BSA < e_end) { sw_issue<BSA>(Y, El + k * ELP + s + BSA, EDq, voff); sw_proc_a<BSA>(bC, hq[k], Wl + k * 128, s, n, lane); } else { sw_proc_a<BSA>(bC, hq[k], Wl + k * 128, s, n, lane); break; } \
                            s += BSA; } }
                    if (k & 1) { SWA_REST(bA) } else { SWA_REST(bB) }
#undef SWA_REST
                }
            }
            if (pn > 0) sw_proc_a<BSA>(bB, hq[7], Wl + 7 * 128, ps, pn, lane);
        }
#pragma unroll
        for (int k = 0; k < 8; ++k) { int tk = tok0 + k; asm volatile("" : "+s"(tk)); const size_t base = (size_t)tk * 128; const float sh = H2S[tk];
            const float r0 = Wl[k * 128 + lane], r1 = Wl[k * 128 + 64 + lane];
            const _Float16 w0 = (_Float16)(PG[base + (E0[k] & 127u)] * gelu_erf(r0 * sh * EDS[E0[k] >> 7])), w1 = (_Float16)(PG[base + (E1[k] & 127u)] * gelu_erf(r1 * sh * EDS[E1[k] >> 7]));
            Wl[k * 128 + lane] = __builtin_bit_cast(float, (h2_t){w0, w0}); Wl[k * 128 + 64 + lane] = __builtin_bit_cast(float, (h2_t){w1, w1}); }
        int ln = lane; asm volatile("" : "+v"(ln));
#pragma unroll
        for (int sub = 0; sub < 8 / TPS; ++sub) {
        h2_t acc[TPS][8];
        for (int repb = 0; repb < PROBE_REPB; ++repb) {
#pragma unroll
            for (int kk = 0; kk < TPS; ++kk)
#pragma unroll
                for (int i = 0; i < 8; ++i) acc[kk][i] = (h2_t){(_Float16)0.f, (_Float16)0.f};
            int pos[TPS];
#pragma unroll
            for (int kk = 0; kk < TPS; ++kk) pos[kk] = 0;
            v4u bA[BSB], bB[BSB]; int ps = 0, pn = 0;
            for (int r = 0; r < NR; ++r) {
#pragma unroll
                for (int kk = 0; kk < TPS; ++kk) {
                    const int k = sub * TPS + kk, kkp = (kk + TPS - 1) % TPS, kp = sub * TPS + kkp;
                    int s = __builtin_amdgcn_readfirstlane(pos[kk]); const int e_end = __builtin_amdgcn_readfirstlane(Bnd[k * (NR + 1) + r + 1]); pos[kk] = e_end;
                    const int n1 = (e_end - s) < BSB ? (e_end - s) : BSB;
                    if (kk & 1) sw_issue<BSB>(bB, El + k * ELP + s, EUq, voff); else sw_issue<BSB>(bA, El + k * ELP + s, EUq, voff);
                    if (pn > 0) { if (kk & 1) sw_proc_b<BSB>(bA, acc[kkp], Wl + kp * 128, ps, pn); else sw_proc_b<BSB>(bB, acc[kkp], Wl + kp * 128, ps, pn); }
                    ps = s; pn = n1; s += n1;
                    for (; s < e_end; s += BSB) {
                        const int n = (e_end - s) < BSB ? (e_end - s) : BSB;
                        if (kk & 1) { sw_issue<BSB>(bA, El + k * ELP + s, EUq, voff); sw_proc_b<BSB>(bA, acc[kk], Wl + k * 128, s, n); }
                        else        { sw_issue<BSB>(bB, El + k * ELP + s, EUq, voff); sw_proc_b<BSB>(bB, acc[kk], Wl + k * 128, s, n); }
                    }
                }
            }
            if (pn > 0) sw_proc_b<BSB>(bB, acc[TPS - 1], Wl + (sub * TPS + TPS - 1) * 128, ps, pn);
        }
        {
            asm volatile("" : "+v"(ln));
            float* outp = (float*)karg(18);
            const float* gt2 = MOD + ((tok0 + sub * TPS) >> 12) * NMOD + 5120;
            f32x4 gtv[4], xcur[4], xnxt[4];
#pragma unroll
            for (int j = 0; j < 4; ++j) { const int col = 4 * ln + 256 * j; gtv[j] = *(const f32x4*)(gt2 + col); xcur[j] = *(const f32x4*)(X1 + (size_t)(tok0 + sub * TPS) * D + col); }
#pragma unroll
            for (int kk = 0; kk < TPS; ++kk) {
                const int tok = tok0 + sub * TPS + kk;
                if (kk + 1 < TPS) {
#pragma unroll
                    for (int j = 0; j < 4; ++j) xnxt[j] = __builtin_nontemporal_load((const f32x4*)(X1 + (size_t)(tok + 1) * D + 4 * ln + 256 * j));
                }
                f32x4 x2[4]; float ss = 0.f;
#pragma unroll
                for (int j = 0; j < 4; ++j) {
#pragma unroll
                    for (int i = 0; i < 4; ++i) { const float v = xcur[j][i] + gtv[j][i] * (0.0625f * (float)acc[kk][2 * j + (i >> 1)][i & 1]); x2[j][i] = v; ss += v * v; } }
                ss = wave_sum_x(ss, ln);
                if (!(FAKE && ss != 12345.678f)) {
                    const float rstd = 1.0f / sqrtf(ss * (1.0f / D) + EPS);
                    f32x4 fgv[4];
#pragma unroll
                    for (int j = 0; j < 4; ++j) fgv[j] = *(const f32x4*)(fg + 4 * ln + 256 * j);
#pragma unroll
                    for (int j = 0; j < 4; ++j) __builtin_nontemporal_store(x2[j] * rstd * fgv[j], (f32x4*)(outp + (size_t)tok * D + 4 * ln + 256 * j));
                }
#pragma unroll
                for (int j = 0; j < 4; ++j) xcur[j] = xnxt[j];
            }
        }
        }
    }
}

struct Args { const float* in[18]; float* out; unsigned char* ws; };
__global__ void __launch_bounds__(NTHR, 2) mega_fwd(Args args) {
    extern __shared__ __attribute__((aligned(16))) unsigned char lds[];
    Frame F;
    F.lds = (LAS unsigned char*)lds;
    F.wave = __builtin_amdgcn_readfirstlane((int)threadIdx.x >> 6); F.lane = lane_fresh(); F.tid = F.wave * 64 + F.lane;
    F.G = gridDim.x; { const int bx = blockIdx.x; F.vcu = (F.G % 8 == 0) ? (bx % 8) * (F.G / 8) + bx / 8 : bx; }
    volatile LAS unsigned* MISC = (volatile LAS unsigned*)(F.lds + MISC_OFF);
    for (int u = F.tid; u < (LDS_BYTES - LDSCTL_OFF) / 4; u += NTHR) ((LAS unsigned*)(F.lds + LDSCTL_OFF))[u] = 0u;
    __syncthreads();
    gu32* ctl = (gu32*)(((unsigned char*)karg(19)) + WS_CTL);
    XcdBarrier bar = xcd_barrier_post((unsigned*)(ctl + CW_BAR), MISC + 8, F.wave);
#define GRID_BAR() xcd_barrier(bar)
#define PROBE_TS -1
#define STAMP(i) do { if (PROBE_TS >= 0 && blockIdx.x == 0 && F.tid == 0) { const unsigned long long t_ = __builtin_amdgcn_s_memrealtime(); MISC[16 + 2 * (i)] = (unsigned)t_; MISC[17 + 2 * (i)] = (unsigned)(t_ >> 32); } } while (0)
#define PROBE_DBL -1

    STAMP(0);
    F.lane = lane_fresh(); F.tid = F.wave * 64 + F.lane;
    p0_prologue(F); GRID_BAR(); STAMP(1);
    if (PROBE_DBL == 0) { p0_prologue(F); GRID_BAR(); }
    F.lane = lane_fresh(); F.tid = F.wave * 64 + F.lane;
    p1_norm(F); p0_transposes(F); GRID_BAR(); STAMP(2);
    if (PROBE_DBL == 1) { p1_norm(F); GRID_BAR(); }
    {
    {
        pg8::Gemm g{(const pg8::bf16_t*)(((unsigned char*)karg(19)) + WS_H), (const pg8::bf16_t*)(((unsigned char*)karg(19)) + WS_WIN), M, NPROJ, D, nullptr, nullptr};
        pg8::StaticOrder S; S.init(M, NPROJ, F.G, (int)blockIdx.x);
        pg8::EpiBf16<0> E{(pg8::bf16_t*)(((unsigned char*)karg(19)) + WS_PROJ), NPROJ, nullptr, 0, 0, 1.f};
        pg8::gemm_phase<pg8::EpiBf16<0>, pg8::StaticOrder, true, true>(F.lds + RING_OFF, g, S, E, F.wave);
        const int nwg = (M / 256) * (NPROJ / 256), busy = nwg % F.G;
        if (busy == 0) p0_quant_tables(F, F.vcu * NWAVES + F.wave, F.G * NWAVES);
        else if ((int)blockIdx.x >= busy) p0_quant_tables(F, ((int)blockIdx.x - busy) * NWAVES + F.wave, (F.G - busy) * NWAVES);
    }
    GRID_BAR(); STAMP(3);
    }
    p3_attention(F); GRID_BAR(); STAMP(4);
    if (PROBE_DBL == 3) { p3_attention(F); GRID_BAR(); }
    {
    {
        pg8::Gemm g{(const pg8::bf16_t*)(((unsigned char*)karg(19)) + WS_OA), (const pg8::bf16_t*)(((unsigned char*)karg(19)) + WS_WA), M, D, 512, (const pg8::bf16_t*)(((unsigned char*)karg(19)) + WS_OB), (const pg8::bf16_t*)(((unsigned char*)karg(19)) + WS_WB)};
        PairOrder S; S.S.init(M, D, F.G, (int)blockIdx.x);
        EpiGate E{(const bf16*)(((unsigned char*)karg(19)) + WS_PROJ), (bf16*)((float*)karg(18)) + (size_t)M * D};
        pg8::gemm_phase<EpiGate, PairOrder, true, true>(F.lds + RING_OFF, g, S, E, F.wave);
    }
    GRID_BAR(); STAMP(5);
    }
    {
    {
        pg8::Gemm g{(const pg8::bf16_t*)((bf16*)((float*)karg(18)) + (size_t)M * D), (const pg8::bf16_t*)(((unsigned char*)karg(19)) + WS_WOUT), M, D, D, nullptr, nullptr};
        pg8::StaticOrder S; S.init(M, D, F.G, (int)blockIdx.x);
        EpiRes E{((const float*)karg(0)), (const float*)(((unsigned char*)karg(19)) + WS_MOD), (float*)(((unsigned char*)karg(19)) + WS_X1)};
        pg8::gemm_phase<EpiRes, pg8::StaticOrder, true, true>(F.lds + RING_OFF, g, S, E, F.wave);
    }
    GRID_BAR(); STAMP(6);
    }
    F.lane = lane_fresh(); F.tid = F.wave * 64 + F.lane;
    F.lane = lane_fresh(); F.tid = F.wave * 64 + F.lane;
    p6_norm2(F); GRID_BAR(); STAMP(7);
    if (PROBE_DBL == 6) { p6_norm2(F); GRID_BAR(); }
    {
    {
        pg8::Gemm g{(const pg8::bf16_t*)(((unsigned char*)karg(19)) + WS_H2), (const pg8::bf16_t*)(((unsigned char*)karg(19)) + WS_WQ), M, D, D, nullptr, nullptr};
        pg8::StaticOrder S; S.init(M, D, F.G, (int)blockIdx.x);
        pg8::EpiBf16<0> E{(pg8::bf16_t*)(((unsigned char*)karg(19)) + WS_QP), D, nullptr, 0, 0, 1.f};
        pg8::gemm_phase<pg8::EpiBf16<0>, pg8::StaticOrder, true, true>(F.lds + RING_OFF, g, S, E, F.wave);
    }
    GRID_BAR(); STAMP(8);
    }
    F.lane = lane_fresh(); F.tid = F.wave * 64 + F.lane;
    p8a_topk(F); __syncthreads(); STAMP(9);
    if (PROBE_DBL == 8) { p8a_topk(F); GRID_BAR(); }
    if (PROBE_DBL == 12) { p8b_sweep<1>(F); __syncthreads(); }
    p8b_sweep<0>(F);
    if (PROBE_DBL == 9) { GRID_BAR(); p8b_sweep<0>(F); }
    if (PROBE_TS >= 0) {
        GRID_BAR(); STAMP(10);
        if (blockIdx.x == 0) { __syncthreads();
            const unsigned long long t0 = ((unsigned long long)MISC[17 + 2 * PROBE_TS] << 32) | MISC[16 + 2 * PROBE_TS], t1 = ((unsigned long long)MISC[19 + 2 * PROBE_TS] << 32) | MISC[18 + 2 * PROBE_TS];
            const float d_us = (float)(t1 - t0) * 0.01f;
            const float V = 128.0f * sqrtf(d_us * 1e-5f);
            float* o = (float*)karg(18); for (int c = F.tid; c < D; c += NTHR) o[c] = V; }
    }
}

extern "C" void kernel_launch(void* const* d_in, const int* in_sizes, int n_in, void* d_out, int out_size, void* d_ws, size_t ws_size, hipStream_t stream) {
    static int grid = 0;
    if (grid == 0) {
        if (n_in != 18 || in_sizes[0] != M * D || out_size != M * D || ws_size < WS_END) { fprintf(stderr, "kernel_launch: unexpected shapes (n_in %d, in0 %d, out %d, ws %zu)\n", n_in, n_in > 0 ? in_sizes[0] : -1, out_size, ws_size); grid = -1; return; }
        int dev = 0, cus = 0, per_cu = 0;
        if (hipGetDevice(&dev) != hipSuccess || hipDeviceGetAttribute(&cus, hipDeviceAttributeMultiprocessorCount, dev) != hipSuccess) { grid = -1; return; }
        if (hipFuncSetAttribute((const void*)mega_fwd, hipFuncAttributeMaxDynamicSharedMemorySize, LDS_BYTES) != hipSuccess) { fprintf(stderr, "kernel_launch: hipFuncSetAttribute failed\n"); grid = -1; return; }
        if (hipOccupancyMaxActiveBlocksPerMultiprocessor(&per_cu, (const void*)mega_fwd, NTHR, LDS_BYTES) != hipSuccess || per_cu < 1) { fprintf(stderr, "kernel_launch: occupancy query says %d blocks per CU\n", per_cu); }
        (void)hipGetLastError();
        grid = cus;
    }
    if (grid < 0) return;
    if (hipMemsetAsync((char*)d_ws + WS_CTL, 0, CTL_ZERO_BYTES, stream) != hipSuccess) { fprintf(stderr, "kernel_launch: memset failed\n"); return; }
    Args a{};
    for (int i = 0; i < 18; ++i) a.in[i] = (const float*)d_in[i];
    a.out = (float*)d_out; a.ws = (unsigned char*)d_ws;
    hipLaunchKernelGGL(mega_fwd, dim3(grid), dim3(NTHR), LDS_BYTES, stream, a);
}
```

```cpp
#include <hip/hip_runtime.h>
#include <cstdio>
#include <cstdint>
__device__ __forceinline__ int lane_fresh() { unsigned ones = ~0u; asm volatile("" : "+s"(ones)); return (int)__builtin_amdgcn_mbcnt_hi(ones, __builtin_amdgcn_mbcnt_lo(ones, 0u)); }
namespace pg8 {
#define PG8_LAS __attribute__((address_space(3)))
typedef unsigned short bf16_t;
typedef short bf16x8 __attribute__((ext_vector_type(8)));
typedef float f32x4 __attribute__((ext_vector_type(4)));
typedef unsigned u32x4 __attribute__((ext_vector_type(4)));
constexpr int BM = 256, BK = 64, HALF = 128, HTB = HALF * BK * 2  , STAGE_BYTES = 8 * HTB, NXCD = 8, WGM = 8;

__host__ __device__ __forceinline__ int lds_byte(int r, int c) { const int st = (r >> 4) * 2 + (c >> 5), rr = r & 15, cc = c & 31, ob = rr * 64 + cc * 2; return st * 1024 + (ob ^ (((ob >> 9) & 1) << 5)); }
__host__ __device__ __forceinline__ void stage_rc(int b, int& R, int& C) { const int st = b / 1024, sb = b % 1024, swz = sb ^ (((sb >> 9) & 1) << 5); R = (st >> 1) * 16 + swz / 64; C = (st & 1) * 32 + (swz % 64) / 2; }
__host__ __device__ __forceinline__ int perm32(int rho) { const int n = rho >> 4, i = rho & 15; return 8 * (i >> 2) + 4 * n + (i & 3); }

struct Unit { int pm, pn, src; };
struct Gemm { const bf16_t* A; const bf16_t* Bt; int M, N, K; const bf16_t* A2; const bf16_t* Bt2; };

struct StaticOrder {
    int nM, nN, nwg, G, c;
    __host__ __device__ void init(int M, int N, int G_, int c_) { nM = M / BM; nN = N / BM; nwg = nM * nN; G = G_; c = c_; }
    __host__ __device__ bool next(int i, Unit& u) const {
        const long L = (long)i * G + c; if (L >= nwg) return false;
        int wgid = (int)L; { const int q = nwg / NXCD, r = nwg % NXCD, xcd = wgid % NXCD, off = wgid / NXCD; wgid = (xcd < r ? xcd * (q + 1) : r * (q + 1) + (xcd - r) * q) + off; }
        const int nig = WGM * nN, gid = wgid / nig, fm = gid * WGM, gsz = (nM - fm) < WGM ? (nM - fm) : WGM;
        u.pm = fm + ((wgid % nig) % gsz); u.pn = (wgid % nig) / gsz; u.src = 0; return true;
    }
    __device__ __forceinline__ void a_ready(const Unit&) const {}
    __device__ __forceinline__ void done(const Unit&) const {}
};

__device__ __forceinline__ unsigned cvt_pk_bf16(float lo, float hi) { unsigned r; asm volatile("v_cvt_pk_bf16_f32 %0, %1, %2" : "=v"(r) : "v"(lo), "v"(hi)); return r; }
typedef float f32x2 __attribute__((ext_vector_type(2)));
__device__ __forceinline__ f32x2 gelu_pk(f32x2 v) {
    const f32x2 av = __builtin_elementwise_abs(v), d = av * 0.2316418882f + 1.0f;
    f32x2 t; t.x = __builtin_amdgcn_rcpf(d.x); t.y = __builtin_amdgcn_rcpf(d.y);
    f32x2 q = t * 0.5307027145f + (-0.7265760135f); q = q * t + 0.7107068705f; q = q * t + (-0.142248368f); q = q * t + 0.127414796f; q = q * t;
    const f32x2 s = (v * v) * (-0.72134752044f);
    f32x2 e; e.x = __builtin_amdgcn_exp2f(s.x); e.y = __builtin_amdgcn_exp2f(s.y);
    const f32x2 m = v * (q * e), r = v - m;
    f32x2 o; o.x = v.x < 0.f ? m.x : r.x; o.y = v.y < 0.f ? m.y : r.y; return o;
}

template <int ACT  > struct EpiBf16 {
    static constexpr bool PERM = true, AFTER_DRAIN = false, CHAIN = false; static_assert(ACT == 0 || ACT == 1, "EpiBf16: ACT is 0 (none) or 1 (gelu_pk)");
    bf16_t* O; int ldc; const float* bias; int split_cols; size_t split_stride; float scale0;
    __device__ __forceinline__ void operator()(const f32x4 (&acc)[2][2][4][2], const Unit& u, int wr, int wc, int fr, int fq) const {
        const int row0 = u.pm * BM + wr * 64 + fr; int colt = u.pn * BM; bf16_t* base = O;
        float sc = 1.f; if (split_cols) { const int t = colt / split_cols; base += (size_t)t * split_stride; colt -= t * split_cols; if (t == 0) sc = scale0; }
        const int col0 = colt + wc * 32 + 8 * fq, bcol0 = u.pn * BM + wc * 32 + 8 * fq;
        f32x4 bv[2][2];
#pragma unroll
        for (int bj = 0; bj < 2; ++bj)
#pragma unroll
            for (int n = 0; n < 2; ++n) bv[bj][n] = bias ? *(const f32x4*)(bias + bcol0 + bj * HALF + 4 * n) : (f32x4){0.f, 0.f, 0.f, 0.f};
#pragma unroll
        for (int ai = 0; ai < 2; ++ai)
#pragma unroll
            for (int m = 0; m < 4; ++m) { bf16_t* rowp = base + (size_t)(row0 + ai * HALF + m * 16) * ldc + col0;
#pragma unroll
                for (int bj = 0; bj < 2; ++bj) { f32x4 v0 = acc[ai][bj][m][0] + bv[bj][0], v1 = acc[ai][bj][m][1] + bv[bj][1];
                    if (ACT == 1) { f32x2 a = gelu_pk((f32x2){v0[0], v0[1]}), b = gelu_pk((f32x2){v0[2], v0[3]}), c = gelu_pk((f32x2){v1[0], v1[1]}), d = gelu_pk((f32x2){v1[2], v1[3]});
                        v0 = (f32x4){a.x, a.y, b.x, b.y}; v1 = (f32x4){c.x, c.y, d.x, d.y}; }
                    v0 = v0 * sc; v1 = v1 * sc; u32x4 w; w.x = cvt_pk_bf16(v0[0], v0[1]); w.y = cvt_pk_bf16(v0[2], v0[3]); w.z = cvt_pk_bf16(v1[0], v1[1]); w.w = cvt_pk_bf16(v1[2], v1[3]);
                    *(u32x4*)(rowp + bj * HALF) = w; } }
    }
};

template <class Epi, class Sched, bool ALIGN_EPI = false, bool SP2 = false>
__device__ __forceinline__ void gemm_phase(PG8_LAS unsigned char* lds, const Gemm g, const Sched& S, const Epi& E, int wave_id) {
    int tid = wave_id * 64 + ::lane_fresh(); asm volatile("" : "+v"(tid));
    const int wid = __builtin_amdgcn_readfirstlane(tid >> 6), lane = tid & 63, wr = wid >> 2, wc = wid & 3, fr = lane & 15, fq = lane >> 4;
    const int K = g.K, nt = K / BK;
    unsigned voffA[2], voffB[2];
#pragma unroll
    for (int i = 0; i < 2; ++i) { int R, C; stage_rc(tid * 16 + i * 8192, R, C); const int Rb = Epi::PERM ? ((R & ~31) + perm32(R & 31)) : R;
        voffA[i] = (unsigned)(R * K + C) * 2u; voffB[i] = (unsigned)(Rb * K + C) * 2u; }
    const size_t kstep = (size_t)(BK * 2);
    const size_t hstep = (size_t)HALF * K * 2;
    const size_t tstep = 2 * hstep;
    const unsigned ldsw = (unsigned)wid * 1024u;
    const int aoff = lds_byte(wr * 64 + fr, fq * 8), boff = lds_byte(wc * 32 + fr, fq * 8);
#define PG8_SA(b, h) (((b) * 2 + (h)) * HTB)
#define PG8_SB(b, h) ((4 + (b) * 2 + (h)) * HTB)
#define PG8_STAGE(bufoff, gbase, voff) do { _Pragma("unroll") for (int _i = 0; _i < 2; ++_i) \
        __builtin_amdgcn_global_load_lds((const unsigned*)((const char*)(gbase) + (voff)[_i]), (PG8_LAS unsigned*)(lds + (bufoff) + ldsw + _i * 8192), 16, 0, 0); } while (0)
#define PG8_LDA(dst, b, h) do { _Pragma("unroll") for (int m = 0; m < 4; ++m) _Pragma("unroll") for (int k = 0; k < 2; ++k) dst[m][k] = *(const PG8_LAS bf16x8*)(lds + PG8_SA(b, h) + aoff + m * 2048 + k * 1024); } while (0)
#define PG8_LDB(dst, b, h) do { _Pragma("unroll") for (int n = 0; n < 2; ++n) _Pragma("unroll") for (int k = 0; k < 2; ++k) dst[n][k] = *(const PG8_LAS bf16x8*)(lds + PG8_SB(b, h) + boff + n * 2048 + k * 1024); } while (0)
#define PG8_MMA(ai, bj, At, Bt) do { __builtin_amdgcn_s_setprio(1); _Pragma("unroll") for (int m = 0; m < 4; ++m) _Pragma("unroll") for (int n = 0; n < 2; ++n) _Pragma("unroll") for (int k = 0; k < 2; ++k) \
        acc[ai][bj][m][n] = __builtin_amdgcn_mfma_f32_16x16x32_bf16(Bt[n][k], At[m][k], acc[ai][bj][m][n], 0, 0, 0); __builtin_amdgcn_s_setprio(0); } while (0)
#define PG8_WAIT_V(n) asm volatile("s_waitcnt vmcnt(" #n ")" ::: "memory")
#define PG8_WAIT_L(n) asm volatile("s_waitcnt lgkmcnt(" #n ")" ::: "memory")
#define PG8_BAR __builtin_amdgcn_s_barrier()
#define PG8_SCHED __builtin_amdgcn_sched_barrier(0)
    Unit cur, nxt; int ui = 0;
    if (!S.next(0, cur)) return;
    f32x4 acc[2][2][4][2];
#pragma unroll
    for (int a = 0; a < 2; ++a)
#pragma unroll
        for (int b = 0; b < 2; ++b)
#pragma unroll
            for (int m = 0; m < 4; ++m)
#pragma unroll
                for (int n = 0; n < 2; ++n) acc[a][b][m][n] = (f32x4){0.f, 0.f, 0.f, 0.f};
    bf16x8 At[4][2], B0[2][2], B1[2][2];
    const char* cA = (const char*)(cur.src ? g.A2 : g.A) + (size_t)cur.pm * tstep; const char* cB = (const char*)(cur.src ? g.Bt2 : g.Bt) + (size_t)cur.pn * tstep;
    S.a_ready(cur);
    if constexpr (SP2) {
        PG8_STAGE(PG8_SB(0, 0), cB, voffB); PG8_STAGE(PG8_SB(0, 1), cB + hstep, voffB); PG8_STAGE(PG8_SA(0, 0), cA, voffA); PG8_STAGE(PG8_SA(0, 1), cA + hstep, voffA);
        if (wr == 1) PG8_BAR;
        PG8_WAIT_V(2); PG8_BAR;
        PG8_STAGE(PG8_SB(1, 0), cB + kstep, voffB); PG8_STAGE(PG8_SA(1, 0), cA + kstep, voffA); PG8_STAGE(PG8_SB(1, 1), cB + hstep + kstep, voffB);
        PG8_WAIT_V(6); PG8_BAR;
    } else {
        PG8_STAGE(PG8_SB(0, 0), cB, voffB); PG8_STAGE(PG8_SA(0, 0), cA, voffA); PG8_STAGE(PG8_SB(0, 1), cB + hstep, voffB); PG8_STAGE(PG8_SA(0, 1), cA + hstep, voffA);
        if (wr == 1) PG8_BAR;
        PG8_WAIT_V(4); PG8_BAR;
        PG8_STAGE(PG8_SB(1, 0), cB + kstep, voffB); PG8_STAGE(PG8_SA(1, 0), cA + kstep, voffA); PG8_STAGE(PG8_SB(1, 1), cB + hstep + kstep, voffB);
        PG8_WAIT_V(6); PG8_BAR;
    }
    for (;;) {
        const bool has_next = S.next(ui + 1, nxt);
        const char* nA = has_next ? (const char*)(nxt.src ? g.A2 : g.A) + (size_t)nxt.pm * tstep : cA; const char* nB = has_next ? (const char*)(nxt.src ? g.Bt2 : g.Bt) + (size_t)nxt.pn * tstep : cB;
        for (int t = 0; t < nt; t += 2) {
            const bool last = (t == nt - 2);
            const char* a1 = cA + (size_t)(t + 1) * kstep;
            const char* a2 = last ? nA : cA + (size_t)(t + 2) * kstep; const char* b2 = last ? nB : cB + (size_t)(t + 2) * kstep;
            const char* a3 = a2 + kstep; const char* b3 = b2 + kstep;
            if (last && has_next) S.a_ready(nxt);
            if constexpr (SP2) {
            PG8_LDB(B0, 0, 0); PG8_LDB(B1, 0, 1); PG8_SCHED; PG8_LDA(At, 0, 0); PG8_STAGE(PG8_SA(1, 1), a1 + hstep, voffA);
            PG8_WAIT_V(8); PG8_WAIT_L(0); PG8_BAR; PG8_MMA(0, 0, At, B0); PG8_MMA(0, 1, At, B1); PG8_BAR; PG8_SCHED;
            PG8_LDA(At, 0, 1); PG8_STAGE(PG8_SB(0, 0), b2, voffB); PG8_STAGE(PG8_SB(0, 1), b2 + hstep, voffB); PG8_STAGE(PG8_SA(0, 0), a2, voffA);
            PG8_WAIT_V(8); PG8_WAIT_L(0); PG8_BAR; PG8_MMA(1, 0, At, B0); PG8_MMA(1, 1, At, B1); PG8_BAR; PG8_SCHED;
            PG8_LDB(B0, 1, 0); PG8_LDB(B1, 1, 1); PG8_SCHED; PG8_LDA(At, 1, 0); PG8_STAGE(PG8_SA(0, 1), a2 + hstep, voffA);
            PG8_WAIT_V(8); PG8_WAIT_L(0); PG8_BAR; PG8_MMA(0, 0, At, B0); PG8_MMA(0, 1, At, B1); PG8_BAR; PG8_SCHED;
            PG8_LDA(At, 1, 1); PG8_STAGE(PG8_SB(1, 0), b3, voffB); PG8_STAGE(PG8_SB(1, 1), b3 + hstep, voffB); PG8_STAGE(PG8_SA(1, 0), a3, voffA);
            PG8_WAIT_V(8); PG8_WAIT_L(0); PG8_BAR; PG8_MMA(1, 0, At, B0); PG8_MMA(1, 1, At, B1); PG8_BAR; PG8_SCHED;
            } else {
            PG8_LDB(B0, 0, 0); PG8_SCHED; PG8_LDA(At, 0, 0); PG8_STAGE(PG8_SA(1, 1), a1 + hstep, voffA);
            PG8_WAIT_L(8); PG8_BAR; PG8_WAIT_L(0); PG8_MMA(0, 0, At, B0); PG8_BAR; PG8_SCHED;
            PG8_LDB(B1, 0, 1); PG8_STAGE(PG8_SB(0, 0), b2, voffB);
            PG8_BAR; PG8_WAIT_L(0); PG8_MMA(0, 1, At, B1); PG8_BAR;
            PG8_LDA(At, 0, 1); PG8_STAGE(PG8_SA(0, 0), a2, voffA);
            PG8_BAR; PG8_WAIT_L(0); PG8_MMA(1, 0, At, B0); PG8_BAR; PG8_SCHED;
            PG8_STAGE(PG8_SB(0, 1), b2 + hstep, voffB);
            PG8_WAIT_V(6); PG8_BAR; PG8_MMA(1, 1, At, B1); PG8_BAR;
            PG8_LDB(B0, 1, 0); PG8_SCHED; PG8_LDA(At, 1, 0); PG8_STAGE(PG8_SA(0, 1), a2 + hstep, voffA);
            PG8_WAIT_L(8); PG8_BAR; PG8_WAIT_L(0); PG8_MMA(0, 0, At, B0); PG8_BAR; PG8_SCHED;
            PG8_LDB(B1, 1, 1); PG8_STAGE(PG8_SB(1, 0), b3, voffB);
            PG8_BAR; PG8_WAIT_L(0); PG8_MMA(0, 1, At, B1); PG8_BAR;
            PG8_LDA(At, 1, 1); PG8_STAGE(PG8_SA(1, 0), a3, voffA);
            PG8_BAR; PG8_WAIT_L(0); PG8_MMA(1, 0, At, B0); PG8_BAR; PG8_SCHED;
            PG8_STAGE(PG8_SB(1, 1), b3 + hstep, voffB);
            PG8_WAIT_V(6); PG8_BAR; PG8_MMA(1, 1, At, B1); PG8_BAR;
            }
        }
        if constexpr (ALIGN_EPI) { if (wr == 0) PG8_BAR; }
        if constexpr (!Epi::AFTER_DRAIN) { E(acc, cur, wr, wc, fr, fq); S.done(cur); }
        if (!has_next) break;
        if (!(Epi::CHAIN && cur.src == 0)) {
#pragma unroll
        for (int a = 0; a < 2; ++a)
#pragma unroll
            for (int b = 0; b < 2; ++b)
#pragma unroll
                for (int m = 0; m < 4; ++m)
#pragma unroll
                    for (int n = 0; n < 2; ++n) acc[a][b][m][n] = (f32x4){0.f, 0.f, 0.f, 0.f};
        }
        cur = nxt; cA = nA; cB = nB; ++ui;
        if constexpr (ALIGN_EPI) { if (wr == 1) PG8_BAR; }
    }
    PG8_WAIT_V(0);
    if constexpr (!ALIGN_EPI) { if (wr == 0) PG8_BAR; }
    PG8_BAR;
    if constexpr (Epi::AFTER_DRAIN) { E.fused(acc, cur, wr, wc, fr, fq, lds, wid, lane); S.done(cur); }
#undef PG8_SA
#undef PG8_SB
#undef PG8_STAGE
#undef PG8_LDA
#undef PG8_LDB
#undef PG8_MMA
#undef PG8_WAIT_V
#undef PG8_WAIT_L
#undef PG8_BAR
#undef PG8_SCHED
}
}

#define GAS __attribute__((address_space(1)))
#define LAS __attribute__((address_space(3)))
typedef unsigned short bf16;
typedef unsigned v4u __attribute__((ext_vector_type(4)));
typedef float f32x4 __attribute__((ext_vector_type(4)));
typedef short bf16x8 __attribute__((ext_vector_type(8)));
typedef GAS unsigned gu32;
typedef GAS unsigned long long gu64;
#define RLX_AGENT __ATOMIC_RELAXED, __HIP_MEMORY_SCOPE_AGENT
#define LDS_WAIT() asm volatile("s_waitcnt lgkmcnt(0)" ::: "memory")
#define VM_WAIT() asm volatile("s_waitcnt vmcnt(0)" ::: "memory")
__device__ __forceinline__ unsigned long long rt() { return __builtin_amdgcn_s_memrealtime(); }
__device__ __forceinline__ unsigned f2bf(float f) { unsigned u = __builtin_bit_cast(unsigned, f); return (u + 0x7fffu + ((u >> 16) & 1u)) >> 16; }
__device__ __forceinline__ unsigned pk2(float lo, float hi) { return f2bf(lo) | (f2bf(hi) << 16); }

__device__ __forceinline__ const void* karg(int i);
constexpr int CW_BAR_FWD = 4096;
#define XB_TMO      128
#define XB_XCNT(j)  (256  + 64 * (j))
#define XB_XSUB(j)  (1280 + 64 * (j))
#define XB_XGEN(j)  (2304 + 64 * (j))
#define XB_TOP      3328
#define XB_TOPGEN   3392
#define XCD_BAR_WORDS 3456
#define XB_SPIN_CAP (1u << 18)

__device__ __forceinline__ unsigned xb_ld(unsigned* p)              { return __hip_atomic_load(p, __ATOMIC_RELAXED, __HIP_MEMORY_SCOPE_AGENT); }
__device__ __forceinline__ unsigned xb_add(unsigned* p, unsigned v) { return __hip_atomic_fetch_add(p, v, __ATOMIC_RELAXED, __HIP_MEMORY_SCOPE_AGENT); }
__device__ __forceinline__ unsigned xb_xcc_id() { return (unsigned)__builtin_amdgcn_s_getreg((3 << 11) | 20) & 0xFu; }
#define XB_SPIN(cond, bar) do { unsigned _sp = 0; while (cond) { __builtin_amdgcn_s_sleep(1); \
    if ((++_sp & 255u) == 0u) { if (xb_ld(&(bar)[XB_TMO])) break; if (_sp > XB_SPIN_CAP) { atomicAdd(&(bar)[XB_TMO], 1u); break; } } } } while (0)

struct XcdBarrier {
    int wave;
    unsigned* bar; unsigned x;
    volatile LAS unsigned* st;
};

__device__ __forceinline__ XcdBarrier xcd_barrier_post(unsigned* bar, volatile LAS unsigned* st, int wave) {
    XcdBarrier b; b.wave = wave; b.bar = bar; b.x = xb_xcc_id(); b.st = st;
    if (wave == 0 && lane_fresh() == 0) (void)xb_add(&bar[XB_XCNT(b.x)], 1u);
    return b;
}
__device__ __forceinline__ void xcd_barrier_complete(unsigned* bar, unsigned x, unsigned& nloc, unsigned& nx) {
    const unsigned G = gridDim.x * gridDim.y * gridDim.z;
    unsigned sum, cnt, mine, sp = 0u;
    for (;;) {
        sum = 0u; cnt = 0u; mine = 0u;
#pragma unroll
        for (unsigned j = 0; j < 16; ++j) { const unsigned c = xb_ld(&bar[XB_XCNT(j)]); sum += c; cnt += (c > 0u) ? 1u : 0u; mine = (j == x) ? c : mine; }
        if (sum == G) break;
        __builtin_amdgcn_s_sleep(1);
        if ((++sp & 255u) == 0u) { if (xb_ld(&bar[XB_TMO])) break; if (sp > XB_SPIN_CAP) { atomicAdd(&bar[XB_TMO], 1u); break; } }
    }
    nloc = mine > 0u ? mine : 1u; nx = cnt > 0u ? cnt : 1u;
}

__device__ __forceinline__ void xcd_barrier(const XcdBarrier& b) {
    asm volatile("s_waitcnt vmcnt(0)" ::: "memory");
    __syncthreads();
    if (b.wave == 0 && lane_fresh() == 0) {
        unsigned* bar = (unsigned*)((gu32*)((unsigned char*)karg(19)) + CW_BAR_FWD);
        __builtin_amdgcn_s_waitcnt(0);
        unsigned nloc = b.st[0], nx = b.st[1];
        if (nloc == 0u) { xcd_barrier_complete(bar, b.x, nloc, nx); b.st[0] = nloc; b.st[1] = nx; }
        const unsigned old = xb_add(&bar[XB_XSUB(b.x)], 1u);
        const unsigned gen = old / nloc;
        if (old + 1u == (gen + 1u) * nloc) {
            __builtin_amdgcn_fence(__ATOMIC_RELEASE, "agent");
            asm volatile("s_waitcnt vmcnt(0)" ::: "memory");
            const unsigned og = xb_add(&bar[XB_TOP], 1u);
            const unsigned tg = og / nx;
            if (og + 1u == (tg + 1u) * nx) xb_add(&bar[XB_TOPGEN], 1u);
            else XB_SPIN(xb_ld(&bar[XB_TOPGEN]) == tg, bar);
            __builtin_amdgcn_fence(__ATOMIC_ACQUIRE, "agent");
            xb_add(&bar[XB_XGEN(b.x)], 1u);
            asm volatile("s_waitcnt vmcnt(0)" ::: "memory");
        } else {
            XB_SPIN(xb_ld(&bar[XB_XGEN(b.x)]) == gen, bar);
            __builtin_amdgcn_fence(__ATOMIC_ACQUIRE, "agent");
            asm volatile("s_waitcnt vmcnt(0)" ::: "memory");
        }
    }
    __syncthreads();
}

constexpr int NWAVES = 8, NTHR = 512;
constexpr int BATCH = 4, SEQ = 4096, D = 1024, M = BATCH * SEQ;
constexpr int NPROJ = 4352, LDW_IN = 4360, NMOD = 6144;
constexpr int C_QA = 0, C_KA = 512, C_VA = 640, C_QB = 768, C_KB = 1280, C_VB = 1792, C_GLA = 2304, C_GLB = 3328;
constexpr int NEXP = 16384;
constexpr float EPS = 1e-6f;

constexpr size_t MiB = 1u << 20;
constexpr size_t WS_CTL = 0, CTL_ZERO_BYTES = 1 * MiB;
constexpr size_t WS_MOD = 1 * MiB, WS_LOGF = 1 * MiB + 128 * 1024, WS_SUBK = 2 * MiB;
constexpr size_t WS_WIN = 4 * MiB, WS_WA = 12 * MiB + 512 * 1024, WS_WB = 13 * MiB + 512 * 1024, WS_WOUT = 14 * MiB + 512 * 1024, WS_WQ = 16 * MiB + 512 * 1024;
constexpr size_t WS_ED = 19 * MiB, WS_EU = 35 * MiB;
constexpr size_t WS_EDS = 2 * MiB + 512 * 1024;
constexpr size_t WS_H2Q = 95 * MiB, WS_H2S = 111 * MiB;
constexpr size_t WS_H = 83 * MiB, WS_OA = 83 * MiB, WS_OB = 99 * MiB, WS_PIDX = 83 * MiB, WS_PG = 87 * MiB;
constexpr size_t WS_PROJ = 115 * MiB, WS_X1 = 115 * MiB, WS_H2 = 179 * MiB, WS_QP = 211 * MiB;
constexpr size_t WS_END = 251 * MiB;
static_assert(WS_WIN + (size_t)NPROJ * D * 2 <= WS_WA && WS_WQ + (size_t)D * D * 2 <= WS_ED && WS_PROJ + (size_t)M * NPROJ * 2 <= WS_END, "ws map");
constexpr int CW_BAR = 4096; static_assert(CW_BAR == CW_BAR_FWD && WS_CTL == 0, "barrier words");

constexpr int RING_OFF = 0, RING_BYTES = 131072;
constexpr int LDSCTL_OFF = RING_BYTES, MISC_OFF = LDSCTL_OFF + 320;
constexpr int LDS_BYTES = 147456;

typedef float f32x16 __attribute__((ext_vector_type(16)));
typedef short s16x4 __attribute__((ext_vector_type(4)));
typedef unsigned u32x2 __attribute__((ext_vector_type(2)));
typedef float f32x2_t __attribute__((ext_vector_type(2)));
typedef __bf16 bf16x2_t __attribute__((ext_vector_type(2)));

__device__ __forceinline__ unsigned cvtpk(float lo, float hi) { f32x2_t v = {lo, hi}; bf16x2_t b = __builtin_convertvector(v, bf16x2_t); return __builtin_bit_cast(unsigned, b); }
__device__ __forceinline__ float bflo(unsigned u) { return __uint_as_float(u << 16); }
__device__ __forceinline__ float bfhi(unsigned u) { return __uint_as_float(u & 0xffff0000u); }
template <int S> __device__ __forceinline__ unsigned xorx(unsigned v, int lane) {
    if constexpr (S == 1) return (unsigned)__builtin_amdgcn_update_dpp(0, (int)v, 0xB1, 0xF, 0xF, true);
    else if constexpr (S == 2) return (unsigned)__builtin_amdgcn_update_dpp(0, (int)v, 0x4E, 0xF, 0xF, true);
    else if constexpr (S == 4) { const unsigned a = (unsigned)__builtin_amdgcn_update_dpp(0, (int)v, 0x124, 0xF, 0xF, true), b = (unsigned)__builtin_amdgcn_update_dpp(0, (int)v, 0x12C, 0xF, 0xF, true); return (lane & 4) ? a : b; }
    else if constexpr (S == 8) return (unsigned)__builtin_amdgcn_update_dpp(0, (int)v, 0x128, 0xF, 0xF, true);
    else if constexpr (S == 16) { const auto r = __builtin_amdgcn_permlane16_swap(v, v, false, false); return (lane & 16) ? r[0] : r[1]; }
    else { const auto r = __builtin_amdgcn_permlane32_swap(v, v, false, false); return (lane & 32) ? r[0] : r[1]; }
}
__device__ __forceinline__ unsigned xorx_sw(unsigned v, int lane, int s) {
    switch (s) { case 1: return xorx<1>(v, lane); case 2: return xorx<2>(v, lane); case 4: return xorx<4>(v, lane); case 8: return xorx<8>(v, lane); case 16: return xorx<16>(v, lane); default: return xorx<32>(v, lane); }
}
__device__ __forceinline__ float wave_sum_x(float v, int lane) {
    v += __uint_as_float(xorx<1>(__float_as_uint(v), lane)); v += __uint_as_float(xorx<2>(__float_as_uint(v), lane)); v += __uint_as_float(xorx<4>(__float_as_uint(v), lane));
    v += __uint_as_float(xorx<8>(__float_as_uint(v), lane)); v += __uint_as_float(xorx<16>(__float_as_uint(v), lane)); v += __uint_as_float(xorx<32>(__float_as_uint(v), lane));
    return v;
}
__device__ __forceinline__ float dppf(float v, const int ctrl_sel) { return v; }
#define DPP_F(v, CTRL) __uint_as_float(__builtin_amdgcn_update_dpp(0, __float_as_uint(v), (CTRL), 0xF, 0xF, true))
__device__ __forceinline__ float reduce8_t(const float (&dd)[8], int lane) {
    float r4[4];
#pragma unroll
    for (int u = 0; u < 4; ++u) { const auto p = __builtin_amdgcn_permlane32_swap(__float_as_uint(dd[u]), __float_as_uint(dd[u + 4]), false, false); r4[u] = __uint_as_float(p[0]) + __uint_as_float(p[1]); }
    float r2[2];
#pragma unroll
    for (int u = 0; u < 2; ++u) { const auto p = __builtin_amdgcn_permlane16_swap(__float_as_uint(r4[u]), __float_as_uint(r4[u + 2]), false, false); r2[u] = __uint_as_float(p[0]) + __uint_as_float(p[1]); }
    const bool b3 = (lane & 8) != 0;
    const float keep = b3 ? r2[1] : r2[0], send = b3 ? r2[0] : r2[1];
    float r1 = keep + DPP_F(send, 0x128);
    r1 += DPP_F(r1, 0xB1);
    r1 += DPP_F(r1, 0x4E);
    r1 += DPP_F(r1, 0x141);
    return r1;
}
__device__ __forceinline__ int lane_id() { return (int)__builtin_amdgcn_mbcnt_hi(~0u, __builtin_amdgcn_mbcnt_lo(~0u, 0u)); }
__device__ __forceinline__ float wave_sum(float v) { return wave_sum_x(v, lane_id()); }
__device__ __forceinline__ float wave_max(float v) { const int lane = lane_id();
    v = fmaxf(v, __uint_as_float(xorx<1>(__float_as_uint(v), lane))); v = fmaxf(v, __uint_as_float(xorx<2>(__float_as_uint(v), lane))); v = fmaxf(v, __uint_as_float(xorx<4>(__float_as_uint(v), lane)));
    v = fmaxf(v, __uint_as_float(xorx<8>(__float_as_uint(v), lane))); v = fmaxf(v, __uint_as_float(xorx<16>(__float_as_uint(v), lane))); v = fmaxf(v, __uint_as_float(xorx<32>(__float_as_uint(v), lane)));
    return v; }
__device__ __forceinline__ int crow(int r, int hi) { return (r & 3) + 8 * (r >> 2) + 4 * hi; }
#define MFMA32(a, b, c) __builtin_amdgcn_mfma_f32_32x32x16_bf16((a), (b), (c), 0, 0, 0)

struct Frame {
    LAS unsigned char* lds;
    int tid, lane, wave, vcu, G;
};
__device__ __forceinline__ const void* karg(int i) {
    unsigned long z = 0; asm volatile("" : "+s"(z));
    const char* base = (const char*)__builtin_amdgcn_kernarg_segment_ptr();
    return *(const void* const*)(base + 8 * i + z);
}

__device__ __forceinline__ void p0_transpose_item(const float* W, int ld, int K, int ncols, bf16* WT, int row_off, LAS float* scr, int item, int lane) {
    const int nblk = ncols / 32, kb = item / nblk, nb = item % nblk, k0 = 64 * kb, n0 = 32 * nb;
#pragma unroll 8
    for (int i = 0; i < 32; ++i) { const int kk = 2 * i + (lane >> 5); scr[kk * 33 + (lane & 31)] = __builtin_nontemporal_load(W + (size_t)(k0 + kk) * ld + n0 + (lane & 31)); }
    LDS_WAIT(); asm volatile("" ::: "memory");
    const int c = lane & 7;
#pragma unroll
    for (int j = 0; j < 4; ++j) { const int n = (lane >> 3) + 8 * j; const LAS float* s = scr + (8 * c) * 33 + n;
        v4u o; o.x = pk2(s[0 * 33], s[1 * 33]); o.y = pk2(s[2 * 33], s[3 * 33]); o.z = pk2(s[4 * 33], s[5 * 33]); o.w = pk2(s[6 * 33], s[7 * 33]);
        *(GAS v4u*)(WT + (size_t)(row_off + n0 + n) * K + k0 + 8 * c) = o; }
    LDS_WAIT(); asm volatile("" ::: "memory");
}
__device__ __forceinline__ void p0_convert(const float* __restrict__ src, bf16* __restrict__ dst, long n_iters, int gw, int NGW, int lane) {
    for (long it0 = (long)gw * 4; it0 < n_iters; it0 += (long)NGW * 4) {
        f32x4 a[4][2];
#pragma unroll
        for (int u = 0; u < 4; ++u) { const long it = it0 + u; if (it < n_iters) { const float* p = src + it * 512 + lane * 4; a[u][0] = *(const f32x4*)p; a[u][1] = *(const f32x4*)(p + 256); } }
#pragma unroll
        for (int u = 0; u < 4; ++u) { const long it = it0 + u; if (it < n_iters) { bf16* q = dst + it * 512 + lane * 4;
            u32x2 w0, w1; w0.x = cvtpk(a[u][0].x, a[u][0].y); w0.y = cvtpk(a[u][0].z, a[u][0].w); w1.x = cvtpk(a[u][1].x, a[u][1].y); w1.y = cvtpk(a[u][1].z, a[u][1].w);
            *(u32x2*)q = w0; *(u32x2*)(q + 256) = w1; } }
    }
}

__device__ __forceinline__ void p0_quant_tables(Frame& F, int gw, int NGW) {
    const float* ed = ((const float*)karg(15)); const float* eu = ((const float*)karg(16));
    unsigned char* EDq = (unsigned char*)(((unsigned char*)karg(19)) + WS_ED); unsigned char* EUq = (unsigned char*)(((unsigned char*)karg(19)) + WS_EU); float* EDS = (float*)(((unsigned char*)karg(19)) + WS_EDS);
    const int lane = F.lane;
    for (int row0 = gw * 4; row0 < NEXP; row0 += NGW * 4) {
        f32x4 a[4][4], u[4][4];
#pragma unroll
        for (int q = 0; q < 4; ++q)
#pragma unroll
            for (int j = 0; j < 4; ++j) { a[q][j] = __builtin_nontemporal_load((const f32x4*)(ed + (size_t)(row0 + q) * D) + lane + 64 * j); u[q][j] = __builtin_nontemporal_load((const f32x4*)(eu + (size_t)(row0 + q) * D) + lane + 64 * j); }
#pragma unroll
        for (int q = 0; q < 4; ++q) {
            float am = 0.f;
#pragma unroll
            for (int j = 0; j < 4; ++j) am = fmaxf(fmaxf(am, fmaxf(fabsf(a[q][j].x), fabsf(a[q][j].y))), fmaxf(fabsf(a[q][j].z), fabsf(a[q][j].w)));
            am = wave_max(am);
            const float sc = am > 0.f ? am * (1.0f / 127.0f) : 1.0f, inv = 1.0f / sc;
            v4u qa, qu;
#pragma unroll
            for (int j = 0; j < 4; ++j) {
                const int b0 = (int)rintf(a[q][j].x * inv), b1 = (int)rintf(a[q][j].y * inv), b2 = (int)rintf(a[q][j].z * inv), b3 = (int)rintf(a[q][j].w * inv);
                qa[j] = (unsigned)(b0 & 255) | ((unsigned)(b1 & 255) << 8) | ((unsigned)(b2 & 255) << 16) | ((unsigned)(b3 & 255) << 24);
                int p = __builtin_amdgcn_cvt_pk_fp8_f32(u[q][j].x * 16.0f, u[q][j].y * 16.0f, 0, false);
                p = __builtin_amdgcn_cvt_pk_fp8_f32(u[q][j].z * 16.0f, u[q][j].w * 16.0f, p, true);
                qu[j] = (unsigned)p;
            }
            __builtin_nontemporal_store(qa, (v4u*)(EDq + (size_t)(row0 + q) * D + 16 * lane));
            __builtin_nontemporal_store(qu, (v4u*)(EUq + (size_t)(row0 + q) * D + 16 * lane));
            if (lane == 0) EDS[row0 + q] = sc;
        }
    }
}
__device__ __forceinline__ void p0_prologue(Frame& F) {
    const float* c = ((const float*)karg(1)); const float* w_ada = ((const float*)karg(4)); const float* b_ada = ((const float*)karg(5));
    float* MOD = (float*)(((unsigned char*)karg(19)) + WS_MOD);
    {
        LAS float* cact = (LAS float*)(F.lds);
        LAS float* part = (LAS float*)(F.lds + 16384);
        bool did = false;
        for (int item = F.vcu; item < NMOD / 32; item += F.G) {
            if (!did) { for (int i = F.tid; i < 4096; i += NTHR) { const float cv = c[i]; cact[i] = cv / (1.0f + __expf(-cv)); } did = true; }
            __syncthreads();
            const int n0 = item * 32, col = n0 + (F.lane & 31), ksub = F.lane >> 5;
            float a0 = 0.f, a1 = 0.f, a2 = 0.f, a3 = 0.f;
#pragma unroll 16
            for (int it = 0; it < 64; ++it) { const int k = (it * 8 + F.wave) * 2 + ksub; const float w = __builtin_nontemporal_load(w_ada + (size_t)k * NMOD + col);
                a0 += cact[k] * w; a1 += cact[1024 + k] * w; a2 += cact[2048 + k] * w; a3 += cact[3072 + k] * w; }
            a0 += __shfl_xor(a0, 32); a1 += __shfl_xor(a1, 32); a2 += __shfl_xor(a2, 32); a3 += __shfl_xor(a3, 32);
            if (F.lane < 32) { part[(F.wave * 4 + 0) * 32 + F.lane] = a0; part[(F.wave * 4 + 1) * 32 + F.lane] = a1; part[(F.wave * 4 + 2) * 32 + F.lane] = a2; part[(F.wave * 4 + 3) * 32 + F.lane] = a3; }
            __syncthreads();
            if (F.tid < 128) { const int b = F.tid >> 5, cl = F.tid & 31; float s = 0.f;
#pragma unroll
                for (int w = 0; w < 8; ++w) s += part[(w * 4 + b) * 32 + cl];
                MOD[b * NMOD + n0 + cl] = s + b_ada[n0 + cl]; }
            __syncthreads();
        }
    }
    {
        const int gw = F.vcu * NWAVES + F.wave, NGW = F.G * NWAVES;
        p0_convert(((const float*)karg(14)), (bf16*)(((unsigned char*)karg(19)) + WS_SUBK), (long)(8 * 2 * 128 * 64) / 512, gw, NGW, F.lane);
    }
}
__device__ __forceinline__ void p0_transposes(Frame& F) {
    LAS float* scr = (LAS float*)(F.lds + 32768 + F.wave * 8704);
    const int gw = F.vcu * NWAVES + F.wave, NGW = F.G * NWAVES;
    constexpr int I_IN1 = (D / 64) * (2304 / 32), I_IN2 = (D / 64) * (2048 / 32), I_AB = (512 / 64) * (D / 32), I_SQ = (D / 64) * (D / 32);
    constexpr int NITEMS = I_IN1 + I_IN2 + 2 * I_AB + 2 * I_SQ;
    bf16* Win_t = (bf16*)(((unsigned char*)karg(19)) + WS_WIN);
    for (int it = gw; it < NITEMS; it += NGW) {
        int r = it;
        if (r < I_IN1) { p0_transpose_item(((const float*)karg(6)), LDW_IN, D, 2304, Win_t, 0, scr, r, F.lane); continue; } r -= I_IN1;
        if (r < I_IN2) { p0_transpose_item(((const float*)karg(6)) + 2312, LDW_IN, D, 2048, Win_t, 2304, scr, r, F.lane); continue; } r -= I_IN2;
        if (r < I_AB) { p0_transpose_item(((const float*)karg(9)), D, 512, D, (bf16*)(((unsigned char*)karg(19)) + WS_WA), 0, scr, r, F.lane); continue; } r -= I_AB;
        if (r < I_AB) { p0_transpose_item(((const float*)karg(10)), D, 512, D, (bf16*)(((unsigned char*)karg(19)) + WS_WB), 0, scr, r, F.lane); continue; } r -= I_AB;
        if (r < I_SQ) { p0_transpose_item(((const float*)karg(11)), D, D, D, (bf16*)(((unsigned char*)karg(19)) + WS_WOUT), 0, scr, r, F.lane); continue; } r -= I_SQ;
        p0_transpose_item(((const float*)karg(13)), D, D, D, (bf16*)(((unsigned char*)karg(19)) + WS_WQ), 0, scr, r, F.lane);
    }
}

__device__ __forceinline__ void p1_norm(Frame& F) {
    const float* x = ((const float*)karg(0)); const float* g1 = ((const float*)karg(2)); const float* w_in = ((const float*)karg(6)); const float* b_forget = ((const float*)karg(7));
    const float* MOD = (const float*)(((unsigned char*)karg(19)) + WS_MOD); bf16* H = (bf16*)(((unsigned char*)karg(19)) + WS_H); float* LOGF = (float*)(((unsigned char*)karg(19)) + WS_LOGF);
    LAS float* wfl = (LAS float*)(F.lds);
    { float tmp[16];
#pragma unroll
      for (int n = 0; n < 16; ++n) { const int i = F.tid + n * NTHR; tmp[n] = w_in[(size_t)(i >> 3) * LDW_IN + 2304 + (i & 7)]; }
#pragma unroll
      for (int n = 0; n < 16; ++n) { const int i = F.tid + n * NTHR; wfl[(i & 7) * 1024 + (i >> 3)] = tmp[n]; } }
    __syncthreads();
    const int gw = F.vcu * NWAVES + F.wave, NGW = F.G * NWAVES;
    for (int c = gw; c < M / 8; c += NGW) {
        const int row0 = c * 8; const float* mb = MOD + (row0 >> 12) * NMOD;
        f32x4 ga[4], sh[4];
#pragma unroll
        for (int j = 0; j < 4; ++j) { const int col = 4 * F.lane + 256 * j; const f32x4 g = *(const f32x4*)(g1 + col), sc = *(const f32x4*)(mb + 1024 + col); sh[j] = *(const f32x4*)(mb + col); ga[j] = g * (sc + 1.0f); }
        f32x4 r0[4], r1[4], r2[4];
        { const f32x4* xr = (const f32x4*)(x + (size_t)row0 * D) + F.lane;
#pragma unroll
          for (int j = 0; j < 4; ++j) r0[j] = __builtin_nontemporal_load(xr + 64 * j);
#pragma unroll
          for (int j = 0; j < 4; ++j) r1[j] = __builtin_nontemporal_load(xr + 256 + 64 * j); }
#pragma unroll
        for (int i = 0; i < 8; ++i) {
            const int row = row0 + i;
            if (i + 2 < 8) { const f32x4* xr = (const f32x4*)(x + (size_t)(row + 2) * D) + F.lane;
#pragma unroll
                for (int j = 0; j < 4; ++j) r2[j] = __builtin_nontemporal_load(xr + 64 * j); }
            float ss = 0.f;
#pragma unroll
            for (int j = 0; j < 4; ++j) ss += (r0[j].x * r0[j].x + r0[j].y * r0[j].y) + (r0[j].z * r0[j].z + r0[j].w * r0[j].w);
            ss = wave_sum(ss);
            const float rstd = 1.0f / sqrtf(ss * (1.0f / D) + EPS);
            float fl[8];
#pragma unroll
            for (int jj = 0; jj < 8; ++jj) fl[jj] = 0.f;
#pragma unroll
            for (int j = 0; j < 4; ++j) { const int col = 4 * F.lane + 256 * j;
                const f32x4 hv = (r0[j] * rstd) * ga[j] + sh[j];
                u32x2 w; w.x = cvtpk(hv.x, hv.y); w.y = cvtpk(hv.z, hv.w);
                *(u32x2*)(H + (size_t)row * D + col) = w;
#pragma unroll
                for (int jj = 0; jj < 8; ++jj) { const f32x4 wv = *(const LAS f32x4*)(wfl + jj * 1024 + col); fl[jj] += (hv.x * wv.x + hv.y * wv.y) + (hv.z * wv.z + hv.w * wv.w); }
            }
            const int lane = F.lane; const float r1s = reduce8_t(fl, lane);
            if ((lane & 7) == 0) { const int jj = lane >> 3; const float z = r1s + b_forget[jj]; const float ls = fminf(z, 0.f) - log1pf(__expf(-fabsf(z))); LOGF[(size_t)row * 8 + jj] = ls; }
#pragma unroll
            for (int j = 0; j < 4; ++j) { r0[j] = r1[j]; r1[j] = r2[j]; }
        }
    }
}

constexpr int KP = 72;
constexpr int VPF = 68;
constexpr int VPS = 260;
struct FlashState { f32x16 o[2]; float m, l; };

__device__ __forceinline__ void flash_tail(FlashState& st, f32x16& s0, f32x16& s1, const LAS bf16* Vs, int vp, int r32, int hi) {
    float mt = s0[0];
#pragma unroll
    for (int r = 1; r < 16; ++r) mt = fmaxf(mt, s0[r]);
#pragma unroll
    for (int r = 0; r < 16; ++r) mt = fmaxf(mt, s1[r]);
    mt = fmaxf(mt, __uint_as_float(xorx<32>(__float_as_uint(mt), 32 * hi)));
    const float mn = fmaxf(st.m, mt);
    const float alpha = __expf(st.m - mn);
    st.m = mn;
    float ps = 0.f;
#pragma unroll
    for (int r = 0; r < 16; ++r) { s0[r] = __expf(s0[r] - mn); ps += s0[r]; }
#pragma unroll
    for (int r = 0; r < 16; ++r) { s1[r] = __expf(s1[r] - mn); ps += s1[r]; }
    st.l = st.l * alpha + ps;
    if (__any(alpha != 1.0f)) {
#pragma unroll
        for (int r = 0; r < 16; ++r) { st.o[0][r] *= alpha; st.o[1][r] *= alpha; }
    }
#pragma unroll
    for (int blk = 0; blk < 2; ++blk)
#pragma unroll
        for (int s = 0; s < 2; ++s) {
            v4u pw;
            if (blk == 0) { pw.x = cvtpk(s0[8 * s + 0], s0[8 * s + 1]); pw.y = cvtpk(s0[8 * s + 2], s0[8 * s + 3]); pw.z = cvtpk(s0[8 * s + 4], s0[8 * s + 5]); pw.w = cvtpk(s0[8 * s + 6], s0[8 * s + 7]); }
            else          { pw.x = cvtpk(s1[8 * s + 0], s1[8 * s + 1]); pw.y = cvtpk(s1[8 * s + 2], s1[8 * s + 3]); pw.z = cvtpk(s1[8 * s + 4], s1[8 * s + 5]); pw.w = cvtpk(s1[8 * s + 6], s1[8 * s + 7]); }
            const bf16x8 pf = __builtin_bit_cast(bf16x8, pw);
#pragma unroll
            for (int db = 0; db < 2; ++db) {
                const LAS bf16* vp0 = Vs + (32 * db + r32) * vp + 32 * blk + 16 * s + 4 * hi;
                const s16x4 lo = *(const LAS s16x4*)vp0, hh = *(const LAS s16x4*)(vp0 + 8);
                const bf16x8 vf = __builtin_shufflevector(lo, hh, 0, 1, 2, 3, 4, 5, 6, 7);
                st.o[db] = MFMA32(vf, pf, st.o[db]);
            }
        }
}
__device__ __forceinline__ void flash_qk(f32x16& s0, f32x16& s1, const bf16x8 (&qf)[4], const LAS bf16* Ks, int r32, int hi) {
    s0 = (f32x16){0.f}; s1 = (f32x16){0.f};
#pragma unroll
    for (int r = 0; r < 16; ++r) { s0[r] = 0.f; s1[r] = 0.f; }
#pragma unroll
    for (int ks = 0; ks < 4; ++ks) {
        const bf16x8 a0 = *(const LAS bf16x8*)(Ks + r32 * KP + 16 * ks + 8 * hi);
        const bf16x8 a1 = *(const LAS bf16x8*)(Ks + (32 + r32) * KP + 16 * ks + 8 * hi);
        s0 = MFMA32(a0, qf[ks], s0); s1 = MFMA32(a1, qf[ks], s1);
    }
}
__device__ __forceinline__ void flash_qk2(f32x16& a0, f32x16& a1, f32x16& b0, f32x16& b1, const bf16x8 (&qa)[4], const bf16x8 (&qb)[4], const LAS bf16* Ks, int r32, int hi) {
#pragma unroll
    for (int r = 0; r < 16; ++r) { a0[r] = 0.f; a1[r] = 0.f; b0[r] = 0.f; b1[r] = 0.f; }
#pragma unroll
    for (int ks = 0; ks < 4; ++ks) {
        const bf16x8 k0 = *(const LAS bf16x8*)(Ks + r32 * KP + 16 * ks + 8 * hi);
        const bf16x8 k1 = *(const LAS bf16x8*)(Ks + (32 + r32) * KP + 16 * ks + 8 * hi);
        a0 = MFMA32(k0, qa[ks], a0); b0 = MFMA32(k0, qb[ks], b0); a1 = MFMA32(k1, qa[ks], a1); b1 = MFMA32(k1, qb[ks], b1);
    }
}
__device__ __forceinline__ void flash_soft(FlashState& st, f32x16& s0, f32x16& s1, int hi) {
    float mt = s0[0];
#pragma unroll
    for (int r = 1; r < 16; ++r) mt = fmaxf(mt, s0[r]);
#pragma unroll
    for (int r = 0; r < 16; ++r) mt = fmaxf(mt, s1[r]);
    mt = fmaxf(mt, __uint_as_float(xorx<32>(__float_as_uint(mt), 32 * hi)));
    const float mn = fmaxf(st.m, mt);
    const float alpha = __expf(st.m - mn);
    st.m = mn;
    float ps = 0.f;
#pragma unroll
    for (int r = 0; r < 16; ++r) { s0[r] = __expf(s0[r] - mn); ps += s0[r]; }
#pragma unroll
    for (int r = 0; r < 16; ++r) { s1[r] = __expf(s1[r] - mn); ps += s1[r]; }
    st.l = st.l * alpha + ps;
    if (__any(alpha != 1.0f)) {
#pragma unroll
        for (int r = 0; r < 16; ++r) { st.o[0][r] *= alpha; st.o[1][r] *= alpha; }
    }
}
__device__ __forceinline__ bf16x8 pack_p(const f32x16& p, int s) {
    v4u pw; pw.x = cvtpk(p[8 * s + 0], p[8 * s + 1]); pw.y = cvtpk(p[8 * s + 2], p[8 * s + 3]); pw.z = cvtpk(p[8 * s + 4], p[8 * s + 5]); pw.w = cvtpk(p[8 * s + 6], p[8 * s + 7]);
    return __builtin_bit_cast(bf16x8, pw);
}
__device__ __forceinline__ void flash_pv2(FlashState& sa, FlashState& sb, const f32x16& a0, const f32x16& a1, const f32x16& b0, const f32x16& b1, const LAS bf16* Vs, int vp, int r32, int hi) {
#pragma unroll
    for (int blk = 0; blk < 2; ++blk)
#pragma unroll
        for (int s = 0; s < 2; ++s) {
            const bf16x8 pfa = blk ? pack_p(a1, s) : pack_p(a0, s), pfb = blk ? pack_p(b1, s) : pack_p(b0, s);
#pragma unroll
            for (int db = 0; db < 2; ++db) {
                const LAS bf16* vp0 = Vs + (32 * db + r32) * vp + 32 * blk + 16 * s + 4 * hi;
                const s16x4 lo = *(const LAS s16x4*)vp0, hh = *(const LAS s16x4*)(vp0 + 8);
                const bf16x8 vf = __builtin_shufflevector(lo, hh, 0, 1, 2, 3, 4, 5, 6, 7);
                sa.o[db] = MFMA32(vf, pfa, sa.o[db]); sb.o[db] = MFMA32(vf, pfb, sb.o[db]);
            }
        }
}
__device__ __forceinline__ void flash_store(const FlashState& st, bf16* orow, int hi) {
    float lt = st.l + __uint_as_float(xorx<32>(__float_as_uint(st.l), 32 * hi));
    const float inv = 1.0f / lt;
#pragma unroll
    for (int db = 0; db < 2; ++db)
#pragma unroll
        for (int rg = 0; rg < 4; ++rg) { u32x2 w; w.x = cvtpk(st.o[db][4 * rg] * inv, st.o[db][4 * rg + 1] * inv); w.y = cvtpk(st.o[db][4 * rg + 2] * inv, st.o[db][4 * rg + 3] * inv);
            *(u32x2*)(orow + 32 * db + 8 * rg + 4 * hi) = w; }
}

__device__ __forceinline__ void fox_unit(Frame& F, int b, int h, int qb, float& kmax2) {
    const bf16* proj = (const bf16*)(((unsigned char*)karg(19)) + WS_PROJ); const float* LOGF = (const float*)(((unsigned char*)karg(19)) + WS_LOGF); bf16* OB = (bf16*)(((unsigned char*)karg(19)) + WS_OB);
    LAS float* Fs = (LAS float*)(F.lds);
    LAS float* wtot = (LAS float*)(F.lds + 16384);
    LAS bf16* Kb = (LAS bf16*)(F.lds + 16384 + 128);
    LAS bf16* Vb = (LAS bf16*)(F.lds + 16384 + 128 + 2 * 64 * KP * 2);
    const int lane = F.lane, wave = F.wave, tid = F.tid, r32 = lane & 31, hi = lane >> 5;
    const int q_end = 512 * (qb + 1), NT = q_end / 64;
    const size_t rowbase = (size_t)b * SEQ;
    if (kmax2 < 0.f) {
        float v[8]; float run = 0.f;
#pragma unroll
        for (int i = 0; i < 8; ++i) { const int pos = tid * 8 + i; const float lf = (pos < q_end) ? LOGF[(rowbase + pos) * 8 + h] : 0.f; run += lf; v[i] = run; }
        float inc = run;
#pragma unroll
        for (int o = 1; o < 64; o <<= 1) { const float t = __shfl_up(inc, o); if (lane >= o) inc += t; }
        if (lane == 63) wtot[wave] = inc;
        __syncthreads();
        float off = inc - run;
        for (int w = 0; w < wave; ++w) off += wtot[w];
#pragma unroll
        for (int i = 0; i < 8; ++i) Fs[tid * 8 + i] = v[i] + off;
    }
    const int qrow = 512 * qb + 64 * wave + r32, qrowB = qrow + 32;
    bf16x8 qf[4], qg[4];
    { const bf16* qp = proj + (rowbase + qrow) * NPROJ + C_QB + 64 * h + 8 * hi;
#pragma unroll
      for (int ks = 0; ks < 4; ++ks) { qf[ks] = *(const bf16x8*)(qp + 16 * ks); qg[ks] = *(const bf16x8*)(qp + (size_t)32 * NPROJ + 16 * ks); } }
    const int tq = 8 * qb + wave;
    LAS bf16* Qs = (LAS bf16*)(F.lds + 53248) + wave * (64 * KP);
    {
        float qn = 0.f;
#pragma unroll
        for (int ks = 0; ks < 4; ++ks)
#pragma unroll
            for (int j = 0; j < 8; ++j) { const float e = __uint_as_float(((unsigned)(unsigned short)qf[ks][j]) << 16); qn += e * e; }
        qn += __shfl_xor(qn, 32);
        { float qn2 = 0.f;
#pragma unroll
          for (int ks = 0; ks < 4; ++ks)
#pragma unroll
              for (int j = 0; j < 8; ++j) { const float e = __uint_as_float(((unsigned)(unsigned short)qg[ks][j]) << 16); qn2 += e * e; }
          qn2 += __shfl_xor(qn2, 32); qn = fmaxf(qn, qn2); }
#pragma unroll
        for (int o = 1; o < 32; o <<= 1) qn = fmaxf(qn, __shfl_xor(qn, o));
        float kn = 0.f;
        if (kmax2 < 0.f) {
            for (int p0 = 0; p0 < q_end; p0 += 4 * 64) {
                v4u w4[4];
#pragma unroll
                for (int i = 0; i < 4; ++i) w4[i] = *(const v4u*)(proj + (rowbase + p0 + 64 * i + (tid >> 3)) * NPROJ + C_KB + 64 * h + 8 * (tid & 7));
#pragma unroll
                for (int i = 0; i < 4; ++i) { const unsigned wx = w4[i].x, wy = w4[i].y, wz = w4[i].z, ww = w4[i].w;
                    float s = bflo(wx) * bflo(wx) + bfhi(wx) * bfhi(wx) + bflo(wy) * bflo(wy) + bfhi(wy) * bfhi(wy) + bflo(wz) * bflo(wz) + bfhi(wz) * bfhi(wz) + bflo(ww) * bflo(ww) + bfhi(ww) * bfhi(ww);
                    s += __shfl_xor(s, 1); s += __shfl_xor(s, 2); s += __shfl_xor(s, 4);
                    kn = fmaxf(kn, s); } }
            kn = wave_max(kn);
        }
        if (lane == 0) { wtot[8 + wave] = qn; wtot[16 + wave] = kn; }
    }
#pragma unroll
    for (int ks = 0; ks < 4; ++ks) { *(LAS bf16x8*)(Qs + r32 * KP + 16 * ks + 8 * hi) = qf[ks]; *(LAS bf16x8*)(Qs + (32 + r32) * KP + 16 * ks + 8 * hi) = qg[ks]; }
    FlashState st, su; st.m = -INFINITY; st.l = 0.f; su.m = -INFINITY; su.l = 0.f;
#pragma unroll
    for (int r = 0; r < 16; ++r) { st.o[0][r] = 0.f; st.o[1][r] = 0.f; su.o[0][r] = 0.f; su.o[1][r] = 0.f; }
    const int srow = tid >> 3, sch = tid & 7;
    const bf16* kg = proj + (rowbase + srow) * NPROJ + C_KB + 64 * h + 8 * sch;
    const bf16* vg = proj + (rowbase + srow) * NPROJ + C_VB + 64 * h + 8 * sch;
    v4u kreg, vreg;
    { const size_t o = (size_t)(NT - 1) * 64 * NPROJ; kreg = *(const v4u*)(kg + o); vreg = *(const v4u*)(vg + o); }
    int cur = 0;
    {   *(LAS v4u*)(Kb + srow * KP + 8 * sch) = kreg;
        const unsigned short* vs = (const unsigned short*)&vreg;
#pragma unroll
        for (int i = 0; i < 8; ++i) Vb[(8 * sch + i) * VPF + srow] = vs[i];
    }
    __syncthreads();
    const float fq = Fs[qrow], fqB = Fs[qrowB];
    int t_lo = 0;
    {
        float qm = 0.f, km = 0.f;
#pragma unroll
        for (int w = 0; w < 8; ++w) { qm = fmaxf(qm, wtot[8 + w]); km = fmaxf(km, wtot[16 + w]); }
        if (kmax2 < 0.f) kmax2 = km;
        const float A = 0.125f * sqrtf(qm) * sqrtf(kmax2) * 1.01f, f0 = Fs[512 * qb];
        for (int t = NT - 9; t >= 0; --t) if (Fs[64 * t + 63] - f0 > 2.0f * A + 60.0f) { t_lo = t + 1; break; }
    }
    for (int t = NT - 1; t >= t_lo; --t) {
        if (t > t_lo) { const size_t o = (size_t)(t - 1) * 64 * NPROJ; kreg = *(const v4u*)(kg + o); vreg = *(const v4u*)(vg + o); }
        if (t <= tq) {
            const LAS bf16* Ks = Kb + cur * 64 * KP; const LAS bf16* Vs = Vb + cur * 64 * VPF;
            bf16x8 qa[4], qb4[4];
#pragma unroll
            for (int ks = 0; ks < 4; ++ks) { qa[ks] = *(const LAS bf16x8*)(Qs + r32 * KP + 16 * ks + 8 * hi); qb4[ks] = *(const LAS bf16x8*)(Qs + (32 + r32) * KP + 16 * ks + 8 * hi); }
            f32x16 s0, s1, u0, u1; flash_qk2(s0, s1, u0, u1, qa, qb4, Ks, r32, hi);
            const LAS float* Fk = Fs + 64 * t;
            const bool diag = (t == tq);
#pragma unroll
            for (int rg = 0; rg < 4; ++rg) {
                const f32x4 f0 = *(const LAS f32x4*)(Fk + 8 * rg + 4 * hi), f1 = *(const LAS f32x4*)(Fk + 32 + 8 * rg + 4 * hi);
#pragma unroll
                for (int i = 0; i < 4; ++i) { const int r = 4 * rg + i; const int kv = 64 * t + 8 * rg + 4 * hi + i;
                    float a = s0[r] * 0.125f + (fq - f0[i]), c = s1[r] * 0.125f + (fq - f1[i]), d = u0[r] * 0.125f + (fqB - f0[i]), e = u1[r] * 0.125f + (fqB - f1[i]);
                    if (diag) { if (kv > qrow) a = -INFINITY; if (kv + 32 > qrow) c = -INFINITY; if (kv > qrowB) d = -INFINITY; if (kv + 32 > qrowB) e = -INFINITY; }
                    s0[r] = a; s1[r] = c; u0[r] = d; u1[r] = e; }
            }
            flash_soft(st, s0, s1, hi); flash_soft(su, u0, u1, hi);
            flash_pv2(st, su, s0, s1, u0, u1, Vs, VPF, r32, hi);
        }
        if (t > t_lo) {
            const int nb = cur ^ 1;
            *(LAS v4u*)(Kb + nb * 64 * KP + srow * KP + 8 * sch) = kreg;
            const unsigned short* vs = (const unsigned short*)&vreg;
#pragma unroll
            for (int i = 0; i < 8; ++i) Vb[nb * 64 * VPF + (8 * sch + i) * VPF + srow] = vs[i];
        }
        __syncthreads();
        cur ^= 1;
    }
    flash_store(st, OB + (rowbase + qrow) * 512 + 64 * h, hi); flash_store(su, OB + (rowbase + qrowB) * 512 + 64 * h, hi);
    __syncthreads();
}

__device__ const unsigned char T5_BUCKET[128] = {0,1,2,3,4,5,6,7,8,9,10,11,12,13,14,15,16,16,16,17,17,18,18,18,19,19,19,20,20,20,20,21,21,21,21,22,22,22,22,22,23,23,23,23,23,23,24,24,24,24,24,24,25,25,25,25,25,25,25,26,26,26,26,26,26,26,26,27,27,27,27,27,27,27,27,27,27,28,28,28,28,28,28,28,28,28,28,29,29,29,29,29,29,29,29,29,29,29,29,30,30,30,30,30,30,30,30,30,30,30,30,30,30,31,31,31,31,31,31,31,31,31,31,31,31,31,31,31};

__device__ __forceinline__ void swa_unit(Frame& F, int b, int kvh, int n) {
    const bf16* proj = (const bf16*)(((unsigned char*)karg(19)) + WS_PROJ); bf16* OA = (bf16*)(((unsigned char*)karg(19)) + WS_OA);
    const float* sinks = ((const float*)karg(8)); const float* rel_bias = ((const float*)karg(12));
    LAS bf16* Kb = (LAS bf16*)(F.lds);
    LAS bf16* Vb = (LAS bf16*)(F.lds + 36864);
    LAS float* bt = (LAS float*)(F.lds + 36864 + 33280);
    const int lane = F.lane, wave = F.wave, tid = F.tid, r32 = lane & 31, hi = lane >> 5;
    const size_t rowbase = (size_t)b * SEQ;
    {
        const int g = tid >> 7, d = tid & 127;
        bt[tid] = rel_bias[(int)T5_BUCKET[d] * 8 + kvh * 4 + g];
#pragma unroll
        for (int i = 0; i < 4; ++i) {
            const int idx = tid + i * NTHR, kb = idx >> 3, sch = idx & 7; const int pos = 128 * (n - 1) + kb;
            v4u kreg = (v4u){0u, 0u, 0u, 0u}, vreg = (v4u){0u, 0u, 0u, 0u};
            if (pos >= 0) { const bf16* p = proj + (rowbase + pos) * NPROJ + 64 * kvh + 8 * sch; kreg = *(const v4u*)(p + C_KA); vreg = *(const v4u*)(p + C_VA); }
            *(LAS v4u*)(Kb + kb * KP + 8 * sch) = kreg;
            const unsigned short* vs = (const unsigned short*)&vreg;
#pragma unroll
            for (int j = 0; j < 8; ++j) Vb[(8 * sch + j) * VPS + kb] = vs[j];
        }
    }
    __syncthreads();
    const int g = wave & 3, qh = wave >> 2, head = kvh * 4 + g;
    const LAS float* btg = bt + g * 128;
    for (int sb = 0; sb < 2; ++sb) {
        const int qrel0 = 64 * qh + 32 * sb, qrel = qrel0 + r32;
        const size_t row = rowbase + 128 * n + qrel;
        bf16x8 qf[4];
        { const bf16* qp = proj + row * NPROJ + C_QA + 64 * head + 8 * hi;
#pragma unroll
          for (int ks = 0; ks < 4; ++ks) qf[ks] = *(const bf16x8*)(qp + 16 * ks); }
        FlashState st; st.m = sinks[head]; st.l = (hi == 0) ? 1.0f : 0.0f;
#pragma unroll
        for (int r = 0; r < 16; ++r) { st.o[0][r] = 0.f; st.o[1][r] = 0.f; }
        const int t_lo = (qrel0 + 1) >> 6, t_hi = (qrel0 + 159) >> 6;
        for (int t = t_lo; t <= t_hi; ++t) {
            f32x16 s0, s1; flash_qk(s0, s1, qf, Kb + t * 64 * KP, r32, hi);
#pragma unroll
            for (int r = 0; r < 16; ++r) {
                const int kb0 = 64 * t + crow(r, hi), kb1 = kb0 + 32;
                const int d0 = 128 + qrel - kb0, d1 = d0 - 32;
                const bool v0 = (d0 >= 0) && (d0 < 128) && (n > 0 || kb0 >= 128);
                const bool v1 = (d1 >= 0) && (d1 < 128) && (n > 0 || kb1 >= 128);
                const float b0 = btg[d0 & 127], b1 = btg[d1 & 127];
                s0[r] = v0 ? (s0[r] * 0.125f + b0) : -INFINITY;
                s1[r] = v1 ? (s1[r] * 0.125f + b1) : -INFINITY;
            }
            flash_tail(st, s0, s1, Vb + 64 * t, VPS, r32, hi);
        }
        flash_store(st, OA + row * 512 + 64 * head, hi);
    }
    __syncthreads();
}
__device__ __forceinline__ void p3_attention(Frame& F) {
    for (int item = F.vcu; item < 256; item += F.G) {
        swa_unit(F, item >> 6, (item >> 5) & 1, item & 31);
        const int bh = item >> 3, j = item & 7;
        float kmax2 = -1.0f;
        fox_unit(F, bh >> 3, bh & 7, j, kmax2);
    }
}

struct PairOrder {
    pg8::StaticOrder S;
    __device__ bool next(int i, pg8::Unit& u) const { if (!S.next(i >> 1, u)) return false; u.src = i & 1; return true; }
    __device__ __forceinline__ void a_ready(const pg8::Unit&) const {}
    __device__ __forceinline__ void done(const pg8::Unit&) const {}
};
__device__ __forceinline__ float sigmoidf_(float z) { return 1.0f / (1.0f + __expf(-z)); }
struct EpiGate {
    static constexpr bool PERM = true, AFTER_DRAIN = false, CHAIN = true;
    const bf16* proj; bf16* mixed;
    __device__ __forceinline__ void operator()(pg8::f32x4 (&acc)[2][2][4][2], const pg8::Unit& u, int wr, int wc, int fr, int fq) const {
#pragma unroll
        for (int ai = 0; ai < 2; ++ai) {
            v4u gbv[4][2], gav[4][2];
#pragma unroll
            for (int m = 0; m < 4; ++m) { const size_t row = (size_t)u.pm * 256 + ai * 128 + wr * 64 + m * 16 + fr;
#pragma unroll
                for (int bj = 0; bj < 2; ++bj) { const int col0 = u.pn * 256 + bj * 128 + wc * 32 + 8 * fq;
                    gbv[m][bj] = *(const v4u*)(proj + row * NPROJ + C_GLB + col0);
                    if (u.src == 0) gav[m][bj] = __builtin_nontemporal_load((const v4u*)(proj + row * NPROJ + C_GLA + col0)); } }
#pragma unroll
            for (int m = 0; m < 4; ++m) { const size_t row = (size_t)u.pm * 256 + ai * 128 + wr * 64 + m * 16 + fr;
#pragma unroll
                for (int bj = 0; bj < 2; ++bj) { const int col0 = u.pn * 256 + bj * 128 + wc * 32 + 8 * fq;
                    const unsigned gbw[4] = {gbv[m][bj].x, gbv[m][bj].y, gbv[m][bj].z, gbv[m][bj].w};
                    if (u.src == 0) {
                        const unsigned gaw[4] = {gav[m][bj].x, gav[m][bj].y, gav[m][bj].z, gav[m][bj].w};
#pragma unroll
                        for (int e = 0; e < 8; ++e) { const float za = (e & 1) ? bfhi(gaw[e >> 1]) : bflo(gaw[e >> 1]), zb = (e & 1) ? bfhi(gbw[e >> 1]) : bflo(gbw[e >> 1]);
                            const float ratio = (1.0f + __expf(-zb)) * __builtin_amdgcn_rcpf(1.0f + __expf(-za));
                            acc[ai][bj][m][e >> 2][e & 3] *= ratio; }
                    } else {
                        float v[8];
#pragma unroll
                        for (int e = 0; e < 8; ++e) { const float zb = (e & 1) ? bfhi(gbw[e >> 1]) : bflo(gbw[e >> 1]); v[e] = acc[ai][bj][m][e >> 2][e & 3] * __builtin_amdgcn_rcpf(1.0f + __expf(-zb)); }
                        v4u w; w.x = cvtpk(v[0], v[1]); w.y = cvtpk(v[2], v[3]); w.z = cvtpk(v[4], v[5]); w.w = cvtpk(v[6], v[7]);
                        *(v4u*)(mixed + row * D + col0) = w;
                    }
                }
            }
        }
    }
};
struct EpiRes {
    static constexpr bool PERM = true, AFTER_DRAIN = false, CHAIN = false;
    const float* x; const float* mod; bf16* x1;
    __device__ __forceinline__ void operator()(const pg8::f32x4 (&acc)[2][2][4][2], const pg8::Unit& u, int wr, int wc, int fr, int fq) const {
        const int b = (u.pm * 256) >> 12;
        pg8::f32x4 gt[2][2];
#pragma unroll
        for (int bj = 0; bj < 2; ++bj)
#pragma unroll
            for (int n = 0; n < 2; ++n) gt[bj][n] = *(const pg8::f32x4*)(mod + b * NMOD + 2048 + u.pn * 256 + bj * 128 + wc * 32 + 8 * fq + 4 * n);
#pragma unroll
        for (int ai = 0; ai < 2; ++ai) {
            pg8::f32x4 xin[4][2][2];
#pragma unroll
            for (int m = 0; m < 4; ++m) { const size_t row = (size_t)u.pm * 256 + ai * 128 + wr * 64 + m * 16 + fr;
#pragma unroll
                for (int bj = 0; bj < 2; ++bj)
#pragma unroll
                    for (int n = 0; n < 2; ++n) xin[m][bj][n] = __builtin_nontemporal_load((const pg8::f32x4*)(x + row * D + u.pn * 256 + bj * 128 + wc * 32 + 8 * fq + 4 * n)); }
#pragma unroll
            for (int m = 0; m < 4; ++m) { const size_t row = (size_t)u.pm * 256 + ai * 128 + wr * 64 + m * 16 + fr;
#pragma unroll
                for (int bj = 0; bj < 2; ++bj) { const pg8::f32x4 v0 = xin[m][bj][0] + gt[bj][0] * acc[ai][bj][m][0], v1 = xin[m][bj][1] + gt[bj][1] * acc[ai][bj][m][1];
                    v4u w; w.x = cvtpk(v0.x, v0.y); w.y = cvtpk(v0.z, v0.w); w.z = cvtpk(v1.x, v1.y); w.w = cvtpk(v1.z, v1.w);
                    *(v4u*)(x1 + row * D + u.pn * 256 + bj * 128 + wc * 32 + 8 * fq) = w; } }
        }
    }
};

__device__ __forceinline__ void p6_norm2(Frame& F) {
    const bf16* x1 = (const bf16*)(((unsigned char*)karg(19)) + WS_X1); const float* g2 = ((const float*)karg(3)); const float* MOD = (const float*)(((unsigned char*)karg(19)) + WS_MOD); bf16* H2 = (bf16*)(((unsigned char*)karg(19)) + WS_H2); unsigned char* H2Q = (unsigned char*)(((unsigned char*)karg(19)) + WS_H2Q); float* H2S = (float*)(((unsigned char*)karg(19)) + WS_H2S);
    const int gw = F.vcu * NWAVES + F.wave, NGW = F.G * NWAVES;
    for (int c = gw; c < M / 8; c += NGW) {
        const int row0 = c * 8; const float* mb = MOD + (row0 >> 12) * NMOD;
        f32x4 ga[4], sh[4];
#pragma unroll
        for (int j = 0; j < 4; ++j) { const int col = 4 * F.lane + 256 * j; const f32x4 g = *(const f32x4*)(g2 + col), sc = *(const f32x4*)(mb + 4096 + col); sh[j] = *(const f32x4*)(mb + 3072 + col); ga[j] = g * (sc + 1.0f); }
        u32x2 r0[4], r1[4], r2[4];
        { const u32x2* xr = (const u32x2*)(x1 + (size_t)row0 * D) + F.lane;
#pragma unroll
          for (int j = 0; j < 4; ++j) r0[j] = xr[64 * j];
#pragma unroll
          for (int j = 0; j < 4; ++j) r1[j] = xr[256 + 64 * j]; }
#pragma unroll
        for (int i = 0; i < 8; ++i) {
            const int row = row0 + i;
            if (i + 2 < 8) { const u32x2* xr = (const u32x2*)(x1 + (size_t)(row + 2) * D) + F.lane;
#pragma unroll
                for (int j = 0; j < 4; ++j) r2[j] = xr[64 * j]; }
            f32x4 hq[4], xv[4]; float ss = 0.f;
#pragma unroll
            for (int j = 0; j < 4; ++j) { xv[j].x = bflo(r0[j].x); xv[j].y = bfhi(r0[j].x); xv[j].z = bflo(r0[j].y); xv[j].w = bfhi(r0[j].y);
                ss += (xv[j].x * xv[j].x + xv[j].y * xv[j].y) + (xv[j].z * xv[j].z + xv[j].w * xv[j].w); }
            ss = wave_sum(ss);
            const float rstd = 1.0f / sqrtf(ss * (1.0f / D) + EPS);
#pragma unroll
            for (int j = 0; j < 4; ++j) { const int col = 4 * F.lane + 256 * j;
                const f32x4 hv = (xv[j] * rstd) * ga[j] + sh[j];
                u32x2 w; w.x = cvtpk(hv.x, hv.y); w.y = cvtpk(hv.z, hv.w);
                *(u32x2*)(H2 + (size_t)row * D + col) = w; hq[j] = hv; }
            float am = 0.f;
#pragma unroll
            for (int j = 0; j < 4; ++j) am = fmaxf(fmaxf(am, fmaxf(fabsf(hq[j].x), fabsf(hq[j].y))), fmaxf(fabsf(hq[j].z), fabsf(hq[j].w)));
            am = wave_max(am);
            const float sc = am > 0.f ? am * (1.0f / 127.0f) : 1.0f, inv = 1.0f / sc;
            v4u qa;
#pragma unroll
            for (int j = 0; j < 4; ++j) { const int b0 = (int)rintf(hq[j].x * inv), b1 = (int)rintf(hq[j].y * inv), b2 = (int)rintf(hq[j].z * inv), b3 = (int)rintf(hq[j].w * inv);
                qa[j] = (unsigned)(b0 & 255) | ((unsigned)(b1 & 255) << 8) | ((unsigned)(b2 & 255) << 16) | ((unsigned)(b3 & 255) << 24); }
            __builtin_nontemporal_store(qa, (v4u*)(H2Q + (size_t)row * D + 16 * F.lane));
            if (F.lane == 0) H2S[row] = sc;
#pragma unroll
            for (int j = 0; j < 4; ++j) { r0[j] = r1[j]; r1[j] = r2[j]; }
        }
    }
}

__device__ __forceinline__ unsigned f2ord(float f) { const unsigned u = __float_as_uint(f); return u ^ ((unsigned)((int)u >> 31) | 0x80000000u); }
__device__ __forceinline__ float ord2f(unsigned o) { const unsigned u = (o & 0x80000000u) ? (o & 0x7fffffffu) : ~o; return __uint_as_float(u); }
#define CE_DESC(a, b) do { const unsigned _x = (a), _y = (b); (a) = _x > _y ? _x : _y; (b) = _x > _y ? _y : _x; } while (0)
__device__ __forceinline__ void sort16(unsigned (&k)[16]) {
#pragma unroll
    for (int size = 2; size <= 16; size <<= 1)
#pragma unroll
        for (int stride = size >> 1; stride > 0; stride >>= 1)
#pragma unroll
            for (int i = 0; i < 16; ++i) { const int j = i ^ stride; if (j > i) { if ((i & size) == 0) CE_DESC(k[i], k[j]); else CE_DESC(k[j], k[i]); } }
}
__device__ __forceinline__ void merge16(unsigned (&a)[16], const unsigned (&b)[16]) {
#pragma unroll
    for (int i = 0; i < 16; ++i) a[i] = a[i] > b[15 - i] ? a[i] : b[15 - i];
#pragma unroll
    for (int stride = 8; stride > 0; stride >>= 1)
#pragma unroll
        for (int i = 0; i < 16; ++i) { const int j = i ^ stride; if (j > i) CE_DESC(a[i], a[j]); }
}
__device__ __forceinline__ void top16_of_64(unsigned (&g0)[16], unsigned (&g1)[16], unsigned (&g2)[16], unsigned (&g3)[16]) {
    sort16(g0); sort16(g1); sort16(g2); sort16(g3);
    merge16(g0, g1); merge16(g2, g3); merge16(g0, g2);
}
constexpr int NCAND = 50;
__device__ __forceinline__ void p8a_topk(Frame& F) {
    const bf16* QP = (const bf16*)(((unsigned char*)karg(19)) + WS_QP); const bf16* SUBK = (const bf16*)(((unsigned char*)karg(19)) + WS_SUBK);
    unsigned short* PIDX = (unsigned short*)(((unsigned char*)karg(19)) + WS_PIDX); float* PG = (float*)(((unsigned char*)karg(19)) + WS_PG);
    LAS unsigned short* Elds = (LAS unsigned short*)(F.lds) + F.wave * (NCAND * 64);
    const int lane = F.lane, r32 = lane & 31, hi = lane >> 5;
    const int gw = F.vcu * NWAVES + F.wave, NGW = F.G * NWAVES;
    for (int it2 = 0; it2 < 2 * ((M / 64 - F.vcu + F.G - 1) / F.G); ++it2) {
        const int wi = F.vcu + (it2 >> 1) * F.G;
        const int tile = 2 * wi + (it2 & 1);
        const int tok = tile * 32 + r32;
        { const int h = F.wave;
            unsigned top[2][16];
#pragma unroll
            for (int p = 0; p < 2; ++p) {
                bf16x8 qf[4];
                { const bf16* qp = QP + (size_t)tok * D + h * 128 + p * 64 + 8 * hi;
#pragma unroll
                  for (int ks = 0; ks < 4; ++ks) qf[ks] = *(const bf16x8*)(qp + 16 * ks); }
                const bf16* kp = SUBK + (size_t)((h * 2 + p) * 128 + r32) * 64 + 8 * hi;
                unsigned kk[4][16];
#pragma unroll
                for (int blk = 0; blk < 4; ++blk) {
                    f32x16 acc;
#pragma unroll
                    for (int r = 0; r < 16; ++r) acc[r] = 0.f;
#pragma unroll
                    for (int ks = 0; ks < 4; ++ks) { const bf16x8 a = *(const bf16x8*)(kp + (size_t)blk * 32 * 64 + 16 * ks); acc = MFMA32(a, qf[ks], acc); }
#pragma unroll
                    for (int r = 0; r < 16; ++r) { const int key = 32 * blk + crow(r, hi); kk[blk][r] = (f2ord(acc[r]) & ~127u) | (unsigned)(127 - key); }
                }
                top16_of_64(kk[0], kk[1], kk[2], kk[3]);
                unsigned other[16];
#pragma unroll
                for (int i = 0; i < 16; ++i) other[i] = xorx<32>(kk[0][i], lane);
                merge16(kk[0], other);
#pragma unroll
                for (int i = 0; i < 16; ++i) top[p][i] = kk[0][i];
            }
            float s1[16], s2[16]; unsigned i1[16], i2[16];
#pragma unroll
            for (int i = 0; i < 16; ++i) { s1[i] = ord2f(top[0][i] & ~127u); i1[i] = 127u - (top[0][i] & 127u); s2[i] = ord2f(top[1][i] & ~127u); i2[i] = 127u - (top[1][i] & 127u); }
            unsigned ck[4][16];
#pragma unroll
            for (int c = 0; c < 64; ++c) {
                if (c < NCAND) { constexpr int CA[NCAND] = {0,0,0,0,0,0,0,0,0,0,0,0,0,0,0,0,1,1,1,1,1,1,1,1,2,2,2,2,2,3,3,3,3,4,4,4,5,5,6,6,7,7,8,9,10,11,12,13,14,15}; constexpr int CB[NCAND] = {0,1,2,3,4,5,6,7,8,9,10,11,12,13,14,15,0,1,2,3,4,5,6,7,0,1,2,3,4,0,1,2,3,0,1,2,0,1,0,1,0,1,0,0,0,0,0,0,0,0}; const int a = CA[c], b = CB[c];
                    ck[c >> 4][c & 15] = (f2ord(s1[a] + s2[b]) & ~63u) | (unsigned)(63 - c);
                    Elds[c * 64 + lane] = (unsigned short)(i1[a] * 128u + i2[b]); }
                else ck[c >> 4][c & 15] = 0u;
            }
            top16_of_64(ck[0], ck[1], ck[2], ck[3]);
            float w[16]; float wsum = 0.f; const float v0 = ord2f(ck[0][0] & ~63u);
#pragma unroll
            for (int r = 0; r < 16; ++r) { w[r] = __expf(ord2f(ck[0][r] & ~63u) - v0); wsum += w[r]; }
            const float winv = 1.0f / wsum;
#pragma unroll
            for (int r = 0; r < 16; ++r) if ((r >> 3) == hi) {
                const int c = 63 - (int)(ck[0][r] & 63u);
                const unsigned short eid = Elds[c * 64 + lane];
                PIDX[(size_t)tok * 128 + h * 16 + r] = eid; PG[(size_t)tok * 128 + h * 16 + r] = w[r] * winv; }
        }
    }
}

__device__ __forceinline__ float gelu_erf(float v) { return 0.5f * v * (1.0f + erff(v * 0.70710678118654752f)); }

#define PROBE_REPA 1
#define PROBE_REPB 1
constexpr int NR = 8, RSH = 18, BSA = 8, BSB = 8, ELP = 136, TPS = 8; static_assert(BSA == 8 && BSB == 8, "whole batches of 8");
__device__ __forceinline__ void sort128(unsigned& e0, unsigned& e1, int lane) {
#pragma unroll
    for (int size = 2; size <= 128; size <<= 1) {
#pragma unroll
        for (int stride = size >> 1; stride > 0; stride >>= 1) {
            if (stride == 64) { const unsigned lo = e0 < e1 ? e0 : e1, hi = e0 < e1 ? e1 : e0; e0 = lo; e1 = hi; }
            else {
                const bool lower = (lane & stride) == 0;
                const bool asc0 = (size == 128) ? true : (size == 64 ? true : ((lane & size) == 0));
                const bool asc1 = (size == 128) ? true : (size == 64 ? false : ((lane & size) == 0));
                const unsigned p0 = xorx_sw(e0, lane, stride), p1 = xorx_sw(e1, lane, stride);
                const unsigned mn0 = e0 < p0 ? e0 : p0, mx0 = e0 < p0 ? p0 : e0, mn1 = e1 < p1 ? e1 : p1, mx1 = e1 < p1 ? p1 : e1;
                e0 = (lower == asc0) ? mn0 : mx0; e1 = (lower == asc1) ? mn1 : mx1;
            }
        }
    }
}
template <int BS> __device__ __forceinline__ void sw_issue(v4u (&buf)[BS], const LAS unsigned* el, const unsigned char* tab, unsigned voff) {
#pragma unroll
    for (int i = 0; i < BS; ++i) { const unsigned off = (el[i] << 10) + voff;
        buf[i] = *(const v4u*)(tab + off); }
}
template <int BS> __device__ __forceinline__ void sw_proc_a(const v4u (&buf)[BS], const v4u& hq, LAS float* wl, int s, int n, int lane) {
    const int hx = (int)hq.x, hy = (int)hq.y, hz = (int)hq.z, hw = (int)hq.w;
    float dd[8];
#pragma unroll
    for (int i = 0; i < 8; ++i) dd[i] = 0.f;
#pragma unroll
    for (int i = 0; i < BS; ++i) { const int dx = (int)buf[i].x, dy = (int)buf[i].y, dz = (int)buf[i].z, dw = (int)buf[i].w;
        int t = __builtin_amdgcn_sdot4(hx, dx, 0, false); t = __builtin_amdgcn_sdot4(hy, dy, t, false); t = __builtin_amdgcn_sdot4(hz, dz, t, false); t = __builtin_amdgcn_sdot4(hw, dw, t, false);
        dd[i] = (float)t; }
    const float r1 = reduce8_t(dd, lane);
    if ((lane & 7) == 0) wl[s + (lane >> 3)] = r1;
}
typedef _Float16 h2_t __attribute__((ext_vector_type(2)));
#define CVT_H2_FP8(u, hi) __builtin_bit_cast(h2_t, __builtin_amdgcn_cvt_scalef32_pk_f16_fp8((u), 1.0f, (hi)))
template <int BS> __device__ __forceinline__ void sw_proc_b(const v4u (&buf)[BS], h2_t (&acc)[8], const LAS float* wl, int s, int n) {
    float wr[BS];
#pragma unroll
    for (int i = 0; i < BS; ++i) wr[i] = wl[s + i];
#pragma unroll
    for (int i = 0; i < BS; ++i) {
        const h2_t wv = __builtin_bit_cast(h2_t, wr[i]);
        const unsigned ux = buf[i].x, uy = buf[i].y, uz = buf[i].z, uw = buf[i].w;
        acc[0] = __builtin_elementwise_fma(CVT_H2_FP8(ux, false), wv, acc[0]); acc[1] = __builtin_elementwise_fma(CVT_H2_FP8(ux, true), wv, acc[1]);
        acc[2] = __builtin_elementwise_fma(CVT_H2_FP8(uy, false), wv, acc[2]); acc[3] = __builtin_elementwise_fma(CVT_H2_FP8(uy, true), wv, acc[3]);
        acc[4] = __builtin_elementwise_fma(CVT_H2_FP8(uz, false), wv, acc[4]); acc[5] = __builtin_elementwise_fma(CVT_H2_FP8(uz, true), wv, acc[5]);
        acc[6] = __builtin_elementwise_fma(CVT_H2_FP8(uw, false), wv, acc[6]); acc[7] = __builtin_elementwise_fma(CVT_H2_FP8(uw, true), wv, acc[7]); }
}
__device__ __forceinline__ void sw_warm(v4u (&pf)[4], const unsigned char* tab, int range, int lw, unsigned voff) {
#pragma unroll
    for (int i = 0; i < 4; ++i) { const unsigned off = ((unsigned)(range * 1024 + lw * 4 + i) << 10) + voff; pf[i] = *(const v4u*)(tab + off); }
}
__device__ __forceinline__ void sw_warm_done(const v4u (&pf)[4]) {
#pragma unroll
    for (int i = 0; i < 4; ++i) asm volatile("" :: "v"(pf[i]));
}
template <int FAKE> __device__ __forceinline__ void p8b_sweep(Frame& F) {
    const bf16* X1 = (const bf16*)(((unsigned char*)karg(19)) + WS_X1); const float* MOD = (const float*)(((unsigned char*)karg(19)) + WS_MOD);
    const unsigned char* H2Q = (const unsigned char*)(((unsigned char*)karg(19)) + WS_H2Q); const float* H2S = (const float*)(((unsigned char*)karg(19)) + WS_H2S);
    const unsigned char* EDq = (const unsigned char*)(((unsigned char*)karg(19)) + WS_ED); const unsigned char* EUq = (const unsigned char*)(((unsigned char*)karg(19)) + WS_EU); const float* EDS = (const float*)(((unsigned char*)karg(19)) + WS_EDS);
    const unsigned short* PIDX = (const unsigned short*)(((unsigned char*)karg(19)) + WS_PIDX); const float* PG = (const float*)(((unsigned char*)karg(19)) + WS_PG);
    const float* fg = ((const float*)karg(17));
    const int gw = F.vcu * NWAVES + F.wave, NGW = F.G * NWAVES;
    for (int wi = F.vcu; wi < M / 64; wi += F.G) {
        const int tb = wi * 8 + F.wave;
        unsigned ones = ~0u; asm volatile("" : "+s"(ones));
        int lane = (int)__builtin_amdgcn_mbcnt_hi(ones, __builtin_amdgcn_mbcnt_lo(ones, 0u)); asm volatile("" : "+v"(lane));
        const int tok0 = tb * 8;
        unsigned E0[8], E1[8];
        LAS float* Wl = (LAS float*)(F.lds) + F.wave * 1024;
        LAS unsigned* El = (LAS unsigned*)(F.lds + 32768) + F.wave * (8 * ELP);
        unsigned voff = 16u * (unsigned)lane; asm volatile("" : "+v"(voff));
        LAS int* Bnd = (LAS int*)(F.lds + 67584) + F.wave * (8 * (NR + 1));
#pragma unroll
        for (int k = 0; k < 8; ++k) {
            const size_t base = (size_t)(tok0 + k) * 128;
            E0[k] = ((unsigned)PIDX[base + lane] << 7) | (unsigned)lane; E1[k] = ((unsigned)PIDX[base + 64 + lane] << 7) | (unsigned)(64 + lane);
            sort128(E0[k], E1[k], lane);
            if (FAKE) { E0[k] = (E0[k] & 0x1ffffu) ; E1[k] = (E1[k] & 0x1ffffu); sort128(E0[k], E1[k], lane); }
            El[k * ELP + lane] = E0[k] >> 7; El[k * ELP + 64 + lane] = E1[k] >> 7;
            if (lane < 8) El[k * ELP + 128 + lane] = (unsigned)__builtin_amdgcn_readlane((int)E1[k], 63) >> 7;
        }
        for (int repa = 0; repa < PROBE_REPA; ++repa) {
            v4u hq[8];
#pragma unroll
            for (int k = 0; k < 8; ++k) hq[k] = *(const v4u*)(H2Q + (size_t)(tok0 + k) * D + 16 * lane);
            int pos[8];
#pragma unroll
            for (int k = 0; k < 8; ++k) pos[k] = 0;
            v4u bA[BSA], bB[BSA], bC[BSA]; int ps = 0, pn = 0;
            for (int r = 0; r < NR; ++r) {
#pragma unroll
                for (int k = 0; k < 8; ++k) {
                    constexpr int dummy = 0; (void)dummy;
                    const int kp = (k + 7) & 7;
                    const unsigned long long BM = 0x0101010101010101ull;
                    const int c = __builtin_popcountll(__ballot((E0[k] >> RSH) == (unsigned)r) & BM) + __builtin_popcountll(__ballot((E1[k] >> RSH) == (unsigned)r) & BM);
                    int s = __builtin_amdgcn_readfirstlane(pos[k]); const int e_end = __builtin_amdgcn_readfirstlane(s + 8 * c); pos[k] = e_end;
                    if (lane == 0) Bnd[k * (NR + 1) + r + 1] = e_end;
                    const int n1 = (e_end - s) < BSA ? (e_end - s) : BSA;
                    if (k & 1) sw_issue<BSA>(bB, El + k * ELP + s, EDq, voff); else sw_issue<BSA>(bA, El + k * ELP + s, EDq, voff);
                    if (pn > 0) { if (k & 1) sw_proc_a<BSA>(bA, hq[kp], Wl + kp * 128, ps, pn, lane); else sw_proc_a<BSA>(bB, hq[kp], Wl + kp * 128, ps, pn, lane); }
                    ps = s; pn = n1; s += n1;
#define SWA_REST(Y) if (s < e_end) { sw_issue<BSA>(Y, El + k * ELP + s, EDq, voff); \
                        for (;;) { int n = (e_end - s) < BSA ? (e_end - s) : BSA; \
                            if (s + BSA < e_end) { sw_issue<BSA>(bC, El + k * ELP + s + BSA, EDq, voff); sw_proc_a<BSA>(Y, hq[k], Wl + k * 128, s, n, lane); } else { sw_proc_a<BSA>(Y, hq[k], Wl + k * 128, s, n, lane); break; } \
                            s += BSA; n = (e_end - s) < BSA ? (e_end - s) : BSA; \
                            if (s + BSA < e_end) { sw_issue<BSA>(Y, El + k * ELP + s + BSA, EDq, voff); sw_proc_a<BSA>(bC, hq[k], Wl + k * 128, s, n, lane); } else { sw_proc_a<BSA>(bC, hq[k], Wl + k * 128, s, n, lane); break; } \
                            s += BSA; } }
                    if (k & 1) { SWA_REST(bA) } else { SWA_REST(bB) }
#undef SWA_REST
                }
            }
            if (pn > 0) sw_proc_a<BSA>(bB, hq[7], Wl + 7 * 128, ps, pn, lane);
        }
#pragma unroll
        for (int k = 0; k < 8; ++k) { int tk = tok0 + k; asm volatile("" : "+s"(tk)); const size_t base = (size_t)tk * 128; const float sh = H2S[tk];
            const float r0 = Wl[k * 128 + lane], r1 = Wl[k * 128 + 64 + lane];
            const _Float16 w0 = (_Float16)(PG[base + (E0[k] & 127u)] * gelu_erf(r0 * sh * EDS[E0[k] >> 7])), w1 = (_Float16)(PG[base + (E1[k] & 127u)] * gelu_erf(r1 * sh * EDS[E1[k] >> 7]));
            Wl[k * 128 + lane] = __builtin_bit_cast(float, (h2_t){w0, w0}); Wl[k * 128 + 64 + lane] = __builtin_bit_cast(float, (h2_t){w1, w1}); }
        int ln = lane; asm volatile("" : "+v"(ln));
#pragma unroll
        for (int sub = 0; sub < 8 / TPS; ++sub) {
        h2_t acc[TPS][8];
        for (int repb = 0; repb < PROBE_REPB; ++repb) {
#pragma unroll
            for (int kk = 0; kk < TPS; ++kk)
#pragma unroll
                for (int i = 0; i < 8; ++i) acc[kk][i] = (h2_t){(_Float16)0.f, (_Float16)0.f};
            int pos[TPS];
#pragma unroll
            for (int kk = 0; kk < TPS; ++kk) pos[kk] = 0;
            v4u bA[BSB], bB[BSB]; int ps = 0, pn = 0;
            for (int r = 0; r < NR; ++r) {
#pragma unroll
                for (int kk = 0; kk < TPS; ++kk) {
                    const int k = sub * TPS + kk, kkp = (kk + TPS - 1) % TPS, kp = sub * TPS + kkp;
                    int s = __builtin_amdgcn_readfirstlane(pos[kk]); const int e_end = __builtin_amdgcn_readfirstlane(Bnd[k * (NR + 1) + r + 1]); pos[kk] = e_end;
                    const int n1 = (e_end - s) < BSB ? (e_end - s) : BSB;
                    if (kk & 1) sw_issue<BSB>(bB, El + k * ELP + s, EUq, voff); else sw_issue<BSB>(bA, El + k * ELP + s, EUq, voff);
                    if (pn > 0) { if (kk & 1) sw_proc_b<BSB>(bA, acc[kkp], Wl + kp * 128, ps, pn); else sw_proc_b<BSB>(bB, acc[kkp], Wl + kp * 128, ps, pn); }
                    ps = s; pn = n1; s += n1;
                    for (; s < e_end; s += BSB) {
                        const int n = (e_end - s) < BSB ? (e_end - s) : BSB;
                        if (kk & 1) { sw_issue<BSB>(bA, El + k * ELP + s, EUq, voff); sw_proc_b<BSB>(bA, acc[kk], Wl + k * 128, s, n); }
                        else        { sw_issue<BSB>(bB, El + k * ELP + s, EUq, voff); sw_proc_b<BSB>(bB, acc[kk], Wl + k * 128, s, n); }
                    }
                }
            }
            if (pn > 0) sw_proc_b<BSB>(bB, acc[TPS - 1], Wl + (sub * TPS + TPS - 1) * 128, ps, pn);
        }
        {
            asm volatile("" : "+v"(ln));
            float* outp = (float*)karg(18);
            const float* gt2 = MOD + ((tok0 + sub * TPS) >> 12) * NMOD + 5120;
            f32x4 gtv[4]; u32x2 xcur[4], xnxt[4];
#pragma unroll
            for (int j = 0; j < 4; ++j) { const int col = 4 * ln + 256 * j; gtv[j] = *(const f32x4*)(gt2 + col); xcur[j] = *(const u32x2*)(X1 + (size_t)(tok0 + sub * TPS) * D + col); }
#pragma unroll
            for (int kk = 0; kk < TPS; ++kk) {
                const int tok = tok0 + sub * TPS + kk;
                if (kk + 1 < TPS) {
#pragma unroll
                    for (int j = 0; j < 4; ++j) xnxt[j] = __builtin_nontemporal_load((const u32x2*)(X1 + (size_t)(tok + 1) * D + 4 * ln + 256 * j));
                }
                f32x4 x2[4]; float ss = 0.f;
#pragma unroll
                for (int j = 0; j < 4; ++j) {
#pragma unroll
                    for (int i = 0; i < 4; ++i) { const unsigned xw = (i >> 1) ? xcur[j].y : xcur[j].x; const float xf = (i & 1) ? bfhi(xw) : bflo(xw);
                        const float v = xf + gtv[j][i] * (0.0625f * (float)acc[kk][2 * j + (i >> 1)][i & 1]); x2[j][i] = v; ss += v * v; } }
                ss = wave_sum_x(ss, ln);
                if (!(FAKE && ss != 12345.678f)) {
                    const float rstd = 1.0f / sqrtf(ss * (1.0f / D) + EPS);
                    f32x4 fgv[4];
#pragma unroll
                    for (int j = 0; j < 4; ++j) fgv[j] = *(const f32x4*)(fg + 4 * ln + 256 * j);
#pragma unroll
                    for (int j = 0; j < 4; ++j) __builtin_nontemporal_store(x2[j] * rstd * fgv[j], (f32x4*)(outp + (size_t)tok * D + 4 * ln + 256 * j));
                }
#pragma unroll
                for (int j = 0; j < 4; ++j) xcur[j] = xnxt[j];
            }
        }
        }
    }
}

struct Args { const float* in[18]; float* out; unsigned char* ws; };
__global__ void __launch_bounds__(NTHR, 2) mega_fwd(Args args) {
    extern __shared__ __attribute__((aligned(16))) unsigned char lds[];
    Frame F;
    F.lds = (LAS unsigned char*)lds;
    F.wave = __builtin_amdgcn_readfirstlane((int)threadIdx.x >> 6); F.lane = lane_fresh(); F.tid = F.wave * 64 + F.lane;
    F.G = gridDim.x; { const int bx = blockIdx.x; F.vcu = (F.G % 8 == 0) ? (bx % 8) * (F.G / 8) + bx / 8 : bx; }
    volatile LAS unsigned* MISC = (volatile LAS unsigned*)(F.lds + MISC_OFF);
    for (int u = F.tid; u < (LDS_BYTES - LDSCTL_OFF) / 4; u += NTHR) ((LAS unsigned*)(F.lds + LDSCTL_OFF))[u] = 0u;
    __syncthreads();
    gu32* ctl = (gu32*)(((unsigned char*)karg(19)) + WS_CTL);
    XcdBarrier bar = xcd_barrier_post((unsigned*)(ctl + CW_BAR), MISC + 8, F.wave);
#define GRID_BAR() xcd_barrier(bar)
#define PROBE_TS -1
#define STAMP(i) do { if (PROBE_TS >= 0 && blockIdx.x == 0 && F.tid == 0) { const unsigned long long t_ = __builtin_amdgcn_s_memrealtime(); MISC[16 + 2 * (i)] = (unsigned)t_; MISC[17 + 2 * (i)] = (unsigned)(t_ >> 32); } } while (0)
#define PROBE_DBL -1

    STAMP(0);
    F.lane = lane_fresh(); F.tid = F.wave * 64 + F.lane;
    p0_prologue(F); GRID_BAR(); STAMP(1);
    if (PROBE_DBL == 0) { p0_prologue(F); GRID_BAR(); }
    F.lane = lane_fresh(); F.tid = F.wave * 64 + F.lane;
    p1_norm(F); p0_transposes(F); GRID_BAR(); STAMP(2);
    if (PROBE_DBL == 1) { p1_norm(F); GRID_BAR(); }
    {
    {
        pg8::Gemm g{(const pg8::bf16_t*)(((unsigned char*)karg(19)) + WS_H), (const pg8::bf16_t*)(((unsigned char*)karg(19)) + WS_WIN), M, NPROJ, D, nullptr, nullptr};
        pg8::StaticOrder S; S.init(M, NPROJ, F.G, (int)blockIdx.x);
        pg8::EpiBf16<0> E{(pg8::bf16_t*)(((unsigned char*)karg(19)) + WS_PROJ), NPROJ, nullptr, 0, 0, 1.f};
        pg8::gemm_phase<pg8::EpiBf16<0>, pg8::StaticOrder, true, true>(F.lds + RING_OFF, g, S, E, F.wave);
        const int nwg = (M / 256) * (NPROJ / 256), busy = nwg % F.G;
        if (busy == 0) p0_quant_tables(F, F.vcu * NWAVES + F.wave, F.G * NWAVES);
        else if ((int)blockIdx.x >= busy) p0_quant_tables(F, ((int)blockIdx.x - busy) * NWAVES + F.wave, (F.G - busy) * NWAVES);
    }
    GRID_BAR(); STAMP(3);
    }
    p3_attention(F); GRID_BAR(); STAMP(4);
    if (PROBE_DBL == 3) { p3_attention(F); GRID_BAR(); }
    {
    {
        pg8::Gemm g{(const pg8::bf16_t*)(((unsigned char*)karg(19)) + WS_OA), (const pg8::bf16_t*)(((unsigned char*)karg(19)) + WS_WA), M, D, 512, (const pg8::bf16_t*)(((unsigned char*)karg(19)) + WS_OB), (const pg8::bf16_t*)(((unsigned char*)karg(19)) + WS_WB)};
        PairOrder S; S.S.init(M, D, F.G, (int)blockIdx.x);
        EpiGate E{(const bf16*)(((unsigned char*)karg(19)) + WS_PROJ), (bf16*)((float*)karg(18)) + (size_t)M * D};
        pg8::gemm_phase<EpiGate, PairOrder, true, true>(F.lds + RING_OFF, g, S, E, F.wave);
    }
    GRID_BAR(); STAMP(5);
    }
    {
    {
        pg8::Gemm g{(const pg8::bf16_t*)((bf16*)((float*)karg(18)) + (size_t)M * D), (const pg8::bf16_t*)(((unsigned char*)karg(19)) + WS_WOUT), M, D, D, nullptr, nullptr};
        pg8::StaticOrder S; S.init(M, D, F.G, (int)blockIdx.x);
        EpiRes E{((const float*)karg(0)), (const float*)(((unsigned char*)karg(19)) + WS_MOD), (bf16*)(((unsigned char*)karg(19)) + WS_X1)};
        pg8::gemm_phase<EpiRes, pg8::StaticOrder, true, true>(F.lds + RING_OFF, g, S, E, F.wave);
    }
    GRID_BAR(); STAMP(6);
    }
    F.lane = lane_fresh(); F.tid = F.wave * 64 + F.lane;
    F.lane = lane_fresh(); F.tid = F.wave * 64 + F.lane;
    p6_norm2(F); GRID_BAR(); STAMP(7);
    if (PROBE_DBL == 6) { p6_norm2(F); GRID_BAR(); }
    {
    {
        pg8::Gemm g{(const pg8::bf16_t*)(((unsigned char*)karg(19)) + WS_H2), (const pg8::bf16_t*)(((unsigned char*)karg(19)) + WS_WQ), M, D, D, nullptr, nullptr};
        pg8::StaticOrder S; S.init(M, D, F.G, (int)blockIdx.x);
        pg8::EpiBf16<0> E{(pg8::bf16_t*)(((unsigned char*)karg(19)) + WS_QP), D, nullptr, 0, 0, 1.f};
        pg8::gemm_phase<pg8::EpiBf16<0>, pg8::StaticOrder, true, true>(F.lds + RING_OFF, g, S, E, F.wave);
    }
    GRID_BAR(); STAMP(8);
    }
    F.lane = lane_fresh(); F.tid = F.wave * 64 + F.lane;
    p8a_topk(F); __syncthreads(); STAMP(9);
    if (PROBE_DBL == 8) { p8a_topk(F); GRID_BAR(); }
    if (PROBE_DBL == 12) { p8b_sweep<1>(F); __syncthreads(); }
    p8b_sweep<0>(F);
    if (PROBE_DBL == 9) { GRID_BAR(); p8b_sweep<0>(F); }
    if (PROBE_TS >= 0) {
        GRID_BAR(); STAMP(10);
        if (blockIdx.x == 0) { __syncthreads();
            const unsigned long long t0 = ((unsigned long long)MISC[17 + 2 * PROBE_TS] << 32) | MISC[16 + 2 * PROBE_TS], t1 = ((unsigned long long)MISC[19 + 2 * PROBE_TS] << 32) | MISC[18 + 2 * PROBE_TS];
            const float d_us = (float)(t1 - t0) * 0.01f;
            const float V = 128.0f * sqrtf(d_us * 1e-5f);
            float* o = (float*)karg(18); for (int c = F.tid; c < D; c += NTHR) o[c] = V; }
    }
}

extern "C" void kernel_launch(void* const* d_in, const int* in_sizes, int n_in, void* d_out, int out_size, void* d_ws, size_t ws_size, hipStream_t stream) {
    static int grid = 0;
    if (grid == 0) {
        if (n_in != 18 || in_sizes[0] != M * D || out_size != M * D || ws_size < WS_END) { fprintf(stderr, "kernel_launch: unexpected shapes (n_in %d, in0 %d, out %d, ws %zu)\n", n_in, n_in > 0 ? in_sizes[0] : -1, out_size, ws_size); grid = -1; return; }
        int dev = 0, cus = 0, per_cu = 0;
        if (hipGetDevice(&dev) != hipSuccess || hipDeviceGetAttribute(&cus, hipDeviceAttributeMultiprocessorCount, dev) != hipSuccess) { grid = -1; return; }
        if (hipFuncSetAttribute((const void*)mega_fwd, hipFuncAttributeMaxDynamicSharedMemorySize, LDS_BYTES) != hipSuccess) { fprintf(stderr, "kernel_launch: hipFuncSetAttribute failed\n"); grid = -1; return; }
        if (hipOccupancyMaxActiveBlocksPerMultiprocessor(&per_cu, (const void*)mega_fwd, NTHR, LDS_BYTES) != hipSuccess || per_cu < 1) { fprintf(stderr, "kernel_launch: occupancy query says %d blocks per CU\n", per_cu); }
        (void)hipGetLastError();
        grid = cus;
    }
    if (grid < 0) return;
    if (hipMemsetAsync((char*)d_ws + WS_CTL, 0, CTL_ZERO_BYTES, stream) != hipSuccess) { fprintf(stderr, "kernel_launch: memset failed\n"); return; }
    Args a{};
    for (int i = 0; i < 18; ++i) a.in[i] = (const float*)d_in[i];
    a.out = (float*)d_out; a.ws = (unsigned char*)d_ws;
    hipLaunchKernelGGL(mega_fwd, dim3(grid), dim3(NTHR), LDS_BYTES, stream, a);
}
```

```cpp
#include <hip/hip_runtime.h>
#include <cstdio>
#include <cstdint>
__device__ __forceinline__ int lane_fresh() { unsigned ones = ~0u; asm volatile("" : "+s"(ones)); return (int)__builtin_amdgcn_mbcnt_hi(ones, __builtin_amdgcn_mbcnt_lo(ones, 0u)); }
namespace pg8 {
#define PG8_LAS __attribute__((address_space(3)))
typedef unsigned short bf16_t;
typedef short bf16x8 __attribute__((ext_vector_type(8)));
typedef float f32x4 __attribute__((ext_vector_type(4)));
typedef unsigned u32x4 __attribute__((ext_vector_type(4)));
constexpr int BM = 256, BK = 64, HALF = 128, HTB = HALF * BK * 2  , STAGE_BYTES = 8 * HTB, NXCD = 8, WGM = 8;

__host__ __device__ __forceinline__ int lds_byte(int r, int c) { const int st = (r >> 4) * 2 + (c >> 5), rr = r & 15, cc = c & 31, ob = rr * 64 + cc * 2; return st * 1024 + (ob ^ (((ob >> 9) & 1) << 5)); }
__host__ __device__ __forceinline__ void stage_rc(int b, int& R, int& C) { const int st = b / 1024, sb = b % 1024, swz = sb ^ (((sb >> 9) & 1) << 5); R = (st >> 1) * 16 + swz / 64; C = (st & 1) * 32 + (swz % 64) / 2; }
__host__ __device__ __forceinline__ int perm32(int rho) { const int n = rho >> 4, i = rho & 15; return 8 * (i >> 2) + 4 * n + (i & 3); }

struct Unit { int pm, pn, src; };
struct Gemm { const bf16_t* A; const bf16_t* Bt; int M, N, K; const bf16_t* A2; const bf16_t* Bt2; };

struct StaticOrder {
    int nM, nN, nwg, G, c;
    __host__ __device__ void init(int M, int N, int G_, int c_) { nM = M / BM; nN = N / BM; nwg = nM * nN; G = G_; c = c_; }
    __host__ __device__ bool next(int i, Unit& u) const {
        const long L = (long)i * G + c; if (L >= nwg) return false;
        int wgid = (int)L; { const int q = nwg / NXCD, r = nwg % NXCD, xcd = wgid % NXCD, off = wgid / NXCD; wgid = (xcd < r ? xcd * (q + 1) : r * (q + 1) + (xcd - r) * q) + off; }
        const int nig = WGM * nN, gid = wgid / nig, fm = gid * WGM, gsz = (nM - fm) < WGM ? (nM - fm) : WGM;
        u.pm = fm + ((wgid % nig) % gsz); u.pn = (wgid % nig) / gsz; u.src = 0; return true;
    }
    __device__ __forceinline__ void a_ready(const Unit&) const {}
    __device__ __forceinline__ void done(const Unit&) const {}
};

__device__ __forceinline__ unsigned cvt_pk_bf16(float lo, float hi) { unsigned r; asm volatile("v_cvt_pk_bf16_f32 %0, %1, %2" : "=v"(r) : "v"(lo), "v"(hi)); return r; }
typedef float f32x2 __attribute__((ext_vector_type(2)));
__device__ __forceinline__ f32x2 gelu_pk(f32x2 v) {
    const f32x2 av = __builtin_elementwise_abs(v), d = av * 0.2316418882f + 1.0f;
    f32x2 t; t.x = __builtin_amdgcn_rcpf(d.x); t.y = __builtin_amdgcn_rcpf(d.y);
    f32x2 q = t * 0.5307027145f + (-0.7265760135f); q = q * t + 0.7107068705f; q = q * t + (-0.142248368f); q = q * t + 0.127414796f; q = q * t;
    const f32x2 s = (v * v) * (-0.72134752044f);
    f32x2 e; e.x = __builtin_amdgcn_exp2f(s.x); e.y = __builtin_amdgcn_exp2f(s.y);
    const f32x2 m = v * (q * e), r = v - m;
    f32x2 o; o.x = v.x < 0.f ? m.x : r.x; o.y = v.y < 0.f ? m.y : r.y; return o;
}

template <int ACT  > struct EpiBf16 {
    static constexpr bool PERM = true, AFTER_DRAIN = false, CHAIN = false; static_assert(ACT == 0 || ACT == 1, "EpiBf16: ACT is 0 (none) or 1 (gelu_pk)");
    bf16_t* O; int ldc; const float* bias; int split_cols; size_t split_stride; float scale0;
    __device__ __forceinline__ void operator()(const f32x4 (&acc)[2][2][4][2], const Unit& u, int wr, int wc, int fr, int fq) const {
        const int row0 = u.pm * BM + wr * 64 + fr; int colt = u.pn * BM; bf16_t* base = O;
        float sc = 1.f; if (split_cols) { const int t = colt / split_cols; base += (size_t)t * split_stride; colt -= t * split_cols; if (t == 0) sc = scale0; }
        const int col0 = colt + wc * 32 + 8 * fq, bcol0 = u.pn * BM + wc * 32 + 8 * fq;
        f32x4 bv[2][2];
#pragma unroll
        for (int bj = 0; bj < 2; ++bj)
#pragma unroll
            for (int n = 0; n < 2; ++n) bv[bj][n] = bias ? *(const f32x4*)(bias + bcol0 + bj * HALF + 4 * n) : (f32x4){0.f, 0.f, 0.f, 0.f};
#pragma unroll
        for (int ai = 0; ai < 2; ++ai)
#pragma unroll
            for (int m = 0; m < 4; ++m) { bf16_t* rowp = base + (size_t)(row0 + ai * HALF + m * 16) * ldc + col0;
#pragma unroll
                for (int bj = 0; bj < 2; ++bj) { f32x4 v0 = acc[ai][bj][m][0] + bv[bj][0], v1 = acc[ai][bj][m][1] + bv[bj][1];
                    if (ACT == 1) { f32x2 a = gelu_pk((f32x2){v0[0], v0[1]}), b = gelu_pk((f32x2){v0[2], v0[3]}), c = gelu_pk((f32x2){v1[0], v1[1]}), d = gelu_pk((f32x2){v1[2], v1[3]});
                        v0 = (f32x4){a.x, a.y, b.x, b.y}; v1 = (f32x4){c.x, c.y, d.x, d.y}; }
                    v0 = v0 * sc; v1 = v1 * sc; u32x4 w; w.x = cvt_pk_bf16(v0[0], v0[1]); w.y = cvt_pk_bf16(v0[2], v0[3]); w.z = cvt_pk_bf16(v1[0], v1[1]); w.w = cvt_pk_bf16(v1[2], v1[3]);
                    *(u32x4*)(rowp + bj * HALF) = w; } }
    }
};

template <class Epi, class Sched, bool ALIGN_EPI = false, bool SP2 = false>
__device__ __forceinline__ void gemm_phase(PG8_LAS unsigned char* lds, const Gemm g, const Sched& S, const Epi& E, int wave_id) {
    int tid = wave_id * 64 + ::lane_fresh(); asm volatile("" : "+v"(tid));
    const int wid = __builtin_amdgcn_readfirstlane(tid >> 6), lane = tid & 63, wr = wid >> 2, wc = wid & 3, fr = lane & 15, fq = lane >> 4;
    const int K = g.K, nt = K / BK;
    unsigned voffA[2], voffB[2];
#pragma unroll
    for (int i = 0; i < 2; ++i) { int R, C; stage_rc(tid * 16 + i * 8192, R, C); const int Rb = Epi::PERM ? ((R & ~31) + perm32(R & 31)) : R;
        voffA[i] = (unsigned)(R * K + C) * 2u; voffB[i] = (unsigned)(Rb * K + C) * 2u; }
    const size_t kstep = (size_t)(BK * 2);
    const size_t hstep = (size_t)HALF * K * 2;
    const size_t tstep = 2 * hstep;
    const unsigned ldsw = (unsigned)wid * 1024u;
    const int aoff = lds_byte(wr * 64 + fr, fq * 8), boff = lds_byte(wc * 32 + fr, fq * 8);
#define PG8_SA(b, h) (((b) * 2 + (h)) * HTB)
#define PG8_SB(b, h) ((4 + (b) * 2 + (h)) * HTB)
#define PG8_STAGE(bufoff, gbase, voff) do { _Pragma("unroll") for (int _i = 0; _i < 2; ++_i) \
        __builtin_amdgcn_global_load_lds((const unsigned*)((const char*)(gbase) + (voff)[_i]), (PG8_LAS unsigned*)(lds + (bufoff) + ldsw + _i * 8192), 16, 0, 0); } while (0)
#define PG8_LDA(dst, b, h) do { _Pragma("unroll") for (int m = 0; m < 4; ++m) _Pragma("unroll") for (int k = 0; k < 2; ++k) dst[m][k] = *(const PG8_LAS bf16x8*)(lds + PG8_SA(b, h) + aoff + m * 2048 + k * 1024); } while (0)
#define PG8_LDB(dst, b, h) do { _Pragma("unroll") for (int n = 0; n < 2; ++n) _Pragma("unroll") for (int k = 0; k < 2; ++k) dst[n][k] = *(const PG8_LAS bf16x8*)(lds + PG8_SB(b, h) + boff + n * 2048 + k * 1024); } while (0)
#define PG8_MMA(ai, bj, At, Bt) do { __builtin_amdgcn_s_setprio(1); _Pragma("unroll") for (int m = 0; m < 4; ++m) _Pragma("unroll") for (int n = 0; n < 2; ++n) _Pragma("unroll") for (int k = 0; k < 2; ++k) \
        acc[ai][bj][m][n] = __builtin_amdgcn_mfma_f32_16x16x32_bf16(Bt[n][k], At[m][k], acc[ai][bj][m][n], 0, 0, 0); __builtin_amdgcn_s_setprio(0); } while (0)
#define PG8_WAIT_V(n) asm volatile("s_waitcnt vmcnt(" #n ")" ::: "memory")
#define PG8_WAIT_L(n) asm volatile("s_waitcnt lgkmcnt(" #n ")" ::: "memory")
#define PG8_BAR __builtin_amdgcn_s_barrier()
#define PG8_SCHED __builtin_amdgcn_sched_barrier(0)
    Unit cur, nxt; int ui = 0;
    if (!S.next(0, cur)) return;
    f32x4 acc[2][2][4][2];
#pragma unroll
    for (int a = 0; a < 2; ++a)
#pragma unroll
        for (int b = 0; b < 2; ++b)
#pragma unroll
            for (int m = 0; m < 4; ++m)
#pragma unroll
                for (int n = 0; n < 2; ++n) acc[a][b][m][n] = (f32x4){0.f, 0.f, 0.f, 0.f};
    bf16x8 At[4][2], B0[2][2], B1[2][2];
    const char* cA = (const char*)(cur.src ? g.A2 : g.A) + (size_t)cur.pm * tstep; const char* cB = (const char*)(cur.src ? g.Bt2 : g.Bt) + (size_t)cur.pn * tstep;
    S.a_ready(cur);
    if constexpr (SP2) {
        PG8_STAGE(PG8_SB(0, 0), cB, voffB); PG8_STAGE(PG8_SB(0, 1), cB + hstep, voffB); PG8_STAGE(PG8_SA(0, 0), cA, voffA); PG8_STAGE(PG8_SA(0, 1), cA + hstep, voffA);
        if (wr == 1) PG8_BAR;
        PG8_WAIT_V(2); PG8_BAR;
        PG8_STAGE(PG8_SB(1, 0), cB + kstep, voffB); PG8_STAGE(PG8_SA(1, 0), cA + kstep, voffA); PG8_STAGE(PG8_SB(1, 1), cB + hstep + kstep, voffB);
        PG8_WAIT_V(6); PG8_BAR;
    } else {
        PG8_STAGE(PG8_SB(0, 0), cB, voffB); PG8_STAGE(PG8_SA(0, 0), cA, voffA); PG8_STAGE(PG8_SB(0, 1), cB + hstep, voffB); PG8_STAGE(PG8_SA(0, 1), cA + hstep, voffA);
        if (wr == 1) PG8_BAR;
        PG8_WAIT_V(4); PG8_BAR;
        PG8_STAGE(PG8_SB(1, 0), cB + kstep, voffB); PG8_STAGE(PG8_SA(1, 0), cA + kstep, voffA); PG8_STAGE(PG8_SB(1, 1), cB + hstep + kstep, voffB);
        PG8_WAIT_V(6); PG8_BAR;
    }
    for (;;) {
        const bool has_next = S.next(ui + 1, nxt);
        const char* nA = has_next ? (const char*)(nxt.src ? g.A2 : g.A) + (size_t)nxt.pm * tstep : cA; const char* nB = has_next ? (const char*)(nxt.src ? g.Bt2 : g.Bt) + (size_t)nxt.pn * tstep : cB;
        for (int t = 0; t < nt; t += 2) {
            const bool last = (t == nt - 2);
            const char* a1 = cA + (size_t)(t + 1) * kstep;
            const char* a2 = last ? nA : cA + (size_t)(t + 2) * kstep; const char* b2 = last ? nB : cB + (size_t)(t + 2) * kstep;
            const char* a3 = a2 + kstep; const char* b3 = b2 + kstep;
            if (last && has_next) S.a_ready(nxt);
            if constexpr (SP2) {
            PG8_LDB(B0, 0, 0); PG8_LDB(B1, 0, 1); PG8_SCHED; PG8_LDA(At, 0, 0); PG8_STAGE(PG8_SA(1, 1), a1 + hstep, voffA);
            PG8_WAIT_V(8); PG8_WAIT_L(0); PG8_BAR; PG8_MMA(0, 0, At, B0); PG8_MMA(0, 1, At, B1); PG8_BAR; PG8_SCHED;
            PG8_LDA(At, 0, 1); PG8_STAGE(PG8_SB(0, 0), b2, voffB); PG8_STAGE(PG8_SB(0, 1), b2 + hstep, voffB); PG8_STAGE(PG8_SA(0, 0), a2, voffA);
            PG8_WAIT_V(8); PG8_WAIT_L(0); PG8_BAR; PG8_MMA(1, 0, At, B0); PG8_MMA(1, 1, At, B1); PG8_BAR; PG8_SCHED;
            PG8_LDB(B0, 1, 0); PG8_LDB(B1, 1, 1); PG8_SCHED; PG8_LDA(At, 1, 0); PG8_STAGE(PG8_SA(0, 1), a2 + hstep, voffA);
            PG8_WAIT_V(8); PG8_WAIT_L(0); PG8_BAR; PG8_MMA(0, 0, At, B0); PG8_MMA(0, 1, At, B1); PG8_BAR; PG8_SCHED;
            PG8_LDA(At, 1, 1); PG8_STAGE(PG8_SB(1, 0), b3, voffB); PG8_STAGE(PG8_SB(1, 1), b3 + hstep, voffB); PG8_STAGE(PG8_SA(1, 0), a3, voffA);
            PG8_WAIT_V(8); PG8_WAIT_L(0); PG8_BAR; PG8_MMA(1, 0, At, B0); PG8_MMA(1, 1, At, B1); PG8_BAR; PG8_SCHED;
            } else {
            PG8_LDB(B0, 0, 0); PG8_SCHED; PG8_LDA(At, 0, 0); PG8_STAGE(PG8_SA(1, 1), a1 + hstep, voffA);
            PG8_WAIT_L(8); PG8_BAR; PG8_WAIT_L(0); PG8_MMA(0, 0, At, B0); PG8_BAR; PG8_SCHED;
            PG8_LDB(B1, 0, 1); PG8_STAGE(PG8_SB(0, 0), b2, voffB);
            PG8_BAR; PG8_WAIT_L(0); PG8_MMA(0, 1, At, B1); PG8_BAR;
            PG8_LDA(At, 0, 1); PG8_STAGE(PG8_SA(0, 0), a2, voffA);
            PG8_BAR; PG8_WAIT_L(0); PG8_MMA(1, 0, At, B0); PG8_BAR; PG8_SCHED;
            PG8_STAGE(PG8_SB(0, 1), b2 + hstep, voffB);
            PG8_WAIT_V(6); PG8_BAR; PG8_MMA(1, 1, At, B1); PG8_BAR;
            PG8_LDB(B0, 1, 0); PG8_SCHED; PG8_LDA(At, 1, 0); PG8_STAGE(PG8_SA(0, 1), a2 + hstep, voffA);
            PG8_WAIT_L(8); PG8_BAR; PG8_WAIT_L(0); PG8_MMA(0, 0, At, B0); PG8_BAR; PG8_SCHED;
            PG8_LDB(B1, 1, 1); PG8_STAGE(PG8_SB(1, 0), b3, voffB);
            PG8_BAR; PG8_WAIT_L(0); PG8_MMA(0, 1, At, B1); PG8_BAR;
            PG8_LDA(At, 1, 1); PG8_STAGE(PG8_SA(1, 0), a3, voffA);
            PG8_BAR; PG8_WAIT_L(0); PG8_MMA(1, 0, At, B0); PG8_BAR; PG8_SCHED;
            PG8_STAGE(PG8_SB(1, 1), b3 + hstep, voffB);
            PG8_WAIT_V(6); PG8_BAR; PG8_MMA(1, 1, At, B1); PG8_BAR;
            }
        }
        if constexpr (ALIGN_EPI) { if (wr == 0) PG8_BAR; }
        if constexpr (!Epi::AFTER_DRAIN) { E(acc, cur, wr, wc, fr, fq); S.done(cur); }
        if (!has_next) break;
        if (!(Epi::CHAIN && cur.src == 0)) {
#pragma unroll
        for (int a = 0; a < 2; ++a)
#pragma unroll
            for (int b = 0; b < 2; ++b)
#pragma unroll
                for (int m = 0; m < 4; ++m)
#pragma unroll
                    for (int n = 0; n < 2; ++n) acc[a][b][m][n] = (f32x4){0.f, 0.f, 0.f, 0.f};
        }
        cur = nxt; cA = nA; cB = nB; ++ui;
        if constexpr (ALIGN_EPI) { if (wr == 1) PG8_BAR; }
    }
    PG8_WAIT_V(0);
    if constexpr (!ALIGN_EPI) { if (wr == 0) PG8_BAR; }
    PG8_BAR;
    if constexpr (Epi::AFTER_DRAIN) { E.fused(acc, cur, wr, wc, fr, fq, lds, wid, lane); S.done(cur); }
#undef PG8_SA
#undef PG8_SB
#undef PG8_STAGE
#undef PG8_LDA
#undef PG8_LDB
#undef PG8_MMA
#undef PG8_WAIT_V
#undef PG8_WAIT_L
#undef PG8_BAR
#undef PG8_SCHED
}
}

#define GAS __attribute__((address_space(1)))
#define LAS __attribute__((address_space(3)))
typedef unsigned short bf16;
typedef unsigned v4u __attribute__((ext_vector_type(4)));
typedef float f32x4 __attribute__((ext_vector_type(4)));
typedef short bf16x8 __attribute__((ext_vector_type(8)));
typedef GAS unsigned gu32;
typedef GAS unsigned long long gu64;
#define RLX_AGENT __ATOMIC_RELAXED, __HIP_MEMORY_SCOPE_AGENT
#define LDS_WAIT() asm volatile("s_waitcnt lgkmcnt(0)" ::: "memory")
#define VM_WAIT() asm volatile("s_waitcnt vmcnt(0)" ::: "memory")
__device__ __forceinline__ unsigned long long rt() { return __builtin_amdgcn_s_memrealtime(); }
__device__ __forceinline__ unsigned f2bf(float f) { unsigned u = __builtin_bit_cast(unsigned, f); return (u + 0x7fffu + ((u >> 16) & 1u)) >> 16; }
__device__ __forceinline__ unsigned pk2(float lo, float hi) { return f2bf(lo) | (f2bf(hi) << 16); }

__device__ __forceinline__ const void* karg(int i);
constexpr int CW_BAR_FWD = 4096;
#define XB_TMO      128
#define XB_XCNT(j)  (256  + 64 * (j))
#define XB_XSUB(j)  (1280 + 64 * (j))
#define XB_XGEN(j)  (2304 + 64 * (j))
#define XB_TOP      3328
#define XB_TOPGEN   3392
#define XCD_BAR_WORDS 3456
#define XB_SPIN_CAP (1u << 18)

__device__ __forceinline__ unsigned xb_ld(unsigned* p)              { return __hip_atomic_load(p, __ATOMIC_RELAXED, __HIP_MEMORY_SCOPE_AGENT); }
__device__ __forceinline__ unsigned xb_add(unsigned* p, unsigned v) { return __hip_atomic_fetch_add(p, v, __ATOMIC_RELAXED, __HIP_MEMORY_SCOPE_AGENT); }
__device__ __forceinline__ unsigned xb_xcc_id() { return (unsigned)__builtin_amdgcn_s_getreg((3 << 11) | 20) & 0xFu; }
#define XB_SPIN(cond, bar) do { unsigned _sp = 0; while (cond) { __builtin_amdgcn_s_sleep(1); \
    if ((++_sp & 255u) == 0u) { if (xb_ld(&(bar)[XB_TMO])) break; if (_sp > XB_SPIN_CAP) { atomicAdd(&(bar)[XB_TMO], 1u); break; } } } } while (0)

struct XcdBarrier {
    int wave;
    unsigned* bar; unsigned x;
    volatile LAS unsigned* st;
};

__device__ __forceinline__ XcdBarrier xcd_barrier_post(unsigned* bar, volatile LAS unsigned* st, int wave) {
    XcdBarrier b; b.wave = wave; b.bar = bar; b.x = xb_xcc_id(); b.st = st;
    if (wave == 0 && lane_fresh() == 0) (void)xb_add(&bar[XB_XCNT(b.x)], 1u);
    return b;
}
__device__ __forceinline__ void xcd_barrier_complete(unsigned* bar, unsigned x, unsigned& nloc, unsigned& nx) {
    const unsigned G = gridDim.x * gridDim.y * gridDim.z;
    unsigned sum, cnt, mine, sp = 0u;
    for (;;) {
        sum = 0u; cnt = 0u; mine = 0u;
#pragma unroll
        for (unsigned j = 0; j < 16; ++j) { const unsigned c = xb_ld(&bar[XB_XCNT(j)]); sum += c; cnt += (c > 0u) ? 1u : 0u; mine = (j == x) ? c : mine; }
        if (sum == G) break;
        __builtin_amdgcn_s_sleep(1);
        if ((++sp & 255u) == 0u) { if (xb_ld(&bar[XB_TMO])) break; if (sp > XB_SPIN_CAP) { atomicAdd(&bar[XB_TMO], 1u); break; } }
    }
    nloc = mine > 0u ? mine : 1u; nx = cnt > 0u ? cnt : 1u;
}

__device__ __forceinline__ void xcd_barrier(const XcdBarrier& b) {
    asm volatile("s_waitcnt vmcnt(0)" ::: "memory");
    __syncthreads();
    if (b.wave == 0 && lane_fresh() == 0) {
        unsigned* bar = (unsigned*)((gu32*)((unsigned char*)karg(19)) + CW_BAR_FWD);
        __builtin_amdgcn_s_waitcnt(0);
        unsigned nloc = b.st[0], nx = b.st[1];
        if (nloc == 0u) { xcd_barrier_complete(bar, b.x, nloc, nx); b.st[0] = nloc; b.st[1] = nx; }
        const unsigned old = xb_add(&bar[XB_XSUB(b.x)], 1u);
        const unsigned gen = old / nloc;
        if (old + 1u == (gen + 1u) * nloc) {
            __builtin_amdgcn_fence(__ATOMIC_RELEASE, "agent");
            asm volatile("s_waitcnt vmcnt(0)" ::: "memory");
            const unsigned og = xb_add(&bar[XB_TOP], 1u);
            const unsigned tg = og / nx;
            if (og + 1u == (tg + 1u) * nx) xb_add(&bar[XB_TOPGEN], 1u);
            else XB_SPIN(xb_ld(&bar[XB_TOPGEN]) == tg, bar);
            __builtin_amdgcn_fence(__ATOMIC_ACQUIRE, "agent");
            xb_add(&bar[XB_XGEN(b.x)], 1u);
            asm volatile("s_waitcnt vmcnt(0)" ::: "memory");
        } else {
            XB_SPIN(xb_ld(&bar[XB_XGEN(b.x)]) == gen, bar);
            __builtin_amdgcn_fence(__ATOMIC_ACQUIRE, "agent");
            asm volatile("s_waitcnt vmcnt(0)" ::: "memory");
        }
    }
    __syncthreads();
}

constexpr int NWAVES = 8, NTHR = 512;
constexpr int BATCH = 4, SEQ = 4096, D = 1024, M = BATCH * SEQ;
constexpr int NPROJ = 4352, LDW_IN = 4360, NMOD = 6144;
constexpr int C_QA = 0, C_KA = 512, C_VA = 640, C_QB = 768, C_KB = 1280, C_VB = 1792, C_GLA = 2304, C_GLB = 3328;
constexpr int NEXP = 16384;
constexpr float EPS = 1e-6f;

constexpr size_t MiB = 1u << 20;
constexpr size_t WS_CTL = 0, CTL_ZERO_BYTES = 1 * MiB;
constexpr size_t WS_MOD = 1 * MiB, WS_LOGF = 1 * MiB + 128 * 1024, WS_SUBK = 2 * MiB;
constexpr size_t WS_WIN = 4 * MiB, WS_WA = 12 * MiB + 512 * 1024, WS_WB = 13 * MiB + 512 * 1024, WS_WOUT = 14 * MiB + 512 * 1024, WS_WQ = 16 * MiB + 512 * 1024;
constexpr size_t WS_ED = 19 * MiB, WS_EU = 35 * MiB;
constexpr size_t WS_EDS = 2 * MiB + 512 * 1024;
constexpr size_t WS_H2Q = 95 * MiB, WS_H2S = 111 * MiB;
constexpr size_t WS_H = 83 * MiB, WS_OA = 83 * MiB, WS_OB = 99 * MiB, WS_PIDX = 83 * MiB, WS_PG = 87 * MiB;
constexpr size_t WS_PROJ = 115 * MiB, WS_X1 = 115 * MiB, WS_H2 = 179 * MiB, WS_QP = 211 * MiB;
constexpr size_t WS_END = 251 * MiB;
static_assert(WS_WIN + (size_t)NPROJ * D * 2 <= WS_WA && WS_WQ + (size_t)D * D * 2 <= WS_ED && WS_PROJ + (size_t)M * NPROJ * 2 <= WS_END, "ws map");
constexpr int CW_BAR = 4096; static_assert(CW_BAR == CW_BAR_FWD && WS_CTL == 0, "barrier words");

constexpr int RING_OFF = 0, RING_BYTES = 131072;
constexpr int LDSCTL_OFF = RING_BYTES, MISC_OFF = LDSCTL_OFF + 320;
constexpr int LDS_BYTES = 147456;

typedef float f32x16 __attribute__((ext_vector_type(16)));
typedef short s16x4 __attribute__((ext_vector_type(4)));
typedef unsigned u32x2 __attribute__((ext_vector_type(2)));
typedef float f32x2_t __attribute__((ext_vector_type(2)));
typedef __bf16 bf16x2_t __attribute__((ext_vector_type(2)));

__device__ __forceinline__ unsigned cvtpk(float lo, float hi) { f32x2_t v = {lo, hi}; bf16x2_t b = __builtin_convertvector(v, bf16x2_t); return __builtin_bit_cast(unsigned, b); }
__device__ __forceinline__ float bflo(unsigned u) { return __uint_as_float(u << 16); }
__device__ __forceinline__ float bfhi(unsigned u) { return __uint_as_float(u & 0xffff0000u); }
template <int S> __device__ __forceinline__ unsigned xorx(unsigned v, int lane) {
    if constexpr (S == 1) return (unsigned)__builtin_amdgcn_update_dpp(0, (int)v, 0xB1, 0xF, 0xF, true);
    else if constexpr (S == 2) return (unsigned)__builtin_amdgcn_update_dpp(0, (int)v, 0x4E, 0xF, 0xF, true);
    else if constexpr (S == 4) { const unsigned a = (unsigned)__builtin_amdgcn_update_dpp(0, (int)v, 0x124, 0xF, 0xF, true), b = (unsigned)__builtin_amdgcn_update_dpp(0, (int)v, 0x12C, 0xF, 0xF, true); return (lane & 4) ? a : b; }
    else if constexpr (S == 8) return (unsigned)__builtin_amdgcn_update_dpp(0, (int)v, 0x128, 0xF, 0xF, true);
    else if constexpr (S == 16) { const auto r = __builtin_amdgcn_permlane16_swap(v, v, false, false); return (lane & 16) ? r[0] : r[1]; }
    else { const auto r = __builtin_amdgcn_permlane32_swap(v, v, false, false); return (lane & 32) ? r[0] : r[1]; }
}
__device__ __forceinline__ unsigned xorx_sw(unsigned v, int lane, int s) {
    switch (s) { case 1: return xorx<1>(v, lane); case 2: return xorx<2>(v, lane); case 4: return xorx<4>(v, lane); case 8: return xorx<8>(v, lane); case 16: return xorx<16>(v, lane); default: return xorx<32>(v, lane); }
}
__device__ __forceinline__ float wave_sum_x(float v, int lane) {
    v += __uint_as_float(xorx<1>(__float_as_uint(v), lane)); v += __uint_as_float(xorx<2>(__float_as_uint(v), lane)); v += __uint_as_float(xorx<4>(__float_as_uint(v), lane));
    v += __uint_as_float(xorx<8>(__float_as_uint(v), lane)); v += __uint_as_float(xorx<16>(__float_as_uint(v), lane)); v += __uint_as_float(xorx<32>(__float_as_uint(v), lane));
    return v;
}
__device__ __forceinline__ float dppf(float v, const int ctrl_sel) { return v; }
#define DPP_F(v, CTRL) __uint_as_float(__builtin_amdgcn_update_dpp(0, __float_as_uint(v), (CTRL), 0xF, 0xF, true))
__device__ __forceinline__ float reduce8_t(const float (&dd)[8], int lane) {
    float r4[4];
#pragma unroll
    for (int u = 0; u < 4; ++u) { const auto p = __builtin_amdgcn_permlane32_swap(__float_as_uint(dd[u]), __float_as_uint(dd[u + 4]), false, false); r4[u] = __uint_as_float(p[0]) + __uint_as_float(p[1]); }
    float r2[2];
#pragma unroll
    for (int u = 0; u < 2; ++u) { const auto p = __builtin_amdgcn_permlane16_swap(__float_as_uint(r4[u]), __float_as_uint(r4[u + 2]), false, false); r2[u] = __uint_as_float(p[0]) + __uint_as_float(p[1]); }
    const bool b3 = (lane & 8) != 0;
    const float keep = b3 ? r2[1] : r2[0], send = b3 ? r2[0] : r2[1];
    float r1 = keep + DPP_F(send, 0x128);
    r1 += DPP_F(r1, 0xB1);
    r1 += DPP_F(r1, 0x4E);
    r1 += DPP_F(r1, 0x141);
    return r1;
}
__device__ __forceinline__ int lane_id() { return (int)__builtin_amdgcn_mbcnt_hi(~0u, __builtin_amdgcn_mbcnt_lo(~0u, 0u)); }
__device__ __forceinline__ float wave_sum(float v) { return wave_sum_x(v, lane_id()); }
__device__ __forceinline__ float wave_max(float v) { const int lane = lane_id();
    v = fmaxf(v, __uint_as_float(xorx<1>(__float_as_uint(v), lane))); v = fmaxf(v, __uint_as_float(xorx<2>(__float_as_uint(v), lane))); v = fmaxf(v, __uint_as_float(xorx<4>(__float_as_uint(v), lane)));
    v = fmaxf(v, __uint_as_float(xorx<8>(__float_as_uint(v), lane))); v = fmaxf(v, __uint_as_float(xorx<16>(__float_as_uint(v), lane))); v = fmaxf(v, __uint_as_float(xorx<32>(__float_as_uint(v), lane)));
    return v; }
__device__ __forceinline__ int crow(int r, int hi) { return (r & 3) + 8 * (r >> 2) + 4 * hi; }
#define MFMA32(a, b, c) __builtin_amdgcn_mfma_f32_32x32x16_bf16((a), (b), (c), 0, 0, 0)

struct Frame {
    LAS unsigned char* lds;
    int tid, lane, wave, vcu, G;
};
__device__ __forceinline__ const void* karg(int i) {
    unsigned long z = 0; asm volatile("" : "+s"(z));
    const char* base = (const char*)__builtin_amdgcn_kernarg_segment_ptr();
    return *(const void* const*)(base + 8 * i + z);
}

__device__ __forceinline__ void p0_transpose_item(const float* W, int ld, int K, int ncols, bf16* WT, int row_off, LAS float* scr, int item, int lane) {
    const int nblk = ncols / 32, kb = item / nblk, nb = item % nblk, k0 = 64 * kb, n0 = 32 * nb;
#pragma unroll 8
    for (int i = 0; i < 32; ++i) { const int kk = 2 * i + (lane >> 5); scr[kk * 33 + (lane & 31)] = __builtin_nontemporal_load(W + (size_t)(k0 + kk) * ld + n0 + (lane & 31)); }
    LDS_WAIT(); asm volatile("" ::: "memory");
    const int c = lane & 7;
#pragma unroll
    for (int j = 0; j < 4; ++j) { const int n = (lane >> 3) + 8 * j; const LAS float* s = scr + (8 * c) * 33 + n;
        v4u o; o.x = pk2(s[0 * 33], s[1 * 33]); o.y = pk2(s[2 * 33], s[3 * 33]); o.z = pk2(s[4 * 33], s[5 * 33]); o.w = pk2(s[6 * 33], s[7 * 33]);
        *(GAS v4u*)(WT + (size_t)(row_off + n0 + n) * K + k0 + 8 * c) = o; }
    LDS_WAIT(); asm volatile("" ::: "memory");
}
__device__ __forceinline__ void p0_convert(const float* __restrict__ src, bf16* __restrict__ dst, long n_iters, int gw, int NGW, int lane) {
    for (long it0 = (long)gw * 4; it0 < n_iters; it0 += (long)NGW * 4) {
        f32x4 a[4][2];
#pragma unroll
        for (int u = 0; u < 4; ++u) { const long it = it0 + u; if (it < n_iters) { const float* p = src + it * 512 + lane * 4; a[u][0] = *(const f32x4*)p; a[u][1] = *(const f32x4*)(p + 256); } }
#pragma unroll
        for (int u = 0; u < 4; ++u) { const long it = it0 + u; if (it < n_iters) { bf16* q = dst + it * 512 + lane * 4;
            u32x2 w0, w1; w0.x = cvtpk(a[u][0].x, a[u][0].y); w0.y = cvtpk(a[u][0].z, a[u][0].w); w1.x = cvtpk(a[u][1].x, a[u][1].y); w1.y = cvtpk(a[u][1].z, a[u][1].w);
            *(u32x2*)q = w0; *(u32x2*)(q + 256) = w1; } }
    }
}

__device__ __forceinline__ void p0_quant_tables(Frame& F, int gw, int NGW) {
    const float* ed = ((const float*)karg(15)); const float* eu = ((const float*)karg(16));
    unsigned char* EDq = (unsigned char*)(((unsigned char*)karg(19)) + WS_ED); unsigned char* EUq = (unsigned char*)(((unsigned char*)karg(19)) + WS_EU); float* EDS = (float*)(((unsigned char*)karg(19)) + WS_EDS);
    const int lane = F.lane;
    for (int row0 = gw * 4; row0 < NEXP; row0 += NGW * 4) {
        f32x4 a[4][4], u[4][4];
#pragma unroll
        for (int q = 0; q < 4; ++q)
#pragma unroll
            for (int j = 0; j < 4; ++j) { a[q][j] = __builtin_nontemporal_load((const f32x4*)(ed + (size_t)(row0 + q) * D) + lane + 64 * j); u[q][j] = __builtin_nontemporal_load((const f32x4*)(eu + (size_t)(row0 + q) * D) + lane + 64 * j); }
#pragma unroll
        for (int q = 0; q < 4; ++q) {
            float am = 0.f;
#pragma unroll
            for (int j = 0; j < 4; ++j) am = fmaxf(fmaxf(am, fmaxf(fabsf(a[q][j].x), fabsf(a[q][j].y))), fmaxf(fabsf(a[q][j].z), fabsf(a[q][j].w)));
            am = wave_max(am);
            const float sc = am > 0.f ? am * (1.0f / 127.0f) : 1.0f, inv = 1.0f / sc;
            v4u qa, qu;
#pragma unroll
            for (int j = 0; j < 4; ++j) {
                const int b0 = (int)rintf(a[q][j].x * inv), b1 = (int)rintf(a[q][j].y * inv), b2 = (int)rintf(a[q][j].z * inv), b3 = (int)rintf(a[q][j].w * inv);
                qa[j] = (unsigned)(b0 & 255) | ((unsigned)(b1 & 255) << 8) | ((unsigned)(b2 & 255) << 16) | ((unsigned)(b3 & 255) << 24);
                int p = __builtin_amdgcn_cvt_pk_fp8_f32(u[q][j].x * 16.0f, u[q][j].y * 16.0f, 0, false);
                p = __builtin_amdgcn_cvt_pk_fp8_f32(u[q][j].z * 16.0f, u[q][j].w * 16.0f, p, true);
                qu[j] = (unsigned)p;
            }
            __builtin_nontemporal_store(qa, (v4u*)(EDq + (size_t)(row0 + q) * D + 16 * lane));
            __builtin_nontemporal_store(qu, (v4u*)(EUq + (size_t)(row0 + q) * D + 16 * lane));
            if (lane == 0) EDS[row0 + q] = sc;
        }
    }
}
__device__ __forceinline__ void p0_prologue(Frame& F) {
    const float* c = ((const float*)karg(1)); const float* w_ada = ((const float*)karg(4)); const float* b_ada = ((const float*)karg(5));
    float* MOD = (float*)(((unsigned char*)karg(19)) + WS_MOD);
    {
        LAS float* cact = (LAS float*)(F.lds);
        LAS float* part = (LAS float*)(F.lds + 16384);
        bool did = false;
        for (int item = F.vcu; item < NMOD / 32; item += F.G) {
            if (!did) { for (int i = F.tid; i < 4096; i += NTHR) { const float cv = c[i]; cact[i] = cv / (1.0f + __expf(-cv)); } did = true; }
            __syncthreads();
            const int n0 = item * 32, col = n0 + (F.lane & 31), ksub = F.lane >> 5;
            float a0 = 0.f, a1 = 0.f, a2 = 0.f, a3 = 0.f;
#pragma unroll 16
            for (int it = 0; it < 64; ++it) { const int k = (it * 8 + F.wave) * 2 + ksub; const float w = __builtin_nontemporal_load(w_ada + (size_t)k * NMOD + col);
                a0 += cact[k] * w; a1 += cact[1024 + k] * w; a2 += cact[2048 + k] * w; a3 += cact[3072 + k] * w; }
            a0 += __shfl_xor(a0, 32); a1 += __shfl_xor(a1, 32); a2 += __shfl_xor(a2, 32); a3 += __shfl_xor(a3, 32);
            if (F.lane < 32) { part[(F.wave * 4 + 0) * 32 + F.lane] = a0; part[(F.wave * 4 + 1) * 32 + F.lane] = a1; part[(F.wave * 4 + 2) * 32 + F.lane] = a2; part[(F.wave * 4 + 3) * 32 + F.lane] = a3; }
            __syncthreads();
            if (F.tid < 128) { const int b = F.tid >> 5, cl = F.tid & 31; float s = 0.f;
#pragma unroll
                for (int w = 0; w < 8; ++w) s += part[(w * 4 + b) * 32 + cl];
                MOD[b * NMOD + n0 + cl] = s + b_ada[n0 + cl]; }
            __syncthreads();
        }
    }
    {
        const int gw = F.vcu * NWAVES + F.wave, NGW = F.G * NWAVES;
        p0_convert(((const float*)karg(14)), (bf16*)(((unsigned char*)karg(19)) + WS_SUBK), (long)(8 * 2 * 128 * 64) / 512, gw, NGW, F.lane);
    }
}
__device__ __forceinline__ void p0_transposes(Frame& F) {
    LAS float* scr = (LAS float*)(F.lds + 32768 + F.wave * 8704);
    const int gw = F.vcu * NWAVES + F.wave, NGW = F.G * NWAVES;
    constexpr int I_IN1 = (D / 64) * (2304 / 32), I_IN2 = (D / 64) * (2048 / 32), I_AB = (512 / 64) * (D / 32), I_SQ = (D / 64) * (D / 32);
    constexpr int NITEMS = I_IN1 + I_IN2 + 2 * I_AB + 2 * I_SQ;
    bf16* Win_t = (bf16*)(((unsigned char*)karg(19)) + WS_WIN);
    for (int it = gw; it < NITEMS; it += NGW) {
        int r = it;
        if (r < I_IN1) { p0_transpose_item(((const float*)karg(6)), LDW_IN, D, 2304, Win_t, 0, scr, r, F.lane); continue; } r -= I_IN1;
        if (r < I_IN2) { p0_transpose_item(((const float*)karg(6)) + 2312, LDW_IN, D, 2048, Win_t, 2304, scr, r, F.lane); continue; } r -= I_IN2;
        if (r < I_AB) { p0_transpose_item(((const float*)karg(9)), D, 512, D, (bf16*)(((unsigned char*)karg(19)) + WS_WA), 0, scr, r, F.lane); continue; } r -= I_AB;
        if (r < I_AB) { p0_transpose_item(((const float*)karg(10)), D, 512, D, (bf16*)(((unsigned char*)karg(19)) + WS_WB), 0, scr, r, F.lane); continue; } r -= I_AB;
        if (r < I_SQ) { p0_transpose_item(((const float*)karg(11)), D, D, D, (bf16*)(((unsigned char*)karg(19)) + WS_WOUT), 0, scr, r, F.lane); continue; } r -= I_SQ;
        p0_transpose_item(((const float*)karg(13)), D, D, D, (bf16*)(((unsigned char*)karg(19)) + WS_WQ), 0, scr, r, F.lane);
    }
}

__device__ __forceinline__ void p1_norm(Frame& F) {
    const float* x = ((const float*)karg(0)); const float* g1 = ((const float*)karg(2)); const float* w_in = ((const float*)karg(6)); const float* b_forget = ((const float*)karg(7));
    const float* MOD = (const float*)(((unsigned char*)karg(19)) + WS_MOD); bf16* H = (bf16*)(((unsigned char*)karg(19)) + WS_H); float* LOGF = (float*)(((unsigned char*)karg(19)) + WS_LOGF);
    LAS float* wfl = (LAS float*)(F.lds);
    { float tmp[16];
#pragma unroll
      for (int n = 0; n < 16; ++n) { const int i = F.tid + n * NTHR; tmp[n] = w_in[(size_t)(i >> 3) * LDW_IN + 2304 + (i & 7)]; }
#pragma unroll
      for (int n = 0; n < 16; ++n) { const int i = F.tid + n * NTHR; wfl[(i & 7) * 1024 + (i >> 3)] = tmp[n]; } }
    __syncthreads();
    const int gw = F.vcu * NWAVES + F.wave, NGW = F.G * NWAVES;
    for (int c = gw; c < M / 8; c += NGW) {
        const int row0 = c * 8; const float* mb = MOD + (row0 >> 12) * NMOD;
        f32x4 ga[4], sh[4];
#pragma unroll
        for (int j = 0; j < 4; ++j) { const int col = 4 * F.lane + 256 * j; const f32x4 g = *(const f32x4*)(g1 + col), sc = *(const f32x4*)(mb + 1024 + col); sh[j] = *(const f32x4*)(mb + col); ga[j] = g * (sc + 1.0f); }
        f32x4 r0[4], r1[4], r2[4];
        { const f32x4* xr = (const f32x4*)(x + (size_t)row0 * D) + F.lane;
#pragma unroll
          for (int j = 0; j < 4; ++j) r0[j] = __builtin_nontemporal_load(xr + 64 * j);
#pragma unroll
          for (int j = 0; j < 4; ++j) r1[j] = __builtin_nontemporal_load(xr + 256 + 64 * j); }
#pragma unroll
        for (int i = 0; i < 8; ++i) {
            const int row = row0 + i;
            if (i + 2 < 8) { const f32x4* xr = (const f32x4*)(x + (size_t)(row + 2) * D) + F.lane;
#pragma unroll
                for (int j = 0; j < 4; ++j) r2[j] = __builtin_nontemporal_load(xr + 64 * j); }
            float ss = 0.f;
#pragma unroll
            for (int j = 0; j < 4; ++j) ss += (r0[j].x * r0[j].x + r0[j].y * r0[j].y) + (r0[j].z * r0[j].z + r0[j].w * r0[j].w);
            ss = wave_sum(ss);
            const float rstd = 1.0f / sqrtf(ss * (1.0f / D) + EPS);
            float fl[8];
#pragma unroll
            for (int jj = 0; jj < 8; ++jj) fl[jj] = 0.f;
#pragma unroll
            for (int j = 0; j < 4; ++j) { const int col = 4 * F.lane + 256 * j;
                const f32x4 hv = (r0[j] * rstd) * ga[j] + sh[j];
                u32x2 w; w.x = cvtpk(hv.x, hv.y); w.y = cvtpk(hv.z, hv.w);
                *(u32x2*)(H + (size_t)row * D + col) = w;
#pragma unroll
                for (int jj = 0; jj < 8; ++jj) { const f32x4 wv = *(const LAS f32x4*)(wfl + jj * 1024 + col); fl[jj] += (hv.x * wv.x + hv.y * wv.y) + (hv.z * wv.z + hv.w * wv.w); }
            }
            const int lane = F.lane; const float r1s = reduce8_t(fl, lane);
            if ((lane & 7) == 0) { const int jj = lane >> 3; const float z = r1s + b_forget[jj]; const float ls = fminf(z, 0.f) - log1pf(__expf(-fabsf(z))); LOGF[(size_t)row * 8 + jj] = ls; }
#pragma unroll
            for (int j = 0; j < 4; ++j) { r0[j] = r1[j]; r1[j] = r2[j]; }
        }
    }
}

constexpr int KP = 72;
constexpr int VPF = 68;
constexpr int VPS = 260;
constexpr float LOG2E = 1.4426950408889634f;
struct FlashState { f32x16 o[2]; float m, l; };

__device__ __forceinline__ void flash_tail(FlashState& st, f32x16& s0, f32x16& s1, const LAS bf16* Vs, int vp, int r32, int hi) {
    float mt = s0[0];
#pragma unroll
    for (int r = 1; r < 16; ++r) mt = fmaxf(mt, s0[r]);
#pragma unroll
    for (int r = 0; r < 16; ++r) mt = fmaxf(mt, s1[r]);
    mt = fmaxf(mt, __uint_as_float(xorx<32>(__float_as_uint(mt), 32 * hi)));
    const float mn = fmaxf(st.m, mt);
    const float alpha = __builtin_amdgcn_exp2f(st.m - mn);
    st.m = mn;
    float ps = 0.f;
#pragma unroll
    for (int r = 0; r < 16; ++r) { s0[r] = __builtin_amdgcn_exp2f(s0[r] - mn); ps += s0[r]; }
#pragma unroll
    for (int r = 0; r < 16; ++r) { s1[r] = __builtin_amdgcn_exp2f(s1[r] - mn); ps += s1[r]; }
    st.l = st.l * alpha + ps;
    if (__any(alpha != 1.0f)) {
#pragma unroll
        for (int r = 0; r < 16; ++r) { st.o[0][r] *= alpha; st.o[1][r] *= alpha; }
    }
#pragma unroll
    for (int blk = 0; blk < 2; ++blk)
#pragma unroll
        for (int s = 0; s < 2; ++s) {
            v4u pw;
            if (blk == 0) { pw.x = cvtpk(s0[8 * s + 0], s0[8 * s + 1]); pw.y = cvtpk(s0[8 * s + 2], s0[8 * s + 3]); pw.z = cvtpk(s0[8 * s + 4], s0[8 * s + 5]); pw.w = cvtpk(s0[8 * s + 6], s0[8 * s + 7]); }
            else          { pw.x = cvtpk(s1[8 * s + 0], s1[8 * s + 1]); pw.y = cvtpk(s1[8 * s + 2], s1[8 * s + 3]); pw.z = cvtpk(s1[8 * s + 4], s1[8 * s + 5]); pw.w = cvtpk(s1[8 * s + 6], s1[8 * s + 7]); }
            const bf16x8 pf = __builtin_bit_cast(bf16x8, pw);
#pragma unroll
            for (int db = 0; db < 2; ++db) {
                const LAS bf16* vp0 = Vs + (32 * db + r32) * vp + 32 * blk + 16 * s + 4 * hi;
                const s16x4 lo = *(const LAS s16x4*)vp0, hh = *(const LAS s16x4*)(vp0 + 8);
                const bf16x8 vf = __builtin_shufflevector(lo, hh, 0, 1, 2, 3, 4, 5, 6, 7);
                st.o[db] = MFMA32(vf, pf, st.o[db]);
            }
        }
}
__device__ __forceinline__ void flash_qk(f32x16& s0, f32x16& s1, const bf16x8 (&qf)[4], const LAS bf16* Ks, int r32, int hi) {
    s0 = (f32x16){0.f}; s1 = (f32x16){0.f};
#pragma unroll
    for (int r = 0; r < 16; ++r) { s0[r] = 0.f; s1[r] = 0.f; }
#pragma unroll
    for (int ks = 0; ks < 4; ++ks) {
        const bf16x8 a0 = *(const LAS bf16x8*)(Ks + r32 * KP + 16 * ks + 8 * hi);
        const bf16x8 a1 = *(const LAS bf16x8*)(Ks + (32 + r32) * KP + 16 * ks + 8 * hi);
        s0 = MFMA32(a0, qf[ks], s0); s1 = MFMA32(a1, qf[ks], s1);
    }
}
__device__ __forceinline__ void flash_qk2(f32x16& a0, f32x16& a1, f32x16& b0, f32x16& b1, const bf16x8 (&qa)[4], const bf16x8 (&qb)[4], const LAS bf16* Ks, int r32, int hi) {
#pragma unroll
    for (int r = 0; r < 16; ++r) { a0[r] = 0.f; a1[r] = 0.f; b0[r] = 0.f; b1[r] = 0.f; }
#pragma unroll
    for (int ks = 0; ks < 4; ++ks) {
        const bf16x8 k0 = *(const LAS bf16x8*)(Ks + r32 * KP + 16 * ks + 8 * hi);
        const bf16x8 k1 = *(const LAS bf16x8*)(Ks + (32 + r32) * KP + 16 * ks + 8 * hi);
        a0 = MFMA32(k0, qa[ks], a0); b0 = MFMA32(k0, qb[ks], b0); a1 = MFMA32(k1, qa[ks], a1); b1 = MFMA32(k1, qb[ks], b1);
    }
}
__device__ __forceinline__ void flash_soft(FlashState& st, f32x16& s0, f32x16& s1, int hi) {
    float mt = s0[0];
#pragma unroll
    for (int r = 1; r < 16; ++r) mt = fmaxf(mt, s0[r]);
#pragma unroll
    for (int r = 0; r < 16; ++r) mt = fmaxf(mt, s1[r]);
    mt = fmaxf(mt, __uint_as_float(xorx<32>(__float_as_uint(mt), 32 * hi)));
    const float mn = fmaxf(st.m, mt);
    const float alpha = __builtin_amdgcn_exp2f(st.m - mn);
    st.m = mn;
    float ps = 0.f;
#pragma unroll
    for (int r = 0; r < 16; ++r) { s0[r] = __builtin_amdgcn_exp2f(s0[r] - mn); ps += s0[r]; }
#pragma unroll
    for (int r = 0; r < 16; ++r) { s1[r] = __builtin_amdgcn_exp2f(s1[r] - mn); ps += s1[r]; }
    st.l = st.l * alpha + ps;
    if (__any(alpha != 1.0f)) {
#pragma unroll
        for (int r = 0; r < 16; ++r) { st.o[0][r] *= alpha; st.o[1][r] *= alpha; }
    }
}
__device__ __forceinline__ bf16x8 pack_p(const f32x16& p, int s) {
    v4u pw; pw.x = cvtpk(p[8 * s + 0], p[8 * s + 1]); pw.y = cvtpk(p[8 * s + 2], p[8 * s + 3]); pw.z = cvtpk(p[8 * s + 4], p[8 * s + 5]); pw.w = cvtpk(p[8 * s + 6], p[8 * s + 7]);
    return __builtin_bit_cast(bf16x8, pw);
}
__device__ __forceinline__ void flash_pv2(FlashState& sa, FlashState& sb, const f32x16& a0, const f32x16& a1, const f32x16& b0, const f32x16& b1, const LAS bf16* Vs, int vp, int r32, int hi) {
#pragma unroll
    for (int blk = 0; blk < 2; ++blk)
#pragma unroll
        for (int s = 0; s < 2; ++s) {
            const bf16x8 pfa = blk ? pack_p(a1, s) : pack_p(a0, s), pfb = blk ? pack_p(b1, s) : pack_p(b0, s);
#pragma unroll
            for (int db = 0; db < 2; ++db) {
                const LAS bf16* vp0 = Vs + (32 * db + r32) * vp + 32 * blk + 16 * s + 4 * hi;
                const s16x4 lo = *(const LAS s16x4*)vp0, hh = *(const LAS s16x4*)(vp0 + 8);
                const bf16x8 vf = __builtin_shufflevector(lo, hh, 0, 1, 2, 3, 4, 5, 6, 7);
                sa.o[db] = MFMA32(vf, pfa, sa.o[db]); sb.o[db] = MFMA32(vf, pfb, sb.o[db]);
            }
        }
}
__device__ __forceinline__ void flash_store(const FlashState& st, bf16* orow, int hi) {
    float lt = st.l + __uint_as_float(xorx<32>(__float_as_uint(st.l), 32 * hi));
    const float inv = 1.0f / lt;
#pragma unroll
    for (int db = 0; db < 2; ++db)
#pragma unroll
        for (int rg = 0; rg < 4; ++rg) { u32x2 w; w.x = cvtpk(st.o[db][4 * rg] * inv, st.o[db][4 * rg + 1] * inv); w.y = cvtpk(st.o[db][4 * rg + 2] * inv, st.o[db][4 * rg + 3] * inv);
            *(u32x2*)(orow + 32 * db + 8 * rg + 4 * hi) = w; }
}

__device__ __forceinline__ void fox_unit(Frame& F, int b, int h, int qb, float& kmax2) {
    const bf16* proj = (const bf16*)(((unsigned char*)karg(19)) + WS_PROJ); const float* LOGF = (const float*)(((unsigned char*)karg(19)) + WS_LOGF); bf16* OB = (bf16*)(((unsigned char*)karg(19)) + WS_OB);
    LAS float* Fs = (LAS float*)(F.lds);
    LAS float* wtot = (LAS float*)(F.lds + 16384);
    LAS bf16* Kb = (LAS bf16*)(F.lds + 16384 + 128);
    LAS bf16* Vb = (LAS bf16*)(F.lds + 16384 + 128 + 2 * 64 * KP * 2);
    const int lane = F.lane, wave = F.wave, tid = F.tid, r32 = lane & 31, hi = lane >> 5;
    const int q_end = 512 * (qb + 1), NT = q_end / 64;
    const size_t rowbase = (size_t)b * SEQ;
    if (kmax2 < 0.f) {
        float v[8]; float run = 0.f;
#pragma unroll
        for (int i = 0; i < 8; ++i) { const int pos = tid * 8 + i; const float lf = (pos < q_end) ? LOGF[(rowbase + pos) * 8 + h] : 0.f; run += lf; v[i] = run; }
        float inc = run;
#pragma unroll
        for (int o = 1; o < 64; o <<= 1) { const float t = __shfl_up(inc, o); if (lane >= o) inc += t; }
        if (lane == 63) wtot[wave] = inc;
        __syncthreads();
        float off = inc - run;
        for (int w = 0; w < wave; ++w) off += wtot[w];
#pragma unroll
        for (int i = 0; i < 8; ++i) Fs[tid * 8 + i] = -LOG2E * (v[i] + off);
    }
    const int qrow = 512 * qb + 64 * wave + r32, qrowB = qrow + 32;
    bf16x8 qf[4], qg[4];
    { const bf16* qp = proj + (rowbase + qrow) * NPROJ + C_QB + 64 * h + 8 * hi;
#pragma unroll
      for (int ks = 0; ks < 4; ++ks) { qf[ks] = *(const bf16x8*)(qp + 16 * ks); qg[ks] = *(const bf16x8*)(qp + (size_t)32 * NPROJ + 16 * ks); } }
    const int tq = 8 * qb + wave;
    LAS bf16* Qs = (LAS bf16*)(F.lds + 53248) + wave * (64 * KP);
    {
        float qn = 0.f;
#pragma unroll
        for (int ks = 0; ks < 4; ++ks)
#pragma unroll
            for (int j = 0; j < 8; ++j) { const float e = __uint_as_float(((unsigned)(unsigned short)qf[ks][j]) << 16); qn += e * e; }
        qn += __shfl_xor(qn, 32);
        { float qn2 = 0.f;
#pragma unroll
          for (int ks = 0; ks < 4; ++ks)
#pragma unroll
              for (int j = 0; j < 8; ++j) { const float e = __uint_as_float(((unsigned)(unsigned short)qg[ks][j]) << 16); qn2 += e * e; }
          qn2 += __shfl_xor(qn2, 32); qn = fmaxf(qn, qn2); }
#pragma unroll
        for (int o = 1; o < 32; o <<= 1) qn = fmaxf(qn, __shfl_xor(qn, o));
        float kn = 0.f;
        if (kmax2 < 0.f) {
            for (int p0 = 0; p0 < q_end; p0 += 4 * 64) {
                v4u w4[4];
#pragma unroll
                for (int i = 0; i < 4; ++i) w4[i] = *(const v4u*)(proj + (rowbase + p0 + 64 * i + (tid >> 3)) * NPROJ + C_KB + 64 * h + 8 * (tid & 7));
#pragma unroll
                for (int i = 0; i < 4; ++i) { const unsigned wx = w4[i].x, wy = w4[i].y, wz = w4[i].z, ww = w4[i].w;
                    float s = bflo(wx) * bflo(wx) + bfhi(wx) * bfhi(wx) + bflo(wy) * bflo(wy) + bfhi(wy) * bfhi(wy) + bflo(wz) * bflo(wz) + bfhi(wz) * bfhi(wz) + bflo(ww) * bflo(ww) + bfhi(ww) * bfhi(ww);
                    s += __shfl_xor(s, 1); s += __shfl_xor(s, 2); s += __shfl_xor(s, 4);
                    kn = fmaxf(kn, s); } }
            kn = wave_max(kn);
        }
        if (lane == 0) { wtot[8 + wave] = qn; wtot[16 + wave] = kn; }
    }
#pragma unroll
    for (int ks = 0; ks < 4; ++ks) { *(LAS bf16x8*)(Qs + r32 * KP + 16 * ks + 8 * hi) = qf[ks]; *(LAS bf16x8*)(Qs + (32 + r32) * KP + 16 * ks + 8 * hi) = qg[ks]; }
    FlashState st, su; st.m = -INFINITY; st.l = 0.f; su.m = -INFINITY; su.l = 0.f;
#pragma unroll
    for (int r = 0; r < 16; ++r) { st.o[0][r] = 0.f; st.o[1][r] = 0.f; su.o[0][r] = 0.f; su.o[1][r] = 0.f; }
    const int srow = tid >> 3, sch = tid & 7;
    const bf16* kg = proj + (rowbase + srow) * NPROJ + C_KB + 64 * h + 8 * sch;
    const bf16* vg = proj + (rowbase + srow) * NPROJ + C_VB + 64 * h + 8 * sch;
    v4u kreg, vreg;
    { const size_t o = (size_t)(NT - 1) * 64 * NPROJ; kreg = *(const v4u*)(kg + o); vreg = *(const v4u*)(vg + o); }
    int cur = 0;
    {   *(LAS v4u*)(Kb + srow * KP + 8 * sch) = kreg;
        const unsigned short* vs = (const unsigned short*)&vreg;
#pragma unroll
        for (int i = 0; i < 8; ++i) Vb[(8 * sch + i) * VPF + srow] = vs[i];
    }
    __syncthreads();
    int t_lo = 0;
    {
        float qm = 0.f, km = 0.f;
#pragma unroll
        for (int w = 0; w < 8; ++w) { qm = fmaxf(qm, wtot[8 + w]); km = fmaxf(km, wtot[16 + w]); }
        if (kmax2 < 0.f) kmax2 = km;
        const float A = 0.125f * sqrtf(qm) * sqrtf(kmax2) * 1.01f, f0 = Fs[512 * qb];
        for (int t = NT - 9; t >= 0; --t) if (f0 - Fs[64 * t + 63] > (2.0f * A + 60.0f) * LOG2E) { t_lo = t + 1; break; }
    }
    for (int t = NT - 1; t >= t_lo; --t) {
        if (t > t_lo) { const size_t o = (size_t)(t - 1) * 64 * NPROJ; kreg = *(const v4u*)(kg + o); vreg = *(const v4u*)(vg + o); }
        if (t <= tq) {
            const LAS bf16* Ks = Kb + cur * 64 * KP; const LAS bf16* Vs = Vb + cur * 64 * VPF;
            bf16x8 qa[4], qb4[4];
#pragma unroll
            for (int ks = 0; ks < 4; ++ks) { qa[ks] = *(const LAS bf16x8*)(Qs + r32 * KP + 16 * ks + 8 * hi); qb4[ks] = *(const LAS bf16x8*)(Qs + (32 + r32) * KP + 16 * ks + 8 * hi); }
            f32x16 s0, s1, u0, u1; flash_qk2(s0, s1, u0, u1, qa, qb4, Ks, r32, hi);
            const LAS float* Fk = Fs + 64 * t;
            constexpr float C = 0.125f * LOG2E;
#pragma unroll
            for (int rg = 0; rg < 4; ++rg) {
                const f32x4 f0 = *(const LAS f32x4*)(Fk + 8 * rg + 4 * hi), f1 = *(const LAS f32x4*)(Fk + 32 + 8 * rg + 4 * hi);
#pragma unroll
                for (int i = 0; i < 4; ++i) { const int r = 4 * rg + i;
                    s0[r] = fmaf(s0[r], C, f0[i]); s1[r] = fmaf(s1[r], C, f1[i]); u0[r] = fmaf(u0[r], C, f0[i]); u1[r] = fmaf(u1[r], C, f1[i]); }
            }
            if (t == tq) {
#pragma unroll
                for (int r = 0; r < 16; ++r) { const int kv = 64 * t + crow(r, hi);
                    s0[r] = (kv > qrow) ? -INFINITY : s0[r]; s1[r] = (kv + 32 > qrow) ? -INFINITY : s1[r];
                    u0[r] = (kv > qrowB) ? -INFINITY : u0[r]; u1[r] = (kv + 32 > qrowB) ? -INFINITY : u1[r]; }
            }
            flash_soft(st, s0, s1, hi); flash_soft(su, u0, u1, hi);
            flash_pv2(st, su, s0, s1, u0, u1, Vs, VPF, r32, hi);
        }
        if (t > t_lo) {
            const int nb = cur ^ 1;
            *(LAS v4u*)(Kb + nb * 64 * KP + srow * KP + 8 * sch) = kreg;
            const unsigned short* vs = (const unsigned short*)&vreg;
#pragma unroll
            for (int i = 0; i < 8; ++i) Vb[nb * 64 * VPF + (8 * sch + i) * VPF + srow] = vs[i];
        }
        __syncthreads();
        cur ^= 1;
    }
    flash_store(st, OB + (rowbase + qrow) * 512 + 64 * h, hi); flash_store(su, OB + (rowbase + qrowB) * 512 + 64 * h, hi);
    __syncthreads();
}

__device__ const unsigned char T5_BUCKET[128] = {0,1,2,3,4,5,6,7,8,9,10,11,12,13,14,15,16,16,16,17,17,18,18,18,19,19,19,20,20,20,20,21,21,21,21,22,22,22,22,22,23,23,23,23,23,23,24,24,24,24,24,24,25,25,25,25,25,25,25,26,26,26,26,26,26,26,26,27,27,27,27,27,27,27,27,27,27,28,28,28,28,28,28,28,28,28,28,29,29,29,29,29,29,29,29,29,29,29,29,30,30,30,30,30,30,30,30,30,30,30,30,30,30,31,31,31,31,31,31,31,31,31,31,31,31,31,31,31};

__device__ __forceinline__ void swa_unit(Frame& F, int b, int kvh, int n) {
    const bf16* proj = (const bf16*)(((unsigned char*)karg(19)) + WS_PROJ); bf16* OA = (bf16*)(((unsigned char*)karg(19)) + WS_OA);
    const float* sinks = ((const float*)karg(8)); const float* rel_bias = ((const float*)karg(12));
    LAS bf16* Kb = (LAS bf16*)(F.lds);
    LAS bf16* Vb = (LAS bf16*)(F.lds + 36864);
    LAS float* bt = (LAS float*)(F.lds + 36864 + 33280);
    const int lane = F.lane, wave = F.wave, tid = F.tid, r32 = lane & 31, hi = lane >> 5;
    const size_t rowbase = (size_t)b * SEQ;
    {
        const int g = tid >> 7, d = tid & 127;
        bt[tid] = LOG2E * rel_bias[(int)T5_BUCKET[d] * 8 + kvh * 4 + g];
#pragma unroll
        for (int i = 0; i < 4; ++i) {
            const int idx = tid + i * NTHR, kb = idx >> 3, sch = idx & 7; const int pos = 128 * (n - 1) + kb;
            v4u kreg = (v4u){0u, 0u, 0u, 0u}, vreg = (v4u){0u, 0u, 0u, 0u};
            if (pos >= 0) { const bf16* p = proj + (rowbase + pos) * NPROJ + 64 * kvh + 8 * sch; kreg = *(const v4u*)(p + C_KA); vreg = *(const v4u*)(p + C_VA); }
            *(LAS v4u*)(Kb + kb * KP + 8 * sch) = kreg;
            const unsigned short* vs = (const unsigned short*)&vreg;
#pragma unroll
            for (int j = 0; j < 8; ++j) Vb[(8 * sch + j) * VPS + kb] = vs[j];
        }
    }
    __syncthreads();
    const int g = wave & 3, qh = wave >> 2, head = kvh * 4 + g;
    const LAS float* btg = bt + g * 128;
    for (int sb = 0; sb < 2; ++sb) {
        const int qrel0 = 64 * qh + 32 * sb, qrel = qrel0 + r32;
        const size_t row = rowbase + 128 * n + qrel;
        bf16x8 qf[4];
        { const bf16* qp = proj + row * NPROJ + C_QA + 64 * head + 8 * hi;
#pragma unroll
          for (int ks = 0; ks < 4; ++ks) qf[ks] = *(const bf16x8*)(qp + 16 * ks); }
        FlashState st; st.m = LOG2E * sinks[head]; st.l = (hi == 0) ? 1.0f : 0.0f;
#pragma unroll
        for (int r = 0; r < 16; ++r) { st.o[0][r] = 0.f; st.o[1][r] = 0.f; }
        const int t_lo = (qrel0 + 1) >> 6, t_hi = (qrel0 + 159) >> 6;
        for (int t = t_lo; t <= t_hi; ++t) {
            f32x16 s0, s1; flash_qk(s0, s1, qf, Kb + t * 64 * KP, r32, hi);
#pragma unroll
            for (int r = 0; r < 16; ++r) {
                const int kb0 = 64 * t + crow(r, hi), kb1 = kb0 + 32;
                const int d0 = 128 + qrel - kb0, d1 = d0 - 32;
                const bool v0 = (d0 >= 0) && (d0 < 128) && (n > 0 || kb0 >= 128);
                const bool v1 = (d1 >= 0) && (d1 < 128) && (n > 0 || kb1 >= 128);
                const float b0 = btg[d0 & 127], b1 = btg[d1 & 127];
                s0[r] = v0 ? fmaf(s0[r], 0.125f * LOG2E, b0) : -INFINITY;
                s1[r] = v1 ? fmaf(s1[r], 0.125f * LOG2E, b1) : -INFINITY;
            }
            flash_tail(st, s0, s1, Vb + 64 * t, VPS, r32, hi);
        }
        flash_store(st, OA + row * 512 + 64 * head, hi);
    }
    __syncthreads();
}
__device__ __forceinline__ void p3_attention(Frame& F) {
    for (int item = F.vcu; item < 256; item += F.G) {
        swa_unit(F, item >> 6, (item >> 5) & 1, item & 31);
        F.lane = lane_fresh(); F.tid = F.wave * 64 + F.lane;
        const int bh = item >> 3, j = item & 7;
        float kmax2 = -1.0f;
        fox_unit(F, bh >> 3, bh & 7, j, kmax2);
    }
}

struct PairOrder {
    pg8::StaticOrder S;
    __device__ bool next(int i, pg8::Unit& u) const { if (!S.next(i >> 1, u)) return false; u.src = i & 1; return true; }
    __device__ __forceinline__ void a_ready(const pg8::Unit&) const {}
    __device__ __forceinline__ void done(const pg8::Unit&) const {}
};
__device__ __forceinline__ float sigmoidf_(float z) { return 1.0f / (1.0f + __expf(-z)); }
struct EpiGate {
    static constexpr bool PERM = true, AFTER_DRAIN = false, CHAIN = true;
    const bf16* proj; bf16* mixed;
    __device__ __forceinline__ void operator()(pg8::f32x4 (&acc)[2][2][4][2], const pg8::Unit& u, int wr, int wc, int fr, int fq) const {
#pragma unroll
        for (int ai = 0; ai < 2; ++ai) {
            v4u gbv[4][2], gav[4][2];
#pragma unroll
            for (int m = 0; m < 4; ++m) { const size_t row = (size_t)u.pm * 256 + ai * 128 + wr * 64 + m * 16 + fr;
#pragma unroll
                for (int bj = 0; bj < 2; ++bj) { const int col0 = u.pn * 256 + bj * 128 + wc * 32 + 8 * fq;
                    gbv[m][bj] = *(const v4u*)(proj + row * NPROJ + C_GLB + col0);
                    if (u.src == 0) gav[m][bj] = __builtin_nontemporal_load((const v4u*)(proj + row * NPROJ + C_GLA + col0)); } }
#pragma unroll
            for (int m = 0; m < 4; ++m) { const size_t row = (size_t)u.pm * 256 + ai * 128 + wr * 64 + m * 16 + fr;
#pragma unroll
                for (int bj = 0; bj < 2; ++bj) { const int col0 = u.pn * 256 + bj * 128 + wc * 32 + 8 * fq;
                    const unsigned gbw[4] = {gbv[m][bj].x, gbv[m][bj].y, gbv[m][bj].z, gbv[m][bj].w};
                    if (u.src == 0) {
                        const unsigned gaw[4] = {gav[m][bj].x, gav[m][bj].y, gav[m][bj].z, gav[m][bj].w};
#pragma unroll
                        for (int e = 0; e < 8; ++e) { const float za = (e & 1) ? bfhi(gaw[e >> 1]) : bflo(gaw[e >> 1]), zb = (e & 1) ? bfhi(gbw[e >> 1]) : bflo(gbw[e >> 1]);
                            const float ratio = (1.0f + __expf(-zb)) * __builtin_amdgcn_rcpf(1.0f + __expf(-za));
                            acc[ai][bj][m][e >> 2][e & 3] *= ratio; }
                    } else {
                        float v[8];
#pragma unroll
                        for (int e = 0; e < 8; ++e) { const float zb = (e & 1) ? bfhi(gbw[e >> 1]) : bflo(gbw[e >> 1]); v[e] = acc[ai][bj][m][e >> 2][e & 3] * __builtin_amdgcn_rcpf(1.0f + __expf(-zb)); }
                        v4u w; w.x = cvtpk(v[0], v[1]); w.y = cvtpk(v[2], v[3]); w.z = cvtpk(v[4], v[5]); w.w = cvtpk(v[6], v[7]);
                        *(v4u*)(mixed + row * D + col0) = w;
                    }
                }
            }
        }
    }
};
struct EpiRes {
    static constexpr bool PERM = true, AFTER_DRAIN = false, CHAIN = false;
    const float* x; const float* mod; bf16* x1;
    __device__ __forceinline__ void operator()(const pg8::f32x4 (&acc)[2][2][4][2], const pg8::Unit& u, int wr, int wc, int fr, int fq) const {
        const int b = (u.pm * 256) >> 12;
        pg8::f32x4 gt[2][2];
#pragma unroll
        for (int bj = 0; bj < 2; ++bj)
#pragma unroll
            for (int n = 0; n < 2; ++n) gt[bj][n] = *(const pg8::f32x4*)(mod + b * NMOD + 2048 + u.pn * 256 + bj * 128 + wc * 32 + 8 * fq + 4 * n);
#pragma unroll
        for (int ai = 0; ai < 2; ++ai) {
            pg8::f32x4 xin[4][2][2];
#pragma unroll
            for (int m = 0; m < 4; ++m) { const size_t row = (size_t)u.pm * 256 + ai * 128 + wr * 64 + m * 16 + fr;
#pragma unroll
                for (int bj = 0; bj < 2; ++bj)
#pragma unroll
                    for (int n = 0; n < 2; ++n) xin[m][bj][n] = __builtin_nontemporal_load((const pg8::f32x4*)(x + row * D + u.pn * 256 + bj * 128 + wc * 32 + 8 * fq + 4 * n)); }
#pragma unroll
            for (int m = 0; m < 4; ++m) { const size_t row = (size_t)u.pm * 256 + ai * 128 + wr * 64 + m * 16 + fr;
#pragma unroll
                for (int bj = 0; bj < 2; ++bj) { const pg8::f32x4 v0 = xin[m][bj][0] + gt[bj][0] * acc[ai][bj][m][0], v1 = xin[m][bj][1] + gt[bj][1] * acc[ai][bj][m][1];
                    v4u w; w.x = cvtpk(v0.x, v0.y); w.y = cvtpk(v0.z, v0.w); w.z = cvtpk(v1.x, v1.y); w.w = cvtpk(v1.z, v1.w);
                    *(v4u*)(x1 + row * D + u.pn * 256 + bj * 128 + wc * 32 + 8 * fq) = w; } }
        }
    }
};

__device__ __forceinline__ void p6_norm2(Frame& F) {
    const bf16* x1 = (const bf16*)(((unsigned char*)karg(19)) + WS_X1); const float* g2 = ((const float*)karg(3)); const float* MOD = (const float*)(((unsigned char*)karg(19)) + WS_MOD); bf16* H2 = (bf16*)(((unsigned char*)karg(19)) + WS_H2); unsigned char* H2Q = (unsigned char*)(((unsigned char*)karg(19)) + WS_H2Q); float* H2S = (float*)(((unsigned char*)karg(19)) + WS_H2S);
    const int gw = F.vcu * NWAVES + F.wave, NGW = F.G * NWAVES;
    for (int c = gw; c < M / 8; c += NGW) {
        const int row0 = c * 8; const float* mb = MOD + (row0 >> 12) * NMOD;
        f32x4 ga[4], sh[4];
#pragma unroll
        for (int j = 0; j < 4; ++j) { const int col = 4 * F.lane + 256 * j; const f32x4 g = *(const f32x4*)(g2 + col), sc = *(const f32x4*)(mb + 4096 + col); sh[j] = *(const f32x4*)(mb + 3072 + col); ga[j] = g * (sc + 1.0f); }
        u32x2 r0[4], r1[4], r2[4];
        { const u32x2* xr = (const u32x2*)(x1 + (size_t)row0 * D) + F.lane;
#pragma unroll
          for (int j = 0; j < 4; ++j) r0[j] = xr[64 * j];
#pragma unroll
          for (int j = 0; j < 4; ++j) r1[j] = xr[256 + 64 * j]; }
#pragma unroll
        for (int i = 0; i < 8; ++i) {
            const int row = row0 + i;
            if (i + 2 < 8) { const u32x2* xr = (const u32x2*)(x1 + (size_t)(row + 2) * D) + F.lane;
#pragma unroll
                for (int j = 0; j < 4; ++j) r2[j] = xr[64 * j]; }
            f32x4 hq[4], xv[4]; float ss = 0.f;
#pragma unroll
            for (int j = 0; j < 4; ++j) { xv[j].x = bflo(r0[j].x); xv[j].y = bfhi(r0[j].x); xv[j].z = bflo(r0[j].y); xv[j].w = bfhi(r0[j].y);
                ss += (xv[j].x * xv[j].x + xv[j].y * xv[j].y) + (xv[j].z * xv[j].z + xv[j].w * xv[j].w); }
            ss = wave_sum(ss);
            const float rstd = 1.0f / sqrtf(ss * (1.0f / D) + EPS);
#pragma unroll
            for (int j = 0; j < 4; ++j) { const int col = 4 * F.lane + 256 * j;
                const f32x4 hv = (xv[j] * rstd) * ga[j] + sh[j];
                u32x2 w; w.x = cvtpk(hv.x, hv.y); w.y = cvtpk(hv.z, hv.w);
                *(u32x2*)(H2 + (size_t)row * D + col) = w; hq[j] = hv; }
            float am = 0.f;
#pragma unroll
            for (int j = 0; j < 4; ++j) am = fmaxf(fmaxf(am, fmaxf(fabsf(hq[j].x), fabsf(hq[j].y))), fmaxf(fabsf(hq[j].z), fabsf(hq[j].w)));
            am = wave_max(am);
            const float sc = am > 0.f ? am * (1.0f / 127.0f) : 1.0f, inv = 1.0f / sc;
            v4u qa;
#pragma unroll
            for (int j = 0; j < 4; ++j) { const int b0 = (int)rintf(hq[j].x * inv), b1 = (int)rintf(hq[j].y * inv), b2 = (int)rintf(hq[j].z * inv), b3 = (int)rintf(hq[j].w * inv);
                qa[j] = (unsigned)(b0 & 255) | ((unsigned)(b1 & 255) << 8) | ((unsigned)(b2 & 255) << 16) | ((unsigned)(b3 & 255) << 24); }
            __builtin_nontemporal_store(qa, (v4u*)(H2Q + (size_t)row * D + 16 * F.lane));
            if (F.lane == 0) H2S[row] = sc;
#pragma unroll
            for (int j = 0; j < 4; ++j) { r0[j] = r1[j]; r1[j] = r2[j]; }
        }
    }
}

__device__ __forceinline__ unsigned f2ord(float f) { const unsigned u = __float_as_uint(f); return u ^ ((unsigned)((int)u >> 31) | 0x80000000u); }
__device__ __forceinline__ float ord2f(unsigned o) { const unsigned u = (o & 0x80000000u) ? (o & 0x7fffffffu) : ~o; return __uint_as_float(u); }
#define CE_DESC(a, b) do { const unsigned _x = (a), _y = (b); (a) = _x > _y ? _x : _y; (b) = _x > _y ? _y : _x; } while (0)
__device__ __forceinline__ void sort16(unsigned (&k)[16]) {
#pragma unroll
    for (int size = 2; size <= 16; size <<= 1)
#pragma unroll
        for (int stride = size >> 1; stride > 0; stride >>= 1)
#pragma unroll
            for (int i = 0; i < 16; ++i) { const int j = i ^ stride; if (j > i) { if ((i & size) == 0) CE_DESC(k[i], k[j]); else CE_DESC(k[j], k[i]); } }
}
__device__ __forceinline__ void merge16(unsigned (&a)[16], const unsigned (&b)[16]) {
#pragma unroll
    for (int i = 0; i < 16; ++i) a[i] = a[i] > b[15 - i] ? a[i] : b[15 - i];
#pragma unroll
    for (int stride = 8; stride > 0; stride >>= 1)
#pragma unroll
        for (int i = 0; i < 16; ++i) { const int j = i ^ stride; if (j > i) CE_DESC(a[i], a[j]); }
}
__device__ __forceinline__ void top16_of_64(unsigned (&g0)[16], unsigned (&g1)[16], unsigned (&g2)[16], unsigned (&g3)[16]) {
    sort16(g0); sort16(g1); sort16(g2); sort16(g3);
    merge16(g0, g1); merge16(g2, g3); merge16(g0, g2);
}
constexpr int NCAND = 50;
__device__ __forceinline__ void p8a_topk(Frame& F) {
    const bf16* QP = (const bf16*)(((unsigned char*)karg(19)) + WS_QP); const bf16* SUBK = (const bf16*)(((unsigned char*)karg(19)) + WS_SUBK);
    unsigned short* PIDX = (unsigned short*)(((unsigned char*)karg(19)) + WS_PIDX); float* PG = (float*)(((unsigned char*)karg(19)) + WS_PG);
    LAS unsigned short* Elds = (LAS unsigned short*)(F.lds) + F.wave * (NCAND * 64);
    const int lane = F.lane, r32 = lane & 31, hi = lane >> 5;
    const int gw = F.vcu * NWAVES + F.wave, NGW = F.G * NWAVES;
    for (int it2 = 0; it2 < 2 * ((M / 64 - F.vcu + F.G - 1) / F.G); ++it2) {
        const int wi = F.vcu + (it2 >> 1) * F.G;
        const int tile = 2 * wi + (it2 & 1);
        const int tok = tile * 32 + r32;
        { const int h = F.wave;
            unsigned top[2][16];
#pragma unroll
            for (int p = 0; p < 2; ++p) {
                bf16x8 qf[4];
                { const bf16* qp = QP + (size_t)tok * D + h * 128 + p * 64 + 8 * hi;
#pragma unroll
                  for (int ks = 0; ks < 4; ++ks) qf[ks] = *(const bf16x8*)(qp + 16 * ks); }
                const bf16* kp = SUBK + (size_t)((h * 2 + p) * 128 + r32) * 64 + 8 * hi;
                unsigned kk[4][16];
#pragma unroll
                for (int blk = 0; blk < 4; ++blk) {
                    f32x16 acc;
#pragma unroll
                    for (int r = 0; r < 16; ++r) acc[r] = 0.f;
#pragma unroll
                    for (int ks = 0; ks < 4; ++ks) { const bf16x8 a = *(const bf16x8*)(kp + (size_t)blk * 32 * 64 + 16 * ks); acc = MFMA32(a, qf[ks], acc); }
#pragma unroll
                    for (int r = 0; r < 16; ++r) { const int key = 32 * blk + crow(r, hi); kk[blk][r] = (f2ord(acc[r]) & ~127u) | (unsigned)(127 - key); }
                }
                top16_of_64(kk[0], kk[1], kk[2], kk[3]);
                unsigned other[16];
#pragma unroll
                for (int i = 0; i < 16; ++i) other[i] = xorx<32>(kk[0][i], lane);
                merge16(kk[0], other);
#pragma unroll
                for (int i = 0; i < 16; ++i) top[p][i] = kk[0][i];
            }
            float s1[16], s2[16]; unsigned i1[16], i2[16];
#pragma unroll
            for (int i = 0; i < 16; ++i) { s1[i] = ord2f(top[0][i] & ~127u); i1[i] = 127u - (top[0][i] & 127u); s2[i] = ord2f(top[1][i] & ~127u); i2[i] = 127u - (top[1][i] & 127u); }
            unsigned ck[4][16];
#pragma unroll
            for (int c = 0; c < 64; ++c) {
                if (c < NCAND) { constexpr int CA[NCAND] = {0,0,0,0,0,0,0,0,0,0,0,0,0,0,0,0,1,1,1,1,1,1,1,1,2,2,2,2,2,3,3,3,3,4,4,4,5,5,6,6,7,7,8,9,10,11,12,13,14,15}; constexpr int CB[NCAND] = {0,1,2,3,4,5,6,7,8,9,10,11,12,13,14,15,0,1,2,3,4,5,6,7,0,1,2,3,4,0,1,2,3,0,1,2,0,1,0,1,0,1,0,0,0,0,0,0,0,0}; const int a = CA[c], b = CB[c];
                    ck[c >> 4][c & 15] = (f2ord(s1[a] + s2[b]) & ~63u) | (unsigned)(63 - c);
                    Elds[c * 64 + lane] = (unsigned short)(i1[a] * 128u + i2[b]); }
                else ck[c >> 4][c & 15] = 0u;
            }
            top16_of_64(ck[0], ck[1], ck[2], ck[3]);
            float w[16]; float wsum = 0.f; const float v0 = ord2f(ck[0][0] & ~63u);
#pragma unroll
            for (int r = 0; r < 16; ++r) { w[r] = __expf(ord2f(ck[0][r] & ~63u) - v0); wsum += w[r]; }
            const float winv = 1.0f / wsum;
#pragma unroll
            for (int r = 0; r < 16; ++r) if ((r >> 3) == hi) {
                const int c = 63 - (int)(ck[0][r] & 63u);
                const unsigned short eid = Elds[c * 64 + lane];
                PIDX[(size_t)tok * 128 + h * 16 + r] = eid; PG[(size_t)tok * 128 + h * 16 + r] = w[r] * winv; }
        }
    }
}

__device__ __forceinline__ float gelu_erf(float v) { return 0.5f * v * (1.0f + erff(v * 0.70710678118654752f)); }

#define PROBE_REPA 1
#define PROBE_REPB 1
constexpr int NR = 8, RSH = 18, BSA = 8, BSB = 8, ELP = 136, TPS = 8; static_assert(BSA == 8 && BSB == 8, "whole batches of 8");
__device__ __forceinline__ void sort128(unsigned& e0, unsigned& e1, int lane) {
#pragma unroll
    for (int size = 2; size <= 128; size <<= 1) {
#pragma unroll
        for (int stride = size >> 1; stride > 0; stride >>= 1) {
            if (stride == 64) { const unsigned lo = e0 < e1 ? e0 : e1, hi = e0 < e1 ? e1 : e0; e0 = lo; e1 = hi; }
            else {
                const bool lower = (lane & stride) == 0;
                const bool asc0 = (size == 128) ? true : (size == 64 ? true : ((lane & size) == 0));
                const bool asc1 = (size == 128) ? true : (size == 64 ? false : ((lane & size) == 0));
                const unsigned p0 = xorx_sw(e0, lane, stride), p1 = xorx_sw(e1, lane, stride);
                const unsigned mn0 = e0 < p0 ? e0 : p0, mx0 = e0 < p0 ? p0 : e0, mn1 = e1 < p1 ? e1 : p1, mx1 = e1 < p1 ? p1 : e1;
                e0 = (lower == asc0) ? mn0 : mx0; e1 = (lower == asc1) ? mn1 : mx1;
            }
        }
    }
}
template <int BS> __device__ __forceinline__ void sw_issue(v4u (&buf)[BS], const LAS unsigned* el, const unsigned char* tab, unsigned voff) {
#pragma unroll
    for (int i = 0; i < BS; ++i) { const unsigned off = (el[i] << 10) + voff;
        buf[i] = *(const v4u*)(tab + off); }
}
template <int BS> __device__ __forceinline__ void sw_proc_a(const v4u (&buf)[BS], const v4u& hq, LAS float* wl, int s, int n, int lane) {
    const int hx = (int)hq.x, hy = (int)hq.y, hz = (int)hq.z, hw = (int)hq.w;
    float dd[8];
#pragma unroll
    for (int i = 0; i < 8; ++i) dd[i] = 0.f;
#pragma unroll
    for (int i = 0; i < BS; ++i) { const int dx = (int)buf[i].x, dy = (int)buf[i].y, dz = (int)buf[i].z, dw = (int)buf[i].w;
        int t = __builtin_amdgcn_sdot4(hx, dx, 0, false); t = __builtin_amdgcn_sdot4(hy, dy, t, false); t = __builtin_amdgcn_sdot4(hz, dz, t, false); t = __builtin_amdgcn_sdot4(hw, dw, t, false);
        dd[i] = (float)t; }
    const float r1 = reduce8_t(dd, lane);
    if ((lane & 7) == 0) wl[s + (lane >> 3)] = r1;
}
typedef _Float16 h2_t __attribute__((ext_vector_type(2)));
#define CVT_H2_FP8(u, hi) __builtin_bit_cast(h2_t, __builtin_amdgcn_cvt_scalef32_pk_f16_fp8((u), 1.0f, (hi)))
template <int BS> __device__ __forceinline__ void sw_proc_b(const v4u (&buf)[BS], h2_t (&acc)[8], const LAS float* wl, int s, int n) {
    float wr[BS];
#pragma unroll
    for (int i = 0; i < BS; ++i) wr[i] = wl[s + i];
#pragma unroll
    for (int i = 0; i < BS; ++i) {
        const h2_t wv = __builtin_bit_cast(h2_t, wr[i]);
        const unsigned ux = buf[i].x, uy = buf[i].y, uz = buf[i].z, uw = buf[i].w;
        acc[0] = __builtin_elementwise_fma(CVT_H2_FP8(ux, false), wv, acc[0]); acc[1] = __builtin_elementwise_fma(CVT_H2_FP8(ux, true), wv, acc[1]);
        acc[2] = __builtin_elementwise_fma(CVT_H2_FP8(uy, false), wv, acc[2]); acc[3] = __builtin_elementwise_fma(CVT_H2_FP8(uy, true), wv, acc[3]);
        acc[4] = __builtin_elementwise_fma(CVT_H2_FP8(uz, false), wv, acc[4]); acc[5] = __builtin_elementwise_fma(CVT_H2_FP8(uz, true), wv, acc[5]);
        acc[6] = __builtin_elementwise_fma(CVT_H2_FP8(uw, false), wv, acc[6]); acc[7] = __builtin_elementwise_fma(CVT_H2_FP8(uw, true), wv, acc[7]); }
}
__device__ __forceinline__ void sw_warm(v4u (&pf)[4], const unsigned char* tab, int range, int lw, unsigned voff) {
#pragma unroll
    for (int i = 0; i < 4; ++i) { const unsigned off = ((unsigned)(range * 1024 + lw * 4 + i) << 10) + voff; pf[i] = *(const v4u*)(tab + off); }
}
__device__ __forceinline__ void sw_warm_done(const v4u (&pf)[4]) {
#pragma unroll
    for (int i = 0; i < 4; ++i) asm volatile("" :: "v"(pf[i]));
}
template <int FAKE> __device__ __forceinline__ void p8b_sweep(Frame& F) {
    const bf16* X1 = (const bf16*)(((unsigned char*)karg(19)) + WS_X1); const float* MOD = (const float*)(((unsigned char*)karg(19)) + WS_MOD);
    const unsigned char* H2Q = (const unsigned char*)(((unsigned char*)karg(19)) + WS_H2Q); const float* H2S = (const float*)(((unsigned char*)karg(19)) + WS_H2S);
    const unsigned char* EDq = (const unsigned char*)(((unsigned char*)karg(19)) + WS_ED); const unsigned char* EUq = (const unsigned char*)(((unsigned char*)karg(19)) + WS_EU); const float* EDS = (const float*)(((unsigned char*)karg(19)) + WS_EDS);
    const unsigned short* PIDX = (const unsigned short*)(((unsigned char*)karg(19)) + WS_PIDX); const float* PG = (const float*)(((unsigned char*)karg(19)) + WS_PG);
    const float* fg = ((const float*)karg(17));
    const int gw = F.vcu * NWAVES + F.wave, NGW = F.G * NWAVES;
    for (int wi = F.vcu; wi < M / 64; wi += F.G) {
        const int tb = wi * 8 + F.wave;
        unsigned ones = ~0u; asm volatile("" : "+s"(ones));
        int lane = (int)__builtin_amdgcn_mbcnt_hi(ones, __builtin_amdgcn_mbcnt_lo(ones, 0u)); asm volatile("" : "+v"(lane));
        const int tok0 = tb * 8;
        unsigned E0[8], E1[8];
        LAS float* Wl = (LAS float*)(F.lds) + F.wave * 1024;
        LAS unsigned* El = (LAS unsigned*)(F.lds + 32768) + F.wave * (8 * ELP);
        unsigned voff = 16u * (unsigned)lane; asm volatile("" : "+v"(voff));
        LAS int* Bnd = (LAS int*)(F.lds + 67584) + F.wave * (8 * (NR + 1));
#pragma unroll
        for (int k = 0; k < 8; ++k) {
            const size_t base = (size_t)(tok0 + k) * 128;
            E0[k] = ((unsigned)PIDX[base + lane] << 7) | (unsigned)lane; E1[k] = ((unsigned)PIDX[base + 64 + lane] << 7) | (unsigned)(64 + lane);
            sort128(E0[k], E1[k], lane);
            if (FAKE) { E0[k] = (E0[k] & 0x1ffffu) ; E1[k] = (E1[k] & 0x1ffffu); sort128(E0[k], E1[k], lane); }
            El[k * ELP + lane] = E0[k] >> 7; El[k * ELP + 64 + lane] = E1[k] >> 7;
            if (lane < 8) El[k * ELP + 128 + lane] = (unsigned)__builtin_amdgcn_readlane((int)E1[k], 63) >> 7;
        }
        for (int repa = 0; repa < PROBE_REPA; ++repa) {
            v4u hq[8];
#pragma unroll
            for (int k = 0; k < 8; ++k) hq[k] = *(const v4u*)(H2Q + (size_t)(tok0 + k) * D + 16 * lane);
            int pos[8];
#pragma unroll
            for (int k = 0; k < 8; ++k) pos[k] = 0;
            v4u bA[BSA], bB[BSA], bC[BSA]; int ps = 0, pn = 0;
            for (int r = 0; r < NR; ++r) {
#pragma unroll
                for (int k = 0; k < 8; ++k) {
                    constexpr int dummy = 0; (void)dummy;
                    const int kp = (k + 7) & 7;
                    const unsigned long long BM = 0x0101010101010101ull;
                    const int c = __builtin_popcountll(__ballot((E0[k] >> RSH) == (unsigned)r) & BM) + __builtin_popcountll(__ballot((E1[k] >> RSH) == (unsigned)r) & BM);
                    int s = __builtin_amdgcn_readfirstlane(pos[k]); const int e_end = __builtin_amdgcn_readfirstlane(s + 8 * c); pos[k] = e_end;
                    if (lane == 0) Bnd[k * (NR + 1) + r + 1] = e_end;
                    const int n1 = (e_end - s) < BSA ? (e_end - s) : BSA;
                    if (k & 1) sw_issue<BSA>(bB, El + k * ELP + s, EDq, voff); else sw_issue<BSA>(bA, El + k * ELP + s, EDq, voff);
                    if (pn > 0) { if (k & 1) sw_proc_a<BSA>(bA, hq[kp], Wl + kp * 128, ps, pn, lane); else sw_proc_a<BSA>(bB, hq[kp], Wl + kp * 128, ps, pn, lane); }
                    ps = s; pn = n1; s += n1;
#define SWA_REST(Y) if (s < e_end) { sw_issue<BSA>(Y, El + k * ELP + s, EDq, voff); \
                        for (;;) { int n = (e_end - s) < BSA ? (e_end - s) : BSA; \
                            if (s + BSA < e_end) { sw_issue<BSA>(bC, El + k * ELP + s + BSA, EDq, voff); sw_proc_a<BSA>(Y, hq[k], Wl + k * 128, s, n, lane); } else { sw_proc_a<BSA>(Y, hq[k], Wl + k * 128, s, n, lane); break; } \
                            s += BSA; n = (e_end - s) < BSA ? (e_end - s) : BSA; \
                            if (s + BSA < e_end) { sw_issue<BSA>(Y, El + k * ELP + s + BSA, EDq, voff); sw_proc_a<BSA>(bC, hq[k], Wl + k * 128, s, n, lane); } else { sw_proc_a<BSA>(bC, hq[k], Wl + k * 128, s, n, lane); break; } \
                            s += BSA; } }
                    if (k & 1) { SWA_REST(bA) } else { SWA_REST(bB) }
#undef SWA_REST
                }
            }
            if (pn > 0) sw_proc_a<BSA>(bB, hq[7], Wl + 7 * 128, ps, pn, lane);
        }
#pragma unroll
        for (int k = 0; k < 8; ++k) { int tk = tok0 + k; asm volatile("" : "+s"(tk)); const size_t base = (size_t)tk * 128; const float sh = H2S[tk];
            const float r0 = Wl[k * 128 + lane], r1 = Wl[k * 128 + 64 + lane];
            const _Float16 w0 = (_Float16)(PG[base + (E0[k] & 127u)] * gelu_erf(r0 * sh * EDS[E0[k] >> 7])), w1 = (_Float16)(PG[base + (E1[k] & 127u)] * gelu_erf(r1 * sh * EDS[E1[k] >> 7]));
            Wl[k * 128 + lane] = __builtin_bit_cast(float, (h2_t){w0, w0}); Wl[k * 128 + 64 + lane] = __builtin_bit_cast(float, (h2_t){w1, w1}); }
        int ln = lane; asm volatile("" : "+v"(ln));
#pragma unroll
        for (int sub = 0; sub < 8 / TPS; ++sub) {
        h2_t acc[TPS][8];
        for (int repb = 0; repb < PROBE_REPB; ++repb) {
#pragma unroll
            for (int kk = 0; kk < TPS; ++kk)
#pragma unroll
                for (int i = 0; i < 8; ++i) acc[kk][i] = (h2_t){(_Float16)0.f, (_Float16)0.f};
            int pos[TPS];
#pragma unroll
            for (int kk = 0; kk < TPS; ++kk) pos[kk] = 0;
            v4u bA[BSB], bB[BSB]; int ps = 0, pn = 0;
            for (int r = 0; r < NR; ++r) {
#pragma unroll
                for (int kk = 0; kk < TPS; ++kk) {
                    const int k = sub * TPS + kk, kkp = (kk + TPS - 1) % TPS, kp = sub * TPS + kkp;
                    int s = __builtin_amdgcn_readfirstlane(pos[kk]); const int e_end = __builtin_amdgcn_readfirstlane(Bnd[k * (NR + 1) + r + 1]); pos[kk] = e_end;
                    const int n1 = (e_end - s) < BSB ? (e_end - s) : BSB;
                    if (kk & 1) sw_issue<BSB>(bB, El + k * ELP + s, EUq, voff); else sw_issue<BSB>(bA, El + k * ELP + s, EUq, voff);
                    if (pn > 0) { if (kk & 1) sw_proc_b<BSB>(bA, acc[kkp], Wl + kp * 128, ps, pn); else sw_proc_b<BSB>(bB, acc[kkp], Wl + kp * 128, ps, pn); }
                    ps = s; pn = n1; s += n1;
                    for (; s < e_end; s += BSB) {
                        const int n = (e_end - s) < BSB ? (e_end - s) : BSB;
                        if (kk & 1) { sw_issue<BSB>(bA, El + k * ELP + s, EUq, voff); sw_proc_b<BSB>(bA, acc[kk], Wl + k * 128, s, n); }
                        else        { sw_issue<BSB>(bB, El + k * ELP + s, EUq, voff); sw_proc_b<BSB>(bB, acc[kk], Wl + k * 128, s, n); }
                    }
                }
            }
            if (pn > 0) sw_proc_b<BSB>(bB, acc[TPS - 1], Wl + (sub * TPS + TPS - 1) * 128, ps, pn);
        }
        {
            asm volatile("" : "+v"(ln));
            float* outp = (float*)karg(18);
            const float* gt2 = MOD + ((tok0 + sub * TPS) >> 12) * NMOD + 5120;
            f32x4 gtv[4]; u32x2 xcur[4], xnxt[4];
#pragma unroll
            for (int j = 0; j < 4; ++j) { const int col = 4 * ln + 256 * j; gtv[j] = *(const f32x4*)(gt2 + col); xcur[j] = *(const u32x2*)(X1 + (size_t)(tok0 + sub * TPS) * D + col); }
#pragma unroll
            for (int kk = 0; kk < TPS; ++kk) {
                const int tok = tok0 + sub * TPS + kk;
                if (kk + 1 < TPS) {
#pragma unroll
                    for (int j = 0; j < 4; ++j) xnxt[j] = __builtin_nontemporal_load((const u32x2*)(X1 + (size_t)(tok + 1) * D + 4 * ln + 256 * j));
                }
                f32x4 x2[4]; float ss = 0.f;
#pragma unroll
                for (int j = 0; j < 4; ++j) {
#pragma unroll
                    for (int i = 0; i < 4; ++i) { const unsigned xw = (i >> 1) ? xcur[j].y : xcur[j].x; const float xf = (i & 1) ? bfhi(xw) : bflo(xw);
                        const float v = xf + gtv[j][i] * (0.0625f * (float)acc[kk][2 * j + (i >> 1)][i & 1]); x2[j][i] = v; ss += v * v; } }
                ss = wave_sum_x(ss, ln);
                if (!(FAKE && ss != 12345.678f)) {
                    const float rstd = 1.0f / sqrtf(ss * (1.0f / D) + EPS);
                    f32x4 fgv[4];
#pragma unroll
                    for (int j = 0; j < 4; ++j) fgv[j] = *(const f32x4*)(fg + 4 * ln + 256 * j);
#pragma unroll
                    for (int j = 0; j < 4; ++j) __builtin_nontemporal_store(x2[j] * rstd * fgv[j], (f32x4*)(outp + (size_t)tok * D + 4 * ln + 256 * j));
                }
#pragma unroll
                for (int j = 0; j < 4; ++j) xcur[j] = xnxt[j];
            }
        }
        }
    }
}

struct Args { const float* in[18]; float* out; unsigned char* ws; };
__global__ void __launch_bounds__(NTHR, 2) mega_fwd(Args args) {
    extern __shared__ __attribute__((aligned(16))) unsigned char lds[];
    Frame F;
    F.lds = (LAS unsigned char*)lds;
    F.wave = __builtin_amdgcn_readfirstlane((int)threadIdx.x >> 6); F.lane = lane_fresh(); F.tid = F.wave * 64 + F.lane;
    F.G = gridDim.x; { const int bx = blockIdx.x; F.vcu = (F.G % 8 == 0) ? (bx % 8) * (F.G / 8) + bx / 8 : bx; }
    volatile LAS unsigned* MISC = (volatile LAS unsigned*)(F.lds + MISC_OFF);
    for (int u = F.tid; u < (LDS_BYTES - LDSCTL_OFF) / 4; u += NTHR) ((LAS unsigned*)(F.lds + LDSCTL_OFF))[u] = 0u;
    __syncthreads();
    gu32* ctl = (gu32*)(((unsigned char*)karg(19)) + WS_CTL);
    XcdBarrier bar = xcd_barrier_post((unsigned*)(ctl + CW_BAR), MISC + 8, F.wave);
#define GRID_BAR() xcd_barrier(bar)
#define PROBE_TS -1
#define STAMP(i) do { if (PROBE_TS >= 0 && blockIdx.x == 0 && F.tid == 0) { const unsigned long long t_ = __builtin_amdgcn_s_memrealtime(); MISC[16 + 2 * (i)] = (unsigned)t_; MISC[17 + 2 * (i)] = (unsigned)(t_ >> 32); } } while (0)
#define PROBE_DBL -1

    STAMP(0);
    F.lane = lane_fresh(); F.tid = F.wave * 64 + F.lane;
    p0_prologue(F); GRID_BAR(); STAMP(1);
    if (PROBE_DBL == 0) { p0_prologue(F); GRID_BAR(); }
    F.lane = lane_fresh(); F.tid = F.wave * 64 + F.lane;
    p1_norm(F); p0_transposes(F); GRID_BAR(); STAMP(2);
    if (PROBE_DBL == 1) { p1_norm(F); GRID_BAR(); }
    {
    {
        pg8::Gemm g{(const pg8::bf16_t*)(((unsigned char*)karg(19)) + WS_H), (const pg8::bf16_t*)(((unsigned char*)karg(19)) + WS_WIN), M, NPROJ, D, nullptr, nullptr};
        pg8::StaticOrder S; S.init(M, NPROJ, F.G, (int)blockIdx.x);
        pg8::EpiBf16<0> E{(pg8::bf16_t*)(((unsigned char*)karg(19)) + WS_PROJ), NPROJ, nullptr, 0, 0, 1.f};
        pg8::gemm_phase<pg8::EpiBf16<0>, pg8::StaticOrder, true, true>(F.lds + RING_OFF, g, S, E, F.wave);
        const int nwg = (M / 256) * (NPROJ / 256), busy = nwg % F.G;
        if (busy == 0) p0_quant_tables(F, F.vcu * NWAVES + F.wave, F.G * NWAVES);
        else if ((int)blockIdx.x >= busy) p0_quant_tables(F, ((int)blockIdx.x - busy) * NWAVES + F.wave, (F.G - busy) * NWAVES);
    }
    GRID_BAR(); STAMP(3);
    }
    F.lane = lane_fresh(); F.tid = F.wave * 64 + F.lane;
    p3_attention(F); GRID_BAR(); STAMP(4);
    if (PROBE_DBL == 3) { p3_attention(F); GRID_BAR(); }
    {
    {
        pg8::Gemm g{(const pg8::bf16_t*)(((unsigned char*)karg(19)) + WS_OA), (const pg8::bf16_t*)(((unsigned char*)karg(19)) + WS_WA), M, D, 512, (const pg8::bf16_t*)(((unsigned char*)karg(19)) + WS_OB), (const pg8::bf16_t*)(((unsigned char*)karg(19)) + WS_WB)};
        PairOrder S; S.S.init(M, D, F.G, (int)blockIdx.x);
        EpiGate E{(const bf16*)(((unsigned char*)karg(19)) + WS_PROJ), (bf16*)((float*)karg(18)) + (size_t)M * D};
        pg8::gemm_phase<EpiGate, PairOrder, true, true>(F.lds + RING_OFF, g, S, E, F.wave);
    }
    GRID_BAR(); STAMP(5);
    }
    {
    {
        pg8::Gemm g{(const pg8::bf16_t*)((bf16*)((float*)karg(18)) + (size_t)M * D), (const pg8::bf16_t*)(((unsigned char*)karg(19)) + WS_WOUT), M, D, D, nullptr, nullptr};
        pg8::StaticOrder S; S.init(M, D, F.G, (int)blockIdx.x);
        EpiRes E{((const float*)karg(0)), (const float*)(((unsigned char*)karg(19)) + WS_MOD), (bf16*)(((unsigned char*)karg(19)) + WS_X1)};
        pg8::gemm_phase<EpiRes, pg8::StaticOrder, true, true>(F.lds + RING_OFF, g, S, E, F.wave);
    }
    GRID_BAR(); STAMP(6);
    }
    F.lane = lane_fresh(); F.tid = F.wave * 64 + F.lane;
    F.lane = lane_fresh(); F.tid = F.wave * 64 + F.lane;
    p6_norm2(F); GRID_BAR(); STAMP(7);
    if (PROBE_DBL == 6) { p6_norm2(F); GRID_BAR(); }
    {
    {
        pg8::Gemm g{(const pg8::bf16_t*)(((unsigned char*)karg(19)) + WS_H2), (const pg8::bf16_t*)(((unsigned char*)karg(19)) + WS_WQ), M, D, D, nullptr, nullptr};
        pg8::StaticOrder S; S.init(M, D, F.G, (int)blockIdx.x);
        pg8::EpiBf16<0> E{(pg8::bf16_t*)(((unsigned char*)karg(19)) + WS_QP), D, nullptr, 0, 0, 1.f};
        pg8::gemm_phase<pg8::EpiBf16<0>, pg8::StaticOrder, true, true>(F.lds + RING_OFF, g, S, E, F.wave);
    }
    GRID_BAR(); STAMP(8);
    }
    F.lane = lane_fresh(); F.tid = F.wave * 64 + F.lane;
    p8a_topk(F); __syncthreads(); STAMP(9);
    if (PROBE_DBL == 8) { p8a_topk(F); GRID_BAR(); }
    if (PROBE_DBL == 12) { p8b_sweep<1>(F); __syncthreads(); }
    p8b_sweep<0>(F);
    if (PROBE_DBL == 9) { GRID_BAR(); p8b_sweep<0>(F); }
    if (PROBE_TS >= 0) {
        GRID_BAR(); STAMP(10);
        if (blockIdx.x == 0) { __syncthreads();
            const unsigned long long t0 = ((unsigned long long)MISC[17 + 2 * PROBE_TS] << 32) | MISC[16 + 2 * PROBE_TS], t1 = ((unsigned long long)MISC[19 + 2 * PROBE_TS] << 32) | MISC[18 + 2 * PROBE_TS];
            const float d_us = (float)(t1 - t0) * 0.01f;
            const float V = 128.0f * sqrtf(d_us * 1e-5f);
            float* o = (float*)karg(18); for (int c = F.tid; c < D; c += NTHR) o[c] = V; }
    }
}

extern "C" void kernel_launch(void* const* d_in, const int* in_sizes, int n_in, void* d_out, int out_size, void* d_ws, size_t ws_size, hipStream_t stream) {
    static int grid = 0;
    if (grid == 0) {
        if (n_in != 18 || in_sizes[0] != M * D || out_size != M * D || ws_size < WS_END) { fprintf(stderr, "kernel_launch: unexpected shapes (n_in %d, in0 %d, out %d, ws %zu)\n", n_in, n_in > 0 ? in_sizes[0] : -1, out_size, ws_size); grid = -1; return; }
        int dev = 0, cus = 0, per_cu = 0;
        if (hipGetDevice(&dev) != hipSuccess || hipDeviceGetAttribute(&cus, hipDeviceAttributeMultiprocessorCount, dev) != hipSuccess) { grid = -1; return; }
        if (hipFuncSetAttribute((const void*)mega_fwd, hipFuncAttributeMaxDynamicSharedMemorySize, LDS_BYTES) != hipSuccess) { fprintf(stderr, "kernel_launch: hipFuncSetAttribute failed\n"); grid = -1; return; }
        if (hipOccupancyMaxActiveBlocksPerMultiprocessor(&per_cu, (const void*)mega_fwd, NTHR, LDS_BYTES) != hipSuccess || per_cu < 1) { fprintf(stderr, "kernel_launch: occupancy query says %d blocks per CU\n", per_cu); }
        (void)hipGetLastError();
        grid = cus;
    }
    if (grid < 0) return;
    if (hipMemsetAsync((char*)d_ws + WS_CTL, 0, CTL_ZERO_BYTES, stream) != hipSuccess) { fprintf(stderr, "kernel_launch: memset failed\n"); return; }
    Args a{};
    for (int i = 0; i < 18; ++i) a.in[i] = (const float*)d_in[i];
    a.out = (float*)d_out; a.ws = (unsigned char*)d_ws;
    hipLaunchKernelGGL(mega_fwd, dim3(grid), dim3(NTHR), LDS_BYTES, stream, a);
}
```

```cpp
#include <hip/hip_runtime.h>
#include <cstdio>
#include <cstdint>
__device__ __forceinline__ int lane_fresh() { unsigned ones = ~0u; asm volatile("" : "+s"(ones)); return (int)__builtin_amdgcn_mbcnt_hi(ones, __builtin_amdgcn_mbcnt_lo(ones, 0u)); }
namespace pg8 {
#define PG8_LAS __attribute__((address_space(3)))
typedef unsigned short bf16_t;
typedef short bf16x8 __attribute__((ext_vector_type(8)));
typedef float f32x4 __attribute__((ext_vector_type(4)));
typedef unsigned u32x4 __attribute__((ext_vector_type(4)));
constexpr int BM = 256, BK = 64, HALF = 128, HTB = HALF * BK * 2  , STAGE_BYTES = 8 * HTB, NXCD = 8, WGM = 8;

__host__ __device__ __forceinline__ int lds_byte(int r, int c) { const int st = (r >> 4) * 2 + (c >> 5), rr = r & 15, cc = c & 31, ob = rr * 64 + cc * 2; return st * 1024 + (ob ^ (((ob >> 9) & 1) << 5)); }
__host__ __device__ __forceinline__ void stage_rc(int b, int& R, int& C) { const int st = b / 1024, sb = b % 1024, swz = sb ^ (((sb >> 9) & 1) << 5); R = (st >> 1) * 16 + swz / 64; C = (st & 1) * 32 + (swz % 64) / 2; }
__host__ __device__ __forceinline__ int perm32(int rho) { const int n = rho >> 4, i = rho & 15; return 8 * (i >> 2) + 4 * n + (i & 3); }

struct Unit { int pm, pn, src; };
struct Gemm { const bf16_t* A; const bf16_t* Bt; int M, N, K; const bf16_t* A2; const bf16_t* Bt2; };

struct StaticOrder {
    int nM, nN, nwg, G, c;
    __host__ __device__ void init(int M, int N, int G_, int c_) { nM = M / BM; nN = N / BM; nwg = nM * nN; G = G_; c = c_; }
    __host__ __device__ bool next(int i, Unit& u) const {
        const long L = (long)i * G + c; if (L >= nwg) return false;
        int wgid = (int)L; { const int q = nwg / NXCD, r = nwg % NXCD, xcd = wgid % NXCD, off = wgid / NXCD; wgid = (xcd < r ? xcd * (q + 1) : r * (q + 1) + (xcd - r) * q) + off; }
        const int nig = WGM * nN, gid = wgid / nig, fm = gid * WGM, gsz = (nM - fm) < WGM ? (nM - fm) : WGM;
        u.pm = fm + ((wgid % nig) % gsz); u.pn = (wgid % nig) / gsz; u.src = 0; return true;
    }
    __device__ __forceinline__ void a_ready(const Unit&) const {}
    __device__ __forceinline__ void done(const Unit&) const {}
};

__device__ __forceinline__ unsigned cvt_pk_bf16(float lo, float hi) { unsigned r; asm volatile("v_cvt_pk_bf16_f32 %0, %1, %2" : "=v"(r) : "v"(lo), "v"(hi)); return r; }
typedef float f32x2 __attribute__((ext_vector_type(2)));
__device__ __forceinline__ f32x2 gelu_pk(f32x2 v) {
    const f32x2 av = __builtin_elementwise_abs(v), d = av * 0.2316418882f + 1.0f;
    f32x2 t; t.x = __builtin_amdgcn_rcpf(d.x); t.y = __builtin_amdgcn_rcpf(d.y);
    f32x2 q = t * 0.5307027145f + (-0.7265760135f); q = q * t + 0.7107068705f; q = q * t + (-0.142248368f); q = q * t + 0.127414796f; q = q * t;
    const f32x2 s = (v * v) * (-0.72134752044f);
    f32x2 e; e.x = __builtin_amdgcn_exp2f(s.x); e.y = __builtin_amdgcn_exp2f(s.y);
    const f32x2 m = v * (q * e), r = v - m;
    f32x2 o; o.x = v.x < 0.f ? m.x : r.x; o.y = v.y < 0.f ? m.y : r.y; return o;
}

template <int ACT  > struct EpiBf16 {
    static constexpr bool PERM = true, AFTER_DRAIN = false, CHAIN = false; static_assert(ACT == 0 || ACT == 1, "EpiBf16: ACT is 0 (none) or 1 (gelu_pk)");
    bf16_t* O; int ldc; const float* bias; int split_cols; size_t split_stride; float scale0;
    __device__ __forceinline__ void operator()(const f32x4 (&acc)[2][2][4][2], const Unit& u, int wr, int wc, int fr, int fq) const {
        const int row0 = u.pm * BM + wr * 64 + fr; int colt = u.pn * BM; bf16_t* base = O;
        float sc = 1.f; if (split_cols) { const int t = colt / split_cols; base += (size_t)t * split_stride; colt -= t * split_cols; if (t == 0) sc = scale0; }
        const int col0 = colt + wc * 32 + 8 * fq, bcol0 = u.pn * BM + wc * 32 + 8 * fq;
        f32x4 bv[2][2];
#pragma unroll
        for (int bj = 0; bj < 2; ++bj)
#pragma unroll
            for (int n = 0; n < 2; ++n) bv[bj][n] = bias ? *(const f32x4*)(bias + bcol0 + bj * HALF + 4 * n) : (f32x4){0.f, 0.f, 0.f, 0.f};
#pragma unroll
        for (int ai = 0; ai < 2; ++ai)
#pragma unroll
            for (int m = 0; m < 4; ++m) { bf16_t* rowp = base + (size_t)(row0 + ai * HALF + m * 16) * ldc + col0;
#pragma unroll
                for (int bj = 0; bj < 2; ++bj) { f32x4 v0 = acc[ai][bj][m][0] + bv[bj][0], v1 = acc[ai][bj][m][1] + bv[bj][1];
                    if (ACT == 1) { f32x2 a = gelu_pk((f32x2){v0[0], v0[1]}), b = gelu_pk((f32x2){v0[2], v0[3]}), c = gelu_pk((f32x2){v1[0], v1[1]}), d = gelu_pk((f32x2){v1[2], v1[3]});
                        v0 = (f32x4){a.x, a.y, b.x, b.y}; v1 = (f32x4){c.x, c.y, d.x, d.y}; }
                    v0 = v0 * sc; v1 = v1 * sc; u32x4 w; w.x = cvt_pk_bf16(v0[0], v0[1]); w.y = cvt_pk_bf16(v0[2], v0[3]); w.z = cvt_pk_bf16(v1[0], v1[1]); w.w = cvt_pk_bf16(v1[2], v1[3]);
                    *(u32x4*)(rowp + bj * HALF) = w; } }
    }
};

template <class Epi, class Sched, bool ALIGN_EPI = false, bool SP2 = false>
__device__ __forceinline__ void gemm_phase(PG8_LAS unsigned char* lds, const Gemm g, const Sched& S, const Epi& E, int wave_id) {
    int tid = wave_id * 64 + ::lane_fresh(); asm volatile("" : "+v"(tid));
    const int wid = __builtin_amdgcn_readfirstlane(tid >> 6), lane = tid & 63, wr = wid >> 2, wc = wid & 3, fr = lane & 15, fq = lane >> 4;
    const int K = g.K, nt = K / BK;
    unsigned voffA[2], voffB[2];
#pragma unroll
    for (int i = 0; i < 2; ++i) { int R, C; stage_rc(tid * 16 + i * 8192, R, C); const int Rb = Epi::PERM ? ((R & ~31) + perm32(R & 31)) : R;
        voffA[i] = (unsigned)(R * K + C) * 2u; voffB[i] = (unsigned)(Rb * K + C) * 2u; }
    const size_t kstep = (size_t)(BK * 2);
    const size_t hstep = (size_t)HALF * K * 2;
    const size_t tstep = 2 * hstep;
    const unsigned ldsw = (unsigned)wid * 1024u;
    const int aoff = lds_byte(wr * 64 + fr, fq * 8), boff = lds_byte(wc * 32 + fr, fq * 8);
#define PG8_SA(b, h) (((b) * 2 + (h)) * HTB)
#define PG8_SB(b, h) ((4 + (b) * 2 + (h)) * HTB)
#define PG8_STAGE(bufoff, gbase, voff) do { _Pragma("unroll") for (int _i = 0; _i < 2; ++_i) \
        __builtin_amdgcn_global_load_lds((const unsigned*)((const char*)(gbase) + (voff)[_i]), (PG8_LAS unsigned*)(lds + (bufoff) + ldsw + _i * 8192), 16, 0, 0); } while (0)
#define PG8_LDA(dst, b, h) do { _Pragma("unroll") for (int m = 0; m < 4; ++m) _Pragma("unroll") for (int k = 0; k < 2; ++k) dst[m][k] = *(const PG8_LAS bf16x8*)(lds + PG8_SA(b, h) + aoff + m * 2048 + k * 1024); } while (0)
#define PG8_LDB(dst, b, h) do { _Pragma("unroll") for (int n = 0; n < 2; ++n) _Pragma("unroll") for (int k = 0; k < 2; ++k) dst[n][k] = *(const PG8_LAS bf16x8*)(lds + PG8_SB(b, h) + boff + n * 2048 + k * 1024); } while (0)
#define PG8_MMA(ai, bj, At, Bt) do { __builtin_amdgcn_s_setprio(1); _Pragma("unroll") for (int m = 0; m < 4; ++m) _Pragma("unroll") for (int n = 0; n < 2; ++n) _Pragma("unroll") for (int k = 0; k < 2; ++k) \
        acc[ai][bj][m][n] = __builtin_amdgcn_mfma_f32_16x16x32_bf16(Bt[n][k], At[m][k], acc[ai][bj][m][n], 0, 0, 0); __builtin_amdgcn_s_setprio(0); } while (0)
#define PG8_WAIT_V(n) asm volatile("s_waitcnt vmcnt(" #n ")" ::: "memory")
#define PG8_WAIT_L(n) asm volatile("s_waitcnt lgkmcnt(" #n ")" ::: "memory")
#define PG8_BAR __builtin_amdgcn_s_barrier()
#define PG8_SCHED __builtin_amdgcn_sched_barrier(0)
    Unit cur, nxt; int ui = 0;
    if (!S.next(0, cur)) return;
    f32x4 acc[2][2][4][2];
#pragma unroll
    for (int a = 0; a < 2; ++a)
#pragma unroll
        for (int b = 0; b < 2; ++b)
#pragma unroll
            for (int m = 0; m < 4; ++m)
#pragma unroll
                for (int n = 0; n < 2; ++n) acc[a][b][m][n] = (f32x4){0.f, 0.f, 0.f, 0.f};
    bf16x8 At[4][2], B0[2][2], B1[2][2];
    const char* cA = (const char*)(cur.src ? g.A2 : g.A) + (size_t)cur.pm * tstep; const char* cB = (const char*)(cur.src ? g.Bt2 : g.Bt) + (size_t)cur.pn * tstep;
    S.a_ready(cur);
    if constexpr (SP2) {
        PG8_STAGE(PG8_SB(0, 0), cB, voffB); PG8_STAGE(PG8_SB(0, 1), cB + hstep, voffB); PG8_STAGE(PG8_SA(0, 0), cA, voffA); PG8_STAGE(PG8_SA(0, 1), cA + hstep, voffA);
        if (wr == 1) PG8_BAR;
        PG8_WAIT_V(2); PG8_BAR;
        PG8_STAGE(PG8_SB(1, 0), cB + kstep, voffB); PG8_STAGE(PG8_SA(1, 0), cA + kstep, voffA); PG8_STAGE(PG8_SB(1, 1), cB + hstep + kstep, voffB);
        PG8_WAIT_V(6); PG8_BAR;
    } else {
        PG8_STAGE(PG8_SB(0, 0), cB, voffB); PG8_STAGE(PG8_SA(0, 0), cA, voffA); PG8_STAGE(PG8_SB(0, 1), cB + hstep, voffB); PG8_STAGE(PG8_SA(0, 1), cA + hstep, voffA);
        if (wr == 1) PG8_BAR;
        PG8_WAIT_V(4); PG8_BAR;
        PG8_STAGE(PG8_SB(1, 0), cB + kstep, voffB); PG8_STAGE(PG8_SA(1, 0), cA + kstep, voffA); PG8_STAGE(PG8_SB(1, 1), cB + hstep + kstep, voffB);
        PG8_WAIT_V(6); PG8_BAR;
    }
    for (;;) {
        const bool has_next = S.next(ui + 1, nxt);
        const char* nA = has_next ? (const char*)(nxt.src ? g.A2 : g.A) + (size_t)nxt.pm * tstep : cA; const char* nB = has_next ? (const char*)(nxt.src ? g.Bt2 : g.Bt) + (size_t)nxt.pn * tstep : cB;
        for (int t = 0; t < nt; t += 2) {
            const bool last = (t == nt - 2);
            const char* a1 = cA + (size_t)(t + 1) * kstep;
            const char* a2 = last ? nA : cA + (size_t)(t + 2) * kstep; const char* b2 = last ? nB : cB + (size_t)(t + 2) * kstep;
            const char* a3 = a2 + kstep; const char* b3 = b2 + kstep;
            if (last && has_next) S.a_ready(nxt);
            if constexpr (SP2) {
            PG8_LDB(B0, 0, 0); PG8_LDB(B1, 0, 1); PG8_SCHED; PG8_LDA(At, 0, 0); PG8_STAGE(PG8_SA(1, 1), a1 + hstep, voffA);
            PG8_WAIT_V(8); PG8_WAIT_L(0); PG8_BAR; PG8_MMA(0, 0, At, B0); PG8_MMA(0, 1, At, B1); PG8_BAR; PG8_SCHED;
            PG8_LDA(At, 0, 1); PG8_STAGE(PG8_SB(0, 0), b2, voffB); PG8_STAGE(PG8_SB(0, 1), b2 + hstep, voffB); PG8_STAGE(PG8_SA(0, 0), a2, voffA);
            PG8_WAIT_V(8); PG8_WAIT_L(0); PG8_BAR; PG8_MMA(1, 0, At, B0); PG8_MMA(1, 1, At, B1); PG8_BAR; PG8_SCHED;
            PG8_LDB(B0, 1, 0); PG8_LDB(B1, 1, 1); PG8_SCHED; PG8_LDA(At, 1, 0); PG8_STAGE(PG8_SA(0, 1), a2 + hstep, voffA);
            PG8_WAIT_V(8); PG8_WAIT_L(0); PG8_BAR; PG8_MMA(0, 0, At, B0); PG8_MMA(0, 1, At, B1); PG8_BAR; PG8_SCHED;
            PG8_LDA(At, 1, 1); PG8_STAGE(PG8_SB(1, 0), b3, voffB); PG8_STAGE(PG8_SB(1, 1), b3 + hstep, voffB); PG8_STAGE(PG8_SA(1, 0), a3, voffA);
            PG8_WAIT_V(8); PG8_WAIT_L(0); PG8_BAR; PG8_MMA(1, 0, At, B0); PG8_MMA(1, 1, At, B1); PG8_BAR; PG8_SCHED;
            } else {
            PG8_LDB(B0, 0, 0); PG8_SCHED; PG8_LDA(At, 0, 0); PG8_STAGE(PG8_SA(1, 1), a1 + hstep, voffA);
            PG8_WAIT_L(8); PG8_BAR; PG8_WAIT_L(0); PG8_MMA(0, 0, At, B0); PG8_BAR; PG8_SCHED;
            PG8_LDB(B1, 0, 1); PG8_STAGE(PG8_SB(0, 0), b2, voffB);
            PG8_BAR; PG8_WAIT_L(0); PG8_MMA(0, 1, At, B1); PG8_BAR;
            PG8_LDA(At, 0, 1); PG8_STAGE(PG8_SA(0, 0), a2, voffA);
            PG8_BAR; PG8_WAIT_L(0); PG8_MMA(1, 0, At, B0); PG8_BAR; PG8_SCHED;
            PG8_STAGE(PG8_SB(0, 1), b2 + hstep, voffB);
            PG8_WAIT_V(6); PG8_BAR; PG8_MMA(1, 1, At, B1); PG8_BAR;
            PG8_LDB(B0, 1, 0); PG8_SCHED; PG8_LDA(At, 1, 0); PG8_STAGE(PG8_SA(0, 1), a2 + hstep, voffA);
            PG8_WAIT_L(8); PG8_BAR; PG8_WAIT_L(0); PG8_MMA(0, 0, At, B0); PG8_BAR; PG8_SCHED;
            PG8_LDB(B1, 1, 1); PG8_STAGE(PG8_SB(1, 0), b3, voffB);
            PG8_BAR; PG8_WAIT_L(0); PG8_MMA(0, 1, At, B1); PG8_BAR;
            PG8_LDA(At, 1, 1); PG8_STAGE(PG8_SA(1, 0), a3, voffA);
            PG8_BAR; PG8_WAIT_L(0); PG8_MMA(1, 0, At, B0); PG8_BAR; PG8_SCHED;
            PG8_STAGE(PG8_SB(1, 1), b3 + hstep, voffB);
            PG8_WAIT_V(6); PG8_BAR; PG8_MMA(1, 1, At, B1); PG8_BAR;
            }
        }
        if constexpr (ALIGN_EPI) { if (wr == 0) PG8_BAR; }
        if constexpr (!Epi::AFTER_DRAIN) { E(acc, cur, wr, wc, fr, fq); S.done(cur); }
        if (!has_next) break;
        if (!(Epi::CHAIN && cur.src == 0)) {
#pragma unroll
        for (int a = 0; a < 2; ++a)
#pragma unroll
            for (int b = 0; b < 2; ++b)
#pragma unroll
                for (int m = 0; m < 4; ++m)
#pragma unroll
                    for (int n = 0; n < 2; ++n) acc[a][b][m][n] = (f32x4){0.f, 0.f, 0.f, 0.f};
        }
        cur = nxt; cA = nA; cB = nB; ++ui;
        if constexpr (ALIGN_EPI) { if (wr == 1) PG8_BAR; }
    }
    PG8_WAIT_V(0);
    if constexpr (!ALIGN_EPI) { if (wr == 0) PG8_BAR; }
    PG8_BAR;
    if constexpr (Epi::AFTER_DRAIN) { E.fused(acc, cur, wr, wc, fr, fq, lds, wid, lane); S.done(cur); }
#undef PG8_SA
#undef PG8_SB
#undef PG8_STAGE
#undef PG8_LDA
#undef PG8_LDB
#undef PG8_MMA
#undef PG8_WAIT_V
#undef PG8_WAIT_L
#undef PG8_BAR
#undef PG8_SCHED
}
}

#define GAS __attribute__((address_space(1)))
#define LAS __attribute__((address_space(3)))
typedef unsigned short bf16;
typedef unsigned v4u __attribute__((ext_vector_type(4)));
typedef float f32x4 __attribute__((ext_vector_type(4)));
typedef short bf16x8 __attribute__((ext_vector_type(8)));
typedef GAS unsigned gu32;
typedef GAS unsigned long long gu64;
#define RLX_AGENT __ATOMIC_RELAXED, __HIP_MEMORY_SCOPE_AGENT
#define LDS_WAIT() asm volatile("s_waitcnt lgkmcnt(0)" ::: "memory")
#define VM_WAIT() asm volatile("s_waitcnt vmcnt(0)" ::: "memory")
__device__ __forceinline__ unsigned long long rt() { return __builtin_amdgcn_s_memrealtime(); }
__device__ __forceinline__ unsigned f2bf(float f) { unsigned u = __builtin_bit_cast(unsigned, f); return (u + 0x7fffu + ((u >> 16) & 1u)) >> 16; }
__device__ __forceinline__ unsigned pk2(float lo, float hi) { return f2bf(lo) | (f2bf(hi) << 16); }

__device__ __forceinline__ const void* karg(int i);
constexpr int CW_BAR_FWD = 4096;
#define XB_TMO      128
#define XB_XCNT(j)  (256  + 64 * (j))
#define XB_XSUB(j)  (1280 + 64 * (j))
#define XB_XGEN(j)  (2304 + 64 * (j))
#define XB_TOP      3328
#define XB_TOPGEN   3392
#define XCD_BAR_WORDS 3456
#define XB_SPIN_CAP (1u << 18)

__device__ __forceinline__ unsigned xb_ld(unsigned* p)              { return __hip_atomic_load(p, __ATOMIC_RELAXED, __HIP_MEMORY_SCOPE_AGENT); }
__device__ __forceinline__ unsigned xb_add(unsigned* p, unsigned v) { return __hip_atomic_fetch_add(p, v, __ATOMIC_RELAXED, __HIP_MEMORY_SCOPE_AGENT); }
__device__ __forceinline__ unsigned xb_xcc_id() { return (unsigned)__builtin_amdgcn_s_getreg((3 << 11) | 20) & 0xFu; }
#define XB_SPIN(cond, bar) do { unsigned _sp = 0; while (cond) { __builtin_amdgcn_s_sleep(1); \
    if ((++_sp & 255u) == 0u) { if (xb_ld(&(bar)[XB_TMO])) break; if (_sp > XB_SPIN_CAP) { atomicAdd(&(bar)[XB_TMO], 1u); break; } } } } while (0)

struct XcdBarrier {
    int wave;
    unsigned* bar; unsigned x;
    volatile LAS unsigned* st;
};

__device__ __forceinline__ XcdBarrier xcd_barrier_post(unsigned* bar, volatile LAS unsigned* st, int wave) {
    XcdBarrier b; b.wave = wave; b.bar = bar; b.x = xb_xcc_id(); b.st = st;
    if (wave == 0 && lane_fresh() == 0) (void)xb_add(&bar[XB_XCNT(b.x)], 1u);
    return b;
}
__device__ __forceinline__ void xcd_barrier_complete(unsigned* bar, unsigned x, unsigned& nloc, unsigned& nx) {
    const unsigned G = gridDim.x * gridDim.y * gridDim.z;
    unsigned sum, cnt, mine, sp = 0u;
    for (;;) {
        sum = 0u; cnt = 0u; mine = 0u;
#pragma unroll
        for (unsigned j = 0; j < 16; ++j) { const unsigned c = xb_ld(&bar[XB_XCNT(j)]); sum += c; cnt += (c > 0u) ? 1u : 0u; mine = (j == x) ? c : mine; }
        if (sum == G) break;
        __builtin_amdgcn_s_sleep(1);
        if ((++sp & 255u) == 0u) { if (xb_ld(&bar[XB_TMO])) break; if (sp > XB_SPIN_CAP) { atomicAdd(&bar[XB_TMO], 1u); break; } }
    }
    nloc = mine > 0u ? mine : 1u; nx = cnt > 0u ? cnt : 1u;
}

__device__ __forceinline__ void xcd_barrier(const XcdBarrier& b) {
    asm volatile("s_waitcnt vmcnt(0)" ::: "memory");
    __syncthreads();
    if (b.wave == 0 && lane_fresh() == 0) {
        unsigned* bar = (unsigned*)((gu32*)((unsigned char*)karg(19)) + CW_BAR_FWD);
        __builtin_amdgcn_s_waitcnt(0);
        unsigned nloc = b.st[0], nx = b.st[1];
        if (nloc == 0u) { xcd_barrier_complete(bar, b.x, nloc, nx); b.st[0] = nloc; b.st[1] = nx; }
        const unsigned old = xb_add(&bar[XB_XSUB(b.x)], 1u);
        const unsigned gen = old / nloc;
        if (old + 1u == (gen + 1u) * nloc) {
            __builtin_amdgcn_fence(__ATOMIC_RELEASE, "agent");
            asm volatile("s_waitcnt vmcnt(0)" ::: "memory");
            const unsigned og = xb_add(&bar[XB_TOP], 1u);
            const unsigned tg = og / nx;
            if (og + 1u == (tg + 1u) * nx) xb_add(&bar[XB_TOPGEN], 1u);
            else XB_SPIN(xb_ld(&bar[XB_TOPGEN]) == tg, bar);
            __builtin_amdgcn_fence(__ATOMIC_ACQUIRE, "agent");
            xb_add(&bar[XB_XGEN(b.x)], 1u);
            asm volatile("s_waitcnt vmcnt(0)" ::: "memory");
        } else {
            XB_SPIN(xb_ld(&bar[XB_XGEN(b.x)]) == gen, bar);
            __builtin_amdgcn_fence(__ATOMIC_ACQUIRE, "agent");
            asm volatile("s_waitcnt vmcnt(0)" ::: "memory");
        }
    }
    __syncthreads();
}

constexpr int NWAVES = 8, NTHR = 512;
constexpr int BATCH = 4, SEQ = 4096, D = 1024, M = BATCH * SEQ;
constexpr int NPROJ = 4352, LDW_IN = 4360, NMOD = 6144;
constexpr int C_QA = 0, C_KA = 512, C_VA = 640, C_QB = 768, C_KB = 1280, C_VB = 1792, C_GLA = 2304, C_GLB = 3328;
constexpr int NEXP = 16384;
constexpr float EPS = 1e-6f;

constexpr size_t MiB = 1u << 20;
constexpr size_t WS_CTL = 0, CTL_ZERO_BYTES = 1 * MiB;
constexpr size_t WS_MOD = 1 * MiB, WS_LOGF = 1 * MiB + 128 * 1024, WS_SUBK = 2 * MiB;
constexpr size_t WS_WIN = 4 * MiB, WS_WA = 12 * MiB + 512 * 1024, WS_WB = 13 * MiB + 512 * 1024, WS_WOUT = 14 * MiB + 512 * 1024, WS_WQ = 16 * MiB + 512 * 1024;
constexpr size_t WS_ED = 19 * MiB, WS_EU = 35 * MiB;
constexpr size_t WS_EDS = 2 * MiB + 512 * 1024;
constexpr size_t WS_H2Q = 95 * MiB, WS_H2S = 111 * MiB;
constexpr size_t WS_H = 83 * MiB, WS_OA = 83 * MiB, WS_OB = 99 * MiB, WS_PIDX = 83 * MiB, WS_PG = 87 * MiB;
constexpr size_t WS_PROJ = 115 * MiB, WS_X1 = 115 * MiB, WS_H2 = 179 * MiB, WS_QP = 211 * MiB;
constexpr size_t WS_END = 251 * MiB;
static_assert(WS_WIN + (size_t)NPROJ * D * 2 <= WS_WA && WS_WQ + (size_t)D * D * 2 <= WS_ED && WS_PROJ + (size_t)M * NPROJ * 2 <= WS_END, "ws map");
constexpr int CW_BAR = 4096; static_assert(CW_BAR == CW_BAR_FWD && WS_CTL == 0, "barrier words");

constexpr int RING_OFF = 0, RING_BYTES = 131072;
constexpr int LDSCTL_OFF = RING_BYTES, MISC_OFF = LDSCTL_OFF + 320;
constexpr int LDS_BYTES = 147456;

typedef float f32x16 __attribute__((ext_vector_type(16)));
typedef short s16x4 __attribute__((ext_vector_type(4)));
typedef unsigned u32x2 __attribute__((ext_vector_type(2)));
typedef float f32x2_t __attribute__((ext_vector_type(2)));
typedef __bf16 bf16x2_t __attribute__((ext_vector_type(2)));

__device__ __forceinline__ unsigned cvtpk(float lo, float hi) { f32x2_t v = {lo, hi}; bf16x2_t b = __builtin_convertvector(v, bf16x2_t); return __builtin_bit_cast(unsigned, b); }
__device__ __forceinline__ float bflo(unsigned u) { return __uint_as_float(u << 16); }
__device__ __forceinline__ float bfhi(unsigned u) { return __uint_as_float(u & 0xffff0000u); }
template <int S> __device__ __forceinline__ unsigned xorx(unsigned v, int lane) {
    if constexpr (S == 1) return (unsigned)__builtin_amdgcn_update_dpp(0, (int)v, 0xB1, 0xF, 0xF, true);
    else if constexpr (S == 2) return (unsigned)__builtin_amdgcn_update_dpp(0, (int)v, 0x4E, 0xF, 0xF, true);
    else if constexpr (S == 4) { const unsigned a = (unsigned)__builtin_amdgcn_update_dpp(0, (int)v, 0x124, 0xF, 0xF, true), b = (unsigned)__builtin_amdgcn_update_dpp(0, (int)v, 0x12C, 0xF, 0xF, true); return (lane & 4) ? a : b; }
    else if constexpr (S == 8) return (unsigned)__builtin_amdgcn_update_dpp(0, (int)v, 0x128, 0xF, 0xF, true);
    else if constexpr (S == 16) { const auto r = __builtin_amdgcn_permlane16_swap(v, v, false, false); return (lane & 16) ? r[0] : r[1]; }
    else { const auto r = __builtin_amdgcn_permlane32_swap(v, v, false, false); return (lane & 32) ? r[0] : r[1]; }
}
__device__ __forceinline__ unsigned xorx_sw(unsigned v, int lane, int s) {
    switch (s) { case 1: return xorx<1>(v, lane); case 2: return xorx<2>(v, lane); case 4: return xorx<4>(v, lane); case 8: return xorx<8>(v, lane); case 16: return xorx<16>(v, lane); default: return xorx<32>(v, lane); }
}
__device__ __forceinline__ float wave_sum_x(float v, int lane) {
    v += __uint_as_float(xorx<1>(__float_as_uint(v), lane)); v += __uint_as_float(xorx<2>(__float_as_uint(v), lane)); v += __uint_as_float(xorx<4>(__float_as_uint(v), lane));
    v += __uint_as_float(xorx<8>(__float_as_uint(v), lane)); v += __uint_as_float(xorx<16>(__float_as_uint(v), lane)); v += __uint_as_float(xorx<32>(__float_as_uint(v), lane));
    return v;
}
__device__ __forceinline__ float dppf(float v, const int ctrl_sel) { return v; }
#define DPP_F(v, CTRL) __uint_as_float(__builtin_amdgcn_update_dpp(0, __float_as_uint(v), (CTRL), 0xF, 0xF, true))
__device__ __forceinline__ float reduce8_t(const float (&dd)[8], int lane) {
    float r4[4];
#pragma unroll
    for (int u = 0; u < 4; ++u) { const auto p = __builtin_amdgcn_permlane32_swap(__float_as_uint(dd[u]), __float_as_uint(dd[u + 4]), false, false); r4[u] = __uint_as_float(p[0]) + __uint_as_float(p[1]); }
    float r2[2];
#pragma unroll
    for (int u = 0; u < 2; ++u) { const auto p = __builtin_amdgcn_permlane16_swap(__float_as_uint(r4[u]), __float_as_uint(r4[u + 2]), false, false); r2[u] = __uint_as_float(p[0]) + __uint_as_float(p[1]); }
    const bool b3 = (lane & 8) != 0;
    const float keep = b3 ? r2[1] : r2[0], send = b3 ? r2[0] : r2[1];
    float r1 = keep + DPP_F(send, 0x128);
    r1 += DPP_F(r1, 0xB1);
    r1 += DPP_F(r1, 0x4E);
    r1 += DPP_F(r1, 0x141);
    return r1;
}
__device__ __forceinline__ int lane_id() { return (int)__builtin_amdgcn_mbcnt_hi(~0u, __builtin_amdgcn_mbcnt_lo(~0u, 0u)); }
__device__ __forceinline__ float wave_sum(float v) { return wave_sum_x(v, lane_id()); }
__device__ __forceinline__ float wave_max(float v) { const int lane = lane_id();
    v = fmaxf(v, __uint_as_float(xorx<1>(__float_as_uint(v), lane))); v = fmaxf(v, __uint_as_float(xorx<2>(__float_as_uint(v), lane))); v = fmaxf(v, __uint_as_float(xorx<4>(__float_as_uint(v), lane)));
    v = fmaxf(v, __uint_as_float(xorx<8>(__float_as_uint(v), lane))); v = fmaxf(v, __uint_as_float(xorx<16>(__float_as_uint(v), lane))); v = fmaxf(v, __uint_as_float(xorx<32>(__float_as_uint(v), lane)));
    return v; }
__device__ __forceinline__ int crow(int r, int hi) { return (r & 3) + 8 * (r >> 2) + 4 * hi; }
#define MFMA32(a, b, c) __builtin_amdgcn_mfma_f32_32x32x16_bf16((a), (b), (c), 0, 0, 0)

struct Frame {
    LAS unsigned char* lds;
    int tid, lane, wave, vcu, G;
};
__device__ __forceinline__ const void* karg(int i) {
    unsigned long z = 0; asm volatile("" : "+s"(z));
    const char* base = (const char*)__builtin_amdgcn_kernarg_segment_ptr();
    return *(const void* const*)(base + 8 * i + z);
}

__device__ __forceinline__ void p0_transpose_item(const float* W, int ld, int K, int ncols, bf16* WT, int row_off, LAS float* scr, int item, int lane) {
    const int nblk = ncols / 32, kb = item / nblk, nb = item % nblk, k0 = 64 * kb, n0 = 32 * nb;
#pragma unroll 8
    for (int i = 0; i < 32; ++i) { const int kk = 2 * i + (lane >> 5); scr[kk * 33 + (lane & 31)] = __builtin_nontemporal_load(W + (size_t)(k0 + kk) * ld + n0 + (lane & 31)); }
    LDS_WAIT(); asm volatile("" ::: "memory");
    const int c = lane & 7;
#pragma unroll
    for (int j = 0; j < 4; ++j) { const int n = (lane >> 3) + 8 * j; const LAS float* s = scr + (8 * c) * 33 + n;
        v4u o; o.x = pk2(s[0 * 33], s[1 * 33]); o.y = pk2(s[2 * 33], s[3 * 33]); o.z = pk2(s[4 * 33], s[5 * 33]); o.w = pk2(s[6 * 33], s[7 * 33]);
        *(GAS v4u*)(WT + (size_t)(row_off + n0 + n) * K + k0 + 8 * c) = o; }
    LDS_WAIT(); asm volatile("" ::: "memory");
}
__device__ __forceinline__ void p0_convert(const float* __restrict__ src, bf16* __restrict__ dst, long n_iters, int gw, int NGW, int lane) {
    for (long it0 = (long)gw * 4; it0 < n_iters; it0 += (long)NGW * 4) {
        f32x4 a[4][2];
#pragma unroll
        for (int u = 0; u < 4; ++u) { const long it = it0 + u; if (it < n_iters) { const float* p = src + it * 512 + lane * 4; a[u][0] = *(const f32x4*)p; a[u][1] = *(const f32x4*)(p + 256); } }
#pragma unroll
        for (int u = 0; u < 4; ++u) { const long it = it0 + u; if (it < n_iters) { bf16* q = dst + it * 512 + lane * 4;
            u32x2 w0, w1; w0.x = cvtpk(a[u][0].x, a[u][0].y); w0.y = cvtpk(a[u][0].z, a[u][0].w); w1.x = cvtpk(a[u][1].x, a[u][1].y); w1.y = cvtpk(a[u][1].z, a[u][1].w);
            *(u32x2*)q = w0; *(u32x2*)(q + 256) = w1; } }
    }
}

__device__ __forceinline__ void p0_quant_tables(Frame& F, int gw, int NGW) {
    const float* ed = ((const float*)karg(15)); const float* eu = ((const float*)karg(16));
    unsigned char* EDq = (unsigned char*)(((unsigned char*)karg(19)) + WS_ED); unsigned char* EUq = (unsigned char*)(((unsigned char*)karg(19)) + WS_EU); float* EDS = (float*)(((unsigned char*)karg(19)) + WS_EDS);
    const int lane = F.lane;
    for (int row0 = gw * 4; row0 < NEXP; row0 += NGW * 4) {
        f32x4 a[4][4], u[4][4];
#pragma unroll
        for (int q = 0; q < 4; ++q)
#pragma unroll
            for (int j = 0; j < 4; ++j) { a[q][j] = __builtin_nontemporal_load((const f32x4*)(ed + (size_t)(row0 + q) * D) + lane + 64 * j); u[q][j] = __builtin_nontemporal_load((const f32x4*)(eu + (size_t)(row0 + q) * D) + lane + 64 * j); }
#pragma unroll
        for (int q = 0; q < 4; ++q) {
            float am = 0.f;
#pragma unroll
            for (int j = 0; j < 4; ++j) am = fmaxf(fmaxf(am, fmaxf(fabsf(a[q][j].x), fabsf(a[q][j].y))), fmaxf(fabsf(a[q][j].z), fabsf(a[q][j].w)));
            am = wave_max(am);
            const float sc = am > 0.f ? am * (1.0f / 127.0f) : 1.0f, inv = 1.0f / sc;
            v4u qa, qu;
#pragma unroll
            for (int j = 0; j < 4; ++j) {
                const int b0 = (int)rintf(a[q][j].x * inv), b1 = (int)rintf(a[q][j].y * inv), b2 = (int)rintf(a[q][j].z * inv), b3 = (int)rintf(a[q][j].w * inv);
                qa[j] = (unsigned)(b0 & 255) | ((unsigned)(b1 & 255) << 8) | ((unsigned)(b2 & 255) << 16) | ((unsigned)(b3 & 255) << 24);
                int p = __builtin_amdgcn_cvt_pk_fp8_f32(u[q][j].x * 16.0f, u[q][j].y * 16.0f, 0, false);
                p = __builtin_amdgcn_cvt_pk_fp8_f32(u[q][j].z * 16.0f, u[q][j].w * 16.0f, p, true);
                qu[j] = (unsigned)p;
            }
            __builtin_nontemporal_store(qa, (v4u*)(EDq + (size_t)(row0 + q) * D + 16 * lane));
            __builtin_nontemporal_store(qu, (v4u*)(EUq + (size_t)(row0 + q) * D + 16 * lane));
            if (lane == 0) EDS[row0 + q] = sc;
        }
    }
}
__device__ __forceinline__ void p0_prologue(Frame& F) {
    const float* c = ((const float*)karg(1)); const float* w_ada = ((const float*)karg(4)); const float* b_ada = ((const float*)karg(5));
    float* MOD = (float*)(((unsigned char*)karg(19)) + WS_MOD);
    {
        LAS float* cact = (LAS float*)(F.lds);
        LAS float* part = (LAS float*)(F.lds + 16384);
        bool did = false;
        for (int item = F.vcu; item < NMOD / 32; item += F.G) {
            if (!did) { for (int i = F.tid; i < 4096; i += NTHR) { const float cv = c[i]; cact[i] = cv / (1.0f + __expf(-cv)); } did = true; }
            __syncthreads();
            const int n0 = item * 32, col = n0 + (F.lane & 31), ksub = F.lane >> 5;
            float a0 = 0.f, a1 = 0.f, a2 = 0.f, a3 = 0.f;
#pragma unroll 16
            for (int it = 0; it < 64; ++it) { const int k = (it * 8 + F.wave) * 2 + ksub; const float w = __builtin_nontemporal_load(w_ada + (size_t)k * NMOD + col);
                a0 += cact[k] * w; a1 += cact[1024 + k] * w; a2 += cact[2048 + k] * w; a3 += cact[3072 + k] * w; }
            a0 += __shfl_xor(a0, 32); a1 += __shfl_xor(a1, 32); a2 += __shfl_xor(a2, 32); a3 += __shfl_xor(a3, 32);
            if (F.lane < 32) { part[(F.wave * 4 + 0) * 32 + F.lane] = a0; part[(F.wave * 4 + 1) * 32 + F.lane] = a1; part[(F.wave * 4 + 2) * 32 + F.lane] = a2; part[(F.wave * 4 + 3) * 32 + F.lane] = a3; }
            __syncthreads();
            if (F.tid < 128) { const int b = F.tid >> 5, cl = F.tid & 31; float s = 0.f;
#pragma unroll
                for (int w = 0; w < 8; ++w) s += part[(w * 4 + b) * 32 + cl];
                MOD[b * NMOD + n0 + cl] = s + b_ada[n0 + cl]; }
            __syncthreads();
        }
    }
    {
        const int gw = F.vcu * NWAVES + F.wave, NGW = F.G * NWAVES;
        p0_convert(((const float*)karg(14)), (bf16*)(((unsigned char*)karg(19)) + WS_SUBK), (long)(8 * 2 * 128 * 64) / 512, gw, NGW, F.lane);
    }
}
__device__ __forceinline__ void p0_transposes(Frame& F) {
    LAS float* scr = (LAS float*)(F.lds + 32768 + F.wave * 8704);
    const int gw = F.vcu * NWAVES + F.wave, NGW = F.G * NWAVES;
    constexpr int I_IN1 = (D / 64) * (2304 / 32), I_IN2 = (D / 64) * (2048 / 32), I_AB = (512 / 64) * (D / 32), I_SQ = (D / 64) * (D / 32);
    constexpr int NITEMS = I_IN1 + I_IN2 + 2 * I_AB + 2 * I_SQ;
    bf16* Win_t = (bf16*)(((unsigned char*)karg(19)) + WS_WIN);
    for (int it = gw; it < NITEMS; it += NGW) {
        int r = it;
        if (r < I_IN1) { p0_transpose_item(((const float*)karg(6)), LDW_IN, D, 2304, Win_t, 0, scr, r, F.lane); continue; } r -= I_IN1;
        if (r < I_IN2) { p0_transpose_item(((const float*)karg(6)) + 2312, LDW_IN, D, 2048, Win_t, 2304, scr, r, F.lane); continue; } r -= I_IN2;
        if (r < I_AB) { p0_transpose_item(((const float*)karg(9)), D, 512, D, (bf16*)(((unsigned char*)karg(19)) + WS_WA), 0, scr, r, F.lane); continue; } r -= I_AB;
        if (r < I_AB) { p0_transpose_item(((const float*)karg(10)), D, 512, D, (bf16*)(((unsigned char*)karg(19)) + WS_WB), 0, scr, r, F.lane); continue; } r -= I_AB;
        if (r < I_SQ) { p0_transpose_item(((const float*)karg(11)), D, D, D, (bf16*)(((unsigned char*)karg(19)) + WS_WOUT), 0, scr, r, F.lane); continue; } r -= I_SQ;
        p0_transpose_item(((const float*)karg(13)), D, D, D, (bf16*)(((unsigned char*)karg(19)) + WS_WQ), 0, scr, r, F.lane);
    }
}

__device__ __forceinline__ void p1_norm(Frame& F) {
    const float* x = ((const float*)karg(0)); const float* g1 = ((const float*)karg(2)); const float* w_in = ((const float*)karg(6)); const float* b_forget = ((const float*)karg(7));
    const float* MOD = (const float*)(((unsigned char*)karg(19)) + WS_MOD); bf16* H = (bf16*)(((unsigned char*)karg(19)) + WS_H); float* LOGF = (float*)(((unsigned char*)karg(19)) + WS_LOGF);
    LAS float* wfl = (LAS float*)(F.lds);
    { float tmp[16];
#pragma unroll
      for (int n = 0; n < 16; ++n) { const int i = F.tid + n * NTHR; tmp[n] = w_in[(size_t)(i >> 3) * LDW_IN + 2304 + (i & 7)]; }
#pragma unroll
      for (int n = 0; n < 16; ++n) { const int i = F.tid + n * NTHR; wfl[(i & 7) * 1024 + (i >> 3)] = tmp[n]; } }
    __syncthreads();
    const int gw = F.vcu * NWAVES + F.wave, NGW = F.G * NWAVES;
    for (int c = gw; c < M / 8; c += NGW) {
        const int row0 = c * 8; const float* mb = MOD + (row0 >> 12) * NMOD;
        f32x4 ga[4], sh[4];
#pragma unroll
        for (int j = 0; j < 4; ++j) { const int col = 4 * F.lane + 256 * j; const f32x4 g = *(const f32x4*)(g1 + col), sc = *(const f32x4*)(mb + 1024 + col); sh[j] = *(const f32x4*)(mb + col); ga[j] = g * (sc + 1.0f); }
        f32x4 r0[4], r1[4], r2[4];
        { const f32x4* xr = (const f32x4*)(x + (size_t)row0 * D) + F.lane;
#pragma unroll
          for (int j = 0; j < 4; ++j) r0[j] = __builtin_nontemporal_load(xr + 64 * j);
#pragma unroll
          for (int j = 0; j < 4; ++j) r1[j] = __builtin_nontemporal_load(xr + 256 + 64 * j); }
#pragma unroll
        for (int i = 0; i < 8; ++i) {
            const int row = row0 + i;
            if (i + 2 < 8) { const f32x4* xr = (const f32x4*)(x + (size_t)(row + 2) * D) + F.lane;
#pragma unroll
                for (int j = 0; j < 4; ++j) r2[j] = __builtin_nontemporal_load(xr + 64 * j); }
            float ss = 0.f;
#pragma unroll
            for (int j = 0; j < 4; ++j) ss += (r0[j].x * r0[j].x + r0[j].y * r0[j].y) + (r0[j].z * r0[j].z + r0[j].w * r0[j].w);
            ss = wave_sum(ss);
            const float rstd = 1.0f / sqrtf(ss * (1.0f / D) + EPS);
            float fl[8];
#pragma unroll
            for (int jj = 0; jj < 8; ++jj) fl[jj] = 0.f;
#pragma unroll
            for (int j = 0; j < 4; ++j) { const int col = 4 * F.lane + 256 * j;
                const f32x4 hv = (r0[j] * rstd) * ga[j] + sh[j];
                u32x2 w; w.x = cvtpk(hv.x, hv.y); w.y = cvtpk(hv.z, hv.w);
                __hip_atomic_store((unsigned long long*)(H + (size_t)row * D + col), __builtin_bit_cast(unsigned long long, w), __ATOMIC_RELAXED, __HIP_MEMORY_SCOPE_AGENT);
#pragma unroll
                for (int jj = 0; jj < 8; ++jj) { const f32x4 wv = *(const LAS f32x4*)(wfl + jj * 1024 + col); fl[jj] += (hv.x * wv.x + hv.y * wv.y) + (hv.z * wv.z + hv.w * wv.w); }
            }
            const int lane = F.lane; const float r1s = reduce8_t(fl, lane);
            if ((lane & 7) == 0) { const int jj = lane >> 3; const float z = r1s + b_forget[jj]; const float ls = fminf(z, 0.f) - log1pf(__expf(-fabsf(z))); LOGF[(size_t)row * 8 + jj] = ls; }
#pragma unroll
            for (int j = 0; j < 4; ++j) { r0[j] = r1[j]; r1[j] = r2[j]; }
        }
    }
}

constexpr int KP = 72;
constexpr int VPF = 68;
constexpr int VPS = 260;
constexpr float LOG2E = 1.4426950408889634f;
struct FlashState { f32x16 o[2]; float m, l; };

__device__ __forceinline__ void flash_tail(FlashState& st, f32x16& s0, f32x16& s1, const LAS bf16* Vs, int vp, int r32, int hi) {
    float mt = s0[0];
#pragma unroll
    for (int r = 1; r < 16; ++r) mt = fmaxf(mt, s0[r]);
#pragma unroll
    for (int r = 0; r < 16; ++r) mt = fmaxf(mt, s1[r]);
    mt = fmaxf(mt, __uint_as_float(xorx<32>(__float_as_uint(mt), 32 * hi)));
    const float mn = fmaxf(st.m, mt);
    const float alpha = __builtin_amdgcn_exp2f(st.m - mn);
    st.m = mn;
    float ps = 0.f;
#pragma unroll
    for (int r = 0; r < 16; ++r) { s0[r] = __builtin_amdgcn_exp2f(s0[r] - mn); ps += s0[r]; }
#pragma unroll
    for (int r = 0; r < 16; ++r) { s1[r] = __builtin_amdgcn_exp2f(s1[r] - mn); ps += s1[r]; }
    st.l = st.l * alpha + ps;
    if (__any(alpha != 1.0f)) {
#pragma unroll
        for (int r = 0; r < 16; ++r) { st.o[0][r] *= alpha; st.o[1][r] *= alpha; }
    }
#pragma unroll
    for (int blk = 0; blk < 2; ++blk)
#pragma unroll
        for (int s = 0; s < 2; ++s) {
            v4u pw;
            if (blk == 0) { pw.x = cvtpk(s0[8 * s + 0], s0[8 * s + 1]); pw.y = cvtpk(s0[8 * s + 2], s0[8 * s + 3]); pw.z = cvtpk(s0[8 * s + 4], s0[8 * s + 5]); pw.w = cvtpk(s0[8 * s + 6], s0[8 * s + 7]); }
            else          { pw.x = cvtpk(s1[8 * s + 0], s1[8 * s + 1]); pw.y = cvtpk(s1[8 * s + 2], s1[8 * s + 3]); pw.z = cvtpk(s1[8 * s + 4], s1[8 * s + 5]); pw.w = cvtpk(s1[8 * s + 6], s1[8 * s + 7]); }
            const bf16x8 pf = __builtin_bit_cast(bf16x8, pw);
#pragma unroll
            for (int db = 0; db < 2; ++db) {
                const LAS bf16* vp0 = Vs + (32 * db + r32) * vp + 32 * blk + 16 * s + 4 * hi;
                const s16x4 lo = *(const LAS s16x4*)vp0, hh = *(const LAS s16x4*)(vp0 + 8);
                const bf16x8 vf = __builtin_shufflevector(lo, hh, 0, 1, 2, 3, 4, 5, 6, 7);
                st.o[db] = MFMA32(vf, pf, st.o[db]);
            }
        }
}
__device__ __forceinline__ void flash_qk(f32x16& s0, f32x16& s1, const bf16x8 (&qf)[4], const LAS bf16* Ks, int r32, int hi) {
    s0 = (f32x16){0.f}; s1 = (f32x16){0.f};
#pragma unroll
    for (int r = 0; r < 16; ++r) { s0[r] = 0.f; s1[r] = 0.f; }
#pragma unroll
    for (int ks = 0; ks < 4; ++ks) {
        const bf16x8 a0 = *(const LAS bf16x8*)(Ks + r32 * KP + 16 * ks + 8 * hi);
        const bf16x8 a1 = *(const LAS bf16x8*)(Ks + (32 + r32) * KP + 16 * ks + 8 * hi);
        s0 = MFMA32(a0, qf[ks], s0); s1 = MFMA32(a1, qf[ks], s1);
    }
}
__device__ __forceinline__ void flash_qk2(f32x16& a0, f32x16& a1, f32x16& b0, f32x16& b1, const bf16x8 (&qa)[4], const bf16x8 (&qb)[4], const LAS bf16* Ks, int r32, int hi) {
#pragma unroll
    for (int r = 0; r < 16; ++r) { a0[r] = 0.f; a1[r] = 0.f; b0[r] = 0.f; b1[r] = 0.f; }
#pragma unroll
    for (int ks = 0; ks < 4; ++ks) {
        const bf16x8 k0 = *(const LAS bf16x8*)(Ks + r32 * KP + 16 * ks + 8 * hi);
        const bf16x8 k1 = *(const LAS bf16x8*)(Ks + (32 + r32) * KP + 16 * ks + 8 * hi);
        a0 = MFMA32(k0, qa[ks], a0); b0 = MFMA32(k0, qb[ks], b0); a1 = MFMA32(k1, qa[ks], a1); b1 = MFMA32(k1, qb[ks], b1);
    }
}
__device__ __forceinline__ void flash_soft(FlashState& st, f32x16& s0, f32x16& s1, int hi) {
    float mt = s0[0];
#pragma unroll
    for (int r = 1; r < 16; ++r) mt = fmaxf(mt, s0[r]);
#pragma unroll
    for (int r = 0; r < 16; ++r) mt = fmaxf(mt, s1[r]);
    mt = fmaxf(mt, __uint_as_float(xorx<32>(__float_as_uint(mt), 32 * hi)));
    const float mn = fmaxf(st.m, mt);
    const float alpha = __builtin_amdgcn_exp2f(st.m - mn);
    st.m = mn;
    float ps = 0.f;
#pragma unroll
    for (int r = 0; r < 16; ++r) { s0[r] = __builtin_amdgcn_exp2f(s0[r] - mn); ps += s0[r]; }
#pragma unroll
    for (int r = 0; r < 16; ++r) { s1[r] = __builtin_amdgcn_exp2f(s1[r] - mn); ps += s1[r]; }
    st.l = st.l * alpha + ps;
    if (__any(alpha != 1.0f)) {
#pragma unroll
        for (int r = 0; r < 16; ++r) { st.o[0][r] *= alpha; st.o[1][r] *= alpha; }
    }
}
__device__ __forceinline__ bf16x8 pack_p(const f32x16& p, int s) {
    v4u pw; pw.x = cvtpk(p[8 * s + 0], p[8 * s + 1]); pw.y = cvtpk(p[8 * s + 2], p[8 * s + 3]); pw.z = cvtpk(p[8 * s + 4], p[8 * s + 5]); pw.w = cvtpk(p[8 * s + 6], p[8 * s + 7]);
    return __builtin_bit_cast(bf16x8, pw);
}
__device__ __forceinline__ void flash_pv2(FlashState& sa, FlashState& sb, const f32x16& a0, const f32x16& a1, const f32x16& b0, const f32x16& b1, const LAS bf16* Vs, int vp, int r32, int hi) {
#pragma unroll
    for (int blk = 0; blk < 2; ++blk)
#pragma unroll
        for (int s = 0; s < 2; ++s) {
            const bf16x8 pfa = blk ? pack_p(a1, s) : pack_p(a0, s), pfb = blk ? pack_p(b1, s) : pack_p(b0, s);
#pragma unroll
            for (int db = 0; db < 2; ++db) {
                const LAS bf16* vp0 = Vs + (32 * db + r32) * vp + 32 * blk + 16 * s + 4 * hi;
                const s16x4 lo = *(const LAS s16x4*)vp0, hh = *(const LAS s16x4*)(vp0 + 8);
                const bf16x8 vf = __builtin_shufflevector(lo, hh, 0, 1, 2, 3, 4, 5, 6, 7);
                sa.o[db] = MFMA32(vf, pfa, sa.o[db]); sb.o[db] = MFMA32(vf, pfb, sb.o[db]);
            }
        }
}
__device__ __forceinline__ void flash_store(const FlashState& st, bf16* orow, int hi) {
    float lt = st.l + __uint_as_float(xorx<32>(__float_as_uint(st.l), 32 * hi));
    const float inv = 1.0f / lt;
#pragma unroll
    for (int db = 0; db < 2; ++db)
#pragma unroll
        for (int rg = 0; rg < 4; ++rg) { u32x2 w; w.x = cvtpk(st.o[db][4 * rg] * inv, st.o[db][4 * rg + 1] * inv); w.y = cvtpk(st.o[db][4 * rg + 2] * inv, st.o[db][4 * rg + 3] * inv);
            *(u32x2*)(orow + 32 * db + 8 * rg + 4 * hi) = w; }
}

__device__ __forceinline__ void fox_unit(Frame& F, int b, int h, int qb, float& kmax2) {
    const bf16* proj = (const bf16*)(((unsigned char*)karg(19)) + WS_PROJ); const float* LOGF = (const float*)(((unsigned char*)karg(19)) + WS_LOGF); bf16* OB = (bf16*)(((unsigned char*)karg(19)) + WS_OB);
    LAS float* Fs = (LAS float*)(F.lds);
    LAS float* wtot = (LAS float*)(F.lds + 16384);
    LAS bf16* Kb = (LAS bf16*)(F.lds + 16384 + 128);
    LAS bf16* Vb = (LAS bf16*)(F.lds + 16384 + 128 + 2 * 64 * KP * 2);
    const int lane = F.lane, wave = F.wave, tid = F.tid, r32 = lane & 31, hi = lane >> 5;
    const int q_end = 512 * (qb + 1), NT = q_end / 64;
    const size_t rowbase = (size_t)b * SEQ;
    if (kmax2 < 0.f) {
        float v[8]; float run = 0.f;
#pragma unroll
        for (int i = 0; i < 8; ++i) { const int pos = tid * 8 + i; const float lf = (pos < q_end) ? LOGF[(rowbase + pos) * 8 + h] : 0.f; run += lf; v[i] = run; }
        float inc = run;
#pragma unroll
        for (int o = 1; o < 64; o <<= 1) { const float t = __shfl_up(inc, o); if (lane >= o) inc += t; }
        if (lane == 63) wtot[wave] = inc;
        __syncthreads();
        float off = inc - run;
        for (int w = 0; w < wave; ++w) off += wtot[w];
#pragma unroll
        for (int i = 0; i < 8; ++i) Fs[tid * 8 + i] = -LOG2E * (v[i] + off);
    }
    const int qrow = 512 * qb + 64 * wave + r32, qrowB = qrow + 32;
    bf16x8 qf[4], qg[4];
    { const bf16* qp = proj + (rowbase + qrow) * NPROJ + C_QB + 64 * h + 8 * hi;
#pragma unroll
      for (int ks = 0; ks < 4; ++ks) { qf[ks] = *(const bf16x8*)(qp + 16 * ks); qg[ks] = *(const bf16x8*)(qp + (size_t)32 * NPROJ + 16 * ks); } }
    const int tq = 8 * qb + wave;
    LAS bf16* Qs = (LAS bf16*)(F.lds + 53248) + wave * (64 * KP);
    {
        float qn = 0.f;
#pragma unroll
        for (int ks = 0; ks < 4; ++ks)
#pragma unroll
            for (int j = 0; j < 8; ++j) { const float e = __uint_as_float(((unsigned)(unsigned short)qf[ks][j]) << 16); qn += e * e; }
        qn += __shfl_xor(qn, 32);
        { float qn2 = 0.f;
#pragma unroll
          for (int ks = 0; ks < 4; ++ks)
#pragma unroll
              for (int j = 0; j < 8; ++j) { const float e = __uint_as_float(((unsigned)(unsigned short)qg[ks][j]) << 16); qn2 += e * e; }
          qn2 += __shfl_xor(qn2, 32); qn = fmaxf(qn, qn2); }
#pragma unroll
        for (int o = 1; o < 32; o <<= 1) qn = fmaxf(qn, __shfl_xor(qn, o));
        float kn = 0.f;
        if (kmax2 < 0.f) {
            for (int p0 = 0; p0 < q_end; p0 += 4 * 64) {
                v4u w4[4];
#pragma unroll
                for (int i = 0; i < 4; ++i) w4[i] = *(const v4u*)(proj + (rowbase + p0 + 64 * i + (tid >> 3)) * NPROJ + C_KB + 64 * h + 8 * (tid & 7));
#pragma unroll
                for (int i = 0; i < 4; ++i) { const unsigned wx = w4[i].x, wy = w4[i].y, wz = w4[i].z, ww = w4[i].w;
                    float s = bflo(wx) * bflo(wx) + bfhi(wx) * bfhi(wx) + bflo(wy) * bflo(wy) + bfhi(wy) * bfhi(wy) + bflo(wz) * bflo(wz) + bfhi(wz) * bfhi(wz) + bflo(ww) * bflo(ww) + bfhi(ww) * bfhi(ww);
                    s += __shfl_xor(s, 1); s += __shfl_xor(s, 2); s += __shfl_xor(s, 4);
                    kn = fmaxf(kn, s); } }
            kn = wave_max(kn);
        }
        if (lane == 0) { wtot[8 + wave] = qn; wtot[16 + wave] = kn; }
    }
#pragma unroll
    for (int ks = 0; ks < 4; ++ks) { *(LAS bf16x8*)(Qs + r32 * KP + 16 * ks + 8 * hi) = qf[ks]; *(LAS bf16x8*)(Qs + (32 + r32) * KP + 16 * ks + 8 * hi) = qg[ks]; }
    FlashState st, su; st.m = -INFINITY; st.l = 0.f; su.m = -INFINITY; su.l = 0.f;
#pragma unroll
    for (int r = 0; r < 16; ++r) { st.o[0][r] = 0.f; st.o[1][r] = 0.f; su.o[0][r] = 0.f; su.o[1][r] = 0.f; }
    const int srow = tid >> 3, sch = tid & 7;
    const bf16* kg = proj + (rowbase + srow) * NPROJ + C_KB + 64 * h + 8 * sch;
    const bf16* vg = proj + (rowbase + srow) * NPROJ + C_VB + 64 * h + 8 * sch;
    v4u kreg, vreg;
    { const size_t o = (size_t)(NT - 1) * 64 * NPROJ; kreg = *(const v4u*)(kg + o); vreg = *(const v4u*)(vg + o); }
    int cur = 0;
    {   *(LAS v4u*)(Kb + srow * KP + 8 * sch) = kreg;
        const unsigned short* vs = (const unsigned short*)&vreg;
#pragma unroll
        for (int i = 0; i < 8; ++i) Vb[(8 * sch + i) * VPF + srow] = vs[i];
    }
    __syncthreads();
    int t_lo = 0;
    {
        float qm = 0.f, km = 0.f;
#pragma unroll
        for (int w = 0; w < 8; ++w) { qm = fmaxf(qm, wtot[8 + w]); km = fmaxf(km, wtot[16 + w]); }
        if (kmax2 < 0.f) kmax2 = km;
        const float A = 0.125f * sqrtf(qm) * sqrtf(kmax2) * 1.01f, f0 = Fs[512 * qb];
        for (int t = NT - 9; t >= 0; --t) if (f0 - Fs[64 * t + 63] > (2.0f * A + 60.0f) * LOG2E) { t_lo = t + 1; break; }
    }
    for (int t = NT - 1; t >= t_lo; --t) {
        if (t > t_lo) { const size_t o = (size_t)(t - 1) * 64 * NPROJ; kreg = *(const v4u*)(kg + o); vreg = *(const v4u*)(vg + o); }
        if (t <= tq) {
            const LAS bf16* Ks = Kb + cur * 64 * KP; const LAS bf16* Vs = Vb + cur * 64 * VPF;
            bf16x8 qa[4], qb4[4];
#pragma unroll
            for (int ks = 0; ks < 4; ++ks) { qa[ks] = *(const LAS bf16x8*)(Qs + r32 * KP + 16 * ks + 8 * hi); qb4[ks] = *(const LAS bf16x8*)(Qs + (32 + r32) * KP + 16 * ks + 8 * hi); }
            f32x16 s0, s1, u0, u1; flash_qk2(s0, s1, u0, u1, qa, qb4, Ks, r32, hi);
            const LAS float* Fk = Fs + 64 * t;
            constexpr float C = 0.125f * LOG2E;
#pragma unroll
            for (int rg = 0; rg < 4; ++rg) {
                const f32x4 f0 = *(const LAS f32x4*)(Fk + 8 * rg + 4 * hi), f1 = *(const LAS f32x4*)(Fk + 32 + 8 * rg + 4 * hi);
#pragma unroll
                for (int i = 0; i < 4; ++i) { const int r = 4 * rg + i;
                    s0[r] = fmaf(s0[r], C, f0[i]); s1[r] = fmaf(s1[r], C, f1[i]); u0[r] = fmaf(u0[r], C, f0[i]); u1[r] = fmaf(u1[r], C, f1[i]); }
            }
            if (t == tq) {
#pragma unroll
                for (int r = 0; r < 16; ++r) { const int kv = 64 * t + crow(r, hi);
                    s0[r] = (kv > qrow) ? -INFINITY : s0[r]; s1[r] = (kv + 32 > qrow) ? -INFINITY : s1[r];
                    u0[r] = (kv > qrowB) ? -INFINITY : u0[r]; u1[r] = (kv + 32 > qrowB) ? -INFINITY : u1[r]; }
            }
            flash_soft(st, s0, s1, hi); flash_soft(su, u0, u1, hi);
            flash_pv2(st, su, s0, s1, u0, u1, Vs, VPF, r32, hi);
        }
        if (t > t_lo) {
            const int nb = cur ^ 1;
            *(LAS v4u*)(Kb + nb * 64 * KP + srow * KP + 8 * sch) = kreg;
            const unsigned short* vs = (const unsigned short*)&vreg;
#pragma unroll
            for (int i = 0; i < 8; ++i) Vb[nb * 64 * VPF + (8 * sch + i) * VPF + srow] = vs[i];
        }
        __syncthreads();
        cur ^= 1;
    }
    flash_store(st, OB + (rowbase + qrow) * 512 + 64 * h, hi); flash_store(su, OB + (rowbase + qrowB) * 512 + 64 * h, hi);
    __syncthreads();
}

__device__ const unsigned char T5_BUCKET[128] = {0,1,2,3,4,5,6,7,8,9,10,11,12,13,14,15,16,16,16,17,17,18,18,18,19,19,19,20,20,20,20,21,21,21,21,22,22,22,22,22,23,23,23,23,23,23,24,24,24,24,24,24,25,25,25,25,25,25,25,26,26,26,26,26,26,26,26,27,27,27,27,27,27,27,27,27,27,28,28,28,28,28,28,28,28,28,28,29,29,29,29,29,29,29,29,29,29,29,29,30,30,30,30,30,30,30,30,30,30,30,30,30,30,31,31,31,31,31,31,31,31,31,31,31,31,31,31,31};

__device__ __forceinline__ void swa_unit(Frame& F, int b, int kvh, int n) {
    const bf16* proj = (const bf16*)(((unsigned char*)karg(19)) + WS_PROJ); bf16* OA = (bf16*)(((unsigned char*)karg(19)) + WS_OA);
    const float* sinks = ((const float*)karg(8)); const float* rel_bias = ((const float*)karg(12));
    LAS bf16* Kb = (LAS bf16*)(F.lds);
    LAS bf16* Vb = (LAS bf16*)(F.lds + 36864);
    LAS float* bt = (LAS float*)(F.lds + 36864 + 33280);
    const int lane = F.lane, wave = F.wave, tid = F.tid, r32 = lane & 31, hi = lane >> 5;
    const size_t rowbase = (size_t)b * SEQ;
    {
        const int g = tid >> 7, d = tid & 127;
        bt[tid] = LOG2E * rel_bias[(int)T5_BUCKET[d] * 8 + kvh * 4 + g];
#pragma unroll
        for (int i = 0; i < 4; ++i) {
            const int idx = tid + i * NTHR, kb = idx >> 3, sch = idx & 7; const int pos = 128 * (n - 1) + kb;
            v4u kreg = (v4u){0u, 0u, 0u, 0u}, vreg = (v4u){0u, 0u, 0u, 0u};
            if (pos >= 0) { const bf16* p = proj + (rowbase + pos) * NPROJ + 64 * kvh + 8 * sch; kreg = *(const v4u*)(p + C_KA); vreg = *(const v4u*)(p + C_VA); }
            *(LAS v4u*)(Kb + kb * KP + 8 * sch) = kreg;
            const unsigned short* vs = (const unsigned short*)&vreg;
#pragma unroll
            for (int j = 0; j < 8; ++j) Vb[(8 * sch + j) * VPS + kb] = vs[j];
        }
    }
    __syncthreads();
    const int g = wave & 3, qh = wave >> 2, head = kvh * 4 + g;
    const LAS float* btg = bt + g * 128;
    for (int sb = 0; sb < 2; ++sb) {
        const int qrel0 = 64 * qh + 32 * sb, qrel = qrel0 + r32;
        const size_t row = rowbase + 128 * n + qrel;
        bf16x8 qf[4];
        { const bf16* qp = proj + row * NPROJ + C_QA + 64 * head + 8 * hi;
#pragma unroll
          for (int ks = 0; ks < 4; ++ks) qf[ks] = *(const bf16x8*)(qp + 16 * ks); }
        FlashState st; st.m = LOG2E * sinks[head]; st.l = (hi == 0) ? 1.0f : 0.0f;
#pragma unroll
        for (int r = 0; r < 16; ++r) { st.o[0][r] = 0.f; st.o[1][r] = 0.f; }
        const int t_lo = (qrel0 + 1) >> 6, t_hi = (qrel0 + 159) >> 6;
        for (int t = t_lo; t <= t_hi; ++t) {
            f32x16 s0, s1; flash_qk(s0, s1, qf, Kb + t * 64 * KP, r32, hi);
#pragma unroll
            for (int r = 0; r < 16; ++r) {
                const int kb0 = 64 * t + crow(r, hi), kb1 = kb0 + 32;
                const int d0 = 128 + qrel - kb0, d1 = d0 - 32;
                const bool v0 = (d0 >= 0) && (d0 < 128) && (n > 0 || kb0 >= 128);
                const bool v1 = (d1 >= 0) && (d1 < 128) && (n > 0 || kb1 >= 128);
                const float b0 = btg[d0 & 127], b1 = btg[d1 & 127];
                s0[r] = v0 ? fmaf(s0[r], 0.125f * LOG2E, b0) : -INFINITY;
                s1[r] = v1 ? fmaf(s1[r], 0.125f * LOG2E, b1) : -INFINITY;
            }
            flash_tail(st, s0, s1, Vb + 64 * t, VPS, r32, hi);
        }
        flash_store(st, OA + row * 512 + 64 * head, hi);
    }
    __syncthreads();
}
__device__ __forceinline__ void p3_attention(Frame& F) {
    for (int item = F.vcu; item < 256; item += F.G) {
        swa_unit(F, item >> 6, (item >> 5) & 1, item & 31);
        F.lane = lane_fresh(); F.tid = F.wave * 64 + F.lane;
        const int bh = item >> 3, j = item & 7;
        float kmax2 = -1.0f;
        fox_unit(F, bh >> 3, bh & 7, j, kmax2);
    }
}

struct PairOrder {
    pg8::StaticOrder S;
    __device__ bool next(int i, pg8::Unit& u) const { if (!S.next(i >> 1, u)) return false; u.src = i & 1; return true; }
    __device__ __forceinline__ void a_ready(const pg8::Unit&) const {}
    __device__ __forceinline__ void done(const pg8::Unit&) const {}
};
__device__ __forceinline__ float sigmoidf_(float z) { return 1.0f / (1.0f + __expf(-z)); }
struct EpiGate {
    static constexpr bool PERM = true, AFTER_DRAIN = false, CHAIN = true;
    const bf16* proj; bf16* mixed;
    __device__ __forceinline__ void operator()(pg8::f32x4 (&acc)[2][2][4][2], const pg8::Unit& u, int wr, int wc, int fr, int fq) const {
#pragma unroll
        for (int ai = 0; ai < 2; ++ai) {
            v4u gbv[4][2], gav[4][2];
#pragma unroll
            for (int m = 0; m < 4; ++m) { const size_t row = (size_t)u.pm * 256 + ai * 128 + wr * 64 + m * 16 + fr;
#pragma unroll
                for (int bj = 0; bj < 2; ++bj) { const int col0 = u.pn * 256 + bj * 128 + wc * 32 + 8 * fq;
                    gbv[m][bj] = *(const v4u*)(proj + row * NPROJ + C_GLB + col0);
                    if (u.src == 0) gav[m][bj] = __builtin_nontemporal_load((const v4u*)(proj + row * NPROJ + C_GLA + col0)); } }
#pragma unroll
            for (int m = 0; m < 4; ++m) { const size_t row = (size_t)u.pm * 256 + ai * 128 + wr * 64 + m * 16 + fr;
#pragma unroll
                for (int bj = 0; bj < 2; ++bj) { const int col0 = u.pn * 256 + bj * 128 + wc * 32 + 8 * fq;
                    const unsigned gbw[4] = {gbv[m][bj].x, gbv[m][bj].y, gbv[m][bj].z, gbv[m][bj].w};
                    if (u.src == 0) {
                        const unsigned gaw[4] = {gav[m][bj].x, gav[m][bj].y, gav[m][bj].z, gav[m][bj].w};
#pragma unroll
                        for (int e = 0; e < 8; ++e) { const float za = (e & 1) ? bfhi(gaw[e >> 1]) : bflo(gaw[e >> 1]), zb = (e & 1) ? bfhi(gbw[e >> 1]) : bflo(gbw[e >> 1]);
                            const float ratio = (1.0f + __expf(-zb)) * __builtin_amdgcn_rcpf(1.0f + __expf(-za));
                            acc[ai][bj][m][e >> 2][e & 3] *= ratio; }
                    } else {
                        float v[8];
#pragma unroll
                        for (int e = 0; e < 8; ++e) { const float zb = (e & 1) ? bfhi(gbw[e >> 1]) : bflo(gbw[e >> 1]); v[e] = acc[ai][bj][m][e >> 2][e & 3] * __builtin_amdgcn_rcpf(1.0f + __expf(-zb)); }
                        v4u w; w.x = cvtpk(v[0], v[1]); w.y = cvtpk(v[2], v[3]); w.z = cvtpk(v[4], v[5]); w.w = cvtpk(v[6], v[7]);
                        *(v4u*)(mixed + row * D + col0) = w;
                    }
                }
            }
        }
    }
};
struct EpiRes {
    static constexpr bool PERM = true, AFTER_DRAIN = false, CHAIN = false;
    const float* x; const float* mod; bf16* x1;
    __device__ __forceinline__ void operator()(const pg8::f32x4 (&acc)[2][2][4][2], const pg8::Unit& u, int wr, int wc, int fr, int fq) const {
        const int b = (u.pm * 256) >> 12;
        pg8::f32x4 gt[2][2];
#pragma unroll
        for (int bj = 0; bj < 2; ++bj)
#pragma unroll
            for (int n = 0; n < 2; ++n) gt[bj][n] = *(const pg8::f32x4*)(mod + b * NMOD + 2048 + u.pn * 256 + bj * 128 + wc * 32 + 8 * fq + 4 * n);
#pragma unroll
        for (int ai = 0; ai < 2; ++ai) {
            pg8::f32x4 xin[4][2][2];
#pragma unroll
            for (int m = 0; m < 4; ++m) { const size_t row = (size_t)u.pm * 256 + ai * 128 + wr * 64 + m * 16 + fr;
#pragma unroll
                for (int bj = 0; bj < 2; ++bj)
#pragma unroll
                    for (int n = 0; n < 2; ++n) xin[m][bj][n] = __builtin_nontemporal_load((const pg8::f32x4*)(x + row * D + u.pn * 256 + bj * 128 + wc * 32 + 8 * fq + 4 * n)); }
#pragma unroll
            for (int m = 0; m < 4; ++m) { const size_t row = (size_t)u.pm * 256 + ai * 128 + wr * 64 + m * 16 + fr;
#pragma unroll
                for (int bj = 0; bj < 2; ++bj) { const pg8::f32x4 v0 = xin[m][bj][0] + gt[bj][0] * acc[ai][bj][m][0], v1 = xin[m][bj][1] + gt[bj][1] * acc[ai][bj][m][1];
                    v4u w; w.x = cvtpk(v0.x, v0.y); w.y = cvtpk(v0.z, v0.w); w.z = cvtpk(v1.x, v1.y); w.w = cvtpk(v1.z, v1.w);
                    *(v4u*)(x1 + row * D + u.pn * 256 + bj * 128 + wc * 32 + 8 * fq) = w; } }
        }
    }
};

__device__ __forceinline__ void p6_norm2(Frame& F) {
    const bf16* x1 = (const bf16*)(((unsigned char*)karg(19)) + WS_X1); const float* g2 = ((const float*)karg(3)); const float* MOD = (const float*)(((unsigned char*)karg(19)) + WS_MOD); bf16* H2 = (bf16*)(((unsigned char*)karg(19)) + WS_H2); unsigned char* H2Q = (unsigned char*)(((unsigned char*)karg(19)) + WS_H2Q); float* H2S = (float*)(((unsigned char*)karg(19)) + WS_H2S);
    const int gw = F.vcu * NWAVES + F.wave, NGW = F.G * NWAVES;
    for (int c = gw; c < M / 8; c += NGW) {
        const int row0 = c * 8; const float* mb = MOD + (row0 >> 12) * NMOD;
        f32x4 ga[4], sh[4];
#pragma unroll
        for (int j = 0; j < 4; ++j) { const int col = 4 * F.lane + 256 * j; const f32x4 g = *(const f32x4*)(g2 + col), sc = *(const f32x4*)(mb + 4096 + col); sh[j] = *(const f32x4*)(mb + 3072 + col); ga[j] = g * (sc + 1.0f); }
        u32x2 r0[4], r1[4], r2[4];
        { const u32x2* xr = (const u32x2*)(x1 + (size_t)row0 * D) + F.lane;
#pragma unroll
          for (int j = 0; j < 4; ++j) r0[j] = xr[64 * j];
#pragma unroll
          for (int j = 0; j < 4; ++j) r1[j] = xr[256 + 64 * j]; }
#pragma unroll
        for (int i = 0; i < 8; ++i) {
            const int row = row0 + i;
            if (i + 2 < 8) { const u32x2* xr = (const u32x2*)(x1 + (size_t)(row + 2) * D) + F.lane;
#pragma unroll
                for (int j = 0; j < 4; ++j) r2[j] = xr[64 * j]; }
            f32x4 hq[4], xv[4]; float ss = 0.f;
#pragma unroll
            for (int j = 0; j < 4; ++j) { xv[j].x = bflo(r0[j].x); xv[j].y = bfhi(r0[j].x); xv[j].z = bflo(r0[j].y); xv[j].w = bfhi(r0[j].y);
                ss += (xv[j].x * xv[j].x + xv[j].y * xv[j].y) + (xv[j].z * xv[j].z + xv[j].w * xv[j].w); }
            ss = wave_sum(ss);
            const float rstd = 1.0f / sqrtf(ss * (1.0f / D) + EPS);
#pragma unroll
            for (int j = 0; j < 4; ++j) { const int col = 4 * F.lane + 256 * j;
                const f32x4 hv = (xv[j] * rstd) * ga[j] + sh[j];
                u32x2 w; w.x = cvtpk(hv.x, hv.y); w.y = cvtpk(hv.z, hv.w);
                __hip_atomic_store((unsigned long long*)(H2 + (size_t)row * D + col), __builtin_bit_cast(unsigned long long, w), __ATOMIC_RELAXED, __HIP_MEMORY_SCOPE_AGENT); hq[j] = hv; }
            float am = 0.f;
#pragma unroll
            for (int j = 0; j < 4; ++j) am = fmaxf(fmaxf(am, fmaxf(fabsf(hq[j].x), fabsf(hq[j].y))), fmaxf(fabsf(hq[j].z), fabsf(hq[j].w)));
            am = wave_max(am);
            const float sc = am > 0.f ? am * (1.0f / 127.0f) : 1.0f, inv = 1.0f / sc;
            v4u qa;
#pragma unroll
            for (int j = 0; j < 4; ++j) { const int b0 = (int)rintf(hq[j].x * inv), b1 = (int)rintf(hq[j].y * inv), b2 = (int)rintf(hq[j].z * inv), b3 = (int)rintf(hq[j].w * inv);
                qa[j] = (unsigned)(b0 & 255) | ((unsigned)(b1 & 255) << 8) | ((unsigned)(b2 & 255) << 16) | ((unsigned)(b3 & 255) << 24); }
            __builtin_nontemporal_store(qa, (v4u*)(H2Q + (size_t)row * D + 16 * F.lane));
            if (F.lane == 0) H2S[row] = sc;
#pragma unroll
            for (int j = 0; j < 4; ++j) { r0[j] = r1[j]; r1[j] = r2[j]; }
        }
    }
}

__device__ __forceinline__ unsigned f2ord(float f) { const unsigned u = __float_as_uint(f); return u ^ ((unsigned)((int)u >> 31) | 0x80000000u); }
__device__ __forceinline__ float ord2f(unsigned o) { const unsigned u = (o & 0x80000000u) ? (o & 0x7fffffffu) : ~o; return __uint_as_float(u); }
#define CE_DESC(a, b) do { const unsigned _x = (a), _y = (b); (a) = _x > _y ? _x : _y; (b) = _x > _y ? _y : _x; } while (0)
__device__ __forceinline__ void sort16(unsigned (&k)[16]) {
    CE_DESC(k[0], k[13]); CE_DESC(k[1], k[12]); CE_DESC(k[2], k[15]); CE_DESC(k[3], k[14]); CE_DESC(k[4], k[8]); CE_DESC(k[5], k[6]); CE_DESC(k[7], k[11]); CE_DESC(k[9], k[10]);
    CE_DESC(k[0], k[5]); CE_DESC(k[1], k[7]); CE_DESC(k[2], k[9]); CE_DESC(k[3], k[4]); CE_DESC(k[6], k[13]); CE_DESC(k[8], k[14]); CE_DESC(k[10], k[15]); CE_DESC(k[11], k[12]);
    CE_DESC(k[0], k[1]); CE_DESC(k[2], k[3]); CE_DESC(k[4], k[5]); CE_DESC(k[6], k[8]); CE_DESC(k[7], k[9]); CE_DESC(k[10], k[11]); CE_DESC(k[12], k[13]); CE_DESC(k[14], k[15]);
    CE_DESC(k[0], k[2]); CE_DESC(k[1], k[3]); CE_DESC(k[4], k[10]); CE_DESC(k[5], k[11]); CE_DESC(k[6], k[7]); CE_DESC(k[8], k[9]); CE_DESC(k[12], k[14]); CE_DESC(k[13], k[15]);
    CE_DESC(k[1], k[2]); CE_DESC(k[3], k[12]); CE_DESC(k[4], k[6]); CE_DESC(k[5], k[7]); CE_DESC(k[8], k[10]); CE_DESC(k[9], k[11]); CE_DESC(k[13], k[14]);
    CE_DESC(k[1], k[4]); CE_DESC(k[2], k[6]); CE_DESC(k[5], k[8]); CE_DESC(k[7], k[10]); CE_DESC(k[9], k[13]); CE_DESC(k[11], k[14]);
    CE_DESC(k[2], k[4]); CE_DESC(k[3], k[6]); CE_DESC(k[9], k[12]); CE_DESC(k[11], k[13]);
    CE_DESC(k[3], k[5]); CE_DESC(k[6], k[8]); CE_DESC(k[7], k[9]); CE_DESC(k[10], k[12]);
    CE_DESC(k[3], k[4]); CE_DESC(k[5], k[6]); CE_DESC(k[7], k[8]); CE_DESC(k[9], k[10]); CE_DESC(k[11], k[12]);
    CE_DESC(k[6], k[7]); CE_DESC(k[8], k[9]);
}
__device__ __forceinline__ void merge16(unsigned (&a)[16], const unsigned (&b)[16]) {
#pragma unroll
    for (int i = 0; i < 16; ++i) a[i] = a[i] > b[15 - i] ? a[i] : b[15 - i];
#pragma unroll
    for (int stride = 8; stride > 0; stride >>= 1)
#pragma unroll
        for (int i = 0; i < 16; ++i) { const int j = i ^ stride; if (j > i) CE_DESC(a[i], a[j]); }
}
__device__ __forceinline__ void top16_of_64(unsigned (&g0)[16], unsigned (&g1)[16], unsigned (&g2)[16], unsigned (&g3)[16]) {
    sort16(g0); sort16(g1); sort16(g2); sort16(g3);
    merge16(g0, g1); merge16(g2, g3); merge16(g0, g2);
}
constexpr int NCAND = 50;
__device__ __forceinline__ void p8a_topk(Frame& F) {
    const bf16* QP = (const bf16*)(((unsigned char*)karg(19)) + WS_QP); const bf16* SUBK = (const bf16*)(((unsigned char*)karg(19)) + WS_SUBK);
    unsigned short* PIDX = (unsigned short*)(((unsigned char*)karg(19)) + WS_PIDX); float* PG = (float*)(((unsigned char*)karg(19)) + WS_PG);
    LAS unsigned short* Elds = (LAS unsigned short*)(F.lds) + F.wave * (NCAND * 64);
    const int lane = F.lane, r32 = lane & 31, hi = lane >> 5;
    const int gw = F.vcu * NWAVES + F.wave, NGW = F.G * NWAVES;
    for (int it2 = 0; it2 < 2 * ((M / 64 - F.vcu + F.G - 1) / F.G); ++it2) {
        const int wi = F.vcu + (it2 >> 1) * F.G;
        const int tile = 2 * wi + (it2 & 1);
        const int tok = tile * 32 + r32;
        { const int h = F.wave;
            unsigned top[2][16];
#pragma unroll
            for (int p = 0; p < 2; ++p) {
                bf16x8 qf[4];
                { const bf16* qp = QP + (size_t)tok * D + h * 128 + p * 64 + 8 * hi;
#pragma unroll
                  for (int ks = 0; ks < 4; ++ks) qf[ks] = *(const bf16x8*)(qp + 16 * ks); }
                const bf16* kp = SUBK + (size_t)((h * 2 + p) * 128 + r32) * 64 + 8 * hi;
                unsigned kk[4][16];
#pragma unroll
                for (int blk = 0; blk < 4; ++blk) {
                    f32x16 acc;
#pragma unroll
                    for (int r = 0; r < 16; ++r) acc[r] = 0.f;
#pragma unroll
                    for (int ks = 0; ks < 4; ++ks) { const bf16x8 a = *(const bf16x8*)(kp + (size_t)blk * 32 * 64 + 16 * ks); acc = MFMA32(a, qf[ks], acc); }
#pragma unroll
                    for (int r = 0; r < 16; ++r) { const int key = 32 * blk + crow(r, hi); kk[blk][r] = (f2ord(acc[r]) & ~127u) | (unsigned)(127 - key); }
                }
                top16_of_64(kk[0], kk[1], kk[2], kk[3]);
                unsigned other[16];
#pragma unroll
                for (int i = 0; i < 16; ++i) other[i] = xorx<32>(kk[0][i], lane);
                merge16(kk[0], other);
#pragma unroll
                for (int i = 0; i < 16; ++i) top[p][i] = kk[0][i];
            }
            float s1[16], s2[16]; unsigned i1[16], i2[16];
#pragma unroll
            for (int i = 0; i < 16; ++i) { s1[i] = ord2f(top[0][i] & ~127u); i1[i] = 127u - (top[0][i] & 127u); s2[i] = ord2f(top[1][i] & ~127u); i2[i] = 127u - (top[1][i] & 127u); }
            unsigned ck[4][16];
#pragma unroll
            for (int c = 0; c < 64; ++c) {
                if (c < NCAND) { constexpr int CA[NCAND] = {0,0,0,0,0,0,0,0,0,0,0,0,0,0,0,0,1,1,1,1,1,1,1,1,2,2,2,2,2,3,3,3,3,4,4,4,5,5,6,6,7,7,8,9,10,11,12,13,14,15}; constexpr int CB[NCAND] = {0,1,2,3,4,5,6,7,8,9,10,11,12,13,14,15,0,1,2,3,4,5,6,7,0,1,2,3,4,0,1,2,3,0,1,2,0,1,0,1,0,1,0,0,0,0,0,0,0,0}; const int a = CA[c], b = CB[c];
                    ck[c >> 4][c & 15] = (f2ord(s1[a] + s2[b]) & ~63u) | (unsigned)(63 - c);
                    Elds[c * 64 + lane] = (unsigned short)(i1[a] * 128u + i2[b]); }
                else ck[c >> 4][c & 15] = 0u;
            }
            top16_of_64(ck[0], ck[1], ck[2], ck[3]);
            float w[16]; float wsum = 0.f; const float v0 = ord2f(ck[0][0] & ~63u);
#pragma unroll
            for (int r = 0; r < 16; ++r) { w[r] = __expf(ord2f(ck[0][r] & ~63u) - v0); wsum += w[r]; }
            const float winv = 1.0f / wsum;
#pragma unroll
            for (int r = 0; r < 16; ++r) if ((r >> 3) == hi) {
                const int c = 63 - (int)(ck[0][r] & 63u);
                const unsigned short eid = Elds[c * 64 + lane];
                PIDX[(size_t)tok * 128 + h * 16 + r] = eid; PG[(size_t)tok * 128 + h * 16 + r] = w[r] * winv; }
        }
    }
}

__device__ __forceinline__ float gelu_erf(float v) { return 0.5f * v * (1.0f + erff(v * 0.70710678118654752f)); }

#define PROBE_REPA 1
#define PROBE_REPB 1
constexpr int NR = 8, RSH = 18, BSA = 8, BSB = 8, ELP = 136, TPS = 8; static_assert(BSA == 8 && BSB == 8, "whole batches of 8");
__device__ __forceinline__ void sort128(unsigned& e0, unsigned& e1, int lane) {
#pragma unroll
    for (int size = 2; size <= 128; size <<= 1) {
#pragma unroll
        for (int stride = size >> 1; stride > 0; stride >>= 1) {
            if (stride == 64) { const unsigned lo = e0 < e1 ? e0 : e1, hi = e0 < e1 ? e1 : e0; e0 = lo; e1 = hi; }
            else {
                const bool lower = (lane & stride) == 0;
                const bool asc0 = (size == 128) ? true : (size == 64 ? true : ((lane & size) == 0));
                const bool asc1 = (size == 128) ? true : (size == 64 ? false : ((lane & size) == 0));
                const unsigned p0 = xorx_sw(e0, lane, stride), p1 = xorx_sw(e1, lane, stride);
                const unsigned mn0 = e0 < p0 ? e0 : p0, mx0 = e0 < p0 ? p0 : e0, mn1 = e1 < p1 ? e1 : p1, mx1 = e1 < p1 ? p1 : e1;
                e0 = (lower == asc0) ? mn0 : mx0; e1 = (lower == asc1) ? mn1 : mx1;
            }
        }
    }
}
template <int BS> __device__ __forceinline__ void sw_issue(v4u (&buf)[BS], const LAS unsigned* el, const unsigned char* tab, unsigned voff) {
#pragma unroll
    for (int i = 0; i < BS; ++i) { const unsigned off = (el[i] << 10) + voff;
        buf[i] = *(const v4u*)(tab + off); }
}
template <int BS> __device__ __forceinline__ void sw_proc_a(const v4u (&buf)[BS], const v4u& hq, LAS float* wl, int s, int n, int lane) {
    const int hx = (int)hq.x, hy = (int)hq.y, hz = (int)hq.z, hw = (int)hq.w;
    float dd[8];
#pragma unroll
    for (int i = 0; i < 8; ++i) dd[i] = 0.f;
#pragma unroll
    for (int i = 0; i < BS; ++i) { const int dx = (int)buf[i].x, dy = (int)buf[i].y, dz = (int)buf[i].z, dw = (int)buf[i].w;
        int t = __builtin_amdgcn_sdot4(hx, dx, 0, false); t = __builtin_amdgcn_sdot4(hy, dy, t, false); t = __builtin_amdgcn_sdot4(hz, dz, t, false); t = __builtin_amdgcn_sdot4(hw, dw, t, false);
        dd[i] = (float)t; }
    const float r1 = reduce8_t(dd, lane);
    if ((lane & 7) == 0) wl[s + (lane >> 3)] = r1;
}
typedef _Float16 h2_t __attribute__((ext_vector_type(2)));
#define CVT_H2_FP8(u, hi) __builtin_bit_cast(h2_t, __builtin_amdgcn_cvt_scalef32_pk_f16_fp8((u), 1.0f, (hi)))
template <int BS> __device__ __forceinline__ void sw_proc_b(const v4u (&buf)[BS], h2_t (&acc)[8], const LAS float* wl, int s, int n) {
    float wr[BS];
#pragma unroll
    for (int i = 0; i < BS; ++i) wr[i] = wl[s + i];
#pragma unroll
    for (int i = 0; i < BS; ++i) {
        const h2_t wv = __builtin_bit_cast(h2_t, wr[i]);
        const unsigned ux = buf[i].x, uy = buf[i].y, uz = buf[i].z, uw = buf[i].w;
        acc[0] = __builtin_elementwise_fma(CVT_H2_FP8(ux, false), wv, acc[0]); acc[1] = __builtin_elementwise_fma(CVT_H2_FP8(ux, true), wv, acc[1]);
        acc[2] = __builtin_elementwise_fma(CVT_H2_FP8(uy, false), wv, acc[2]); acc[3] = __builtin_elementwise_fma(CVT_H2_FP8(uy, true), wv, acc[3]);
        acc[4] = __builtin_elementwise_fma(CVT_H2_FP8(uz, false), wv, acc[4]); acc[5] = __builtin_elementwise_fma(CVT_H2_FP8(uz, true), wv, acc[5]);
        acc[6] = __builtin_elementwise_fma(CVT_H2_FP8(uw, false), wv, acc[6]); acc[7] = __builtin_elementwise_fma(CVT_H2_FP8(uw, true), wv, acc[7]); }
}
__device__ __forceinline__ void sw_warm(v4u (&pf)[4], const unsigned char* tab, int range, int lw, unsigned voff) {
#pragma unroll
    for (int i = 0; i < 4; ++i) { const unsigned off = ((unsigned)(range * 1024 + lw * 4 + i) << 10) + voff; pf[i] = *(const v4u*)(tab + off); }
}
__device__ __forceinline__ void sw_warm_done(const v4u (&pf)[4]) {
#pragma unroll
    for (int i = 0; i < 4; ++i) asm volatile("" :: "v"(pf[i]));
}
template <int FAKE> __device__ __forceinline__ void p8b_sweep(Frame& F) {
    const bf16* X1 = (const bf16*)(((unsigned char*)karg(19)) + WS_X1); const float* MOD = (const float*)(((unsigned char*)karg(19)) + WS_MOD);
    const unsigned char* H2Q = (const unsigned char*)(((unsigned char*)karg(19)) + WS_H2Q); const float* H2S = (const float*)(((unsigned char*)karg(19)) + WS_H2S);
    const unsigned char* EDq = (const unsigned char*)(((unsigned char*)karg(19)) + WS_ED); const unsigned char* EUq = (const unsigned char*)(((unsigned char*)karg(19)) + WS_EU); const float* EDS = (const float*)(((unsigned char*)karg(19)) + WS_EDS);
    const unsigned short* PIDX = (const unsigned short*)(((unsigned char*)karg(19)) + WS_PIDX); const float* PG = (const float*)(((unsigned char*)karg(19)) + WS_PG);
    const float* fg = ((const float*)karg(17));
    const int gw = F.vcu * NWAVES + F.wave, NGW = F.G * NWAVES;
    for (int wi = F.vcu; wi < M / 64; wi += F.G) {
        const int tb = wi * 8 + F.wave;
        unsigned ones = ~0u; asm volatile("" : "+s"(ones));
        int lane = (int)__builtin_amdgcn_mbcnt_hi(ones, __builtin_amdgcn_mbcnt_lo(ones, 0u)); asm volatile("" : "+v"(lane));
        const int tok0 = tb * 8;
        unsigned E0[8], E1[8];
        LAS float* Wl = (LAS float*)(F.lds) + F.wave * 1024;
        LAS unsigned* El = (LAS unsigned*)(F.lds + 32768) + F.wave * (8 * ELP);
        unsigned voff = 16u * (unsigned)lane; asm volatile("" : "+v"(voff));
        LAS int* Bnd = (LAS int*)(F.lds + 67584) + F.wave * (8 * (NR + 1));
#pragma unroll
        for (int k = 0; k < 8; ++k) {
            const size_t base = (size_t)(tok0 + k) * 128;
            E0[k] = ((unsigned)PIDX[base + lane] << 7) | (unsigned)lane; E1[k] = ((unsigned)PIDX[base + 64 + lane] << 7) | (unsigned)(64 + lane);
            sort128(E0[k], E1[k], lane);
            if (FAKE) { E0[k] = (E0[k] & 0x1ffffu) ; E1[k] = (E1[k] & 0x1ffffu); sort128(E0[k], E1[k], lane); }
            El[k * ELP + lane] = E0[k] >> 7; El[k * ELP + 64 + lane] = E1[k] >> 7;
            if (lane < 8) El[k * ELP + 128 + lane] = (unsigned)__builtin_amdgcn_readlane((int)E1[k], 63) >> 7;
        }
        for (int repa = 0; repa < PROBE_REPA; ++repa) {
            v4u hq[8];
#pragma unroll
            for (int k = 0; k < 8; ++k) hq[k] = *(const v4u*)(H2Q + (size_t)(tok0 + k) * D + 16 * lane);
            int pos[8];
#pragma unroll
            for (int k = 0; k < 8; ++k) pos[k] = 0;
            v4u bA[BSA], bB[BSA], bC[BSA]; int ps = 0, pn = 0;
            for (int r = 0; r < NR; ++r) {
#pragma unroll
                for (int k = 0; k < 8; ++k) {
                    constexpr int dummy = 0; (void)dummy;
                    const int kp = (k + 7) & 7;
                    const unsigned long long BM = 0x0101010101010101ull;
                    const int c = __builtin_popcountll(__ballot((E0[k] >> RSH) == (unsigned)r) & BM) + __builtin_popcountll(__ballot((E1[k] >> RSH) == (unsigned)r) & BM);
                    int s = __builtin_amdgcn_readfirstlane(pos[k]); const int e_end = __builtin_amdgcn_readfirstlane(s + 8 * c); pos[k] = e_end;
                    if (lane == 0) Bnd[k * (NR + 1) + r + 1] = e_end;
                    const int n1 = (e_end - s) < BSA ? (e_end - s) : BSA;
                    if (k & 1) sw_issue<BSA>(bB, El + k * ELP + s, EDq, voff); else sw_issue<BSA>(bA, El + k * ELP + s, EDq, voff);
                    if (pn > 0) { if (k & 1) sw_proc_a<BSA>(bA, hq[kp], Wl + kp * 128, ps, pn, lane); else sw_proc_a<BSA>(bB, hq[kp], Wl + kp * 128, ps, pn, lane); }
                    ps = s; pn = n1; s += n1;
#define SWA_REST(Y) if (s < e_end) { sw_issue<BSA>(Y, El + k * ELP + s, EDq, voff); \
                        for (;;) { int n = (e_end - s) < BSA ? (e_end - s) : BSA; \
                            if (s + BSA < e_end) { sw_issue<BSA>(bC, El + k * ELP + s + BSA, EDq, voff); sw_proc_a<BSA>(Y, hq[k], Wl + k * 128, s, n, lane); } else { sw_proc_a<BSA>(Y, hq[k], Wl + k * 128, s, n, lane); break; } \
                            s += BSA; n = (e_end - s) < BSA ? (e_end - s) : BSA; \
                            if (s + BSA < e_end) { sw_issue<BSA>(Y, El + k * ELP + s + BSA, EDq, voff); sw_proc_a<BSA>(bC, hq[k], Wl + k * 128, s, n, lane); } else { sw_proc_a<BSA>(bC, hq[k], Wl + k * 128, s, n, lane); break; } \
                            s += BSA; } }
                    if (k & 1) { SWA_REST(bA) } else { SWA_REST(bB) }
#undef SWA_REST
                }
            }
            if (pn > 0) sw_proc_a<BSA>(bB, hq[7], Wl + 7 * 128, ps, pn, lane);
        }
#pragma unroll
        for (int k = 0; k < 8; ++k) { int tk = tok0 + k; asm volatile("" : "+s"(tk)); const size_t base = (size_t)tk * 128; const float sh = H2S[tk];
            const float r0 = Wl[k * 128 + lane], r1 = Wl[k * 128 + 64 + lane];
            const _Float16 w0 = (_Float16)(PG[base + (E0[k] & 127u)] * gelu_erf(r0 * sh * EDS[E0[k] >> 7])), w1 = (_Float16)(PG[base + (E1[k] & 127u)] * gelu_erf(r1 * sh * EDS[E1[k] >> 7]));
            Wl[k * 128 + lane] = __builtin_bit_cast(float, (h2_t){w0, w0}); Wl[k * 128 + 64 + lane] = __builtin_bit_cast(float, (h2_t){w1, w1}); }
        int ln = lane; asm volatile("" : "+v"(ln));
#pragma unroll
        for (int sub = 0; sub < 8 / TPS; ++sub) {
        h2_t acc[TPS][8];
        for (int repb = 0; repb < PROBE_REPB; ++repb) {
#pragma unroll
            for (int kk = 0; kk < TPS; ++kk)
#pragma unroll
                for (int i = 0; i < 8; ++i) acc[kk][i] = (h2_t){(_Float16)0.f, (_Float16)0.f};
            int pos[TPS];
#pragma unroll
            for (int kk = 0; kk < TPS; ++kk) pos[kk] = 0;
            v4u bA[BSB], bB[BSB]; int ps = 0, pn = 0;
            for (int r = 0; r < NR; ++r) {
#pragma unroll
                for (int kk = 0; kk < TPS; ++kk) {
                    const int k = sub * TPS + kk, kkp = (kk + TPS - 1) % TPS, kp = sub * TPS + kkp;
                    int s = __builtin_amdgcn_readfirstlane(pos[kk]); const int e_end = __builtin_amdgcn_readfirstlane(Bnd[k * (NR + 1) + r + 1]); pos[kk] = e_end;
                    const int n1 = (e_end - s) < BSB ? (e_end - s) : BSB;
                    if (kk & 1) sw_issue<BSB>(bB, El + k * ELP + s, EUq, voff); else sw_issue<BSB>(bA, El + k * ELP + s, EUq, voff);
                    if (pn > 0) { if (kk & 1) sw_proc_b<BSB>(bA, acc[kkp], Wl + kp * 128, ps, pn); else sw_proc_b<BSB>(bB, acc[kkp], Wl + kp * 128, ps, pn); }
                    ps = s; pn = n1; s += n1;
                    for (; s < e_end; s += BSB) {
                        const int n = (e_end - s) < BSB ? (e_end - s) : BSB;
                        if (kk & 1) { sw_issue<BSB>(bA, El + k * ELP + s, EUq, voff); sw_proc_b<BSB>(bA, acc[kk], Wl + k * 128, s, n); }
                        else        { sw_issue<BSB>(bB, El + k * ELP + s, EUq, voff); sw_proc_b<BSB>(bB, acc[kk], Wl + k * 128, s, n); }
                    }
                }
            }
            if (pn > 0) sw_proc_b<BSB>(bB, acc[TPS - 1], Wl + (sub * TPS + TPS - 1) * 128, ps, pn);
        }
        {
            asm volatile("" : "+v"(ln));
            float* outp = (float*)karg(18);
            const float* gt2 = MOD + ((tok0 + sub * TPS) >> 12) * NMOD + 5120;
            f32x4 gtv[4]; u32x2 xcur[4], xnxt[4];
#pragma unroll
            for (int j = 0; j < 4; ++j) { const int col = 4 * ln + 256 * j; gtv[j] = *(const f32x4*)(gt2 + col); xcur[j] = *(const u32x2*)(X1 + (size_t)(tok0 + sub * TPS) * D + col); }
#pragma unroll
            for (int kk = 0; kk < TPS; ++kk) {
                const int tok = tok0 + sub * TPS + kk;
                if (kk + 1 < TPS) {
#pragma unroll
                    for (int j = 0; j < 4; ++j) xnxt[j] = __builtin_nontemporal_load((const u32x2*)(X1 + (size_t)(tok + 1) * D + 4 * ln + 256 * j));
                }
                f32x4 x2[4]; float ss = 0.f;
#pragma unroll
                for (int j = 0; j < 4; ++j) {
#pragma unroll
                    for (int i = 0; i < 4; ++i) { const unsigned xw = (i >> 1) ? xcur[j].y : xcur[j].x; const float xf = (i & 1) ? bfhi(xw) : bflo(xw);
                        const float v = xf + gtv[j][i] * (0.0625f * (float)acc[kk][2 * j + (i >> 1)][i & 1]); x2[j][i] = v; ss += v * v; } }
                ss = wave_sum_x(ss, ln);
                if (!(FAKE && ss != 12345.678f)) {
                    const float rstd = 1.0f / sqrtf(ss * (1.0f / D) + EPS);
                    f32x4 fgv[4];
#pragma unroll
                    for (int j = 0; j < 4; ++j) fgv[j] = *(const f32x4*)(fg + 4 * ln + 256 * j);
#pragma unroll
                    for (int j = 0; j < 4; ++j) __builtin_nontemporal_store(x2[j] * rstd * fgv[j], (f32x4*)(outp + (size_t)tok * D + 4 * ln + 256 * j));
                }
#pragma unroll
                for (int j = 0; j < 4; ++j) xcur[j] = xnxt[j];
            }
        }
        }
    }
}

struct Args { const float* in[18]; float* out; unsigned char* ws; };
__global__ void __launch_bounds__(NTHR, 2) mega_fwd(Args args) {
    extern __shared__ __attribute__((aligned(16))) unsigned char lds[];
    Frame F;
    F.lds = (LAS unsigned char*)lds;
    F.wave = __builtin_amdgcn_readfirstlane((int)threadIdx.x >> 6); F.lane = lane_fresh(); F.tid = F.wave * 64 + F.lane;
    F.G = gridDim.x; { const int bx = blockIdx.x; F.vcu = (F.G % 8 == 0) ? (bx % 8) * (F.G / 8) + bx / 8 : bx; }
    volatile LAS unsigned* MISC = (volatile LAS unsigned*)(F.lds + MISC_OFF);
    for (int u = F.tid; u < (LDS_BYTES - LDSCTL_OFF) / 4; u += NTHR) ((LAS unsigned*)(F.lds + LDSCTL_OFF))[u] = 0u;
    __syncthreads();
    gu32* ctl = (gu32*)(((unsigned char*)karg(19)) + WS_CTL);
    XcdBarrier bar = xcd_barrier_post((unsigned*)(ctl + CW_BAR), MISC + 8, F.wave);
#define GRID_BAR() xcd_barrier(bar)
#define PROBE_TS -1
#define STAMP(i) do { if (PROBE_TS >= 0 && blockIdx.x == 0 && F.tid == 0) { const unsigned long long t_ = __builtin_amdgcn_s_memrealtime(); MISC[16 + 2 * (i)] = (unsigned)t_; MISC[17 + 2 * (i)] = (unsigned)(t_ >> 32); } } while (0)
#define PROBE_DBL -1

    STAMP(0);
    F.lane = lane_fresh(); F.tid = F.wave * 64 + F.lane;
    p0_prologue(F); GRID_BAR(); STAMP(1);
    if (PROBE_DBL == 0) { p0_prologue(F); GRID_BAR(); }
    F.lane = lane_fresh(); F.tid = F.wave * 64 + F.lane;
    p1_norm(F); p0_transposes(F); GRID_BAR(); STAMP(2);
    if (PROBE_DBL == 1) { p1_norm(F); GRID_BAR(); }
    {
    {
        pg8::Gemm g{(const pg8::bf16_t*)(((unsigned char*)karg(19)) + WS_H), (const pg8::bf16_t*)(((unsigned char*)karg(19)) + WS_WIN), M, NPROJ, D, nullptr, nullptr};
        pg8::StaticOrder S; S.init(M, NPROJ, F.G, (int)blockIdx.x);
        pg8::EpiBf16<0> E{(pg8::bf16_t*)(((unsigned char*)karg(19)) + WS_PROJ), NPROJ, nullptr, 0, 0, 1.f};
        pg8::gemm_phase<pg8::EpiBf16<0>, pg8::StaticOrder, true, true>(F.lds + RING_OFF, g, S, E, F.wave);
        const int nwg = (M / 256) * (NPROJ / 256), busy = nwg % F.G;
        if (busy == 0) p0_quant_tables(F, F.vcu * NWAVES + F.wave, F.G * NWAVES);
        else if ((int)blockIdx.x >= busy) p0_quant_tables(F, ((int)blockIdx.x - busy) * NWAVES + F.wave, (F.G - busy) * NWAVES);
    }
    GRID_BAR(); STAMP(3);
    }
    F.lane = lane_fresh(); F.tid = F.wave * 64 + F.lane;
    p3_attention(F); GRID_BAR(); STAMP(4);
    if (PROBE_DBL == 3) { p3_attention(F); GRID_BAR(); }
    {
    {
        pg8::Gemm g{(const pg8::bf16_t*)(((unsigned char*)karg(19)) + WS_OA), (const pg8::bf16_t*)(((unsigned char*)karg(19)) + WS_WA), M, D, 512, (const pg8::bf16_t*)(((unsigned char*)karg(19)) + WS_OB), (const pg8::bf16_t*)(((unsigned char*)karg(19)) + WS_WB)};
        PairOrder S; S.S.init(M, D, F.G, (int)blockIdx.x);
        EpiGate E{(const bf16*)(((unsigned char*)karg(19)) + WS_PROJ), (bf16*)((float*)karg(18)) + (size_t)M * D};
        pg8::gemm_phase<EpiGate, PairOrder, true, true>(F.lds + RING_OFF, g, S, E, F.wave);
    }
    GRID_BAR(); STAMP(5);
    }
    {
    {
        pg8::Gemm g{(const pg8::bf16_t*)((bf16*)((float*)karg(18)) + (size_t)M * D), (const pg8::bf16_t*)(((unsigned char*)karg(19)) + WS_WOUT), M, D, D, nullptr, nullptr};
        pg8::StaticOrder S; S.init(M, D, F.G, (int)blockIdx.x);
        EpiRes E{((const float*)karg(0)), (const float*)(((unsigned char*)karg(19)) + WS_MOD), (bf16*)(((unsigned char*)karg(19)) + WS_X1)};
        pg8::gemm_phase<EpiRes, pg8::StaticOrder, true, true>(F.lds + RING_OFF, g, S, E, F.wave);
    }
    GRID_BAR(); STAMP(6);
    }
    F.lane = lane_fresh(); F.tid = F.wave * 64 + F.lane;
    F.lane = lane_fresh(); F.tid = F.wave * 64 + F.lane;
    p6_norm2(F); GRID_BAR(); STAMP(7);
    if (PROBE_DBL == 6) { p6_norm2(F); GRID_BAR(); }
    {
    {
        pg8::Gemm g{(const pg8::bf16_t*)(((unsigned char*)karg(19)) + WS_H2), (const pg8::bf16_t*)(((unsigned char*)karg(19)) + WS_WQ), M, D, D, nullptr, nullptr};
        pg8::StaticOrder S; S.init(M, D, F.G, (int)blockIdx.x);
        pg8::EpiBf16<0> E{(pg8::bf16_t*)(((unsigned char*)karg(19)) + WS_QP), D, nullptr, 0, 0, 1.f};
        pg8::gemm_phase<pg8::EpiBf16<0>, pg8::StaticOrder, true, true>(F.lds + RING_OFF, g, S, E, F.wave);
    }
    GRID_BAR(); STAMP(8);
    }
    F.lane = lane_fresh(); F.tid = F.wave * 64 + F.lane;
    p8a_topk(F); __syncthreads(); STAMP(9);
    if (PROBE_DBL == 8) { p8a_topk(F); GRID_BAR(); }
    if (PROBE_DBL == 12) { p8b_sweep<1>(F); __syncthreads(); }
    p8b_sweep<0>(F);
    if (PROBE_DBL == 9) { GRID_BAR(); p8b_sweep<0>(F); }
    if (PROBE_TS >= 0) {
        GRID_BAR(); STAMP(10);
        if (blockIdx.x == 0) { __syncthreads();
            const unsigned long long t0 = ((unsigned long long)MISC[17 + 2 * PROBE_TS] << 32) | MISC[16 + 2 * PROBE_TS], t1 = ((unsigned long long)MISC[19 + 2 * PROBE_TS] << 32) | MISC[18 + 2 * PROBE_TS];
            const float d_us = (float)(t1 - t0) * 0.01f;
            const float V = 128.0f * sqrtf(d_us * 1e-5f);
            float* o = (float*)karg(18); for (int c = F.tid; c < D; c += NTHR) o[c] = V; }
    }
}

extern "C" void kernel_launch(void* const* d_in, const int* in_sizes, int n_in, void* d_out, int out_size, void* d_ws, size_t ws_size, hipStream_t stream) {
    static int grid = 0;
    if (grid == 0) {
        if (n_in != 18 || in_sizes[0] != M * D || out_size != M * D || ws_size < WS_END) { fprintf(stderr, "kernel_launch: unexpected shapes (n_in %d, in0 %d, out %d, ws %zu)\n", n_in, n_in > 0 ? in_sizes[0] : -1, out_size, ws_size); grid = -1; return; }
        int dev = 0, cus = 0, per_cu = 0;
        if (hipGetDevice(&dev) != hipSuccess || hipDeviceGetAttribute(&cus, hipDeviceAttributeMultiprocessorCount, dev) != hipSuccess) { grid = -1; return; }
        if (hipFuncSetAttribute((const void*)mega_fwd, hipFuncAttributeMaxDynamicSharedMemorySize, LDS_BYTES) != hipSuccess) { fprintf(stderr, "kernel_launch: hipFuncSetAttribute failed\n"); grid = -1; return; }
        if (hipOccupancyMaxActiveBlocksPerMultiprocessor(&per_cu, (const void*)mega_fwd, NTHR, LDS_BYTES) != hipSuccess || per_cu < 1) { fprintf(stderr, "kernel_launch: occupancy query says %d blocks per CU\n", per_cu); }
        (void)hipGetLastError();
        grid = cus;
    }
    if (grid < 0) return;
    if (hipMemsetAsync((char*)d_ws + WS_CTL, 0, CTL_ZERO_BYTES, stream) != hipSuccess) { fprintf(stderr, "kernel_launch: memset failed\n"); return; }
    Args a{};
    for (int i = 0; i < 18; ++i) a.in[i] = (const float*)d_in[i];
    a.out = (float*)d_out; a.ws = (unsigned char*)d_ws;
    hipLaunchKernelGGL(mega_fwd, dim3(grid), dim3(NTHR), LDS_BYTES, stream, a);
}
```

```cpp
#include <hip/hip_runtime.h>
#include <cstdio>
#include <cstdint>
__device__ __forceinline__ int lane_fresh() { unsigned ones = ~0u; asm volatile("" : "+s"(ones)); return (int)__builtin_amdgcn_mbcnt_hi(ones, __builtin_amdgcn_mbcnt_lo(ones, 0u)); }
namespace pg8 {
#define PG8_LAS __attribute__((address_space(3)))
typedef unsigned short bf16_t;
typedef short bf16x8 __attribute__((ext_vector_type(8)));
typedef float f32x4 __attribute__((ext_vector_type(4)));
typedef unsigned u32x4 __attribute__((ext_vector_type(4)));
constexpr int BM = 256, BK = 64, HALF = 128, HTB = HALF * BK * 2  , STAGE_BYTES = 8 * HTB, NXCD = 8, WGM = 8;

__host__ __device__ __forceinline__ int lds_byte(int r, int c) { const int st = (r >> 4) * 2 + (c >> 5), rr = r & 15, cc = c & 31, ob = rr * 64 + cc * 2; return st * 1024 + (ob ^ (((ob >> 9) & 1) << 5)); }
__host__ __device__ __forceinline__ void stage_rc(int b, int& R, int& C) { const int st = b / 1024, sb = b % 1024, swz = sb ^ (((sb >> 9) & 1) << 5); R = (st >> 1) * 16 + swz / 64; C = (st & 1) * 32 + (swz % 64) / 2; }
__host__ __device__ __forceinline__ int perm32(int rho) { const int n = rho >> 4, i = rho & 15; return 8 * (i >> 2) + 4 * n + (i & 3); }

struct Unit { int pm, pn, src; };
struct Gemm { const bf16_t* A; const bf16_t* Bt; int M, N, K; const bf16_t* A2; const bf16_t* Bt2; };

struct StaticOrder {
    int nM, nN, nwg, G, c;
    __host__ __device__ void init(int M, int N, int G_, int c_) { nM = M / BM; nN = N / BM; nwg = nM * nN; G = G_; c = c_; }
    __host__ __device__ bool next(int i, Unit& u) const {
        const long L = (long)i * G + c; if (L >= nwg) return false;
        int wgid = (int)L; { const int q = nwg / NXCD, r = nwg % NXCD, xcd = wgid % NXCD, off = wgid / NXCD; wgid = (xcd < r ? xcd * (q + 1) : r * (q + 1) + (xcd - r) * q) + off; }
        const int nig = WGM * nN, gid = wgid / nig, fm = gid * WGM, gsz = (nM - fm) < WGM ? (nM - fm) : WGM;
        u.pm = fm + ((wgid % nig) % gsz); u.pn = (wgid % nig) / gsz; u.src = 0; return true;
    }
    __device__ __forceinline__ void a_ready(const Unit&) const {}
    __device__ __forceinline__ void done(const Unit&) const {}
};

__device__ __forceinline__ unsigned cvt_pk_bf16(float lo, float hi) { unsigned r; asm volatile("v_cvt_pk_bf16_f32 %0, %1, %2" : "=v"(r) : "v"(lo), "v"(hi)); return r; }
typedef float f32x2 __attribute__((ext_vector_type(2)));
__device__ __forceinline__ f32x2 gelu_pk(f32x2 v) {
    const f32x2 av = __builtin_elementwise_abs(v), d = av * 0.2316418882f + 1.0f;
    f32x2 t; t.x = __builtin_amdgcn_rcpf(d.x); t.y = __builtin_amdgcn_rcpf(d.y);
    f32x2 q = t * 0.5307027145f + (-0.7265760135f); q = q * t + 0.7107068705f; q = q * t + (-0.142248368f); q = q * t + 0.127414796f; q = q * t;
    const f32x2 s = (v * v) * (-0.72134752044f);
    f32x2 e; e.x = __builtin_amdgcn_exp2f(s.x); e.y = __builtin_amdgcn_exp2f(s.y);
    const f32x2 m = v * (q * e), r = v - m;
    f32x2 o; o.x = v.x < 0.f ? m.x : r.x; o.y = v.y < 0.f ? m.y : r.y; return o;
}

template <int ACT  > struct EpiBf16 {
    static constexpr bool PERM = true, AFTER_DRAIN = false, CHAIN = false; static_assert(ACT == 0 || ACT == 1, "EpiBf16: ACT is 0 (none) or 1 (gelu_pk)");
    bf16_t* O; int ldc; const float* bias; int split_cols; size_t split_stride; float scale0;
    __device__ __forceinline__ void operator()(const f32x4 (&acc)[2][2][4][2], const Unit& u, int wr, int wc, int fr, int fq) const {
        const int row0 = u.pm * BM + wr * 64 + fr; int colt = u.pn * BM; bf16_t* base = O;
        float sc = 1.f; if (split_cols) { const int t = colt / split_cols; base += (size_t)t * split_stride; colt -= t * split_cols; if (t == 0) sc = scale0; }
        const int col0 = colt + wc * 32 + 8 * fq, bcol0 = u.pn * BM + wc * 32 + 8 * fq;
        f32x4 bv[2][2];
#pragma unroll
        for (int bj = 0; bj < 2; ++bj)
#pragma unroll
            for (int n = 0; n < 2; ++n) bv[bj][n] = bias ? *(const f32x4*)(bias + bcol0 + bj * HALF + 4 * n) : (f32x4){0.f, 0.f, 0.f, 0.f};
#pragma unroll
        for (int ai = 0; ai < 2; ++ai)
#pragma unroll
            for (int m = 0; m < 4; ++m) { bf16_t* rowp = base + (size_t)(row0 + ai * HALF + m * 16) * ldc + col0;
#pragma unroll
                for (int bj = 0; bj < 2; ++bj) { f32x4 v0 = acc[ai][bj][m][0] + bv[bj][0], v1 = acc[ai][bj][m][1] + bv[bj][1];
                    if (ACT == 1) { f32x2 a = gelu_pk((f32x2){v0[0], v0[1]}), b = gelu_pk((f32x2){v0[2], v0[3]}), c = gelu_pk((f32x2){v1[0], v1[1]}), d = gelu_pk((f32x2){v1[2], v1[3]});
                        v0 = (f32x4){a.x, a.y, b.x, b.y}; v1 = (f32x4){c.x, c.y, d.x, d.y}; }
                    v0 = v0 * sc; v1 = v1 * sc; u32x4 w; w.x = cvt_pk_bf16(v0[0], v0[1]); w.y = cvt_pk_bf16(v0[2], v0[3]); w.z = cvt_pk_bf16(v1[0], v1[1]); w.w = cvt_pk_bf16(v1[2], v1[3]);
                    *(u32x4*)(rowp + bj * HALF) = w; } }
    }
};

template <class Epi, class Sched, bool ALIGN_EPI = false, bool SP2 = false>
__device__ __forceinline__ void gemm_phase(PG8_LAS unsigned char* lds, const Gemm g, const Sched& S, const Epi& E, int wave_id) {
    int tid = wave_id * 64 + ::lane_fresh(); asm volatile("" : "+v"(tid));
    const int wid = __builtin_amdgcn_readfirstlane(tid >> 6), lane = tid & 63, wr = wid >> 2, wc = wid & 3, fr = lane & 15, fq = lane >> 4;
    const int K = g.K, nt = K / BK;
    unsigned voffA[2], voffB[2];
#pragma unroll
    for (int i = 0; i < 2; ++i) { int R, C; stage_rc(tid * 16 + i * 8192, R, C); const int Rb = Epi::PERM ? ((R & ~31) + perm32(R & 31)) : R;
        voffA[i] = (unsigned)(R * K + C) * 2u; voffB[i] = (unsigned)(Rb * K + C) * 2u; }
    const size_t kstep = (size_t)(BK * 2);
    const size_t hstep = (size_t)HALF * K * 2;
    const size_t tstep = 2 * hstep;
    const unsigned ldsw = (unsigned)wid * 1024u;
    const int aoff = lds_byte(wr * 64 + fr, fq * 8), boff = lds_byte(wc * 32 + fr, fq * 8);
#define PG8_SA(b, h) (((b) * 2 + (h)) * HTB)
#define PG8_SB(b, h) ((4 + (b) * 2 + (h)) * HTB)
#define PG8_STAGE(bufoff, gbase, voff) do { _Pragma("unroll") for (int _i = 0; _i < 2; ++_i) \
        __builtin_amdgcn_global_load_lds((const unsigned*)((const char*)(gbase) + (voff)[_i]), (PG8_LAS unsigned*)(lds + (bufoff) + ldsw + _i * 8192), 16, 0, 0); } while (0)
#define PG8_LDA(dst, b, h) do { _Pragma("unroll") for (int m = 0; m < 4; ++m) _Pragma("unroll") for (int k = 0; k < 2; ++k) dst[m][k] = *(const PG8_LAS bf16x8*)(lds + PG8_SA(b, h) + aoff + m * 2048 + k * 1024); } while (0)
#define PG8_LDB(dst, b, h) do { _Pragma("unroll") for (int n = 0; n < 2; ++n) _Pragma("unroll") for (int k = 0; k < 2; ++k) dst[n][k] = *(const PG8_LAS bf16x8*)(lds + PG8_SB(b, h) + boff + n * 2048 + k * 1024); } while (0)
#define PG8_MMA(ai, bj, At, Bt) do { __builtin_amdgcn_s_setprio(1); _Pragma("unroll") for (int m = 0; m < 4; ++m) _Pragma("unroll") for (int n = 0; n < 2; ++n) _Pragma("unroll") for (int k = 0; k < 2; ++k) \
        acc[ai][bj][m][n] = __builtin_amdgcn_mfma_f32_16x16x32_bf16(Bt[n][k], At[m][k], acc[ai][bj][m][n], 0, 0, 0); __builtin_amdgcn_s_setprio(0); } while (0)
#define PG8_WAIT_V(n) asm volatile("s_waitcnt vmcnt(" #n ")" ::: "memory")
#define PG8_WAIT_L(n) asm volatile("s_waitcnt lgkmcnt(" #n ")" ::: "memory")
#define PG8_BAR __builtin_amdgcn_s_barrier()
#define PG8_SCHED __builtin_amdgcn_sched_barrier(0)
    Unit cur, nxt; int ui = 0;
    if (!S.next(0, cur)) return;
    f32x4 acc[2][2][4][2];
#pragma unroll
    for (int a = 0; a < 2; ++a)
#pragma unroll
        for (int b = 0; b < 2; ++b)
#pragma unroll
            for (int m = 0; m < 4; ++m)
#pragma unroll
                for (int n = 0; n < 2; ++n) acc[a][b][m][n] = (f32x4){0.f, 0.f, 0.f, 0.f};
    bf16x8 At[4][2], B0[2][2], B1[2][2];
    const char* cA = (const char*)(cur.src ? g.A2 : g.A) + (size_t)cur.pm * tstep; const char* cB = (const char*)(cur.src ? g.Bt2 : g.Bt) + (size_t)cur.pn * tstep;
    S.a_ready(cur);
    if constexpr (SP2) {
        PG8_STAGE(PG8_SB(0, 0), cB, voffB); PG8_STAGE(PG8_SB(0, 1), cB + hstep, voffB); PG8_STAGE(PG8_SA(0, 0), cA, voffA); PG8_STAGE(PG8_SA(0, 1), cA + hstep, voffA);
        if (wr == 1) PG8_BAR;
        PG8_WAIT_V(2); PG8_BAR;
        PG8_STAGE(PG8_SB(1, 0), cB + kstep, voffB); PG8_STAGE(PG8_SA(1, 0), cA + kstep, voffA); PG8_STAGE(PG8_SB(1, 1), cB + hstep + kstep, voffB);
        PG8_WAIT_V(6); PG8_BAR;
    } else {
        PG8_STAGE(PG8_SB(0, 0), cB, voffB); PG8_STAGE(PG8_SA(0, 0), cA, voffA); PG8_STAGE(PG8_SB(0, 1), cB + hstep, voffB); PG8_STAGE(PG8_SA(0, 1), cA + hstep, voffA);
        if (wr == 1) PG8_BAR;
        PG8_WAIT_V(4); PG8_BAR;
        PG8_STAGE(PG8_SB(1, 0), cB + kstep, voffB); PG8_STAGE(PG8_SA(1, 0), cA + kstep, voffA); PG8_STAGE(PG8_SB(1, 1), cB + hstep + kstep, voffB);
        PG8_WAIT_V(6); PG8_BAR;
    }
    for (;;) {
        const bool has_next = S.next(ui + 1, nxt);
        const char* nA = has_next ? (const char*)(nxt.src ? g.A2 : g.A) + (size_t)nxt.pm * tstep : cA; const char* nB = has_next ? (const char*)(nxt.src ? g.Bt2 : g.Bt) + (size_t)nxt.pn * tstep : cB;
        for (int t = 0; t < nt; t += 2) {
            const bool last = (t == nt - 2);
            const char* a1 = cA + (size_t)(t + 1) * kstep;
            const char* a2 = last ? nA : cA + (size_t)(t + 2) * kstep; const char* b2 = last ? nB : cB + (size_t)(t + 2) * kstep;
            const char* a3 = a2 + kstep; const char* b3 = b2 + kstep;
            if (last && has_next) S.a_ready(nxt);
            if constexpr (SP2) {
            PG8_LDB(B0, 0, 0); PG8_LDB(B1, 0, 1); PG8_SCHED; PG8_LDA(At, 0, 0); PG8_STAGE(PG8_SA(1, 1), a1 + hstep, voffA);
            PG8_WAIT_V(8); PG8_WAIT_L(0); PG8_BAR; PG8_MMA(0, 0, At, B0); PG8_MMA(0, 1, At, B1); PG8_BAR; PG8_SCHED;
            PG8_LDA(At, 0, 1); PG8_STAGE(PG8_SB(0, 0), b2, voffB); PG8_STAGE(PG8_SB(0, 1), b2 + hstep, voffB); PG8_STAGE(PG8_SA(0, 0), a2, voffA);
            PG8_WAIT_V(8); PG8_WAIT_L(0); PG8_BAR; PG8_MMA(1, 0, At, B0); PG8_MMA(1, 1, At, B1); PG8_BAR; PG8_SCHED;
            PG8_LDB(B0, 1, 0); PG8_LDB(B1, 1, 1); PG8_SCHED; PG8_LDA(At, 1, 0); PG8_STAGE(PG8_SA(0, 1), a2 + hstep, voffA);
            PG8_WAIT_V(8); PG8_WAIT_L(0); PG8_BAR; PG8_MMA(0, 0, At, B0); PG8_MMA(0, 1, At, B1); PG8_BAR; PG8_SCHED;
            PG8_LDA(At, 1, 1); PG8_STAGE(PG8_SB(1, 0), b3, voffB); PG8_STAGE(PG8_SB(1, 1), b3 + hstep, voffB); PG8_STAGE(PG8_SA(1, 0), a3, voffA);
            PG8_WAIT_V(8); PG8_WAIT_L(0); PG8_BAR; PG8_MMA(1, 0, At, B0); PG8_MMA(1, 1, At, B1); PG8_BAR; PG8_SCHED;
            } else {
            PG8_LDB(B0, 0, 0); PG8_SCHED; PG8_LDA(At, 0, 0); PG8_STAGE(PG8_SA(1, 1), a1 + hstep, voffA);
            PG8_WAIT_L(8); PG8_BAR; PG8_WAIT_L(0); PG8_MMA(0, 0, At, B0); PG8_BAR; PG8_SCHED;
            PG8_LDB(B1, 0, 1); PG8_STAGE(PG8_SB(0, 0), b2, voffB);
            PG8_BAR; PG8_WAIT_L(0); PG8_MMA(0, 1, At, B1); PG8_BAR;
            PG8_LDA(At, 0, 1); PG8_STAGE(PG8_SA(0, 0), a2, voffA);
            PG8_BAR; PG8_WAIT_L(0); PG8_MMA(1, 0, At, B0); PG8_BAR; PG8_SCHED;
            PG8_STAGE(PG8_SB(0, 1), b2 + hstep, voffB);
            PG8_WAIT_V(6); PG8_BAR; PG8_MMA(1, 1, At, B1); PG8_BAR;
            PG8_LDB(B0, 1, 0); PG8_SCHED; PG8_LDA(At, 1, 0); PG8_STAGE(PG8_SA(0, 1), a2 + hstep, voffA);
            PG8_WAIT_L(8); PG8_BAR; PG8_WAIT_L(0); PG8_MMA(0, 0, At, B0); PG8_BAR; PG8_SCHED;
            PG8_LDB(B1, 1, 1); PG8_STAGE(PG8_SB(1, 0), b3, voffB);
            PG8_BAR; PG8_WAIT_L(0); PG8_MMA(0, 1, At, B1); PG8_BAR;
            PG8_LDA(At, 1, 1); PG8_STAGE(PG8_SA(1, 0), a3, voffA);
            PG8_BAR; PG8_WAIT_L(0); PG8_MMA(1, 0, At, B0); PG8_BAR; PG8_SCHED;
            PG8_STAGE(PG8_SB(1, 1), b3 + hstep, voffB);
            PG8_WAIT_V(6); PG8_BAR; PG8_MMA(1, 1, At, B1); PG8_BAR;
            }
        }
        if constexpr (ALIGN_EPI) { if (wr == 0) PG8_BAR; }
        if constexpr (!Epi::AFTER_DRAIN) { E(acc, cur, wr, wc, fr, fq); S.done(cur); }
        if (!has_next) break;
        if (!(Epi::CHAIN && cur.src == 0)) {
#pragma unroll
        for (int a = 0; a < 2; ++a)
#pragma unroll
            for (int b = 0; b < 2; ++b)
#pragma unroll
                for (int m = 0; m < 4; ++m)
#pragma unroll
                    for (int n = 0; n < 2; ++n) acc[a][b][m][n] = (f32x4){0.f, 0.f, 0.f, 0.f};
        }
        cur = nxt; cA = nA; cB = nB; ++ui;
        if constexpr (ALIGN_EPI) { if (wr == 1) PG8_BAR; }
    }
    PG8_WAIT_V(0);
    if constexpr (!ALIGN_EPI) { if (wr == 0) PG8_BAR; }
    PG8_BAR;
    if constexpr (Epi::AFTER_DRAIN) { E.fused(acc, cur, wr, wc, fr, fq, lds, wid, lane); S.done(cur); }
#undef PG8_SA
#undef PG8_SB
#undef PG8_STAGE
#undef PG8_LDA
#undef PG8_LDB
#undef PG8_MMA
#undef PG8_WAIT_V
#undef PG8_WAIT_L
#undef PG8_BAR
#undef PG8_SCHED
}
}

#define GAS __attribute__((address_space(1)))
#define LAS __attribute__((address_space(3)))
typedef unsigned short bf16;
typedef unsigned v4u __attribute__((ext_vector_type(4)));
typedef float f32x4 __attribute__((ext_vector_type(4)));
typedef short bf16x8 __attribute__((ext_vector_type(8)));
typedef GAS unsigned gu32;
typedef GAS unsigned long long gu64;
#define RLX_AGENT __ATOMIC_RELAXED, __HIP_MEMORY_SCOPE_AGENT
#define LDS_WAIT() asm volatile("s_waitcnt lgkmcnt(0)" ::: "memory")
#define VM_WAIT() asm volatile("s_waitcnt vmcnt(0)" ::: "memory")
__device__ __forceinline__ unsigned long long rt() { return __builtin_amdgcn_s_memrealtime(); }
__device__ __forceinline__ unsigned f2bf(float f) { unsigned u = __builtin_bit_cast(unsigned, f); return (u + 0x7fffu + ((u >> 16) & 1u)) >> 16; }
__device__ __forceinline__ unsigned pk2(float lo, float hi) { return f2bf(lo) | (f2bf(hi) << 16); }

__device__ __forceinline__ const void* karg(int i);
constexpr int CW_BAR_FWD = 4096;
#define XB_TMO      128
#define XB_XCNT(j)  (256  + 64 * (j))
#define XB_XSUB(j)  (1280 + 64 * (j))
#define XB_XGEN(j)  (2304 + 64 * (j))
#define XB_TOP      3328
#define XB_TOPGEN   3392
#define XCD_BAR_WORDS 3456
#define XB_SPIN_CAP (1u << 18)

__device__ __forceinline__ unsigned xb_ld(unsigned* p)              { return __hip_atomic_load(p, __ATOMIC_RELAXED, __HIP_MEMORY_SCOPE_AGENT); }
__device__ __forceinline__ unsigned xb_add(unsigned* p, unsigned v) { return __hip_atomic_fetch_add(p, v, __ATOMIC_RELAXED, __HIP_MEMORY_SCOPE_AGENT); }
__device__ __forceinline__ unsigned xb_xcc_id() { return (unsigned)__builtin_amdgcn_s_getreg((3 << 11) | 20) & 0xFu; }
#define XB_SPIN(cond, bar) do { unsigned _sp = 0; while (cond) { __builtin_amdgcn_s_sleep(1); \
    if ((++_sp & 255u) == 0u) { if (xb_ld(&(bar)[XB_TMO])) break; if (_sp > XB_SPIN_CAP) { atomicAdd(&(bar)[XB_TMO], 1u); break; } } } } while (0)

struct XcdBarrier {
    int wave;
    unsigned* bar; unsigned x;
    volatile LAS unsigned* st;
};

__device__ __forceinline__ XcdBarrier xcd_barrier_post(unsigned* bar, volatile LAS unsigned* st, int wave) {
    XcdBarrier b; b.wave = wave; b.bar = bar; b.x = xb_xcc_id(); b.st = st;
    if (wave == 0 && lane_fresh() == 0) (void)xb_add(&bar[XB_XCNT(b.x)], 1u);
    return b;
}
__device__ __forceinline__ void xcd_barrier_complete(unsigned* bar, unsigned x, unsigned& nloc, unsigned& nx) {
    const unsigned G = gridDim.x * gridDim.y * gridDim.z;
    unsigned sum, cnt, mine, sp = 0u;
    for (;;) {
        sum = 0u; cnt = 0u; mine = 0u;
#pragma unroll
        for (unsigned j = 0; j < 16; ++j) { const unsigned c = xb_ld(&bar[XB_XCNT(j)]); sum += c; cnt += (c > 0u) ? 1u : 0u; mine = (j == x) ? c : mine; }
        if (sum == G) break;
        __builtin_amdgcn_s_sleep(1);
        if ((++sp & 255u) == 0u) { if (xb_ld(&bar[XB_TMO])) break; if (sp > XB_SPIN_CAP) { atomicAdd(&bar[XB_TMO], 1u); break; } }
    }
    nloc = mine > 0u ? mine : 1u; nx = cnt > 0u ? cnt : 1u;
}

__device__ __forceinline__ void xcd_barrier(const XcdBarrier& b) {
    asm volatile("s_waitcnt vmcnt(0)" ::: "memory");
    __syncthreads();
    if (b.wave == 0 && lane_fresh() == 0) {
        unsigned* bar = (unsigned*)((gu32*)((unsigned char*)karg(19)) + CW_BAR_FWD);
        __builtin_amdgcn_s_waitcnt(0);
        unsigned nloc = b.st[0], nx = b.st[1];
        if (nloc == 0u) { xcd_barrier_complete(bar, b.x, nloc, nx); b.st[0] = nloc; b.st[1] = nx; }
        const unsigned old = xb_add(&bar[XB_XSUB(b.x)], 1u);
        const unsigned gen = old / nloc;
        if (old + 1u == (gen + 1u) * nloc) {
            __builtin_amdgcn_fence(__ATOMIC_RELEASE, "agent");
            asm volatile("s_waitcnt vmcnt(0)" ::: "memory");
            const unsigned og = xb_add(&bar[XB_TOP], 1u);
            const unsigned tg = og / nx;
            if (og + 1u == (tg + 1u) * nx) xb_add(&bar[XB_TOPGEN], 1u);
            else XB_SPIN(xb_ld(&bar[XB_TOPGEN]) == tg, bar);
            __builtin_amdgcn_fence(__ATOMIC_ACQUIRE, "agent");
            xb_add(&bar[XB_XGEN(b.x)], 1u);
            asm volatile("s_waitcnt vmcnt(0)" ::: "memory");
        } else {
            XB_SPIN(xb_ld(&bar[XB_XGEN(b.x)]) == gen, bar);
            __builtin_amdgcn_fence(__ATOMIC_ACQUIRE, "agent");
            asm volatile("s_waitcnt vmcnt(0)" ::: "memory");
        }
    }
    __syncthreads();
}

constexpr int NWAVES = 8, NTHR = 512;
constexpr int BATCH = 4, SEQ = 4096, D = 1024, M = BATCH * SEQ;
constexpr int NPROJ = 4352, LDW_IN = 4360, NMOD = 6144;
constexpr int C_QA = 0, C_KA = 512, C_VA = 640, C_QB = 768, C_KB = 1280, C_VB = 1792, C_GLA = 2304, C_GLB = 3328;
constexpr int NEXP = 16384;
constexpr float EPS = 1e-6f;

constexpr size_t MiB = 1u << 20;
constexpr size_t WS_CTL = 0, CTL_ZERO_BYTES = 1 * MiB;
constexpr size_t WS_MOD = 1 * MiB, WS_LOGF = 1 * MiB + 128 * 1024, WS_SUBK = 2 * MiB;
constexpr size_t WS_WIN = 4 * MiB, WS_WA = 12 * MiB + 512 * 1024, WS_WB = 13 * MiB + 512 * 1024, WS_WOUT = 14 * MiB + 512 * 1024, WS_WQ = 16 * MiB + 512 * 1024;
constexpr size_t WS_ED = 19 * MiB, WS_EU = 35 * MiB;
constexpr size_t WS_EDS = 2 * MiB + 512 * 1024;
constexpr size_t WS_H2Q = 95 * MiB, WS_H2S = 111 * MiB;
constexpr size_t WS_H = 83 * MiB, WS_OA = 83 * MiB, WS_OB = 99 * MiB, WS_PIDX = 83 * MiB, WS_PG = 87 * MiB;
constexpr size_t WS_PROJ = 115 * MiB, WS_X1 = 115 * MiB, WS_H2 = 179 * MiB, WS_QP = 211 * MiB;
constexpr size_t WS_END = 251 * MiB;
static_assert(WS_WIN + (size_t)NPROJ * D * 2 <= WS_WA && WS_WQ + (size_t)D * D * 2 <= WS_ED && WS_PROJ + (size_t)M * NPROJ * 2 <= WS_END, "ws map");
constexpr int CW_BAR = 4096; static_assert(CW_BAR == CW_BAR_FWD && WS_CTL == 0, "barrier words");

constexpr int RING_OFF = 0, RING_BYTES = 131072;
constexpr int LDSCTL_OFF = RING_BYTES, MISC_OFF = LDSCTL_OFF + 320;
constexpr int LDS_BYTES = 147456;

typedef float f32x16 __attribute__((ext_vector_type(16)));
typedef short s16x4 __attribute__((ext_vector_type(4)));
typedef unsigned u32x2 __attribute__((ext_vector_type(2)));
typedef float f32x2_t __attribute__((ext_vector_type(2)));
typedef __bf16 bf16x2_t __attribute__((ext_vector_type(2)));

__device__ __forceinline__ unsigned cvtpk(float lo, float hi) { f32x2_t v = {lo, hi}; bf16x2_t b = __builtin_convertvector(v, bf16x2_t); return __builtin_bit_cast(unsigned, b); }
__device__ __forceinline__ float bflo(unsigned u) { return __uint_as_float(u << 16); }
__device__ __forceinline__ float bfhi(unsigned u) { return __uint_as_float(u & 0xffff0000u); }
template <int S> __device__ __forceinline__ unsigned xorx(unsigned v, int lane) {
    if constexpr (S == 1) return (unsigned)__builtin_amdgcn_update_dpp(0, (int)v, 0xB1, 0xF, 0xF, true);
    else if constexpr (S == 2) return (unsigned)__builtin_amdgcn_update_dpp(0, (int)v, 0x4E, 0xF, 0xF, true);
    else if constexpr (S == 4) { const unsigned a = (unsigned)__builtin_amdgcn_update_dpp(0, (int)v, 0x124, 0xF, 0xF, true), b = (unsigned)__builtin_amdgcn_update_dpp(0, (int)v, 0x12C, 0xF, 0xF, true); return (lane & 4) ? a : b; }
    else if constexpr (S == 8) return (unsigned)__builtin_amdgcn_update_dpp(0, (int)v, 0x128, 0xF, 0xF, true);
    else if constexpr (S == 16) { const auto r = __builtin_amdgcn_permlane16_swap(v, v, false, false); return (lane & 16) ? r[0] : r[1]; }
    else { const auto r = __builtin_amdgcn_permlane32_swap(v, v, false, false); return (lane & 32) ? r[0] : r[1]; }
}
__device__ __forceinline__ unsigned xorx_sw(unsigned v, int lane, int s) {
    switch (s) { case 1: return xorx<1>(v, lane); case 2: return xorx<2>(v, lane); case 4: return xorx<4>(v, lane); case 8: return xorx<8>(v, lane); case 16: return xorx<16>(v, lane); default: return xorx<32>(v, lane); }
}
__device__ __forceinline__ float wave_sum_x(float v, int lane) {
    v += __uint_as_float(xorx<1>(__float_as_uint(v), lane)); v += __uint_as_float(xorx<2>(__float_as_uint(v), lane)); v += __uint_as_float(xorx<4>(__float_as_uint(v), lane));
    v += __uint_as_float(xorx<8>(__float_as_uint(v), lane)); v += __uint_as_float(xorx<16>(__float_as_uint(v), lane)); v += __uint_as_float(xorx<32>(__float_as_uint(v), lane));
    return v;
}
__device__ __forceinline__ float dppf(float v, const int ctrl_sel) { return v; }
#define DPP_F(v, CTRL) __uint_as_float(__builtin_amdgcn_update_dpp(0, __float_as_uint(v), (CTRL), 0xF, 0xF, true))
__device__ __forceinline__ float reduce8_t(const float (&dd)[8], int lane) {
    float r4[4];
#pragma unroll
    for (int u = 0; u < 4; ++u) { const auto p = __builtin_amdgcn_permlane32_swap(__float_as_uint(dd[u]), __float_as_uint(dd[u + 4]), false, false); r4[u] = __uint_as_float(p[0]) + __uint_as_float(p[1]); }
    float r2[2];
#pragma unroll
    for (int u = 0; u < 2; ++u) { const auto p = __builtin_amdgcn_permlane16_swap(__float_as_uint(r4[u]), __float_as_uint(r4[u + 2]), false, false); r2[u] = __uint_as_float(p[0]) + __uint_as_float(p[1]); }
    const bool b3 = (lane & 8) != 0;
    const float keep = b3 ? r2[1] : r2[0], send = b3 ? r2[0] : r2[1];
    float r1 = keep + DPP_F(send, 0x128);
    r1 += DPP_F(r1, 0xB1);
    r1 += DPP_F(r1, 0x4E);
    r1 += DPP_F(r1, 0x141);
    return r1;
}
__device__ __forceinline__ int lane_id() { return (int)__builtin_amdgcn_mbcnt_hi(~0u, __builtin_amdgcn_mbcnt_lo(~0u, 0u)); }
__device__ __forceinline__ float wave_sum(float v) { return wave_sum_x(v, lane_id()); }
__device__ __forceinline__ float wave_max(float v) { const int lane = lane_id();
    v = fmaxf(v, __uint_as_float(xorx<1>(__float_as_uint(v), lane))); v = fmaxf(v, __uint_as_float(xorx<2>(__float_as_uint(v), lane))); v = fmaxf(v, __uint_as_float(xorx<4>(__float_as_uint(v), lane)));
    v = fmaxf(v, __uint_as_float(xorx<8>(__float_as_uint(v), lane))); v = fmaxf(v, __uint_as_float(xorx<16>(__float_as_uint(v), lane))); v = fmaxf(v, __uint_as_float(xorx<32>(__float_as_uint(v), lane)));
    return v; }
__device__ __forceinline__ int crow(int r, int hi) { return (r & 3) + 8 * (r >> 2) + 4 * hi; }
#define MFMA32(a, b, c) __builtin_amdgcn_mfma_f32_32x32x16_bf16((a), (b), (c), 0, 0, 0)

struct Frame {
    LAS unsigned char* lds;
    int tid, lane, wave, vcu, G;
};
__device__ __forceinline__ const void* karg(int i) {
    unsigned long z = 0; asm volatile("" : "+s"(z));
    const char* base = (const char*)__builtin_amdgcn_kernarg_segment_ptr();
    return *(const void* const*)(base + 8 * i + z);
}

__device__ __forceinline__ void p0_transpose_item(const float* W, int ld, int K, int ncols, bf16* WT, int row_off, LAS float* scr, int item, int lane) {
    const int nblk = ncols / 32, kb = item / nblk, nb = item % nblk, k0 = 64 * kb, n0 = 32 * nb;
#pragma unroll 8
    for (int i = 0; i < 32; ++i) { const int kk = 2 * i + (lane >> 5); scr[kk * 33 + (lane & 31)] = __builtin_nontemporal_load(W + (size_t)(k0 + kk) * ld + n0 + (lane & 31)); }
    LDS_WAIT(); asm volatile("" ::: "memory");
    const int c = lane & 7;
#pragma unroll
    for (int j = 0; j < 4; ++j) { const int n = (lane >> 3) + 8 * j; const LAS float* s = scr + (8 * c) * 33 + n;
        v4u o; o.x = pk2(s[0 * 33], s[1 * 33]); o.y = pk2(s[2 * 33], s[3 * 33]); o.z = pk2(s[4 * 33], s[5 * 33]); o.w = pk2(s[6 * 33], s[7 * 33]);
        *(GAS v4u*)(WT + (size_t)(row_off + n0 + n) * K + k0 + 8 * c) = o; }
    LDS_WAIT(); asm volatile("" ::: "memory");
}
__device__ __forceinline__ void p0_convert(const float* __restrict__ src, bf16* __restrict__ dst, long n_iters, int gw, int NGW, int lane) {
    for (long it0 = (long)gw * 4; it0 < n_iters; it0 += (long)NGW * 4) {
        f32x4 a[4][2];
#pragma unroll
        for (int u = 0; u < 4; ++u) { const long it = it0 + u; if (it < n_iters) { const float* p = src + it * 512 + lane * 4; a[u][0] = *(const f32x4*)p; a[u][1] = *(const f32x4*)(p + 256); } }
#pragma unroll
        for (int u = 0; u < 4; ++u) { const long it = it0 + u; if (it < n_iters) { bf16* q = dst + it * 512 + lane * 4;
            u32x2 w0, w1; w0.x = cvtpk(a[u][0].x, a[u][0].y); w0.y = cvtpk(a[u][0].z, a[u][0].w); w1.x = cvtpk(a[u][1].x, a[u][1].y); w1.y = cvtpk(a[u][1].z, a[u][1].w);
            *(u32x2*)q = w0; *(u32x2*)(q + 256) = w1; } }
    }
}

__device__ __forceinline__ void p0_quant_tables(Frame& F, int gw, int NGW) {
    const float* ed = ((const float*)karg(15)); const float* eu = ((const float*)karg(16));
    unsigned char* EDq = (unsigned char*)(((unsigned char*)karg(19)) + WS_ED); unsigned char* EUq = (unsigned char*)(((unsigned char*)karg(19)) + WS_EU); float* EDS = (float*)(((unsigned char*)karg(19)) + WS_EDS);
    const int lane = F.lane;
    for (int row0 = gw * 4; row0 < NEXP; row0 += NGW * 4) {
        f32x4 a[4][4], u[4][4];
#pragma unroll
        for (int q = 0; q < 4; ++q)
#pragma unroll
            for (int j = 0; j < 4; ++j) { a[q][j] = __builtin_nontemporal_load((const f32x4*)(ed + (size_t)(row0 + q) * D) + lane + 64 * j); u[q][j] = __builtin_nontemporal_load((const f32x4*)(eu + (size_t)(row0 + q) * D) + lane + 64 * j); }
#pragma unroll
        for (int q = 0; q < 4; ++q) {
            float am = 0.f;
#pragma unroll
            for (int j = 0; j < 4; ++j) am = fmaxf(fmaxf(am, fmaxf(fabsf(a[q][j].x), fabsf(a[q][j].y))), fmaxf(fabsf(a[q][j].z), fabsf(a[q][j].w)));
            am = wave_max(am);
            const float sc = am > 0.f ? am * (1.0f / 127.0f) : 1.0f, inv = 1.0f / sc;
            v4u qa, qu;
#pragma unroll
            for (int j = 0; j < 4; ++j) {
                const int b0 = (int)rintf(a[q][j].x * inv), b1 = (int)rintf(a[q][j].y * inv), b2 = (int)rintf(a[q][j].z * inv), b3 = (int)rintf(a[q][j].w * inv);
                qa[j] = (unsigned)(b0 & 255) | ((unsigned)(b1 & 255) << 8) | ((unsigned)(b2 & 255) << 16) | ((unsigned)(b3 & 255) << 24);
                int p = __builtin_amdgcn_cvt_pk_fp8_f32(u[q][j].x * 16.0f, u[q][j].y * 16.0f, 0, false);
                p = __builtin_amdgcn_cvt_pk_fp8_f32(u[q][j].z * 16.0f, u[q][j].w * 16.0f, p, true);
                qu[j] = (unsigned)p;
            }
            __builtin_nontemporal_store(qa, (v4u*)(EDq + (size_t)(row0 + q) * D + 16 * lane));
            __builtin_nontemporal_store(qu, (v4u*)(EUq + (size_t)(row0 + q) * D + 16 * lane));
            if (lane == 0) EDS[row0 + q] = sc;
        }
    }
}
__device__ __forceinline__ void p0_prologue(Frame& F) {
    const float* c = ((const float*)karg(1)); const float* w_ada = ((const float*)karg(4)); const float* b_ada = ((const float*)karg(5));
    float* MOD = (float*)(((unsigned char*)karg(19)) + WS_MOD);
    {
        LAS float* cact = (LAS float*)(F.lds);
        LAS float* part = (LAS float*)(F.lds + 16384);
        bool did = false;
        for (int item = F.vcu; item < NMOD / 32; item += F.G) {
            if (!did) { for (int i = F.tid; i < 4096; i += NTHR) { const float cv = c[i]; cact[i] = cv / (1.0f + __expf(-cv)); } did = true; }
            __syncthreads();
            const int n0 = item * 32, col = n0 + (F.lane & 31), ksub = F.lane >> 5;
            float a0 = 0.f, a1 = 0.f, a2 = 0.f, a3 = 0.f;
#pragma unroll 16
            for (int it = 0; it < 64; ++it) { const int k = (it * 8 + F.wave) * 2 + ksub; const float w = __builtin_nontemporal_load(w_ada + (size_t)k * NMOD + col);
                a0 += cact[k] * w; a1 += cact[1024 + k] * w; a2 += cact[2048 + k] * w; a3 += cact[3072 + k] * w; }
            a0 += __shfl_xor(a0, 32); a1 += __shfl_xor(a1, 32); a2 += __shfl_xor(a2, 32); a3 += __shfl_xor(a3, 32);
            if (F.lane < 32) { part[(F.wave * 4 + 0) * 32 + F.lane] = a0; part[(F.wave * 4 + 1) * 32 + F.lane] = a1; part[(F.wave * 4 + 2) * 32 + F.lane] = a2; part[(F.wave * 4 + 3) * 32 + F.lane] = a3; }
            __syncthreads();
            if (F.tid < 128) { const int b = F.tid >> 5, cl = F.tid & 31; float s = 0.f;
#pragma unroll
                for (int w = 0; w < 8; ++w) s += part[(w * 4 + b) * 32 + cl];
                MOD[b * NMOD + n0 + cl] = s + b_ada[n0 + cl]; }
            __syncthreads();
        }
    }
    {
        const int gw = F.vcu * NWAVES + F.wave, NGW = F.G * NWAVES;
        p0_convert(((const float*)karg(14)), (bf16*)(((unsigned char*)karg(19)) + WS_SUBK), (long)(8 * 2 * 128 * 64) / 512, gw, NGW, F.lane);
    }
}
__device__ __forceinline__ void p0_transposes(Frame& F) {
    LAS float* scr = (LAS float*)(F.lds + 32768 + F.wave * 8704);
    const int gw = F.vcu * NWAVES + F.wave, NGW = F.G * NWAVES;
    constexpr int I_IN1 = (D / 64) * (2304 / 32), I_IN2 = (D / 64) * (2048 / 32), I_AB = (512 / 64) * (D / 32), I_SQ = (D / 64) * (D / 32);
    constexpr int NITEMS = I_IN1 + I_IN2 + 2 * I_AB + 2 * I_SQ;
    bf16* Win_t = (bf16*)(((unsigned char*)karg(19)) + WS_WIN);
    for (int it = gw; it < NITEMS; it += NGW) {
        int r = it;
        if (r < I_IN1) { p0_transpose_item(((const float*)karg(6)), LDW_IN, D, 2304, Win_t, 0, scr, r, F.lane); continue; } r -= I_IN1;
        if (r < I_IN2) { p0_transpose_item(((const float*)karg(6)) + 2312, LDW_IN, D, 2048, Win_t, 2304, scr, r, F.lane); continue; } r -= I_IN2;
        if (r < I_AB) { p0_transpose_item(((const float*)karg(9)), D, 512, D, (bf16*)(((unsigned char*)karg(19)) + WS_WA), 0, scr, r, F.lane); continue; } r -= I_AB;
        if (r < I_AB) { p0_transpose_item(((const float*)karg(10)), D, 512, D, (bf16*)(((unsigned char*)karg(19)) + WS_WB), 0, scr, r, F.lane); continue; } r -= I_AB;
        if (r < I_SQ) { p0_transpose_item(((const float*)karg(11)), D, D, D, (bf16*)(((unsigned char*)karg(19)) + WS_WOUT), 0, scr, r, F.lane); continue; } r -= I_SQ;
        p0_transpose_item(((const float*)karg(13)), D, D, D, (bf16*)(((unsigned char*)karg(19)) + WS_WQ), 0, scr, r, F.lane);
    }
}

__device__ __forceinline__ void p1_norm(Frame& F) {
    const float* x = ((const float*)karg(0)); const float* g1 = ((const float*)karg(2)); const float* w_in = ((const float*)karg(6)); const float* b_forget = ((const float*)karg(7));
    const float* MOD = (const float*)(((unsigned char*)karg(19)) + WS_MOD); bf16* H = (bf16*)(((unsigned char*)karg(19)) + WS_H); float* LOGF = (float*)(((unsigned char*)karg(19)) + WS_LOGF);
    LAS float* wfl = (LAS float*)(F.lds);
    { float tmp[16];
#pragma unroll
      for (int n = 0; n < 16; ++n) { const int i = F.tid + n * NTHR; tmp[n] = w_in[(size_t)(i >> 3) * LDW_IN + 2304 + (i & 7)]; }
#pragma unroll
      for (int n = 0; n < 16; ++n) { const int i = F.tid + n * NTHR; wfl[(i & 7) * 1024 + (i >> 3)] = tmp[n]; } }
    __syncthreads();
    const int gw = F.vcu * NWAVES + F.wave, NGW = F.G * NWAVES;
    for (int c = gw; c < M / 8; c += NGW) {
        const int row0 = c * 8; const float* mb = MOD + (row0 >> 12) * NMOD;
        f32x4 ga[4], sh[4];
#pragma unroll
        for (int j = 0; j < 4; ++j) { const int col = 4 * F.lane + 256 * j; const f32x4 g = *(const f32x4*)(g1 + col), sc = *(const f32x4*)(mb + 1024 + col); sh[j] = *(const f32x4*)(mb + col); ga[j] = g * (sc + 1.0f); }
        f32x4 r0[4], r1[4], r2[4];
        { const f32x4* xr = (const f32x4*)(x + (size_t)row0 * D) + F.lane;
#pragma unroll
          for (int j = 0; j < 4; ++j) r0[j] = __builtin_nontemporal_load(xr + 64 * j);
#pragma unroll
          for (int j = 0; j < 4; ++j) r1[j] = __builtin_nontemporal_load(xr + 256 + 64 * j); }
#pragma unroll
        for (int i = 0; i < 8; ++i) {
            const int row = row0 + i;
            if (i + 2 < 8) { const f32x4* xr = (const f32x4*)(x + (size_t)(row + 2) * D) + F.lane;
#pragma unroll
                for (int j = 0; j < 4; ++j) r2[j] = __builtin_nontemporal_load(xr + 64 * j); }
            float ss = 0.f;
#pragma unroll
            for (int j = 0; j < 4; ++j) ss += (r0[j].x * r0[j].x + r0[j].y * r0[j].y) + (r0[j].z * r0[j].z + r0[j].w * r0[j].w);
            ss = wave_sum(ss);
            const float rstd = 1.0f / sqrtf(ss * (1.0f / D) + EPS);
            float fl[8];
#pragma unroll
            for (int jj = 0; jj < 8; ++jj) fl[jj] = 0.f;
#pragma unroll
            for (int j = 0; j < 4; ++j) { const int col = 4 * F.lane + 256 * j;
                const f32x4 hv = (r0[j] * rstd) * ga[j] + sh[j];
                u32x2 w; w.x = cvtpk(hv.x, hv.y); w.y = cvtpk(hv.z, hv.w);
                __hip_atomic_store((unsigned long long*)(H + (size_t)row * D + col), __builtin_bit_cast(unsigned long long, w), __ATOMIC_RELAXED, __HIP_MEMORY_SCOPE_AGENT);
#pragma unroll
                for (int jj = 0; jj < 8; ++jj) { const f32x4 wv = *(const LAS f32x4*)(wfl + jj * 1024 + col); fl[jj] += (hv.x * wv.x + hv.y * wv.y) + (hv.z * wv.z + hv.w * wv.w); }
            }
            const int lane = F.lane; const float r1s = reduce8_t(fl, lane);
            if ((lane & 7) == 0) { const int jj = lane >> 3; const float z = r1s + b_forget[jj]; const float ls = fminf(z, 0.f) - log1pf(__expf(-fabsf(z))); LOGF[(size_t)row * 8 + jj] = ls; }
#pragma unroll
            for (int j = 0; j < 4; ++j) { r0[j] = r1[j]; r1[j] = r2[j]; }
        }
    }
}

constexpr int KP = 72;
constexpr int VPF = 68;
constexpr int VPS = 260;
constexpr float LOG2E = 1.4426950408889634f;
struct FlashState { f32x16 o[2]; float m, l; };

__device__ __forceinline__ void flash_tail(FlashState& st, f32x16& s0, f32x16& s1, const LAS bf16* Vs, int vp, int r32, int hi) {
    float mt = s0[0];
#pragma unroll
    for (int r = 1; r < 16; ++r) mt = fmaxf(mt, s0[r]);
#pragma unroll
    for (int r = 0; r < 16; ++r) mt = fmaxf(mt, s1[r]);
    mt = fmaxf(mt, __uint_as_float(xorx<32>(__float_as_uint(mt), 32 * hi)));
    const float mn = fmaxf(st.m, mt);
    const float alpha = __builtin_amdgcn_exp2f(st.m - mn);
    st.m = mn;
    float ps = 0.f;
#pragma unroll
    for (int r = 0; r < 16; ++r) { s0[r] = __builtin_amdgcn_exp2f(s0[r] - mn); ps += s0[r]; }
#pragma unroll
    for (int r = 0; r < 16; ++r) { s1[r] = __builtin_amdgcn_exp2f(s1[r] - mn); ps += s1[r]; }
    st.l = st.l * alpha + ps;
    if (__any(alpha != 1.0f)) {
#pragma unroll
        for (int r = 0; r < 16; ++r) { st.o[0][r] *= alpha; st.o[1][r] *= alpha; }
    }
#pragma unroll
    for (int blk = 0; blk < 2; ++blk)
#pragma unroll
        for (int s = 0; s < 2; ++s) {
            v4u pw;
            if (blk == 0) { pw.x = cvtpk(s0[8 * s + 0], s0[8 * s + 1]); pw.y = cvtpk(s0[8 * s + 2], s0[8 * s + 3]); pw.z = cvtpk(s0[8 * s + 4], s0[8 * s + 5]); pw.w = cvtpk(s0[8 * s + 6], s0[8 * s + 7]); }
            else          { pw.x = cvtpk(s1[8 * s + 0], s1[8 * s + 1]); pw.y = cvtpk(s1[8 * s + 2], s1[8 * s + 3]); pw.z = cvtpk(s1[8 * s + 4], s1[8 * s + 5]); pw.w = cvtpk(s1[8 * s + 6], s1[8 * s + 7]); }
            const bf16x8 pf = __builtin_bit_cast(bf16x8, pw);
#pragma unroll
            for (int db = 0; db < 2; ++db) {
                const LAS bf16* vp0 = Vs + (32 * db + r32) * vp + 32 * blk + 16 * s + 4 * hi;
                const s16x4 lo = *(const LAS s16x4*)vp0, hh = *(const LAS s16x4*)(vp0 + 8);
                const bf16x8 vf = __builtin_shufflevector(lo, hh, 0, 1, 2, 3, 4, 5, 6, 7);
                st.o[db] = MFMA32(vf, pf, st.o[db]);
            }
        }
}
__device__ __forceinline__ void flash_qk(f32x16& s0, f32x16& s1, const bf16x8 (&qf)[4], const LAS bf16* Ks, int r32, int hi) {
    s0 = (f32x16){0.f}; s1 = (f32x16){0.f};
#pragma unroll
    for (int r = 0; r < 16; ++r) { s0[r] = 0.f; s1[r] = 0.f; }
#pragma unroll
    for (int ks = 0; ks < 4; ++ks) {
        const bf16x8 a0 = *(const LAS bf16x8*)(Ks + r32 * KP + 16 * ks + 8 * hi);
        const bf16x8 a1 = *(const LAS bf16x8*)(Ks + (32 + r32) * KP + 16 * ks + 8 * hi);
        s0 = MFMA32(a0, qf[ks], s0); s1 = MFMA32(a1, qf[ks], s1);
    }
}
__device__ __forceinline__ void flash_qk2(f32x16& a0, f32x16& a1, f32x16& b0, f32x16& b1, const bf16x8 (&qa)[4], const bf16x8 (&qb)[4], const LAS bf16* Ks, int r32, int hi) {
#pragma unroll
    for (int r = 0; r < 16; ++r) { a0[r] = 0.f; a1[r] = 0.f; b0[r] = 0.f; b1[r] = 0.f; }
#pragma unroll
    for (int ks = 0; ks < 4; ++ks) {
        const bf16x8 k0 = *(const LAS bf16x8*)(Ks + r32 * KP + 16 * ks + 8 * hi);
        const bf16x8 k1 = *(const LAS bf16x8*)(Ks + (32 + r32) * KP + 16 * ks + 8 * hi);
        a0 = MFMA32(k0, qa[ks], a0); b0 = MFMA32(k0, qb[ks], b0); a1 = MFMA32(k1, qa[ks], a1); b1 = MFMA32(k1, qb[ks], b1);
    }
}
__device__ __forceinline__ void flash_soft(FlashState& st, f32x16& s0, f32x16& s1, int hi) {
    float mt = s0[0];
#pragma unroll
    for (int r = 1; r < 16; ++r) mt = fmaxf(mt, s0[r]);
#pragma unroll
    for (int r = 0; r < 16; ++r) mt = fmaxf(mt, s1[r]);
    mt = fmaxf(mt, __uint_as_float(xorx<32>(__float_as_uint(mt), 32 * hi)));
    const float mn = fmaxf(st.m, mt);
    const float alpha = __builtin_amdgcn_exp2f(st.m - mn);
    st.m = mn;
    float ps = 0.f;
#pragma unroll
    for (int r = 0; r < 16; ++r) { s0[r] = __builtin_amdgcn_exp2f(s0[r] - mn); ps += s0[r]; }
#pragma unroll
    for (int r = 0; r < 16; ++r) { s1[r] = __builtin_amdgcn_exp2f(s1[r] - mn); ps += s1[r]; }
    st.l = st.l * alpha + ps;
    if (__any(alpha != 1.0f)) {
#pragma unroll
        for (int r = 0; r < 16; ++r) { st.o[0][r] *= alpha; st.o[1][r] *= alpha; }
    }
}
__device__ __forceinline__ bf16x8 pack_p(const f32x16& p, int s) {
    v4u pw; pw.x = cvtpk(p[8 * s + 0], p[8 * s + 1]); pw.y = cvtpk(p[8 * s + 2], p[8 * s + 3]); pw.z = cvtpk(p[8 * s + 4], p[8 * s + 5]); pw.w = cvtpk(p[8 * s + 6], p[8 * s + 7]);
    return __builtin_bit_cast(bf16x8, pw);
}
__device__ __forceinline__ void flash_pv2(FlashState& sa, FlashState& sb, const f32x16& a0, const f32x16& a1, const f32x16& b0, const f32x16& b1, const LAS bf16* Vs, int vp, int r32, int hi) {
#pragma unroll
    for (int blk = 0; blk < 2; ++blk)
#pragma unroll
        for (int s = 0; s < 2; ++s) {
            const bf16x8 pfa = blk ? pack_p(a1, s) : pack_p(a0, s), pfb = blk ? pack_p(b1, s) : pack_p(b0, s);
#pragma unroll
            for (int db = 0; db < 2; ++db) {
                const LAS bf16* vp0 = Vs + (32 * db + r32) * vp + 32 * blk + 16 * s + 4 * hi;
                const s16x4 lo = *(const LAS s16x4*)vp0, hh = *(const LAS s16x4*)(vp0 + 8);
                const bf16x8 vf = __builtin_shufflevector(lo, hh, 0, 1, 2, 3, 4, 5, 6, 7);
                sa.o[db] = MFMA32(vf, pfa, sa.o[db]); sb.o[db] = MFMA32(vf, pfb, sb.o[db]);
            }
        }
}
__device__ __forceinline__ void flash_store(const FlashState& st, bf16* orow, int hi) {
    float lt = st.l + __uint_as_float(xorx<32>(__float_as_uint(st.l), 32 * hi));
    const float inv = 1.0f / lt;
#pragma unroll
    for (int db = 0; db < 2; ++db)
#pragma unroll
        for (int rg = 0; rg < 4; ++rg) { u32x2 w; w.x = cvtpk(st.o[db][4 * rg] * inv, st.o[db][4 * rg + 1] * inv); w.y = cvtpk(st.o[db][4 * rg + 2] * inv, st.o[db][4 * rg + 3] * inv);
            *(u32x2*)(orow + 32 * db + 8 * rg + 4 * hi) = w; }
}

__device__ __forceinline__ void fox_unit(Frame& F, int b, int h, int qb, float& kmax2) {
    const bf16* proj = (const bf16*)(((unsigned char*)karg(19)) + WS_PROJ); const float* LOGF = (const float*)(((unsigned char*)karg(19)) + WS_LOGF); bf16* OB = (bf16*)(((unsigned char*)karg(19)) + WS_OB);
    LAS float* Fs = (LAS float*)(F.lds);
    LAS float* wtot = (LAS float*)(F.lds + 16384);
    LAS bf16* Kb = (LAS bf16*)(F.lds + 16384 + 128);
    LAS bf16* Vb = (LAS bf16*)(F.lds + 16384 + 128 + 2 * 64 * KP * 2);
    const int lane = F.lane, wave = F.wave, tid = F.tid, r32 = lane & 31, hi = lane >> 5;
    const int q_end = 512 * (qb + 1), NT = q_end / 64;
    const size_t rowbase = (size_t)b * SEQ;
    if (kmax2 < 0.f) {
        float v[8]; float run = 0.f;
#pragma unroll
        for (int i = 0; i < 8; ++i) { const int pos = tid * 8 + i; const float lf = (pos < q_end) ? LOGF[(rowbase + pos) * 8 + h] : 0.f; run += lf; v[i] = run; }
        float inc = run;
#pragma unroll
        for (int o = 1; o < 64; o <<= 1) { const float t = __shfl_up(inc, o); if (lane >= o) inc += t; }
        if (lane == 63) wtot[wave] = inc;
        __syncthreads();
        float off = inc - run;
        for (int w = 0; w < wave; ++w) off += wtot[w];
#pragma unroll
        for (int i = 0; i < 8; ++i) Fs[tid * 8 + i] = -LOG2E * (v[i] + off);
    }
    const int qrow = 512 * qb + 64 * wave + r32, qrowB = qrow + 32;
    bf16x8 qf[4], qg[4];
    { const bf16* qp = proj + (rowbase + qrow) * NPROJ + C_QB + 64 * h + 8 * hi;
#pragma unroll
      for (int ks = 0; ks < 4; ++ks) { qf[ks] = *(const bf16x8*)(qp + 16 * ks); qg[ks] = *(const bf16x8*)(qp + (size_t)32 * NPROJ + 16 * ks); } }
    const int tq = 8 * qb + wave;
    LAS bf16* Qs = (LAS bf16*)(F.lds + 53248) + wave * (64 * KP);
    {
        float qn = 0.f;
#pragma unroll
        for (int ks = 0; ks < 4; ++ks)
#pragma unroll
            for (int j = 0; j < 8; ++j) { const float e = __uint_as_float(((unsigned)(unsigned short)qf[ks][j]) << 16); qn += e * e; }
        qn += __shfl_xor(qn, 32);
        { float qn2 = 0.f;
#pragma unroll
          for (int ks = 0; ks < 4; ++ks)
#pragma unroll
              for (int j = 0; j < 8; ++j) { const float e = __uint_as_float(((unsigned)(unsigned short)qg[ks][j]) << 16); qn2 += e * e; }
          qn2 += __shfl_xor(qn2, 32); qn = fmaxf(qn, qn2); }
#pragma unroll
        for (int o = 1; o < 32; o <<= 1) qn = fmaxf(qn, __shfl_xor(qn, o));
        float kn = 0.f;
        if (kmax2 < 0.f) {
            for (int p0 = 0; p0 < q_end; p0 += 4 * 64) {
                v4u w4[4];
#pragma unroll
                for (int i = 0; i < 4; ++i) w4[i] = *(const v4u*)(proj + (rowbase + p0 + 64 * i + (tid >> 3)) * NPROJ + C_KB + 64 * h + 8 * (tid & 7));
#pragma unroll
                for (int i = 0; i < 4; ++i) { const unsigned wx = w4[i].x, wy = w4[i].y, wz = w4[i].z, ww = w4[i].w;
                    float s = bflo(wx) * bflo(wx) + bfhi(wx) * bfhi(wx) + bflo(wy) * bflo(wy) + bfhi(wy) * bfhi(wy) + bflo(wz) * bflo(wz) + bfhi(wz) * bfhi(wz) + bflo(ww) * bflo(ww) + bfhi(ww) * bfhi(ww);
                    s += __shfl_xor(s, 1); s += __shfl_xor(s, 2); s += __shfl_xor(s, 4);
                    kn = fmaxf(kn, s); } }
            kn = wave_max(kn);
        }
        if (lane == 0) { wtot[8 + wave] = qn; wtot[16 + wave] = kn; }
    }
#pragma unroll
    for (int ks = 0; ks < 4; ++ks) { *(LAS bf16x8*)(Qs + r32 * KP + 16 * ks + 8 * hi) = qf[ks]; *(LAS bf16x8*)(Qs + (32 + r32) * KP + 16 * ks + 8 * hi) = qg[ks]; }
    FlashState st, su; st.m = -INFINITY; st.l = 0.f; su.m = -INFINITY; su.l = 0.f;
#pragma unroll
    for (int r = 0; r < 16; ++r) { st.o[0][r] = 0.f; st.o[1][r] = 0.f; su.o[0][r] = 0.f; su.o[1][r] = 0.f; }
    const int srow = tid >> 3, sch = tid & 7;
    const bf16* kg = proj + (rowbase + srow) * NPROJ + C_KB + 64 * h + 8 * sch;
    const bf16* vg = proj + (rowbase + srow) * NPROJ + C_VB + 64 * h + 8 * sch;
    v4u kreg, vreg;
    { const size_t o = (size_t)(NT - 1) * 64 * NPROJ; kreg = *(const v4u*)(kg + o); vreg = *(const v4u*)(vg + o); }
    int cur = 0;
    {   *(LAS v4u*)(Kb + srow * KP + 8 * sch) = kreg;
        const unsigned short* vs = (const unsigned short*)&vreg;
#pragma unroll
        for (int i = 0; i < 8; ++i) Vb[(8 * sch + i) * VPF + srow] = vs[i];
    }
    __syncthreads();
    int t_lo = 0;
    {
        float qm = 0.f, km = 0.f;
#pragma unroll
        for (int w = 0; w < 8; ++w) { qm = fmaxf(qm, wtot[8 + w]); km = fmaxf(km, wtot[16 + w]); }
        if (kmax2 < 0.f) kmax2 = km;
        const float A = 0.125f * sqrtf(qm) * sqrtf(kmax2) * 1.01f, f0 = Fs[512 * qb];
        for (int t = NT - 9; t >= 0; --t) if (f0 - Fs[64 * t + 63] > (2.0f * A + 30.0f) * LOG2E) { t_lo = t + 1; break; }
    }
    for (int t = NT - 1; t >= t_lo; --t) {
        if (t > t_lo) { const size_t o = (size_t)(t - 1) * 64 * NPROJ; kreg = *(const v4u*)(kg + o); vreg = *(const v4u*)(vg + o); }
        if (t <= tq) {
            const LAS bf16* Ks = Kb + cur * 64 * KP; const LAS bf16* Vs = Vb + cur * 64 * VPF;
            bf16x8 qa[4], qb4[4];
#pragma unroll
            for (int ks = 0; ks < 4; ++ks) { qa[ks] = *(const LAS bf16x8*)(Qs + r32 * KP + 16 * ks + 8 * hi); qb4[ks] = *(const LAS bf16x8*)(Qs + (32 + r32) * KP + 16 * ks + 8 * hi); }
            f32x16 s0, s1, u0, u1; flash_qk2(s0, s1, u0, u1, qa, qb4, Ks, r32, hi);
            const LAS float* Fk = Fs + 64 * t;
            constexpr float C = 0.125f * LOG2E;
#pragma unroll
            for (int rg = 0; rg < 4; ++rg) {
                const f32x4 f0 = *(const LAS f32x4*)(Fk + 8 * rg + 4 * hi), f1 = *(const LAS f32x4*)(Fk + 32 + 8 * rg + 4 * hi);
#pragma unroll
                for (int i = 0; i < 4; ++i) { const int r = 4 * rg + i;
                    s0[r] = fmaf(s0[r], C, f0[i]); s1[r] = fmaf(s1[r], C, f1[i]); u0[r] = fmaf(u0[r], C, f0[i]); u1[r] = fmaf(u1[r], C, f1[i]); }
            }
            if (t == tq) {
#pragma unroll
                for (int r = 0; r < 16; ++r) { const int kv = 64 * t + crow(r, hi);
                    s0[r] = (kv > qrow) ? -INFINITY : s0[r]; s1[r] = (kv + 32 > qrow) ? -INFINITY : s1[r];
                    u0[r] = (kv > qrowB) ? -INFINITY : u0[r]; u1[r] = (kv + 32 > qrowB) ? -INFINITY : u1[r]; }
            }
            flash_soft(st, s0, s1, hi); flash_soft(su, u0, u1, hi);
            flash_pv2(st, su, s0, s1, u0, u1, Vs, VPF, r32, hi);
        }
        if (t > t_lo) {
            const int nb = cur ^ 1;
            *(LAS v4u*)(Kb + nb * 64 * KP + srow * KP + 8 * sch) = kreg;
            const unsigned short* vs = (const unsigned short*)&vreg;
#pragma unroll
            for (int i = 0; i < 8; ++i) Vb[nb * 64 * VPF + (8 * sch + i) * VPF + srow] = vs[i];
        }
        __syncthreads();
        cur ^= 1;
    }
    flash_store(st, OB + (rowbase + qrow) * 512 + 64 * h, hi); flash_store(su, OB + (rowbase + qrowB) * 512 + 64 * h, hi);
    __syncthreads();
}

__device__ const unsigned char T5_BUCKET[128] = {0,1,2,3,4,5,6,7,8,9,10,11,12,13,14,15,16,16,16,17,17,18,18,18,19,19,19,20,20,20,20,21,21,21,21,22,22,22,22,22,23,23,23,23,23,23,24,24,24,24,24,24,25,25,25,25,25,25,25,26,26,26,26,26,26,26,26,27,27,27,27,27,27,27,27,27,27,28,28,28,28,28,28,28,28,28,28,29,29,29,29,29,29,29,29,29,29,29,29,30,30,30,30,30,30,30,30,30,30,30,30,30,30,31,31,31,31,31,31,31,31,31,31,31,31,31,31,31};

__device__ __forceinline__ void swa_unit(Frame& F, int b, int kvh, int n) {
    const bf16* proj = (const bf16*)(((unsigned char*)karg(19)) + WS_PROJ); bf16* OA = (bf16*)(((unsigned char*)karg(19)) + WS_OA);
    const float* sinks = ((const float*)karg(8)); const float* rel_bias = ((const float*)karg(12));
    LAS bf16* Kb = (LAS bf16*)(F.lds);
    LAS bf16* Vb = (LAS bf16*)(F.lds + 36864);
    LAS float* bt = (LAS float*)(F.lds + 36864 + 33280);
    const int lane = F.lane, wave = F.wave, tid = F.tid, r32 = lane & 31, hi = lane >> 5;
    const size_t rowbase = (size_t)b * SEQ;
    {
        const int g = tid >> 7, d = tid & 127;
        bt[tid] = LOG2E * rel_bias[(int)T5_BUCKET[d] * 8 + kvh * 4 + g];
#pragma unroll
        for (int i = 0; i < 4; ++i) {
            const int idx = tid + i * NTHR, kb = idx >> 3, sch = idx & 7; const int pos = 128 * (n - 1) + kb;
            v4u kreg = (v4u){0u, 0u, 0u, 0u}, vreg = (v4u){0u, 0u, 0u, 0u};
            if (pos >= 0) { const bf16* p = proj + (rowbase + pos) * NPROJ + 64 * kvh + 8 * sch; kreg = *(const v4u*)(p + C_KA); vreg = *(const v4u*)(p + C_VA); }
            *(LAS v4u*)(Kb + kb * KP + 8 * sch) = kreg;
            const unsigned short* vs = (const unsigned short*)&vreg;
#pragma unroll
            for (int j = 0; j < 8; ++j) Vb[(8 * sch + j) * VPS + kb] = vs[j];
        }
    }
    __syncthreads();
    const int g = wave & 3, qh = wave >> 2, head = kvh * 4 + g;
    const LAS float* btg = bt + g * 128;
    for (int sb = 0; sb < 2; ++sb) {
        const int qrel0 = 64 * qh + 32 * sb, qrel = qrel0 + r32;
        const size_t row = rowbase + 128 * n + qrel;
        bf16x8 qf[4];
        { const bf16* qp = proj + row * NPROJ + C_QA + 64 * head + 8 * hi;
#pragma unroll
          for (int ks = 0; ks < 4; ++ks) qf[ks] = *(const bf16x8*)(qp + 16 * ks); }
        FlashState st; st.m = LOG2E * sinks[head]; st.l = (hi == 0) ? 1.0f : 0.0f;
#pragma unroll
        for (int r = 0; r < 16; ++r) { st.o[0][r] = 0.f; st.o[1][r] = 0.f; }
        const int t_lo = (qrel0 + 1) >> 6, t_hi = (qrel0 + 159) >> 6;
        for (int t = t_lo; t <= t_hi; ++t) {
            f32x16 s0, s1; flash_qk(s0, s1, qf, Kb + t * 64 * KP, r32, hi);
#pragma unroll
            for (int r = 0; r < 16; ++r) {
                const int kb0 = 64 * t + crow(r, hi), kb1 = kb0 + 32;
                const int d0 = 128 + qrel - kb0, d1 = d0 - 32;
                const bool v0 = (d0 >= 0) && (d0 < 128) && (n > 0 || kb0 >= 128);
                const bool v1 = (d1 >= 0) && (d1 < 128) && (n > 0 || kb1 >= 128);
                const float b0 = btg[d0 & 127], b1 = btg[d1 & 127];
                s0[r] = v0 ? fmaf(s0[r], 0.125f * LOG2E, b0) : -INFINITY;
                s1[r] = v1 ? fmaf(s1[r], 0.125f * LOG2E, b1) : -INFINITY;
            }
            flash_tail(st, s0, s1, Vb + 64 * t, VPS, r32, hi);
        }
        flash_store(st, OA + row * 512 + 64 * head, hi);
    }
    __syncthreads();
}
__device__ __forceinline__ void p3_attention(Frame& F) {
    for (int item = F.vcu; item < 256; item += F.G) {
        swa_unit(F, item >> 6, (item >> 5) & 1, item & 31);
        F.lane = lane_fresh(); F.tid = F.wave * 64 + F.lane;
        const int bh = item >> 3, j = item & 7;
        float kmax2 = -1.0f;
        fox_unit(F, bh >> 3, bh & 7, j, kmax2);
    }
}

struct PairOrder {
    pg8::StaticOrder S;
    __device__ bool next(int i, pg8::Unit& u) const { if (!S.next(i >> 1, u)) return false; u.src = i & 1; return true; }
    __device__ __forceinline__ void a_ready(const pg8::Unit&) const {}
    __device__ __forceinline__ void done(const pg8::Unit&) const {}
};
__device__ __forceinline__ float sigmoidf_(float z) { return 1.0f / (1.0f + __expf(-z)); }
struct EpiGate {
    static constexpr bool PERM = true, AFTER_DRAIN = false, CHAIN = true;
    const bf16* proj; bf16* mixed;
    __device__ __forceinline__ void operator()(pg8::f32x4 (&acc)[2][2][4][2], const pg8::Unit& u, int wr, int wc, int fr, int fq) const {
#pragma unroll
        for (int ai = 0; ai < 2; ++ai) {
            v4u gbv[4][2], gav[4][2];
#pragma unroll
            for (int m = 0; m < 4; ++m) { const size_t row = (size_t)u.pm * 256 + ai * 128 + wr * 64 + m * 16 + fr;
#pragma unroll
                for (int bj = 0; bj < 2; ++bj) { const int col0 = u.pn * 256 + bj * 128 + wc * 32 + 8 * fq;
                    gbv[m][bj] = *(const v4u*)(proj + row * NPROJ + C_GLB + col0);
                    if (u.src == 0) gav[m][bj] = __builtin_nontemporal_load((const v4u*)(proj + row * NPROJ + C_GLA + col0)); } }
#pragma unroll
            for (int m = 0; m < 4; ++m) { const size_t row = (size_t)u.pm * 256 + ai * 128 + wr * 64 + m * 16 + fr;
#pragma unroll
                for (int bj = 0; bj < 2; ++bj) { const int col0 = u.pn * 256 + bj * 128 + wc * 32 + 8 * fq;
                    const unsigned gbw[4] = {gbv[m][bj].x, gbv[m][bj].y, gbv[m][bj].z, gbv[m][bj].w};
                    if (u.src == 0) {
                        const unsigned gaw[4] = {gav[m][bj].x, gav[m][bj].y, gav[m][bj].z, gav[m][bj].w};
#pragma unroll
                        for (int e = 0; e < 8; ++e) { const float za = (e & 1) ? bfhi(gaw[e >> 1]) : bflo(gaw[e >> 1]), zb = (e & 1) ? bfhi(gbw[e >> 1]) : bflo(gbw[e >> 1]);
                            const float ratio = (1.0f + __expf(-zb)) * __builtin_amdgcn_rcpf(1.0f + __expf(-za));
                            acc[ai][bj][m][e >> 2][e & 3] *= ratio; }
                    } else {
                        float v[8];
#pragma unroll
                        for (int e = 0; e < 8; ++e) { const float zb = (e & 1) ? bfhi(gbw[e >> 1]) : bflo(gbw[e >> 1]); v[e] = acc[ai][bj][m][e >> 2][e & 3] * __builtin_amdgcn_rcpf(1.0f + __expf(-zb)); }
                        v4u w; w.x = cvtpk(v[0], v[1]); w.y = cvtpk(v[2], v[3]); w.z = cvtpk(v[4], v[5]); w.w = cvtpk(v[6], v[7]);
                        *(v4u*)(mixed + row * D + col0) = w;
                    }
                }
            }
        }
    }
};
struct EpiRes {
    static constexpr bool PERM = true, AFTER_DRAIN = false, CHAIN = false;
    const float* x; const float* mod; bf16* x1;
    __device__ __forceinline__ void operator()(const pg8::f32x4 (&acc)[2][2][4][2], const pg8::Unit& u, int wr, int wc, int fr, int fq) const {
        const int b = (u.pm * 256) >> 12;
        pg8::f32x4 gt[2][2];
#pragma unroll
        for (int bj = 0; bj < 2; ++bj)
#pragma unroll
            for (int n = 0; n < 2; ++n) gt[bj][n] = *(const pg8::f32x4*)(mod + b * NMOD + 2048 + u.pn * 256 + bj * 128 + wc * 32 + 8 * fq + 4 * n);
#pragma unroll
        for (int ai = 0; ai < 2; ++ai) {
            pg8::f32x4 xin[4][2][2];
#pragma unroll
            for (int m = 0; m < 4; ++m) { const size_t row = (size_t)u.pm * 256 + ai * 128 + wr * 64 + m * 16 + fr;
#pragma unroll
                for (int bj = 0; bj < 2; ++bj)
#pragma unroll
                    for (int n = 0; n < 2; ++n) xin[m][bj][n] = __builtin_nontemporal_load((const pg8::f32x4*)(x + row * D + u.pn * 256 + bj * 128 + wc * 32 + 8 * fq + 4 * n)); }
#pragma unroll
            for (int m = 0; m < 4; ++m) { const size_t row = (size_t)u.pm * 256 + ai * 128 + wr * 64 + m * 16 + fr;
#pragma unroll
                for (int bj = 0; bj < 2; ++bj) { const pg8::f32x4 v0 = xin[m][bj][0] + gt[bj][0] * acc[ai][bj][m][0], v1 = xin[m][bj][1] + gt[bj][1] * acc[ai][bj][m][1];
                    v4u w; w.x = cvtpk(v0.x, v0.y); w.y = cvtpk(v0.z, v0.w); w.z = cvtpk(v1.x, v1.y); w.w = cvtpk(v1.z, v1.w);
                    *(v4u*)(x1 + row * D + u.pn * 256 + bj * 128 + wc * 32 + 8 * fq) = w; } }
        }
    }
};

__device__ __forceinline__ void p6_norm2(Frame& F) {
    const bf16* x1 = (const bf16*)(((unsigned char*)karg(19)) + WS_X1); const float* g2 = ((const float*)karg(3)); const float* MOD = (const float*)(((unsigned char*)karg(19)) + WS_MOD); bf16* H2 = (bf16*)(((unsigned char*)karg(19)) + WS_H2); unsigned char* H2Q = (unsigned char*)(((unsigned char*)karg(19)) + WS_H2Q); float* H2S = (float*)(((unsigned char*)karg(19)) + WS_H2S);
    const int gw = F.vcu * NWAVES + F.wave, NGW = F.G * NWAVES;
    for (int c = gw; c < M / 8; c += NGW) {
        const int row0 = c * 8; const float* mb = MOD + (row0 >> 12) * NMOD;
        f32x4 ga[4], sh[4];
#pragma unroll
        for (int j = 0; j < 4; ++j) { const int col = 4 * F.lane + 256 * j; const f32x4 g = *(const f32x4*)(g2 + col), sc = *(const f32x4*)(mb + 4096 + col); sh[j] = *(const f32x4*)(mb + 3072 + col); ga[j] = g * (sc + 1.0f); }
        u32x2 r0[4], r1[4], r2[4];
        { const u32x2* xr = (const u32x2*)(x1 + (size_t)row0 * D) + F.lane;
#pragma unroll
          for (int j = 0; j < 4; ++j) r0[j] = xr[64 * j];
#pragma unroll
          for (int j = 0; j < 4; ++j) r1[j] = xr[256 + 64 * j]; }
#pragma unroll
        for (int i = 0; i < 8; ++i) {
            const int row = row0 + i;
            if (i + 2 < 8) { const u32x2* xr = (const u32x2*)(x1 + (size_t)(row + 2) * D) + F.lane;
#pragma unroll
                for (int j = 0; j < 4; ++j) r2[j] = xr[64 * j]; }
            f32x4 hq[4], xv[4]; float ss = 0.f;
#pragma unroll
            for (int j = 0; j < 4; ++j) { xv[j].x = bflo(r0[j].x); xv[j].y = bfhi(r0[j].x); xv[j].z = bflo(r0[j].y); xv[j].w = bfhi(r0[j].y);
                ss += (xv[j].x * xv[j].x + xv[j].y * xv[j].y) + (xv[j].z * xv[j].z + xv[j].w * xv[j].w); }
            ss = wave_sum(ss);
            const float rstd = 1.0f / sqrtf(ss * (1.0f / D) + EPS);
#pragma unroll
            for (int j = 0; j < 4; ++j) { const int col = 4 * F.lane + 256 * j;
                const f32x4 hv = (xv[j] * rstd) * ga[j] + sh[j];
                u32x2 w; w.x = cvtpk(hv.x, hv.y); w.y = cvtpk(hv.z, hv.w);
                __hip_atomic_store((unsigned long long*)(H2 + (size_t)row * D + col), __builtin_bit_cast(unsigned long long, w), __ATOMIC_RELAXED, __HIP_MEMORY_SCOPE_AGENT); hq[j] = hv; }
            float am = 0.f;
#pragma unroll
            for (int j = 0; j < 4; ++j) am = fmaxf(fmaxf(am, fmaxf(fabsf(hq[j].x), fabsf(hq[j].y))), fmaxf(fabsf(hq[j].z), fabsf(hq[j].w)));
            am = wave_max(am);
            const float sc = am > 0.f ? am * (1.0f / 127.0f) : 1.0f, inv = 1.0f / sc;
            v4u qa;
#pragma unroll
            for (int j = 0; j < 4; ++j) { const int b0 = (int)rintf(hq[j].x * inv), b1 = (int)rintf(hq[j].y * inv), b2 = (int)rintf(hq[j].z * inv), b3 = (int)rintf(hq[j].w * inv);
                qa[j] = (unsigned)(b0 & 255) | ((unsigned)(b1 & 255) << 8) | ((unsigned)(b2 & 255) << 16) | ((unsigned)(b3 & 255) << 24); }
            __builtin_nontemporal_store(qa, (v4u*)(H2Q + (size_t)row * D + 16 * F.lane));
            if (F.lane == 0) H2S[row] = sc;
#pragma unroll
            for (int j = 0; j < 4; ++j) { r0[j] = r1[j]; r1[j] = r2[j]; }
        }
    }
}

__device__ __forceinline__ unsigned f2ord(float f) { const unsigned u = __float_as_uint(f); return u ^ ((unsigned)((int)u >> 31) | 0x80000000u); }
__device__ __forceinline__ float ord2f(unsigned o) { const unsigned u = (o & 0x80000000u) ? (o & 0x7fffffffu) : ~o; return __uint_as_float(u); }
#define CE_DESC(a, b) do { const unsigned _x = (a), _y = (b); (a) = _x > _y ? _x : _y; (b) = _x > _y ? _y : _x; } while (0)
__device__ __forceinline__ void sort16(unsigned (&k)[16]) {
    CE_DESC(k[0], k[13]); CE_DESC(k[1], k[12]); CE_DESC(k[2], k[15]); CE_DESC(k[3], k[14]); CE_DESC(k[4], k[8]); CE_DESC(k[5], k[6]); CE_DESC(k[7], k[11]); CE_DESC(k[9], k[10]);
    CE_DESC(k[0], k[5]); CE_DESC(k[1], k[7]); CE_DESC(k[2], k[9]); CE_DESC(k[3], k[4]); CE_DESC(k[6], k[13]); CE_DESC(k[8], k[14]); CE_DESC(k[10], k[15]); CE_DESC(k[11], k[12]);
    CE_DESC(k[0], k[1]); CE_DESC(k[2], k[3]); CE_DESC(k[4], k[5]); CE_DESC(k[6], k[8]); CE_DESC(k[7], k[9]); CE_DESC(k[10], k[11]); CE_DESC(k[12], k[13]); CE_DESC(k[14], k[15]);
    CE_DESC(k[0], k[2]); CE_DESC(k[1], k[3]); CE_DESC(k[4], k[10]); CE_DESC(k[5], k[11]); CE_DESC(k[6], k[7]); CE_DESC(k[8], k[9]); CE_DESC(k[12], k[14]); CE_DESC(k[13], k[15]);
    CE_DESC(k[1], k[2]); CE_DESC(k[3], k[12]); CE_DESC(k[4], k[6]); CE_DESC(k[5], k[7]); CE_DESC(k[8], k[10]); CE_DESC(k[9], k[11]); CE_DESC(k[13], k[14]);
    CE_DESC(k[1], k[4]); CE_DESC(k[2], k[6]); CE_DESC(k[5], k[8]); CE_DESC(k[7], k[10]); CE_DESC(k[9], k[13]); CE_DESC(k[11], k[14]);
    CE_DESC(k[2], k[4]); CE_DESC(k[3], k[6]); CE_DESC(k[9], k[12]); CE_DESC(k[11], k[13]);
    CE_DESC(k[3], k[5]); CE_DESC(k[6], k[8]); CE_DESC(k[7], k[9]); CE_DESC(k[10], k[12]);
    CE_DESC(k[3], k[4]); CE_DESC(k[5], k[6]); CE_DESC(k[7], k[8]); CE_DESC(k[9], k[10]); CE_DESC(k[11], k[12]);
    CE_DESC(k[6], k[7]); CE_DESC(k[8], k[9]);
}
__device__ __forceinline__ void merge16(unsigned (&a)[16], const unsigned (&b)[16]) {
#pragma unroll
    for (int i = 0; i < 16; ++i) a[i] = a[i] > b[15 - i] ? a[i] : b[15 - i];
#pragma unroll
    for (int stride = 8; stride > 0; stride >>= 1)
#pragma unroll
        for (int i = 0; i < 16; ++i) { const int j = i ^ stride; if (j > i) CE_DESC(a[i], a[j]); }
}
__device__ __forceinline__ void top16_of_64(unsigned (&g0)[16], unsigned (&g1)[16], unsigned (&g2)[16], unsigned (&g3)[16]) {
    sort16(g0); sort16(g1); sort16(g2); sort16(g3);
    merge16(g0, g1); merge16(g2, g3); merge16(g0, g2);
}
constexpr int NCAND = 50;
__device__ __forceinline__ void p8a_topk(Frame& F) {
    const bf16* QP = (const bf16*)(((unsigned char*)karg(19)) + WS_QP); const bf16* SUBK = (const bf16*)(((unsigned char*)karg(19)) + WS_SUBK);
    unsigned short* PIDX = (unsigned short*)(((unsigned char*)karg(19)) + WS_PIDX); float* PG = (float*)(((unsigned char*)karg(19)) + WS_PG);
    LAS unsigned short* Elds = (LAS unsigned short*)(F.lds) + F.wave * (NCAND * 64);
    const int lane = F.lane, r32 = lane & 31, hi = lane >> 5;
    const int gw = F.vcu * NWAVES + F.wave, NGW = F.G * NWAVES;
    for (int it2 = 0; it2 < 2 * ((M / 64 - F.vcu + F.G - 1) / F.G); ++it2) {
        const int wi = F.vcu + (it2 >> 1) * F.G;
        const int tile = 2 * wi + (it2 & 1);
        const int tok = tile * 32 + r32;
        { const int h = F.wave;
            unsigned top[2][16];
#pragma unroll
            for (int p = 0; p < 2; ++p) {
                bf16x8 qf[4];
                { const bf16* qp = QP + (size_t)tok * D + h * 128 + p * 64 + 8 * hi;
#pragma unroll
                  for (int ks = 0; ks < 4; ++ks) qf[ks] = *(const bf16x8*)(qp + 16 * ks); }
                const bf16* kp = SUBK + (size_t)((h * 2 + p) * 128 + r32) * 64 + 8 * hi;
                unsigned kk[4][16];
#pragma unroll
                for (int blk = 0; blk < 4; ++blk) {
                    f32x16 acc;
#pragma unroll
                    for (int r = 0; r < 16; ++r) acc[r] = 0.f;
#pragma unroll
                    for (int ks = 0; ks < 4; ++ks) { const bf16x8 a = *(const bf16x8*)(kp + (size_t)blk * 32 * 64 + 16 * ks); acc = MFMA32(a, qf[ks], acc); }
#pragma unroll
                    for (int r = 0; r < 16; ++r) { const int key = 32 * blk + crow(r, hi); kk[blk][r] = (f2ord(acc[r]) & ~127u) | (unsigned)(127 - key); }
                }
                top16_of_64(kk[0], kk[1], kk[2], kk[3]);
                unsigned other[16];
#pragma unroll
                for (int i = 0; i < 16; ++i) other[i] = xorx<32>(kk[0][i], lane);
                merge16(kk[0], other);
#pragma unroll
                for (int i = 0; i < 16; ++i) top[p][i] = kk[0][i];
            }
            float s1[16], s2[16]; unsigned i1[16], i2[16];
#pragma unroll
            for (int i = 0; i < 16; ++i) { s1[i] = ord2f(top[0][i] & ~127u); i1[i] = 127u - (top[0][i] & 127u); s2[i] = ord2f(top[1][i] & ~127u); i2[i] = 127u - (top[1][i] & 127u); }
            unsigned ck[4][16];
#pragma unroll
            for (int c = 0; c < 64; ++c) {
                if (c < NCAND) { constexpr int CA[NCAND] = {0,0,0,0,0,0,0,0,0,0,0,0,0,0,0,0,1,1,1,1,1,1,1,1,2,2,2,2,2,3,3,3,3,4,4,4,5,5,6,6,7,7,8,9,10,11,12,13,14,15}; constexpr int CB[NCAND] = {0,1,2,3,4,5,6,7,8,9,10,11,12,13,14,15,0,1,2,3,4,5,6,7,0,1,2,3,4,0,1,2,3,0,1,2,0,1,0,1,0,1,0,0,0,0,0,0,0,0}; const int a = CA[c], b = CB[c];
                    ck[c >> 4][c & 15] = (f2ord(s1[a] + s2[b]) & ~63u) | (unsigned)(63 - c);
                    Elds[c * 64 + lane] = (unsigned short)(i1[a] * 128u + i2[b]); }
                else ck[c >> 4][c & 15] = 0u;
            }
            top16_of_64(ck[0], ck[1], ck[2], ck[3]);
            float w[16]; float wsum = 0.f; const float v0 = ord2f(ck[0][0] & ~63u);
#pragma unroll
            for (int r = 0; r < 16; ++r) { w[r] = __expf(ord2f(ck[0][r] & ~63u) - v0); wsum += w[r]; }
            const float winv = 1.0f / wsum;
#pragma unroll
            for (int r = 0; r < 16; ++r) if ((r >> 3) == hi) {
                const int c = 63 - (int)(ck[0][r] & 63u);
                const unsigned short eid = Elds[c * 64 + lane];
                PIDX[(size_t)tok * 128 + h * 16 + r] = eid; PG[(size_t)tok * 128 + h * 16 + r] = w[r] * winv; }
        }
    }
}

__device__ __forceinline__ float gelu_erf(float v) { return 0.5f * v * (1.0f + erff(v * 0.70710678118654752f)); }

#define PROBE_REPA 1
#define PROBE_REPB 1
constexpr int NR = 8, RSH = 18, BSA = 8, BSB = 8, ELP = 136, TPS = 8; static_assert(BSA == 8 && BSB == 8, "whole batches of 8");
__device__ __forceinline__ void sort128(unsigned& e0, unsigned& e1, int lane) {
#pragma unroll
    for (int size = 2; size <= 128; size <<= 1) {
#pragma unroll
        for (int stride = size >> 1; stride > 0; stride >>= 1) {
            if (stride == 64) { const unsigned lo = e0 < e1 ? e0 : e1, hi = e0 < e1 ? e1 : e0; e0 = lo; e1 = hi; }
            else {
                const bool lower = (lane & stride) == 0;
                const bool asc0 = (size == 128) ? true : (size == 64 ? true : ((lane & size) == 0));
                const bool asc1 = (size == 128) ? true : (size == 64 ? false : ((lane & size) == 0));
                const unsigned p0 = xorx_sw(e0, lane, stride), p1 = xorx_sw(e1, lane, stride);
                const unsigned mn0 = e0 < p0 ? e0 : p0, mx0 = e0 < p0 ? p0 : e0, mn1 = e1 < p1 ? e1 : p1, mx1 = e1 < p1 ? p1 : e1;
                e0 = (lower == asc0) ? mn0 : mx0; e1 = (lower == asc1) ? mn1 : mx1;
            }
        }
    }
}
template <int BS> __device__ __forceinline__ void sw_issue(v4u (&buf)[BS], const LAS unsigned* el, const unsigned char* tab, unsigned voff) {
#pragma unroll
    for (int i = 0; i < BS; ++i) { const unsigned off = (el[i] << 10) + voff;
        buf[i] = *(const v4u*)(tab + off); }
}
template <int BS> __device__ __forceinline__ void sw_proc_a(const v4u (&buf)[BS], const v4u& hq, LAS float* wl, int s, int n, int lane) {
    const int hx = (int)hq.x, hy = (int)hq.y, hz = (int)hq.z, hw = (int)hq.w;
    float dd[8];
#pragma unroll
    for (int i = 0; i < 8; ++i) dd[i] = 0.f;
#pragma unroll
    for (int i = 0; i < BS; ++i) { const int dx = (int)buf[i].x, dy = (int)buf[i].y, dz = (int)buf[i].z, dw = (int)buf[i].w;
        int t = __builtin_amdgcn_sdot4(hx, dx, 0, false); t = __builtin_amdgcn_sdot4(hy, dy, t, false); t = __builtin_amdgcn_sdot4(hz, dz, t, false); t = __builtin_amdgcn_sdot4(hw, dw, t, false);
        dd[i] = (float)t; }
    const float r1 = reduce8_t(dd, lane);
    if ((lane & 7) == 0) wl[s + (lane >> 3)] = r1;
}
typedef _Float16 h2_t __attribute__((ext_vector_type(2)));
#define CVT_H2_FP8(u, hi) __builtin_bit_cast(h2_t, __builtin_amdgcn_cvt_scalef32_pk_f16_fp8((u), 1.0f, (hi)))
template <int BS> __device__ __forceinline__ void sw_proc_b(const v4u (&buf)[BS], h2_t (&acc)[8], const LAS float* wl, int s, int n) {
    float wr[BS];
#pragma unroll
    for (int i = 0; i < BS; ++i) wr[i] = wl[s + i];
#pragma unroll
    for (int i = 0; i < BS; ++i) {
        const h2_t wv = __builtin_bit_cast(h2_t, wr[i]);
        const unsigned ux = buf[i].x, uy = buf[i].y, uz = buf[i].z, uw = buf[i].w;
        acc[0] = __builtin_elementwise_fma(CVT_H2_FP8(ux, false), wv, acc[0]); acc[1] = __builtin_elementwise_fma(CVT_H2_FP8(ux, true), wv, acc[1]);
        acc[2] = __builtin_elementwise_fma(CVT_H2_FP8(uy, false), wv, acc[2]); acc[3] = __builtin_elementwise_fma(CVT_H2_FP8(uy, true), wv, acc[3]);
        acc[4] = __builtin_elementwise_fma(CVT_H2_FP8(uz, false), wv, acc[4]); acc[5] = __builtin_elementwise_fma(CVT_H2_FP8(uz, true), wv, acc[5]);
        acc[6] = __builtin_elementwise_fma(CVT_H2_FP8(uw, false), wv, acc[6]); acc[7] = __builtin_elementwise_fma(CVT_H2_FP8(uw, true), wv, acc[7]); }
}
__device__ __forceinline__ void sw_warm(v4u (&pf)[4], const unsigned char* tab, int range, int lw, unsigned voff) {
#pragma unroll
    for (int i = 0; i < 4; ++i) { const unsigned off = ((unsigned)(range * 1024 + lw * 4 + i) << 10) + voff; pf[i] = *(const v4u*)(tab + off); }
}
__device__ __forceinline__ void sw_warm_done(const v4u (&pf)[4]) {
#pragma unroll
    for (int i = 0; i < 4; ++i) asm volatile("" :: "v"(pf[i]));
}
template <int FAKE> __device__ __forceinline__ void p8b_sweep(Frame& F) {
    const bf16* X1 = (const bf16*)(((unsigned char*)karg(19)) + WS_X1); const float* MOD = (const float*)(((unsigned char*)karg(19)) + WS_MOD);
    const unsigned char* H2Q = (const unsigned char*)(((unsigned char*)karg(19)) + WS_H2Q); const float* H2S = (const float*)(((unsigned char*)karg(19)) + WS_H2S);
    const unsigned char* EDq = (const unsigned char*)(((unsigned char*)karg(19)) + WS_ED); const unsigned char* EUq = (const unsigned char*)(((unsigned char*)karg(19)) + WS_EU); const float* EDS = (const float*)(((unsigned char*)karg(19)) + WS_EDS);
    const unsigned short* PIDX = (const unsigned short*)(((unsigned char*)karg(19)) + WS_PIDX); const float* PG = (const float*)(((unsigned char*)karg(19)) + WS_PG);
    const float* fg = ((const float*)karg(17));
    const int gw = F.vcu * NWAVES + F.wave, NGW = F.G * NWAVES;
    for (int wi = F.vcu; wi < M / 64; wi += F.G) {
        const int tb = wi * 8 + F.wave;
        unsigned ones = ~0u; asm volatile("" : "+s"(ones));
        int lane = (int)__builtin_amdgcn_mbcnt_hi(ones, __builtin_amdgcn_mbcnt_lo(ones, 0u)); asm volatile("" : "+v"(lane));
        const int tok0 = tb * 8;
        unsigned E0[8], E1[8];
        LAS float* Wl = (LAS float*)(F.lds) + F.wave * 1024;
        LAS unsigned* El = (LAS unsigned*)(F.lds + 32768) + F.wave * (8 * ELP);
        unsigned voff = 16u * (unsigned)lane; asm volatile("" : "+v"(voff));
        LAS int* Bnd = (LAS int*)(F.lds + 67584) + F.wave * (8 * (NR + 1));
#pragma unroll
        for (int k = 0; k < 8; ++k) {
            const size_t base = (size_t)(tok0 + k) * 128;
            E0[k] = ((unsigned)PIDX[base + lane] << 7) | (unsigned)lane; E1[k] = ((unsigned)PIDX[base + 64 + lane] << 7) | (unsigned)(64 + lane);
            sort128(E0[k], E1[k], lane);
            if (FAKE) { E0[k] = (E0[k] & 0x1ffffu) ; E1[k] = (E1[k] & 0x1ffffu); sort128(E0[k], E1[k], lane); }
            El[k * ELP + lane] = E0[k] >> 7; El[k * ELP + 64 + lane] = E1[k] >> 7;
            if (lane < 8) El[k * ELP + 128 + lane] = (unsigned)__builtin_amdgcn_readlane((int)E1[k], 63) >> 7;
        }
        for (int repa = 0; repa < PROBE_REPA; ++repa) {
            v4u hq[8];
#pragma unroll
            for (int k = 0; k < 8; ++k) hq[k] = *(const v4u*)(H2Q + (size_t)(tok0 + k) * D + 16 * lane);
            int pos[8];
#pragma unroll
            for (int k = 0; k < 8; ++k) pos[k] = 0;
            v4u bA[BSA], bB[BSA], bC[BSA]; int ps = 0, pn = 0;
            for (int r = 0; r < NR; ++r) {
#pragma unroll
                for (int k = 0; k < 8; ++k) {
                    constexpr int dummy = 0; (void)dummy;
                    const int kp = (k + 7) & 7;
                    const unsigned long long BM = 0x0101010101010101ull;
                    const int c = __builtin_popcountll(__ballot((E0[k] >> RSH) == (unsigned)r) & BM) + __builtin_popcountll(__ballot((E1[k] >> RSH) == (unsigned)r) & BM);
                    int s = __builtin_amdgcn_readfirstlane(pos[k]); const int e_end = __builtin_amdgcn_readfirstlane(s + 8 * c); pos[k] = e_end;
                    if (lane == 0) Bnd[k * (NR + 1) + r + 1] = e_end;
                    const int n1 = (e_end - s) < BSA ? (e_end - s) : BSA;
                    if (k & 1) sw_issue<BSA>(bB, El + k * ELP + s, EDq, voff); else sw_issue<BSA>(bA, El + k * ELP + s, EDq, voff);
                    if (pn > 0) { if (k & 1) sw_proc_a<BSA>(bA, hq[kp], Wl + kp * 128, ps, pn, lane); else sw_proc_a<BSA>(bB, hq[kp], Wl + kp * 128, ps, pn, lane); }
                    ps = s; pn = n1; s += n1;
#define SWA_REST(Y) if (s < e_end) { sw_issue<BSA>(Y, El + k * ELP + s, EDq, voff); \
                        for (;;) { int n = (e_end - s) < BSA ? (e_end - s) : BSA; \
                            if (s + BSA < e_end) { sw_issue<BSA>(bC, El + k * ELP + s + BSA, EDq, voff); sw_proc_a<BSA>(Y, hq[k], Wl + k * 128, s, n, lane); } else { sw_proc_a<BSA>(Y, hq[k], Wl + k * 128, s, n, lane); break; } \
                            s += BSA; n = (e_end - s) < BSA ? (e_end - s) : BSA; \
                            if (s + BSA < e_end) { sw_issue<BSA>(Y, El + k * ELP + s + BSA, EDq, voff); sw_proc_a<BSA>(bC, hq[k], Wl + k * 128, s, n, lane); } else { sw_proc_a<BSA>(bC, hq[k], Wl + k * 128, s, n, lane); break; } \
                            s += BSA; } }
                    if (k & 1) { SWA_REST(bA) } else { SWA_REST(bB) }
#undef SWA_REST
                }
            }
            if (pn > 0) sw_proc_a<BSA>(bB, hq[7], Wl + 7 * 128, ps, pn, lane);
        }
#pragma unroll
        for (int k = 0; k < 8; ++k) { int tk = tok0 + k; asm volatile("" : "+s"(tk)); const size_t base = (size_t)tk * 128; const float sh = H2S[tk];
            const float r0 = Wl[k * 128 + lane], r1 = Wl[k * 128 + 64 + lane];
            const _Float16 w0 = (_Float16)(PG[base + (E0[k] & 127u)] * gelu_erf(r0 * sh * EDS[E0[k] >> 7])), w1 = (_Float16)(PG[base + (E1[k] & 127u)] * gelu_erf(r1 * sh * EDS[E1[k] >> 7]));
            Wl[k * 128 + lane] = __builtin_bit_cast(float, (h2_t){w0, w0}); Wl[k * 128 + 64 + lane] = __builtin_bit_cast(float, (h2_t){w1, w1}); }
        int ln = lane; asm volatile("" : "+v"(ln));
#pragma unroll
        for (int sub = 0; sub < 8 / TPS; ++sub) {
        h2_t acc[TPS][8];
        for (int repb = 0; repb < PROBE_REPB; ++repb) {
#pragma unroll
            for (int kk = 0; kk < TPS; ++kk)
#pragma unroll
                for (int i = 0; i < 8; ++i) acc[kk][i] = (h2_t){(_Float16)0.f, (_Float16)0.f};
            int pos[TPS];
#pragma unroll
            for (int kk = 0; kk < TPS; ++kk) pos[kk] = 0;
            v4u bA[BSB], bB[BSB]; int ps = 0, pn = 0;
            for (int r = 0; r < NR; ++r) {
#pragma unroll
                for (int kk = 0; kk < TPS; ++kk) {
                    const int k = sub * TPS + kk, kkp = (kk + TPS - 1) % TPS, kp = sub * TPS + kkp;
                    int s = __builtin_amdgcn_readfirstlane(pos[kk]); const int e_end = __builtin_amdgcn_readfirstlane(Bnd[k * (NR + 1) + r + 1]); pos[kk] = e_end;
                    const int n1 = (e_end - s) < BSB ? (e_end - s) : BSB;
                    if (kk & 1) sw_issue<BSB>(bB, El + k * ELP + s, EUq, voff); else sw_issue<BSB>(bA, El + k * ELP + s, EUq, voff);
                    if (pn > 0) { if (kk & 1) sw_proc_b<BSB>(bA, acc[kkp], Wl + kp * 128, ps, pn); else sw_proc_b<BSB>(bB, acc[kkp], Wl + kp * 128, ps, pn); }
                    ps = s; pn = n1; s += n1;
                    for (; s < e_end; s += BSB) {
                        const int n = (e_end - s) < BSB ? (e_end - s) : BSB;
                        if (kk & 1) { sw_issue<BSB>(bA, El + k * ELP + s, EUq, voff); sw_proc_b<BSB>(bA, acc[kk], Wl + k * 128, s, n); }
                        else        { sw_issue<BSB>(bB, El + k * ELP + s, EUq, voff); sw_proc_b<BSB>(bB, acc[kk], Wl + k * 128, s, n); }
                    }
                }
            }
            if (pn > 0) sw_proc_b<BSB>(bB, acc[TPS - 1], Wl + (sub * TPS + TPS - 1) * 128, ps, pn);
        }
        {
            asm volatile("" : "+v"(ln));
            float* outp = (float*)karg(18);
            const float* gt2 = MOD + ((tok0 + sub * TPS) >> 12) * NMOD + 5120;
            f32x4 gtv[4]; u32x2 xcur[4], xnxt[4];
#pragma unroll
            for (int j = 0; j < 4; ++j) { const int col = 4 * ln + 256 * j; gtv[j] = *(const f32x4*)(gt2 + col); xcur[j] = *(const u32x2*)(X1 + (size_t)(tok0 + sub * TPS) * D + col); }
#pragma unroll
            for (int kk = 0; kk < TPS; ++kk) {
                const int tok = tok0 + sub * TPS + kk;
                if (kk + 1 < TPS) {
#pragma unroll
                    for (int j = 0; j < 4; ++j) xnxt[j] = __builtin_nontemporal_load((const u32x2*)(X1 + (size_t)(tok + 1) * D + 4 * ln + 256 * j));
                }
                f32x4 x2[4]; float ss = 0.f;
#pragma unroll
                for (int j = 0; j < 4; ++j) {
#pragma unroll
                    for (int i = 0; i < 4; ++i) { const unsigned xw = (i >> 1) ? xcur[j].y : xcur[j].x; const float xf = (i & 1) ? bfhi(xw) : bflo(xw);
                        const float v = xf + gtv[j][i] * (0.0625f * (float)acc[kk][2 * j + (i >> 1)][i & 1]); x2[j][i] = v; ss += v * v; } }
                ss = wave_sum_x(ss, ln);
                if (!(FAKE && ss != 12345.678f)) {
                    const float rstd = 1.0f / sqrtf(ss * (1.0f / D) + EPS);
                    f32x4 fgv[4];
#pragma unroll
                    for (int j = 0; j < 4; ++j) fgv[j] = *(const f32x4*)(fg + 4 * ln + 256 * j);
#pragma unroll
                    for (int j = 0; j < 4; ++j) __builtin_nontemporal_store(x2[j] * rstd * fgv[j], (f32x4*)(outp + (size_t)tok * D + 4 * ln + 256 * j));
                }
#pragma unroll
                for (int j = 0; j < 4; ++j) xcur[j] = xnxt[j];
            }
        }
        }
    }
}

struct Args { const float* in[18]; float* out; unsigned char* ws; };
__global__ void __launch_bounds__(NTHR, 2) mega_fwd(Args args) {
    extern __shared__ __attribute__((aligned(16))) unsigned char lds[];
    Frame F;
    F.lds = (LAS unsigned char*)lds;
    F.wave = __builtin_amdgcn_readfirstlane((int)threadIdx.x >> 6); F.lane = lane_fresh(); F.tid = F.wave * 64 + F.lane;
    F.G = gridDim.x; { const int bx = blockIdx.x; F.vcu = (F.G % 8 == 0) ? (bx % 8) * (F.G / 8) + bx / 8 : bx; }
    volatile LAS unsigned* MISC = (volatile LAS unsigned*)(F.lds + MISC_OFF);
    for (int u = F.tid; u < (LDS_BYTES - LDSCTL_OFF) / 4; u += NTHR) ((LAS unsigned*)(F.lds + LDSCTL_OFF))[u] = 0u;
    __syncthreads();
    gu32* ctl = (gu32*)(((unsigned char*)karg(19)) + WS_CTL);
    XcdBarrier bar = xcd_barrier_post((unsigned*)(ctl + CW_BAR), MISC + 8, F.wave);
#define GRID_BAR() xcd_barrier(bar)
#define PROBE_TS -1
#define STAMP(i) do { if (PROBE_TS >= 0 && blockIdx.x == 0 && F.tid == 0) { const unsigned long long t_ = __builtin_amdgcn_s_memrealtime(); MISC[16 + 2 * (i)] = (unsigned)t_; MISC[17 + 2 * (i)] = (unsigned)(t_ >> 32); } } while (0)
#define PROBE_DBL -1

    STAMP(0);
    F.lane = lane_fresh(); F.tid = F.wave * 64 + F.lane;
    p0_prologue(F); GRID_BAR(); STAMP(1);
    if (PROBE_DBL == 0) { p0_prologue(F); GRID_BAR(); }
    F.lane = lane_fresh(); F.tid = F.wave * 64 + F.lane;
    p1_norm(F); p0_transposes(F); GRID_BAR(); STAMP(2);
    if (PROBE_DBL == 1) { p1_norm(F); GRID_BAR(); }
    {
    {
        pg8::Gemm g{(const pg8::bf16_t*)(((unsigned char*)karg(19)) + WS_H), (const pg8::bf16_t*)(((unsigned char*)karg(19)) + WS_WIN), M, NPROJ, D, nullptr, nullptr};
        pg8::StaticOrder S; S.init(M, NPROJ, F.G, (int)blockIdx.x);
        pg8::EpiBf16<0> E{(pg8::bf16_t*)(((unsigned char*)karg(19)) + WS_PROJ), NPROJ, nullptr, 0, 0, 1.f};
        pg8::gemm_phase<pg8::EpiBf16<0>, pg8::StaticOrder, true, true>(F.lds + RING_OFF, g, S, E, F.wave);
        const int nwg = (M / 256) * (NPROJ / 256), busy = nwg % F.G;
        if (busy == 0) p0_quant_tables(F, F.vcu * NWAVES + F.wave, F.G * NWAVES);
        else if ((int)blockIdx.x >= busy) p0_quant_tables(F, ((int)blockIdx.x - busy) * NWAVES + F.wave, (F.G - busy) * NWAVES);
    }
    GRID_BAR(); STAMP(3);
    }
    F.lane = lane_fresh(); F.tid = F.wave * 64 + F.lane;
    p3_attention(F); GRID_BAR(); STAMP(4);
    if (PROBE_DBL == 3) { p3_attention(F); GRID_BAR(); }
    {
    {
        pg8::Gemm g{(const pg8::bf16_t*)(((unsigned char*)karg(19)) + WS_OA), (const pg8::bf16_t*)(((unsigned char*)karg(19)) + WS_WA), M, D, 512, (const pg8::bf16_t*)(((unsigned char*)karg(19)) + WS_OB), (const pg8::bf16_t*)(((unsigned char*)karg(19)) + WS_WB)};
        PairOrder S; S.S.init(M, D, F.G, (int)blockIdx.x);
        EpiGate E{(const bf16*)(((unsigned char*)karg(19)) + WS_PROJ), (bf16*)((float*)karg(18)) + (size_t)M * D};
        pg8::gemm_phase<EpiGate, PairOrder, true, true>(F.lds + RING_OFF, g, S, E, F.wave);
    }
    GRID_BAR(); STAMP(5);
    }
    {
    {
        pg8::Gemm g{(const pg8::bf16_t*)((bf16*)((float*)karg(18)) + (size_t)M * D), (const pg8::bf16_t*)(((unsigned char*)karg(19)) + WS_WOUT), M, D, D, nullptr, nullptr};
        pg8::StaticOrder S; S.init(M, D, F.G, (int)blockIdx.x);
        EpiRes E{((const float*)karg(0)), (const float*)(((unsigned char*)karg(19)) + WS_MOD), (bf16*)(((unsigned char*)karg(19)) + WS_X1)};
        pg8::gemm_phase<EpiRes, pg8::StaticOrder, true, true>(F.lds + RING_OFF, g, S, E, F.wave);
    }
    GRID_BAR(); STAMP(6);
    }
    F.lane = lane_fresh(); F.tid = F.wave * 64 + F.lane;
    F.lane = lane_fresh(); F.tid = F.wave * 64 + F.lane;
    p6_norm2(F); GRID_BAR(); STAMP(7);
    if (PROBE_DBL == 6) { p6_norm2(F); GRID_BAR(); }
    {
    {
        pg8::Gemm g{(const pg8::bf16_t*)(((unsigned char*)karg(19)) + WS_H2), (const pg8::bf16_t*)(((unsigned char*)karg(19)) + WS_WQ), M, D, D, nullptr, nullptr};
        pg8::StaticOrder S; S.init(M, D, F.G, (int)blockIdx.x);
        pg8::EpiBf16<0> E{(pg8::bf16_t*)(((unsigned char*)karg(19)) + WS_QP), D, nullptr, 0, 0, 1.f};
        pg8::gemm_phase<pg8::EpiBf16<0>, pg8::StaticOrder, true, true>(F.lds + RING_OFF, g, S, E, F.wave);
    }
    GRID_BAR(); STAMP(8);
    }
    F.lane = lane_fresh(); F.tid = F.wave * 64 + F.lane;
    p8a_topk(F); __syncthreads(); STAMP(9);
    if (PROBE_DBL == 8) { p8a_topk(F); GRID_BAR(); }
    if (PROBE_DBL == 12) { p8b_sweep<1>(F); __syncthreads(); }
    p8b_sweep<0>(F);
    if (PROBE_DBL == 9) { GRID_BAR(); p8b_sweep<0>(F); }
    if (PROBE_TS >= 0) {
        GRID_BAR(); STAMP(10);
        if (blockIdx.x == 0) { __syncthreads();
            const unsigned long long t0 = ((unsigned long long)MISC[17 + 2 * PROBE_TS] << 32) | MISC[16 + 2 * PROBE_TS], t1 = ((unsigned long long)MISC[19 + 2 * PROBE_TS] << 32) | MISC[18 + 2 * PROBE_TS];
            const float d_us = (float)(t1 - t0) * 0.01f;
            const float V = 128.0f * sqrtf(d_us * 1e-5f);
            float* o = (float*)karg(18); for (int c = F.tid; c < D; c += NTHR) o[c] = V; }
    }
}

extern "C" void kernel_launch(void* const* d_in, const int* in_sizes, int n_in, void* d_out, int out_size, void* d_ws, size_t ws_size, hipStream_t stream) {
    static int grid = 0;
    if (grid == 0) {
        if (n_in != 18 || in_sizes[0] != M * D || out_size != M * D || ws_size < WS_END) { fprintf(stderr, "kernel_launch: unexpected shapes (n_in %d, in0 %d, out %d, ws %zu)\n", n_in, n_in > 0 ? in_sizes[0] : -1, out_size, ws_size); grid = -1; return; }
        int dev = 0, cus = 0, per_cu = 0;
        if (hipGetDevice(&dev) != hipSuccess || hipDeviceGetAttribute(&cus, hipDeviceAttributeMultiprocessorCount, dev) != hipSuccess) { grid = -1; return; }
        if (hipFuncSetAttribute((const void*)mega_fwd, hipFuncAttributeMaxDynamicSharedMemorySize, LDS_BYTES) != hipSuccess) { fprintf(stderr, "kernel_launch: hipFuncSetAttribute failed\n"); grid = -1; return; }
        if (hipOccupancyMaxActiveBlocksPerMultiprocessor(&per_cu, (const void*)mega_fwd, NTHR, LDS_BYTES) != hipSuccess || per_cu < 1) { fprintf(stderr, "kernel_launch: occupancy query says %d blocks per CU\n", per_cu); }
        (void)hipGetLastError();
        grid = cus;
    }
    if (grid < 0) return;
    if (hipMemsetAsync((char*)d_ws + WS_CTL, 0, CTL_ZERO_BYTES, stream) != hipSuccess) { fprintf(stderr, "kernel_launch: memset failed\n"); return; }
    Args a{};
    for (int i = 0; i < 18; ++i) a.in[i] = (const float*)d_in[i];
    a.out = (float*)d_out; a.ws = (unsigned char*)d_ws;
    hipLaunchKernelGGL(mega_fwd, dim3(grid), dim3(NTHR), LDS_BYTES, stream, a);
}
```

```cpp
#include <hip/hip_runtime.h>
#include <cstdio>
#include <cstdint>
__device__ __forceinline__ int lane_fresh() { unsigned ones = ~0u; asm volatile("" : "+s"(ones)); return (int)__builtin_amdgcn_mbcnt_hi(ones, __builtin_amdgcn_mbcnt_lo(ones, 0u)); }
namespace pg8 {
#define PG8_LAS __attribute__((address_space(3)))
typedef unsigned short bf16_t;
typedef short bf16x8 __attribute__((ext_vector_type(8)));
typedef float f32x4 __attribute__((ext_vector_type(4)));
typedef unsigned u32x4 __attribute__((ext_vector_type(4)));
constexpr int BM = 256, BK = 64, HALF = 128, HTB = HALF * BK * 2  , STAGE_BYTES = 8 * HTB, NXCD = 8, WGM = 8;

__host__ __device__ __forceinline__ int lds_byte(int r, int c) { const int st = (r >> 4) * 2 + (c >> 5), rr = r & 15, cc = c & 31, ob = rr * 64 + cc * 2; return st * 1024 + (ob ^ (((ob >> 9) & 1) << 5)); }
__host__ __device__ __forceinline__ void stage_rc(int b, int& R, int& C) { const int st = b / 1024, sb = b % 1024, swz = sb ^ (((sb >> 9) & 1) << 5); R = (st >> 1) * 16 + swz / 64; C = (st & 1) * 32 + (swz % 64) / 2; }
__host__ __device__ __forceinline__ int perm32(int rho) { const int n = rho >> 4, i = rho & 15; return 8 * (i >> 2) + 4 * n + (i & 3); }

struct Unit { int pm, pn, src; };
struct Gemm { const bf16_t* A; const bf16_t* Bt; int M, N, K; const bf16_t* A2; const bf16_t* Bt2; };

struct StaticOrder {
    int nM, nN, nwg, G, c;
    __host__ __device__ void init(int M, int N, int G_, int c_) { nM = M / BM; nN = N / BM; nwg = nM * nN; G = G_; c = c_; }
    __host__ __device__ bool next(int i, Unit& u) const {
        const long L = (long)i * G + c; if (L >= nwg) return false;
        int wgid = (int)L; { const int q = nwg / NXCD, r = nwg % NXCD, xcd = wgid % NXCD, off = wgid / NXCD; wgid = (xcd < r ? xcd * (q + 1) : r * (q + 1) + (xcd - r) * q) + off; }
        const int nig = WGM * nN, gid = wgid / nig, fm = gid * WGM, gsz = (nM - fm) < WGM ? (nM - fm) : WGM;
        u.pm = fm + ((wgid % nig) % gsz); u.pn = (wgid % nig) / gsz; u.src = 0; return true;
    }
    __device__ __forceinline__ void a_ready(const Unit&) const {}
    __device__ __forceinline__ void done(const Unit&) const {}
};

__device__ __forceinline__ unsigned cvt_pk_bf16(float lo, float hi) { unsigned r; asm volatile("v_cvt_pk_bf16_f32 %0, %1, %2" : "=v"(r) : "v"(lo), "v"(hi)); return r; }
typedef float f32x2 __attribute__((ext_vector_type(2)));
__device__ __forceinline__ f32x2 gelu_pk(f32x2 v) {
    const f32x2 av = __builtin_elementwise_abs(v), d = av * 0.2316418882f + 1.0f;
    f32x2 t; t.x = __builtin_amdgcn_rcpf(d.x); t.y = __builtin_amdgcn_rcpf(d.y);
    f32x2 q = t * 0.5307027145f + (-0.7265760135f); q = q * t + 0.7107068705f; q = q * t + (-0.142248368f); q = q * t + 0.127414796f; q = q * t;
    const f32x2 s = (v * v) * (-0.72134752044f);
    f32x2 e; e.x = __builtin_amdgcn_exp2f(s.x); e.y = __builtin_amdgcn_exp2f(s.y);
    const f32x2 m = v * (q * e), r = v - m;
    f32x2 o; o.x = v.x < 0.f ? m.x : r.x; o.y = v.y < 0.f ? m.y : r.y; return o;
}

template <int ACT  > struct EpiBf16 {
    static constexpr bool PERM = true, AFTER_DRAIN = false, CHAIN = false; static_assert(ACT == 0 || ACT == 1, "EpiBf16: ACT is 0 (none) or 1 (gelu_pk)");
    bf16_t* O; int ldc; const float* bias; int split_cols; size_t split_stride; float scale0;
    __device__ __forceinline__ void operator()(const f32x4 (&acc)[2][2][4][2], const Unit& u, int wr, int wc, int fr, int fq) const {
        const int row0 = u.pm * BM + wr * 64 + fr; int colt = u.pn * BM; bf16_t* base = O;
        float sc = 1.f; if (split_cols) { const int t = colt / split_cols; base += (size_t)t * split_stride; colt -= t * split_cols; if (t == 0) sc = scale0; }
        const int col0 = colt + wc * 32 + 8 * fq, bcol0 = u.pn * BM + wc * 32 + 8 * fq;
        f32x4 bv[2][2];
#pragma unroll
        for (int bj = 0; bj < 2; ++bj)
#pragma unroll
            for (int n = 0; n < 2; ++n) bv[bj][n] = bias ? *(const f32x4*)(bias + bcol0 + bj * HALF + 4 * n) : (f32x4){0.f, 0.f, 0.f, 0.f};
#pragma unroll
        for (int ai = 0; ai < 2; ++ai)
#pragma unroll
            for (int m = 0; m < 4; ++m) { bf16_t* rowp = base + (size_t)(row0 + ai * HALF + m * 16) * ldc + col0;
#pragma unroll
                for (int bj = 0; bj < 2; ++bj) { f32x4 v0 = acc[ai][bj][m][0] + bv[bj][0], v1 = acc[ai][bj][m][1] + bv[bj][1];
                    if (ACT == 1) { f32x2 a = gelu_pk((f32x2){v0[0], v0[1]}), b = gelu_pk((f32x2){v0[2], v0[3]}), c = gelu_pk((f32x2){v1[0], v1[1]}), d = gelu_pk((f32x2){v1[2], v1[3]});
                        v0 = (f32x4){a.x, a.y, b.x, b.y}; v1 = (f32x4){c.x, c.y, d.x, d.y}; }
                    v0 = v0 * sc; v1 = v1 * sc; u32x4 w; w.x = cvt_pk_bf16(v0[0], v0[1]); w.y = cvt_pk_bf16(v0[2], v0[3]); w.z = cvt_pk_bf16(v1[0], v1[1]); w.w = cvt_pk_bf16(v1[2], v1[3]);
                    *(u32x4*)(rowp + bj * HALF) = w; } }
    }
};

template <class Epi, class Sched, bool ALIGN_EPI = false, bool SP2 = false>
__device__ __forceinline__ void gemm_phase(PG8_LAS unsigned char* lds, const Gemm g, const Sched& S, const Epi& E, int wave_id) {
    int tid = wave_id * 64 + ::lane_fresh(); asm volatile("" : "+v"(tid));
    const int wid = __builtin_amdgcn_readfirstlane(tid >> 6), lane = tid & 63, wr = wid >> 2, wc = wid & 3, fr = lane & 15, fq = lane >> 4;
    const int K = g.K, nt = K / BK;
    unsigned voffA[2], voffB[2];
#pragma unroll
    for (int i = 0; i < 2; ++i) { int R, C; stage_rc(tid * 16 + i * 8192, R, C); const int Rb = Epi::PERM ? ((R & ~31) + perm32(R & 31)) : R;
        voffA[i] = (unsigned)(R * K + C) * 2u; voffB[i] = (unsigned)(Rb * K + C) * 2u; }
    const size_t kstep = (size_t)(BK * 2);
    const size_t hstep = (size_t)HALF * K * 2;
    const size_t tstep = 2 * hstep;
    const unsigned ldsw = (unsigned)wid * 1024u;
    const int aoff = lds_byte(wr * 64 + fr, fq * 8), boff = lds_byte(wc * 32 + fr, fq * 8);
#define PG8_SA(b, h) (((b) * 2 + (h)) * HTB)
#define PG8_SB(b, h) ((4 + (b) * 2 + (h)) * HTB)
#define PG8_STAGE(bufoff, gbase, voff) do { _Pragma("unroll") for (int _i = 0; _i < 2; ++_i) \
        __builtin_amdgcn_global_load_lds((const unsigned*)((const char*)(gbase) + (voff)[_i]), (PG8_LAS unsigned*)(lds + (bufoff) + ldsw + _i * 8192), 16, 0, 0); } while (0)
#define PG8_LDA(dst, b, h) do { _Pragma("unroll") for (int m = 0; m < 4; ++m) _Pragma("unroll") for (int k = 0; k < 2; ++k) dst[m][k] = *(const PG8_LAS bf16x8*)(lds + PG8_SA(b, h) + aoff + m * 2048 + k * 1024); } while (0)
#define PG8_LDB(dst, b, h) do { _Pragma("unroll") for (int n = 0; n < 2; ++n) _Pragma("unroll") for (int k = 0; k < 2; ++k) dst[n][k] = *(const PG8_LAS bf16x8*)(lds + PG8_SB(b, h) + boff + n * 2048 + k * 1024); } while (0)
#define PG8_MMA(ai, bj, At, Bt) do { __builtin_amdgcn_s_setprio(1); _Pragma("unroll") for (int m = 0; m < 4; ++m) _Pragma("unroll") for (int n = 0; n < 2; ++n) _Pragma("unroll") for (int k = 0; k < 2; ++k) \
        acc[ai][bj][m][n] = __builtin_amdgcn_mfma_f32_16x16x32_bf16(Bt[n][k], At[m][k], acc[ai][bj][m][n], 0, 0, 0); __builtin_amdgcn_s_setprio(0); } while (0)
#define PG8_WAIT_V(n) asm volatile("s_waitcnt vmcnt(" #n ")" ::: "memory")
#define PG8_WAIT_L(n) asm volatile("s_waitcnt lgkmcnt(" #n ")" ::: "memory")
#define PG8_BAR __builtin_amdgcn_s_barrier()
#define PG8_SCHED __builtin_amdgcn_sched_barrier(0)
    Unit cur, nxt; int ui = 0;
    if (!S.next(0, cur)) return;
    f32x4 acc[2][2][4][2];
#pragma unroll
    for (int a = 0; a < 2; ++a)
#pragma unroll
        for (int b = 0; b < 2; ++b)
#pragma unroll
            for (int m = 0; m < 4; ++m)
#pragma unroll
                for (int n = 0; n < 2; ++n) acc[a][b][m][n] = (f32x4){0.f, 0.f, 0.f, 0.f};
    bf16x8 At[4][2], B0[2][2], B1[2][2];
    const char* cA = (const char*)(cur.src ? g.A2 : g.A) + (size_t)cur.pm * tstep; const char* cB = (const char*)(cur.src ? g.Bt2 : g.Bt) + (size_t)cur.pn * tstep;
    S.a_ready(cur);
    if constexpr (SP2) {
        PG8_STAGE(PG8_SB(0, 0), cB, voffB); PG8_STAGE(PG8_SB(0, 1), cB + hstep, voffB); PG8_STAGE(PG8_SA(0, 0), cA, voffA); PG8_STAGE(PG8_SA(0, 1), cA + hstep, voffA);
        if (wr == 1) PG8_BAR;
        PG8_WAIT_V(2); PG8_BAR;
        PG8_STAGE(PG8_SB(1, 0), cB + kstep, voffB); PG8_STAGE(PG8_SA(1, 0), cA + kstep, voffA); PG8_STAGE(PG8_SB(1, 1), cB + hstep + kstep, voffB);
        PG8_WAIT_V(6); PG8_BAR;
    } else {
        PG8_STAGE(PG8_SB(0, 0), cB, voffB); PG8_STAGE(PG8_SA(0, 0), cA, voffA); PG8_STAGE(PG8_SB(0, 1), cB + hstep, voffB); PG8_STAGE(PG8_SA(0, 1), cA + hstep, voffA);
        if (wr == 1) PG8_BAR;
        PG8_WAIT_V(4); PG8_BAR;
        PG8_STAGE(PG8_SB(1, 0), cB + kstep, voffB); PG8_STAGE(PG8_SA(1, 0), cA + kstep, voffA); PG8_STAGE(PG8_SB(1, 1), cB + hstep + kstep, voffB);
        PG8_WAIT_V(6); PG8_BAR;
    }
    for (;;) {
        const bool has_next = S.next(ui + 1, nxt);
        const char* nA = has_next ? (const char*)(nxt.src ? g.A2 : g.A) + (size_t)nxt.pm * tstep : cA; const char* nB = has_next ? (const char*)(nxt.src ? g.Bt2 : g.Bt) + (size_t)nxt.pn * tstep : cB;
        for (int t = 0; t < nt; t += 2) {
            const bool last = (t == nt - 2);
            const char* a1 = cA + (size_t)(t + 1) * kstep;
            const char* a2 = last ? nA : cA + (size_t)(t + 2) * kstep; const char* b2 = last ? nB : cB + (size_t)(t + 2) * kstep;
            const char* a3 = a2 + kstep; const char* b3 = b2 + kstep;
            if (last && has_next) S.a_ready(nxt);
            if constexpr (SP2) {
            PG8_LDB(B0, 0, 0); PG8_LDB(B1, 0, 1); PG8_SCHED; PG8_LDA(At, 0, 0); PG8_STAGE(PG8_SA(1, 1), a1 + hstep, voffA);
            PG8_WAIT_V(8); PG8_WAIT_L(0); PG8_BAR; PG8_MMA(0, 0, At, B0); PG8_MMA(0, 1, At, B1); PG8_BAR; PG8_SCHED;
            PG8_LDA(At, 0, 1); PG8_STAGE(PG8_SB(0, 0), b2, voffB); PG8_STAGE(PG8_SB(0, 1), b2 + hstep, voffB); PG8_STAGE(PG8_SA(0, 0), a2, voffA);
            PG8_WAIT_V(8); PG8_WAIT_L(0); PG8_BAR; PG8_MMA(1, 0, At, B0); PG8_MMA(1, 1, At, B1); PG8_BAR; PG8_SCHED;
            PG8_LDB(B0, 1, 0); PG8_LDB(B1, 1, 1); PG8_SCHED; PG8_LDA(At, 1, 0); PG8_STAGE(PG8_SA(0, 1), a2 + hstep, voffA);
            PG8_WAIT_V(8); PG8_WAIT_L(0); PG8_BAR; PG8_MMA(0, 0, At, B0); PG8_MMA(0, 1, At, B1); PG8_BAR; PG8_SCHED;
            PG8_LDA(At, 1, 1); PG8_STAGE(PG8_SB(1, 0), b3, voffB); PG8_STAGE(PG8_SB(1, 1), b3 + hstep, voffB); PG8_STAGE(PG8_SA(1, 0), a3, voffA);
            PG8_WAIT_V(8); PG8_WAIT_L(0); PG8_BAR; PG8_MMA(1, 0, At, B0); PG8_MMA(1, 1, At, B1); PG8_BAR; PG8_SCHED;
            } else {
            PG8_LDB(B0, 0, 0); PG8_SCHED; PG8_LDA(At, 0, 0); PG8_STAGE(PG8_SA(1, 1), a1 + hstep, voffA);
            PG8_WAIT_L(8); PG8_BAR; PG8_WAIT_L(0); PG8_MMA(0, 0, At, B0); PG8_BAR; PG8_SCHED;
            PG8_LDB(B1, 0, 1); PG8_STAGE(PG8_SB(0, 0), b2, voffB);
            PG8_BAR; PG8_WAIT_L(0); PG8_MMA(0, 1, At, B1); PG8_BAR;
            PG8_LDA(At, 0, 1); PG8_STAGE(PG8_SA(0, 0), a2, voffA);
            PG8_BAR; PG8_WAIT_L(0); PG8_MMA(1, 0, At, B0); PG8_BAR; PG8_SCHED;
            PG8_STAGE(PG8_SB(0, 1), b2 + hstep, voffB);
            PG8_WAIT_V(6); PG8_BAR; PG8_MMA(1, 1, At, B1); PG8_BAR;
            PG8_LDB(B0, 1, 0); PG8_SCHED; PG8_LDA(At, 1, 0); PG8_STAGE(PG8_SA(0, 1), a2 + hstep, voffA);
            PG8_WAIT_L(8); PG8_BAR; PG8_WAIT_L(0); PG8_MMA(0, 0, At, B0); PG8_BAR; PG8_SCHED;
            PG8_LDB(B1, 1, 1); PG8_STAGE(PG8_SB(1, 0), b3, voffB);
            PG8_BAR; PG8_WAIT_L(0); PG8_MMA(0, 1, At, B1); PG8_BAR;
            PG8_LDA(At, 1, 1); PG8_STAGE(PG8_SA(1, 0), a3, voffA);
            PG8_BAR; PG8_WAIT_L(0); PG8_MMA(1, 0, At, B0); PG8_BAR; PG8_SCHED;
            PG8_STAGE(PG8_SB(1, 1), b3 + hstep, voffB);
            PG8_WAIT_V(6); PG8_BAR; PG8_MMA(1, 1, At, B1); PG8_BAR;
            }
        }
        if constexpr (ALIGN_EPI) { if (wr == 0) PG8_BAR; }
        if constexpr (!Epi::AFTER_DRAIN) { E(acc, cur, wr, wc, fr, fq); S.done(cur); }
        if (!has_next) break;
        if (!(Epi::CHAIN && cur.src == 0)) {
#pragma unroll
        for (int a = 0; a < 2; ++a)
#pragma unroll
            for (int b = 0; b < 2; ++b)
#pragma unroll
                for (int m = 0; m < 4; ++m)
#pragma unroll
                    for (int n = 0; n < 2; ++n) acc[a][b][m][n] = (f32x4){0.f, 0.f, 0.f, 0.f};
        }
        cur = nxt; cA = nA; cB = nB; ++ui;
        if constexpr (ALIGN_EPI) { if (wr == 1) PG8_BAR; }
    }
    PG8_WAIT_V(0);
    if constexpr (!ALIGN_EPI) { if (wr == 0) PG8_BAR; }
    PG8_BAR;
    if constexpr (Epi::AFTER_DRAIN) { E.fused(acc, cur, wr, wc, fr, fq, lds, wid, lane); S.done(cur); }
#undef PG8_SA
#undef PG8_SB
#undef PG8_STAGE
#undef PG8_LDA
#undef PG8_LDB
#undef PG8_MMA
#undef PG8_WAIT_V
#undef PG8_WAIT_L
#undef PG8_BAR
#undef PG8_SCHED
}
}

#define GAS __attribute__((address_space(1)))
#define LAS __attribute__((address_space(3)))
typedef unsigned short bf16;
typedef unsigned v4u __attribute__((ext_vector_type(4)));
typedef float f32x4 __attribute__((ext_vector_type(4)));
typedef short bf16x8 __attribute__((ext_vector_type(8)));
typedef GAS unsigned gu32;
typedef GAS unsigned long long gu64;
#define RLX_AGENT __ATOMIC_RELAXED, __HIP_MEMORY_SCOPE_AGENT
#define LDS_WAIT() asm volatile("s_waitcnt lgkmcnt(0)" ::: "memory")
#define VM_WAIT() asm volatile("s_waitcnt vmcnt(0)" ::: "memory")
__device__ __forceinline__ unsigned long long rt() { return __builtin_amdgcn_s_memrealtime(); }
__device__ __forceinline__ unsigned f2bf(float f) { unsigned u = __builtin_bit_cast(unsigned, f); return (u + 0x7fffu + ((u >> 16) & 1u)) >> 16; }
__device__ __forceinline__ unsigned pk2(float lo, float hi) { return f2bf(lo) | (f2bf(hi) << 16); }

__device__ __forceinline__ const void* karg(int i);
constexpr int CW_BAR_FWD = 4096;
#define XB_TMO      128
#define XB_XCNT(j)  (256  + 64 * (j))
#define XB_XSUB(j)  (1280 + 64 * (j))
#define XB_XGEN(j)  (2304 + 64 * (j))
#define XB_TOP      3328
#define XB_TOPGEN   3392
#define XCD_BAR_WORDS 3456
#define XB_SPIN_CAP (1u << 18)

__device__ __forceinline__ unsigned xb_ld(unsigned* p)              { return __hip_atomic_load(p, __ATOMIC_RELAXED, __HIP_MEMORY_SCOPE_AGENT); }
__device__ __forceinline__ unsigned xb_add(unsigned* p, unsigned v) { return __hip_atomic_fetch_add(p, v, __ATOMIC_RELAXED, __HIP_MEMORY_SCOPE_AGENT); }
__device__ __forceinline__ unsigned xb_xcc_id() { return (unsigned)__builtin_amdgcn_s_getreg((3 << 11) | 20) & 0xFu; }
#define XB_SPIN(cond, bar) do { unsigned _sp = 0; while (cond) { __builtin_amdgcn_s_sleep(1); \
    if ((++_sp & 255u) == 0u) { if (xb_ld(&(bar)[XB_TMO])) break; if (_sp > XB_SPIN_CAP) { atomicAdd(&(bar)[XB_TMO], 1u); break; } } } } while (0)

struct XcdBarrier {
    int wave;
    unsigned* bar; unsigned x;
    volatile LAS unsigned* st;
};

__device__ __forceinline__ XcdBarrier xcd_barrier_post(unsigned* bar, volatile LAS unsigned* st, int wave) {
    XcdBarrier b; b.wave = wave; b.bar = bar; b.x = xb_xcc_id(); b.st = st;
    if (wave == 0 && lane_fresh() == 0) (void)xb_add(&bar[XB_XCNT(b.x)], 1u);
    return b;
}
__device__ __forceinline__ void xcd_barrier_complete(unsigned* bar, unsigned x, unsigned& nloc, unsigned& nx) {
    const unsigned G = gridDim.x * gridDim.y * gridDim.z;
    unsigned sum, cnt, mine, sp = 0u;
    for (;;) {
        sum = 0u; cnt = 0u; mine = 0u;
#pragma unroll
        for (unsigned j = 0; j < 16; ++j) { const unsigned c = xb_ld(&bar[XB_XCNT(j)]); sum += c; cnt += (c > 0u) ? 1u : 0u; mine = (j == x) ? c : mine; }
        if (sum == G) break;
        __builtin_amdgcn_s_sleep(1);
        if ((++sp & 255u) == 0u) { if (xb_ld(&bar[XB_TMO])) break; if (sp > XB_SPIN_CAP) { atomicAdd(&bar[XB_TMO], 1u); break; } }
    }
    nloc = mine > 0u ? mine : 1u; nx = cnt > 0u ? cnt : 1u;
}

__device__ __forceinline__ void xcd_barrier(const XcdBarrier& b) {
    asm volatile("s_waitcnt vmcnt(0)" ::: "memory");
    __syncthreads();
    if (b.wave == 0 && lane_fresh() == 0) {
        unsigned* bar = (unsigned*)((gu32*)((unsigned char*)karg(19)) + CW_BAR_FWD);
        __builtin_amdgcn_s_waitcnt(0);
        unsigned nloc = b.st[0], nx = b.st[1];
        if (nloc == 0u) { xcd_barrier_complete(bar, b.x, nloc, nx); b.st[0] = nloc; b.st[1] = nx; }
        const unsigned old = xb_add(&bar[XB_XSUB(b.x)], 1u);
        const unsigned gen = old / nloc;
        if (old + 1u == (gen + 1u) * nloc) {
            __builtin_amdgcn_fence(__ATOMIC_RELEASE, "agent");
            asm volatile("s_waitcnt vmcnt(0)" ::: "memory");
            const unsigned og = xb_add(&bar[XB_TOP], 1u);
            const unsigned tg = og / nx;
            if (og + 1u == (tg + 1u) * nx) xb_add(&bar[XB_TOPGEN], 1u);
            else XB_SPIN(xb_ld(&bar[XB_TOPGEN]) == tg, bar);
            __builtin_amdgcn_fence(__ATOMIC_ACQUIRE, "agent");
            xb_add(&bar[XB_XGEN(b.x)], 1u);
            asm volatile("s_waitcnt vmcnt(0)" ::: "memory");
        } else {
            XB_SPIN(xb_ld(&bar[XB_XGEN(b.x)]) == gen, bar);
            __builtin_amdgcn_fence(__ATOMIC_ACQUIRE, "agent");
            asm volatile("s_waitcnt vmcnt(0)" ::: "memory");
        }
    }
    __syncthreads();
}

constexpr int NWAVES = 8, NTHR = 512;
constexpr int BATCH = 4, SEQ = 4096, D = 1024, M = BATCH * SEQ;
constexpr int NPROJ = 4352, LDW_IN = 4360, NMOD = 6144;
constexpr int C_QA = 0, C_KA = 512, C_VA = 640, C_QB = 768, C_KB = 1280, C_VB = 1792, C_GLA = 2304, C_GLB = 3328;
constexpr int NEXP = 16384;
constexpr float EPS = 1e-6f;

constexpr size_t MiB = 1u << 20;
constexpr size_t WS_CTL = 0, CTL_ZERO_BYTES = 1 * MiB;
constexpr size_t WS_MOD = 1 * MiB, WS_LOGF = 1 * MiB + 128 * 1024, WS_SUBK = 2 * MiB;
constexpr size_t WS_WIN = 4 * MiB, WS_WA = 12 * MiB + 512 * 1024, WS_WB = 13 * MiB + 512 * 1024, WS_WOUT = 14 * MiB + 512 * 1024, WS_WQ = 16 * MiB + 512 * 1024;
constexpr size_t WS_ED = 19 * MiB, WS_EU = 35 * MiB;
constexpr size_t WS_EDS = 2 * MiB + 512 * 1024;
constexpr size_t WS_H2Q = 95 * MiB, WS_H2S = 111 * MiB;
constexpr size_t WS_H = 83 * MiB, WS_OA = 83 * MiB, WS_OB = 99 * MiB, WS_PIDX = 83 * MiB, WS_PG = 87 * MiB;
constexpr size_t WS_PROJ = 115 * MiB, WS_X1 = 115 * MiB, WS_H2 = 179 * MiB, WS_QP = 211 * MiB;
constexpr size_t WS_END = 251 * MiB;
static_assert(WS_WIN + (size_t)NPROJ * D * 2 <= WS_WA && WS_WQ + (size_t)D * D * 2 <= WS_ED && WS_PROJ + (size_t)M * NPROJ * 2 <= WS_END, "ws map");
constexpr int CW_BAR = 4096; static_assert(CW_BAR == CW_BAR_FWD && WS_CTL == 0, "barrier words");

constexpr int RING_OFF = 0, RING_BYTES = 131072;
constexpr int LDSCTL_OFF = RING_BYTES, MISC_OFF = LDSCTL_OFF + 320;
constexpr int LDS_BYTES = 147456;

typedef float f32x16 __attribute__((ext_vector_type(16)));
typedef short s16x4 __attribute__((ext_vector_type(4)));
typedef unsigned u32x2 __attribute__((ext_vector_type(2)));
typedef float f32x2_t __attribute__((ext_vector_type(2)));
typedef __bf16 bf16x2_t __attribute__((ext_vector_type(2)));

__device__ __forceinline__ unsigned cvtpk(float lo, float hi) { f32x2_t v = {lo, hi}; bf16x2_t b = __builtin_convertvector(v, bf16x2_t); return __builtin_bit_cast(unsigned, b); }
__device__ __forceinline__ float bflo(unsigned u) { return __uint_as_float(u << 16); }
__device__ __forceinline__ float bfhi(unsigned u) { return __uint_as_float(u & 0xffff0000u); }
template <int S> __device__ __forceinline__ unsigned xorx(unsigned v, int lane) {
    if constexpr (S == 1) return (unsigned)__builtin_amdgcn_update_dpp(0, (int)v, 0xB1, 0xF, 0xF, true);
    else if constexpr (S == 2) return (unsigned)__builtin_amdgcn_update_dpp(0, (int)v, 0x4E, 0xF, 0xF, true);
    else if constexpr (S == 4) { const unsigned a = (unsigned)__builtin_amdgcn_update_dpp(0, (int)v, 0x124, 0xF, 0xF, true), b = (unsigned)__builtin_amdgcn_update_dpp(0, (int)v, 0x12C, 0xF, 0xF, true); return (lane & 4) ? a : b; }
    else if constexpr (S == 8) return (unsigned)__builtin_amdgcn_update_dpp(0, (int)v, 0x128, 0xF, 0xF, true);
    else if constexpr (S == 16) { const auto r = __builtin_amdgcn_permlane16_swap(v, v, false, false); return (lane & 16) ? r[0] : r[1]; }
    else { const auto r = __builtin_amdgcn_permlane32_swap(v, v, false, false); return (lane & 32) ? r[0] : r[1]; }
}
__device__ __forceinline__ unsigned xorx_sw(unsigned v, int lane, int s) {
    switch (s) { case 1: return xorx<1>(v, lane); case 2: return xorx<2>(v, lane); case 4: return xorx<4>(v, lane); case 8: return xorx<8>(v, lane); case 16: return xorx<16>(v, lane); default: return xorx<32>(v, lane); }
}
__device__ __forceinline__ float wave_sum_x(float v, int lane) {
    v += __uint_as_float(xorx<1>(__float_as_uint(v), lane)); v += __uint_as_float(xorx<2>(__float_as_uint(v), lane)); v += __uint_as_float(xorx<4>(__float_as_uint(v), lane));
    v += __uint_as_float(xorx<8>(__float_as_uint(v), lane)); v += __uint_as_float(xorx<16>(__float_as_uint(v), lane)); v += __uint_as_float(xorx<32>(__float_as_uint(v), lane));
    return v;
}
__device__ __forceinline__ float dppf(float v, const int ctrl_sel) { return v; }
#define DPP_F(v, CTRL) __uint_as_float(__builtin_amdgcn_update_dpp(0, __float_as_uint(v), (CTRL), 0xF, 0xF, true))
__device__ __forceinline__ float reduce8_t(const float (&dd)[8], int lane) {
    float r4[4];
#pragma unroll
    for (int u = 0; u < 4; ++u) { const auto p = __builtin_amdgcn_permlane32_swap(__float_as_uint(dd[u]), __float_as_uint(dd[u + 4]), false, false); r4[u] = __uint_as_float(p[0]) + __uint_as_float(p[1]); }
    float r2[2];
#pragma unroll
    for (int u = 0; u < 2; ++u) { const auto p = __builtin_amdgcn_permlane16_swap(__float_as_uint(r4[u]), __float_as_uint(r4[u + 2]), false, false); r2[u] = __uint_as_float(p[0]) + __uint_as_float(p[1]); }
    const bool b3 = (lane & 8) != 0;
    const float keep = b3 ? r2[1] : r2[0], send = b3 ? r2[0] : r2[1];
    float r1 = keep + DPP_F(send, 0x128);
    r1 += DPP_F(r1, 0xB1);
    r1 += DPP_F(r1, 0x4E);
    r1 += DPP_F(r1, 0x141);
    return r1;
}
__device__ __forceinline__ int lane_id() { return (int)__builtin_amdgcn_mbcnt_hi(~0u, __builtin_amdgcn_mbcnt_lo(~0u, 0u)); }
__device__ __forceinline__ float wave_sum(float v) { return wave_sum_x(v, lane_id()); }
__device__ __forceinline__ float wave_max(float v) { const int lane = lane_id();
    v = fmaxf(v, __uint_as_float(xorx<1>(__float_as_uint(v), lane))); v = fmaxf(v, __uint_as_float(xorx<2>(__float_as_uint(v), lane))); v = fmaxf(v, __uint_as_float(xorx<4>(__float_as_uint(v), lane)));
    v = fmaxf(v, __uint_as_float(xorx<8>(__float_as_uint(v), lane))); v = fmaxf(v, __uint_as_float(xorx<16>(__float_as_uint(v), lane))); v = fmaxf(v, __uint_as_float(xorx<32>(__float_as_uint(v), lane)));
    return v; }
__device__ __forceinline__ int crow(int r, int hi) { return (r & 3) + 8 * (r >> 2) + 4 * hi; }
#define MFMA32(a, b, c) __builtin_amdgcn_mfma_f32_32x32x16_bf16((a), (b), (c), 0, 0, 0)

struct Frame {
    LAS unsigned char* lds;
    int tid, lane, wave, vcu, G;
};
__device__ __forceinline__ const void* karg(int i) {
    unsigned long z = 0; asm volatile("" : "+s"(z));
    const char* base = (const char*)__builtin_amdgcn_kernarg_segment_ptr();
    return *(const void* const*)(base + 8 * i + z);
}

__device__ __forceinline__ void p0_transpose_item(const float* W, int ld, int K, int ncols, bf16* WT, int row_off, LAS float* scr, int item, int lane) {
    const int nblk = ncols / 32, kb = item / nblk, nb = item % nblk, k0 = 64 * kb, n0 = 32 * nb;
#pragma unroll 8
    for (int i = 0; i < 32; ++i) { const int kk = 2 * i + (lane >> 5); scr[kk * 33 + (lane & 31)] = __builtin_nontemporal_load(W + (size_t)(k0 + kk) * ld + n0 + (lane & 31)); }
    LDS_WAIT(); asm volatile("" ::: "memory");
    const int c = lane & 7;
#pragma unroll
    for (int j = 0; j < 4; ++j) { const int n = (lane >> 3) + 8 * j; const LAS float* s = scr + (8 * c) * 33 + n;
        v4u o; o.x = pk2(s[0 * 33], s[1 * 33]); o.y = pk2(s[2 * 33], s[3 * 33]); o.z = pk2(s[4 * 33], s[5 * 33]); o.w = pk2(s[6 * 33], s[7 * 33]);
        *(GAS v4u*)(WT + (size_t)(row_off + n0 + n) * K + k0 + 8 * c) = o; }
    LDS_WAIT(); asm volatile("" ::: "memory");
}
__device__ __forceinline__ void p0_convert(const float* __restrict__ src, bf16* __restrict__ dst, long n_iters, int gw, int NGW, int lane) {
    for (long it0 = (long)gw * 4; it0 < n_iters; it0 += (long)NGW * 4) {
        f32x4 a[4][2];
#pragma unroll
        for (int u = 0; u < 4; ++u) { const long it = it0 + u; if (it < n_iters) { const float* p = src + it * 512 + lane * 4; a[u][0] = *(const f32x4*)p; a[u][1] = *(const f32x4*)(p + 256); } }
#pragma unroll
        for (int u = 0; u < 4; ++u) { const long it = it0 + u; if (it < n_iters) { bf16* q = dst + it * 512 + lane * 4;
            u32x2 w0, w1; w0.x = cvtpk(a[u][0].x, a[u][0].y); w0.y = cvtpk(a[u][0].z, a[u][0].w); w1.x = cvtpk(a[u][1].x, a[u][1].y); w1.y = cvtpk(a[u][1].z, a[u][1].w);
            *(u32x2*)q = w0; *(u32x2*)(q + 256) = w1; } }
    }
}

__device__ __forceinline__ void p0_quant_tables(Frame& F, int gw, int NGW) {
    const float* ed = ((const float*)karg(15)); const float* eu = ((const float*)karg(16));
    unsigned char* EDq = (unsigned char*)(((unsigned char*)karg(19)) + WS_ED); unsigned char* EUq = (unsigned char*)(((unsigned char*)karg(19)) + WS_EU); float* EDS = (float*)(((unsigned char*)karg(19)) + WS_EDS);
    const int lane = F.lane;
    for (int row0 = gw * 4; row0 < NEXP; row0 += NGW * 4) {
        f32x4 a[4][4], u[4][4];
#pragma unroll
        for (int q = 0; q < 4; ++q)
#pragma unroll
            for (int j = 0; j < 4; ++j) { a[q][j] = __builtin_nontemporal_load((const f32x4*)(ed + (size_t)(row0 + q) * D) + lane + 64 * j); u[q][j] = __builtin_nontemporal_load((const f32x4*)(eu + (size_t)(row0 + q) * D) + lane + 64 * j); }
#pragma unroll
        for (int q = 0; q < 4; ++q) {
            float am = 0.f;
#pragma unroll
            for (int j = 0; j < 4; ++j) am = fmaxf(fmaxf(am, fmaxf(fabsf(a[q][j].x), fabsf(a[q][j].y))), fmaxf(fabsf(a[q][j].z), fabsf(a[q][j].w)));
            am = wave_max(am);
            const float sc = am > 0.f ? am * (1.0f / 127.0f) : 1.0f, inv = 1.0f / sc;
            v4u qa, qu;
#pragma unroll
            for (int j = 0; j < 4; ++j) {
                const int b0 = (int)rintf(a[q][j].x * inv), b1 = (int)rintf(a[q][j].y * inv), b2 = (int)rintf(a[q][j].z * inv), b3 = (int)rintf(a[q][j].w * inv);
                qa[j] = (unsigned)(b0 & 255) | ((unsigned)(b1 & 255) << 8) | ((unsigned)(b2 & 255) << 16) | ((unsigned)(b3 & 255) << 24);
                int p = __builtin_amdgcn_cvt_pk_fp8_f32(u[q][j].x * 16.0f, u[q][j].y * 16.0f, 0, false);
                p = __builtin_amdgcn_cvt_pk_fp8_f32(u[q][j].z * 16.0f, u[q][j].w * 16.0f, p, true);
                qu[j] = (unsigned)p;
            }
            __builtin_nontemporal_store(qa, (v4u*)(EDq + (size_t)(row0 + q) * D + 16 * lane));
            __builtin_nontemporal_store(qu, (v4u*)(EUq + (size_t)(row0 + q) * D + 16 * lane));
            if (lane == 0) EDS[row0 + q] = sc;
        }
    }
}
__device__ __forceinline__ void p0_prologue(Frame& F) {
    const float* c = ((const float*)karg(1)); const float* w_ada = ((const float*)karg(4)); const float* b_ada = ((const float*)karg(5));
    float* MOD = (float*)(((unsigned char*)karg(19)) + WS_MOD);
    {
        LAS float* cact = (LAS float*)(F.lds);
        LAS float* part = (LAS float*)(F.lds + 16384);
        bool did = false;
        for (int item = F.vcu; item < NMOD / 32; item += F.G) {
            if (!did) { for (int i = F.tid; i < 4096; i += NTHR) { const float cv = c[i]; cact[i] = cv / (1.0f + __expf(-cv)); } did = true; }
            __syncthreads();
            const int n0 = item * 32, col = n0 + (F.lane & 31), ksub = F.lane >> 5;
            float a0 = 0.f, a1 = 0.f, a2 = 0.f, a3 = 0.f;
#pragma unroll 16
            for (int it = 0; it < 64; ++it) { const int k = (it * 8 + F.wave) * 2 + ksub; const float w = __builtin_nontemporal_load(w_ada + (size_t)k * NMOD + col);
                a0 += cact[k] * w; a1 += cact[1024 + k] * w; a2 += cact[2048 + k] * w; a3 += cact[3072 + k] * w; }
            a0 += __shfl_xor(a0, 32); a1 += __shfl_xor(a1, 32); a2 += __shfl_xor(a2, 32); a3 += __shfl_xor(a3, 32);
            if (F.lane < 32) { part[(F.wave * 4 + 0) * 32 + F.lane] = a0; part[(F.wave * 4 + 1) * 32 + F.lane] = a1; part[(F.wave * 4 + 2) * 32 + F.lane] = a2; part[(F.wave * 4 + 3) * 32 + F.lane] = a3; }
            __syncthreads();
            if (F.tid < 128) { const int b = F.tid >> 5, cl = F.tid & 31; float s = 0.f;
#pragma unroll
                for (int w = 0; w < 8; ++w) s += part[(w * 4 + b) * 32 + cl];
                MOD[b * NMOD + n0 + cl] = s + b_ada[n0 + cl]; }
            __syncthreads();
        }
    }
    {
        const int gw = F.vcu * NWAVES + F.wave, NGW = F.G * NWAVES;
        p0_convert(((const float*)karg(14)), (bf16*)(((unsigned char*)karg(19)) + WS_SUBK), (long)(8 * 2 * 128 * 64) / 512, gw, NGW, F.lane);
    }
}
__device__ __forceinline__ void p0_transposes(Frame& F) {
    LAS float* scr = (LAS float*)(F.lds + 32768 + F.wave * 8704);
    const int gw = F.vcu * NWAVES + F.wave, NGW = F.G * NWAVES;
    constexpr int I_IN1 = (D / 64) * (2304 / 32), I_IN2 = (D / 64) * (2048 / 32), I_AB = (512 / 64) * (D / 32), I_SQ = (D / 64) * (D / 32);
    constexpr int NITEMS = I_IN1 + I_IN2 + 2 * I_AB + 2 * I_SQ;
    bf16* Win_t = (bf16*)(((unsigned char*)karg(19)) + WS_WIN);
    for (int it = gw; it < NITEMS; it += NGW) {
        int r = it;
        if (r < I_IN1) { p0_transpose_item(((const float*)karg(6)), LDW_IN, D, 2304, Win_t, 0, scr, r, F.lane); continue; } r -= I_IN1;
        if (r < I_IN2) { p0_transpose_item(((const float*)karg(6)) + 2312, LDW_IN, D, 2048, Win_t, 2304, scr, r, F.lane); continue; } r -= I_IN2;
        if (r < I_AB) { p0_transpose_item(((const float*)karg(9)), D, 512, D, (bf16*)(((unsigned char*)karg(19)) + WS_WA), 0, scr, r, F.lane); continue; } r -= I_AB;
        if (r < I_AB) { p0_transpose_item(((const float*)karg(10)), D, 512, D, (bf16*)(((unsigned char*)karg(19)) + WS_WB), 0, scr, r, F.lane); continue; } r -= I_AB;
        if (r < I_SQ) { p0_transpose_item(((const float*)karg(11)), D, D, D, (bf16*)(((unsigned char*)karg(19)) + WS_WOUT), 0, scr, r, F.lane); continue; } r -= I_SQ;
        p0_transpose_item(((const float*)karg(13)), D, D, D, (bf16*)(((unsigned char*)karg(19)) + WS_WQ), 0, scr, r, F.lane);
    }
}

__device__ __forceinline__ void p1_norm(Frame& F) {
    const float* x = ((const float*)karg(0)); const float* g1 = ((const float*)karg(2)); const float* w_in = ((const float*)karg(6)); const float* b_forget = ((const float*)karg(7));
    const float* MOD = (const float*)(((unsigned char*)karg(19)) + WS_MOD); bf16* H = (bf16*)(((unsigned char*)karg(19)) + WS_H); float* LOGF = (float*)(((unsigned char*)karg(19)) + WS_LOGF);
    LAS float* wfl = (LAS float*)(F.lds);
    { float tmp[16];
#pragma unroll
      for (int n = 0; n < 16; ++n) { const int i = F.tid + n * NTHR; tmp[n] = w_in[(size_t)(i >> 3) * LDW_IN + 2304 + (i & 7)]; }
#pragma unroll
      for (int n = 0; n < 16; ++n) { const int i = F.tid + n * NTHR; wfl[(i & 7) * 1024 + (i >> 3)] = tmp[n]; } }
    __syncthreads();
    const int gw = F.vcu * NWAVES + F.wave, NGW = F.G * NWAVES;
    for (int c = gw; c < M / 8; c += NGW) {
        const int row0 = c * 8; const float* mb = MOD + (row0 >> 12) * NMOD;
        f32x4 ga[4], sh[4];
#pragma unroll
        for (int j = 0; j < 4; ++j) { const int col = 4 * F.lane + 256 * j; const f32x4 g = *(const f32x4*)(g1 + col), sc = *(const f32x4*)(mb + 1024 + col); sh[j] = *(const f32x4*)(mb + col); ga[j] = g * (sc + 1.0f); }
        f32x4 r0[4], r1[4], r2[4];
        { const f32x4* xr = (const f32x4*)(x + (size_t)row0 * D) + F.lane;
#pragma unroll
          for (int j = 0; j < 4; ++j) r0[j] = __builtin_nontemporal_load(xr + 64 * j);
#pragma unroll
          for (int j = 0; j < 4; ++j) r1[j] = __builtin_nontemporal_load(xr + 256 + 64 * j); }
#pragma unroll
        for (int i = 0; i < 8; ++i) {
            const int row = row0 + i;
            if (i + 2 < 8) { const f32x4* xr = (const f32x4*)(x + (size_t)(row + 2) * D) + F.lane;
#pragma unroll
                for (int j = 0; j < 4; ++j) r2[j] = __builtin_nontemporal_load(xr + 64 * j); }
            float ss = 0.f;
#pragma unroll
            for (int j = 0; j < 4; ++j) ss += (r0[j].x * r0[j].x + r0[j].y * r0[j].y) + (r0[j].z * r0[j].z + r0[j].w * r0[j].w);
            ss = wave_sum(ss);
            const float rstd = 1.0f / sqrtf(ss * (1.0f / D) + EPS);
            float fl[8];
#pragma unroll
            for (int jj = 0; jj < 8; ++jj) fl[jj] = 0.f;
#pragma unroll
            for (int j = 0; j < 4; ++j) { const int col = 4 * F.lane + 256 * j;
                const f32x4 hv = (r0[j] * rstd) * ga[j] + sh[j];
                u32x2 w; w.x = cvtpk(hv.x, hv.y); w.y = cvtpk(hv.z, hv.w);
                __hip_atomic_store((unsigned long long*)(H + (size_t)row * D + col), __builtin_bit_cast(unsigned long long, w), __ATOMIC_RELAXED, __HIP_MEMORY_SCOPE_AGENT);
#pragma unroll
                for (int jj = 0; jj < 8; ++jj) { const f32x4 wv = *(const LAS f32x4*)(wfl + jj * 1024 + col); fl[jj] += (hv.x * wv.x + hv.y * wv.y) + (hv.z * wv.z + hv.w * wv.w); }
            }
            const int lane = F.lane; const float r1s = reduce8_t(fl, lane);
            if ((lane & 7) == 0) { const int jj = lane >> 3; const float z = r1s + b_forget[jj]; const float ls = fminf(z, 0.f) - log1pf(__expf(-fabsf(z))); LOGF[(size_t)row * 8 + jj] = ls; }
#pragma unroll
            for (int j = 0; j < 4; ++j) { r0[j] = r1[j]; r1[j] = r2[j]; }
        }
    }
}

constexpr int KP = 72;
constexpr int VPF = 68;
constexpr int VPS = 260;
constexpr float LOG2E = 1.4426950408889634f;
struct FlashState { f32x16 o[2]; float m, l; };

__device__ __forceinline__ void flash_tail(FlashState& st, f32x16& s0, f32x16& s1, const LAS bf16* Vs, int vp, int r32, int hi) {
    float mt = s0[0];
#pragma unroll
    for (int r = 1; r < 16; ++r) mt = fmaxf(mt, s0[r]);
#pragma unroll
    for (int r = 0; r < 16; ++r) mt = fmaxf(mt, s1[r]);
    mt = fmaxf(mt, __uint_as_float(xorx<32>(__float_as_uint(mt), 32 * hi)));
    const float mn = fmaxf(st.m, mt);
    const float alpha = __builtin_amdgcn_exp2f(st.m - mn);
    st.m = mn;
    float ps = 0.f;
#pragma unroll
    for (int r = 0; r < 16; ++r) { s0[r] = __builtin_amdgcn_exp2f(s0[r] - mn); ps += s0[r]; }
#pragma unroll
    for (int r = 0; r < 16; ++r) { s1[r] = __builtin_amdgcn_exp2f(s1[r] - mn); ps += s1[r]; }
    st.l = st.l * alpha + ps;
    if (__any(alpha != 1.0f)) {
#pragma unroll
        for (int r = 0; r < 16; ++r) { st.o[0][r] *= alpha; st.o[1][r] *= alpha; }
    }
#pragma unroll
    for (int blk = 0; blk < 2; ++blk)
#pragma unroll
        for (int s = 0; s < 2; ++s) {
            v4u pw;
            if (blk == 0) { pw.x = cvtpk(s0[8 * s + 0], s0[8 * s + 1]); pw.y = cvtpk(s0[8 * s + 2], s0[8 * s + 3]); pw.z = cvtpk(s0[8 * s + 4], s0[8 * s + 5]); pw.w = cvtpk(s0[8 * s + 6], s0[8 * s + 7]); }
            else          { pw.x = cvtpk(s1[8 * s + 0], s1[8 * s + 1]); pw.y = cvtpk(s1[8 * s + 2], s1[8 * s + 3]); pw.z = cvtpk(s1[8 * s + 4], s1[8 * s + 5]); pw.w = cvtpk(s1[8 * s + 6], s1[8 * s + 7]); }
            const bf16x8 pf = __builtin_bit_cast(bf16x8, pw);
#pragma unroll
            for (int db = 0; db < 2; ++db) {
                const LAS bf16* vp0 = Vs + (32 * db + r32) * vp + 32 * blk + 16 * s + 4 * hi;
                const s16x4 lo = *(const LAS s16x4*)vp0, hh = *(const LAS s16x4*)(vp0 + 8);
                const bf16x8 vf = __builtin_shufflevector(lo, hh, 0, 1, 2, 3, 4, 5, 6, 7);
                st.o[db] = MFMA32(vf, pf, st.o[db]);
            }
        }
}
__device__ __forceinline__ void flash_qk(f32x16& s0, f32x16& s1, const bf16x8 (&qf)[4], const LAS bf16* Ks, int r32, int hi) {
    s0 = (f32x16){0.f}; s1 = (f32x16){0.f};
#pragma unroll
    for (int r = 0; r < 16; ++r) { s0[r] = 0.f; s1[r] = 0.f; }
#pragma unroll
    for (int ks = 0; ks < 4; ++ks) {
        const bf16x8 a0 = *(const LAS bf16x8*)(Ks + r32 * KP + 16 * ks + 8 * hi);
        const bf16x8 a1 = *(const LAS bf16x8*)(Ks + (32 + r32) * KP + 16 * ks + 8 * hi);
        s0 = MFMA32(a0, qf[ks], s0); s1 = MFMA32(a1, qf[ks], s1);
    }
}
__device__ __forceinline__ void flash_qk2(f32x16& a0, f32x16& a1, f32x16& b0, f32x16& b1, const bf16x8 (&qa)[4], const bf16x8 (&qb)[4], const LAS bf16* Ks, int r32, int hi) {
#pragma unroll
    for (int r = 0; r < 16; ++r) { a0[r] = 0.f; a1[r] = 0.f; b0[r] = 0.f; b1[r] = 0.f; }
#pragma unroll
    for (int ks = 0; ks < 4; ++ks) {
        const bf16x8 k0 = *(const LAS bf16x8*)(Ks + r32 * KP + 16 * ks + 8 * hi);
        const bf16x8 k1 = *(const LAS bf16x8*)(Ks + (32 + r32) * KP + 16 * ks + 8 * hi);
        a0 = MFMA32(k0, qa[ks], a0); b0 = MFMA32(k0, qb[ks], b0); a1 = MFMA32(k1, qa[ks], a1); b1 = MFMA32(k1, qb[ks], b1);
    }
}
__device__ __forceinline__ void flash_soft(FlashState& st, f32x16& s0, f32x16& s1, int hi) {
    float mt = s0[0];
#pragma unroll
    for (int r = 1; r < 16; ++r) mt = fmaxf(mt, s0[r]);
#pragma unroll
    for (int r = 0; r < 16; ++r) mt = fmaxf(mt, s1[r]);
    mt = fmaxf(mt, __uint_as_float(xorx<32>(__float_as_uint(mt), 32 * hi)));
    const float mn = fmaxf(st.m, mt);
    const float alpha = __builtin_amdgcn_exp2f(st.m - mn);
    st.m = mn;
    float ps = 0.f;
#pragma unroll
    for (int r = 0; r < 16; ++r) { s0[r] = __builtin_amdgcn_exp2f(s0[r] - mn); ps += s0[r]; }
#pragma unroll
    for (int r = 0; r < 16; ++r) { s1[r] = __builtin_amdgcn_exp2f(s1[r] - mn); ps += s1[r]; }
    st.l = st.l * alpha + ps;
    if (__any(alpha != 1.0f)) {
#pragma unroll
        for (int r = 0; r < 16; ++r) { st.o[0][r] *= alpha; st.o[1][r] *= alpha; }
    }
}
__device__ __forceinline__ bf16x8 pack_p(const f32x16& p, int s) {
    v4u pw; pw.x = cvtpk(p[8 * s + 0], p[8 * s + 1]); pw.y = cvtpk(p[8 * s + 2], p[8 * s + 3]); pw.z = cvtpk(p[8 * s + 4], p[8 * s + 5]); pw.w = cvtpk(p[8 * s + 6], p[8 * s + 7]);
    return __builtin_bit_cast(bf16x8, pw);
}
__device__ __forceinline__ void flash_pv2(FlashState& sa, FlashState& sb, const f32x16& a0, const f32x16& a1, const f32x16& b0, const f32x16& b1, const LAS bf16* Vs, int vp, int r32, int hi) {
#pragma unroll
    for (int blk = 0; blk < 2; ++blk)
#pragma unroll
        for (int s = 0; s < 2; ++s) {
            const bf16x8 pfa = blk ? pack_p(a1, s) : pack_p(a0, s), pfb = blk ? pack_p(b1, s) : pack_p(b0, s);
#pragma unroll
            for (int db = 0; db < 2; ++db) {
                const LAS bf16* vp0 = Vs + (32 * db + r32) * vp + 32 * blk + 16 * s + 4 * hi;
                const s16x4 lo = *(const LAS s16x4*)vp0, hh = *(const LAS s16x4*)(vp0 + 8);
                const bf16x8 vf = __builtin_shufflevector(lo, hh, 0, 1, 2, 3, 4, 5, 6, 7);
                sa.o[db] = MFMA32(vf, pfa, sa.o[db]); sb.o[db] = MFMA32(vf, pfb, sb.o[db]);
            }
        }
}
__device__ __forceinline__ void flash_store(const FlashState& st, bf16* orow, int hi) {
    float lt = st.l + __uint_as_float(xorx<32>(__float_as_uint(st.l), 32 * hi));
    const float inv = 1.0f / lt;
#pragma unroll
    for (int db = 0; db < 2; ++db)
#pragma unroll
        for (int rg = 0; rg < 4; ++rg) { u32x2 w; w.x = cvtpk(st.o[db][4 * rg] * inv, st.o[db][4 * rg + 1] * inv); w.y = cvtpk(st.o[db][4 * rg + 2] * inv, st.o[db][4 * rg + 3] * inv);
            *(u32x2*)(orow + 32 * db + 8 * rg + 4 * hi) = w; }
}

__device__ __forceinline__ void fox_unit(Frame& F, int b, int h, int qb, float& kmax2) {
    const bf16* proj = (const bf16*)(((unsigned char*)karg(19)) + WS_PROJ); const float* LOGF = (const float*)(((unsigned char*)karg(19)) + WS_LOGF); bf16* OB = (bf16*)(((unsigned char*)karg(19)) + WS_OB);
    LAS float* Fs = (LAS float*)(F.lds);
    LAS float* wtot = (LAS float*)(F.lds + 16384);
    LAS bf16* Kb = (LAS bf16*)(F.lds + 16384 + 128);
    LAS bf16* Vb = (LAS bf16*)(F.lds + 16384 + 128 + 2 * 64 * KP * 2);
    const int lane = F.lane, wave = F.wave, tid = F.tid, r32 = lane & 31, hi = lane >> 5;
    const int q_end = 512 * (qb + 1), NT = q_end / 64;
    const size_t rowbase = (size_t)b * SEQ;
    if (kmax2 < 0.f) {
        float v[8]; float run = 0.f;
#pragma unroll
        for (int i = 0; i < 8; ++i) { const int pos = tid * 8 + i; const float lf = (pos < q_end) ? LOGF[(rowbase + pos) * 8 + h] : 0.f; run += lf; v[i] = run; }
        float inc = run;
#pragma unroll
        for (int o = 1; o < 64; o <<= 1) { const float t = __shfl_up(inc, o); if (lane >= o) inc += t; }
        if (lane == 63) wtot[wave] = inc;
        __syncthreads();
        float off = inc - run;
        for (int w = 0; w < wave; ++w) off += wtot[w];
#pragma unroll
        for (int i = 0; i < 8; ++i) Fs[tid * 8 + i] = -LOG2E * (v[i] + off);
    }
    const int qrow = 512 * qb + 64 * wave + r32, qrowB = qrow + 32;
    bf16x8 qf[4], qg[4];
    { const bf16* qp = proj + (rowbase + qrow) * NPROJ + C_QB + 64 * h + 8 * hi;
#pragma unroll
      for (int ks = 0; ks < 4; ++ks) { qf[ks] = *(const bf16x8*)(qp + 16 * ks); qg[ks] = *(const bf16x8*)(qp + (size_t)32 * NPROJ + 16 * ks); } }
    const int tq = 8 * qb + wave;
    LAS bf16* Qs = (LAS bf16*)(F.lds + 53248) + wave * (64 * KP);
    {
        float qn = 0.f;
#pragma unroll
        for (int ks = 0; ks < 4; ++ks)
#pragma unroll
            for (int j = 0; j < 8; ++j) { const float e = __uint_as_float(((unsigned)(unsigned short)qf[ks][j]) << 16); qn += e * e; }
        qn += __shfl_xor(qn, 32);
        { float qn2 = 0.f;
#pragma unroll
          for (int ks = 0; ks < 4; ++ks)
#pragma unroll
              for (int j = 0; j < 8; ++j) { const float e = __uint_as_float(((unsigned)(unsigned short)qg[ks][j]) << 16); qn2 += e * e; }
          qn2 += __shfl_xor(qn2, 32); qn = fmaxf(qn, qn2); }
#pragma unroll
        for (int o = 1; o < 32; o <<= 1) qn = fmaxf(qn, __shfl_xor(qn, o));
        float kn = 0.f;
        if (kmax2 < 0.f) {
            for (int p0 = 0; p0 < q_end; p0 += 4 * 64) {
                v4u w4[4];
#pragma unroll
                for (int i = 0; i < 4; ++i) w4[i] = *(const v4u*)(proj + (rowbase + p0 + 64 * i + (tid >> 3)) * NPROJ + C_KB + 64 * h + 8 * (tid & 7));
#pragma unroll
                for (int i = 0; i < 4; ++i) { const unsigned wx = w4[i].x, wy = w4[i].y, wz = w4[i].z, ww = w4[i].w;
                    float s = bflo(wx) * bflo(wx) + bfhi(wx) * bfhi(wx) + bflo(wy) * bflo(wy) + bfhi(wy) * bfhi(wy) + bflo(wz) * bflo(wz) + bfhi(wz) * bfhi(wz) + bflo(ww) * bflo(ww) + bfhi(ww) * bfhi(ww);
                    s += __shfl_xor(s, 1); s += __shfl_xor(s, 2); s += __shfl_xor(s, 4);
                    kn = fmaxf(kn, s); } }
            kn = wave_max(kn);
        }
        if (lane == 0) { wtot[8 + wave] = qn; wtot[16 + wave] = kn; }
    }
#pragma unroll
    for (int ks = 0; ks < 4; ++ks) { *(LAS bf16x8*)(Qs + r32 * KP + 16 * ks + 8 * hi) = qf[ks]; *(LAS bf16x8*)(Qs + (32 + r32) * KP + 16 * ks + 8 * hi) = qg[ks]; }
    FlashState st, su; st.m = -INFINITY; st.l = 0.f; su.m = -INFINITY; su.l = 0.f;
#pragma unroll
    for (int r = 0; r < 16; ++r) { st.o[0][r] = 0.f; st.o[1][r] = 0.f; su.o[0][r] = 0.f; su.o[1][r] = 0.f; }
    const int srow = tid >> 3, sch = tid & 7;
    const bf16* kg = proj + (rowbase + srow) * NPROJ + C_KB + 64 * h + 8 * sch;
    const bf16* vg = proj + (rowbase + srow) * NPROJ + C_VB + 64 * h + 8 * sch;
    v4u kreg, vreg;
    { const size_t o = (size_t)(NT - 1) * 64 * NPROJ; kreg = *(const v4u*)(kg + o); vreg = *(const v4u*)(vg + o); }
    int cur = 0;
    {   *(LAS v4u*)(Kb + srow * KP + 8 * sch) = kreg;
        const unsigned short* vs = (const unsigned short*)&vreg;
#pragma unroll
        for (int i = 0; i < 8; ++i) Vb[(8 * sch + i) * VPF + srow] = vs[i];
    }
    LAS int* wdslot = (LAS int*)(wtot + 24);
    if (tid < 8) wdslot[tid] = -1;
    __syncthreads();
    int t_lo = 0;
    {
        float qm = 0.f, km = 0.f;
#pragma unroll
        for (int w = 0; w < 8; ++w) { qm = fmaxf(qm, wtot[8 + w]); km = fmaxf(km, wtot[16 + w]); }
        if (kmax2 < 0.f) kmax2 = km;
        const float A = 0.125f * sqrtf(qm) * sqrtf(kmax2) * 1.01f, f0 = Fs[512 * qb];
        for (int t = NT - 9; t >= 0; --t) if (f0 - Fs[64 * t + 63] > (2.0f * A + 30.0f) * LOG2E) { t_lo = t + 1; break; }
    }
    const float A2w = 0.125f * sqrtf(wtot[8 + wave]) * sqrtf(kmax2) * 1.01f * LOG2E;
    bool wfin = false;
    for (int t = NT - 1; t >= t_lo; --t) {
        if (t > t_lo) { const size_t o = (size_t)(t - 1) * 64 * NPROJ; kreg = *(const v4u*)(kg + o); vreg = *(const v4u*)(vg + o); }
        if (!wfin && t < tq) { const float bound = A2w + Fs[64 * t + 63];
            if (__all(bound < fminf(st.m, su.m) - 30.0f * LOG2E)) { wfin = true; if (lane == 0) wdslot[wave] = t; } }
        if (t <= tq && !wfin) {
            const LAS bf16* Ks = Kb + cur * 64 * KP; const LAS bf16* Vs = Vb + cur * 64 * VPF;
            bf16x8 qa[4], qb4[4];
#pragma unroll
            for (int ks = 0; ks < 4; ++ks) { qa[ks] = *(const LAS bf16x8*)(Qs + r32 * KP + 16 * ks + 8 * hi); qb4[ks] = *(const LAS bf16x8*)(Qs + (32 + r32) * KP + 16 * ks + 8 * hi); }
            f32x16 s0, s1, u0, u1; flash_qk2(s0, s1, u0, u1, qa, qb4, Ks, r32, hi);
            const LAS float* Fk = Fs + 64 * t;
            constexpr float C = 0.125f * LOG2E;
#pragma unroll
            for (int rg = 0; rg < 4; ++rg) {
                const f32x4 f0 = *(const LAS f32x4*)(Fk + 8 * rg + 4 * hi), f1 = *(const LAS f32x4*)(Fk + 32 + 8 * rg + 4 * hi);
#pragma unroll
                for (int i = 0; i < 4; ++i) { const int r = 4 * rg + i;
                    s0[r] = fmaf(s0[r], C, f0[i]); s1[r] = fmaf(s1[r], C, f1[i]); u0[r] = fmaf(u0[r], C, f0[i]); u1[r] = fmaf(u1[r], C, f1[i]); }
            }
            if (t == tq) {
#pragma unroll
                for (int r = 0; r < 16; ++r) { const int kv = 64 * t + crow(r, hi);
                    s0[r] = (kv > qrow) ? -INFINITY : s0[r]; s1[r] = (kv + 32 > qrow) ? -INFINITY : s1[r];
                    u0[r] = (kv > qrowB) ? -INFINITY : u0[r]; u1[r] = (kv + 32 > qrowB) ? -INFINITY : u1[r]; }
            }
            flash_soft(st, s0, s1, hi); flash_soft(su, u0, u1, hi);
            flash_pv2(st, su, s0, s1, u0, u1, Vs, VPF, r32, hi);
        }
        if (t > t_lo) {
            const int nb = cur ^ 1;
            *(LAS v4u*)(Kb + nb * 64 * KP + srow * KP + 8 * sch) = kreg;
            const unsigned short* vs = (const unsigned short*)&vreg;
#pragma unroll
            for (int i = 0; i < 8; ++i) Vb[nb * 64 * VPF + (8 * sch + i) * VPF + srow] = vs[i];
        }
        __syncthreads();
        cur ^= 1;
        { int mn = wdslot[0];
#pragma unroll
          for (int w = 1; w < 8; ++w) mn = min(mn, wdslot[w]);
          if (mn >= t) break; }
    }
    flash_store(st, OB + (rowbase + qrow) * 512 + 64 * h, hi); flash_store(su, OB + (rowbase + qrowB) * 512 + 64 * h, hi);
    __syncthreads();
}

__device__ const unsigned char T5_BUCKET[128] = {0,1,2,3,4,5,6,7,8,9,10,11,12,13,14,15,16,16,16,17,17,18,18,18,19,19,19,20,20,20,20,21,21,21,21,22,22,22,22,22,23,23,23,23,23,23,24,24,24,24,24,24,25,25,25,25,25,25,25,26,26,26,26,26,26,26,26,27,27,27,27,27,27,27,27,27,27,28,28,28,28,28,28,28,28,28,28,29,29,29,29,29,29,29,29,29,29,29,29,30,30,30,30,30,30,30,30,30,30,30,30,30,30,31,31,31,31,31,31,31,31,31,31,31,31,31,31,31};

__device__ __forceinline__ void swa_unit(Frame& F, int b, int kvh, int n) {
    const bf16* proj = (const bf16*)(((unsigned char*)karg(19)) + WS_PROJ); bf16* OA = (bf16*)(((unsigned char*)karg(19)) + WS_OA);
    const float* sinks = ((const float*)karg(8)); const float* rel_bias = ((const float*)karg(12));
    LAS bf16* Kb = (LAS bf16*)(F.lds);
    LAS bf16* Vb = (LAS bf16*)(F.lds + 36864);
    LAS float* bt = (LAS float*)(F.lds + 36864 + 33280);
    const int lane = F.lane, wave = F.wave, tid = F.tid, r32 = lane & 31, hi = lane >> 5;
    const size_t rowbase = (size_t)b * SEQ;
    {
        const int g = tid >> 7, d = tid & 127;
        bt[tid] = LOG2E * rel_bias[(int)T5_BUCKET[d] * 8 + kvh * 4 + g];
#pragma unroll
        for (int i = 0; i < 4; ++i) {
            const int idx = tid + i * NTHR, kb = idx >> 3, sch = idx & 7; const int pos = 128 * (n - 1) + kb;
            v4u kreg = (v4u){0u, 0u, 0u, 0u}, vreg = (v4u){0u, 0u, 0u, 0u};
            if (pos >= 0) { const bf16* p = proj + (rowbase + pos) * NPROJ + 64 * kvh + 8 * sch; kreg = *(const v4u*)(p + C_KA); vreg = *(const v4u*)(p + C_VA); }
            *(LAS v4u*)(Kb + kb * KP + 8 * sch) = kreg;
            const unsigned short* vs = (const unsigned short*)&vreg;
#pragma unroll
            for (int j = 0; j < 8; ++j) Vb[(8 * sch + j) * VPS + kb] = vs[j];
        }
    }
    __syncthreads();
    const int g = wave & 3, qh = wave >> 2, head = kvh * 4 + g;
    const LAS float* btg = bt + g * 128;
    for (int sb = 0; sb < 2; ++sb) {
        const int qrel0 = 64 * qh + 32 * sb, qrel = qrel0 + r32;
        const size_t row = rowbase + 128 * n + qrel;
        bf16x8 qf[4];
        { const bf16* qp = proj + row * NPROJ + C_QA + 64 * head + 8 * hi;
#pragma unroll
          for (int ks = 0; ks < 4; ++ks) qf[ks] = *(const bf16x8*)(qp + 16 * ks); }
        FlashState st; st.m = LOG2E * sinks[head]; st.l = (hi == 0) ? 1.0f : 0.0f;
#pragma unroll
        for (int r = 0; r < 16; ++r) { st.o[0][r] = 0.f; st.o[1][r] = 0.f; }
        const int t_hi = (qrel0 + 159) >> 6; int t_lo = (qrel0 + 1) >> 6;
        if (n == 0 && t_lo < 2) t_lo = 2;
        for (int t = t_lo; t <= t_hi; ++t) {
            f32x16 s0, s1; flash_qk(s0, s1, qf, Kb + t * 64 * KP, r32, hi);
            const int X = 128 + qrel - 64 * t - 4 * hi;
#pragma unroll
            for (int rg = 0; rg < 4; ++rg) {
                const LAS float* bp = btg + (X - 8 * rg - 35);
#pragma unroll
                for (int i = 0; i < 4; ++i) { const int r = 4 * rg + i; const int d0 = X - 8 * rg - i;
                    const float b0 = bp[35 - i], b1 = bp[3 - i];
                    s0[r] = ((unsigned)d0 < 128u) ? fmaf(s0[r], 0.125f * LOG2E, b0) : -INFINITY;
                    s1[r] = ((unsigned)(d0 - 32) < 128u) ? fmaf(s1[r], 0.125f * LOG2E, b1) : -INFINITY; }
            }
            flash_tail(st, s0, s1, Vb + 64 * t, VPS, r32, hi);
        }
        flash_store(st, OA + row * 512 + 64 * head, hi);
    }
    __syncthreads();
}
__device__ __forceinline__ void p3_attention(Frame& F) {
    for (int item = F.vcu; item < 256; item += F.G) {
        swa_unit(F, item >> 6, (item >> 5) & 1, item & 31);
        F.lane = lane_fresh(); F.tid = F.wave * 64 + F.lane;
        const int bh = item >> 3, j = item & 7;
        float kmax2 = -1.0f;
        fox_unit(F, bh >> 3, bh & 7, j, kmax2);
    }
}

struct PairOrder {
    pg8::StaticOrder S;
    __device__ bool next(int i, pg8::Unit& u) const { if (!S.next(i >> 1, u)) return false; u.src = i & 1; return true; }
    __device__ __forceinline__ void a_ready(const pg8::Unit&) const {}
    __device__ __forceinline__ void done(const pg8::Unit&) const {}
};
__device__ __forceinline__ float sigmoidf_(float z) { return 1.0f / (1.0f + __expf(-z)); }
struct EpiGate {
    static constexpr bool PERM = true, AFTER_DRAIN = false, CHAIN = true;
    const bf16* proj; bf16* mixed;
    __device__ __forceinline__ void operator()(pg8::f32x4 (&acc)[2][2][4][2], const pg8::Unit& u, int wr, int wc, int fr, int fq) const {
#pragma unroll
        for (int ai = 0; ai < 2; ++ai) {
            v4u gbv[4][2], gav[4][2];
#pragma unroll
            for (int m = 0; m < 4; ++m) { const size_t row = (size_t)u.pm * 256 + ai * 128 + wr * 64 + m * 16 + fr;
#pragma unroll
                for (int bj = 0; bj < 2; ++bj) { const int col0 = u.pn * 256 + bj * 128 + wc * 32 + 8 * fq;
                    gbv[m][bj] = *(const v4u*)(proj + row * NPROJ + C_GLB + col0);
                    if (u.src == 0) gav[m][bj] = __builtin_nontemporal_load((const v4u*)(proj + row * NPROJ + C_GLA + col0)); } }
#pragma unroll
            for (int m = 0; m < 4; ++m) { const size_t row = (size_t)u.pm * 256 + ai * 128 + wr * 64 + m * 16 + fr;
#pragma unroll
                for (int bj = 0; bj < 2; ++bj) { const int col0 = u.pn * 256 + bj * 128 + wc * 32 + 8 * fq;
                    const unsigned gbw[4] = {gbv[m][bj].x, gbv[m][bj].y, gbv[m][bj].z, gbv[m][bj].w};
                    if (u.src == 0) {
                        const unsigned gaw[4] = {gav[m][bj].x, gav[m][bj].y, gav[m][bj].z, gav[m][bj].w};
#pragma unroll
                        for (int e = 0; e < 8; ++e) { const float za = (e & 1) ? bfhi(gaw[e >> 1]) : bflo(gaw[e >> 1]), zb = (e & 1) ? bfhi(gbw[e >> 1]) : bflo(gbw[e >> 1]);
                            const float ratio = (1.0f + __expf(-zb)) * __builtin_amdgcn_rcpf(1.0f + __expf(-za));
                            acc[ai][bj][m][e >> 2][e & 3] *= ratio; }
                    } else {
                        float v[8];
#pragma unroll
                        for (int e = 0; e < 8; ++e) { const float zb = (e & 1) ? bfhi(gbw[e >> 1]) : bflo(gbw[e >> 1]); v[e] = acc[ai][bj][m][e >> 2][e & 3] * __builtin_amdgcn_rcpf(1.0f + __expf(-zb)); }
                        v4u w; w.x = cvtpk(v[0], v[1]); w.y = cvtpk(v[2], v[3]); w.z = cvtpk(v[4], v[5]); w.w = cvtpk(v[6], v[7]);
                        *(v4u*)(mixed + row * D + col0) = w;
                    }
                }
            }
        }
    }
};
struct EpiRes {
    static constexpr bool PERM = true, AFTER_DRAIN = false, CHAIN = false;
    const float* x; const float* mod; bf16* x1;
    __device__ __forceinline__ void operator()(const pg8::f32x4 (&acc)[2][2][4][2], const pg8::Unit& u, int wr, int wc, int fr, int fq) const {
        const int b = (u.pm * 256) >> 12;
        pg8::f32x4 gt[2][2];
#pragma unroll
        for (int bj = 0; bj < 2; ++bj)
#pragma unroll
            for (int n = 0; n < 2; ++n) gt[bj][n] = *(const pg8::f32x4*)(mod + b * NMOD + 2048 + u.pn * 256 + bj * 128 + wc * 32 + 8 * fq + 4 * n);
#pragma unroll
        for (int ai = 0; ai < 2; ++ai) {
            pg8::f32x4 xin[4][2][2];
#pragma unroll
            for (int m = 0; m < 4; ++m) { const size_t row = (size_t)u.pm * 256 + ai * 128 + wr * 64 + m * 16 + fr;
#pragma unroll
                for (int bj = 0; bj < 2; ++bj)
#pragma unroll
                    for (int n = 0; n < 2; ++n) xin[m][bj][n] = __builtin_nontemporal_load((const pg8::f32x4*)(x + row * D + u.pn * 256 + bj * 128 + wc * 32 + 8 * fq + 4 * n)); }
#pragma unroll
            for (int m = 0; m < 4; ++m) { const size_t row = (size_t)u.pm * 256 + ai * 128 + wr * 64 + m * 16 + fr;
#pragma unroll
                for (int bj = 0; bj < 2; ++bj) { const pg8::f32x4 v0 = xin[m][bj][0] + gt[bj][0] * acc[ai][bj][m][0], v1 = xin[m][bj][1] + gt[bj][1] * acc[ai][bj][m][1];
                    v4u w; w.x = cvtpk(v0.x, v0.y); w.y = cvtpk(v0.z, v0.w); w.z = cvtpk(v1.x, v1.y); w.w = cvtpk(v1.z, v1.w);
                    *(v4u*)(x1 + row * D + u.pn * 256 + bj * 128 + wc * 32 + 8 * fq) = w; } }
        }
    }
};

__device__ __forceinline__ void p6_norm2(Frame& F) {
    const bf16* x1 = (const bf16*)(((unsigned char*)karg(19)) + WS_X1); const float* g2 = ((const float*)karg(3)); const float* MOD = (const float*)(((unsigned char*)karg(19)) + WS_MOD); bf16* H2 = (bf16*)(((unsigned char*)karg(19)) + WS_H2); unsigned char* H2Q = (unsigned char*)(((unsigned char*)karg(19)) + WS_H2Q); float* H2S = (float*)(((unsigned char*)karg(19)) + WS_H2S);
    const int gw = F.vcu * NWAVES + F.wave, NGW = F.G * NWAVES;
    for (int c = gw; c < M / 8; c += NGW) {
        const int row0 = c * 8; const float* mb = MOD + (row0 >> 12) * NMOD;
        f32x4 ga[4], sh[4];
#pragma unroll
        for (int j = 0; j < 4; ++j) { const int col = 4 * F.lane + 256 * j; const f32x4 g = *(const f32x4*)(g2 + col), sc = *(const f32x4*)(mb + 4096 + col); sh[j] = *(const f32x4*)(mb + 3072 + col); ga[j] = g * (sc + 1.0f); }
        u32x2 r0[4], r1[4], r2[4];
        { const u32x2* xr = (const u32x2*)(x1 + (size_t)row0 * D) + F.lane;
#pragma unroll
          for (int j = 0; j < 4; ++j) r0[j] = xr[64 * j];
#pragma unroll
          for (int j = 0; j < 4; ++j) r1[j] = xr[256 + 64 * j]; }
#pragma unroll
        for (int i = 0; i < 8; ++i) {
            const int row = row0 + i;
            if (i + 2 < 8) { const u32x2* xr = (const u32x2*)(x1 + (size_t)(row + 2) * D) + F.lane;
#pragma unroll
                for (int j = 0; j < 4; ++j) r2[j] = xr[64 * j]; }
            f32x4 hq[4], xv[4]; float ss = 0.f;
#pragma unroll
            for (int j = 0; j < 4; ++j) { xv[j].x = bflo(r0[j].x); xv[j].y = bfhi(r0[j].x); xv[j].z = bflo(r0[j].y); xv[j].w = bfhi(r0[j].y);
                ss += (xv[j].x * xv[j].x + xv[j].y * xv[j].y) + (xv[j].z * xv[j].z + xv[j].w * xv[j].w); }
            ss = wave_sum(ss);
            const float rstd = 1.0f / sqrtf(ss * (1.0f / D) + EPS);
#pragma unroll
            for (int j = 0; j < 4; ++j) { const int col = 4 * F.lane + 256 * j;
                const f32x4 hv = (xv[j] * rstd) * ga[j] + sh[j];
                u32x2 w; w.x = cvtpk(hv.x, hv.y); w.y = cvtpk(hv.z, hv.w);
                __hip_atomic_store((unsigned long long*)(H2 + (size_t)row * D + col), __builtin_bit_cast(unsigned long long, w), __ATOMIC_RELAXED, __HIP_MEMORY_SCOPE_AGENT); hq[j] = hv; }
            float am = 0.f;
#pragma unroll
            for (int j = 0; j < 4; ++j) am = fmaxf(fmaxf(am, fmaxf(fabsf(hq[j].x), fabsf(hq[j].y))), fmaxf(fabsf(hq[j].z), fabsf(hq[j].w)));
            am = wave_max(am);
            const float sc = am > 0.f ? am * (1.0f / 127.0f) : 1.0f, inv = 1.0f / sc;
            v4u qa;
#pragma unroll
            for (int j = 0; j < 4; ++j) { const int b0 = (int)rintf(hq[j].x * inv), b1 = (int)rintf(hq[j].y * inv), b2 = (int)rintf(hq[j].z * inv), b3 = (int)rintf(hq[j].w * inv);
                qa[j] = (unsigned)(b0 & 255) | ((unsigned)(b1 & 255) << 8) | ((unsigned)(b2 & 255) << 16) | ((unsigned)(b3 & 255) << 24); }
            __builtin_nontemporal_store(qa, (v4u*)(H2Q + (size_t)row * D + 16 * F.lane));
            if (F.lane == 0) H2S[row] = sc;
#pragma unroll
            for (int j = 0; j < 4; ++j) { r0[j] = r1[j]; r1[j] = r2[j]; }
        }
    }
}

__device__ __forceinline__ unsigned f2ord(float f) { const unsigned u = __float_as_uint(f); return u ^ ((unsigned)((int)u >> 31) | 0x80000000u); }
__device__ __forceinline__ float ord2f(unsigned o) { const unsigned u = (o & 0x80000000u) ? (o & 0x7fffffffu) : ~o; return __uint_as_float(u); }
#define CE_DESC(a, b) do { const unsigned _x = (a), _y = (b); (a) = _x > _y ? _x : _y; (b) = _x > _y ? _y : _x; } while (0)
__device__ __forceinline__ void sort16(unsigned (&k)[16]) {
    CE_DESC(k[0], k[13]); CE_DESC(k[1], k[12]); CE_DESC(k[2], k[15]); CE_DESC(k[3], k[14]); CE_DESC(k[4], k[8]); CE_DESC(k[5], k[6]); CE_DESC(k[7], k[11]); CE_DESC(k[9], k[10]);
    CE_DESC(k[0], k[5]); CE_DESC(k[1], k[7]); CE_DESC(k[2], k[9]); CE_DESC(k[3], k[4]); CE_DESC(k[6], k[13]); CE_DESC(k[8], k[14]); CE_DESC(k[10], k[15]); CE_DESC(k[11], k[12]);
    CE_DESC(k[0], k[1]); CE_DESC(k[2], k[3]); CE_DESC(k[4], k[5]); CE_DESC(k[6], k[8]); CE_DESC(k[7], k[9]); CE_DESC(k[10], k[11]); CE_DESC(k[12], k[13]); CE_DESC(k[14], k[15]);
    CE_DESC(k[0], k[2]); CE_DESC(k[1], k[3]); CE_DESC(k[4], k[10]); CE_DESC(k[5], k[11]); CE_DESC(k[6], k[7]); CE_DESC(k[8], k[9]); CE_DESC(k[12], k[14]); CE_DESC(k[13], k[15]);
    CE_DESC(k[1], k[2]); CE_DESC(k[3], k[12]); CE_DESC(k[4], k[6]); CE_DESC(k[5], k[7]); CE_DESC(k[8], k[10]); CE_DESC(k[9], k[11]); CE_DESC(k[13], k[14]);
    CE_DESC(k[1], k[4]); CE_DESC(k[2], k[6]); CE_DESC(k[5], k[8]); CE_DESC(k[7], k[10]); CE_DESC(k[9], k[13]); CE_DESC(k[11], k[14]);
    CE_DESC(k[2], k[4]); CE_DESC(k[3], k[6]); CE_DESC(k[9], k[12]); CE_DESC(k[11], k[13]);
    CE_DESC(k[3], k[5]); CE_DESC(k[6], k[8]); CE_DESC(k[7], k[9]); CE_DESC(k[10], k[12]);
    CE_DESC(k[3], k[4]); CE_DESC(k[5], k[6]); CE_DESC(k[7], k[8]); CE_DESC(k[9], k[10]); CE_DESC(k[11], k[12]);
    CE_DESC(k[6], k[7]); CE_DESC(k[8], k[9]);
}
__device__ __forceinline__ void merge16(unsigned (&a)[16], const unsigned (&b)[16]) {
#pragma unroll
    for (int i = 0; i < 16; ++i) a[i] = a[i] > b[15 - i] ? a[i] : b[15 - i];
#pragma unroll
    for (int stride = 8; stride > 0; stride >>= 1)
#pragma unroll
        for (int i = 0; i < 16; ++i) { const int j = i ^ stride; if (j > i) CE_DESC(a[i], a[j]); }
}
__device__ __forceinline__ void top16_of_64(unsigned (&g0)[16], unsigned (&g1)[16], unsigned (&g2)[16], unsigned (&g3)[16]) {
    sort16(g0); sort16(g1); sort16(g2); sort16(g3);
    merge16(g0, g1); merge16(g2, g3); merge16(g0, g2);
}
constexpr int NCAND = 50;
__device__ __forceinline__ void p8a_topk(Frame& F) {
    const bf16* QP = (const bf16*)(((unsigned char*)karg(19)) + WS_QP); const bf16* SUBK = (const bf16*)(((unsigned char*)karg(19)) + WS_SUBK);
    unsigned short* PIDX = (unsigned short*)(((unsigned char*)karg(19)) + WS_PIDX); float* PG = (float*)(((unsigned char*)karg(19)) + WS_PG);
    LAS unsigned short* Elds = (LAS unsigned short*)(F.lds) + F.wave * (NCAND * 64);
    const int lane = F.lane, r32 = lane & 31, hi = lane >> 5;
    const int gw = F.vcu * NWAVES + F.wave, NGW = F.G * NWAVES;
    for (int it2 = 0; it2 < 2 * ((M / 64 - F.vcu + F.G - 1) / F.G); ++it2) {
        const int wi = F.vcu + (it2 >> 1) * F.G;
        const int tile = 2 * wi + (it2 & 1);
        const int tok = tile * 32 + r32;
        { const int h = F.wave;
            unsigned top[2][16];
#pragma unroll
            for (int p = 0; p < 2; ++p) {
                bf16x8 qf[4];
                { const bf16* qp = QP + (size_t)tok * D + h * 128 + p * 64 + 8 * hi;
#pragma unroll
                  for (int ks = 0; ks < 4; ++ks) qf[ks] = *(const bf16x8*)(qp + 16 * ks); }
                const bf16* kp = SUBK + (size_t)((h * 2 + p) * 128 + r32) * 64 + 8 * hi;
                unsigned kk[4][16];
#pragma unroll
                for (int blk = 0; blk < 4; ++blk) {
                    f32x16 acc;
#pragma unroll
                    for (int r = 0; r < 16; ++r) acc[r] = 0.f;
#pragma unroll
                    for (int ks = 0; ks < 4; ++ks) { const bf16x8 a = *(const bf16x8*)(kp + (size_t)blk * 32 * 64 + 16 * ks); acc = MFMA32(a, qf[ks], acc); }
#pragma unroll
                    for (int r = 0; r < 16; ++r) { const int key = 32 * blk + crow(r, hi); kk[blk][r] = (f2ord(acc[r]) & ~127u) | (unsigned)(127 - key); }
                }
                top16_of_64(kk[0], kk[1], kk[2], kk[3]);
                unsigned other[16];
#pragma unroll
                for (int i = 0; i < 16; ++i) other[i] = xorx<32>(kk[0][i], lane);
                merge16(kk[0], other);
#pragma unroll
                for (int i = 0; i < 16; ++i) top[p][i] = kk[0][i];
            }
            float s1[16], s2[16]; unsigned i1[16], i2[16];
#pragma unroll
            for (int i = 0; i < 16; ++i) { s1[i] = ord2f(top[0][i] & ~127u); i1[i] = 127u - (top[0][i] & 127u); s2[i] = ord2f(top[1][i] & ~127u); i2[i] = 127u - (top[1][i] & 127u); }
            unsigned ck[2][16];
#pragma unroll
            for (int j = 0; j < 32; ++j) {
                if (2 * j < NCAND) { constexpr int CA[NCAND] = {0,0,0,0,0,0,0,0,0,0,0,0,0,0,0,0,1,1,1,1,1,1,1,1,2,2,2,2,2,3,3,3,3,4,4,4,5,5,6,6,7,7,8,9,10,11,12,13,14,15}; constexpr int CB[NCAND] = {0,1,2,3,4,5,6,7,8,9,10,11,12,13,14,15,0,1,2,3,4,5,6,7,0,1,2,3,4,0,1,2,3,0,1,2,0,1,0,1,0,1,0,0,0,0,0,0,0,0};
                    const int a0 = CA[2 * j], b0 = CB[2 * j], a1 = CA[2 * j + 1], b1 = CB[2 * j + 1];
                    const float sa = hi ? s1[a1] : s1[a0], sb = hi ? s2[b1] : s2[b0];
                    const unsigned ia = hi ? i1[a1] : i1[a0], ib = hi ? i2[b1] : i2[b0];
                    ck[j >> 4][j & 15] = (f2ord(sa + sb) & ~63u) | (unsigned)(63 - 2 * j - hi);
                    Elds[(2 * j + hi) * 64 + lane] = (unsigned short)(ia * 128u + ib); }
                else ck[j >> 4][j & 15] = 0u;
            }
            sort16(ck[0]); sort16(ck[1]); merge16(ck[0], ck[1]);
            { unsigned oth[16];
#pragma unroll
              for (int i = 0; i < 16; ++i) oth[i] = xorx<32>(ck[0][i], lane);
              merge16(ck[0], oth); }
            float w[16]; float wsum = 0.f; const float v0 = ord2f(ck[0][0] & ~63u);
#pragma unroll
            for (int r = 0; r < 16; ++r) { w[r] = __expf(ord2f(ck[0][r] & ~63u) - v0); wsum += w[r]; }
            const float winv = 1.0f / wsum;
#pragma unroll
            for (int r = 0; r < 16; ++r) if ((r >> 3) == hi) {
                const int c = 63 - (int)(ck[0][r] & 63u);
                const unsigned short eid = Elds[c * 64 + r32 + 32 * (c & 1)];
                PIDX[(size_t)tok * 128 + h * 16 + r] = eid; PG[(size_t)tok * 128 + h * 16 + r] = w[r] * winv; }
        }
    }
}

__device__ __forceinline__ float gelu_erf(float v) { return 0.5f * v * (1.0f + erff(v * 0.70710678118654752f)); }

#define PROBE_REPA 1
#define PROBE_REPB 1
constexpr int NR = 8, RSH = 18, BSA = 8, BSB = 8, ELP = 136, TPS = 8; static_assert(BSA == 8 && BSB == 8, "whole batches of 8");
__device__ __forceinline__ void sort128(unsigned& e0, unsigned& e1, int lane) {
#pragma unroll
    for (int size = 2; size <= 128; size <<= 1) {
#pragma unroll
        for (int stride = size >> 1; stride > 0; stride >>= 1) {
            if (stride == 64) { const unsigned lo = e0 < e1 ? e0 : e1, hi = e0 < e1 ? e1 : e0; e0 = lo; e1 = hi; }
            else {
                const bool lower = (lane & stride) == 0;
                const bool asc0 = (size == 128) ? true : (size == 64 ? true : ((lane & size) == 0));
                const bool asc1 = (size == 128) ? true : (size == 64 ? false : ((lane & size) == 0));
                const unsigned p0 = xorx_sw(e0, lane, stride), p1 = xorx_sw(e1, lane, stride);
                const unsigned mn0 = e0 < p0 ? e0 : p0, mx0 = e0 < p0 ? p0 : e0, mn1 = e1 < p1 ? e1 : p1, mx1 = e1 < p1 ? p1 : e1;
                e0 = (lower == asc0) ? mn0 : mx0; e1 = (lower == asc1) ? mn1 : mx1;
            }
        }
    }
}
template <int BS> __device__ __forceinline__ void sw_issue(v4u (&buf)[BS], const LAS unsigned* el, const unsigned char* tab, unsigned voff) {
#pragma unroll
    for (int i = 0; i < BS; ++i) { const unsigned off = (el[i] << 10) + voff;
        buf[i] = *(const v4u*)(tab + off); }
}
template <int BS> __device__ __forceinline__ void sw_proc_a(const v4u (&buf)[BS], const v4u& hq, LAS float* wl, int s, int n, int lane) {
    const int hx = (int)hq.x, hy = (int)hq.y, hz = (int)hq.z, hw = (int)hq.w;
    float dd[8];
#pragma unroll
    for (int i = 0; i < 8; ++i) dd[i] = 0.f;
#pragma unroll
    for (int i = 0; i < BS; ++i) { const int dx = (int)buf[i].x, dy = (int)buf[i].y, dz = (int)buf[i].z, dw = (int)buf[i].w;
        int t = __builtin_amdgcn_sdot4(hx, dx, 0, false); t = __builtin_amdgcn_sdot4(hy, dy, t, false); t = __builtin_amdgcn_sdot4(hz, dz, t, false); t = __builtin_amdgcn_sdot4(hw, dw, t, false);
        dd[i] = (float)t; }
    const float r1 = reduce8_t(dd, lane);
    if ((lane & 7) == 0) wl[s + (lane >> 3)] = r1;
}
typedef _Float16 h2_t __attribute__((ext_vector_type(2)));
#define CVT_H2_FP8(u, hi) __builtin_bit_cast(h2_t, __builtin_amdgcn_cvt_scalef32_pk_f16_fp8((u), 1.0f, (hi)))
template <int BS> __device__ __forceinline__ void sw_proc_b(const v4u (&buf)[BS], h2_t (&acc)[8], const LAS float* wl, int s, int n) {
    float wr[BS];
#pragma unroll
    for (int i = 0; i < BS; ++i) wr[i] = wl[s + i];
#pragma unroll
    for (int i = 0; i < BS; ++i) {
        const h2_t wv = __builtin_bit_cast(h2_t, wr[i]);
        const unsigned ux = buf[i].x, uy = buf[i].y, uz = buf[i].z, uw = buf[i].w;
        acc[0] = __builtin_elementwise_fma(CVT_H2_FP8(ux, false), wv, acc[0]); acc[1] = __builtin_elementwise_fma(CVT_H2_FP8(ux, true), wv, acc[1]);
        acc[2] = __builtin_elementwise_fma(CVT_H2_FP8(uy, false), wv, acc[2]); acc[3] = __builtin_elementwise_fma(CVT_H2_FP8(uy, true), wv, acc[3]);
        acc[4] = __builtin_elementwise_fma(CVT_H2_FP8(uz, false), wv, acc[4]); acc[5] = __builtin_elementwise_fma(CVT_H2_FP8(uz, true), wv, acc[5]);
        acc[6] = __builtin_elementwise_fma(CVT_H2_FP8(uw, false), wv, acc[6]); acc[7] = __builtin_elementwise_fma(CVT_H2_FP8(uw, true), wv, acc[7]); }
}
__device__ __forceinline__ void sw_warm(v4u (&pf)[4], const unsigned char* tab, int range, int lw, unsigned voff) {
#pragma unroll
    for (int i = 0; i < 4; ++i) { const unsigned off = ((unsigned)(range * 1024 + lw * 4 + i) << 10) + voff; pf[i] = *(const v4u*)(tab + off); }
}
__device__ __forceinline__ void sw_warm_done(const v4u (&pf)[4]) {
#pragma unroll
    for (int i = 0; i < 4; ++i) asm volatile("" :: "v"(pf[i]));
}
template <int FAKE> __device__ __forceinline__ void p8b_sweep(Frame& F) {
    const bf16* X1 = (const bf16*)(((unsigned char*)karg(19)) + WS_X1); const float* MOD = (const float*)(((unsigned char*)karg(19)) + WS_MOD);
    const unsigned char* H2Q = (const unsigned char*)(((unsigned char*)karg(19)) + WS_H2Q); const float* H2S = (const float*)(((unsigned char*)karg(19)) + WS_H2S);
    const unsigned char* EDq = (const unsigned char*)(((unsigned char*)karg(19)) + WS_ED); const unsigned char* EUq = (const unsigned char*)(((unsigned char*)karg(19)) + WS_EU); const float* EDS = (const float*)(((unsigned char*)karg(19)) + WS_EDS);
    const unsigned short* PIDX = (const unsigned short*)(((unsigned char*)karg(19)) + WS_PIDX); const float* PG = (const float*)(((unsigned char*)karg(19)) + WS_PG);
    const float* fg = ((const float*)karg(17));
    const int gw = F.vcu * NWAVES + F.wave, NGW = F.G * NWAVES;
    for (int wi = F.vcu; wi < M / 64; wi += F.G) {
        const int tb = wi * 8 + F.wave;
        unsigned ones = ~0u; asm volatile("" : "+s"(ones));
        int lane = (int)__builtin_amdgcn_mbcnt_hi(ones, __builtin_amdgcn_mbcnt_lo(ones, 0u)); asm volatile("" : "+v"(lane));
        const int tok0 = tb * 8;
        unsigned E0[8], E1[8];
        LAS float* Wl = (LAS float*)(F.lds) + F.wave * 1024;
        LAS unsigned* El = (LAS unsigned*)(F.lds + 32768) + F.wave * (8 * ELP);
        unsigned voff = 16u * (unsigned)lane; asm volatile("" : "+v"(voff));
        LAS int* Bnd = (LAS int*)(F.lds + 67584) + F.wave * (8 * (NR + 1));
#pragma unroll
        for (int k = 0; k < 8; ++k) {
            const size_t base = (size_t)(tok0 + k) * 128;
            E0[k] = ((unsigned)PIDX[base + lane] << 7) | (unsigned)lane; E1[k] = ((unsigned)PIDX[base + 64 + lane] << 7) | (unsigned)(64 + lane);
            sort128(E0[k], E1[k], lane);
            if (FAKE) { E0[k] = (E0[k] & 0x1ffffu) ; E1[k] = (E1[k] & 0x1ffffu); sort128(E0[k], E1[k], lane); }
            El[k * ELP + lane] = E0[k] >> 7; El[k * ELP + 64 + lane] = E1[k] >> 7;
            if (lane < 8) El[k * ELP + 128 + lane] = (unsigned)__builtin_amdgcn_readlane((int)E1[k], 63) >> 7;
        }
        for (int repa = 0; repa < PROBE_REPA; ++repa) {
            v4u hq[8];
#pragma unroll
            for (int k = 0; k < 8; ++k) hq[k] = *(const v4u*)(H2Q + (size_t)(tok0 + k) * D + 16 * lane);
            int pos[8];
#pragma unroll
            for (int k = 0; k < 8; ++k) pos[k] = 0;
            v4u bA[BSA], bB[BSA], bC[BSA]; int ps = 0, pn = 0;
            for (int r = 0; r < NR; ++r) {
#pragma unroll
                for (int k = 0; k < 8; ++k) {
                    constexpr int dummy = 0; (void)dummy;
                    const int kp = (k + 7) & 7;
                    const unsigned long long BM = 0x0101010101010101ull;
                    const int c = __builtin_popcountll(__ballot((E0[k] >> RSH) == (unsigned)r) & BM) + __builtin_popcountll(__ballot((E1[k] >> RSH) == (unsigned)r) & BM);
                    int s = __builtin_amdgcn_readfirstlane(pos[k]); const int e_end = __builtin_amdgcn_readfirstlane(s + 8 * c); pos[k] = e_end;
                    if (lane == 0) Bnd[k * (NR + 1) + r + 1] = e_end;
                    const int n1 = (e_end - s) < BSA ? (e_end - s) : BSA;
                    if (k & 1) sw_issue<BSA>(bB, El + k * ELP + s, EDq, voff); else sw_issue<BSA>(bA, El + k * ELP + s, EDq, voff);
                    if (pn > 0) { if (k & 1) sw_proc_a<BSA>(bA, hq[kp], Wl + kp * 128, ps, pn, lane); else sw_proc_a<BSA>(bB, hq[kp], Wl + kp * 128, ps, pn, lane); }
                    ps = s; pn = n1; s += n1;
#define SWA_REST(Y) if (s < e_end) { sw_issue<BSA>(Y, El + k * ELP + s, EDq, voff); \
                        for (;;) { int n = (e_end - s) < BSA ? (e_end - s) : BSA; \
                            if (s + BSA < e_end) { sw_issue<BSA>(bC, El + k * ELP + s + BSA, EDq, voff); sw_proc_a<BSA>(Y, hq[k], Wl + k * 128, s, n, lane); } else { sw_proc_a<BSA>(Y, hq[k], Wl + k * 128, s, n, lane); break; } \
                            s += BSA; n = (e_end - s) < BSA ? (e_end - s) : BSA; \
                            if (s + BSA < e_end) { sw_issue<BSA>(Y, El + k * ELP + s + BSA, EDq, voff); sw_proc_a<BSA>(bC, hq[k], Wl + k * 128, s, n, lane); } else { sw_proc_a<BSA>(bC, hq[k], Wl + k * 128, s, n, lane); break; } \
                            s += BSA; } }
                    if (k & 1) { SWA_REST(bA) } else { SWA_REST(bB) }
#undef SWA_REST
                }
            }
            if (pn > 0) sw_proc_a<BSA>(bB, hq[7], Wl + 7 * 128, ps, pn, lane);
        }
#pragma unroll
        for (int k = 0; k < 8; ++k) { int tk = tok0 + k; asm volatile("" : "+s"(tk)); const size_t base = (size_t)tk * 128; const float sh = H2S[tk];
            const float r0 = Wl[k * 128 + lane], r1 = Wl[k * 128 + 64 + lane];
            const _Float16 w0 = (_Float16)(PG[base + (E0[k] & 127u)] * gelu_erf(r0 * sh * EDS[E0[k] >> 7])), w1 = (_Float16)(PG[base + (E1[k] & 127u)] * gelu_erf(r1 * sh * EDS[E1[k] >> 7]));
            Wl[k * 128 + lane] = __builtin_bit_cast(float, (h2_t){w0, w0}); Wl[k * 128 + 64 + lane] = __builtin_bit_cast(float, (h2_t){w1, w1}); }
        int ln = lane; asm volatile("" : "+v"(ln));
#pragma unroll
        for (int sub = 0; sub < 8 / TPS; ++sub) {
        h2_t acc[TPS][8];
        for (int repb = 0; repb < PROBE_REPB; ++repb) {
#pragma unroll
            for (int kk = 0; kk < TPS; ++kk)
#pragma unroll
                for (int i = 0; i < 8; ++i) acc[kk][i] = (h2_t){(_Float16)0.f, (_Float16)0.f};
            int pos[TPS];
#pragma unroll
            for (int kk = 0; kk < TPS; ++kk) pos[kk] = 0;
            v4u bA[BSB], bB[BSB]; int ps = 0, pn = 0;
            for (int r = 0; r < NR; ++r) {
#pragma unroll
                for (int kk = 0; kk < TPS; ++kk) {
                    const int k = sub * TPS + kk, kkp = (kk + TPS - 1) % TPS, kp = sub * TPS + kkp;
                    int s = __builtin_amdgcn_readfirstlane(pos[kk]); const int e_end = __builtin_amdgcn_readfirstlane(Bnd[k * (NR + 1) + r + 1]); pos[kk] = e_end;
                    const int n1 = (e_end - s) < BSB ? (e_end - s) : BSB;
                    if (kk & 1) sw_issue<BSB>(bB, El + k * ELP + s, EUq, voff); else sw_issue<BSB>(bA, El + k * ELP + s, EUq, voff);
                    if (pn > 0) { if (kk & 1) sw_proc_b<BSB>(bA, acc[kkp], Wl + kp * 128, ps, pn); else sw_proc_b<BSB>(bB, acc[kkp], Wl + kp * 128, ps, pn); }
                    ps = s; pn = n1; s += n1;
                    for (; s < e_end; s += BSB) {
                        const int n = (e_end - s) < BSB ? (e_end - s) : BSB;
                        if (kk & 1) { sw_issue<BSB>(bA, El + k * ELP + s, EUq, voff); sw_proc_b<BSB>(bA, acc[kk], Wl + k * 128, s, n); }
                        else        { sw_issue<BSB>(bB, El + k * ELP + s, EUq, voff); sw_proc_b<BSB>(bB, acc[kk], Wl + k * 128, s, n); }
                    }
                }
            }
            if (pn > 0) sw_proc_b<BSB>(bB, acc[TPS - 1], Wl + (sub * TPS + TPS - 1) * 128, ps, pn);
        }
        {
            asm volatile("" : "+v"(ln));
            float* outp = (float*)karg(18);
            const float* gt2 = MOD + ((tok0 + sub * TPS) >> 12) * NMOD + 5120;
            f32x4 gtv[4]; u32x2 xcur[4], xnxt[4];
#pragma unroll
            for (int j = 0; j < 4; ++j) { const int col = 4 * ln + 256 * j; gtv[j] = *(const f32x4*)(gt2 + col); xcur[j] = *(const u32x2*)(X1 + (size_t)(tok0 + sub * TPS) * D + col); }
#pragma unroll
            for (int kk = 0; kk < TPS; ++kk) {
                const int tok = tok0 + sub * TPS + kk;
                if (kk + 1 < TPS) {
#pragma unroll
                    for (int j = 0; j < 4; ++j) xnxt[j] = __builtin_nontemporal_load((const u32x2*)(X1 + (size_t)(tok + 1) * D + 4 * ln + 256 * j));
                }
                f32x4 x2[4]; float ss = 0.f;
#pragma unroll
                for (int j = 0; j < 4; ++j) {
#pragma unroll
                    for (int i = 0; i < 4; ++i) { const unsigned xw = (i >> 1) ? xcur[j].y : xcur[j].x; const float xf = (i & 1) ? bfhi(xw) : bflo(xw);
                        const float v = xf + gtv[j][i] * (0.0625f * (float)acc[kk][2 * j + (i >> 1)][i & 1]); x2[j][i] = v; ss += v * v; } }
                ss = wave_sum_x(ss, ln);
                if (!(FAKE && ss != 12345.678f)) {
                    const float rstd = 1.0f / sqrtf(ss * (1.0f / D) + EPS);
                    f32x4 fgv[4];
#pragma unroll
                    for (int j = 0; j < 4; ++j) fgv[j] = *(const f32x4*)(fg + 4 * ln + 256 * j);
#pragma unroll
                    for (int j = 0; j < 4; ++j) __builtin_nontemporal_store(x2[j] * rstd * fgv[j], (f32x4*)(outp + (size_t)tok * D + 4 * ln + 256 * j));
                }
#pragma unroll
                for (int j = 0; j < 4; ++j) xcur[j] = xnxt[j];
            }
        }
        }
    }
}

struct Args { const float* in[18]; float* out; unsigned char* ws; };
__global__ void __launch_bounds__(NTHR, 2) mega_fwd(Args args) {
    extern __shared__ __attribute__((aligned(16))) unsigned char lds[];
    Frame F;
    F.lds = (LAS unsigned char*)lds;
    F.wave = __builtin_amdgcn_readfirstlane((int)threadIdx.x >> 6); F.lane = lane_fresh(); F.tid = F.wave * 64 + F.lane;
    F.G = gridDim.x; { const int bx = blockIdx.x; F.vcu = (F.G % 8 == 0) ? (bx % 8) * (F.G / 8) + bx / 8 : bx; }
    volatile LAS unsigned* MISC = (volatile LAS unsigned*)(F.lds + MISC_OFF);
    for (int u = F.tid; u < (LDS_BYTES - LDSCTL_OFF) / 4; u += NTHR) ((LAS unsigned*)(F.lds + LDSCTL_OFF))[u] = 0u;
    __syncthreads();
    gu32* ctl = (gu32*)(((unsigned char*)karg(19)) + WS_CTL);
    XcdBarrier bar = xcd_barrier_post((unsigned*)(ctl + CW_BAR), MISC + 8, F.wave);
#define GRID_BAR() xcd_barrier(bar)
#define PROBE_TS -1
#define STAMP(i) do { if (PROBE_TS >= 0 && blockIdx.x == 0 && F.tid == 0) { const unsigned long long t_ = __builtin_amdgcn_s_memrealtime(); MISC[16 + 2 * (i)] = (unsigned)t_; MISC[17 + 2 * (i)] = (unsigned)(t_ >> 32); } } while (0)
#define PROBE_DBL -1

    STAMP(0);
    F.lane = lane_fresh(); F.tid = F.wave * 64 + F.lane;
    p0_prologue(F); GRID_BAR(); STAMP(1);
    if (PROBE_DBL == 0) { p0_prologue(F); GRID_BAR(); }
    F.lane = lane_fresh(); F.tid = F.wave * 64 + F.lane;
    p1_norm(F); p0_transposes(F); GRID_BAR(); STAMP(2);
    if (PROBE_DBL == 1) { p1_norm(F); GRID_BAR(); }
    {
    {
        pg8::Gemm g{(const pg8::bf16_t*)(((unsigned char*)karg(19)) + WS_H), (const pg8::bf16_t*)(((unsigned char*)karg(19)) + WS_WIN), M, NPROJ, D, nullptr, nullptr};
        pg8::StaticOrder S; S.init(M, NPROJ, F.G, (int)blockIdx.x);
        pg8::EpiBf16<0> E{(pg8::bf16_t*)(((unsigned char*)karg(19)) + WS_PROJ), NPROJ, nullptr, 0, 0, 1.f};
        pg8::gemm_phase<pg8::EpiBf16<0>, pg8::StaticOrder, true, true>(F.lds + RING_OFF, g, S, E, F.wave);
        const int nwg = (M / 256) * (NPROJ / 256), busy = nwg % F.G;
        if (busy == 0) p0_quant_tables(F, F.vcu * NWAVES + F.wave, F.G * NWAVES);
        else if ((int)blockIdx.x >= busy) p0_quant_tables(F, ((int)blockIdx.x - busy) * NWAVES + F.wave, (F.G - busy) * NWAVES);
    }
    GRID_BAR(); STAMP(3);
    }
    F.lane = lane_fresh(); F.tid = F.wave * 64 + F.lane;
    p3_attention(F); GRID_BAR(); STAMP(4);
    if (PROBE_DBL == 3) { p3_attention(F); GRID_BAR(); }
    {
    {
        pg8::Gemm g{(const pg8::bf16_t*)(((unsigned char*)karg(19)) + WS_OA), (const pg8::bf16_t*)(((unsigned char*)karg(19)) + WS_WA), M, D, 512, (const pg8::bf16_t*)(((unsigned char*)karg(19)) + WS_OB), (const pg8::bf16_t*)(((unsigned char*)karg(19)) + WS_WB)};
        PairOrder S; S.S.init(M, D, F.G, (int)blockIdx.x);
        EpiGate E{(const bf16*)(((unsigned char*)karg(19)) + WS_PROJ), (bf16*)((float*)karg(18)) + (size_t)M * D};
        pg8::gemm_phase<EpiGate, PairOrder, true, true>(F.lds + RING_OFF, g, S, E, F.wave);
    }
    GRID_BAR(); STAMP(5);
    }
    {
    {
        pg8::Gemm g{(const pg8::bf16_t*)((bf16*)((float*)karg(18)) + (size_t)M * D), (const pg8::bf16_t*)(((unsigned char*)karg(19)) + WS_WOUT), M, D, D, nullptr, nullptr};
        pg8::StaticOrder S; S.init(M, D, F.G, (int)blockIdx.x);
        EpiRes E{((const float*)karg(0)), (const float*)(((unsigned char*)karg(19)) + WS_MOD), (bf16*)(((unsigned char*)karg(19)) + WS_X1)};
        pg8::gemm_phase<EpiRes, pg8::StaticOrder, true, true>(F.lds + RING_OFF, g, S, E, F.wave);
    }
    GRID_BAR(); STAMP(6);
    }
    F.lane = lane_fresh(); F.tid = F.wave * 64 + F.lane;
    F.lane = lane_fresh(); F.tid = F.wave * 64 + F.lane;
    p6_norm2(F); GRID_BAR(); STAMP(7);
    if (PROBE_DBL == 6) { p6_norm2(F); GRID_BAR(); }
    {
    {
        pg8::Gemm g{(const pg8::bf16_t*)(((unsigned char*)karg(19)) + WS_H2), (const pg8::bf16_t*)(((unsigned char*)karg(19)) + WS_WQ), M, D, D, nullptr, nullptr};
        pg8::StaticOrder S; S.init(M, D, F.G, (int)blockIdx.x);
        pg8::EpiBf16<0> E{(pg8::bf16_t*)(((unsigned char*)karg(19)) + WS_QP), D, nullptr, 0, 0, 1.f};
        pg8::gemm_phase<pg8::EpiBf16<0>, pg8::StaticOrder, true, true>(F.lds + RING_OFF, g, S, E, F.wave);
    }
    GRID_BAR(); STAMP(8);
    }
    F.lane = lane_fresh(); F.tid = F.wave * 64 + F.lane;
    p8a_topk(F); __syncthreads(); STAMP(9);
    if (PROBE_DBL == 8) { p8a_topk(F); GRID_BAR(); }
    if (PROBE_DBL == 12) { p8b_sweep<1>(F); __syncthreads(); }
    p8b_sweep<0>(F);
    if (PROBE_DBL == 9) { GRID_BAR(); p8b_sweep<0>(F); }
    if (PROBE_TS >= 0) {
        GRID_BAR(); STAMP(10);
        if (blockIdx.x == 0) { __syncthreads();
            const unsigned long long t0 = ((unsigned long long)MISC[17 + 2 * PROBE_TS] << 32) | MISC[16 + 2 * PROBE_TS], t1 = ((unsigned long long)MISC[19 + 2 * PROBE_TS] << 32) | MISC[18 + 2 * PROBE_TS];
            const float d_us = (float)(t1 - t0) * 0.01f;
            const float V = 128.0f * sqrtf(d_us * 1e-5f);
            float* o = (float*)karg(18); for (int c = F.tid; c < D; c += NTHR) o[c] = V; }
    }
}

extern "C" void kernel_launch(void* const* d_in, const int* in_sizes, int n_in, void* d_out, int out_size, void* d_ws, size_t ws_size, hipStream_t stream) {
    static int grid = 0;
    if (grid == 0) {
        if (n_in != 18 || in_sizes[0] != M * D || out_size != M * D || ws_size < WS_END) { fprintf(stderr, "kernel_launch: unexpected shapes (n_in %d, in0 %d, out %d, ws %zu)\n", n_in, n_in > 0 ? in_sizes[0] : -1, out_size, ws_size); grid = -1; return; }
        int dev = 0, cus = 0, per_cu = 0;
        if (hipGetDevice(&dev) != hipSuccess || hipDeviceGetAttribute(&cus, hipDeviceAttributeMultiprocessorCount, dev) != hipSuccess) { grid = -1; return; }
        if (hipFuncSetAttribute((const void*)mega_fwd, hipFuncAttributeMaxDynamicSharedMemorySize, LDS_BYTES) != hipSuccess) { fprintf(stderr, "kernel_launch: hipFuncSetAttribute failed\n"); grid = -1; return; }
        if (hipOccupancyMaxActiveBlocksPerMultiprocessor(&per_cu, (const void*)mega_fwd, NTHR, LDS_BYTES) != hipSuccess || per_cu < 1) { fprintf(stderr, "kernel_launch: occupancy query says %d blocks per CU\n", per_cu); }
        (void)hipGetLastError();
        grid = cus;
    }
    if (grid < 0) return;
    if (hipMemsetAsync((char*)d_ws + WS_CTL, 0, CTL_ZERO_BYTES, stream) != hipSuccess) { fprintf(stderr, "kernel_launch: memset failed\n"); return; }
    Args a{};
    for (int i = 0; i < 18; ++i) a.in[i] = (const float*)d_in[i];
    a.out = (float*)d_out; a.ws = (unsigned char*)d_ws;
    hipLaunchKernelGGL(mega_fwd, dim3(grid), dim3(NTHR), LDS_BYTES, stream, a);
}
```

```cpp
#include <hip/hip_runtime.h>
#include <cstdio>
#include <cstdint>
__device__ __forceinline__ int lane_fresh() { unsigned ones = ~0u; asm volatile("" : "+s"(ones)); return (int)__builtin_amdgcn_mbcnt_hi(ones, __builtin_amdgcn_mbcnt_lo(ones, 0u)); }
namespace pg8 {
#define PG8_LAS __attribute__((address_space(3)))
typedef unsigned short bf16_t;
typedef short bf16x8 __attribute__((ext_vector_type(8)));
typedef float f32x4 __attribute__((ext_vector_type(4)));
typedef unsigned u32x4 __attribute__((ext_vector_type(4)));
constexpr int BM = 256, BK = 64, HALF = 128, HTB = HALF * BK * 2  , STAGE_BYTES = 8 * HTB, NXCD = 8, WGM = 8;

__host__ __device__ __forceinline__ int lds_byte(int r, int c) { const int st = (r >> 4) * 2 + (c >> 5), rr = r & 15, cc = c & 31, ob = rr * 64 + cc * 2; return st * 1024 + (ob ^ (((ob >> 9) & 1) << 5)); }
__host__ __device__ __forceinline__ void stage_rc(int b, int& R, int& C) { const int st = b / 1024, sb = b % 1024, swz = sb ^ (((sb >> 9) & 1) << 5); R = (st >> 1) * 16 + swz / 64; C = (st & 1) * 32 + (swz % 64) / 2; }
__host__ __device__ __forceinline__ int perm32(int rho) { const int n = rho >> 4, i = rho & 15; return 8 * (i >> 2) + 4 * n + (i & 3); }

struct Unit { int pm, pn, src; };
struct Gemm { const bf16_t* A; const bf16_t* Bt; int M, N, K; const bf16_t* A2; const bf16_t* Bt2; };

struct StaticOrder {
    int nM, nN, nwg, G, c;
    __host__ __device__ void init(int M, int N, int G_, int c_) { nM = M / BM; nN = N / BM; nwg = nM * nN; G = G_; c = c_; }
    __host__ __device__ bool next(int i, Unit& u) const {
        const long L = (long)i * G + c; if (L >= nwg) return false;
        int wgid = (int)L; { const int q = nwg / NXCD, r = nwg % NXCD, xcd = wgid % NXCD, off = wgid / NXCD; wgid = (xcd < r ? xcd * (q + 1) : r * (q + 1) + (xcd - r) * q) + off; }
        const int nig = WGM * nN, gid = wgid / nig, fm = gid * WGM, gsz = (nM - fm) < WGM ? (nM - fm) : WGM;
        u.pm = fm + ((wgid % nig) % gsz); u.pn = (wgid % nig) / gsz; u.src = 0; return true;
    }
    __device__ __forceinline__ void a_ready(const Unit&) const {}
    __device__ __forceinline__ void done(const Unit&) const {}
};

__device__ __forceinline__ unsigned cvt_pk_bf16(float lo, float hi) { unsigned r; asm volatile("v_cvt_pk_bf16_f32 %0, %1, %2" : "=v"(r) : "v"(lo), "v"(hi)); return r; }
typedef float f32x2 __attribute__((ext_vector_type(2)));
__device__ __forceinline__ f32x2 gelu_pk(f32x2 v) {
    const f32x2 av = __builtin_elementwise_abs(v), d = av * 0.2316418882f + 1.0f;
    f32x2 t; t.x = __builtin_amdgcn_rcpf(d.x); t.y = __builtin_amdgcn_rcpf(d.y);
    f32x2 q = t * 0.5307027145f + (-0.7265760135f); q = q * t + 0.7107068705f; q = q * t + (-0.142248368f); q = q * t + 0.127414796f; q = q * t;
    const f32x2 s = (v * v) * (-0.72134752044f);
    f32x2 e; e.x = __builtin_amdgcn_exp2f(s.x); e.y = __builtin_amdgcn_exp2f(s.y);
    const f32x2 m = v * (q * e), r = v - m;
    f32x2 o; o.x = v.x < 0.f ? m.x : r.x; o.y = v.y < 0.f ? m.y : r.y; return o;
}

template <int ACT  > struct EpiBf16 {
    static constexpr bool PERM = true, AFTER_DRAIN = false, CHAIN = false; static_assert(ACT == 0 || ACT == 1, "EpiBf16: ACT is 0 (none) or 1 (gelu_pk)");
    bf16_t* O; int ldc; const float* bias; int split_cols; size_t split_stride; float scale0;
    __device__ __forceinline__ void operator()(const f32x4 (&acc)[2][2][4][2], const Unit& u, int wr, int wc, int fr, int fq) const {
        const int row0 = u.pm * BM + wr * 64 + fr; int colt = u.pn * BM; bf16_t* base = O;
        float sc = 1.f; if (split_cols) { const int t = colt / split_cols; base += (size_t)t * split_stride; colt -= t * split_cols; if (t == 0) sc = scale0; }
        const int col0 = colt + wc * 32 + 8 * fq, bcol0 = u.pn * BM + wc * 32 + 8 * fq;
        f32x4 bv[2][2];
#pragma unroll
        for (int bj = 0; bj < 2; ++bj)
#pragma unroll
            for (int n = 0; n < 2; ++n) bv[bj][n] = bias ? *(const f32x4*)(bias + bcol0 + bj * HALF + 4 * n) : (f32x4){0.f, 0.f, 0.f, 0.f};
#pragma unroll
        for (int ai = 0; ai < 2; ++ai)
#pragma unroll
            for (int m = 0; m < 4; ++m) { bf16_t* rowp = base + (size_t)(row0 + ai * HALF + m * 16) * ldc + col0;
#pragma unroll
                for (int bj = 0; bj < 2; ++bj) { f32x4 v0 = acc[ai][bj][m][0] + bv[bj][0], v1 = acc[ai][bj][m][1] + bv[bj][1];
                    if (ACT == 1) { f32x2 a = gelu_pk((f32x2){v0[0], v0[1]}), b = gelu_pk((f32x2){v0[2], v0[3]}), c = gelu_pk((f32x2){v1[0], v1[1]}), d = gelu_pk((f32x2){v1[2], v1[3]});
                        v0 = (f32x4){a.x, a.y, b.x, b.y}; v1 = (f32x4){c.x, c.y, d.x, d.y}; }
                    v0 = v0 * sc; v1 = v1 * sc; u32x4 w; w.x = cvt_pk_bf16(v0[0], v0[1]); w.y = cvt_pk_bf16(v0[2], v0[3]); w.z = cvt_pk_bf16(v1[0], v1[1]); w.w = cvt_pk_bf16(v1[2], v1[3]);
                    *(u32x4*)(rowp + bj * HALF) = w; } }
    }
};

template <class Epi, class Sched, bool ALIGN_EPI = false, bool SP2 = false>
__device__ __forceinline__ void gemm_phase(PG8_LAS unsigned char* lds, const Gemm g, const Sched& S, const Epi& E, int wave_id) {
    int tid = wave_id * 64 + ::lane_fresh(); asm volatile("" : "+v"(tid));
    const int wid = __builtin_amdgcn_readfirstlane(tid >> 6), lane = tid & 63, wr = wid >> 2, wc = wid & 3, fr = lane & 15, fq = lane >> 4;
    const int K = g.K, nt = K / BK;
    unsigned voffA[2], voffB[2];
#pragma unroll
    for (int i = 0; i < 2; ++i) { int R, C; stage_rc(tid * 16 + i * 8192, R, C); const int Rb = Epi::PERM ? ((R & ~31) + perm32(R & 31)) : R;
        voffA[i] = (unsigned)(R * K + C) * 2u; voffB[i] = (unsigned)(Rb * K + C) * 2u; }
    const size_t kstep = (size_t)(BK * 2);
    const size_t hstep = (size_t)HALF * K * 2;
    const size_t tstep = 2 * hstep;
    const unsigned ldsw = (unsigned)wid * 1024u;
    const int aoff = lds_byte(wr * 64 + fr, fq * 8), boff = lds_byte(wc * 32 + fr, fq * 8);
#define PG8_SA(b, h) (((b) * 2 + (h)) * HTB)
#define PG8_SB(b, h) ((4 + (b) * 2 + (h)) * HTB)
#define PG8_STAGE(bufoff, gbase, voff) do { _Pragma("unroll") for (int _i = 0; _i < 2; ++_i) \
        __builtin_amdgcn_global_load_lds((const unsigned*)((const char*)(gbase) + (voff)[_i]), (PG8_LAS unsigned*)(lds + (bufoff) + ldsw + _i * 8192), 16, 0, 0); } while (0)
#define PG8_LDA(dst, b, h) do { _Pragma("unroll") for (int m = 0; m < 4; ++m) _Pragma("unroll") for (int k = 0; k < 2; ++k) dst[m][k] = *(const PG8_LAS bf16x8*)(lds + PG8_SA(b, h) + aoff + m * 2048 + k * 1024); } while (0)
#define PG8_LDB(dst, b, h) do { _Pragma("unroll") for (int n = 0; n < 2; ++n) _Pragma("unroll") for (int k = 0; k < 2; ++k) dst[n][k] = *(const PG8_LAS bf16x8*)(lds + PG8_SB(b, h) + boff + n * 2048 + k * 1024); } while (0)
#define PG8_MMA(ai, bj, At, Bt) do { __builtin_amdgcn_s_setprio(1); _Pragma("unroll") for (int m = 0; m < 4; ++m) _Pragma("unroll") for (int n = 0; n < 2; ++n) _Pragma("unroll") for (int k = 0; k < 2; ++k) \
        acc[ai][bj][m][n] = __builtin_amdgcn_mfma_f32_16x16x32_bf16(Bt[n][k], At[m][k], acc[ai][bj][m][n], 0, 0, 0); __builtin_amdgcn_s_setprio(0); } while (0)
#define PG8_WAIT_V(n) asm volatile("s_waitcnt vmcnt(" #n ")" ::: "memory")
#define PG8_WAIT_L(n) asm volatile("s_waitcnt lgkmcnt(" #n ")" ::: "memory")
#define PG8_BAR __builtin_amdgcn_s_barrier()
#define PG8_SCHED __builtin_amdgcn_sched_barrier(0)
    Unit cur, nxt; int ui = 0;
    if (!S.next(0, cur)) return;
    f32x4 acc[2][2][4][2];
#pragma unroll
    for (int a = 0; a < 2; ++a)
#pragma unroll
        for (int b = 0; b < 2; ++b)
#pragma unroll
            for (int m = 0; m < 4; ++m)
#pragma unroll
                for (int n = 0; n < 2; ++n) acc[a][b][m][n] = (f32x4){0.f, 0.f, 0.f, 0.f};
    bf16x8 At[4][2], B0[2][2], B1[2][2];
    const char* cA = (const char*)(cur.src ? g.A2 : g.A) + (size_t)cur.pm * tstep; const char* cB = (const char*)(cur.src ? g.Bt2 : g.Bt) + (size_t)cur.pn * tstep;
    S.a_ready(cur);
    if constexpr (SP2) {
        PG8_STAGE(PG8_SB(0, 0), cB, voffB); PG8_STAGE(PG8_SB(0, 1), cB + hstep, voffB); PG8_STAGE(PG8_SA(0, 0), cA, voffA); PG8_STAGE(PG8_SA(0, 1), cA + hstep, voffA);
        if (wr == 1) PG8_BAR;
        PG8_WAIT_V(2); PG8_BAR;
        PG8_STAGE(PG8_SB(1, 0), cB + kstep, voffB); PG8_STAGE(PG8_SA(1, 0), cA + kstep, voffA); PG8_STAGE(PG8_SB(1, 1), cB + hstep + kstep, voffB);
        PG8_WAIT_V(6); PG8_BAR;
    } else {
        PG8_STAGE(PG8_SB(0, 0), cB, voffB); PG8_STAGE(PG8_SA(0, 0), cA, voffA); PG8_STAGE(PG8_SB(0, 1), cB + hstep, voffB); PG8_STAGE(PG8_SA(0, 1), cA + hstep, voffA);
        if (wr == 1) PG8_BAR;
        PG8_WAIT_V(4); PG8_BAR;
        PG8_STAGE(PG8_SB(1, 0), cB + kstep, voffB); PG8_STAGE(PG8_SA(1, 0), cA + kstep, voffA); PG8_STAGE(PG8_SB(1, 1), cB + hstep + kstep, voffB);
        PG8_WAIT_V(6); PG8_BAR;
    }
    for (;;) {
        const bool has_next = S.next(ui + 1, nxt);
        const char* nA = has_next ? (const char*)(nxt.src ? g.A2 : g.A) + (size_t)nxt.pm * tstep : cA; const char* nB = has_next ? (const char*)(nxt.src ? g.Bt2 : g.Bt) + (size_t)nxt.pn * tstep : cB;
        for (int t = 0; t < nt; t += 2) {
            const bool last = (t == nt - 2);
            const char* a1 = cA + (size_t)(t + 1) * kstep;
            const char* a2 = last ? nA : cA + (size_t)(t + 2) * kstep; const char* b2 = last ? nB : cB + (size_t)(t + 2) * kstep;
            const char* a3 = a2 + kstep; const char* b3 = b2 + kstep;
            if (last && has_next) S.a_ready(nxt);
            if constexpr (SP2) {
            PG8_LDB(B0, 0, 0); PG8_LDB(B1, 0, 1); PG8_SCHED; PG8_LDA(At, 0, 0); PG8_STAGE(PG8_SA(1, 1), a1 + hstep, voffA);
            PG8_WAIT_V(8); PG8_WAIT_L(0); PG8_BAR; PG8_MMA(0, 0, At, B0); PG8_MMA(0, 1, At, B1); PG8_BAR; PG8_SCHED;
            PG8_LDA(At, 0, 1); PG8_STAGE(PG8_SB(0, 0), b2, voffB); PG8_STAGE(PG8_SB(0, 1), b2 + hstep, voffB); PG8_STAGE(PG8_SA(0, 0), a2, voffA);
            PG8_WAIT_V(8); PG8_WAIT_L(0); PG8_BAR; PG8_MMA(1, 0, At, B0); PG8_MMA(1, 1, At, B1); PG8_BAR; PG8_SCHED;
            PG8_LDB(B0, 1, 0); PG8_LDB(B1, 1, 1); PG8_SCHED; PG8_LDA(At, 1, 0); PG8_STAGE(PG8_SA(0, 1), a2 + hstep, voffA);
            PG8_WAIT_V(8); PG8_WAIT_L(0); PG8_BAR; PG8_MMA(0, 0, At, B0); PG8_MMA(0, 1, At, B1); PG8_BAR; PG8_SCHED;
            PG8_LDA(At, 1, 1); PG8_STAGE(PG8_SB(1, 0), b3, voffB); PG8_STAGE(PG8_SB(1, 1), b3 + hstep, voffB); PG8_STAGE(PG8_SA(1, 0), a3, voffA);
            PG8_WAIT_V(8); PG8_WAIT_L(0); PG8_BAR; PG8_MMA(1, 0, At, B0); PG8_MMA(1, 1, At, B1); PG8_BAR; PG8_SCHED;
            } else {
            PG8_LDB(B0, 0, 0); PG8_SCHED; PG8_LDA(At, 0, 0); PG8_STAGE(PG8_SA(1, 1), a1 + hstep, voffA);
            PG8_WAIT_L(8); PG8_BAR; PG8_WAIT_L(0); PG8_MMA(0, 0, At, B0); PG8_BAR; PG8_SCHED;
            PG8_LDB(B1, 0, 1); PG8_STAGE(PG8_SB(0, 0), b2, voffB);
            PG8_BAR; PG8_WAIT_L(0); PG8_MMA(0, 1, At, B1); PG8_BAR;
            PG8_LDA(At, 0, 1); PG8_STAGE(PG8_SA(0, 0), a2, voffA);
            PG8_BAR; PG8_WAIT_L(0); PG8_MMA(1, 0, At, B0); PG8_BAR; PG8_SCHED;
            PG8_STAGE(PG8_SB(0, 1), b2 + hstep, voffB);
            PG8_WAIT_V(6); PG8_BAR; PG8_MMA(1, 1, At, B1); PG8_BAR;
            PG8_LDB(B0, 1, 0); PG8_SCHED; PG8_LDA(At, 1, 0); PG8_STAGE(PG8_SA(0, 1), a2 + hstep, voffA);
            PG8_WAIT_L(8); PG8_BAR; PG8_WAIT_L(0); PG8_MMA(0, 0, At, B0); PG8_BAR; PG8_SCHED;
            PG8_LDB(B1, 1, 1); PG8_STAGE(PG8_SB(1, 0), b3, voffB);
            PG8_BAR; PG8_WAIT_L(0); PG8_MMA(0, 1, At, B1); PG8_BAR;
            PG8_LDA(At, 1, 1); PG8_STAGE(PG8_SA(1, 0), a3, voffA);
            PG8_BAR; PG8_WAIT_L(0); PG8_MMA(1, 0, At, B0); PG8_BAR; PG8_SCHED;
            PG8_STAGE(PG8_SB(1, 1), b3 + hstep, voffB);
            PG8_WAIT_V(6); PG8_BAR; PG8_MMA(1, 1, At, B1); PG8_BAR;
            }
        }
        if constexpr (ALIGN_EPI) { if (wr == 0) PG8_BAR; }
        if constexpr (!Epi::AFTER_DRAIN) { E(acc, cur, wr, wc, fr, fq); S.done(cur); }
        if (!has_next) break;
        if (!(Epi::CHAIN && cur.src == 0)) {
#pragma unroll
        for (int a = 0; a < 2; ++a)
#pragma unroll
            for (int b = 0; b < 2; ++b)
#pragma unroll
                for (int m = 0; m < 4; ++m)
#pragma unroll
                    for (int n = 0; n < 2; ++n) acc[a][b][m][n] = (f32x4){0.f, 0.f, 0.f, 0.f};
        }
        cur = nxt; cA = nA; cB = nB; ++ui;
        if constexpr (ALIGN_EPI) { if (wr == 1) PG8_BAR; }
    }
    PG8_WAIT_V(0);
    if constexpr (!ALIGN_EPI) { if (wr == 0) PG8_BAR; }
    PG8_BAR;
    if constexpr (Epi::AFTER_DRAIN) { E.fused(acc, cur, wr, wc, fr, fq, lds, wid, lane); S.done(cur); }
#undef PG8_SA
#undef PG8_SB
#undef PG8_STAGE
#undef PG8_LDA
#undef PG8_LDB
#undef PG8_MMA
#undef PG8_WAIT_V
#undef PG8_WAIT_L
#undef PG8_BAR
#undef PG8_SCHED
}
}

#define GAS __attribute__((address_space(1)))
#define LAS __attribute__((address_space(3)))
typedef unsigned short bf16;
typedef unsigned v4u __attribute__((ext_vector_type(4)));
typedef float f32x4 __attribute__((ext_vector_type(4)));
typedef short bf16x8 __attribute__((ext_vector_type(8)));
typedef GAS unsigned gu32;
typedef GAS unsigned long long gu64;
#define RLX_AGENT __ATOMIC_RELAXED, __HIP_MEMORY_SCOPE_AGENT
#define LDS_WAIT() asm volatile("s_waitcnt lgkmcnt(0)" ::: "memory")
#define VM_WAIT() asm volatile("s_waitcnt vmcnt(0)" ::: "memory")
__device__ __forceinline__ unsigned long long rt() { return __builtin_amdgcn_s_memrealtime(); }
__device__ __forceinline__ unsigned f2bf(float f) { unsigned u = __builtin_bit_cast(unsigned, f); return (u + 0x7fffu + ((u >> 16) & 1u)) >> 16; }
__device__ __forceinline__ unsigned pk2(float lo, float hi) { return f2bf(lo) | (f2bf(hi) << 16); }

__device__ __forceinline__ const void* karg(int i);
constexpr int CW_BAR_FWD = 4096;
#define XB_TMO      128
#define XB_XCNT(j)  (256  + 64 * (j))
#define XB_XSUB(j)  (1280 + 64 * (j))
#define XB_XGEN(j)  (2304 + 64 * (j))
#define XB_TOP      3328
#define XB_TOPGEN   3392
#define XCD_BAR_WORDS 3456
#define XB_SPIN_CAP (1u << 18)

__device__ __forceinline__ unsigned xb_ld(unsigned* p)              { return __hip_atomic_load(p, __ATOMIC_RELAXED, __HIP_MEMORY_SCOPE_AGENT); }
__device__ __forceinline__ unsigned xb_add(unsigned* p, unsigned v) { return __hip_atomic_fetch_add(p, v, __ATOMIC_RELAXED, __HIP_MEMORY_SCOPE_AGENT); }
__device__ __forceinline__ unsigned xb_xcc_id() { return (unsigned)__builtin_amdgcn_s_getreg((3 << 11) | 20) & 0xFu; }
#define XB_SPIN(cond, bar) do { unsigned _sp = 0; while (cond) { __builtin_amdgcn_s_sleep(1); \
    if ((++_sp & 255u) == 0u) { if (xb_ld(&(bar)[XB_TMO])) break; if (_sp > XB_SPIN_CAP) { atomicAdd(&(bar)[XB_TMO], 1u); break; } } } } while (0)

struct XcdBarrier {
    int wave;
    unsigned* bar; unsigned x;
    volatile LAS unsigned* st;
};

__device__ __forceinline__ XcdBarrier xcd_barrier_post(unsigned* bar, volatile LAS unsigned* st, int wave) {
    XcdBarrier b; b.wave = wave; b.bar = bar; b.x = xb_xcc_id(); b.st = st;
    if (wave == 0 && lane_fresh() == 0) (void)xb_add(&bar[XB_XCNT(b.x)], 1u);
    return b;
}
__device__ __forceinline__ void xcd_barrier_complete(unsigned* bar, unsigned x, unsigned& nloc, unsigned& nx) {
    const unsigned G = gridDim.x * gridDim.y * gridDim.z;
    unsigned sum, cnt, mine, sp = 0u;
    for (;;) {
        sum = 0u; cnt = 0u; mine = 0u;
#pragma unroll
        for (unsigned j = 0; j < 16; ++j) { const unsigned c = xb_ld(&bar[XB_XCNT(j)]); sum += c; cnt += (c > 0u) ? 1u : 0u; mine = (j == x) ? c : mine; }
        if (sum == G) break;
        __builtin_amdgcn_s_sleep(1);
        if ((++sp & 255u) == 0u) { if (xb_ld(&bar[XB_TMO])) break; if (sp > XB_SPIN_CAP) { atomicAdd(&bar[XB_TMO], 1u); break; } }
    }
    nloc = mine > 0u ? mine : 1u; nx = cnt > 0u ? cnt : 1u;
}

__device__ __forceinline__ void xcd_barrier(const XcdBarrier& b) {
    asm volatile("s_waitcnt vmcnt(0)" ::: "memory");
    __syncthreads();
    if (b.wave == 0 && lane_fresh() == 0) {
        unsigned* bar = (unsigned*)((gu32*)((unsigned char*)karg(19)) + CW_BAR_FWD);
        __builtin_amdgcn_s_waitcnt(0);
        unsigned nloc = b.st[0], nx = b.st[1];
        if (nloc == 0u) { xcd_barrier_complete(bar, b.x, nloc, nx); b.st[0] = nloc; b.st[1] = nx; }
        const unsigned old = xb_add(&bar[XB_XSUB(b.x)], 1u);
        const unsigned gen = old / nloc;
        if (old + 1u == (gen + 1u) * nloc) {
            __builtin_amdgcn_fence(__ATOMIC_RELEASE, "agent");
            asm volatile("s_waitcnt vmcnt(0)" ::: "memory");
            const unsigned og = xb_add(&bar[XB_TOP], 1u);
            const unsigned tg = og / nx;
            if (og + 1u == (tg + 1u) * nx) xb_add(&bar[XB_TOPGEN], 1u);
            else XB_SPIN(xb_ld(&bar[XB_TOPGEN]) == tg, bar);
            __builtin_amdgcn_fence(__ATOMIC_ACQUIRE, "agent");
            xb_add(&bar[XB_XGEN(b.x)], 1u);
            asm volatile("s_waitcnt vmcnt(0)" ::: "memory");
        } else {
            XB_SPIN(xb_ld(&bar[XB_XGEN(b.x)]) == gen, bar);
            __builtin_amdgcn_fence(__ATOMIC_ACQUIRE, "agent");
            asm volatile("s_waitcnt vmcnt(0)" ::: "memory");
        }
    }
    __syncthreads();
}

constexpr int NWAVES = 8, NTHR = 512;
constexpr int BATCH = 4, SEQ = 4096, D = 1024, M = BATCH * SEQ;
constexpr int NPROJ = 4352, LDW_IN = 4360, NMOD = 6144;
constexpr int C_QA = 0, C_KA = 512, C_VA = 640, C_QB = 768, C_KB = 1280, C_VB = 1792, C_GLA = 2304, C_GLB = 3328;
constexpr int NEXP = 16384;
constexpr float EPS = 1e-6f;

constexpr size_t MiB = 1u << 20;
constexpr size_t WS_CTL = 0, CTL_ZERO_BYTES = 1 * MiB;
constexpr size_t WS_MOD = 1 * MiB, WS_LOGF = 1 * MiB + 128 * 1024, WS_SUBK = 2 * MiB;
constexpr size_t WS_WIN = 4 * MiB, WS_WA = 12 * MiB + 512 * 1024, WS_WB = 13 * MiB + 512 * 1024, WS_WOUT = 14 * MiB + 512 * 1024, WS_WQ = 16 * MiB + 512 * 1024;
constexpr size_t WS_ED = 19 * MiB, WS_EU = 35 * MiB;
constexpr size_t WS_EDS = 2 * MiB + 512 * 1024;
constexpr size_t WS_H2Q = 95 * MiB, WS_H2S = 111 * MiB;
constexpr size_t WS_H = 83 * MiB, WS_OA = 83 * MiB, WS_OB = 99 * MiB, WS_PIDX = 83 * MiB, WS_PG = 87 * MiB;
constexpr size_t WS_PROJ = 115 * MiB, WS_X1 = 115 * MiB, WS_H2 = 179 * MiB, WS_QP = 211 * MiB;
constexpr size_t WS_END = 251 * MiB;
static_assert(WS_WIN + (size_t)NPROJ * D * 2 <= WS_WA && WS_WQ + (size_t)D * D * 2 <= WS_ED && WS_PROJ + (size_t)M * NPROJ * 2 <= WS_END, "ws map");
constexpr int CW_BAR = 4096; static_assert(CW_BAR == CW_BAR_FWD && WS_CTL == 0, "barrier words");

constexpr int RING_OFF = 0, RING_BYTES = 131072;
constexpr int LDSCTL_OFF = RING_BYTES, MISC_OFF = LDSCTL_OFF + 320;
constexpr int LDS_BYTES = 147456;

typedef float f32x16 __attribute__((ext_vector_type(16)));
typedef short s16x4 __attribute__((ext_vector_type(4)));
typedef unsigned u32x2 __attribute__((ext_vector_type(2)));
typedef float f32x2_t __attribute__((ext_vector_type(2)));
typedef __bf16 bf16x2_t __attribute__((ext_vector_type(2)));

__device__ __forceinline__ unsigned cvtpk(float lo, float hi) { f32x2_t v = {lo, hi}; bf16x2_t b = __builtin_convertvector(v, bf16x2_t); return __builtin_bit_cast(unsigned, b); }
__device__ __forceinline__ float bflo(unsigned u) { return __uint_as_float(u << 16); }
__device__ __forceinline__ float bfhi(unsigned u) { return __uint_as_float(u & 0xffff0000u); }
template <int S> __device__ __forceinline__ unsigned xorx(unsigned v, int lane) {
    if constexpr (S == 1) return (unsigned)__builtin_amdgcn_update_dpp(0, (int)v, 0xB1, 0xF, 0xF, true);
    else if constexpr (S == 2) return (unsigned)__builtin_amdgcn_update_dpp(0, (int)v, 0x4E, 0xF, 0xF, true);
    else if constexpr (S == 4) { const unsigned a = (unsigned)__builtin_amdgcn_update_dpp(0, (int)v, 0x124, 0xF, 0xF, true), b = (unsigned)__builtin_amdgcn_update_dpp(0, (int)v, 0x12C, 0xF, 0xF, true); return (lane & 4) ? a : b; }
    else if constexpr (S == 8) return (unsigned)__builtin_amdgcn_update_dpp(0, (int)v, 0x128, 0xF, 0xF, true);
    else if constexpr (S == 16) { const auto r = __builtin_amdgcn_permlane16_swap(v, v, false, false); return (lane & 16) ? r[0] : r[1]; }
    else { const auto r = __builtin_amdgcn_permlane32_swap(v, v, false, false); return (lane & 32) ? r[0] : r[1]; }
}
__device__ __forceinline__ unsigned xorx_sw(unsigned v, int lane, int s) {
    switch (s) { case 1: return xorx<1>(v, lane); case 2: return xorx<2>(v, lane); case 4: return xorx<4>(v, lane); case 8: return xorx<8>(v, lane); case 16: return xorx<16>(v, lane); default: return xorx<32>(v, lane); }
}
__device__ __forceinline__ float wave_sum_x(float v, int lane) {
    v += __uint_as_float(xorx<1>(__float_as_uint(v), lane)); v += __uint_as_float(xorx<2>(__float_as_uint(v), lane)); v += __uint_as_float(xorx<4>(__float_as_uint(v), lane));
    v += __uint_as_float(xorx<8>(__float_as_uint(v), lane)); v += __uint_as_float(xorx<16>(__float_as_uint(v), lane)); v += __uint_as_float(xorx<32>(__float_as_uint(v), lane));
    return v;
}
__device__ __forceinline__ float dppf(float v, const int ctrl_sel) { return v; }
#define DPP_F(v, CTRL) __uint_as_float(__builtin_amdgcn_update_dpp(0, __float_as_uint(v), (CTRL), 0xF, 0xF, true))
__device__ __forceinline__ float reduce8_t(const float (&dd)[8], int lane) {
    float r4[4];
#pragma unroll
    for (int u = 0; u < 4; ++u) { const auto p = __builtin_amdgcn_permlane32_swap(__float_as_uint(dd[u]), __float_as_uint(dd[u + 4]), false, false); r4[u] = __uint_as_float(p[0]) + __uint_as_float(p[1]); }
    float r2[2];
#pragma unroll
    for (int u = 0; u < 2; ++u) { const auto p = __builtin_amdgcn_permlane16_swap(__float_as_uint(r4[u]), __float_as_uint(r4[u + 2]), false, false); r2[u] = __uint_as_float(p[0]) + __uint_as_float(p[1]); }
    const bool b3 = (lane & 8) != 0;
    const float keep = b3 ? r2[1] : r2[0], send = b3 ? r2[0] : r2[1];
    float r1 = keep + DPP_F(send, 0x128);
    r1 += DPP_F(r1, 0xB1);
    r1 += DPP_F(r1, 0x4E);
    r1 += DPP_F(r1, 0x141);
    return r1;
}
__device__ __forceinline__ int lane_id() { return (int)__builtin_amdgcn_mbcnt_hi(~0u, __builtin_amdgcn_mbcnt_lo(~0u, 0u)); }
__device__ __forceinline__ float wave_sum(float v) { return wave_sum_x(v, lane_id()); }
__device__ __forceinline__ float wave_max(float v) { const int lane = lane_id();
    v = fmaxf(v, __uint_as_float(xorx<1>(__float_as_uint(v), lane))); v = fmaxf(v, __uint_as_float(xorx<2>(__float_as_uint(v), lane))); v = fmaxf(v, __uint_as_float(xorx<4>(__float_as_uint(v), lane)));
    v = fmaxf(v, __uint_as_float(xorx<8>(__float_as_uint(v), lane))); v = fmaxf(v, __uint_as_float(xorx<16>(__float_as_uint(v), lane))); v = fmaxf(v, __uint_as_float(xorx<32>(__float_as_uint(v), lane)));
    return v; }
__device__ __forceinline__ int crow(int r, int hi) { return (r & 3) + 8 * (r >> 2) + 4 * hi; }
#define MFMA32(a, b, c) __builtin_amdgcn_mfma_f32_32x32x16_bf16((a), (b), (c), 0, 0, 0)

struct Frame {
    LAS unsigned char* lds;
    int tid, lane, wave, vcu, G;
};
__device__ __forceinline__ const void* karg(int i) {
    unsigned long z = 0; asm volatile("" : "+s"(z));
    const char* base = (const char*)__builtin_amdgcn_kernarg_segment_ptr();
    return *(const void* const*)(base + 8 * i + z);
}

__device__ __forceinline__ void p0_transpose_item(const float* W, int ld, int K, int ncols, bf16* WT, int row_off, LAS float* scr, int item, int lane) {
    const int nblk = ncols / 32, kb = item / nblk, nb = item % nblk, k0 = 64 * kb, n0 = 32 * nb;
#pragma unroll 8
    for (int i = 0; i < 32; ++i) { const int kk = 2 * i + (lane >> 5); scr[kk * 33 + (lane & 31)] = __builtin_nontemporal_load(W + (size_t)(k0 + kk) * ld + n0 + (lane & 31)); }
    LDS_WAIT(); asm volatile("" ::: "memory");
    const int c = lane & 7;
#pragma unroll
    for (int j = 0; j < 4; ++j) { const int n = (lane >> 3) + 8 * j; const LAS float* s = scr + (8 * c) * 33 + n;
        v4u o; o.x = pk2(s[0 * 33], s[1 * 33]); o.y = pk2(s[2 * 33], s[3 * 33]); o.z = pk2(s[4 * 33], s[5 * 33]); o.w = pk2(s[6 * 33], s[7 * 33]);
        *(GAS v4u*)(WT + (size_t)(row_off + n0 + n) * K + k0 + 8 * c) = o; }
    LDS_WAIT(); asm volatile("" ::: "memory");
}
__device__ __forceinline__ void p0_convert(const float* __restrict__ src, bf16* __restrict__ dst, long n_iters, int gw, int NGW, int lane) {
    for (long it0 = (long)gw * 4; it0 < n_iters; it0 += (long)NGW * 4) {
        f32x4 a[4][2];
#pragma unroll
        for (int u = 0; u < 4; ++u) { const long it = it0 + u; if (it < n_iters) { const float* p = src + it * 512 + lane * 4; a[u][0] = *(const f32x4*)p; a[u][1] = *(const f32x4*)(p + 256); } }
#pragma unroll
        for (int u = 0; u < 4; ++u) { const long it = it0 + u; if (it < n_iters) { bf16* q = dst + it * 512 + lane * 4;
            u32x2 w0, w1; w0.x = cvtpk(a[u][0].x, a[u][0].y); w0.y = cvtpk(a[u][0].z, a[u][0].w); w1.x = cvtpk(a[u][1].x, a[u][1].y); w1.y = cvtpk(a[u][1].z, a[u][1].w);
            *(u32x2*)q = w0; *(u32x2*)(q + 256) = w1; } }
    }
}

__device__ __forceinline__ void p0_quant_tables(Frame& F, int gw, int NGW) {
    const float* ed = ((const float*)karg(15)); const float* eu = ((const float*)karg(16));
    unsigned char* EDq = (unsigned char*)(((unsigned char*)karg(19)) + WS_ED); unsigned char* EUq = (unsigned char*)(((unsigned char*)karg(19)) + WS_EU); float* EDS = (float*)(((unsigned char*)karg(19)) + WS_EDS);
    const int lane = F.lane;
    for (int row0 = gw * 4; row0 < NEXP; row0 += NGW * 4) {
        f32x4 a[4][4], u[4][4];
#pragma unroll
        for (int q = 0; q < 4; ++q)
#pragma unroll
            for (int j = 0; j < 4; ++j) { a[q][j] = __builtin_nontemporal_load((const f32x4*)(ed + (size_t)(row0 + q) * D) + lane + 64 * j); u[q][j] = __builtin_nontemporal_load((const f32x4*)(eu + (size_t)(row0 + q) * D) + lane + 64 * j); }
#pragma unroll
        for (int q = 0; q < 4; ++q) {
            float am = 0.f;
#pragma unroll
            for (int j = 0; j < 4; ++j) am = fmaxf(fmaxf(am, fmaxf(fabsf(a[q][j].x), fabsf(a[q][j].y))), fmaxf(fabsf(a[q][j].z), fabsf(a[q][j].w)));
            am = wave_max(am);
            const float sc = am > 0.f ? am * (1.0f / 127.0f) : 1.0f, inv = 1.0f / sc;
            v4u qa, qu;
#pragma unroll
            for (int j = 0; j < 4; ++j) {
                const int b0 = (int)rintf(a[q][j].x * inv), b1 = (int)rintf(a[q][j].y * inv), b2 = (int)rintf(a[q][j].z * inv), b3 = (int)rintf(a[q][j].w * inv);
                qa[j] = (unsigned)(b0 & 255) | ((unsigned)(b1 & 255) << 8) | ((unsigned)(b2 & 255) << 16) | ((unsigned)(b3 & 255) << 24);
                int p = __builtin_amdgcn_cvt_pk_fp8_f32(u[q][j].x * 16.0f, u[q][j].y * 16.0f, 0, false);
                p = __builtin_amdgcn_cvt_pk_fp8_f32(u[q][j].z * 16.0f, u[q][j].w * 16.0f, p, true);
                qu[j] = (unsigned)p;
            }
            __builtin_nontemporal_store(qa, (v4u*)(EDq + (size_t)(row0 + q) * D + 16 * lane));
            __builtin_nontemporal_store(qu, (v4u*)(EUq + (size_t)(row0 + q) * D + 16 * lane));
            if (lane == 0) EDS[row0 + q] = sc;
        }
    }
}
__device__ __forceinline__ void p0_prologue(Frame& F) {
    const float* c = ((const float*)karg(1)); const float* w_ada = ((const float*)karg(4)); const float* b_ada = ((const float*)karg(5));
    float* MOD = (float*)(((unsigned char*)karg(19)) + WS_MOD);
    {
        LAS float* cact = (LAS float*)(F.lds);
        LAS float* part = (LAS float*)(F.lds + 16384);
        bool did = false;
        for (int item = F.vcu; item < NMOD / 32; item += F.G) {
            if (!did) { for (int i = F.tid; i < 4096; i += NTHR) { const float cv = c[i]; cact[i] = cv / (1.0f + __expf(-cv)); } did = true; }
            __syncthreads();
            const int n0 = item * 32, col = n0 + (F.lane & 31), ksub = F.lane >> 5;
            float a0 = 0.f, a1 = 0.f, a2 = 0.f, a3 = 0.f;
#pragma unroll 16
            for (int it = 0; it < 64; ++it) { const int k = (it * 8 + F.wave) * 2 + ksub; const float w = __builtin_nontemporal_load(w_ada + (size_t)k * NMOD + col);
                a0 += cact[k] * w; a1 += cact[1024 + k] * w; a2 += cact[2048 + k] * w; a3 += cact[3072 + k] * w; }
            a0 += __shfl_xor(a0, 32); a1 += __shfl_xor(a1, 32); a2 += __shfl_xor(a2, 32); a3 += __shfl_xor(a3, 32);
            if (F.lane < 32) { part[(F.wave * 4 + 0) * 32 + F.lane] = a0; part[(F.wave * 4 + 1) * 32 + F.lane] = a1; part[(F.wave * 4 + 2) * 32 + F.lane] = a2; part[(F.wave * 4 + 3) * 32 + F.lane] = a3; }
            __syncthreads();
            if (F.tid < 128) { const int b = F.tid >> 5, cl = F.tid & 31; float s = 0.f;
#pragma unroll
                for (int w = 0; w < 8; ++w) s += part[(w * 4 + b) * 32 + cl];
                MOD[b * NMOD + n0 + cl] = s + b_ada[n0 + cl]; }
            __syncthreads();
        }
    }
    {
        const int gw = F.vcu * NWAVES + F.wave, NGW = F.G * NWAVES;
        p0_convert(((const float*)karg(14)), (bf16*)(((unsigned char*)karg(19)) + WS_SUBK), (long)(8 * 2 * 128 * 64) / 512, gw, NGW, F.lane);
    }
}
__device__ __forceinline__ void p0_transposes(Frame& F) {
    LAS float* scr = (LAS float*)(F.lds + 32768 + F.wave * 8704);
    const int gw = F.vcu * NWAVES + F.wave, NGW = F.G * NWAVES;
    constexpr int I_IN1 = (D / 64) * (2304 / 32), I_IN2 = (D / 64) * (2048 / 32), I_AB = (512 / 64) * (D / 32), I_SQ = (D / 64) * (D / 32);
    constexpr int NITEMS = I_IN1 + I_IN2 + 2 * I_AB + 2 * I_SQ;
    bf16* Win_t = (bf16*)(((unsigned char*)karg(19)) + WS_WIN);
    for (int it = gw; it < NITEMS; it += NGW) {
        int r = it;
        if (r < I_IN1) { p0_transpose_item(((const float*)karg(6)), LDW_IN, D, 2304, Win_t, 0, scr, r, F.lane); continue; } r -= I_IN1;
        if (r < I_IN2) { p0_transpose_item(((const float*)karg(6)) + 2312, LDW_IN, D, 2048, Win_t, 2304, scr, r, F.lane); continue; } r -= I_IN2;
        if (r < I_AB) { p0_transpose_item(((const float*)karg(9)), D, 512, D, (bf16*)(((unsigned char*)karg(19)) + WS_WA), 0, scr, r, F.lane); continue; } r -= I_AB;
        if (r < I_AB) { p0_transpose_item(((const float*)karg(10)), D, 512, D, (bf16*)(((unsigned char*)karg(19)) + WS_WB), 0, scr, r, F.lane); continue; } r -= I_AB;
        if (r < I_SQ) { p0_transpose_item(((const float*)karg(11)), D, D, D, (bf16*)(((unsigned char*)karg(19)) + WS_WOUT), 0, scr, r, F.lane); continue; } r -= I_SQ;
        p0_transpose_item(((const float*)karg(13)), D, D, D, (bf16*)(((unsigned char*)karg(19)) + WS_WQ), 0, scr, r, F.lane);
    }
}

__device__ __forceinline__ void p1_norm(Frame& F) {
    const float* x = ((const float*)karg(0)); const float* g1 = ((const float*)karg(2)); const float* w_in = ((const float*)karg(6)); const float* b_forget = ((const float*)karg(7));
    const float* MOD = (const float*)(((unsigned char*)karg(19)) + WS_MOD); bf16* H = (bf16*)(((unsigned char*)karg(19)) + WS_H); float* LOGF = (float*)(((unsigned char*)karg(19)) + WS_LOGF);
    LAS float* wfl = (LAS float*)(F.lds);
    { float tmp[16];
#pragma unroll
      for (int n = 0; n < 16; ++n) { const int i = F.tid + n * NTHR; tmp[n] = w_in[(size_t)(i >> 3) * LDW_IN + 2304 + (i & 7)]; }
#pragma unroll
      for (int n = 0; n < 16; ++n) { const int i = F.tid + n * NTHR; wfl[(i & 7) * 1024 + (i >> 3)] = tmp[n]; } }
    __syncthreads();
    const int gw = F.vcu * NWAVES + F.wave, NGW = F.G * NWAVES;
    for (int c = gw; c < M / 8; c += NGW) {
        const int row0 = c * 8; const float* mb = MOD + (row0 >> 12) * NMOD;
        f32x4 ga[4], sh[4];
#pragma unroll
        for (int j = 0; j < 4; ++j) { const int col = 4 * F.lane + 256 * j; const f32x4 g = *(const f32x4*)(g1 + col), sc = *(const f32x4*)(mb + 1024 + col); sh[j] = *(const f32x4*)(mb + col); ga[j] = g * (sc + 1.0f); }
        f32x4 r0[4], r1[4], r2[4];
        { const f32x4* xr = (const f32x4*)(x + (size_t)row0 * D) + F.lane;
#pragma unroll
          for (int j = 0; j < 4; ++j) r0[j] = __builtin_nontemporal_load(xr + 64 * j);
#pragma unroll
          for (int j = 0; j < 4; ++j) r1[j] = __builtin_nontemporal_load(xr + 256 + 64 * j); }
#pragma unroll
        for (int i = 0; i < 8; ++i) {
            const int row = row0 + i;
            if (i + 2 < 8) { const f32x4* xr = (const f32x4*)(x + (size_t)(row + 2) * D) + F.lane;
#pragma unroll
                for (int j = 0; j < 4; ++j) r2[j] = __builtin_nontemporal_load(xr + 64 * j); }
            float ss = 0.f;
#pragma unroll
            for (int j = 0; j < 4; ++j) ss += (r0[j].x * r0[j].x + r0[j].y * r0[j].y) + (r0[j].z * r0[j].z + r0[j].w * r0[j].w);
            ss = wave_sum(ss);
            const float rstd = 1.0f / sqrtf(ss * (1.0f / D) + EPS);
            float fl[8];
#pragma unroll
            for (int jj = 0; jj < 8; ++jj) fl[jj] = 0.f;
#pragma unroll
            for (int j = 0; j < 4; ++j) { const int col = 4 * F.lane + 256 * j;
                const f32x4 hv = (r0[j] * rstd) * ga[j] + sh[j];
                u32x2 w; w.x = cvtpk(hv.x, hv.y); w.y = cvtpk(hv.z, hv.w);
                __hip_atomic_store((unsigned long long*)(H + (size_t)row * D + col), __builtin_bit_cast(unsigned long long, w), __ATOMIC_RELAXED, __HIP_MEMORY_SCOPE_AGENT);
#pragma unroll
                for (int jj = 0; jj < 8; ++jj) { const f32x4 wv = *(const LAS f32x4*)(wfl + jj * 1024 + col); fl[jj] += (hv.x * wv.x + hv.y * wv.y) + (hv.z * wv.z + hv.w * wv.w); }
            }
            const int lane = F.lane; const float r1s = reduce8_t(fl, lane);
            if ((lane & 7) == 0) { const int jj = lane >> 3; const float z = r1s + b_forget[jj]; const float ls = fminf(z, 0.f) - log1pf(__expf(-fabsf(z))); LOGF[(size_t)row * 8 + jj] = ls; }
#pragma unroll
            for (int j = 0; j < 4; ++j) { r0[j] = r1[j]; r1[j] = r2[j]; }
        }
    }
}

constexpr int KP = 72;
constexpr int VPF = 68;
constexpr int VPS = 260;
constexpr float LOG2E = 1.4426950408889634f;
struct FlashState { f32x16 o[2]; float m, l; };

__device__ __forceinline__ void flash_tail(FlashState& st, f32x16& s0, f32x16& s1, const LAS bf16* Vs, int vp, int r32, int hi) {
    float mt = s0[0];
#pragma unroll
    for (int r = 1; r < 16; ++r) mt = fmaxf(mt, s0[r]);
#pragma unroll
    for (int r = 0; r < 16; ++r) mt = fmaxf(mt, s1[r]);
    mt = fmaxf(mt, __uint_as_float(xorx<32>(__float_as_uint(mt), 32 * hi)));
    const float mn = fmaxf(st.m, mt);
    const float alpha = __builtin_amdgcn_exp2f(st.m - mn);
    st.m = mn;
    float ps = 0.f;
#pragma unroll
    for (int r = 0; r < 16; ++r) { s0[r] = __builtin_amdgcn_exp2f(s0[r] - mn); ps += s0[r]; }
#pragma unroll
    for (int r = 0; r < 16; ++r) { s1[r] = __builtin_amdgcn_exp2f(s1[r] - mn); ps += s1[r]; }
    st.l = st.l * alpha + ps;
    if (__any(alpha != 1.0f)) {
#pragma unroll
        for (int r = 0; r < 16; ++r) { st.o[0][r] *= alpha; st.o[1][r] *= alpha; }
    }
#pragma unroll
    for (int blk = 0; blk < 2; ++blk)
#pragma unroll
        for (int s = 0; s < 2; ++s) {
            v4u pw;
            if (blk == 0) { pw.x = cvtpk(s0[8 * s + 0], s0[8 * s + 1]); pw.y = cvtpk(s0[8 * s + 2], s0[8 * s + 3]); pw.z = cvtpk(s0[8 * s + 4], s0[8 * s + 5]); pw.w = cvtpk(s0[8 * s + 6], s0[8 * s + 7]); }
            else          { pw.x = cvtpk(s1[8 * s + 0], s1[8 * s + 1]); pw.y = cvtpk(s1[8 * s + 2], s1[8 * s + 3]); pw.z = cvtpk(s1[8 * s + 4], s1[8 * s + 5]); pw.w = cvtpk(s1[8 * s + 6], s1[8 * s + 7]); }
            const bf16x8 pf = __builtin_bit_cast(bf16x8, pw);
#pragma unroll
            for (int db = 0; db < 2; ++db) {
                const LAS bf16* vp0 = Vs + (32 * db + r32) * vp + 32 * blk + 16 * s + 4 * hi;
                const s16x4 lo = *(const LAS s16x4*)vp0, hh = *(const LAS s16x4*)(vp0 + 8);
                const bf16x8 vf = __builtin_shufflevector(lo, hh, 0, 1, 2, 3, 4, 5, 6, 7);
                st.o[db] = MFMA32(vf, pf, st.o[db]);
            }
        }
}
__device__ __forceinline__ void flash_qk(f32x16& s0, f32x16& s1, const bf16x8 (&qf)[4], const LAS bf16* Ks, int r32, int hi) {
    s0 = (f32x16){0.f}; s1 = (f32x16){0.f};
#pragma unroll
    for (int r = 0; r < 16; ++r) { s0[r] = 0.f; s1[r] = 0.f; }
#pragma unroll
    for (int ks = 0; ks < 4; ++ks) {
        const bf16x8 a0 = *(const LAS bf16x8*)(Ks + r32 * KP + 16 * ks + 8 * hi);
        const bf16x8 a1 = *(const LAS bf16x8*)(Ks + (32 + r32) * KP + 16 * ks + 8 * hi);
        s0 = MFMA32(a0, qf[ks], s0); s1 = MFMA32(a1, qf[ks], s1);
    }
}
__device__ __forceinline__ void flash_qk2(f32x16& a0, f32x16& a1, f32x16& b0, f32x16& b1, const bf16x8 (&qa)[4], const bf16x8 (&qb)[4], const LAS bf16* Ks, int r32, int hi) {
#pragma unroll
    for (int r = 0; r < 16; ++r) { a0[r] = 0.f; a1[r] = 0.f; b0[r] = 0.f; b1[r] = 0.f; }
#pragma unroll
    for (int ks = 0; ks < 4; ++ks) {
        const bf16x8 k0 = *(const LAS bf16x8*)(Ks + r32 * KP + 16 * ks + 8 * hi);
        const bf16x8 k1 = *(const LAS bf16x8*)(Ks + (32 + r32) * KP + 16 * ks + 8 * hi);
        a0 = MFMA32(k0, qa[ks], a0); b0 = MFMA32(k0, qb[ks], b0); a1 = MFMA32(k1, qa[ks], a1); b1 = MFMA32(k1, qb[ks], b1);
    }
}
__device__ __forceinline__ void flash_soft(FlashState& st, f32x16& s0, f32x16& s1, int hi) {
    float mt = s0[0];
#pragma unroll
    for (int r = 1; r < 16; ++r) mt = fmaxf(mt, s0[r]);
#pragma unroll
    for (int r = 0; r < 16; ++r) mt = fmaxf(mt, s1[r]);
    mt = fmaxf(mt, __uint_as_float(xorx<32>(__float_as_uint(mt), 32 * hi)));
    const float mn = fmaxf(st.m, mt);
    const float alpha = __builtin_amdgcn_exp2f(st.m - mn);
    st.m = mn;
    float ps = 0.f;
#pragma unroll
    for (int r = 0; r < 16; ++r) { s0[r] = __builtin_amdgcn_exp2f(s0[r] - mn); ps += s0[r]; }
#pragma unroll
    for (int r = 0; r < 16; ++r) { s1[r] = __builtin_amdgcn_exp2f(s1[r] - mn); ps += s1[r]; }
    st.l = st.l * alpha + ps;
    if (__any(alpha != 1.0f)) {
#pragma unroll
        for (int r = 0; r < 16; ++r) { st.o[0][r] *= alpha; st.o[1][r] *= alpha; }
    }
}
__device__ __forceinline__ bf16x8 pack_p(const f32x16& p, int s) {
    v4u pw; pw.x = cvtpk(p[8 * s + 0], p[8 * s + 1]); pw.y = cvtpk(p[8 * s + 2], p[8 * s + 3]); pw.z = cvtpk(p[8 * s + 4], p[8 * s + 5]); pw.w = cvtpk(p[8 * s + 6], p[8 * s + 7]);
    return __builtin_bit_cast(bf16x8, pw);
}
__device__ __forceinline__ void flash_pv2(FlashState& sa, FlashState& sb, const f32x16& a0, const f32x16& a1, const f32x16& b0, const f32x16& b1, const LAS bf16* Vs, int vp, int r32, int hi) {
#pragma unroll
    for (int blk = 0; blk < 2; ++blk)
#pragma unroll
        for (int s = 0; s < 2; ++s) {
            const bf16x8 pfa = blk ? pack_p(a1, s) : pack_p(a0, s), pfb = blk ? pack_p(b1, s) : pack_p(b0, s);
#pragma unroll
            for (int db = 0; db < 2; ++db) {
                const LAS bf16* vp0 = Vs + (32 * db + r32) * vp + 32 * blk + 16 * s + 4 * hi;
                const s16x4 lo = *(const LAS s16x4*)vp0, hh = *(const LAS s16x4*)(vp0 + 8);
                const bf16x8 vf = __builtin_shufflevector(lo, hh, 0, 1, 2, 3, 4, 5, 6, 7);
                sa.o[db] = MFMA32(vf, pfa, sa.o[db]); sb.o[db] = MFMA32(vf, pfb, sb.o[db]);
            }
        }
}
__device__ __forceinline__ void flash_store(const FlashState& st, bf16* orow, int hi) {
    float lt = st.l + __uint_as_float(xorx<32>(__float_as_uint(st.l), 32 * hi));
    const float inv = 1.0f / lt;
#pragma unroll
    for (int db = 0; db < 2; ++db)
#pragma unroll
        for (int rg = 0; rg < 4; ++rg) { u32x2 w; w.x = cvtpk(st.o[db][4 * rg] * inv, st.o[db][4 * rg + 1] * inv); w.y = cvtpk(st.o[db][4 * rg + 2] * inv, st.o[db][4 * rg + 3] * inv);
            *(u32x2*)(orow + 32 * db + 8 * rg + 4 * hi) = w; }
}

constexpr int CW_FOXK = 8192;
static_assert((size_t)(CW_FOXK + 32 * 64) * 4 <= CTL_ZERO_BYTES && CW_FOXK >= CW_BAR_FWD + XCD_BAR_WORDS, "FoX key-norm words inside the zeroed control region");
__device__ __forceinline__ void fox_knorm_publish(Frame& F, int b, int h, int qb) {
    const bf16* proj = (const bf16*)(((unsigned char*)karg(19)) + WS_PROJ);
    const int tid = F.tid;
    const bf16* kb0 = proj + ((size_t)b * SEQ + 512 * qb + (tid >> 3)) * NPROJ + C_KB + 64 * h + 8 * (tid & 7);
    v4u wa[8];
#pragma unroll
    for (int i = 0; i < 8; ++i) wa[i] = *(const v4u*)(kb0 + (size_t)(64 * i) * NPROJ);
    float kn = 0.f;
#pragma unroll
    for (int i = 0; i < 8; ++i) { const unsigned wx = wa[i].x, wy = wa[i].y, wz = wa[i].z, ww = wa[i].w;
        float s = bflo(wx) * bflo(wx) + bfhi(wx) * bfhi(wx) + bflo(wy) * bflo(wy) + bfhi(wy) * bfhi(wy) + bflo(wz) * bflo(wz) + bfhi(wz) * bfhi(wz) + bflo(ww) * bflo(ww) + bfhi(ww) * bfhi(ww);
        s += __shfl_xor(s, 1); s += __shfl_xor(s, 2); s += __shfl_xor(s, 4);
        kn = fmaxf(kn, s); }
    kn = wave_max(kn);
    if (F.lane == 0) { unsigned* slot = (unsigned*)((unsigned char*)karg(19) + WS_CTL) + CW_FOXK + (b * 8 + h) * 64 + qb * 8 + F.wave;
        __hip_atomic_store(slot, __float_as_uint(kn) | 0x80000000u, __ATOMIC_RELAXED, __HIP_MEMORY_SCOPE_AGENT); }
}
__device__ __forceinline__ void fox_unit(Frame& F, int b, int h, int qb, float& kmax2) {
    const bf16* proj = (const bf16*)(((unsigned char*)karg(19)) + WS_PROJ); const float* LOGF = (const float*)(((unsigned char*)karg(19)) + WS_LOGF); bf16* OB = (bf16*)(((unsigned char*)karg(19)) + WS_OB);
    LAS float* Fs = (LAS float*)(F.lds);
    LAS float* wtot = (LAS float*)(F.lds + 16384);
    LAS bf16* Kb = (LAS bf16*)(F.lds + 16384 + 128);
    LAS bf16* Vb = (LAS bf16*)(F.lds + 16384 + 128 + 2 * 64 * KP * 2);
    const int lane = F.lane, wave = F.wave, tid = F.tid, r32 = lane & 31, hi = lane >> 5;
    const int q_end = 512 * (qb + 1), NT = q_end / 64;
    const size_t rowbase = (size_t)b * SEQ;
    if (kmax2 < 0.f) {
        float v[8]; float run = 0.f;
#pragma unroll
        for (int i = 0; i < 8; ++i) { const int pos = tid * 8 + i; const float lf = (pos < q_end) ? LOGF[(rowbase + pos) * 8 + h] : 0.f; run += lf; v[i] = run; }
        float inc = run;
#pragma unroll
        for (int o = 1; o < 64; o <<= 1) { const float t = __shfl_up(inc, o); if (lane >= o) inc += t; }
        if (lane == 63) wtot[wave] = inc;
        __syncthreads();
        float off = inc - run;
        for (int w = 0; w < wave; ++w) off += wtot[w];
#pragma unroll
        for (int i = 0; i < 8; ++i) Fs[tid * 8 + i] = -LOG2E * (v[i] + off);
    }
    const int qrow = 512 * qb + 64 * wave + r32, qrowB = qrow + 32;
    bf16x8 qf[4], qg[4];
    { const bf16* qp = proj + (rowbase + qrow) * NPROJ + C_QB + 64 * h + 8 * hi;
#pragma unroll
      for (int ks = 0; ks < 4; ++ks) { qf[ks] = *(const bf16x8*)(qp + 16 * ks); qg[ks] = *(const bf16x8*)(qp + (size_t)32 * NPROJ + 16 * ks); } }
    const int tq = 8 * qb + wave;
    LAS bf16* Qs = (LAS bf16*)(F.lds + 53248) + wave * (64 * KP);
    {
        float qn = 0.f;
#pragma unroll
        for (int ks = 0; ks < 4; ++ks)
#pragma unroll
            for (int j = 0; j < 8; ++j) { const float e = __uint_as_float(((unsigned)(unsigned short)qf[ks][j]) << 16); qn += e * e; }
        qn += __shfl_xor(qn, 32);
        { float qn2 = 0.f;
#pragma unroll
          for (int ks = 0; ks < 4; ++ks)
#pragma unroll
              for (int j = 0; j < 8; ++j) { const float e = __uint_as_float(((unsigned)(unsigned short)qg[ks][j]) << 16); qn2 += e * e; }
          qn2 += __shfl_xor(qn2, 32); qn = fmaxf(qn, qn2); }
#pragma unroll
        for (int o = 1; o < 32; o <<= 1) qn = fmaxf(qn, __shfl_xor(qn, o));
        float kn = 0.f;
        if (kmax2 < 0.f) {
            unsigned* slots = (unsigned*)((unsigned char*)karg(19) + WS_CTL) + CW_FOXK + (b * 8 + h) * 64; unsigned v, sp = 0u;
            for (;;) { v = xb_ld(slots + lane); if (__all((v >> 31) != 0u)) break; __builtin_amdgcn_s_sleep(1); if (++sp > XB_SPIN_CAP) break; }
            kn = __uint_as_float(v & 0x7fffffffu);
            kn = wave_max(kn);
        }
        if (lane == 0) { wtot[8 + wave] = qn; wtot[16 + wave] = kn; }
    }
#pragma unroll
    for (int ks = 0; ks < 4; ++ks) { *(LAS bf16x8*)(Qs + r32 * KP + 16 * ks + 8 * hi) = qf[ks]; *(LAS bf16x8*)(Qs + (32 + r32) * KP + 16 * ks + 8 * hi) = qg[ks]; }
    FlashState st, su; st.m = -INFINITY; st.l = 0.f; su.m = -INFINITY; su.l = 0.f;
#pragma unroll
    for (int r = 0; r < 16; ++r) { st.o[0][r] = 0.f; st.o[1][r] = 0.f; su.o[0][r] = 0.f; su.o[1][r] = 0.f; }
    const int srow = tid >> 3, sch = tid & 7;
    const bf16* kg = proj + (rowbase + srow) * NPROJ + C_KB + 64 * h + 8 * sch;
    const bf16* vg = proj + (rowbase + srow) * NPROJ + C_VB + 64 * h + 8 * sch;
    v4u kreg, vreg;
    { const size_t o = (size_t)(NT - 1) * 64 * NPROJ; kreg = *(const v4u*)(kg + o); vreg = *(const v4u*)(vg + o); }
    int cur = 0;
    {   *(LAS v4u*)(Kb + srow * KP + 8 * sch) = kreg;
        const unsigned short* vs = (const unsigned short*)&vreg;
#pragma unroll
        for (int i = 0; i < 8; ++i) Vb[(8 * sch + i) * VPF + srow] = vs[i];
    }
    LAS int* wdslot = (LAS int*)(wtot + 24);
    if (tid < 8) wdslot[tid] = -1;
    __syncthreads();
    int t_lo = 0;
    {
        float qm = 0.f, km = 0.f;
#pragma unroll
        for (int w = 0; w < 8; ++w) { qm = fmaxf(qm, wtot[8 + w]); km = fmaxf(km, wtot[16 + w]); }
        if (kmax2 < 0.f) kmax2 = km;
        const float A = 0.125f * sqrtf(qm) * sqrtf(kmax2) * 1.01f, f0 = Fs[512 * qb];
        for (int t = NT - 9; t >= 0; --t) if (f0 - Fs[64 * t + 63] > (2.0f * A + 30.0f) * LOG2E) { t_lo = t + 1; break; }
    }
    const float A2w = 0.125f * sqrtf(wtot[8 + wave]) * sqrtf(kmax2) * 1.01f * LOG2E;
    bool wfin = false;
    for (int t = NT - 1; t >= t_lo; --t) {
        if (t > t_lo) { const size_t o = (size_t)(t - 1) * 64 * NPROJ; kreg = *(const v4u*)(kg + o); vreg = *(const v4u*)(vg + o); }
        if (!wfin && t < tq) { const float bound = A2w + Fs[64 * t + 63];
            if (__all(bound < fminf(st.m, su.m) - 30.0f * LOG2E)) { wfin = true; if (lane == 0) wdslot[wave] = t; } }
        if (t <= tq && !wfin) {
            const LAS bf16* Ks = Kb + cur * 64 * KP; const LAS bf16* Vs = Vb + cur * 64 * VPF;
            bf16x8 qa[4], qb4[4];
#pragma unroll
            for (int ks = 0; ks < 4; ++ks) { qa[ks] = *(const LAS bf16x8*)(Qs + r32 * KP + 16 * ks + 8 * hi); qb4[ks] = *(const LAS bf16x8*)(Qs + (32 + r32) * KP + 16 * ks + 8 * hi); }
            f32x16 s0, s1, u0, u1; flash_qk2(s0, s1, u0, u1, qa, qb4, Ks, r32, hi);
            const LAS float* Fk = Fs + 64 * t;
            constexpr float C = 0.125f * LOG2E;
#pragma unroll
            for (int rg = 0; rg < 4; ++rg) {
                const f32x4 f0 = *(const LAS f32x4*)(Fk + 8 * rg + 4 * hi), f1 = *(const LAS f32x4*)(Fk + 32 + 8 * rg + 4 * hi);
#pragma unroll
                for (int i = 0; i < 4; ++i) { const int r = 4 * rg + i;
                    s0[r] = fmaf(s0[r], C, f0[i]); s1[r] = fmaf(s1[r], C, f1[i]); u0[r] = fmaf(u0[r], C, f0[i]); u1[r] = fmaf(u1[r], C, f1[i]); }
            }
            if (t == tq) {
#pragma unroll
                for (int r = 0; r < 16; ++r) { const int kv = 64 * t + crow(r, hi);
                    s0[r] = (kv > qrow) ? -INFINITY : s0[r]; s1[r] = (kv + 32 > qrow) ? -INFINITY : s1[r];
                    u0[r] = (kv > qrowB) ? -INFINITY : u0[r]; u1[r] = (kv + 32 > qrowB) ? -INFINITY : u1[r]; }
            }
            flash_soft(st, s0, s1, hi); flash_soft(su, u0, u1, hi);
            flash_pv2(st, su, s0, s1, u0, u1, Vs, VPF, r32, hi);
        }
        if (t > t_lo) {
            const int nb = cur ^ 1;
            *(LAS v4u*)(Kb + nb * 64 * KP + srow * KP + 8 * sch) = kreg;
            const unsigned short* vs = (const unsigned short*)&vreg;
#pragma unroll
            for (int i = 0; i < 8; ++i) Vb[nb * 64 * VPF + (8 * sch + i) * VPF + srow] = vs[i];
        }
        __syncthreads();
        cur ^= 1;
        { int mn = wdslot[0];
#pragma unroll
          for (int w = 1; w < 8; ++w) mn = min(mn, wdslot[w]);
          if (mn >= t) break; }
    }
    flash_store(st, OB + (rowbase + qrow) * 512 + 64 * h, hi); flash_store(su, OB + (rowbase + qrowB) * 512 + 64 * h, hi);
    __syncthreads();
}

__device__ const unsigned char T5_BUCKET[128] = {0,1,2,3,4,5,6,7,8,9,10,11,12,13,14,15,16,16,16,17,17,18,18,18,19,19,19,20,20,20,20,21,21,21,21,22,22,22,22,22,23,23,23,23,23,23,24,24,24,24,24,24,25,25,25,25,25,25,25,26,26,26,26,26,26,26,26,27,27,27,27,27,27,27,27,27,27,28,28,28,28,28,28,28,28,28,28,29,29,29,29,29,29,29,29,29,29,29,29,30,30,30,30,30,30,30,30,30,30,30,30,30,30,31,31,31,31,31,31,31,31,31,31,31,31,31,31,31};

__device__ __forceinline__ void swa_unit(Frame& F, int b, int kvh, int n) {
    const bf16* proj = (const bf16*)(((unsigned char*)karg(19)) + WS_PROJ); bf16* OA = (bf16*)(((unsigned char*)karg(19)) + WS_OA);
    const float* sinks = ((const float*)karg(8)); const float* rel_bias = ((const float*)karg(12));
    LAS bf16* Kb = (LAS bf16*)(F.lds);
    LAS bf16* Vb = (LAS bf16*)(F.lds + 36864);
    LAS float* bt = (LAS float*)(F.lds + 36864 + 33280);
    const int lane = F.lane, wave = F.wave, tid = F.tid, r32 = lane & 31, hi = lane >> 5;
    const size_t rowbase = (size_t)b * SEQ;
    {
        const int g = tid >> 7, d = tid & 127;
        bt[tid] = LOG2E * rel_bias[(int)T5_BUCKET[d] * 8 + kvh * 4 + g];
#pragma unroll
        for (int i = 0; i < 4; ++i) {
            const int idx = tid + i * NTHR, kb = idx >> 3, sch = idx & 7; const int pos = 128 * (n - 1) + kb;
            v4u kreg = (v4u){0u, 0u, 0u, 0u}, vreg = (v4u){0u, 0u, 0u, 0u};
            if (pos >= 0) { const bf16* p = proj + (rowbase + pos) * NPROJ + 64 * kvh + 8 * sch; kreg = *(const v4u*)(p + C_KA); vreg = *(const v4u*)(p + C_VA); }
            *(LAS v4u*)(Kb + kb * KP + 8 * sch) = kreg;
            const unsigned short* vs = (const unsigned short*)&vreg;
#pragma unroll
            for (int j = 0; j < 8; ++j) Vb[(8 * sch + j) * VPS + kb] = vs[j];
        }
    }
    __syncthreads();
    const int g = wave & 3, qh = wave >> 2, head = kvh * 4 + g;
    const LAS float* btg = bt + g * 128;
    for (int sb = 0; sb < 2; ++sb) {
        const int qrel0 = 64 * qh + 32 * sb, qrel = qrel0 + r32;
        const size_t row = rowbase + 128 * n + qrel;
        bf16x8 qf[4];
        { const bf16* qp = proj + row * NPROJ + C_QA + 64 * head + 8 * hi;
#pragma unroll
          for (int ks = 0; ks < 4; ++ks) qf[ks] = *(const bf16x8*)(qp + 16 * ks); }
        FlashState st; st.m = LOG2E * sinks[head]; st.l = (hi == 0) ? 1.0f : 0.0f;
#pragma unroll
        for (int r = 0; r < 16; ++r) { st.o[0][r] = 0.f; st.o[1][r] = 0.f; }
        const int t_hi = (qrel0 + 159) >> 6; int t_lo = (qrel0 + 1) >> 6;
        if (n == 0 && t_lo < 2) t_lo = 2;
        for (int t = t_lo; t <= t_hi; ++t) {
            f32x16 s0, s1; flash_qk(s0, s1, qf, Kb + t * 64 * KP, r32, hi);
            const int X = 128 + qrel - 64 * t - 4 * hi;
#pragma unroll
            for (int rg = 0; rg < 4; ++rg) {
                const LAS float* bp = btg + (X - 8 * rg - 35);
#pragma unroll
                for (int i = 0; i < 4; ++i) { const int r = 4 * rg + i; const int d0 = X - 8 * rg - i;
                    const float b0 = bp[35 - i], b1 = bp[3 - i];
                    s0[r] = ((unsigned)d0 < 128u) ? fmaf(s0[r], 0.125f * LOG2E, b0) : -INFINITY;
                    s1[r] = ((unsigned)(d0 - 32) < 128u) ? fmaf(s1[r], 0.125f * LOG2E, b1) : -INFINITY; }
            }
            flash_tail(st, s0, s1, Vb + 64 * t, VPS, r32, hi);
        }
        flash_store(st, OA + row * 512 + 64 * head, hi);
    }
    __syncthreads();
}
__device__ __forceinline__ void p3_attention(Frame& F) {
    for (int item = F.vcu; item < 256; item += F.G) fox_knorm_publish(F, item >> 6, (item >> 3) & 7, item & 7);
    for (int item = F.vcu; item < 256; item += F.G) {
        swa_unit(F, item >> 6, (item >> 5) & 1, item & 31);
        F.lane = lane_fresh(); F.tid = F.wave * 64 + F.lane;
        const int bh = item >> 3, j = item & 7;
        float kmax2 = -1.0f;
        fox_unit(F, bh >> 3, bh & 7, j, kmax2);
    }
}

struct PairOrder {
    pg8::StaticOrder S;
    __device__ bool next(int i, pg8::Unit& u) const { if (!S.next(i >> 1, u)) return false; u.src = i & 1; return true; }
    __device__ __forceinline__ void a_ready(const pg8::Unit&) const {}
    __device__ __forceinline__ void done(const pg8::Unit&) const {}
};
__device__ __forceinline__ float sigmoidf_(float z) { return 1.0f / (1.0f + __expf(-z)); }
struct EpiGate {
    static constexpr bool PERM = true, AFTER_DRAIN = false, CHAIN = true;
    const bf16* proj; bf16* mixed;
    __device__ __forceinline__ void operator()(pg8::f32x4 (&acc)[2][2][4][2], const pg8::Unit& u, int wr, int wc, int fr, int fq) const {
#pragma unroll
        for (int ai = 0; ai < 2; ++ai) {
            v4u gbv[4][2], gav[4][2];
#pragma unroll
            for (int m = 0; m < 4; ++m) { const size_t row = (size_t)u.pm * 256 + ai * 128 + wr * 64 + m * 16 + fr;
#pragma unroll
                for (int bj = 0; bj < 2; ++bj) { const int col0 = u.pn * 256 + bj * 128 + wc * 32 + 8 * fq;
                    gbv[m][bj] = *(const v4u*)(proj + row * NPROJ + C_GLB + col0);
                    if (u.src == 0) gav[m][bj] = __builtin_nontemporal_load((const v4u*)(proj + row * NPROJ + C_GLA + col0)); } }
#pragma unroll
            for (int m = 0; m < 4; ++m) { const size_t row = (size_t)u.pm * 256 + ai * 128 + wr * 64 + m * 16 + fr;
#pragma unroll
                for (int bj = 0; bj < 2; ++bj) { const int col0 = u.pn * 256 + bj * 128 + wc * 32 + 8 * fq;
                    const unsigned gbw[4] = {gbv[m][bj].x, gbv[m][bj].y, gbv[m][bj].z, gbv[m][bj].w};
                    if (u.src == 0) {
                        const unsigned gaw[4] = {gav[m][bj].x, gav[m][bj].y, gav[m][bj].z, gav[m][bj].w};
#pragma unroll
                        for (int e = 0; e < 8; ++e) { const float za = (e & 1) ? bfhi(gaw[e >> 1]) : bflo(gaw[e >> 1]), zb = (e & 1) ? bfhi(gbw[e >> 1]) : bflo(gbw[e >> 1]);
                            const float ratio = (1.0f + __expf(-zb)) * __builtin_amdgcn_rcpf(1.0f + __expf(-za));
                            acc[ai][bj][m][e >> 2][e & 3] *= ratio; }
                    } else {
                        float v[8];
#pragma unroll
                        for (int e = 0; e < 8; ++e) { const float zb = (e & 1) ? bfhi(gbw[e >> 1]) : bflo(gbw[e >> 1]); v[e] = acc[ai][bj][m][e >> 2][e & 3] * __builtin_amdgcn_rcpf(1.0f + __expf(-zb)); }
                        v4u w; w.x = cvtpk(v[0], v[1]); w.y = cvtpk(v[2], v[3]); w.z = cvtpk(v[4], v[5]); w.w = cvtpk(v[6], v[7]);
                        *(v4u*)(mixed + row * D + col0) = w;
                    }
                }
            }
        }
    }
};
struct EpiRes {
    static constexpr bool PERM = true, AFTER_DRAIN = false, CHAIN = false;
    const float* x; const float* mod; bf16* x1;
    __device__ __forceinline__ void operator()(const pg8::f32x4 (&acc)[2][2][4][2], const pg8::Unit& u, int wr, int wc, int fr, int fq) const {
        const int b = (u.pm * 256) >> 12;
        pg8::f32x4 gt[2][2];
#pragma unroll
        for (int bj = 0; bj < 2; ++bj)
#pragma unroll
            for (int n = 0; n < 2; ++n) gt[bj][n] = *(const pg8::f32x4*)(mod + b * NMOD + 2048 + u.pn * 256 + bj * 128 + wc * 32 + 8 * fq + 4 * n);
#pragma unroll
        for (int ai = 0; ai < 2; ++ai) {
            pg8::f32x4 xin[4][2][2];
#pragma unroll
            for (int m = 0; m < 4; ++m) { const size_t row = (size_t)u.pm * 256 + ai * 128 + wr * 64 + m * 16 + fr;
#pragma unroll
                for (int bj = 0; bj < 2; ++bj)
#pragma unroll
                    for (int n = 0; n < 2; ++n) xin[m][bj][n] = __builtin_nontemporal_load((const pg8::f32x4*)(x + row * D + u.pn * 256 + bj * 128 + wc * 32 + 8 * fq + 4 * n)); }
#pragma unroll
            for (int m = 0; m < 4; ++m) { const size_t row = (size_t)u.pm * 256 + ai * 128 + wr * 64 + m * 16 + fr;
#pragma unroll
                for (int bj = 0; bj < 2; ++bj) { const pg8::f32x4 v0 = xin[m][bj][0] + gt[bj][0] * acc[ai][bj][m][0], v1 = xin[m][bj][1] + gt[bj][1] * acc[ai][bj][m][1];
                    v4u w; w.x = cvtpk(v0.x, v0.y); w.y = cvtpk(v0.z, v0.w); w.z = cvtpk(v1.x, v1.y); w.w = cvtpk(v1.z, v1.w);
                    *(v4u*)(x1 + row * D + u.pn * 256 + bj * 128 + wc * 32 + 8 * fq) = w; } }
        }
    }
};

__device__ __forceinline__ void p6_norm2(Frame& F) {
    const bf16* x1 = (const bf16*)(((unsigned char*)karg(19)) + WS_X1); const float* g2 = ((const float*)karg(3)); const float* MOD = (const float*)(((unsigned char*)karg(19)) + WS_MOD); bf16* H2 = (bf16*)(((unsigned char*)karg(19)) + WS_H2); unsigned char* H2Q = (unsigned char*)(((unsigned char*)karg(19)) + WS_H2Q); float* H2S = (float*)(((unsigned char*)karg(19)) + WS_H2S);
    const int gw = F.vcu * NWAVES + F.wave, NGW = F.G * NWAVES;
    for (int c = gw; c < M / 8; c += NGW) {
        const int row0 = c * 8; const float* mb = MOD + (row0 >> 12) * NMOD;
        f32x4 ga[4], sh[4];
#pragma unroll
        for (int j = 0; j < 4; ++j) { const int col = 4 * F.lane + 256 * j; const f32x4 g = *(const f32x4*)(g2 + col), sc = *(const f32x4*)(mb + 4096 + col); sh[j] = *(const f32x4*)(mb + 3072 + col); ga[j] = g * (sc + 1.0f); }
        u32x2 r0[4], r1[4], r2[4];
        { const u32x2* xr = (const u32x2*)(x1 + (size_t)row0 * D) + F.lane;
#pragma unroll
          for (int j = 0; j < 4; ++j) r0[j] = xr[64 * j];
#pragma unroll
          for (int j = 0; j < 4; ++j) r1[j] = xr[256 + 64 * j]; }
#pragma unroll
        for (int i = 0; i < 8; ++i) {
            const int row = row0 + i;
            if (i + 2 < 8) { const u32x2* xr = (const u32x2*)(x1 + (size_t)(row + 2) * D) + F.lane;
#pragma unroll
                for (int j = 0; j < 4; ++j) r2[j] = xr[64 * j]; }
            f32x4 hq[4], xv[4]; float ss = 0.f;
#pragma unroll
            for (int j = 0; j < 4; ++j) { xv[j].x = bflo(r0[j].x); xv[j].y = bfhi(r0[j].x); xv[j].z = bflo(r0[j].y); xv[j].w = bfhi(r0[j].y);
                ss += (xv[j].x * xv[j].x + xv[j].y * xv[j].y) + (xv[j].z * xv[j].z + xv[j].w * xv[j].w); }
            ss = wave_sum(ss);
            const float rstd = 1.0f / sqrtf(ss * (1.0f / D) + EPS);
#pragma unroll
            for (int j = 0; j < 4; ++j) { const int col = 4 * F.lane + 256 * j;
                const f32x4 hv = (xv[j] * rstd) * ga[j] + sh[j];
                u32x2 w; w.x = cvtpk(hv.x, hv.y); w.y = cvtpk(hv.z, hv.w);
                __hip_atomic_store((unsigned long long*)(H2 + (size_t)row * D + col), __builtin_bit_cast(unsigned long long, w), __ATOMIC_RELAXED, __HIP_MEMORY_SCOPE_AGENT); hq[j] = hv; }
            float am = 0.f;
#pragma unroll
            for (int j = 0; j < 4; ++j) am = fmaxf(fmaxf(am, fmaxf(fabsf(hq[j].x), fabsf(hq[j].y))), fmaxf(fabsf(hq[j].z), fabsf(hq[j].w)));
            am = wave_max(am);
            const float sc = am > 0.f ? am * (1.0f / 127.0f) : 1.0f, inv = 1.0f / sc;
            v4u qa;
#pragma unroll
            for (int j = 0; j < 4; ++j) { const int b0 = (int)rintf(hq[j].x * inv), b1 = (int)rintf(hq[j].y * inv), b2 = (int)rintf(hq[j].z * inv), b3 = (int)rintf(hq[j].w * inv);
                qa[j] = (unsigned)(b0 & 255) | ((unsigned)(b1 & 255) << 8) | ((unsigned)(b2 & 255) << 16) | ((unsigned)(b3 & 255) << 24); }
            __builtin_nontemporal_store(qa, (v4u*)(H2Q + (size_t)row * D + 16 * F.lane));
            if (F.lane == 0) H2S[row] = sc;
#pragma unroll
            for (int j = 0; j < 4; ++j) { r0[j] = r1[j]; r1[j] = r2[j]; }
        }
    }
}

__device__ __forceinline__ unsigned f2ord(float f) { const unsigned u = __float_as_uint(f); return u ^ ((unsigned)((int)u >> 31) | 0x80000000u); }
__device__ __forceinline__ float ord2f(unsigned o) { const unsigned u = (o & 0x80000000u) ? (o & 0x7fffffffu) : ~o; return __uint_as_float(u); }
#define CE_DESC(a, b) do { const unsigned _x = (a), _y = (b); (a) = _x > _y ? _x : _y; (b) = _x > _y ? _y : _x; } while (0)
__device__ __forceinline__ void sort16(unsigned (&k)[16]) {
    CE_DESC(k[0], k[13]); CE_DESC(k[1], k[12]); CE_DESC(k[2], k[15]); CE_DESC(k[3], k[14]); CE_DESC(k[4], k[8]); CE_DESC(k[5], k[6]); CE_DESC(k[7], k[11]); CE_DESC(k[9], k[10]);
    CE_DESC(k[0], k[5]); CE_DESC(k[1], k[7]); CE_DESC(k[2], k[9]); CE_DESC(k[3], k[4]); CE_DESC(k[6], k[13]); CE_DESC(k[8], k[14]); CE_DESC(k[10], k[15]); CE_DESC(k[11], k[12]);
    CE_DESC(k[0], k[1]); CE_DESC(k[2], k[3]); CE_DESC(k[4], k[5]); CE_DESC(k[6], k[8]); CE_DESC(k[7], k[9]); CE_DESC(k[10], k[11]); CE_DESC(k[12], k[13]); CE_DESC(k[14], k[15]);
    CE_DESC(k[0], k[2]); CE_DESC(k[1], k[3]); CE_DESC(k[4], k[10]); CE_DESC(k[5], k[11]); CE_DESC(k[6], k[7]); CE_DESC(k[8], k[9]); CE_DESC(k[12], k[14]); CE_DESC(k[13], k[15]);
    CE_DESC(k[1], k[2]); CE_DESC(k[3], k[12]); CE_DESC(k[4], k[6]); CE_DESC(k[5], k[7]); CE_DESC(k[8], k[10]); CE_DESC(k[9], k[11]); CE_DESC(k[13], k[14]);
    CE_DESC(k[1], k[4]); CE_DESC(k[2], k[6]); CE_DESC(k[5], k[8]); CE_DESC(k[7], k[10]); CE_DESC(k[9], k[13]); CE_DESC(k[11], k[14]);
    CE_DESC(k[2], k[4]); CE_DESC(k[3], k[6]); CE_DESC(k[9], k[12]); CE_DESC(k[11], k[13]);
    CE_DESC(k[3], k[5]); CE_DESC(k[6], k[8]); CE_DESC(k[7], k[9]); CE_DESC(k[10], k[12]);
    CE_DESC(k[3], k[4]); CE_DESC(k[5], k[6]); CE_DESC(k[7], k[8]); CE_DESC(k[9], k[10]); CE_DESC(k[11], k[12]);
    CE_DESC(k[6], k[7]); CE_DESC(k[8], k[9]);
}
__device__ __forceinline__ void merge16(unsigned (&a)[16], const unsigned (&b)[16]) {
#pragma unroll
    for (int i = 0; i < 16; ++i) a[i] = a[i] > b[15 - i] ? a[i] : b[15 - i];
#pragma unroll
    for (int stride = 8; stride > 0; stride >>= 1)
#pragma unroll
        for (int i = 0; i < 16; ++i) { const int j = i ^ stride; if (j > i) CE_DESC(a[i], a[j]); }
}
__device__ __forceinline__ void top16_of_64(unsigned (&g0)[16], unsigned (&g1)[16], unsigned (&g2)[16], unsigned (&g3)[16]) {
    sort16(g0); sort16(g1); sort16(g2); sort16(g3);
    merge16(g0, g1); merge16(g2, g3); merge16(g0, g2);
}
constexpr int NCAND = 50;
__device__ __forceinline__ void p8a_topk(Frame& F) {
    const bf16* QP = (const bf16*)(((unsigned char*)karg(19)) + WS_QP); const bf16* SUBK = (const bf16*)(((unsigned char*)karg(19)) + WS_SUBK);
    unsigned short* PIDX = (unsigned short*)(((unsigned char*)karg(19)) + WS_PIDX); float* PG = (float*)(((unsigned char*)karg(19)) + WS_PG);
    LAS unsigned short* Elds = (LAS unsigned short*)(F.lds) + F.wave * (NCAND * 64);
    const int lane = F.lane, r32 = lane & 31, hi = lane >> 5;
    const int gw = F.vcu * NWAVES + F.wave, NGW = F.G * NWAVES;
    for (int it2 = 0; it2 < 2 * ((M / 64 - F.vcu + F.G - 1) / F.G); ++it2) {
        const int wi = F.vcu + (it2 >> 1) * F.G;
        const int tile = 2 * wi + (it2 & 1);
        const int tok = tile * 32 + r32;
        { const int h = F.wave;
            unsigned top[2][16];
#pragma unroll
            for (int p = 0; p < 2; ++p) {
                bf16x8 qf[4];
                { const bf16* qp = QP + (size_t)tok * D + h * 128 + p * 64 + 8 * hi;
#pragma unroll
                  for (int ks = 0; ks < 4; ++ks) qf[ks] = *(const bf16x8*)(qp + 16 * ks); }
                const bf16* kp = SUBK + (size_t)((h * 2 + p) * 128 + r32) * 64 + 8 * hi;
                unsigned kk[4][16];
#pragma unroll
                for (int blk = 0; blk < 4; ++blk) {
                    f32x16 acc;
#pragma unroll
                    for (int r = 0; r < 16; ++r) acc[r] = 0.f;
#pragma unroll
                    for (int ks = 0; ks < 4; ++ks) { const bf16x8 a = *(const bf16x8*)(kp + (size_t)blk * 32 * 64 + 16 * ks); acc = MFMA32(a, qf[ks], acc); }
#pragma unroll
                    for (int r = 0; r < 16; ++r) { const int key = 32 * blk + crow(r, hi); kk[blk][r] = (f2ord(acc[r]) & ~127u) | (unsigned)(127 - key); }
                }
                top16_of_64(kk[0], kk[1], kk[2], kk[3]);
                unsigned other[16];
#pragma unroll
                for (int i = 0; i < 16; ++i) other[i] = xorx<32>(kk[0][i], lane);
                merge16(kk[0], other);
#pragma unroll
                for (int i = 0; i < 16; ++i) top[p][i] = kk[0][i];
            }
            float s1[16], s2[16]; unsigned i1[16], i2[16];
#pragma unroll
            for (int i = 0; i < 16; ++i) { s1[i] = ord2f(top[0][i] & ~127u); i1[i] = 127u - (top[0][i] & 127u); s2[i] = ord2f(top[1][i] & ~127u); i2[i] = 127u - (top[1][i] & 127u); }
            unsigned ck[2][16];
#pragma unroll
            for (int j = 0; j < 32; ++j) {
                if (2 * j < NCAND) { constexpr int CA[NCAND] = {0,0,0,0,0,0,0,0,0,0,0,0,0,0,0,0,1,1,1,1,1,1,1,1,2,2,2,2,2,3,3,3,3,4,4,4,5,5,6,6,7,7,8,9,10,11,12,13,14,15}; constexpr int CB[NCAND] = {0,1,2,3,4,5,6,7,8,9,10,11,12,13,14,15,0,1,2,3,4,5,6,7,0,1,2,3,4,0,1,2,3,0,1,2,0,1,0,1,0,1,0,0,0,0,0,0,0,0};
                    const int a0 = CA[2 * j], b0 = CB[2 * j], a1 = CA[2 * j + 1], b1 = CB[2 * j + 1];
                    const float sa = hi ? s1[a1] : s1[a0], sb = hi ? s2[b1] : s2[b0];
                    const unsigned ia = hi ? i1[a1] : i1[a0], ib = hi ? i2[b1] : i2[b0];
                    ck[j >> 4][j & 15] = (f2ord(sa + sb) & ~63u) | (unsigned)(63 - 2 * j - hi);
                    Elds[(2 * j + hi) * 64 + lane] = (unsigned short)(ia * 128u + ib); }
                else ck[j >> 4][j & 15] = 0u;
            }
            sort16(ck[0]); sort16(ck[1]); merge16(ck[0], ck[1]);
            { unsigned oth[16];
#pragma unroll
              for (int i = 0; i < 16; ++i) oth[i] = xorx<32>(ck[0][i], lane);
              merge16(ck[0], oth); }
            float w[16]; float wsum = 0.f; const float v0 = ord2f(ck[0][0] & ~63u);
#pragma unroll
            for (int r = 0; r < 16; ++r) { w[r] = __expf(ord2f(ck[0][r] & ~63u) - v0); wsum += w[r]; }
            const float winv = 1.0f / wsum;
#pragma unroll
            for (int r = 0; r < 16; ++r) if ((r >> 3) == hi) {
                const int c = 63 - (int)(ck[0][r] & 63u);
                const unsigned short eid = Elds[c * 64 + r32 + 32 * (c & 1)];
                PIDX[(size_t)tok * 128 + h * 16 + r] = eid; PG[(size_t)tok * 128 + h * 16 + r] = w[r] * winv; }
        }
    }
}

__device__ __forceinline__ float gelu_erf(float v) { return 0.5f * v * (1.0f + erff(v * 0.70710678118654752f)); }

#define PROBE_REPA 1
#define PROBE_REPB 1
constexpr int NR = 8, RSH = 18, BSA = 8, BSB = 8, ELP = 136, TPS = 8; static_assert(BSA == 8 && BSB == 8, "whole batches of 8");
__device__ __forceinline__ void sort128(unsigned& e0, unsigned& e1, int lane) {
#pragma unroll
    for (int size = 2; size <= 128; size <<= 1) {
#pragma unroll
        for (int stride = size >> 1; stride > 0; stride >>= 1) {
            if (stride == 64) { const unsigned lo = e0 < e1 ? e0 : e1, hi = e0 < e1 ? e1 : e0; e0 = lo; e1 = hi; }
            else {
                const bool lower = (lane & stride) == 0;
                const bool asc0 = (size == 128) ? true : (size == 64 ? true : ((lane & size) == 0));
                const bool asc1 = (size == 128) ? true : (size == 64 ? false : ((lane & size) == 0));
                const unsigned p0 = xorx_sw(e0, lane, stride), p1 = xorx_sw(e1, lane, stride);
                const unsigned mn0 = e0 < p0 ? e0 : p0, mx0 = e0 < p0 ? p0 : e0, mn1 = e1 < p1 ? e1 : p1, mx1 = e1 < p1 ? p1 : e1;
                e0 = (lower == asc0) ? mn0 : mx0; e1 = (lower == asc1) ? mn1 : mx1;
            }
        }
    }
}
template <int BS> __device__ __forceinline__ void sw_issue(v4u (&buf)[BS], const LAS unsigned* el, const unsigned char* tab, unsigned voff) {
#pragma unroll
    for (int i = 0; i < BS; ++i) { const unsigned off = (el[i] << 10) + voff;
        buf[i] = *(const v4u*)(tab + off); }
}
template <int BS> __device__ __forceinline__ void sw_proc_a(const v4u (&buf)[BS], const v4u& hq, LAS float* wl, int s, int n, int lane) {
    const int hx = (int)hq.x, hy = (int)hq.y, hz = (int)hq.z, hw = (int)hq.w;
    float dd[8];
#pragma unroll
    for (int i = 0; i < 8; ++i) dd[i] = 0.f;
#pragma unroll
    for (int i = 0; i < BS; ++i) { const int dx = (int)buf[i].x, dy = (int)buf[i].y, dz = (int)buf[i].z, dw = (int)buf[i].w;
        int t = __builtin_amdgcn_sdot4(hx, dx, 0, false); t = __builtin_amdgcn_sdot4(hy, dy, t, false); t = __builtin_amdgcn_sdot4(hz, dz, t, false); t = __builtin_amdgcn_sdot4(hw, dw, t, false);
        dd[i] = (float)t; }
    const float r1 = reduce8_t(dd, lane);
    if ((lane & 7) == 0) wl[s + (lane >> 3)] = r1;
}
typedef _Float16 h2_t __attribute__((ext_vector_type(2)));
#define CVT_H2_FP8(u, hi) __builtin_bit_cast(h2_t, __builtin_amdgcn_cvt_scalef32_pk_f16_fp8((u), 1.0f, (hi)))
template <int BS> __device__ __forceinline__ void sw_proc_b(const v4u (&buf)[BS], h2_t (&acc)[8], const LAS float* wl, int s, int n) {
    float wr[BS];
#pragma unroll
    for (int i = 0; i < BS; ++i) wr[i] = wl[s + i];
#pragma unroll
    for (int i = 0; i < BS; ++i) {
        const h2_t wv = __builtin_bit_cast(h2_t, wr[i]);
        const unsigned ux = buf[i].x, uy = buf[i].y, uz = buf[i].z, uw = buf[i].w;
        acc[0] = __builtin_elementwise_fma(CVT_H2_FP8(ux, false), wv, acc[0]); acc[1] = __builtin_elementwise_fma(CVT_H2_FP8(ux, true), wv, acc[1]);
        acc[2] = __builtin_elementwise_fma(CVT_H2_FP8(uy, false), wv, acc[2]); acc[3] = __builtin_elementwise_fma(CVT_H2_FP8(uy, true), wv, acc[3]);
        acc[4] = __builtin_elementwise_fma(CVT_H2_FP8(uz, false), wv, acc[4]); acc[5] = __builtin_elementwise_fma(CVT_H2_FP8(uz, true), wv, acc[5]);
        acc[6] = __builtin_elementwise_fma(CVT_H2_FP8(uw, false), wv, acc[6]); acc[7] = __builtin_elementwise_fma(CVT_H2_FP8(uw, true), wv, acc[7]); }
}
__device__ __forceinline__ void sw_warm(v4u (&pf)[4], const unsigned char* tab, int range, int lw, unsigned voff) {
#pragma unroll
    for (int i = 0; i < 4; ++i) { const unsigned off = ((unsigned)(range * 1024 + lw * 4 + i) << 10) + voff; pf[i] = *(const v4u*)(tab + off); }
}
__device__ __forceinline__ void sw_warm_done(const v4u (&pf)[4]) {
#pragma unroll
    for (int i = 0; i < 4; ++i) asm volatile("" :: "v"(pf[i]));
}
template <int FAKE> __device__ __forceinline__ void p8b_sweep(Frame& F) {
    const bf16* X1 = (const bf16*)(((unsigned char*)karg(19)) + WS_X1); const float* MOD = (const float*)(((unsigned char*)karg(19)) + WS_MOD);
    const unsigned char* H2Q = (const unsigned char*)(((unsigned char*)karg(19)) + WS_H2Q); const float* H2S = (const float*)(((unsigned char*)karg(19)) + WS_H2S);
    const unsigned char* EDq = (const unsigned char*)(((unsigned char*)karg(19)) + WS_ED); const unsigned char* EUq = (const unsigned char*)(((unsigned char*)karg(19)) + WS_EU); const float* EDS = (const float*)(((unsigned char*)karg(19)) + WS_EDS);
    const unsigned short* PIDX = (const unsigned short*)(((unsigned char*)karg(19)) + WS_PIDX); const float* PG = (const float*)(((unsigned char*)karg(19)) + WS_PG);
    const float* fg = ((const float*)karg(17));
    const int gw = F.vcu * NWAVES + F.wave, NGW = F.G * NWAVES;
    for (int wi = F.vcu; wi < M / 64; wi += F.G) {
        const int tb = wi * 8 + F.wave;
        unsigned ones = ~0u; asm volatile("" : "+s"(ones));
        int lane = (int)__builtin_amdgcn_mbcnt_hi(ones, __builtin_amdgcn_mbcnt_lo(ones, 0u)); asm volatile("" : "+v"(lane));
        const int tok0 = tb * 8;
        unsigned E0[8], E1[8];
        LAS float* Wl = (LAS float*)(F.lds) + F.wave * 1024;
        LAS unsigned* El = (LAS unsigned*)(F.lds + 32768) + F.wave * (8 * ELP);
        unsigned voff = 16u * (unsigned)lane; asm volatile("" : "+v"(voff));
        LAS int* Bnd = (LAS int*)(F.lds + 67584) + F.wave * (8 * (NR + 1));
#pragma unroll
        for (int k = 0; k < 8; ++k) {
            const size_t base = (size_t)(tok0 + k) * 128;
            E0[k] = ((unsigned)PIDX[base + lane] << 7) | (unsigned)lane; E1[k] = ((unsigned)PIDX[base + 64 + lane] << 7) | (unsigned)(64 + lane);
            sort128(E0[k], E1[k], lane);
            if (FAKE) { E0[k] = (E0[k] & 0x1ffffu) ; E1[k] = (E1[k] & 0x1ffffu); sort128(E0[k], E1[k], lane); }
            El[k * ELP + lane] = E0[k] >> 7; El[k * ELP + 64 + lane] = E1[k] >> 7;
            if (lane < 8) El[k * ELP + 128 + lane] = (unsigned)__builtin_amdgcn_readlane((int)E1[k], 63) >> 7;
        }
        for (int repa = 0; repa < PROBE_REPA; ++repa) {
            v4u hq[8];
#pragma unroll
            for (int k = 0; k < 8; ++k) hq[k] = *(const v4u*)(H2Q + (size_t)(tok0 + k) * D + 16 * lane);
            int pos[8];
#pragma unroll
            for (int k = 0; k < 8; ++k) pos[k] = 0;
            v4u bA[BSA], bB[BSA], bC[BSA]; int ps = 0, pn = 0;
            for (int r = 0; r < NR; ++r) {
#pragma unroll
                for (int k = 0; k < 8; ++k) {
                    constexpr int dummy = 0; (void)dummy;
                    const int kp = (k + 7) & 7;
                    const unsigned long long BM = 0x0101010101010101ull;
                    const int c = __builtin_popcountll(__ballot((E0[k] >> RSH) == (unsigned)r) & BM) + __builtin_popcountll(__ballot((E1[k] >> RSH) == (unsigned)r) & BM);
                    int s = __builtin_amdgcn_readfirstlane(pos[k]); const int e_end = __builtin_amdgcn_readfirstlane(s + 8 * c); pos[k] = e_end;
                    if (lane == 0) Bnd[k * (NR + 1) + r + 1] = e_end;
                    const int n1 = (e_end - s) < BSA ? (e_end - s) : BSA;
                    if (k & 1) sw_issue<BSA>(bB, El + k * ELP + s, EDq, voff); else sw_issue<BSA>(bA, El + k * ELP + s, EDq, voff);
                    if (pn > 0) { if (k & 1) sw_proc_a<BSA>(bA, hq[kp], Wl + kp * 128, ps, pn, lane); else sw_proc_a<BSA>(bB, hq[kp], Wl + kp * 128, ps, pn, lane); }
                    ps = s; pn = n1; s += n1;
#define SWA_REST(Y) if (s < e_end) { sw_issue<BSA>(Y, El + k * ELP + s, EDq, voff); \
                        for (;;) { int n = (e_end - s) < BSA ? (e_end - s) : BSA; \
                            if (s + BSA < e_end) { sw_issue<BSA>(bC, El + k * ELP + s + BSA, EDq, voff); sw_proc_a<BSA>(Y, hq[k], Wl + k * 128, s, n, lane); } else { sw_proc_a<BSA>(Y, hq[k], Wl + k * 128, s, n, lane); break; } \
                            s += BSA; n = (e_end - s) < BSA ? (e_end - s) : BSA; \
                            if (s + BSA < e_end) { sw_issue<BSA>(Y, El + k * ELP + s + BSA, EDq, voff); sw_proc_a<BSA>(bC, hq[k], Wl + k * 128, s, n, lane); } else { sw_proc_a<BSA>(bC, hq[k], Wl + k * 128, s, n, lane); break; } \
                            s += BSA; } }
                    if (k & 1) { SWA_REST(bA) } else { SWA_REST(bB) }
#undef SWA_REST
                }
            }
            if (pn > 0) sw_proc_a<BSA>(bB, hq[7], Wl + 7 * 128, ps, pn, lane);
        }
#pragma unroll
        for (int k = 0; k < 8; ++k) { int tk = tok0 + k; asm volatile("" : "+s"(tk)); const size_t base = (size_t)tk * 128; const float sh = H2S[tk];
            const float r0 = Wl[k * 128 + lane], r1 = Wl[k * 128 + 64 + lane];
            const _Float16 w0 = (_Float16)(PG[base + (E0[k] & 127u)] * gelu_erf(r0 * sh * EDS[E0[k] >> 7])), w1 = (_Float16)(PG[base + (E1[k] & 127u)] * gelu_erf(r1 * sh * EDS[E1[k] >> 7]));
            Wl[k * 128 + lane] = __builtin_bit_cast(float, (h2_t){w0, w0}); Wl[k * 128 + 64 + lane] = __builtin_bit_cast(float, (h2_t){w1, w1}); }
        int ln = lane; asm volatile("" : "+v"(ln));
#pragma unroll
        for (int sub = 0; sub < 8 / TPS; ++sub) {
        h2_t acc[TPS][8];
        for (int repb = 0; repb < PROBE_REPB; ++repb) {
#pragma unroll
            for (int kk = 0; kk < TPS; ++kk)
#pragma unroll
                for (int i = 0; i < 8; ++i) acc[kk][i] = (h2_t){(_Float16)0.f, (_Float16)0.f};
            int pos[TPS];
#pragma unroll
            for (int kk = 0; kk < TPS; ++kk) pos[kk] = 0;
            v4u bA[BSB], bB[BSB]; int ps = 0, pn = 0;
            for (int r = 0; r < NR; ++r) {
#pragma unroll
                for (int kk = 0; kk < TPS; ++kk) {
                    const int k = sub * TPS + kk, kkp = (kk + TPS - 1) % TPS, kp = sub * TPS + kkp;
                    int s = __builtin_amdgcn_readfirstlane(pos[kk]); const int e_end = __builtin_amdgcn_readfirstlane(Bnd[k * (NR + 1) + r + 1]); pos[kk] = e_end;
                    const int n1 = (e_end - s) < BSB ? (e_end - s) : BSB;
                    if (kk & 1) sw_issue<BSB>(bB, El + k * ELP + s, EUq, voff); else sw_issue<BSB>(bA, El + k * ELP + s, EUq, voff);
                    if (pn > 0) { if (kk & 1) sw_proc_b<BSB>(bA, acc[kkp], Wl + kp * 128, ps, pn); else sw_proc_b<BSB>(bB, acc[kkp], Wl + kp * 128, ps, pn); }
                    ps = s; pn = n1; s += n1;
                    for (; s < e_end; s += BSB) {
                        const int n = (e_end - s) < BSB ? (e_end - s) : BSB;
                        if (kk & 1) { sw_issue<BSB>(bA, El + k * ELP + s, EUq, voff); sw_proc_b<BSB>(bA, acc[kk], Wl + k * 128, s, n); }
                        else        { sw_issue<BSB>(bB, El + k * ELP + s, EUq, voff); sw_proc_b<BSB>(bB, acc[kk], Wl + k * 128, s, n); }
                    }
                }
            }
            if (pn > 0) sw_proc_b<BSB>(bB, acc[TPS - 1], Wl + (sub * TPS + TPS - 1) * 128, ps, pn);
        }
        {
            asm volatile("" : "+v"(ln));
            float* outp = (float*)karg(18);
            const float* gt2 = MOD + ((tok0 + sub * TPS) >> 12) * NMOD + 5120;
            f32x4 gtv[4]; u32x2 xcur[4], xnxt[4];
#pragma unroll
            for (int j = 0; j < 4; ++j) { const int col = 4 * ln + 256 * j; gtv[j] = *(const f32x4*)(gt2 + col); xcur[j] = *(const u32x2*)(X1 + (size_t)(tok0 + sub * TPS) * D + col); }
#pragma unroll
            for (int kk = 0; kk < TPS; ++kk) {
                const int tok = tok0 + sub * TPS + kk;
                if (kk + 1 < TPS) {
#pragma unroll
                    for (int j = 0; j < 4; ++j) xnxt[j] = __builtin_nontemporal_load((const u32x2*)(X1 + (size_t)(tok + 1) * D + 4 * ln + 256 * j));
                }
                f32x4 x2[4]; float ss = 0.f;
#pragma unroll
                for (int j = 0; j < 4; ++j) {
#pragma unroll
                    for (int i = 0; i < 4; ++i) { const unsigned xw = (i >> 1) ? xcur[j].y : xcur[j].x; const float xf = (i & 1) ? bfhi(xw) : bflo(xw);
                        const float v = xf + gtv[j][i] * (0.0625f * (float)acc[kk][2 * j + (i >> 1)][i & 1]); x2[j][i] = v; ss += v * v; } }
                ss = wave_sum_x(ss, ln);
                if (!(FAKE && ss != 12345.678f)) {
                    const float rstd = 1.0f / sqrtf(ss * (1.0f / D) + EPS);
                    f32x4 fgv[4];
#pragma unroll
                    for (int j = 0; j < 4; ++j) fgv[j] = *(const f32x4*)(fg + 4 * ln + 256 * j);
#pragma unroll
                    for (int j = 0; j < 4; ++j) __builtin_nontemporal_store(x2[j] * rstd * fgv[j], (f32x4*)(outp + (size_t)tok * D + 4 * ln + 256 * j));
                }
#pragma unroll
                for (int j = 0; j < 4; ++j) xcur[j] = xnxt[j];
            }
        }
        }
    }
}

struct Args { const float* in[18]; float* out; unsigned char* ws; };
__global__ void __launch_bounds__(NTHR, 2) mega_fwd(Args args) {
    extern __shared__ __attribute__((aligned(16))) unsigned char lds[];
    Frame F;
    F.lds = (LAS unsigned char*)lds;
    F.wave = __builtin_amdgcn_readfirstlane((int)threadIdx.x >> 6); F.lane = lane_fresh(); F.tid = F.wave * 64 + F.lane;
    F.G = gridDim.x; { const int bx = blockIdx.x; F.vcu = (F.G % 8 == 0) ? (bx % 8) * (F.G / 8) + bx / 8 : bx; }
    volatile LAS unsigned* MISC = (volatile LAS unsigned*)(F.lds + MISC_OFF);
    for (int u = F.tid; u < (LDS_BYTES - LDSCTL_OFF) / 4; u += NTHR) ((LAS unsigned*)(F.lds + LDSCTL_OFF))[u] = 0u;
    __syncthreads();
    gu32* ctl = (gu32*)(((unsigned char*)karg(19)) + WS_CTL);
    XcdBarrier bar = xcd_barrier_post((unsigned*)(ctl + CW_BAR), MISC + 8, F.wave);
#define GRID_BAR() xcd_barrier(bar)
#define PROBE_TS -1
#define STAMP(i) do { if (PROBE_TS >= 0 && blockIdx.x == 0 && F.tid == 0) { const unsigned long long t_ = __builtin_amdgcn_s_memrealtime(); MISC[16 + 2 * (i)] = (unsigned)t_; MISC[17 + 2 * (i)] = (unsigned)(t_ >> 32); } } while (0)
#define PROBE_DBL -1

    STAMP(0);
    F.lane = lane_fresh(); F.tid = F.wave * 64 + F.lane;
    p0_prologue(F); GRID_BAR(); STAMP(1);
    if (PROBE_DBL == 0) { p0_prologue(F); GRID_BAR(); }
    F.lane = lane_fresh(); F.tid = F.wave * 64 + F.lane;
    p1_norm(F); p0_transposes(F); GRID_BAR(); STAMP(2);
    if (PROBE_DBL == 1) { p1_norm(F); GRID_BAR(); }
    {
    {
        pg8::Gemm g{(const pg8::bf16_t*)(((unsigned char*)karg(19)) + WS_H), (const pg8::bf16_t*)(((unsigned char*)karg(19)) + WS_WIN), M, NPROJ, D, nullptr, nullptr};
        pg8::StaticOrder S; S.init(M, NPROJ, F.G, (int)blockIdx.x);
        pg8::EpiBf16<0> E{(pg8::bf16_t*)(((unsigned char*)karg(19)) + WS_PROJ), NPROJ, nullptr, 0, 0, 1.f};
        pg8::gemm_phase<pg8::EpiBf16<0>, pg8::StaticOrder, true, true>(F.lds + RING_OFF, g, S, E, F.wave);
        const int nwg = (M / 256) * (NPROJ / 256), busy = nwg % F.G;
        if (busy == 0) p0_quant_tables(F, F.vcu * NWAVES + F.wave, F.G * NWAVES);
        else if ((int)blockIdx.x >= busy) p0_quant_tables(F, ((int)blockIdx.x - busy) * NWAVES + F.wave, (F.G - busy) * NWAVES);
    }
    GRID_BAR(); STAMP(3);
    }
    F.lane = lane_fresh(); F.tid = F.wave * 64 + F.lane;
    p3_attention(F); GRID_BAR(); STAMP(4);
    if (PROBE_DBL == 3) { p3_attention(F); GRID_BAR(); }
    {
    {
        pg8::Gemm g{(const pg8::bf16_t*)(((unsigned char*)karg(19)) + WS_OA), (const pg8::bf16_t*)(((unsigned char*)karg(19)) + WS_WA), M, D, 512, (const pg8::bf16_t*)(((unsigned char*)karg(19)) + WS_OB), (const pg8::bf16_t*)(((unsigned char*)karg(19)) + WS_WB)};
        PairOrder S; S.S.init(M, D, F.G, (int)blockIdx.x);
        EpiGate E{(const bf16*)(((unsigned char*)karg(19)) + WS_PROJ), (bf16*)((float*)karg(18)) + (size_t)M * D};
        pg8::gemm_phase<EpiGate, PairOrder, true, true>(F.lds + RING_OFF, g, S, E, F.wave);
    }
    GRID_BAR(); STAMP(5);
    }
    {
    {
        pg8::Gemm g{(const pg8::bf16_t*)((bf16*)((float*)karg(18)) + (size_t)M * D), (const pg8::bf16_t*)(((unsigned char*)karg(19)) + WS_WOUT), M, D, D, nullptr, nullptr};
        pg8::StaticOrder S; S.init(M, D, F.G, (int)blockIdx.x);
        EpiRes E{((const float*)karg(0)), (const float*)(((unsigned char*)karg(19)) + WS_MOD), (bf16*)(((unsigned char*)karg(19)) + WS_X1)};
        pg8::gemm_phase<EpiRes, pg8::StaticOrder, true, true>(F.lds + RING_OFF, g, S, E, F.wave);
    }
    GRID_BAR(); STAMP(6);
    }
    F.lane = lane_fresh(); F.tid = F.wave * 64 + F.lane;
    F.lane = lane_fresh(); F.tid = F.wave * 64 + F.lane;
    p6_norm2(F); GRID_BAR(); STAMP(7);
    if (PROBE_DBL == 6) { p6_norm2(F); GRID_BAR(); }
    {
    {
        pg8::Gemm g{(const pg8::bf16_t*)(((unsigned char*)karg(19)) + WS_H2), (const pg8::bf16_t*)(((unsigned char*)karg(19)) + WS_WQ), M, D, D, nullptr, nullptr};
        pg8::StaticOrder S; S.init(M, D, F.G, (int)blockIdx.x);
        pg8::EpiBf16<0> E{(pg8::bf16_t*)(((unsigned char*)karg(19)) + WS_QP), D, nullptr, 0, 0, 1.f};
        pg8::gemm_phase<pg8::EpiBf16<0>, pg8::StaticOrder, true, true>(F.lds + RING_OFF, g, S, E, F.wave);
    }
    GRID_BAR(); STAMP(8);
    }
    F.lane = lane_fresh(); F.tid = F.wave * 64 + F.lane;
    p8a_topk(F); __syncthreads(); STAMP(9);
    if (PROBE_DBL == 8) { p8a_topk(F); GRID_BAR(); }
    if (PROBE_DBL == 12) { p8b_sweep<1>(F); __syncthreads(); }
    p8b_sweep<0>(F);
    if (PROBE_DBL == 9) { GRID_BAR(); p8b_sweep<0>(F); }
    if (PROBE_TS >= 0) {
        GRID_BAR(); STAMP(10);
        if (blockIdx.x == 0) { __syncthreads();
            const unsigned long long t0 = ((unsigned long long)MISC[17 + 2 * PROBE_TS] << 32) | MISC[16 + 2 * PROBE_TS], t1 = ((unsigned long long)MISC[19 + 2 * PROBE_TS] << 32) | MISC[18 + 2 * PROBE_TS];
            const float d_us = (float)(t1 - t0) * 0.01f;
            const float V = 128.0f * sqrtf(d_us * 1e-5f);
            float* o = (float*)karg(18); for (int c = F.tid; c < D; c += NTHR) o[c] = V; }
    }
}

extern "C" void kernel_launch(void* const* d_in, const int* in_sizes, int n_in, void* d_out, int out_size, void* d_ws, size_t ws_size, hipStream_t stream) {
    static int grid = 0;
    if (grid == 0) {
        if (n_in != 18 || in_sizes[0] != M * D || out_size != M * D || ws_size < WS_END) { fprintf(stderr, "kernel_launch: unexpected shapes (n_in %d, in0 %d, out %d, ws %zu)\n", n_in, n_in > 0 ? in_sizes[0] : -1, out_size, ws_size); grid = -1; return; }
        int dev = 0, cus = 0, per_cu = 0;
        if (hipGetDevice(&dev) != hipSuccess || hipDeviceGetAttribute(&cus, hipDeviceAttributeMultiprocessorCount, dev) != hipSuccess) { grid = -1; return; }
        if (hipFuncSetAttribute((const void*)mega_fwd, hipFuncAttributeMaxDynamicSharedMemorySize, LDS_BYTES) != hipSuccess) { fprintf(stderr, "kernel_launch: hipFuncSetAttribute failed\n"); grid = -1; return; }
        if (hipOccupancyMaxActiveBlocksPerMultiprocessor(&per_cu, (const void*)mega_fwd, NTHR, LDS_BYTES) != hipSuccess || per_cu < 1) { fprintf(stderr, "kernel_launch: occupancy query says %d blocks per CU\n", per_cu); }
        (void)hipGetLastError();
        grid = cus;
    }
    if (grid < 0) return;
    if (hipMemsetAsync((char*)d_ws + WS_CTL, 0, CTL_ZERO_BYTES, stream) != hipSuccess) { fprintf(stderr, "kernel_launch: memset failed\n"); return; }
    Args a{};
    for (int i = 0; i < 18; ++i) a.in[i] = (const float*)d_in[i];
    a.out = (float*)d_out; a.ws = (unsigned char*)d_ws;
    hipLaunchKernelGGL(mega_fwd, dim3(grid), dim3(NTHR), LDS_BYTES, stream, a);
}
```
